# Optimizing an MI355X kernel written in HIP

```python
import math
import functools
import jax
import jax.numpy as jnp
from jax import lax
import numpy as np

D_MODEL = 2048
BATCH = 4
SEQ = 4096
DEPTH = 2

GRID_W = 64
CTX_LEN = 256
MIX_HALF = D_MODEL // 2
D_FF = ((8 * D_MODEL // 3 + 127) // 128) * 128
FFN_RES = 0.5
N_MOD = 9
CHUNK = 64
EPS = 1e-6

GLA_HEADS = 4
GLA_DV = MIX_HALF // GLA_HEADS
GLA_DK = GLA_DV // 2
GLA_QK = GLA_HEADS * GLA_DK
GLA_RANK = 16
GLA_GATE_NORM = 16.0

MLSTM_HEADS = 4
MLSTM_DH = MIX_HALF // MLSTM_HEADS
MLSTM_CONV = 3

S5_CHANNELS = MIX_HALF
S5_GROUP = 16
S5_GROUPS = S5_CHANNELS // S5_GROUP
S5_STATE = 64

RET_HEADS = 4
RET_DH = MIX_HALF // RET_HEADS

N_EVEN = (DEPTH + 1) // 2
N_ODD = DEPTH // 2

EV_SIZES = (GLA_QK, GLA_QK, MIX_HALF, MIX_HALF, 2 * GLA_RANK, MIX_HALF, MIX_HALF, MIX_HALF, MIX_HALF, 4 * MLSTM_HEADS)
EV_COLS = sum(EV_SIZES)
OD_SIZES = (S5_CHANNELS, MIX_HALF, MIX_HALF, MIX_HALF, MIX_HALF)
OD_COLS = sum(OD_SIZES)

kernel_name = "hybrid_gla_mlstm_s5_retention_dit"


def rms_norm(x, g):
    xf = x.astype(jnp.float32)
    y = xf * lax.rsqrt(jnp.mean(xf * xf, axis=-1, keepdims=True) + EPS)
    return (y * g.astype(jnp.float32)).astype(x.dtype)


def head_norm(o, g, center):
    b, h, n, d = o.shape
    o = o.transpose(0, 2, 1, 3)
    if center:
        o = o - jnp.mean(o, axis=-1, keepdims=True)
    o = o * lax.rsqrt(jnp.mean(o * o, axis=-1, keepdims=True) + EPS)
    return o.reshape(b, n, h * d) * g


def sublayer_in(h, g, shift, scale):
    return rms_norm(h, g) * (1 + scale) + shift


def sublayer_out(y, g, gate, weight):
    return weight * gate * rms_norm(y, g)


def swiglu(h, w_gate, w_up, w_down):
    return (jax.nn.silu(h @ w_gate) * (h @ w_up)) @ w_down


def split_cols(p, sizes):
    out, start = [], 0
    for s in sizes:
        out.append(p[..., start:start + s])
        start += s
    return out


def split_heads(t, heads):
    b, n, _ = t.shape
    return t.reshape(b, n, heads, -1).transpose(0, 2, 1, 3)


def to_col_major(t, rows):
    b, rest = t.shape[0], t.shape[2:]
    return t.reshape(b, rows, GRID_W, *rest).swapaxes(1, 2).reshape(b, rows * GRID_W, *rest)


def to_row_major(t, rows):
    b, rest = t.shape[0], t.shape[2:]
    return t.reshape(b, GRID_W, rows, *rest).swapaxes(1, 2).reshape(b, rows * GRID_W, *rest)


def depthwise_conv(u, w, bias):
    out = lax.conv_general_dilated(u, w[:, None, :].astype(u.dtype), window_strides=(1,), padding='SAME',
                                   dimension_numbers=('NWC', 'WIO', 'NWC'), feature_group_count=u.shape[-1])
    return out + bias


def to_chunks(t):
    b, h, n = t.shape[:3]
    return jnp.moveaxis(t.reshape(b, h, n // CHUNK, CHUNK, *t.shape[3:]), 2, 0)


def from_chunks(t):
    t = jnp.moveaxis(t, 0, 2)
    return t.reshape(t.shape[0], t.shape[1], t.shape[2] * t.shape[3], *t.shape[4:])


def gla_scan(q, k, v, log_a, s0):
    mask = jnp.tril(jnp.ones((CHUNK, CHUNK), dtype=bool))
    mid = CHUNK // 2

    def step(s, inp):
        qc, kc, vc, ac = inp
        b = jnp.cumsum(ac, axis=2)
        b_mid = b[:, :, mid:mid + 1]
        b_end = b[:, :, -1:]
        scores = jnp.einsum('bhtd,bhsd->bhts', qc * jnp.exp(b - b_mid), kc * jnp.exp(b_mid - b))
        scores = jnp.where(mask, scores, 0.0)
        o = (jnp.einsum('bhts,bhsv->bhtv', scores, vc)
             + jnp.einsum('bhtd,bhdv->bhtv', qc * jnp.exp(b), s))
        s_new = (jnp.exp(b_end[:, :, 0])[..., None] * s
                 + jnp.einsum('bhsd,bhsv->bhdv', kc * jnp.exp(b_end - b), vc))
        return s_new, o

    s_fin, o = lax.scan(step, s0, (to_chunks(q), to_chunks(k), to_chunks(v), to_chunks(log_a)))
    return from_chunks(o), s_fin


def mlstm_scan(q, k, v, ig, lf, state):
    mask = jnp.tril(jnp.ones((CHUNK, CHUNK), dtype=bool))

    def step(carry, inp):
        c_st, n_st, m_st = carry
        qc, kc, vc, ic, fc = inp
        b = jnp.cumsum(fc, axis=-1)
        dmat = jnp.where(mask, b[..., :, None] - b[..., None, :] + ic[..., None, :], -jnp.inf)
        inter = b + m_st[..., None]
        m_t = jnp.maximum(inter, jnp.max(dmat, axis=-1))
        scores = jnp.einsum('bhtd,bhsd->bhts', qc, kc) * jnp.exp(dmat - m_t[..., None])
        w_inter = jnp.exp(inter - m_t)
        num = (jnp.einsum('bhts,bhsv->bhtv', scores, vc)
               + w_inter[..., None] * jnp.einsum('bhtd,bhdv->bhtv', qc, c_st))
        den = jnp.sum(scores, axis=-1) + w_inter * jnp.einsum('bhtd,bhd->bht', qc, n_st)
        h = num / jnp.maximum(jnp.abs(den), jnp.exp(-m_t))[..., None]
        b_end = b[..., -1]
        d_end = b_end[..., None] - b + ic
        m_new = jnp.maximum(b_end + m_st, jnp.max(d_end, axis=-1))
        wk = jnp.exp(d_end - m_new[..., None])
        decay = jnp.exp(b_end + m_st - m_new)
        c_new = decay[..., None, None] * c_st + jnp.einsum('bhsd,bhsv->bhdv', kc * wk[..., None], vc)
        n_new = decay[..., None] * n_st + jnp.einsum('bhsd,bhs->bhd', kc, wk)
        return (c_new, n_new, m_new), h

    fin, h = lax.scan(step, state, (to_chunks(q), to_chunks(k), to_chunks(v), to_chunks(ig), to_chunks(lf)))
    return from_chunks(h), fin


def complex_affine_combine(e1, e2):
    a1r, a1i, b1r, b1i = e1
    a2r, a2i, b2r, b2i = e2
    return (a2r * a1r - a2i * a1i, a2r * a1i + a2i * a1r,
            a2r * b1r - a2i * b1i + b2r, a2r * b1i + a2i * b1r + b2i)


def s5_direction(lam_re, lam_im, log_step, b_re, b_im, c_re, c_im, u, state):
    lam_re = lam_re.astype(jnp.float32)
    lam_im = lam_im.astype(jnp.float32)
    step = jnp.exp(log_step.astype(jnp.float32))[:, None]
    mag = jnp.exp(lam_re * step)
    ab_re, ab_im = mag * jnp.cos(lam_im * step), mag * jnp.sin(lam_im * step)
    den = lam_re * lam_re + lam_im * lam_im
    coef_re = ((ab_re - 1.0) * lam_re + ab_im * lam_im) / den
    coef_im = (ab_im * lam_re - (ab_re - 1.0) * lam_im) / den
    bu_re = jnp.einsum('bngp,gsp->bngs', u, b_re)
    bu_im = jnp.einsum('bngp,gsp->bngs', u, b_im)
    x_re = coef_re * bu_re - coef_im * bu_im
    x_im = coef_re * bu_im + coef_im * bu_re
    a_re = jnp.broadcast_to(ab_re, x_re.shape)
    a_im = jnp.broadcast_to(ab_im, x_re.shape)
    acc_re, acc_im, hs_re, hs_im = lax.associative_scan(complex_affine_combine, (a_re, a_im, x_re, x_im), axis=1)
    h0_re, h0_im = state[0][:, None], state[1][:, None]
    h_re = hs_re + acc_re * h0_re - acc_im * h0_im
    h_im = hs_im + acc_re * h0_im + acc_im * h0_re
    y = jnp.einsum('bngs,gps->bngp', h_re, c_re) - jnp.einsum('bngs,gps->bngp', h_im, c_im)
    return y, (h_re[:, -1], h_im[:, -1])


def bidirectional(scan_f, scan_b, ctx_f, lat_f, ctx_b, lat_b, state0, axis):
    flip = lambda t: jnp.flip(t, axis=axis)
    oc_f, sc_f = scan_f(*ctx_f, state0)
    ol_f, _ = scan_f(*lat_f, sc_f)
    oc_b, sc_b = scan_b(*[flip(t) for t in ctx_b], state0)
    ol_b, _ = scan_b(*[flip(t) for t in lat_b], sc_b)
    return oc_f + flip(oc_b), ol_f + flip(ol_b)


def even_mixer(hx, hc, rows, need_ctx, w_in, w_out, gla_w_gate, gla_b_gate, gla_norm,
               ml_conv_w, ml_conv_b, ml_b_gates, ml_norm):
    bsz = hx.shape[0]
    sx = split_cols((hx @ w_in).astype(jnp.float32), EV_SIZES)
    sc = split_cols((hc @ w_in).astype(jnp.float32), EV_SIZES)

    def gla_prep(s):
        q, k, v, _, low_rank = s[:5]
        base = (split_heads(q, GLA_HEADS) * GLA_DK ** -0.5, split_heads(k, GLA_HEADS), split_heads(v, GLA_HEADS))
        dirs = []
        for d in range(2):
            z = low_rank[..., d * GLA_RANK:(d + 1) * GLA_RANK] @ gla_w_gate[d] + gla_b_gate[d]
            dirs.append(base + (split_heads(jax.nn.log_sigmoid(z) / GLA_GATE_NORM, GLA_HEADS),))
        return dirs

    gc, gx = gla_prep(sc), gla_prep(sx)
    s0 = jnp.zeros((bsz, GLA_HEADS, GLA_DK, GLA_DV), jnp.float32)
    oc_a, ox_a = bidirectional(gla_scan, gla_scan, gc[0], gx[0], gc[1], gx[1], s0, axis=2)

    def ml_prep(s, reorder):
        q, k, v, _, g = s[5:]
        if reorder:
            q, k, v, g = (to_col_major(t, rows) for t in (q, k, v, g))
        qk = jax.nn.silu(depthwise_conv(jnp.concatenate([q, k], axis=-1), ml_conv_w, ml_conv_b))
        base = (split_heads(qk[..., :MIX_HALF], MLSTM_HEADS),
                split_heads(qk[..., MIX_HALF:], MLSTM_HEADS) * MLSTM_DH ** -0.5,
                split_heads(v, MLSTM_HEADS))
        gates = (g.reshape(g.shape[0], g.shape[1], 2, 2, MLSTM_HEADS) + ml_b_gates).transpose(2, 3, 0, 4, 1)
        return [base + (gates[d, 0], jax.nn.log_sigmoid(gates[d, 1])) for d in range(2)]

    mc, mx = ml_prep(sc, False), ml_prep(sx, True)
    m0 = (jnp.zeros((bsz, MLSTM_HEADS, MLSTM_DH, MLSTM_DH), jnp.float32),
          jnp.zeros((bsz, MLSTM_HEADS, MLSTM_DH), jnp.float32),
          jnp.zeros((bsz, MLSTM_HEADS), jnp.float32))
    oc_b, ox_b = bidirectional(mlstm_scan, mlstm_scan, mc[0], mx[0], mc[1], mx[1], m0, axis=2)

    def merge(o_a, o_b, s, reorder):
        a = jax.nn.silu(s[3]) * head_norm(o_a, gla_norm, False)
        b = head_norm(o_b, ml_norm, True)
        if reorder:
            b = to_row_major(b, rows)
        b = jax.nn.sigmoid(s[8]) * b
        return jnp.concatenate([a, b], axis=-1).astype(hx.dtype) @ w_out

    yx = merge(ox_a, ox_b, sx, True)
    yc = merge(oc_a, oc_b, sc, False) if need_ctx else None
    return yx, yc


def odd_mixer(hx, hc, rows, need_ctx, w_in, w_out, lam_re, lam_im, log_step, b_re, b_im, c_re, c_im,
              s5_d, w_glu, b_glu, ret_log_decay, ret_norm):
    bsz = hx.shape[0]
    sx = split_cols((hx @ w_in).astype(jnp.float32), OD_SIZES)
    sc = split_cols((hc @ w_in).astype(jnp.float32), OD_SIZES)

    scans = [functools.partial(s5_direction, lam_re[d], lam_im[d], log_step[d], b_re[d], b_im[d], c_re[d], c_im[d])
             for d in range(2)]
    grp = lambda u: u.reshape(u.shape[0], u.shape[1], S5_GROUPS, S5_GROUP)
    uc, ux = grp(sc[0]), grp(sx[0])
    h0 = (jnp.zeros((bsz, S5_GROUPS, S5_STATE), jnp.float32), jnp.zeros((bsz, S5_GROUPS, S5_STATE), jnp.float32))
    oc_c, ox_c = bidirectional(scans[0], scans[1], (uc,), (ux,), (uc,), (ux,), h0, axis=1)

    log_gamma = -jnp.exp(ret_log_decay.astype(jnp.float32))

    def ret_prep(s, reorder):
        q, k, v = s[1:4]
        if reorder:
            q, k, v = (to_col_major(t, rows) for t in (q, k, v))
        base = (split_heads(q, RET_HEADS), split_heads(k, RET_HEADS) * RET_DH ** -0.5, split_heads(v, RET_HEADS))
        shape = base[0].shape
        return [base + (jnp.broadcast_to(log_gamma[d][None, :, None, None], shape),) for d in range(2)]

    rc, rx = ret_prep(sc, False), ret_prep(sx, True)
    r0 = jnp.zeros((bsz, RET_HEADS, RET_DH, RET_DH), jnp.float32)
    oc_d, ox_d = bidirectional(gla_scan, gla_scan, rc[0], rx[0], rc[1], rx[1], r0, axis=2)

    def merge(o_c, o_d, s, reorder):
        y = o_c.reshape(s[0].shape) + s5_d * s[0]
        g = jax.nn.gelu(y)
        a = g * jax.nn.sigmoid(g @ w_glu + b_glu)
        b = head_norm(o_d, ret_norm, True)
        if reorder:
            b = to_row_major(b, rows)
        b = jax.nn.silu(s[4]) * b
        return jnp.concatenate([a, b], axis=-1).astype(hx.dtype) @ w_out

    yx = merge(ox_c, ox_d, sx, True)
    yc = merge(oc_c, oc_d, sc, False) if need_ctx else None
    return yx, yc


def setup_inputs(seed: int = 0) -> dict:
    key = jax.random.key(seed)
    keys = iter(jax.random.split(key, 48))

    def nrm(shape, scale):
        return jax.random.normal(next(keys), shape, jnp.float32) * scale

    D = D_MODEL
    gate_bias = jnp.stack([jnp.zeros((MLSTM_HEADS,), jnp.float32),
                           jnp.linspace(3.0, 6.0, MLSTM_HEADS, dtype=jnp.float32)])
    ret_base = jnp.log(-jnp.log(1.0 - 2.0 ** (-5.0 - jnp.arange(RET_HEADS, dtype=jnp.float32))))
    return {
        'x': nrm((BATCH, SEQ, D), 1.0),
        'c': nrm((BATCH, D), 1.0),
        'ctx': nrm((BATCH, CTX_LEN, D), 1.0),
        'c_ctx': nrm((D,), 1.0),
        'w_mod': nrm((DEPTH, D, N_MOD * D), 0.5 * D ** -0.5),
        'b_mod': nrm((DEPTH, N_MOD * D), 0.02),
        'norm_pre': 1.0 + nrm((DEPTH, 3, D), 0.02),
        'norm_post': 1.0 + nrm((DEPTH, 3, D), 0.02),
        'ffn_w_gate': nrm((DEPTH, 2, D, D_FF), D ** -0.5),
        'ffn_w_up': nrm((DEPTH, 2, D, D_FF), D ** -0.5),
        'ffn_w_down': nrm((DEPTH, 2, D_FF, D), D_FF ** -0.5),
        'ev_w_in': nrm((N_EVEN, D, EV_COLS), D ** -0.5),
        'ev_w_out': nrm((N_EVEN, 2 * MIX_HALF, D), (2 * MIX_HALF) ** -0.5),
        'gla_w_gate': nrm((N_EVEN, 2, GLA_RANK, GLA_QK), GLA_RANK ** -0.5),
        'gla_b_gate': 2.0 + nrm((N_EVEN, 2, GLA_QK), 0.1),
        'gla_norm': 1.0 + nrm((N_EVEN, MIX_HALF), 0.02),
        'ml_conv_w': nrm((N_EVEN, MLSTM_CONV, 2 * MIX_HALF), MLSTM_CONV ** -0.5),
        'ml_conv_b': nrm((N_EVEN, 2 * MIX_HALF), 0.02),
        'ml_b_gates': gate_bias + nrm((N_EVEN, 2, 2, MLSTM_HEADS), 0.1),
        'ml_norm': 1.0 + nrm((N_EVEN, MIX_HALF), 0.02),
        'od_w_in': nrm((N_ODD, D, OD_COLS), D ** -0.5),
        'od_w_out': nrm((N_ODD, 2 * MIX_HALF, D), (2 * MIX_HALF) ** -0.5),
        's5_lam_re': -0.5 + nrm((N_ODD, 2, S5_GROUPS, S5_STATE), 0.01),
        's5_lam_im': jnp.pi * jnp.arange(S5_STATE, dtype=jnp.float32) + nrm((N_ODD, 2, S5_GROUPS, S5_STATE), 0.01),
        's5_log_step': jax.random.uniform(next(keys), (N_ODD, 2, S5_GROUPS), jnp.float32,
                                          math.log(1e-3), math.log(1e-1)),
        's5_b_re': nrm((N_ODD, 2, S5_GROUPS, S5_STATE, S5_GROUP), (2 * S5_GROUP) ** -0.5),
        's5_b_im': nrm((N_ODD, 2, S5_GROUPS, S5_STATE, S5_GROUP), (2 * S5_GROUP) ** -0.5),
        's5_c_re': nrm((N_ODD, 2, S5_GROUPS, S5_GROUP, S5_STATE), 0.5),
        's5_c_im': nrm((N_ODD, 2, S5_GROUPS, S5_GROUP, S5_STATE), 0.5),
        's5_d': nrm((N_ODD, S5_CHANNELS), 0.5),
        's5_w_glu': nrm((N_ODD, S5_CHANNELS, S5_CHANNELS), S5_CHANNELS ** -0.5),
        's5_b_glu': nrm((N_ODD, S5_CHANNELS), 0.02),
        'ret_log_decay': ret_base + nrm((N_ODD, 2, RET_HEADS), 0.05),
        'ret_norm': 1.0 + nrm((N_ODD, MIX_HALF), 0.02),
    }


def reference(x, c, ctx, c_ctx, w_mod, b_mod, norm_pre, norm_post, ffn_w_gate, ffn_w_up, ffn_w_down,
              ev_w_in, ev_w_out, gla_w_gate, gla_b_gate, gla_norm, ml_conv_w, ml_conv_b, ml_b_gates, ml_norm,
              od_w_in, od_w_out, s5_lam_re, s5_lam_im, s5_log_step, s5_b_re, s5_b_im, s5_c_re, s5_c_im,
              s5_d, s5_w_glu, s5_b_glu, ret_log_decay, ret_norm):
    rows = x.shape[1] // GRID_W
    for layer in range(DEPTH):
        need_ctx = layer < DEPTH - 1
        mod_x = (jax.nn.silu(c) @ w_mod[layer] + b_mod[layer]).reshape(c.shape[0], N_MOD, 1, D_MODEL)
        mod_c = (jax.nn.silu(c_ctx) @ w_mod[layer] + b_mod[layer]).reshape(N_MOD, D_MODEL)
        mx = [mod_x[:, j] for j in range(N_MOD)]
        mc = [mod_c[j] for j in range(N_MOD)]
        g_pre, g_post = norm_pre[layer], norm_post[layer]
        wg, wu, wd = ffn_w_gate[layer], ffn_w_up[layer], ffn_w_down[layer]

        x = x + sublayer_out(swiglu(sublayer_in(x, g_pre[0], mx[0], mx[1]), wg[0], wu[0], wd[0]), g_post[0], mx[2], FFN_RES)
        ctx = ctx + sublayer_out(swiglu(sublayer_in(ctx, g_pre[0], mc[0], mc[1]), wg[0], wu[0], wd[0]), g_post[0], mc[2], FFN_RES)

        hx = sublayer_in(x, g_pre[1], mx[3], mx[4])
        hc = sublayer_in(ctx, g_pre[1], mc[3], mc[4])
        if layer % 2 == 0:
            e = layer // 2
            yx, yc = even_mixer(hx, hc, rows, need_ctx, ev_w_in[e], ev_w_out[e], gla_w_gate[e], gla_b_gate[e],
                                gla_norm[e], ml_conv_w[e], ml_conv_b[e], ml_b_gates[e], ml_norm[e])
        else:
            o = layer // 2
            yx, yc = odd_mixer(hx, hc, rows, need_ctx, od_w_in[o], od_w_out[o], s5_lam_re[o], s5_lam_im[o],
                               s5_log_step[o], s5_b_re[o], s5_b_im[o], s5_c_re[o], s5_c_im[o], s5_d[o],
                               s5_w_glu[o], s5_b_glu[o], ret_log_decay[o], ret_norm[o])
        x = x + sublayer_out(yx, g_post[1], mx[5], 1.0)

        x = x + sublayer_out(swiglu(sublayer_in(x, g_pre[2], mx[6], mx[7]), wg[1], wu[1], wd[1]), g_post[2], mx[8], FFN_RES)
        if need_ctx:
            ctx = ctx + sublayer_out(yc, g_post[1], mc[5], 1.0)
            ctx = ctx + sublayer_out(swiglu(sublayer_in(ctx, g_pre[2], mc[6], mc[7]), wg[1], wu[1], wd[1]), g_post[2], mc[8], FFN_RES)
    return x
```

```cpp
#include <hip/hip_runtime.h>
#include <cstdio>
#include <cstdint>
#define MIXER_ON 1

#define XB_TMO      128
#define XB_XCNT(j)  (256  + 64 * (j))
#define XB_XSUB(j)  (1280 + 64 * (j))
#define XB_XGEN(j)  (2304 + 64 * (j))
#define XB_TOP      3328
#define XB_TOPGEN   3392
#define XCD_BAR_WORDS 3456
#define XB_SPIN_CAP (1u << 18)
#define LAS __attribute__((address_space(3)))

__device__ __forceinline__ unsigned xb_ld(unsigned* p)              { return __hip_atomic_load(p, __ATOMIC_RELAXED, __HIP_MEMORY_SCOPE_AGENT); }
__device__ __forceinline__ unsigned xb_add(unsigned* p, unsigned v) { return __hip_atomic_fetch_add(p, v, __ATOMIC_RELAXED, __HIP_MEMORY_SCOPE_AGENT); }
__device__ __forceinline__ unsigned xb_xcc_id() { return (unsigned)__builtin_amdgcn_s_getreg((3 << 11) | 20) & 0xFu; }
#define XB_SPIN(cond, bar) do { unsigned _sp = 0; while (cond) { __builtin_amdgcn_s_sleep(1); \
    if ((++_sp & 255u) == 0u) { if (xb_ld(&(bar)[XB_TMO])) break; if (_sp > XB_SPIN_CAP) { atomicAdd(&(bar)[XB_TMO], 1u); break; } } } } while (0)

struct XcdBarrier {
    unsigned* bar; unsigned x;
    volatile LAS unsigned* st;
};

__device__ __forceinline__ XcdBarrier xcd_barrier_post(unsigned* bar, volatile LAS unsigned* st) {
    XcdBarrier b; b.bar = bar; b.x = xb_xcc_id(); b.st = st;
    if (threadIdx.x == 0) (void)xb_add(&bar[XB_XCNT(b.x)], 1u);
    return b;
}
__device__ __forceinline__ void xcd_barrier_complete(unsigned* bar, unsigned x, unsigned& nloc, unsigned& nx) {
    const unsigned G = gridDim.x * gridDim.y * gridDim.z;
    unsigned sum, cnt, mine, sp = 0u;
    for (;;) {
        sum = 0u; cnt = 0u; mine = 0u;
#pragma unroll
        for (unsigned j = 0; j < 16; ++j) { const unsigned c = xb_ld(&bar[XB_XCNT(j)]); sum += c; cnt += (c > 0u) ? 1u : 0u; mine = (j == x) ? c : mine; }
        if (sum == G) break;
        __builtin_amdgcn_s_sleep(1);
        if ((++sp & 255u) == 0u) { if (xb_ld(&bar[XB_TMO])) break; if (sp > XB_SPIN_CAP) { atomicAdd(&bar[XB_TMO], 1u); break; } }
    }
    nloc = mine > 0u ? mine : 1u; nx = cnt > 0u ? cnt : 1u;
}

__device__ __forceinline__ void xcd_barrier(const XcdBarrier& b) {
    asm volatile("s_waitcnt vmcnt(0)" ::: "memory");
    __syncthreads();
    if (threadIdx.x == 0) {
        unsigned* bar = b.bar;
        __builtin_amdgcn_s_waitcnt(0);
        unsigned nloc = b.st[0], nx = b.st[1];
        if (nloc == 0u) { xcd_barrier_complete(bar, b.x, nloc, nx); b.st[0] = nloc; b.st[1] = nx; }
        const unsigned old = xb_add(&bar[XB_XSUB(b.x)], 1u);
        const unsigned gen = old / nloc;
        if (old + 1u == (gen + 1u) * nloc) {
            __builtin_amdgcn_fence(__ATOMIC_RELEASE, "agent");
            asm volatile("s_waitcnt vmcnt(0)" ::: "memory");
            const unsigned og = xb_add(&bar[XB_TOP], 1u);
            const unsigned tg = og / nx;
            if (og + 1u == (tg + 1u) * nx) xb_add(&bar[XB_TOPGEN], 1u);
            else XB_SPIN(xb_ld(&bar[XB_TOPGEN]) == tg, bar);
            __builtin_amdgcn_fence(__ATOMIC_ACQUIRE, "agent");
            xb_add(&bar[XB_XGEN(b.x)], 1u);
            asm volatile("s_waitcnt vmcnt(0)" ::: "memory");
        } else {
            XB_SPIN(xb_ld(&bar[XB_XGEN(b.x)]) == gen, bar);
            __builtin_amdgcn_fence(__ATOMIC_ACQUIRE, "agent");
            asm volatile("s_waitcnt vmcnt(0)" ::: "memory");
        }
    }
    __syncthreads();
}

namespace pg8 {
#define PG8_LAS __attribute__((address_space(3)))
typedef unsigned short bf16_t;
typedef short bf16x8 __attribute__((ext_vector_type(8)));
typedef float f32x4 __attribute__((ext_vector_type(4)));
typedef unsigned u32x4 __attribute__((ext_vector_type(4)));
constexpr int BM = 256, BK = 64, HALF = 128, HTB = HALF * BK * 2  , STAGE_BYTES = 8 * HTB, NXCD = 8, WGM = 8;

__host__ __device__ __forceinline__ int lds_byte(int r, int c) { const int st = (r >> 4) * 2 + (c >> 5), rr = r & 15, cc = c & 31, ob = rr * 64 + cc * 2; return st * 1024 + (ob ^ (((ob >> 9) & 1) << 5)); }
__host__ __device__ __forceinline__ void stage_rc(int b, int& R, int& C) { const int st = b / 1024, sb = b % 1024, swz = sb ^ (((sb >> 9) & 1) << 5); R = (st >> 1) * 16 + swz / 64; C = (st & 1) * 32 + (swz % 64) / 2; }
__host__ __device__ __forceinline__ int perm32(int rho) { const int n = rho >> 4, i = rho & 15; return 8 * (i >> 2) + 4 * n + (i & 3); }

struct Unit { int pm, pn; };
struct Gemm { const bf16_t* A; const bf16_t* Bt; int M, N, K; };

struct StaticOrder {
    int nM, nN, nwg, G, c;
    __host__ __device__ void init(int M, int N, int G_, int c_) { nM = M / BM; nN = N / BM; nwg = nM * nN; G = G_; c = c_; }
    __host__ __device__ bool next(int i, Unit& u) const {
        const long L = (long)i * G + c; if (L >= nwg) return false;
        int wgid = (int)L; { const int q = nwg / NXCD, r = nwg % NXCD, xcd = wgid % NXCD, off = wgid / NXCD; wgid = (xcd < r ? xcd * (q + 1) : r * (q + 1) + (xcd - r) * q) + off; }
        const int nig = WGM * nN, gid = wgid / nig, fm = gid * WGM, gsz = (nM - fm) < WGM ? (nM - fm) : WGM;
        u.pm = fm + ((wgid % nig) % gsz); u.pn = (wgid % nig) / gsz; return true;
    }
    __device__ __forceinline__ void a_ready(const Unit&) const {}
    __device__ __forceinline__ void done(const Unit&) const {}
};
__device__ __forceinline__ unsigned cvt_pk_bf16(float lo, float hi) { unsigned r; asm volatile("v_cvt_pk_bf16_f32 %0, %1, %2" : "=v"(r) : "v"(lo), "v"(hi)); return r; }
template <class Epi, class Sched, bool ALIGN_EPI = false, bool SP2 = false>
__device__ __forceinline__ void gemm_phase(PG8_LAS unsigned char* lds, const Gemm g, const Sched& S, const Epi& E) {
    int tid_ = threadIdx.x; asm volatile("" : "+v"(tid_));
    const int tid = tid_, wid = __builtin_amdgcn_readfirstlane(tid >> 6), lane = tid & 63, wr = wid >> 2, wc = wid & 3, fr = lane & 15, fq = lane >> 4;
    const int K = g.K, nt = K / BK;
    unsigned voffA[2], voffB[2];
#pragma unroll
    for (int i = 0; i < 2; ++i) { int R, C; stage_rc(tid * 16 + i * 8192, R, C); const int Rb = Epi::PERM ? ((R & ~31) + perm32(R & 31)) : R;
        voffA[i] = (unsigned)(R * K + C) * 2u; voffB[i] = (unsigned)(Rb * K + C) * 2u; }
    const size_t kstep = (size_t)(BK * 2);
    const size_t hstep = (size_t)HALF * K * 2;
    const size_t tstep = 2 * hstep;
    const unsigned ldsw = (unsigned)wid * 1024u;
    const int aoff = lds_byte(wr * 64 + fr, fq * 8), boff = lds_byte(wc * 32 + fr, fq * 8);
#define PG8_SA(b, h) (((b) * 2 + (h)) * HTB)
#define PG8_SB(b, h) ((4 + (b) * 2 + (h)) * HTB)
#define PG8_STAGE(bufoff, gbase, voff) do { _Pragma("unroll") for (int _i = 0; _i < 2; ++_i) \
        __builtin_amdgcn_global_load_lds((const unsigned*)((const char*)(gbase) + (voff)[_i]), (PG8_LAS unsigned*)(lds + (bufoff) + ldsw + _i * 8192), 16, 0, 0); } while (0)
#define PG8_LDA(dst, b, h) do { _Pragma("unroll") for (int m = 0; m < 4; ++m) _Pragma("unroll") for (int k = 0; k < 2; ++k) dst[m][k] = *(const PG8_LAS bf16x8*)(lds + PG8_SA(b, h) + aoff + m * 2048 + k * 1024); } while (0)
#define PG8_LDB(dst, b, h) do { _Pragma("unroll") for (int n = 0; n < 2; ++n) _Pragma("unroll") for (int k = 0; k < 2; ++k) dst[n][k] = *(const PG8_LAS bf16x8*)(lds + PG8_SB(b, h) + boff + n * 2048 + k * 1024); } while (0)
#define PG8_MMA(ai, bj, At, Bt) do { __builtin_amdgcn_s_setprio(1); _Pragma("unroll") for (int m = 0; m < 4; ++m) _Pragma("unroll") for (int n = 0; n < 2; ++n) _Pragma("unroll") for (int k = 0; k < 2; ++k) \
        acc[ai][bj][m][n] = __builtin_amdgcn_mfma_f32_16x16x32_bf16(Bt[n][k], At[m][k], acc[ai][bj][m][n], 0, 0, 0); __builtin_amdgcn_s_setprio(0); } while (0)
#define PG8_WAIT_V(n) asm volatile("s_waitcnt vmcnt(" #n ")" ::: "memory")
#define PG8_WAIT_L(n) asm volatile("s_waitcnt lgkmcnt(" #n ")" ::: "memory")
#define PG8_BAR __builtin_amdgcn_s_barrier()
#define PG8_SCHED __builtin_amdgcn_sched_barrier(0)
    Unit cur, nxt; int ui = 0;
    if (!S.next(0, cur)) return;
    f32x4 acc[2][2][4][2];
#pragma unroll
    for (int a = 0; a < 2; ++a)
#pragma unroll
        for (int b = 0; b < 2; ++b)
#pragma unroll
            for (int m = 0; m < 4; ++m)
#pragma unroll
                for (int n = 0; n < 2; ++n) acc[a][b][m][n] = (f32x4){0.f, 0.f, 0.f, 0.f};
    bf16x8 At[4][2], B0[2][2], B1[2][2];
    const char* cA = (const char*)g.A + (size_t)cur.pm * tstep; const char* cB = (const char*)g.Bt + (size_t)cur.pn * tstep;
    S.a_ready(cur);
    if constexpr (SP2) {
        PG8_STAGE(PG8_SB(0, 0), cB, voffB); PG8_STAGE(PG8_SB(0, 1), cB + hstep, voffB); PG8_STAGE(PG8_SA(0, 0), cA, voffA); PG8_STAGE(PG8_SA(0, 1), cA + hstep, voffA);
        if (wr == 1) PG8_BAR;
        PG8_WAIT_V(2); PG8_BAR;
        PG8_STAGE(PG8_SB(1, 0), cB + kstep, voffB); PG8_STAGE(PG8_SA(1, 0), cA + kstep, voffA); PG8_STAGE(PG8_SB(1, 1), cB + hstep + kstep, voffB);
        PG8_WAIT_V(6); PG8_BAR;
    } else {
        PG8_STAGE(PG8_SB(0, 0), cB, voffB); PG8_STAGE(PG8_SA(0, 0), cA, voffA); PG8_STAGE(PG8_SB(0, 1), cB + hstep, voffB); PG8_STAGE(PG8_SA(0, 1), cA + hstep, voffA);
        if (wr == 1) PG8_BAR;
        PG8_WAIT_V(4); PG8_BAR;
        PG8_STAGE(PG8_SB(1, 0), cB + kstep, voffB); PG8_STAGE(PG8_SA(1, 0), cA + kstep, voffA); PG8_STAGE(PG8_SB(1, 1), cB + hstep + kstep, voffB);
        PG8_WAIT_V(6); PG8_BAR;
    }
    for (;;) {
        const bool has_next = S.next(ui + 1, nxt);
        const char* nA = has_next ? (const char*)g.A + (size_t)nxt.pm * tstep : cA; const char* nB = has_next ? (const char*)g.Bt + (size_t)nxt.pn * tstep : cB;
        for (int t = 0; t < nt; t += 2) {
            const bool last = (t == nt - 2);
            const char* a1 = cA + (size_t)(t + 1) * kstep;
            const char* a2 = last ? nA : cA + (size_t)(t + 2) * kstep; const char* b2 = last ? nB : cB + (size_t)(t + 2) * kstep;
            const char* a3 = a2 + kstep; const char* b3 = b2 + kstep;
            if (last && has_next) S.a_ready(nxt);
            if constexpr (SP2) {
            PG8_LDB(B0, 0, 0); PG8_LDB(B1, 0, 1); PG8_SCHED; PG8_LDA(At, 0, 0); PG8_STAGE(PG8_SA(1, 1), a1 + hstep, voffA);
            PG8_WAIT_V(8); PG8_WAIT_L(0); PG8_BAR; PG8_MMA(0, 0, At, B0); PG8_MMA(0, 1, At, B1); PG8_BAR; PG8_SCHED;
            PG8_LDA(At, 0, 1); PG8_STAGE(PG8_SB(0, 0), b2, voffB); PG8_STAGE(PG8_SB(0, 1), b2 + hstep, voffB); PG8_STAGE(PG8_SA(0, 0), a2, voffA);
            PG8_WAIT_V(8); PG8_WAIT_L(0); PG8_BAR; PG8_MMA(1, 0, At, B0); PG8_MMA(1, 1, At, B1); PG8_BAR; PG8_SCHED;
            PG8_LDB(B0, 1, 0); PG8_LDB(B1, 1, 1); PG8_SCHED; PG8_LDA(At, 1, 0); PG8_STAGE(PG8_SA(0, 1), a2 + hstep, voffA);
            PG8_WAIT_V(8); PG8_WAIT_L(0); PG8_BAR; PG8_MMA(0, 0, At, B0); PG8_MMA(0, 1, At, B1); PG8_BAR; PG8_SCHED;
            PG8_LDA(At, 1, 1); PG8_STAGE(PG8_SB(1, 0), b3, voffB); PG8_STAGE(PG8_SB(1, 1), b3 + hstep, voffB); PG8_STAGE(PG8_SA(1, 0), a3, voffA);
            PG8_WAIT_V(8); PG8_WAIT_L(0); PG8_BAR; PG8_MMA(1, 0, At, B0); PG8_MMA(1, 1, At, B1); PG8_BAR; PG8_SCHED;
            } else {
            PG8_LDB(B0, 0, 0); PG8_SCHED; PG8_LDA(At, 0, 0); PG8_STAGE(PG8_SA(1, 1), a1 + hstep, voffA);
            PG8_WAIT_L(8); PG8_BAR; PG8_WAIT_L(0); PG8_MMA(0, 0, At, B0); PG8_BAR; PG8_SCHED;
            PG8_LDB(B1, 0, 1); PG8_STAGE(PG8_SB(0, 0), b2, voffB);
            PG8_BAR; PG8_WAIT_L(0); PG8_MMA(0, 1, At, B1); PG8_BAR;
            PG8_LDA(At, 0, 1); PG8_STAGE(PG8_SA(0, 0), a2, voffA);
            PG8_BAR; PG8_WAIT_L(0); PG8_MMA(1, 0, At, B0); PG8_BAR; PG8_SCHED;
            PG8_STAGE(PG8_SB(0, 1), b2 + hstep, voffB);
            PG8_WAIT_V(6); PG8_BAR; PG8_MMA(1, 1, At, B1); PG8_BAR;
            PG8_LDB(B0, 1, 0); PG8_SCHED; PG8_LDA(At, 1, 0); PG8_STAGE(PG8_SA(0, 1), a2 + hstep, voffA);
            PG8_WAIT_L(8); PG8_BAR; PG8_WAIT_L(0); PG8_MMA(0, 0, At, B0); PG8_BAR; PG8_SCHED;
            PG8_LDB(B1, 1, 1); PG8_STAGE(PG8_SB(1, 0), b3, voffB);
            PG8_BAR; PG8_WAIT_L(0); PG8_MMA(0, 1, At, B1); PG8_BAR;
            PG8_LDA(At, 1, 1); PG8_STAGE(PG8_SA(1, 0), a3, voffA);
            PG8_BAR; PG8_WAIT_L(0); PG8_MMA(1, 0, At, B0); PG8_BAR; PG8_SCHED;
            PG8_STAGE(PG8_SB(1, 1), b3 + hstep, voffB);
            PG8_WAIT_V(6); PG8_BAR; PG8_MMA(1, 1, At, B1); PG8_BAR;
            }
        }
        if constexpr (ALIGN_EPI) { if (wr == 0) PG8_BAR; }
        if constexpr (!Epi::AFTER_DRAIN) { E(acc, cur, wr, wc, fr, fq); S.done(cur); }
        if (!has_next) break;
#pragma unroll
        for (int a = 0; a < 2; ++a)
#pragma unroll
            for (int b = 0; b < 2; ++b)
#pragma unroll
                for (int m = 0; m < 4; ++m)
#pragma unroll
                    for (int n = 0; n < 2; ++n) acc[a][b][m][n] = (f32x4){0.f, 0.f, 0.f, 0.f};
        cur = nxt; cA = nA; cB = nB; ++ui;
        if constexpr (ALIGN_EPI) { if (wr == 1) PG8_BAR; }
    }
    PG8_WAIT_V(0);
    if constexpr (!ALIGN_EPI) { if (wr == 0) PG8_BAR; }
    PG8_BAR;
    if constexpr (Epi::AFTER_DRAIN) { E.fused(acc, cur, wr, wc, fr, fq, lds, wid, lane); S.done(cur); }
#undef PG8_SA
#undef PG8_SB
#undef PG8_STAGE
#undef PG8_LDA
#undef PG8_LDB
#undef PG8_MMA
#undef PG8_WAIT_V
#undef PG8_WAIT_L
#undef PG8_BAR
#undef PG8_SCHED
}
}

#define GAS __attribute__((address_space(1)))
typedef unsigned short bf16;
typedef float f32x4 __attribute__((ext_vector_type(4)));
typedef unsigned v4u __attribute__((ext_vector_type(4)));
typedef unsigned v2u __attribute__((ext_vector_type(2)));
constexpr int D = 2048, NB = 4, SEQ = 4096, CTXL = 256, DFF = 5504, NMOD = 9;
constexpr int TL = NB * SEQ, TC = NB * CTXL, TT = TL + TC;
constexpr int MIXH = 1024;
constexpr int EV_COLS = 7216, EV_PAD = 7424, OD_COLS = 5120;
constexpr int NWAVES = 8, NTHR = 512;
constexpr float EPS = 1e-6f;

constexpr size_t MiB = 1u << 20;
constexpr size_t WS_CTL = 0, CTL_ZERO_BYTES = 64 * 1024;
constexpr size_t WS_MOD = 1 * MiB;
constexpr size_t WS_MODP = 2 * MiB;
constexpr int MOD_KC = 16;
constexpr size_t WS_WGU = 16 * MiB;
constexpr size_t SZ_WGU = (size_t)11008 * 2048 * 2;
constexpr size_t WS_WD = WS_WGU + 4 * SZ_WGU;
constexpr size_t SZ_WD = (size_t)2048 * 5504 * 2;
constexpr size_t WS_WIN_EV = WS_WD + 4 * SZ_WD;
constexpr size_t WS_WOUT_EV = WS_WIN_EV + (size_t)EV_PAD * 2048 * 2;
constexpr size_t WS_WIN_OD = WS_WOUT_EV + (size_t)2048 * 2048 * 2;
constexpr size_t WS_WOUT_OD = WS_WIN_OD + (size_t)OD_COLS * 2048 * 2;
constexpr size_t WS_WGLU = WS_WOUT_OD + (size_t)2048 * 2048 * 2;
constexpr size_t WS_XC = WS_WGLU + (size_t)1024 * 1024 * 2;
constexpr size_t WS_HB = WS_XC + (size_t)TC * D * 4;
constexpr size_t WS_R = WS_HB + (size_t)TT * D * 2;
constexpr size_t WS_HID = WS_R;
constexpr size_t WS_Y = WS_R + 183 * MiB;
constexpr size_t WS_S = WS_R;
constexpr size_t WS_GT = WS_R + 247 * MiB;
constexpr size_t WS_GB = WS_R + 264 * MiB;
constexpr size_t WS_O = WS_R + 298 * MiB;
constexpr size_t SZ_O = (size_t)TT * 1024 * 4;
constexpr size_t WS_END = WS_O + 4 * SZ_O;
static_assert(WS_HID + (size_t)TT * DFF * 2 <= WS_Y && WS_S + (size_t)TT * EV_PAD * 2 <= WS_GT && WS_GT + (size_t)TT * 256 * 4 <= WS_GB && WS_GB + (size_t)TT * 1024 * 2 <= WS_O, "ws map");
static_assert(WS_Y + (size_t)TT * D * 4 <= WS_END, "ws map");

constexpr int LDS_BYTES = 156 * 1024;
constexpr int MISC_OFF = LDS_BYTES - 64;

struct Args { const float* in[34]; float* out; unsigned char* ws; };

__device__ __forceinline__ unsigned f2bf(float f) { unsigned u = __float_as_uint(f); u += 0x7FFFu + ((u >> 16) & 1u); return u >> 16; }
typedef __bf16 bf16x2_t __attribute__((ext_vector_type(2)));
typedef float f32x2_t __attribute__((ext_vector_type(2)));
__device__ __forceinline__ unsigned pk2(float lo, float hi) { const f32x2_t v = {lo, hi}; const bf16x2_t b = __builtin_convertvector(v, bf16x2_t); return __builtin_bit_cast(unsigned, b); }
__device__ __forceinline__ float bf2f(unsigned short b) { return __uint_as_float(((unsigned)b) << 16); }
__device__ __forceinline__ float wave_sum(float v) {
#pragma unroll
    for (int o = 1; o < 64; o <<= 1) v += __shfl_xor(v, o);
    return v;
}
__device__ __forceinline__ float fast_silu(float g) { return g * __builtin_amdgcn_rcpf(1.0f + __expf(-g)); }
__device__ __forceinline__ float fast_sigmoid(float g) { return __builtin_amdgcn_rcpf(1.0f + __expf(-g)); }

struct TJob { const float* src; bf16* dst; int K, N, map, tstart; };
constexpr int NJOBS = 17;
__device__ __forceinline__ int tj_tiles(int K, int N) { return (K / 64) * ((N + 31) / 32); }
__device__ __forceinline__ void transpose_tile(const TJob& j, int tl, int lane) {
    const int nblk = (j.N + 31) / 32, kb = tl / nblk, nb = tl % nblk, k0 = 64 * kb, n0 = 32 * nb;
    const int kb8 = lane >> 3, nb4 = lane & 7, n = n0 + 4 * nb4;
    int drow0;
    if (j.map == 0) drow0 = n0;
    else if (j.map == 1) drow0 = (n0 / 128) * 256 + (n0 % 128);
    else if (j.map == 2) drow0 = (n0 / 128) * 256 + (n0 % 128) + 128;
    else drow0 = (nb < 96) ? n0 : (nb == 96 ? 7168 : (nb < 225 ? n0 - 32 : 7200));
    if (n < j.N) {
        const float* s = j.src + (size_t)(k0 + 8 * kb8) * j.N + n;
        f32x4 v[8];
#pragma unroll
        for (int i = 0; i < 8; ++i) v[i] = *(const f32x4*)(s + (size_t)i * j.N);
        bf16* d = j.dst + (size_t)(drow0 + 4 * nb4) * j.K + k0 + 8 * kb8;
#pragma unroll
        for (int e = 0; e < 4; ++e) { v4u o; o.x = pk2(v[0][e], v[1][e]); o.y = pk2(v[2][e], v[3][e]); o.z = pk2(v[4][e], v[5][e]); o.w = pk2(v[6][e], v[7][e]);
            *(v4u*)(d + (size_t)e * j.K) = o; }
    }
}

struct NormP {
    const float* xin_lat; const float* xin_ctx; float* xout_lat; float* xout_ctx; const float* y; bf16* h;
    int rows_end; int has_y, has_h; float w;
    int lp, sp;
    int ln, sn;
};
__device__ __forceinline__ void norm_phase(const NormP& p, const float* mod, const float* norm_pre, const float* norm_post, LAS unsigned char* lds, int gw, int ngw, int tid, int lane) {
    { int t2 = threadIdx.x; asm volatile("" : "+v"(t2)); tid = t2; lane = t2 & 63; gw = blockIdx.x * NWAVES + __builtin_amdgcn_readfirstlane(t2 >> 6); }
    LAS float* TA = (LAS float*)lds; LAS float* TB = TA + 5 * D; LAS float* TCc = TB + 5 * D;
    for (int i = tid; i < 5 * D; i += NTHR) { const int var = i >> 11, j = i & (D - 1);
        if (p.has_y) TA[i] = p.w * mod[((size_t)p.lp * 5 + var) * (NMOD * D) + (3 * p.sp + 2) * D + j] * norm_post[(p.lp * 3 + p.sp) * D + j];
        if (p.has_h) { TB[i] = norm_pre[(p.ln * 3 + p.sn) * D + j] * (1.0f + mod[((size_t)p.ln * 5 + var) * (NMOD * D) + (3 * p.sn + 1) * D + j]);
                       TCc[i] = mod[((size_t)p.ln * 5 + var) * (NMOD * D) + (3 * p.sn) * D + j]; } }
    __syncthreads();
    for (int r = gw; r < p.rows_end; r += ngw) {
        const int var = r < TL ? (r >> 12) : 4;
        const float* xi = r < TL ? p.xin_lat + (size_t)r * D : p.xin_ctx + (size_t)(r - TL) * D;
        float* xo = r < TL ? p.xout_lat + (size_t)r * D : p.xout_ctx + (size_t)(r - TL) * D;
        f32x4 xv[8];
#pragma unroll
        for (int j = 0; j < 8; ++j) xv[j] = *(const f32x4*)(xi + 4 * lane + 256 * j);
        if (p.has_y) {
            const float* yr = p.y + (size_t)r * D; f32x4 yv[8]; float s = 0.f;
#pragma unroll
            for (int j = 0; j < 8; ++j) { yv[j] = *(const f32x4*)(yr + 4 * lane + 256 * j); s += (yv[j].x * yv[j].x + yv[j].y * yv[j].y) + (yv[j].z * yv[j].z + yv[j].w * yv[j].w); }
            const float rstd = 1.0f / sqrtf(wave_sum(s) * (1.0f / D) + EPS);
#pragma unroll
            for (int j = 0; j < 8; ++j) { const f32x4 a = *(const LAS f32x4*)(TA + var * D + 4 * lane + 256 * j); xv[j] = xv[j] + a * (yv[j] * rstd); *(f32x4*)(xo + 4 * lane + 256 * j) = xv[j]; }
        }
        if (p.has_h) {
            float s = 0.f;
#pragma unroll
            for (int j = 0; j < 8; ++j) s += (xv[j].x * xv[j].x + xv[j].y * xv[j].y) + (xv[j].z * xv[j].z + xv[j].w * xv[j].w);
            const float rstd = 1.0f / sqrtf(wave_sum(s) * (1.0f / D) + EPS);
            bf16* hr = p.h + (size_t)r * D;
#pragma unroll
            for (int j = 0; j < 8; ++j) { const f32x4 b = *(const LAS f32x4*)(TB + var * D + 4 * lane + 256 * j), c = *(const LAS f32x4*)(TCc + var * D + 4 * lane + 256 * j);
                const f32x4 o = xv[j] * rstd * b + c; v2u w; w.x = pk2(o.x, o.y); w.y = pk2(o.z, o.w); *(v2u*)(hr + 4 * lane + 256 * j) = w; }
        }
    }
    __syncthreads();
}

struct EpiSwiGLU {
    static constexpr bool PERM = true, AFTER_DRAIN = false;
    bf16* O; int ldc;
    __device__ __forceinline__ void operator()(const pg8::f32x4 (&acc)[2][2][4][2], const pg8::Unit& u, int wr, int wc, int fr, int fq) const {
        const int row0 = u.pm * 256 + wr * 64 + fr, col0 = u.pn * 128 + wc * 32 + 8 * fq;
#pragma unroll
        for (int ai = 0; ai < 2; ++ai)
#pragma unroll
            for (int m = 0; m < 4; ++m) { bf16* rowp = O + (size_t)(row0 + ai * 128 + m * 16) * ldc + col0;
                const pg8::f32x4 g0 = acc[ai][0][m][0], g1 = acc[ai][0][m][1], u0 = acc[ai][1][m][0], u1 = acc[ai][1][m][1];
                v4u w; w.x = pk2(fast_silu(g0[0]) * u0[0], fast_silu(g0[1]) * u0[1]); w.y = pk2(fast_silu(g0[2]) * u0[2], fast_silu(g0[3]) * u0[3]);
                w.z = pk2(fast_silu(g1[0]) * u1[0], fast_silu(g1[1]) * u1[1]); w.w = pk2(fast_silu(g1[2]) * u1[2], fast_silu(g1[3]) * u1[3]);
                *(v4u*)rowp = w; }
    }
};
struct EpiF32 {
    static constexpr bool PERM = false, AFTER_DRAIN = false;
    float* C; int ldc;
    __device__ __forceinline__ void operator()(const pg8::f32x4 (&acc)[2][2][4][2], const pg8::Unit& u, int wr, int wc, int fr, int fq) const {
        const int row0 = u.pm * 256 + wr * 64 + fr, col0 = u.pn * 256 + wc * 32 + 4 * fq;
#pragma unroll
        for (int ai = 0; ai < 2; ++ai)
#pragma unroll
            for (int m = 0; m < 4; ++m) { float* rowp = C + (size_t)(row0 + ai * 128 + m * 16) * ldc + col0;
#pragma unroll
                for (int bj = 0; bj < 2; ++bj)
#pragma unroll
                    for (int n = 0; n < 2; ++n) *(pg8::f32x4*)(rowp + bj * 128 + n * 16) = acc[ai][bj][m][n]; }
    }
};
struct EpiS {
    static constexpr bool PERM = true, AFTER_DRAIN = false;
    bf16* S; int ldc; float* GT; int gt_pn;
    __device__ __forceinline__ void operator()(const pg8::f32x4 (&acc)[2][2][4][2], const pg8::Unit& u, int wr, int wc, int fr, int fq) const {
        const int row0 = u.pm * 256 + wr * 64 + fr;
        if (u.pn == gt_pn) {
            if (wc < 2) {
#pragma unroll
                for (int ai = 0; ai < 2; ++ai)
#pragma unroll
                    for (int m = 0; m < 4; ++m) { float* rowp = GT + (size_t)(row0 + ai * 128 + m * 16) * 256 + wc * 32 + 8 * fq;
                        *(pg8::f32x4*)rowp = acc[ai][0][m][0]; *(pg8::f32x4*)(rowp + 4) = acc[ai][0][m][1]; }
            }
        } else {
            const int col0 = u.pn * 256 + wc * 32 + 8 * fq;
#pragma unroll
            for (int ai = 0; ai < 2; ++ai)
#pragma unroll
                for (int m = 0; m < 4; ++m) { bf16* rowp = S + (size_t)(row0 + ai * 128 + m * 16) * ldc + col0;
#pragma unroll
                    for (int bj = 0; bj < 2; ++bj) { const pg8::f32x4 v0 = acc[ai][bj][m][0], v1 = acc[ai][bj][m][1];
                        v4u w; w.x = pk2(v0[0], v0[1]); w.y = pk2(v0[2], v0[3]); w.z = pk2(v1[0], v1[1]); w.w = pk2(v1[2], v1[3]);
                        *(v4u*)(rowp + bj * 128) = w; } }
        }
    }
};

#define DEV __device__ __forceinline__
#define LP(T) LAS T*
#define SYNC() __syncthreads()
typedef short v8s __attribute__((ext_vector_type(8)));
typedef float v4f __attribute__((ext_vector_type(4)));
#define MFMA16(x, y, c) __builtin_amdgcn_mfma_f32_16x16x32_bf16((x), (y), (c), 0, 0, 0)
#define SHX(v, m) __shfl_xor((v), (m))
#define SHUP(v, d) __shfl_up((v), (d))
#define SHIDX(v, l) __shfl((v), (l))
#define EXPF(x) __expf(x)
#define LOGF(x) __logf(x)
#define RCPF(x) __builtin_amdgcn_rcpf(x)
#define RSQRTF(x) (1.0f / sqrtf(x))
#define PK2(lo, hi) pk2((lo), (hi))
#define F2BF(x) ((unsigned short)f2bf(x))
#define WAVE_SYNC() asm volatile("s_waitcnt lgkmcnt(0)" ::: "memory")

DEV int seq_row(int b, int seg, int np, int cm) {
    if (!seg) return TL + b * CTXL + np;
    const int n = cm ? ((np & 63) * 64 + (np >> 6)) : np;
    return b * SEQ + n;
}
DEV int tok_row(int b, int seg, int pos, int dir, int cm) {
    const int len = seg ? SEQ : CTXL;
    return seq_row(b, seg, dir ? len - 1 - pos : pos, cm);
}
DEV float bflo(unsigned u) { return __uint_as_float(u << 16); }
DEV float bfhi(unsigned u) { return __uint_as_float(u & 0xffff0000u); }
DEV float logsigmoidf(float z) { return fminf(z, 0.f) - LOGF(1.0f + EXPF(-fabsf(z))); }
DEV v4f tile_mma(v4f acc, LP(const unsigned char) A, int sa, int m0, LP(const unsigned char) B, int sb, int n0, int ksteps, int fr, int fq) {
    LP(const unsigned char) ap = A + (m0 + fr) * sa + fq * 16;
    LP(const unsigned char) bp = B + (n0 + fr) * sb + fq * 16;
    for (int k = 0; k < ksteps; ++k) {
        const v8s af = *(LP(const v8s))(ap + k * 64);
        const v8s bf = *(LP(const v8s))(bp + k * 64);
        acc = MFMA16(bf, af, acc);
    }
    return acc;
}
constexpr int ST128 = 272, ST64 = 144, ST256 = 528;

DEV void gla_unit(const bf16* S, const float* GT, float* O, const float* wg_all, const float* bg_all, int unit, LP(unsigned char) lds, int tid) {
    const int lane = tid & 63, wave = tid >> 6, fr = lane & 15, fq = lane >> 4;
    const int vs = unit & 7, dir = (unit >> 3) & 1, h = (unit >> 4) & 3, b = unit >> 6;
    LP(unsigned char) QS = lds; LP(unsigned char) KS = lds + 17408; LP(unsigned char) QB = lds + 34816; LP(unsigned char) KBT = lds + 52224;
    LP(unsigned char) VT = lds + 70656; LP(unsigned char) PM = lds + 75264; LP(unsigned char) STT = lds + 84480;
    LP(float) LA = (LP(float))(lds + 93184); LP(float) SEG = (LP(float))(lds + 125952); LP(float) DEC = (LP(float))(lds + 128000);
    LP(float) LR = (LP(float))(lds + 128512); LP(float) WG = (LP(float))(lds + 132608); LP(float) BG = (LP(float))(lds + 140800);
    for (int i = tid; i < 16 * 128; i += NTHR) { const int m = i >> 7, d = i & 127; WG[i] = wg_all[(dir * 16 + m) * 512 + h * 128 + d]; }
    if (tid < 128) BG[tid] = bg_all[dir * 512 + h * 128 + tid];
    for (int i = tid; i < 32 * ST128 / 4; i += NTHR) ((LP(unsigned))STT)[i] = 0u;
    v4f sacc[2]; sacc[0] = (v4f){0.f, 0.f, 0.f, 0.f}; sacc[1] = sacc[0];
    const int j = tid >> 3, c8 = tid & 7, dc = c8 * 16;
    const int tt = wave >> 1, vt = wave & 1;
    const float qscale = 0.08838834764831845f;
    float* Od = O + (size_t)dir * TT * 1024;
    for (int seg = 0; seg < 2; ++seg) {
        const int nch = seg ? (SEQ / 64) : (CTXL / 64);
        for (int ci = 0; ci < nch; ++ci) {
            const int row = tok_row(b, seg, ci * 64 + j, dir, 0);
            const bf16* sr = S + (size_t)row * EV_PAD;
            const v4u q0 = *(const v4u*)(sr + h * 128 + dc), q1 = *(const v4u*)(sr + h * 128 + dc + 8);
            const v4u k0 = *(const v4u*)(sr + 512 + h * 128 + dc), k1 = *(const v4u*)(sr + 512 + h * 128 + dc + 8);
            const v2u vv = *(const v2u*)(sr + 1024 + h * 256 + vs * 32 + c8 * 4);
            if (tid < 256) { const int jj = tid >> 2, part = tid & 3; const int rr = tok_row(b, seg, ci * 64 + jj, dir, 0);
                *(LP(v4f))(LR + jj * 16 + part * 4) = *(const v4f*)(GT + (size_t)rr * 256 + dir * 16 + part * 4); }
            SYNC();
            {
                float z[16];
#pragma unroll
                for (int i = 0; i < 16; ++i) z[i] = BG[dc + i];
                for (int m = 0; m < 16; ++m) { const float lrm = LR[j * 16 + m];
#pragma unroll
                    for (int i4 = 0; i4 < 4; ++i4) { const v4f w = *(LP(const v4f))(WG + m * 128 + dc + 4 * i4);
                        z[4 * i4 + 0] += lrm * w.x; z[4 * i4 + 1] += lrm * w.y; z[4 * i4 + 2] += lrm * w.z; z[4 * i4 + 3] += lrm * w.w; } }
#pragma unroll
                for (int i4 = 0; i4 < 4; ++i4) { v4f o; o.x = logsigmoidf(z[4 * i4]) * 0.0625f; o.y = logsigmoidf(z[4 * i4 + 1]) * 0.0625f; o.z = logsigmoidf(z[4 * i4 + 2]) * 0.0625f; o.w = logsigmoidf(z[4 * i4 + 3]) * 0.0625f;
                    *(LP(v4f))(LA + j * 128 + dc + 4 * i4) = o; }
            }
            SYNC();
            {
                const int d = tid & 127, sg = tid >> 7; float acc = 0.f;
                for (int jj = 0; jj < 16; ++jj) { acc += LA[(sg * 16 + jj) * 128 + d]; LA[(sg * 16 + jj) * 128 + d] = acc; }
                SEG[sg * 128 + d] = acc;
            }
            SYNC();
            {
                const int sgj = j >> 4;
#pragma unroll 1
                for (int g = 0; g < 2; ++g) {
                    const v4u qv = g ? q1 : q0, kv = g ? k1 : k0;
                    const unsigned qw[4] = {qv.x, qv.y, qv.z, qv.w}, kw[4] = {kv.x, kv.y, kv.z, kv.w};
                    unsigned oqs[4], oks[4], oqb[4];
#pragma unroll
                    for (int i2 = 0; i2 < 4; ++i2) {
                        float vqs[2], vks[2], vqb[2];
#pragma unroll
                        for (int e = 0; e < 2; ++e) {
                            const int d = dc + 8 * g + 2 * i2 + e;
                            const float s0 = SEG[d], s1 = SEG[128 + d], s2 = SEG[256 + d];
                            const float pre = (sgj > 0 ? s0 : 0.f) + (sgj > 1 ? s1 : 0.f) + (sgj > 2 ? s2 : 0.f);
                            const float bv = LA[j * 128 + d] + pre;
                            const float bmid = LA[32 * 128 + d] + s0 + s1;
                            const float bend = LA[63 * 128 + d] + s0 + s1 + s2;
                            const float q = (e ? bfhi(qw[i2]) : bflo(qw[i2])) * qscale, k = e ? bfhi(kw[i2]) : bflo(kw[i2]);
                            vqs[e] = q * EXPF(bv - bmid); vks[e] = k * EXPF(bmid - bv); vqb[e] = q * EXPF(bv);
                            const float kb = k * EXPF(bend - bv);
                            *(LP(unsigned short))(KBT + d * ST64 + j * 2) = F2BF(kb);
                            if (j == 63) DEC[d] = EXPF(bend);
                        }
                        oqs[i2] = PK2(vqs[0], vqs[1]); oks[i2] = PK2(vks[0], vks[1]); oqb[i2] = PK2(vqb[0], vqb[1]);
                    }
                    *(LP(v4u))(QS + j * ST128 + (dc + 8 * g) * 2) = (v4u){oqs[0], oqs[1], oqs[2], oqs[3]};
                    *(LP(v4u))(KS + j * ST128 + (dc + 8 * g) * 2) = (v4u){oks[0], oks[1], oks[2], oks[3]};
                    *(LP(v4u))(QB + j * ST128 + (dc + 8 * g) * 2) = (v4u){oqb[0], oqb[1], oqb[2], oqb[3]};
                }
                const int v0 = c8 * 4;
                *(LP(unsigned short))(VT + (v0 + 0) * ST64 + j * 2) = (unsigned short)(vv.x & 0xffffu); *(LP(unsigned short))(VT + (v0 + 1) * ST64 + j * 2) = (unsigned short)(vv.x >> 16);
                *(LP(unsigned short))(VT + (v0 + 2) * ST64 + j * 2) = (unsigned short)(vv.y & 0xffffu); *(LP(unsigned short))(VT + (v0 + 3) * ST64 + j * 2) = (unsigned short)(vv.y >> 16);
            }
            SYNC();
            v4f oacc = (v4f){0.f, 0.f, 0.f, 0.f};
            {
#pragma unroll
                for (int i = 0; i < 2; ++i) { const int st = (wave & 1) * 2 + i; v4f p = (v4f){0.f, 0.f, 0.f, 0.f};
                    if (st <= tt) { p = tile_mma(p, QS, ST128, 16 * tt, KS, ST128, 16 * st, 4, fr, fq);
                        if (st == tt) { if (4 * fq + 0 > fr) p.x = 0.f; if (4 * fq + 1 > fr) p.y = 0.f; if (4 * fq + 2 > fr) p.z = 0.f; if (4 * fq + 3 > fr) p.w = 0.f; } }
                    *(LP(v2u))(PM + (16 * tt + fr) * ST64 + (16 * st + 4 * fq) * 2) = (v2u){PK2(p.x, p.y), PK2(p.z, p.w)}; }
                oacc = tile_mma(oacc, QB, ST128, 16 * tt, STT, ST128, 16 * vt, 4, fr, fq);
            }
            SYNC();
            oacc = tile_mma(oacc, PM, ST64, 16 * tt, VT, ST64, 16 * vt, 2, fr, fq);
            { const int orow = tok_row(b, seg, ci * 64 + 16 * tt + fr, dir, 0);
              *(v4f*)(Od + (size_t)orow * 1024 + h * 256 + vs * 32 + 16 * vt + 4 * fq) = oacc; }
#pragma unroll
            for (int i = 0; i < 2; ++i) { const int dt = (wave >> 1) * 2 + i; const v4f dcy = *(LP(const v4f))(DEC + 16 * dt + 4 * fq);
                sacc[i] = sacc[i] * dcy;
                sacc[i] = tile_mma(sacc[i], VT, ST64, 16 * vt, KBT, ST64, 16 * dt, 2, fr, fq);
                *(LP(v2u))(STT + (16 * vt + fr) * ST128 + (16 * dt + 4 * fq) * 2) = (v2u){PK2(sacc[i].x, sacc[i].y), PK2(sacc[i].z, sacc[i].w)}; }
        }
    }
    SYNC();
}

template <int MODE>
DEV void mat_unit(const bf16* S, int ldS, int qoff, int koff, int voff, const float* GT, float* O, int store_ctx,
                  const float* conv_w, const float* conv_b, const float* gate_b, const float* ret_log_decay,
                  int unit, LP(unsigned char) lds, int tid) {
    const int lane = tid & 63, wave = tid >> 6, fr = lane & 15, fq = lane >> 4;
    const int vs = unit & 7, dir = (unit >> 3) & 1, h = (unit >> 4) & 3, b = unit >> 6;
    LP(unsigned char) Q = lds; LP(unsigned char) K = lds + 33792; LP(unsigned char) KWT = lds + 67584;
    LP(unsigned char) VT = lds + 104448; LP(unsigned char) PM = lds + 109056; LP(unsigned char) STT = lds + 118272;
    LP(float) AS = (LP(float))(lds + 135168); LP(float) RT = AS + 64; LP(float) WI = AS + 128; LP(float) WK = AS + 192; LP(float) EMT = AS + 256;
    LP(float) QN = AS + 320; LP(float) DENP = AS + 384;
    LP(float) SC = AS + 640;
    LP(float) NV = AS + 704;
    LP(float) CW = AS + 960;
    for (int i = tid; i < 32 * ST256 / 4; i += NTHR) ((LP(unsigned))STT)[i] = 0u;
    if (tid < 256) NV[tid] = 0.f;
    if (MODE == 0) { for (int i = tid; i < 4 * 512; i += NTHR) { const int t3 = i >> 9, c = i & 511; const int ch = (c < 256 ? 0 : 1024 - 256) + h * 256 + c;
            CW[i] = t3 < 3 ? conv_w[t3 * 2048 + ch] : conv_b[ch]; } }
    v4f sacc[4];
#pragma unroll
    for (int i = 0; i < 4; ++i) sacc[i] = (v4f){0.f, 0.f, 0.f, 0.f};
    const int j = tid >> 3, c8 = tid & 7, dc = c8 * 32;
    const int tt = wave >> 1, vt = wave & 1;
    const float kscale = 0.0625f;
    float m_st = 0.f;
    float lg = 0.f, bias_i = 0.f, bias_f = 0.f;
    if (MODE == 1) lg = -expf(ret_log_decay[dir * 4 + h]);
    else { bias_i = gate_b[(dir * 2 + 0) * 4 + h]; bias_f = gate_b[(dir * 2 + 1) * 4 + h]; }
    float* Od = O + (size_t)(2 + dir) * TT * 1024;
    SYNC();
    for (int seg = 0; seg < 2; ++seg) {
        const int nch = seg ? (SEQ / 64) : (CTXL / 64), len = seg ? SEQ : CTXL;
        for (int ci = 0; ci < nch; ++ci) {
            const int pos = ci * 64 + j, np = dir ? len - 1 - pos : pos;
            const int row = seq_row(b, seg, np, 1);
            if (wave == 0) {
                float a_s, r_t, wi, emt, M63, bend;
                if (MODE == 0) {
                    const int prow = tok_row(b, seg, ci * 64 + lane, dir, 1);
                    const float ig = GT[(size_t)prow * 256 + 32 + (dir * 2 + 0) * 4 + h] + bias_i;
                    const float lf = logsigmoidf(GT[(size_t)prow * 256 + 32 + (dir * 2 + 1) * 4 + h] + bias_f);
                    float bcum = lf;
#pragma unroll
                    for (int o = 1; o < 64; o <<= 1) { const float t = SHUP(bcum, o); if (lane >= o) bcum += t; }
                    a_s = ig - bcum;
                    float cm = a_s;
#pragma unroll
                    for (int o = 1; o < 64; o <<= 1) { const float t = SHUP(cm, o); if (lane >= o) cm = fmaxf(cm, t); }
                    const float Mt = fmaxf(m_st, cm);
                    r_t = -Mt; wi = EXPF(m_st - Mt); emt = EXPF(-(bcum + Mt));
                    M63 = SHIDX(Mt, 63); bend = SHIDX(bcum, 63);
                    WK[lane] = EXPF(a_s - M63);
                    if (lane == 0) SC[0] = EXPF(m_st - M63);
                    m_st = bend + M63;
                } else {
                    a_s = -(float)(lane + 1) * lg; r_t = (float)(lane + 1) * lg; wi = EXPF(r_t); emt = 0.f;
                    WK[lane] = EXPF((float)(63 - lane) * lg);
                    if (lane == 0) SC[0] = EXPF(64.f * lg);
                }
                AS[lane] = a_s; RT[lane] = r_t; WI[lane] = wi; EMT[lane] = emt;
            }
            SYNC();
            {
                const float wk = WK[j];
                const bool hasm = np > 0, hasp = np < len - 1;
                const bf16* s1 = S + (size_t)row * ldS;
                const bf16* s0 = S + (size_t)seq_row(b, seg, hasm ? np - 1 : np, 1) * ldS;
                const bf16* s2 = S + (size_t)seq_row(b, seg, hasp ? np + 1 : np, 1) * ldS;
                float qn = 0.f;
#pragma unroll 1
                for (int it = 0; it < 8; ++it) {
                    const int qk = it >> 2, d0 = dc + 8 * (it & 3); const int off = (qk ? koff : qoff) + h * 256 + d0, cwo = qk * 256 + d0;
                    float val[8];
                    const v4u a1 = *(const v4u*)(s1 + off); const unsigned w1[4] = {a1.x, a1.y, a1.z, a1.w};
                    if (MODE == 0) {
                        const v4u a0 = *(const v4u*)(s0 + off), a2 = *(const v4u*)(s2 + off);
                        const unsigned w0[4] = {a0.x, a0.y, a0.z, a0.w}, w2[4] = {a2.x, a2.y, a2.z, a2.w};
#pragma unroll
                        for (int i2 = 0; i2 < 4; ++i2)
#pragma unroll
                            for (int e = 0; e < 2; ++e) { const int di = 2 * i2 + e;
                                const float um = hasm ? (e ? bfhi(w0[i2]) : bflo(w0[i2])) : 0.f, u0 = e ? bfhi(w1[i2]) : bflo(w1[i2]), up = hasp ? (e ? bfhi(w2[i2]) : bflo(w2[i2])) : 0.f;
                                const float pre = CW[1536 + cwo + di] + CW[cwo + di] * um + CW[512 + cwo + di] * u0 + CW[1024 + cwo + di] * up;
                                val[di] = pre * RCPF(1.0f + EXPF(-pre)); }
                    } else {
#pragma unroll
                        for (int i2 = 0; i2 < 4; ++i2) { val[2 * i2] = bflo(w1[i2]); val[2 * i2 + 1] = bfhi(w1[i2]); }
                    }
                    if (qk) {
#pragma unroll
                        for (int e = 0; e < 8; ++e) { val[e] *= kscale; *(LP(unsigned short))(KWT + (d0 + e) * ST64 + j * 2) = F2BF(val[e] * wk); }
                        *(LP(v4u))(K + j * ST256 + d0 * 2) = (v4u){PK2(val[0], val[1]), PK2(val[2], val[3]), PK2(val[4], val[5]), PK2(val[6], val[7])};
                    } else {
                        if (MODE == 0) {
#pragma unroll
                            for (int e = 0; e < 8; ++e) qn += val[e] * NV[d0 + e]; }
                        *(LP(v4u))(Q + j * ST256 + d0 * 2) = (v4u){PK2(val[0], val[1]), PK2(val[2], val[3]), PK2(val[4], val[5]), PK2(val[6], val[7])};
                    }
                }
                if (MODE == 0) { qn += SHX(qn, 1); qn += SHX(qn, 2); qn += SHX(qn, 4); if (c8 == 0) QN[j] = qn; }
                const v2u vv = *(const v2u*)(s1 + voff + h * 256 + vs * 32 + c8 * 4);
                const int v0 = c8 * 4;
                *(LP(unsigned short))(VT + (v0 + 0) * ST64 + j * 2) = (unsigned short)(vv.x & 0xffffu); *(LP(unsigned short))(VT + (v0 + 1) * ST64 + j * 2) = (unsigned short)(vv.x >> 16);
                *(LP(unsigned short))(VT + (v0 + 2) * ST64 + j * 2) = (unsigned short)(vv.y & 0xffffu); *(LP(unsigned short))(VT + (v0 + 3) * ST64 + j * 2) = (unsigned short)(vv.y >> 16);
            }
            SYNC();
            v4f oacc = (v4f){0.f, 0.f, 0.f, 0.f};
            {
                const float rt = RT[16 * tt + fr];
#pragma unroll
                for (int i = 0; i < 2; ++i) { const int st = (wave & 1) * 2 + i; v4f p = (v4f){0.f, 0.f, 0.f, 0.f};
                    if (st <= tt) { p = tile_mma(p, Q, ST256, 16 * tt, K, ST256, 16 * st, 8, fr, fq);
                        const v4f as4 = *(LP(const v4f))(AS + 16 * st + 4 * fq);
                        p.x *= EXPF(as4.x + rt); p.y *= EXPF(as4.y + rt); p.z *= EXPF(as4.z + rt); p.w *= EXPF(as4.w + rt);
                        if (st == tt) { if (4 * fq + 0 > fr) p.x = 0.f; if (4 * fq + 1 > fr) p.y = 0.f; if (4 * fq + 2 > fr) p.z = 0.f; if (4 * fq + 3 > fr) p.w = 0.f; } }
                    *(LP(v2u))(PM + (16 * tt + fr) * ST64 + (16 * st + 4 * fq) * 2) = (v2u){PK2(p.x, p.y), PK2(p.z, p.w)};
                    if (MODE == 0) { float rs = (p.x + p.y) + (p.z + p.w); rs += SHX(rs, 16); rs += SHX(rs, 32); if (fq == 0) DENP[st * 64 + 16 * tt + fr] = rs; } }
                oacc = tile_mma(oacc, Q, ST256, 16 * tt, STT, ST256, 16 * vt, 8, fr, fq);
                const float wi = WI[16 * tt + fr];
                oacc = oacc * wi;
            }
            SYNC();
            oacc = tile_mma(oacc, PM, ST64, 16 * tt, VT, ST64, 16 * vt, 2, fr, fq);
            if (MODE == 0) { const int t = 16 * tt + fr; const float den = (DENP[t] + DENP[64 + t]) + (DENP[128 + t] + DENP[192 + t]) + WI[t] * QN[t];
                const float dv = 1.0f / fmaxf(fabsf(den), EMT[t]); oacc = oacc * dv; }
            if (seg || store_ctx) { const int orow = tok_row(b, seg, ci * 64 + 16 * tt + fr, dir, 1);
                *(v4f*)(Od + (size_t)orow * 1024 + h * 256 + vs * 32 + 16 * vt + 4 * fq) = oacc; }
            const float dcy = SC[0];
#pragma unroll
            for (int i = 0; i < 4; ++i) { const int dt = (wave >> 1) * 4 + i;
                sacc[i] = sacc[i] * dcy;
                sacc[i] = tile_mma(sacc[i], VT, ST64, 16 * vt, KWT, ST64, 16 * dt, 2, fr, fq);
                *(LP(v2u))(STT + (16 * vt + fr) * ST256 + (16 * dt + 4 * fq) * 2) = (v2u){PK2(sacc[i].x, sacc[i].y), PK2(sacc[i].z, sacc[i].w)}; }
            if (MODE == 0 && tid < 256) { float s = 0.f;
#pragma unroll
                for (int g8 = 0; g8 < 8; ++g8) { const v4u w = *(LP(const v4u))(KWT + tid * ST64 + g8 * 16);
                    s += (bflo(w.x) + bfhi(w.x)) + (bflo(w.y) + bfhi(w.y)) + (bflo(w.z) + bfhi(w.z)) + (bflo(w.w) + bfhi(w.w)); }
                NV[tid] = dcy * NV[tid] + s; }
            SYNC();
        }
    }
}

constexpr int S5_LDS_PER_WAVE = 1280 + 8448 + 4352;
DEV void s5_unit(const bf16* S, int ldS, float* O, const float* lam_re, const float* lam_im, const float* log_step, const float* b_re, const float* b_im,
                 const float* c_re, const float* c_im, int unit, LP(unsigned char) wl, int lane) {
    const int fr = lane & 15, fq = lane >> 4;
    const int dir = unit & 1, g = (unit >> 1) & 63, b = unit >> 7;
    LP(unsigned char) UB = wl; LP(unsigned char) XB = wl + 1280; LP(unsigned char) HB = wl + 1280 + 8448;
    const int pg = (dir * 64 + g);
    const float lr = lam_re[pg * 64 + lane], li = lam_im[pg * 64 + lane], step = expf(log_step[pg]);
    const float mag = expf(lr * step); float sn, cs; sincosf(li * step, &sn, &cs);
    const float ar = mag * cs, ai = mag * sn, den = lr * lr + li * li;
    const float cre = ((ar - 1.0f) * lr + ai * li) / den, cim = (ai * lr - (ar - 1.0f) * li) / den;
    for (int p = 0; p < 16; ++p) { const float br = b_re[(pg * 64 + lane) * 16 + p], bi = b_im[(pg * 64 + lane) * 16 + p];
        *(LP(unsigned short))(XB + lane * 32 + p * 2) = F2BF(cre * br - cim * bi);
        *(LP(unsigned short))(XB + (64 + lane) * 32 + p * 2) = F2BF(cre * bi + cim * br); }
    WAVE_SYNC();
    v8s bfrag[8];
#pragma unroll
    for (int nt = 0; nt < 8; ++nt) { if (fq < 2) bfrag[nt] = *(LP(const v8s))(XB + (16 * nt + fr) * 32 + fq * 16); else bfrag[nt] = (v8s){0, 0, 0, 0, 0, 0, 0, 0}; }
    v8s cfrag[4];
#pragma unroll
    for (int ks = 0; ks < 4; ++ks) { const int n0 = 32 * ks + 8 * fq; const float* src = (n0 < 64 ? c_re : c_im) + ((size_t)pg * 16 + fr) * 64 + (n0 & 63); const float sgn = n0 < 64 ? 1.f : -1.f;
        v8s f;
#pragma unroll
        for (int i = 0; i < 8; ++i) f[i] = (short)F2BF(sgn * src[i]);
        cfrag[ks] = f; }
    WAVE_SYNC();
    for (int i = lane; i < 1280 / 4; i += 64) ((LP(unsigned))UB)[i] = 0u;
    WAVE_SYNC();
    float hr = 0.f, hi = 0.f;
    float* Od = O + (size_t)dir * TT * 1024;
    for (int seg = 0; seg < 2; ++seg) {
        const int nblk = (seg ? SEQ : CTXL) / 16;
        for (int bi = 0; bi < nblk; ++bi) {
            if (lane < 32) { const int tk = lane >> 1, hf = lane & 1; const int row = tok_row(b, seg, bi * 16 + tk, dir, 0);
                *(LP(v4u))(UB + tk * 80 + hf * 16) = *(const v4u*)(S + (size_t)row * ldS + g * 16 + hf * 8); }
            WAVE_SYNC();
            const v8s uf = *(LP(const v8s))(UB + fr * 80 + fq * 16);
#pragma unroll
            for (int nt = 0; nt < 8; ++nt) { v4f x = (v4f){0.f, 0.f, 0.f, 0.f}; x = MFMA16(bfrag[nt], uf, x);
                *(LP(v4f))(XB + fr * 528 + (16 * nt + 4 * fq) * 4) = x; }
            WAVE_SYNC();
#pragma unroll
            for (int tk = 0; tk < 16; ++tk) { const float xr = *(LP(const float))(XB + tk * 528 + lane * 4), xi = *(LP(const float))(XB + tk * 528 + (64 + lane) * 4);
                const float nr = ar * hr - ai * hi + xr, ni = ar * hi + ai * hr + xi; hr = nr; hi = ni;
                *(LP(unsigned short))(HB + tk * 272 + lane * 2) = F2BF(hr); *(LP(unsigned short))(HB + tk * 272 + (64 + lane) * 2) = F2BF(hi); }
            WAVE_SYNC();
            if (seg) { v4f y = (v4f){0.f, 0.f, 0.f, 0.f};
#pragma unroll
                for (int ks = 0; ks < 4; ++ks) { const v8s hf = *(LP(const v8s))(HB + fr * 272 + ks * 64 + fq * 16); y = MFMA16(cfrag[ks], hf, y); }
                const int orow = tok_row(b, seg, bi * 16 + fr, dir, 0);
                *(v4f*)(Od + (size_t)orow * 1024 + g * 16 + 4 * fq) = y; }
        }
    }
}

DEV float wsum(float v) {
#pragma unroll
    for (int o = 1; o < 64; o <<= 1) v += SHX(v, o);
    return v;
}
DEV void merge_even_row(int r, const bf16* S, const float* O, const float* gla_norm, const float* ml_norm, bf16* HBo, int lane) {
    const bf16* sr = S + (size_t)r * EV_PAD;
#pragma unroll
    for (int hh = 0; hh < 8; ++hh) { const int mix = hh >> 2, c = (hh & 3) * 256 + 4 * lane;
        const float* o0 = O + (size_t)(2 * mix) * TT * 1024 + (size_t)r * 1024 + c; const float* o1 = o0 + (size_t)TT * 1024;
        v4f o = *(const v4f*)o0 + *(const v4f*)o1;
#ifdef NO_GLA
        if (!mix) o = (v4f){0.f, 0.f, 0.f, 0.f};
#endif
#ifdef NO_ML
        if (mix) o = (v4f){0.f, 0.f, 0.f, 0.f};
#endif
        if (mix) { const float mean = wsum((o.x + o.y) + (o.z + o.w)) * (1.0f / 256.0f); o = o - mean; }
        const float ms = wsum((o.x * o.x + o.y * o.y) + (o.z * o.z + o.w * o.w)) * (1.0f / 256.0f);
        const float rstd = RSQRTF(ms + EPS);
        const v4f gn = *(const v4f*)((mix ? ml_norm : gla_norm) + c);
        const v2u gw = *(const v2u*)(sr + (mix ? 6144 : 2048) + c);
        const float g0 = bflo(gw.x), g1 = bfhi(gw.x), g2 = bflo(gw.y), g3 = bfhi(gw.y);
        v4f gate;
        if (mix) { gate.x = RCPF(1.0f + EXPF(-g0)); gate.y = RCPF(1.0f + EXPF(-g1)); gate.z = RCPF(1.0f + EXPF(-g2)); gate.w = RCPF(1.0f + EXPF(-g3)); }
        else { gate.x = g0 * RCPF(1.0f + EXPF(-g0)); gate.y = g1 * RCPF(1.0f + EXPF(-g1)); gate.z = g2 * RCPF(1.0f + EXPF(-g2)); gate.w = g3 * RCPF(1.0f + EXPF(-g3)); }
        const v4f res = gate * (o * rstd * gn);
        *(v2u*)(HBo + (size_t)r * D + mix * 1024 + c) = (v2u){PK2(res.x, res.y), PK2(res.z, res.w)}; }
}
DEV float gelu_tanh(float y) { const float z = 0.7978845608028654f * (y + 0.044715f * y * y * y); const float t = 1.0f - 2.0f * RCPF(1.0f + EXPF(2.0f * z)); return 0.5f * y * (1.0f + t); }
DEV void merge_odd_row(int r, const bf16* S, const float* O, const float* s5_d, const float* ret_norm, bf16* GBo, bf16* HBo, int lane) {
    const bf16* sr = S + (size_t)r * OD_COLS;
#pragma unroll
    for (int hh = 0; hh < 4; ++hh) { const int c = hh * 256 + 4 * lane;
        { const float* o0 = O + (size_t)r * 1024 + c; const float* o1 = o0 + (size_t)TT * 1024;
          v4f y0 = *(const v4f*)o0 + *(const v4f*)o1;
#ifdef NO_S5
          y0 = (v4f){0.f, 0.f, 0.f, 0.f};
#endif
          const v4f dd = *(const v4f*)(s5_d + c); const v2u uw = *(const v2u*)(sr + c);
          const float y[4] = {y0.x + dd.x * bflo(uw.x), y0.y + dd.y * bfhi(uw.x), y0.z + dd.z * bflo(uw.y), y0.w + dd.w * bfhi(uw.y)};
          *(v2u*)(GBo + (size_t)r * 1024 + c) = (v2u){PK2(gelu_tanh(y[0]), gelu_tanh(y[1])), PK2(gelu_tanh(y[2]), gelu_tanh(y[3]))}; }
        { const float* o0 = O + (size_t)2 * TT * 1024 + (size_t)r * 1024 + c; const float* o1 = o0 + (size_t)TT * 1024;
          v4f o = *(const v4f*)o0 + *(const v4f*)o1;
#ifdef NO_RET
          o = (v4f){0.f, 0.f, 0.f, 0.f};
#endif
          const float mean = wsum((o.x + o.y) + (o.z + o.w)) * (1.0f / 256.0f); o = o - mean;
          const float ms = wsum((o.x * o.x + o.y * o.y) + (o.z * o.z + o.w * o.w)) * (1.0f / 256.0f);
          const float rstd = RSQRTF(ms + EPS);
          const v4f gn = *(const v4f*)(ret_norm + c);
          const v2u gw = *(const v2u*)(sr + 4096 + c);
          const float g0 = bflo(gw.x), g1 = bfhi(gw.x), g2 = bflo(gw.y), g3 = bfhi(gw.y);
          v4f gate; gate.x = g0 * RCPF(1.0f + EXPF(-g0)); gate.y = g1 * RCPF(1.0f + EXPF(-g1)); gate.z = g2 * RCPF(1.0f + EXPF(-g2)); gate.w = g3 * RCPF(1.0f + EXPF(-g3));
          const v4f res = gate * (o * rstd * gn);
          *(v2u*)(HBo + (size_t)r * D + 1024 + c) = (v2u){PK2(res.x, res.y), PK2(res.z, res.w)}; }
    }
}

struct EpiGLU {
    static constexpr bool PERM = true, AFTER_DRAIN = false;
    const bf16* G; const float* bias; bf16* O;
    __device__ __forceinline__ void operator()(const pg8::f32x4 (&acc)[2][2][4][2], const pg8::Unit& u, int wr, int wc, int fr, int fq) const {
        const int row0 = u.pm * 256 + wr * 64 + fr, col0 = u.pn * 256 + wc * 32 + 8 * fq;
#pragma unroll
        for (int ai = 0; ai < 2; ++ai)
#pragma unroll
            for (int m = 0; m < 4; ++m) { const size_t row = (size_t)(row0 + ai * 128 + m * 16);
#pragma unroll
                for (int bj = 0; bj < 2; ++bj) { const int col = col0 + bj * 128;
                    const v4u gw = *(const v4u*)(G + row * 1024 + col); const pg8::f32x4 b0 = *(const pg8::f32x4*)(bias + col), b1 = *(const pg8::f32x4*)(bias + col + 4);
                    const pg8::f32x4 v0 = acc[ai][bj][m][0] + b0, v1 = acc[ai][bj][m][1] + b1;
                    v4u w; w.x = pk2(bflo(gw.x) * fast_sigmoid(v0[0]), bfhi(gw.x) * fast_sigmoid(v0[1])); w.y = pk2(bflo(gw.y) * fast_sigmoid(v0[2]), bfhi(gw.y) * fast_sigmoid(v0[3]));
                    w.z = pk2(bflo(gw.z) * fast_sigmoid(v1[0]), bfhi(gw.z) * fast_sigmoid(v1[1])); w.w = pk2(bflo(gw.w) * fast_sigmoid(v1[2]), bfhi(gw.w) * fast_sigmoid(v1[3]));
                    *(v4u*)(O + row * D + col) = w; } }
    }
};

__device__ __forceinline__ void mixer_phases(const Args& a, unsigned char* ws, LAS unsigned char* lds, const XcdBarrier& bar, int layer, int G, int gw, int ngw, int tid, int lane, int wave) {
    bf16* HB = (bf16*)(ws + WS_HB); bf16* S = (bf16*)(ws + WS_S); float* GT = (float*)(ws + WS_GT); float* O = (float*)(ws + WS_O); bf16* GB = (bf16*)(ws + WS_GB); float* Y = (float*)(ws + WS_Y);
    const int ldS = layer == 0 ? EV_PAD : OD_COLS;
    { pg8::Gemm g{HB, (const bf16*)(ws + (layer == 0 ? WS_WIN_EV : WS_WIN_OD)), TT, ldS, D}; pg8::StaticOrder So; So.init(TT, ldS, G, (int)blockIdx.x);
      EpiS E{S, ldS, GT, layer == 0 ? 28 : -1};
      pg8::gemm_phase<EpiS, pg8::StaticOrder, true, true>(lds, g, So, E); }
    xcd_barrier(bar);
    { int t2 = threadIdx.x; asm volatile("" : "+v"(t2)); tid = t2; lane = t2 & 63; wave = __builtin_amdgcn_readfirstlane(t2 >> 6); }
    if (layer == 0) {
        for (int u = blockIdx.x; u < NB * 64; u += G) {
#ifndef NO_GLA
            gla_unit(S, GT, O, a.in[13], a.in[14], u, lds, tid);
#endif
#ifndef NO_ML
            mat_unit<0>(S, EV_PAD, 3072, 4096, 5120, GT, O, 1, a.in[16], a.in[17], a.in[18], nullptr, u, lds, tid);
#endif
        }
    } else {
        for (int u = blockIdx.x; u < NB * 64; u += G)
#ifndef NO_RET
            mat_unit<1>(S, OD_COLS, 1024, 2048, 3072, nullptr, O, 0, nullptr, nullptr, nullptr, a.in[32], u, lds, tid);
#else
            ;
#endif
#ifndef NO_S5
        if (wave < 2) { for (int su = blockIdx.x * 2 + wave; su < NB * 128; su += 2 * G)
            s5_unit(S, OD_COLS, O, a.in[22], a.in[23], a.in[24], a.in[25], a.in[26], a.in[27], a.in[28], su, lds + wave * S5_LDS_PER_WAVE, lane); }
#endif
    }
    xcd_barrier(bar);
    { int t2 = threadIdx.x; asm volatile("" : "+v"(t2)); tid = t2; lane = t2 & 63; wave = __builtin_amdgcn_readfirstlane(t2 >> 6); gw = blockIdx.x * NWAVES + wave; }
#ifndef NO_MERGE
    if (layer == 0) { for (int r = gw; r < TT; r += ngw) merge_even_row(r, S, O, a.in[15], a.in[19], HB, lane); }
    else { for (int r = gw; r < TL; r += ngw) merge_odd_row(r, S, O, a.in[29], a.in[33], GB, HB, lane); }
#endif
    xcd_barrier(bar);
    const int Mo = layer == 0 ? TT : TL;
    if (layer == 1) {
        pg8::Gemm g{GB, (const bf16*)(ws + WS_WGLU), TL, 1024, 1024}; pg8::StaticOrder So; So.init(TL, 1024, G, (int)blockIdx.x);
        EpiGLU E{GB, a.in[31], HB};
        pg8::gemm_phase<EpiGLU, pg8::StaticOrder, true, true>(lds, g, So, E);
        xcd_barrier(bar);
    }
    { pg8::Gemm g{HB, (const bf16*)(ws + (layer == 0 ? WS_WOUT_EV : WS_WOUT_OD)), Mo, D, D}; pg8::StaticOrder So; So.init(Mo, D, G, (int)blockIdx.x);
      EpiF32 E{Y, D};
      pg8::gemm_phase<EpiF32, pg8::StaticOrder, true, true>(lds, g, So, E); }
    xcd_barrier(bar);
}

#ifndef MIXER_ON
#define MIXER_ON 1
#endif
__global__ void __launch_bounds__(NTHR, 2) fwd(Args a) {
    extern __shared__ __attribute__((aligned(16))) unsigned char lds_raw[];
    LAS unsigned char* lds = (LAS unsigned char*)lds_raw;
    const int tid = threadIdx.x, lane = tid & 63, wave = __builtin_amdgcn_readfirstlane(tid >> 6);
    const int G = gridDim.x, gw = blockIdx.x * NWAVES + wave, ngw = G * NWAVES;
    unsigned char* ws = a.ws;
    if (tid < 16) ((LAS unsigned*)(lds + MISC_OFF))[tid] = 0u;
    __syncthreads();
    XcdBarrier bar = xcd_barrier_post((unsigned*)(ws + WS_CTL), (volatile LAS unsigned*)(lds + MISC_OFF));

#ifdef NAN_POISON
    {
        v4u q = (v4u){0xffffffffu, 0xffffffffu, 0xffffffffu, 0xffffffffu};
        for (int i = tid; i < (MISC_OFF) / 16; i += NTHR) ((LAS v4u*)lds)[i] = q;
        { v4u* p = (v4u*)(ws + WS_MOD); const size_t n = (WS_WGU - WS_MOD) / 16; for (size_t i = (size_t)blockIdx.x * NTHR + tid; i < n; i += (size_t)G * NTHR) p[i] = q; }
        { v4u* p = (v4u*)(ws + WS_XC); const size_t n = (WS_END - WS_XC) / 16; for (size_t i = (size_t)blockIdx.x * NTHR + tid; i < n; i += (size_t)G * NTHR) p[i] = q; }
        { v4u* p = (v4u*)a.out; const size_t n = (size_t)TL * D * 4 / 16; for (size_t i = (size_t)blockIdx.x * NTHR + tid; i < n; i += (size_t)G * NTHR) p[i] = q; }
        __syncthreads();
        xcd_barrier(bar);
    }
#endif
    float* MOD = (float*)(ws + WS_MOD); float* MODP = (float*)(ws + WS_MODP);
    bf16* HB = (bf16*)(ws + WS_HB); bf16* HID = (bf16*)(ws + WS_HID); float* Y = (float*)(ws + WS_Y); float* XC = (float*)(ws + WS_XC);
    const float* in_x = a.in[0]; const float* in_ctx = a.in[2];
    const float* norm_pre = a.in[6]; const float* norm_post = a.in[7];

    {
        TJob* jobs = (TJob*)lds_raw;
        LAS float* stab = (LAS float*)(lds + 1024);
        if (tid == 0) {
            int t = 0, ji = 0;
            for (int l = 0; l < 2; ++l) for (int i = 0; i < 2; ++i) {
                const size_t wo = (size_t)(l * 2 + i) * 2048 * 5504;
                TJob j; j.K = 2048; j.N = 5504; j.dst = (bf16*)(ws + WS_WGU + (size_t)(l * 2 + i) * SZ_WGU);
                j.src = a.in[8] + wo; j.map = 1; j.tstart = t; jobs[ji++] = j; t += tj_tiles(2048, 5504);
                j.src = a.in[9] + wo; j.map = 2; j.tstart = t; jobs[ji++] = j; t += tj_tiles(2048, 5504);
                j.K = 5504; j.N = 2048; j.dst = (bf16*)(ws + WS_WD + (size_t)(l * 2 + i) * SZ_WD); j.src = a.in[10] + wo; j.map = 0; j.tstart = t; jobs[ji++] = j; t += tj_tiles(5504, 2048);
            }
            TJob j; j.map = 0;
            j.K = 2048; j.N = EV_COLS; j.src = a.in[11]; j.dst = (bf16*)(ws + WS_WIN_EV); j.map = 3; j.tstart = t; jobs[ji++] = j; t += tj_tiles(2048, EV_COLS);
            j.map = 0;
            j.K = 2048; j.N = 2048; j.src = a.in[12]; j.dst = (bf16*)(ws + WS_WOUT_EV); j.tstart = t; jobs[ji++] = j; t += tj_tiles(2048, 2048);
            j.K = 2048; j.N = OD_COLS; j.src = a.in[20]; j.dst = (bf16*)(ws + WS_WIN_OD); j.tstart = t; jobs[ji++] = j; t += tj_tiles(2048, OD_COLS);
            j.K = 2048; j.N = 2048; j.src = a.in[21]; j.dst = (bf16*)(ws + WS_WOUT_OD); j.tstart = t; jobs[ji++] = j; t += tj_tiles(2048, 2048);
            j.K = 1024; j.N = 1024; j.src = a.in[30]; j.dst = (bf16*)(ws + WS_WGLU); j.tstart = t; jobs[ji++] = j; t += tj_tiles(1024, 1024);
            ((LAS int*)(lds + 1024 - 16))[0] = t;
        }
        for (int i = tid; i < 5 * D; i += NTHR) { const int r = i >> 11, k = i & (D - 1); const float c = r < 4 ? a.in[1][r * D + k] : a.in[3][k]; stab[i] = c / (1.0f + expf(-c)); }
        __syncthreads();
        for (int it = gw; it < 2 * MOD_KC * 72; it += ngw) {
            const int l = it / (MOD_KC * 72), rem = it % (MOD_KC * 72), kc = rem / 72, jb = rem % 72; constexpr int KCH = D / MOD_KC;
            const float* W = a.in[4] + ((size_t)l * D + kc * KCH) * (NMOD * D) + jb * 256 + lane * 4;
            f32x4 acc[5];
#pragma unroll
            for (int r = 0; r < 5; ++r) acc[r] = (f32x4){0.f, 0.f, 0.f, 0.f};
            for (int k = 0; k < KCH; k += 8) { f32x4 w[8];
#pragma unroll
                for (int i = 0; i < 8; ++i) w[i] = *(const f32x4*)(W + (size_t)(k + i) * (NMOD * D));
#pragma unroll
                for (int i = 0; i < 8; ++i)
#pragma unroll
                    for (int r = 0; r < 5; ++r) acc[r] += stab[r * D + kc * KCH + k + i] * w[i]; }
#pragma unroll
            for (int r = 0; r < 5; ++r) *(f32x4*)(MODP + (((size_t)l * MOD_KC + kc) * 5 + r) * (NMOD * D) + jb * 256 + lane * 4) = acc[r];
        }
        const int ntiles = ((LAS int*)(lds + 1024 - 16))[0];
        for (int t = gw; t < ntiles; t += ngw) {
            int ji = 0;
#pragma unroll 1
            for (int q = 1; q < NJOBS; ++q) if (t >= jobs[q].tstart) ji = q;
            const TJob j = jobs[ji];
            transpose_tile(j, t - j.tstart, lane);
        }
        { v4u z = (v4u){0u, 0u, 0u, 0u}; v4u* p = (v4u*)(ws + WS_WIN_EV + (size_t)EV_COLS * 2048 * 2); const int n16 = (EV_PAD - EV_COLS) * 2048 * 2 / 16;
          for (int i = blockIdx.x * NTHR + tid; i < n16; i += G * NTHR) p[i] = z; }
    }
    xcd_barrier(bar);
    for (int i = blockIdx.x * NTHR + tid; i < 2 * 5 * NMOD * D; i += G * NTHR) {
        const int l = i / (5 * NMOD * D), rem = i % (5 * NMOD * D), r = rem / (NMOD * D), j = rem % (NMOD * D);
        float s = a.in[5][l * (NMOD * D) + j];
        for (int kc = 0; kc < MOD_KC; ++kc) s += MODP[(((size_t)l * MOD_KC + kc) * 5 + r) * (NMOD * D) + j];
        MOD[i] = s;
    }
    xcd_barrier(bar);
    { NormP p{}; p.xin_lat = in_x; p.xin_ctx = in_ctx; p.xout_lat = a.out; p.xout_ctx = XC; p.y = nullptr; p.h = HB; p.rows_end = TT; p.has_y = 0; p.has_h = 1; p.w = 0.f; p.lp = 0; p.sp = 0; p.ln = 0; p.sn = 0;
      norm_phase(p, MOD, norm_pre, norm_post, lds, gw, ngw, tid, lane); }
    xcd_barrier(bar);

#pragma unroll 1
    for (int layer = 0; layer < 2; ++layer) {
#pragma unroll 1
        for (int half = 0; half < 2; ++half) {
            const int Mrows = (layer == 1 && half == 1) ? TL : TT;
#if MIXER_ON
            if (half == 1) {
                mixer_phases(a, ws, lds, bar, layer, G, gw, ngw, tid, lane, wave);
                NormP p{}; p.xin_lat = a.out; p.xin_ctx = XC; p.xout_lat = a.out; p.xout_ctx = XC; p.y = Y; p.h = HB; p.rows_end = Mrows; p.has_y = 1; p.has_h = 1; p.w = 1.0f; p.lp = layer; p.sp = 1; p.ln = layer; p.sn = 2;
                norm_phase(p, MOD, norm_pre, norm_post, lds, gw, ngw, tid, lane);
                xcd_barrier(bar);
            }
#endif
            const int sub = half * 2;
            { pg8::Gemm g{HB, (const bf16*)(ws + WS_WGU + (size_t)(layer * 2 + half) * SZ_WGU), Mrows, 2 * DFF, D}; pg8::StaticOrder S; S.init(Mrows, 2 * DFF, G, (int)blockIdx.x);
              EpiSwiGLU E{HID, DFF};
              pg8::gemm_phase<EpiSwiGLU, pg8::StaticOrder, true, true>(lds, g, S, E); }
            xcd_barrier(bar);
            { pg8::Gemm g{HID, (const bf16*)(ws + WS_WD + (size_t)(layer * 2 + half) * SZ_WD), Mrows, D, DFF}; pg8::StaticOrder S; S.init(Mrows, D, G, (int)blockIdx.x);
              EpiF32 E{Y, D};
              pg8::gemm_phase<EpiF32, pg8::StaticOrder, true, true>(lds, g, S, E); }
            xcd_barrier(bar);
            { NormP p{}; const bool first = (layer == 0 && half == 0);
              p.xin_lat = first ? in_x : a.out; p.xin_ctx = first ? in_ctx : XC; p.xout_lat = a.out; p.xout_ctx = XC; p.y = Y; p.h = HB; p.rows_end = Mrows; p.has_y = 1; p.w = 0.5f; p.lp = layer; p.sp = sub;
              if (half == 0) { p.has_h = 1; p.ln = layer; p.sn = MIXER_ON ? 1 : 2; }
              else if (layer == 0) { p.has_h = 1; p.ln = 1; p.sn = 0; }
              else { p.has_h = 0; p.ln = 0; p.sn = 0; }
              norm_phase(p, MOD, norm_pre, norm_post, lds, gw, ngw, tid, lane); }
            if (!(layer == 1 && half == 1)) xcd_barrier(bar);
        }
    }
}

extern "C" void kernel_launch(void* const* d_in, const int* in_sizes, int n_in, void* d_out, int out_size, void* d_ws, size_t ws_size, hipStream_t stream) {
    static int grid = 0;
    if (grid == 0) {
        if (n_in != 34 || out_size != TL * D || ws_size < WS_END) { fprintf(stderr, "kernel_launch: unexpected shapes (n_in %d out %d ws %zu need %zu)\n", n_in, out_size, ws_size, (size_t)WS_END); grid = -1; return; }
        int dev = 0, cus = 0, per_cu = 0;
        if (hipGetDevice(&dev) != hipSuccess || hipDeviceGetAttribute(&cus, hipDeviceAttributeMultiprocessorCount, dev) != hipSuccess) { grid = -1; return; }
        if (hipFuncSetAttribute((const void*)fwd, hipFuncAttributeMaxDynamicSharedMemorySize, LDS_BYTES) != hipSuccess) { fprintf(stderr, "kernel_launch: hipFuncSetAttribute failed\n"); grid = -1; return; }
        if (hipOccupancyMaxActiveBlocksPerMultiprocessor(&per_cu, (const void*)fwd, NTHR, LDS_BYTES) != hipSuccess || per_cu < 1) { fprintf(stderr, "kernel_launch: occupancy query says %d\n", per_cu); }
        (void)hipGetLastError();
        grid = cus;
    }
    if (grid < 0) return;
    if (hipMemsetAsync((char*)d_ws + WS_CTL, 0, CTL_ZERO_BYTES, stream) != hipSuccess) return;
    Args a{};
    for (int i = 0; i < 34; ++i) a.in[i] = (const float*)d_in[i];
    a.out = (float*)d_out; a.ws = (unsigned char*)d_ws;
    hipLaunchKernelGGL(fwd, dim3(grid), dim3(NTHR), LDS_BYTES, stream, a);
}
```

```cpp
#include <hip/hip_runtime.h>
#include <cstdio>
#include <cstdint>
#define MIXER_ON 1

#define XB_TMO      128
#define XB_XCNT(j)  (256  + 64 * (j))
#define XB_XSUB(j)  (1280 + 64 * (j))
#define XB_XGEN(j)  (2304 + 64 * (j))
#define XB_TOP      3328
#define XB_TOPGEN   3392
#define XCD_BAR_WORDS 3456
#define XB_SPIN_CAP (1u << 18)
#define LAS __attribute__((address_space(3)))

__device__ __forceinline__ unsigned xb_ld(unsigned* p)              { return __hip_atomic_load(p, __ATOMIC_RELAXED, __HIP_MEMORY_SCOPE_AGENT); }
__device__ __forceinline__ unsigned xb_add(unsigned* p, unsigned v) { return __hip_atomic_fetch_add(p, v, __ATOMIC_RELAXED, __HIP_MEMORY_SCOPE_AGENT); }
__device__ __forceinline__ unsigned xb_xcc_id() { return (unsigned)__builtin_amdgcn_s_getreg((3 << 11) | 20) & 0xFu; }
#define XB_SPIN(cond, bar) do { unsigned _sp = 0; while (cond) { __builtin_amdgcn_s_sleep(1); \
    if ((++_sp & 255u) == 0u) { if (xb_ld(&(bar)[XB_TMO])) break; if (_sp > XB_SPIN_CAP) { atomicAdd(&(bar)[XB_TMO], 1u); break; } } } } while (0)

struct XcdBarrier {
    unsigned* bar; unsigned x;
    volatile LAS unsigned* st;
};

__device__ __forceinline__ XcdBarrier xcd_barrier_post(unsigned* bar, volatile LAS unsigned* st) {
    XcdBarrier b; b.bar = bar; b.x = xb_xcc_id(); b.st = st;
    if (threadIdx.x == 0) (void)xb_add(&bar[XB_XCNT(b.x)], 1u);
    return b;
}
__device__ __forceinline__ void xcd_barrier_complete(unsigned* bar, unsigned x, unsigned& nloc, unsigned& nx) {
    const unsigned G = gridDim.x * gridDim.y * gridDim.z;
    unsigned sum, cnt, mine, sp = 0u;
    for (;;) {
        sum = 0u; cnt = 0u; mine = 0u;
#pragma unroll
        for (unsigned j = 0; j < 16; ++j) { const unsigned c = xb_ld(&bar[XB_XCNT(j)]); sum += c; cnt += (c > 0u) ? 1u : 0u; mine = (j == x) ? c : mine; }
        if (sum == G) break;
        __builtin_amdgcn_s_sleep(1);
        if ((++sp & 255u) == 0u) { if (xb_ld(&bar[XB_TMO])) break; if (sp > XB_SPIN_CAP) { atomicAdd(&bar[XB_TMO], 1u); break; } }
    }
    nloc = mine > 0u ? mine : 1u; nx = cnt > 0u ? cnt : 1u;
}

__device__ __forceinline__ void xcd_barrier(const XcdBarrier& b) {
    asm volatile("s_waitcnt vmcnt(0)" ::: "memory");
    __syncthreads();
    if (threadIdx.x == 0) {
        unsigned* bar = b.bar;
        __builtin_amdgcn_s_waitcnt(0);
        unsigned nloc = b.st[0], nx = b.st[1];
        if (nloc == 0u) { xcd_barrier_complete(bar, b.x, nloc, nx); b.st[0] = nloc; b.st[1] = nx; }
        const unsigned old = xb_add(&bar[XB_XSUB(b.x)], 1u);
        const unsigned gen = old / nloc;
        if (old + 1u == (gen + 1u) * nloc) {
            __builtin_amdgcn_fence(__ATOMIC_RELEASE, "agent");
            asm volatile("s_waitcnt vmcnt(0)" ::: "memory");
            const unsigned og = xb_add(&bar[XB_TOP], 1u);
            const unsigned tg = og / nx;
            if (og + 1u == (tg + 1u) * nx) xb_add(&bar[XB_TOPGEN], 1u);
            else XB_SPIN(xb_ld(&bar[XB_TOPGEN]) == tg, bar);
            __builtin_amdgcn_fence(__ATOMIC_ACQUIRE, "agent");
            xb_add(&bar[XB_XGEN(b.x)], 1u);
            asm volatile("s_waitcnt vmcnt(0)" ::: "memory");
        } else {
            XB_SPIN(xb_ld(&bar[XB_XGEN(b.x)]) == gen, bar);
            __builtin_amdgcn_fence(__ATOMIC_ACQUIRE, "agent");
            asm volatile("s_waitcnt vmcnt(0)" ::: "memory");
        }
    }
    __syncthreads();
}

namespace pg8 {
#define PG8_LAS __attribute__((address_space(3)))
typedef unsigned short bf16_t;
typedef short bf16x8 __attribute__((ext_vector_type(8)));
typedef float f32x4 __attribute__((ext_vector_type(4)));
typedef unsigned u32x4 __attribute__((ext_vector_type(4)));
constexpr int BM = 256, BK = 64, HALF = 128, HTB = HALF * BK * 2  , STAGE_BYTES = 8 * HTB, NXCD = 8, WGM = 8;

__host__ __device__ __forceinline__ int lds_byte(int r, int c) { const int st = (r >> 4) * 2 + (c >> 5), rr = r & 15, cc = c & 31, ob = rr * 64 + cc * 2; return st * 1024 + (ob ^ (((ob >> 9) & 1) << 5)); }
__host__ __device__ __forceinline__ void stage_rc(int b, int& R, int& C) { const int st = b / 1024, sb = b % 1024, swz = sb ^ (((sb >> 9) & 1) << 5); R = (st >> 1) * 16 + swz / 64; C = (st & 1) * 32 + (swz % 64) / 2; }
__host__ __device__ __forceinline__ int perm32(int rho) { const int n = rho >> 4, i = rho & 15; return 8 * (i >> 2) + 4 * n + (i & 3); }

struct Unit { int pm, pn; };
struct Gemm { const bf16_t* A; const bf16_t* Bt; int M, N, K; };

struct StaticOrder {
    int nM, nN, nwg, G, c;
    __host__ __device__ void init(int M, int N, int G_, int c_) { nM = M / BM; nN = N / BM; nwg = nM * nN; G = G_; c = c_; }
    __host__ __device__ bool next(int i, Unit& u) const {
        const long L = (long)i * G + c; if (L >= nwg) return false;
        int wgid = (int)L; { const int q = nwg / NXCD, r = nwg % NXCD, xcd = wgid % NXCD, off = wgid / NXCD; wgid = (xcd < r ? xcd * (q + 1) : r * (q + 1) + (xcd - r) * q) + off; }
        const int nig = WGM * nN, gid = wgid / nig, fm = gid * WGM, gsz = (nM - fm) < WGM ? (nM - fm) : WGM;
        u.pm = fm + ((wgid % nig) % gsz); u.pn = (wgid % nig) / gsz; return true;
    }
    __device__ __forceinline__ void a_ready(const Unit&) const {}
    __device__ __forceinline__ void done(const Unit&) const {}
};
__device__ __forceinline__ unsigned cvt_pk_bf16(float lo, float hi) { unsigned r; asm volatile("v_cvt_pk_bf16_f32 %0, %1, %2" : "=v"(r) : "v"(lo), "v"(hi)); return r; }
template <class Epi, class Sched, bool ALIGN_EPI = false, bool SP2 = false>
__device__ __forceinline__ void gemm_phase(PG8_LAS unsigned char* lds, const Gemm g, const Sched& S, const Epi& E) {
    int tid_ = threadIdx.x; asm volatile("" : "+v"(tid_));
    const int tid = tid_, wid = __builtin_amdgcn_readfirstlane(tid >> 6), lane = tid & 63, wr = wid >> 2, wc = wid & 3, fr = lane & 15, fq = lane >> 4;
    const int K = g.K, nt = K / BK;
    unsigned voffA[2], voffB[2];
#pragma unroll
    for (int i = 0; i < 2; ++i) { int R, C; stage_rc(tid * 16 + i * 8192, R, C); const int Rb = Epi::PERM ? ((R & ~31) + perm32(R & 31)) : R;
        voffA[i] = (unsigned)(R * K + C) * 2u; voffB[i] = (unsigned)(Rb * K + C) * 2u; }
    const size_t kstep = (size_t)(BK * 2);
    const size_t hstep = (size_t)HALF * K * 2;
    const size_t tstep = 2 * hstep;
    const unsigned ldsw = (unsigned)wid * 1024u;
    const int aoff = lds_byte(wr * 64 + fr, fq * 8), boff = lds_byte(wc * 32 + fr, fq * 8);
#define PG8_SA(b, h) (((b) * 2 + (h)) * HTB)
#define PG8_SB(b, h) ((4 + (b) * 2 + (h)) * HTB)
#define PG8_STAGE(bufoff, gbase, voff) do { _Pragma("unroll") for (int _i = 0; _i < 2; ++_i) \
        __builtin_amdgcn_global_load_lds((const unsigned*)((const char*)(gbase) + (voff)[_i]), (PG8_LAS unsigned*)(lds + (bufoff) + ldsw + _i * 8192), 16, 0, 0); } while (0)
#define PG8_LDA(dst, b, h) do { _Pragma("unroll") for (int m = 0; m < 4; ++m) _Pragma("unroll") for (int k = 0; k < 2; ++k) dst[m][k] = *(const PG8_LAS bf16x8*)(lds + PG8_SA(b, h) + aoff + m * 2048 + k * 1024); } while (0)
#define PG8_LDB(dst, b, h) do { _Pragma("unroll") for (int n = 0; n < 2; ++n) _Pragma("unroll") for (int k = 0; k < 2; ++k) dst[n][k] = *(const PG8_LAS bf16x8*)(lds + PG8_SB(b, h) + boff + n * 2048 + k * 1024); } while (0)
#define PG8_MMA(ai, bj, At, Bt) do { __builtin_amdgcn_s_setprio(1); _Pragma("unroll") for (int m = 0; m < 4; ++m) _Pragma("unroll") for (int n = 0; n < 2; ++n) _Pragma("unroll") for (int k = 0; k < 2; ++k) \
        acc[ai][bj][m][n] = __builtin_amdgcn_mfma_f32_16x16x32_bf16(Bt[n][k], At[m][k], acc[ai][bj][m][n], 0, 0, 0); __builtin_amdgcn_s_setprio(0); } while (0)
#define PG8_WAIT_V(n) asm volatile("s_waitcnt vmcnt(" #n ")" ::: "memory")
#define PG8_WAIT_L(n) asm volatile("s_waitcnt lgkmcnt(" #n ")" ::: "memory")
#define PG8_BAR __builtin_amdgcn_s_barrier()
#define PG8_SCHED __builtin_amdgcn_sched_barrier(0)
    Unit cur, nxt; int ui = 0;
    if (!S.next(0, cur)) return;
    f32x4 acc[2][2][4][2];
#pragma unroll
    for (int a = 0; a < 2; ++a)
#pragma unroll
        for (int b = 0; b < 2; ++b)
#pragma unroll
            for (int m = 0; m < 4; ++m)
#pragma unroll
                for (int n = 0; n < 2; ++n) acc[a][b][m][n] = (f32x4){0.f, 0.f, 0.f, 0.f};
    bf16x8 At[4][2], B0[2][2], B1[2][2];
    const char* cA = (const char*)g.A + (size_t)cur.pm * tstep; const char* cB = (const char*)g.Bt + (size_t)cur.pn * tstep;
    S.a_ready(cur);
    if constexpr (SP2) {
        PG8_STAGE(PG8_SB(0, 0), cB, voffB); PG8_STAGE(PG8_SB(0, 1), cB + hstep, voffB); PG8_STAGE(PG8_SA(0, 0), cA, voffA); PG8_STAGE(PG8_SA(0, 1), cA + hstep, voffA);
        if (wr == 1) PG8_BAR;
        PG8_WAIT_V(2); PG8_BAR;
        PG8_STAGE(PG8_SB(1, 0), cB + kstep, voffB); PG8_STAGE(PG8_SA(1, 0), cA + kstep, voffA); PG8_STAGE(PG8_SB(1, 1), cB + hstep + kstep, voffB);
        PG8_WAIT_V(6); PG8_BAR;
    } else {
        PG8_STAGE(PG8_SB(0, 0), cB, voffB); PG8_STAGE(PG8_SA(0, 0), cA, voffA); PG8_STAGE(PG8_SB(0, 1), cB + hstep, voffB); PG8_STAGE(PG8_SA(0, 1), cA + hstep, voffA);
        if (wr == 1) PG8_BAR;
        PG8_WAIT_V(4); PG8_BAR;
        PG8_STAGE(PG8_SB(1, 0), cB + kstep, voffB); PG8_STAGE(PG8_SA(1, 0), cA + kstep, voffA); PG8_STAGE(PG8_SB(1, 1), cB + hstep + kstep, voffB);
        PG8_WAIT_V(6); PG8_BAR;
    }
    for (;;) {
        const bool has_next = S.next(ui + 1, nxt);
        const char* nA = has_next ? (const char*)g.A + (size_t)nxt.pm * tstep : cA; const char* nB = has_next ? (const char*)g.Bt + (size_t)nxt.pn * tstep : cB;
        for (int t = 0; t < nt; t += 2) {
            const bool last = (t == nt - 2);
            const char* a1 = cA + (size_t)(t + 1) * kstep;
            const char* a2 = last ? nA : cA + (size_t)(t + 2) * kstep; const char* b2 = last ? nB : cB + (size_t)(t + 2) * kstep;
            const char* a3 = a2 + kstep; const char* b3 = b2 + kstep;
            if (last && has_next) S.a_ready(nxt);
            if constexpr (SP2) {
            PG8_LDB(B0, 0, 0); PG8_LDB(B1, 0, 1); PG8_SCHED; PG8_LDA(At, 0, 0); PG8_STAGE(PG8_SA(1, 1), a1 + hstep, voffA);
            PG8_WAIT_V(8); PG8_WAIT_L(0); PG8_BAR; PG8_MMA(0, 0, At, B0); PG8_MMA(0, 1, At, B1); PG8_BAR; PG8_SCHED;
            PG8_LDA(At, 0, 1); PG8_STAGE(PG8_SB(0, 0), b2, voffB); PG8_STAGE(PG8_SB(0, 1), b2 + hstep, voffB); PG8_STAGE(PG8_SA(0, 0), a2, voffA);
            PG8_WAIT_V(8); PG8_WAIT_L(0); PG8_BAR; PG8_MMA(1, 0, At, B0); PG8_MMA(1, 1, At, B1); PG8_BAR; PG8_SCHED;
            PG8_LDB(B0, 1, 0); PG8_LDB(B1, 1, 1); PG8_SCHED; PG8_LDA(At, 1, 0); PG8_STAGE(PG8_SA(0, 1), a2 + hstep, voffA);
            PG8_WAIT_V(8); PG8_WAIT_L(0); PG8_BAR; PG8_MMA(0, 0, At, B0); PG8_MMA(0, 1, At, B1); PG8_BAR; PG8_SCHED;
            PG8_LDA(At, 1, 1); PG8_STAGE(PG8_SB(1, 0), b3, voffB); PG8_STAGE(PG8_SB(1, 1), b3 + hstep, voffB); PG8_STAGE(PG8_SA(1, 0), a3, voffA);
            PG8_WAIT_V(8); PG8_WAIT_L(0); PG8_BAR; PG8_MMA(1, 0, At, B0); PG8_MMA(1, 1, At, B1); PG8_BAR; PG8_SCHED;
            } else {
            PG8_LDB(B0, 0, 0); PG8_SCHED; PG8_LDA(At, 0, 0); PG8_STAGE(PG8_SA(1, 1), a1 + hstep, voffA);
            PG8_WAIT_L(8); PG8_BAR; PG8_WAIT_L(0); PG8_MMA(0, 0, At, B0); PG8_BAR; PG8_SCHED;
            PG8_LDB(B1, 0, 1); PG8_STAGE(PG8_SB(0, 0), b2, voffB);
            PG8_BAR; PG8_WAIT_L(0); PG8_MMA(0, 1, At, B1); PG8_BAR;
            PG8_LDA(At, 0, 1); PG8_STAGE(PG8_SA(0, 0), a2, voffA);
            PG8_BAR; PG8_WAIT_L(0); PG8_MMA(1, 0, At, B0); PG8_BAR; PG8_SCHED;
            PG8_STAGE(PG8_SB(0, 1), b2 + hstep, voffB);
            PG8_WAIT_V(6); PG8_BAR; PG8_MMA(1, 1, At, B1); PG8_BAR;
            PG8_LDB(B0, 1, 0); PG8_SCHED; PG8_LDA(At, 1, 0); PG8_STAGE(PG8_SA(0, 1), a2 + hstep, voffA);
            PG8_WAIT_L(8); PG8_BAR; PG8_WAIT_L(0); PG8_MMA(0, 0, At, B0); PG8_BAR; PG8_SCHED;
            PG8_LDB(B1, 1, 1); PG8_STAGE(PG8_SB(1, 0), b3, voffB);
            PG8_BAR; PG8_WAIT_L(0); PG8_MMA(0, 1, At, B1); PG8_BAR;
            PG8_LDA(At, 1, 1); PG8_STAGE(PG8_SA(1, 0), a3, voffA);
            PG8_BAR; PG8_WAIT_L(0); PG8_MMA(1, 0, At, B0); PG8_BAR; PG8_SCHED;
            PG8_STAGE(PG8_SB(1, 1), b3 + hstep, voffB);
            PG8_WAIT_V(6); PG8_BAR; PG8_MMA(1, 1, At, B1); PG8_BAR;
            }
        }
        if constexpr (ALIGN_EPI) { if (wr == 0) PG8_BAR; }
        if constexpr (!Epi::AFTER_DRAIN) { E(acc, cur, wr, wc, fr, fq); S.done(cur); }
        if (!has_next) break;
#pragma unroll
        for (int a = 0; a < 2; ++a)
#pragma unroll
            for (int b = 0; b < 2; ++b)
#pragma unroll
                for (int m = 0; m < 4; ++m)
#pragma unroll
                    for (int n = 0; n < 2; ++n) acc[a][b][m][n] = (f32x4){0.f, 0.f, 0.f, 0.f};
        cur = nxt; cA = nA; cB = nB; ++ui;
        if constexpr (ALIGN_EPI) { if (wr == 1) PG8_BAR; }
    }
    PG8_WAIT_V(0);
    if constexpr (!ALIGN_EPI) { if (wr == 0) PG8_BAR; }
    PG8_BAR;
    if constexpr (Epi::AFTER_DRAIN) { E.fused(acc, cur, wr, wc, fr, fq, lds, wid, lane); S.done(cur); }
#undef PG8_SA
#undef PG8_SB
#undef PG8_STAGE
#undef PG8_LDA
#undef PG8_LDB
#undef PG8_MMA
#undef PG8_WAIT_V
#undef PG8_WAIT_L
#undef PG8_BAR
#undef PG8_SCHED
}
}

#define GAS __attribute__((address_space(1)))
typedef unsigned short bf16;
typedef float f32x4 __attribute__((ext_vector_type(4)));
typedef unsigned v4u __attribute__((ext_vector_type(4)));
typedef unsigned v2u __attribute__((ext_vector_type(2)));
constexpr int D = 2048, NB = 4, SEQ = 4096, CTXL = 256, DFF = 5504, NMOD = 9;
constexpr int TL = NB * SEQ, TC = NB * CTXL, TT = TL + TC;
constexpr int MIXH = 1024;
constexpr int EV_COLS = 7216, EV_PAD = 7424, OD_COLS = 5120;
constexpr int NWAVES = 8, NTHR = 512;
constexpr float EPS = 1e-6f;

constexpr size_t MiB = 1u << 20;
constexpr size_t WS_CTL = 0, CTL_ZERO_BYTES = 64 * 1024;
constexpr size_t WS_MOD = 1 * MiB;
constexpr size_t WS_MODP = 2 * MiB;
constexpr int MOD_KC = 16;
constexpr size_t WS_WGU = 16 * MiB;
constexpr size_t SZ_WGU = (size_t)11008 * 2048 * 2;
constexpr size_t WS_WD = WS_WGU + 4 * SZ_WGU;
constexpr size_t SZ_WD = (size_t)2048 * 5504 * 2;
constexpr size_t WS_WIN_EV = WS_WD + 4 * SZ_WD;
constexpr size_t WS_WOUT_EV = WS_WIN_EV + (size_t)EV_PAD * 2048 * 2;
constexpr size_t WS_WIN_OD = WS_WOUT_EV + (size_t)2048 * 2048 * 2;
constexpr size_t WS_WOUT_OD = WS_WIN_OD + (size_t)OD_COLS * 2048 * 2;
constexpr size_t WS_WGLU = WS_WOUT_OD + (size_t)2048 * 2048 * 2;
constexpr size_t WS_XC = WS_WGLU + (size_t)1024 * 1024 * 2;
constexpr size_t WS_HB = WS_XC + (size_t)TC * D * 4;
constexpr size_t WS_R = WS_HB + (size_t)TT * D * 2;
constexpr size_t WS_HID = WS_R;
constexpr size_t WS_Y = WS_R + 183 * MiB;
constexpr size_t WS_S = WS_R;
constexpr size_t WS_GT = WS_R + 247 * MiB;
constexpr size_t WS_GB = WS_R + 264 * MiB;
constexpr size_t WS_O = WS_R + 298 * MiB;
constexpr size_t SZ_O = (size_t)TT * 1024 * 4;
constexpr size_t WS_QK2 = WS_O + 4 * SZ_O;
constexpr size_t WS_GP = WS_QK2 + (size_t)TT * 2048 * 2;
constexpr size_t WS_END = WS_GP + (size_t)TT * 8 * 4 * 4;
static_assert(WS_HID + (size_t)TT * DFF * 2 <= WS_Y && WS_S + (size_t)TT * EV_PAD * 2 <= WS_GT && WS_GT + (size_t)TT * 256 * 4 <= WS_GB && WS_GB + (size_t)TT * 1024 * 2 <= WS_O, "ws map");
static_assert(WS_Y + (size_t)TT * D * 4 <= WS_END, "ws map");

constexpr int LDS_BYTES = 156 * 1024;
constexpr int MISC_OFF = LDS_BYTES - 64;

struct Args { const float* in[34]; float* out; unsigned char* ws; };
#define ARG(k) (a.in[opaque_idx(k)])
__device__ __forceinline__ int opaque_idx(int k) { asm volatile("" : "+s"(k)); return k; }

__device__ __forceinline__ unsigned f2bf(float f) { unsigned u = __float_as_uint(f); u += 0x7FFFu + ((u >> 16) & 1u); return u >> 16; }
typedef __bf16 bf16x2_t __attribute__((ext_vector_type(2)));
typedef float f32x2_t __attribute__((ext_vector_type(2)));
__device__ __forceinline__ unsigned pk2(float lo, float hi) { const f32x2_t v = {lo, hi}; const bf16x2_t b = __builtin_convertvector(v, bf16x2_t); return __builtin_bit_cast(unsigned, b); }
__device__ __forceinline__ float bf2f(unsigned short b) { return __uint_as_float(((unsigned)b) << 16); }
__device__ __forceinline__ float wave_sum(float v) {
#pragma unroll
    for (int o = 1; o < 64; o <<= 1) v += __shfl_xor(v, o);
    return v;
}
__device__ __forceinline__ float fast_silu(float g) { return g * __builtin_amdgcn_rcpf(1.0f + __expf(-g)); }
__device__ __forceinline__ float fast_sigmoid(float g) { return __builtin_amdgcn_rcpf(1.0f + __expf(-g)); }

struct TJob { const float* src; bf16* dst; int K, N, map, tstart; };
constexpr int NJOBS = 17;
__device__ __forceinline__ int tj_tiles(int K, int N) { return (K / 64) * ((N + 31) / 32); }
__device__ __forceinline__ void transpose_tile(const TJob& j, int tl, int lane) {
    const int nblk = (j.N + 31) / 32, kb = tl / nblk, nb = tl % nblk, k0 = 64 * kb, n0 = 32 * nb;
    const int kb8 = lane >> 3, nb4 = lane & 7, n = n0 + 4 * nb4;
    int drow0;
    if (j.map == 0) drow0 = n0;
    else if (j.map == 1) drow0 = (n0 / 128) * 256 + (n0 % 128);
    else if (j.map == 2) drow0 = (n0 / 128) * 256 + (n0 % 128) + 128;
    else drow0 = (nb < 96) ? n0 : (nb == 96 ? 7168 : (nb < 225 ? n0 - 32 : 7200));
    if (n < j.N) {
        const float* s = j.src + (size_t)(k0 + 8 * kb8) * j.N + n;
        f32x4 v[8];
#pragma unroll
        for (int i = 0; i < 8; ++i) v[i] = *(const f32x4*)(s + (size_t)i * j.N);
        bf16* d = j.dst + (size_t)(drow0 + 4 * nb4) * j.K + k0 + 8 * kb8;
#pragma unroll
        for (int e = 0; e < 4; ++e) { v4u o; o.x = pk2(v[0][e], v[1][e]); o.y = pk2(v[2][e], v[3][e]); o.z = pk2(v[4][e], v[5][e]); o.w = pk2(v[6][e], v[7][e]);
            *(v4u*)(d + (size_t)e * j.K) = o; }
    }
}

struct NormP {
    const float* xin_lat; const float* xin_ctx; float* xout_lat; float* xout_ctx; const float* y; bf16* h;
    int rows_end; int has_y, has_h; float w;
    int lp, sp;
    int ln, sn;
};
__device__ __forceinline__ void norm_phase(const NormP& p, const float* mod, const float* norm_pre, const float* norm_post, LAS unsigned char* lds, int gw, int ngw, int tid, int lane) {
    { int t2 = threadIdx.x; asm volatile("" : "+v"(t2)); tid = t2; lane = t2 & 63; gw = blockIdx.x * NWAVES + __builtin_amdgcn_readfirstlane(t2 >> 6); }
    LAS float* TA = (LAS float*)lds; LAS float* TB = TA + 5 * D; LAS float* TCc = TB + 5 * D;
    for (int i = tid; i < 5 * D; i += NTHR) { const int var = i >> 11, j = i & (D - 1);
        if (p.has_y) TA[i] = p.w * mod[((size_t)p.lp * 5 + var) * (NMOD * D) + (3 * p.sp + 2) * D + j] * norm_post[(p.lp * 3 + p.sp) * D + j];
        if (p.has_h) { TB[i] = norm_pre[(p.ln * 3 + p.sn) * D + j] * (1.0f + mod[((size_t)p.ln * 5 + var) * (NMOD * D) + (3 * p.sn + 1) * D + j]);
                       TCc[i] = mod[((size_t)p.ln * 5 + var) * (NMOD * D) + (3 * p.sn) * D + j]; } }
    __syncthreads();
    for (int r = gw; r < p.rows_end; r += ngw) {
        const int var = r < TL ? (r >> 12) : 4;
        const float* xi = r < TL ? p.xin_lat + (size_t)r * D : p.xin_ctx + (size_t)(r - TL) * D;
        float* xo = r < TL ? p.xout_lat + (size_t)r * D : p.xout_ctx + (size_t)(r - TL) * D;
        f32x4 xv[8];
#pragma unroll
        for (int j = 0; j < 8; ++j) xv[j] = *(const f32x4*)(xi + 4 * lane + 256 * j);
        if (p.has_y) {
            const float* yr = p.y + (size_t)r * D; f32x4 yv[8]; float s = 0.f;
#pragma unroll
            for (int j = 0; j < 8; ++j) { yv[j] = *(const f32x4*)(yr + 4 * lane + 256 * j); s += (yv[j].x * yv[j].x + yv[j].y * yv[j].y) + (yv[j].z * yv[j].z + yv[j].w * yv[j].w); }
            const float rstd = 1.0f / sqrtf(wave_sum(s) * (1.0f / D) + EPS);
#pragma unroll
            for (int j = 0; j < 8; ++j) { const f32x4 a = *(const LAS f32x4*)(TA + var * D + 4 * lane + 256 * j); xv[j] = xv[j] + a * (yv[j] * rstd); *(f32x4*)(xo + 4 * lane + 256 * j) = xv[j]; }
        }
        if (p.has_h) {
            float s = 0.f;
#pragma unroll
            for (int j = 0; j < 8; ++j) s += (xv[j].x * xv[j].x + xv[j].y * xv[j].y) + (xv[j].z * xv[j].z + xv[j].w * xv[j].w);
            const float rstd = 1.0f / sqrtf(wave_sum(s) * (1.0f / D) + EPS);
            bf16* hr = p.h + (size_t)r * D;
#pragma unroll
            for (int j = 0; j < 8; ++j) { const f32x4 b = *(const LAS f32x4*)(TB + var * D + 4 * lane + 256 * j), c = *(const LAS f32x4*)(TCc + var * D + 4 * lane + 256 * j);
                const f32x4 o = xv[j] * rstd * b + c; v2u w; w.x = pk2(o.x, o.y); w.y = pk2(o.z, o.w); *(v2u*)(hr + 4 * lane + 256 * j) = w; }
        }
    }
    __syncthreads();
}

struct EpiSwiGLU {
    static constexpr bool PERM = true, AFTER_DRAIN = false;
    bf16* O; int ldc;
    __device__ __forceinline__ void operator()(const pg8::f32x4 (&acc)[2][2][4][2], const pg8::Unit& u, int wr, int wc, int fr, int fq) const {
        const int row0 = u.pm * 256 + wr * 64 + fr, col0 = u.pn * 128 + wc * 32 + 8 * fq;
#pragma unroll
        for (int ai = 0; ai < 2; ++ai)
#pragma unroll
            for (int m = 0; m < 4; ++m) { bf16* rowp = O + (size_t)(row0 + ai * 128 + m * 16) * ldc + col0;
                const pg8::f32x4 g0 = acc[ai][0][m][0], g1 = acc[ai][0][m][1], u0 = acc[ai][1][m][0], u1 = acc[ai][1][m][1];
                v4u w; w.x = pk2(fast_silu(g0[0]) * u0[0], fast_silu(g0[1]) * u0[1]); w.y = pk2(fast_silu(g0[2]) * u0[2], fast_silu(g0[3]) * u0[3]);
                w.z = pk2(fast_silu(g1[0]) * u1[0], fast_silu(g1[1]) * u1[1]); w.w = pk2(fast_silu(g1[2]) * u1[2], fast_silu(g1[3]) * u1[3]);
                *(v4u*)rowp = w; }
    }
};
struct EpiF32 {
    static constexpr bool PERM = false, AFTER_DRAIN = false;
    float* C; int ldc;
    __device__ __forceinline__ void operator()(const pg8::f32x4 (&acc)[2][2][4][2], const pg8::Unit& u, int wr, int wc, int fr, int fq) const {
        const int row0 = u.pm * 256 + wr * 64 + fr, col0 = u.pn * 256 + wc * 32 + 4 * fq;
#pragma unroll
        for (int ai = 0; ai < 2; ++ai)
#pragma unroll
            for (int m = 0; m < 4; ++m) { float* rowp = C + (size_t)(row0 + ai * 128 + m * 16) * ldc + col0;
#pragma unroll
                for (int bj = 0; bj < 2; ++bj)
#pragma unroll
                    for (int n = 0; n < 2; ++n) *(pg8::f32x4*)(rowp + bj * 128 + n * 16) = acc[ai][bj][m][n]; }
    }
};
struct EpiS {
    static constexpr bool PERM = true, AFTER_DRAIN = false;
    bf16* S; int ldc; float* GT; int gt_pn;
    __device__ __forceinline__ void operator()(const pg8::f32x4 (&acc)[2][2][4][2], const pg8::Unit& u, int wr, int wc, int fr, int fq) const {
        const int row0 = u.pm * 256 + wr * 64 + fr;
        if (u.pn == gt_pn) {
            if (wc < 2) {
#pragma unroll
                for (int ai = 0; ai < 2; ++ai)
#pragma unroll
                    for (int m = 0; m < 4; ++m) { float* rowp = GT + (size_t)(row0 + ai * 128 + m * 16) * 256 + wc * 32 + 8 * fq;
                        *(pg8::f32x4*)rowp = acc[ai][0][m][0]; *(pg8::f32x4*)(rowp + 4) = acc[ai][0][m][1]; }
            }
        } else {
            const int col0 = u.pn * 256 + wc * 32 + 8 * fq;
#pragma unroll
            for (int ai = 0; ai < 2; ++ai)
#pragma unroll
                for (int m = 0; m < 4; ++m) { bf16* rowp = S + (size_t)(row0 + ai * 128 + m * 16) * ldc + col0;
#pragma unroll
                    for (int bj = 0; bj < 2; ++bj) { const pg8::f32x4 v0 = acc[ai][bj][m][0], v1 = acc[ai][bj][m][1];
                        v4u w; w.x = pk2(v0[0], v0[1]); w.y = pk2(v0[2], v0[3]); w.z = pk2(v1[0], v1[1]); w.w = pk2(v1[2], v1[3]);
                        *(v4u*)(rowp + bj * 128) = w; } }
        }
    }
};

#define DEV __device__ __forceinline__
#define LP(T) LAS T*
#define SYNC() __syncthreads()
typedef short v8s __attribute__((ext_vector_type(8)));
typedef float v4f __attribute__((ext_vector_type(4)));
#define MFMA16(x, y, c) __builtin_amdgcn_mfma_f32_16x16x32_bf16((x), (y), (c), 0, 0, 0)
#define SHX(v, m) __shfl_xor((v), (m))
#define SHUP(v, d) __shfl_up((v), (d))
#define SHIDX(v, l) __shfl((v), (l))
#define EXPF(x) __expf(x)
#define LOGF(x) __logf(x)
#define RCPF(x) __builtin_amdgcn_rcpf(x)
#define RSQRTF(x) (1.0f / sqrtf(x))
#define PK2(lo, hi) pk2((lo), (hi))
#define F2BF(x) ((unsigned short)f2bf(x))
#define WAVE_SYNC() asm volatile("s_waitcnt lgkmcnt(0)" ::: "memory")
typedef short v4s __attribute__((ext_vector_type(4)));
#define LDS_TR16(p) __builtin_amdgcn_ds_read_tr16_b64_v4i16((LAS v4s*)(p))

DEV int seq_row(int b, int seg, int np, int cm) {
    if (!seg) return TL + b * CTXL + np;
    const int n = cm ? ((np & 63) * 64 + (np >> 6)) : np;
    return b * SEQ + n;
}
DEV int tok_row(int b, int seg, int pos, int dir, int cm) {
    const int len = seg ? SEQ : CTXL;
    return seq_row(b, seg, dir ? len - 1 - pos : pos, cm);
}
DEV float bflo(unsigned u) { return __uint_as_float(u << 16); }
DEV float bfhi(unsigned u) { return __uint_as_float(u & 0xffff0000u); }
DEV float logsigmoidf(float z) { return fminf(z, 0.f) - LOGF(1.0f + EXPF(-fabsf(z))); }
DEV v4f tile_mma(v4f acc, LP(const unsigned char) A, int sa, int m0, LP(const unsigned char) B, int sb, int n0, int ksteps, int fr, int fq) {
    LP(const unsigned char) ap = A + (m0 + fr) * sa + fq * 16;
    LP(const unsigned char) bp = B + (n0 + fr) * sb + fq * 16;
    for (int k = 0; k < ksteps; ++k) {
        const v8s af = *(LP(const v8s))(ap + k * 64);
        const v8s bf = *(LP(const v8s))(bp + k * 64);
        acc = MFMA16(bf, af, acc);
    }
    return acc;
}
DEV v8s tr_frag(LP(const unsigned char) T, int st, int k0, int n0, int lane) {
    const int l16 = lane & 15, fq = lane >> 4;
    LP(const unsigned char) p = T + (k0 + 8 * fq + (l16 >> 2)) * st + (n0 + 4 * (l16 & 3)) * 2;
    const v4s a = LDS_TR16(p), b = LDS_TR16(p + 4 * st);
    return (v8s){a.x, a.y, a.z, a.w, b.x, b.y, b.z, b.w};
}
DEV v4f tile_mma_nt(v4f acc, LP(const unsigned char) A, int sa, int m0, LP(const unsigned char) Bt, int sb, int n0, int ksteps, int lane) {
    const int fr = lane & 15, fq = lane >> 4;
    for (int k = 0; k < ksteps; ++k) { const v8s af = *(LP(const v8s))(A + (m0 + fr) * sa + fq * 16 + k * 64); const v8s bf = tr_frag(Bt, sb, 32 * k, n0, lane); acc = MFMA16(bf, af, acc); }
    return acc;
}
DEV v4f tile_mma_tt(v4f acc, LP(const unsigned char) At, int sa, int m0, LP(const unsigned char) Bt, int sb, int n0, int ksteps, int lane) {
    for (int k = 0; k < ksteps; ++k) { const v8s af = tr_frag(At, sa, 32 * k, m0, lane); const v8s bf = tr_frag(Bt, sb, 32 * k, n0, lane); acc = MFMA16(bf, af, acc); }
    return acc;
}
constexpr int ST128 = 272, ST64 = 144, ST256 = 528, STV = 80;

constexpr int MIX_UNITS = NB * 32;
DEV void gla_unit(const bf16* S, const float* GT, float* O, const float* wg_all, const float* bg_all, int unit, LP(unsigned char) lds, int tid) {
    const int lane = tid & 63, wave = tid >> 6, fr = lane & 15, fq = lane >> 4;
    const int vs = unit & 3, dir = (unit >> 2) & 1, h = (unit >> 3) & 3, b = unit >> 5;
    LP(unsigned char) QS = lds; LP(unsigned char) KS = lds + 17408; LP(unsigned char) QB = lds + 34816; LP(unsigned char) KB = lds + 52224;
    LP(unsigned char) VV = lds + 69632; LP(unsigned char) PM = lds + 78848; LP(unsigned char) STT = lds + 88064;
    LP(float) LA = (LP(float))(lds + 105472); LP(float) SEG = (LP(float))(lds + 138240); LP(float) DEC = (LP(float))(lds + 140288);
    LP(float) LR = (LP(float))(lds + 140800); LP(float) WG = (LP(float))(lds + 144896); LP(float) BG = (LP(float))(lds + 153088);
    for (int i = tid; i < 16 * 128; i += NTHR) { const int m = i >> 7, d = i & 127; WG[i] = wg_all[(dir * 16 + m) * 512 + h * 128 + d]; }
    if (tid < 128) BG[tid] = bg_all[dir * 512 + h * 128 + tid];
    for (int i = tid; i < 64 * ST128 / 4; i += NTHR) ((LP(unsigned))STT)[i] = 0u;
    v4f sacc[4];
#pragma unroll
    for (int i = 0; i < 4; ++i) sacc[i] = (v4f){0.f, 0.f, 0.f, 0.f};
    const int j = tid >> 3, c8 = tid & 7, dc = c8 * 16;
    const int tt = wave >> 1, vt0 = (wave & 1) * 2;
    const int svt = wave & 3, sdt0 = (wave >> 2) * 4;
    const float qscale = 0.08838834764831845f;
    float* Od = O + (size_t)dir * TT * 1024;
    constexpr int NCHUNK = CTXL / 64 + SEQ / 64;
    v4u q0, q1, k0, k1, vv; v4f lrv = (v4f){0.f, 0.f, 0.f, 0.f};
#define GLA_ISSUE(cx) do { const int seg_ = (cx) >= CTXL / 64, ci_ = seg_ ? (cx) - CTXL / 64 : (cx); \
        const bf16* sr_ = S + (size_t)tok_row(b, seg_, ci_ * 64 + j, dir, 0) * EV_PAD; \
        q0 = *(const v4u*)(sr_ + h * 128 + dc); q1 = *(const v4u*)(sr_ + h * 128 + dc + 8); \
        k0 = *(const v4u*)(sr_ + 512 + h * 128 + dc); k1 = *(const v4u*)(sr_ + 512 + h * 128 + dc + 8); \
        vv = *(const v4u*)(sr_ + 1024 + h * 256 + vs * 64 + c8 * 8); \
        if (tid < 256) { const int rr_ = tok_row(b, seg_, ci_ * 64 + (tid >> 2), dir, 0); lrv = *(const v4f*)(GT + (size_t)rr_ * 256 + dir * 16 + (tid & 3) * 4); } } while (0)
    GLA_ISSUE(0);
    for (int cidx = 0; cidx < NCHUNK; ++cidx) {
        const int seg = cidx >= CTXL / 64, ci = seg ? cidx - CTXL / 64 : cidx;
        if (tid < 256) *(LP(v4f))(LR + (tid >> 2) * 16 + (tid & 3) * 4) = lrv;
        SYNC();
        {
            float z[16];
#pragma unroll
            for (int i = 0; i < 16; ++i) z[i] = BG[dc + i];
            for (int m = 0; m < 16; ++m) { const float lrm = LR[j * 16 + m];
#pragma unroll
                for (int i4 = 0; i4 < 4; ++i4) { const v4f w = *(LP(const v4f))(WG + m * 128 + dc + 4 * i4);
                    z[4 * i4 + 0] += lrm * w.x; z[4 * i4 + 1] += lrm * w.y; z[4 * i4 + 2] += lrm * w.z; z[4 * i4 + 3] += lrm * w.w; } }
#pragma unroll
            for (int i4 = 0; i4 < 4; ++i4) { v4f o; o.x = logsigmoidf(z[4 * i4]) * 0.0625f; o.y = logsigmoidf(z[4 * i4 + 1]) * 0.0625f; o.z = logsigmoidf(z[4 * i4 + 2]) * 0.0625f; o.w = logsigmoidf(z[4 * i4 + 3]) * 0.0625f;
                *(LP(v4f))(LA + j * 128 + dc + 4 * i4) = o; }
        }
        SYNC();
        {
            const int d = tid & 127, sg = tid >> 7; float acc = 0.f;
            for (int jj = 0; jj < 16; ++jj) { acc += LA[(sg * 16 + jj) * 128 + d]; LA[(sg * 16 + jj) * 128 + d] = acc; }
            SEG[sg * 128 + d] = acc;
        }
        SYNC();
        {
            const int sgj = j >> 4;
#pragma unroll 1
            for (int g = 0; g < 2; ++g) {
                const v4u qv = g ? q1 : q0, kv = g ? k1 : k0;
                const unsigned qw[4] = {qv.x, qv.y, qv.z, qv.w}, kw[4] = {kv.x, kv.y, kv.z, kv.w};
                unsigned oqs[4], oks[4], oqb[4], okb[4];
#pragma unroll
                for (int i2 = 0; i2 < 4; ++i2) {
                    float vqs[2], vks[2], vqb[2], vkb[2];
#pragma unroll
                    for (int e = 0; e < 2; ++e) {
                        const int d = dc + 8 * g + 2 * i2 + e;
                        const float s0 = SEG[d], s1 = SEG[128 + d], s2 = SEG[256 + d];
                        const float pre = (sgj > 0 ? s0 : 0.f) + (sgj > 1 ? s1 : 0.f) + (sgj > 2 ? s2 : 0.f);
                        const float bv = LA[j * 128 + d] + pre;
                        const float bmid = LA[32 * 128 + d] + s0 + s1;
                        const float bend = LA[63 * 128 + d] + s0 + s1 + s2;
                        const float q = (e ? bfhi(qw[i2]) : bflo(qw[i2])) * qscale, k = e ? bfhi(kw[i2]) : bflo(kw[i2]);
                        vqs[e] = q * EXPF(bv - bmid); vks[e] = k * EXPF(bmid - bv); vqb[e] = q * EXPF(bv);
                        vkb[e] = k * EXPF(bend - bv);
                        if (j == 63) DEC[d] = EXPF(bend);
                    }
                    oqs[i2] = PK2(vqs[0], vqs[1]); oks[i2] = PK2(vks[0], vks[1]); oqb[i2] = PK2(vqb[0], vqb[1]); okb[i2] = PK2(vkb[0], vkb[1]);
                }
                *(LP(v4u))(QS + j * ST128 + (dc + 8 * g) * 2) = (v4u){oqs[0], oqs[1], oqs[2], oqs[3]};
                *(LP(v4u))(KS + j * ST128 + (dc + 8 * g) * 2) = (v4u){oks[0], oks[1], oks[2], oks[3]};
                *(LP(v4u))(QB + j * ST128 + (dc + 8 * g) * 2) = (v4u){oqb[0], oqb[1], oqb[2], oqb[3]};
                *(LP(v4u))(KB + j * ST128 + (dc + 8 * g) * 2) = (v4u){okb[0], okb[1], okb[2], okb[3]};
            }
            *(LP(v4u))(VV + j * ST64 + c8 * 16) = vv;
        }
        if (cidx + 1 < NCHUNK) GLA_ISSUE(cidx + 1);
        SYNC();
        v4f oacc[2]; oacc[0] = (v4f){0.f, 0.f, 0.f, 0.f}; oacc[1] = oacc[0];
        {
#pragma unroll
            for (int i = 0; i < 2; ++i) { const int st = vt0 + i; v4f p = (v4f){0.f, 0.f, 0.f, 0.f};
                if (st <= tt) { p = tile_mma(p, QS, ST128, 16 * tt, KS, ST128, 16 * st, 4, fr, fq);
                    if (st == tt) { if (4 * fq + 0 > fr) p.x = 0.f; if (4 * fq + 1 > fr) p.y = 0.f; if (4 * fq + 2 > fr) p.z = 0.f; if (4 * fq + 3 > fr) p.w = 0.f; } }
                *(LP(v2u))(PM + (16 * tt + fr) * ST64 + (16 * st + 4 * fq) * 2) = (v2u){PK2(p.x, p.y), PK2(p.z, p.w)}; }
#pragma unroll
            for (int k = 0; k < 4; ++k) { const v8s af = *(LP(const v8s))(QB + (16 * tt + fr) * ST128 + fq * 16 + k * 64);
#pragma unroll
                for (int i = 0; i < 2; ++i) { const v8s bf = *(LP(const v8s))(STT + (16 * (vt0 + i) + fr) * ST128 + fq * 16 + k * 64); oacc[i] = MFMA16(bf, af, oacc[i]); } }
        }
        SYNC();
#pragma unroll
        for (int k = 0; k < 2; ++k) { const v8s af = *(LP(const v8s))(PM + (16 * tt + fr) * ST64 + fq * 16 + k * 64);
#pragma unroll
            for (int i = 0; i < 2; ++i) { const v8s bf = tr_frag(VV, ST64, 32 * k, 16 * (vt0 + i), lane); oacc[i] = MFMA16(bf, af, oacc[i]); } }
        { const int orow = tok_row(b, seg, ci * 64 + 16 * tt + fr, dir, 0);
#pragma unroll
          for (int i = 0; i < 2; ++i) *(v4f*)(Od + (size_t)orow * 1024 + h * 256 + vs * 64 + 16 * (vt0 + i) + 4 * fq) = oacc[i]; }
        {
#pragma unroll
            for (int i = 0; i < 4; ++i) { const v4f dcy = *(LP(const v4f))(DEC + 16 * (sdt0 + i) + 4 * fq); sacc[i] = sacc[i] * dcy; }
#pragma unroll
            for (int k = 0; k < 2; ++k) { const v8s af = tr_frag(VV, ST64, 32 * k, 16 * svt, lane);
#pragma unroll
                for (int i = 0; i < 4; ++i) { const v8s bf = tr_frag(KB, ST128, 32 * k, 16 * (sdt0 + i), lane); sacc[i] = MFMA16(bf, af, sacc[i]); } }
#pragma unroll
            for (int i = 0; i < 4; ++i) *(LP(v2u))(STT + (16 * svt + fr) * ST128 + (16 * (sdt0 + i) + 4 * fq) * 2) = (v2u){PK2(sacc[i].x, sacc[i].y), PK2(sacc[i].z, sacc[i].w)};
        }
    }
#undef GLA_ISSUE
    SYNC();
}

constexpr int GATE_TASKS = NB * 4 * 2 * (CTXL / 64 + SEQ / 64);
DEV void gate_prep_task(int task, const float* GT, float* GP, const float* gate_b, int lane) {
    constexpr int NCHUNK = CTXL / 64 + SEQ / 64;
    const int cidx = task % NCHUNK, r1 = task / NCHUNK, dir = r1 & 1, h = (r1 >> 1) & 3, b = r1 >> 3;
    const int seg = cidx >= CTXL / 64, ci = seg ? cidx - CTXL / 64 : cidx;
    const int prow = tok_row(b, seg, ci * 64 + lane, dir, 1);
    const float ig = GT[(size_t)prow * 256 + 32 + (dir * 2 + 0) * 4 + h] + gate_b[(dir * 2 + 0) * 4 + h];
    const float lf = logsigmoidf(GT[(size_t)prow * 256 + 32 + (dir * 2 + 1) * 4 + h] + gate_b[(dir * 2 + 1) * 4 + h]);
    float bcum = lf;
#pragma unroll
    for (int o = 1; o < 64; o <<= 1) { const float t = SHUP(bcum, o); if (lane >= o) bcum += t; }
    const float a_s = ig - bcum;
    float cm = a_s;
#pragma unroll
    for (int o = 1; o < 64; o <<= 1) { const float t = SHUP(cm, o); if (lane >= o) cm = fmaxf(cm, t); }
    *(v4f*)(GP + ((size_t)prow * 8 + dir * 4 + h) * 4) = (v4f){bcum, a_s, cm, 0.f};
}

template <int MODE>
DEV void mat_unit(const bf16* Sqk, int ldqk, int qoff, int koff, const bf16* Sv, int ldv, int voff, float kscale, const float* GP, float* O, int store_ctx,
                  const float* ret_log_decay, int unit, LP(unsigned char) lds, int tid) {
    const int lane = tid & 63, wave = tid >> 6, fr = lane & 15, fq = lane >> 4;
    const int vs = unit & 3, dir = (unit >> 2) & 1, h = (unit >> 3) & 3, b = unit >> 5;
    LP(unsigned char) Q = lds; LP(unsigned char) K = lds + 33792;
    LP(unsigned char) VV = lds + 67584; LP(unsigned char) VW = lds + 76800;
    LP(unsigned char) PM = lds + 86016; LP(unsigned char) STT = lds + 95232;
    LP(float) AS = (LP(float))(lds + 129024); LP(float) RT = AS + 64; LP(float) WI = AS + 128; LP(float) WK = AS + 192; LP(float) EMT = AS + 256;
    LP(float) QN = AS + 320; LP(float) DENP = AS + 384;
    LP(float) SC = AS + 640;
    LP(float) NV = AS + 704;
    for (int i = tid; i < 64 * ST256 / 4; i += NTHR) ((LP(unsigned))STT)[i] = 0u;
    if (tid < 256) NV[tid] = 0.f;
    v4f sacc[8];
#pragma unroll
    for (int i = 0; i < 8; ++i) sacc[i] = (v4f){0.f, 0.f, 0.f, 0.f};
    const int j = tid >> 3, c8 = tid & 7, dc = c8 * 32;
    const int tt = wave >> 1, vt0 = (wave & 1) * 2;
    const int svt = wave & 3, sdt0 = (wave >> 2) * 8;
    float m_st = 0.f;
    float lg = 0.f;
    if (MODE == 1) lg = -expf(ret_log_decay[dir * 4 + h]);
    float* Od = O + (size_t)(2 + dir) * TT * 1024;
    SYNC();
    constexpr int NCHUNK = CTXL / 64 + SEQ / 64;
    v4u rq[4], rk[4], rv; v4f gpv = (v4f){0.f, 0.f, 0.f, 0.f};
#define MAT_ISSUE(cx) do { const int seg_ = (cx) >= CTXL / 64, ci_ = seg_ ? (cx) - CTXL / 64 : (cx); \
        const int row_ = tok_row(b, seg_, ci_ * 64 + j, dir, 1); \
        const bf16* s1_ = Sqk + (size_t)row_ * ldqk; \
        _Pragma("unroll") for (int g_ = 0; g_ < 4; ++g_) { rq[g_] = *(const v4u*)(s1_ + qoff + h * 256 + dc + 8 * g_); rk[g_] = *(const v4u*)(s1_ + koff + h * 256 + dc + 8 * g_); } \
        rv = *(const v4u*)(Sv + (size_t)row_ * ldv + voff + h * 256 + vs * 64 + c8 * 8); \
        if (MODE == 0 && wave == 0) { const int prow_ = tok_row(b, seg_, ci_ * 64 + lane, dir, 1); gpv = *(const v4f*)(GP + ((size_t)prow_ * 8 + dir * 4 + h) * 4); } } while (0)
    MAT_ISSUE(0);
    for (int cidx = 0; cidx < NCHUNK; ++cidx) {
        const int seg = cidx >= CTXL / 64, ci = seg ? cidx - CTXL / 64 : cidx;
        if (wave == 0) {
            float a_s, r_t, wi, emt;
            if (MODE == 0) {
                const float bcum = gpv.x; a_s = gpv.y;
                const float Mt = fmaxf(m_st, gpv.z);
                r_t = -Mt; wi = EXPF(m_st - Mt); emt = EXPF(-(bcum + Mt));
                const float M63 = SHIDX(Mt, 63), bend = SHIDX(bcum, 63);
                WK[lane] = EXPF(a_s - M63);
                if (lane == 0) SC[0] = EXPF(m_st - M63);
                m_st = bend + M63;
            } else {
                a_s = -(float)(lane + 1) * lg; r_t = (float)(lane + 1) * lg; wi = EXPF(r_t); emt = 0.f;
                WK[lane] = EXPF((float)(63 - lane) * lg);
                if (lane == 0) SC[0] = EXPF(64.f * lg);
            }
            AS[lane] = a_s; RT[lane] = r_t; WI[lane] = wi; EMT[lane] = emt;
        }
        SYNC();
        {
            const float wk = WK[j] * kscale;
            float qn = 0.f;
#pragma unroll
            for (int g8 = 0; g8 < 4; ++g8) {
                const int d0 = dc + 8 * g8;
                *(LP(v4u))(Q + j * ST256 + d0 * 2) = rq[g8];
                *(LP(v4u))(K + j * ST256 + d0 * 2) = rk[g8];
                if (MODE == 0) { const unsigned wq[4] = {rq[g8].x, rq[g8].y, rq[g8].z, rq[g8].w};
#pragma unroll
                    for (int i2 = 0; i2 < 4; ++i2) qn += bflo(wq[i2]) * NV[d0 + 2 * i2] + bfhi(wq[i2]) * NV[d0 + 2 * i2 + 1]; }
            }
            if (MODE == 0) { qn += SHX(qn, 1); qn += SHX(qn, 2); qn += SHX(qn, 4); if (c8 == 0) QN[j] = qn; }
            *(LP(v4u))(VV + j * ST64 + c8 * 16) = rv;
            *(LP(v4u))(VW + j * ST64 + c8 * 16) = (v4u){PK2(bflo(rv.x) * wk, bfhi(rv.x) * wk), PK2(bflo(rv.y) * wk, bfhi(rv.y) * wk), PK2(bflo(rv.z) * wk, bfhi(rv.z) * wk), PK2(bflo(rv.w) * wk, bfhi(rv.w) * wk)};
        }
        if (cidx + 1 < NCHUNK) MAT_ISSUE(cidx + 1);
        SYNC();
        v4f oacc[2]; oacc[0] = (v4f){0.f, 0.f, 0.f, 0.f}; oacc[1] = oacc[0];
        {
            const float rt = RT[16 * tt + fr];
#pragma unroll
            for (int i = 0; i < 2; ++i) { const int st = vt0 + i; v4f p = (v4f){0.f, 0.f, 0.f, 0.f};
                if (st <= tt) { p = tile_mma(p, Q, ST256, 16 * tt, K, ST256, 16 * st, 8, fr, fq);
                    const v4f as4 = *(LP(const v4f))(AS + 16 * st + 4 * fq);
                    p.x *= kscale * EXPF(as4.x + rt); p.y *= kscale * EXPF(as4.y + rt); p.z *= kscale * EXPF(as4.z + rt); p.w *= kscale * EXPF(as4.w + rt);
                    if (st == tt) { if (4 * fq + 0 > fr) p.x = 0.f; if (4 * fq + 1 > fr) p.y = 0.f; if (4 * fq + 2 > fr) p.z = 0.f; if (4 * fq + 3 > fr) p.w = 0.f; } }
                *(LP(v2u))(PM + (16 * tt + fr) * ST64 + (16 * st + 4 * fq) * 2) = (v2u){PK2(p.x, p.y), PK2(p.z, p.w)};
                if (MODE == 0) { float rs = (p.x + p.y) + (p.z + p.w); rs += SHX(rs, 16); rs += SHX(rs, 32); if (fq == 0) DENP[st * 64 + 16 * tt + fr] = rs; } }
#pragma unroll
            for (int k = 0; k < 8; ++k) { const v8s af = *(LP(const v8s))(Q + (16 * tt + fr) * ST256 + fq * 16 + k * 64);
#pragma unroll
                for (int i = 0; i < 2; ++i) { const v8s bf = *(LP(const v8s))(STT + (16 * (vt0 + i) + fr) * ST256 + fq * 16 + k * 64); oacc[i] = MFMA16(bf, af, oacc[i]); } }
            const float wi = WI[16 * tt + fr];
            oacc[0] = oacc[0] * wi; oacc[1] = oacc[1] * wi;
        }
        SYNC();
#pragma unroll
        for (int k = 0; k < 2; ++k) { const v8s af = *(LP(const v8s))(PM + (16 * tt + fr) * ST64 + fq * 16 + k * 64);
#pragma unroll
            for (int i = 0; i < 2; ++i) { const v8s bf = tr_frag(VV, ST64, 32 * k, 16 * (vt0 + i), lane); oacc[i] = MFMA16(bf, af, oacc[i]); } }
        if (MODE == 0) { const int t = 16 * tt + fr; const float den = (DENP[t] + DENP[64 + t]) + (DENP[128 + t] + DENP[192 + t]) + WI[t] * QN[t];
            const float dv = 1.0f / fmaxf(fabsf(den), EMT[t]); oacc[0] = oacc[0] * dv; oacc[1] = oacc[1] * dv; }
        if (seg || store_ctx) { const int orow = tok_row(b, seg, ci * 64 + 16 * tt + fr, dir, 1);
#pragma unroll
            for (int i = 0; i < 2; ++i) *(v4f*)(Od + (size_t)orow * 1024 + h * 256 + vs * 64 + 16 * (vt0 + i) + 4 * fq) = oacc[i]; }
        const float dcy = SC[0];
        {
#pragma unroll
            for (int i = 0; i < 8; ++i) sacc[i] = sacc[i] * dcy;
#pragma unroll
            for (int k = 0; k < 2; ++k) { const v8s af = tr_frag(VW, ST64, 32 * k, 16 * svt, lane);
#pragma unroll
                for (int i = 0; i < 8; ++i) { const v8s bf = tr_frag(K, ST256, 32 * k, 16 * (sdt0 + i), lane); sacc[i] = MFMA16(bf, af, sacc[i]); } }
#pragma unroll
            for (int i = 0; i < 8; ++i) *(LP(v2u))(STT + (16 * svt + fr) * ST256 + (16 * (sdt0 + i) + 4 * fq) * 2) = (v2u){PK2(sacc[i].x, sacc[i].y), PK2(sacc[i].z, sacc[i].w)};
        }
        if (MODE == 0 && tid < 256) { float s = 0.f;
            for (int jj = 0; jj < 64; ++jj) s += __uint_as_float(((unsigned)*(LP(const unsigned short))(K + jj * ST256 + tid * 2)) << 16) * WK[jj];
            NV[tid] = dcy * NV[tid] + s * kscale; }
        SYNC();
    }
#undef MAT_ISSUE
}

constexpr int S5_LDS_PER_WAVE = 1280 + 8448 + 4352;
DEV void s5_unit(const bf16* S, int ldS, float* O, const float* lam_re, const float* lam_im, const float* log_step, const float* b_re, const float* b_im,
                 const float* c_re, const float* c_im, int unit, LP(unsigned char) wl, int lane) {
    const int fr = lane & 15, fq = lane >> 4;
    const int dir = unit & 1, g = (unit >> 1) & 63, b = unit >> 7;
    LP(unsigned char) UB = wl; LP(unsigned char) XB = wl + 1280; LP(unsigned char) HB = wl + 1280 + 8448;
    const int pg = (dir * 64 + g);
    const float lr = lam_re[pg * 64 + lane], li = lam_im[pg * 64 + lane], step = expf(log_step[pg]);
    const float mag = expf(lr * step); float sn, cs; sincosf(li * step, &sn, &cs);
    const float ar = mag * cs, ai = mag * sn, den = lr * lr + li * li;
    const float cre = ((ar - 1.0f) * lr + ai * li) / den, cim = (ai * lr - (ar - 1.0f) * li) / den;
    for (int p = 0; p < 16; ++p) { const float br = b_re[(pg * 64 + lane) * 16 + p], bi = b_im[(pg * 64 + lane) * 16 + p];
        *(LP(unsigned short))(XB + lane * 32 + p * 2) = F2BF(cre * br - cim * bi);
        *(LP(unsigned short))(XB + (64 + lane) * 32 + p * 2) = F2BF(cre * bi + cim * br); }
    WAVE_SYNC();
    v8s bfrag[8];
#pragma unroll
    for (int nt = 0; nt < 8; ++nt) { if (fq < 2) bfrag[nt] = *(LP(const v8s))(XB + (16 * nt + fr) * 32 + fq * 16); else bfrag[nt] = (v8s){0, 0, 0, 0, 0, 0, 0, 0}; }
    v8s cfrag[4];
#pragma unroll
    for (int ks = 0; ks < 4; ++ks) { const int n0 = 32 * ks + 8 * fq; const float* src = (n0 < 64 ? c_re : c_im) + ((size_t)pg * 16 + fr) * 64 + (n0 & 63); const float sgn = n0 < 64 ? 1.f : -1.f;
        v8s f;
#pragma unroll
        for (int i = 0; i < 8; ++i) f[i] = (short)F2BF(sgn * src[i]);
        cfrag[ks] = f; }
    WAVE_SYNC();
    for (int i = lane; i < 1280 / 4; i += 64) ((LP(unsigned))UB)[i] = 0u;
    WAVE_SYNC();
    float hr = 0.f, hi = 0.f;
    float* Od = O + (size_t)dir * TT * 1024;
    constexpr int NBLK = CTXL / 16 + SEQ / 16;
    v4u un = (v4u){0u, 0u, 0u, 0u};
#define S5_ISSUE(bx) do { if (lane < 32) { const int seg_ = (bx) >= CTXL / 16, bi_ = seg_ ? (bx) - CTXL / 16 : (bx); \
        un = *(const v4u*)(S + (size_t)tok_row(b, seg_, bi_ * 16 + (lane >> 1), dir, 0) * ldS + g * 16 + (lane & 1) * 8); } } while (0)
    S5_ISSUE(0);
    for (int bx = 0; bx < NBLK; ++bx) {
        const int seg = bx >= CTXL / 16, bi = seg ? bx - CTXL / 16 : bx;
        {
            if (lane < 32) *(LP(v4u))(UB + (lane >> 1) * 80 + (lane & 1) * 16) = un;
            if (bx + 1 < NBLK) S5_ISSUE(bx + 1);
            WAVE_SYNC();
            const v8s uf = *(LP(const v8s))(UB + fr * 80 + fq * 16);
#pragma unroll
            for (int nt = 0; nt < 8; ++nt) { v4f x = (v4f){0.f, 0.f, 0.f, 0.f}; x = MFMA16(bfrag[nt], uf, x);
                *(LP(v4f))(XB + fr * 528 + (16 * nt + 4 * fq) * 4) = x; }
            WAVE_SYNC();
#pragma unroll
            for (int tk = 0; tk < 16; ++tk) { const float xr = *(LP(const float))(XB + tk * 528 + lane * 4), xi = *(LP(const float))(XB + tk * 528 + (64 + lane) * 4);
                const float nr = ar * hr - ai * hi + xr, ni = ar * hi + ai * hr + xi; hr = nr; hi = ni;
                *(LP(unsigned short))(HB + tk * 272 + lane * 2) = F2BF(hr); *(LP(unsigned short))(HB + tk * 272 + (64 + lane) * 2) = F2BF(hi); }
            WAVE_SYNC();
            if (seg) { v4f y = (v4f){0.f, 0.f, 0.f, 0.f};
#pragma unroll
                for (int ks = 0; ks < 4; ++ks) { const v8s hf = *(LP(const v8s))(HB + fr * 272 + ks * 64 + fq * 16); y = MFMA16(cfrag[ks], hf, y); }
                const int orow = tok_row(b, seg, bi * 16 + fr, dir, 0);
                *(v4f*)(Od + (size_t)orow * 1024 + g * 16 + 4 * fq) = y; }
        }
    }
#undef S5_ISSUE
}

DEV void conv_prep_row(int r, const bf16* S, bf16* QK2, const float* conv_w, const float* conv_b, int lane) {
    int rm, rp; bool hasm, hasp;
    if (r < TL) { const int b = r >> 12, n = r & (SEQ - 1), gr = n >> 6, col = n & 63, np = col * 64 + gr;
        hasm = np > 0; hasp = np < SEQ - 1; rm = seq_row(b, 1, hasm ? np - 1 : np, 1); rp = seq_row(b, 1, hasp ? np + 1 : np, 1); }
    else { const int n = (r - TL) & (CTXL - 1); hasm = n > 0; hasp = n < CTXL - 1; rm = hasm ? r - 1 : r; rp = hasp ? r + 1 : r; }
    const bf16* s0 = S + (size_t)rm * EV_PAD + 3072; const bf16* s1 = S + (size_t)r * EV_PAD + 3072; const bf16* s2 = S + (size_t)rp * EV_PAD + 3072;
#pragma unroll
    for (int i = 0; i < 4; ++i) { const int c = 8 * lane + 512 * i;
        const v4u a0 = *(const v4u*)(s0 + c), a1 = *(const v4u*)(s1 + c), a2 = *(const v4u*)(s2 + c);
        const unsigned w0[4] = {a0.x, a0.y, a0.z, a0.w}, w1[4] = {a1.x, a1.y, a1.z, a1.w}, w2[4] = {a2.x, a2.y, a2.z, a2.w};
        const float sc = c >= 1024 ? 0.0625f : 1.0f;
        float val[8];
#pragma unroll
        for (int i2 = 0; i2 < 4; ++i2)
#pragma unroll
            for (int e = 0; e < 2; ++e) { const int di = 2 * i2 + e;
                const float um = hasm ? (e ? bfhi(w0[i2]) : bflo(w0[i2])) : 0.f, u0 = e ? bfhi(w1[i2]) : bflo(w1[i2]), up = hasp ? (e ? bfhi(w2[i2]) : bflo(w2[i2])) : 0.f;
                const float pre = conv_b[c + di] + conv_w[c + di] * um + conv_w[2048 + c + di] * u0 + conv_w[4096 + c + di] * up;
                val[di] = pre * RCPF(1.0f + EXPF(-pre)) * sc; }
        *(v4u*)(QK2 + (size_t)r * 2048 + c) = (v4u){PK2(val[0], val[1]), PK2(val[2], val[3]), PK2(val[4], val[5]), PK2(val[6], val[7])}; }
}

DEV float wsum(float v) {
#pragma unroll
    for (int o = 1; o < 64; o <<= 1) v += SHX(v, o);
    return v;
}
DEV void merge_even_row(int r, const bf16* S, const float* O, const float* gla_norm, const float* ml_norm, bf16* HBo, int lane) {
    const bf16* sr = S + (size_t)r * EV_PAD;
#pragma unroll
    for (int hh = 0; hh < 8; ++hh) { const int mix = hh >> 2, c = (hh & 3) * 256 + 4 * lane;
        const float* o0 = O + (size_t)(2 * mix) * TT * 1024 + (size_t)r * 1024 + c; const float* o1 = o0 + (size_t)TT * 1024;
        v4f o = *(const v4f*)o0 + *(const v4f*)o1;
#ifdef NO_GLA
        if (!mix) o = (v4f){0.f, 0.f, 0.f, 0.f};
#endif
#ifdef NO_ML
        if (mix) o = (v4f){0.f, 0.f, 0.f, 0.f};
#endif
        if (mix) { const float mean = wsum((o.x + o.y) + (o.z + o.w)) * (1.0f / 256.0f); o = o - mean; }
        const float ms = wsum((o.x * o.x + o.y * o.y) + (o.z * o.z + o.w * o.w)) * (1.0f / 256.0f);
        const float rstd = RSQRTF(ms + EPS);
        const v4f gn = *(const v4f*)((mix ? ml_norm : gla_norm) + c);
        const v2u gw = *(const v2u*)(sr + (mix ? 6144 : 2048) + c);
        const float g0 = bflo(gw.x), g1 = bfhi(gw.x), g2 = bflo(gw.y), g3 = bfhi(gw.y);
        v4f gate;
        if (mix) { gate.x = RCPF(1.0f + EXPF(-g0)); gate.y = RCPF(1.0f + EXPF(-g1)); gate.z = RCPF(1.0f + EXPF(-g2)); gate.w = RCPF(1.0f + EXPF(-g3)); }
        else { gate.x = g0 * RCPF(1.0f + EXPF(-g0)); gate.y = g1 * RCPF(1.0f + EXPF(-g1)); gate.z = g2 * RCPF(1.0f + EXPF(-g2)); gate.w = g3 * RCPF(1.0f + EXPF(-g3)); }
        const v4f res = gate * (o * rstd * gn);
        *(v2u*)(HBo + (size_t)r * D + mix * 1024 + c) = (v2u){PK2(res.x, res.y), PK2(res.z, res.w)}; }
}
DEV float gelu_tanh(float y) { const float z = 0.7978845608028654f * (y + 0.044715f * y * y * y); const float t = 1.0f - 2.0f * RCPF(1.0f + EXPF(2.0f * z)); return 0.5f * y * (1.0f + t); }
DEV void merge_odd_row(int r, const bf16* S, const float* O, const float* s5_d, const float* ret_norm, bf16* GBo, bf16* HBo, int lane) {
    const bf16* sr = S + (size_t)r * OD_COLS;
#pragma unroll
    for (int hh = 0; hh < 4; ++hh) { const int c = hh * 256 + 4 * lane;
        { const float* o0 = O + (size_t)r * 1024 + c; const float* o1 = o0 + (size_t)TT * 1024;
          v4f y0 = *(const v4f*)o0 + *(const v4f*)o1;
#ifdef NO_S5
          y0 = (v4f){0.f, 0.f, 0.f, 0.f};
#endif
          const v4f dd = *(const v4f*)(s5_d + c); const v2u uw = *(const v2u*)(sr + c);
          const float y[4] = {y0.x + dd.x * bflo(uw.x), y0.y + dd.y * bfhi(uw.x), y0.z + dd.z * bflo(uw.y), y0.w + dd.w * bfhi(uw.y)};
          *(v2u*)(GBo + (size_t)r * 1024 + c) = (v2u){PK2(gelu_tanh(y[0]), gelu_tanh(y[1])), PK2(gelu_tanh(y[2]), gelu_tanh(y[3]))}; }
        { const float* o0 = O + (size_t)2 * TT * 1024 + (size_t)r * 1024 + c; const float* o1 = o0 + (size_t)TT * 1024;
          v4f o = *(const v4f*)o0 + *(const v4f*)o1;
#ifdef NO_RET
          o = (v4f){0.f, 0.f, 0.f, 0.f};
#endif
          const float mean = wsum((o.x + o.y) + (o.z + o.w)) * (1.0f / 256.0f); o = o - mean;
          const float ms = wsum((o.x * o.x + o.y * o.y) + (o.z * o.z + o.w * o.w)) * (1.0f / 256.0f);
          const float rstd = RSQRTF(ms + EPS);
          const v4f gn = *(const v4f*)(ret_norm + c);
          const v2u gw = *(const v2u*)(sr + 4096 + c);
          const float g0 = bflo(gw.x), g1 = bfhi(gw.x), g2 = bflo(gw.y), g3 = bfhi(gw.y);
          v4f gate; gate.x = g0 * RCPF(1.0f + EXPF(-g0)); gate.y = g1 * RCPF(1.0f + EXPF(-g1)); gate.z = g2 * RCPF(1.0f + EXPF(-g2)); gate.w = g3 * RCPF(1.0f + EXPF(-g3));
          const v4f res = gate * (o * rstd * gn);
          *(v2u*)(HBo + (size_t)r * D + 1024 + c) = (v2u){PK2(res.x, res.y), PK2(res.z, res.w)}; }
    }
}

struct EpiGLU {
    static constexpr bool PERM = true, AFTER_DRAIN = false;
    const bf16* G; const float* bias; bf16* O;
    __device__ __forceinline__ void operator()(const pg8::f32x4 (&acc)[2][2][4][2], const pg8::Unit& u, int wr, int wc, int fr, int fq) const {
        const int row0 = u.pm * 256 + wr * 64 + fr, col0 = u.pn * 256 + wc * 32 + 8 * fq;
#pragma unroll
        for (int ai = 0; ai < 2; ++ai)
#pragma unroll
            for (int m = 0; m < 4; ++m) { const size_t row = (size_t)(row0 + ai * 128 + m * 16);
#pragma unroll
                for (int bj = 0; bj < 2; ++bj) { const int col = col0 + bj * 128;
                    const v4u gw = *(const v4u*)(G + row * 1024 + col); const pg8::f32x4 b0 = *(const pg8::f32x4*)(bias + col), b1 = *(const pg8::f32x4*)(bias + col + 4);
                    const pg8::f32x4 v0 = acc[ai][bj][m][0] + b0, v1 = acc[ai][bj][m][1] + b1;
                    v4u w; w.x = pk2(bflo(gw.x) * fast_sigmoid(v0[0]), bfhi(gw.x) * fast_sigmoid(v0[1])); w.y = pk2(bflo(gw.y) * fast_sigmoid(v0[2]), bfhi(gw.y) * fast_sigmoid(v0[3]));
                    w.z = pk2(bflo(gw.z) * fast_sigmoid(v1[0]), bfhi(gw.z) * fast_sigmoid(v1[1])); w.w = pk2(bflo(gw.w) * fast_sigmoid(v1[2]), bfhi(gw.w) * fast_sigmoid(v1[3]));
                    *(v4u*)(O + row * D + col) = w; } }
    }
};

__device__ __forceinline__ void mixer_phases(const Args& a, unsigned char* ws, LAS unsigned char* lds, const XcdBarrier& bar, int layer, int G, int gw, int ngw, int tid, int lane, int wave) {
    bf16* HB = (bf16*)(ws + WS_HB); bf16* S = (bf16*)(ws + WS_S); float* GT = (float*)(ws + WS_GT); float* O = (float*)(ws + WS_O); bf16* GB = (bf16*)(ws + WS_GB); float* Y = (float*)(ws + WS_Y);
    const int ldS = layer == 0 ? EV_PAD : OD_COLS;
    { pg8::Gemm g{HB, (const bf16*)(ws + (layer == 0 ? WS_WIN_EV : WS_WIN_OD)), TT, ldS, D}; pg8::StaticOrder So; So.init(TT, ldS, G, (int)blockIdx.x);
      EpiS E{S, ldS, GT, layer == 0 ? 28 : -1};
      pg8::gemm_phase<EpiS, pg8::StaticOrder, true, true>(lds, g, So, E); }
    xcd_barrier(bar);
    bf16* QK2 = (bf16*)(ws + WS_QK2); float* GP = (float*)(ws + WS_GP);
    if (layer == 0) {
        for (int r = gw; r < TT; r += ngw) conv_prep_row(r, S, QK2, ARG(16), ARG(17), lane);
        for (int t = gw; t < GATE_TASKS; t += ngw) gate_prep_task(t, GT, GP, ARG(18), lane);
        xcd_barrier(bar);
    }
    { int t2 = threadIdx.x; asm volatile("" : "+v"(t2)); tid = t2; lane = t2 & 63; wave = __builtin_amdgcn_readfirstlane(t2 >> 6); }
#ifndef SCAN_REPS
#define SCAN_REPS 1
#endif
#pragma unroll 1
    for (int rep = 0; rep < SCAN_REPS; ++rep) {
    if (layer == 0) {
        for (int it = blockIdx.x; it < 2 * MIX_UNITS; it += G) {
            if (it < MIX_UNITS) {
#ifndef NO_GLA
                gla_unit(S, GT, O, ARG(13), ARG(14), it, lds, tid);
#endif
            } else {
#ifndef NO_ML
                mat_unit<0>(QK2, 2048, 0, 1024, S, EV_PAD, 5120, 1.0f, GP, O, 1, nullptr, it - MIX_UNITS, lds, tid);
#endif
            }
        }
    } else {
        const int s5_first = G >= 2 * MIX_UNITS ? MIX_UNITS : 0, s5_wgs = G - s5_first;
#ifndef NO_RET
        for (int u = blockIdx.x; u < MIX_UNITS; u += G)
            mat_unit<1>(S, OD_COLS, 1024, 2048, S, OD_COLS, 3072, 0.0625f, nullptr, O, 0, ARG(32), u, lds, tid);
#endif
#ifndef NO_S5
        if ((int)blockIdx.x >= s5_first && wave < 4) { for (int su = ((int)blockIdx.x - s5_first) * 4 + wave; su < NB * 128; su += 4 * s5_wgs)
            s5_unit(S, OD_COLS, O, ARG(22), ARG(23), ARG(24), ARG(25), ARG(26), ARG(27), ARG(28), su, lds + wave * S5_LDS_PER_WAVE, lane); }
#endif
    }
    }
    xcd_barrier(bar);
    { int t2 = threadIdx.x; asm volatile("" : "+v"(t2)); tid = t2; lane = t2 & 63; wave = __builtin_amdgcn_readfirstlane(t2 >> 6); gw = blockIdx.x * NWAVES + wave; }
#ifndef NO_MERGE
    if (layer == 0) { for (int r = gw; r < TT; r += ngw) merge_even_row(r, S, O, ARG(15), ARG(19), HB, lane); }
    else { for (int r = gw; r < TL; r += ngw) merge_odd_row(r, S, O, ARG(29), ARG(33), GB, HB, lane); }
#endif
    xcd_barrier(bar);
    const int Mo = layer == 0 ? TT : TL;
    if (layer == 1) {
        pg8::Gemm g{GB, (const bf16*)(ws + WS_WGLU), TL, 1024, 1024}; pg8::StaticOrder So; So.init(TL, 1024, G, (int)blockIdx.x);
        EpiGLU E{GB, ARG(31), HB};
        pg8::gemm_phase<EpiGLU, pg8::StaticOrder, true, true>(lds, g, So, E);
        xcd_barrier(bar);
    }
    { pg8::Gemm g{HB, (const bf16*)(ws + (layer == 0 ? WS_WOUT_EV : WS_WOUT_OD)), Mo, D, D}; pg8::StaticOrder So; So.init(Mo, D, G, (int)blockIdx.x);
      EpiF32 E{Y, D};
      pg8::gemm_phase<EpiF32, pg8::StaticOrder, true, true>(lds, g, So, E); }
    xcd_barrier(bar);
}

#ifndef MIXER_ON
#define MIXER_ON 1
#endif
__global__ void __launch_bounds__(NTHR, 2) fwd(Args a) {
    extern __shared__ __attribute__((aligned(16))) unsigned char lds_raw[];
    LAS unsigned char* lds = (LAS unsigned char*)lds_raw;
    const int tid = threadIdx.x, lane = tid & 63, wave = __builtin_amdgcn_readfirstlane(tid >> 6);
    const int G = gridDim.x, gw = blockIdx.x * NWAVES + wave, ngw = G * NWAVES;
    unsigned char* ws = a.ws;
    if (tid < 16) ((LAS unsigned*)(lds + MISC_OFF))[tid] = 0u;
    __syncthreads();
    XcdBarrier bar = xcd_barrier_post((unsigned*)(ws + WS_CTL), (volatile LAS unsigned*)(lds + MISC_OFF));

#ifdef NAN_POISON
    {
        v4u q = (v4u){0xffffffffu, 0xffffffffu, 0xffffffffu, 0xffffffffu};
        for (int i = tid; i < (MISC_OFF) / 16; i += NTHR) ((LAS v4u*)lds)[i] = q;
        { v4u* p = (v4u*)(ws + WS_MOD); const size_t n = (WS_WGU - WS_MOD) / 16; for (size_t i = (size_t)blockIdx.x * NTHR + tid; i < n; i += (size_t)G * NTHR) p[i] = q; }
        { v4u* p = (v4u*)(ws + WS_XC); const size_t n = (WS_END - WS_XC) / 16; for (size_t i = (size_t)blockIdx.x * NTHR + tid; i < n; i += (size_t)G * NTHR) p[i] = q; }
        { v4u* p = (v4u*)a.out; const size_t n = (size_t)TL * D * 4 / 16; for (size_t i = (size_t)blockIdx.x * NTHR + tid; i < n; i += (size_t)G * NTHR) p[i] = q; }
        __syncthreads();
        xcd_barrier(bar);
    }
#endif
    float* MOD = (float*)(ws + WS_MOD); float* MODP = (float*)(ws + WS_MODP);
    bf16* HB = (bf16*)(ws + WS_HB); bf16* HID = (bf16*)(ws + WS_HID); float* Y = (float*)(ws + WS_Y); float* XC = (float*)(ws + WS_XC);

    {
        TJob* jobs = (TJob*)lds_raw;
        LAS float* stab = (LAS float*)(lds + 1024);
        if (tid == 0) {
            int t = 0, ji = 0;
            for (int l = 0; l < 2; ++l) for (int i = 0; i < 2; ++i) {
                const size_t wo = (size_t)(l * 2 + i) * 2048 * 5504;
                TJob j; j.K = 2048; j.N = 5504; j.dst = (bf16*)(ws + WS_WGU + (size_t)(l * 2 + i) * SZ_WGU);
                j.src = ARG(8) + wo; j.map = 1; j.tstart = t; jobs[ji++] = j; t += tj_tiles(2048, 5504);
                j.src = ARG(9) + wo; j.map = 2; j.tstart = t; jobs[ji++] = j; t += tj_tiles(2048, 5504);
                j.K = 5504; j.N = 2048; j.dst = (bf16*)(ws + WS_WD + (size_t)(l * 2 + i) * SZ_WD); j.src = ARG(10) + wo; j.map = 0; j.tstart = t; jobs[ji++] = j; t += tj_tiles(5504, 2048);
            }
            TJob j; j.map = 0;
            j.K = 2048; j.N = EV_COLS; j.src = ARG(11); j.dst = (bf16*)(ws + WS_WIN_EV); j.map = 3; j.tstart = t; jobs[ji++] = j; t += tj_tiles(2048, EV_COLS);
            j.map = 0;
            j.K = 2048; j.N = 2048; j.src = ARG(12); j.dst = (bf16*)(ws + WS_WOUT_EV); j.tstart = t; jobs[ji++] = j; t += tj_tiles(2048, 2048);
            j.K = 2048; j.N = OD_COLS; j.src = ARG(20); j.dst = (bf16*)(ws + WS_WIN_OD); j.tstart = t; jobs[ji++] = j; t += tj_tiles(2048, OD_COLS);
            j.K = 2048; j.N = 2048; j.src = ARG(21); j.dst = (bf16*)(ws + WS_WOUT_OD); j.tstart = t; jobs[ji++] = j; t += tj_tiles(2048, 2048);
            j.K = 1024; j.N = 1024; j.src = ARG(30); j.dst = (bf16*)(ws + WS_WGLU); j.tstart = t; jobs[ji++] = j; t += tj_tiles(1024, 1024);
            ((LAS int*)(lds + 1024 - 16))[0] = t;
        }
        { const float* cin = ARG(1); const float* cctx = ARG(3);
        for (int i = tid; i < 5 * D; i += NTHR) { const int r = i >> 11, k = i & (D - 1); const float c = r < 4 ? cin[r * D + k] : cctx[k]; stab[i] = c / (1.0f + expf(-c)); } }
        __syncthreads();
        for (int it = gw; it < 2 * MOD_KC * 72; it += ngw) {
            const int l = it / (MOD_KC * 72), rem = it % (MOD_KC * 72), kc = rem / 72, jb = rem % 72; constexpr int KCH = D / MOD_KC;
            const float* W = ARG(4) + ((size_t)l * D + kc * KCH) * (NMOD * D) + jb * 256 + lane * 4;
            f32x4 acc[5];
#pragma unroll
            for (int r = 0; r < 5; ++r) acc[r] = (f32x4){0.f, 0.f, 0.f, 0.f};
            for (int k = 0; k < KCH; k += 8) { f32x4 w[8];
#pragma unroll
                for (int i = 0; i < 8; ++i) w[i] = *(const f32x4*)(W + (size_t)(k + i) * (NMOD * D));
#pragma unroll
                for (int i = 0; i < 8; ++i)
#pragma unroll
                    for (int r = 0; r < 5; ++r) acc[r] += stab[r * D + kc * KCH + k + i] * w[i]; }
#pragma unroll
            for (int r = 0; r < 5; ++r) *(f32x4*)(MODP + (((size_t)l * MOD_KC + kc) * 5 + r) * (NMOD * D) + jb * 256 + lane * 4) = acc[r];
        }
        const int ntiles = ((LAS int*)(lds + 1024 - 16))[0];
        for (int t = gw; t < ntiles; t += ngw) {
            int ji = 0;
#pragma unroll 1
            for (int q = 1; q < NJOBS; ++q) if (t >= jobs[q].tstart) ji = q;
            const TJob j = jobs[ji];
            transpose_tile(j, t - j.tstart, lane);
        }
        { v4u z = (v4u){0u, 0u, 0u, 0u}; v4u* p = (v4u*)(ws + WS_WIN_EV + (size_t)EV_COLS * 2048 * 2); const int n16 = (EV_PAD - EV_COLS) * 2048 * 2 / 16;
          for (int i = blockIdx.x * NTHR + tid; i < n16; i += G * NTHR) p[i] = z; }
    }
    xcd_barrier(bar);
    { const float* bmod = ARG(5);
    for (int i = blockIdx.x * NTHR + tid; i < 2 * 5 * NMOD * D; i += G * NTHR) {
        const int l = i / (5 * NMOD * D), rem = i % (5 * NMOD * D), r = rem / (NMOD * D), j = rem % (NMOD * D);
        float s = bmod[l * (NMOD * D) + j];
        for (int kc = 0; kc < MOD_KC; ++kc) s += MODP[(((size_t)l * MOD_KC + kc) * 5 + r) * (NMOD * D) + j];
        MOD[i] = s;
    } }
    xcd_barrier(bar);
    { NormP p{}; p.xin_lat = ARG(0); p.xin_ctx = ARG(2); p.xout_lat = a.out; p.xout_ctx = XC; p.y = nullptr; p.h = HB; p.rows_end = TT; p.has_y = 0; p.has_h = 1; p.w = 0.f; p.lp = 0; p.sp = 0; p.ln = 0; p.sn = 0;
      norm_phase(p, MOD, ARG(6), ARG(7), lds, gw, ngw, tid, lane); }
    xcd_barrier(bar);

#pragma unroll 1
    for (int layer = 0; layer < 2; ++layer) {
#pragma unroll 1
        for (int half = 0; half < 2; ++half) {
            const int Mrows = (layer == 1 && half == 1) ? TL : TT;
#if MIXER_ON
            if (half == 1) {
                mixer_phases(a, ws, lds, bar, layer, G, gw, ngw, tid, lane, wave);
                NormP p{}; p.xin_lat = a.out; p.xin_ctx = XC; p.xout_lat = a.out; p.xout_ctx = XC; p.y = Y; p.h = HB; p.rows_end = Mrows; p.has_y = 1; p.has_h = 1; p.w = 1.0f; p.lp = layer; p.sp = 1; p.ln = layer; p.sn = 2;
                norm_phase(p, MOD, ARG(6), ARG(7), lds, gw, ngw, tid, lane);
                xcd_barrier(bar);
            }
#endif
            const int sub = half * 2;
            { pg8::Gemm g{HB, (const bf16*)(ws + WS_WGU + (size_t)(layer * 2 + half) * SZ_WGU), Mrows, 2 * DFF, D}; pg8::StaticOrder S; S.init(Mrows, 2 * DFF, G, (int)blockIdx.x);
              EpiSwiGLU E{HID, DFF};
              pg8::gemm_phase<EpiSwiGLU, pg8::StaticOrder, true, true>(lds, g, S, E); }
            xcd_barrier(bar);
            { pg8::Gemm g{HID, (const bf16*)(ws + WS_WD + (size_t)(layer * 2 + half) * SZ_WD), Mrows, D, DFF}; pg8::StaticOrder S; S.init(Mrows, D, G, (int)blockIdx.x);
              EpiF32 E{Y, D};
              pg8::gemm_phase<EpiF32, pg8::StaticOrder, true, true>(lds, g, S, E); }
            xcd_barrier(bar);
            { NormP p{}; const bool first = (layer == 0 && half == 0);
              p.xin_lat = first ? ARG(0) : a.out; p.xin_ctx = first ? ARG(2) : XC; p.xout_lat = a.out; p.xout_ctx = XC; p.y = Y; p.h = HB; p.rows_end = Mrows; p.has_y = 1; p.w = 0.5f; p.lp = layer; p.sp = sub;
              if (half == 0) { p.has_h = 1; p.ln = layer; p.sn = MIXER_ON ? 1 : 2; }
              else if (layer == 0) { p.has_h = 1; p.ln = 1; p.sn = 0; }
              else { p.has_h = 0; p.ln = 0; p.sn = 0; }
              norm_phase(p, MOD, ARG(6), ARG(7), lds, gw, ngw, tid, lane); }
            if (!(layer == 1 && half == 1)) xcd_barrier(bar);
        }
    }
}

extern "C" void kernel_launch(void* const* d_in, const int* in_sizes, int n_in, void* d_out, int out_size, void* d_ws, size_t ws_size, hipStream_t stream) {
    static int grid = 0;
    if (grid == 0) {
        if (n_in != 34 || out_size != TL * D || ws_size < WS_END) { fprintf(stderr, "kernel_launch: unexpected shapes (n_in %d out %d ws %zu need %zu)\n", n_in, out_size, ws_size, (size_t)WS_END); grid = -1; return; }
        int dev = 0, cus = 0, per_cu = 0;
        if (hipGetDevice(&dev) != hipSuccess || hipDeviceGetAttribute(&cus, hipDeviceAttributeMultiprocessorCount, dev) != hipSuccess) { grid = -1; return; }
        if (hipFuncSetAttribute((const void*)fwd, hipFuncAttributeMaxDynamicSharedMemorySize, LDS_BYTES) != hipSuccess) { fprintf(stderr, "kernel_launch: hipFuncSetAttribute failed\n"); grid = -1; return; }
        if (hipOccupancyMaxActiveBlocksPerMultiprocessor(&per_cu, (const void*)fwd, NTHR, LDS_BYTES) != hipSuccess || per_cu < 1) { fprintf(stderr, "kernel_launch: occupancy query says %d\n", per_cu); }
        (void)hipGetLastError();
        grid = cus;
    }
    if (grid < 0) return;
    if (hipMemsetAsync((char*)d_ws + WS_CTL, 0, CTL_ZERO_BYTES, stream) != hipSuccess) return;
    Args a{};
    for (int i = 0; i < 34; ++i) a.in[i] = (const float*)d_in[i];
    a.out = (float*)d_out; a.ws = (unsigned char*)d_ws;
    hipLaunchKernelGGL(fwd, dim3(grid), dim3(NTHR), LDS_BYTES, stream, a);
}
```

```cpp
#include <hip/hip_runtime.h>
#include <cstdio>
#include <cstdint>
#define MIXER_ON 1

#define XB_TMO      128
#define XB_XCNT(j)  (256  + 64 * (j))
#define XB_XSUB(j)  (1280 + 64 * (j))
#define XB_XGEN(j)  (2304 + 64 * (j))
#define XB_TOP      3328
#define XB_TOPGEN   3392
#define XCD_BAR_WORDS 3456
#define XB_SPIN_CAP (1u << 18)
#define LAS __attribute__((address_space(3)))

__device__ __forceinline__ unsigned xb_ld(unsigned* p)              { return __hip_atomic_load(p, __ATOMIC_RELAXED, __HIP_MEMORY_SCOPE_AGENT); }
__device__ __forceinline__ unsigned xb_add(unsigned* p, unsigned v) { return __hip_atomic_fetch_add(p, v, __ATOMIC_RELAXED, __HIP_MEMORY_SCOPE_AGENT); }
__device__ __forceinline__ unsigned xb_xcc_id() { return (unsigned)__builtin_amdgcn_s_getreg((3 << 11) | 20) & 0xFu; }
#define XB_SPIN(cond, bar) do { unsigned _sp = 0; while (cond) { __builtin_amdgcn_s_sleep(1); \
    if ((++_sp & 255u) == 0u) { if (xb_ld(&(bar)[XB_TMO])) break; if (_sp > XB_SPIN_CAP) { atomicAdd(&(bar)[XB_TMO], 1u); break; } } } } while (0)

struct XcdBarrier {
    unsigned* bar; unsigned x;
    volatile LAS unsigned* st;
};

__device__ __forceinline__ XcdBarrier xcd_barrier_post(unsigned* bar, volatile LAS unsigned* st) {
    XcdBarrier b; b.bar = bar; b.x = xb_xcc_id(); b.st = st;
    if (threadIdx.x == 0) (void)xb_add(&bar[XB_XCNT(b.x)], 1u);
    return b;
}
__device__ __forceinline__ void xcd_barrier_complete(unsigned* bar, unsigned x, unsigned& nloc, unsigned& nx) {
    const unsigned G = gridDim.x * gridDim.y * gridDim.z;
    unsigned sum, cnt, mine, sp = 0u;
    for (;;) {
        sum = 0u; cnt = 0u; mine = 0u;
#pragma unroll
        for (unsigned j = 0; j < 16; ++j) { const unsigned c = xb_ld(&bar[XB_XCNT(j)]); sum += c; cnt += (c > 0u) ? 1u : 0u; mine = (j == x) ? c : mine; }
        if (sum == G) break;
        __builtin_amdgcn_s_sleep(1);
        if ((++sp & 255u) == 0u) { if (xb_ld(&bar[XB_TMO])) break; if (sp > XB_SPIN_CAP) { atomicAdd(&bar[XB_TMO], 1u); break; } }
    }
    nloc = mine > 0u ? mine : 1u; nx = cnt > 0u ? cnt : 1u;
}

__device__ __forceinline__ void xcd_barrier(const XcdBarrier& b) {
    asm volatile("s_waitcnt vmcnt(0)" ::: "memory");
    __syncthreads();
    if (threadIdx.x == 0) {
        unsigned* bar = b.bar;
        __builtin_amdgcn_s_waitcnt(0);
        unsigned nloc = b.st[0], nx = b.st[1];
        if (nloc == 0u) { xcd_barrier_complete(bar, b.x, nloc, nx); b.st[0] = nloc; b.st[1] = nx; }
        const unsigned old = xb_add(&bar[XB_XSUB(b.x)], 1u);
        const unsigned gen = old / nloc;
        if (old + 1u == (gen + 1u) * nloc) {
            __builtin_amdgcn_fence(__ATOMIC_RELEASE, "agent");
            asm volatile("s_waitcnt vmcnt(0)" ::: "memory");
            const unsigned og = xb_add(&bar[XB_TOP], 1u);
            const unsigned tg = og / nx;
            if (og + 1u == (tg + 1u) * nx) xb_add(&bar[XB_TOPGEN], 1u);
            else XB_SPIN(xb_ld(&bar[XB_TOPGEN]) == tg, bar);
            __builtin_amdgcn_fence(__ATOMIC_ACQUIRE, "agent");
            xb_add(&bar[XB_XGEN(b.x)], 1u);
            asm volatile("s_waitcnt vmcnt(0)" ::: "memory");
        } else {
            XB_SPIN(xb_ld(&bar[XB_XGEN(b.x)]) == gen, bar);
            __builtin_amdgcn_fence(__ATOMIC_ACQUIRE, "agent");
            asm volatile("s_waitcnt vmcnt(0)" ::: "memory");
        }
    }
    __syncthreads();
}

namespace pg8 {
#define PG8_LAS __attribute__((address_space(3)))
typedef unsigned short bf16_t;
typedef short bf16x8 __attribute__((ext_vector_type(8)));
typedef float f32x4 __attribute__((ext_vector_type(4)));
typedef unsigned u32x4 __attribute__((ext_vector_type(4)));
constexpr int BM = 256, BK = 64, HALF = 128, HTB = HALF * BK * 2  , STAGE_BYTES = 8 * HTB, NXCD = 8, WGM = 8;

__host__ __device__ __forceinline__ int lds_byte(int r, int c) { const int st = (r >> 4) * 2 + (c >> 5), rr = r & 15, cc = c & 31, ob = rr * 64 + cc * 2; return st * 1024 + (ob ^ (((ob >> 9) & 1) << 5)); }
__host__ __device__ __forceinline__ void stage_rc(int b, int& R, int& C) { const int st = b / 1024, sb = b % 1024, swz = sb ^ (((sb >> 9) & 1) << 5); R = (st >> 1) * 16 + swz / 64; C = (st & 1) * 32 + (swz % 64) / 2; }
__host__ __device__ __forceinline__ int perm32(int rho) { const int n = rho >> 4, i = rho & 15; return 8 * (i >> 2) + 4 * n + (i & 3); }

struct Unit { int pm, pn, k0, nt, part; };
struct Gemm { const bf16_t* A; const bf16_t* Bt; int M, N, K; };

struct StaticOrder {
    int nM, nN, nwg, G, c;
    __host__ __device__ void init(int M, int N, int G_, int c_) { nM = M / BM; nN = N / BM; nwg = nM * nN; G = G_; c = c_; }
    __host__ __device__ bool next(int i, Unit& u) const {
        const long L = (long)i * G + c; if (L >= nwg) return false;
        int wgid = (int)L; { const int q = nwg / NXCD, r = nwg % NXCD, xcd = wgid % NXCD, off = wgid / NXCD; wgid = (xcd < r ? xcd * (q + 1) : r * (q + 1) + (xcd - r) * q) + off; }
        const int nig = WGM * nN, gid = wgid / nig, fm = gid * WGM, gsz = (nM - fm) < WGM ? (nM - fm) : WGM;
        u.pm = fm + ((wgid % nig) % gsz); u.pn = (wgid % nig) / gsz; u.k0 = 0; u.nt = 0; u.part = -1; return true;
    }
    __device__ __forceinline__ void a_ready(const Unit&) const {}
    __device__ __forceinline__ void done(const Unit&) const {}
};
struct SplitOrder {
    static constexpr int NMF = 64, NN = 8, PARTS = 8, NFULL = NMF * NN;
    int nsplit, ntK, G, c;
    __host__ __device__ void init(int Msplit, int K, int G_, int c_) { nsplit = (Msplit / BM) * NN * PARTS; ntK = K / BK; G = G_; c = c_; }
    __host__ __device__ bool next(int i, Unit& u) const {
        const int L = i * G + c, p = L - NFULL; const bool fullu = L < NFULL;
        const int wgid = (L % NXCD) * (NFULL / NXCD) + L / NXCD, nig = WGM * NN, fm = (wgid / nig) * WGM;
        const int q = p & 7, cu = p >> 3, h = ntK >> 1, ks = ((h * q) >> 3) << 1, ke = ((h * (q + 1)) >> 3) << 1;
        u.pm = fullu ? fm + ((wgid % nig) % WGM) : NMF + (cu >> 3);
        u.pn = fullu ? (wgid % nig) / WGM : (cu & 7);
        u.k0 = fullu ? 0 : ks; u.nt = fullu ? 0 : ke - ks; u.part = fullu ? -1 : q;
        return fullu || p < nsplit;
    }
    __device__ __forceinline__ void a_ready(const Unit&) const {}
    __device__ __forceinline__ void done(const Unit&) const {}
};
__device__ __forceinline__ unsigned cvt_pk_bf16(float lo, float hi) { unsigned r; asm volatile("v_cvt_pk_bf16_f32 %0, %1, %2" : "=v"(r) : "v"(lo), "v"(hi)); return r; }
template <class Epi, class Sched, bool ALIGN_EPI = false, bool SP2 = false>
__device__ __forceinline__ void gemm_phase(PG8_LAS unsigned char* lds, const Gemm g, const Sched& S, const Epi& E) {
    int tid_ = threadIdx.x; asm volatile("" : "+v"(tid_));
    const int tid = tid_, wid = __builtin_amdgcn_readfirstlane(tid >> 6), lane = tid & 63, wr = wid >> 2, wc = wid & 3, fr = lane & 15, fq = lane >> 4;
    const int K = g.K, nt = K / BK;
    unsigned voffA[2], voffB[2];
#pragma unroll
    for (int i = 0; i < 2; ++i) { int R, C; stage_rc(tid * 16 + i * 8192, R, C); const int Rb = Epi::PERM ? ((R & ~31) + perm32(R & 31)) : R;
        voffA[i] = (unsigned)(R * K + C) * 2u; voffB[i] = (unsigned)(Rb * K + C) * 2u; }
    const unsigned kstep = BK * 2;
    const unsigned hstep = (unsigned)HALF * K * 2;
    const unsigned tstep = 2 * hstep;
    const unsigned ldsw = (unsigned)wid * 1024u;
    const int aoff = lds_byte(wr * 64 + fr, fq * 8), boff = lds_byte(wc * 32 + fr, fq * 8);
#define PG8_SA(b, h) (((b) * 2 + (h)) * HTB)
#define PG8_SB(b, h) ((4 + (b) * 2 + (h)) * HTB)
#define PG8_STAGE(bufoff, gbase, voff) do { _Pragma("unroll") for (int _i = 0; _i < 2; ++_i) \
        __builtin_amdgcn_global_load_lds((const unsigned*)((const char*)(gbase) + (voff)[_i]), (PG8_LAS unsigned*)(lds + (bufoff) + ldsw + _i * 8192), 16, 0, 0); } while (0)
#define PG8_LDA(dst, b, h) do { _Pragma("unroll") for (int m = 0; m < 4; ++m) _Pragma("unroll") for (int k = 0; k < 2; ++k) dst[m][k] = *(const PG8_LAS bf16x8*)(lds + PG8_SA(b, h) + aoff + m * 2048 + k * 1024); } while (0)
#define PG8_LDB(dst, b, h) do { _Pragma("unroll") for (int n = 0; n < 2; ++n) _Pragma("unroll") for (int k = 0; k < 2; ++k) dst[n][k] = *(const PG8_LAS bf16x8*)(lds + PG8_SB(b, h) + boff + n * 2048 + k * 1024); } while (0)
#define PG8_MMA(ai, bj, At, Bt) do { __builtin_amdgcn_s_setprio(1); _Pragma("unroll") for (int m = 0; m < 4; ++m) _Pragma("unroll") for (int n = 0; n < 2; ++n) _Pragma("unroll") for (int k = 0; k < 2; ++k) \
        acc[ai][bj][m][n] = __builtin_amdgcn_mfma_f32_16x16x32_bf16(Bt[n][k], At[m][k], acc[ai][bj][m][n], 0, 0, 0); __builtin_amdgcn_s_setprio(0); } while (0)
#define PG8_WAIT_V(n) asm volatile("s_waitcnt vmcnt(" #n ")" ::: "memory")
#define PG8_WAIT_L(n) asm volatile("s_waitcnt lgkmcnt(" #n ")" ::: "memory")
#define PG8_BAR __builtin_amdgcn_s_barrier()
#define PG8_SCHED __builtin_amdgcn_sched_barrier(0)
    Unit cur, nxt; int ui = 0;
    if (!S.next(0, cur)) return;
    f32x4 acc[2][2][4][2];
#pragma unroll
    for (int a = 0; a < 2; ++a)
#pragma unroll
        for (int b = 0; b < 2; ++b)
#pragma unroll
            for (int m = 0; m < 4; ++m)
#pragma unroll
                for (int n = 0; n < 2; ++n) acc[a][b][m][n] = (f32x4){0.f, 0.f, 0.f, 0.f};
    bf16x8 At[4][2], B0[2][2], B1[2][2];
    unsigned cA = (unsigned)cur.pm * tstep + (unsigned)cur.k0 * kstep, cB = (unsigned)cur.pn * tstep + (unsigned)cur.k0 * kstep;
    S.a_ready(cur);
    if constexpr (SP2) {
        PG8_STAGE(PG8_SB(0, 0), (const char*)g.Bt + (size_t)(cB), voffB); PG8_STAGE(PG8_SB(0, 1), (const char*)g.Bt + (size_t)(cB + hstep), voffB); PG8_STAGE(PG8_SA(0, 0), (const char*)g.A + (size_t)(cA), voffA); PG8_STAGE(PG8_SA(0, 1), (const char*)g.A + (size_t)(cA + hstep), voffA);
        if (wr == 1) PG8_BAR;
        PG8_WAIT_V(2); PG8_BAR;
        PG8_STAGE(PG8_SB(1, 0), (const char*)g.Bt + (size_t)(cB + kstep), voffB); PG8_STAGE(PG8_SA(1, 0), (const char*)g.A + (size_t)(cA + kstep), voffA); PG8_STAGE(PG8_SB(1, 1), (const char*)g.Bt + (size_t)(cB + hstep + kstep), voffB);
        PG8_WAIT_V(6); PG8_BAR;
    } else {
        PG8_STAGE(PG8_SB(0, 0), (const char*)g.Bt + (size_t)(cB), voffB); PG8_STAGE(PG8_SA(0, 0), (const char*)g.A + (size_t)(cA), voffA); PG8_STAGE(PG8_SB(0, 1), (const char*)g.Bt + (size_t)(cB + hstep), voffB); PG8_STAGE(PG8_SA(0, 1), (const char*)g.A + (size_t)(cA + hstep), voffA);
        if (wr == 1) PG8_BAR;
        PG8_WAIT_V(4); PG8_BAR;
        PG8_STAGE(PG8_SB(1, 0), (const char*)g.Bt + (size_t)(cB + kstep), voffB); PG8_STAGE(PG8_SA(1, 0), (const char*)g.A + (size_t)(cA + kstep), voffA); PG8_STAGE(PG8_SB(1, 1), (const char*)g.Bt + (size_t)(cB + hstep + kstep), voffB);
        PG8_WAIT_V(6); PG8_BAR;
    }
    for (;;) {
        const bool has_next = S.next(ui + 1, nxt);
        const unsigned nA = has_next ? (unsigned)nxt.pm * tstep + (unsigned)nxt.k0 * kstep : cA, nB = has_next ? (unsigned)nxt.pn * tstep + (unsigned)nxt.k0 * kstep : cB;
        const int unt = cur.nt ? cur.nt : nt;
        for (int t = 0; t < unt; t += 2) {
            const bool last = (t == unt - 2);
            const unsigned a1 = cA + (unsigned)(t + 1) * kstep;
            const unsigned a2 = last ? nA : cA + (unsigned)(t + 2) * kstep, b2 = last ? nB : cB + (unsigned)(t + 2) * kstep;
            const unsigned a3 = a2 + kstep, b3 = b2 + kstep;
            if (last && has_next) S.a_ready(nxt);
            if constexpr (SP2) {
            PG8_LDB(B0, 0, 0); PG8_LDB(B1, 0, 1); PG8_SCHED; PG8_LDA(At, 0, 0); PG8_STAGE(PG8_SA(1, 1), (const char*)g.A + (size_t)(a1 + hstep), voffA);
            PG8_WAIT_V(8); PG8_WAIT_L(0); PG8_BAR; PG8_MMA(0, 0, At, B0); PG8_MMA(0, 1, At, B1); PG8_BAR; PG8_SCHED;
            PG8_LDA(At, 0, 1); PG8_STAGE(PG8_SB(0, 0), (const char*)g.Bt + (size_t)(b2), voffB); PG8_STAGE(PG8_SB(0, 1), (const char*)g.Bt + (size_t)(b2 + hstep), voffB); PG8_STAGE(PG8_SA(0, 0), (const char*)g.A + (size_t)(a2), voffA);
            PG8_WAIT_V(8); PG8_WAIT_L(0); PG8_BAR; PG8_MMA(1, 0, At, B0); PG8_MMA(1, 1, At, B1); PG8_BAR; PG8_SCHED;
            PG8_LDB(B0, 1, 0); PG8_LDB(B1, 1, 1); PG8_SCHED; PG8_LDA(At, 1, 0); PG8_STAGE(PG8_SA(0, 1), (const char*)g.A + (size_t)(a2 + hstep), voffA);
            PG8_WAIT_V(8); PG8_WAIT_L(0); PG8_BAR; PG8_MMA(0, 0, At, B0); PG8_MMA(0, 1, At, B1); PG8_BAR; PG8_SCHED;
            PG8_LDA(At, 1, 1); PG8_STAGE(PG8_SB(1, 0), (const char*)g.Bt + (size_t)(b3), voffB); PG8_STAGE(PG8_SB(1, 1), (const char*)g.Bt + (size_t)(b3 + hstep), voffB); PG8_STAGE(PG8_SA(1, 0), (const char*)g.A + (size_t)(a3), voffA);
            PG8_WAIT_V(8); PG8_WAIT_L(0); PG8_BAR; PG8_MMA(1, 0, At, B0); PG8_MMA(1, 1, At, B1); PG8_BAR; PG8_SCHED;
            } else {
            PG8_LDB(B0, 0, 0); PG8_SCHED; PG8_LDA(At, 0, 0); PG8_STAGE(PG8_SA(1, 1), (const char*)g.A + (size_t)(a1 + hstep), voffA);
            PG8_WAIT_L(8); PG8_BAR; PG8_WAIT_L(0); PG8_MMA(0, 0, At, B0); PG8_BAR; PG8_SCHED;
            PG8_LDB(B1, 0, 1); PG8_STAGE(PG8_SB(0, 0), (const char*)g.Bt + (size_t)(b2), voffB);
            PG8_BAR; PG8_WAIT_L(0); PG8_MMA(0, 1, At, B1); PG8_BAR;
            PG8_LDA(At, 0, 1); PG8_STAGE(PG8_SA(0, 0), (const char*)g.A + (size_t)(a2), voffA);
            PG8_BAR; PG8_WAIT_L(0); PG8_MMA(1, 0, At, B0); PG8_BAR; PG8_SCHED;
            PG8_STAGE(PG8_SB(0, 1), (const char*)g.Bt + (size_t)(b2 + hstep), voffB);
            PG8_WAIT_V(6); PG8_BAR; PG8_MMA(1, 1, At, B1); PG8_BAR;
            PG8_LDB(B0, 1, 0); PG8_SCHED; PG8_LDA(At, 1, 0); PG8_STAGE(PG8_SA(0, 1), (const char*)g.A + (size_t)(a2 + hstep), voffA);
            PG8_WAIT_L(8); PG8_BAR; PG8_WAIT_L(0); PG8_MMA(0, 0, At, B0); PG8_BAR; PG8_SCHED;
            PG8_LDB(B1, 1, 1); PG8_STAGE(PG8_SB(1, 0), (const char*)g.Bt + (size_t)(b3), voffB);
            PG8_BAR; PG8_WAIT_L(0); PG8_MMA(0, 1, At, B1); PG8_BAR;
            PG8_LDA(At, 1, 1); PG8_STAGE(PG8_SA(1, 0), (const char*)g.A + (size_t)(a3), voffA);
            PG8_BAR; PG8_WAIT_L(0); PG8_MMA(1, 0, At, B0); PG8_BAR; PG8_SCHED;
            PG8_STAGE(PG8_SB(1, 1), (const char*)g.Bt + (size_t)(b3 + hstep), voffB);
            PG8_WAIT_V(6); PG8_BAR; PG8_MMA(1, 1, At, B1); PG8_BAR;
            }
        }
        if constexpr (ALIGN_EPI) { if (wr == 0) PG8_BAR; }
        if constexpr (!Epi::AFTER_DRAIN) { int t_ = threadIdx.x; asm volatile("" : "+v"(t_)); const int l_ = t_ & 63, w_ = __builtin_amdgcn_readfirstlane(t_ >> 6);
            E(acc, cur, w_ >> 2, w_ & 3, l_ & 15, l_ >> 4); S.done(cur); }
        if (!has_next) break;
#pragma unroll
        for (int a = 0; a < 2; ++a)
#pragma unroll
            for (int b = 0; b < 2; ++b)
#pragma unroll
                for (int m = 0; m < 4; ++m)
#pragma unroll
                    for (int n = 0; n < 2; ++n) acc[a][b][m][n] = (f32x4){0.f, 0.f, 0.f, 0.f};
        cur = nxt; cA = nA; cB = nB; ++ui;
        if constexpr (ALIGN_EPI) { if (wr == 1) PG8_BAR; }
    }
    PG8_WAIT_V(0);
    if constexpr (!ALIGN_EPI) { if (wr == 0) PG8_BAR; }
    PG8_BAR;
    if constexpr (Epi::AFTER_DRAIN) { E.fused(acc, cur, wr, wc, fr, fq, lds, wid, lane); S.done(cur); }
#undef PG8_SA
#undef PG8_SB
#undef PG8_STAGE
#undef PG8_LDA
#undef PG8_LDB
#undef PG8_MMA
#undef PG8_WAIT_V
#undef PG8_WAIT_L
#undef PG8_BAR
#undef PG8_SCHED
}
}

#define GAS __attribute__((address_space(1)))
typedef unsigned short bf16;
typedef float f32x4 __attribute__((ext_vector_type(4)));
typedef unsigned v4u __attribute__((ext_vector_type(4)));
typedef unsigned v2u __attribute__((ext_vector_type(2)));
constexpr int D = 2048, NB = 4, SEQ = 4096, CTXL = 256, DFF = 5504, NMOD = 9;
constexpr int TL = NB * SEQ, TC = NB * CTXL, TT = TL + TC;
constexpr int MIXH = 1024;
constexpr int EV_COLS = 7216, EV_PAD = 7424, OD_COLS = 5120;
constexpr int NWAVES = 8, NTHR = 512;
constexpr float EPS = 1e-6f;

constexpr size_t MiB = 1u << 20;
constexpr size_t WS_CTL = 0, CTL_ZERO_BYTES = 64 * 1024;
constexpr size_t WS_MOD = 1 * MiB;
constexpr size_t WS_MODP = 2 * MiB;
constexpr int MOD_KC = 16;
constexpr size_t WS_WGU = 16 * MiB;
constexpr size_t SZ_WGU = (size_t)11008 * 2048 * 2;
constexpr size_t WS_WD = WS_WGU + 4 * SZ_WGU;
constexpr size_t SZ_WD = (size_t)2048 * 5504 * 2;
constexpr size_t WS_WIN_EV = WS_WD + 4 * SZ_WD;
constexpr size_t WS_WOUT_EV = WS_WIN_EV + (size_t)EV_PAD * 2048 * 2;
constexpr size_t WS_WIN_OD = WS_WOUT_EV + (size_t)2048 * 2048 * 2;
constexpr size_t WS_WOUT_OD = WS_WIN_OD + (size_t)OD_COLS * 2048 * 2;
constexpr size_t WS_WGLU = WS_WOUT_OD + (size_t)2048 * 2048 * 2;
constexpr size_t WS_XC = WS_WGLU + (size_t)1024 * 1024 * 2;
constexpr size_t WS_HB = WS_XC + (size_t)TC * D * 4;
constexpr size_t WS_R = WS_HB + (size_t)TT * D * 2;
constexpr size_t WS_HID = WS_R;
constexpr size_t WS_Y = WS_R + 183 * MiB;
constexpr size_t WS_S = WS_R;
constexpr size_t WS_GT = WS_R + 247 * MiB;
constexpr size_t WS_GB = WS_R + 264 * MiB;
constexpr size_t WS_O = WS_R + 298 * MiB;
constexpr size_t SZ_O = (size_t)TT * 1024 * 4;
constexpr size_t WS_QK2 = WS_O + 4 * SZ_O;
constexpr size_t WS_GP = WS_QK2 + (size_t)TT * 2048 * 2;
constexpr size_t WS_QKS = WS_GP + (size_t)TT * 8 * 4 * 4;
constexpr size_t WS_VEC = WS_QKS + (size_t)2 * TT * 1024 * 2;
constexpr size_t WS_GPK = WS_VEC + (size_t)NB * 4 * 2 * 68 * 384 * 4;
constexpr size_t WS_END = WS_GPK + (size_t)NB * 4 * 2 * 68 * 256 * 4;
constexpr size_t WS_YCP = WS_R + 320 * MiB;
constexpr int YPARTS = 8;
static_assert(WS_YCP >= WS_Y + (size_t)TT * D * 4 && WS_YCP + (size_t)YPARTS * TC * D * 4 <= WS_O + 4 * SZ_O, "ws map");
static_assert(WS_HID + (size_t)TT * DFF * 2 <= WS_Y && WS_S + (size_t)TT * EV_PAD * 2 <= WS_GT && WS_GT + (size_t)TT * 256 * 4 <= WS_GB && WS_GB + (size_t)TT * 1024 * 2 <= WS_O, "ws map");
static_assert(WS_Y + (size_t)TT * D * 4 <= WS_END, "ws map");

constexpr int LDS_BYTES = 156 * 1024;
constexpr int MISC_OFF = LDS_BYTES - 64;

struct Args { const float* in[34]; float* out; unsigned char* ws; };
#define ARG(k) (a.in[opaque_idx(k)])
__device__ __forceinline__ unsigned char* wsp(unsigned char* w, size_t off) { asm volatile("" : "+s"(w)); return w + off; }
__device__ __forceinline__ int opaque_idx(int k) { asm volatile("" : "+s"(k)); return k; }

__device__ __forceinline__ unsigned f2bf(float f) { unsigned u = __float_as_uint(f); u += 0x7FFFu + ((u >> 16) & 1u); return u >> 16; }
typedef __bf16 bf16x2_t __attribute__((ext_vector_type(2)));
typedef float f32x2_t __attribute__((ext_vector_type(2)));
__device__ __forceinline__ unsigned pk2(float lo, float hi) { const f32x2_t v = {lo, hi}; const bf16x2_t b = __builtin_convertvector(v, bf16x2_t); return __builtin_bit_cast(unsigned, b); }
__device__ __forceinline__ float bf2f(unsigned short b) { return __uint_as_float(((unsigned)b) << 16); }
__device__ __forceinline__ float wave_sum(float v) {
#pragma unroll
    for (int o = 1; o < 64; o <<= 1) v += __shfl_xor(v, o);
    return v;
}
__device__ __forceinline__ float fast_silu(float g) { return g * __builtin_amdgcn_rcpf(1.0f + __expf(-g)); }
__device__ __forceinline__ float fast_sigmoid(float g) { return __builtin_amdgcn_rcpf(1.0f + __expf(-g)); }

struct TJob { const float* src; bf16* dst; int K, N, map, tstart; };
constexpr int NJOBS = 17;
__device__ __forceinline__ int tj_tiles(int K, int N) { return (K / 64) * ((N + 31) / 32); }
__device__ __forceinline__ void transpose_tile(const TJob& j, int tl, int lane) {
    const int nblk = (j.N + 31) / 32, kb = tl / nblk, nb = tl % nblk, k0 = 64 * kb, n0 = 32 * nb;
    const int kb8 = lane >> 3, nb4 = lane & 7, n = n0 + 4 * nb4;
    int drow0;
    if (j.map == 0) drow0 = n0;
    else if (j.map == 1) drow0 = (n0 / 128) * 256 + (n0 % 128);
    else if (j.map == 2) drow0 = (n0 / 128) * 256 + (n0 % 128) + 128;
    else drow0 = (nb < 96) ? n0 : (nb == 96 ? 7168 : (nb < 225 ? n0 - 32 : 7200));
    if (n < j.N) {
        const float* s = j.src + (size_t)(k0 + 8 * kb8) * j.N + n;
        f32x4 v[8];
#pragma unroll
        for (int i = 0; i < 8; ++i) v[i] = *(const f32x4*)(s + (size_t)i * j.N);
        bf16* d = j.dst + (size_t)(drow0 + 4 * nb4) * j.K + k0 + 8 * kb8;
#pragma unroll
        for (int e = 0; e < 4; ++e) { v4u o; o.x = pk2(v[0][e], v[1][e]); o.y = pk2(v[2][e], v[3][e]); o.z = pk2(v[4][e], v[5][e]); o.w = pk2(v[6][e], v[7][e]);
            *(v4u*)(d + (size_t)e * j.K) = o; }
    }
}

struct NormP {
    const float* xin_lat; const float* xin_ctx; float* xout_lat; float* xout_ctx; const float* y; bf16* h;
    int rows_end; int has_y, has_h; float w;
    const float* y_ctx;
    int lp, sp;
    int ln, sn;
};
__device__ __forceinline__ void norm_phase(const NormP& p, const float* mod, const float* norm_pre, const float* norm_post, LAS unsigned char* lds, int gw, int ngw, int tid, int lane) {
    { int t2 = threadIdx.x; asm volatile("" : "+v"(t2)); tid = t2; lane = t2 & 63; gw = blockIdx.x * NWAVES + __builtin_amdgcn_readfirstlane(t2 >> 6); }
    LAS float* TA = (LAS float*)lds; LAS float* TB = TA + 5 * D; LAS float* TCc = TB + 5 * D;
    for (int i = tid; i < 5 * D; i += NTHR) { const int var = i >> 11, j = i & (D - 1);
        if (p.has_y) TA[i] = p.w * mod[((size_t)p.lp * 5 + var) * (NMOD * D) + (3 * p.sp + 2) * D + j] * norm_post[(p.lp * 3 + p.sp) * D + j];
        if (p.has_h) { TB[i] = norm_pre[(p.ln * 3 + p.sn) * D + j] * (1.0f + mod[((size_t)p.ln * 5 + var) * (NMOD * D) + (3 * p.sn + 1) * D + j]);
                       TCc[i] = mod[((size_t)p.ln * 5 + var) * (NMOD * D) + (3 * p.sn) * D + j]; } }
    __syncthreads();
    for (int r = gw; r < p.rows_end; r += ngw) {
        const int var = r < TL ? (r >> 12) : 4;
        const float* xi = r < TL ? p.xin_lat + (size_t)r * D : p.xin_ctx + (size_t)(r - TL) * D;
        float* xo = r < TL ? p.xout_lat + (size_t)r * D : p.xout_ctx + (size_t)(r - TL) * D;
        f32x4 xv[8];
#pragma unroll
        for (int j = 0; j < 8; ++j) xv[j] = *(const f32x4*)(xi + 4 * lane + 256 * j);
        if (p.has_y) {
            const bool yc = (r >= TL) && p.y_ctx; const float* yr = yc ? p.y_ctx + (size_t)(r - TL) * D : p.y + (size_t)r * D; f32x4 yv[8]; float s = 0.f;
#pragma unroll
            for (int j = 0; j < 8; ++j) yv[j] = *(const f32x4*)(yr + 4 * lane + 256 * j);
            if (yc) { for (int q = 1; q < YPARTS; ++q) {
#pragma unroll
                for (int j = 0; j < 8; ++j) yv[j] += *(const f32x4*)(yr + (size_t)q * TC * D + 4 * lane + 256 * j); } }
#pragma unroll
            for (int j = 0; j < 8; ++j) { s += (yv[j].x * yv[j].x + yv[j].y * yv[j].y) + (yv[j].z * yv[j].z + yv[j].w * yv[j].w); }
            const float rstd = 1.0f / sqrtf(wave_sum(s) * (1.0f / D) + EPS);
#pragma unroll
            for (int j = 0; j < 8; ++j) { const f32x4 a = *(const LAS f32x4*)(TA + var * D + 4 * lane + 256 * j); xv[j] = xv[j] + a * (yv[j] * rstd); *(f32x4*)(xo + 4 * lane + 256 * j) = xv[j]; }
        }
        if (p.has_h) {
            float s = 0.f;
#pragma unroll
            for (int j = 0; j < 8; ++j) s += (xv[j].x * xv[j].x + xv[j].y * xv[j].y) + (xv[j].z * xv[j].z + xv[j].w * xv[j].w);
            const float rstd = 1.0f / sqrtf(wave_sum(s) * (1.0f / D) + EPS);
            bf16* hr = p.h + (size_t)r * D;
#pragma unroll
            for (int j = 0; j < 8; ++j) { const f32x4 b = *(const LAS f32x4*)(TB + var * D + 4 * lane + 256 * j), c = *(const LAS f32x4*)(TCc + var * D + 4 * lane + 256 * j);
                const f32x4 o = xv[j] * rstd * b + c; v2u w; w.x = pk2(o.x, o.y); w.y = pk2(o.z, o.w); *(v2u*)(hr + 4 * lane + 256 * j) = w; }
        }
    }
    __syncthreads();
}

struct EpiSwiGLU {
    static constexpr bool PERM = true, AFTER_DRAIN = false;
    bf16* O; int ldc;
    __device__ __forceinline__ void operator()(const pg8::f32x4 (&acc)[2][2][4][2], const pg8::Unit& u, int wr, int wc, int fr, int fq) const {
        const int row0 = u.pm * 256 + wr * 64 + fr, col0 = u.pn * 128 + wc * 32 + 8 * fq;
#pragma unroll
        for (int ai = 0; ai < 2; ++ai)
#pragma unroll
            for (int m = 0; m < 4; ++m) { bf16* rowp = O + (size_t)(row0 + ai * 128 + m * 16) * ldc + col0;
                const pg8::f32x4 g0 = acc[ai][0][m][0], g1 = acc[ai][0][m][1], u0 = acc[ai][1][m][0], u1 = acc[ai][1][m][1];
                v4u w; w.x = pk2(fast_silu(g0[0]) * u0[0], fast_silu(g0[1]) * u0[1]); w.y = pk2(fast_silu(g0[2]) * u0[2], fast_silu(g0[3]) * u0[3]);
                w.z = pk2(fast_silu(g1[0]) * u1[0], fast_silu(g1[1]) * u1[1]); w.w = pk2(fast_silu(g1[2]) * u1[2], fast_silu(g1[3]) * u1[3]);
                *(v4u*)rowp = w; }
    }
};
struct EpiF32 {
    static constexpr bool PERM = false, AFTER_DRAIN = false;
    float* C; float* Cs;
    static constexpr int ldc = D;
    __device__ __forceinline__ void operator()(const pg8::f32x4 (&acc)[2][2][4][2], const pg8::Unit& u, int wr, int wc, int fr, int fq) const {
        const int row0 = u.pm * 256 + wr * 64 + fr, col0 = u.pn * 256 + wc * 32 + 4 * fq;
        float* base = u.part >= 0 ? Cs + ((size_t)u.part * TC - (size_t)TL) * D : C;
#pragma unroll
        for (int ai = 0; ai < 2; ++ai)
#pragma unroll
            for (int m = 0; m < 4; ++m) { float* rowp = base + (size_t)(row0 + ai * 128 + m * 16) * ldc + col0;
#pragma unroll
                for (int bj = 0; bj < 2; ++bj)
#pragma unroll
                    for (int n = 0; n < 2; ++n) *(pg8::f32x4*)(rowp + bj * 128 + n * 16) = acc[ai][bj][m][n]; }
    }
};
struct EpiS {
    static constexpr bool PERM = true, AFTER_DRAIN = false;
    bf16* S; int ldc; float* GT; int gt_pn;
    __device__ __forceinline__ void operator()(const pg8::f32x4 (&acc)[2][2][4][2], const pg8::Unit& u, int wr, int wc, int fr, int fq) const {
        const int row0 = u.pm * 256 + wr * 64 + fr;
        if (u.pn == gt_pn) {
            if (wc < 2) {
#pragma unroll
                for (int ai = 0; ai < 2; ++ai)
#pragma unroll
                    for (int m = 0; m < 4; ++m) { float* rowp = GT + (size_t)(row0 + ai * 128 + m * 16) * 256 + wc * 32 + 8 * fq;
                        *(pg8::f32x4*)rowp = acc[ai][0][m][0]; *(pg8::f32x4*)(rowp + 4) = acc[ai][0][m][1]; }
            }
        } else {
            const int col0 = u.pn * 256 + wc * 32 + 8 * fq;
#pragma unroll
            for (int ai = 0; ai < 2; ++ai)
#pragma unroll
                for (int m = 0; m < 4; ++m) { bf16* rowp = S + (size_t)(row0 + ai * 128 + m * 16) * ldc + col0;
#pragma unroll
                    for (int bj = 0; bj < 2; ++bj) { const pg8::f32x4 v0 = acc[ai][bj][m][0], v1 = acc[ai][bj][m][1];
                        v4u w; w.x = pk2(v0[0], v0[1]); w.y = pk2(v0[2], v0[3]); w.z = pk2(v1[0], v1[1]); w.w = pk2(v1[2], v1[3]);
                        *(v4u*)(rowp + bj * 128) = w; } }
        }
    }
};

#define DEV __device__ __forceinline__
#define LP(T) LAS T*
#define SYNC() __syncthreads()
typedef short v8s __attribute__((ext_vector_type(8)));
typedef float v4f __attribute__((ext_vector_type(4)));
#define MFMA16(x, y, c) __builtin_amdgcn_mfma_f32_16x16x32_bf16((x), (y), (c), 0, 0, 0)
#define SHX(v, m) __shfl_xor((v), (m))
#define SHUP(v, d) __shfl_up((v), (d))
#define SHIDX(v, l) __shfl((v), (l))
#define EXPF(x) __expf(x)
#define LOGF(x) __logf(x)
#define RCPF(x) __builtin_amdgcn_rcpf(x)
#define RSQRTF(x) (1.0f / sqrtf(x))
#define PK2(lo, hi) pk2((lo), (hi))
#define F2BF(x) ((unsigned short)f2bf(x))
#define WAVE_SYNC() asm volatile("s_waitcnt lgkmcnt(0)" ::: "memory")
typedef short v4s __attribute__((ext_vector_type(4)));
#define LDS_TR16(p) __builtin_amdgcn_ds_read_tr16_b64_v4i16((LAS v4s*)(p))
#define RDLANE(v, l) __int_as_float(__builtin_amdgcn_readlane(__float_as_int(v), (l)))

DEV int seq_row(int b, int seg, int np, int cm) {
    if (!seg) return TL + b * CTXL + np;
    const int n = cm ? ((np & 63) * 64 + (np >> 6)) : np;
    return b * SEQ + n;
}
DEV int tok_row(int b, int seg, int pos, int dir, int cm) {
    const int len = seg ? SEQ : CTXL;
    return seq_row(b, seg, dir ? len - 1 - pos : pos, cm);
}
DEV float bflo(unsigned u) { return __uint_as_float(u << 16); }
DEV float bfhi(unsigned u) { return __uint_as_float(u & 0xffff0000u); }
DEV float logsigmoidf(float z) { return fminf(z, 0.f) - LOGF(1.0f + EXPF(-fabsf(z))); }
DEV v4f tile_mma(v4f acc, LP(const unsigned char) A, int sa, int m0, LP(const unsigned char) B, int sb, int n0, int ksteps, int fr, int fq) {
    LP(const unsigned char) ap = A + (m0 + fr) * sa + fq * 16;
    LP(const unsigned char) bp = B + (n0 + fr) * sb + fq * 16;
    for (int k = 0; k < ksteps; ++k) {
        const v8s af = *(LP(const v8s))(ap + k * 64);
        const v8s bf = *(LP(const v8s))(bp + k * 64);
        acc = MFMA16(bf, af, acc);
    }
    return acc;
}
DEV v8s tr_frag(LP(const unsigned char) T, int st, int k0, int n0, int lane) {
    const int l16 = lane & 15, fq = lane >> 4;
    LP(const unsigned char) p = T + (k0 + 8 * fq + (l16 >> 2)) * st + (n0 + 4 * (l16 & 3)) * 2;
    const v4s a = LDS_TR16(p), b = LDS_TR16(p + 4 * st);
    return (v8s){a.x, a.y, a.z, a.w, b.x, b.y, b.z, b.w};
}
DEV v4f tile_mma_nt(v4f acc, LP(const unsigned char) A, int sa, int m0, LP(const unsigned char) Bt, int sb, int n0, int ksteps, int lane) {
    const int fr = lane & 15, fq = lane >> 4;
    for (int k = 0; k < ksteps; ++k) { const v8s af = *(LP(const v8s))(A + (m0 + fr) * sa + fq * 16 + k * 64); const v8s bf = tr_frag(Bt, sb, 32 * k, n0, lane); acc = MFMA16(bf, af, acc); }
    return acc;
}
DEV v4f tile_mma_tt(v4f acc, LP(const unsigned char) At, int sa, int m0, LP(const unsigned char) Bt, int sb, int n0, int ksteps, int lane) {
    for (int k = 0; k < ksteps; ++k) { const v8s af = tr_frag(At, sa, 32 * k, m0, lane); const v8s bf = tr_frag(Bt, sb, 32 * k, n0, lane); acc = MFMA16(bf, af, acc); }
    return acc;
}
constexpr int ST128 = 272, ST64 = 144, ST256 = 528, STV = 80;

constexpr int MIX_UNITS = NB * 32;
constexpr int GLA_TASKS = NB * 4 * 2 * (CTXL / 64 + SEQ / 64);
DEV void gla_prep_task(int task, const bf16* S, const float* GT, const float* wg_all, const float* bg_all, bf16* QKS, float* VEC, LP(unsigned char) lds, int tid) {
    constexpr int NCHUNK = CTXL / 64 + SEQ / 64;
    const int cidx = task % NCHUNK, r1 = task / NCHUNK, dir = r1 & 1, h = (r1 >> 1) & 3, b = r1 >> 3;
    const int seg = cidx >= CTXL / 64, ci = seg ? cidx - CTXL / 64 : cidx;
    LP(float) LA = (LP(float))lds; LP(float) SEG = (LP(float))(lds + 32768); LP(float) LR = (LP(float))(lds + 34816); LP(float) WG = (LP(float))(lds + 38912); LP(float) BG = (LP(float))(lds + 47104);
    const int j = tid >> 3, c8 = tid & 7, dc = c8 * 16;
    const float qscale = 0.08838834764831845f;
    const int row = tok_row(b, seg, ci * 64 + j, dir, 0);
    const bf16* sr = S + (size_t)row * EV_PAD;
    const v4u q0 = *(const v4u*)(sr + h * 128 + dc), q1 = *(const v4u*)(sr + h * 128 + dc + 8);
    const v4u k0 = *(const v4u*)(sr + 512 + h * 128 + dc), k1 = *(const v4u*)(sr + 512 + h * 128 + dc + 8);
    for (int i = tid; i < 16 * 128; i += NTHR) { const int m = i >> 7, d = i & 127; WG[i] = wg_all[(dir * 16 + m) * 512 + h * 128 + d]; }
    if (tid < 128) BG[tid] = bg_all[dir * 512 + h * 128 + tid];
    if (tid < 256) { const int rr = tok_row(b, seg, ci * 64 + (tid >> 2), dir, 0); *(LP(v4f))(LR + (tid >> 2) * 16 + (tid & 3) * 4) = *(const v4f*)(GT + (size_t)rr * 256 + dir * 16 + (tid & 3) * 4); }
    SYNC();
    {
        float z[16];
#pragma unroll
        for (int i = 0; i < 16; ++i) z[i] = BG[dc + i];
        for (int m = 0; m < 16; ++m) { const float lrm = LR[j * 16 + m];
#pragma unroll
            for (int i4 = 0; i4 < 4; ++i4) { const v4f w = *(LP(const v4f))(WG + m * 128 + dc + 4 * i4);
                z[4 * i4 + 0] += lrm * w.x; z[4 * i4 + 1] += lrm * w.y; z[4 * i4 + 2] += lrm * w.z; z[4 * i4 + 3] += lrm * w.w; } }
#pragma unroll
        for (int i4 = 0; i4 < 4; ++i4) { v4f o; o.x = logsigmoidf(z[4 * i4]) * 0.0625f; o.y = logsigmoidf(z[4 * i4 + 1]) * 0.0625f; o.z = logsigmoidf(z[4 * i4 + 2]) * 0.0625f; o.w = logsigmoidf(z[4 * i4 + 3]) * 0.0625f;
            *(LP(v4f))(LA + j * 128 + dc + 4 * i4) = o; }
    }
    SYNC();
    {
        const int d = tid & 127, sg = tid >> 7; float acc = 0.f;
        for (int jj = 0; jj < 16; ++jj) { acc += LA[(sg * 16 + jj) * 128 + d]; LA[(sg * 16 + jj) * 128 + d] = acc; }
        SEG[sg * 128 + d] = acc;
    }
    SYNC();
    {
        const int sgj = j >> 4;
        bf16* orow = QKS + ((size_t)dir * TT + row) * 1024 + h * 128 + dc;
#pragma unroll 1
        for (int g = 0; g < 2; ++g) {
            const v4u qv = g ? q1 : q0, kv = g ? k1 : k0;
            const unsigned qw[4] = {qv.x, qv.y, qv.z, qv.w}, kw[4] = {kv.x, kv.y, kv.z, kv.w};
            unsigned oqs[4], oks[4];
#pragma unroll
            for (int i2 = 0; i2 < 4; ++i2) {
                float vqs[2], vks[2];
#pragma unroll
                for (int e = 0; e < 2; ++e) {
                    const int d = dc + 8 * g + 2 * i2 + e;
                    const float s0 = SEG[d], s1 = SEG[128 + d], s2 = SEG[256 + d];
                    const float pre = (sgj > 0 ? s0 : 0.f) + (sgj > 1 ? s1 : 0.f) + (sgj > 2 ? s2 : 0.f);
                    const float bv = LA[j * 128 + d] + pre;
                    const float bmid = LA[32 * 128 + d] + s0 + s1;
                    const float q = (e ? bfhi(qw[i2]) : bflo(qw[i2])) * qscale, k = e ? bfhi(kw[i2]) : bflo(kw[i2]);
                    const float e1 = EXPF(bv - bmid);
                    vqs[e] = q * e1; vks[e] = k * RCPF(e1);
                    if (j == 63) { const float bend = bv; float* vp = VEC + (size_t)task * 384 + d; vp[0] = EXPF(bmid); vp[128] = EXPF(bend - bmid); vp[256] = EXPF(bend); }
                }
                oqs[i2] = PK2(vqs[0], vqs[1]); oks[i2] = PK2(vks[0], vks[1]);
            }
            *(v4u*)(orow + 8 * g) = (v4u){oqs[0], oqs[1], oqs[2], oqs[3]};
            *(v4u*)(orow + 512 + 8 * g) = (v4u){oks[0], oks[1], oks[2], oks[3]};
        }
    }
    SYNC();
}

DEV void gla_unit(const bf16* S, const bf16* QKS, const float* VEC, float* O, int unit, LP(unsigned char) lds, int tid) {
    const int lane = tid & 63, wave = tid >> 6, fr = lane & 15, fq = lane >> 4;
    const int vs = unit & 3, dir = (unit >> 2) & 1, h = (unit >> 3) & 3, b = unit >> 5;
    LP(unsigned char) QS = lds; LP(unsigned char) KS = lds + 17408; LP(unsigned char) QB = lds + 34816;
    LP(unsigned char) VV = lds + 52224; LP(unsigned char) PM = lds + 61440; LP(unsigned char) STT = lds + 70656;
    LP(float) DV = (LP(float))(lds + 88064);
    for (int i = tid; i < 64 * ST128 / 4; i += NTHR) ((LP(unsigned))STT)[i] = 0u;
    v4f sacc[4];
#pragma unroll
    for (int i = 0; i < 4; ++i) sacc[i] = (v4f){0.f, 0.f, 0.f, 0.f};
    const int j = tid >> 3, c8 = tid & 7, dc = c8 * 16;
    const int tt = wave >> 1, vt0 = (wave & 1) * 2;
    const int svt = wave & 3, sdt0 = (wave >> 2) * 4;
    float* Od = O + (size_t)dir * TT * 1024;
    constexpr int NCHUNK = CTXL / 64 + SEQ / 64;
    const int task0 = ((b * 4 + h) * 2 + dir) * NCHUNK;
    v4u q0, q1, k0, k1, vv; v4f em[4]; v4f dvv = (v4f){0.f, 0.f, 0.f, 0.f};
#define GLA_ISSUE(cx) do { const int seg_ = (cx) >= CTXL / 64, ci_ = seg_ ? (cx) - CTXL / 64 : (cx); \
        const int row_ = tok_row(b, seg_, ci_ * 64 + j, dir, 0); \
        const bf16* qr_ = QKS + ((size_t)dir * TT + row_) * 1024 + h * 128 + dc; \
        q0 = *(const v4u*)(qr_); q1 = *(const v4u*)(qr_ + 8); k0 = *(const v4u*)(qr_ + 512); k1 = *(const v4u*)(qr_ + 520); \
        vv = *(const v4u*)(S + (size_t)row_ * EV_PAD + 1024 + h * 256 + vs * 64 + c8 * 8); \
        const float* vp_ = VEC + (size_t)(task0 + (cx)) * 384; \
        _Pragma("unroll") for (int i_ = 0; i_ < 4; ++i_) em[i_] = *(const v4f*)(vp_ + dc + 4 * i_); \
        if (tid < 64) dvv = *(const v4f*)(vp_ + 128 + tid * 4); } while (0)
    GLA_ISSUE(0);
    SYNC();
    for (int cidx = 0; cidx < NCHUNK; ++cidx) {
        const int seg = cidx >= CTXL / 64, ci = seg ? cidx - CTXL / 64 : cidx;
        {
            *(LP(v4u))(QS + j * ST128 + dc * 2) = q0; *(LP(v4u))(QS + j * ST128 + dc * 2 + 16) = q1;
            *(LP(v4u))(KS + j * ST128 + dc * 2) = k0; *(LP(v4u))(KS + j * ST128 + dc * 2 + 16) = k1;
            const unsigned qw[8] = {q0.x, q0.y, q0.z, q0.w, q1.x, q1.y, q1.z, q1.w}; unsigned ob[8];
#pragma unroll
            for (int i2 = 0; i2 < 8; ++i2) { const v4f e4 = em[i2 >> 1]; const float ea = (i2 & 1) ? e4.z : e4.x, eb = (i2 & 1) ? e4.w : e4.y; ob[i2] = PK2(bflo(qw[i2]) * ea, bfhi(qw[i2]) * eb); }
            *(LP(v4u))(QB + j * ST128 + dc * 2) = (v4u){ob[0], ob[1], ob[2], ob[3]}; *(LP(v4u))(QB + j * ST128 + dc * 2 + 16) = (v4u){ob[4], ob[5], ob[6], ob[7]};
            *(LP(v4u))(VV + j * ST64 + c8 * 16) = vv;
            if (tid < 64) *(LP(v4f))(DV + tid * 4) = dvv;
        }
        if (cidx + 1 < NCHUNK) GLA_ISSUE(cidx + 1);
        SYNC();
        v4f oacc[2]; oacc[0] = (v4f){0.f, 0.f, 0.f, 0.f}; oacc[1] = oacc[0];
        {
#pragma unroll
            for (int i = 0; i < 2; ++i) { const int st = vt0 + i; v4f p = (v4f){0.f, 0.f, 0.f, 0.f};
                if (st <= tt) { p = tile_mma(p, QS, ST128, 16 * tt, KS, ST128, 16 * st, 4, fr, fq);
                    if (st == tt) { if (4 * fq + 0 > fr) p.x = 0.f; if (4 * fq + 1 > fr) p.y = 0.f; if (4 * fq + 2 > fr) p.z = 0.f; if (4 * fq + 3 > fr) p.w = 0.f; } }
                *(LP(v2u))(PM + (16 * tt + fr) * ST64 + (16 * st + 4 * fq) * 2) = (v2u){PK2(p.x, p.y), PK2(p.z, p.w)}; }
#pragma unroll
            for (int k = 0; k < 4; ++k) { const v8s af = *(LP(const v8s))(QB + (16 * tt + fr) * ST128 + fq * 16 + k * 64);
#pragma unroll
                for (int i = 0; i < 2; ++i) { const v8s bf = *(LP(const v8s))(STT + (16 * (vt0 + i) + fr) * ST128 + fq * 16 + k * 64); oacc[i] = MFMA16(bf, af, oacc[i]); } }
        }
        SYNC();
#pragma unroll
        for (int k = 0; k < 2; ++k) { const v8s af = *(LP(const v8s))(PM + (16 * tt + fr) * ST64 + fq * 16 + k * 64);
#pragma unroll
            for (int i = 0; i < 2; ++i) { const v8s bf = tr_frag(VV, ST64, 32 * k, 16 * (vt0 + i), lane); oacc[i] = MFMA16(bf, af, oacc[i]); } }
        { const int orow = tok_row(b, seg, ci * 64 + 16 * tt + fr, dir, 0);
#pragma unroll
          for (int i = 0; i < 2; ++i) *(v4f*)(Od + (size_t)orow * 1024 + h * 256 + vs * 64 + 16 * (vt0 + i) + 4 * fq) = oacc[i]; }
        {
            v4f tmp[4];
#pragma unroll
            for (int i = 0; i < 4; ++i) tmp[i] = (v4f){0.f, 0.f, 0.f, 0.f};
#pragma unroll
            for (int k = 0; k < 2; ++k) { const v8s af = tr_frag(VV, ST64, 32 * k, 16 * svt, lane);
#pragma unroll
                for (int i = 0; i < 4; ++i) { const v8s bf = tr_frag(KS, ST128, 32 * k, 16 * (sdt0 + i), lane); tmp[i] = MFMA16(bf, af, tmp[i]); } }
#pragma unroll
            for (int i = 0; i < 4; ++i) { const v4f ee = *(LP(const v4f))(DV + 16 * (sdt0 + i) + 4 * fq), de = *(LP(const v4f))(DV + 128 + 16 * (sdt0 + i) + 4 * fq);
                sacc[i] = sacc[i] * de + tmp[i] * ee;
                *(LP(v2u))(STT + (16 * svt + fr) * ST128 + (16 * (sdt0 + i) + 4 * fq) * 2) = (v2u){PK2(sacc[i].x, sacc[i].y), PK2(sacc[i].z, sacc[i].w)}; }
        }
        SYNC();
    }
#undef GLA_ISSUE
}

constexpr int GATE_TASKS = NB * 4 * 2 * (CTXL / 64 + SEQ / 64);
DEV void gate_prep_task(int task, const float* GT, const bf16* QK2, float* GP, float* GPK, const float* gate_b, int lane) {
    constexpr int NCHUNK = CTXL / 64 + SEQ / 64;
    const int cidx = task % NCHUNK, r1 = task / NCHUNK, dir = r1 & 1, h = (r1 >> 1) & 3, b = r1 >> 3;
    const int seg = cidx >= CTXL / 64, ci = seg ? cidx - CTXL / 64 : cidx;
    const int prow = tok_row(b, seg, ci * 64 + lane, dir, 1);
    const float ig = GT[(size_t)prow * 256 + 32 + (dir * 2 + 0) * 4 + h] + gate_b[(dir * 2 + 0) * 4 + h];
    const float lf = logsigmoidf(GT[(size_t)prow * 256 + 32 + (dir * 2 + 1) * 4 + h] + gate_b[(dir * 2 + 1) * 4 + h]);
    float bcum = lf;
#pragma unroll
    for (int o = 1; o < 64; o <<= 1) { const float t = SHUP(bcum, o); if (lane >= o) bcum += t; }
    const float a_s = ig - bcum;
    float cm = a_s;
#pragma unroll
    for (int o = 1; o < 64; o <<= 1) { const float t = SHUP(cm, o); if (lane >= o) cm = fmaxf(cm, t); }
    *(v4f*)(GP + ((size_t)prow * 8 + dir * 4 + h) * 4) = (v4f){bcum, a_s, cm, 0.f};
    const float w0 = EXPF(a_s - RDLANE(cm, 63));
    v4f kw = (v4f){0.f, 0.f, 0.f, 0.f};
    for (int jj = 0; jj < 64; ++jj) { const int rj = tok_row(b, seg, ci * 64 + jj, dir, 1); const float wj = RDLANE(w0, jj);
        const v2u kk = *(const v2u*)(QK2 + (size_t)rj * 2048 + 1024 + h * 256 + 4 * lane);
        kw.x += bflo(kk.x) * wj; kw.y += bfhi(kk.x) * wj; kw.z += bflo(kk.y) * wj; kw.w += bfhi(kk.y) * wj; }
    *(v4f*)(GPK + (size_t)task * 256 + 4 * lane) = kw;
}

template <int MODE>
DEV void mat_unit(const bf16* Sqk, int ldqk, int qoff, int koff, const bf16* Sv, int ldv, int voff, float kscale, const float* GP, const float* GPK, float* O, int store_ctx,
                  const float* ret_log_decay, int unit, LP(unsigned char) lds, int tid) {
    const int lane = tid & 63, wave = tid >> 6, fr = lane & 15, fq = lane >> 4;
    const int vs = unit & 3, dir = (unit >> 2) & 1, h = (unit >> 3) & 3, b = unit >> 5;
    LP(unsigned char) Q = lds; LP(unsigned char) K = lds + 33792;
    LP(unsigned char) VV = lds + 67584; LP(unsigned char) VW = lds + 76800;
    LP(unsigned char) PM = lds + 86016; LP(unsigned char) STT = lds + 95232;
    LP(float) AS = (LP(float))(lds + 137472); LP(float) RT = AS + 64; LP(float) WI = AS + 128; LP(float) WK = AS + 192; LP(float) EMT = AS + 256;
    LP(float) QN = AS + 320; LP(float) DENP = AS + 384;
    LP(float) SC = AS + 640;
    LP(float) NV = AS + 704;
    for (int i = tid; i < 80 * ST256 / 4; i += NTHR) ((LP(unsigned))STT)[i] = 0u;
    if (tid < 256) NV[tid] = 0.f;
    v4f sacc[8];
#pragma unroll
    for (int i = 0; i < 8; ++i) sacc[i] = (v4f){0.f, 0.f, 0.f, 0.f};
    const int j = tid >> 3, c8 = tid & 7, dc = c8 * 32;
    const int tt = wave >> 1, vt0 = (wave & 1) * 2;
    const int svt = wave & 3, sdt0 = (wave >> 2) * 8;
    float m_st = 0.f;
    float lg = 0.f;
    if (MODE == 1) lg = -expf(ret_log_decay[dir * 4 + h]);
    float* Od = O + (size_t)(2 + dir) * TT * 1024;
    SYNC();
    constexpr int NCHUNK = CTXL / 64 + SEQ / 64;
    v4u rq[4], rk[4], rv; v4f gpv = (v4f){0.f, 0.f, 0.f, 0.f}; float kwv = 0.f;
    const int task0 = ((b * 4 + h) * 2 + dir) * NCHUNK;
#define MAT_ISSUE(cx) do { const int seg_ = (cx) >= CTXL / 64, ci_ = seg_ ? (cx) - CTXL / 64 : (cx); \
        const int row_ = tok_row(b, seg_, ci_ * 64 + j, dir, 1); \
        const bf16* s1_ = Sqk + (size_t)row_ * ldqk; \
        _Pragma("unroll") for (int g_ = 0; g_ < 4; ++g_) { rq[g_] = *(const v4u*)(s1_ + qoff + h * 256 + dc + 8 * g_); rk[g_] = *(const v4u*)(s1_ + koff + h * 256 + dc + 8 * g_); } \
        rv = *(const v4u*)(Sv + (size_t)row_ * ldv + voff + h * 256 + vs * 64 + c8 * 8); \
        if (MODE == 0 && wave == 0) { const int prow_ = tok_row(b, seg_, ci_ * 64 + lane, dir, 1); gpv = *(const v4f*)(GP + ((size_t)prow_ * 8 + dir * 4 + h) * 4); } \
        if (MODE == 0 && tid < 256) kwv = GPK[(size_t)(task0 + (cx)) * 256 + tid]; } while (0)
    MAT_ISSUE(0);
    for (int cidx = 0; cidx < NCHUNK; ++cidx) {
        const int seg = cidx >= CTXL / 64, ci = seg ? cidx - CTXL / 64 : cidx;
        if (wave == 0) {
            float a_s, r_t, wi, emt;
            if (MODE == 0) {
                const float bcum = gpv.x; a_s = gpv.y;
                const float Mt = fmaxf(m_st, gpv.z);
                r_t = -Mt; wi = EXPF(m_st - Mt); emt = EXPF(-(bcum + Mt));
                const float M63 = RDLANE(Mt, 63), bend = RDLANE(bcum, 63), cm63 = RDLANE(gpv.z, 63);
                WK[lane] = EXPF(a_s - M63);
                if (lane == 0) { SC[0] = EXPF(m_st - M63); SC[1] = EXPF(cm63 - M63); }
                m_st = bend + M63;
            } else {
                a_s = -(float)(lane + 1) * lg; r_t = (float)(lane + 1) * lg; wi = EXPF(r_t); emt = 0.f;
                WK[lane] = EXPF((float)(63 - lane) * lg);
                if (lane == 0) SC[0] = EXPF(64.f * lg);
            }
            AS[lane] = a_s; RT[lane] = r_t; WI[lane] = wi; EMT[lane] = emt;
        }
        SYNC();
        const float kw_cur = kwv;
        {
            const float wk = WK[j] * kscale;
#pragma unroll
            for (int g8 = 0; g8 < 4; ++g8) {
                const int d0 = dc + 8 * g8;
                *(LP(v4u))(Q + j * ST256 + d0 * 2) = rq[g8];
                *(LP(v4u))(K + j * ST256 + d0 * 2) = rk[g8];
            }
            *(LP(v4u))(VV + j * ST64 + c8 * 16) = rv;
            *(LP(v4u))(VW + j * ST64 + c8 * 16) = (v4u){PK2(bflo(rv.x) * wk, bfhi(rv.x) * wk), PK2(bflo(rv.y) * wk, bfhi(rv.y) * wk), PK2(bflo(rv.z) * wk, bfhi(rv.z) * wk), PK2(bflo(rv.w) * wk, bfhi(rv.w) * wk)};
        }
        if (cidx + 1 < NCHUNK) MAT_ISSUE(cidx + 1);
        SYNC();
        v4f oacc[2]; oacc[0] = (v4f){0.f, 0.f, 0.f, 0.f}; oacc[1] = oacc[0];
        {
            const float rt = RT[16 * tt + fr];
#pragma unroll
            for (int i = 0; i < 2; ++i) { const int st = vt0 + i; v4f p = (v4f){0.f, 0.f, 0.f, 0.f};
                if (st <= tt) { p = tile_mma(p, Q, ST256, 16 * tt, K, ST256, 16 * st, 8, fr, fq);
                    const v4f as4 = *(LP(const v4f))(AS + 16 * st + 4 * fq);
                    p.x *= kscale * EXPF(as4.x + rt); p.y *= kscale * EXPF(as4.y + rt); p.z *= kscale * EXPF(as4.z + rt); p.w *= kscale * EXPF(as4.w + rt);
                    if (st == tt) { if (4 * fq + 0 > fr) p.x = 0.f; if (4 * fq + 1 > fr) p.y = 0.f; if (4 * fq + 2 > fr) p.z = 0.f; if (4 * fq + 3 > fr) p.w = 0.f; } }
                *(LP(v2u))(PM + (16 * tt + fr) * ST64 + (16 * st + 4 * fq) * 2) = (v2u){PK2(p.x, p.y), PK2(p.z, p.w)};
                if (MODE == 0) { float rs = (p.x + p.y) + (p.z + p.w); rs += SHX(rs, 16); rs += SHX(rs, 32); if (fq == 0) DENP[st * 64 + 16 * tt + fr] = rs; } }
#pragma unroll
            for (int k = 0; k < 8; ++k) { const v8s af = *(LP(const v8s))(Q + (16 * tt + fr) * ST256 + fq * 16 + k * 64);
#pragma unroll
                for (int i = 0; i < 2; ++i) { const v8s bf = *(LP(const v8s))(STT + (16 * (vt0 + i) + fr) * ST256 + fq * 16 + k * 64); oacc[i] = MFMA16(bf, af, oacc[i]); } }
            const float wi = WI[16 * tt + fr];
            oacc[0] = oacc[0] * wi; oacc[1] = oacc[1] * wi;
            if (MODE == 0 && vt0 == 0) {
                v4f qa = (v4f){0.f, 0.f, 0.f, 0.f};
                qa = tile_mma(qa, Q, ST256, 16 * tt, STT, ST256, 64, 8, fr, fq);
                if (fq == 0) QN[16 * tt + fr] = qa.x; }
        }
        SYNC();
#pragma unroll
        for (int k = 0; k < 2; ++k) { const v8s af = *(LP(const v8s))(PM + (16 * tt + fr) * ST64 + fq * 16 + k * 64);
#pragma unroll
            for (int i = 0; i < 2; ++i) { const v8s bf = tr_frag(VV, ST64, 32 * k, 16 * (vt0 + i), lane); oacc[i] = MFMA16(bf, af, oacc[i]); } }
        if (MODE == 0) { const int t = 16 * tt + fr; const float den = (DENP[t] + DENP[64 + t]) + (DENP[128 + t] + DENP[192 + t]) + WI[t] * QN[t];
            const float dv = 1.0f / fmaxf(fabsf(den), EMT[t]); oacc[0] = oacc[0] * dv; oacc[1] = oacc[1] * dv; }
        if (seg || store_ctx) { const int orow = tok_row(b, seg, ci * 64 + 16 * tt + fr, dir, 1);
#pragma unroll
            for (int i = 0; i < 2; ++i) *(v4f*)(Od + (size_t)orow * 1024 + h * 256 + vs * 64 + 16 * (vt0 + i) + 4 * fq) = oacc[i]; }
        const float dcy = SC[0];
        {
#pragma unroll
            for (int i = 0; i < 8; ++i) sacc[i] = sacc[i] * dcy;
#pragma unroll
            for (int k = 0; k < 2; ++k) { const v8s af = tr_frag(VW, ST64, 32 * k, 16 * svt, lane);
#pragma unroll
                for (int i = 0; i < 8; ++i) { const v8s bf = tr_frag(K, ST256, 32 * k, 16 * (sdt0 + i), lane); sacc[i] = MFMA16(bf, af, sacc[i]); } }
#pragma unroll
            for (int i = 0; i < 8; ++i) *(LP(v2u))(STT + (16 * svt + fr) * ST256 + (16 * (sdt0 + i) + 4 * fq) * 2) = (v2u){PK2(sacc[i].x, sacc[i].y), PK2(sacc[i].z, sacc[i].w)};
        }
        if (MODE == 0 && tid < 256) {
            const float nn = dcy * NV[tid] + SC[1] * kw_cur * kscale; NV[tid] = nn;
            *(LP(unsigned short))(STT + 64 * ST256 + tid * 2) = F2BF(nn); }
        SYNC();
    }
#undef MAT_ISSUE
}

constexpr int S5_LDS_PER_WAVE = 1280 + 10240 + 6144;
DEV void s5_unit(const bf16* S, int ldS, float* O, const float* lam_re, const float* lam_im, const float* log_step, const float* b_re, const float* b_im,
                 const float* c_re, const float* c_im, int unit, LP(unsigned char) wl, int lane) {
    const int fr = lane & 15, fq = lane >> 4;
    const int dir = unit & 1, g = (unit >> 1) & 63, b = unit >> 7;
    LP(unsigned char) UB = wl; LP(unsigned char) XB = wl + 1280; LP(unsigned char) HB = wl + 1280 + 10240;
    const int pg = (dir * 64 + g);
    const float lr = lam_re[pg * 64 + lane], li = lam_im[pg * 64 + lane], step = expf(log_step[pg]);
    const float mag = expf(lr * step); float sn, cs; sincosf(li * step, &sn, &cs);
    const float ar = mag * cs, ai = mag * sn, den = lr * lr + li * li;
    const float cre = ((ar - 1.0f) * lr + ai * li) / den, cim = (ai * lr - (ar - 1.0f) * li) / den;
    for (int p = 0; p < 16; ++p) { const float br = b_re[(pg * 64 + lane) * 16 + p], bi = b_im[(pg * 64 + lane) * 16 + p];
        *(LP(unsigned short))(XB + lane * 32 + p * 2) = F2BF(cre * br - cim * bi);
        *(LP(unsigned short))(XB + (64 + lane) * 32 + p * 2) = F2BF(cre * bi + cim * br); }
    WAVE_SYNC();
    v8s bfrag[8];
#pragma unroll
    for (int nt = 0; nt < 8; ++nt) { if (fq < 2) bfrag[nt] = *(LP(const v8s))(XB + (16 * nt + fr) * 32 + fq * 16); else bfrag[nt] = (v8s){0, 0, 0, 0, 0, 0, 0, 0}; }
    v8s cfrag[4];
#pragma unroll
    for (int ks = 0; ks < 4; ++ks) { const int n0 = 32 * ks + 8 * fq; const float* src = (n0 < 64 ? c_re : c_im) + ((size_t)pg * 16 + fr) * 64 + (n0 & 63); const float sgn = n0 < 64 ? 1.f : -1.f;
        v8s f;
#pragma unroll
        for (int i = 0; i < 8; ++i) f[i] = (short)F2BF(sgn * src[i]);
        cfrag[ks] = f; }
    WAVE_SYNC();
    for (int i = lane; i < 1280 / 4; i += 64) ((LP(unsigned))UB)[i] = 0u;
    WAVE_SYNC();
    float hr = 0.f, hi = 0.f;
    float* Od = O + (size_t)dir * TT * 1024;
    constexpr int NBLK = CTXL / 16 + SEQ / 16;
    v4u un = (v4u){0u, 0u, 0u, 0u};
#define S5_ISSUE(bx) do { if (lane < 32) { const int seg_ = (bx) >= CTXL / 16, bi_ = seg_ ? (bx) - CTXL / 16 : (bx); \
        un = *(const v4u*)(S + (size_t)tok_row(b, seg_, bi_ * 16 + (lane >> 1), dir, 0) * ldS + g * 16 + (lane & 1) * 8); } } while (0)
    S5_ISSUE(0);
    for (int bx = 0; bx < NBLK; ++bx) {
        const int seg = bx >= CTXL / 16, bi = seg ? bx - CTXL / 16 : bx;
        {
            if (lane < 32) *(LP(v4u))(UB + (lane >> 1) * 80 + (lane & 1) * 16) = un;
            if (bx + 1 < NBLK) S5_ISSUE(bx + 1);
            WAVE_SYNC();
            const v8s uf = *(LP(const v8s))(UB + fr * 80 + fq * 16);
#pragma unroll
            for (int nt = 0; nt < 8; ++nt) { v4f x = (v4f){0.f, 0.f, 0.f, 0.f}; x = MFMA16(uf, bfrag[nt], x);
                *(LP(v4f))(XB + (16 * nt + fr) * 80 + fq * 16) = x; }
            WAVE_SYNC();
            float xr[16], xi[16];
#pragma unroll
            for (int q4 = 0; q4 < 4; ++q4) { const v4f a4 = *(LP(const v4f))(XB + lane * 80 + q4 * 16), b4 = *(LP(const v4f))(XB + (64 + lane) * 80 + q4 * 16);
                xr[4 * q4] = a4.x; xr[4 * q4 + 1] = a4.y; xr[4 * q4 + 2] = a4.z; xr[4 * q4 + 3] = a4.w; xi[4 * q4] = b4.x; xi[4 * q4 + 1] = b4.y; xi[4 * q4 + 2] = b4.z; xi[4 * q4 + 3] = b4.w; }
            unsigned pr[8], pi[8];
#pragma unroll
            for (int t2 = 0; t2 < 8; ++t2) {
                const float r0 = ar * hr - ai * hi + xr[2 * t2], i0 = ar * hi + ai * hr + xi[2 * t2];
                hr = ar * r0 - ai * i0 + xr[2 * t2 + 1]; hi = ar * i0 + ai * r0 + xi[2 * t2 + 1];
                pr[t2] = PK2(r0, hr); pi[t2] = PK2(i0, hi); }
            *(LP(v4u))(HB + lane * 48) = (v4u){pr[0], pr[1], pr[2], pr[3]}; *(LP(v4u))(HB + lane * 48 + 16) = (v4u){pr[4], pr[5], pr[6], pr[7]};
            *(LP(v4u))(HB + (64 + lane) * 48) = (v4u){pi[0], pi[1], pi[2], pi[3]}; *(LP(v4u))(HB + (64 + lane) * 48 + 16) = (v4u){pi[4], pi[5], pi[6], pi[7]};
            WAVE_SYNC();
            if (seg) { v4f y = (v4f){0.f, 0.f, 0.f, 0.f};
#pragma unroll
                for (int ks = 0; ks < 4; ++ks) { const v8s hf = tr_frag(HB, 48, 32 * ks, 0, lane); y = MFMA16(cfrag[ks], hf, y); }
                const int orow = tok_row(b, seg, bi * 16 + fr, dir, 0);
                *(v4f*)(Od + (size_t)orow * 1024 + g * 16 + 4 * fq) = y; }
        }
    }
#undef S5_ISSUE
}

DEV void conv_prep_row(int r, const bf16* S, bf16* QK2, const float* conv_w, const float* conv_b, int lane) {
    int rm, rp; bool hasm, hasp;
    if (r < TL) { const int b = r >> 12, n = r & (SEQ - 1), gr = n >> 6, col = n & 63, np = col * 64 + gr;
        hasm = np > 0; hasp = np < SEQ - 1; rm = seq_row(b, 1, hasm ? np - 1 : np, 1); rp = seq_row(b, 1, hasp ? np + 1 : np, 1); }
    else { const int n = (r - TL) & (CTXL - 1); hasm = n > 0; hasp = n < CTXL - 1; rm = hasm ? r - 1 : r; rp = hasp ? r + 1 : r; }
    const bf16* s0 = S + (size_t)rm * EV_PAD + 3072; const bf16* s1 = S + (size_t)r * EV_PAD + 3072; const bf16* s2 = S + (size_t)rp * EV_PAD + 3072;
#pragma unroll
    for (int i = 0; i < 4; ++i) { const int c = 8 * lane + 512 * i;
        const v4u a0 = *(const v4u*)(s0 + c), a1 = *(const v4u*)(s1 + c), a2 = *(const v4u*)(s2 + c);
        const unsigned w0[4] = {a0.x, a0.y, a0.z, a0.w}, w1[4] = {a1.x, a1.y, a1.z, a1.w}, w2[4] = {a2.x, a2.y, a2.z, a2.w};
        const float sc = c >= 1024 ? 0.0625f : 1.0f;
        float val[8];
#pragma unroll
        for (int i2 = 0; i2 < 4; ++i2)
#pragma unroll
            for (int e = 0; e < 2; ++e) { const int di = 2 * i2 + e;
                const float um = hasm ? (e ? bfhi(w0[i2]) : bflo(w0[i2])) : 0.f, u0 = e ? bfhi(w1[i2]) : bflo(w1[i2]), up = hasp ? (e ? bfhi(w2[i2]) : bflo(w2[i2])) : 0.f;
                const float pre = conv_b[c + di] + conv_w[c + di] * um + conv_w[2048 + c + di] * u0 + conv_w[4096 + c + di] * up;
                val[di] = pre * RCPF(1.0f + EXPF(-pre)) * sc; }
        *(v4u*)(QK2 + (size_t)r * 2048 + c) = (v4u){PK2(val[0], val[1]), PK2(val[2], val[3]), PK2(val[4], val[5]), PK2(val[6], val[7])}; }
}

DEV float wsum(float v) {
#pragma unroll
    for (int o = 1; o < 64; o <<= 1) v += SHX(v, o);
    return v;
}
DEV void merge_even_row(int r, const bf16* S, const float* O, const float* gla_norm, const float* ml_norm, bf16* HBo, int lane) {
    const bf16* sr = S + (size_t)r * EV_PAD;
#pragma unroll
    for (int hh = 0; hh < 8; ++hh) { const int mix = hh >> 2, c = (hh & 3) * 256 + 4 * lane;
        const float* o0 = O + (size_t)(2 * mix) * TT * 1024 + (size_t)r * 1024 + c; const float* o1 = o0 + (size_t)TT * 1024;
        v4f o = *(const v4f*)o0 + *(const v4f*)o1;
#ifdef NO_GLA
        if (!mix) o = (v4f){0.f, 0.f, 0.f, 0.f};
#endif
#ifdef NO_ML
        if (mix) o = (v4f){0.f, 0.f, 0.f, 0.f};
#endif
        if (mix) { const float mean = wsum((o.x + o.y) + (o.z + o.w)) * (1.0f / 256.0f); o = o - mean; }
        const float ms = wsum((o.x * o.x + o.y * o.y) + (o.z * o.z + o.w * o.w)) * (1.0f / 256.0f);
        const float rstd = RSQRTF(ms + EPS);
        const v4f gn = *(const v4f*)((mix ? ml_norm : gla_norm) + c);
        const v2u gw = *(const v2u*)(sr + (mix ? 6144 : 2048) + c);
        const float g0 = bflo(gw.x), g1 = bfhi(gw.x), g2 = bflo(gw.y), g3 = bfhi(gw.y);
        v4f gate;
        if (mix) { gate.x = RCPF(1.0f + EXPF(-g0)); gate.y = RCPF(1.0f + EXPF(-g1)); gate.z = RCPF(1.0f + EXPF(-g2)); gate.w = RCPF(1.0f + EXPF(-g3)); }
        else { gate.x = g0 * RCPF(1.0f + EXPF(-g0)); gate.y = g1 * RCPF(1.0f + EXPF(-g1)); gate.z = g2 * RCPF(1.0f + EXPF(-g2)); gate.w = g3 * RCPF(1.0f + EXPF(-g3)); }
        const v4f res = gate * (o * rstd * gn);
        *(v2u*)(HBo + (size_t)r * D + mix * 1024 + c) = (v2u){PK2(res.x, res.y), PK2(res.z, res.w)}; }
}
DEV float gelu_tanh(float y) { const float z = 0.7978845608028654f * (y + 0.044715f * y * y * y); const float t = 1.0f - 2.0f * RCPF(1.0f + EXPF(2.0f * z)); return 0.5f * y * (1.0f + t); }
DEV void merge_odd_row(int r, const bf16* S, const float* O, const float* s5_d, const float* ret_norm, bf16* GBo, bf16* HBo, int lane) {
    const bf16* sr = S + (size_t)r * OD_COLS;
#pragma unroll
    for (int hh = 0; hh < 4; ++hh) { const int c = hh * 256 + 4 * lane;
        { const float* o0 = O + (size_t)r * 1024 + c; const float* o1 = o0 + (size_t)TT * 1024;
          v4f y0 = *(const v4f*)o0 + *(const v4f*)o1;
#ifdef NO_S5
          y0 = (v4f){0.f, 0.f, 0.f, 0.f};
#endif
          const v4f dd = *(const v4f*)(s5_d + c); const v2u uw = *(const v2u*)(sr + c);
          const float y[4] = {y0.x + dd.x * bflo(uw.x), y0.y + dd.y * bfhi(uw.x), y0.z + dd.z * bflo(uw.y), y0.w + dd.w * bfhi(uw.y)};
          *(v2u*)(GBo + (size_t)r * 1024 + c) = (v2u){PK2(gelu_tanh(y[0]), gelu_tanh(y[1])), PK2(gelu_tanh(y[2]), gelu_tanh(y[3]))}; }
        { const float* o0 = O + (size_t)2 * TT * 1024 + (size_t)r * 1024 + c; const float* o1 = o0 + (size_t)TT * 1024;
          v4f o = *(const v4f*)o0 + *(const v4f*)o1;
#ifdef NO_RET
          o = (v4f){0.f, 0.f, 0.f, 0.f};
#endif
          const float mean = wsum((o.x + o.y) + (o.z + o.w)) * (1.0f / 256.0f); o = o - mean;
          const float ms = wsum((o.x * o.x + o.y * o.y) + (o.z * o.z + o.w * o.w)) * (1.0f / 256.0f);
          const float rstd = RSQRTF(ms + EPS);
          const v4f gn = *(const v4f*)(ret_norm + c);
          const v2u gw = *(const v2u*)(sr + 4096 + c);
          const float g0 = bflo(gw.x), g1 = bfhi(gw.x), g2 = bflo(gw.y), g3 = bfhi(gw.y);
          v4f gate; gate.x = g0 * RCPF(1.0f + EXPF(-g0)); gate.y = g1 * RCPF(1.0f + EXPF(-g1)); gate.z = g2 * RCPF(1.0f + EXPF(-g2)); gate.w = g3 * RCPF(1.0f + EXPF(-g3));
          const v4f res = gate * (o * rstd * gn);
          *(v2u*)(HBo + (size_t)r * D + 1024 + c) = (v2u){PK2(res.x, res.y), PK2(res.z, res.w)}; }
    }
}

struct EpiGLU {
    static constexpr bool PERM = true, AFTER_DRAIN = false;
    const bf16* G; const float* bias; bf16* O;
    __device__ __forceinline__ void operator()(const pg8::f32x4 (&acc)[2][2][4][2], const pg8::Unit& u, int wr, int wc, int fr, int fq) const {
        const int row0 = u.pm * 256 + wr * 64 + fr, col0 = u.pn * 256 + wc * 32 + 8 * fq;
#pragma unroll
        for (int ai = 0; ai < 2; ++ai)
#pragma unroll
            for (int m = 0; m < 4; ++m) { const size_t row = (size_t)(row0 + ai * 128 + m * 16);
#pragma unroll
                for (int bj = 0; bj < 2; ++bj) { const int col = col0 + bj * 128;
                    const v4u gw = *(const v4u*)(G + row * 1024 + col); const pg8::f32x4 b0 = *(const pg8::f32x4*)(bias + col), b1 = *(const pg8::f32x4*)(bias + col + 4);
                    const pg8::f32x4 v0 = acc[ai][bj][m][0] + b0, v1 = acc[ai][bj][m][1] + b1;
                    v4u w; w.x = pk2(bflo(gw.x) * fast_sigmoid(v0[0]), bfhi(gw.x) * fast_sigmoid(v0[1])); w.y = pk2(bflo(gw.y) * fast_sigmoid(v0[2]), bfhi(gw.y) * fast_sigmoid(v0[3]));
                    w.z = pk2(bflo(gw.z) * fast_sigmoid(v1[0]), bfhi(gw.z) * fast_sigmoid(v1[1])); w.w = pk2(bflo(gw.w) * fast_sigmoid(v1[2]), bfhi(gw.w) * fast_sigmoid(v1[3]));
                    *(v4u*)(O + row * D + col) = w; } }
    }
};

__device__ __forceinline__ void mixer_phases(const Args& a, unsigned char* ws, LAS unsigned char* lds, const XcdBarrier& bar, int layer, int G, int gw, int ngw, int tid, int lane, int wave) {
#define HB ((bf16*)wsp(ws, WS_HB))
#define S ((bf16*)wsp(ws, WS_S))
#define GT ((float*)wsp(ws, WS_GT))
#define O ((float*)wsp(ws, WS_O))
#define GB ((bf16*)wsp(ws, WS_GB))
#define Y ((float*)wsp(ws, WS_Y))
    const int ldS = layer == 0 ? EV_PAD : OD_COLS;
    { pg8::Gemm g{HB, (const bf16*)(wsp(ws, (layer == 0 ? WS_WIN_EV : WS_WIN_OD))), TT, ldS, D}; pg8::StaticOrder So; So.init(TT, ldS, G, (int)blockIdx.x);
      EpiS E{S, ldS, GT, layer == 0 ? 28 : -1};
      pg8::gemm_phase<EpiS, pg8::StaticOrder, true, true>(lds, g, So, E); }
    xcd_barrier(bar);
#define QK2 ((bf16*)wsp(ws, WS_QK2))
#define GP ((float*)wsp(ws, WS_GP))
#define QKS ((bf16*)wsp(ws, WS_QKS))
#define GPK ((float*)wsp(ws, WS_GPK))
#define VEC ((float*)wsp(ws, WS_VEC))
    if (layer == 0) {
        { const bf16* s_ = S; bf16* qk_ = QK2; const float* cw_ = ARG(16); const float* cb_ = ARG(17); for (int r = gw; r < TT; r += ngw) conv_prep_row(r, s_, qk_, cw_, cb_, lane); }
        xcd_barrier(bar);
        { const float* gt_ = GT; const bf16* qk_ = QK2; float* gp_ = GP; float* gk_ = GPK; const float* gb_ = ARG(18); for (int t = gw; t < GATE_TASKS; t += ngw) gate_prep_task(t, gt_, qk_, gp_, gk_, gb_, lane); }
        { int t2 = threadIdx.x; asm volatile("" : "+v"(t2)); for (int t = blockIdx.x; t < GLA_TASKS; t += G) gla_prep_task(t, S, GT, ARG(13), ARG(14), QKS, VEC, lds, t2); }
        xcd_barrier(bar);
    }
    { int t2 = threadIdx.x; asm volatile("" : "+v"(t2)); tid = t2; lane = t2 & 63; wave = __builtin_amdgcn_readfirstlane(t2 >> 6); }
#ifndef SCAN_REPS
#define SCAN_REPS 1
#endif
#pragma unroll 1
    for (int rep = 0; rep < SCAN_REPS; ++rep) {
    if (layer == 0) {
        for (int it = blockIdx.x; it < 2 * MIX_UNITS; it += G) {
            if (it < MIX_UNITS) {
#ifndef REP_GLA
#define REP_GLA 1
#endif
#pragma unroll 1
                for (int r_ = 0; r_ < REP_GLA; ++r_) gla_unit(S, QKS, VEC, O, it, lds, tid);
            } else {
#ifndef REP_ML
#define REP_ML 1
#endif
#pragma unroll 1
                for (int r_ = 0; r_ < REP_ML; ++r_) mat_unit<0>(QK2, 2048, 0, 1024, S, EV_PAD, 5120, 1.0f, GP, GPK, O, 1, nullptr, it - MIX_UNITS, lds, tid);
            }
        }
    } else {
        const int s5_first = G >= 2 * MIX_UNITS ? MIX_UNITS : 0, s5_wgs = G - s5_first;
#ifndef REP_RET
#define REP_RET 1
#endif
#ifndef REP_S5
#define REP_S5 1
#endif
#pragma unroll 1
        for (int r_ = 0; r_ < REP_RET; ++r_)
        for (int u = blockIdx.x; u < MIX_UNITS; u += G)
            mat_unit<1>(S, OD_COLS, 1024, 2048, S, OD_COLS, 3072, 0.0625f, nullptr, nullptr, O, 0, ARG(32), u, lds, tid);
#pragma unroll 1
        for (int r_ = 0; r_ < REP_S5; ++r_)
        if ((int)blockIdx.x >= s5_first && wave < 4) { for (int su = ((int)blockIdx.x - s5_first) * 4 + wave; su < NB * 128; su += 4 * s5_wgs)
            s5_unit(S, OD_COLS, O, ARG(22), ARG(23), ARG(24), ARG(25), ARG(26), ARG(27), ARG(28), su, lds + wave * S5_LDS_PER_WAVE, lane); }
    }
    }
    xcd_barrier(bar);
    { int t2 = threadIdx.x; asm volatile("" : "+v"(t2)); tid = t2; lane = t2 & 63; wave = __builtin_amdgcn_readfirstlane(t2 >> 6); gw = blockIdx.x * NWAVES + wave; }
#ifndef NO_MERGE
    if (layer == 0) { const bf16* s_ = S; const float* o_ = O; const float* n0 = ARG(15); const float* n1 = ARG(19); bf16* hb_ = HB; for (int r = gw; r < TT; r += ngw) merge_even_row(r, s_, o_, n0, n1, hb_, lane); }
    else { const bf16* s_ = S; const float* o_ = O; const float* n0 = ARG(29); const float* n1 = ARG(33); bf16* gb_ = GB; bf16* hb_ = HB; for (int r = gw; r < TL; r += ngw) merge_odd_row(r, s_, o_, n0, n1, gb_, hb_, lane); }
#endif
    xcd_barrier(bar);
    const int Mo = layer == 0 ? TT : TL;
    if (layer == 1) {
        pg8::Gemm g{GB, (const bf16*)(wsp(ws, WS_WGLU)), TL, 1024, 1024}; pg8::StaticOrder So; So.init(TL, 1024, G, (int)blockIdx.x);
        EpiGLU E{GB, ARG(31), HB};
        pg8::gemm_phase<EpiGLU, pg8::StaticOrder, true, true>(lds, g, So, E);
        xcd_barrier(bar);
    }
    { pg8::Gemm g{HB, (const bf16*)(wsp(ws, (layer == 0 ? WS_WOUT_EV : WS_WOUT_OD))), Mo, D, D}; pg8::SplitOrder So; So.init(Mo - TL, D, G, (int)blockIdx.x);
      EpiF32 E{Y, (float*)(wsp(ws, WS_YCP))};
      pg8::gemm_phase<EpiF32, pg8::SplitOrder, true, true>(lds, g, So, E); }
    xcd_barrier(bar);
}
#undef HB
#undef S
#undef GT
#undef O
#undef GB
#undef Y
#undef QK2
#undef GP
#undef QKS
#undef GPK
#undef VEC

#ifndef MIXER_ON
#define MIXER_ON 1
#endif
__global__ void __launch_bounds__(NTHR, 2) fwd(Args a) {
    extern __shared__ __attribute__((aligned(16))) unsigned char lds_raw[];
    LAS unsigned char* lds = (LAS unsigned char*)lds_raw;
    const int tid = threadIdx.x, lane = tid & 63, wave = __builtin_amdgcn_readfirstlane(tid >> 6);
    const int G = gridDim.x, gw = blockIdx.x * NWAVES + wave, ngw = G * NWAVES;
    unsigned char* ws = a.ws;
    if (tid < 16) ((LAS unsigned*)(lds + MISC_OFF))[tid] = 0u;
    __syncthreads();
    XcdBarrier bar = xcd_barrier_post((unsigned*)(wsp(ws, WS_CTL)), (volatile LAS unsigned*)(lds + MISC_OFF));

#ifdef NAN_POISON
    {
        v4u q = (v4u){0xffffffffu, 0xffffffffu, 0xffffffffu, 0xffffffffu};
        for (int i = tid; i < (MISC_OFF) / 16; i += NTHR) ((LAS v4u*)lds)[i] = q;
        { v4u* p = (v4u*)(wsp(ws, WS_MOD)); const size_t n = (WS_WGU - WS_MOD) / 16; for (size_t i = (size_t)blockIdx.x * NTHR + tid; i < n; i += (size_t)G * NTHR) p[i] = q; }
        { v4u* p = (v4u*)(wsp(ws, WS_XC)); const size_t n = (WS_END - WS_XC) / 16; for (size_t i = (size_t)blockIdx.x * NTHR + tid; i < n; i += (size_t)G * NTHR) p[i] = q; }
        { v4u* p = (v4u*)a.out; const size_t n = (size_t)TL * D * 4 / 16; for (size_t i = (size_t)blockIdx.x * NTHR + tid; i < n; i += (size_t)G * NTHR) p[i] = q; }
        __syncthreads();
        xcd_barrier(bar);
    }
#endif
#define MOD ((float*)wsp(ws, WS_MOD))
#define MODP ((float*)wsp(ws, WS_MODP))
#define HB ((bf16*)wsp(ws, WS_HB))
#define HID ((bf16*)wsp(ws, WS_HID))
#define Y ((float*)wsp(ws, WS_Y))
#define XC ((float*)wsp(ws, WS_XC))

#ifndef REP_PRO
#define REP_PRO 1
#endif
#ifndef REP_GU
#define REP_GU 1
#endif
#ifndef REP_DN
#define REP_DN 1
#endif
#pragma unroll 1
    for (int rep_ = 0; rep_ < REP_PRO; ++rep_) {
        __syncthreads();
        TJob* jobs = (TJob*)lds_raw;
        LAS float* stab = (LAS float*)(lds + 1024);
        if (tid == 0) {
            int t = 0, ji = 0;
            for (int l = 0; l < 2; ++l) for (int i = 0; i < 2; ++i) {
                const size_t wo = (size_t)(l * 2 + i) * 2048 * 5504;
                TJob j; j.K = 2048; j.N = 5504; j.dst = (bf16*)(wsp(ws, WS_WGU) + (size_t)(l * 2 + i) * SZ_WGU);
                j.src = ARG(8) + wo; j.map = 1; j.tstart = t; jobs[ji++] = j; t += tj_tiles(2048, 5504);
                j.src = ARG(9) + wo; j.map = 2; j.tstart = t; jobs[ji++] = j; t += tj_tiles(2048, 5504);
                j.K = 5504; j.N = 2048; j.dst = (bf16*)(wsp(ws, WS_WD) + (size_t)(l * 2 + i) * SZ_WD); j.src = ARG(10) + wo; j.map = 0; j.tstart = t; jobs[ji++] = j; t += tj_tiles(5504, 2048);
            }
            TJob j; j.map = 0;
            j.K = 2048; j.N = EV_COLS; j.src = ARG(11); j.dst = (bf16*)(wsp(ws, WS_WIN_EV)); j.map = 3; j.tstart = t; jobs[ji++] = j; t += tj_tiles(2048, EV_COLS);
            j.map = 0;
            j.K = 2048; j.N = 2048; j.src = ARG(12); j.dst = (bf16*)(wsp(ws, WS_WOUT_EV)); j.tstart = t; jobs[ji++] = j; t += tj_tiles(2048, 2048);
            j.K = 2048; j.N = OD_COLS; j.src = ARG(20); j.dst = (bf16*)(wsp(ws, WS_WIN_OD)); j.tstart = t; jobs[ji++] = j; t += tj_tiles(2048, OD_COLS);
            j.K = 2048; j.N = 2048; j.src = ARG(21); j.dst = (bf16*)(wsp(ws, WS_WOUT_OD)); j.tstart = t; jobs[ji++] = j; t += tj_tiles(2048, 2048);
            j.K = 1024; j.N = 1024; j.src = ARG(30); j.dst = (bf16*)(wsp(ws, WS_WGLU)); j.tstart = t; jobs[ji++] = j; t += tj_tiles(1024, 1024);
            ((LAS int*)(lds + 1024 - 16))[0] = t;
        }
        { const float* cin = ARG(1); const float* cctx = ARG(3);
        for (int i = tid; i < 5 * D; i += NTHR) { const int r = i >> 11, k = i & (D - 1); const float c = r < 4 ? cin[r * D + k] : cctx[k]; stab[i] = c / (1.0f + expf(-c)); } }
        __syncthreads();
        for (int it = gw; it < 2 * MOD_KC * 72; it += ngw) {
            const int l = it / (MOD_KC * 72), rem = it % (MOD_KC * 72), kc = rem / 72, jb = rem % 72; constexpr int KCH = D / MOD_KC;
            const float* W = ARG(4) + ((size_t)l * D + kc * KCH) * (NMOD * D) + jb * 256 + lane * 4;
            f32x4 acc[5];
#pragma unroll
            for (int r = 0; r < 5; ++r) acc[r] = (f32x4){0.f, 0.f, 0.f, 0.f};
            for (int k = 0; k < KCH; k += 8) { f32x4 w[8];
#pragma unroll
                for (int i = 0; i < 8; ++i) w[i] = *(const f32x4*)(W + (size_t)(k + i) * (NMOD * D));
#pragma unroll
                for (int i = 0; i < 8; ++i)
#pragma unroll
                    for (int r = 0; r < 5; ++r) acc[r] += stab[r * D + kc * KCH + k + i] * w[i]; }
            { float* modp = MODP;
#pragma unroll
            for (int r = 0; r < 5; ++r) *(f32x4*)(modp + (((size_t)l * MOD_KC + kc) * 5 + r) * (NMOD * D) + jb * 256 + lane * 4) = acc[r]; }
        }
        const int ntiles = ((LAS int*)(lds + 1024 - 16))[0];
        for (int t = gw; t < ntiles; t += ngw) {
            int ji = 0;
#pragma unroll 1
            for (int q = 1; q < NJOBS; ++q) if (t >= jobs[q].tstart) ji = q;
            const TJob j = jobs[ji];
            transpose_tile(j, t - j.tstart, lane);
        }
        { v4u z = (v4u){0u, 0u, 0u, 0u}; v4u* p = (v4u*)(wsp(ws, WS_WIN_EV) + (size_t)EV_COLS * 2048 * 2); const int n16 = (EV_PAD - EV_COLS) * 2048 * 2 / 16;
          for (int i = blockIdx.x * NTHR + tid; i < n16; i += G * NTHR) p[i] = z; }
    }
    xcd_barrier(bar);
    { const float* bmod = ARG(5); const float* modp = MODP; float* modf = MOD;
    for (int i = blockIdx.x * NTHR + tid; i < 2 * 5 * NMOD * D; i += G * NTHR) {
        const int l = i / (5 * NMOD * D), rem = i % (5 * NMOD * D), r = rem / (NMOD * D), j = rem % (NMOD * D);
        float s = bmod[l * (NMOD * D) + j];
        for (int kc = 0; kc < MOD_KC; ++kc) s += modp[(((size_t)l * MOD_KC + kc) * 5 + r) * (NMOD * D) + j];
        modf[i] = s;
    } }
    xcd_barrier(bar);
    { NormP p{}; p.xin_lat = ARG(0); p.xin_ctx = ARG(2); p.xout_lat = a.out; p.xout_ctx = XC; p.y = nullptr; p.h = HB; p.rows_end = TT; p.has_y = 0; p.has_h = 1; p.w = 0.f; p.lp = 0; p.sp = 0; p.ln = 0; p.sn = 0;
      norm_phase(p, MOD, ARG(6), ARG(7), lds, gw, ngw, tid, lane); }
    xcd_barrier(bar);

#pragma unroll 1
    for (int layer = 0; layer < 2; ++layer) {
#pragma unroll 1
        for (int half = 0; half < 2; ++half) {
            const int Mrows = (layer == 1 && half == 1) ? TL : TT;
#if MIXER_ON
            if (half == 1) {
                mixer_phases(a, ws, lds, bar, layer, G, gw, ngw, tid, lane, wave);
                NormP p{}; p.xin_lat = a.out; p.xin_ctx = XC; p.xout_lat = a.out; p.xout_ctx = XC; p.y = Y; p.y_ctx = (const float*)(wsp(ws, WS_YCP)); p.h = HB; p.rows_end = Mrows; p.has_y = 1; p.has_h = 1; p.w = 1.0f; p.lp = layer; p.sp = 1; p.ln = layer; p.sn = 2;
                norm_phase(p, MOD, ARG(6), ARG(7), lds, gw, ngw, tid, lane);
                xcd_barrier(bar);
            }
#endif
            const int sub = half * 2;
#pragma unroll 1
            for (int rep_ = 0; rep_ < REP_GU; ++rep_) { pg8::Gemm g{HB, (const bf16*)(wsp(ws, WS_WGU) + (size_t)(layer * 2 + half) * SZ_WGU), Mrows, 2 * DFF, D}; pg8::StaticOrder S; S.init(Mrows, 2 * DFF, G, (int)blockIdx.x);
              EpiSwiGLU E{HID, DFF};
              pg8::gemm_phase<EpiSwiGLU, pg8::StaticOrder, true, true>(lds, g, S, E);
              if (rep_ + 1 < REP_GU) xcd_barrier(bar); }
            xcd_barrier(bar);
#pragma unroll 1
            for (int rep_ = 0; rep_ < REP_DN; ++rep_) { pg8::Gemm g{HID, (const bf16*)(wsp(ws, WS_WD) + (size_t)(layer * 2 + half) * SZ_WD), Mrows, D, DFF}; pg8::SplitOrder S; S.init(Mrows - TL, DFF, G, (int)blockIdx.x);
              EpiF32 E{Y, (float*)(wsp(ws, WS_YCP))};
              pg8::gemm_phase<EpiF32, pg8::SplitOrder, true, true>(lds, g, S, E);
              if (rep_ + 1 < REP_DN) xcd_barrier(bar); }
            xcd_barrier(bar);
            { NormP p{}; const bool first = (layer == 0 && half == 0);
              p.xin_lat = first ? ARG(0) : a.out; p.xin_ctx = first ? ARG(2) : XC; p.xout_lat = a.out; p.xout_ctx = XC; p.y = Y; p.y_ctx = (const float*)(wsp(ws, WS_YCP)); p.h = HB; p.rows_end = Mrows; p.has_y = 1; p.w = 0.5f; p.lp = layer; p.sp = sub;
              if (half == 0) { p.has_h = 1; p.ln = layer; p.sn = MIXER_ON ? 1 : 2; }
              else if (layer == 0) { p.has_h = 1; p.ln = 1; p.sn = 0; }
              else { p.has_h = 0; p.ln = 0; p.sn = 0; }
              norm_phase(p, MOD, ARG(6), ARG(7), lds, gw, ngw, tid, lane); }
            if (!(layer == 1 && half == 1)) xcd_barrier(bar);
        }
    }
}

#undef MOD
#undef MODP
#undef HB
#undef HID
#undef Y
#undef XC
extern "C" void kernel_launch(void* const* d_in, const int* in_sizes, int n_in, void* d_out, int out_size, void* d_ws, size_t ws_size, hipStream_t stream) {
    static int grid = 0;
    if (grid == 0) {
        if (n_in != 34 || out_size != TL * D || ws_size < WS_END) { fprintf(stderr, "kernel_launch: unexpected shapes (n_in %d out %d ws %zu need %zu)\n", n_in, out_size, ws_size, (size_t)WS_END); grid = -1; return; }
        int dev = 0, cus = 0, per_cu = 0;
        if (hipGetDevice(&dev) != hipSuccess || hipDeviceGetAttribute(&cus, hipDeviceAttributeMultiprocessorCount, dev) != hipSuccess) { grid = -1; return; }
        if (hipFuncSetAttribute((const void*)fwd, hipFuncAttributeMaxDynamicSharedMemorySize, LDS_BYTES) != hipSuccess) { fprintf(stderr, "kernel_launch: hipFuncSetAttribute failed\n"); grid = -1; return; }
        if (hipOccupancyMaxActiveBlocksPerMultiprocessor(&per_cu, (const void*)fwd, NTHR, LDS_BYTES) != hipSuccess || per_cu < 1) { fprintf(stderr, "kernel_launch: occupancy query says %d\n", per_cu); }
        (void)hipGetLastError();
        grid = cus;
    }
    if (grid < 0) return;
    if (hipMemsetAsync((char*)d_ws + WS_CTL, 0, CTL_ZERO_BYTES, stream) != hipSuccess) return;
    Args a{};
    for (int i = 0; i < 34; ++i) a.in[i] = (const float*)d_in[i];
    a.out = (float*)d_out; a.ws = (unsigned char*)d_ws;
    hipLaunchKernelGGL(fwd, dim3(grid), dim3(NTHR), LDS_BYTES, stream, a);
}
```

```cpp
#include <hip/hip_runtime.h>
#include <cstdio>
#include <cstdint>
#define MIXER_ON 1

#define XB_TMO      128
#define XB_XCNT(j)  (256  + 64 * (j))
#define XB_XSUB(j)  (1280 + 64 * (j))
#define XB_XGEN(j)  (2304 + 64 * (j))
#define XB_TOP      3328
#define XB_TOPGEN   3392
#define XCD_BAR_WORDS 3456
#define XB_SPIN_CAP (1u << 18)
#define LAS __attribute__((address_space(3)))

__device__ __forceinline__ unsigned xb_ld(unsigned* p)              { return __hip_atomic_load(p, __ATOMIC_RELAXED, __HIP_MEMORY_SCOPE_AGENT); }
__device__ __forceinline__ unsigned xb_add(unsigned* p, unsigned v) { return __hip_atomic_fetch_add(p, v, __ATOMIC_RELAXED, __HIP_MEMORY_SCOPE_AGENT); }
__device__ __forceinline__ unsigned xb_xcc_id() { return (unsigned)__builtin_amdgcn_s_getreg((3 << 11) | 20) & 0xFu; }
#define XB_SPIN(cond, bar) do { unsigned _sp = 0; while (cond) { __builtin_amdgcn_s_sleep(1); \
    if ((++_sp & 255u) == 0u) { if (xb_ld(&(bar)[XB_TMO])) break; if (_sp > XB_SPIN_CAP) { atomicAdd(&(bar)[XB_TMO], 1u); break; } } } } while (0)

struct XcdBarrier {
    unsigned* bar; unsigned x;
    volatile LAS unsigned* st;
};

__device__ __forceinline__ XcdBarrier xcd_barrier_post(unsigned* bar, volatile LAS unsigned* st) {
    XcdBarrier b; b.bar = bar; b.x = xb_xcc_id(); b.st = st;
    if (threadIdx.x == 0) (void)xb_add(&bar[XB_XCNT(b.x)], 1u);
    return b;
}
__device__ __forceinline__ void xcd_barrier_complete(unsigned* bar, unsigned x, unsigned& nloc, unsigned& nx) {
    const unsigned G = gridDim.x * gridDim.y * gridDim.z;
    unsigned sum, cnt, mine, sp = 0u;
    for (;;) {
        sum = 0u; cnt = 0u; mine = 0u;
#pragma unroll
        for (unsigned j = 0; j < 16; ++j) { const unsigned c = xb_ld(&bar[XB_XCNT(j)]); sum += c; cnt += (c > 0u) ? 1u : 0u; mine = (j == x) ? c : mine; }
        if (sum == G) break;
        __builtin_amdgcn_s_sleep(1);
        if ((++sp & 255u) == 0u) { if (xb_ld(&bar[XB_TMO])) break; if (sp > XB_SPIN_CAP) { atomicAdd(&bar[XB_TMO], 1u); break; } }
    }
    nloc = mine > 0u ? mine : 1u; nx = cnt > 0u ? cnt : 1u;
}

__device__ __forceinline__ void xcd_barrier(const XcdBarrier& b) {
    asm volatile("s_waitcnt vmcnt(0)" ::: "memory");
    __syncthreads();
    if (threadIdx.x == 0) {
        unsigned* bar = b.bar;
        unsigned bx = __builtin_amdgcn_readfirstlane(b.x); asm volatile("" : "+s"(bx));
        __builtin_amdgcn_s_waitcnt(0);
        unsigned nloc = b.st[0], nx = b.st[1];
        if (nloc == 0u) { xcd_barrier_complete(bar, bx, nloc, nx); b.st[0] = nloc; b.st[1] = nx; }
        const unsigned old = xb_add(&bar[XB_XSUB(bx)], 1u);
        const unsigned gen = old / nloc;
        if (old + 1u == (gen + 1u) * nloc) {
            __builtin_amdgcn_fence(__ATOMIC_RELEASE, "agent");
            asm volatile("s_waitcnt vmcnt(0)" ::: "memory");
            const unsigned og = xb_add(&bar[XB_TOP], 1u);
            const unsigned tg = og / nx;
            if (og + 1u == (tg + 1u) * nx) xb_add(&bar[XB_TOPGEN], 1u);
            else XB_SPIN(xb_ld(&bar[XB_TOPGEN]) == tg, bar);
            __builtin_amdgcn_fence(__ATOMIC_ACQUIRE, "agent");
            xb_add(&bar[XB_XGEN(bx)], 1u);
            asm volatile("s_waitcnt vmcnt(0)" ::: "memory");
        } else {
            XB_SPIN(xb_ld(&bar[XB_XGEN(bx)]) == gen, bar);
            __builtin_amdgcn_fence(__ATOMIC_ACQUIRE, "agent");
            asm volatile("s_waitcnt vmcnt(0)" ::: "memory");
        }
    }
    __syncthreads();
}

namespace pg8 {
#define PG8_LAS __attribute__((address_space(3)))
typedef unsigned short bf16_t;
typedef short bf16x8 __attribute__((ext_vector_type(8)));
typedef float f32x4 __attribute__((ext_vector_type(4)));
typedef unsigned u32x4 __attribute__((ext_vector_type(4)));
constexpr int BM = 256, BK = 64, HALF = 128, HTB = HALF * BK * 2  , STAGE_BYTES = 8 * HTB, NXCD = 8, WGM = 8;

__host__ __device__ __forceinline__ int lds_byte(int r, int c) { const int st = (r >> 4) * 2 + (c >> 5), rr = r & 15, cc = c & 31, ob = rr * 64 + cc * 2; return st * 1024 + (ob ^ (((ob >> 9) & 1) << 5)); }
__host__ __device__ __forceinline__ void stage_rc(int b, int& R, int& C) { const int st = b / 1024, sb = b % 1024, swz = sb ^ (((sb >> 9) & 1) << 5); R = (st >> 1) * 16 + swz / 64; C = (st & 1) * 32 + (swz % 64) / 2; }
__host__ __device__ __forceinline__ int perm32(int rho) { const int n = rho >> 4, i = rho & 15; return 8 * (i >> 2) + 4 * n + (i & 3); }

struct Unit { int pm, pn, k0, nt, part; };
struct Gemm { const bf16_t* A; const bf16_t* Bt; int M, N, K; };

struct StaticOrder {
    int nM, nN, nwg, G, c;
    __host__ __device__ void init(int M, int N, int G_, int c_) { nM = M / BM; nN = N / BM; nwg = nM * nN; G = G_; c = c_; }
    __host__ __device__ bool next(int i, Unit& u) const {
        const long L = (long)i * G + c; if (L >= nwg) return false;
        int wgid = (int)L; { const int q = nwg / NXCD, r = nwg % NXCD, xcd = wgid % NXCD, off = wgid / NXCD; wgid = (xcd < r ? xcd * (q + 1) : r * (q + 1) + (xcd - r) * q) + off; }
        const int nig = WGM * nN, gid = wgid / nig, fm = gid * WGM, gsz = (nM - fm) < WGM ? (nM - fm) : WGM;
        u.pm = fm + ((wgid % nig) % gsz); u.pn = (wgid % nig) / gsz; u.k0 = 0; u.nt = 0; u.part = -1; return true;
    }
    __device__ __forceinline__ void a_ready(const Unit&) const {}
    __device__ __forceinline__ void done(const Unit&) const {}
};
struct SplitOrder {
    static constexpr int NMF = 64, NN = 8, PARTS = 8, NFULL = NMF * NN;
    int nsplit, ntK, G, c;
    __host__ __device__ void init(int Msplit, int K, int G_, int c_) { nsplit = (Msplit / BM) * NN * PARTS; ntK = K / BK; G = G_; c = c_; }
    __host__ __device__ bool next(int i, Unit& u) const {
        const int L = i * G + c, p = L - NFULL; const bool fullu = L < NFULL;
        const int wgid = (L % NXCD) * (NFULL / NXCD) + L / NXCD, nig = WGM * NN, fm = (wgid / nig) * WGM;
        const int q = p & 7, cu = p >> 3, h = ntK >> 1, ks = ((h * q) >> 3) << 1, ke = ((h * (q + 1)) >> 3) << 1;
        u.pm = fullu ? fm + ((wgid % nig) % WGM) : NMF + (cu >> 3);
        u.pn = fullu ? (wgid % nig) / WGM : (cu & 7);
        u.k0 = fullu ? 0 : ks; u.nt = fullu ? 0 : ke - ks; u.part = fullu ? -1 : q;
        return fullu || p < nsplit;
    }
    __device__ __forceinline__ void a_ready(const Unit&) const {}
    __device__ __forceinline__ void done(const Unit&) const {}
};
__device__ __forceinline__ unsigned cvt_pk_bf16(float lo, float hi) { unsigned r; asm volatile("v_cvt_pk_bf16_f32 %0, %1, %2" : "=v"(r) : "v"(lo), "v"(hi)); return r; }
template <class Epi, class Sched, bool ALIGN_EPI = false, bool SP2 = false>
__device__ __forceinline__ void gemm_phase(PG8_LAS unsigned char* lds, const Gemm g, const Sched& S, const Epi& E) {
    int tid_ = threadIdx.x; asm volatile("" : "+v"(tid_));
    const int tid = tid_, wid = __builtin_amdgcn_readfirstlane(tid >> 6), lane = tid & 63, wr = wid >> 2, wc = wid & 3, fr = lane & 15, fq = lane >> 4;
    const int K = g.K, nt = K / BK;
    unsigned voffA[2], voffB[2];
#pragma unroll
    for (int i = 0; i < 2; ++i) { int R, C; stage_rc(tid * 16 + i * 8192, R, C); const int Rb = Epi::PERM ? ((R & ~31) + perm32(R & 31)) : R;
        voffA[i] = (unsigned)(R * K + C) * 2u; voffB[i] = (unsigned)(Rb * K + C) * 2u; }
    const unsigned kstep = BK * 2;
    const unsigned hstep = (unsigned)HALF * K * 2;
    const unsigned tstep = 2 * hstep;
    const unsigned ldsw = (unsigned)wid * 1024u;
    const int aoff = lds_byte(wr * 64 + fr, fq * 8), boff = lds_byte(wc * 32 + fr, fq * 8);
#define PG8_SA(b, h) (((b) * 2 + (h)) * HTB)
#define PG8_SB(b, h) ((4 + (b) * 2 + (h)) * HTB)
#define PG8_STAGE(bufoff, gbase, voff) do { _Pragma("unroll") for (int _i = 0; _i < 2; ++_i) \
        __builtin_amdgcn_global_load_lds((const unsigned*)((const char*)(gbase) + (voff)[_i]), (PG8_LAS unsigned*)(lds + (bufoff) + ldsw + _i * 8192), 16, 0, 0); } while (0)
#define PG8_LDA(dst, b, h) do { _Pragma("unroll") for (int m = 0; m < 4; ++m) _Pragma("unroll") for (int k = 0; k < 2; ++k) dst[m][k] = *(const PG8_LAS bf16x8*)(lds + PG8_SA(b, h) + aoff + m * 2048 + k * 1024); } while (0)
#define PG8_LDB(dst, b, h) do { _Pragma("unroll") for (int n = 0; n < 2; ++n) _Pragma("unroll") for (int k = 0; k < 2; ++k) dst[n][k] = *(const PG8_LAS bf16x8*)(lds + PG8_SB(b, h) + boff + n * 2048 + k * 1024); } while (0)
#define PG8_MMA(ai, bj, At, Bt) do { __builtin_amdgcn_s_setprio(1); _Pragma("unroll") for (int m = 0; m < 4; ++m) _Pragma("unroll") for (int n = 0; n < 2; ++n) _Pragma("unroll") for (int k = 0; k < 2; ++k) \
        acc[ai][bj][m][n] = __builtin_amdgcn_mfma_f32_16x16x32_bf16(Bt[n][k], At[m][k], acc[ai][bj][m][n], 0, 0, 0); __builtin_amdgcn_s_setprio(0); } while (0)
#define PG8_WAIT_V(n) asm volatile("s_waitcnt vmcnt(" #n ")" ::: "memory")
#define PG8_WAIT_L(n) asm volatile("s_waitcnt lgkmcnt(" #n ")" ::: "memory")
#define PG8_BAR __builtin_amdgcn_s_barrier()
#define PG8_SCHED __builtin_amdgcn_sched_barrier(0)
    Unit cur, nxt; int ui = 0;
    if (!S.next(0, cur)) return;
    f32x4 acc[2][2][4][2];
#pragma unroll
    for (int a = 0; a < 2; ++a)
#pragma unroll
        for (int b = 0; b < 2; ++b)
#pragma unroll
            for (int m = 0; m < 4; ++m)
#pragma unroll
                for (int n = 0; n < 2; ++n) acc[a][b][m][n] = (f32x4){0.f, 0.f, 0.f, 0.f};
    bf16x8 At[4][2], B0[2][2], B1[2][2];
    unsigned cA = (unsigned)cur.pm * tstep + (unsigned)cur.k0 * kstep, cB = (unsigned)cur.pn * tstep + (unsigned)cur.k0 * kstep;
    S.a_ready(cur);
    if constexpr (SP2) {
        PG8_STAGE(PG8_SB(0, 0), (const char*)g.Bt + (size_t)(cB), voffB); PG8_STAGE(PG8_SB(0, 1), (const char*)g.Bt + (size_t)(cB + hstep), voffB); PG8_STAGE(PG8_SA(0, 0), (const char*)g.A + (size_t)(cA), voffA); PG8_STAGE(PG8_SA(0, 1), (const char*)g.A + (size_t)(cA + hstep), voffA);
        if (wr == 1) PG8_BAR;
        PG8_WAIT_V(2); PG8_BAR;
        PG8_STAGE(PG8_SB(1, 0), (const char*)g.Bt + (size_t)(cB + kstep), voffB); PG8_STAGE(PG8_SA(1, 0), (const char*)g.A + (size_t)(cA + kstep), voffA); PG8_STAGE(PG8_SB(1, 1), (const char*)g.Bt + (size_t)(cB + hstep + kstep), voffB);
        PG8_WAIT_V(6); PG8_BAR;
    } else {
        PG8_STAGE(PG8_SB(0, 0), (const char*)g.Bt + (size_t)(cB), voffB); PG8_STAGE(PG8_SA(0, 0), (const char*)g.A + (size_t)(cA), voffA); PG8_STAGE(PG8_SB(0, 1), (const char*)g.Bt + (size_t)(cB + hstep), voffB); PG8_STAGE(PG8_SA(0, 1), (const char*)g.A + (size_t)(cA + hstep), voffA);
        if (wr == 1) PG8_BAR;
        PG8_WAIT_V(4); PG8_BAR;
        PG8_STAGE(PG8_SB(1, 0), (const char*)g.Bt + (size_t)(cB + kstep), voffB); PG8_STAGE(PG8_SA(1, 0), (const char*)g.A + (size_t)(cA + kstep), voffA); PG8_STAGE(PG8_SB(1, 1), (const char*)g.Bt + (size_t)(cB + hstep + kstep), voffB);
        PG8_WAIT_V(6); PG8_BAR;
    }
    for (;;) {
        const bool has_next = S.next(ui + 1, nxt);
        const unsigned nA = has_next ? (unsigned)nxt.pm * tstep + (unsigned)nxt.k0 * kstep : cA, nB = has_next ? (unsigned)nxt.pn * tstep + (unsigned)nxt.k0 * kstep : cB;
        const int unt = cur.nt ? cur.nt : nt;
        for (int t = 0; t < unt; t += 2) {
            const bool last = (t == unt - 2);
            const unsigned a1 = cA + (unsigned)(t + 1) * kstep;
            const unsigned a2 = last ? nA : cA + (unsigned)(t + 2) * kstep, b2 = last ? nB : cB + (unsigned)(t + 2) * kstep;
            const unsigned a3 = a2 + kstep, b3 = b2 + kstep;
            if (last && has_next) S.a_ready(nxt);
            if constexpr (SP2) {
            PG8_LDB(B0, 0, 0); PG8_LDB(B1, 0, 1); PG8_SCHED; PG8_LDA(At, 0, 0); PG8_STAGE(PG8_SA(1, 1), (const char*)g.A + (size_t)(a1 + hstep), voffA);
            PG8_WAIT_V(8); PG8_WAIT_L(0); PG8_BAR; PG8_MMA(0, 0, At, B0); PG8_MMA(0, 1, At, B1); PG8_BAR; PG8_SCHED;
            PG8_LDA(At, 0, 1); PG8_STAGE(PG8_SB(0, 0), (const char*)g.Bt + (size_t)(b2), voffB); PG8_STAGE(PG8_SB(0, 1), (const char*)g.Bt + (size_t)(b2 + hstep), voffB); PG8_STAGE(PG8_SA(0, 0), (const char*)g.A + (size_t)(a2), voffA);
            PG8_WAIT_V(8); PG8_WAIT_L(0); PG8_BAR; PG8_MMA(1, 0, At, B0); PG8_MMA(1, 1, At, B1); PG8_BAR; PG8_SCHED;
            PG8_LDB(B0, 1, 0); PG8_LDB(B1, 1, 1); PG8_SCHED; PG8_LDA(At, 1, 0); PG8_STAGE(PG8_SA(0, 1), (const char*)g.A + (size_t)(a2 + hstep), voffA);
            PG8_WAIT_V(8); PG8_WAIT_L(0); PG8_BAR; PG8_MMA(0, 0, At, B0); PG8_MMA(0, 1, At, B1); PG8_BAR; PG8_SCHED;
            PG8_LDA(At, 1, 1); PG8_STAGE(PG8_SB(1, 0), (const char*)g.Bt + (size_t)(b3), voffB); PG8_STAGE(PG8_SB(1, 1), (const char*)g.Bt + (size_t)(b3 + hstep), voffB); PG8_STAGE(PG8_SA(1, 0), (const char*)g.A + (size_t)(a3), voffA);
            PG8_WAIT_V(8); PG8_WAIT_L(0); PG8_BAR; PG8_MMA(1, 0, At, B0); PG8_MMA(1, 1, At, B1); PG8_BAR; PG8_SCHED;
            } else {
            PG8_LDB(B0, 0, 0); PG8_SCHED; PG8_LDA(At, 0, 0); PG8_STAGE(PG8_SA(1, 1), (const char*)g.A + (size_t)(a1 + hstep), voffA);
            PG8_WAIT_L(8); PG8_BAR; PG8_WAIT_L(0); PG8_MMA(0, 0, At, B0); PG8_BAR; PG8_SCHED;
            PG8_LDB(B1, 0, 1); PG8_STAGE(PG8_SB(0, 0), (const char*)g.Bt + (size_t)(b2), voffB);
            PG8_BAR; PG8_WAIT_L(0); PG8_MMA(0, 1, At, B1); PG8_BAR;
            PG8_LDA(At, 0, 1); PG8_STAGE(PG8_SA(0, 0), (const char*)g.A + (size_t)(a2), voffA);
            PG8_BAR; PG8_WAIT_L(0); PG8_MMA(1, 0, At, B0); PG8_BAR; PG8_SCHED;
            PG8_STAGE(PG8_SB(0, 1), (const char*)g.Bt + (size_t)(b2 + hstep), voffB);
            PG8_WAIT_V(6); PG8_BAR; PG8_MMA(1, 1, At, B1); PG8_BAR;
            PG8_LDB(B0, 1, 0); PG8_SCHED; PG8_LDA(At, 1, 0); PG8_STAGE(PG8_SA(0, 1), (const char*)g.A + (size_t)(a2 + hstep), voffA);
            PG8_WAIT_L(8); PG8_BAR; PG8_WAIT_L(0); PG8_MMA(0, 0, At, B0); PG8_BAR; PG8_SCHED;
            PG8_LDB(B1, 1, 1); PG8_STAGE(PG8_SB(1, 0), (const char*)g.Bt + (size_t)(b3), voffB);
            PG8_BAR; PG8_WAIT_L(0); PG8_MMA(0, 1, At, B1); PG8_BAR;
            PG8_LDA(At, 1, 1); PG8_STAGE(PG8_SA(1, 0), (const char*)g.A + (size_t)(a3), voffA);
            PG8_BAR; PG8_WAIT_L(0); PG8_MMA(1, 0, At, B0); PG8_BAR; PG8_SCHED;
            PG8_STAGE(PG8_SB(1, 1), (const char*)g.Bt + (size_t)(b3 + hstep), voffB);
            PG8_WAIT_V(6); PG8_BAR; PG8_MMA(1, 1, At, B1); PG8_BAR;
            }
        }
        if constexpr (ALIGN_EPI) { if (wr == 0) PG8_BAR; }
        if constexpr (!Epi::AFTER_DRAIN) { int t_ = threadIdx.x; asm volatile("" : "+v"(t_)); const int l_ = t_ & 63, w_ = __builtin_amdgcn_readfirstlane(t_ >> 6);
            E(acc, cur, w_ >> 2, w_ & 3, l_ & 15, l_ >> 4); S.done(cur); }
        if (!has_next) break;
#pragma unroll
        for (int a = 0; a < 2; ++a)
#pragma unroll
            for (int b = 0; b < 2; ++b)
#pragma unroll
                for (int m = 0; m < 4; ++m)
#pragma unroll
                    for (int n = 0; n < 2; ++n) acc[a][b][m][n] = (f32x4){0.f, 0.f, 0.f, 0.f};
        cur = nxt; cA = nA; cB = nB; ++ui;
        if constexpr (ALIGN_EPI) { if (wr == 1) PG8_BAR; }
    }
    PG8_WAIT_V(0);
    if constexpr (!ALIGN_EPI) { if (wr == 0) PG8_BAR; }
    PG8_BAR;
    if constexpr (Epi::AFTER_DRAIN) { E.fused(acc, cur, wr, wc, fr, fq, lds, wid, lane); S.done(cur); }
#undef PG8_SA
#undef PG8_SB
#undef PG8_STAGE
#undef PG8_LDA
#undef PG8_LDB
#undef PG8_MMA
#undef PG8_WAIT_V
#undef PG8_WAIT_L
#undef PG8_BAR
#undef PG8_SCHED
}
}

#define GAS __attribute__((address_space(1)))
typedef unsigned short bf16;
typedef float f32x4 __attribute__((ext_vector_type(4)));
typedef unsigned v4u __attribute__((ext_vector_type(4)));
typedef unsigned v2u __attribute__((ext_vector_type(2)));
constexpr int D = 2048, NB = 4, SEQ = 4096, CTXL = 256, DFF = 5504, NMOD = 9;
constexpr int TL = NB * SEQ, TC = NB * CTXL, TT = TL + TC;
constexpr int MIXH = 1024;
constexpr int EV_COLS = 7216, EV_PAD = 7424, OD_COLS = 5120;
constexpr int NWAVES = 8, NTHR = 512;
constexpr float EPS = 1e-6f;

constexpr size_t MiB = 1u << 20;
constexpr size_t WS_CTL = 0, CTL_ZERO_BYTES = 64 * 1024;
constexpr size_t WS_MOD = 1 * MiB;
constexpr size_t WS_MODP = 2 * MiB;
constexpr int MOD_KC = 16;
constexpr size_t WS_WGU = 16 * MiB;
constexpr size_t SZ_WGU = (size_t)11008 * 2048 * 2;
constexpr size_t WS_WD = WS_WGU + 4 * SZ_WGU;
constexpr size_t SZ_WD = (size_t)2048 * 5504 * 2;
constexpr size_t WS_WIN_EV = WS_WD + 4 * SZ_WD;
constexpr size_t WS_WOUT_EV = WS_WIN_EV + (size_t)EV_PAD * 2048 * 2;
constexpr size_t WS_WIN_OD = WS_WOUT_EV + (size_t)2048 * 2048 * 2;
constexpr size_t WS_WOUT_OD = WS_WIN_OD + (size_t)OD_COLS * 2048 * 2;
constexpr size_t WS_WGLU = WS_WOUT_OD + (size_t)2048 * 2048 * 2;
constexpr size_t WS_XC = WS_WGLU + (size_t)1024 * 1024 * 2;
constexpr size_t WS_HB = WS_XC + (size_t)TC * D * 4;
constexpr size_t WS_R = WS_HB + (size_t)TT * D * 2;
constexpr size_t WS_HID = WS_R;
constexpr size_t WS_Y = WS_R + 183 * MiB;
constexpr size_t WS_S = WS_R;
constexpr size_t WS_GT = WS_R + 247 * MiB;
constexpr size_t WS_GB = WS_R + 264 * MiB;
constexpr size_t WS_O = WS_R + 298 * MiB;
constexpr size_t SZ_O = (size_t)TT * 1024 * 2;
constexpr size_t WS_XL = WS_R + 434 * MiB;
constexpr size_t WS_QK2 = WS_XL + (size_t)TL * D * 2;
constexpr size_t WS_GP = WS_QK2 + (size_t)TT * 2048 * 2;
constexpr size_t WS_QKS = WS_GP + (size_t)TT * 8 * 4 * 4;
constexpr size_t WS_VEC = WS_QKS + (size_t)2 * TT * 1024 * 2;
constexpr size_t WS_GPK = WS_VEC + (size_t)NB * 4 * 2 * 68 * 384 * 4;
constexpr size_t WS_PP = WS_GPK + (size_t)NB * 4 * 2 * 68 * 256 * 4;
constexpr size_t WS_RS = WS_PP + (size_t)NB * 4 * 2 * 68 * 4096 * 2;
constexpr size_t WS_END = WS_RS + (size_t)NB * 4 * 2 * 68 * 64 * 4;
constexpr size_t WS_YCP = WS_R + 320 * MiB;
constexpr int YPARTS = 8;
static_assert(WS_YCP >= WS_Y + (size_t)TT * D * 2 && WS_YCP + (size_t)YPARTS * TC * D * 4 <= WS_XL && WS_O + 4 * SZ_O <= WS_XL, "ws map");
static_assert(WS_HID + (size_t)TT * DFF * 2 <= WS_Y && WS_S + (size_t)TT * EV_PAD * 2 <= WS_GT && WS_GT + (size_t)TT * 256 * 4 <= WS_GB && WS_GB + (size_t)TT * 1024 * 2 <= WS_O, "ws map");
static_assert(WS_Y + (size_t)TT * D * 2 <= WS_O, "ws map");

constexpr int LDS_BYTES = 156 * 1024;
constexpr int MISC_OFF = LDS_BYTES - 64;

struct Args { const float* in[34]; float* out; unsigned char* ws; };
#define ARG(k) ((const float*)(GAS const float*)(a.in[opaque_idx(k)]))
__device__ __forceinline__ unsigned char* wsp(unsigned char* w, size_t off) { asm volatile("" : "+s"(off)); return w + off; }
__device__ __forceinline__ int opaque_idx(int k) { asm volatile("" : "+s"(k)); return k; }

__device__ __forceinline__ unsigned f2bf(float f) { unsigned u = __float_as_uint(f); u += 0x7FFFu + ((u >> 16) & 1u); return u >> 16; }
typedef __bf16 bf16x2_t __attribute__((ext_vector_type(2)));
typedef float f32x2_t __attribute__((ext_vector_type(2)));
__device__ __forceinline__ unsigned pk2(float lo, float hi) { const f32x2_t v = {lo, hi}; const bf16x2_t b = __builtin_convertvector(v, bf16x2_t); return __builtin_bit_cast(unsigned, b); }
__device__ __forceinline__ float bf2f(unsigned short b) { return __uint_as_float(((unsigned)b) << 16); }
__device__ __forceinline__ float wave_sum(float v) {
#pragma unroll
    for (int o = 1; o < 64; o <<= 1) v += __shfl_xor(v, o);
    return v;
}
__device__ __forceinline__ float fast_silu(float g) { return g * __builtin_amdgcn_rcpf(1.0f + __expf(-g)); }
__device__ __forceinline__ float fast_sigmoid(float g) { return __builtin_amdgcn_rcpf(1.0f + __expf(-g)); }

struct TJob { const float* src; bf16* dst; int K, N, map, tstart; };
constexpr int NJOBS = 17;
__device__ __forceinline__ int tj_tiles(int K, int N) { return (K / 64) * ((N + 31) / 32); }
__device__ __forceinline__ void transpose_tile(const TJob& j, int tl, int lane) {
    const int nblk = (j.N + 31) / 32, kb = tl / nblk, nb = tl % nblk, k0 = 64 * kb, n0 = 32 * nb;
    const int kb8 = lane >> 3, nb4 = lane & 7, n = n0 + 4 * nb4;
    int drow0;
    if (j.map == 0) drow0 = n0;
    else if (j.map == 1) drow0 = (n0 / 128) * 256 + (n0 % 128);
    else if (j.map == 2) drow0 = (n0 / 128) * 256 + (n0 % 128) + 128;
    else drow0 = (nb < 96) ? n0 : (nb == 96 ? 7168 : (nb < 225 ? n0 - 32 : 7200));
    if (n < j.N) {
        const float* s = j.src + (size_t)(k0 + 8 * kb8) * j.N + n;
        f32x4 v[8];
#pragma unroll
        for (int i = 0; i < 8; ++i) v[i] = *(const f32x4*)(s + (size_t)i * j.N);
        bf16* d = j.dst + (size_t)(drow0 + 4 * nb4) * j.K + k0 + 8 * kb8;
#pragma unroll
        for (int e = 0; e < 4; ++e) { v4u o; o.x = pk2(v[0][e], v[1][e]); o.y = pk2(v[2][e], v[3][e]); o.z = pk2(v[4][e], v[5][e]); o.w = pk2(v[6][e], v[7][e]);
            *(v4u*)(d + (size_t)e * j.K) = o; }
    }
}

struct NormP {
    const float* xin_lat; const float* xin_ctx; float* xout_lat; float* xout_ctx; const bf16* y; bf16* h;
    int rows_end; int has_y, has_h; float w;
    const float* y_ctx;
    int lp, sp;
    int ln, sn;
};
__device__ __forceinline__ void norm_phase(const NormP& p, const float* mod, const float* norm_pre, const float* norm_post, LAS unsigned char* lds, int gw, int ngw, int tid, int lane) {
    { int t2 = threadIdx.x; asm volatile("" : "+v"(t2)); tid = t2; lane = t2 & 63; gw = blockIdx.x * NWAVES + __builtin_amdgcn_readfirstlane(t2 >> 6); }
    LAS float* TA = (LAS float*)lds; LAS float* TB = TA + 5 * D; LAS float* TCc = TB + 5 * D;
    for (int i = tid; i < 5 * D; i += NTHR) { const int var = i >> 11, j = i & (D - 1);
        if (p.has_y) TA[i] = p.w * mod[((size_t)p.lp * 5 + var) * (NMOD * D) + (3 * p.sp + 2) * D + j] * norm_post[(p.lp * 3 + p.sp) * D + j];
        if (p.has_h) { TB[i] = norm_pre[(p.ln * 3 + p.sn) * D + j] * (1.0f + mod[((size_t)p.ln * 5 + var) * (NMOD * D) + (3 * p.sn + 1) * D + j]);
                       TCc[i] = mod[((size_t)p.ln * 5 + var) * (NMOD * D) + (3 * p.sn) * D + j]; } }
    __syncthreads();
    for (int r = gw; r < p.rows_end; r += ngw) {
        const int var = r < TL ? (r >> 12) : 4;
        const float* xi = r < TL ? p.xin_lat + (size_t)r * D : p.xin_ctx + (size_t)(r - TL) * D;
        float* xo = r < TL ? p.xout_lat + (size_t)r * D : p.xout_ctx + (size_t)(r - TL) * D;
        f32x4 xv[8];
#pragma unroll
        for (int j = 0; j < 8; ++j) xv[j] = *(const f32x4*)(xi + 4 * lane + 256 * j);
        if (p.has_y) {
            const bool yc = (r >= TL) && p.y_ctx; const float* yr = p.y_ctx + (size_t)(r - TL) * D; f32x4 yv[8]; float s = 0.f;
            if (!yc) { const bf16* yb = p.y + (size_t)r * D;
#pragma unroll
                for (int j = 0; j < 8; ++j) { const v2u w = *(const v2u*)(yb + 4 * lane + 256 * j); yv[j] = (f32x4){__uint_as_float(w.x << 16), __uint_as_float(w.x & 0xffff0000u), __uint_as_float(w.y << 16), __uint_as_float(w.y & 0xffff0000u)}; }
            } else {
#pragma unroll
                for (int j = 0; j < 8; ++j) yv[j] = *(const f32x4*)(yr + 4 * lane + 256 * j);
                for (int q = 1; q < YPARTS; ++q) {
#pragma unroll
                for (int j = 0; j < 8; ++j) yv[j] += *(const f32x4*)(yr + (size_t)q * TC * D + 4 * lane + 256 * j); } }
#pragma unroll
            for (int j = 0; j < 8; ++j) { s += (yv[j].x * yv[j].x + yv[j].y * yv[j].y) + (yv[j].z * yv[j].z + yv[j].w * yv[j].w); }
            const float rstd = 1.0f / sqrtf(wave_sum(s) * (1.0f / D) + EPS);
#pragma unroll
            for (int j = 0; j < 8; ++j) { const f32x4 a = *(const LAS f32x4*)(TA + var * D + 4 * lane + 256 * j); xv[j] = xv[j] + a * (yv[j] * rstd); *(f32x4*)(xo + 4 * lane + 256 * j) = xv[j]; }
        }
        if (p.has_h) {
            float s = 0.f;
#pragma unroll
            for (int j = 0; j < 8; ++j) s += (xv[j].x * xv[j].x + xv[j].y * xv[j].y) + (xv[j].z * xv[j].z + xv[j].w * xv[j].w);
            const float rstd = 1.0f / sqrtf(wave_sum(s) * (1.0f / D) + EPS);
            bf16* hr = p.h + (size_t)r * D;
#pragma unroll
            for (int j = 0; j < 8; ++j) { const f32x4 b = *(const LAS f32x4*)(TB + var * D + 4 * lane + 256 * j), c = *(const LAS f32x4*)(TCc + var * D + 4 * lane + 256 * j);
                const f32x4 o = xv[j] * rstd * b + c; v2u w; w.x = pk2(o.x, o.y); w.y = pk2(o.z, o.w); *(v2u*)(hr + 4 * lane + 256 * j) = w; }
        }
    }
    __syncthreads();
}

struct EpiSwiGLU {
    static constexpr bool PERM = true, AFTER_DRAIN = false;
    bf16* O; int ldc;
    __device__ __forceinline__ void operator()(const pg8::f32x4 (&acc)[2][2][4][2], const pg8::Unit& u, int wr, int wc, int fr, int fq) const {
        const int row0 = u.pm * 256 + wr * 64 + fr, col0 = u.pn * 128 + wc * 32 + 8 * fq;
#pragma unroll
        for (int ai = 0; ai < 2; ++ai)
#pragma unroll
            for (int m = 0; m < 4; ++m) { bf16* rowp = O + (size_t)(row0 + ai * 128 + m * 16) * ldc + col0;
                const pg8::f32x4 g0 = acc[ai][0][m][0], g1 = acc[ai][0][m][1], u0 = acc[ai][1][m][0], u1 = acc[ai][1][m][1];
                v4u w; w.x = pk2(fast_silu(g0[0]) * u0[0], fast_silu(g0[1]) * u0[1]); w.y = pk2(fast_silu(g0[2]) * u0[2], fast_silu(g0[3]) * u0[3]);
                w.z = pk2(fast_silu(g1[0]) * u1[0], fast_silu(g1[1]) * u1[1]); w.w = pk2(fast_silu(g1[2]) * u1[2], fast_silu(g1[3]) * u1[3]);
                *(v4u*)rowp = w; }
    }
};
struct EpiF32 {
    static constexpr bool PERM = true, AFTER_DRAIN = false;
    bf16* C; float* Cs;
    static constexpr int ldc = D;
    __device__ __forceinline__ void operator()(const pg8::f32x4 (&acc)[2][2][4][2], const pg8::Unit& u, int wr, int wc, int fr, int fq) const {
        const int row0 = u.pm * 256 + wr * 64 + fr, col0 = u.pn * 256 + wc * 32 + 8 * fq;
        if (u.part >= 0) {
            float* base = Cs + ((size_t)u.part * TC - (size_t)TL) * D;
#pragma unroll
            for (int ai = 0; ai < 2; ++ai)
#pragma unroll
                for (int m = 0; m < 4; ++m) { float* rowp = base + (size_t)(row0 + ai * 128 + m * 16) * ldc + col0;
#pragma unroll
                    for (int bj = 0; bj < 2; ++bj) { *(pg8::f32x4*)(rowp + bj * 128) = acc[ai][bj][m][0]; *(pg8::f32x4*)(rowp + bj * 128 + 4) = acc[ai][bj][m][1]; } }
        } else {
#pragma unroll
            for (int ai = 0; ai < 2; ++ai)
#pragma unroll
                for (int m = 0; m < 4; ++m) { bf16* rowp = C + (size_t)(row0 + ai * 128 + m * 16) * ldc + col0;
#pragma unroll
                    for (int bj = 0; bj < 2; ++bj) { const pg8::f32x4 v0 = acc[ai][bj][m][0], v1 = acc[ai][bj][m][1];
                        v4u w; w.x = pk2(v0[0], v0[1]); w.y = pk2(v0[2], v0[3]); w.z = pk2(v1[0], v1[1]); w.w = pk2(v1[2], v1[3]);
                        *(v4u*)(rowp + bj * 128) = w; } }
        }
    }
};
struct EpiS {
    static constexpr bool PERM = true, AFTER_DRAIN = false;
    bf16* S; int ldc; float* GT; int gt_pn;
    __device__ __forceinline__ void operator()(const pg8::f32x4 (&acc)[2][2][4][2], const pg8::Unit& u, int wr, int wc, int fr, int fq) const {
        const int row0 = u.pm * 256 + wr * 64 + fr;
        if (u.pn == gt_pn) {
            if (wc < 2) {
#pragma unroll
                for (int ai = 0; ai < 2; ++ai)
#pragma unroll
                    for (int m = 0; m < 4; ++m) { float* rowp = GT + (size_t)(row0 + ai * 128 + m * 16) * 256 + wc * 32 + 8 * fq;
                        *(pg8::f32x4*)rowp = acc[ai][0][m][0]; *(pg8::f32x4*)(rowp + 4) = acc[ai][0][m][1]; }
            }
        } else {
            const int col0 = u.pn * 256 + wc * 32 + 8 * fq;
#pragma unroll
            for (int ai = 0; ai < 2; ++ai)
#pragma unroll
                for (int m = 0; m < 4; ++m) { bf16* rowp = S + (size_t)(row0 + ai * 128 + m * 16) * ldc + col0;
#pragma unroll
                    for (int bj = 0; bj < 2; ++bj) { const pg8::f32x4 v0 = acc[ai][bj][m][0], v1 = acc[ai][bj][m][1];
                        v4u w; w.x = pk2(v0[0], v0[1]); w.y = pk2(v0[2], v0[3]); w.z = pk2(v1[0], v1[1]); w.w = pk2(v1[2], v1[3]);
                        *(v4u*)(rowp + bj * 128) = w; } }
        }
    }
};

#define DEV __device__ __forceinline__
#define LP(T) LAS T*
#define SYNC() do { asm volatile("s_waitcnt lgkmcnt(0)" ::: "memory"); __builtin_amdgcn_s_barrier(); asm volatile("" ::: "memory"); } while (0)
typedef short v8s __attribute__((ext_vector_type(8)));
typedef float v4f __attribute__((ext_vector_type(4)));
#define MFMA16(x, y, c) __builtin_amdgcn_mfma_f32_16x16x32_bf16((x), (y), (c), 0, 0, 0)
#define SHX(v, m) __shfl_xor((v), (m))
#define SHUP(v, d) __shfl_up((v), (d))
#define SHIDX(v, l) __shfl((v), (l))
#define EXPF(x) __expf(x)
#define LOGF(x) __logf(x)
#define RCPF(x) __builtin_amdgcn_rcpf(x)
#define RSQRTF(x) (1.0f / sqrtf(x))
#define PK2(lo, hi) pk2((lo), (hi))
#define F2BF(x) ((unsigned short)f2bf(x))
#define WAVE_SYNC() asm volatile("s_waitcnt lgkmcnt(0)" ::: "memory")
typedef short v4s __attribute__((ext_vector_type(4)));
#define LDS_TR16(p) __builtin_amdgcn_ds_read_tr16_b64_v4i16((LAS v4s*)(p))
#define RDLANE(v, l) __int_as_float(__builtin_amdgcn_readlane(__float_as_int(v), (l)))
#define RDLANE16(v, l) __shfl((v), (l))

DEV int seq_row(int b, int seg, int np, int cm) {
    if (!seg) return TL + b * CTXL + np;
    const int n = cm ? ((np & 63) * 64 + (np >> 6)) : np;
    return b * SEQ + n;
}
DEV int tok_row(int b, int seg, int pos, int dir, int cm) {
    const int len = seg ? SEQ : CTXL;
    return seq_row(b, seg, dir ? len - 1 - pos : pos, cm);
}
DEV float bflo(unsigned u) { return __uint_as_float(u << 16); }
DEV float bfhi(unsigned u) { return __uint_as_float(u & 0xffff0000u); }
DEV float logsigmoidf(float z) { return fminf(z, 0.f) - LOGF(1.0f + EXPF(-fabsf(z))); }
DEV v4f tile_mma(v4f acc, LP(const unsigned char) A, int sa, int m0, LP(const unsigned char) B, int sb, int n0, int ksteps, int fr, int fq) {
    LP(const unsigned char) ap = A + (m0 + fr) * sa + fq * 16;
    LP(const unsigned char) bp = B + (n0 + fr) * sb + fq * 16;
    for (int k = 0; k < ksteps; ++k) {
        const v8s af = *(LP(const v8s))(ap + k * 64);
        const v8s bf = *(LP(const v8s))(bp + k * 64);
        acc = MFMA16(bf, af, acc);
    }
    return acc;
}
DEV v8s tr_frag(LP(const unsigned char) T, int st, int k0, int n0, int lane) {
    const int l16 = lane & 15, fq = lane >> 4;
    LP(const unsigned char) p = T + (k0 + 8 * fq + (l16 >> 2)) * st + (n0 + 4 * (l16 & 3)) * 2;
    const v4s a = LDS_TR16(p), b = LDS_TR16(p + 4 * st);
    return (v8s){a.x, a.y, a.z, a.w, b.x, b.y, b.z, b.w};
}
DEV v4f tile_mma_nt(v4f acc, LP(const unsigned char) A, int sa, int m0, LP(const unsigned char) Bt, int sb, int n0, int ksteps, int lane) {
    const int fr = lane & 15, fq = lane >> 4;
    for (int k = 0; k < ksteps; ++k) { const v8s af = *(LP(const v8s))(A + (m0 + fr) * sa + fq * 16 + k * 64); const v8s bf = tr_frag(Bt, sb, 32 * k, n0, lane); acc = MFMA16(bf, af, acc); }
    return acc;
}
DEV v4f tile_mma_tt(v4f acc, LP(const unsigned char) At, int sa, int m0, LP(const unsigned char) Bt, int sb, int n0, int ksteps, int lane) {
    for (int k = 0; k < ksteps; ++k) { const v8s af = tr_frag(At, sa, 32 * k, m0, lane); const v8s bf = tr_frag(Bt, sb, 32 * k, n0, lane); acc = MFMA16(bf, af, acc); }
    return acc;
}
constexpr int ST128 = 272, ST64 = 144, ST256 = 528, STV = 80;

constexpr int MIX_UNITS = NB * 32;
constexpr int GLA_TASKS = NB * 4 * 2 * (CTXL / 64 + SEQ / 64);
DEV void gla_prep_task(int task, const bf16* S, const float* GT, const float* wg_all, const float* bg_all, bf16* QKS, float* VEC, LP(unsigned char) lds, int tid) {
    constexpr int NCHUNK = CTXL / 64 + SEQ / 64;
    const int cidx = task % NCHUNK, r1 = task / NCHUNK, dir = r1 & 1, h = (r1 >> 1) & 3, b = r1 >> 3;
    const int seg = cidx >= CTXL / 64, ci = seg ? cidx - CTXL / 64 : cidx;
    LP(float) LA = (LP(float))lds; LP(float) SEG = (LP(float))(lds + 32768); LP(float) LR = (LP(float))(lds + 34816); LP(float) WG = (LP(float))(lds + 38912); LP(float) BG = (LP(float))(lds + 47104);
    const int j = tid >> 3, c8 = tid & 7, dc = c8 * 16;
    const float qscale = 0.08838834764831845f;
    const int row = tok_row(b, seg, ci * 64 + j, dir, 0);
    const bf16* sr = S + (size_t)row * EV_PAD;
    const v4u q0 = *(const v4u*)(sr + h * 128 + dc), q1 = *(const v4u*)(sr + h * 128 + dc + 8);
    const v4u k0 = *(const v4u*)(sr + 512 + h * 128 + dc), k1 = *(const v4u*)(sr + 512 + h * 128 + dc + 8);
    for (int i = tid; i < 16 * 128; i += NTHR) { const int m = i >> 7, d = i & 127; WG[i] = wg_all[(dir * 16 + m) * 512 + h * 128 + d]; }
    if (tid < 128) BG[tid] = bg_all[dir * 512 + h * 128 + tid];
    if (tid < 256) { const int rr = tok_row(b, seg, ci * 64 + (tid >> 2), dir, 0); *(LP(v4f))(LR + (tid >> 2) * 16 + (tid & 3) * 4) = *(const v4f*)(GT + (size_t)rr * 256 + dir * 16 + (tid & 3) * 4); }
    SYNC();
    {
        float z[16];
#pragma unroll
        for (int i = 0; i < 16; ++i) z[i] = BG[dc + i];
        for (int m = 0; m < 16; ++m) { const float lrm = LR[j * 16 + m];
#pragma unroll
            for (int i4 = 0; i4 < 4; ++i4) { const v4f w = *(LP(const v4f))(WG + m * 128 + dc + 4 * i4);
                z[4 * i4 + 0] += lrm * w.x; z[4 * i4 + 1] += lrm * w.y; z[4 * i4 + 2] += lrm * w.z; z[4 * i4 + 3] += lrm * w.w; } }
#pragma unroll
        for (int i4 = 0; i4 < 4; ++i4) { v4f o; o.x = logsigmoidf(z[4 * i4]) * 0.0625f; o.y = logsigmoidf(z[4 * i4 + 1]) * 0.0625f; o.z = logsigmoidf(z[4 * i4 + 2]) * 0.0625f; o.w = logsigmoidf(z[4 * i4 + 3]) * 0.0625f;
            *(LP(v4f))(LA + j * 128 + dc + 4 * i4) = o; }
    }
    SYNC();
    {
        const int d = tid & 127, sg = tid >> 7; float acc = 0.f;
        for (int jj = 0; jj < 16; ++jj) { acc += LA[(sg * 16 + jj) * 128 + d]; LA[(sg * 16 + jj) * 128 + d] = acc; }
        SEG[sg * 128 + d] = acc;
    }
    SYNC();
    {
        const int sgj = j >> 4;
        bf16* orow = QKS + ((size_t)dir * TT + row) * 1024 + h * 128 + dc;
#pragma unroll 1
        for (int g = 0; g < 2; ++g) {
            const v4u qv = g ? q1 : q0, kv = g ? k1 : k0;
            const unsigned qw[4] = {qv.x, qv.y, qv.z, qv.w}, kw[4] = {kv.x, kv.y, kv.z, kv.w};
            unsigned oqs[4], oks[4];
#pragma unroll
            for (int i2 = 0; i2 < 4; ++i2) {
                float vqs[2], vks[2];
#pragma unroll
                for (int e = 0; e < 2; ++e) {
                    const int d = dc + 8 * g + 2 * i2 + e;
                    const float s0 = SEG[d], s1 = SEG[128 + d], s2 = SEG[256 + d];
                    const float pre = (sgj > 0 ? s0 : 0.f) + (sgj > 1 ? s1 : 0.f) + (sgj > 2 ? s2 : 0.f);
                    const float bv = LA[j * 128 + d] + pre;
                    const float bmid = LA[32 * 128 + d] + s0 + s1;
                    const float q = (e ? bfhi(qw[i2]) : bflo(qw[i2])) * qscale, k = e ? bfhi(kw[i2]) : bflo(kw[i2]);
                    const float e1 = EXPF(bv - bmid);
                    vqs[e] = q * e1; vks[e] = k * RCPF(e1);
                    if (j == 63) { const float bend = bv; float* vp = VEC + (size_t)task * 384 + d; vp[0] = EXPF(bmid); vp[128] = EXPF(bend - bmid); vp[256] = EXPF(bend); }
                }
                oqs[i2] = PK2(vqs[0], vqs[1]); oks[i2] = PK2(vks[0], vks[1]);
            }
            *(v4u*)(orow + 8 * g) = (v4u){oqs[0], oqs[1], oqs[2], oqs[3]};
            *(v4u*)(orow + 512 + 8 * g) = (v4u){oks[0], oks[1], oks[2], oks[3]};
        }
    }
    SYNC();
}

DEV void gla_unit(const bf16* S, const bf16* QKS, const float* VEC, bf16* O, int unit, LP(unsigned char) lds, int tid) {
    const int lane = tid & 63, wave = tid >> 6, fr = lane & 15, fq = lane >> 4;
    const int vs = unit & 3, dir = (unit >> 2) & 1, h = (unit >> 3) & 3, b = unit >> 5;
    LP(unsigned char) QS = lds; LP(unsigned char) KS = lds + 17408; LP(unsigned char) QB = lds + 34816;
    LP(unsigned char) VV = lds + 52224; LP(unsigned char) PM = lds + 61440; LP(unsigned char) STT = lds + 70656;
    LP(float) DV = (LP(float))(lds + 88064);
    for (int i = tid; i < 64 * ST128 / 4; i += NTHR) ((LP(unsigned))STT)[i] = 0u;
    v4f sacc[4];
#pragma unroll
    for (int i = 0; i < 4; ++i) sacc[i] = (v4f){0.f, 0.f, 0.f, 0.f};
    const int j = tid >> 3, c8 = tid & 7, dc = c8 * 16;
    const int tt = wave >> 1, vt0 = (wave & 1) * 2;
    const int svt = wave & 3, sdt0 = (wave >> 2) * 4;
    bf16* Od = O + (size_t)dir * TT * 1024;
    constexpr int NCHUNK = CTXL / 64 + SEQ / 64;
    const int task0 = ((b * 4 + h) * 2 + dir) * NCHUNK;
    v4u q0, q1, k0, k1, vv; v4f em[4]; v4f dvv = (v4f){0.f, 0.f, 0.f, 0.f};
#define GLA_ISSUE(cx) do { const int seg_ = (cx) >= CTXL / 64, ci_ = seg_ ? (cx) - CTXL / 64 : (cx); \
        const int row_ = tok_row(b, seg_, ci_ * 64 + j, dir, 0); \
        const bf16* qr_ = QKS + ((size_t)dir * TT + row_) * 1024 + h * 128 + dc; \
        q0 = *(const v4u*)(qr_); q1 = *(const v4u*)(qr_ + 8); k0 = *(const v4u*)(qr_ + 512); k1 = *(const v4u*)(qr_ + 520); \
        vv = *(const v4u*)(S + (size_t)row_ * EV_PAD + 1024 + h * 256 + vs * 64 + c8 * 8); \
        const float* vp_ = VEC + (size_t)(task0 + (cx)) * 384; \
        _Pragma("unroll") for (int i_ = 0; i_ < 4; ++i_) em[i_] = *(const v4f*)(vp_ + dc + 4 * i_); \
        if (tid < 64) dvv = *(const v4f*)(vp_ + 128 + tid * 4); } while (0)
    GLA_ISSUE(0);
    SYNC();
    for (int cidx = 0; cidx < NCHUNK; ++cidx) {
        const int seg = cidx >= CTXL / 64, ci = seg ? cidx - CTXL / 64 : cidx;
        {
            *(LP(v4u))(QS + j * ST128 + dc * 2) = q0; *(LP(v4u))(QS + j * ST128 + dc * 2 + 16) = q1;
            *(LP(v4u))(KS + j * ST128 + dc * 2) = k0; *(LP(v4u))(KS + j * ST128 + dc * 2 + 16) = k1;
            const unsigned qw[8] = {q0.x, q0.y, q0.z, q0.w, q1.x, q1.y, q1.z, q1.w}; unsigned ob[8];
#pragma unroll
            for (int i2 = 0; i2 < 8; ++i2) { const v4f e4 = em[i2 >> 1]; const float ea = (i2 & 1) ? e4.z : e4.x, eb = (i2 & 1) ? e4.w : e4.y; ob[i2] = PK2(bflo(qw[i2]) * ea, bfhi(qw[i2]) * eb); }
            *(LP(v4u))(QB + j * ST128 + dc * 2) = (v4u){ob[0], ob[1], ob[2], ob[3]}; *(LP(v4u))(QB + j * ST128 + dc * 2 + 16) = (v4u){ob[4], ob[5], ob[6], ob[7]};
            *(LP(v4u))(VV + j * ST64 + c8 * 16) = vv;
            if (tid < 64) *(LP(v4f))(DV + tid * 4) = dvv;
        }
        if (cidx + 1 < NCHUNK) GLA_ISSUE(cidx + 1);
        SYNC();
        v4f oacc[2]; oacc[0] = (v4f){0.f, 0.f, 0.f, 0.f}; oacc[1] = oacc[0];
        {
#pragma unroll
            for (int i = 0; i < 2; ++i) { const int st = vt0 + i; v4f p = (v4f){0.f, 0.f, 0.f, 0.f};
                if (st <= tt) { p = tile_mma(p, QS, ST128, 16 * tt, KS, ST128, 16 * st, 4, fr, fq);
                    if (st == tt) { if (4 * fq + 0 > fr) p.x = 0.f; if (4 * fq + 1 > fr) p.y = 0.f; if (4 * fq + 2 > fr) p.z = 0.f; if (4 * fq + 3 > fr) p.w = 0.f; } }
                *(LP(v2u))(PM + (16 * tt + fr) * ST64 + (16 * st + 4 * fq) * 2) = (v2u){PK2(p.x, p.y), PK2(p.z, p.w)}; }
#pragma unroll
            for (int k = 0; k < 4; ++k) { const v8s af = *(LP(const v8s))(QB + (16 * tt + fr) * ST128 + fq * 16 + k * 64);
#pragma unroll
                for (int i = 0; i < 2; ++i) { const v8s bf = *(LP(const v8s))(STT + (16 * (vt0 + i) + fr) * ST128 + fq * 16 + k * 64); oacc[i] = MFMA16(bf, af, oacc[i]); } }
        }
        SYNC();
#pragma unroll
        for (int k = 0; k < 2; ++k) { const v8s af = *(LP(const v8s))(PM + (16 * tt + fr) * ST64 + fq * 16 + k * 64);
#pragma unroll
            for (int i = 0; i < 2; ++i) { const v8s bf = tr_frag(VV, ST64, 32 * k, 16 * (vt0 + i), lane); oacc[i] = MFMA16(bf, af, oacc[i]); } }
        { const int orow = tok_row(b, seg, ci * 64 + 16 * tt + fr, dir, 0);
#pragma unroll
          for (int i = 0; i < 2; ++i) *(v2u*)(Od + (size_t)orow * 1024 + h * 256 + vs * 64 + 16 * (vt0 + i) + 4 * fq) = (v2u){PK2(oacc[i].x, oacc[i].y), PK2(oacc[i].z, oacc[i].w)}; }
        {
            v4f tmp[4];
#pragma unroll
            for (int i = 0; i < 4; ++i) tmp[i] = (v4f){0.f, 0.f, 0.f, 0.f};
#pragma unroll
            for (int k = 0; k < 2; ++k) { const v8s af = tr_frag(VV, ST64, 32 * k, 16 * svt, lane);
#pragma unroll
                for (int i = 0; i < 4; ++i) { const v8s bf = tr_frag(KS, ST128, 32 * k, 16 * (sdt0 + i), lane); tmp[i] = MFMA16(bf, af, tmp[i]); } }
#pragma unroll
            for (int i = 0; i < 4; ++i) { const v4f ee = *(LP(const v4f))(DV + 16 * (sdt0 + i) + 4 * fq), de = *(LP(const v4f))(DV + 128 + 16 * (sdt0 + i) + 4 * fq);
                sacc[i] = sacc[i] * de + tmp[i] * ee;
                *(LP(v2u))(STT + (16 * svt + fr) * ST128 + (16 * (sdt0 + i) + 4 * fq) * 2) = (v2u){PK2(sacc[i].x, sacc[i].y), PK2(sacc[i].z, sacc[i].w)}; }
        }
        SYNC();
    }
#undef GLA_ISSUE
}

constexpr int GATE_TASKS = NB * 4 * 2 * (CTXL / 64 + SEQ / 64);
DEV void gate_prep_task(int task, const float* GT, const bf16* QK2, float* GP, float* GPK, const float* gate_b, int lane) {
    constexpr int NCHUNK = CTXL / 64 + SEQ / 64;
    const int cidx = task % NCHUNK, r1 = task / NCHUNK, dir = r1 & 1, h = (r1 >> 1) & 3, b = r1 >> 3;
    const int seg = cidx >= CTXL / 64, ci = seg ? cidx - CTXL / 64 : cidx;
    const int prow = tok_row(b, seg, ci * 64 + lane, dir, 1);
    const float ig = GT[(size_t)prow * 256 + 32 + (dir * 2 + 0) * 4 + h] + gate_b[(dir * 2 + 0) * 4 + h];
    const float lf = logsigmoidf(GT[(size_t)prow * 256 + 32 + (dir * 2 + 1) * 4 + h] + gate_b[(dir * 2 + 1) * 4 + h]);
    float bcum = lf;
#pragma unroll
    for (int o = 1; o < 64; o <<= 1) { const float t = SHUP(bcum, o); if (lane >= o) bcum += t; }
    const float a_s = ig - bcum;
    float cm = a_s;
#pragma unroll
    for (int o = 1; o < 64; o <<= 1) { const float t = SHUP(cm, o); if (lane >= o) cm = fmaxf(cm, t); }
    *(v4f*)(GP + ((size_t)prow * 8 + dir * 4 + h) * 4) = (v4f){bcum, a_s, cm, 0.f};
    const float w0 = EXPF(a_s - RDLANE(cm, 63));
    v4f kw = (v4f){0.f, 0.f, 0.f, 0.f};
    for (int jj = 0; jj < 64; ++jj) { const int rj = tok_row(b, seg, ci * 64 + jj, dir, 1); const float wj = RDLANE(w0, jj);
        const v2u kk = *(const v2u*)(QK2 + (size_t)rj * 2048 + 1024 + h * 256 + 4 * lane);
        kw.x += bflo(kk.x) * wj; kw.y += bfhi(kk.x) * wj; kw.z += bflo(kk.y) * wj; kw.w += bfhi(kk.y) * wj; }
    *(v4f*)(GPK + (size_t)task * 256 + 4 * lane) = kw;
}

constexpr int MAT_TASKS = NB * 4 * 2 * (CTXL / 64 + SEQ / 64);
template <int MODE>
DEV void mat_prep_task(int task, const bf16* Sqk, int ldqk, int qoff, int koff, float kscale, const float* GP, const float* ret_log_decay, bf16* PP, float* RS, LP(unsigned char) lds, int tid) {
    constexpr int NCHUNK = CTXL / 64 + SEQ / 64;
    const int lane = tid & 63, wave = tid >> 6, fr = lane & 15, fq = lane >> 4;
    const int cidx = task % NCHUNK, r1 = task / NCHUNK, dir = r1 & 1, h = (r1 >> 1) & 3, b = r1 >> 3;
    const int seg = cidx >= CTXL / 64, ci = seg ? cidx - CTXL / 64 : cidx;
    LP(unsigned char) Q = lds; LP(unsigned char) K = lds + 33792; LP(float) AS = (LP(float))(lds + 67584); LP(float) R0 = AS + 64; LP(float) DENP = AS + 128;
    const int j = tid >> 3, c8 = tid & 7, dc = c8 * 32;
    { const bf16* s1 = Sqk + (size_t)tok_row(b, seg, ci * 64 + j, dir, 1) * ldqk;
#pragma unroll
      for (int g8 = 0; g8 < 4; ++g8) { *(LP(v4u))(Q + j * ST256 + (dc + 8 * g8) * 2) = *(const v4u*)(s1 + qoff + h * 256 + dc + 8 * g8); *(LP(v4u))(K + j * ST256 + (dc + 8 * g8) * 2) = *(const v4u*)(s1 + koff + h * 256 + dc + 8 * g8); } }
    if (wave == 0) {
        if (MODE == 0) { const int prow = tok_row(b, seg, ci * 64 + lane, dir, 1); const v4f gpv = *(const v4f*)(GP + ((size_t)prow * 8 + dir * 4 + h) * 4); AS[lane] = gpv.y; R0[lane] = -gpv.z; }
        else { const float lg = -expf(ret_log_decay[dir * 4 + h]); AS[lane] = -(float)(lane + 1) * lg; R0[lane] = (float)(lane + 1) * lg; }
    }
    SYNC();
    const int tt = wave >> 1;
    bf16* pp = PP + (size_t)task * 4096;
    const float rt = R0[16 * tt + fr];
#pragma unroll
    for (int i = 0; i < 2; ++i) { const int st = (wave & 1) * 2 + i; v4f p = (v4f){0.f, 0.f, 0.f, 0.f};
        if (st <= tt) { p = tile_mma(p, Q, ST256, 16 * tt, K, ST256, 16 * st, 8, fr, fq);
            const v4f as4 = *(LP(const v4f))(AS + 16 * st + 4 * fq);
            p.x *= kscale * EXPF(as4.x + rt); p.y *= kscale * EXPF(as4.y + rt); p.z *= kscale * EXPF(as4.z + rt); p.w *= kscale * EXPF(as4.w + rt);
            if (st == tt) { if (4 * fq + 0 > fr) p.x = 0.f; if (4 * fq + 1 > fr) p.y = 0.f; if (4 * fq + 2 > fr) p.z = 0.f; if (4 * fq + 3 > fr) p.w = 0.f; } }
        *(v2u*)(pp + (16 * tt + fr) * 64 + 16 * st + 4 * fq) = (v2u){PK2(p.x, p.y), PK2(p.z, p.w)};
        if (MODE == 0) { float rs = (p.x + p.y) + (p.z + p.w); rs += SHX(rs, 16); rs += SHX(rs, 32); if (fq == 0) DENP[st * 64 + 16 * tt + fr] = rs; } }
    SYNC();
    if (MODE == 0 && tid < 64) RS[(size_t)task * 64 + tid] = (DENP[tid] + DENP[64 + tid]) + (DENP[128 + tid] + DENP[192 + tid]);
    SYNC();
}

template <int MODE>
DEV void mat_unit(const bf16* Sqk, int ldqk, int qoff, int koff, const bf16* Sv, int ldv, int voff, float kscale, const float* GP, const float* GPK, const bf16* PP, const float* RS, bf16* O, int store_ctx,
                  const float* ret_log_decay, int unit, LP(unsigned char) lds, int tid) {
    const int lane = tid & 63, wave = tid >> 6, fr = lane & 15, fq = lane >> 4;
    const int vs = unit & 3, dir = (unit >> 2) & 1, h = (unit >> 3) & 3, b = unit >> 5;
    LP(unsigned char) Q = lds; LP(unsigned char) K = lds + 33792;
    LP(unsigned char) VV = lds + 67584; LP(unsigned char) VW = lds + 76800;
    LP(unsigned char) PM = lds + 86016; LP(unsigned char) STT = lds + 95232;
    LP(float) SCAL = (LP(float))(lds + 137472);
    LP(float) NV = SCAL + 768;
    for (int i = tid; i < 80 * ST256 / 4; i += NTHR) ((LP(unsigned))STT)[i] = 0u;
    if (tid < 256) NV[tid] = 0.f;
    v4f sacc[8];
#pragma unroll
    for (int i = 0; i < 8; ++i) sacc[i] = (v4f){0.f, 0.f, 0.f, 0.f};
    const int j = tid >> 3, c8 = tid & 7, dc = c8 * 32;
    const int tt = wave >> 1, vt0 = (wave & 1) * 2;
    const int svt = wave & 3, sdt0 = (wave >> 2) * 8;
    float m_st = 0.f;
    float lg = 0.f;
    if (MODE == 1) lg = -expf(ret_log_decay[dir * 4 + h]);
    bf16* Od = O + (size_t)(2 + dir) * TT * 1024;
    constexpr int NCHUNK = CTXL / 64 + SEQ / 64;
    v4u rq[4], rk[4], rv, rp; v4f gpv = (v4f){0.f, 0.f, 0.f, 0.f}; float kwv = 0.f, rsv = 0.f;
    const int task0 = ((b * 4 + h) * 2 + dir) * NCHUNK;
#define MAT_ISSUE(cx) do { const int seg_ = (cx) >= CTXL / 64, ci_ = seg_ ? (cx) - CTXL / 64 : (cx); \
        const int row_ = tok_row(b, seg_, ci_ * 64 + j, dir, 1); \
        const bf16* s1_ = Sqk + (size_t)row_ * ldqk; \
        _Pragma("unroll") for (int g_ = 0; g_ < 4; ++g_) { rq[g_] = *(const v4u*)(s1_ + qoff + h * 256 + dc + 8 * g_); rk[g_] = *(const v4u*)(s1_ + koff + h * 256 + dc + 8 * g_); } \
        rv = *(const v4u*)(Sv + (size_t)row_ * ldv + voff + h * 256 + vs * 64 + c8 * 8); \
        rp = *(const v4u*)(PP + (size_t)(task0 + (cx)) * 4096 + j * 64 + c8 * 8); \
        if (MODE == 0 && tid < 256) kwv = GPK[(size_t)(task0 + (cx)) * 256 + tid]; } while (0)
#define MAT_GATE_LOAD(cx) do { if (MODE == 0 && wave == 0) { const int seg_ = (cx) >= CTXL / 64, ci_ = seg_ ? (cx) - CTXL / 64 : (cx); \
        const int prow_ = tok_row(b, seg_, ci_ * 64 + lane, dir, 1); gpv = *(const v4f*)(GP + ((size_t)prow_ * 8 + dir * 4 + h) * 4); rsv = RS[(size_t)(task0 + (cx)) * 64 + lane]; } } while (0)
#define MAT_GATES(cx) do { if (wave == 0) { LP(float) sc_ = SCAL + ((cx) & 1) * 384; \
        if (MODE == 0) { const float bcum_ = gpv.x, a_s_ = gpv.y, Mt_ = fmaxf(m_st, gpv.z); \
            const float M63_ = RDLANE(Mt_, 63), bend_ = RDLANE(bcum_, 63), cm63_ = RDLANE(gpv.z, 63); const float wp_ = EXPF(gpv.z - Mt_); \
            sc_[lane] = wp_; sc_[64 + lane] = EXPF(m_st - Mt_); sc_[128 + lane] = EXPF(a_s_ - M63_); sc_[192 + lane] = EXPF(-(bcum_ + Mt_)); sc_[256 + lane] = rsv * wp_; \
            if (lane == 0) { sc_[320] = EXPF(m_st - M63_); sc_[321] = EXPF(cm63_ - M63_); } \
            m_st = bend_ + M63_; \
        } else { sc_[lane] = 1.0f; sc_[64 + lane] = EXPF((float)(lane + 1) * lg); sc_[128 + lane] = EXPF((float)(63 - lane) * lg); sc_[192 + lane] = 0.f; sc_[256 + lane] = 0.f; \
            if (lane == 0) { sc_[320] = EXPF(64.f * lg); sc_[321] = 0.f; } } } } while (0)
    MAT_ISSUE(0); MAT_GATE_LOAD(0);
    MAT_GATES(0);
    if (NCHUNK > 1) MAT_GATE_LOAD(1);
    SYNC();
    for (int cidx = 0; cidx < NCHUNK; ++cidx) {
        const int seg = cidx >= CTXL / 64, ci = seg ? cidx - CTXL / 64 : cidx;
        LP(const float) sc = SCAL + (cidx & 1) * 384;
        const float kw_cur = kwv;
        {
            const float wk = sc[128 + j] * kscale;
#pragma unroll
            for (int g8 = 0; g8 < 4; ++g8) { const int d0 = dc + 8 * g8; *(LP(v4u))(Q + j * ST256 + d0 * 2) = rq[g8]; *(LP(v4u))(K + j * ST256 + d0 * 2) = rk[g8]; }
            *(LP(v4u))(VV + j * ST64 + c8 * 16) = rv;
            *(LP(v4u))(VW + j * ST64 + c8 * 16) = (v4u){PK2(bflo(rv.x) * wk, bfhi(rv.x) * wk), PK2(bflo(rv.y) * wk, bfhi(rv.y) * wk), PK2(bflo(rv.z) * wk, bfhi(rv.z) * wk), PK2(bflo(rv.w) * wk, bfhi(rv.w) * wk)};
            *(LP(v4u))(PM + j * ST64 + c8 * 16) = rp;
#pragma unroll
            for (int i = 0; i < 8; ++i) *(LP(v2u))(STT + (16 * svt + fr) * ST256 + (16 * (sdt0 + i) + 4 * fq) * 2) = (v2u){PK2(sacc[i].x, sacc[i].y), PK2(sacc[i].z, sacc[i].w)};
        }
        if (cidx + 1 < NCHUNK) MAT_ISSUE(cidx + 1);
        SYNC();
        if (cidx + 1 < NCHUNK) { MAT_GATES(cidx + 1); if (cidx + 2 < NCHUNK) MAT_GATE_LOAD(cidx + 2); }
        v4f oP[2], oI[2]; oP[0] = (v4f){0.f, 0.f, 0.f, 0.f}; oP[1] = oP[0]; oI[0] = oP[0]; oI[1] = oP[0];
        v4f qa = (v4f){0.f, 0.f, 0.f, 0.f};
#pragma unroll 2
        for (int k = 0; k < 8; ++k) { const v8s af = *(LP(const v8s))(Q + (16 * tt + fr) * ST256 + fq * 16 + k * 64);
#pragma unroll
            for (int i = 0; i < 2; ++i) { const v8s bf = *(LP(const v8s))(STT + (16 * (vt0 + i) + fr) * ST256 + fq * 16 + k * 64); oI[i] = MFMA16(bf, af, oI[i]); }
            if (MODE == 0) { const v8s bn = *(LP(const v8s))(STT + (64 + fr) * ST256 + fq * 16 + k * 64); qa = MFMA16(bn, af, qa); } }
#pragma unroll
        for (int k = 0; k < 2; ++k) { const v8s af = *(LP(const v8s))(PM + (16 * tt + fr) * ST64 + fq * 16 + k * 64);
#pragma unroll
            for (int i = 0; i < 2; ++i) { const v8s bf = tr_frag(VV, ST64, 32 * k, 16 * (vt0 + i), lane); oP[i] = MFMA16(bf, af, oP[i]); } }
        { const int t = 16 * tt + fr; const float wp = sc[t], wi = sc[64 + t];
          v4f o0 = oP[0] * wp + oI[0] * wi, o1 = oP[1] * wp + oI[1] * wi;
          if (MODE == 0) { const float qn = RDLANE16(qa.x, fr); const float den = sc[256 + t] + wi * qn; const float dv = 1.0f / fmaxf(fabsf(den), sc[192 + t]); o0 = o0 * dv; o1 = o1 * dv; }
          if (seg || store_ctx) { const int orow = tok_row(b, seg, ci * 64 + t, dir, 1);
              *(v2u*)(Od + (size_t)orow * 1024 + h * 256 + vs * 64 + 16 * vt0 + 4 * fq) = (v2u){PK2(o0.x, o0.y), PK2(o0.z, o0.w)};
              *(v2u*)(Od + (size_t)orow * 1024 + h * 256 + vs * 64 + 16 * (vt0 + 1) + 4 * fq) = (v2u){PK2(o1.x, o1.y), PK2(o1.z, o1.w)}; } }
        const float dcy = sc[320];
        {
#pragma unroll
            for (int i = 0; i < 8; ++i) sacc[i] = sacc[i] * dcy;
#pragma unroll 1
            for (int k = 0; k < 2; ++k) { const v8s af = tr_frag(VW, ST64, 32 * k, 16 * svt, lane);
#pragma unroll
                for (int i = 0; i < 8; ++i) { const v8s bf = tr_frag(K, ST256, 32 * k, 16 * (sdt0 + i), lane); sacc[i] = MFMA16(bf, af, sacc[i]); } }
        }
        SYNC();
        if (MODE == 0 && tid < 256) {
            const float nn = dcy * NV[tid] + sc[321] * kw_cur * kscale; NV[tid] = nn;
            *(LP(unsigned short))(STT + 64 * ST256 + tid * 2) = F2BF(nn); }
    }
#undef MAT_ISSUE
#undef MAT_GATE_LOAD
#undef MAT_GATES
    SYNC();
}

constexpr int S5_LDS_PER_WAVE = 1280 + 2 * 10240 + 2 * 6144;
DEV void s5_unit(const bf16* S, int ldS, bf16* O, const float* lam_re, const float* lam_im, const float* log_step, const float* b_re, const float* b_im,
                 const float* c_re, const float* c_im, int unit, LP(unsigned char) wl, int lane) {
    const int fr = lane & 15, fq = lane >> 4;
    const int dir = unit & 1, g = (unit >> 1) & 63, b = unit >> 7;
    LP(unsigned char) UB = wl; LP(unsigned char) XB = wl + 1280; LP(unsigned char) HB = wl + 1280 + 2 * 10240;
    const int pg = (dir * 64 + g);
    const float lr = lam_re[pg * 64 + lane], li = lam_im[pg * 64 + lane], step = expf(log_step[pg]);
    const float mag = expf(lr * step); float sn, cs; sincosf(li * step, &sn, &cs);
    const float ar = mag * cs, ai = mag * sn, den = lr * lr + li * li;
    const float cre = ((ar - 1.0f) * lr + ai * li) / den, cim = (ai * lr - (ar - 1.0f) * li) / den;
    for (int p = 0; p < 16; ++p) { const float br = b_re[(pg * 64 + lane) * 16 + p], bi = b_im[(pg * 64 + lane) * 16 + p];
        *(LP(unsigned short))(XB + lane * 32 + p * 2) = F2BF(cre * br - cim * bi);
        *(LP(unsigned short))(XB + (64 + lane) * 32 + p * 2) = F2BF(cre * bi + cim * br); }
    WAVE_SYNC();
    v8s bfrag[8];
#pragma unroll
    for (int nt = 0; nt < 8; ++nt) { if (fq < 2) bfrag[nt] = *(LP(const v8s))(XB + (16 * nt + fr) * 32 + fq * 16); else bfrag[nt] = (v8s){0, 0, 0, 0, 0, 0, 0, 0}; }
    v8s cfrag[4];
#pragma unroll
    for (int ks = 0; ks < 4; ++ks) { const int n0 = 32 * ks + 8 * fq; const float* src = (n0 < 64 ? c_re : c_im) + ((size_t)pg * 16 + fr) * 64 + (n0 & 63); const float sgn = n0 < 64 ? 1.f : -1.f;
        v8s f;
#pragma unroll
        for (int i = 0; i < 8; ++i) f[i] = (short)F2BF(sgn * src[i]);
        cfrag[ks] = f; }
    WAVE_SYNC();
    for (int i = lane; i < 1280 / 4; i += 64) ((LP(unsigned))UB)[i] = 0u;
    WAVE_SYNC();
    float hr = 0.f, hi = 0.f;
    bf16* Od = O + (size_t)dir * TT * 1024;
    constexpr int NBLK = CTXL / 16 + SEQ / 16;
    v4u un = (v4u){0u, 0u, 0u, 0u};
#define S5_ISSUE(bx) do { if (lane < 32) { const int seg_ = (bx) >= CTXL / 16, bi_ = seg_ ? (bx) - CTXL / 16 : (bx); \
        un = *(const v4u*)(S + (size_t)tok_row(b, seg_, bi_ * 16 + (lane >> 1), dir, 0) * ldS + g * 16 + (lane & 1) * 8); } } while (0)
#define S5_STAGE_A(bx) do { const v8s uf_ = *(LP(const v8s))(UB + fr * 80 + fq * 16); LP(unsigned char) xb_ = XB + ((bx) & 1) * 10240; \
        _Pragma("unroll") for (int nt = 0; nt < 8; ++nt) { v4f x = (v4f){0.f, 0.f, 0.f, 0.f}; x = MFMA16(uf_, bfrag[nt], x); *(LP(v4f))(xb_ + (16 * nt + fr) * 80 + fq * 16) = x; } } while (0)
    S5_ISSUE(0);
    if (lane < 32) *(LP(v4u))(UB + (lane >> 1) * 80 + (lane & 1) * 16) = un;
    S5_ISSUE(1);
    WAVE_SYNC();
    S5_STAGE_A(0);
    for (int bx = 0; bx <= NBLK; ++bx) {
        WAVE_SYNC();
        v8s hf[4]; float xr[16], xi[16];
        if (bx >= 1) { LP(unsigned char) hb = HB + ((bx - 1) & 1) * 6144;
#pragma unroll
            for (int ks = 0; ks < 4; ++ks) hf[ks] = tr_frag(hb, 48, 32 * ks, 0, lane); }
        if (bx < NBLK) { LP(unsigned char) xb = XB + (bx & 1) * 10240;
#pragma unroll
            for (int q4 = 0; q4 < 4; ++q4) { const v4f a4 = *(LP(const v4f))(xb + lane * 80 + q4 * 16), b4 = *(LP(const v4f))(xb + (64 + lane) * 80 + q4 * 16);
                xr[4 * q4] = a4.x; xr[4 * q4 + 1] = a4.y; xr[4 * q4 + 2] = a4.z; xr[4 * q4 + 3] = a4.w; xi[4 * q4] = b4.x; xi[4 * q4 + 1] = b4.y; xi[4 * q4 + 2] = b4.z; xi[4 * q4 + 3] = b4.w; } }
        if (bx + 1 < NBLK) { if (lane < 32) *(LP(v4u))(UB + (lane >> 1) * 80 + (lane & 1) * 16) = un; if (bx + 2 < NBLK) S5_ISSUE(bx + 2); }
        WAVE_SYNC();
        if (bx + 1 < NBLK) S5_STAGE_A(bx + 1);
        if (bx >= 1) { const int pb = bx - 1, seg = pb >= CTXL / 16, bi = seg ? pb - CTXL / 16 : pb;
            if (seg) { v4f y = (v4f){0.f, 0.f, 0.f, 0.f};
#pragma unroll
                for (int ks = 0; ks < 4; ++ks) y = MFMA16(cfrag[ks], hf[ks], y);
                const int orow = tok_row(b, seg, bi * 16 + fr, dir, 0);
                *(v2u*)(Od + (size_t)orow * 1024 + g * 16 + 4 * fq) = (v2u){PK2(y.x, y.y), PK2(y.z, y.w)}; } }
        if (bx < NBLK) { LP(unsigned char) hb = HB + (bx & 1) * 6144;
            unsigned pr[8], pi[8];
#pragma unroll
            for (int t2 = 0; t2 < 8; ++t2) {
                const float r0 = ar * hr - ai * hi + xr[2 * t2], i0 = ar * hi + ai * hr + xi[2 * t2];
                hr = ar * r0 - ai * i0 + xr[2 * t2 + 1]; hi = ar * i0 + ai * r0 + xi[2 * t2 + 1];
                pr[t2] = PK2(r0, hr); pi[t2] = PK2(i0, hi); }
            *(LP(v4u))(hb + lane * 48) = (v4u){pr[0], pr[1], pr[2], pr[3]}; *(LP(v4u))(hb + lane * 48 + 16) = (v4u){pr[4], pr[5], pr[6], pr[7]};
            *(LP(v4u))(hb + (64 + lane) * 48) = (v4u){pi[0], pi[1], pi[2], pi[3]}; *(LP(v4u))(hb + (64 + lane) * 48 + 16) = (v4u){pi[4], pi[5], pi[6], pi[7]}; }
    }
#undef S5_STAGE_A
#undef S5_ISSUE
}

DEV void conv_prep_row(int r, const bf16* S, bf16* QK2, const float* conv_w, const float* conv_b, int lane) {
    int rm, rp; bool hasm, hasp;
    if (r < TL) { const int b = r >> 12, n = r & (SEQ - 1), gr = n >> 6, col = n & 63, np = col * 64 + gr;
        hasm = np > 0; hasp = np < SEQ - 1; rm = seq_row(b, 1, hasm ? np - 1 : np, 1); rp = seq_row(b, 1, hasp ? np + 1 : np, 1); }
    else { const int n = (r - TL) & (CTXL - 1); hasm = n > 0; hasp = n < CTXL - 1; rm = hasm ? r - 1 : r; rp = hasp ? r + 1 : r; }
    const bf16* s0 = S + (size_t)rm * EV_PAD + 3072; const bf16* s1 = S + (size_t)r * EV_PAD + 3072; const bf16* s2 = S + (size_t)rp * EV_PAD + 3072;
#pragma unroll
    for (int i = 0; i < 4; ++i) { const int c = 8 * lane + 512 * i;
        const v4u a0 = *(const v4u*)(s0 + c), a1 = *(const v4u*)(s1 + c), a2 = *(const v4u*)(s2 + c);
        const unsigned w0[4] = {a0.x, a0.y, a0.z, a0.w}, w1[4] = {a1.x, a1.y, a1.z, a1.w}, w2[4] = {a2.x, a2.y, a2.z, a2.w};
        const float sc = c >= 1024 ? 0.0625f : 1.0f;
        float val[8];
#pragma unroll
        for (int i2 = 0; i2 < 4; ++i2)
#pragma unroll
            for (int e = 0; e < 2; ++e) { const int di = 2 * i2 + e;
                const float um = hasm ? (e ? bfhi(w0[i2]) : bflo(w0[i2])) : 0.f, u0 = e ? bfhi(w1[i2]) : bflo(w1[i2]), up = hasp ? (e ? bfhi(w2[i2]) : bflo(w2[i2])) : 0.f;
                const float pre = conv_b[c + di] + conv_w[c + di] * um + conv_w[2048 + c + di] * u0 + conv_w[4096 + c + di] * up;
                val[di] = pre * RCPF(1.0f + EXPF(-pre)) * sc; }
        *(v4u*)(QK2 + (size_t)r * 2048 + c) = (v4u){PK2(val[0], val[1]), PK2(val[2], val[3]), PK2(val[4], val[5]), PK2(val[6], val[7])}; }
}

DEV v4f ld4bf(const bf16* p) { const v2u w = *(const v2u*)p; return (v4f){bflo(w.x), bfhi(w.x), bflo(w.y), bfhi(w.y)}; }
DEV float wsum(float v) {
#pragma unroll
    for (int o = 1; o < 64; o <<= 1) v += SHX(v, o);
    return v;
}
DEV void merge_even_row(int r, const bf16* S, const bf16* O, const float* gla_norm, const float* ml_norm, bf16* HBo, int lane) {
    const bf16* sr = S + (size_t)r * EV_PAD;
#pragma unroll
    for (int hh = 0; hh < 8; ++hh) { const int mix = hh >> 2, c = (hh & 3) * 256 + 4 * lane;
        const bf16* o0 = O + (size_t)(2 * mix) * TT * 1024 + (size_t)r * 1024 + c; const bf16* o1 = o0 + (size_t)TT * 1024;
        v4f o = ld4bf(o0) + ld4bf(o1);
#ifdef NO_GLA
        if (!mix) o = (v4f){0.f, 0.f, 0.f, 0.f};
#endif
#ifdef NO_ML
        if (mix) o = (v4f){0.f, 0.f, 0.f, 0.f};
#endif
        if (mix) { const float mean = wsum((o.x + o.y) + (o.z + o.w)) * (1.0f / 256.0f); o = o - mean; }
        const float ms = wsum((o.x * o.x + o.y * o.y) + (o.z * o.z + o.w * o.w)) * (1.0f / 256.0f);
        const float rstd = RSQRTF(ms + EPS);
        const v4f gn = *(const v4f*)((mix ? ml_norm : gla_norm) + c);
        const v2u gw = *(const v2u*)(sr + (mix ? 6144 : 2048) + c);
        const float g0 = bflo(gw.x), g1 = bfhi(gw.x), g2 = bflo(gw.y), g3 = bfhi(gw.y);
        v4f gate;
        if (mix) { gate.x = RCPF(1.0f + EXPF(-g0)); gate.y = RCPF(1.0f + EXPF(-g1)); gate.z = RCPF(1.0f + EXPF(-g2)); gate.w = RCPF(1.0f + EXPF(-g3)); }
        else { gate.x = g0 * RCPF(1.0f + EXPF(-g0)); gate.y = g1 * RCPF(1.0f + EXPF(-g1)); gate.z = g2 * RCPF(1.0f + EXPF(-g2)); gate.w = g3 * RCPF(1.0f + EXPF(-g3)); }
        const v4f res = gate * (o * rstd * gn);
        *(v2u*)(HBo + (size_t)r * D + mix * 1024 + c) = (v2u){PK2(res.x, res.y), PK2(res.z, res.w)}; }
}
DEV float gelu_tanh(float y) { const float z = 0.7978845608028654f * (y + 0.044715f * y * y * y); const float t = 1.0f - 2.0f * RCPF(1.0f + EXPF(2.0f * z)); return 0.5f * y * (1.0f + t); }
DEV void merge_odd_row(int r, const bf16* S, const bf16* O, const float* s5_d, const float* ret_norm, bf16* GBo, bf16* HBo, int lane) {
    const bf16* sr = S + (size_t)r * OD_COLS;
#pragma unroll
    for (int hh = 0; hh < 4; ++hh) { const int c = hh * 256 + 4 * lane;
        { const bf16* o0 = O + (size_t)r * 1024 + c; const bf16* o1 = o0 + (size_t)TT * 1024;
          v4f y0 = ld4bf(o0) + ld4bf(o1);
#ifdef NO_S5
          y0 = (v4f){0.f, 0.f, 0.f, 0.f};
#endif
          const v4f dd = *(const v4f*)(s5_d + c); const v2u uw = *(const v2u*)(sr + c);
          const float y[4] = {y0.x + dd.x * bflo(uw.x), y0.y + dd.y * bfhi(uw.x), y0.z + dd.z * bflo(uw.y), y0.w + dd.w * bfhi(uw.y)};
          *(v2u*)(GBo + (size_t)r * 1024 + c) = (v2u){PK2(gelu_tanh(y[0]), gelu_tanh(y[1])), PK2(gelu_tanh(y[2]), gelu_tanh(y[3]))}; }
        { const bf16* o0 = O + (size_t)2 * TT * 1024 + (size_t)r * 1024 + c; const bf16* o1 = o0 + (size_t)TT * 1024;
          v4f o = ld4bf(o0) + ld4bf(o1);
#ifdef NO_RET
          o = (v4f){0.f, 0.f, 0.f, 0.f};
#endif
          const float mean = wsum((o.x + o.y) + (o.z + o.w)) * (1.0f / 256.0f); o = o - mean;
          const float ms = wsum((o.x * o.x + o.y * o.y) + (o.z * o.z + o.w * o.w)) * (1.0f / 256.0f);
          const float rstd = RSQRTF(ms + EPS);
          const v4f gn = *(const v4f*)(ret_norm + c);
          const v2u gw = *(const v2u*)(sr + 4096 + c);
          const float g0 = bflo(gw.x), g1 = bfhi(gw.x), g2 = bflo(gw.y), g3 = bfhi(gw.y);
          v4f gate; gate.x = g0 * RCPF(1.0f + EXPF(-g0)); gate.y = g1 * RCPF(1.0f + EXPF(-g1)); gate.z = g2 * RCPF(1.0f + EXPF(-g2)); gate.w = g3 * RCPF(1.0f + EXPF(-g3));
          const v4f res = gate * (o * rstd * gn);
          *(v2u*)(HBo + (size_t)r * D + 1024 + c) = (v2u){PK2(res.x, res.y), PK2(res.z, res.w)}; }
    }
}

struct EpiGLU {
    static constexpr bool PERM = true, AFTER_DRAIN = false;
    const bf16* G; const float* bias; bf16* O;
    __device__ __forceinline__ void operator()(const pg8::f32x4 (&acc)[2][2][4][2], const pg8::Unit& u, int wr, int wc, int fr, int fq) const {
        const int row0 = u.pm * 256 + wr * 64 + fr, col0 = u.pn * 256 + wc * 32 + 8 * fq;
#pragma unroll
        for (int ai = 0; ai < 2; ++ai)
#pragma unroll
            for (int m = 0; m < 4; ++m) { const size_t row = (size_t)(row0 + ai * 128 + m * 16);
#pragma unroll
                for (int bj = 0; bj < 2; ++bj) { const int col = col0 + bj * 128;
                    const v4u gw = *(const v4u*)(G + row * 1024 + col); const pg8::f32x4 b0 = *(const pg8::f32x4*)(bias + col), b1 = *(const pg8::f32x4*)(bias + col + 4);
                    const pg8::f32x4 v0 = acc[ai][bj][m][0] + b0, v1 = acc[ai][bj][m][1] + b1;
                    v4u w; w.x = pk2(bflo(gw.x) * fast_sigmoid(v0[0]), bfhi(gw.x) * fast_sigmoid(v0[1])); w.y = pk2(bflo(gw.y) * fast_sigmoid(v0[2]), bfhi(gw.y) * fast_sigmoid(v0[3]));
                    w.z = pk2(bflo(gw.z) * fast_sigmoid(v1[0]), bfhi(gw.z) * fast_sigmoid(v1[1])); w.w = pk2(bflo(gw.w) * fast_sigmoid(v1[2]), bfhi(gw.w) * fast_sigmoid(v1[3]));
                    *(v4u*)(O + row * D + col) = w; } }
    }
};

__device__ __forceinline__ void mixer_phases(const Args& a, unsigned char* ws, LAS unsigned char* lds, const XcdBarrier& bar, int layer, int G, int gw, int ngw, int tid, int lane, int wave) {
#define HB ((bf16*)wsp(ws, WS_HB))
#define S ((bf16*)wsp(ws, WS_S))
#define GT ((float*)wsp(ws, WS_GT))
#define O ((bf16*)wsp(ws, WS_O))
#define GB ((bf16*)wsp(ws, WS_GB))
#define Y ((bf16*)wsp(ws, WS_Y))
    const int ldS = layer == 0 ? EV_PAD : OD_COLS;
    { pg8::Gemm g{HB, (const bf16*)(wsp(ws, (layer == 0 ? WS_WIN_EV : WS_WIN_OD))), TT, ldS, D}; pg8::StaticOrder So; So.init(TT, ldS, G, (int)blockIdx.x);
      EpiS E{S, ldS, GT, layer == 0 ? 28 : -1};
      pg8::gemm_phase<EpiS, pg8::StaticOrder, true, true>(lds, g, So, E); }
    xcd_barrier(bar);
#define QK2 ((bf16*)wsp(ws, WS_QK2))
#define GP ((float*)wsp(ws, WS_GP))
#define QKS ((bf16*)wsp(ws, WS_QKS))
#define GPK ((float*)wsp(ws, WS_GPK))
#define PP ((bf16*)wsp(ws, WS_PP))
#define RS ((float*)wsp(ws, WS_RS))
#define VEC ((float*)wsp(ws, WS_VEC))
    { int t2 = threadIdx.x; asm volatile("" : "+v"(t2)); tid = t2; lane = t2 & 63; wave = __builtin_amdgcn_readfirstlane(t2 >> 6); gw = blockIdx.x * NWAVES + wave; }
    if (layer == 0) {
        { const bf16* s_ = S; bf16* qk_ = QK2; const float* cw_ = ARG(16); const float* cb_ = ARG(17); for (int r = gw; r < TT; r += ngw) conv_prep_row(r, s_, qk_, cw_, cb_, lane); }
        xcd_barrier(bar);
        { const float* gt_ = GT; const bf16* qk_ = QK2; float* gp_ = GP; float* gk_ = GPK; const float* gb_ = ARG(18); for (int t = gw; t < GATE_TASKS; t += ngw) gate_prep_task(t, gt_, qk_, gp_, gk_, gb_, lane); }
        { int t2 = threadIdx.x; asm volatile("" : "+v"(t2)); for (int t = blockIdx.x; t < GLA_TASKS; t += G) gla_prep_task(t, S, GT, ARG(13), ARG(14), QKS, VEC, lds, t2); }
        xcd_barrier(bar);
        { int t2 = threadIdx.x; asm volatile("" : "+v"(t2)); for (int t = blockIdx.x; t < MAT_TASKS; t += G) mat_prep_task<0>(t, QK2, 2048, 0, 1024, 1.0f, GP, nullptr, PP, RS, lds, t2); }
        xcd_barrier(bar);
    } else {
        { int t2 = threadIdx.x; asm volatile("" : "+v"(t2)); for (int t = blockIdx.x; t < MAT_TASKS; t += G) mat_prep_task<1>(t, S, OD_COLS, 1024, 2048, 0.0625f, nullptr, ARG(32), PP, RS, lds, t2); }
        xcd_barrier(bar);
    }
    { int t2 = threadIdx.x; asm volatile("" : "+v"(t2)); tid = t2; lane = t2 & 63; wave = __builtin_amdgcn_readfirstlane(t2 >> 6); }
#ifndef SCAN_REPS
#define SCAN_REPS 1
#endif
#pragma unroll 1
    for (int rep = 0; rep < SCAN_REPS; ++rep) {
    if (layer == 0) {
        for (int it = blockIdx.x; it < 2 * MIX_UNITS; it += G) {
            if (it < MIX_UNITS) {
#ifndef REP_GLA
#define REP_GLA 1
#endif
#pragma unroll 1
                for (int r_ = 0; r_ < REP_GLA; ++r_) gla_unit(S, QKS, VEC, O, it, lds, tid);
            } else {
#ifndef REP_ML
#define REP_ML 1
#endif
#pragma unroll 1
                for (int r_ = 0; r_ < REP_ML; ++r_) mat_unit<0>(QK2, 2048, 0, 1024, S, EV_PAD, 5120, 1.0f, GP, GPK, PP, RS, O, 1, nullptr, it - MIX_UNITS, lds, tid);
            }
        }
    } else {
        const int s5_first = G >= 2 * MIX_UNITS ? MIX_UNITS : 0, s5_wgs = G - s5_first;
#ifndef REP_RET
#define REP_RET 1
#endif
#ifndef REP_S5
#define REP_S5 1
#endif
#pragma unroll 1
        for (int r_ = 0; r_ < REP_RET; ++r_)
        for (int u = blockIdx.x; u < MIX_UNITS; u += G)
            mat_unit<1>(S, OD_COLS, 1024, 2048, S, OD_COLS, 3072, 0.0625f, nullptr, nullptr, PP, RS, O, 0, ARG(32), u, lds, tid);
#pragma unroll 1
        for (int r_ = 0; r_ < REP_S5; ++r_)
        if ((int)blockIdx.x >= s5_first && wave < 4) { for (int su = ((int)blockIdx.x - s5_first) * 4 + wave; su < NB * 128; su += 4 * s5_wgs)
            s5_unit(S, OD_COLS, O, ARG(22), ARG(23), ARG(24), ARG(25), ARG(26), ARG(27), ARG(28), su, lds + wave * S5_LDS_PER_WAVE, lane); }
    }
    }
    xcd_barrier(bar);
    { int t2 = threadIdx.x; asm volatile("" : "+v"(t2)); tid = t2; lane = t2 & 63; wave = __builtin_amdgcn_readfirstlane(t2 >> 6); gw = blockIdx.x * NWAVES + wave; }
#ifndef NO_MERGE
    if (layer == 0) { const bf16* s_ = S; const bf16* o_ = O; const float* n0 = ARG(15); const float* n1 = ARG(19); bf16* hb_ = HB; for (int r = gw; r < TT; r += ngw) merge_even_row(r, s_, o_, n0, n1, hb_, lane); }
    else { const bf16* s_ = S; const bf16* o_ = O; const float* n0 = ARG(29); const float* n1 = ARG(33); bf16* gb_ = GB; bf16* hb_ = HB; for (int r = gw; r < TL; r += ngw) merge_odd_row(r, s_, o_, n0, n1, gb_, hb_, lane); }
#endif
    xcd_barrier(bar);
    const int Mo = layer == 0 ? TT : TL;
    if (layer == 1) {
        pg8::Gemm g{GB, (const bf16*)(wsp(ws, WS_WGLU)), TL, 1024, 1024}; pg8::StaticOrder So; So.init(TL, 1024, G, (int)blockIdx.x);
        EpiGLU E{GB, ARG(31), HB};
        pg8::gemm_phase<EpiGLU, pg8::StaticOrder, true, true>(lds, g, So, E);
        xcd_barrier(bar);
    }
    { pg8::Gemm g{HB, (const bf16*)(wsp(ws, (layer == 0 ? WS_WOUT_EV : WS_WOUT_OD))), Mo, D, D}; pg8::SplitOrder So; So.init(Mo - TL, D, G, (int)blockIdx.x);
      EpiF32 E{Y, (float*)(wsp(ws, WS_YCP))};
      pg8::gemm_phase<EpiF32, pg8::SplitOrder, true, true>(lds, g, So, E); }
    xcd_barrier(bar);
}
#undef HB
#undef S
#undef GT
#undef O
#undef GB
#undef Y
#undef QK2
#undef GP
#undef QKS
#undef GPK
#undef PP
#undef RS
#undef VEC

#ifndef MIXER_ON
#define MIXER_ON 1
#endif
__global__ void __launch_bounds__(NTHR, 2) fwd(Args a) {
    extern __shared__ __attribute__((aligned(16))) unsigned char lds_raw[];
    LAS unsigned char* lds = (LAS unsigned char*)lds_raw;
    const int tid = threadIdx.x, lane = tid & 63, wave = __builtin_amdgcn_readfirstlane(tid >> 6);
    const int G = gridDim.x, gw = blockIdx.x * NWAVES + wave, ngw = G * NWAVES;
    unsigned char* ws = a.ws;
    if (tid < 16) ((LAS unsigned*)(lds + MISC_OFF))[tid] = 0u;
    __syncthreads();
    XcdBarrier bar = xcd_barrier_post((unsigned*)(wsp(ws, WS_CTL)), (volatile LAS unsigned*)(lds + MISC_OFF));

#ifdef NAN_POISON
    {
        v4u q = (v4u){0xffffffffu, 0xffffffffu, 0xffffffffu, 0xffffffffu};
        for (int i = tid; i < (MISC_OFF) / 16; i += NTHR) ((LAS v4u*)lds)[i] = q;
        { v4u* p = (v4u*)(wsp(ws, WS_MOD)); const size_t n = (WS_WGU - WS_MOD) / 16; for (size_t i = (size_t)blockIdx.x * NTHR + tid; i < n; i += (size_t)G * NTHR) p[i] = q; }
        { v4u* p = (v4u*)(wsp(ws, WS_XC)); const size_t n = (WS_END - WS_XC) / 16; for (size_t i = (size_t)blockIdx.x * NTHR + tid; i < n; i += (size_t)G * NTHR) p[i] = q; }
        { v4u* p = (v4u*)a.out; const size_t n = (size_t)TL * D * 4 / 16; for (size_t i = (size_t)blockIdx.x * NTHR + tid; i < n; i += (size_t)G * NTHR) p[i] = q; }
        __syncthreads();
        xcd_barrier(bar);
    }
#endif
#define MOD ((float*)wsp(ws, WS_MOD))
#define MODP ((float*)wsp(ws, WS_MODP))
#define HB ((bf16*)wsp(ws, WS_HB))
#define HID ((bf16*)wsp(ws, WS_HID))
#define Y ((bf16*)wsp(ws, WS_Y))
#define XC ((float*)wsp(ws, WS_XC))

#ifndef REP_PRO
#define REP_PRO 1
#endif
#ifndef REP_GU
#define REP_GU 1
#endif
#ifndef REP_DN
#define REP_DN 1
#endif
#pragma unroll 1
    for (int rep_ = 0; rep_ < REP_PRO; ++rep_) {
        __syncthreads();
        TJob* jobs = (TJob*)lds_raw;
        LAS float* stab = (LAS float*)(lds + 1024);
        if (tid == 0) {
            int t = 0, ji = 0;
            for (int l = 0; l < 2; ++l) for (int i = 0; i < 2; ++i) {
                const size_t wo = (size_t)(l * 2 + i) * 2048 * 5504;
                TJob j; j.K = 2048; j.N = 5504; j.dst = (bf16*)(wsp(ws, WS_WGU) + (size_t)(l * 2 + i) * SZ_WGU);
                j.src = ARG(8) + wo; j.map = 1; j.tstart = t; jobs[ji++] = j; t += tj_tiles(2048, 5504);
                j.src = ARG(9) + wo; j.map = 2; j.tstart = t; jobs[ji++] = j; t += tj_tiles(2048, 5504);
                j.K = 5504; j.N = 2048; j.dst = (bf16*)(wsp(ws, WS_WD) + (size_t)(l * 2 + i) * SZ_WD); j.src = ARG(10) + wo; j.map = 0; j.tstart = t; jobs[ji++] = j; t += tj_tiles(5504, 2048);
            }
            TJob j; j.map = 0;
            j.K = 2048; j.N = EV_COLS; j.src = ARG(11); j.dst = (bf16*)(wsp(ws, WS_WIN_EV)); j.map = 3; j.tstart = t; jobs[ji++] = j; t += tj_tiles(2048, EV_COLS);
            j.map = 0;
            j.K = 2048; j.N = 2048; j.src = ARG(12); j.dst = (bf16*)(wsp(ws, WS_WOUT_EV)); j.tstart = t; jobs[ji++] = j; t += tj_tiles(2048, 2048);
            j.K = 2048; j.N = OD_COLS; j.src = ARG(20); j.dst = (bf16*)(wsp(ws, WS_WIN_OD)); j.tstart = t; jobs[ji++] = j; t += tj_tiles(2048, OD_COLS);
            j.K = 2048; j.N = 2048; j.src = ARG(21); j.dst = (bf16*)(wsp(ws, WS_WOUT_OD)); j.tstart = t; jobs[ji++] = j; t += tj_tiles(2048, 2048);
            j.K = 1024; j.N = 1024; j.src = ARG(30); j.dst = (bf16*)(wsp(ws, WS_WGLU)); j.tstart = t; jobs[ji++] = j; t += tj_tiles(1024, 1024);
            ((LAS int*)(lds + 1024 - 16))[0] = t;
        }
        { const float* cin = ARG(1); const float* cctx = ARG(3);
        for (int i = tid; i < 5 * D; i += NTHR) { const int r = i >> 11, k = i & (D - 1); const float c = r < 4 ? cin[r * D + k] : cctx[k]; stab[i] = c / (1.0f + expf(-c)); } }
        __syncthreads();
        for (int it = gw; it < 2 * MOD_KC * 72; it += ngw) {
            const int l = it / (MOD_KC * 72), rem = it % (MOD_KC * 72), kc = rem / 72, jb = rem % 72; constexpr int KCH = D / MOD_KC;
            const float* W = ARG(4) + ((size_t)l * D + kc * KCH) * (NMOD * D) + jb * 256 + lane * 4;
            f32x4 acc[5];
#pragma unroll
            for (int r = 0; r < 5; ++r) acc[r] = (f32x4){0.f, 0.f, 0.f, 0.f};
            for (int k = 0; k < KCH; k += 8) { f32x4 w[8];
#pragma unroll
                for (int i = 0; i < 8; ++i) w[i] = *(const f32x4*)(W + (size_t)(k + i) * (NMOD * D));
#pragma unroll
                for (int i = 0; i < 8; ++i)
#pragma unroll
                    for (int r = 0; r < 5; ++r) acc[r] += stab[r * D + kc * KCH + k + i] * w[i]; }
            { float* modp = MODP;
#pragma unroll
            for (int r = 0; r < 5; ++r) *(f32x4*)(modp + (((size_t)l * MOD_KC + kc) * 5 + r) * (NMOD * D) + jb * 256 + lane * 4) = acc[r]; }
        }
        const int ntiles = ((LAS int*)(lds + 1024 - 16))[0];
        for (int t = gw; t < ntiles; t += ngw) {
            int ji = 0;
#pragma unroll 1
            for (int q = 1; q < NJOBS; ++q) if (t >= jobs[q].tstart) ji = q;
            const TJob j = jobs[ji];
            transpose_tile(j, t - j.tstart, lane);
        }
        { v4u z = (v4u){0u, 0u, 0u, 0u}; v4u* p = (v4u*)(wsp(ws, WS_WIN_EV) + (size_t)EV_COLS * 2048 * 2); const int n16 = (EV_PAD - EV_COLS) * 2048 * 2 / 16;
          for (int i = blockIdx.x * NTHR + tid; i < n16; i += G * NTHR) p[i] = z; }
    }
    xcd_barrier(bar);
    { const float* bmod = ARG(5); const float* modp = MODP; float* modf = MOD;
    for (int i = blockIdx.x * NTHR + tid; i < 2 * 5 * NMOD * D; i += G * NTHR) {
        const int l = i / (5 * NMOD * D), rem = i % (5 * NMOD * D), r = rem / (NMOD * D), j = rem % (NMOD * D);
        float s = bmod[l * (NMOD * D) + j];
        for (int kc = 0; kc < MOD_KC; ++kc) s += modp[(((size_t)l * MOD_KC + kc) * 5 + r) * (NMOD * D) + j];
        modf[i] = s;
    } }
    xcd_barrier(bar);
    { NormP p{}; p.xin_lat = ARG(0); p.xin_ctx = ARG(2); p.xout_lat = a.out; p.xout_ctx = XC; p.y = nullptr; p.h = HB; p.rows_end = TT; p.has_y = 0; p.has_h = 1; p.w = 0.f; p.lp = 0; p.sp = 0; p.ln = 0; p.sn = 0;
      norm_phase(p, MOD, ARG(6), ARG(7), lds, gw, ngw, tid, lane); }
    xcd_barrier(bar);

#pragma unroll 1
    for (int layer = 0; layer < 2; ++layer) {
#pragma unroll 1
        for (int half = 0; half < 2; ++half) {
            const int Mrows = (layer == 1 && half == 1) ? TL : TT;
#if MIXER_ON
            if (half == 1) {
                mixer_phases(a, ws, lds, bar, layer, G, gw, ngw, tid, lane, wave);
                NormP p{}; p.xin_lat = a.out; p.xin_ctx = XC; p.xout_lat = a.out; p.xout_ctx = XC; p.y = Y; p.y_ctx = (const float*)(wsp(ws, WS_YCP)); p.h = HB; p.rows_end = Mrows; p.has_y = 1; p.has_h = 1; p.w = 1.0f; p.lp = layer; p.sp = 1; p.ln = layer; p.sn = 2;
                norm_phase(p, MOD, ARG(6), ARG(7), lds, gw, ngw, tid, lane);
                xcd_barrier(bar);
            }
#endif
            const int sub = half * 2;
#pragma unroll 1
            for (int rep_ = 0; rep_ < REP_GU; ++rep_) { pg8::Gemm g{HB, (const bf16*)(wsp(ws, WS_WGU) + (size_t)(layer * 2 + half) * SZ_WGU), Mrows, 2 * DFF, D}; pg8::StaticOrder S; S.init(Mrows, 2 * DFF, G, (int)blockIdx.x);
              EpiSwiGLU E{HID, DFF};
              pg8::gemm_phase<EpiSwiGLU, pg8::StaticOrder, true, true>(lds, g, S, E);
              if (rep_ + 1 < REP_GU) xcd_barrier(bar); }
            xcd_barrier(bar);
#pragma unroll 1
            for (int rep_ = 0; rep_ < REP_DN; ++rep_) { pg8::Gemm g{HID, (const bf16*)(wsp(ws, WS_WD) + (size_t)(layer * 2 + half) * SZ_WD), Mrows, D, DFF}; pg8::SplitOrder S; S.init(Mrows - TL, DFF, G, (int)blockIdx.x);
              EpiF32 E{Y, (float*)(wsp(ws, WS_YCP))};
              pg8::gemm_phase<EpiF32, pg8::SplitOrder, true, true>(lds, g, S, E);
              if (rep_ + 1 < REP_DN) xcd_barrier(bar); }
            xcd_barrier(bar);
            { NormP p{}; const bool first = (layer == 0 && half == 0);
              p.xin_lat = first ? ARG(0) : a.out; p.xin_ctx = first ? ARG(2) : XC; p.xout_lat = a.out; p.xout_ctx = XC; p.y = Y; p.y_ctx = (const float*)(wsp(ws, WS_YCP)); p.h = HB; p.rows_end = Mrows; p.has_y = 1; p.w = 0.5f; p.lp = layer; p.sp = sub;
              if (half == 0) { p.has_h = 1; p.ln = layer; p.sn = MIXER_ON ? 1 : 2; }
              else if (layer == 0) { p.has_h = 1; p.ln = 1; p.sn = 0; }
              else { p.has_h = 0; p.ln = 0; p.sn = 0; }
              norm_phase(p, MOD, ARG(6), ARG(7), lds, gw, ngw, tid, lane); }
            if (!(layer == 1 && half == 1)) xcd_barrier(bar);
        }
    }
}

#undef MOD
#undef MODP
#undef HB
#undef HID
#undef Y
#undef XC
extern "C" void kernel_launch(void* const* d_in, const int* in_sizes, int n_in, void* d_out, int out_size, void* d_ws, size_t ws_size, hipStream_t stream) {
    static int grid = 0;
    if (grid == 0) {
        if (n_in != 34 || out_size != TL * D || ws_size < WS_END) { fprintf(stderr, "kernel_launch: unexpected shapes (n_in %d out %d ws %zu need %zu)\n", n_in, out_size, ws_size, (size_t)WS_END); grid = -1; return; }
        int dev = 0, cus = 0, per_cu = 0;
        if (hipGetDevice(&dev) != hipSuccess || hipDeviceGetAttribute(&cus, hipDeviceAttributeMultiprocessorCount, dev) != hipSuccess) { grid = -1; return; }
        if (hipFuncSetAttribute((const void*)fwd, hipFuncAttributeMaxDynamicSharedMemorySize, LDS_BYTES) != hipSuccess) { fprintf(stderr, "kernel_launch: hipFuncSetAttribute failed\n"); grid = -1; return; }
        if (hipOccupancyMaxActiveBlocksPerMultiprocessor(&per_cu, (const void*)fwd, NTHR, LDS_BYTES) != hipSuccess || per_cu < 1) { fprintf(stderr, "kernel_launch: occupancy query says %d\n", per_cu); }
        (void)hipGetLastError();
        grid = cus;
    }
    if (grid < 0) return;
    if (hipMemsetAsync((char*)d_ws + WS_CTL, 0, CTL_ZERO_BYTES, stream) != hipSuccess) return;
    Args a{};
    for (int i = 0; i < 34; ++i) a.in[i] = (const float*)d_in[i];
    a.out = (float*)d_out; a.ws = (unsigned char*)d_ws;
    hipLaunchKernelGGL(fwd, dim3(grid), dim3(NTHR), LDS_BYTES, stream, a);
}
```

```cpp
#include <hip/hip_runtime.h>
#include <cstdio>
#include <cstdint>
#define MIXER_ON 1

#define XB_TMO      128
#define XB_XCNT(j)  (256  + 64 * (j))
#define XB_XSUB(j)  (1280 + 64 * (j))
#define XB_XGEN(j)  (2304 + 64 * (j))
#define XB_TOP      3328
#define XB_TOPGEN   3392
#define XCD_BAR_WORDS 3456
#define XB_SPIN_CAP (1u << 18)
#define LAS __attribute__((address_space(3)))

__device__ __forceinline__ unsigned xb_ld(unsigned* p)              { return __hip_atomic_load(p, __ATOMIC_RELAXED, __HIP_MEMORY_SCOPE_AGENT); }
__device__ __forceinline__ unsigned xb_add(unsigned* p, unsigned v) { return __hip_atomic_fetch_add(p, v, __ATOMIC_RELAXED, __HIP_MEMORY_SCOPE_AGENT); }
__device__ __forceinline__ unsigned xb_xcc_id() { return (unsigned)__builtin_amdgcn_s_getreg((3 << 11) | 20) & 0xFu; }
#define XB_SPIN(cond, bar) do { unsigned _sp = 0; while (cond) { __builtin_amdgcn_s_sleep(1); \
    if ((++_sp & 255u) == 0u) { if (xb_ld(&(bar)[XB_TMO])) break; if (_sp > XB_SPIN_CAP) { atomicAdd(&(bar)[XB_TMO], 1u); break; } } } } while (0)

struct XcdBarrier {
    unsigned* bar; unsigned x;
    volatile LAS unsigned* st;
};

__device__ __forceinline__ XcdBarrier xcd_barrier_post(unsigned* bar, volatile LAS unsigned* st) {
    XcdBarrier b; b.bar = bar; b.x = xb_xcc_id(); b.st = st;
    if (threadIdx.x == 0) (void)xb_add(&bar[XB_XCNT(b.x)], 1u);
    return b;
}
__device__ __forceinline__ void xcd_barrier_complete(unsigned* bar, unsigned x, unsigned& nloc, unsigned& nx) {
    const unsigned G = gridDim.x * gridDim.y * gridDim.z;
    unsigned sum, cnt, mine, sp = 0u;
    for (;;) {
        sum = 0u; cnt = 0u; mine = 0u;
#pragma unroll
        for (unsigned j = 0; j < 16; ++j) { const unsigned c = xb_ld(&bar[XB_XCNT(j)]); sum += c; cnt += (c > 0u) ? 1u : 0u; mine = (j == x) ? c : mine; }
        if (sum == G) break;
        __builtin_amdgcn_s_sleep(1);
        if ((++sp & 255u) == 0u) { if (xb_ld(&bar[XB_TMO])) break; if (sp > XB_SPIN_CAP) { atomicAdd(&bar[XB_TMO], 1u); break; } }
    }
    nloc = mine > 0u ? mine : 1u; nx = cnt > 0u ? cnt : 1u;
}

__device__ __forceinline__ void xcd_barrier(const XcdBarrier& b) {
    asm volatile("s_waitcnt vmcnt(0)" ::: "memory");
    __syncthreads();
    if (threadIdx.x == 0) {
        unsigned* bar = b.bar;
        unsigned bx = __builtin_amdgcn_readfirstlane(b.x); asm volatile("" : "+s"(bx));
        __builtin_amdgcn_s_waitcnt(0);
        unsigned nloc = b.st[0], nx = b.st[1];
        if (nloc == 0u) { xcd_barrier_complete(bar, bx, nloc, nx); b.st[0] = nloc; b.st[1] = nx; }
        const unsigned old = xb_add(&bar[XB_XSUB(bx)], 1u);
        const unsigned gen = old / nloc;
        if (old + 1u == (gen + 1u) * nloc) {
            __builtin_amdgcn_fence(__ATOMIC_RELEASE, "agent");
            asm volatile("s_waitcnt vmcnt(0)" ::: "memory");
            const unsigned og = xb_add(&bar[XB_TOP], 1u);
            const unsigned tg = og / nx;
            if (og + 1u == (tg + 1u) * nx) xb_add(&bar[XB_TOPGEN], 1u);
            else XB_SPIN(xb_ld(&bar[XB_TOPGEN]) == tg, bar);
            __builtin_amdgcn_fence(__ATOMIC_ACQUIRE, "agent");
            xb_add(&bar[XB_XGEN(bx)], 1u);
            asm volatile("s_waitcnt vmcnt(0)" ::: "memory");
        } else {
            XB_SPIN(xb_ld(&bar[XB_XGEN(bx)]) == gen, bar);
            __builtin_amdgcn_fence(__ATOMIC_ACQUIRE, "agent");
            asm volatile("s_waitcnt vmcnt(0)" ::: "memory");
        }
    }
    __syncthreads();
}

namespace pg8 {
#define PG8_LAS __attribute__((address_space(3)))
typedef unsigned short bf16_t;
typedef short bf16x8 __attribute__((ext_vector_type(8)));
typedef float f32x4 __attribute__((ext_vector_type(4)));
typedef unsigned u32x4 __attribute__((ext_vector_type(4)));
constexpr int BM = 256, BK = 64, HALF = 128, HTB = HALF * BK * 2  , STAGE_BYTES = 8 * HTB, NXCD = 8, WGM = 8;

__host__ __device__ __forceinline__ int lds_byte(int r, int c) { const int st = (r >> 4) * 2 + (c >> 5), rr = r & 15, cc = c & 31, ob = rr * 64 + cc * 2; return st * 1024 + (ob ^ (((ob >> 9) & 1) << 5)); }
__host__ __device__ __forceinline__ void stage_rc(int b, int& R, int& C) { const int st = b / 1024, sb = b % 1024, swz = sb ^ (((sb >> 9) & 1) << 5); R = (st >> 1) * 16 + swz / 64; C = (st & 1) * 32 + (swz % 64) / 2; }
__host__ __device__ __forceinline__ int perm32(int rho) { const int n = rho >> 4, i = rho & 15; return 8 * (i >> 2) + 4 * n + (i & 3); }

struct Unit { int pm, pn, k0, nt, part; };
struct Gemm { const bf16_t* A; const bf16_t* Bt; int M, N, K; };

struct StaticOrder {
    int nM, nN, nwg, G, c;
    __host__ __device__ void init(int M, int N, int G_, int c_) { nM = M / BM; nN = N / BM; nwg = nM * nN; G = G_; c = c_; }
    __host__ __device__ bool next(int i, Unit& u) const {
        const long L = (long)i * G + c; if (L >= nwg) return false;
        int wgid = (int)L; { const int q = nwg / NXCD, r = nwg % NXCD, xcd = wgid % NXCD, off = wgid / NXCD; wgid = (xcd < r ? xcd * (q + 1) : r * (q + 1) + (xcd - r) * q) + off; }
        const int nig = WGM * nN, gid = wgid / nig, fm = gid * WGM, gsz = (nM - fm) < WGM ? (nM - fm) : WGM;
        u.pm = fm + ((wgid % nig) % gsz); u.pn = (wgid % nig) / gsz; u.k0 = 0; u.nt = 0; u.part = -1; return true;
    }
    __device__ __forceinline__ void a_ready(const Unit&) const {}
    __device__ __forceinline__ void done(const Unit&) const {}
};
struct SplitOrder {
    static constexpr int NMF = 64, NN = 8, PARTS = 8, NFULL = NMF * NN;
    int nsplit, ntK, G, c;
    __host__ __device__ void init(int Msplit, int K, int G_, int c_) { nsplit = (Msplit / BM) * NN * PARTS; ntK = K / BK; G = G_; c = c_; }
    __host__ __device__ bool next(int i, Unit& u) const {
        const int L = i * G + c, p = L - NFULL; const bool fullu = L < NFULL;
        const int wgid = (L % NXCD) * (NFULL / NXCD) + L / NXCD, nig = WGM * NN, fm = (wgid / nig) * WGM;
        const int q = p & 7, cu = p >> 3, h = ntK >> 1, ks = ((h * q) >> 3) << 1, ke = ((h * (q + 1)) >> 3) << 1;
        u.pm = fullu ? fm + ((wgid % nig) % WGM) : NMF + (cu >> 3);
        u.pn = fullu ? (wgid % nig) / WGM : (cu & 7);
        u.k0 = fullu ? 0 : ks; u.nt = fullu ? 0 : ke - ks; u.part = fullu ? -1 : q;
        return fullu || p < nsplit;
    }
    __device__ __forceinline__ void a_ready(const Unit&) const {}
    __device__ __forceinline__ void done(const Unit&) const {}
};
__device__ __forceinline__ unsigned cvt_pk_bf16(float lo, float hi) { unsigned r; asm volatile("v_cvt_pk_bf16_f32 %0, %1, %2" : "=v"(r) : "v"(lo), "v"(hi)); return r; }
template <class Epi, class Sched, bool ALIGN_EPI = false, bool SP2 = false>
__device__ __forceinline__ void gemm_phase(PG8_LAS unsigned char* lds, const Gemm g, const Sched& S, const Epi& E) {
    int tid_ = threadIdx.x; asm volatile("" : "+v"(tid_));
    const int tid = tid_, wid = __builtin_amdgcn_readfirstlane(tid >> 6), lane = tid & 63, wr = wid >> 2, wc = wid & 3, fr = lane & 15, fq = lane >> 4;
    const int K = g.K, nt = K / BK;
    unsigned voffA[2], voffB[2];
#pragma unroll
    for (int i = 0; i < 2; ++i) { int R, C; stage_rc(tid * 16 + i * 8192, R, C); const int Rb = Epi::PERM ? ((R & ~31) + perm32(R & 31)) : R;
        voffA[i] = (unsigned)(R * K + C) * 2u; voffB[i] = (unsigned)(Rb * K + C) * 2u; }
    const unsigned kstep = BK * 2;
    const unsigned hstep = (unsigned)HALF * K * 2;
    const unsigned tstep = 2 * hstep;
    const unsigned ldsw = (unsigned)wid * 1024u;
    const int aoff = lds_byte(wr * 64 + fr, fq * 8), boff = lds_byte(wc * 32 + fr, fq * 8);
#define PG8_SA(b, h) (((b) * 2 + (h)) * HTB)
#define PG8_SB(b, h) ((4 + (b) * 2 + (h)) * HTB)
#define PG8_STAGE(bufoff, gbase, voff) do { _Pragma("unroll") for (int _i = 0; _i < 2; ++_i) \
        __builtin_amdgcn_global_load_lds((const unsigned*)((const char*)(gbase) + (voff)[_i]), (PG8_LAS unsigned*)(lds + (bufoff) + ldsw + _i * 8192), 16, 0, 0); } while (0)
#define PG8_LDA(dst, b, h) do { _Pragma("unroll") for (int m = 0; m < 4; ++m) _Pragma("unroll") for (int k = 0; k < 2; ++k) dst[m][k] = *(const PG8_LAS bf16x8*)(lds + PG8_SA(b, h) + aoff + m * 2048 + k * 1024); } while (0)
#define PG8_LDB(dst, b, h) do { _Pragma("unroll") for (int n = 0; n < 2; ++n) _Pragma("unroll") for (int k = 0; k < 2; ++k) dst[n][k] = *(const PG8_LAS bf16x8*)(lds + PG8_SB(b, h) + boff + n * 2048 + k * 1024); } while (0)
#define PG8_MMA(ai, bj, At, Bt) do { __builtin_amdgcn_s_setprio(1); _Pragma("unroll") for (int m = 0; m < 4; ++m) _Pragma("unroll") for (int n = 0; n < 2; ++n) _Pragma("unroll") for (int k = 0; k < 2; ++k) \
        acc[ai][bj][m][n] = __builtin_amdgcn_mfma_f32_16x16x32_bf16(Bt[n][k], At[m][k], acc[ai][bj][m][n], 0, 0, 0); __builtin_amdgcn_s_setprio(0); } while (0)
#define PG8_WAIT_V(n) asm volatile("s_waitcnt vmcnt(" #n ")" ::: "memory")
#define PG8_WAIT_L(n) asm volatile("s_waitcnt lgkmcnt(" #n ")" ::: "memory")
#define PG8_BAR __builtin_amdgcn_s_barrier()
#define PG8_SCHED __builtin_amdgcn_sched_barrier(0)
    Unit cur, nxt; int ui = 0;
    if (!S.next(0, cur)) return;
    f32x4 acc[2][2][4][2];
#pragma unroll
    for (int a = 0; a < 2; ++a)
#pragma unroll
        for (int b = 0; b < 2; ++b)
#pragma unroll
            for (int m = 0; m < 4; ++m)
#pragma unroll
                for (int n = 0; n < 2; ++n) acc[a][b][m][n] = (f32x4){0.f, 0.f, 0.f, 0.f};
    bf16x8 At[4][2], B0[2][2], B1[2][2];
    unsigned cA = (unsigned)cur.pm * tstep + (unsigned)cur.k0 * kstep, cB = (unsigned)cur.pn * tstep + (unsigned)cur.k0 * kstep;
    S.a_ready(cur);
    if constexpr (SP2) {
        PG8_STAGE(PG8_SB(0, 0), (const char*)g.Bt + (size_t)(cB), voffB); PG8_STAGE(PG8_SB(0, 1), (const char*)g.Bt + (size_t)(cB + hstep), voffB); PG8_STAGE(PG8_SA(0, 0), (const char*)g.A + (size_t)(cA), voffA); PG8_STAGE(PG8_SA(0, 1), (const char*)g.A + (size_t)(cA + hstep), voffA);
        if (wr == 1) PG8_BAR;
        PG8_WAIT_V(2); PG8_BAR;
        PG8_STAGE(PG8_SB(1, 0), (const char*)g.Bt + (size_t)(cB + kstep), voffB); PG8_STAGE(PG8_SA(1, 0), (const char*)g.A + (size_t)(cA + kstep), voffA); PG8_STAGE(PG8_SB(1, 1), (const char*)g.Bt + (size_t)(cB + hstep + kstep), voffB);
        PG8_WAIT_V(6); PG8_BAR;
    } else {
        PG8_STAGE(PG8_SB(0, 0), (const char*)g.Bt + (size_t)(cB), voffB); PG8_STAGE(PG8_SA(0, 0), (const char*)g.A + (size_t)(cA), voffA); PG8_STAGE(PG8_SB(0, 1), (const char*)g.Bt + (size_t)(cB + hstep), voffB); PG8_STAGE(PG8_SA(0, 1), (const char*)g.A + (size_t)(cA + hstep), voffA);
        if (wr == 1) PG8_BAR;
        PG8_WAIT_V(4); PG8_BAR;
        PG8_STAGE(PG8_SB(1, 0), (const char*)g.Bt + (size_t)(cB + kstep), voffB); PG8_STAGE(PG8_SA(1, 0), (const char*)g.A + (size_t)(cA + kstep), voffA); PG8_STAGE(PG8_SB(1, 1), (const char*)g.Bt + (size_t)(cB + hstep + kstep), voffB);
        PG8_WAIT_V(6); PG8_BAR;
    }
    for (;;) {
        const bool has_next = S.next(ui + 1, nxt);
        const unsigned nA = has_next ? (unsigned)nxt.pm * tstep + (unsigned)nxt.k0 * kstep : cA, nB = has_next ? (unsigned)nxt.pn * tstep + (unsigned)nxt.k0 * kstep : cB;
        const int unt = cur.nt ? cur.nt : nt;
        for (int t = 0; t < unt; t += 2) {
            const bool last = (t == unt - 2);
            const unsigned a1 = cA + (unsigned)(t + 1) * kstep;
            const unsigned a2 = last ? nA : cA + (unsigned)(t + 2) * kstep, b2 = last ? nB : cB + (unsigned)(t + 2) * kstep;
            const unsigned a3 = a2 + kstep, b3 = b2 + kstep;
            if (last && has_next) S.a_ready(nxt);
            if constexpr (SP2) {
            PG8_LDB(B0, 0, 0); PG8_LDB(B1, 0, 1); PG8_SCHED; PG8_LDA(At, 0, 0); PG8_STAGE(PG8_SA(1, 1), (const char*)g.A + (size_t)(a1 + hstep), voffA);
            PG8_WAIT_V(8); PG8_WAIT_L(0); PG8_BAR; PG8_MMA(0, 0, At, B0); PG8_MMA(0, 1, At, B1); PG8_BAR; PG8_SCHED;
            PG8_LDA(At, 0, 1); PG8_STAGE(PG8_SB(0, 0), (const char*)g.Bt + (size_t)(b2), voffB); PG8_STAGE(PG8_SB(0, 1), (const char*)g.Bt + (size_t)(b2 + hstep), voffB); PG8_STAGE(PG8_SA(0, 0), (const char*)g.A + (size_t)(a2), voffA);
            PG8_WAIT_V(8); PG8_WAIT_L(0); PG8_BAR; PG8_MMA(1, 0, At, B0); PG8_MMA(1, 1, At, B1); PG8_BAR; PG8_SCHED;
            PG8_LDB(B0, 1, 0); PG8_LDB(B1, 1, 1); PG8_SCHED; PG8_LDA(At, 1, 0); PG8_STAGE(PG8_SA(0, 1), (const char*)g.A + (size_t)(a2 + hstep), voffA);
            PG8_WAIT_V(8); PG8_WAIT_L(0); PG8_BAR; PG8_MMA(0, 0, At, B0); PG8_MMA(0, 1, At, B1); PG8_BAR; PG8_SCHED;
            PG8_LDA(At, 1, 1); PG8_STAGE(PG8_SB(1, 0), (const char*)g.Bt + (size_t)(b3), voffB); PG8_STAGE(PG8_SB(1, 1), (const char*)g.Bt + (size_t)(b3 + hstep), voffB); PG8_STAGE(PG8_SA(1, 0), (const char*)g.A + (size_t)(a3), voffA);
            PG8_WAIT_V(8); PG8_WAIT_L(0); PG8_BAR; PG8_MMA(1, 0, At, B0); PG8_MMA(1, 1, At, B1); PG8_BAR; PG8_SCHED;
            } else {
            PG8_LDB(B0, 0, 0); PG8_SCHED; PG8_LDA(At, 0, 0); PG8_STAGE(PG8_SA(1, 1), (const char*)g.A + (size_t)(a1 + hstep), voffA);
            PG8_WAIT_L(8); PG8_BAR; PG8_WAIT_L(0); PG8_MMA(0, 0, At, B0); PG8_BAR; PG8_SCHED;
            PG8_LDB(B1, 0, 1); PG8_STAGE(PG8_SB(0, 0), (const char*)g.Bt + (size_t)(b2), voffB);
            PG8_BAR; PG8_WAIT_L(0); PG8_MMA(0, 1, At, B1); PG8_BAR;
            PG8_LDA(At, 0, 1); PG8_STAGE(PG8_SA(0, 0), (const char*)g.A + (size_t)(a2), voffA);
            PG8_BAR; PG8_WAIT_L(0); PG8_MMA(1, 0, At, B0); PG8_BAR; PG8_SCHED;
            PG8_STAGE(PG8_SB(0, 1), (const char*)g.Bt + (size_t)(b2 + hstep), voffB);
            PG8_WAIT_V(6); PG8_BAR; PG8_MMA(1, 1, At, B1); PG8_BAR;
            PG8_LDB(B0, 1, 0); PG8_SCHED; PG8_LDA(At, 1, 0); PG8_STAGE(PG8_SA(0, 1), (const char*)g.A + (size_t)(a2 + hstep), voffA);
            PG8_WAIT_L(8); PG8_BAR; PG8_WAIT_L(0); PG8_MMA(0, 0, At, B0); PG8_BAR; PG8_SCHED;
            PG8_LDB(B1, 1, 1); PG8_STAGE(PG8_SB(1, 0), (const char*)g.Bt + (size_t)(b3), voffB);
            PG8_BAR; PG8_WAIT_L(0); PG8_MMA(0, 1, At, B1); PG8_BAR;
            PG8_LDA(At, 1, 1); PG8_STAGE(PG8_SA(1, 0), (const char*)g.A + (size_t)(a3), voffA);
            PG8_BAR; PG8_WAIT_L(0); PG8_MMA(1, 0, At, B0); PG8_BAR; PG8_SCHED;
            PG8_STAGE(PG8_SB(1, 1), (const char*)g.Bt + (size_t)(b3 + hstep), voffB);
            PG8_WAIT_V(6); PG8_BAR; PG8_MMA(1, 1, At, B1); PG8_BAR;
            }
        }
        if constexpr (ALIGN_EPI) { if (wr == 0) PG8_BAR; }
        if constexpr (!Epi::AFTER_DRAIN) { int t_ = threadIdx.x; asm volatile("" : "+v"(t_)); const int l_ = t_ & 63, w_ = __builtin_amdgcn_readfirstlane(t_ >> 6);
            E(acc, cur, w_ >> 2, w_ & 3, l_ & 15, l_ >> 4); S.done(cur); }
        if (!has_next) break;
#pragma unroll
        for (int a = 0; a < 2; ++a)
#pragma unroll
            for (int b = 0; b < 2; ++b)
#pragma unroll
                for (int m = 0; m < 4; ++m)
#pragma unroll
                    for (int n = 0; n < 2; ++n) acc[a][b][m][n] = (f32x4){0.f, 0.f, 0.f, 0.f};
        cur = nxt; cA = nA; cB = nB; ++ui;
        if constexpr (ALIGN_EPI) { if (wr == 1) PG8_BAR; }
    }
    PG8_WAIT_V(0);
    if constexpr (!ALIGN_EPI) { if (wr == 0) PG8_BAR; }
    PG8_BAR;
    if constexpr (Epi::AFTER_DRAIN) { E.fused(acc, cur, wr, wc, fr, fq, lds, wid, lane); S.done(cur); }
#undef PG8_SA
#undef PG8_SB
#undef PG8_STAGE
#undef PG8_LDA
#undef PG8_LDB
#undef PG8_MMA
#undef PG8_WAIT_V
#undef PG8_WAIT_L
#undef PG8_BAR
#undef PG8_SCHED
}
}

#define GAS __attribute__((address_space(1)))
typedef unsigned short bf16;
typedef float f32x4 __attribute__((ext_vector_type(4)));
typedef unsigned v4u __attribute__((ext_vector_type(4)));
typedef unsigned v2u __attribute__((ext_vector_type(2)));
constexpr int D = 2048, NB = 4, SEQ = 4096, CTXL = 256, DFF = 5504, NMOD = 9;
constexpr int TL = NB * SEQ, TC = NB * CTXL, TT = TL + TC;
constexpr int MIXH = 1024;
constexpr int EV_COLS = 7216, EV_PAD = 7424, OD_COLS = 5120;
constexpr int NWAVES = 8, NTHR = 512;
constexpr float EPS = 1e-6f;

constexpr size_t MiB = 1u << 20;
constexpr size_t WS_CTL = 0, CTL_ZERO_BYTES = 64 * 1024;
constexpr size_t WS_MOD = 1 * MiB;
constexpr size_t WS_MODP = 2 * MiB;
constexpr int MOD_KC = 16;
constexpr size_t WS_WGU = 16 * MiB;
constexpr size_t SZ_WGU = (size_t)11008 * 2048 * 2;
constexpr size_t WS_WD = WS_WGU + 4 * SZ_WGU;
constexpr size_t SZ_WD = (size_t)2048 * 5504 * 2;
constexpr size_t WS_WIN_EV = WS_WD + 4 * SZ_WD;
constexpr size_t WS_WOUT_EV = WS_WIN_EV + (size_t)EV_PAD * 2048 * 2;
constexpr size_t WS_WIN_OD = WS_WOUT_EV + (size_t)2048 * 2048 * 2;
constexpr size_t WS_WOUT_OD = WS_WIN_OD + (size_t)OD_COLS * 2048 * 2;
constexpr size_t WS_WGLU = WS_WOUT_OD + (size_t)2048 * 2048 * 2;
constexpr size_t WS_XC = WS_WGLU + (size_t)1024 * 1024 * 2;
constexpr size_t WS_HB = WS_XC + (size_t)TC * D * 4;
constexpr size_t WS_R = WS_HB + (size_t)TT * D * 2;
constexpr size_t WS_HID = WS_R;
constexpr size_t WS_Y = WS_R + 183 * MiB;
constexpr size_t WS_S = WS_R;
constexpr size_t WS_GT = WS_R + 247 * MiB;
constexpr size_t WS_GB = WS_R + 264 * MiB;
constexpr size_t WS_O = WS_R + 298 * MiB;
constexpr size_t SZ_O = (size_t)TT * 1024 * 2;
constexpr size_t WS_XL = WS_R + 434 * MiB;
constexpr size_t WS_QK2 = WS_XL + (size_t)TL * D * 2;
constexpr size_t WS_GP = WS_QK2 + (size_t)TT * 2048 * 2;
constexpr size_t WS_QKS = WS_GP + (size_t)TT * 8 * 4 * 4;
constexpr size_t WS_VEC = WS_QKS + (size_t)2 * TT * 1024 * 2;
constexpr size_t WS_GPK = WS_VEC + (size_t)NB * 4 * 2 * 68 * 384 * 4;
constexpr size_t WS_PP = WS_GPK + (size_t)NB * 4 * 2 * 68 * 256 * 4;
constexpr size_t WS_RS = WS_PP + (size_t)NB * 4 * 2 * 68 * 4096 * 2;
constexpr size_t WS_END = WS_RS + (size_t)NB * 4 * 2 * 68 * 64 * 4;
constexpr size_t WS_YCP = WS_R + 320 * MiB;
constexpr int YPARTS = 8;
static_assert(WS_YCP >= WS_Y + (size_t)TT * D * 2 && WS_YCP + (size_t)YPARTS * TC * D * 4 <= WS_XL && WS_O + 4 * SZ_O <= WS_XL, "ws map");
static_assert(WS_HID + (size_t)TT * DFF * 2 <= WS_Y && WS_S + (size_t)TT * EV_PAD * 2 <= WS_GT && WS_GT + (size_t)TT * 256 * 4 <= WS_GB && WS_GB + (size_t)TT * 1024 * 2 <= WS_O, "ws map");
static_assert(WS_Y + (size_t)TT * D * 2 <= WS_O, "ws map");

constexpr int LDS_BYTES = 156 * 1024;
constexpr int MISC_OFF = LDS_BYTES - 64;

struct Args { const float* in[34]; float* out; unsigned char* ws; };
#define ARG(k) ((const float*)(GAS const float*)(a.in[opaque_idx(k)]))
__device__ __forceinline__ unsigned char* wsp(unsigned char* w, size_t off) { asm volatile("" : "+s"(off)); return w + off; }
__device__ __forceinline__ int opaque_idx(int k) { asm volatile("" : "+s"(k)); return k; }

__device__ __forceinline__ unsigned f2bf(float f) { unsigned u = __float_as_uint(f); u += 0x7FFFu + ((u >> 16) & 1u); return u >> 16; }
typedef __bf16 bf16x2_t __attribute__((ext_vector_type(2)));
typedef float f32x2_t __attribute__((ext_vector_type(2)));
__device__ __forceinline__ unsigned pk2(float lo, float hi) { const f32x2_t v = {lo, hi}; const bf16x2_t b = __builtin_convertvector(v, bf16x2_t); return __builtin_bit_cast(unsigned, b); }
__device__ __forceinline__ float bf2f(unsigned short b) { return __uint_as_float(((unsigned)b) << 16); }
__device__ __forceinline__ float wave_sum(float v) {
#pragma unroll
    for (int o = 1; o < 64; o <<= 1) v += __shfl_xor(v, o);
    return v;
}
__device__ __forceinline__ float fast_silu(float g) { return g * __builtin_amdgcn_rcpf(1.0f + __expf(-g)); }
__device__ __forceinline__ float fast_sigmoid(float g) { return __builtin_amdgcn_rcpf(1.0f + __expf(-g)); }

#ifndef DEFER
#define DEFER 1
#endif
struct TJob { const float* src; bf16* dst; int K, N, map; };
constexpr int NT_FFN = 5504, NT_EVIN = 32 * 226, NT_SQ = 2048, NT_ODIN = 32 * 160, NT_GLU = 512;
constexpr int NT_SET0 = 6 * NT_FFN + NT_EVIN + NT_SQ + NT_ODIN + NT_SQ + NT_GLU, NT_SET1 = 3 * NT_FFN, NT_SET2 = 3 * NT_FFN;
__device__ __forceinline__ void transpose_tile(const TJob& j, int tl, int lane) {
    const int nblk = (j.N + 31) / 32, kb = tl / nblk, nb = tl % nblk, k0 = 64 * kb, n0 = 32 * nb;
    const int kb8 = lane >> 3, nb4 = lane & 7, n = n0 + 4 * nb4;
    int drow0;
    if (j.map == 0) drow0 = n0;
    else if (j.map == 1) drow0 = (n0 / 128) * 256 + (n0 % 128);
    else if (j.map == 2) drow0 = (n0 / 128) * 256 + (n0 % 128) + 128;
    else drow0 = (nb < 96) ? n0 : (nb == 96 ? 7168 : (nb < 225 ? n0 - 32 : 7200));
    if (n < j.N) {
        const float* s = j.src + (size_t)(k0 + 8 * kb8) * j.N + n;
        f32x4 v[8];
#pragma unroll
        for (int i = 0; i < 8; ++i) v[i] = *(const f32x4*)(s + (size_t)i * j.N);
        bf16* d = j.dst + (size_t)(drow0 + 4 * nb4) * j.K + k0 + 8 * kb8;
#pragma unroll
        for (int e = 0; e < 4; ++e) { v4u o; o.x = pk2(v[0][e], v[1][e]); o.y = pk2(v[2][e], v[3][e]); o.z = pk2(v[4][e], v[5][e]); o.w = pk2(v[6][e], v[7][e]);
            *(v4u*)(d + (size_t)e * j.K) = o; }
    }
}

__device__ __forceinline__ TJob make_job(const Args& a, unsigned char* ws, int id) {
    TJob j;
    if (id < 12) { const int li = id / 3, kind = id % 3; const size_t wo = (size_t)li * 2048 * 5504;
        j.src = ARG(8 + kind) + wo;
        if (kind == 2) { j.K = 5504; j.N = 2048; j.map = 0; j.dst = (bf16*)(wsp(ws, WS_WD) + (size_t)li * SZ_WD); }
        else { j.K = 2048; j.N = 5504; j.map = 1 + kind; j.dst = (bf16*)(wsp(ws, WS_WGU) + (size_t)li * SZ_WGU); } }
    else if (id == 12) { j.src = ARG(11); j.K = 2048; j.N = EV_COLS; j.map = 3; j.dst = (bf16*)wsp(ws, WS_WIN_EV); }
    else if (id == 13) { j.src = ARG(12); j.K = 2048; j.N = 2048; j.map = 0; j.dst = (bf16*)wsp(ws, WS_WOUT_EV); }
    else if (id == 14) { j.src = ARG(20); j.K = 2048; j.N = OD_COLS; j.map = 0; j.dst = (bf16*)wsp(ws, WS_WIN_OD); }
    else if (id == 15) { j.src = ARG(21); j.K = 2048; j.N = 2048; j.map = 0; j.dst = (bf16*)wsp(ws, WS_WOUT_OD); }
    else { j.src = ARG(30); j.K = 1024; j.N = 1024; j.map = 0; j.dst = (bf16*)wsp(ws, WS_WGLU); }
    return j;
}
__device__ __forceinline__ void convert_tiles(const Args& a, unsigned char* ws, int set, int wave_index, int nwaves, int lane) {
    const int njobs = set == 0 ? 11 : 3;
    int start = wave_index;
#pragma unroll 1
    for (int q = 0; q < njobs; ++q) {
        const int id = set == 0 ? (q < 3 ? q : (q < 6 ? q + 3 : q + 6)) : (set == 1 ? 3 + q : 9 + q);
        const int nt = id < 12 ? NT_FFN : (id == 12 ? NT_EVIN : (id == 14 ? NT_ODIN : (id == 16 ? NT_GLU : NT_SQ)));
        const TJob j = make_job(a, ws, id);
        int t = start;
#pragma unroll 1
        for (; t < nt; t += nwaves) transpose_tile(j, t, lane);
        start = t - nt;
    }
}

struct NormP {
    const float* xin_lat; const float* xin_ctx; float* xout_lat; float* xout_ctx; const bf16* y; bf16* h;
    int rows_end; int has_y, has_h; float w;
    const float* y_ctx;
    int lp, sp;
    int ln, sn;
};
__device__ __forceinline__ void norm_phase(const NormP& p, const float* mod, const float* norm_pre, const float* norm_post, LAS unsigned char* lds, int gw, int ngw, int tid, int lane) {
    { int t2 = threadIdx.x; asm volatile("" : "+v"(t2)); tid = t2; lane = t2 & 63; gw = blockIdx.x * NWAVES + __builtin_amdgcn_readfirstlane(t2 >> 6); }
    LAS float* TA = (LAS float*)lds; LAS float* TB = TA + 5 * D; LAS float* TCc = TB + 5 * D;
    for (int i = tid; i < 5 * D; i += NTHR) { const int var = i >> 11, j = i & (D - 1);
        if (p.has_y) TA[i] = p.w * mod[((size_t)p.lp * 5 + var) * (NMOD * D) + (3 * p.sp + 2) * D + j] * norm_post[(p.lp * 3 + p.sp) * D + j];
        if (p.has_h) { TB[i] = norm_pre[(p.ln * 3 + p.sn) * D + j] * (1.0f + mod[((size_t)p.ln * 5 + var) * (NMOD * D) + (3 * p.sn + 1) * D + j]);
                       TCc[i] = mod[((size_t)p.ln * 5 + var) * (NMOD * D) + (3 * p.sn) * D + j]; } }
    __syncthreads();
    for (int r = gw; r < p.rows_end; r += ngw) {
        const int var = r < TL ? (r >> 12) : 4;
        const float* xi = r < TL ? p.xin_lat + (size_t)r * D : p.xin_ctx + (size_t)(r - TL) * D;
        float* xo = r < TL ? p.xout_lat + (size_t)r * D : p.xout_ctx + (size_t)(r - TL) * D;
        f32x4 xv[8];
#pragma unroll
        for (int j = 0; j < 8; ++j) xv[j] = *(const f32x4*)(xi + 4 * lane + 256 * j);
        if (p.has_y) {
            const bool yc = (r >= TL) && p.y_ctx; const float* yr = p.y_ctx + (size_t)(r - TL) * D; f32x4 yv[8]; float s = 0.f;
            if (!yc) { const bf16* yb = p.y + (size_t)r * D;
#pragma unroll
                for (int j = 0; j < 8; ++j) { const v2u w = *(const v2u*)(yb + 4 * lane + 256 * j); yv[j] = (f32x4){__uint_as_float(w.x << 16), __uint_as_float(w.x & 0xffff0000u), __uint_as_float(w.y << 16), __uint_as_float(w.y & 0xffff0000u)}; }
            } else {
#pragma unroll
                for (int j = 0; j < 8; ++j) yv[j] = *(const f32x4*)(yr + 4 * lane + 256 * j);
                for (int q = 1; q < YPARTS; ++q) {
#pragma unroll
                for (int j = 0; j < 8; ++j) yv[j] += *(const f32x4*)(yr + (size_t)q * TC * D + 4 * lane + 256 * j); } }
#pragma unroll
            for (int j = 0; j < 8; ++j) { s += (yv[j].x * yv[j].x + yv[j].y * yv[j].y) + (yv[j].z * yv[j].z + yv[j].w * yv[j].w); }
            const float rstd = 1.0f / sqrtf(wave_sum(s) * (1.0f / D) + EPS);
#pragma unroll
            for (int j = 0; j < 8; ++j) { const f32x4 a = *(const LAS f32x4*)(TA + var * D + 4 * lane + 256 * j); xv[j] = xv[j] + a * (yv[j] * rstd); *(f32x4*)(xo + 4 * lane + 256 * j) = xv[j]; }
        }
        if (p.has_h) {
            float s = 0.f;
#pragma unroll
            for (int j = 0; j < 8; ++j) s += (xv[j].x * xv[j].x + xv[j].y * xv[j].y) + (xv[j].z * xv[j].z + xv[j].w * xv[j].w);
            const float rstd = 1.0f / sqrtf(wave_sum(s) * (1.0f / D) + EPS);
            bf16* hr = p.h + (size_t)r * D;
#pragma unroll
            for (int j = 0; j < 8; ++j) { const f32x4 b = *(const LAS f32x4*)(TB + var * D + 4 * lane + 256 * j), c = *(const LAS f32x4*)(TCc + var * D + 4 * lane + 256 * j);
                const f32x4 o = xv[j] * rstd * b + c; v2u w; w.x = pk2(o.x, o.y); w.y = pk2(o.z, o.w); *(v2u*)(hr + 4 * lane + 256 * j) = w; }
        }
    }
    __syncthreads();
}

struct EpiSwiGLU {
    static constexpr bool PERM = true, AFTER_DRAIN = false;
    bf16* O; int ldc;
    __device__ __forceinline__ void operator()(const pg8::f32x4 (&acc)[2][2][4][2], const pg8::Unit& u, int wr, int wc, int fr, int fq) const {
        const int row0 = u.pm * 256 + wr * 64 + fr, col0 = u.pn * 128 + wc * 32 + 8 * fq;
#pragma unroll
        for (int ai = 0; ai < 2; ++ai)
#pragma unroll
            for (int m = 0; m < 4; ++m) { bf16* rowp = O + (size_t)(row0 + ai * 128 + m * 16) * ldc + col0;
                const pg8::f32x4 g0 = acc[ai][0][m][0], g1 = acc[ai][0][m][1], u0 = acc[ai][1][m][0], u1 = acc[ai][1][m][1];
                v4u w; w.x = pk2(fast_silu(g0[0]) * u0[0], fast_silu(g0[1]) * u0[1]); w.y = pk2(fast_silu(g0[2]) * u0[2], fast_silu(g0[3]) * u0[3]);
                w.z = pk2(fast_silu(g1[0]) * u1[0], fast_silu(g1[1]) * u1[1]); w.w = pk2(fast_silu(g1[2]) * u1[2], fast_silu(g1[3]) * u1[3]);
                *(v4u*)rowp = w; }
    }
};
struct EpiF32 {
    static constexpr bool PERM = true, AFTER_DRAIN = false;
    bf16* C; float* Cs;
    static constexpr int ldc = D;
    __device__ __forceinline__ void operator()(const pg8::f32x4 (&acc)[2][2][4][2], const pg8::Unit& u, int wr, int wc, int fr, int fq) const {
        const int row0 = u.pm * 256 + wr * 64 + fr, col0 = u.pn * 256 + wc * 32 + 8 * fq;
        if (u.part >= 0) {
            float* base = Cs + ((size_t)u.part * TC - (size_t)TL) * D;
#pragma unroll
            for (int ai = 0; ai < 2; ++ai)
#pragma unroll
                for (int m = 0; m < 4; ++m) { float* rowp = base + (size_t)(row0 + ai * 128 + m * 16) * ldc + col0;
#pragma unroll
                    for (int bj = 0; bj < 2; ++bj) { *(pg8::f32x4*)(rowp + bj * 128) = acc[ai][bj][m][0]; *(pg8::f32x4*)(rowp + bj * 128 + 4) = acc[ai][bj][m][1]; } }
        } else {
#pragma unroll
            for (int ai = 0; ai < 2; ++ai)
#pragma unroll
                for (int m = 0; m < 4; ++m) { bf16* rowp = C + (size_t)(row0 + ai * 128 + m * 16) * ldc + col0;
#pragma unroll
                    for (int bj = 0; bj < 2; ++bj) { const pg8::f32x4 v0 = acc[ai][bj][m][0], v1 = acc[ai][bj][m][1];
                        v4u w; w.x = pk2(v0[0], v0[1]); w.y = pk2(v0[2], v0[3]); w.z = pk2(v1[0], v1[1]); w.w = pk2(v1[2], v1[3]);
                        *(v4u*)(rowp + bj * 128) = w; } }
        }
    }
};
struct EpiS {
    static constexpr bool PERM = true, AFTER_DRAIN = false;
    bf16* S; int ldc; float* GT; int gt_pn;
    __device__ __forceinline__ void operator()(const pg8::f32x4 (&acc)[2][2][4][2], const pg8::Unit& u, int wr, int wc, int fr, int fq) const {
        const int row0 = u.pm * 256 + wr * 64 + fr;
        if (u.pn == gt_pn) {
            if (wc < 2) {
#pragma unroll
                for (int ai = 0; ai < 2; ++ai)
#pragma unroll
                    for (int m = 0; m < 4; ++m) { float* rowp = GT + (size_t)(row0 + ai * 128 + m * 16) * 256 + wc * 32 + 8 * fq;
                        *(pg8::f32x4*)rowp = acc[ai][0][m][0]; *(pg8::f32x4*)(rowp + 4) = acc[ai][0][m][1]; }
            }
        } else {
            const int col0 = u.pn * 256 + wc * 32 + 8 * fq;
#pragma unroll
            for (int ai = 0; ai < 2; ++ai)
#pragma unroll
                for (int m = 0; m < 4; ++m) { bf16* rowp = S + (size_t)(row0 + ai * 128 + m * 16) * ldc + col0;
#pragma unroll
                    for (int bj = 0; bj < 2; ++bj) { const pg8::f32x4 v0 = acc[ai][bj][m][0], v1 = acc[ai][bj][m][1];
                        v4u w; w.x = pk2(v0[0], v0[1]); w.y = pk2(v0[2], v0[3]); w.z = pk2(v1[0], v1[1]); w.w = pk2(v1[2], v1[3]);
                        *(v4u*)(rowp + bj * 128) = w; } }
        }
    }
};

#define DEV __device__ __forceinline__
#define LP(T) LAS T*
#define SYNC() do { asm volatile("s_waitcnt lgkmcnt(0)" ::: "memory"); __builtin_amdgcn_s_barrier(); asm volatile("" ::: "memory"); } while (0)
typedef short v8s __attribute__((ext_vector_type(8)));
typedef float v4f __attribute__((ext_vector_type(4)));
#define MFMA16(x, y, c) __builtin_amdgcn_mfma_f32_16x16x32_bf16((x), (y), (c), 0, 0, 0)
#define SHX(v, m) __shfl_xor((v), (m))
#define SHUP(v, d) __shfl_up((v), (d))
#define SHIDX(v, l) __shfl((v), (l))
#define EXPF(x) __expf(x)
#define LOGF(x) __logf(x)
#define RCPF(x) __builtin_amdgcn_rcpf(x)
#define RSQRTF(x) (1.0f / sqrtf(x))
#define PK2(lo, hi) pk2((lo), (hi))
#define F2BF(x) ((unsigned short)f2bf(x))
#define WAVE_SYNC() asm volatile("s_waitcnt lgkmcnt(0)" ::: "memory")
typedef short v4s __attribute__((ext_vector_type(4)));
#define LDS_TR16(p) __builtin_amdgcn_ds_read_tr16_b64_v4i16((LAS v4s*)(p))
#define RDLANE(v, l) __int_as_float(__builtin_amdgcn_readlane(__float_as_int(v), (l)))
#define RDLANE16(v, l) __shfl((v), (l))

DEV int seq_row(int b, int seg, int np, int cm) {
    if (!seg) return TL + b * CTXL + np;
    const int n = cm ? ((np & 63) * 64 + (np >> 6)) : np;
    return b * SEQ + n;
}
DEV int tok_row(int b, int seg, int pos, int dir, int cm) {
    const int len = seg ? SEQ : CTXL;
    return seq_row(b, seg, dir ? len - 1 - pos : pos, cm);
}
DEV float bflo(unsigned u) { return __uint_as_float(u << 16); }
DEV float bfhi(unsigned u) { return __uint_as_float(u & 0xffff0000u); }
DEV float logsigmoidf(float z) { return fminf(z, 0.f) - LOGF(1.0f + EXPF(-fabsf(z))); }
DEV v4f tile_mma(v4f acc, LP(const unsigned char) A, int sa, int m0, LP(const unsigned char) B, int sb, int n0, int ksteps, int fr, int fq) {
    LP(const unsigned char) ap = A + (m0 + fr) * sa + fq * 16;
    LP(const unsigned char) bp = B + (n0 + fr) * sb + fq * 16;
    for (int k = 0; k < ksteps; ++k) {
        const v8s af = *(LP(const v8s))(ap + k * 64);
        const v8s bf = *(LP(const v8s))(bp + k * 64);
        acc = MFMA16(bf, af, acc);
    }
    return acc;
}
DEV v8s tr_frag(LP(const unsigned char) T, int st, int k0, int n0, int lane) {
    const int l16 = lane & 15, fq = lane >> 4;
    LP(const unsigned char) p = T + (k0 + 8 * fq + (l16 >> 2)) * st + (n0 + 4 * (l16 & 3)) * 2;
    const v4s a = LDS_TR16(p), b = LDS_TR16(p + 4 * st);
    return (v8s){a.x, a.y, a.z, a.w, b.x, b.y, b.z, b.w};
}
DEV v4f tile_mma_nt(v4f acc, LP(const unsigned char) A, int sa, int m0, LP(const unsigned char) Bt, int sb, int n0, int ksteps, int lane) {
    const int fr = lane & 15, fq = lane >> 4;
    for (int k = 0; k < ksteps; ++k) { const v8s af = *(LP(const v8s))(A + (m0 + fr) * sa + fq * 16 + k * 64); const v8s bf = tr_frag(Bt, sb, 32 * k, n0, lane); acc = MFMA16(bf, af, acc); }
    return acc;
}
DEV v4f tile_mma_tt(v4f acc, LP(const unsigned char) At, int sa, int m0, LP(const unsigned char) Bt, int sb, int n0, int ksteps, int lane) {
    for (int k = 0; k < ksteps; ++k) { const v8s af = tr_frag(At, sa, 32 * k, m0, lane); const v8s bf = tr_frag(Bt, sb, 32 * k, n0, lane); acc = MFMA16(bf, af, acc); }
    return acc;
}
constexpr int ST128 = 272, ST64 = 144, ST256 = 528, STV = 80;

constexpr int MIX_UNITS = NB * 32;
constexpr int GLA_TASKS = NB * 4 * 2 * (CTXL / 64 + SEQ / 64);
DEV void gla_prep_task(int task, const bf16* S, const float* GT, const float* wg_all, const float* bg_all, bf16* QKS, float* VEC, LP(unsigned char) lds, int tid) {
    constexpr int NCHUNK = CTXL / 64 + SEQ / 64;
    const int cidx = task % NCHUNK, r1 = task / NCHUNK, dir = r1 & 1, h = (r1 >> 1) & 3, b = r1 >> 3;
    const int seg = cidx >= CTXL / 64, ci = seg ? cidx - CTXL / 64 : cidx;
    LP(float) LA = (LP(float))lds; LP(float) SEG = (LP(float))(lds + 32768); LP(float) LR = (LP(float))(lds + 34816); LP(float) WG = (LP(float))(lds + 38912); LP(float) BG = (LP(float))(lds + 47104);
    const int j = tid >> 3, c8 = tid & 7, dc = c8 * 16;
    const float qscale = 0.08838834764831845f;
    const int row = tok_row(b, seg, ci * 64 + j, dir, 0);
    const bf16* sr = S + (size_t)row * EV_PAD;
    const v4u q0 = *(const v4u*)(sr + h * 128 + dc), q1 = *(const v4u*)(sr + h * 128 + dc + 8);
    const v4u k0 = *(const v4u*)(sr + 512 + h * 128 + dc), k1 = *(const v4u*)(sr + 512 + h * 128 + dc + 8);
    for (int i = tid; i < 16 * 128; i += NTHR) { const int m = i >> 7, d = i & 127; WG[i] = wg_all[(dir * 16 + m) * 512 + h * 128 + d]; }
    if (tid < 128) BG[tid] = bg_all[dir * 512 + h * 128 + tid];
    if (tid < 256) { const int rr = tok_row(b, seg, ci * 64 + (tid >> 2), dir, 0); *(LP(v4f))(LR + (tid >> 2) * 16 + (tid & 3) * 4) = *(const v4f*)(GT + (size_t)rr * 256 + dir * 16 + (tid & 3) * 4); }
    SYNC();
    {
        float z[16];
#pragma unroll
        for (int i = 0; i < 16; ++i) z[i] = BG[dc + i];
        for (int m = 0; m < 16; ++m) { const float lrm = LR[j * 16 + m];
#pragma unroll
            for (int i4 = 0; i4 < 4; ++i4) { const v4f w = *(LP(const v4f))(WG + m * 128 + dc + 4 * i4);
                z[4 * i4 + 0] += lrm * w.x; z[4 * i4 + 1] += lrm * w.y; z[4 * i4 + 2] += lrm * w.z; z[4 * i4 + 3] += lrm * w.w; } }
#pragma unroll
        for (int i4 = 0; i4 < 4; ++i4) { v4f o; o.x = logsigmoidf(z[4 * i4]) * 0.0625f; o.y = logsigmoidf(z[4 * i4 + 1]) * 0.0625f; o.z = logsigmoidf(z[4 * i4 + 2]) * 0.0625f; o.w = logsigmoidf(z[4 * i4 + 3]) * 0.0625f;
            *(LP(v4f))(LA + j * 128 + dc + 4 * i4) = o; }
    }
    SYNC();
    {
        const int d = tid & 127, sg = tid >> 7; float acc = 0.f;
        for (int jj = 0; jj < 16; ++jj) { acc += LA[(sg * 16 + jj) * 128 + d]; LA[(sg * 16 + jj) * 128 + d] = acc; }
        SEG[sg * 128 + d] = acc;
    }
    SYNC();
    {
        const int sgj = j >> 4;
        bf16* orow = QKS + ((size_t)dir * TT + row) * 1024 + h * 128 + dc;
#pragma unroll 1
        for (int g = 0; g < 2; ++g) {
            const v4u qv = g ? q1 : q0, kv = g ? k1 : k0;
            const unsigned qw[4] = {qv.x, qv.y, qv.z, qv.w}, kw[4] = {kv.x, kv.y, kv.z, kv.w};
            unsigned oqs[4], oks[4];
#pragma unroll
            for (int i2 = 0; i2 < 4; ++i2) {
                float vqs[2], vks[2];
#pragma unroll
                for (int e = 0; e < 2; ++e) {
                    const int d = dc + 8 * g + 2 * i2 + e;
                    const float s0 = SEG[d], s1 = SEG[128 + d], s2 = SEG[256 + d];
                    const float pre = (sgj > 0 ? s0 : 0.f) + (sgj > 1 ? s1 : 0.f) + (sgj > 2 ? s2 : 0.f);
                    const float bv = LA[j * 128 + d] + pre;
                    const float bmid = LA[32 * 128 + d] + s0 + s1;
                    const float q = (e ? bfhi(qw[i2]) : bflo(qw[i2])) * qscale, k = e ? bfhi(kw[i2]) : bflo(kw[i2]);
                    const float e1 = EXPF(bv - bmid);
                    vqs[e] = q * e1; vks[e] = k * RCPF(e1);
                    if (j == 63) { const float bend = bv; float* vp = VEC + (size_t)task * 384 + d; vp[0] = EXPF(bmid); vp[128] = EXPF(bend - bmid); vp[256] = EXPF(bend); }
                }
                oqs[i2] = PK2(vqs[0], vqs[1]); oks[i2] = PK2(vks[0], vks[1]);
            }
            *(v4u*)(orow + 8 * g) = (v4u){oqs[0], oqs[1], oqs[2], oqs[3]};
            *(v4u*)(orow + 512 + 8 * g) = (v4u){oks[0], oks[1], oks[2], oks[3]};
        }
    }
    SYNC();
}

DEV void gla_unit(const bf16* S, const bf16* QKS, const float* VEC, bf16* O, int unit, LP(unsigned char) lds, int tid) {
    const int lane = tid & 63, wave = tid >> 6, fr = lane & 15, fq = lane >> 4;
    const int vs = unit & 3, dir = (unit >> 2) & 1, h = (unit >> 3) & 3, b = unit >> 5;
    LP(unsigned char) QS = lds; LP(unsigned char) KS = lds + 17408; LP(unsigned char) QB = lds + 34816;
    LP(unsigned char) VV = lds + 52224; LP(unsigned char) PM = lds + 61440; LP(unsigned char) STT = lds + 70656;
    LP(float) DV = (LP(float))(lds + 88064);
    for (int i = tid; i < 64 * ST128 / 4; i += NTHR) ((LP(unsigned))STT)[i] = 0u;
    v4f sacc[4];
#pragma unroll
    for (int i = 0; i < 4; ++i) sacc[i] = (v4f){0.f, 0.f, 0.f, 0.f};
    const int j = tid >> 3, c8 = tid & 7, dc = c8 * 16;
    const int tt = wave >> 1, vt0 = (wave & 1) * 2;
    const int svt = wave & 3, sdt0 = (wave >> 2) * 4;
    bf16* Od = O + (size_t)dir * TT * 1024;
    constexpr int NCHUNK = CTXL / 64 + SEQ / 64;
    const int task0 = ((b * 4 + h) * 2 + dir) * NCHUNK;
    v4u q0, q1, k0, k1, vv; v4f em[4]; v4f dvv = (v4f){0.f, 0.f, 0.f, 0.f};
#define GLA_ISSUE(cx) do { const int seg_ = (cx) >= CTXL / 64, ci_ = seg_ ? (cx) - CTXL / 64 : (cx); \
        const int row_ = tok_row(b, seg_, ci_ * 64 + j, dir, 0); \
        const bf16* qr_ = QKS + ((size_t)dir * TT + row_) * 1024 + h * 128 + dc; \
        q0 = *(const v4u*)(qr_); q1 = *(const v4u*)(qr_ + 8); k0 = *(const v4u*)(qr_ + 512); k1 = *(const v4u*)(qr_ + 520); \
        vv = *(const v4u*)(S + (size_t)row_ * EV_PAD + 1024 + h * 256 + vs * 64 + c8 * 8); \
        const float* vp_ = VEC + (size_t)(task0 + (cx)) * 384; \
        _Pragma("unroll") for (int i_ = 0; i_ < 4; ++i_) em[i_] = *(const v4f*)(vp_ + dc + 4 * i_); \
        if (tid < 64) dvv = *(const v4f*)(vp_ + 128 + tid * 4); } while (0)
    GLA_ISSUE(0);
    SYNC();
    for (int cidx = 0; cidx < NCHUNK; ++cidx) {
        const int seg = cidx >= CTXL / 64, ci = seg ? cidx - CTXL / 64 : cidx;
        {
            *(LP(v4u))(QS + j * ST128 + dc * 2) = q0; *(LP(v4u))(QS + j * ST128 + dc * 2 + 16) = q1;
            *(LP(v4u))(KS + j * ST128 + dc * 2) = k0; *(LP(v4u))(KS + j * ST128 + dc * 2 + 16) = k1;
            const unsigned qw[8] = {q0.x, q0.y, q0.z, q0.w, q1.x, q1.y, q1.z, q1.w}; unsigned ob[8];
#pragma unroll
            for (int i2 = 0; i2 < 8; ++i2) { const v4f e4 = em[i2 >> 1]; const float ea = (i2 & 1) ? e4.z : e4.x, eb = (i2 & 1) ? e4.w : e4.y; ob[i2] = PK2(bflo(qw[i2]) * ea, bfhi(qw[i2]) * eb); }
            *(LP(v4u))(QB + j * ST128 + dc * 2) = (v4u){ob[0], ob[1], ob[2], ob[3]}; *(LP(v4u))(QB + j * ST128 + dc * 2 + 16) = (v4u){ob[4], ob[5], ob[6], ob[7]};
            *(LP(v4u))(VV + j * ST64 + c8 * 16) = vv;
            if (tid < 64) *(LP(v4f))(DV + tid * 4) = dvv;
        }
        if (cidx + 1 < NCHUNK) GLA_ISSUE(cidx + 1);
        SYNC();
        v4f oacc[2]; oacc[0] = (v4f){0.f, 0.f, 0.f, 0.f}; oacc[1] = oacc[0];
        {
#pragma unroll
            for (int i = 0; i < 2; ++i) { const int st = vt0 + i; v4f p = (v4f){0.f, 0.f, 0.f, 0.f};
                if (st <= tt) { p = tile_mma(p, QS, ST128, 16 * tt, KS, ST128, 16 * st, 4, fr, fq);
                    if (st == tt) { if (4 * fq + 0 > fr) p.x = 0.f; if (4 * fq + 1 > fr) p.y = 0.f; if (4 * fq + 2 > fr) p.z = 0.f; if (4 * fq + 3 > fr) p.w = 0.f; } }
                *(LP(v2u))(PM + (16 * tt + fr) * ST64 + (16 * st + 4 * fq) * 2) = (v2u){PK2(p.x, p.y), PK2(p.z, p.w)}; }
#pragma unroll
            for (int k = 0; k < 4; ++k) { const v8s af = *(LP(const v8s))(QB + (16 * tt + fr) * ST128 + fq * 16 + k * 64);
#pragma unroll
                for (int i = 0; i < 2; ++i) { const v8s bf = *(LP(const v8s))(STT + (16 * (vt0 + i) + fr) * ST128 + fq * 16 + k * 64); oacc[i] = MFMA16(bf, af, oacc[i]); } }
        }
        SYNC();
#pragma unroll
        for (int k = 0; k < 2; ++k) { const v8s af = *(LP(const v8s))(PM + (16 * tt + fr) * ST64 + fq * 16 + k * 64);
#pragma unroll
            for (int i = 0; i < 2; ++i) { const v8s bf = tr_frag(VV, ST64, 32 * k, 16 * (vt0 + i), lane); oacc[i] = MFMA16(bf, af, oacc[i]); } }
        { const int orow = tok_row(b, seg, ci * 64 + 16 * tt + fr, dir, 0);
#pragma unroll
          for (int i = 0; i < 2; ++i) *(v2u*)(Od + (size_t)orow * 1024 + h * 256 + vs * 64 + 16 * (vt0 + i) + 4 * fq) = (v2u){PK2(oacc[i].x, oacc[i].y), PK2(oacc[i].z, oacc[i].w)}; }
        {
            v4f tmp[4];
#pragma unroll
            for (int i = 0; i < 4; ++i) tmp[i] = (v4f){0.f, 0.f, 0.f, 0.f};
#pragma unroll
            for (int k = 0; k < 2; ++k) { const v8s af = tr_frag(VV, ST64, 32 * k, 16 * svt, lane);
#pragma unroll
                for (int i = 0; i < 4; ++i) { const v8s bf = tr_frag(KS, ST128, 32 * k, 16 * (sdt0 + i), lane); tmp[i] = MFMA16(bf, af, tmp[i]); } }
#pragma unroll
            for (int i = 0; i < 4; ++i) { const v4f ee = *(LP(const v4f))(DV + 16 * (sdt0 + i) + 4 * fq), de = *(LP(const v4f))(DV + 128 + 16 * (sdt0 + i) + 4 * fq);
                sacc[i] = sacc[i] * de + tmp[i] * ee;
                *(LP(v2u))(STT + (16 * svt + fr) * ST128 + (16 * (sdt0 + i) + 4 * fq) * 2) = (v2u){PK2(sacc[i].x, sacc[i].y), PK2(sacc[i].z, sacc[i].w)}; }
        }
        SYNC();
    }
#undef GLA_ISSUE
}

constexpr int GATE_TASKS = NB * 4 * 2 * (CTXL / 64 + SEQ / 64);
DEV void gate_prep_task(int task, const float* GT, const bf16* QK2, float* GP, float* GPK, const float* gate_b, int lane) {
    constexpr int NCHUNK = CTXL / 64 + SEQ / 64;
    const int cidx = task % NCHUNK, r1 = task / NCHUNK, dir = r1 & 1, h = (r1 >> 1) & 3, b = r1 >> 3;
    const int seg = cidx >= CTXL / 64, ci = seg ? cidx - CTXL / 64 : cidx;
    const int prow = tok_row(b, seg, ci * 64 + lane, dir, 1);
    const float ig = GT[(size_t)prow * 256 + 32 + (dir * 2 + 0) * 4 + h] + gate_b[(dir * 2 + 0) * 4 + h];
    const float lf = logsigmoidf(GT[(size_t)prow * 256 + 32 + (dir * 2 + 1) * 4 + h] + gate_b[(dir * 2 + 1) * 4 + h]);
    float bcum = lf;
#pragma unroll
    for (int o = 1; o < 64; o <<= 1) { const float t = SHUP(bcum, o); if (lane >= o) bcum += t; }
    const float a_s = ig - bcum;
    float cm = a_s;
#pragma unroll
    for (int o = 1; o < 64; o <<= 1) { const float t = SHUP(cm, o); if (lane >= o) cm = fmaxf(cm, t); }
    *(v4f*)(GP + ((size_t)prow * 8 + dir * 4 + h) * 4) = (v4f){bcum, a_s, cm, 0.f};
    const float w0 = EXPF(a_s - RDLANE(cm, 63));
    v4f kw = (v4f){0.f, 0.f, 0.f, 0.f};
    for (int jj = 0; jj < 64; ++jj) { const int rj = tok_row(b, seg, ci * 64 + jj, dir, 1); const float wj = RDLANE(w0, jj);
        const v2u kk = *(const v2u*)(QK2 + (size_t)rj * 2048 + 1024 + h * 256 + 4 * lane);
        kw.x += bflo(kk.x) * wj; kw.y += bfhi(kk.x) * wj; kw.z += bflo(kk.y) * wj; kw.w += bfhi(kk.y) * wj; }
    *(v4f*)(GPK + (size_t)task * 256 + 4 * lane) = kw;
}

constexpr int MAT_TASKS = NB * 4 * 2 * (CTXL / 64 + SEQ / 64);
template <int MODE>
DEV void mat_prep_task(int task, const bf16* Sqk, int ldqk, int qoff, int koff, float kscale, const float* GP, const float* ret_log_decay, bf16* PP, float* RS, LP(unsigned char) lds, int tid) {
    constexpr int NCHUNK = CTXL / 64 + SEQ / 64;
    const int lane = tid & 63, wave = tid >> 6, fr = lane & 15, fq = lane >> 4;
    const int cidx = task % NCHUNK, r1 = task / NCHUNK, dir = r1 & 1, h = (r1 >> 1) & 3, b = r1 >> 3;
    const int seg = cidx >= CTXL / 64, ci = seg ? cidx - CTXL / 64 : cidx;
    LP(unsigned char) Q = lds; LP(unsigned char) K = lds + 33792; LP(float) AS = (LP(float))(lds + 67584); LP(float) R0 = AS + 64; LP(float) DENP = AS + 128;
    const int j = tid >> 3, c8 = tid & 7, dc = c8 * 32;
    { const bf16* s1 = Sqk + (size_t)tok_row(b, seg, ci * 64 + j, dir, 1) * ldqk;
#pragma unroll
      for (int g8 = 0; g8 < 4; ++g8) { *(LP(v4u))(Q + j * ST256 + (dc + 8 * g8) * 2) = *(const v4u*)(s1 + qoff + h * 256 + dc + 8 * g8); *(LP(v4u))(K + j * ST256 + (dc + 8 * g8) * 2) = *(const v4u*)(s1 + koff + h * 256 + dc + 8 * g8); } }
    if (wave == 0) {
        if (MODE == 0) { const int prow = tok_row(b, seg, ci * 64 + lane, dir, 1); const v4f gpv = *(const v4f*)(GP + ((size_t)prow * 8 + dir * 4 + h) * 4); AS[lane] = gpv.y; R0[lane] = -gpv.z; }
        else { const float lg = -expf(ret_log_decay[dir * 4 + h]); AS[lane] = -(float)(lane + 1) * lg; R0[lane] = (float)(lane + 1) * lg; }
    }
    SYNC();
    const int tt = wave >> 1;
    bf16* pp = PP + (size_t)task * 4096;
    const float rt = R0[16 * tt + fr];
#pragma unroll
    for (int i = 0; i < 2; ++i) { const int st = (wave & 1) * 2 + i; v4f p = (v4f){0.f, 0.f, 0.f, 0.f};
        if (st <= tt) { p = tile_mma(p, Q, ST256, 16 * tt, K, ST256, 16 * st, 8, fr, fq);
            const v4f as4 = *(LP(const v4f))(AS + 16 * st + 4 * fq);
            p.x *= kscale * EXPF(as4.x + rt); p.y *= kscale * EXPF(as4.y + rt); p.z *= kscale * EXPF(as4.z + rt); p.w *= kscale * EXPF(as4.w + rt);
            if (st == tt) { if (4 * fq + 0 > fr) p.x = 0.f; if (4 * fq + 1 > fr) p.y = 0.f; if (4 * fq + 2 > fr) p.z = 0.f; if (4 * fq + 3 > fr) p.w = 0.f; } }
        *(v2u*)(pp + (16 * tt + fr) * 64 + 16 * st + 4 * fq) = (v2u){PK2(p.x, p.y), PK2(p.z, p.w)};
        if (MODE == 0) { float rs = (p.x + p.y) + (p.z + p.w); rs += SHX(rs, 16); rs += SHX(rs, 32); if (fq == 0) DENP[st * 64 + 16 * tt + fr] = rs; } }
    SYNC();
    if (MODE == 0 && tid < 64) RS[(size_t)task * 64 + tid] = (DENP[tid] + DENP[64 + tid]) + (DENP[128 + tid] + DENP[192 + tid]);
    SYNC();
}

template <int MODE>
DEV void mat_unit(const bf16* Sqk, int ldqk, int qoff, int koff, const bf16* Sv, int ldv, int voff, float kscale, const float* GP, const float* GPK, const bf16* PP, const float* RS, bf16* O, int store_ctx,
                  const float* ret_log_decay, int unit, LP(unsigned char) lds, int tid) {
    const int lane = tid & 63, wave = tid >> 6, fr = lane & 15, fq = lane >> 4;
    const int vs = unit & 3, dir = (unit >> 2) & 1, h = (unit >> 3) & 3, b = unit >> 5;
    LP(unsigned char) Q = lds; LP(unsigned char) K = lds + 33792;
    LP(unsigned char) VV = lds + 67584; LP(unsigned char) VW = lds + 76800;
    LP(unsigned char) PM = lds + 86016; LP(unsigned char) STT = lds + 95232;
    LP(float) SCAL = (LP(float))(lds + 137472);
    LP(float) NV = SCAL + 768;
    for (int i = tid; i < 80 * ST256 / 4; i += NTHR) ((LP(unsigned))STT)[i] = 0u;
    if (tid < 256) NV[tid] = 0.f;
    v4f sacc[8];
#pragma unroll
    for (int i = 0; i < 8; ++i) sacc[i] = (v4f){0.f, 0.f, 0.f, 0.f};
    const int j = tid >> 3, c8 = tid & 7, dc = c8 * 32;
    const int tt = wave >> 1, vt0 = (wave & 1) * 2;
    const int svt = wave & 3, sdt0 = (wave >> 2) * 8;
    float m_st = 0.f;
    float lg = 0.f;
    if (MODE == 1) lg = -expf(ret_log_decay[dir * 4 + h]);
    bf16* Od = O + (size_t)(2 + dir) * TT * 1024;
    constexpr int NCHUNK = CTXL / 64 + SEQ / 64;
    v4u rq[4], rk[4], rv, rp; v4f gpv = (v4f){0.f, 0.f, 0.f, 0.f}; float kwv = 0.f, rsv = 0.f;
    const int task0 = ((b * 4 + h) * 2 + dir) * NCHUNK;
#define MAT_ISSUE(cx) do { const int seg_ = (cx) >= CTXL / 64, ci_ = seg_ ? (cx) - CTXL / 64 : (cx); \
        const int row_ = tok_row(b, seg_, ci_ * 64 + j, dir, 1); \
        const bf16* s1_ = Sqk + (size_t)row_ * ldqk; \
        _Pragma("unroll") for (int g_ = 0; g_ < 4; ++g_) { rq[g_] = *(const v4u*)(s1_ + qoff + h * 256 + dc + 8 * g_); rk[g_] = *(const v4u*)(s1_ + koff + h * 256 + dc + 8 * g_); } \
        rv = *(const v4u*)(Sv + (size_t)row_ * ldv + voff + h * 256 + vs * 64 + c8 * 8); \
        rp = *(const v4u*)(PP + (size_t)(task0 + (cx)) * 4096 + j * 64 + c8 * 8); \
        if (MODE == 0 && tid < 256) kwv = GPK[(size_t)(task0 + (cx)) * 256 + tid]; } while (0)
#define MAT_GATE_LOAD(cx) do { if (MODE == 0 && wave == 0) { const int seg_ = (cx) >= CTXL / 64, ci_ = seg_ ? (cx) - CTXL / 64 : (cx); \
        const int prow_ = tok_row(b, seg_, ci_ * 64 + lane, dir, 1); gpv = *(const v4f*)(GP + ((size_t)prow_ * 8 + dir * 4 + h) * 4); rsv = RS[(size_t)(task0 + (cx)) * 64 + lane]; } } while (0)
#define MAT_GATES(cx) do { if (wave == 0) { LP(float) sc_ = SCAL + ((cx) & 1) * 384; \
        if (MODE == 0) { const float bcum_ = gpv.x, a_s_ = gpv.y, Mt_ = fmaxf(m_st, gpv.z); \
            const float M63_ = RDLANE(Mt_, 63), bend_ = RDLANE(bcum_, 63), cm63_ = RDLANE(gpv.z, 63); const float wp_ = EXPF(gpv.z - Mt_); \
            sc_[lane] = wp_; sc_[64 + lane] = EXPF(m_st - Mt_); sc_[128 + lane] = EXPF(a_s_ - M63_); sc_[192 + lane] = EXPF(-(bcum_ + Mt_)); sc_[256 + lane] = rsv * wp_; \
            if (lane == 0) { sc_[320] = EXPF(m_st - M63_); sc_[321] = EXPF(cm63_ - M63_); } \
            m_st = bend_ + M63_; \
        } else { sc_[lane] = 1.0f; sc_[64 + lane] = EXPF((float)(lane + 1) * lg); sc_[128 + lane] = EXPF((float)(63 - lane) * lg); sc_[192 + lane] = 0.f; sc_[256 + lane] = 0.f; \
            if (lane == 0) { sc_[320] = EXPF(64.f * lg); sc_[321] = 0.f; } } } } while (0)
    MAT_ISSUE(0); MAT_GATE_LOAD(0);
    MAT_GATES(0);
    if (NCHUNK > 1) MAT_GATE_LOAD(1);
    SYNC();
    for (int cidx = 0; cidx < NCHUNK; ++cidx) {
        const int seg = cidx >= CTXL / 64, ci = seg ? cidx - CTXL / 64 : cidx;
        LP(const float) sc = SCAL + (cidx & 1) * 384;
        const float kw_cur = kwv;
        {
            const float wk = sc[128 + j] * kscale;
#pragma unroll
            for (int g8 = 0; g8 < 4; ++g8) { const int d0 = dc + 8 * g8; *(LP(v4u))(Q + j * ST256 + d0 * 2) = rq[g8]; *(LP(v4u))(K + j * ST256 + d0 * 2) = rk[g8]; }
            *(LP(v4u))(VV + j * ST64 + c8 * 16) = rv;
            *(LP(v4u))(VW + j * ST64 + c8 * 16) = (v4u){PK2(bflo(rv.x) * wk, bfhi(rv.x) * wk), PK2(bflo(rv.y) * wk, bfhi(rv.y) * wk), PK2(bflo(rv.z) * wk, bfhi(rv.z) * wk), PK2(bflo(rv.w) * wk, bfhi(rv.w) * wk)};
            *(LP(v4u))(PM + j * ST64 + c8 * 16) = rp;
#pragma unroll
            for (int i = 0; i < 8; ++i) *(LP(v2u))(STT + (16 * svt + fr) * ST256 + (16 * (sdt0 + i) + 4 * fq) * 2) = (v2u){PK2(sacc[i].x, sacc[i].y), PK2(sacc[i].z, sacc[i].w)};
        }
        if (cidx + 1 < NCHUNK) MAT_ISSUE(cidx + 1);
        SYNC();
        if (cidx + 1 < NCHUNK) { MAT_GATES(cidx + 1); if (cidx + 2 < NCHUNK) MAT_GATE_LOAD(cidx + 2); }
        v4f oP[2], oI[2]; oP[0] = (v4f){0.f, 0.f, 0.f, 0.f}; oP[1] = oP[0]; oI[0] = oP[0]; oI[1] = oP[0];
        v4f qa = (v4f){0.f, 0.f, 0.f, 0.f};
#pragma unroll 2
        for (int k = 0; k < 8; ++k) { const v8s af = *(LP(const v8s))(Q + (16 * tt + fr) * ST256 + fq * 16 + k * 64);
#pragma unroll
            for (int i = 0; i < 2; ++i) { const v8s bf = *(LP(const v8s))(STT + (16 * (vt0 + i) + fr) * ST256 + fq * 16 + k * 64); oI[i] = MFMA16(bf, af, oI[i]); }
            if (MODE == 0) { const v8s bn = *(LP(const v8s))(STT + (64 + fr) * ST256 + fq * 16 + k * 64); qa = MFMA16(bn, af, qa); } }
#pragma unroll
        for (int k = 0; k < 2; ++k) { const v8s af = *(LP(const v8s))(PM + (16 * tt + fr) * ST64 + fq * 16 + k * 64);
#pragma unroll
            for (int i = 0; i < 2; ++i) { const v8s bf = tr_frag(VV, ST64, 32 * k, 16 * (vt0 + i), lane); oP[i] = MFMA16(bf, af, oP[i]); } }
        { const int t = 16 * tt + fr; const float wp = sc[t], wi = sc[64 + t];
          v4f o0 = oP[0] * wp + oI[0] * wi, o1 = oP[1] * wp + oI[1] * wi;
          if (MODE == 0) { const float qn = RDLANE16(qa.x, fr); const float den = sc[256 + t] + wi * qn; const float dv = 1.0f / fmaxf(fabsf(den), sc[192 + t]); o0 = o0 * dv; o1 = o1 * dv; }
          if (seg || store_ctx) { const int orow = tok_row(b, seg, ci * 64 + t, dir, 1);
              *(v2u*)(Od + (size_t)orow * 1024 + h * 256 + vs * 64 + 16 * vt0 + 4 * fq) = (v2u){PK2(o0.x, o0.y), PK2(o0.z, o0.w)};
              *(v2u*)(Od + (size_t)orow * 1024 + h * 256 + vs * 64 + 16 * (vt0 + 1) + 4 * fq) = (v2u){PK2(o1.x, o1.y), PK2(o1.z, o1.w)}; } }
        const float dcy = sc[320];
        {
#pragma unroll
            for (int i = 0; i < 8; ++i) sacc[i] = sacc[i] * dcy;
#pragma unroll 1
            for (int k = 0; k < 2; ++k) { const v8s af = tr_frag(VW, ST64, 32 * k, 16 * svt, lane);
#pragma unroll
                for (int i = 0; i < 8; ++i) { const v8s bf = tr_frag(K, ST256, 32 * k, 16 * (sdt0 + i), lane); sacc[i] = MFMA16(bf, af, sacc[i]); } }
        }
        SYNC();
        if (MODE == 0 && tid < 256) {
            const float nn = dcy * NV[tid] + sc[321] * kw_cur * kscale; NV[tid] = nn;
            *(LP(unsigned short))(STT + 64 * ST256 + tid * 2) = F2BF(nn); }
    }
#undef MAT_ISSUE
#undef MAT_GATE_LOAD
#undef MAT_GATES
    SYNC();
}

constexpr int S5_LDS_PER_WAVE = 1280 + 2 * 10240 + 2 * 6144;
DEV void s5_unit(const bf16* S, int ldS, bf16* O, const float* lam_re, const float* lam_im, const float* log_step, const float* b_re, const float* b_im,
                 const float* c_re, const float* c_im, int unit, LP(unsigned char) wl, int lane) {
    const int fr = lane & 15, fq = lane >> 4;
    const int dir = unit & 1, g = (unit >> 1) & 63, b = unit >> 7;
    LP(unsigned char) UB = wl; LP(unsigned char) XB = wl + 1280; LP(unsigned char) HB = wl + 1280 + 2 * 10240;
    const int pg = (dir * 64 + g);
    const float lr = lam_re[pg * 64 + lane], li = lam_im[pg * 64 + lane], step = expf(log_step[pg]);
    const float mag = expf(lr * step); float sn, cs; sincosf(li * step, &sn, &cs);
    const float ar = mag * cs, ai = mag * sn, den = lr * lr + li * li;
    const float cre = ((ar - 1.0f) * lr + ai * li) / den, cim = (ai * lr - (ar - 1.0f) * li) / den;
    for (int p = 0; p < 16; ++p) { const float br = b_re[(pg * 64 + lane) * 16 + p], bi = b_im[(pg * 64 + lane) * 16 + p];
        *(LP(unsigned short))(XB + lane * 32 + p * 2) = F2BF(cre * br - cim * bi);
        *(LP(unsigned short))(XB + (64 + lane) * 32 + p * 2) = F2BF(cre * bi + cim * br); }
    WAVE_SYNC();
    v8s bfrag[8];
#pragma unroll
    for (int nt = 0; nt < 8; ++nt) { if (fq < 2) bfrag[nt] = *(LP(const v8s))(XB + (16 * nt + fr) * 32 + fq * 16); else bfrag[nt] = (v8s){0, 0, 0, 0, 0, 0, 0, 0}; }
    v8s cfrag[4];
#pragma unroll
    for (int ks = 0; ks < 4; ++ks) { const int n0 = 32 * ks + 8 * fq; const float* src = (n0 < 64 ? c_re : c_im) + ((size_t)pg * 16 + fr) * 64 + (n0 & 63); const float sgn = n0 < 64 ? 1.f : -1.f;
        v8s f;
#pragma unroll
        for (int i = 0; i < 8; ++i) f[i] = (short)F2BF(sgn * src[i]);
        cfrag[ks] = f; }
    WAVE_SYNC();
    for (int i = lane; i < 1280 / 4; i += 64) ((LP(unsigned))UB)[i] = 0u;
    WAVE_SYNC();
    float hr = 0.f, hi = 0.f;
    bf16* Od = O + (size_t)dir * TT * 1024;
    constexpr int NBLK = CTXL / 16 + SEQ / 16;
    v4u un = (v4u){0u, 0u, 0u, 0u};
#define S5_ISSUE(bx) do { if (lane < 32) { const int seg_ = (bx) >= CTXL / 16, bi_ = seg_ ? (bx) - CTXL / 16 : (bx); \
        un = *(const v4u*)(S + (size_t)tok_row(b, seg_, bi_ * 16 + (lane >> 1), dir, 0) * ldS + g * 16 + (lane & 1) * 8); } } while (0)
#define S5_STAGE_A(bx) do { const v8s uf_ = *(LP(const v8s))(UB + fr * 80 + fq * 16); LP(unsigned char) xb_ = XB + ((bx) & 1) * 10240; \
        _Pragma("unroll") for (int nt = 0; nt < 8; ++nt) { v4f x = (v4f){0.f, 0.f, 0.f, 0.f}; x = MFMA16(uf_, bfrag[nt], x); *(LP(v4f))(xb_ + (16 * nt + fr) * 80 + fq * 16) = x; } } while (0)
    S5_ISSUE(0);
    if (lane < 32) *(LP(v4u))(UB + (lane >> 1) * 80 + (lane & 1) * 16) = un;
    S5_ISSUE(1);
    WAVE_SYNC();
    S5_STAGE_A(0);
    for (int bx = 0; bx <= NBLK; ++bx) {
        WAVE_SYNC();
        v8s hf[4]; float xr[16], xi[16];
        if (bx >= 1) { LP(unsigned char) hb = HB + ((bx - 1) & 1) * 6144;
#pragma unroll
            for (int ks = 0; ks < 4; ++ks) hf[ks] = tr_frag(hb, 48, 32 * ks, 0, lane); }
        if (bx < NBLK) { LP(unsigned char) xb = XB + (bx & 1) * 10240;
#pragma unroll
            for (int q4 = 0; q4 < 4; ++q4) { const v4f a4 = *(LP(const v4f))(xb + lane * 80 + q4 * 16), b4 = *(LP(const v4f))(xb + (64 + lane) * 80 + q4 * 16);
                xr[4 * q4] = a4.x; xr[4 * q4 + 1] = a4.y; xr[4 * q4 + 2] = a4.z; xr[4 * q4 + 3] = a4.w; xi[4 * q4] = b4.x; xi[4 * q4 + 1] = b4.y; xi[4 * q4 + 2] = b4.z; xi[4 * q4 + 3] = b4.w; } }
        if (bx + 1 < NBLK) { if (lane < 32) *(LP(v4u))(UB + (lane >> 1) * 80 + (lane & 1) * 16) = un; if (bx + 2 < NBLK) S5_ISSUE(bx + 2); }
        WAVE_SYNC();
        if (bx + 1 < NBLK) S5_STAGE_A(bx + 1);
        if (bx >= 1) { const int pb = bx - 1, seg = pb >= CTXL / 16, bi = seg ? pb - CTXL / 16 : pb;
            if (seg) { v4f y = (v4f){0.f, 0.f, 0.f, 0.f};
#pragma unroll
                for (int ks = 0; ks < 4; ++ks) y = MFMA16(cfrag[ks], hf[ks], y);
                const int orow = tok_row(b, seg, bi * 16 + fr, dir, 0);
                *(v2u*)(Od + (size_t)orow * 1024 + g * 16 + 4 * fq) = (v2u){PK2(y.x, y.y), PK2(y.z, y.w)}; } }
        if (bx < NBLK) { LP(unsigned char) hb = HB + (bx & 1) * 6144;
            unsigned pr[8], pi[8];
#pragma unroll
            for (int t2 = 0; t2 < 8; ++t2) {
                const float r0 = ar * hr - ai * hi + xr[2 * t2], i0 = ar * hi + ai * hr + xi[2 * t2];
                hr = ar * r0 - ai * i0 + xr[2 * t2 + 1]; hi = ar * i0 + ai * r0 + xi[2 * t2 + 1];
                pr[t2] = PK2(r0, hr); pi[t2] = PK2(i0, hi); }
            *(LP(v4u))(hb + lane * 48) = (v4u){pr[0], pr[1], pr[2], pr[3]}; *(LP(v4u))(hb + lane * 48 + 16) = (v4u){pr[4], pr[5], pr[6], pr[7]};
            *(LP(v4u))(hb + (64 + lane) * 48) = (v4u){pi[0], pi[1], pi[2], pi[3]}; *(LP(v4u))(hb + (64 + lane) * 48 + 16) = (v4u){pi[4], pi[5], pi[6], pi[7]}; }
    }
#undef S5_STAGE_A
#undef S5_ISSUE
}

DEV void conv_prep_row(int r, const bf16* S, bf16* QK2, const float* conv_w, const float* conv_b, int lane) {
    int rm, rp; bool hasm, hasp;
    if (r < TL) { const int b = r >> 12, n = r & (SEQ - 1), gr = n >> 6, col = n & 63, np = col * 64 + gr;
        hasm = np > 0; hasp = np < SEQ - 1; rm = seq_row(b, 1, hasm ? np - 1 : np, 1); rp = seq_row(b, 1, hasp ? np + 1 : np, 1); }
    else { const int n = (r - TL) & (CTXL - 1); hasm = n > 0; hasp = n < CTXL - 1; rm = hasm ? r - 1 : r; rp = hasp ? r + 1 : r; }
    const bf16* s0 = S + (size_t)rm * EV_PAD + 3072; const bf16* s1 = S + (size_t)r * EV_PAD + 3072; const bf16* s2 = S + (size_t)rp * EV_PAD + 3072;
#pragma unroll
    for (int i = 0; i < 4; ++i) { const int c = 8 * lane + 512 * i;
        const v4u a0 = *(const v4u*)(s0 + c), a1 = *(const v4u*)(s1 + c), a2 = *(const v4u*)(s2 + c);
        const unsigned w0[4] = {a0.x, a0.y, a0.z, a0.w}, w1[4] = {a1.x, a1.y, a1.z, a1.w}, w2[4] = {a2.x, a2.y, a2.z, a2.w};
        const float sc = c >= 1024 ? 0.0625f : 1.0f;
        float val[8];
#pragma unroll
        for (int i2 = 0; i2 < 4; ++i2)
#pragma unroll
            for (int e = 0; e < 2; ++e) { const int di = 2 * i2 + e;
                const float um = hasm ? (e ? bfhi(w0[i2]) : bflo(w0[i2])) : 0.f, u0 = e ? bfhi(w1[i2]) : bflo(w1[i2]), up = hasp ? (e ? bfhi(w2[i2]) : bflo(w2[i2])) : 0.f;
                const float pre = conv_b[c + di] + conv_w[c + di] * um + conv_w[2048 + c + di] * u0 + conv_w[4096 + c + di] * up;
                val[di] = pre * RCPF(1.0f + EXPF(-pre)) * sc; }
        *(v4u*)(QK2 + (size_t)r * 2048 + c) = (v4u){PK2(val[0], val[1]), PK2(val[2], val[3]), PK2(val[4], val[5]), PK2(val[6], val[7])}; }
}

DEV v4f ld4bf(const bf16* p) { const v2u w = *(const v2u*)p; return (v4f){bflo(w.x), bfhi(w.x), bflo(w.y), bfhi(w.y)}; }
DEV float wsum(float v) {
#pragma unroll
    for (int o = 1; o < 64; o <<= 1) v += SHX(v, o);
    return v;
}
DEV void merge_even_row(int r, const bf16* S, const bf16* O, const float* gla_norm, const float* ml_norm, bf16* HBo, int lane) {
    const bf16* sr = S + (size_t)r * EV_PAD;
#pragma unroll
    for (int hh = 0; hh < 8; ++hh) { const int mix = hh >> 2, c = (hh & 3) * 256 + 4 * lane;
        const bf16* o0 = O + (size_t)(2 * mix) * TT * 1024 + (size_t)r * 1024 + c; const bf16* o1 = o0 + (size_t)TT * 1024;
        v4f o = ld4bf(o0) + ld4bf(o1);
#ifdef NO_GLA
        if (!mix) o = (v4f){0.f, 0.f, 0.f, 0.f};
#endif
#ifdef NO_ML
        if (mix) o = (v4f){0.f, 0.f, 0.f, 0.f};
#endif
        if (mix) { const float mean = wsum((o.x + o.y) + (o.z + o.w)) * (1.0f / 256.0f); o = o - mean; }
        const float ms = wsum((o.x * o.x + o.y * o.y) + (o.z * o.z + o.w * o.w)) * (1.0f / 256.0f);
        const float rstd = RSQRTF(ms + EPS);
        const v4f gn = *(const v4f*)((mix ? ml_norm : gla_norm) + c);
        const v2u gw = *(const v2u*)(sr + (mix ? 6144 : 2048) + c);
        const float g0 = bflo(gw.x), g1 = bfhi(gw.x), g2 = bflo(gw.y), g3 = bfhi(gw.y);
        v4f gate;
        if (mix) { gate.x = RCPF(1.0f + EXPF(-g0)); gate.y = RCPF(1.0f + EXPF(-g1)); gate.z = RCPF(1.0f + EXPF(-g2)); gate.w = RCPF(1.0f + EXPF(-g3)); }
        else { gate.x = g0 * RCPF(1.0f + EXPF(-g0)); gate.y = g1 * RCPF(1.0f + EXPF(-g1)); gate.z = g2 * RCPF(1.0f + EXPF(-g2)); gate.w = g3 * RCPF(1.0f + EXPF(-g3)); }
        const v4f res = gate * (o * rstd * gn);
        *(v2u*)(HBo + (size_t)r * D + mix * 1024 + c) = (v2u){PK2(res.x, res.y), PK2(res.z, res.w)}; }
}
DEV float gelu_tanh(float y) { const float z = 0.7978845608028654f * (y + 0.044715f * y * y * y); const float t = 1.0f - 2.0f * RCPF(1.0f + EXPF(2.0f * z)); return 0.5f * y * (1.0f + t); }
DEV void merge_odd_row(int r, const bf16* S, const bf16* O, const float* s5_d, const float* ret_norm, bf16* GBo, bf16* HBo, int lane) {
    const bf16* sr = S + (size_t)r * OD_COLS;
#pragma unroll
    for (int hh = 0; hh < 4; ++hh) { const int c = hh * 256 + 4 * lane;
        { const bf16* o0 = O + (size_t)r * 1024 + c; const bf16* o1 = o0 + (size_t)TT * 1024;
          v4f y0 = ld4bf(o0) + ld4bf(o1);
#ifdef NO_S5
          y0 = (v4f){0.f, 0.f, 0.f, 0.f};
#endif
          const v4f dd = *(const v4f*)(s5_d + c); const v2u uw = *(const v2u*)(sr + c);
          const float y[4] = {y0.x + dd.x * bflo(uw.x), y0.y + dd.y * bfhi(uw.x), y0.z + dd.z * bflo(uw.y), y0.w + dd.w * bfhi(uw.y)};
          *(v2u*)(GBo + (size_t)r * 1024 + c) = (v2u){PK2(gelu_tanh(y[0]), gelu_tanh(y[1])), PK2(gelu_tanh(y[2]), gelu_tanh(y[3]))}; }
        { const bf16* o0 = O + (size_t)2 * TT * 1024 + (size_t)r * 1024 + c; const bf16* o1 = o0 + (size_t)TT * 1024;
          v4f o = ld4bf(o0) + ld4bf(o1);
#ifdef NO_RET
          o = (v4f){0.f, 0.f, 0.f, 0.f};
#endif
          const float mean = wsum((o.x + o.y) + (o.z + o.w)) * (1.0f / 256.0f); o = o - mean;
          const float ms = wsum((o.x * o.x + o.y * o.y) + (o.z * o.z + o.w * o.w)) * (1.0f / 256.0f);
          const float rstd = RSQRTF(ms + EPS);
          const v4f gn = *(const v4f*)(ret_norm + c);
          const v2u gw = *(const v2u*)(sr + 4096 + c);
          const float g0 = bflo(gw.x), g1 = bfhi(gw.x), g2 = bflo(gw.y), g3 = bfhi(gw.y);
          v4f gate; gate.x = g0 * RCPF(1.0f + EXPF(-g0)); gate.y = g1 * RCPF(1.0f + EXPF(-g1)); gate.z = g2 * RCPF(1.0f + EXPF(-g2)); gate.w = g3 * RCPF(1.0f + EXPF(-g3));
          const v4f res = gate * (o * rstd * gn);
          *(v2u*)(HBo + (size_t)r * D + 1024 + c) = (v2u){PK2(res.x, res.y), PK2(res.z, res.w)}; }
    }
}

struct EpiGLU {
    static constexpr bool PERM = true, AFTER_DRAIN = false;
    const bf16* G; const float* bias; bf16* O;
    __device__ __forceinline__ void operator()(const pg8::f32x4 (&acc)[2][2][4][2], const pg8::Unit& u, int wr, int wc, int fr, int fq) const {
        const int row0 = u.pm * 256 + wr * 64 + fr, col0 = u.pn * 256 + wc * 32 + 8 * fq;
#pragma unroll
        for (int ai = 0; ai < 2; ++ai)
#pragma unroll
            for (int m = 0; m < 4; ++m) { const size_t row = (size_t)(row0 + ai * 128 + m * 16);
#pragma unroll
                for (int bj = 0; bj < 2; ++bj) { const int col = col0 + bj * 128;
                    const v4u gw = *(const v4u*)(G + row * 1024 + col); const pg8::f32x4 b0 = *(const pg8::f32x4*)(bias + col), b1 = *(const pg8::f32x4*)(bias + col + 4);
                    const pg8::f32x4 v0 = acc[ai][bj][m][0] + b0, v1 = acc[ai][bj][m][1] + b1;
                    v4u w; w.x = pk2(bflo(gw.x) * fast_sigmoid(v0[0]), bfhi(gw.x) * fast_sigmoid(v0[1])); w.y = pk2(bflo(gw.y) * fast_sigmoid(v0[2]), bfhi(gw.y) * fast_sigmoid(v0[3]));
                    w.z = pk2(bflo(gw.z) * fast_sigmoid(v1[0]), bfhi(gw.z) * fast_sigmoid(v1[1])); w.w = pk2(bflo(gw.w) * fast_sigmoid(v1[2]), bfhi(gw.w) * fast_sigmoid(v1[3]));
                    *(v4u*)(O + row * D + col) = w; } }
    }
};

__device__ __forceinline__ void mixer_phases(const Args& a, unsigned char* ws, LAS unsigned char* lds, const XcdBarrier& bar, int layer, int G, int gw, int ngw, int tid, int lane, int wave) {
#define HB ((bf16*)wsp(ws, WS_HB))
#define S ((bf16*)wsp(ws, WS_S))
#define GT ((float*)wsp(ws, WS_GT))
#define O ((bf16*)wsp(ws, WS_O))
#define GB ((bf16*)wsp(ws, WS_GB))
#define Y ((bf16*)wsp(ws, WS_Y))
    const int ldS = layer == 0 ? EV_PAD : OD_COLS;
    { pg8::Gemm g{HB, (const bf16*)(wsp(ws, (layer == 0 ? WS_WIN_EV : WS_WIN_OD))), TT, ldS, D}; pg8::StaticOrder So; So.init(TT, ldS, G, (int)blockIdx.x);
      EpiS E{S, ldS, GT, layer == 0 ? 28 : -1};
      pg8::gemm_phase<EpiS, pg8::StaticOrder, true, true>(lds, g, So, E); }
    xcd_barrier(bar);
#define QK2 ((bf16*)wsp(ws, WS_QK2))
#define GP ((float*)wsp(ws, WS_GP))
#define QKS ((bf16*)wsp(ws, WS_QKS))
#define GPK ((float*)wsp(ws, WS_GPK))
#define PP ((bf16*)wsp(ws, WS_PP))
#define RS ((float*)wsp(ws, WS_RS))
#define VEC ((float*)wsp(ws, WS_VEC))
    { int t2 = threadIdx.x; asm volatile("" : "+v"(t2)); tid = t2; lane = t2 & 63; wave = __builtin_amdgcn_readfirstlane(t2 >> 6); gw = blockIdx.x * NWAVES + wave; }
    if (layer == 0) {
        { const bf16* s_ = S; bf16* qk_ = QK2; const float* cw_ = ARG(16); const float* cb_ = ARG(17); for (int r = gw; r < TT; r += ngw) conv_prep_row(r, s_, qk_, cw_, cb_, lane); }
        xcd_barrier(bar);
        { const float* gt_ = GT; const bf16* qk_ = QK2; float* gp_ = GP; float* gk_ = GPK; const float* gb_ = ARG(18); for (int t = gw; t < GATE_TASKS; t += ngw) gate_prep_task(t, gt_, qk_, gp_, gk_, gb_, lane); }
        { int t2 = threadIdx.x; asm volatile("" : "+v"(t2)); for (int t = blockIdx.x; t < GLA_TASKS; t += G) gla_prep_task(t, S, GT, ARG(13), ARG(14), QKS, VEC, lds, t2); }
        xcd_barrier(bar);
        { int t2 = threadIdx.x; asm volatile("" : "+v"(t2)); for (int t = blockIdx.x; t < MAT_TASKS; t += G) mat_prep_task<0>(t, QK2, 2048, 0, 1024, 1.0f, GP, nullptr, PP, RS, lds, t2); }
        xcd_barrier(bar);
    } else {
        { int t2 = threadIdx.x; asm volatile("" : "+v"(t2)); for (int t = blockIdx.x; t < MAT_TASKS; t += G) mat_prep_task<1>(t, S, OD_COLS, 1024, 2048, 0.0625f, nullptr, ARG(32), PP, RS, lds, t2); }
        xcd_barrier(bar);
    }
    { int t2 = threadIdx.x; asm volatile("" : "+v"(t2)); tid = t2; lane = t2 & 63; wave = __builtin_amdgcn_readfirstlane(t2 >> 6); }
#ifndef SCAN_REPS
#define SCAN_REPS 1
#endif
#pragma unroll 1
    for (int rep = 0; rep < SCAN_REPS; ++rep) {
    if (layer == 0) {
        for (int it = blockIdx.x; it < 2 * MIX_UNITS; it += G) {
            if (it < MIX_UNITS) {
#ifndef REP_GLA
#define REP_GLA 1
#endif
#pragma unroll 1
                for (int r_ = 0; r_ < REP_GLA; ++r_) gla_unit(S, QKS, VEC, O, it, lds, tid);
                if (DEFER && G >= 2 * MIX_UNITS) convert_tiles(a, ws, 1, (int)blockIdx.x * NWAVES + wave, MIX_UNITS * NWAVES, lane);
            } else {
#ifndef REP_ML
#define REP_ML 1
#endif
#pragma unroll 1
                for (int r_ = 0; r_ < REP_ML; ++r_) mat_unit<0>(QK2, 2048, 0, 1024, S, EV_PAD, 5120, 1.0f, GP, GPK, PP, RS, O, 1, nullptr, it - MIX_UNITS, lds, tid);
            }
        }
        if (DEFER && G < 2 * MIX_UNITS) convert_tiles(a, ws, 1, (int)blockIdx.x * NWAVES + wave, G * NWAVES, lane);
    } else {
        const int s5_first = G >= 2 * MIX_UNITS ? MIX_UNITS : 0, s5_wgs = G - s5_first;
#ifndef REP_RET
#define REP_RET 1
#endif
#ifndef REP_S5
#define REP_S5 1
#endif
#pragma unroll 1
        for (int r_ = 0; r_ < REP_RET; ++r_)
        for (int u = blockIdx.x; u < MIX_UNITS; u += G)
            mat_unit<1>(S, OD_COLS, 1024, 2048, S, OD_COLS, 3072, 0.0625f, nullptr, nullptr, PP, RS, O, 0, ARG(32), u, lds, tid);
        if (DEFER && rep == 0 && (int)blockIdx.x >= s5_first && wave >= 4) convert_tiles(a, ws, 2, ((int)blockIdx.x - s5_first) * 4 + (wave - 4), 4 * s5_wgs, lane);
#pragma unroll 1
        for (int r_ = 0; r_ < REP_S5; ++r_)
        if ((int)blockIdx.x >= s5_first && wave < 4) { for (int su = ((int)blockIdx.x - s5_first) * 4 + wave; su < NB * 128; su += 4 * s5_wgs)
            s5_unit(S, OD_COLS, O, ARG(22), ARG(23), ARG(24), ARG(25), ARG(26), ARG(27), ARG(28), su, lds + wave * S5_LDS_PER_WAVE, lane); }
    }
    }
    xcd_barrier(bar);
    { int t2 = threadIdx.x; asm volatile("" : "+v"(t2)); tid = t2; lane = t2 & 63; wave = __builtin_amdgcn_readfirstlane(t2 >> 6); gw = blockIdx.x * NWAVES + wave; }
#ifndef NO_MERGE
    if (layer == 0) { const bf16* s_ = S; const bf16* o_ = O; const float* n0 = ARG(15); const float* n1 = ARG(19); bf16* hb_ = HB; for (int r = gw; r < TT; r += ngw) merge_even_row(r, s_, o_, n0, n1, hb_, lane); }
    else { const bf16* s_ = S; const bf16* o_ = O; const float* n0 = ARG(29); const float* n1 = ARG(33); bf16* gb_ = GB; bf16* hb_ = HB; for (int r = gw; r < TL; r += ngw) merge_odd_row(r, s_, o_, n0, n1, gb_, hb_, lane); }
#endif
    xcd_barrier(bar);
    const int Mo = layer == 0 ? TT : TL;
    if (layer == 1) {
        pg8::Gemm g{GB, (const bf16*)(wsp(ws, WS_WGLU)), TL, 1024, 1024}; pg8::StaticOrder So; So.init(TL, 1024, G, (int)blockIdx.x);
        EpiGLU E{GB, ARG(31), HB};
        pg8::gemm_phase<EpiGLU, pg8::StaticOrder, true, true>(lds, g, So, E);
        xcd_barrier(bar);
    }
    { pg8::Gemm g{HB, (const bf16*)(wsp(ws, (layer == 0 ? WS_WOUT_EV : WS_WOUT_OD))), Mo, D, D}; pg8::SplitOrder So; So.init(Mo - TL, D, G, (int)blockIdx.x);
      EpiF32 E{Y, (float*)(wsp(ws, WS_YCP))};
      pg8::gemm_phase<EpiF32, pg8::SplitOrder, true, true>(lds, g, So, E); }
    xcd_barrier(bar);
}
#undef HB
#undef S
#undef GT
#undef O
#undef GB
#undef Y
#undef QK2
#undef GP
#undef QKS
#undef GPK
#undef PP
#undef RS
#undef VEC

#ifndef MIXER_ON
#define MIXER_ON 1
#endif
__global__ void __launch_bounds__(NTHR, 2) fwd(Args a) {
    extern __shared__ __attribute__((aligned(16))) unsigned char lds_raw[];
    LAS unsigned char* lds = (LAS unsigned char*)lds_raw;
    const int tid = threadIdx.x, lane = tid & 63, wave = __builtin_amdgcn_readfirstlane(tid >> 6);
    const int G = gridDim.x, gw = blockIdx.x * NWAVES + wave, ngw = G * NWAVES;
    unsigned char* ws = a.ws;
    if (tid < 16) ((LAS unsigned*)(lds + MISC_OFF))[tid] = 0u;
    __syncthreads();
    XcdBarrier bar = xcd_barrier_post((unsigned*)(wsp(ws, WS_CTL)), (volatile LAS unsigned*)(lds + MISC_OFF));

#ifdef NAN_POISON
    {
        v4u q = (v4u){0xffffffffu, 0xffffffffu, 0xffffffffu, 0xffffffffu};
        for (int i = tid; i < (MISC_OFF) / 16; i += NTHR) ((LAS v4u*)lds)[i] = q;
        { v4u* p = (v4u*)(wsp(ws, WS_MOD)); const size_t n = (WS_WGU - WS_MOD) / 16; for (size_t i = (size_t)blockIdx.x * NTHR + tid; i < n; i += (size_t)G * NTHR) p[i] = q; }
        { v4u* p = (v4u*)(wsp(ws, WS_XC)); const size_t n = (WS_END - WS_XC) / 16; for (size_t i = (size_t)blockIdx.x * NTHR + tid; i < n; i += (size_t)G * NTHR) p[i] = q; }
        { v4u* p = (v4u*)a.out; const size_t n = (size_t)TL * D * 4 / 16; for (size_t i = (size_t)blockIdx.x * NTHR + tid; i < n; i += (size_t)G * NTHR) p[i] = q; }
        __syncthreads();
        xcd_barrier(bar);
    }
#endif
#define MOD ((float*)wsp(ws, WS_MOD))
#define MODP ((float*)wsp(ws, WS_MODP))
#define HB ((bf16*)wsp(ws, WS_HB))
#define HID ((bf16*)wsp(ws, WS_HID))
#define Y ((bf16*)wsp(ws, WS_Y))
#define XC ((float*)wsp(ws, WS_XC))

#ifndef REP_PRO
#define REP_PRO 1
#endif
#ifndef REP_GU
#define REP_GU 1
#endif
#ifndef REP_DN
#define REP_DN 1
#endif
#pragma unroll 1
    for (int rep_ = 0; rep_ < REP_PRO; ++rep_) {
        __syncthreads();
        LAS float* stab = (LAS float*)(lds + 1024);
        { const float* cin = ARG(1); const float* cctx = ARG(3);
        for (int i = tid; i < 5 * D; i += NTHR) { const int r = i >> 11, k = i & (D - 1); const float c = r < 4 ? cin[r * D + k] : cctx[k]; stab[i] = c / (1.0f + expf(-c)); } }
        __syncthreads();
        for (int it = gw; it < 2 * MOD_KC * 72; it += ngw) {
            const int l = it / (MOD_KC * 72), rem = it % (MOD_KC * 72), kc = rem / 72, jb = rem % 72; constexpr int KCH = D / MOD_KC;
            const float* W = ARG(4) + ((size_t)l * D + kc * KCH) * (NMOD * D) + jb * 256 + lane * 4;
            f32x4 acc[5];
#pragma unroll
            for (int r = 0; r < 5; ++r) acc[r] = (f32x4){0.f, 0.f, 0.f, 0.f};
            for (int k = 0; k < KCH; k += 8) { f32x4 w[8];
#pragma unroll
                for (int i = 0; i < 8; ++i) w[i] = *(const f32x4*)(W + (size_t)(k + i) * (NMOD * D));
#pragma unroll
                for (int i = 0; i < 8; ++i)
#pragma unroll
                    for (int r = 0; r < 5; ++r) acc[r] += stab[r * D + kc * KCH + k + i] * w[i]; }
            { float* modp = MODP;
#pragma unroll
            for (int r = 0; r < 5; ++r) *(f32x4*)(modp + (((size_t)l * MOD_KC + kc) * 5 + r) * (NMOD * D) + jb * 256 + lane * 4) = acc[r]; }
        }
        convert_tiles(a, ws, 0, gw, ngw, lane);
#ifndef DEFER
#define DEFER 1
#endif
        if (!DEFER) { convert_tiles(a, ws, 1, gw, ngw, lane); convert_tiles(a, ws, 2, gw, ngw, lane); }
        { v4u z = (v4u){0u, 0u, 0u, 0u}; v4u* p = (v4u*)(wsp(ws, WS_WIN_EV) + (size_t)EV_COLS * 2048 * 2); const int n16 = (EV_PAD - EV_COLS) * 2048 * 2 / 16;
          for (int i = blockIdx.x * NTHR + tid; i < n16; i += G * NTHR) p[i] = z; }
    }
    xcd_barrier(bar);
    { const float* bmod = ARG(5); const float* modp = MODP; float* modf = MOD;
    for (int i = blockIdx.x * NTHR + tid; i < 2 * 5 * NMOD * D; i += G * NTHR) {
        const int l = i / (5 * NMOD * D), rem = i % (5 * NMOD * D), r = rem / (NMOD * D), j = rem % (NMOD * D);
        float s = bmod[l * (NMOD * D) + j];
        for (int kc = 0; kc < MOD_KC; ++kc) s += modp[(((size_t)l * MOD_KC + kc) * 5 + r) * (NMOD * D) + j];
        modf[i] = s;
    } }
    xcd_barrier(bar);
#ifndef REP_N0
#define REP_N0 1
#endif
#pragma unroll 1
    for (int rep_ = 0; rep_ < REP_N0; ++rep_)
    { NormP p{}; p.xin_lat = ARG(0); p.xin_ctx = ARG(2); p.xout_lat = a.out; p.xout_ctx = XC; p.y = nullptr; p.h = HB; p.rows_end = TT; p.has_y = 0; p.has_h = 1; p.w = 0.f; p.lp = 0; p.sp = 0; p.ln = 0; p.sn = 0;
      norm_phase(p, MOD, ARG(6), ARG(7), lds, gw, ngw, tid, lane); }
    xcd_barrier(bar);

#pragma unroll 1
    for (int layer = 0; layer < 2; ++layer) {
#pragma unroll 1
        for (int half = 0; half < 2; ++half) {
            const int Mrows = (layer == 1 && half == 1) ? TL : TT;
#if MIXER_ON
            if (half == 1) {
                mixer_phases(a, ws, lds, bar, layer, G, gw, ngw, tid, lane, wave);
                NormP p{}; p.xin_lat = a.out; p.xin_ctx = XC; p.xout_lat = a.out; p.xout_ctx = XC; p.y = Y; p.y_ctx = (const float*)(wsp(ws, WS_YCP)); p.h = HB; p.rows_end = Mrows; p.has_y = 1; p.has_h = 1; p.w = 1.0f; p.lp = layer; p.sp = 1; p.ln = layer; p.sn = 2;
                norm_phase(p, MOD, ARG(6), ARG(7), lds, gw, ngw, tid, lane);
                xcd_barrier(bar);
            }
#endif
            const int sub = half * 2;
#pragma unroll 1
            for (int rep_ = 0; rep_ < REP_GU; ++rep_) { pg8::Gemm g{HB, (const bf16*)(wsp(ws, WS_WGU) + (size_t)(layer * 2 + half) * SZ_WGU), Mrows, 2 * DFF, D}; pg8::StaticOrder S; S.init(Mrows, 2 * DFF, G, (int)blockIdx.x);
              EpiSwiGLU E{HID, DFF};
              pg8::gemm_phase<EpiSwiGLU, pg8::StaticOrder, true, true>(lds, g, S, E);
              if (rep_ + 1 < REP_GU) xcd_barrier(bar); }
            xcd_barrier(bar);
#pragma unroll 1
            for (int rep_ = 0; rep_ < REP_DN; ++rep_) { pg8::Gemm g{HID, (const bf16*)(wsp(ws, WS_WD) + (size_t)(layer * 2 + half) * SZ_WD), Mrows, D, DFF}; pg8::SplitOrder S; S.init(Mrows - TL, DFF, G, (int)blockIdx.x);
              EpiF32 E{Y, (float*)(wsp(ws, WS_YCP))};
              pg8::gemm_phase<EpiF32, pg8::SplitOrder, true, true>(lds, g, S, E);
              if (rep_ + 1 < REP_DN) xcd_barrier(bar); }
            xcd_barrier(bar);
            { NormP p{}; const bool first = (layer == 0 && half == 0);
              p.xin_lat = first ? ARG(0) : a.out; p.xin_ctx = first ? ARG(2) : XC; p.xout_lat = a.out; p.xout_ctx = XC; p.y = Y; p.y_ctx = (const float*)(wsp(ws, WS_YCP)); p.h = HB; p.rows_end = Mrows; p.has_y = 1; p.w = 0.5f; p.lp = layer; p.sp = sub;
              if (half == 0) { p.has_h = 1; p.ln = layer; p.sn = MIXER_ON ? 1 : 2; }
              else if (layer == 0) { p.has_h = 1; p.ln = 1; p.sn = 0; }
              else { p.has_h = 0; p.ln = 0; p.sn = 0; }
              norm_phase(p, MOD, ARG(6), ARG(7), lds, gw, ngw, tid, lane); }
            if (!(layer == 1 && half == 1)) xcd_barrier(bar);
        }
    }
}

#undef MOD
#undef MODP
#undef HB
#undef HID
#undef Y
#undef XC
extern "C" void kernel_launch(void* const* d_in, const int* in_sizes, int n_in, void* d_out, int out_size, void* d_ws, size_t ws_size, hipStream_t stream) {
    static int grid = 0;
    if (grid == 0) {
        if (n_in != 34 || out_size != TL * D || ws_size < WS_END) { fprintf(stderr, "kernel_launch: unexpected shapes (n_in %d out %d ws %zu need %zu)\n", n_in, out_size, ws_size, (size_t)WS_END); grid = -1; return; }
        int dev = 0, cus = 0, per_cu = 0;
        if (hipGetDevice(&dev) != hipSuccess || hipDeviceGetAttribute(&cus, hipDeviceAttributeMultiprocessorCount, dev) != hipSuccess) { grid = -1; return; }
        if (hipFuncSetAttribute((const void*)fwd, hipFuncAttributeMaxDynamicSharedMemorySize, LDS_BYTES) != hipSuccess) { fprintf(stderr, "kernel_launch: hipFuncSetAttribute failed\n"); grid = -1; return; }
        if (hipOccupancyMaxActiveBlocksPerMultiprocessor(&per_cu, (const void*)fwd, NTHR, LDS_BYTES) != hipSuccess || per_cu < 1) { fprintf(stderr, "kernel_launch: occupancy query says %d\n", per_cu); }
        (void)hipGetLastError();
        grid = cus;
    }
    if (grid < 0) return;
    if (hipMemsetAsync((char*)d_ws + WS_CTL, 0, CTL_ZERO_BYTES, stream) != hipSuccess) return;
    Args a{};
    for (int i = 0; i < 34; ++i) a.in[i] = (const float*)d_in[i];
    a.out = (float*)d_out; a.ws = (unsigned char*)d_ws;
    hipLaunchKernelGGL(fwd, dim3(grid), dim3(NTHR), LDS_BYTES, stream, a);
}
```

```cpp
#include <hip/hip_runtime.h>
#include <cstdio>
#include <cstdint>
#define MIXER_ON 1

#define XB_TMO      128
#define XB_XCNT(j)  (256  + 64 * (j))
#define XB_XSUB(j)  (1280 + 64 * (j))
#define XB_XGEN(j)  (2304 + 64 * (j))
#define XB_TOP      3328
#define XB_TOPGEN   3392
#define XCD_BAR_WORDS 3456
#define XB_SPIN_CAP (1u << 18)
#define LAS __attribute__((address_space(3)))

__device__ __forceinline__ unsigned xb_ld(unsigned* p)              { return __hip_atomic_load(p, __ATOMIC_RELAXED, __HIP_MEMORY_SCOPE_AGENT); }
__device__ __forceinline__ unsigned xb_add(unsigned* p, unsigned v) { return __hip_atomic_fetch_add(p, v, __ATOMIC_RELAXED, __HIP_MEMORY_SCOPE_AGENT); }
__device__ __forceinline__ unsigned xb_xcc_id() { return (unsigned)__builtin_amdgcn_s_getreg((3 << 11) | 20) & 0xFu; }
#define XB_SPIN(cond, bar) do { unsigned _sp = 0; while (cond) { __builtin_amdgcn_s_sleep(1); \
    if ((++_sp & 255u) == 0u) { if (xb_ld(&(bar)[XB_TMO])) break; if (_sp > XB_SPIN_CAP) { atomicAdd(&(bar)[XB_TMO], 1u); break; } } } } while (0)

struct XcdBarrier {
    unsigned* bar; unsigned x;
    volatile LAS unsigned* st;
};

__device__ __forceinline__ XcdBarrier xcd_barrier_post(unsigned* bar, volatile LAS unsigned* st) {
    XcdBarrier b; b.bar = bar; b.x = xb_xcc_id(); b.st = st;
    if (threadIdx.x == 0) (void)xb_add(&bar[XB_XCNT(b.x)], 1u);
    return b;
}
__device__ __forceinline__ void xcd_barrier_complete(unsigned* bar, unsigned x, unsigned& nloc, unsigned& nx) {
    const unsigned G = gridDim.x * gridDim.y * gridDim.z;
    unsigned sum, cnt, mine, sp = 0u;
    for (;;) {
        sum = 0u; cnt = 0u; mine = 0u;
#pragma unroll
        for (unsigned j = 0; j < 16; ++j) { const unsigned c = xb_ld(&bar[XB_XCNT(j)]); sum += c; cnt += (c > 0u) ? 1u : 0u; mine = (j == x) ? c : mine; }
        if (sum == G) break;
        __builtin_amdgcn_s_sleep(1);
        if ((++sp & 255u) == 0u) { if (xb_ld(&bar[XB_TMO])) break; if (sp > XB_SPIN_CAP) { atomicAdd(&bar[XB_TMO], 1u); break; } }
    }
    nloc = mine > 0u ? mine : 1u; nx = cnt > 0u ? cnt : 1u;
}

__device__ __forceinline__ void xcd_barrier(const XcdBarrier& b) {
    asm volatile("s_waitcnt vmcnt(0)" ::: "memory");
    __syncthreads();
    if (threadIdx.x == 0) {
        unsigned* bar = b.bar;
        unsigned bx = __builtin_amdgcn_readfirstlane(b.x); asm volatile("" : "+s"(bx));
        __builtin_amdgcn_s_waitcnt(0);
        unsigned nloc = b.st[0], nx = b.st[1];
        if (nloc == 0u) { xcd_barrier_complete(bar, bx, nloc, nx); b.st[0] = nloc; b.st[1] = nx; }
        const unsigned old = xb_add(&bar[XB_XSUB(bx)], 1u);
        const unsigned gen = old / nloc;
        if (old + 1u == (gen + 1u) * nloc) {
            __builtin_amdgcn_fence(__ATOMIC_RELEASE, "agent");
            asm volatile("s_waitcnt vmcnt(0)" ::: "memory");
            const unsigned og = xb_add(&bar[XB_TOP], 1u);
            const unsigned tg = og / nx;
            if (og + 1u == (tg + 1u) * nx) xb_add(&bar[XB_TOPGEN], 1u);
            else XB_SPIN(xb_ld(&bar[XB_TOPGEN]) == tg, bar);
            __builtin_amdgcn_fence(__ATOMIC_ACQUIRE, "agent");
            xb_add(&bar[XB_XGEN(bx)], 1u);
            asm volatile("s_waitcnt vmcnt(0)" ::: "memory");
        } else {
            XB_SPIN(xb_ld(&bar[XB_XGEN(bx)]) == gen, bar);
            __builtin_amdgcn_fence(__ATOMIC_ACQUIRE, "agent");
            asm volatile("s_waitcnt vmcnt(0)" ::: "memory");
        }
    }
    __syncthreads();
}

namespace pg8 {
#define PG8_LAS __attribute__((address_space(3)))
typedef unsigned short bf16_t;
typedef short bf16x8 __attribute__((ext_vector_type(8)));
typedef float f32x4 __attribute__((ext_vector_type(4)));
typedef unsigned u32x4 __attribute__((ext_vector_type(4)));
constexpr int BM = 256, BK = 64, HALF = 128, HTB = HALF * BK * 2  , STAGE_BYTES = 8 * HTB, NXCD = 8, WGM = 8;

__host__ __device__ __forceinline__ int lds_byte(int r, int c) { const int st = (r >> 4) * 2 + (c >> 5), rr = r & 15, cc = c & 31, ob = rr * 64 + cc * 2; return st * 1024 + (ob ^ (((ob >> 9) & 1) << 5)); }
__host__ __device__ __forceinline__ void stage_rc(int b, int& R, int& C) { const int st = b / 1024, sb = b % 1024, swz = sb ^ (((sb >> 9) & 1) << 5); R = (st >> 1) * 16 + swz / 64; C = (st & 1) * 32 + (swz % 64) / 2; }
__host__ __device__ __forceinline__ int perm32(int rho) { const int n = rho >> 4, i = rho & 15; return 8 * (i >> 2) + 4 * n + (i & 3); }

struct Unit { int pm, pn, k0, nt, part; };
struct Gemm { const bf16_t* A; const bf16_t* Bt; int M, N, K; };

struct StaticOrder {
    int nM, nN, nwg, G, c;
    __host__ __device__ void init(int M, int N, int G_, int c_) { nM = M / BM; nN = N / BM; nwg = nM * nN; G = G_; c = c_; }
    __host__ __device__ bool next(int i, Unit& u) const {
        const long L = (long)i * G + c; if (L >= nwg) return false;
        int wgid = (int)L; { const int q = nwg / NXCD, r = nwg % NXCD, xcd = wgid % NXCD, off = wgid / NXCD; wgid = (xcd < r ? xcd * (q + 1) : r * (q + 1) + (xcd - r) * q) + off; }
        const int nig = WGM * nN, gid = wgid / nig, fm = gid * WGM, gsz = (nM - fm) < WGM ? (nM - fm) : WGM;
        u.pm = fm + ((wgid % nig) % gsz); u.pn = (wgid % nig) / gsz; u.k0 = 0; u.nt = 0; u.part = -1; return true;
    }
    __device__ __forceinline__ void a_ready(const Unit&) const {}
    __device__ __forceinline__ void done(const Unit&) const {}
};
struct SplitOrder {
    static constexpr int NMF = 64, NN = 8, PARTS = 8, NFULL = NMF * NN;
    int nsplit, ntK, G, c;
    __host__ __device__ void init(int Msplit, int K, int G_, int c_) { nsplit = (Msplit / BM) * NN * PARTS; ntK = K / BK; G = G_; c = c_; }
    __host__ __device__ bool next(int i, Unit& u) const {
        const int L = i * G + c, p = L - NFULL; const bool fullu = L < NFULL;
        const int wgid = (L % NXCD) * (NFULL / NXCD) + L / NXCD, nig = WGM * NN, fm = (wgid / nig) * WGM;
        const int q = p & 7, cu = p >> 3, h = ntK >> 1, ks = ((h * q) >> 3) << 1, ke = ((h * (q + 1)) >> 3) << 1;
        u.pm = fullu ? fm + ((wgid % nig) % WGM) : NMF + (cu >> 3);
        u.pn = fullu ? (wgid % nig) / WGM : (cu & 7);
        u.k0 = fullu ? 0 : ks; u.nt = fullu ? 0 : ke - ks; u.part = fullu ? -1 : q;
        return fullu || p < nsplit;
    }
    __device__ __forceinline__ void a_ready(const Unit&) const {}
    __device__ __forceinline__ void done(const Unit&) const {}
};
__device__ __forceinline__ unsigned cvt_pk_bf16(float lo, float hi) { unsigned r; asm volatile("v_cvt_pk_bf16_f32 %0, %1, %2" : "=v"(r) : "v"(lo), "v"(hi)); return r; }
template <class Epi, class Sched, bool ALIGN_EPI = false, bool SP2 = false>
__device__ __forceinline__ void gemm_phase(PG8_LAS unsigned char* lds, const Gemm g, const Sched& S, const Epi& E) {
    int tid_ = threadIdx.x; asm volatile("" : "+v"(tid_));
    const int tid = tid_, wid = __builtin_amdgcn_readfirstlane(tid >> 6), lane = tid & 63, wr = wid >> 2, wc = wid & 3, fr = lane & 15, fq = lane >> 4;
    const int K = g.K, nt = K / BK;
    unsigned voffA[2], voffB[2];
#pragma unroll
    for (int i = 0; i < 2; ++i) { int R, C; stage_rc(tid * 16 + i * 8192, R, C); const int Rb = Epi::PERM ? ((R & ~31) + perm32(R & 31)) : R;
        voffA[i] = (unsigned)(R * K + C) * 2u; voffB[i] = (unsigned)(Rb * K + C) * 2u; }
    const unsigned kstep = BK * 2;
    const unsigned hstep = (unsigned)HALF * K * 2;
    const unsigned tstep = 2 * hstep;
    const unsigned ldsw = (unsigned)wid * 1024u;
    const int aoff = lds_byte(wr * 64 + fr, fq * 8), boff = lds_byte(wc * 32 + fr, fq * 8);
#define PG8_SA(b, h) (((b) * 2 + (h)) * HTB)
#define PG8_SB(b, h) ((4 + (b) * 2 + (h)) * HTB)
#define PG8_STAGE(bufoff, gbase, voff) do { _Pragma("unroll") for (int _i = 0; _i < 2; ++_i) \
        __builtin_amdgcn_global_load_lds((const unsigned*)((const char*)(gbase) + (voff)[_i]), (PG8_LAS unsigned*)(lds + (bufoff) + ldsw + _i * 8192), 16, 0, 0); } while (0)
#define PG8_LDA(dst, b, h) do { _Pragma("unroll") for (int m = 0; m < 4; ++m) _Pragma("unroll") for (int k = 0; k < 2; ++k) dst[m][k] = *(const PG8_LAS bf16x8*)(lds + PG8_SA(b, h) + aoff + m * 2048 + k * 1024); } while (0)
#define PG8_LDB(dst, b, h) do { _Pragma("unroll") for (int n = 0; n < 2; ++n) _Pragma("unroll") for (int k = 0; k < 2; ++k) dst[n][k] = *(const PG8_LAS bf16x8*)(lds + PG8_SB(b, h) + boff + n * 2048 + k * 1024); } while (0)
#define PG8_MMA(ai, bj, At, Bt) do { __builtin_amdgcn_s_setprio(1); _Pragma("unroll") for (int m = 0; m < 4; ++m) _Pragma("unroll") for (int n = 0; n < 2; ++n) _Pragma("unroll") for (int k = 0; k < 2; ++k) \
        acc[ai][bj][m][n] = __builtin_amdgcn_mfma_f32_16x16x32_bf16(Bt[n][k], At[m][k], acc[ai][bj][m][n], 0, 0, 0); __builtin_amdgcn_s_setprio(0); } while (0)
#define PG8_WAIT_V(n) asm volatile("s_waitcnt vmcnt(" #n ")" ::: "memory")
#define PG8_WAIT_L(n) asm volatile("s_waitcnt lgkmcnt(" #n ")" ::: "memory")
#define PG8_BAR __builtin_amdgcn_s_barrier()
#define PG8_SCHED __builtin_amdgcn_sched_barrier(0)
    Unit cur, nxt; int ui = 0;
    if (!S.next(0, cur)) return;
    f32x4 acc[2][2][4][2];
#pragma unroll
    for (int a = 0; a < 2; ++a)
#pragma unroll
        for (int b = 0; b < 2; ++b)
#pragma unroll
            for (int m = 0; m < 4; ++m)
#pragma unroll
                for (int n = 0; n < 2; ++n) acc[a][b][m][n] = (f32x4){0.f, 0.f, 0.f, 0.f};
    bf16x8 At[4][2], B0[2][2], B1[2][2];
    unsigned cA = (unsigned)cur.pm * tstep + (unsigned)cur.k0 * kstep, cB = (unsigned)cur.pn * tstep + (unsigned)cur.k0 * kstep;
    S.a_ready(cur);
    if constexpr (SP2) {
        PG8_STAGE(PG8_SB(0, 0), (const char*)g.Bt + (size_t)(cB), voffB); PG8_STAGE(PG8_SB(0, 1), (const char*)g.Bt + (size_t)(cB + hstep), voffB); PG8_STAGE(PG8_SA(0, 0), (const char*)g.A + (size_t)(cA), voffA); PG8_STAGE(PG8_SA(0, 1), (const char*)g.A + (size_t)(cA + hstep), voffA);
        if (wr == 1) PG8_BAR;
        PG8_WAIT_V(2); PG8_BAR;
        PG8_STAGE(PG8_SB(1, 0), (const char*)g.Bt + (size_t)(cB + kstep), voffB); PG8_STAGE(PG8_SA(1, 0), (const char*)g.A + (size_t)(cA + kstep), voffA); PG8_STAGE(PG8_SB(1, 1), (const char*)g.Bt + (size_t)(cB + hstep + kstep), voffB);
        PG8_WAIT_V(6); PG8_BAR;
    } else {
        PG8_STAGE(PG8_SB(0, 0), (const char*)g.Bt + (size_t)(cB), voffB); PG8_STAGE(PG8_SA(0, 0), (const char*)g.A + (size_t)(cA), voffA); PG8_STAGE(PG8_SB(0, 1), (const char*)g.Bt + (size_t)(cB + hstep), voffB); PG8_STAGE(PG8_SA(0, 1), (const char*)g.A + (size_t)(cA + hstep), voffA);
        if (wr == 1) PG8_BAR;
        PG8_WAIT_V(4); PG8_BAR;
        PG8_STAGE(PG8_SB(1, 0), (const char*)g.Bt + (size_t)(cB + kstep), voffB); PG8_STAGE(PG8_SA(1, 0), (const char*)g.A + (size_t)(cA + kstep), voffA); PG8_STAGE(PG8_SB(1, 1), (const char*)g.Bt + (size_t)(cB + hstep + kstep), voffB);
        PG8_WAIT_V(6); PG8_BAR;
    }
    for (;;) {
        const bool has_next = S.next(ui + 1, nxt);
        const unsigned nA = has_next ? (unsigned)nxt.pm * tstep + (unsigned)nxt.k0 * kstep : cA, nB = has_next ? (unsigned)nxt.pn * tstep + (unsigned)nxt.k0 * kstep : cB;
        const int unt = cur.nt ? cur.nt : nt;
        for (int t = 0; t < unt; t += 2) {
            const bool last = (t == unt - 2);
            const unsigned a1 = cA + (unsigned)(t + 1) * kstep;
            const unsigned a2 = last ? nA : cA + (unsigned)(t + 2) * kstep, b2 = last ? nB : cB + (unsigned)(t + 2) * kstep;
            const unsigned a3 = a2 + kstep, b3 = b2 + kstep;
            if (last && has_next) S.a_ready(nxt);
            if constexpr (SP2) {
            PG8_LDB(B0, 0, 0); PG8_LDB(B1, 0, 1); PG8_SCHED; PG8_LDA(At, 0, 0); PG8_STAGE(PG8_SA(1, 1), (const char*)g.A + (size_t)(a1 + hstep), voffA);
            PG8_WAIT_V(8); PG8_WAIT_L(0); PG8_BAR; PG8_MMA(0, 0, At, B0); PG8_MMA(0, 1, At, B1); PG8_BAR; PG8_SCHED;
            PG8_LDA(At, 0, 1); PG8_STAGE(PG8_SB(0, 0), (const char*)g.Bt + (size_t)(b2), voffB); PG8_STAGE(PG8_SB(0, 1), (const char*)g.Bt + (size_t)(b2 + hstep), voffB); PG8_STAGE(PG8_SA(0, 0), (const char*)g.A + (size_t)(a2), voffA);
            PG8_WAIT_V(8); PG8_WAIT_L(0); PG8_BAR; PG8_MMA(1, 0, At, B0); PG8_MMA(1, 1, At, B1); PG8_BAR; PG8_SCHED;
            PG8_LDB(B0, 1, 0); PG8_LDB(B1, 1, 1); PG8_SCHED; PG8_LDA(At, 1, 0); PG8_STAGE(PG8_SA(0, 1), (const char*)g.A + (size_t)(a2 + hstep), voffA);
            PG8_WAIT_V(8); PG8_WAIT_L(0); PG8_BAR; PG8_MMA(0, 0, At, B0); PG8_MMA(0, 1, At, B1); PG8_BAR; PG8_SCHED;
            PG8_LDA(At, 1, 1); PG8_STAGE(PG8_SB(1, 0), (const char*)g.Bt + (size_t)(b3), voffB); PG8_STAGE(PG8_SB(1, 1), (const char*)g.Bt + (size_t)(b3 + hstep), voffB); PG8_STAGE(PG8_SA(1, 0), (const char*)g.A + (size_t)(a3), voffA);
            PG8_WAIT_V(8); PG8_WAIT_L(0); PG8_BAR; PG8_MMA(1, 0, At, B0); PG8_MMA(1, 1, At, B1); PG8_BAR; PG8_SCHED;
            } else {
            PG8_LDB(B0, 0, 0); PG8_SCHED; PG8_LDA(At, 0, 0); PG8_STAGE(PG8_SA(1, 1), (const char*)g.A + (size_t)(a1 + hstep), voffA);
            PG8_WAIT_L(8); PG8_BAR; PG8_WAIT_L(0); PG8_MMA(0, 0, At, B0); PG8_BAR; PG8_SCHED;
            PG8_LDB(B1, 0, 1); PG8_STAGE(PG8_SB(0, 0), (const char*)g.Bt + (size_t)(b2), voffB);
            PG8_BAR; PG8_WAIT_L(0); PG8_MMA(0, 1, At, B1); PG8_BAR;
            PG8_LDA(At, 0, 1); PG8_STAGE(PG8_SA(0, 0), (const char*)g.A + (size_t)(a2), voffA);
            PG8_BAR; PG8_WAIT_L(0); PG8_MMA(1, 0, At, B0); PG8_BAR; PG8_SCHED;
            PG8_STAGE(PG8_SB(0, 1), (const char*)g.Bt + (size_t)(b2 + hstep), voffB);
            PG8_WAIT_V(6); PG8_BAR; PG8_MMA(1, 1, At, B1); PG8_BAR;
            PG8_LDB(B0, 1, 0); PG8_SCHED; PG8_LDA(At, 1, 0); PG8_STAGE(PG8_SA(0, 1), (const char*)g.A + (size_t)(a2 + hstep), voffA);
            PG8_WAIT_L(8); PG8_BAR; PG8_WAIT_L(0); PG8_MMA(0, 0, At, B0); PG8_BAR; PG8_SCHED;
            PG8_LDB(B1, 1, 1); PG8_STAGE(PG8_SB(1, 0), (const char*)g.Bt + (size_t)(b3), voffB);
            PG8_BAR; PG8_WAIT_L(0); PG8_MMA(0, 1, At, B1); PG8_BAR;
            PG8_LDA(At, 1, 1); PG8_STAGE(PG8_SA(1, 0), (const char*)g.A + (size_t)(a3), voffA);
            PG8_BAR; PG8_WAIT_L(0); PG8_MMA(1, 0, At, B0); PG8_BAR; PG8_SCHED;
            PG8_STAGE(PG8_SB(1, 1), (const char*)g.Bt + (size_t)(b3 + hstep), voffB);
            PG8_WAIT_V(6); PG8_BAR; PG8_MMA(1, 1, At, B1); PG8_BAR;
            }
        }
        if constexpr (ALIGN_EPI) { if (wr == 0) PG8_BAR; }
        if constexpr (!Epi::AFTER_DRAIN) { int t_ = threadIdx.x; asm volatile("" : "+v"(t_)); const int l_ = t_ & 63, w_ = __builtin_amdgcn_readfirstlane(t_ >> 6);
            E(acc, cur, w_ >> 2, w_ & 3, l_ & 15, l_ >> 4); S.done(cur); }
        if (!has_next) break;
#pragma unroll
        for (int a = 0; a < 2; ++a)
#pragma unroll
            for (int b = 0; b < 2; ++b)
#pragma unroll
                for (int m = 0; m < 4; ++m)
#pragma unroll
                    for (int n = 0; n < 2; ++n) acc[a][b][m][n] = (f32x4){0.f, 0.f, 0.f, 0.f};
        cur = nxt; cA = nA; cB = nB; ++ui;
        if constexpr (ALIGN_EPI) { if (wr == 1) PG8_BAR; }
    }
    PG8_WAIT_V(0);
    if constexpr (!ALIGN_EPI) { if (wr == 0) PG8_BAR; }
    PG8_BAR;
    if constexpr (Epi::AFTER_DRAIN) { E.fused(acc, cur, wr, wc, fr, fq, lds, wid, lane); S.done(cur); }
#undef PG8_SA
#undef PG8_SB
#undef PG8_STAGE
#undef PG8_LDA
#undef PG8_LDB
#undef PG8_MMA
#undef PG8_WAIT_V
#undef PG8_WAIT_L
#undef PG8_BAR
#undef PG8_SCHED
}
}

#define GAS __attribute__((address_space(1)))
typedef unsigned short bf16;
typedef float f32x4 __attribute__((ext_vector_type(4)));
typedef unsigned v4u __attribute__((ext_vector_type(4)));
typedef unsigned v2u __attribute__((ext_vector_type(2)));
constexpr int D = 2048, NB = 4, SEQ = 4096, CTXL = 256, DFF = 5504, NMOD = 9;
constexpr int TL = NB * SEQ, TC = NB * CTXL, TT = TL + TC;
constexpr int MIXH = 1024;
constexpr int EV_COLS = 7216, EV_PAD = 7424, OD_COLS = 5120;
constexpr int NWAVES = 8, NTHR = 512;
constexpr float EPS = 1e-6f;

constexpr size_t MiB = 1u << 20;
constexpr size_t WS_CTL = 0, CTL_ZERO_BYTES = 64 * 1024;
constexpr size_t WS_MOD = 1 * MiB;
constexpr size_t WS_MODP = 2 * MiB;
constexpr int MOD_KC = 16;
constexpr size_t WS_WGU = 16 * MiB;
constexpr size_t SZ_WGU = (size_t)11008 * 2048 * 2;
constexpr size_t WS_WD = WS_WGU + 4 * SZ_WGU;
constexpr size_t SZ_WD = (size_t)2048 * 5504 * 2;
constexpr size_t WS_WIN_EV = WS_WD + 4 * SZ_WD;
constexpr size_t WS_WOUT_EV = WS_WIN_EV + (size_t)EV_PAD * 2048 * 2;
constexpr size_t WS_WIN_OD = WS_WOUT_EV + (size_t)2048 * 2048 * 2;
constexpr size_t WS_WOUT_OD = WS_WIN_OD + (size_t)OD_COLS * 2048 * 2;
constexpr size_t WS_WGLU = WS_WOUT_OD + (size_t)2048 * 2048 * 2;
constexpr size_t WS_XC = WS_WGLU + (size_t)1024 * 1024 * 2;
constexpr size_t WS_HB = WS_XC + (size_t)TC * D * 4;
constexpr size_t WS_R = WS_HB + (size_t)TT * D * 2;
constexpr size_t WS_HID = WS_R;
constexpr size_t WS_Y = WS_R + 183 * MiB;
constexpr size_t WS_S = WS_R;
constexpr size_t WS_GT = WS_R + 247 * MiB;
constexpr size_t WS_GB = WS_R + 264 * MiB;
constexpr size_t WS_O = WS_R + 298 * MiB;
constexpr size_t SZ_O = (size_t)TT * 1024 * 2;
constexpr size_t WS_XL = WS_R + 434 * MiB;
constexpr size_t WS_QK2 = WS_XL + (size_t)TL * D * 2;
constexpr size_t WS_GP = WS_QK2 + (size_t)TT * 2048 * 2;
constexpr size_t WS_QKS = WS_GP + (size_t)TT * 8 * 4 * 4;
constexpr size_t WS_VEC = WS_QKS + (size_t)2 * TT * 1024 * 2;
constexpr size_t WS_GPK = WS_VEC + (size_t)NB * 4 * 2 * 68 * 384 * 4;
constexpr size_t WS_PP = WS_GPK + (size_t)NB * 4 * 2 * 68 * 256 * 4;
constexpr size_t WS_RS = WS_PP + (size_t)NB * 4 * 2 * 68 * 4096 * 2;
constexpr size_t WS_END = WS_RS + (size_t)NB * 4 * 2 * 68 * 64 * 4;
constexpr size_t WS_YCP = WS_R + 320 * MiB;
constexpr int YPARTS = 8;
static_assert(WS_YCP >= WS_Y + (size_t)TT * D * 2 && WS_YCP + (size_t)YPARTS * TC * D * 4 <= WS_XL && WS_O + 4 * SZ_O <= WS_XL, "ws map");
static_assert(WS_HID + (size_t)TT * DFF * 2 <= WS_Y && WS_S + (size_t)TT * EV_PAD * 2 <= WS_GT && WS_GT + (size_t)TT * 256 * 4 <= WS_GB && WS_GB + (size_t)TT * 1024 * 2 <= WS_O, "ws map");
static_assert(WS_Y + (size_t)TT * D * 2 <= WS_O, "ws map");

constexpr int LDS_BYTES = 156 * 1024;
constexpr int MISC_OFF = LDS_BYTES - 64;

struct Args { const float* in[34]; float* out; unsigned char* ws; };
#ifdef PROBE_A
#ifndef PROBE_A1
#define PROBE_A1 PROBE_A
#endif
#ifndef PROBE_B
#define PROBE_B -100
#endif
#ifndef PROBE_B1
#define PROBE_B1 PROBE_B
#endif
#define XBAR() do { xcd_barrier(bar); if (blockIdx.x == 0 && threadIdx.x == 0) { volatile LAS unsigned* M_ = (volatile LAS unsigned*)(lds + MISC_OFF); const unsigned c_ = M_[4]; \
        const unsigned long long t_ = __builtin_amdgcn_s_memrealtime(); const unsigned lo_ = (unsigned)t_; \
        if ((int)c_ == PROBE_A - 1) M_[6] = lo_; if ((int)c_ == PROBE_A1) M_[7] = lo_; if ((int)c_ == PROBE_B - 1) M_[8] = lo_; if ((int)c_ == PROBE_B1) M_[9] = lo_; M_[4] = c_ + 1u; } } while (0)
#else
#define XBAR() xcd_barrier(bar)
#endif
#define ARG(k) ((const float*)(GAS const float*)(a.in[opaque_idx(k)]))
__device__ __forceinline__ unsigned char* wsp(unsigned char* w, size_t off) { asm volatile("" : "+s"(off)); return w + off; }
__device__ __forceinline__ int opaque_idx(int k) { asm volatile("" : "+s"(k)); return k; }

__device__ __forceinline__ unsigned f2bf(float f) { unsigned u = __float_as_uint(f); u += 0x7FFFu + ((u >> 16) & 1u); return u >> 16; }
typedef __bf16 bf16x2_t __attribute__((ext_vector_type(2)));
typedef float f32x2_t __attribute__((ext_vector_type(2)));
__device__ __forceinline__ unsigned pk2(float lo, float hi) { const f32x2_t v = {lo, hi}; const bf16x2_t b = __builtin_convertvector(v, bf16x2_t); return __builtin_bit_cast(unsigned, b); }
__device__ __forceinline__ float bf2f(unsigned short b) { return __uint_as_float(((unsigned)b) << 16); }
__device__ __forceinline__ float wave_sum(float v) {
#pragma unroll
    for (int o = 1; o < 64; o <<= 1) v += __shfl_xor(v, o);
    return v;
}
__device__ __forceinline__ float fast_silu(float g) { return g * __builtin_amdgcn_rcpf(1.0f + __expf(-g)); }
__device__ __forceinline__ float fast_sigmoid(float g) { return __builtin_amdgcn_rcpf(1.0f + __expf(-g)); }

#ifndef DEFER
#define DEFER 1
#endif
struct TJob { const float* src; bf16* dst; int K, N, map; };
constexpr int NT_FFN = 5504, NT_EVIN = 32 * 226, NT_SQ = 2048, NT_ODIN = 32 * 160, NT_GLU = 512;
constexpr int NT_SET0 = 6 * NT_FFN + NT_EVIN + NT_SQ + NT_ODIN + NT_SQ + NT_GLU, NT_SET1 = 3 * NT_FFN, NT_SET2 = 3 * NT_FFN;
__device__ __forceinline__ void transpose_tile(const TJob& j, int tl, int lane) {
    const int nblk = (j.N + 31) / 32, kb = tl / nblk, nb = tl % nblk, k0 = 64 * kb, n0 = 32 * nb;
    const int kb8 = lane >> 3, nb4 = lane & 7, n = n0 + 4 * nb4;
    int drow0;
    if (j.map == 0) drow0 = n0;
    else if (j.map == 1) drow0 = (n0 / 128) * 256 + (n0 % 128);
    else if (j.map == 2) drow0 = (n0 / 128) * 256 + (n0 % 128) + 128;
    else drow0 = (nb < 96) ? n0 : (nb == 96 ? 7168 : (nb < 225 ? n0 - 32 : 7200));
    if (n < j.N) {
        const float* s = j.src + (size_t)(k0 + 8 * kb8) * j.N + n;
        f32x4 v[8];
#pragma unroll
        for (int i = 0; i < 8; ++i) v[i] = *(const f32x4*)(s + (size_t)i * j.N);
        bf16* d = j.dst + (size_t)(drow0 + 4 * nb4) * j.K + k0 + 8 * kb8;
#pragma unroll
        for (int e = 0; e < 4; ++e) { v4u o; o.x = pk2(v[0][e], v[1][e]); o.y = pk2(v[2][e], v[3][e]); o.z = pk2(v[4][e], v[5][e]); o.w = pk2(v[6][e], v[7][e]);
            *(v4u*)(d + (size_t)e * j.K) = o; }
    }
}

__device__ __forceinline__ TJob make_job(const Args& a, unsigned char* ws, int id) {
    TJob j;
    if (id < 12) { const int li = id / 3, kind = id % 3; const size_t wo = (size_t)li * 2048 * 5504;
        j.src = ARG(8 + kind) + wo;
        if (kind == 2) { j.K = 5504; j.N = 2048; j.map = 0; j.dst = (bf16*)(wsp(ws, WS_WD) + (size_t)li * SZ_WD); }
        else { j.K = 2048; j.N = 5504; j.map = 1 + kind; j.dst = (bf16*)(wsp(ws, WS_WGU) + (size_t)li * SZ_WGU); } }
    else if (id == 12) { j.src = ARG(11); j.K = 2048; j.N = EV_COLS; j.map = 3; j.dst = (bf16*)wsp(ws, WS_WIN_EV); }
    else if (id == 13) { j.src = ARG(12); j.K = 2048; j.N = 2048; j.map = 0; j.dst = (bf16*)wsp(ws, WS_WOUT_EV); }
    else if (id == 14) { j.src = ARG(20); j.K = 2048; j.N = OD_COLS; j.map = 0; j.dst = (bf16*)wsp(ws, WS_WIN_OD); }
    else if (id == 15) { j.src = ARG(21); j.K = 2048; j.N = 2048; j.map = 0; j.dst = (bf16*)wsp(ws, WS_WOUT_OD); }
    else { j.src = ARG(30); j.K = 1024; j.N = 1024; j.map = 0; j.dst = (bf16*)wsp(ws, WS_WGLU); }
    return j;
}
__device__ __forceinline__ void convert_tiles(const Args& a, unsigned char* ws, int set, int wave_index, int nwaves, int lane) {
    const int njobs = set == 0 ? 11 : 3;
    int start = wave_index;
#pragma unroll 1
    for (int q = 0; q < njobs; ++q) {
        const int id = set == 0 ? (q < 3 ? q : (q < 6 ? q + 3 : q + 6)) : (set == 1 ? 3 + q : 9 + q);
        const int nt = id < 12 ? NT_FFN : (id == 12 ? NT_EVIN : (id == 14 ? NT_ODIN : (id == 16 ? NT_GLU : NT_SQ)));
        const TJob j = make_job(a, ws, id);
        int t = start;
#pragma unroll 1
        for (; t < nt; t += nwaves) transpose_tile(j, t, lane);
        start = t - nt;
    }
}

struct NormP {
    const float* xin_lat; const float* xin_ctx; float* xout_lat; float* xout_ctx; const bf16* y; bf16* h;
    int rows_end; int has_y, has_h; float w;
    const float* y_ctx;
    int lp, sp;
    int ln, sn;
};
__device__ __forceinline__ void norm_phase(const NormP& p, const float* mod, const float* norm_pre, const float* norm_post, LAS unsigned char* lds, int gw, int ngw, int tid, int lane) {
    { int t2 = threadIdx.x; asm volatile("" : "+v"(t2)); tid = t2; lane = t2 & 63; gw = blockIdx.x * NWAVES + __builtin_amdgcn_readfirstlane(t2 >> 6); }
    LAS float* TA = (LAS float*)lds; LAS float* TB = TA + 5 * D; LAS float* TCc = TB + 5 * D;
    for (int i = tid; i < 5 * D; i += NTHR) { const int var = i >> 11, j = i & (D - 1);
        if (p.has_y) TA[i] = p.w * mod[((size_t)p.lp * 5 + var) * (NMOD * D) + (3 * p.sp + 2) * D + j] * norm_post[(p.lp * 3 + p.sp) * D + j];
        if (p.has_h) { TB[i] = norm_pre[(p.ln * 3 + p.sn) * D + j] * (1.0f + mod[((size_t)p.ln * 5 + var) * (NMOD * D) + (3 * p.sn + 1) * D + j]);
                       TCc[i] = mod[((size_t)p.ln * 5 + var) * (NMOD * D) + (3 * p.sn) * D + j]; } }
    __syncthreads();
    for (int r = gw; r < p.rows_end; r += ngw) {
        const int var = r < TL ? (r >> 12) : 4;
        const float* xi = r < TL ? p.xin_lat + (size_t)r * D : p.xin_ctx + (size_t)(r - TL) * D;
        float* xo = r < TL ? p.xout_lat + (size_t)r * D : p.xout_ctx + (size_t)(r - TL) * D;
        f32x4 xv[8];
#pragma unroll
        for (int j = 0; j < 8; ++j) xv[j] = *(const f32x4*)(xi + 4 * lane + 256 * j);
        if (p.has_y) {
            const bool yc = (r >= TL) && p.y_ctx; const float* yr = p.y_ctx + (size_t)(r - TL) * D; f32x4 yv[8]; float s = 0.f;
            if (!yc) { const bf16* yb = p.y + (size_t)r * D;
#pragma unroll
                for (int j = 0; j < 8; ++j) { const v2u w = *(const v2u*)(yb + 4 * lane + 256 * j); yv[j] = (f32x4){__uint_as_float(w.x << 16), __uint_as_float(w.x & 0xffff0000u), __uint_as_float(w.y << 16), __uint_as_float(w.y & 0xffff0000u)}; }
            } else {
#pragma unroll
                for (int j = 0; j < 8; ++j) yv[j] = *(const f32x4*)(yr + 4 * lane + 256 * j);
                for (int q = 1; q < YPARTS; ++q) {
#pragma unroll
                for (int j = 0; j < 8; ++j) yv[j] += *(const f32x4*)(yr + (size_t)q * TC * D + 4 * lane + 256 * j); } }
#pragma unroll
            for (int j = 0; j < 8; ++j) { s += (yv[j].x * yv[j].x + yv[j].y * yv[j].y) + (yv[j].z * yv[j].z + yv[j].w * yv[j].w); }
            const float rstd = 1.0f / sqrtf(wave_sum(s) * (1.0f / D) + EPS);
#pragma unroll
            for (int j = 0; j < 8; ++j) { const f32x4 a = *(const LAS f32x4*)(TA + var * D + 4 * lane + 256 * j); xv[j] = xv[j] + a * (yv[j] * rstd); *(f32x4*)(xo + 4 * lane + 256 * j) = xv[j]; }
        }
        if (p.has_h) {
            float s = 0.f;
#pragma unroll
            for (int j = 0; j < 8; ++j) s += (xv[j].x * xv[j].x + xv[j].y * xv[j].y) + (xv[j].z * xv[j].z + xv[j].w * xv[j].w);
            const float rstd = 1.0f / sqrtf(wave_sum(s) * (1.0f / D) + EPS);
            bf16* hr = p.h + (size_t)r * D;
#pragma unroll
            for (int j = 0; j < 8; ++j) { const f32x4 b = *(const LAS f32x4*)(TB + var * D + 4 * lane + 256 * j), c = *(const LAS f32x4*)(TCc + var * D + 4 * lane + 256 * j);
                const f32x4 o = xv[j] * rstd * b + c; v2u w; w.x = pk2(o.x, o.y); w.y = pk2(o.z, o.w); *(v2u*)(hr + 4 * lane + 256 * j) = w; }
        }
    }
    __syncthreads();
}

struct EpiSwiGLU {
    static constexpr bool PERM = true, AFTER_DRAIN = false;
    bf16* O; int ldc;
    __device__ __forceinline__ void operator()(const pg8::f32x4 (&acc)[2][2][4][2], const pg8::Unit& u, int wr, int wc, int fr, int fq) const {
        const int row0 = u.pm * 256 + wr * 64 + fr, col0 = u.pn * 128 + wc * 32 + 8 * fq;
#pragma unroll
        for (int ai = 0; ai < 2; ++ai)
#pragma unroll
            for (int m = 0; m < 4; ++m) { bf16* rowp = O + (size_t)(row0 + ai * 128 + m * 16) * ldc + col0;
                const pg8::f32x4 g0 = acc[ai][0][m][0], g1 = acc[ai][0][m][1], u0 = acc[ai][1][m][0], u1 = acc[ai][1][m][1];
                v4u w; w.x = pk2(fast_silu(g0[0]) * u0[0], fast_silu(g0[1]) * u0[1]); w.y = pk2(fast_silu(g0[2]) * u0[2], fast_silu(g0[3]) * u0[3]);
                w.z = pk2(fast_silu(g1[0]) * u1[0], fast_silu(g1[1]) * u1[1]); w.w = pk2(fast_silu(g1[2]) * u1[2], fast_silu(g1[3]) * u1[3]);
                *(v4u*)rowp = w; }
    }
};
struct EpiF32 {
    static constexpr bool PERM = true, AFTER_DRAIN = false;
    bf16* C; float* Cs;
    static constexpr int ldc = D;
    __device__ __forceinline__ void operator()(const pg8::f32x4 (&acc)[2][2][4][2], const pg8::Unit& u, int wr, int wc, int fr, int fq) const {
        const int row0 = u.pm * 256 + wr * 64 + fr, col0 = u.pn * 256 + wc * 32 + 8 * fq;
        if (u.part >= 0) {
            float* base = Cs + ((size_t)u.part * TC - (size_t)TL) * D;
#pragma unroll
            for (int ai = 0; ai < 2; ++ai)
#pragma unroll
                for (int m = 0; m < 4; ++m) { float* rowp = base + (size_t)(row0 + ai * 128 + m * 16) * ldc + col0;
#pragma unroll
                    for (int bj = 0; bj < 2; ++bj) { *(pg8::f32x4*)(rowp + bj * 128) = acc[ai][bj][m][0]; *(pg8::f32x4*)(rowp + bj * 128 + 4) = acc[ai][bj][m][1]; } }
        } else {
#pragma unroll
            for (int ai = 0; ai < 2; ++ai)
#pragma unroll
                for (int m = 0; m < 4; ++m) { bf16* rowp = C + (size_t)(row0 + ai * 128 + m * 16) * ldc + col0;
#pragma unroll
                    for (int bj = 0; bj < 2; ++bj) { const pg8::f32x4 v0 = acc[ai][bj][m][0], v1 = acc[ai][bj][m][1];
                        v4u w; w.x = pk2(v0[0], v0[1]); w.y = pk2(v0[2], v0[3]); w.z = pk2(v1[0], v1[1]); w.w = pk2(v1[2], v1[3]);
                        *(v4u*)(rowp + bj * 128) = w; } }
        }
    }
};
struct EpiS {
    static constexpr bool PERM = true, AFTER_DRAIN = false;
    bf16* S; int ldc; float* GT; int gt_pn;
    __device__ __forceinline__ void operator()(const pg8::f32x4 (&acc)[2][2][4][2], const pg8::Unit& u, int wr, int wc, int fr, int fq) const {
        const int row0 = u.pm * 256 + wr * 64 + fr;
        if (u.pn == gt_pn) {
            if (wc < 2) {
#pragma unroll
                for (int ai = 0; ai < 2; ++ai)
#pragma unroll
                    for (int m = 0; m < 4; ++m) { float* rowp = GT + (size_t)(row0 + ai * 128 + m * 16) * 256 + wc * 32 + 8 * fq;
                        *(pg8::f32x4*)rowp = acc[ai][0][m][0]; *(pg8::f32x4*)(rowp + 4) = acc[ai][0][m][1]; }
            }
        } else {
            const int col0 = u.pn * 256 + wc * 32 + 8 * fq;
#pragma unroll
            for (int ai = 0; ai < 2; ++ai)
#pragma unroll
                for (int m = 0; m < 4; ++m) { bf16* rowp = S + (size_t)(row0 + ai * 128 + m * 16) * ldc + col0;
#pragma unroll
                    for (int bj = 0; bj < 2; ++bj) { const pg8::f32x4 v0 = acc[ai][bj][m][0], v1 = acc[ai][bj][m][1];
                        v4u w; w.x = pk2(v0[0], v0[1]); w.y = pk2(v0[2], v0[3]); w.z = pk2(v1[0], v1[1]); w.w = pk2(v1[2], v1[3]);
                        *(v4u*)(rowp + bj * 128) = w; } }
        }
    }
};

#define DEV __device__ __forceinline__
#define LP(T) LAS T*
#define SYNC() do { asm volatile("s_waitcnt lgkmcnt(0)" ::: "memory"); __builtin_amdgcn_s_barrier(); asm volatile("" ::: "memory"); } while (0)
typedef short v8s __attribute__((ext_vector_type(8)));
typedef float v4f __attribute__((ext_vector_type(4)));
#define MFMA16(x, y, c) __builtin_amdgcn_mfma_f32_16x16x32_bf16((x), (y), (c), 0, 0, 0)
#define SHX(v, m) __shfl_xor((v), (m))
#define SHUP(v, d) __shfl_up((v), (d))
#define SHIDX(v, l) __shfl((v), (l))
#define EXPF(x) __expf(x)
#define LOGF(x) __logf(x)
#define RCPF(x) __builtin_amdgcn_rcpf(x)
#define RSQRTF(x) (1.0f / sqrtf(x))
#define PK2(lo, hi) pk2((lo), (hi))
#define F2BF(x) ((unsigned short)f2bf(x))
#define WAVE_SYNC() asm volatile("s_waitcnt lgkmcnt(0)" ::: "memory")
typedef short v4s __attribute__((ext_vector_type(4)));
#define LDS_TR16(p) __builtin_amdgcn_ds_read_tr16_b64_v4i16((LAS v4s*)(p))
#define RDLANE(v, l) __int_as_float(__builtin_amdgcn_readlane(__float_as_int(v), (l)))
#define RDLANE16(v, l) __shfl((v), (l))

DEV int seq_row(int b, int seg, int np, int cm) {
    if (!seg) return TL + b * CTXL + np;
    const int n = cm ? ((np & 63) * 64 + (np >> 6)) : np;
    return b * SEQ + n;
}
DEV int tok_row(int b, int seg, int pos, int dir, int cm) {
    const int len = seg ? SEQ : CTXL;
    return seq_row(b, seg, dir ? len - 1 - pos : pos, cm);
}
DEV float bflo(unsigned u) { return __uint_as_float(u << 16); }
DEV float bfhi(unsigned u) { return __uint_as_float(u & 0xffff0000u); }
DEV float logsigmoidf(float z) { return fminf(z, 0.f) - LOGF(1.0f + EXPF(-fabsf(z))); }
DEV v4f tile_mma(v4f acc, LP(const unsigned char) A, int sa, int m0, LP(const unsigned char) B, int sb, int n0, int ksteps, int fr, int fq) {
    LP(const unsigned char) ap = A + (m0 + fr) * sa + fq * 16;
    LP(const unsigned char) bp = B + (n0 + fr) * sb + fq * 16;
    for (int k = 0; k < ksteps; ++k) {
        const v8s af = *(LP(const v8s))(ap + k * 64);
        const v8s bf = *(LP(const v8s))(bp + k * 64);
        acc = MFMA16(bf, af, acc);
    }
    return acc;
}
DEV v8s tr_frag(LP(const unsigned char) T, int st, int k0, int n0, int lane) {
    const int l16 = lane & 15, fq = lane >> 4;
    LP(const unsigned char) p = T + (k0 + 8 * fq + (l16 >> 2)) * st + (n0 + 4 * (l16 & 3)) * 2;
    const v4s a = LDS_TR16(p), b = LDS_TR16(p + 4 * st);
    return (v8s){a.x, a.y, a.z, a.w, b.x, b.y, b.z, b.w};
}
DEV v4f tile_mma_nt(v4f acc, LP(const unsigned char) A, int sa, int m0, LP(const unsigned char) Bt, int sb, int n0, int ksteps, int lane) {
    const int fr = lane & 15, fq = lane >> 4;
    for (int k = 0; k < ksteps; ++k) { const v8s af = *(LP(const v8s))(A + (m0 + fr) * sa + fq * 16 + k * 64); const v8s bf = tr_frag(Bt, sb, 32 * k, n0, lane); acc = MFMA16(bf, af, acc); }
    return acc;
}
DEV v4f tile_mma_tt(v4f acc, LP(const unsigned char) At, int sa, int m0, LP(const unsigned char) Bt, int sb, int n0, int ksteps, int lane) {
    for (int k = 0; k < ksteps; ++k) { const v8s af = tr_frag(At, sa, 32 * k, m0, lane); const v8s bf = tr_frag(Bt, sb, 32 * k, n0, lane); acc = MFMA16(bf, af, acc); }
    return acc;
}
constexpr int ST128 = 272, ST64 = 144, ST256 = 528, STV = 80;

constexpr int MIX_UNITS = NB * 32;
constexpr int GLA_TASKS = NB * 4 * 2 * (CTXL / 64 + SEQ / 64);
DEV void gla_prep_task(int task, const bf16* S, const float* GT, const float* wg_all, const float* bg_all, bf16* QKS, float* VEC, LP(unsigned char) lds, int tid) {
    constexpr int NCHUNK = CTXL / 64 + SEQ / 64;
    const int cidx = task % NCHUNK, r1 = task / NCHUNK, dir = r1 & 1, h = (r1 >> 1) & 3, b = r1 >> 3;
    const int seg = cidx >= CTXL / 64, ci = seg ? cidx - CTXL / 64 : cidx;
    LP(float) LA = (LP(float))lds; LP(float) SEG = (LP(float))(lds + 32768); LP(float) LR = (LP(float))(lds + 34816); LP(float) WG = (LP(float))(lds + 38912); LP(float) BG = (LP(float))(lds + 47104);
    const int j = tid >> 3, c8 = tid & 7, dc = c8 * 16;
    const float qscale = 0.08838834764831845f;
    const int row = tok_row(b, seg, ci * 64 + j, dir, 0);
    const bf16* sr = S + (size_t)row * EV_PAD;
    const v4u q0 = *(const v4u*)(sr + h * 128 + dc), q1 = *(const v4u*)(sr + h * 128 + dc + 8);
    const v4u k0 = *(const v4u*)(sr + 512 + h * 128 + dc), k1 = *(const v4u*)(sr + 512 + h * 128 + dc + 8);
    for (int i = tid; i < 16 * 128; i += NTHR) { const int m = i >> 7, d = i & 127; WG[i] = wg_all[(dir * 16 + m) * 512 + h * 128 + d]; }
    if (tid < 128) BG[tid] = bg_all[dir * 512 + h * 128 + tid];
    if (tid < 256) { const int rr = tok_row(b, seg, ci * 64 + (tid >> 2), dir, 0); *(LP(v4f))(LR + (tid >> 2) * 16 + (tid & 3) * 4) = *(const v4f*)(GT + (size_t)rr * 256 + dir * 16 + (tid & 3) * 4); }
    SYNC();
    {
        float z[16];
#pragma unroll
        for (int i = 0; i < 16; ++i) z[i] = BG[dc + i];
        for (int m = 0; m < 16; ++m) { const float lrm = LR[j * 16 + m];
#pragma unroll
            for (int i4 = 0; i4 < 4; ++i4) { const v4f w = *(LP(const v4f))(WG + m * 128 + dc + 4 * i4);
                z[4 * i4 + 0] += lrm * w.x; z[4 * i4 + 1] += lrm * w.y; z[4 * i4 + 2] += lrm * w.z; z[4 * i4 + 3] += lrm * w.w; } }
#pragma unroll
        for (int i4 = 0; i4 < 4; ++i4) { v4f o; o.x = logsigmoidf(z[4 * i4]) * 0.0625f; o.y = logsigmoidf(z[4 * i4 + 1]) * 0.0625f; o.z = logsigmoidf(z[4 * i4 + 2]) * 0.0625f; o.w = logsigmoidf(z[4 * i4 + 3]) * 0.0625f;
            *(LP(v4f))(LA + j * 128 + dc + 4 * i4) = o; }
    }
    SYNC();
    {
        const int d = tid & 127, sg = tid >> 7; float acc = 0.f;
        for (int jj = 0; jj < 16; ++jj) { acc += LA[(sg * 16 + jj) * 128 + d]; LA[(sg * 16 + jj) * 128 + d] = acc; }
        SEG[sg * 128 + d] = acc;
    }
    SYNC();
    {
        const int sgj = j >> 4;
        bf16* orow = QKS + ((size_t)dir * TT + row) * 1024 + h * 128 + dc;
#pragma unroll 1
        for (int g = 0; g < 2; ++g) {
            const v4u qv = g ? q1 : q0, kv = g ? k1 : k0;
            const unsigned qw[4] = {qv.x, qv.y, qv.z, qv.w}, kw[4] = {kv.x, kv.y, kv.z, kv.w};
            unsigned oqs[4], oks[4];
#pragma unroll
            for (int i2 = 0; i2 < 4; ++i2) {
                float vqs[2], vks[2];
#pragma unroll
                for (int e = 0; e < 2; ++e) {
                    const int d = dc + 8 * g + 2 * i2 + e;
                    const float s0 = SEG[d], s1 = SEG[128 + d], s2 = SEG[256 + d];
                    const float pre = (sgj > 0 ? s0 : 0.f) + (sgj > 1 ? s1 : 0.f) + (sgj > 2 ? s2 : 0.f);
                    const float bv = LA[j * 128 + d] + pre;
                    const float bmid = LA[32 * 128 + d] + s0 + s1;
                    const float q = (e ? bfhi(qw[i2]) : bflo(qw[i2])) * qscale, k = e ? bfhi(kw[i2]) : bflo(kw[i2]);
                    const float e1 = EXPF(bv - bmid);
                    vqs[e] = q * e1; vks[e] = k * RCPF(e1);
                    if (j == 63) { const float bend = bv; float* vp = VEC + (size_t)task * 384 + d; vp[0] = EXPF(bmid); vp[128] = EXPF(bend - bmid); vp[256] = EXPF(bend); }
                }
                oqs[i2] = PK2(vqs[0], vqs[1]); oks[i2] = PK2(vks[0], vks[1]);
            }
            *(v4u*)(orow + 8 * g) = (v4u){oqs[0], oqs[1], oqs[2], oqs[3]};
            *(v4u*)(orow + 512 + 8 * g) = (v4u){oks[0], oks[1], oks[2], oks[3]};
        }
    }
    SYNC();
}

DEV void gla_unit(const bf16* S, const bf16* QKS, const float* VEC, bf16* O, int unit, LP(unsigned char) lds, int tid) {
    const int lane = tid & 63, wave = tid >> 6, fr = lane & 15, fq = lane >> 4;
    const int vs = unit & 3, dir = (unit >> 2) & 1, h = (unit >> 3) & 3, b = unit >> 5;
    LP(unsigned char) QS = lds; LP(unsigned char) KS = lds + 17408; LP(unsigned char) QB = lds + 34816;
    LP(unsigned char) VV = lds + 52224; LP(unsigned char) PM = lds + 61440; LP(unsigned char) STT = lds + 70656;
    LP(float) DV = (LP(float))(lds + 88064);
    for (int i = tid; i < 64 * ST128 / 4; i += NTHR) ((LP(unsigned))STT)[i] = 0u;
    v4f sacc[4];
#pragma unroll
    for (int i = 0; i < 4; ++i) sacc[i] = (v4f){0.f, 0.f, 0.f, 0.f};
    const int j = tid >> 3, c8 = tid & 7, dc = c8 * 16;
    const int tt = wave >> 1, vt0 = (wave & 1) * 2;
    const int svt = wave & 3, sdt0 = (wave >> 2) * 4;
    bf16* Od = O + (size_t)dir * TT * 1024;
    constexpr int NCHUNK = CTXL / 64 + SEQ / 64;
    const int task0 = ((b * 4 + h) * 2 + dir) * NCHUNK;
    v4u gq0[2], gq1[2], gk0[2], gk1[2], gvv[2]; v4f gem[4]; v4f gdv = (v4f){0.f, 0.f, 0.f, 0.f};
#define GLA_ISSUE(cx, P_) do { const int seg_ = (cx) >= CTXL / 64, ci_ = seg_ ? (cx) - CTXL / 64 : (cx); \
        const int row_ = tok_row(b, seg_, ci_ * 64 + j, dir, 0); \
        const bf16* qr_ = QKS + ((size_t)dir * TT + row_) * 1024 + h * 128 + dc; \
        gq0[P_] = *(const v4u*)(qr_); gq1[P_] = *(const v4u*)(qr_ + 8); gk0[P_] = *(const v4u*)(qr_ + 512); gk1[P_] = *(const v4u*)(qr_ + 520); \
        gvv[P_] = *(const v4u*)(S + (size_t)row_ * EV_PAD + 1024 + h * 256 + vs * 64 + c8 * 8); } while (0)
#define GLA_ISSUE_V(cx) do { const float* vp_ = VEC + (size_t)(task0 + (cx)) * 384;     \
        _Pragma("unroll") for (int i_ = 0; i_ < 4; ++i_) gem[i_] = *(const v4f*)(vp_ + dc + 4 * i_); \
        if (tid < 64) gdv = *(const v4f*)(vp_ + 128 + tid * 4); } while (0)
    GLA_ISSUE(0, 0); GLA_ISSUE(1, 1); GLA_ISSUE_V(0);
    SYNC();
#pragma unroll 1
    for (int c2 = 0; c2 < NCHUNK; c2 += 2) {
#pragma unroll
    for (int u_ = 0; u_ < 2; ++u_) {
        const int cidx = c2 + u_;
        const int seg = cidx >= CTXL / 64, ci = seg ? cidx - CTXL / 64 : cidx;
        const v4u q0 = gq0[u_], q1 = gq1[u_], k0 = gk0[u_], k1 = gk1[u_], vv = gvv[u_]; const v4f dvv = gdv;
        v4f em[4];
#pragma unroll
        for (int i_ = 0; i_ < 4; ++i_) em[i_] = gem[i_];
        {
            *(LP(v4u))(QS + j * ST128 + dc * 2) = q0; *(LP(v4u))(QS + j * ST128 + dc * 2 + 16) = q1;
            *(LP(v4u))(KS + j * ST128 + dc * 2) = k0; *(LP(v4u))(KS + j * ST128 + dc * 2 + 16) = k1;
            const unsigned qw[8] = {q0.x, q0.y, q0.z, q0.w, q1.x, q1.y, q1.z, q1.w}; unsigned ob[8];
#pragma unroll
            for (int i2 = 0; i2 < 8; ++i2) { const v4f e4 = em[i2 >> 1]; const float ea = (i2 & 1) ? e4.z : e4.x, eb = (i2 & 1) ? e4.w : e4.y; ob[i2] = PK2(bflo(qw[i2]) * ea, bfhi(qw[i2]) * eb); }
            *(LP(v4u))(QB + j * ST128 + dc * 2) = (v4u){ob[0], ob[1], ob[2], ob[3]}; *(LP(v4u))(QB + j * ST128 + dc * 2 + 16) = (v4u){ob[4], ob[5], ob[6], ob[7]};
            *(LP(v4u))(VV + j * ST64 + c8 * 16) = vv;
            if (tid < 64) *(LP(v4f))(DV + tid * 4) = dvv;
        }
        if (cidx + 2 < NCHUNK) GLA_ISSUE(cidx + 2, u_);
        if (cidx + 1 < NCHUNK) GLA_ISSUE_V(cidx + 1);
        SYNC();
        v4f oacc[2]; oacc[0] = (v4f){0.f, 0.f, 0.f, 0.f}; oacc[1] = oacc[0];
        {
#pragma unroll
            for (int i = 0; i < 2; ++i) { const int st = vt0 + i; v4f p = (v4f){0.f, 0.f, 0.f, 0.f};
                if (st <= tt) { p = tile_mma(p, QS, ST128, 16 * tt, KS, ST128, 16 * st, 4, fr, fq);
                    if (st == tt) { if (4 * fq + 0 > fr) p.x = 0.f; if (4 * fq + 1 > fr) p.y = 0.f; if (4 * fq + 2 > fr) p.z = 0.f; if (4 * fq + 3 > fr) p.w = 0.f; } }
                *(LP(v2u))(PM + (16 * tt + fr) * ST64 + (16 * st + 4 * fq) * 2) = (v2u){PK2(p.x, p.y), PK2(p.z, p.w)}; }
#pragma unroll
            for (int k = 0; k < 4; ++k) { const v8s af = *(LP(const v8s))(QB + (16 * tt + fr) * ST128 + fq * 16 + k * 64);
#pragma unroll
                for (int i = 0; i < 2; ++i) { const v8s bf = *(LP(const v8s))(STT + (16 * (vt0 + i) + fr) * ST128 + fq * 16 + k * 64); oacc[i] = MFMA16(bf, af, oacc[i]); } }
        }
        SYNC();
#pragma unroll
        for (int k = 0; k < 2; ++k) { const v8s af = *(LP(const v8s))(PM + (16 * tt + fr) * ST64 + fq * 16 + k * 64);
#pragma unroll
            for (int i = 0; i < 2; ++i) { const v8s bf = tr_frag(VV, ST64, 32 * k, 16 * (vt0 + i), lane); oacc[i] = MFMA16(bf, af, oacc[i]); } }
        { const int orow = tok_row(b, seg, ci * 64 + 16 * tt + fr, dir, 0);
#pragma unroll
          for (int i = 0; i < 2; ++i) *(v2u*)(Od + (size_t)orow * 1024 + h * 256 + vs * 64 + 16 * (vt0 + i) + 4 * fq) = (v2u){PK2(oacc[i].x, oacc[i].y), PK2(oacc[i].z, oacc[i].w)}; }
        {
            v4f tmp[4];
#pragma unroll
            for (int i = 0; i < 4; ++i) tmp[i] = (v4f){0.f, 0.f, 0.f, 0.f};
#pragma unroll
            for (int k = 0; k < 2; ++k) { const v8s af = tr_frag(VV, ST64, 32 * k, 16 * svt, lane);
#pragma unroll
                for (int i = 0; i < 4; ++i) { const v8s bf = tr_frag(KS, ST128, 32 * k, 16 * (sdt0 + i), lane); tmp[i] = MFMA16(bf, af, tmp[i]); } }
#pragma unroll
            for (int i = 0; i < 4; ++i) { const v4f ee = *(LP(const v4f))(DV + 16 * (sdt0 + i) + 4 * fq), de = *(LP(const v4f))(DV + 128 + 16 * (sdt0 + i) + 4 * fq);
                sacc[i] = sacc[i] * de + tmp[i] * ee;
                *(LP(v2u))(STT + (16 * svt + fr) * ST128 + (16 * (sdt0 + i) + 4 * fq) * 2) = (v2u){PK2(sacc[i].x, sacc[i].y), PK2(sacc[i].z, sacc[i].w)}; }
        }
        SYNC();
    }
    }
#undef GLA_ISSUE
#undef GLA_ISSUE_V
}

constexpr int GATE_TASKS = NB * 4 * 2 * (CTXL / 64 + SEQ / 64);
DEV void gate_prep_task(int task, const float* GT, const bf16* QK2, float* GP, float* GPK, const float* gate_b, int lane) {
    constexpr int NCHUNK = CTXL / 64 + SEQ / 64;
    const int cidx = task % NCHUNK, r1 = task / NCHUNK, dir = r1 & 1, h = (r1 >> 1) & 3, b = r1 >> 3;
    const int seg = cidx >= CTXL / 64, ci = seg ? cidx - CTXL / 64 : cidx;
    const int prow = tok_row(b, seg, ci * 64 + lane, dir, 1);
    const float ig = GT[(size_t)prow * 256 + 32 + (dir * 2 + 0) * 4 + h] + gate_b[(dir * 2 + 0) * 4 + h];
    const float lf = logsigmoidf(GT[(size_t)prow * 256 + 32 + (dir * 2 + 1) * 4 + h] + gate_b[(dir * 2 + 1) * 4 + h]);
    float bcum = lf;
#pragma unroll
    for (int o = 1; o < 64; o <<= 1) { const float t = SHUP(bcum, o); if (lane >= o) bcum += t; }
    const float a_s = ig - bcum;
    float cm = a_s;
#pragma unroll
    for (int o = 1; o < 64; o <<= 1) { const float t = SHUP(cm, o); if (lane >= o) cm = fmaxf(cm, t); }
    *(v4f*)(GP + ((size_t)prow * 8 + dir * 4 + h) * 4) = (v4f){bcum, a_s, cm, 0.f};
    const float w0 = EXPF(a_s - RDLANE(cm, 63));
    v4f kw = (v4f){0.f, 0.f, 0.f, 0.f};
    for (int jj = 0; jj < 64; ++jj) { const int rj = tok_row(b, seg, ci * 64 + jj, dir, 1); const float wj = RDLANE(w0, jj);
        const v2u kk = *(const v2u*)(QK2 + (size_t)rj * 2048 + 1024 + h * 256 + 4 * lane);
        kw.x += bflo(kk.x) * wj; kw.y += bfhi(kk.x) * wj; kw.z += bflo(kk.y) * wj; kw.w += bfhi(kk.y) * wj; }
    *(v4f*)(GPK + (size_t)task * 256 + 4 * lane) = kw;
}

constexpr int MAT_TASKS = NB * 4 * 2 * (CTXL / 64 + SEQ / 64);
template <int MODE>
DEV void mat_prep_task(int task, const bf16* Sqk, int ldqk, int qoff, int koff, float kscale, const float* GP, const float* ret_log_decay, bf16* PP, float* RS, LP(unsigned char) lds, int tid) {
    constexpr int NCHUNK = CTXL / 64 + SEQ / 64;
    const int lane = tid & 63, wave = tid >> 6, fr = lane & 15, fq = lane >> 4;
    const int cidx = task % NCHUNK, r1 = task / NCHUNK, dir = r1 & 1, h = (r1 >> 1) & 3, b = r1 >> 3;
    const int seg = cidx >= CTXL / 64, ci = seg ? cidx - CTXL / 64 : cidx;
    LP(unsigned char) Q = lds; LP(unsigned char) K = lds + 33792; LP(float) AS = (LP(float))(lds + 67584); LP(float) R0 = AS + 64; LP(float) DENP = AS + 128;
    const int j = tid >> 3, c8 = tid & 7, dc = c8 * 32;
    { const bf16* s1 = Sqk + (size_t)tok_row(b, seg, ci * 64 + j, dir, 1) * ldqk;
#pragma unroll
      for (int g8 = 0; g8 < 4; ++g8) { *(LP(v4u))(Q + j * ST256 + (dc + 8 * g8) * 2) = *(const v4u*)(s1 + qoff + h * 256 + dc + 8 * g8); *(LP(v4u))(K + j * ST256 + (dc + 8 * g8) * 2) = *(const v4u*)(s1 + koff + h * 256 + dc + 8 * g8); } }
    if (wave == 0) {
        if (MODE == 0) { const int prow = tok_row(b, seg, ci * 64 + lane, dir, 1); const v4f gpv = *(const v4f*)(GP + ((size_t)prow * 8 + dir * 4 + h) * 4); AS[lane] = gpv.y; R0[lane] = -gpv.z; }
        else { const float lg = -expf(ret_log_decay[dir * 4 + h]); AS[lane] = -(float)(lane + 1) * lg; R0[lane] = (float)(lane + 1) * lg; }
    }
    SYNC();
    const int tt = wave >> 1;
    bf16* pp = PP + (size_t)task * 4096;
    const float rt = R0[16 * tt + fr];
#pragma unroll
    for (int i = 0; i < 2; ++i) { const int st = (wave & 1) * 2 + i; v4f p = (v4f){0.f, 0.f, 0.f, 0.f};
        if (st <= tt) { p = tile_mma(p, Q, ST256, 16 * tt, K, ST256, 16 * st, 8, fr, fq);
            const v4f as4 = *(LP(const v4f))(AS + 16 * st + 4 * fq);
            p.x *= kscale * EXPF(as4.x + rt); p.y *= kscale * EXPF(as4.y + rt); p.z *= kscale * EXPF(as4.z + rt); p.w *= kscale * EXPF(as4.w + rt);
            if (st == tt) { if (4 * fq + 0 > fr) p.x = 0.f; if (4 * fq + 1 > fr) p.y = 0.f; if (4 * fq + 2 > fr) p.z = 0.f; if (4 * fq + 3 > fr) p.w = 0.f; } }
        *(v2u*)(pp + (16 * tt + fr) * 64 + 16 * st + 4 * fq) = (v2u){PK2(p.x, p.y), PK2(p.z, p.w)};
        if (MODE == 0) { float rs = (p.x + p.y) + (p.z + p.w); rs += SHX(rs, 16); rs += SHX(rs, 32); if (fq == 0) DENP[st * 64 + 16 * tt + fr] = rs; } }
    SYNC();
    if (MODE == 0 && tid < 64) RS[(size_t)task * 64 + tid] = (DENP[tid] + DENP[64 + tid]) + (DENP[128 + tid] + DENP[192 + tid]);
    SYNC();
}

template <int MODE>
DEV void mat_unit(const bf16* Sqk, int ldqk, int qoff, int koff, const bf16* Sv, int ldv, int voff, float kscale, const float* GP, const float* GPK, const bf16* PP, const float* RS, bf16* O, int store_ctx,
                  const float* ret_log_decay, int unit, LP(unsigned char) lds, int tid) {
    const int lane = tid & 63, wave = tid >> 6, fr = lane & 15, fq = lane >> 4;
    const int vs = unit & 3, dir = (unit >> 2) & 1, h = (unit >> 3) & 3, b = unit >> 5;
    LP(unsigned char) Q = lds; LP(unsigned char) K = lds + 33792;
    LP(unsigned char) VV = lds + 67584; LP(unsigned char) VW = lds + 76800;
    LP(unsigned char) PM = lds + 86016; LP(unsigned char) STT = lds + 95232;
    LP(float) SCAL = (LP(float))(lds + 137472);
    LP(float) NV = SCAL + 768;
    for (int i = tid; i < 80 * ST256 / 4; i += NTHR) ((LP(unsigned))STT)[i] = 0u;
    if (tid < 256) NV[tid] = 0.f;
    v4f sacc[8];
#pragma unroll
    for (int i = 0; i < 8; ++i) sacc[i] = (v4f){0.f, 0.f, 0.f, 0.f};
    const int j = tid >> 3, c8 = tid & 7, dc = c8 * 32;
    const int tt = wave >> 1, vt0 = (wave & 1) * 2;
    const int svt = wave & 3, sdt0 = (wave >> 2) * 8;
    float m_st = 0.f;
    float lg = 0.f;
    if (MODE == 1) lg = -expf(ret_log_decay[dir * 4 + h]);
    bf16* Od = O + (size_t)(2 + dir) * TT * 1024;
    constexpr int NCHUNK = CTXL / 64 + SEQ / 64;
    v4u rq[2][4], rk[2][4], rv, rp; v4f gpv = (v4f){0.f, 0.f, 0.f, 0.f}; float kwv[2] = {0.f, 0.f}, rsv = 0.f;
    const int task0 = ((b * 4 + h) * 2 + dir) * NCHUNK;
#define MAT_ISSUE(cx, P_) do { const int seg_ = (cx) >= CTXL / 64, ci_ = seg_ ? (cx) - CTXL / 64 : (cx); \
        const int row_ = tok_row(b, seg_, ci_ * 64 + j, dir, 1); \
        const bf16* s1_ = Sqk + (size_t)row_ * ldqk; \
        _Pragma("unroll") for (int g_ = 0; g_ < 4; ++g_) { rq[P_][g_] = *(const v4u*)(s1_ + qoff + h * 256 + dc + 8 * g_); rk[P_][g_] = *(const v4u*)(s1_ + koff + h * 256 + dc + 8 * g_); } \
        if (MODE == 0 && tid < 256) kwv[P_] = GPK[(size_t)(task0 + (cx)) * 256 + tid]; } while (0)
#define MAT_GATE_LOAD(cx) do { if (MODE == 0 && wave == 0) { const int seg_ = (cx) >= CTXL / 64, ci_ = seg_ ? (cx) - CTXL / 64 : (cx); \
        const int prow_ = tok_row(b, seg_, ci_ * 64 + lane, dir, 1); gpv = *(const v4f*)(GP + ((size_t)prow_ * 8 + dir * 4 + h) * 4); rsv = RS[(size_t)(task0 + (cx)) * 64 + lane]; } } while (0)
#define MAT_GATES(cx) do { if (wave == 0) { LP(float) sc_ = SCAL + ((cx) & 1) * 384; \
        if (MODE == 0) { const float bcum_ = gpv.x, a_s_ = gpv.y, Mt_ = fmaxf(m_st, gpv.z); \
            const float M63_ = RDLANE(Mt_, 63), bend_ = RDLANE(bcum_, 63), cm63_ = RDLANE(gpv.z, 63); const float wp_ = EXPF(gpv.z - Mt_); \
            sc_[lane] = wp_; sc_[64 + lane] = EXPF(m_st - Mt_); sc_[128 + lane] = EXPF(a_s_ - M63_); sc_[192 + lane] = EXPF(-(bcum_ + Mt_)); sc_[256 + lane] = rsv * wp_; \
            if (lane == 0) { sc_[320] = EXPF(m_st - M63_); sc_[321] = EXPF(cm63_ - M63_); } \
            m_st = bend_ + M63_; \
        } else { sc_[lane] = 1.0f; sc_[64 + lane] = EXPF((float)(lane + 1) * lg); sc_[128 + lane] = EXPF((float)(63 - lane) * lg); sc_[192 + lane] = 0.f; sc_[256 + lane] = 0.f; \
            if (lane == 0) { sc_[320] = EXPF(64.f * lg); sc_[321] = 0.f; } } } } while (0)
    static_assert(NCHUNK % 2 == 0, "the chunk loop is unrolled by two");
#define MAT_ISSUE_P(cx) do { const int seg_ = (cx) >= CTXL / 64, ci_ = seg_ ? (cx) - CTXL / 64 : (cx); rp = *(const v4u*)(PP + (size_t)(task0 + (cx)) * 4096 + j * 64 + c8 * 8); \
        rv = *(const v4u*)(Sv + (size_t)tok_row(b, seg_, ci_ * 64 + j, dir, 1) * ldv + voff + h * 256 + vs * 64 + c8 * 8); } while (0)
    MAT_ISSUE(0, 0); MAT_ISSUE(1, 1); MAT_ISSUE_P(0); MAT_GATE_LOAD(0);
    MAT_GATES(0);
    MAT_GATE_LOAD(1);
    SYNC();
#pragma unroll 1
    for (int c2 = 0; c2 < NCHUNK; c2 += 2) {
#pragma unroll
    for (int u_ = 0; u_ < 2; ++u_) {
        const int cidx = c2 + u_;
        const int seg = cidx >= CTXL / 64, ci = seg ? cidx - CTXL / 64 : cidx;
        LP(const float) sc = SCAL + u_ * 384;
        const float kw_cur = kwv[u_];
        {
            const float wk = sc[128 + j] * kscale;
#pragma unroll
            for (int g8 = 0; g8 < 4; ++g8) { const int d0 = dc + 8 * g8; *(LP(v4u))(Q + j * ST256 + d0 * 2) = rq[u_][g8]; *(LP(v4u))(K + j * ST256 + d0 * 2) = rk[u_][g8]; }
            const v4u rvv = rv;
            *(LP(v4u))(VV + j * ST64 + c8 * 16) = rvv;
            *(LP(v4u))(VW + j * ST64 + c8 * 16) = (v4u){PK2(bflo(rvv.x) * wk, bfhi(rvv.x) * wk), PK2(bflo(rvv.y) * wk, bfhi(rvv.y) * wk), PK2(bflo(rvv.z) * wk, bfhi(rvv.z) * wk), PK2(bflo(rvv.w) * wk, bfhi(rvv.w) * wk)};
            *(LP(v4u))(PM + j * ST64 + c8 * 16) = rp;
#pragma unroll
            for (int i = 0; i < 8; ++i) *(LP(v2u))(STT + (16 * svt + fr) * ST256 + (16 * (sdt0 + i) + 4 * fq) * 2) = (v2u){PK2(sacc[i].x, sacc[i].y), PK2(sacc[i].z, sacc[i].w)};
        }
        if (cidx + 2 < NCHUNK) MAT_ISSUE(cidx + 2, u_);
        if (cidx + 1 < NCHUNK) MAT_ISSUE_P(cidx + 1);
        SYNC();
        if (cidx + 1 < NCHUNK) { MAT_GATES(cidx + 1); if (cidx + 2 < NCHUNK) MAT_GATE_LOAD(cidx + 2); }
        v4f oP[2], oI[2]; oP[0] = (v4f){0.f, 0.f, 0.f, 0.f}; oP[1] = oP[0]; oI[0] = oP[0]; oI[1] = oP[0];
        v4f qa = (v4f){0.f, 0.f, 0.f, 0.f};
#pragma unroll 1
        for (int k = 0; k < 8; ++k) { const v8s af = *(LP(const v8s))(Q + (16 * tt + fr) * ST256 + fq * 16 + k * 64);
#pragma unroll
            for (int i = 0; i < 2; ++i) { const v8s bf = *(LP(const v8s))(STT + (16 * (vt0 + i) + fr) * ST256 + fq * 16 + k * 64); oI[i] = MFMA16(bf, af, oI[i]); }
            if (MODE == 0) { const v8s bn = *(LP(const v8s))(STT + (64 + fr) * ST256 + fq * 16 + k * 64); qa = MFMA16(bn, af, qa); } }
#pragma unroll
        for (int k = 0; k < 2; ++k) { const v8s af = *(LP(const v8s))(PM + (16 * tt + fr) * ST64 + fq * 16 + k * 64);
#pragma unroll
            for (int i = 0; i < 2; ++i) { const v8s bf = tr_frag(VV, ST64, 32 * k, 16 * (vt0 + i), lane); oP[i] = MFMA16(bf, af, oP[i]); } }
        { const int t = 16 * tt + fr; const float wp = sc[t], wi = sc[64 + t];
          v4f o0 = oP[0] * wp + oI[0] * wi, o1 = oP[1] * wp + oI[1] * wi;
          if (MODE == 0) { const float qn = RDLANE16(qa.x, fr); const float den = sc[256 + t] + wi * qn; const float dv = 1.0f / fmaxf(fabsf(den), sc[192 + t]); o0 = o0 * dv; o1 = o1 * dv; }
          if (seg || store_ctx) { const int orow = tok_row(b, seg, ci * 64 + t, dir, 1);
              *(v2u*)(Od + (size_t)orow * 1024 + h * 256 + vs * 64 + 16 * vt0 + 4 * fq) = (v2u){PK2(o0.x, o0.y), PK2(o0.z, o0.w)};
              *(v2u*)(Od + (size_t)orow * 1024 + h * 256 + vs * 64 + 16 * (vt0 + 1) + 4 * fq) = (v2u){PK2(o1.x, o1.y), PK2(o1.z, o1.w)}; } }
        const float dcy = sc[320];
        {
#pragma unroll
            for (int i = 0; i < 8; ++i) sacc[i] = sacc[i] * dcy;
#pragma unroll 1
            for (int k = 0; k < 2; ++k) { const v8s af = tr_frag(VW, ST64, 32 * k, 16 * svt, lane);
#pragma unroll
                for (int i = 0; i < 8; ++i) { const v8s bf = tr_frag(K, ST256, 32 * k, 16 * (sdt0 + i), lane); sacc[i] = MFMA16(bf, af, sacc[i]); } }
        }
        SYNC();
        if (MODE == 0 && tid < 256) {
            const float nn = dcy * NV[tid] + sc[321] * kw_cur * kscale; NV[tid] = nn;
            *(LP(unsigned short))(STT + 64 * ST256 + tid * 2) = F2BF(nn); }
    }
    }
#undef MAT_ISSUE
#undef MAT_ISSUE_P
#undef MAT_GATE_LOAD
#undef MAT_GATES
    SYNC();
}

constexpr int S5_LDS_PER_WAVE = 1280 + 2 * 10240 + 2 * 6144;
DEV void s5_unit(const bf16* S, int ldS, bf16* O, const float* lam_re, const float* lam_im, const float* log_step, const float* b_re, const float* b_im,
                 const float* c_re, const float* c_im, int unit, LP(unsigned char) wl, int lane) {
    const int fr = lane & 15, fq = lane >> 4;
    const int dir = unit & 1, g = (unit >> 1) & 63, b = unit >> 7;
    LP(unsigned char) UB = wl; LP(unsigned char) XB = wl + 1280; LP(unsigned char) HB = wl + 1280 + 2 * 10240;
    const int pg = (dir * 64 + g);
    const float lr = lam_re[pg * 64 + lane], li = lam_im[pg * 64 + lane], step = expf(log_step[pg]);
    const float mag = expf(lr * step); float sn, cs; sincosf(li * step, &sn, &cs);
    const float ar = mag * cs, ai = mag * sn, den = lr * lr + li * li;
    const float cre = ((ar - 1.0f) * lr + ai * li) / den, cim = (ai * lr - (ar - 1.0f) * li) / den;
    for (int p = 0; p < 16; ++p) { const float br = b_re[(pg * 64 + lane) * 16 + p], bi = b_im[(pg * 64 + lane) * 16 + p];
        *(LP(unsigned short))(XB + lane * 32 + p * 2) = F2BF(cre * br - cim * bi);
        *(LP(unsigned short))(XB + (64 + lane) * 32 + p * 2) = F2BF(cre * bi + cim * br); }
    WAVE_SYNC();
    v8s bfrag[8];
#pragma unroll
    for (int nt = 0; nt < 8; ++nt) { if (fq < 2) bfrag[nt] = *(LP(const v8s))(XB + (16 * nt + fr) * 32 + fq * 16); else bfrag[nt] = (v8s){0, 0, 0, 0, 0, 0, 0, 0}; }
    v8s cfrag[4];
#pragma unroll
    for (int ks = 0; ks < 4; ++ks) { const int n0 = 32 * ks + 8 * fq; const float* src = (n0 < 64 ? c_re : c_im) + ((size_t)pg * 16 + fr) * 64 + (n0 & 63); const float sgn = n0 < 64 ? 1.f : -1.f;
        v8s f;
#pragma unroll
        for (int i = 0; i < 8; ++i) f[i] = (short)F2BF(sgn * src[i]);
        cfrag[ks] = f; }
    WAVE_SYNC();
    for (int i = lane; i < 1280 / 4; i += 64) ((LP(unsigned))UB)[i] = 0u;
    WAVE_SYNC();
    float hr = 0.f, hi = 0.f;
    bf16* Od = O + (size_t)dir * TT * 1024;
    constexpr int NBLK = CTXL / 16 + SEQ / 16;
    constexpr int S5_PF = 8;
    v4u ur[S5_PF];
#pragma unroll
    for (int i_ = 0; i_ < S5_PF; ++i_) ur[i_] = (v4u){0u, 0u, 0u, 0u};
#define S5_LOAD(bx, dst) do { if (lane < 32 && (bx) < NBLK) { const int seg_ = (bx) >= CTXL / 16, bi_ = seg_ ? (bx) - CTXL / 16 : (bx); \
        dst = *(const v4u*)(S + (size_t)tok_row(b, seg_, bi_ * 16 + (lane >> 1), dir, 0) * ldS + g * 16 + (lane & 1) * 8); } } while (0)
#define S5_STAGE_A(bx) do { const v8s uf_ = *(LP(const v8s))(UB + fr * 80 + fq * 16); LP(unsigned char) xb_ = XB + ((bx) & 1) * 10240; \
        _Pragma("unroll") for (int nt = 0; nt < 8; ++nt) { v4f x = (v4f){0.f, 0.f, 0.f, 0.f}; x = MFMA16(uf_, bfrag[nt], x); *(LP(v4f))(xb_ + (16 * nt + fr) * 80 + fq * 16) = x; } } while (0)
#pragma unroll
    for (int i_ = 0; i_ < S5_PF; ++i_) S5_LOAD(i_, ur[i_]);
    if (lane < 32) *(LP(v4u))(UB + (lane >> 1) * 80 + (lane & 1) * 16) = ur[0];
#pragma unroll
    for (int i_ = 0; i_ + 1 < S5_PF; ++i_) ur[i_] = ur[i_ + 1];
    S5_LOAD(S5_PF, ur[S5_PF - 1]);
    WAVE_SYNC();
    S5_STAGE_A(0);
    static_assert(NBLK % S5_PF == 0, "ring unrolling");
#pragma unroll 1
    for (int bx0 = 0; bx0 <= NBLK; bx0 += S5_PF) {
#pragma unroll
    for (int ui = 0; ui < S5_PF; ++ui) {
        const int bx = bx0 + ui; if (bx > NBLK) break;
        WAVE_SYNC();
        v8s hf[4]; float xr[16], xi[16];
        if (bx >= 1) { LP(unsigned char) hb = HB + ((bx - 1) & 1) * 6144;
#pragma unroll
            for (int ks = 0; ks < 4; ++ks) hf[ks] = tr_frag(hb, 48, 32 * ks, 0, lane); }
        if (bx < NBLK) { LP(unsigned char) xb = XB + (bx & 1) * 10240;
#pragma unroll
            for (int q4 = 0; q4 < 4; ++q4) { const v4f a4 = *(LP(const v4f))(xb + lane * 80 + q4 * 16), b4 = *(LP(const v4f))(xb + (64 + lane) * 80 + q4 * 16);
                xr[4 * q4] = a4.x; xr[4 * q4 + 1] = a4.y; xr[4 * q4 + 2] = a4.z; xr[4 * q4 + 3] = a4.w; xi[4 * q4] = b4.x; xi[4 * q4 + 1] = b4.y; xi[4 * q4 + 2] = b4.z; xi[4 * q4 + 3] = b4.w; } }
        if (bx + 1 < NBLK) { if (lane < 32) *(LP(v4u))(UB + (lane >> 1) * 80 + (lane & 1) * 16) = ur[ui]; S5_LOAD(bx + 1 + S5_PF, ur[ui]); }
        WAVE_SYNC();
        if (bx + 1 < NBLK) S5_STAGE_A(bx + 1);
        if (bx >= 1) { const int pb = bx - 1, seg = pb >= CTXL / 16, bi = seg ? pb - CTXL / 16 : pb;
            if (seg) { v4f y = (v4f){0.f, 0.f, 0.f, 0.f};
#pragma unroll
                for (int ks = 0; ks < 4; ++ks) y = MFMA16(cfrag[ks], hf[ks], y);
                const int orow = tok_row(b, seg, bi * 16 + fr, dir, 0);
                *(v2u*)(Od + (size_t)orow * 1024 + g * 16 + 4 * fq) = (v2u){PK2(y.x, y.y), PK2(y.z, y.w)}; } }
        if (bx < NBLK) { LP(unsigned char) hb = HB + (bx & 1) * 6144;
            unsigned pr[8], pi[8];
#pragma unroll
            for (int t2 = 0; t2 < 8; ++t2) {
                const float r0 = ar * hr - ai * hi + xr[2 * t2], i0 = ar * hi + ai * hr + xi[2 * t2];
                hr = ar * r0 - ai * i0 + xr[2 * t2 + 1]; hi = ar * i0 + ai * r0 + xi[2 * t2 + 1];
                pr[t2] = PK2(r0, hr); pi[t2] = PK2(i0, hi); }
            *(LP(v4u))(hb + lane * 48) = (v4u){pr[0], pr[1], pr[2], pr[3]}; *(LP(v4u))(hb + lane * 48 + 16) = (v4u){pr[4], pr[5], pr[6], pr[7]};
            *(LP(v4u))(hb + (64 + lane) * 48) = (v4u){pi[0], pi[1], pi[2], pi[3]}; *(LP(v4u))(hb + (64 + lane) * 48 + 16) = (v4u){pi[4], pi[5], pi[6], pi[7]}; }
    }
    }
#undef S5_STAGE_A
#undef S5_LOAD
}

DEV void conv_prep_row(int r, const bf16* S, bf16* QK2, const float* conv_w, const float* conv_b, int lane) {
    int rm, rp; bool hasm, hasp;
    if (r < TL) { const int b = r >> 12, n = r & (SEQ - 1), gr = n >> 6, col = n & 63, np = col * 64 + gr;
        hasm = np > 0; hasp = np < SEQ - 1; rm = seq_row(b, 1, hasm ? np - 1 : np, 1); rp = seq_row(b, 1, hasp ? np + 1 : np, 1); }
    else { const int n = (r - TL) & (CTXL - 1); hasm = n > 0; hasp = n < CTXL - 1; rm = hasm ? r - 1 : r; rp = hasp ? r + 1 : r; }
    const bf16* s0 = S + (size_t)rm * EV_PAD + 3072; const bf16* s1 = S + (size_t)r * EV_PAD + 3072; const bf16* s2 = S + (size_t)rp * EV_PAD + 3072;
#pragma unroll
    for (int i = 0; i < 4; ++i) { const int c = 8 * lane + 512 * i;
        const v4u a0 = *(const v4u*)(s0 + c), a1 = *(const v4u*)(s1 + c), a2 = *(const v4u*)(s2 + c);
        const unsigned w0[4] = {a0.x, a0.y, a0.z, a0.w}, w1[4] = {a1.x, a1.y, a1.z, a1.w}, w2[4] = {a2.x, a2.y, a2.z, a2.w};
        const float sc = c >= 1024 ? 0.0625f : 1.0f;
        float val[8];
#pragma unroll
        for (int i2 = 0; i2 < 4; ++i2)
#pragma unroll
            for (int e = 0; e < 2; ++e) { const int di = 2 * i2 + e;
                const float um = hasm ? (e ? bfhi(w0[i2]) : bflo(w0[i2])) : 0.f, u0 = e ? bfhi(w1[i2]) : bflo(w1[i2]), up = hasp ? (e ? bfhi(w2[i2]) : bflo(w2[i2])) : 0.f;
                const float pre = conv_b[c + di] + conv_w[c + di] * um + conv_w[2048 + c + di] * u0 + conv_w[4096 + c + di] * up;
                val[di] = pre * RCPF(1.0f + EXPF(-pre)) * sc; }
        *(v4u*)(QK2 + (size_t)r * 2048 + c) = (v4u){PK2(val[0], val[1]), PK2(val[2], val[3]), PK2(val[4], val[5]), PK2(val[6], val[7])}; }
}

DEV v4f ld4bf(const bf16* p) { const v2u w = *(const v2u*)p; return (v4f){bflo(w.x), bfhi(w.x), bflo(w.y), bfhi(w.y)}; }
DEV float wsum(float v) {
#pragma unroll
    for (int o = 1; o < 64; o <<= 1) v += SHX(v, o);
    return v;
}
DEV float grp16_sum(float v) { v += SHX(v, 1); v += SHX(v, 2); v += SHX(v, 4); v += SHX(v, 8); return v; }
DEV void ld16bf(const bf16* p, float (&o)[16]) { const v4u a = *(const v4u*)p, b = *(const v4u*)(p + 8); const unsigned w[8] = {a.x, a.y, a.z, a.w, b.x, b.y, b.z, b.w};
#pragma unroll
    for (int i = 0; i < 8; ++i) { o[2 * i] = bflo(w[i]); o[2 * i + 1] = bfhi(w[i]); } }
DEV void ld16f(const float* p, float (&o)[16]) {
#pragma unroll
    for (int i = 0; i < 4; ++i) { const v4f a = *(const v4f*)(p + 4 * i); o[4 * i] = a.x; o[4 * i + 1] = a.y; o[4 * i + 2] = a.z; o[4 * i + 3] = a.w; } }
DEV void st16bf(bf16* p, const float (&o)[16]) { *(v4u*)p = (v4u){PK2(o[0], o[1]), PK2(o[2], o[3]), PK2(o[4], o[5]), PK2(o[6], o[7])}; *(v4u*)(p + 8) = (v4u){PK2(o[8], o[9]), PK2(o[10], o[11]), PK2(o[12], o[13]), PK2(o[14], o[15])}; }
template <int CENTER, int GATE>
DEV void head_norm16(const bf16* o0, const bf16* o1, const float* gain, const bf16* gs, bf16* dst) {
    float a[16], b2[16], g[16], gt[16];
    ld16bf(o0, a); ld16bf(o1, b2); ld16f(gain, g); ld16bf(gs, gt);
    float s = 0.f;
#pragma unroll
    for (int i = 0; i < 16; ++i) { a[i] += b2[i]; s += a[i]; }
    if (CENTER) { const float mean = grp16_sum(s) * (1.0f / 256.0f);
#pragma unroll
        for (int i = 0; i < 16; ++i) a[i] -= mean; }
    float q = 0.f;
#pragma unroll
    for (int i = 0; i < 16; ++i) q += a[i] * a[i];
    const float rstd = RSQRTF(grp16_sum(q) * (1.0f / 256.0f) + EPS);
#pragma unroll
    for (int i = 0; i < 16; ++i) { const float sg = RCPF(1.0f + EXPF(-gt[i])); const float gate = GATE ? sg : gt[i] * sg; a[i] = gate * (a[i] * rstd * g[i]); }
    st16bf(dst, a);
}
DEV void merge_even_row(int r, const bf16* S, const bf16* O, const float* gla_norm, const float* ml_norm, bf16* HBo, int lane) {
    const bf16* sr = S + (size_t)r * EV_PAD; const int c = 16 * lane; const bf16* ob = O + (size_t)r * 1024 + c; const size_t os = (size_t)TT * 1024;
    head_norm16<0, 0>(ob, ob + os, gla_norm + c, sr + 2048 + c, HBo + (size_t)r * D + c);
    head_norm16<1, 1>(ob + 2 * os, ob + 3 * os, ml_norm + c, sr + 6144 + c, HBo + (size_t)r * D + 1024 + c);
}
DEV float gelu_tanh(float y) { const float z = 0.7978845608028654f * (y + 0.044715f * y * y * y); const float t = 1.0f - 2.0f * RCPF(1.0f + EXPF(2.0f * z)); return 0.5f * y * (1.0f + t); }
DEV void merge_odd_row(int r, const bf16* S, const bf16* O, const float* s5_d, const float* ret_norm, bf16* GBo, bf16* HBo, int lane) {
    const bf16* sr = S + (size_t)r * OD_COLS; const int c = 16 * lane; const bf16* ob = O + (size_t)r * 1024 + c; const size_t os = (size_t)TT * 1024;
    {
        float y0[16], y1[16], dd[16], u[16];
        ld16bf(ob, y0); ld16bf(ob + os, y1); ld16f(s5_d + c, dd); ld16bf(sr + c, u);
#pragma unroll
        for (int i = 0; i < 16; ++i) {
#ifdef NO_S5
            y0[i] = 0.f; y1[i] = 0.f;
#endif
            y0[i] = gelu_tanh(y0[i] + y1[i] + dd[i] * u[i]); }
        st16bf(GBo + (size_t)r * 1024 + c, y0);
    }
    head_norm16<1, 0>(ob + 2 * os, ob + 3 * os, ret_norm + c, sr + 4096 + c, HBo + (size_t)r * D + 1024 + c);
}

struct EpiGLU {
    static constexpr bool PERM = true, AFTER_DRAIN = false;
    const bf16* G; const float* bias; bf16* O;
    __device__ __forceinline__ void operator()(const pg8::f32x4 (&acc)[2][2][4][2], const pg8::Unit& u, int wr, int wc, int fr, int fq) const {
        const int row0 = u.pm * 256 + wr * 64 + fr, col0 = u.pn * 256 + wc * 32 + 8 * fq;
#pragma unroll
        for (int ai = 0; ai < 2; ++ai)
#pragma unroll
            for (int m = 0; m < 4; ++m) { const size_t row = (size_t)(row0 + ai * 128 + m * 16);
#pragma unroll
                for (int bj = 0; bj < 2; ++bj) { const int col = col0 + bj * 128;
                    const v4u gw = *(const v4u*)(G + row * 1024 + col); const pg8::f32x4 b0 = *(const pg8::f32x4*)(bias + col), b1 = *(const pg8::f32x4*)(bias + col + 4);
                    const pg8::f32x4 v0 = acc[ai][bj][m][0] + b0, v1 = acc[ai][bj][m][1] + b1;
                    v4u w; w.x = pk2(bflo(gw.x) * fast_sigmoid(v0[0]), bfhi(gw.x) * fast_sigmoid(v0[1])); w.y = pk2(bflo(gw.y) * fast_sigmoid(v0[2]), bfhi(gw.y) * fast_sigmoid(v0[3]));
                    w.z = pk2(bflo(gw.z) * fast_sigmoid(v1[0]), bfhi(gw.z) * fast_sigmoid(v1[1])); w.w = pk2(bflo(gw.w) * fast_sigmoid(v1[2]), bfhi(gw.w) * fast_sigmoid(v1[3]));
                    *(v4u*)(O + row * D + col) = w; } }
    }
};

__device__ __forceinline__ void mixer_phases(const Args& a, unsigned char* ws, LAS unsigned char* lds, const XcdBarrier& bar, int layer, int G, int gw, int ngw, int tid, int lane, int wave) {
#define HB ((bf16*)wsp(ws, WS_HB))
#define S ((bf16*)wsp(ws, WS_S))
#define GT ((float*)wsp(ws, WS_GT))
#define O ((bf16*)wsp(ws, WS_O))
#define GB ((bf16*)wsp(ws, WS_GB))
#define Y ((bf16*)wsp(ws, WS_Y))
    const int ldS = layer == 0 ? EV_PAD : OD_COLS;
    { pg8::Gemm g{HB, (const bf16*)(wsp(ws, (layer == 0 ? WS_WIN_EV : WS_WIN_OD))), TT, ldS, D}; pg8::StaticOrder So; So.init(TT, ldS, G, (int)blockIdx.x);
      EpiS E{S, ldS, GT, layer == 0 ? 28 : -1};
      pg8::gemm_phase<EpiS, pg8::StaticOrder, true, true>(lds, g, So, E); }
    XBAR();
#define QK2 ((bf16*)wsp(ws, WS_QK2))
#define GP ((float*)wsp(ws, WS_GP))
#define QKS ((bf16*)wsp(ws, WS_QKS))
#define GPK ((float*)wsp(ws, WS_GPK))
#define PP ((bf16*)wsp(ws, WS_PP))
#define RS ((float*)wsp(ws, WS_RS))
#define VEC ((float*)wsp(ws, WS_VEC))
    { int t2 = threadIdx.x; asm volatile("" : "+v"(t2)); tid = t2; lane = t2 & 63; wave = __builtin_amdgcn_readfirstlane(t2 >> 6); gw = blockIdx.x * NWAVES + wave; }
    if (layer == 0) {
        { const bf16* s_ = S; bf16* qk_ = QK2; const float* cw_ = ARG(16); const float* cb_ = ARG(17); for (int r = gw; r < TT; r += ngw) conv_prep_row(r, s_, qk_, cw_, cb_, lane); }
        XBAR();
        { const float* gt_ = GT; const bf16* qk_ = QK2; float* gp_ = GP; float* gk_ = GPK; const float* gb_ = ARG(18); for (int t = gw; t < GATE_TASKS; t += ngw) gate_prep_task(t, gt_, qk_, gp_, gk_, gb_, lane); }
        { int t2 = threadIdx.x; asm volatile("" : "+v"(t2)); for (int t = blockIdx.x; t < GLA_TASKS; t += G) gla_prep_task(t, S, GT, ARG(13), ARG(14), QKS, VEC, lds, t2); }
        XBAR();
        { int t2 = threadIdx.x; asm volatile("" : "+v"(t2)); for (int t = blockIdx.x; t < MAT_TASKS; t += G) mat_prep_task<0>(t, QK2, 2048, 0, 1024, 1.0f, GP, nullptr, PP, RS, lds, t2); }
        XBAR();
    } else {
        { int t2 = threadIdx.x; asm volatile("" : "+v"(t2)); for (int t = blockIdx.x; t < MAT_TASKS; t += G) mat_prep_task<1>(t, S, OD_COLS, 1024, 2048, 0.0625f, nullptr, ARG(32), PP, RS, lds, t2); }
        XBAR();
    }
    { int t2 = threadIdx.x; asm volatile("" : "+v"(t2)); tid = t2; lane = t2 & 63; wave = __builtin_amdgcn_readfirstlane(t2 >> 6); }
#ifndef SCAN_REPS
#define SCAN_REPS 1
#endif
#pragma unroll 1
    for (int rep = 0; rep < SCAN_REPS; ++rep) {
#define UNIT_OF(w) (NB == 4 ? (((((w) & 7) * 4 + (((w) >> 3) & 15) / 4) << 2) | ((((w) >> 3) & 15) & 3)) : (w))
    if (layer == 0) {
#ifdef SPLIT_L0
        for (int it = blockIdx.x; it < MIX_UNITS; it += G) gla_unit(S, QKS, VEC, O, UNIT_OF(it), lds, tid);
        XBAR();
        for (int it = blockIdx.x; it < 2 * MIX_UNITS; it += G) if (it >= MIX_UNITS) mat_unit<0>(QK2, 2048, 0, 1024, S, EV_PAD, 5120, 1.0f, GP, GPK, PP, RS, O, 1, nullptr, UNIT_OF(it - MIX_UNITS), lds, tid);
        if (false)
#endif
        for (int it = blockIdx.x; it < 2 * MIX_UNITS; it += G) {
            if (it < MIX_UNITS) {
#ifndef REP_GLA
#define REP_GLA 1
#endif
#pragma unroll 1
                for (int r_ = 0; r_ < REP_GLA; ++r_) gla_unit(S, QKS, VEC, O, UNIT_OF(it), lds, tid);
                if (DEFER && G >= 2 * MIX_UNITS) convert_tiles(a, ws, 1, (int)blockIdx.x * NWAVES + wave, MIX_UNITS * NWAVES, lane);
            } else {
#ifndef REP_ML
#define REP_ML 1
#endif
#pragma unroll 1
                for (int r_ = 0; r_ < REP_ML; ++r_) mat_unit<0>(QK2, 2048, 0, 1024, S, EV_PAD, 5120, 1.0f, GP, GPK, PP, RS, O, 1, nullptr, UNIT_OF(it - MIX_UNITS), lds, tid);
            }
        }
        if (DEFER && G < 2 * MIX_UNITS) convert_tiles(a, ws, 1, (int)blockIdx.x * NWAVES + wave, G * NWAVES, lane);
    } else {
        const int s5_first = G >= 2 * MIX_UNITS ? MIX_UNITS : 0, s5_wgs = G - s5_first;
#ifndef REP_RET
#define REP_RET 1
#endif
#ifndef REP_S5
#define REP_S5 1
#endif
#pragma unroll 1
        for (int r_ = 0; r_ < REP_RET; ++r_)
        for (int u = blockIdx.x; u < MIX_UNITS; u += G)
            mat_unit<1>(S, OD_COLS, 1024, 2048, S, OD_COLS, 3072, 0.0625f, nullptr, nullptr, PP, RS, O, 0, ARG(32), UNIT_OF(u), lds, tid);
        if (DEFER && rep == 0 && (int)blockIdx.x >= s5_first && wave >= 4) convert_tiles(a, ws, 2, ((int)blockIdx.x - s5_first) * 4 + (wave - 4), 4 * s5_wgs, lane);
#pragma unroll 1
        for (int r_ = 0; r_ < REP_S5; ++r_)
        if ((int)blockIdx.x >= s5_first && wave < 4) { for (int su = ((int)blockIdx.x - s5_first) * 4 + wave; su < NB * 128; su += 4 * s5_wgs)
            s5_unit(S, OD_COLS, O, ARG(22), ARG(23), ARG(24), ARG(25), ARG(26), ARG(27), ARG(28), su, lds + wave * S5_LDS_PER_WAVE, lane); }
    }
    }
    XBAR();
    { int t2 = threadIdx.x; asm volatile("" : "+v"(t2)); tid = t2; lane = t2 & 63; wave = __builtin_amdgcn_readfirstlane(t2 >> 6); gw = blockIdx.x * NWAVES + wave; }
#ifndef NO_MERGE
    if (layer == 0) { const bf16* s_ = S; const bf16* o_ = O; const float* n0 = ARG(15); const float* n1 = ARG(19); bf16* hb_ = HB; for (int r = gw; r < TT; r += ngw) merge_even_row(r, s_, o_, n0, n1, hb_, lane); }
    else { const bf16* s_ = S; const bf16* o_ = O; const float* n0 = ARG(29); const float* n1 = ARG(33); bf16* gb_ = GB; bf16* hb_ = HB; for (int r = gw; r < TL; r += ngw) merge_odd_row(r, s_, o_, n0, n1, gb_, hb_, lane); }
#endif
    XBAR();
    const int Mo = layer == 0 ? TT : TL;
    if (layer == 1) {
        pg8::Gemm g{GB, (const bf16*)(wsp(ws, WS_WGLU)), TL, 1024, 1024}; pg8::StaticOrder So; So.init(TL, 1024, G, (int)blockIdx.x);
        EpiGLU E{GB, ARG(31), HB};
        pg8::gemm_phase<EpiGLU, pg8::StaticOrder, true, true>(lds, g, So, E);
        XBAR();
    }
    { pg8::Gemm g{HB, (const bf16*)(wsp(ws, (layer == 0 ? WS_WOUT_EV : WS_WOUT_OD))), Mo, D, D}; pg8::SplitOrder So; So.init(Mo - TL, D, G, (int)blockIdx.x);
      EpiF32 E{Y, (float*)(wsp(ws, WS_YCP))};
      pg8::gemm_phase<EpiF32, pg8::SplitOrder, true, true>(lds, g, So, E); }
    XBAR();
}
#undef HB
#undef S
#undef GT
#undef O
#undef GB
#undef Y
#undef QK2
#undef GP
#undef QKS
#undef GPK
#undef PP
#undef RS
#undef VEC
#undef UNIT_OF

#ifndef MIXER_ON
#define MIXER_ON 1
#endif
__global__ void __launch_bounds__(NTHR, 2) fwd(Args a) {
    extern __shared__ __attribute__((aligned(16))) unsigned char lds_raw[];
    LAS unsigned char* lds = (LAS unsigned char*)lds_raw;
    const int tid = threadIdx.x, lane = tid & 63, wave = __builtin_amdgcn_readfirstlane(tid >> 6);
    const int G = gridDim.x, gw = blockIdx.x * NWAVES + wave, ngw = G * NWAVES;
    unsigned char* ws = a.ws;
    if (tid < 16) ((LAS unsigned*)(lds + MISC_OFF))[tid] = 0u;
    __syncthreads();
#ifdef PROBE_A
    if (blockIdx.x == 0 && tid == 0) { volatile LAS unsigned* M_ = (volatile LAS unsigned*)(lds + MISC_OFF); const unsigned lo_ = (unsigned)__builtin_amdgcn_s_memrealtime(); if (PROBE_A == 0) M_[6] = lo_; if (PROBE_B == 0) M_[8] = lo_; }
#endif
    XcdBarrier bar = xcd_barrier_post((unsigned*)(wsp(ws, WS_CTL)), (volatile LAS unsigned*)(lds + MISC_OFF));

#ifdef NAN_POISON
    {
        v4u q = (v4u){0xffffffffu, 0xffffffffu, 0xffffffffu, 0xffffffffu};
        for (int i = tid; i < (MISC_OFF) / 16; i += NTHR) ((LAS v4u*)lds)[i] = q;
        { v4u* p = (v4u*)(wsp(ws, WS_MOD)); const size_t n = (WS_WGU - WS_MOD) / 16; for (size_t i = (size_t)blockIdx.x * NTHR + tid; i < n; i += (size_t)G * NTHR) p[i] = q; }
        { v4u* p = (v4u*)(wsp(ws, WS_XC)); const size_t n = (WS_END - WS_XC) / 16; for (size_t i = (size_t)blockIdx.x * NTHR + tid; i < n; i += (size_t)G * NTHR) p[i] = q; }
        { v4u* p = (v4u*)a.out; const size_t n = (size_t)TL * D * 4 / 16; for (size_t i = (size_t)blockIdx.x * NTHR + tid; i < n; i += (size_t)G * NTHR) p[i] = q; }
        __syncthreads();
        XBAR();
    }
#endif
#define MOD ((float*)wsp(ws, WS_MOD))
#define MODP ((float*)wsp(ws, WS_MODP))
#define HB ((bf16*)wsp(ws, WS_HB))
#define HID ((bf16*)wsp(ws, WS_HID))
#define Y ((bf16*)wsp(ws, WS_Y))
#define XC ((float*)wsp(ws, WS_XC))

#ifndef REP_PRO
#define REP_PRO 1
#endif
#ifndef REP_GU
#define REP_GU 1
#endif
#ifndef REP_DN
#define REP_DN 1
#endif
#pragma unroll 1
    for (int rep_ = 0; rep_ < REP_PRO; ++rep_) {
        __syncthreads();
        LAS float* stab = (LAS float*)(lds + 1024);
        { const float* cin = ARG(1); const float* cctx = ARG(3);
        for (int i = tid; i < 5 * D; i += NTHR) { const int r = i >> 11, k = i & (D - 1); const float c = r < 4 ? cin[r * D + k] : cctx[k]; stab[i] = c / (1.0f + expf(-c)); } }
        __syncthreads();
        for (int it = gw; it < 2 * MOD_KC * 72; it += ngw) {
            const int l = it / (MOD_KC * 72), rem = it % (MOD_KC * 72), kc = rem / 72, jb = rem % 72; constexpr int KCH = D / MOD_KC;
            const float* W = ARG(4) + ((size_t)l * D + kc * KCH) * (NMOD * D) + jb * 256 + lane * 4;
            f32x4 acc[5];
#pragma unroll
            for (int r = 0; r < 5; ++r) acc[r] = (f32x4){0.f, 0.f, 0.f, 0.f};
            for (int k = 0; k < KCH; k += 8) { f32x4 w[8];
#pragma unroll
                for (int i = 0; i < 8; ++i) w[i] = *(const f32x4*)(W + (size_t)(k + i) * (NMOD * D));
#pragma unroll
                for (int i = 0; i < 8; ++i)
#pragma unroll
                    for (int r = 0; r < 5; ++r) acc[r] += stab[r * D + kc * KCH + k + i] * w[i]; }
            { float* modp = MODP;
#pragma unroll
            for (int r = 0; r < 5; ++r) *(f32x4*)(modp + (((size_t)l * MOD_KC + kc) * 5 + r) * (NMOD * D) + jb * 256 + lane * 4) = acc[r]; }
        }
        convert_tiles(a, ws, 0, gw, ngw, lane);
#ifndef DEFER
#define DEFER 1
#endif
        if (!DEFER) { convert_tiles(a, ws, 1, gw, ngw, lane); convert_tiles(a, ws, 2, gw, ngw, lane); }
        { v4u z = (v4u){0u, 0u, 0u, 0u}; v4u* p = (v4u*)(wsp(ws, WS_WIN_EV) + (size_t)EV_COLS * 2048 * 2); const int n16 = (EV_PAD - EV_COLS) * 2048 * 2 / 16;
          for (int i = blockIdx.x * NTHR + tid; i < n16; i += G * NTHR) p[i] = z; }
    }
    XBAR();
    { const float* bmod = ARG(5); const float* modp = MODP; float* modf = MOD;
    for (int i = blockIdx.x * NTHR + tid; i < 2 * 5 * NMOD * D; i += G * NTHR) {
        const int l = i / (5 * NMOD * D), rem = i % (5 * NMOD * D), r = rem / (NMOD * D), j = rem % (NMOD * D);
        float s = bmod[l * (NMOD * D) + j];
        for (int kc = 0; kc < MOD_KC; ++kc) s += modp[(((size_t)l * MOD_KC + kc) * 5 + r) * (NMOD * D) + j];
        modf[i] = s;
    } }
    XBAR();
#ifndef REP_N0
#define REP_N0 1
#endif
#pragma unroll 1
    for (int rep_ = 0; rep_ < REP_N0; ++rep_)
    { NormP p{}; p.xin_lat = ARG(0); p.xin_ctx = ARG(2); p.xout_lat = a.out; p.xout_ctx = XC; p.y = nullptr; p.h = HB; p.rows_end = TT; p.has_y = 0; p.has_h = 1; p.w = 0.f; p.lp = 0; p.sp = 0; p.ln = 0; p.sn = 0;
      norm_phase(p, MOD, ARG(6), ARG(7), lds, gw, ngw, tid, lane); }
    XBAR();

#pragma unroll 1
    for (int layer = 0; layer < 2; ++layer) {
#pragma unroll 1
        for (int half = 0; half < 2; ++half) {
            const int Mrows = (layer == 1 && half == 1) ? TL : TT;
#if MIXER_ON
            if (half == 1) {
                mixer_phases(a, ws, lds, bar, layer, G, gw, ngw, tid, lane, wave);
                NormP p{}; p.xin_lat = a.out; p.xin_ctx = XC; p.xout_lat = a.out; p.xout_ctx = XC; p.y = Y; p.y_ctx = (const float*)(wsp(ws, WS_YCP)); p.h = HB; p.rows_end = Mrows; p.has_y = 1; p.has_h = 1; p.w = 1.0f; p.lp = layer; p.sp = 1; p.ln = layer; p.sn = 2;
                norm_phase(p, MOD, ARG(6), ARG(7), lds, gw, ngw, tid, lane);
                XBAR();
            }
#endif
            const int sub = half * 2;
#pragma unroll 1
            for (int rep_ = 0; rep_ < REP_GU; ++rep_) { pg8::Gemm g{HB, (const bf16*)(wsp(ws, WS_WGU) + (size_t)(layer * 2 + half) * SZ_WGU), Mrows, 2 * DFF, D}; pg8::StaticOrder S; S.init(Mrows, 2 * DFF, G, (int)blockIdx.x);
              EpiSwiGLU E{HID, DFF};
              pg8::gemm_phase<EpiSwiGLU, pg8::StaticOrder, true, true>(lds, g, S, E);
              if (rep_ + 1 < REP_GU) XBAR(); }
            XBAR();
#pragma unroll 1
            for (int rep_ = 0; rep_ < REP_DN; ++rep_) { pg8::Gemm g{HID, (const bf16*)(wsp(ws, WS_WD) + (size_t)(layer * 2 + half) * SZ_WD), Mrows, D, DFF}; pg8::SplitOrder S; S.init(Mrows - TL, DFF, G, (int)blockIdx.x);
              EpiF32 E{Y, (float*)(wsp(ws, WS_YCP))};
              pg8::gemm_phase<EpiF32, pg8::SplitOrder, true, true>(lds, g, S, E);
              if (rep_ + 1 < REP_DN) XBAR(); }
            XBAR();
            { NormP p{}; const bool first = (layer == 0 && half == 0);
              p.xin_lat = first ? ARG(0) : a.out; p.xin_ctx = first ? ARG(2) : XC; p.xout_lat = a.out; p.xout_ctx = XC; p.y = Y; p.y_ctx = (const float*)(wsp(ws, WS_YCP)); p.h = HB; p.rows_end = Mrows; p.has_y = 1; p.w = 0.5f; p.lp = layer; p.sp = sub;
              if (half == 0) { p.has_h = 1; p.ln = layer; p.sn = MIXER_ON ? 1 : 2; }
              else if (layer == 0) { p.has_h = 1; p.ln = 1; p.sn = 0; }
              else { p.has_h = 0; p.ln = 0; p.sn = 0; }
              norm_phase(p, MOD, ARG(6), ARG(7), lds, gw, ngw, tid, lane); }
            if (!(layer == 1 && half == 1)) XBAR();
        }
    }
#ifdef PROBE_A
    XBAR();
    if (blockIdx.x == 0 && threadIdx.x == 0) { volatile LAS unsigned* M_ = (volatile LAS unsigned*)(lds + MISC_OFF);
        const unsigned ticks = (M_[7] - M_[6]) + (PROBE_B >= 0 ? (M_[9] - M_[8]) : 0u);
        const unsigned long long t0 = __builtin_amdgcn_s_memrealtime();
        while (__builtin_amdgcn_s_memrealtime() - t0 < 8ull * ticks) __builtin_amdgcn_s_sleep(8); }
#endif
}

#undef MOD
#undef MODP
#undef HB
#undef HID
#undef Y
#undef XC
extern "C" void kernel_launch(void* const* d_in, const int* in_sizes, int n_in, void* d_out, int out_size, void* d_ws, size_t ws_size, hipStream_t stream) {
    static int grid = 0;
    if (grid == 0) {
        if (n_in != 34 || out_size != TL * D || ws_size < WS_END) { fprintf(stderr, "kernel_launch: unexpected shapes (n_in %d out %d ws %zu need %zu)\n", n_in, out_size, ws_size, (size_t)WS_END); grid = -1; return; }
        int dev = 0, cus = 0, per_cu = 0;
        if (hipGetDevice(&dev) != hipSuccess || hipDeviceGetAttribute(&cus, hipDeviceAttributeMultiprocessorCount, dev) != hipSuccess) { grid = -1; return; }
        if (hipFuncSetAttribute((const void*)fwd, hipFuncAttributeMaxDynamicSharedMemorySize, LDS_BYTES) != hipSuccess) { fprintf(stderr, "kernel_launch: hipFuncSetAttribute failed\n"); grid = -1; return; }
        if (hipOccupancyMaxActiveBlocksPerMultiprocessor(&per_cu, (const void*)fwd, NTHR, LDS_BYTES) != hipSuccess || per_cu < 1) { fprintf(stderr, "kernel_launch: occupancy query says %d\n", per_cu); }
        (void)hipGetLastError();
        grid = cus;
    }
    if (grid < 0) return;
    if (hipMemsetAsync((char*)d_ws + WS_CTL, 0, CTL_ZERO_BYTES, stream) != hipSuccess) return;
    Args a{};
    for (int i = 0; i < 34; ++i) a.in[i] = (const float*)d_in[i];
    a.out = (float*)d_out; a.ws = (unsigned char*)d_ws;
    hipLaunchKernelGGL(fwd, dim3(grid), dim3(NTHR), LDS_BYTES, stream, a);
}
```

```cpp
#include <hip/hip_runtime.h>
#include <cstdio>
#include <cstdint>
#define MIXER_ON 1

#define XB_TMO      128
#define XB_XCNT(j)  (256  + 64 * (j))
#define XB_XSUB(j)  (1280 + 64 * (j))
#define XB_XGEN(j)  (2304 + 64 * (j))
#define XB_TOP      3328
#define XB_TOPGEN   3392
#define XCD_BAR_WORDS 3456
#define XB_SPIN_CAP (1u << 18)
#define LAS __attribute__((address_space(3)))

__device__ __forceinline__ unsigned xb_ld(unsigned* p)              { return __hip_atomic_load(p, __ATOMIC_RELAXED, __HIP_MEMORY_SCOPE_AGENT); }
__device__ __forceinline__ unsigned xb_add(unsigned* p, unsigned v) { return __hip_atomic_fetch_add(p, v, __ATOMIC_RELAXED, __HIP_MEMORY_SCOPE_AGENT); }
__device__ __forceinline__ unsigned xb_xcc_id() { return (unsigned)__builtin_amdgcn_s_getreg((3 << 11) | 20) & 0xFu; }
#define XB_SPIN(cond, bar) do { unsigned _sp = 0; while (cond) { __builtin_amdgcn_s_sleep(1); \
    if ((++_sp & 255u) == 0u) { if (xb_ld(&(bar)[XB_TMO])) break; if (_sp > XB_SPIN_CAP) { atomicAdd(&(bar)[XB_TMO], 1u); break; } } } } while (0)

struct XcdBarrier {
    unsigned* bar; unsigned x;
    volatile LAS unsigned* st;
};

__device__ __forceinline__ XcdBarrier xcd_barrier_post(unsigned* bar, volatile LAS unsigned* st) {
    XcdBarrier b; b.bar = bar; b.x = xb_xcc_id(); b.st = st;
    if (threadIdx.x == 0) (void)xb_add(&bar[XB_XCNT(b.x)], 1u);
    return b;
}
__device__ __forceinline__ void xcd_barrier_complete(unsigned* bar, unsigned x, unsigned& nloc, unsigned& nx) {
    const unsigned G = gridDim.x * gridDim.y * gridDim.z;
    unsigned sum, cnt, mine, sp = 0u;
    for (;;) {
        sum = 0u; cnt = 0u; mine = 0u;
#pragma unroll
        for (unsigned j = 0; j < 16; ++j) { const unsigned c = xb_ld(&bar[XB_XCNT(j)]); sum += c; cnt += (c > 0u) ? 1u : 0u; mine = (j == x) ? c : mine; }
        if (sum == G) break;
        __builtin_amdgcn_s_sleep(1);
        if ((++sp & 255u) == 0u) { if (xb_ld(&bar[XB_TMO])) break; if (sp > XB_SPIN_CAP) { atomicAdd(&bar[XB_TMO], 1u); break; } }
    }
    nloc = mine > 0u ? mine : 1u; nx = cnt > 0u ? cnt : 1u;
}

__device__ __forceinline__ void xcd_barrier(const XcdBarrier& b) {
    asm volatile("s_waitcnt vmcnt(0)" ::: "memory");
    __syncthreads();
    if (threadIdx.x == 0) {
        unsigned* bar = b.bar;
        unsigned bx = __builtin_amdgcn_readfirstlane(b.x); asm volatile("" : "+s"(bx));
        __builtin_amdgcn_s_waitcnt(0);
        unsigned nloc = b.st[0], nx = b.st[1];
        if (nloc == 0u) { xcd_barrier_complete(bar, bx, nloc, nx); b.st[0] = nloc; b.st[1] = nx; }
        const unsigned old = xb_add(&bar[XB_XSUB(bx)], 1u);
        const unsigned gen = old / nloc;
        if (old + 1u == (gen + 1u) * nloc) {
            __builtin_amdgcn_fence(__ATOMIC_RELEASE, "agent");
            asm volatile("s_waitcnt vmcnt(0)" ::: "memory");
            const unsigned og = xb_add(&bar[XB_TOP], 1u);
            const unsigned tg = og / nx;
            if (og + 1u == (tg + 1u) * nx) xb_add(&bar[XB_TOPGEN], 1u);
            else XB_SPIN(xb_ld(&bar[XB_TOPGEN]) == tg, bar);
            __builtin_amdgcn_fence(__ATOMIC_ACQUIRE, "agent");
            xb_add(&bar[XB_XGEN(bx)], 1u);
            asm volatile("s_waitcnt vmcnt(0)" ::: "memory");
        } else {
            XB_SPIN(xb_ld(&bar[XB_XGEN(bx)]) == gen, bar);
            __builtin_amdgcn_fence(__ATOMIC_ACQUIRE, "agent");
            asm volatile("s_waitcnt vmcnt(0)" ::: "memory");
        }
    }
    __syncthreads();
}

namespace pg8 {
#define PG8_LAS __attribute__((address_space(3)))
typedef unsigned short bf16_t;
typedef short bf16x8 __attribute__((ext_vector_type(8)));
typedef float f32x4 __attribute__((ext_vector_type(4)));
typedef unsigned u32x4 __attribute__((ext_vector_type(4)));
constexpr int BM = 256, BK = 64, HALF = 128, HTB = HALF * BK * 2  , STAGE_BYTES = 8 * HTB, NXCD = 8, WGM = 8;

__host__ __device__ __forceinline__ int lds_byte(int r, int c) { const int st = (r >> 4) * 2 + (c >> 5), rr = r & 15, cc = c & 31, ob = rr * 64 + cc * 2; return st * 1024 + (ob ^ (((ob >> 9) & 1) << 5)); }
__host__ __device__ __forceinline__ void stage_rc(int b, int& R, int& C) { const int st = b / 1024, sb = b % 1024, swz = sb ^ (((sb >> 9) & 1) << 5); R = (st >> 1) * 16 + swz / 64; C = (st & 1) * 32 + (swz % 64) / 2; }
__host__ __device__ __forceinline__ int perm32(int rho) { const int n = rho >> 4, i = rho & 15; return 8 * (i >> 2) + 4 * n + (i & 3); }

struct Unit { int pm, pn, k0, nt, part; };
struct Gemm { const bf16_t* A; const bf16_t* Bt; int M, N, K; };

struct StaticOrder {
    int nM, nN, nwg, G, c;
    __host__ __device__ void init(int M, int N, int G_, int c_) { nM = M / BM; nN = N / BM; nwg = nM * nN; G = G_; c = c_; }
    __host__ __device__ bool next(int i, Unit& u) const {
        const long L = (long)i * G + c; if (L >= nwg) return false;
        int wgid = (int)L; { const int q = nwg / NXCD, r = nwg % NXCD, xcd = wgid % NXCD, off = wgid / NXCD; wgid = (xcd < r ? xcd * (q + 1) : r * (q + 1) + (xcd - r) * q) + off; }
        const int nig = WGM * nN, gid = wgid / nig, fm = gid * WGM, gsz = (nM - fm) < WGM ? (nM - fm) : WGM;
        u.pm = fm + ((wgid % nig) % gsz); u.pn = (wgid % nig) / gsz; u.k0 = 0; u.nt = 0; u.part = -1; return true;
    }
    __device__ __forceinline__ void a_ready(const Unit&) const {}
    __device__ __forceinline__ void done(const Unit&) const {}
};
struct SplitOrder {
    static constexpr int NMF = 64, NN = 8, PARTS = 8, NFULL = NMF * NN;
    int nsplit, ntK, G, c;
    __host__ __device__ void init(int Msplit, int K, int G_, int c_) { nsplit = (Msplit / BM) * NN * PARTS; ntK = K / BK; G = G_; c = c_; }
    __host__ __device__ bool next(int i, Unit& u) const {
        const int L = i * G + c, p = L - NFULL; const bool fullu = L < NFULL;
        const int wgid = (L % NXCD) * (NFULL / NXCD) + L / NXCD, nig = WGM * NN, fm = (wgid / nig) * WGM;
        const int q = p & 7, cu = p >> 3, h = ntK >> 1, ks = ((h * q) >> 3) << 1, ke = ((h * (q + 1)) >> 3) << 1;
        u.pm = fullu ? fm + ((wgid % nig) % WGM) : NMF + (cu >> 3);
        u.pn = fullu ? (wgid % nig) / WGM : (cu & 7);
        u.k0 = fullu ? 0 : ks; u.nt = fullu ? 0 : ke - ks; u.part = fullu ? -1 : q;
        return fullu || p < nsplit;
    }
    __device__ __forceinline__ void a_ready(const Unit&) const {}
    __device__ __forceinline__ void done(const Unit&) const {}
};
__device__ __forceinline__ unsigned cvt_pk_bf16(float lo, float hi) { unsigned r; asm volatile("v_cvt_pk_bf16_f32 %0, %1, %2" : "=v"(r) : "v"(lo), "v"(hi)); return r; }
template <class Epi, class Sched, bool ALIGN_EPI = false, bool SP2 = false>
__device__ __forceinline__ void gemm_phase(PG8_LAS unsigned char* lds, const Gemm g, const Sched& S, const Epi& E) {
    int tid_ = threadIdx.x; asm volatile("" : "+v"(tid_));
    const int tid = tid_, wid = __builtin_amdgcn_readfirstlane(tid >> 6), lane = tid & 63, wr = wid >> 2, wc = wid & 3, fr = lane & 15, fq = lane >> 4;
    const int K = g.K, nt = K / BK;
    unsigned voffA[2], voffB[2];
#pragma unroll
    for (int i = 0; i < 2; ++i) { int R, C; stage_rc(tid * 16 + i * 8192, R, C); const int Rb = Epi::PERM ? ((R & ~31) + perm32(R & 31)) : R;
        voffA[i] = (unsigned)(R * K + C) * 2u; voffB[i] = (unsigned)(Rb * K + C) * 2u; }
    const unsigned kstep = BK * 2;
    const unsigned hstep = (unsigned)HALF * K * 2;
    const unsigned tstep = 2 * hstep;
    const unsigned ldsw = (unsigned)wid * 1024u;
    const int aoff = lds_byte(wr * 64 + fr, fq * 8), boff = lds_byte(wc * 32 + fr, fq * 8);
#define PG8_SA(b, h) (((b) * 2 + (h)) * HTB)
#define PG8_SB(b, h) ((4 + (b) * 2 + (h)) * HTB)
#define PG8_STAGE(bufoff, gbase, voff) do { _Pragma("unroll") for (int _i = 0; _i < 2; ++_i) \
        __builtin_amdgcn_global_load_lds((const unsigned*)((const char*)(gbase) + (voff)[_i]), (PG8_LAS unsigned*)(lds + (bufoff) + ldsw + _i * 8192), 16, 0, 0); } while (0)
#define PG8_LDA(dst, b, h) do { _Pragma("unroll") for (int m = 0; m < 4; ++m) _Pragma("unroll") for (int k = 0; k < 2; ++k) dst[m][k] = *(const PG8_LAS bf16x8*)(lds + PG8_SA(b, h) + aoff + m * 2048 + k * 1024); } while (0)
#define PG8_LDB(dst, b, h) do { _Pragma("unroll") for (int n = 0; n < 2; ++n) _Pragma("unroll") for (int k = 0; k < 2; ++k) dst[n][k] = *(const PG8_LAS bf16x8*)(lds + PG8_SB(b, h) + boff + n * 2048 + k * 1024); } while (0)
#define PG8_MMA(ai, bj, At, Bt) do { __builtin_amdgcn_s_setprio(1); _Pragma("unroll") for (int m = 0; m < 4; ++m) _Pragma("unroll") for (int n = 0; n < 2; ++n) _Pragma("unroll") for (int k = 0; k < 2; ++k) \
        acc[ai][bj][m][n] = __builtin_amdgcn_mfma_f32_16x16x32_bf16(Bt[n][k], At[m][k], acc[ai][bj][m][n], 0, 0, 0); __builtin_amdgcn_s_setprio(0); } while (0)
#define PG8_WAIT_V(n) asm volatile("s_waitcnt vmcnt(" #n ")" ::: "memory")
#define PG8_WAIT_L(n) asm volatile("s_waitcnt lgkmcnt(" #n ")" ::: "memory")
#define PG8_BAR __builtin_amdgcn_s_barrier()
#define PG8_SCHED __builtin_amdgcn_sched_barrier(0)
    Unit cur, nxt; int ui = 0;
    if (!S.next(0, cur)) return;
    f32x4 acc[2][2][4][2];
#pragma unroll
    for (int a = 0; a < 2; ++a)
#pragma unroll
        for (int b = 0; b < 2; ++b)
#pragma unroll
            for (int m = 0; m < 4; ++m)
#pragma unroll
                for (int n = 0; n < 2; ++n) acc[a][b][m][n] = (f32x4){0.f, 0.f, 0.f, 0.f};
    bf16x8 At[4][2], B0[2][2], B1[2][2];
    unsigned cA = (unsigned)cur.pm * tstep + (unsigned)cur.k0 * kstep, cB = (unsigned)cur.pn * tstep + (unsigned)cur.k0 * kstep;
    S.a_ready(cur);
    if constexpr (SP2) {
        PG8_STAGE(PG8_SB(0, 0), (const char*)g.Bt + (size_t)(cB), voffB); PG8_STAGE(PG8_SB(0, 1), (const char*)g.Bt + (size_t)(cB + hstep), voffB); PG8_STAGE(PG8_SA(0, 0), (const char*)g.A + (size_t)(cA), voffA); PG8_STAGE(PG8_SA(0, 1), (const char*)g.A + (size_t)(cA + hstep), voffA);
        if (wr == 1) PG8_BAR;
        PG8_WAIT_V(2); PG8_BAR;
        PG8_STAGE(PG8_SB(1, 0), (const char*)g.Bt + (size_t)(cB + kstep), voffB); PG8_STAGE(PG8_SA(1, 0), (const char*)g.A + (size_t)(cA + kstep), voffA); PG8_STAGE(PG8_SB(1, 1), (const char*)g.Bt + (size_t)(cB + hstep + kstep), voffB);
        PG8_WAIT_V(6); PG8_BAR;
    } else {
        PG8_STAGE(PG8_SB(0, 0), (const char*)g.Bt + (size_t)(cB), voffB); PG8_STAGE(PG8_SA(0, 0), (const char*)g.A + (size_t)(cA), voffA); PG8_STAGE(PG8_SB(0, 1), (const char*)g.Bt + (size_t)(cB + hstep), voffB); PG8_STAGE(PG8_SA(0, 1), (const char*)g.A + (size_t)(cA + hstep), voffA);
        if (wr == 1) PG8_BAR;
        PG8_WAIT_V(4); PG8_BAR;
        PG8_STAGE(PG8_SB(1, 0), (const char*)g.Bt + (size_t)(cB + kstep), voffB); PG8_STAGE(PG8_SA(1, 0), (const char*)g.A + (size_t)(cA + kstep), voffA); PG8_STAGE(PG8_SB(1, 1), (const char*)g.Bt + (size_t)(cB + hstep + kstep), voffB);
        PG8_WAIT_V(6); PG8_BAR;
    }
    for (;;) {
        const bool has_next = S.next(ui + 1, nxt);
        const unsigned nA = has_next ? (unsigned)nxt.pm * tstep + (unsigned)nxt.k0 * kstep : cA, nB = has_next ? (unsigned)nxt.pn * tstep + (unsigned)nxt.k0 * kstep : cB;
        const int unt = cur.nt ? cur.nt : nt;
        for (int t = 0; t < unt; t += 2) {
            const bool last = (t == unt - 2);
            const unsigned a1 = cA + (unsigned)(t + 1) * kstep;
            const unsigned a2 = last ? nA : cA + (unsigned)(t + 2) * kstep, b2 = last ? nB : cB + (unsigned)(t + 2) * kstep;
            const unsigned a3 = a2 + kstep, b3 = b2 + kstep;
            if (last && has_next) S.a_ready(nxt);
            if constexpr (SP2) {
            PG8_LDB(B0, 0, 0); PG8_LDB(B1, 0, 1); PG8_SCHED; PG8_LDA(At, 0, 0); PG8_STAGE(PG8_SA(1, 1), (const char*)g.A + (size_t)(a1 + hstep), voffA);
            PG8_WAIT_V(8); PG8_WAIT_L(0); PG8_BAR; PG8_MMA(0, 0, At, B0); PG8_MMA(0, 1, At, B1); PG8_BAR; PG8_SCHED;
            PG8_LDA(At, 0, 1); PG8_STAGE(PG8_SB(0, 0), (const char*)g.Bt + (size_t)(b2), voffB); PG8_STAGE(PG8_SB(0, 1), (const char*)g.Bt + (size_t)(b2 + hstep), voffB); PG8_STAGE(PG8_SA(0, 0), (const char*)g.A + (size_t)(a2), voffA);
            PG8_WAIT_V(8); PG8_WAIT_L(0); PG8_BAR; PG8_MMA(1, 0, At, B0); PG8_MMA(1, 1, At, B1); PG8_BAR; PG8_SCHED;
            PG8_LDB(B0, 1, 0); PG8_LDB(B1, 1, 1); PG8_SCHED; PG8_LDA(At, 1, 0); PG8_STAGE(PG8_SA(0, 1), (const char*)g.A + (size_t)(a2 + hstep), voffA);
            PG8_WAIT_V(8); PG8_WAIT_L(0); PG8_BAR; PG8_MMA(0, 0, At, B0); PG8_MMA(0, 1, At, B1); PG8_BAR; PG8_SCHED;
            PG8_LDA(At, 1, 1); PG8_STAGE(PG8_SB(1, 0), (const char*)g.Bt + (size_t)(b3), voffB); PG8_STAGE(PG8_SB(1, 1), (const char*)g.Bt + (size_t)(b3 + hstep), voffB); PG8_STAGE(PG8_SA(1, 0), (const char*)g.A + (size_t)(a3), voffA);
            PG8_WAIT_V(8); PG8_WAIT_L(0); PG8_BAR; PG8_MMA(1, 0, At, B0); PG8_MMA(1, 1, At, B1); PG8_BAR; PG8_SCHED;
            } else {
            PG8_LDB(B0, 0, 0); PG8_SCHED; PG8_LDA(At, 0, 0); PG8_STAGE(PG8_SA(1, 1), (const char*)g.A + (size_t)(a1 + hstep), voffA);
            PG8_WAIT_L(8); PG8_BAR; PG8_WAIT_L(0); PG8_MMA(0, 0, At, B0); PG8_BAR; PG8_SCHED;
            PG8_LDB(B1, 0, 1); PG8_STAGE(PG8_SB(0, 0), (const char*)g.Bt + (size_t)(b2), voffB);
            PG8_BAR; PG8_WAIT_L(0); PG8_MMA(0, 1, At, B1); PG8_BAR;
            PG8_LDA(At, 0, 1); PG8_STAGE(PG8_SA(0, 0), (const char*)g.A + (size_t)(a2), voffA);
            PG8_BAR; PG8_WAIT_L(0); PG8_MMA(1, 0, At, B0); PG8_BAR; PG8_SCHED;
            PG8_STAGE(PG8_SB(0, 1), (const char*)g.Bt + (size_t)(b2 + hstep), voffB);
            PG8_WAIT_V(6); PG8_BAR; PG8_MMA(1, 1, At, B1); PG8_BAR;
            PG8_LDB(B0, 1, 0); PG8_SCHED; PG8_LDA(At, 1, 0); PG8_STAGE(PG8_SA(0, 1), (const char*)g.A + (size_t)(a2 + hstep), voffA);
            PG8_WAIT_L(8); PG8_BAR; PG8_WAIT_L(0); PG8_MMA(0, 0, At, B0); PG8_BAR; PG8_SCHED;
            PG8_LDB(B1, 1, 1); PG8_STAGE(PG8_SB(1, 0), (const char*)g.Bt + (size_t)(b3), voffB);
            PG8_BAR; PG8_WAIT_L(0); PG8_MMA(0, 1, At, B1); PG8_BAR;
            PG8_LDA(At, 1, 1); PG8_STAGE(PG8_SA(1, 0), (const char*)g.A + (size_t)(a3), voffA);
            PG8_BAR; PG8_WAIT_L(0); PG8_MMA(1, 0, At, B0); PG8_BAR; PG8_SCHED;
            PG8_STAGE(PG8_SB(1, 1), (const char*)g.Bt + (size_t)(b3 + hstep), voffB);
            PG8_WAIT_V(6); PG8_BAR; PG8_MMA(1, 1, At, B1); PG8_BAR;
            }
        }
        if constexpr (ALIGN_EPI) { if (wr == 0) PG8_BAR; }
        if constexpr (!Epi::AFTER_DRAIN) { int t_ = threadIdx.x; asm volatile("" : "+v"(t_)); const int l_ = t_ & 63, w_ = __builtin_amdgcn_readfirstlane(t_ >> 6);
            E(acc, cur, w_ >> 2, w_ & 3, l_ & 15, l_ >> 4); S.done(cur); }
        if (!has_next) break;
#pragma unroll
        for (int a = 0; a < 2; ++a)
#pragma unroll
            for (int b = 0; b < 2; ++b)
#pragma unroll
                for (int m = 0; m < 4; ++m)
#pragma unroll
                    for (int n = 0; n < 2; ++n) acc[a][b][m][n] = (f32x4){0.f, 0.f, 0.f, 0.f};
        cur = nxt; cA = nA; cB = nB; ++ui;
        if constexpr (ALIGN_EPI) { if (wr == 1) PG8_BAR; }
    }
    PG8_WAIT_V(0);
    if constexpr (!ALIGN_EPI) { if (wr == 0) PG8_BAR; }
    PG8_BAR;
    if constexpr (Epi::AFTER_DRAIN) { E.fused(acc, cur, wr, wc, fr, fq, lds, wid, lane); S.done(cur); }
#undef PG8_SA
#undef PG8_SB
#undef PG8_STAGE
#undef PG8_LDA
#undef PG8_LDB
#undef PG8_MMA
#undef PG8_WAIT_V
#undef PG8_WAIT_L
#undef PG8_BAR
#undef PG8_SCHED
}
}

#define GAS __attribute__((address_space(1)))
typedef unsigned short bf16;
typedef float f32x4 __attribute__((ext_vector_type(4)));
typedef unsigned v4u __attribute__((ext_vector_type(4)));
typedef unsigned v2u __attribute__((ext_vector_type(2)));
constexpr int D = 2048, NB = 4, SEQ = 4096, CTXL = 256, DFF = 5504, NMOD = 9;
constexpr int TL = NB * SEQ, TC = NB * CTXL, TT = TL + TC;
constexpr int MIXH = 1024;
constexpr int EV_COLS = 7216, EV_PAD = 7424, OD_COLS = 5120;
constexpr int NWAVES = 8, NTHR = 512;
constexpr float EPS = 1e-6f;

constexpr size_t MiB = 1u << 20;
constexpr size_t WS_CTL = 0, CTL_ZERO_BYTES = 64 * 1024;
constexpr size_t WS_MOD = 1 * MiB;
constexpr size_t WS_MODP = 2 * MiB;
constexpr int MOD_KC = 16;
constexpr size_t WS_WGU = 16 * MiB;
constexpr size_t SZ_WGU = (size_t)11008 * 2048 * 2;
constexpr size_t WS_WD = WS_WGU + 4 * SZ_WGU;
constexpr size_t SZ_WD = (size_t)2048 * 5504 * 2;
constexpr size_t WS_WIN_EV = WS_WD + 4 * SZ_WD;
constexpr size_t WS_WOUT_EV = WS_WIN_EV + (size_t)EV_PAD * 2048 * 2;
constexpr size_t WS_WIN_OD = WS_WOUT_EV + (size_t)2048 * 2048 * 2;
constexpr size_t WS_WOUT_OD = WS_WIN_OD + (size_t)OD_COLS * 2048 * 2;
constexpr size_t WS_WGLU = WS_WOUT_OD + (size_t)2048 * 2048 * 2;
constexpr size_t WS_XC = WS_WGLU + (size_t)1024 * 1024 * 2;
constexpr size_t WS_HB = WS_XC + (size_t)TC * D * 4;
constexpr size_t WS_R = WS_HB + (size_t)TT * D * 2;
constexpr size_t WS_HID = WS_R;
constexpr size_t WS_Y = WS_R + 183 * MiB;
constexpr size_t WS_S = WS_R;
constexpr size_t WS_GT = WS_R + 247 * MiB;
constexpr size_t WS_GB = WS_R + 264 * MiB;
constexpr size_t WS_O = WS_R + 298 * MiB;
constexpr size_t SZ_O = (size_t)TT * 1024 * 2;
constexpr size_t WS_XL = WS_R + 434 * MiB;
constexpr size_t WS_QK2 = WS_XL + (size_t)TL * D * 2;
constexpr size_t WS_GP = WS_QK2 + (size_t)TT * 2048 * 2;
constexpr size_t WS_QKS = WS_GP + (size_t)TT * 8 * 4 * 4;
constexpr size_t WS_VEC = WS_QKS + (size_t)2 * TT * 1024 * 2;
constexpr size_t WS_GPK = WS_VEC + (size_t)NB * 4 * 2 * 68 * 384 * 4;
constexpr size_t WS_PP = WS_GPK + (size_t)NB * 4 * 2 * 68 * 256 * 4;
constexpr size_t WS_RS = WS_PP + (size_t)NB * 4 * 2 * 68 * 4096 * 2;
constexpr size_t WS_END = WS_RS + (size_t)NB * 4 * 2 * 68 * 64 * 4;
constexpr size_t WS_YCP = WS_R + 320 * MiB;
constexpr int YPARTS = 8;
static_assert(WS_YCP >= WS_Y + (size_t)TT * D * 2 && WS_YCP + (size_t)YPARTS * TC * D * 4 <= WS_XL && WS_O + 4 * SZ_O <= WS_XL, "ws map");
static_assert(WS_HID + (size_t)TT * DFF * 2 <= WS_Y && WS_S + (size_t)TT * EV_PAD * 2 <= WS_GT && WS_GT + (size_t)TT * 256 * 4 <= WS_GB && WS_GB + (size_t)TT * 1024 * 2 <= WS_O, "ws map");
static_assert(WS_Y + (size_t)TT * D * 2 <= WS_O, "ws map");

constexpr int LDS_BYTES = 156 * 1024;
constexpr int MISC_OFF = LDS_BYTES - 64;

struct Args { const float* in[34]; float* out; unsigned char* ws; };
#ifdef PROBE_A
#ifndef PROBE_A1
#define PROBE_A1 PROBE_A
#endif
#ifndef PROBE_B
#define PROBE_B -100
#endif
#ifndef PROBE_B1
#define PROBE_B1 PROBE_B
#endif
#define XBAR() do { xcd_barrier(bar); if (blockIdx.x == 0 && threadIdx.x == 0) { volatile LAS unsigned* M_ = (volatile LAS unsigned*)(lds + MISC_OFF); const unsigned c_ = M_[4]; \
        const unsigned long long t_ = __builtin_amdgcn_s_memrealtime(); const unsigned lo_ = (unsigned)t_; \
        if ((int)c_ == PROBE_A - 1) M_[6] = lo_; if ((int)c_ == PROBE_A1) M_[7] = lo_; if ((int)c_ == PROBE_B - 1) M_[8] = lo_; if ((int)c_ == PROBE_B1) M_[9] = lo_; M_[4] = c_ + 1u; } } while (0)
#else
#define XBAR() xcd_barrier(bar)
#endif
#define ARG(k) ((const float*)(GAS const float*)(a.in[opaque_idx(k)]))
__device__ __forceinline__ unsigned char* wsp(unsigned char* w, size_t off) { asm volatile("" : "+s"(off)); return w + off; }
__device__ __forceinline__ int opaque_idx(int k) { asm volatile("" : "+s"(k)); return k; }

__device__ __forceinline__ unsigned f2bf(float f) { unsigned u = __float_as_uint(f); u += 0x7FFFu + ((u >> 16) & 1u); return u >> 16; }
typedef __bf16 bf16x2_t __attribute__((ext_vector_type(2)));
typedef float f32x2_t __attribute__((ext_vector_type(2)));
__device__ __forceinline__ unsigned pk2(float lo, float hi) { const f32x2_t v = {lo, hi}; const bf16x2_t b = __builtin_convertvector(v, bf16x2_t); return __builtin_bit_cast(unsigned, b); }
__device__ __forceinline__ float bf2f(unsigned short b) { return __uint_as_float(((unsigned)b) << 16); }
__device__ __forceinline__ float wave_sum(float v) {
#pragma unroll
    for (int o = 1; o < 64; o <<= 1) v += __shfl_xor(v, o);
    return v;
}
__device__ __forceinline__ float fast_silu(float g) { return g * __builtin_amdgcn_rcpf(1.0f + __expf(-g)); }
__device__ __forceinline__ float fast_sigmoid(float g) { return __builtin_amdgcn_rcpf(1.0f + __expf(-g)); }

#ifndef DEFER
#define DEFER 1
#endif
struct TJob { const float* src; bf16* dst; int K, N, map; };
constexpr int NT_FFN = 5504, NT_EVIN = 32 * 226, NT_SQ = 2048, NT_ODIN = 32 * 160, NT_GLU = 512;
constexpr int NT_SET0 = 6 * NT_FFN + NT_EVIN + NT_SQ + NT_ODIN + NT_SQ + NT_GLU, NT_SET1 = 3 * NT_FFN, NT_SET2 = 3 * NT_FFN;
__device__ __forceinline__ void transpose_tile(const TJob& j, int tl, int lane) {
    const int nblk = (j.N + 31) / 32, kb = tl / nblk, nb = tl % nblk, k0 = 64 * kb, n0 = 32 * nb;
    const int kb8 = lane >> 3, nb4 = lane & 7, n = n0 + 4 * nb4;
    int drow0;
    if (j.map == 0) drow0 = n0;
    else if (j.map == 1) drow0 = (n0 / 128) * 256 + (n0 % 128);
    else if (j.map == 2) drow0 = (n0 / 128) * 256 + (n0 % 128) + 128;
    else drow0 = (nb < 96) ? n0 : (nb == 96 ? 7168 : (nb < 225 ? n0 - 32 : 7200));
    if (n < j.N) {
        const float* s = j.src + (size_t)(k0 + 8 * kb8) * j.N + n;
        f32x4 v[8];
#pragma unroll
        for (int i = 0; i < 8; ++i) v[i] = *(const f32x4*)(s + (size_t)i * j.N);
        bf16* d = j.dst + (size_t)(drow0 + 4 * nb4) * j.K + k0 + 8 * kb8;
#pragma unroll
        for (int e = 0; e < 4; ++e) { v4u o; o.x = pk2(v[0][e], v[1][e]); o.y = pk2(v[2][e], v[3][e]); o.z = pk2(v[4][e], v[5][e]); o.w = pk2(v[6][e], v[7][e]);
            *(v4u*)(d + (size_t)e * j.K) = o; }
    }
}

__device__ __forceinline__ TJob make_job(const Args& a, unsigned char* ws, int id) {
    TJob j;
    if (id < 12) { const int li = id / 3, kind = id % 3; const size_t wo = (size_t)li * 2048 * 5504;
        j.src = ARG(8 + kind) + wo;
        if (kind == 2) { j.K = 5504; j.N = 2048; j.map = 0; j.dst = (bf16*)(wsp(ws, WS_WD) + (size_t)li * SZ_WD); }
        else { j.K = 2048; j.N = 5504; j.map = 1 + kind; j.dst = (bf16*)(wsp(ws, WS_WGU) + (size_t)li * SZ_WGU); } }
    else if (id == 12) { j.src = ARG(11); j.K = 2048; j.N = EV_COLS; j.map = 3; j.dst = (bf16*)wsp(ws, WS_WIN_EV); }
    else if (id == 13) { j.src = ARG(12); j.K = 2048; j.N = 2048; j.map = 0; j.dst = (bf16*)wsp(ws, WS_WOUT_EV); }
    else if (id == 14) { j.src = ARG(20); j.K = 2048; j.N = OD_COLS; j.map = 0; j.dst = (bf16*)wsp(ws, WS_WIN_OD); }
    else if (id == 15) { j.src = ARG(21); j.K = 2048; j.N = 2048; j.map = 0; j.dst = (bf16*)wsp(ws, WS_WOUT_OD); }
    else { j.src = ARG(30); j.K = 1024; j.N = 1024; j.map = 0; j.dst = (bf16*)wsp(ws, WS_WGLU); }
    return j;
}
__device__ __forceinline__ void convert_tiles(const Args& a, unsigned char* ws, int set, int wave_index, int nwaves, int lane) {
    const int njobs = set == 0 ? 11 : 3;
    int start = wave_index;
#pragma unroll 1
    for (int q = 0; q < njobs; ++q) {
        const int id = set == 0 ? (q < 3 ? q : (q < 6 ? q + 3 : q + 6)) : (set == 1 ? 3 + q : 9 + q);
        const int nt = id < 12 ? NT_FFN : (id == 12 ? NT_EVIN : (id == 14 ? NT_ODIN : (id == 16 ? NT_GLU : NT_SQ)));
        const TJob j = make_job(a, ws, id);
        int t = start;
#pragma unroll 1
        for (; t < nt; t += nwaves) transpose_tile(j, t, lane);
        start = t - nt;
    }
}

struct NormP {
    const float* xin_lat; const float* xin_ctx; float* xout_lat; float* xout_ctx; const bf16* y; bf16* h;
    int rows_end; int has_y, has_h; float w;
    const float* y_ctx;
    int lp, sp;
    int ln, sn;
};
__device__ __forceinline__ void norm_phase(const NormP& p, const float* mod, const float* norm_pre, const float* norm_post, LAS unsigned char* lds, int gw, int ngw, int tid, int lane) {
    { int t2 = threadIdx.x; asm volatile("" : "+v"(t2)); tid = t2; lane = t2 & 63; gw = blockIdx.x * NWAVES + __builtin_amdgcn_readfirstlane(t2 >> 6); }
    LAS float* TA = (LAS float*)lds; LAS float* TB = TA + 5 * D; LAS float* TCc = TB + 5 * D;
    for (int i = tid; i < 5 * D; i += NTHR) { const int var = i >> 11, j = i & (D - 1);
        if (p.has_y) TA[i] = p.w * mod[((size_t)p.lp * 5 + var) * (NMOD * D) + (3 * p.sp + 2) * D + j] * norm_post[(p.lp * 3 + p.sp) * D + j];
        if (p.has_h) { TB[i] = norm_pre[(p.ln * 3 + p.sn) * D + j] * (1.0f + mod[((size_t)p.ln * 5 + var) * (NMOD * D) + (3 * p.sn + 1) * D + j]);
                       TCc[i] = mod[((size_t)p.ln * 5 + var) * (NMOD * D) + (3 * p.sn) * D + j]; } }
    __syncthreads();
    for (int r = gw; r < p.rows_end; r += ngw) {
        const int var = r < TL ? (r >> 12) : 4;
        const float* xi = r < TL ? p.xin_lat + (size_t)r * D : p.xin_ctx + (size_t)(r - TL) * D;
        float* xo = r < TL ? p.xout_lat + (size_t)r * D : p.xout_ctx + (size_t)(r - TL) * D;
        f32x4 xv[8];
#pragma unroll
        for (int j = 0; j < 8; ++j) xv[j] = *(const f32x4*)(xi + 4 * lane + 256 * j);
        if (p.has_y) {
            const bool yc = (r >= TL) && p.y_ctx; const float* yr = p.y_ctx + (size_t)(r - TL) * D; f32x4 yv[8]; float s = 0.f;
            if (!yc) { const bf16* yb = p.y + (size_t)r * D;
#pragma unroll
                for (int j = 0; j < 8; ++j) { const v2u w = *(const v2u*)(yb + 4 * lane + 256 * j); yv[j] = (f32x4){__uint_as_float(w.x << 16), __uint_as_float(w.x & 0xffff0000u), __uint_as_float(w.y << 16), __uint_as_float(w.y & 0xffff0000u)}; }
            } else {
#pragma unroll
                for (int j = 0; j < 8; ++j) yv[j] = *(const f32x4*)(yr + 4 * lane + 256 * j);
                for (int q = 1; q < YPARTS; ++q) {
#pragma unroll
                for (int j = 0; j < 8; ++j) yv[j] += *(const f32x4*)(yr + (size_t)q * TC * D + 4 * lane + 256 * j); } }
#pragma unroll
            for (int j = 0; j < 8; ++j) { s += (yv[j].x * yv[j].x + yv[j].y * yv[j].y) + (yv[j].z * yv[j].z + yv[j].w * yv[j].w); }
            const float rstd = 1.0f / sqrtf(wave_sum(s) * (1.0f / D) + EPS);
#pragma unroll
            for (int j = 0; j < 8; ++j) { const f32x4 a = *(const LAS f32x4*)(TA + var * D + 4 * lane + 256 * j); xv[j] = xv[j] + a * (yv[j] * rstd); *(f32x4*)(xo + 4 * lane + 256 * j) = xv[j]; }
        }
        if (p.has_h) {
            float s = 0.f;
#pragma unroll
            for (int j = 0; j < 8; ++j) s += (xv[j].x * xv[j].x + xv[j].y * xv[j].y) + (xv[j].z * xv[j].z + xv[j].w * xv[j].w);
            const float rstd = 1.0f / sqrtf(wave_sum(s) * (1.0f / D) + EPS);
            bf16* hr = p.h + (size_t)r * D;
#pragma unroll
            for (int j = 0; j < 8; ++j) { const f32x4 b = *(const LAS f32x4*)(TB + var * D + 4 * lane + 256 * j), c = *(const LAS f32x4*)(TCc + var * D + 4 * lane + 256 * j);
                const f32x4 o = xv[j] * rstd * b + c; v2u w; w.x = pk2(o.x, o.y); w.y = pk2(o.z, o.w); *(v2u*)(hr + 4 * lane + 256 * j) = w; }
        }
    }
    __syncthreads();
}

struct EpiSwiGLU {
    static constexpr bool PERM = true, AFTER_DRAIN = false;
    bf16* O; int ldc;
    __device__ __forceinline__ void operator()(const pg8::f32x4 (&acc)[2][2][4][2], const pg8::Unit& u, int wr, int wc, int fr, int fq) const {
        const int row0 = u.pm * 256 + wr * 64 + fr, col0 = u.pn * 128 + wc * 32 + 8 * fq;
#pragma unroll
        for (int ai = 0; ai < 2; ++ai)
#pragma unroll
            for (int m = 0; m < 4; ++m) { bf16* rowp = O + (size_t)(row0 + ai * 128 + m * 16) * ldc + col0;
                const pg8::f32x4 g0 = acc[ai][0][m][0], g1 = acc[ai][0][m][1], u0 = acc[ai][1][m][0], u1 = acc[ai][1][m][1];
                v4u w; w.x = pk2(fast_silu(g0[0]) * u0[0], fast_silu(g0[1]) * u0[1]); w.y = pk2(fast_silu(g0[2]) * u0[2], fast_silu(g0[3]) * u0[3]);
                w.z = pk2(fast_silu(g1[0]) * u1[0], fast_silu(g1[1]) * u1[1]); w.w = pk2(fast_silu(g1[2]) * u1[2], fast_silu(g1[3]) * u1[3]);
                *(v4u*)rowp = w; }
    }
};
struct EpiF32 {
    static constexpr bool PERM = true, AFTER_DRAIN = false;
    bf16* C; float* Cs;
    static constexpr int ldc = D;
    __device__ __forceinline__ void operator()(const pg8::f32x4 (&acc)[2][2][4][2], const pg8::Unit& u, int wr, int wc, int fr, int fq) const {
        const int row0 = u.pm * 256 + wr * 64 + fr, col0 = u.pn * 256 + wc * 32 + 8 * fq;
        if (u.part >= 0) {
            float* base = Cs + ((size_t)u.part * TC - (size_t)TL) * D;
#pragma unroll
            for (int ai = 0; ai < 2; ++ai)
#pragma unroll
                for (int m = 0; m < 4; ++m) { float* rowp = base + (size_t)(row0 + ai * 128 + m * 16) * ldc + col0;
#pragma unroll
                    for (int bj = 0; bj < 2; ++bj) { *(pg8::f32x4*)(rowp + bj * 128) = acc[ai][bj][m][0]; *(pg8::f32x4*)(rowp + bj * 128 + 4) = acc[ai][bj][m][1]; } }
        } else {
#pragma unroll
            for (int ai = 0; ai < 2; ++ai)
#pragma unroll
                for (int m = 0; m < 4; ++m) { bf16* rowp = C + (size_t)(row0 + ai * 128 + m * 16) * ldc + col0;
#pragma unroll
                    for (int bj = 0; bj < 2; ++bj) { const pg8::f32x4 v0 = acc[ai][bj][m][0], v1 = acc[ai][bj][m][1];
                        v4u w; w.x = pk2(v0[0], v0[1]); w.y = pk2(v0[2], v0[3]); w.z = pk2(v1[0], v1[1]); w.w = pk2(v1[2], v1[3]);
                        *(v4u*)(rowp + bj * 128) = w; } }
        }
    }
};
struct EpiS {
    static constexpr bool PERM = true, AFTER_DRAIN = false;
    bf16* S; int ldc; float* GT; int gt_pn;
    __device__ __forceinline__ void operator()(const pg8::f32x4 (&acc)[2][2][4][2], const pg8::Unit& u, int wr, int wc, int fr, int fq) const {
        const int row0 = u.pm * 256 + wr * 64 + fr;
        if (u.pn == gt_pn) {
            if (wc < 2) {
#pragma unroll
                for (int ai = 0; ai < 2; ++ai)
#pragma unroll
                    for (int m = 0; m < 4; ++m) { float* rowp = GT + (size_t)(row0 + ai * 128 + m * 16) * 256 + wc * 32 + 8 * fq;
                        *(pg8::f32x4*)rowp = acc[ai][0][m][0]; *(pg8::f32x4*)(rowp + 4) = acc[ai][0][m][1]; }
            }
        } else {
            const int col0 = u.pn * 256 + wc * 32 + 8 * fq;
#pragma unroll
            for (int ai = 0; ai < 2; ++ai)
#pragma unroll
                for (int m = 0; m < 4; ++m) { bf16* rowp = S + (size_t)(row0 + ai * 128 + m * 16) * ldc + col0;
#pragma unroll
                    for (int bj = 0; bj < 2; ++bj) { const pg8::f32x4 v0 = acc[ai][bj][m][0], v1 = acc[ai][bj][m][1];
                        v4u w; w.x = pk2(v0[0], v0[1]); w.y = pk2(v0[2], v0[3]); w.z = pk2(v1[0], v1[1]); w.w = pk2(v1[2], v1[3]);
                        *(v4u*)(rowp + bj * 128) = w; } }
        }
    }
};

#define DEV __device__ __forceinline__
#define LP(T) LAS T*
#define SYNC() do { asm volatile("s_waitcnt lgkmcnt(0)" ::: "memory"); __builtin_amdgcn_s_barrier(); asm volatile("" ::: "memory"); } while (0)
typedef short v8s __attribute__((ext_vector_type(8)));
typedef float v4f __attribute__((ext_vector_type(4)));
#define MFMA16(x, y, c) __builtin_amdgcn_mfma_f32_16x16x32_bf16((x), (y), (c), 0, 0, 0)
#define SHX(v, m) __shfl_xor((v), (m))
#define SHUP(v, d) __shfl_up((v), (d))
#define SHIDX(v, l) __shfl((v), (l))
#define EXPF(x) __expf(x)
#define LOGF(x) __logf(x)
#define RCPF(x) __builtin_amdgcn_rcpf(x)
#define RSQRTF(x) (1.0f / sqrtf(x))
#define PK2(lo, hi) pk2((lo), (hi))
#define F2BF(x) ((unsigned short)f2bf(x))
#define WAVE_SYNC() asm volatile("s_waitcnt lgkmcnt(0)" ::: "memory")
typedef short v4s __attribute__((ext_vector_type(4)));
#define LDS_TR16(p) __builtin_amdgcn_ds_read_tr16_b64_v4i16((LAS v4s*)(p))
#define RDLANE(v, l) __int_as_float(__builtin_amdgcn_readlane(__float_as_int(v), (l)))
#define RDLANE16(v, l) __shfl((v), (l))

DEV int seq_row(int b, int seg, int np, int cm) {
    if (!seg) return TL + b * CTXL + np;
    const int n = cm ? ((np & 63) * 64 + (np >> 6)) : np;
    return b * SEQ + n;
}
DEV int tok_row(int b, int seg, int pos, int dir, int cm) {
    const int len = seg ? SEQ : CTXL;
    return seq_row(b, seg, dir ? len - 1 - pos : pos, cm);
}
DEV float bflo(unsigned u) { return __uint_as_float(u << 16); }
DEV float bfhi(unsigned u) { return __uint_as_float(u & 0xffff0000u); }
DEV float logsigmoidf(float z) { return fminf(z, 0.f) - LOGF(1.0f + EXPF(-fabsf(z))); }
DEV v4f tile_mma(v4f acc, LP(const unsigned char) A, int sa, int m0, LP(const unsigned char) B, int sb, int n0, int ksteps, int fr, int fq) {
    LP(const unsigned char) ap = A + (m0 + fr) * sa + fq * 16;
    LP(const unsigned char) bp = B + (n0 + fr) * sb + fq * 16;
    for (int k = 0; k < ksteps; ++k) {
        const v8s af = *(LP(const v8s))(ap + k * 64);
        const v8s bf = *(LP(const v8s))(bp + k * 64);
        acc = MFMA16(bf, af, acc);
    }
    return acc;
}
DEV v8s tr_frag(LP(const unsigned char) T, int st, int k0, int n0, int lane) {
    const int l16 = lane & 15, fq = lane >> 4;
    LP(const unsigned char) p = T + (k0 + 8 * fq + (l16 >> 2)) * st + (n0 + 4 * (l16 & 3)) * 2;
    const v4s a = LDS_TR16(p), b = LDS_TR16(p + 4 * st);
    return (v8s){a.x, a.y, a.z, a.w, b.x, b.y, b.z, b.w};
}
DEV v4f tile_mma_nt(v4f acc, LP(const unsigned char) A, int sa, int m0, LP(const unsigned char) Bt, int sb, int n0, int ksteps, int lane) {
    const int fr = lane & 15, fq = lane >> 4;
    for (int k = 0; k < ksteps; ++k) { const v8s af = *(LP(const v8s))(A + (m0 + fr) * sa + fq * 16 + k * 64); const v8s bf = tr_frag(Bt, sb, 32 * k, n0, lane); acc = MFMA16(bf, af, acc); }
    return acc;
}
DEV v4f tile_mma_tt(v4f acc, LP(const unsigned char) At, int sa, int m0, LP(const unsigned char) Bt, int sb, int n0, int ksteps, int lane) {
    for (int k = 0; k < ksteps; ++k) { const v8s af = tr_frag(At, sa, 32 * k, m0, lane); const v8s bf = tr_frag(Bt, sb, 32 * k, n0, lane); acc = MFMA16(bf, af, acc); }
    return acc;
}
constexpr int ST128 = 272, ST64 = 144, ST256 = 528, STV = 80;

constexpr int MIX_UNITS = NB * 32;
constexpr int GLA_TASKS = NB * 4 * 2 * (CTXL / 64 + SEQ / 64);
DEV void gla_prep_loop(int first, int stride, const bf16* S, const float* GT, const float* wg_all, const float* bg_all, bf16* QKS, float* VEC, LP(unsigned char) lds, int tid) {
    constexpr int NCHUNK = CTXL / 64 + SEQ / 64;
    LP(float) LA = (LP(float))lds; LP(float) SEG = (LP(float))(lds + 32768); LP(unsigned char) LRb = lds + 34816; LP(unsigned char) WGb = lds + 39936; LP(float) BG = (LP(float))(lds + 50176);
    for (int i = tid; i < (5120 + 10240) / 4; i += NTHR) ((LP(unsigned))LRb)[i] = 0u;
    SYNC();
    const int lane = tid & 63, wave = tid >> 6, fr = lane & 15, fq = lane >> 4;
    const int j = tid >> 3, c8 = tid & 7, dc = c8 * 16;
    const float qscale = 0.08838834764831845f;
    v4u pq0, pq1, pk0, pk1; v4f plr = (v4f){0.f, 0.f, 0.f, 0.f}, pwg = plr; float pbg = 0.f;
#define GP_ISSUE(tk) do { const int cx_ = (tk) % NCHUNK, r1_ = (tk) / NCHUNK, dir_ = r1_ & 1, h_ = (r1_ >> 1) & 3, b_ = r1_ >> 3; \
        const int seg_ = cx_ >= CTXL / 64, ci_ = seg_ ? cx_ - CTXL / 64 : cx_; \
        const bf16* sr_ = S + (size_t)tok_row(b_, seg_, ci_ * 64 + j, dir_, 0) * EV_PAD; \
        pq0 = *(const v4u*)(sr_ + h_ * 128 + dc); pq1 = *(const v4u*)(sr_ + h_ * 128 + dc + 8); pk0 = *(const v4u*)(sr_ + 512 + h_ * 128 + dc); pk1 = *(const v4u*)(sr_ + 512 + h_ * 128 + dc + 8); \
        pwg = *(const v4f*)(wg_all + (dir_ * 16 + (tid >> 5)) * 512 + h_ * 128 + (tid & 31) * 4); \
        if (tid < 128) pbg = bg_all[dir_ * 512 + h_ * 128 + tid]; \
        if (tid < 256) { const int rr_ = tok_row(b_, seg_, ci_ * 64 + (tid >> 2), dir_, 0); plr = *(const v4f*)(GT + (size_t)rr_ * 256 + dir_ * 16 + (tid & 3) * 4); } } while (0)
    if (first < GLA_TASKS) GP_ISSUE(first);
    for (int task = first; task < GLA_TASKS; task += stride) {
    const int cidx = task % NCHUNK, r1 = task / NCHUNK, dir = r1 & 1, h = (r1 >> 1) & 3, b = r1 >> 3;
    const int seg = cidx >= CTXL / 64, ci = seg ? cidx - CTXL / 64 : cidx;
    const int row = tok_row(b, seg, ci * 64 + j, dir, 0);
    const v4u q0 = pq0, q1 = pq1, k0 = pk0, k1 = pk1;
    { const int m = tid >> 5, d0 = (tid & 31) * 4;
      *(LP(unsigned short))(WGb + (d0 + 0) * 80 + m * 2) = F2BF(pwg.x); *(LP(unsigned short))(WGb + (d0 + 1) * 80 + m * 2) = F2BF(pwg.y);
      *(LP(unsigned short))(WGb + (d0 + 2) * 80 + m * 2) = F2BF(pwg.z); *(LP(unsigned short))(WGb + (d0 + 3) * 80 + m * 2) = F2BF(pwg.w); }
    if (tid < 128) BG[tid] = pbg;
    if (tid < 256) *(LP(v2u))(LRb + (tid >> 2) * 80 + (tid & 3) * 8) = (v2u){PK2(plr.x, plr.y), PK2(plr.z, plr.w)};
    if (task + stride < GLA_TASKS) GP_ISSUE(task + stride);
    SYNC();
    {
        const int tt = wave >> 1; const v8s af = *(LP(const v8s))(LRb + (16 * tt + fr) * 80 + fq * 16);
#pragma unroll
        for (int i = 0; i < 4; ++i) { const int dt = (wave & 1) * 4 + i; const v8s bf = *(LP(const v8s))(WGb + (16 * dt + fr) * 80 + fq * 16);
            v4f z = (v4f){0.f, 0.f, 0.f, 0.f}; z = MFMA16(bf, af, z);
            const v4f bg4 = *(LP(const v4f))(BG + 16 * dt + 4 * fq);
            v4f o; o.x = logsigmoidf(z.x + bg4.x) * 0.0625f; o.y = logsigmoidf(z.y + bg4.y) * 0.0625f; o.z = logsigmoidf(z.z + bg4.z) * 0.0625f; o.w = logsigmoidf(z.w + bg4.w) * 0.0625f;
            *(LP(v4f))(LA + (16 * tt + fr) * 128 + 16 * dt + 4 * fq) = o; }
    }
    SYNC();
    {
        const int d = tid & 127, sg = tid >> 7; float acc = 0.f;
        for (int jj = 0; jj < 16; ++jj) { acc += LA[(sg * 16 + jj) * 128 + d]; LA[(sg * 16 + jj) * 128 + d] = acc; }
        SEG[sg * 128 + d] = acc;
    }
    SYNC();
    {
        const int sgj = j >> 4;
        bf16* orow = QKS + ((size_t)dir * TT + row) * 1024 + h * 128 + dc;
#pragma unroll 1
        for (int g = 0; g < 2; ++g) {
            const v4u qv = g ? q1 : q0, kv = g ? k1 : k0;
            const unsigned qw[4] = {qv.x, qv.y, qv.z, qv.w}, kw[4] = {kv.x, kv.y, kv.z, kv.w};
            unsigned oqs[4], oks[4];
#pragma unroll
            for (int i2 = 0; i2 < 4; ++i2) {
                float vqs[2], vks[2];
#pragma unroll
                for (int e = 0; e < 2; ++e) {
                    const int d = dc + 8 * g + 2 * i2 + e;
                    const float s0 = SEG[d], s1 = SEG[128 + d], s2 = SEG[256 + d];
                    const float pre = (sgj > 0 ? s0 : 0.f) + (sgj > 1 ? s1 : 0.f) + (sgj > 2 ? s2 : 0.f);
                    const float bv = LA[j * 128 + d] + pre;
                    const float bmid = LA[32 * 128 + d] + s0 + s1;
                    const float q = (e ? bfhi(qw[i2]) : bflo(qw[i2])) * qscale, k = e ? bfhi(kw[i2]) : bflo(kw[i2]);
                    const float e1 = EXPF(bv - bmid);
                    vqs[e] = q * e1; vks[e] = k * RCPF(e1);
                    if (j == 63) { const float bend = bv; float* vp = VEC + (size_t)task * 384 + d; vp[0] = EXPF(bmid); vp[128] = EXPF(bend - bmid); vp[256] = EXPF(bend); }
                }
                oqs[i2] = PK2(vqs[0], vqs[1]); oks[i2] = PK2(vks[0], vks[1]);
            }
            *(v4u*)(orow + 8 * g) = (v4u){oqs[0], oqs[1], oqs[2], oqs[3]};
            *(v4u*)(orow + 512 + 8 * g) = (v4u){oks[0], oks[1], oks[2], oks[3]};
        }
    }
    SYNC();
    }
#undef GP_ISSUE
}

DEV void gla_unit(const bf16* S, const bf16* QKS, const float* VEC, bf16* O, int unit, LP(unsigned char) lds, int tid) {
    const int lane = tid & 63, wave = tid >> 6, fr = lane & 15, fq = lane >> 4;
    const int vs = unit & 3, dir = (unit >> 2) & 1, h = (unit >> 3) & 3, b = unit >> 5;
    LP(unsigned char) QS = lds; LP(unsigned char) KS = lds + 17408; LP(unsigned char) QB = lds + 34816;
    LP(unsigned char) VV = lds + 52224; LP(unsigned char) PM = lds + 61440; LP(unsigned char) STT = lds + 70656;
    LP(float) DV = (LP(float))(lds + 88064);
    for (int i = tid; i < 64 * ST128 / 4; i += NTHR) ((LP(unsigned))STT)[i] = 0u;
    v4f sacc[4];
#pragma unroll
    for (int i = 0; i < 4; ++i) sacc[i] = (v4f){0.f, 0.f, 0.f, 0.f};
    const int j = tid >> 3, c8 = tid & 7, dc = c8 * 16;
    const int tt = wave >> 1, vt0 = (wave & 1) * 2;
    const int svt = wave & 3, sdt0 = (wave >> 2) * 4;
    bf16* Od = O + (size_t)dir * TT * 1024;
    constexpr int NCHUNK = CTXL / 64 + SEQ / 64;
    const int task0 = ((b * 4 + h) * 2 + dir) * NCHUNK;
    v4u gq0[2], gq1[2], gk0[2], gk1[2], gvv[2]; v4f gem[4]; v4f gdv = (v4f){0.f, 0.f, 0.f, 0.f};
#define GLA_ISSUE(cx, P_) do { const int seg_ = (cx) >= CTXL / 64, ci_ = seg_ ? (cx) - CTXL / 64 : (cx); \
        const int row_ = tok_row(b, seg_, ci_ * 64 + j, dir, 0); \
        const bf16* qr_ = QKS + ((size_t)dir * TT + row_) * 1024 + h * 128 + dc; \
        gq0[P_] = *(const v4u*)(qr_); gq1[P_] = *(const v4u*)(qr_ + 8); gk0[P_] = *(const v4u*)(qr_ + 512); gk1[P_] = *(const v4u*)(qr_ + 520); \
        gvv[P_] = *(const v4u*)(S + (size_t)row_ * EV_PAD + 1024 + h * 256 + vs * 64 + c8 * 8); } while (0)
#define GLA_ISSUE_V(cx) do { const float* vp_ = VEC + (size_t)(task0 + (cx)) * 384;     \
        _Pragma("unroll") for (int i_ = 0; i_ < 4; ++i_) gem[i_] = *(const v4f*)(vp_ + dc + 4 * i_); \
        if (tid < 64) gdv = *(const v4f*)(vp_ + 128 + tid * 4); } while (0)
    GLA_ISSUE(0, 0); GLA_ISSUE(1, 1); GLA_ISSUE_V(0);
    SYNC();
#pragma unroll 1
    for (int c2 = 0; c2 < NCHUNK; c2 += 2) {
#pragma unroll
    for (int u_ = 0; u_ < 2; ++u_) {
        const int cidx = c2 + u_;
        const int seg = cidx >= CTXL / 64, ci = seg ? cidx - CTXL / 64 : cidx;
        const v4u q0 = gq0[u_], q1 = gq1[u_], k0 = gk0[u_], k1 = gk1[u_], vv = gvv[u_]; const v4f dvv = gdv;
        v4f em[4];
#pragma unroll
        for (int i_ = 0; i_ < 4; ++i_) em[i_] = gem[i_];
        {
            *(LP(v4u))(QS + j * ST128 + dc * 2) = q0; *(LP(v4u))(QS + j * ST128 + dc * 2 + 16) = q1;
            *(LP(v4u))(KS + j * ST128 + dc * 2) = k0; *(LP(v4u))(KS + j * ST128 + dc * 2 + 16) = k1;
            const unsigned qw[8] = {q0.x, q0.y, q0.z, q0.w, q1.x, q1.y, q1.z, q1.w}; unsigned ob[8];
#pragma unroll
            for (int i2 = 0; i2 < 8; ++i2) { const v4f e4 = em[i2 >> 1]; const float ea = (i2 & 1) ? e4.z : e4.x, eb = (i2 & 1) ? e4.w : e4.y; ob[i2] = PK2(bflo(qw[i2]) * ea, bfhi(qw[i2]) * eb); }
            *(LP(v4u))(QB + j * ST128 + dc * 2) = (v4u){ob[0], ob[1], ob[2], ob[3]}; *(LP(v4u))(QB + j * ST128 + dc * 2 + 16) = (v4u){ob[4], ob[5], ob[6], ob[7]};
            *(LP(v4u))(VV + j * ST64 + c8 * 16) = vv;
            if (tid < 64) *(LP(v4f))(DV + tid * 4) = dvv;
        }
        if (cidx + 2 < NCHUNK) GLA_ISSUE(cidx + 2, u_);
        if (cidx + 1 < NCHUNK) GLA_ISSUE_V(cidx + 1);
        SYNC();
        v4f oacc[2]; oacc[0] = (v4f){0.f, 0.f, 0.f, 0.f}; oacc[1] = oacc[0];
        {
#pragma unroll
            for (int i = 0; i < 2; ++i) { const int st = vt0 + i; v4f p = (v4f){0.f, 0.f, 0.f, 0.f};
                if (st <= tt) { p = tile_mma(p, QS, ST128, 16 * tt, KS, ST128, 16 * st, 4, fr, fq);
                    if (st == tt) { if (4 * fq + 0 > fr) p.x = 0.f; if (4 * fq + 1 > fr) p.y = 0.f; if (4 * fq + 2 > fr) p.z = 0.f; if (4 * fq + 3 > fr) p.w = 0.f; } }
                *(LP(v2u))(PM + (16 * tt + fr) * ST64 + (16 * st + 4 * fq) * 2) = (v2u){PK2(p.x, p.y), PK2(p.z, p.w)}; }
#pragma unroll
            for (int k = 0; k < 4; ++k) { const v8s af = *(LP(const v8s))(QB + (16 * tt + fr) * ST128 + fq * 16 + k * 64);
#pragma unroll
                for (int i = 0; i < 2; ++i) { const v8s bf = *(LP(const v8s))(STT + (16 * (vt0 + i) + fr) * ST128 + fq * 16 + k * 64); oacc[i] = MFMA16(bf, af, oacc[i]); } }
        }
        SYNC();
#pragma unroll
        for (int k = 0; k < 2; ++k) { const v8s af = *(LP(const v8s))(PM + (16 * tt + fr) * ST64 + fq * 16 + k * 64);
#pragma unroll
            for (int i = 0; i < 2; ++i) { const v8s bf = tr_frag(VV, ST64, 32 * k, 16 * (vt0 + i), lane); oacc[i] = MFMA16(bf, af, oacc[i]); } }
        { const int orow = tok_row(b, seg, ci * 64 + 16 * tt + fr, dir, 0);
#pragma unroll
          for (int i = 0; i < 2; ++i) *(v2u*)(Od + (size_t)orow * 1024 + h * 256 + vs * 64 + 16 * (vt0 + i) + 4 * fq) = (v2u){PK2(oacc[i].x, oacc[i].y), PK2(oacc[i].z, oacc[i].w)}; }
        {
            v4f tmp[4];
#pragma unroll
            for (int i = 0; i < 4; ++i) tmp[i] = (v4f){0.f, 0.f, 0.f, 0.f};
#pragma unroll
            for (int k = 0; k < 2; ++k) { const v8s af = tr_frag(VV, ST64, 32 * k, 16 * svt, lane);
#pragma unroll
                for (int i = 0; i < 4; ++i) { const v8s bf = tr_frag(KS, ST128, 32 * k, 16 * (sdt0 + i), lane); tmp[i] = MFMA16(bf, af, tmp[i]); } }
#pragma unroll
            for (int i = 0; i < 4; ++i) { const v4f ee = *(LP(const v4f))(DV + 16 * (sdt0 + i) + 4 * fq), de = *(LP(const v4f))(DV + 128 + 16 * (sdt0 + i) + 4 * fq);
                sacc[i] = sacc[i] * de + tmp[i] * ee;
                *(LP(v2u))(STT + (16 * svt + fr) * ST128 + (16 * (sdt0 + i) + 4 * fq) * 2) = (v2u){PK2(sacc[i].x, sacc[i].y), PK2(sacc[i].z, sacc[i].w)}; }
        }
        SYNC();
    }
    }
#undef GLA_ISSUE
#undef GLA_ISSUE_V
}

constexpr int MAT_TASKS = NB * 4 * 2 * (CTXL / 64 + SEQ / 64);
template <int MODE>
DEV void mat_prep_loop(int first, int stride, const bf16* Sqk, int ldqk, int qoff, int koff, float kscale, const float* GT, const float* gate_b, float* GP, float* GPK,
                       const float* ret_log_decay, bf16* PP, float* RS, LP(unsigned char) lds, int tid) {
    constexpr int NCHUNK = CTXL / 64 + SEQ / 64;
    const int lane = tid & 63, wave = tid >> 6, fr = lane & 15, fq = lane >> 4;
    LP(unsigned char) Q = lds; LP(unsigned char) K = lds + 33792; LP(float) AS = (LP(float))(lds + 67584); LP(float) R0 = AS + 64; LP(float) DENP = AS + 128; LP(float) W0 = AS + 384;
    const int j = tid >> 3, c8 = tid & 7, dc = c8 * 32;
    v4u rq[4], rk[4]; float gi = 0.f, gf = 0.f;
#define MP_ISSUE(tk) do { const int cx_ = (tk) % NCHUNK, r1_ = (tk) / NCHUNK, dir_ = r1_ & 1, h_ = (r1_ >> 1) & 3, b_ = r1_ >> 3; \
        const int seg_ = cx_ >= CTXL / 64, ci_ = seg_ ? cx_ - CTXL / 64 : cx_; \
        const bf16* s1_ = Sqk + (size_t)tok_row(b_, seg_, ci_ * 64 + j, dir_, 1) * ldqk; \
        _Pragma("unroll") for (int g_ = 0; g_ < 4; ++g_) { rq[g_] = *(const v4u*)(s1_ + qoff + h_ * 256 + dc + 8 * g_); rk[g_] = *(const v4u*)(s1_ + koff + h_ * 256 + dc + 8 * g_); } \
        if (MODE == 0 && wave == 0) { const int prow_ = tok_row(b_, seg_, ci_ * 64 + lane, dir_, 1); \
            gi = GT[(size_t)prow_ * 256 + 32 + (dir_ * 2 + 0) * 4 + h_]; gf = GT[(size_t)prow_ * 256 + 32 + (dir_ * 2 + 1) * 4 + h_]; } } while (0)
    if (first < MAT_TASKS) MP_ISSUE(first);
    for (int task = first; task < MAT_TASKS; task += stride) {
        const int cidx = task % NCHUNK, r1 = task / NCHUNK, dir = r1 & 1, h = (r1 >> 1) & 3, b = r1 >> 3;
        const int seg = cidx >= CTXL / 64, ci = seg ? cidx - CTXL / 64 : cidx;
#pragma unroll
        for (int g8 = 0; g8 < 4; ++g8) { *(LP(v4u))(Q + j * ST256 + (dc + 8 * g8) * 2) = rq[g8]; *(LP(v4u))(K + j * ST256 + (dc + 8 * g8) * 2) = rk[g8]; }
        if (wave == 0) {
            if (MODE == 0) {
                const int prow = tok_row(b, seg, ci * 64 + lane, dir, 1);
                const float ig = gi + gate_b[(dir * 2 + 0) * 4 + h];
                float bcum = logsigmoidf(gf + gate_b[(dir * 2 + 1) * 4 + h]);
#pragma unroll
                for (int o = 1; o < 64; o <<= 1) { const float t = SHUP(bcum, o); if (lane >= o) bcum += t; }
                const float a_s = ig - bcum;
                float cm = a_s;
#pragma unroll
                for (int o = 1; o < 64; o <<= 1) { const float t = SHUP(cm, o); if (lane >= o) cm = fmaxf(cm, t); }
                *(v4f*)(GP + ((size_t)prow * 8 + dir * 4 + h) * 4) = (v4f){bcum, a_s, cm, 0.f};
                AS[lane] = a_s; R0[lane] = -cm; W0[lane] = EXPF(a_s - RDLANE(cm, 63));
            } else { const float lg = -expf(ret_log_decay[dir * 4 + h]); AS[lane] = -(float)(lane + 1) * lg; R0[lane] = (float)(lane + 1) * lg; }
        }
        if (task + stride < MAT_TASKS) MP_ISSUE(task + stride);
        SYNC();
        const int tt = wave >> 1;
        bf16* pp = PP + (size_t)task * 4096;
        const float rt = R0[16 * tt + fr];
#pragma unroll
        for (int i = 0; i < 2; ++i) { const int st = (wave & 1) * 2 + i; v4f p = (v4f){0.f, 0.f, 0.f, 0.f};
            if (st <= tt) { p = tile_mma(p, Q, ST256, 16 * tt, K, ST256, 16 * st, 8, fr, fq);
                const v4f as4 = *(LP(const v4f))(AS + 16 * st + 4 * fq);
                p.x *= kscale * EXPF(as4.x + rt); p.y *= kscale * EXPF(as4.y + rt); p.z *= kscale * EXPF(as4.z + rt); p.w *= kscale * EXPF(as4.w + rt);
                if (st == tt) { if (4 * fq + 0 > fr) p.x = 0.f; if (4 * fq + 1 > fr) p.y = 0.f; if (4 * fq + 2 > fr) p.z = 0.f; if (4 * fq + 3 > fr) p.w = 0.f; } }
            *(v2u*)(pp + (16 * tt + fr) * 64 + 16 * st + 4 * fq) = (v2u){PK2(p.x, p.y), PK2(p.z, p.w)};
            if (MODE == 0) { float rs = (p.x + p.y) + (p.z + p.w); rs += SHX(rs, 16); rs += SHX(rs, 32); if (fq == 0) DENP[st * 64 + 16 * tt + fr] = rs; } }
        if (MODE == 0 && tid >= 256) {
            const int d = tid - 256; float kw = 0.f;
            for (int jj = 0; jj < 64; ++jj) kw += __uint_as_float(((unsigned)*(LP(const unsigned short))(K + jj * ST256 + d * 2)) << 16) * W0[jj];
            GPK[(size_t)task * 256 + d] = kw; }
        SYNC();
        if (MODE == 0 && tid < 64) RS[(size_t)task * 64 + tid] = (DENP[tid] + DENP[64 + tid]) + (DENP[128 + tid] + DENP[192 + tid]);
        SYNC();
    }
#undef MP_ISSUE
}

template <int MODE>
DEV void mat_unit(const bf16* Sqk, int ldqk, int qoff, int koff, const bf16* Sv, int ldv, int voff, float kscale, const float* GP, const float* GPK, const bf16* PP, const float* RS, bf16* O, int store_ctx,
                  const float* ret_log_decay, int unit, LP(unsigned char) lds, int tid) {
    const int lane = tid & 63, wave = tid >> 6, fr = lane & 15, fq = lane >> 4;
    const int vs = unit & 3, dir = (unit >> 2) & 1, h = (unit >> 3) & 3, b = unit >> 5;
    LP(unsigned char) Q = lds; LP(unsigned char) K = lds + 33792;
    LP(unsigned char) VV = lds + 67584; LP(unsigned char) VW = lds + 76800;
    LP(unsigned char) PM = lds + 86016; LP(unsigned char) STT = lds + 95232;
    LP(float) SCAL = (LP(float))(lds + 137472);
    LP(float) NV = SCAL + 768;
    for (int i = tid; i < 80 * ST256 / 4; i += NTHR) ((LP(unsigned))STT)[i] = 0u;
    if (tid < 256) NV[tid] = 0.f;
    v4f sacc[8];
#pragma unroll
    for (int i = 0; i < 8; ++i) sacc[i] = (v4f){0.f, 0.f, 0.f, 0.f};
    const int j = tid >> 3, c8 = tid & 7, dc = c8 * 32;
    const int tt = wave >> 1, vt0 = (wave & 1) * 2;
    const int svt = wave & 3, sdt0 = (wave >> 2) * 8;
    float m_st = 0.f;
    float lg = 0.f;
    if (MODE == 1) lg = -expf(ret_log_decay[dir * 4 + h]);
    bf16* Od = O + (size_t)(2 + dir) * TT * 1024;
    constexpr int NCHUNK = CTXL / 64 + SEQ / 64;
    v4u rq[2][4], rk[2][4], rv, rp; v4f gpv = (v4f){0.f, 0.f, 0.f, 0.f}; float kwv[2] = {0.f, 0.f}, rsv = 0.f;
    const int task0 = ((b * 4 + h) * 2 + dir) * NCHUNK;
#define MAT_ISSUE(cx, P_) do { const int seg_ = (cx) >= CTXL / 64, ci_ = seg_ ? (cx) - CTXL / 64 : (cx); \
        const int row_ = tok_row(b, seg_, ci_ * 64 + j, dir, 1); \
        const bf16* s1_ = Sqk + (size_t)row_ * ldqk; \
        _Pragma("unroll") for (int g_ = 0; g_ < 4; ++g_) { rq[P_][g_] = *(const v4u*)(s1_ + qoff + h * 256 + dc + 8 * g_); rk[P_][g_] = *(const v4u*)(s1_ + koff + h * 256 + dc + 8 * g_); } \
        if (MODE == 0 && tid < 256) kwv[P_] = GPK[(size_t)(task0 + (cx)) * 256 + tid]; } while (0)
#define MAT_GATE_LOAD(cx) do { if (MODE == 0 && wave == 0) { const int seg_ = (cx) >= CTXL / 64, ci_ = seg_ ? (cx) - CTXL / 64 : (cx); \
        const int prow_ = tok_row(b, seg_, ci_ * 64 + lane, dir, 1); gpv = *(const v4f*)(GP + ((size_t)prow_ * 8 + dir * 4 + h) * 4); rsv = RS[(size_t)(task0 + (cx)) * 64 + lane]; } } while (0)
#define MAT_GATES(cx) do { if (wave == 0) { LP(float) sc_ = SCAL + ((cx) & 1) * 384; \
        if (MODE == 0) { const float bcum_ = gpv.x, a_s_ = gpv.y, Mt_ = fmaxf(m_st, gpv.z); \
            const float M63_ = RDLANE(Mt_, 63), bend_ = RDLANE(bcum_, 63), cm63_ = RDLANE(gpv.z, 63); const float wp_ = EXPF(gpv.z - Mt_); \
            sc_[lane] = wp_; sc_[64 + lane] = EXPF(m_st - Mt_); sc_[128 + lane] = EXPF(a_s_ - M63_); sc_[192 + lane] = EXPF(-(bcum_ + Mt_)); sc_[256 + lane] = rsv * wp_; \
            if (lane == 0) { sc_[320] = EXPF(m_st - M63_); sc_[321] = EXPF(cm63_ - M63_); } \
            m_st = bend_ + M63_; \
        } else { sc_[lane] = 1.0f; sc_[64 + lane] = EXPF((float)(lane + 1) * lg); sc_[128 + lane] = EXPF((float)(63 - lane) * lg); sc_[192 + lane] = 0.f; sc_[256 + lane] = 0.f; \
            if (lane == 0) { sc_[320] = EXPF(64.f * lg); sc_[321] = 0.f; } } } } while (0)
    static_assert(NCHUNK % 2 == 0, "the chunk loop is unrolled by two");
#define MAT_ISSUE_P(cx) do { const int seg_ = (cx) >= CTXL / 64, ci_ = seg_ ? (cx) - CTXL / 64 : (cx); rp = *(const v4u*)(PP + (size_t)(task0 + (cx)) * 4096 + j * 64 + c8 * 8); \
        rv = *(const v4u*)(Sv + (size_t)tok_row(b, seg_, ci_ * 64 + j, dir, 1) * ldv + voff + h * 256 + vs * 64 + c8 * 8); } while (0)
    MAT_ISSUE(0, 0); MAT_ISSUE(1, 1); MAT_ISSUE_P(0); MAT_GATE_LOAD(0);
    MAT_GATES(0);
    MAT_GATE_LOAD(1);
    SYNC();
#pragma unroll 1
    for (int c2 = 0; c2 < NCHUNK; c2 += 2) {
#pragma unroll
    for (int u_ = 0; u_ < 2; ++u_) {
        const int cidx = c2 + u_;
        const int seg = cidx >= CTXL / 64, ci = seg ? cidx - CTXL / 64 : cidx;
        LP(const float) sc = SCAL + u_ * 384;
        const float kw_cur = kwv[u_];
        {
            const float wk = sc[128 + j] * kscale;
#pragma unroll
            for (int g8 = 0; g8 < 4; ++g8) { const int d0 = dc + 8 * g8; *(LP(v4u))(Q + j * ST256 + d0 * 2) = rq[u_][g8]; *(LP(v4u))(K + j * ST256 + d0 * 2) = rk[u_][g8]; }
            const v4u rvv = rv;
            *(LP(v4u))(VV + j * ST64 + c8 * 16) = rvv;
            *(LP(v4u))(VW + j * ST64 + c8 * 16) = (v4u){PK2(bflo(rvv.x) * wk, bfhi(rvv.x) * wk), PK2(bflo(rvv.y) * wk, bfhi(rvv.y) * wk), PK2(bflo(rvv.z) * wk, bfhi(rvv.z) * wk), PK2(bflo(rvv.w) * wk, bfhi(rvv.w) * wk)};
            *(LP(v4u))(PM + j * ST64 + c8 * 16) = rp;
#pragma unroll
            for (int i = 0; i < 8; ++i) *(LP(v2u))(STT + (16 * svt + fr) * ST256 + (16 * (sdt0 + i) + 4 * fq) * 2) = (v2u){PK2(sacc[i].x, sacc[i].y), PK2(sacc[i].z, sacc[i].w)};
        }
        if (cidx + 2 < NCHUNK) MAT_ISSUE(cidx + 2, u_);
        if (cidx + 1 < NCHUNK) MAT_ISSUE_P(cidx + 1);
        SYNC();
        if (cidx + 1 < NCHUNK) { MAT_GATES(cidx + 1); if (cidx + 2 < NCHUNK) MAT_GATE_LOAD(cidx + 2); }
        v4f oP[2], oI[2]; oP[0] = (v4f){0.f, 0.f, 0.f, 0.f}; oP[1] = oP[0]; oI[0] = oP[0]; oI[1] = oP[0];
        v4f qa = (v4f){0.f, 0.f, 0.f, 0.f};
#pragma unroll 1
        for (int k = 0; k < 8; ++k) { const v8s af = *(LP(const v8s))(Q + (16 * tt + fr) * ST256 + fq * 16 + k * 64);
#pragma unroll
            for (int i = 0; i < 2; ++i) { const v8s bf = *(LP(const v8s))(STT + (16 * (vt0 + i) + fr) * ST256 + fq * 16 + k * 64); oI[i] = MFMA16(bf, af, oI[i]); }
            if (MODE == 0) { const v8s bn = *(LP(const v8s))(STT + (64 + fr) * ST256 + fq * 16 + k * 64); qa = MFMA16(bn, af, qa); } }
#pragma unroll
        for (int k = 0; k < 2; ++k) { const v8s af = *(LP(const v8s))(PM + (16 * tt + fr) * ST64 + fq * 16 + k * 64);
#pragma unroll
            for (int i = 0; i < 2; ++i) { const v8s bf = tr_frag(VV, ST64, 32 * k, 16 * (vt0 + i), lane); oP[i] = MFMA16(bf, af, oP[i]); } }
        { const int t = 16 * tt + fr; const float wp = sc[t], wi = sc[64 + t];
          v4f o0 = oP[0] * wp + oI[0] * wi, o1 = oP[1] * wp + oI[1] * wi;
          if (MODE == 0) { const float qn = RDLANE16(qa.x, fr); const float den = sc[256 + t] + wi * qn; const float dv = 1.0f / fmaxf(fabsf(den), sc[192 + t]); o0 = o0 * dv; o1 = o1 * dv; }
          if (seg || store_ctx) { const int orow = tok_row(b, seg, ci * 64 + t, dir, 1);
              *(v2u*)(Od + (size_t)orow * 1024 + h * 256 + vs * 64 + 16 * vt0 + 4 * fq) = (v2u){PK2(o0.x, o0.y), PK2(o0.z, o0.w)};
              *(v2u*)(Od + (size_t)orow * 1024 + h * 256 + vs * 64 + 16 * (vt0 + 1) + 4 * fq) = (v2u){PK2(o1.x, o1.y), PK2(o1.z, o1.w)}; } }
        const float dcy = sc[320];
        {
#pragma unroll
            for (int i = 0; i < 8; ++i) sacc[i] = sacc[i] * dcy;
#pragma unroll 1
            for (int k = 0; k < 2; ++k) { const v8s af = tr_frag(VW, ST64, 32 * k, 16 * svt, lane);
#pragma unroll
                for (int i = 0; i < 8; ++i) { const v8s bf = tr_frag(K, ST256, 32 * k, 16 * (sdt0 + i), lane); sacc[i] = MFMA16(bf, af, sacc[i]); } }
        }
        SYNC();
        if (MODE == 0 && tid < 256) {
            const float nn = dcy * NV[tid] + sc[321] * kw_cur * kscale; NV[tid] = nn;
            *(LP(unsigned short))(STT + 64 * ST256 + tid * 2) = F2BF(nn); }
    }
    }
#undef MAT_ISSUE
#undef MAT_ISSUE_P
#undef MAT_GATE_LOAD
#undef MAT_GATES
    SYNC();
}

constexpr int S5_LDS_PER_WAVE = 1280 + 2 * 10240 + 2 * 6144;
DEV void s5_unit(const bf16* S, int ldS, bf16* O, const float* lam_re, const float* lam_im, const float* log_step, const float* b_re, const float* b_im,
                 const float* c_re, const float* c_im, int unit, LP(unsigned char) wl, int lane) {
    const int fr = lane & 15, fq = lane >> 4;
    const int dir = unit & 1, g = (unit >> 1) & 63, b = unit >> 7;
    LP(unsigned char) UB = wl; LP(unsigned char) XB = wl + 1280; LP(unsigned char) HB = wl + 1280 + 2 * 10240;
    const int pg = (dir * 64 + g);
    const float lr = lam_re[pg * 64 + lane], li = lam_im[pg * 64 + lane], step = expf(log_step[pg]);
    const float mag = expf(lr * step); float sn, cs; sincosf(li * step, &sn, &cs);
    const float ar = mag * cs, ai = mag * sn, den = lr * lr + li * li;
    const float cre = ((ar - 1.0f) * lr + ai * li) / den, cim = (ai * lr - (ar - 1.0f) * li) / den;
    for (int p = 0; p < 16; ++p) { const float br = b_re[(pg * 64 + lane) * 16 + p], bi = b_im[(pg * 64 + lane) * 16 + p];
        *(LP(unsigned short))(XB + lane * 32 + p * 2) = F2BF(cre * br - cim * bi);
        *(LP(unsigned short))(XB + (64 + lane) * 32 + p * 2) = F2BF(cre * bi + cim * br); }
    WAVE_SYNC();
    v8s bfrag[8];
#pragma unroll
    for (int nt = 0; nt < 8; ++nt) { if (fq < 2) bfrag[nt] = *(LP(const v8s))(XB + (16 * nt + fr) * 32 + fq * 16); else bfrag[nt] = (v8s){0, 0, 0, 0, 0, 0, 0, 0}; }
    v8s cfrag[4];
#pragma unroll
    for (int ks = 0; ks < 4; ++ks) { const int n0 = 32 * ks + 8 * fq; const float* src = (n0 < 64 ? c_re : c_im) + ((size_t)pg * 16 + fr) * 64 + (n0 & 63); const float sgn = n0 < 64 ? 1.f : -1.f;
        v8s f;
#pragma unroll
        for (int i = 0; i < 8; ++i) f[i] = (short)F2BF(sgn * src[i]);
        cfrag[ks] = f; }
    WAVE_SYNC();
    for (int i = lane; i < 1280 / 4; i += 64) ((LP(unsigned))UB)[i] = 0u;
    WAVE_SYNC();
    float hr = 0.f, hi = 0.f;
    bf16* Od = O + (size_t)dir * TT * 1024;
    constexpr int NBLK = CTXL / 16 + SEQ / 16;
    constexpr int S5_PF = 8;
    v4u ur[S5_PF];
#pragma unroll
    for (int i_ = 0; i_ < S5_PF; ++i_) ur[i_] = (v4u){0u, 0u, 0u, 0u};
#define S5_LOAD(bx, dst) do { if (lane < 32 && (bx) < NBLK) { const int seg_ = (bx) >= CTXL / 16, bi_ = seg_ ? (bx) - CTXL / 16 : (bx); \
        dst = *(const v4u*)(S + (size_t)tok_row(b, seg_, bi_ * 16 + (lane >> 1), dir, 0) * ldS + g * 16 + (lane & 1) * 8); } } while (0)
#define S5_STAGE_A(bx) do { const v8s uf_ = *(LP(const v8s))(UB + fr * 80 + fq * 16); LP(unsigned char) xb_ = XB + ((bx) & 1) * 10240; \
        _Pragma("unroll") for (int nt = 0; nt < 8; ++nt) { v4f x = (v4f){0.f, 0.f, 0.f, 0.f}; x = MFMA16(uf_, bfrag[nt], x); *(LP(v4f))(xb_ + (16 * nt + fr) * 80 + fq * 16) = x; } } while (0)
#pragma unroll
    for (int i_ = 0; i_ < S5_PF; ++i_) S5_LOAD(i_, ur[i_]);
    if (lane < 32) *(LP(v4u))(UB + (lane >> 1) * 80 + (lane & 1) * 16) = ur[0];
#pragma unroll
    for (int i_ = 0; i_ + 1 < S5_PF; ++i_) ur[i_] = ur[i_ + 1];
    S5_LOAD(S5_PF, ur[S5_PF - 1]);
    WAVE_SYNC();
    S5_STAGE_A(0);
    static_assert(NBLK % S5_PF == 0, "ring unrolling");
#pragma unroll 1
    for (int bx0 = 0; bx0 <= NBLK; bx0 += S5_PF) {
#pragma unroll
    for (int ui = 0; ui < S5_PF; ++ui) {
        const int bx = bx0 + ui; if (bx > NBLK) break;
        WAVE_SYNC();
        v8s hf[4]; float xr[16], xi[16];
        if (bx >= 1) { LP(unsigned char) hb = HB + ((bx - 1) & 1) * 6144;
#pragma unroll
            for (int ks = 0; ks < 4; ++ks) hf[ks] = tr_frag(hb, 48, 32 * ks, 0, lane); }
        if (bx < NBLK) { LP(unsigned char) xb = XB + (bx & 1) * 10240;
#pragma unroll
            for (int q4 = 0; q4 < 4; ++q4) { const v4f a4 = *(LP(const v4f))(xb + lane * 80 + q4 * 16), b4 = *(LP(const v4f))(xb + (64 + lane) * 80 + q4 * 16);
                xr[4 * q4] = a4.x; xr[4 * q4 + 1] = a4.y; xr[4 * q4 + 2] = a4.z; xr[4 * q4 + 3] = a4.w; xi[4 * q4] = b4.x; xi[4 * q4 + 1] = b4.y; xi[4 * q4 + 2] = b4.z; xi[4 * q4 + 3] = b4.w; } }
        if (bx + 1 < NBLK) { if (lane < 32) *(LP(v4u))(UB + (lane >> 1) * 80 + (lane & 1) * 16) = ur[ui]; S5_LOAD(bx + 1 + S5_PF, ur[ui]); }
        WAVE_SYNC();
        if (bx + 1 < NBLK) S5_STAGE_A(bx + 1);
        if (bx >= 1) { const int pb = bx - 1, seg = pb >= CTXL / 16, bi = seg ? pb - CTXL / 16 : pb;
            if (seg) { v4f y = (v4f){0.f, 0.f, 0.f, 0.f};
#pragma unroll
                for (int ks = 0; ks < 4; ++ks) y = MFMA16(cfrag[ks], hf[ks], y);
                const int orow = tok_row(b, seg, bi * 16 + fr, dir, 0);
                *(v2u*)(Od + (size_t)orow * 1024 + g * 16 + 4 * fq) = (v2u){PK2(y.x, y.y), PK2(y.z, y.w)}; } }
        if (bx < NBLK) { LP(unsigned char) hb = HB + (bx & 1) * 6144;
            unsigned pr[8], pi[8];
#pragma unroll
            for (int t2 = 0; t2 < 8; ++t2) {
                const float r0 = ar * hr - ai * hi + xr[2 * t2], i0 = ar * hi + ai * hr + xi[2 * t2];
                hr = ar * r0 - ai * i0 + xr[2 * t2 + 1]; hi = ar * i0 + ai * r0 + xi[2 * t2 + 1];
                pr[t2] = PK2(r0, hr); pi[t2] = PK2(i0, hi); }
            *(LP(v4u))(hb + lane * 48) = (v4u){pr[0], pr[1], pr[2], pr[3]}; *(LP(v4u))(hb + lane * 48 + 16) = (v4u){pr[4], pr[5], pr[6], pr[7]};
            *(LP(v4u))(hb + (64 + lane) * 48) = (v4u){pi[0], pi[1], pi[2], pi[3]}; *(LP(v4u))(hb + (64 + lane) * 48 + 16) = (v4u){pi[4], pi[5], pi[6], pi[7]}; }
    }
    }
#undef S5_STAGE_A
#undef S5_LOAD
}

DEV void conv_prep_row(int r, const bf16* S, bf16* QK2, const float* conv_w, const float* conv_b, int lane) {
    int rm, rp; bool hasm, hasp;
    if (r < TL) { const int b = r >> 12, n = r & (SEQ - 1), gr = n >> 6, col = n & 63, np = col * 64 + gr;
        hasm = np > 0; hasp = np < SEQ - 1; rm = seq_row(b, 1, hasm ? np - 1 : np, 1); rp = seq_row(b, 1, hasp ? np + 1 : np, 1); }
    else { const int n = (r - TL) & (CTXL - 1); hasm = n > 0; hasp = n < CTXL - 1; rm = hasm ? r - 1 : r; rp = hasp ? r + 1 : r; }
    const bf16* s0 = S + (size_t)rm * EV_PAD + 3072; const bf16* s1 = S + (size_t)r * EV_PAD + 3072; const bf16* s2 = S + (size_t)rp * EV_PAD + 3072;
#pragma unroll
    for (int i = 0; i < 4; ++i) { const int c = 8 * lane + 512 * i;
        const v4u a0 = *(const v4u*)(s0 + c), a1 = *(const v4u*)(s1 + c), a2 = *(const v4u*)(s2 + c);
        const unsigned w0[4] = {a0.x, a0.y, a0.z, a0.w}, w1[4] = {a1.x, a1.y, a1.z, a1.w}, w2[4] = {a2.x, a2.y, a2.z, a2.w};
        const float sc = c >= 1024 ? 0.0625f : 1.0f;
        float val[8];
#pragma unroll
        for (int i2 = 0; i2 < 4; ++i2)
#pragma unroll
            for (int e = 0; e < 2; ++e) { const int di = 2 * i2 + e;
                const float um = hasm ? (e ? bfhi(w0[i2]) : bflo(w0[i2])) : 0.f, u0 = e ? bfhi(w1[i2]) : bflo(w1[i2]), up = hasp ? (e ? bfhi(w2[i2]) : bflo(w2[i2])) : 0.f;
                const float pre = conv_b[c + di] + conv_w[c + di] * um + conv_w[2048 + c + di] * u0 + conv_w[4096 + c + di] * up;
                val[di] = pre * RCPF(1.0f + EXPF(-pre)) * sc; }
        *(v4u*)(QK2 + (size_t)r * 2048 + c) = (v4u){PK2(val[0], val[1]), PK2(val[2], val[3]), PK2(val[4], val[5]), PK2(val[6], val[7])}; }
}

DEV v4f ld4bf(const bf16* p) { const v2u w = *(const v2u*)p; return (v4f){bflo(w.x), bfhi(w.x), bflo(w.y), bfhi(w.y)}; }
DEV float wsum(float v) {
#pragma unroll
    for (int o = 1; o < 64; o <<= 1) v += SHX(v, o);
    return v;
}
DEV float grp16_sum(float v) { v += SHX(v, 1); v += SHX(v, 2); v += SHX(v, 4); v += SHX(v, 8); return v; }
DEV void ld16bf(const bf16* p, float (&o)[16]) { const v4u a = *(const v4u*)p, b = *(const v4u*)(p + 8); const unsigned w[8] = {a.x, a.y, a.z, a.w, b.x, b.y, b.z, b.w};
#pragma unroll
    for (int i = 0; i < 8; ++i) { o[2 * i] = bflo(w[i]); o[2 * i + 1] = bfhi(w[i]); } }
DEV void ld16f(const float* p, float (&o)[16]) {
#pragma unroll
    for (int i = 0; i < 4; ++i) { const v4f a = *(const v4f*)(p + 4 * i); o[4 * i] = a.x; o[4 * i + 1] = a.y; o[4 * i + 2] = a.z; o[4 * i + 3] = a.w; } }
DEV void st16bf(bf16* p, const float (&o)[16]) { *(v4u*)p = (v4u){PK2(o[0], o[1]), PK2(o[2], o[3]), PK2(o[4], o[5]), PK2(o[6], o[7])}; *(v4u*)(p + 8) = (v4u){PK2(o[8], o[9]), PK2(o[10], o[11]), PK2(o[12], o[13]), PK2(o[14], o[15])}; }
template <int CENTER, int GATE>
DEV void head_norm16(const bf16* o0, const bf16* o1, const float* gain, const bf16* gs, bf16* dst) {
    float a[16], b2[16], g[16], gt[16];
    ld16bf(o0, a); ld16bf(o1, b2); ld16f(gain, g); ld16bf(gs, gt);
    float s = 0.f;
#pragma unroll
    for (int i = 0; i < 16; ++i) { a[i] += b2[i]; s += a[i]; }
    if (CENTER) { const float mean = grp16_sum(s) * (1.0f / 256.0f);
#pragma unroll
        for (int i = 0; i < 16; ++i) a[i] -= mean; }
    float q = 0.f;
#pragma unroll
    for (int i = 0; i < 16; ++i) q += a[i] * a[i];
    const float rstd = RSQRTF(grp16_sum(q) * (1.0f / 256.0f) + EPS);
#pragma unroll
    for (int i = 0; i < 16; ++i) { const float sg = RCPF(1.0f + EXPF(-gt[i])); const float gate = GATE ? sg : gt[i] * sg; a[i] = gate * (a[i] * rstd * g[i]); }
    st16bf(dst, a);
}
DEV void merge_even_row(int r, const bf16* S, const bf16* O, const float* gla_norm, const float* ml_norm, bf16* HBo, int lane) {
    const bf16* sr = S + (size_t)r * EV_PAD; const int c = 16 * lane; const bf16* ob = O + (size_t)r * 1024 + c; const size_t os = (size_t)TT * 1024;
    head_norm16<0, 0>(ob, ob + os, gla_norm + c, sr + 2048 + c, HBo + (size_t)r * D + c);
    head_norm16<1, 1>(ob + 2 * os, ob + 3 * os, ml_norm + c, sr + 6144 + c, HBo + (size_t)r * D + 1024 + c);
}
DEV float gelu_tanh(float y) { const float z = 0.7978845608028654f * (y + 0.044715f * y * y * y); const float t = 1.0f - 2.0f * RCPF(1.0f + EXPF(2.0f * z)); return 0.5f * y * (1.0f + t); }
DEV void merge_odd_row(int r, const bf16* S, const bf16* O, const float* s5_d, const float* ret_norm, bf16* GBo, bf16* HBo, int lane) {
    const bf16* sr = S + (size_t)r * OD_COLS; const int c = 16 * lane; const bf16* ob = O + (size_t)r * 1024 + c; const size_t os = (size_t)TT * 1024;
    {
        float y0[16], y1[16], dd[16], u[16];
        ld16bf(ob, y0); ld16bf(ob + os, y1); ld16f(s5_d + c, dd); ld16bf(sr + c, u);
#pragma unroll
        for (int i = 0; i < 16; ++i) {
#ifdef NO_S5
            y0[i] = 0.f; y1[i] = 0.f;
#endif
            y0[i] = gelu_tanh(y0[i] + y1[i] + dd[i] * u[i]); }
        st16bf(GBo + (size_t)r * 1024 + c, y0);
    }
    head_norm16<1, 0>(ob + 2 * os, ob + 3 * os, ret_norm + c, sr + 4096 + c, HBo + (size_t)r * D + 1024 + c);
}

struct EpiGLU {
    static constexpr bool PERM = true, AFTER_DRAIN = false;
    const bf16* G; const float* bias; bf16* O;
    __device__ __forceinline__ void operator()(const pg8::f32x4 (&acc)[2][2][4][2], const pg8::Unit& u, int wr, int wc, int fr, int fq) const {
        const int row0 = u.pm * 256 + wr * 64 + fr, col0 = u.pn * 256 + wc * 32 + 8 * fq;
#pragma unroll
        for (int ai = 0; ai < 2; ++ai)
#pragma unroll
            for (int m = 0; m < 4; ++m) { const size_t row = (size_t)(row0 + ai * 128 + m * 16);
#pragma unroll
                for (int bj = 0; bj < 2; ++bj) { const int col = col0 + bj * 128;
                    const v4u gw = *(const v4u*)(G + row * 1024 + col); const pg8::f32x4 b0 = *(const pg8::f32x4*)(bias + col), b1 = *(const pg8::f32x4*)(bias + col + 4);
                    const pg8::f32x4 v0 = acc[ai][bj][m][0] + b0, v1 = acc[ai][bj][m][1] + b1;
                    v4u w; w.x = pk2(bflo(gw.x) * fast_sigmoid(v0[0]), bfhi(gw.x) * fast_sigmoid(v0[1])); w.y = pk2(bflo(gw.y) * fast_sigmoid(v0[2]), bfhi(gw.y) * fast_sigmoid(v0[3]));
                    w.z = pk2(bflo(gw.z) * fast_sigmoid(v1[0]), bfhi(gw.z) * fast_sigmoid(v1[1])); w.w = pk2(bflo(gw.w) * fast_sigmoid(v1[2]), bfhi(gw.w) * fast_sigmoid(v1[3]));
                    *(v4u*)(O + row * D + col) = w; } }
    }
};

__device__ __forceinline__ void mixer_phases(const Args& a, unsigned char* ws, LAS unsigned char* lds, const XcdBarrier& bar, int layer, int G, int gw, int ngw, int tid, int lane, int wave) {
#define HB ((bf16*)wsp(ws, WS_HB))
#define S ((bf16*)wsp(ws, WS_S))
#define GT ((float*)wsp(ws, WS_GT))
#define O ((bf16*)wsp(ws, WS_O))
#define GB ((bf16*)wsp(ws, WS_GB))
#define Y ((bf16*)wsp(ws, WS_Y))
    const int ldS = layer == 0 ? EV_PAD : OD_COLS;
    { pg8::Gemm g{HB, (const bf16*)(wsp(ws, (layer == 0 ? WS_WIN_EV : WS_WIN_OD))), TT, ldS, D}; pg8::StaticOrder So; So.init(TT, ldS, G, (int)blockIdx.x);
      EpiS E{S, ldS, GT, layer == 0 ? 28 : -1};
      pg8::gemm_phase<EpiS, pg8::StaticOrder, true, true>(lds, g, So, E); }
    XBAR();
#define QK2 ((bf16*)wsp(ws, WS_QK2))
#define GP ((float*)wsp(ws, WS_GP))
#define QKS ((bf16*)wsp(ws, WS_QKS))
#define GPK ((float*)wsp(ws, WS_GPK))
#define PP ((bf16*)wsp(ws, WS_PP))
#define RS ((float*)wsp(ws, WS_RS))
#define VEC ((float*)wsp(ws, WS_VEC))
    { int t2 = threadIdx.x; asm volatile("" : "+v"(t2)); tid = t2; lane = t2 & 63; wave = __builtin_amdgcn_readfirstlane(t2 >> 6); gw = blockIdx.x * NWAVES + wave; }
    if (layer == 0) {
        { const bf16* s_ = S; bf16* qk_ = QK2; const float* cw_ = ARG(16); const float* cb_ = ARG(17); for (int r = gw; r < TT; r += ngw) conv_prep_row(r, s_, qk_, cw_, cb_, lane); }
        { int t2 = threadIdx.x; asm volatile("" : "+v"(t2)); gla_prep_loop((int)blockIdx.x, G, S, GT, ARG(13), ARG(14), QKS, VEC, lds, t2); }
        XBAR();
        { int t2 = threadIdx.x; asm volatile("" : "+v"(t2)); mat_prep_loop<0>((int)blockIdx.x, G, QK2, 2048, 0, 1024, 1.0f, GT, ARG(18), GP, GPK, nullptr, PP, RS, lds, t2); }
        XBAR();
    } else {
        { int t2 = threadIdx.x; asm volatile("" : "+v"(t2)); mat_prep_loop<1>((int)blockIdx.x, G, S, OD_COLS, 1024, 2048, 0.0625f, nullptr, nullptr, nullptr, nullptr, ARG(32), PP, RS, lds, t2); }
        XBAR();
    }
    { int t2 = threadIdx.x; asm volatile("" : "+v"(t2)); tid = t2; lane = t2 & 63; wave = __builtin_amdgcn_readfirstlane(t2 >> 6); }
#ifndef SCAN_REPS
#define SCAN_REPS 1
#endif
#pragma unroll 1
    for (int rep = 0; rep < SCAN_REPS; ++rep) {
#define UNIT_OF(w) (NB == 4 ? (((((w) & 7) * 4 + (((w) >> 3) & 15) / 4) << 2) | ((((w) >> 3) & 15) & 3)) : (w))
    if (layer == 0) {
#ifdef SPLIT_L0
        for (int it = blockIdx.x; it < MIX_UNITS; it += G) gla_unit(S, QKS, VEC, O, UNIT_OF(it), lds, tid);
        XBAR();
        for (int it = blockIdx.x; it < 2 * MIX_UNITS; it += G) if (it >= MIX_UNITS) mat_unit<0>(QK2, 2048, 0, 1024, S, EV_PAD, 5120, 1.0f, GP, GPK, PP, RS, O, 1, nullptr, UNIT_OF(it - MIX_UNITS), lds, tid);
        if (false)
#endif
        for (int it = blockIdx.x; it < 2 * MIX_UNITS; it += G) {
            if (it < MIX_UNITS) {
#ifndef REP_GLA
#define REP_GLA 1
#endif
#pragma unroll 1
                for (int r_ = 0; r_ < REP_GLA; ++r_) gla_unit(S, QKS, VEC, O, UNIT_OF(it), lds, tid);
                if (DEFER && G >= 2 * MIX_UNITS) convert_tiles(a, ws, 1, (int)blockIdx.x * NWAVES + wave, MIX_UNITS * NWAVES, lane);
            } else {
#ifndef REP_ML
#define REP_ML 1
#endif
#pragma unroll 1
                for (int r_ = 0; r_ < REP_ML; ++r_) mat_unit<0>(QK2, 2048, 0, 1024, S, EV_PAD, 5120, 1.0f, GP, GPK, PP, RS, O, 1, nullptr, UNIT_OF(it - MIX_UNITS), lds, tid);
            }
        }
        if (DEFER && G < 2 * MIX_UNITS) convert_tiles(a, ws, 1, (int)blockIdx.x * NWAVES + wave, G * NWAVES, lane);
    } else {
        const int s5_first = G >= 2 * MIX_UNITS ? MIX_UNITS : 0, s5_wgs = G - s5_first;
#ifndef REP_RET
#define REP_RET 1
#endif
#ifndef REP_S5
#define REP_S5 1
#endif
#pragma unroll 1
        for (int r_ = 0; r_ < REP_RET; ++r_)
        for (int u = blockIdx.x; u < MIX_UNITS; u += G)
            mat_unit<1>(S, OD_COLS, 1024, 2048, S, OD_COLS, 3072, 0.0625f, nullptr, nullptr, PP, RS, O, 0, ARG(32), UNIT_OF(u), lds, tid);
        if (DEFER && rep == 0 && (int)blockIdx.x >= s5_first && wave >= 4) convert_tiles(a, ws, 2, ((int)blockIdx.x - s5_first) * 4 + (wave - 4), 4 * s5_wgs, lane);
#pragma unroll 1
        for (int r_ = 0; r_ < REP_S5; ++r_)
        if ((int)blockIdx.x >= s5_first && wave < 4) { for (int su = ((int)blockIdx.x - s5_first) * 4 + wave; su < NB * 128; su += 4 * s5_wgs)
            s5_unit(S, OD_COLS, O, ARG(22), ARG(23), ARG(24), ARG(25), ARG(26), ARG(27), ARG(28), su, lds + wave * S5_LDS_PER_WAVE, lane); }
    }
    }
    XBAR();
    { int t2 = threadIdx.x; asm volatile("" : "+v"(t2)); tid = t2; lane = t2 & 63; wave = __builtin_amdgcn_readfirstlane(t2 >> 6); gw = blockIdx.x * NWAVES + wave; }
#ifndef NO_MERGE
    if (layer == 0) { const bf16* s_ = S; const bf16* o_ = O; const float* n0 = ARG(15); const float* n1 = ARG(19); bf16* hb_ = HB; for (int r = gw; r < TT; r += ngw) merge_even_row(r, s_, o_, n0, n1, hb_, lane); }
    else { const bf16* s_ = S; const bf16* o_ = O; const float* n0 = ARG(29); const float* n1 = ARG(33); bf16* gb_ = GB; bf16* hb_ = HB; for (int r = gw; r < TL; r += ngw) merge_odd_row(r, s_, o_, n0, n1, gb_, hb_, lane); }
#endif
    XBAR();
    const int Mo = layer == 0 ? TT : TL;
    if (layer == 1) {
        pg8::Gemm g{GB, (const bf16*)(wsp(ws, WS_WGLU)), TL, 1024, 1024}; pg8::StaticOrder So; So.init(TL, 1024, G, (int)blockIdx.x);
        EpiGLU E{GB, ARG(31), HB};
        pg8::gemm_phase<EpiGLU, pg8::StaticOrder, true, true>(lds, g, So, E);
        XBAR();
    }
    { pg8::Gemm g{HB, (const bf16*)(wsp(ws, (layer == 0 ? WS_WOUT_EV : WS_WOUT_OD))), Mo, D, D}; pg8::SplitOrder So; So.init(Mo - TL, D, G, (int)blockIdx.x);
      EpiF32 E{Y, (float*)(wsp(ws, WS_YCP))};
      pg8::gemm_phase<EpiF32, pg8::SplitOrder, true, true>(lds, g, So, E); }
    XBAR();
}
#undef HB
#undef S
#undef GT
#undef O
#undef GB
#undef Y
#undef QK2
#undef GP
#undef QKS
#undef GPK
#undef PP
#undef RS
#undef VEC
#undef UNIT_OF

#ifndef MIXER_ON
#define MIXER_ON 1
#endif
__global__ void __launch_bounds__(NTHR, 2) fwd(Args a) {
    extern __shared__ __attribute__((aligned(16))) unsigned char lds_raw[];
    LAS unsigned char* lds = (LAS unsigned char*)lds_raw;
    const int tid = threadIdx.x, lane = tid & 63, wave = __builtin_amdgcn_readfirstlane(tid >> 6);
    const int G = gridDim.x, gw = blockIdx.x * NWAVES + wave, ngw = G * NWAVES;
    unsigned char* ws = a.ws;
    if (tid < 16) ((LAS unsigned*)(lds + MISC_OFF))[tid] = 0u;
    __syncthreads();
#ifdef PROBE_A
    if (blockIdx.x == 0 && tid == 0) { volatile LAS unsigned* M_ = (volatile LAS unsigned*)(lds + MISC_OFF); const unsigned lo_ = (unsigned)__builtin_amdgcn_s_memrealtime(); if (PROBE_A == 0) M_[6] = lo_; if (PROBE_B == 0) M_[8] = lo_; }
#endif
    XcdBarrier bar = xcd_barrier_post((unsigned*)(wsp(ws, WS_CTL)), (volatile LAS unsigned*)(lds + MISC_OFF));

#ifdef NAN_POISON
    {
        v4u q = (v4u){0xffffffffu, 0xffffffffu, 0xffffffffu, 0xffffffffu};
        for (int i = tid; i < (MISC_OFF) / 16; i += NTHR) ((LAS v4u*)lds)[i] = q;
        { v4u* p = (v4u*)(wsp(ws, WS_MOD)); const size_t n = (WS_WGU - WS_MOD) / 16; for (size_t i = (size_t)blockIdx.x * NTHR + tid; i < n; i += (size_t)G * NTHR) p[i] = q; }
        { v4u* p = (v4u*)(wsp(ws, WS_XC)); const size_t n = (WS_END - WS_XC) / 16; for (size_t i = (size_t)blockIdx.x * NTHR + tid; i < n; i += (size_t)G * NTHR) p[i] = q; }
        { v4u* p = (v4u*)a.out; const size_t n = (size_t)TL * D * 4 / 16; for (size_t i = (size_t)blockIdx.x * NTHR + tid; i < n; i += (size_t)G * NTHR) p[i] = q; }
        __syncthreads();
        XBAR();
    }
#endif
#define MOD ((float*)wsp(ws, WS_MOD))
#define MODP ((float*)wsp(ws, WS_MODP))
#define HB ((bf16*)wsp(ws, WS_HB))
#define HID ((bf16*)wsp(ws, WS_HID))
#define Y ((bf16*)wsp(ws, WS_Y))
#define XC ((float*)wsp(ws, WS_XC))

#ifndef REP_PRO
#define REP_PRO 1
#endif
#ifndef REP_GU
#define REP_GU 1
#endif
#ifndef REP_DN
#define REP_DN 1
#endif
#pragma unroll 1
    for (int rep_ = 0; rep_ < REP_PRO; ++rep_) {
        __syncthreads();
        LAS float* stab = (LAS float*)(lds + 1024);
        { const float* cin = ARG(1); const float* cctx = ARG(3);
        for (int i = tid; i < 5 * D; i += NTHR) { const int r = i >> 11, k = i & (D - 1); const float c = r < 4 ? cin[r * D + k] : cctx[k]; stab[i] = c / (1.0f + expf(-c)); } }
        __syncthreads();
        for (int it = gw; it < 2 * MOD_KC * 72; it += ngw) {
            const int l = it / (MOD_KC * 72), rem = it % (MOD_KC * 72), kc = rem / 72, jb = rem % 72; constexpr int KCH = D / MOD_KC;
            const float* W = ARG(4) + ((size_t)l * D + kc * KCH) * (NMOD * D) + jb * 256 + lane * 4;
            f32x4 acc[5];
#pragma unroll
            for (int r = 0; r < 5; ++r) acc[r] = (f32x4){0.f, 0.f, 0.f, 0.f};
            for (int k = 0; k < KCH; k += 8) { f32x4 w[8];
#pragma unroll
                for (int i = 0; i < 8; ++i) w[i] = *(const f32x4*)(W + (size_t)(k + i) * (NMOD * D));
#pragma unroll
                for (int i = 0; i < 8; ++i)
#pragma unroll
                    for (int r = 0; r < 5; ++r) acc[r] += stab[r * D + kc * KCH + k + i] * w[i]; }
            { float* modp = MODP;
#pragma unroll
            for (int r = 0; r < 5; ++r) *(f32x4*)(modp + (((size_t)l * MOD_KC + kc) * 5 + r) * (NMOD * D) + jb * 256 + lane * 4) = acc[r]; }
        }
        convert_tiles(a, ws, 0, gw, ngw, lane);
#ifndef DEFER
#define DEFER 1
#endif
        if (!DEFER) { convert_tiles(a, ws, 1, gw, ngw, lane); convert_tiles(a, ws, 2, gw, ngw, lane); }
        { v4u z = (v4u){0u, 0u, 0u, 0u}; v4u* p = (v4u*)(wsp(ws, WS_WIN_EV) + (size_t)EV_COLS * 2048 * 2); const int n16 = (EV_PAD - EV_COLS) * 2048 * 2 / 16;
          for (int i = blockIdx.x * NTHR + tid; i < n16; i += G * NTHR) p[i] = z; }
    }
    XBAR();
    { const float* bmod = ARG(5); const float* modp = MODP; float* modf = MOD;
    for (int i = blockIdx.x * NTHR + tid; i < 2 * 5 * NMOD * D; i += G * NTHR) {
        const int l = i / (5 * NMOD * D), rem = i % (5 * NMOD * D), r = rem / (NMOD * D), j = rem % (NMOD * D);
        float s = bmod[l * (NMOD * D) + j];
        for (int kc = 0; kc < MOD_KC; ++kc) s += modp[(((size_t)l * MOD_KC + kc) * 5 + r) * (NMOD * D) + j];
        modf[i] = s;
    } }
    XBAR();
#ifndef REP_N0
#define REP_N0 1
#endif
#pragma unroll 1
    for (int rep_ = 0; rep_ < REP_N0; ++rep_)
    { NormP p{}; p.xin_lat = ARG(0); p.xin_ctx = ARG(2); p.xout_lat = a.out; p.xout_ctx = XC; p.y = nullptr; p.h = HB; p.rows_end = TT; p.has_y = 0; p.has_h = 1; p.w = 0.f; p.lp = 0; p.sp = 0; p.ln = 0; p.sn = 0;
      norm_phase(p, MOD, ARG(6), ARG(7), lds, gw, ngw, tid, lane); }
    XBAR();

#pragma unroll 1
    for (int layer = 0; layer < 2; ++layer) {
#pragma unroll 1
        for (int half = 0; half < 2; ++half) {
            const int Mrows = (layer == 1 && half == 1) ? TL : TT;
#if MIXER_ON
            if (half == 1) {
                mixer_phases(a, ws, lds, bar, layer, G, gw, ngw, tid, lane, wave);
                NormP p{}; p.xin_lat = a.out; p.xin_ctx = XC; p.xout_lat = a.out; p.xout_ctx = XC; p.y = Y; p.y_ctx = (const float*)(wsp(ws, WS_YCP)); p.h = HB; p.rows_end = Mrows; p.has_y = 1; p.has_h = 1; p.w = 1.0f; p.lp = layer; p.sp = 1; p.ln = layer; p.sn = 2;
                norm_phase(p, MOD, ARG(6), ARG(7), lds, gw, ngw, tid, lane);
                XBAR();
            }
#endif
            const int sub = half * 2;
#pragma unroll 1
            for (int rep_ = 0; rep_ < REP_GU; ++rep_) { pg8::Gemm g{HB, (const bf16*)(wsp(ws, WS_WGU) + (size_t)(layer * 2 + half) * SZ_WGU), Mrows, 2 * DFF, D}; pg8::StaticOrder S; S.init(Mrows, 2 * DFF, G, (int)blockIdx.x);
              EpiSwiGLU E{HID, DFF};
              pg8::gemm_phase<EpiSwiGLU, pg8::StaticOrder, true, true>(lds, g, S, E);
              if (rep_ + 1 < REP_GU) XBAR(); }
            XBAR();
#pragma unroll 1
            for (int rep_ = 0; rep_ < REP_DN; ++rep_) { pg8::Gemm g{HID, (const bf16*)(wsp(ws, WS_WD) + (size_t)(layer * 2 + half) * SZ_WD), Mrows, D, DFF}; pg8::SplitOrder S; S.init(Mrows - TL, DFF, G, (int)blockIdx.x);
              EpiF32 E{Y, (float*)(wsp(ws, WS_YCP))};
              pg8::gemm_phase<EpiF32, pg8::SplitOrder, true, true>(lds, g, S, E);
              if (rep_ + 1 < REP_DN) XBAR(); }
            XBAR();
            { NormP p{}; const bool first = (layer == 0 && half == 0);
              p.xin_lat = first ? ARG(0) : a.out; p.xin_ctx = first ? ARG(2) : XC; p.xout_lat = a.out; p.xout_ctx = XC; p.y = Y; p.y_ctx = (const float*)(wsp(ws, WS_YCP)); p.h = HB; p.rows_end = Mrows; p.has_y = 1; p.w = 0.5f; p.lp = layer; p.sp = sub;
              if (half == 0) { p.has_h = 1; p.ln = layer; p.sn = MIXER_ON ? 1 : 2; }
              else if (layer == 0) { p.has_h = 1; p.ln = 1; p.sn = 0; }
              else { p.has_h = 0; p.ln = 0; p.sn = 0; }
              norm_phase(p, MOD, ARG(6), ARG(7), lds, gw, ngw, tid, lane); }
            if (!(layer == 1 && half == 1)) XBAR();
        }
    }
#ifdef PROBE_A
    XBAR();
    if (blockIdx.x == 0 && threadIdx.x == 0) { volatile LAS unsigned* M_ = (volatile LAS unsigned*)(lds + MISC_OFF);
        const unsigned ticks = (M_[7] - M_[6]) + (PROBE_B >= 0 ? (M_[9] - M_[8]) : 0u);
        const unsigned long long t0 = __builtin_amdgcn_s_memrealtime();
        while (__builtin_amdgcn_s_memrealtime() - t0 < 8ull * ticks) __builtin_amdgcn_s_sleep(8); }
#endif
}

#undef MOD
#undef MODP
#undef HB
#undef HID
#undef Y
#undef XC
extern "C" void kernel_launch(void* const* d_in, const int* in_sizes, int n_in, void* d_out, int out_size, void* d_ws, size_t ws_size, hipStream_t stream) {
    static int grid = 0;
    if (grid == 0) {
        if (n_in != 34 || out_size != TL * D || ws_size < WS_END) { fprintf(stderr, "kernel_launch: unexpected shapes (n_in %d out %d ws %zu need %zu)\n", n_in, out_size, ws_size, (size_t)WS_END); grid = -1; return; }
        int dev = 0, cus = 0, per_cu = 0;
        if (hipGetDevice(&dev) != hipSuccess || hipDeviceGetAttribute(&cus, hipDeviceAttributeMultiprocessorCount, dev) != hipSuccess) { grid = -1; return; }
        if (hipFuncSetAttribute((const void*)fwd, hipFuncAttributeMaxDynamicSharedMemorySize, LDS_BYTES) != hipSuccess) { fprintf(stderr, "kernel_launch: hipFuncSetAttribute failed\n"); grid = -1; return; }
        if (hipOccupancyMaxActiveBlocksPerMultiprocessor(&per_cu, (const void*)fwd, NTHR, LDS_BYTES) != hipSuccess || per_cu < 1) { fprintf(stderr, "kernel_launch: occupancy query says %d\n", per_cu); }
        (void)hipGetLastError();
        grid = cus;
    }
    if (grid < 0) return;
    if (hipMemsetAsync((char*)d_ws + WS_CTL, 0, CTL_ZERO_BYTES, stream) != hipSuccess) return;
    Args a{};
    for (int i = 0; i < 34; ++i) a.in[i] = (const float*)d_in[i];
    a.out = (float*)d_out; a.ws = (unsigned char*)d_ws;
    hipLaunchKernelGGL(fwd, dim3(grid), dim3(NTHR), LDS_BYTES, stream, a);
}
```

```cpp
#include <hip/hip_runtime.h>
#include <cstdio>
#include <cstdint>
#define MIXER_ON 1

#define XB_TMO      128
#define XB_XCNT(j)  (256  + 64 * (j))
#define XB_XSUB(j)  (1280 + 64 * (j))
#define XB_XGEN(j)  (2304 + 64 * (j))
#define XB_TOP      3328
#define XB_TOPGEN   3392
#define XCD_BAR_WORDS 3456
#define XB_SPIN_CAP (1u << 18)
#define LAS __attribute__((address_space(3)))

__device__ __forceinline__ unsigned xb_ld(unsigned* p)              { return __hip_atomic_load(p, __ATOMIC_RELAXED, __HIP_MEMORY_SCOPE_AGENT); }
__device__ __forceinline__ unsigned xb_add(unsigned* p, unsigned v) { return __hip_atomic_fetch_add(p, v, __ATOMIC_RELAXED, __HIP_MEMORY_SCOPE_AGENT); }
__device__ __forceinline__ unsigned xb_xcc_id() { return (unsigned)__builtin_amdgcn_s_getreg((3 << 11) | 20) & 0xFu; }
#define XB_SPIN(cond, bar) do { unsigned _sp = 0; while (cond) { __builtin_amdgcn_s_sleep(1); \
    if ((++_sp & 255u) == 0u) { if (xb_ld(&(bar)[XB_TMO])) break; if (_sp > XB_SPIN_CAP) { atomicAdd(&(bar)[XB_TMO], 1u); break; } } } } while (0)

struct XcdBarrier {
    unsigned* bar; unsigned x;
    volatile LAS unsigned* st;
};

__device__ __forceinline__ XcdBarrier xcd_barrier_post(unsigned* bar, volatile LAS unsigned* st) {
    XcdBarrier b; b.bar = bar; b.x = xb_xcc_id(); b.st = st;
    if (threadIdx.x == 0) (void)xb_add(&bar[XB_XCNT(b.x)], 1u);
    return b;
}
__device__ __forceinline__ void xcd_barrier_complete(unsigned* bar, unsigned x, unsigned& nloc, unsigned& nx) {
    const unsigned G = gridDim.x * gridDim.y * gridDim.z;
    unsigned sum, cnt, mine, sp = 0u;
    for (;;) {
        sum = 0u; cnt = 0u; mine = 0u;
#pragma unroll
        for (unsigned j = 0; j < 16; ++j) { const unsigned c = xb_ld(&bar[XB_XCNT(j)]); sum += c; cnt += (c > 0u) ? 1u : 0u; mine = (j == x) ? c : mine; }
        if (sum == G) break;
        __builtin_amdgcn_s_sleep(1);
        if ((++sp & 255u) == 0u) { if (xb_ld(&bar[XB_TMO])) break; if (sp > XB_SPIN_CAP) { atomicAdd(&bar[XB_TMO], 1u); break; } }
    }
    nloc = mine > 0u ? mine : 1u; nx = cnt > 0u ? cnt : 1u;
}

__device__ __forceinline__ void xcd_barrier(const XcdBarrier& b) {
    asm volatile("s_waitcnt vmcnt(0)" ::: "memory");
    __syncthreads();
    if (threadIdx.x == 0) {
        unsigned* bar = b.bar;
        unsigned bx = __builtin_amdgcn_readfirstlane(b.x); asm volatile("" : "+s"(bx));
        __builtin_amdgcn_s_waitcnt(0);
        unsigned nloc = b.st[0], nx = b.st[1];
        if (nloc == 0u) { xcd_barrier_complete(bar, bx, nloc, nx); b.st[0] = nloc; b.st[1] = nx; }
        const unsigned old = xb_add(&bar[XB_XSUB(bx)], 1u);
        const unsigned gen = old / nloc;
        if (old + 1u == (gen + 1u) * nloc) {
            __builtin_amdgcn_fence(__ATOMIC_RELEASE, "agent");
            asm volatile("s_waitcnt vmcnt(0)" ::: "memory");
            const unsigned og = xb_add(&bar[XB_TOP], 1u);
            const unsigned tg = og / nx;
            if (og + 1u == (tg + 1u) * nx) xb_add(&bar[XB_TOPGEN], 1u);
            else XB_SPIN(xb_ld(&bar[XB_TOPGEN]) == tg, bar);
            __builtin_amdgcn_fence(__ATOMIC_ACQUIRE, "agent");
            xb_add(&bar[XB_XGEN(bx)], 1u);
            asm volatile("s_waitcnt vmcnt(0)" ::: "memory");
        } else {
            XB_SPIN(xb_ld(&bar[XB_XGEN(bx)]) == gen, bar);
            __builtin_amdgcn_fence(__ATOMIC_ACQUIRE, "agent");
            asm volatile("s_waitcnt vmcnt(0)" ::: "memory");
        }
    }
    __syncthreads();
}

namespace pg8 {
#define PG8_LAS __attribute__((address_space(3)))
typedef unsigned short bf16_t;
typedef short bf16x8 __attribute__((ext_vector_type(8)));
typedef float f32x4 __attribute__((ext_vector_type(4)));
typedef unsigned u32x4 __attribute__((ext_vector_type(4)));
constexpr int BM = 256, BK = 64, HALF = 128, HTB = HALF * BK * 2  , STAGE_BYTES = 8 * HTB, NXCD = 8, WGM = 8;

__host__ __device__ __forceinline__ int lds_byte(int r, int c) { const int st = (r >> 4) * 2 + (c >> 5), rr = r & 15, cc = c & 31, ob = rr * 64 + cc * 2; return st * 1024 + (ob ^ (((ob >> 9) & 1) << 5)); }
__host__ __device__ __forceinline__ void stage_rc(int b, int& R, int& C) { const int st = b / 1024, sb = b % 1024, swz = sb ^ (((sb >> 9) & 1) << 5); R = (st >> 1) * 16 + swz / 64; C = (st & 1) * 32 + (swz % 64) / 2; }
__host__ __device__ __forceinline__ int perm32(int rho) { const int n = rho >> 4, i = rho & 15; return 8 * (i >> 2) + 4 * n + (i & 3); }

struct Unit { int pm, pn, k0, nt, part; };
struct Gemm { const bf16_t* A; const bf16_t* Bt; int M, N, K; };

struct StaticOrder {
    int nM, nN, nwg, G, c;
    __host__ __device__ void init(int M, int N, int G_, int c_) { nM = M / BM; nN = N / BM; nwg = nM * nN; G = G_; c = c_; }
    __host__ __device__ bool next(int i, Unit& u) const {
        const long L = (long)i * G + c; if (L >= nwg) return false;
        int wgid = (int)L; { const int q = nwg / NXCD, r = nwg % NXCD, xcd = wgid % NXCD, off = wgid / NXCD; wgid = (xcd < r ? xcd * (q + 1) : r * (q + 1) + (xcd - r) * q) + off; }
        const int nig = WGM * nN, gid = wgid / nig, fm = gid * WGM, gsz = (nM - fm) < WGM ? (nM - fm) : WGM;
        u.pm = fm + ((wgid % nig) % gsz); u.pn = (wgid % nig) / gsz; u.k0 = 0; u.nt = 0; u.part = -1; return true;
    }
    __device__ __forceinline__ void a_ready(const Unit&) const {}
    __device__ __forceinline__ void done(const Unit&) const {}
};
struct SplitOrder {
    static constexpr int NMF = 64, NN = 8, PARTS = 8, NFULL = NMF * NN;
    int nsplit, ntK, G, c;
    __host__ __device__ void init(int Msplit, int K, int G_, int c_) { nsplit = (Msplit / BM) * NN * PARTS; ntK = K / BK; G = G_; c = c_; }
    __host__ __device__ bool next(int i, Unit& u) const {
        const int L = i * G + c, p = L - NFULL; const bool fullu = L < NFULL;
        const int wgid = (L % NXCD) * (NFULL / NXCD) + L / NXCD, nig = WGM * NN, fm = (wgid / nig) * WGM;
        const int q = p & 7, cu = p >> 3, h = ntK >> 1, ks = ((h * q) >> 3) << 1, ke = ((h * (q + 1)) >> 3) << 1;
        u.pm = fullu ? fm + ((wgid % nig) % WGM) : NMF + (cu >> 3);
        u.pn = fullu ? (wgid % nig) / WGM : (cu & 7);
        u.k0 = fullu ? 0 : ks; u.nt = fullu ? 0 : ke - ks; u.part = fullu ? -1 : q;
        return fullu || p < nsplit;
    }
    __device__ __forceinline__ void a_ready(const Unit&) const {}
    __device__ __forceinline__ void done(const Unit&) const {}
};
__device__ __forceinline__ unsigned cvt_pk_bf16(float lo, float hi) { unsigned r; asm volatile("v_cvt_pk_bf16_f32 %0, %1, %2" : "=v"(r) : "v"(lo), "v"(hi)); return r; }
template <class Epi, class Sched, bool ALIGN_EPI = false, bool SP2 = false>
__device__ __forceinline__ void gemm_phase(PG8_LAS unsigned char* lds, const Gemm g, const Sched& S, const Epi& E) {
    int tid_ = threadIdx.x; asm volatile("" : "+v"(tid_));
    const int tid = tid_, wid = __builtin_amdgcn_readfirstlane(tid >> 6), lane = tid & 63, wr = wid >> 2, wc = wid & 3, fr = lane & 15, fq = lane >> 4;
    const int K = g.K, nt = K / BK;
    unsigned voffA[2], voffB[2];
#pragma unroll
    for (int i = 0; i < 2; ++i) { int R, C; stage_rc(tid * 16 + i * 8192, R, C); const int Rb = Epi::PERM ? ((R & ~31) + perm32(R & 31)) : R;
        voffA[i] = (unsigned)(R * K + C) * 2u; voffB[i] = (unsigned)(Rb * K + C) * 2u; }
    const unsigned kstep = BK * 2;
    const unsigned hstep = (unsigned)HALF * K * 2;
    const unsigned tstep = 2 * hstep;
    const unsigned ldsw = (unsigned)wid * 1024u;
    const int aoff = lds_byte(wr * 64 + fr, fq * 8), boff = lds_byte(wc * 32 + fr, fq * 8);
#define PG8_SA(b, h) (((b) * 2 + (h)) * HTB)
#define PG8_SB(b, h) ((4 + (b) * 2 + (h)) * HTB)
#define PG8_STAGE(bufoff, gbase, voff) do { _Pragma("unroll") for (int _i = 0; _i < 2; ++_i) \
        __builtin_amdgcn_global_load_lds((const unsigned*)((const char*)(gbase) + (voff)[_i]), (PG8_LAS unsigned*)(lds + (bufoff) + ldsw + _i * 8192), 16, 0, 0); } while (0)
#define PG8_LDA(dst, b, h) do { _Pragma("unroll") for (int m = 0; m < 4; ++m) _Pragma("unroll") for (int k = 0; k < 2; ++k) dst[m][k] = *(const PG8_LAS bf16x8*)(lds + PG8_SA(b, h) + aoff + m * 2048 + k * 1024); } while (0)
#define PG8_LDB(dst, b, h) do { _Pragma("unroll") for (int n = 0; n < 2; ++n) _Pragma("unroll") for (int k = 0; k < 2; ++k) dst[n][k] = *(const PG8_LAS bf16x8*)(lds + PG8_SB(b, h) + boff + n * 2048 + k * 1024); } while (0)
#define PG8_MMA(ai, bj, At, Bt) do { __builtin_amdgcn_s_setprio(1); _Pragma("unroll") for (int m = 0; m < 4; ++m) _Pragma("unroll") for (int n = 0; n < 2; ++n) _Pragma("unroll") for (int k = 0; k < 2; ++k) \
        acc[ai][bj][m][n] = __builtin_amdgcn_mfma_f32_16x16x32_bf16(Bt[n][k], At[m][k], acc[ai][bj][m][n], 0, 0, 0); __builtin_amdgcn_s_setprio(0); } while (0)
#define PG8_WAIT_V(n) asm volatile("s_waitcnt vmcnt(" #n ")" ::: "memory")
#define PG8_WAIT_L(n) asm volatile("s_waitcnt lgkmcnt(" #n ")" ::: "memory")
#define PG8_BAR __builtin_amdgcn_s_barrier()
#define PG8_SCHED __builtin_amdgcn_sched_barrier(0)
    Unit cur, nxt; int ui = 0;
    if (!S.next(0, cur)) return;
    f32x4 acc[2][2][4][2];
#pragma unroll
    for (int a = 0; a < 2; ++a)
#pragma unroll
        for (int b = 0; b < 2; ++b)
#pragma unroll
            for (int m = 0; m < 4; ++m)
#pragma unroll
                for (int n = 0; n < 2; ++n) acc[a][b][m][n] = (f32x4){0.f, 0.f, 0.f, 0.f};
    bf16x8 At[4][2], B0[2][2], B1[2][2];
    unsigned cA = (unsigned)cur.pm * tstep + (unsigned)cur.k0 * kstep, cB = (unsigned)cur.pn * tstep + (unsigned)cur.k0 * kstep;
    S.a_ready(cur);
    if constexpr (SP2) {
        PG8_STAGE(PG8_SB(0, 0), (const char*)g.Bt + (size_t)(cB), voffB); PG8_STAGE(PG8_SB(0, 1), (const char*)g.Bt + (size_t)(cB + hstep), voffB); PG8_STAGE(PG8_SA(0, 0), (const char*)g.A + (size_t)(cA), voffA); PG8_STAGE(PG8_SA(0, 1), (const char*)g.A + (size_t)(cA + hstep), voffA);
        if (wr == 1) PG8_BAR;
        PG8_WAIT_V(2); PG8_BAR;
        PG8_STAGE(PG8_SB(1, 0), (const char*)g.Bt + (size_t)(cB + kstep), voffB); PG8_STAGE(PG8_SA(1, 0), (const char*)g.A + (size_t)(cA + kstep), voffA); PG8_STAGE(PG8_SB(1, 1), (const char*)g.Bt + (size_t)(cB + hstep + kstep), voffB);
        PG8_WAIT_V(6); PG8_BAR;
    } else {
        PG8_STAGE(PG8_SB(0, 0), (const char*)g.Bt + (size_t)(cB), voffB); PG8_STAGE(PG8_SA(0, 0), (const char*)g.A + (size_t)(cA), voffA); PG8_STAGE(PG8_SB(0, 1), (const char*)g.Bt + (size_t)(cB + hstep), voffB); PG8_STAGE(PG8_SA(0, 1), (const char*)g.A + (size_t)(cA + hstep), voffA);
        if (wr == 1) PG8_BAR;
        PG8_WAIT_V(4); PG8_BAR;
        PG8_STAGE(PG8_SB(1, 0), (const char*)g.Bt + (size_t)(cB + kstep), voffB); PG8_STAGE(PG8_SA(1, 0), (const char*)g.A + (size_t)(cA + kstep), voffA); PG8_STAGE(PG8_SB(1, 1), (const char*)g.Bt + (size_t)(cB + hstep + kstep), voffB);
        PG8_WAIT_V(6); PG8_BAR;
    }
    for (;;) {
        const bool has_next = S.next(ui + 1, nxt);
        const unsigned nA = has_next ? (unsigned)nxt.pm * tstep + (unsigned)nxt.k0 * kstep : cA, nB = has_next ? (unsigned)nxt.pn * tstep + (unsigned)nxt.k0 * kstep : cB;
        const int unt = cur.nt ? cur.nt : nt;
        for (int t = 0; t < unt; t += 2) {
            const bool last = (t == unt - 2);
            const unsigned a1 = cA + (unsigned)(t + 1) * kstep;
            const unsigned a2 = last ? nA : cA + (unsigned)(t + 2) * kstep, b2 = last ? nB : cB + (unsigned)(t + 2) * kstep;
            const unsigned a3 = a2 + kstep, b3 = b2 + kstep;
            if (last && has_next) S.a_ready(nxt);
            if constexpr (SP2) {
            PG8_LDB(B0, 0, 0); PG8_LDB(B1, 0, 1); PG8_SCHED; PG8_LDA(At, 0, 0); PG8_STAGE(PG8_SA(1, 1), (const char*)g.A + (size_t)(a1 + hstep), voffA);
            PG8_WAIT_V(8); PG8_WAIT_L(0); PG8_BAR; PG8_MMA(0, 0, At, B0); PG8_MMA(0, 1, At, B1); PG8_BAR; PG8_SCHED;
            PG8_LDA(At, 0, 1); PG8_STAGE(PG8_SB(0, 0), (const char*)g.Bt + (size_t)(b2), voffB); PG8_STAGE(PG8_SB(0, 1), (const char*)g.Bt + (size_t)(b2 + hstep), voffB); PG8_STAGE(PG8_SA(0, 0), (const char*)g.A + (size_t)(a2), voffA);
            PG8_WAIT_V(8); PG8_WAIT_L(0); PG8_BAR; PG8_MMA(1, 0, At, B0); PG8_MMA(1, 1, At, B1); PG8_BAR; PG8_SCHED;
            PG8_LDB(B0, 1, 0); PG8_LDB(B1, 1, 1); PG8_SCHED; PG8_LDA(At, 1, 0); PG8_STAGE(PG8_SA(0, 1), (const char*)g.A + (size_t)(a2 + hstep), voffA);
            PG8_WAIT_V(8); PG8_WAIT_L(0); PG8_BAR; PG8_MMA(0, 0, At, B0); PG8_MMA(0, 1, At, B1); PG8_BAR; PG8_SCHED;
            PG8_LDA(At, 1, 1); PG8_STAGE(PG8_SB(1, 0), (const char*)g.Bt + (size_t)(b3), voffB); PG8_STAGE(PG8_SB(1, 1), (const char*)g.Bt + (size_t)(b3 + hstep), voffB); PG8_STAGE(PG8_SA(1, 0), (const char*)g.A + (size_t)(a3), voffA);
            PG8_WAIT_V(8); PG8_WAIT_L(0); PG8_BAR; PG8_MMA(1, 0, At, B0); PG8_MMA(1, 1, At, B1); PG8_BAR; PG8_SCHED;
            } else {
            PG8_LDB(B0, 0, 0); PG8_SCHED; PG8_LDA(At, 0, 0); PG8_STAGE(PG8_SA(1, 1), (const char*)g.A + (size_t)(a1 + hstep), voffA);
            PG8_WAIT_L(8); PG8_BAR; PG8_WAIT_L(0); PG8_MMA(0, 0, At, B0); PG8_BAR; PG8_SCHED;
            PG8_LDB(B1, 0, 1); PG8_STAGE(PG8_SB(0, 0), (const char*)g.Bt + (size_t)(b2), voffB);
            PG8_BAR; PG8_WAIT_L(0); PG8_MMA(0, 1, At, B1); PG8_BAR;
            PG8_LDA(At, 0, 1); PG8_STAGE(PG8_SA(0, 0), (const char*)g.A + (size_t)(a2), voffA);
            PG8_BAR; PG8_WAIT_L(0); PG8_MMA(1, 0, At, B0); PG8_BAR; PG8_SCHED;
            PG8_STAGE(PG8_SB(0, 1), (const char*)g.Bt + (size_t)(b2 + hstep), voffB);
            PG8_WAIT_V(6); PG8_BAR; PG8_MMA(1, 1, At, B1); PG8_BAR;
            PG8_LDB(B0, 1, 0); PG8_SCHED; PG8_LDA(At, 1, 0); PG8_STAGE(PG8_SA(0, 1), (const char*)g.A + (size_t)(a2 + hstep), voffA);
            PG8_WAIT_L(8); PG8_BAR; PG8_WAIT_L(0); PG8_MMA(0, 0, At, B0); PG8_BAR; PG8_SCHED;
            PG8_LDB(B1, 1, 1); PG8_STAGE(PG8_SB(1, 0), (const char*)g.Bt + (size_t)(b3), voffB);
            PG8_BAR; PG8_WAIT_L(0); PG8_MMA(0, 1, At, B1); PG8_BAR;
            PG8_LDA(At, 1, 1); PG8_STAGE(PG8_SA(1, 0), (const char*)g.A + (size_t)(a3), voffA);
            PG8_BAR; PG8_WAIT_L(0); PG8_MMA(1, 0, At, B0); PG8_BAR; PG8_SCHED;
            PG8_STAGE(PG8_SB(1, 1), (const char*)g.Bt + (size_t)(b3 + hstep), voffB);
            PG8_WAIT_V(6); PG8_BAR; PG8_MMA(1, 1, At, B1); PG8_BAR;
            }
        }
        if constexpr (ALIGN_EPI) { if (wr == 0) PG8_BAR; }
        if constexpr (!Epi::AFTER_DRAIN) { int t_ = threadIdx.x; asm volatile("" : "+v"(t_)); const int l_ = t_ & 63, w_ = __builtin_amdgcn_readfirstlane(t_ >> 6);
            E(acc, cur, w_ >> 2, w_ & 3, l_ & 15, l_ >> 4); S.done(cur); }
        if (!has_next) break;
#pragma unroll
        for (int a = 0; a < 2; ++a)
#pragma unroll
            for (int b = 0; b < 2; ++b)
#pragma unroll
                for (int m = 0; m < 4; ++m)
#pragma unroll
                    for (int n = 0; n < 2; ++n) acc[a][b][m][n] = (f32x4){0.f, 0.f, 0.f, 0.f};
        cur = nxt; cA = nA; cB = nB; ++ui;
        if constexpr (ALIGN_EPI) { if (wr == 1) PG8_BAR; }
    }
    PG8_WAIT_V(0);
    if constexpr (!ALIGN_EPI) { if (wr == 0) PG8_BAR; }
    PG8_BAR;
    if constexpr (Epi::AFTER_DRAIN) { E.fused(acc, cur, wr, wc, fr, fq, lds, wid, lane); S.done(cur); }
#undef PG8_SA
#undef PG8_SB
#undef PG8_STAGE
#undef PG8_LDA
#undef PG8_LDB
#undef PG8_MMA
#undef PG8_WAIT_V
#undef PG8_WAIT_L
#undef PG8_BAR
#undef PG8_SCHED
}
}

#define GAS __attribute__((address_space(1)))
typedef unsigned short bf16;
typedef float f32x4 __attribute__((ext_vector_type(4)));
typedef unsigned v4u __attribute__((ext_vector_type(4)));
typedef unsigned v2u __attribute__((ext_vector_type(2)));
constexpr int D = 2048, NB = 4, SEQ = 4096, CTXL = 256, DFF = 5504, NMOD = 9;
constexpr int TL = NB * SEQ, TC = NB * CTXL, TT = TL + TC;
constexpr int MIXH = 1024;
constexpr int EV_COLS = 7216, EV_PAD = 7424, OD_COLS = 5120;
constexpr int NWAVES = 8, NTHR = 512;
constexpr float EPS = 1e-6f;

constexpr size_t MiB = 1u << 20;
constexpr size_t WS_CTL = 0, CTL_ZERO_BYTES = 64 * 1024;
constexpr size_t WS_MOD = 1 * MiB;
constexpr size_t WS_MODP = 2 * MiB;
constexpr int MOD_KC = 16;
constexpr size_t WS_WGU = 16 * MiB;
constexpr size_t SZ_WGU = (size_t)11008 * 2048 * 2;
constexpr size_t WS_WD = WS_WGU + 4 * SZ_WGU;
constexpr size_t SZ_WD = (size_t)2048 * 5504 * 2;
constexpr size_t WS_WIN_EV = WS_WD + 4 * SZ_WD;
constexpr size_t WS_WOUT_EV = WS_WIN_EV + (size_t)EV_PAD * 2048 * 2;
constexpr size_t WS_WIN_OD = WS_WOUT_EV + (size_t)2048 * 2048 * 2;
constexpr size_t WS_WOUT_OD = WS_WIN_OD + (size_t)OD_COLS * 2048 * 2;
constexpr size_t WS_WGLU = WS_WOUT_OD + (size_t)2048 * 2048 * 2;
constexpr size_t WS_XC = WS_WGLU + (size_t)1024 * 1024 * 2;
constexpr size_t WS_HB = WS_XC + (size_t)TC * D * 4;
constexpr size_t WS_R = WS_HB + (size_t)TT * D * 2;
constexpr size_t WS_HID = WS_R;
constexpr size_t WS_Y = WS_R + 183 * MiB;
constexpr size_t WS_S = WS_R;
constexpr size_t WS_GT = WS_R + 247 * MiB;
constexpr size_t WS_GB = WS_R + 264 * MiB;
constexpr size_t WS_O = WS_R + 298 * MiB;
constexpr size_t SZ_O = (size_t)TT * 1024 * 2;
constexpr size_t WS_XL = WS_R + 434 * MiB;
constexpr size_t WS_QK2 = WS_XL + (size_t)TL * D * 2;
constexpr size_t WS_GP = WS_QK2 + (size_t)TT * 2048 * 2;
constexpr size_t WS_QKS = WS_GP + (size_t)TT * 8 * 4 * 4;
constexpr size_t WS_VEC = WS_QKS + (size_t)2 * TT * 1024 * 2;
constexpr size_t WS_GPK = WS_VEC + (size_t)NB * 4 * 2 * 68 * 384 * 4;
constexpr size_t WS_PP = WS_GPK + (size_t)NB * 4 * 2 * 68 * 256 * 4;
constexpr size_t WS_RS = WS_PP + (size_t)NB * 4 * 2 * 68 * 4096 * 2;
constexpr size_t WS_END = WS_RS + (size_t)NB * 4 * 2 * 68 * 64 * 4;
constexpr size_t WS_YCP = WS_R + 320 * MiB;
constexpr int YPARTS = 8;
static_assert(WS_YCP >= WS_Y + (size_t)TT * D * 2 && WS_YCP + (size_t)YPARTS * TC * D * 4 <= WS_XL && WS_O + 4 * SZ_O <= WS_XL, "ws map");
static_assert(WS_HID + (size_t)TT * DFF * 2 <= WS_Y && WS_S + (size_t)TT * EV_PAD * 2 <= WS_GT && WS_GT + (size_t)TT * 256 * 4 <= WS_GB && WS_GB + (size_t)TT * 1024 * 2 <= WS_O, "ws map");
static_assert(WS_Y + (size_t)TT * D * 2 <= WS_O, "ws map");

constexpr int LDS_BYTES = 156 * 1024;
constexpr int MISC_OFF = LDS_BYTES - 64;

struct Args { const float* in[34]; float* out; unsigned char* ws; };
#ifdef PROBE_A
#ifndef PROBE_A1
#define PROBE_A1 PROBE_A
#endif
#ifndef PROBE_B
#define PROBE_B -100
#endif
#ifndef PROBE_B1
#define PROBE_B1 PROBE_B
#endif
#define XBAR() do { xcd_barrier(bar); if (blockIdx.x == 0 && threadIdx.x == 0) { volatile LAS unsigned* M_ = (volatile LAS unsigned*)(lds + MISC_OFF); const unsigned c_ = M_[4]; \
        const unsigned long long t_ = __builtin_amdgcn_s_memrealtime(); const unsigned lo_ = (unsigned)t_; \
        if ((int)c_ == PROBE_A - 1) M_[6] = lo_; if ((int)c_ == PROBE_A1) M_[7] = lo_; if ((int)c_ == PROBE_B - 1) M_[8] = lo_; if ((int)c_ == PROBE_B1) M_[9] = lo_; M_[4] = c_ + 1u; } } while (0)
#else
#define XBAR() xcd_barrier(bar)
#endif
#define ARG(k) ((const float*)(GAS const float*)(a.in[opaque_idx(k)]))
__device__ __forceinline__ unsigned char* wsp(unsigned char* w, size_t off) { asm volatile("" : "+s"(off)); return w + off; }
__device__ __forceinline__ int opaque_idx(int k) { asm volatile("" : "+s"(k)); return k; }

__device__ __forceinline__ unsigned f2bf(float f) { unsigned u = __float_as_uint(f); u += 0x7FFFu + ((u >> 16) & 1u); return u >> 16; }
typedef __bf16 bf16x2_t __attribute__((ext_vector_type(2)));
typedef float f32x2_t __attribute__((ext_vector_type(2)));
__device__ __forceinline__ unsigned pk2(float lo, float hi) { const f32x2_t v = {lo, hi}; const bf16x2_t b = __builtin_convertvector(v, bf16x2_t); return __builtin_bit_cast(unsigned, b); }
__device__ __forceinline__ float bf2f(unsigned short b) { return __uint_as_float(((unsigned)b) << 16); }
__device__ __forceinline__ float wave_sum(float v) {
#pragma unroll
    for (int o = 1; o < 64; o <<= 1) v += __shfl_xor(v, o);
    return v;
}
__device__ __forceinline__ float fast_silu(float g) { return g * __builtin_amdgcn_rcpf(1.0f + __expf(-g)); }
__device__ __forceinline__ float fast_sigmoid(float g) { return __builtin_amdgcn_rcpf(1.0f + __expf(-g)); }

#ifndef DEFER
#define DEFER 2
#endif
struct TJob { const float* src; bf16* dst; int K, N, map; };
constexpr int NT_FFN = 5504, NT_EVIN = 32 * 226, NT_SQ = 2048, NT_ODIN = 32 * 160, NT_GLU = 512;
constexpr int NT_SET0 = 6 * NT_FFN + NT_EVIN + NT_SQ + NT_ODIN + NT_SQ + NT_GLU, NT_SET1 = 3 * NT_FFN, NT_SET2 = 3 * NT_FFN;
__device__ __forceinline__ void transpose_tile(const TJob& j, int tl, int lane) {
    const int nblk = (j.N + 31) / 32, kb = tl / nblk, nb = tl % nblk, k0 = 64 * kb, n0 = 32 * nb;
    const int kb8 = lane >> 3, nb4 = lane & 7, n = n0 + 4 * nb4;
    int drow0;
    if (j.map == 0) drow0 = n0;
    else if (j.map == 1) drow0 = (n0 / 128) * 256 + (n0 % 128);
    else if (j.map == 2) drow0 = (n0 / 128) * 256 + (n0 % 128) + 128;
    else drow0 = (nb < 96) ? n0 : (nb == 96 ? 7168 : (nb < 225 ? n0 - 32 : 7200));
    if (n < j.N) {
        const float* s = j.src + (size_t)(k0 + 8 * kb8) * j.N + n;
        f32x4 v[8];
#pragma unroll
        for (int i = 0; i < 8; ++i) v[i] = *(const f32x4*)(s + (size_t)i * j.N);
        bf16* d = j.dst + (size_t)(drow0 + 4 * nb4) * j.K + k0 + 8 * kb8;
#pragma unroll
        for (int e = 0; e < 4; ++e) { v4u o; o.x = pk2(v[0][e], v[1][e]); o.y = pk2(v[2][e], v[3][e]); o.z = pk2(v[4][e], v[5][e]); o.w = pk2(v[6][e], v[7][e]);
            *(v4u*)(d + (size_t)e * j.K) = o; }
    }
}

__device__ __forceinline__ void transpose_tile2(const TJob& j, int tl0, int tl1, int lane) {
    const int nblk = (j.N + 31) / 32; const int kb8 = lane >> 3, nb4 = lane & 7;
    f32x4 v[2][8]; int drow[2], k0s[2]; bool ok[2];
#pragma unroll
    for (int u = 0; u < 2; ++u) { const int tl = u ? tl1 : tl0; const int kb = tl / nblk, nb = tl % nblk, k0 = 64 * kb, n0 = 32 * nb, n = n0 + 4 * nb4;
        int drow0;
        if (j.map == 0) drow0 = n0;
        else if (j.map == 1) drow0 = (n0 / 128) * 256 + (n0 % 128);
        else if (j.map == 2) drow0 = (n0 / 128) * 256 + (n0 % 128) + 128;
        else drow0 = (nb < 96) ? n0 : (nb == 96 ? 7168 : (nb < 225 ? n0 - 32 : 7200));
        drow[u] = drow0; k0s[u] = k0; ok[u] = n < j.N;
        if (ok[u]) { const float* s = j.src + (size_t)(k0 + 8 * kb8) * j.N + n;
#pragma unroll
            for (int i = 0; i < 8; ++i) v[u][i] = *(const f32x4*)(s + (size_t)i * j.N); } }
#pragma unroll
    for (int u = 0; u < 2; ++u) if (ok[u]) { bf16* d = j.dst + (size_t)(drow[u] + 4 * nb4) * j.K + k0s[u] + 8 * kb8;
#pragma unroll
        for (int e = 0; e < 4; ++e) { v4u o; o.x = pk2(v[u][0][e], v[u][1][e]); o.y = pk2(v[u][2][e], v[u][3][e]); o.z = pk2(v[u][4][e], v[u][5][e]); o.w = pk2(v[u][6][e], v[u][7][e]);
            *(v4u*)(d + (size_t)e * j.K) = o; } }
}
__device__ __forceinline__ TJob make_job(const Args& a, unsigned char* ws, int id) {
    TJob j;
    if (id < 12) { const int li = id / 3, kind = id % 3; const size_t wo = (size_t)li * 2048 * 5504;
        j.src = ARG(8 + kind) + wo;
        if (kind == 2) { j.K = 5504; j.N = 2048; j.map = 0; j.dst = (bf16*)(wsp(ws, WS_WD) + (size_t)li * SZ_WD); }
        else { j.K = 2048; j.N = 5504; j.map = 1 + kind; j.dst = (bf16*)(wsp(ws, WS_WGU) + (size_t)li * SZ_WGU); } }
    else if (id == 12) { j.src = ARG(11); j.K = 2048; j.N = EV_COLS; j.map = 3; j.dst = (bf16*)wsp(ws, WS_WIN_EV); }
    else if (id == 13) { j.src = ARG(12); j.K = 2048; j.N = 2048; j.map = 0; j.dst = (bf16*)wsp(ws, WS_WOUT_EV); }
    else if (id == 14) { j.src = ARG(20); j.K = 2048; j.N = OD_COLS; j.map = 0; j.dst = (bf16*)wsp(ws, WS_WIN_OD); }
    else if (id == 15) { j.src = ARG(21); j.K = 2048; j.N = 2048; j.map = 0; j.dst = (bf16*)wsp(ws, WS_WOUT_OD); }
    else { j.src = ARG(30); j.K = 1024; j.N = 1024; j.map = 0; j.dst = (bf16*)wsp(ws, WS_WGLU); }
    return j;
}
__device__ __forceinline__ void convert_tiles(const Args& a, unsigned char* ws, int set, int wave_index, int nwaves, int lane) {
    const int njobs = DEFER == 2 ? (set == 0 ? 8 : 3) : (set == 0 ? 11 : 3);
    int start = wave_index;
#pragma unroll 1
    for (int q = 0; q < njobs; ++q) {
        const int id = DEFER == 2 ? (set == 0 ? (q < 3 ? q : q + 9) : 3 * set + q) : (set == 0 ? (q < 3 ? q : (q < 6 ? q + 3 : q + 6)) : (set == 1 ? 3 + q : 9 + q));
        const int nt = id < 12 ? NT_FFN : (id == 12 ? NT_EVIN : (id == 14 ? NT_ODIN : (id == 16 ? NT_GLU : NT_SQ)));
        const TJob j = make_job(a, ws, id);
        int t = start;
#pragma unroll 1
        for (; t + nwaves < nt; t += 2 * nwaves) transpose_tile2(j, t, t + nwaves, lane);
        if (t < nt) { transpose_tile(j, t, lane); t += nwaves; }
        start = t - nt;
    }
}

struct NormP {
    const float* xin_lat; const float* xin_ctx; float* xout_lat; float* xout_ctx; const bf16* y; bf16* h;
    int rows_end; int has_y, has_h; float w;
    const float* y_ctx;
    int lp, sp;
    int ln, sn;
};
__device__ __forceinline__ void norm_phase(const NormP& p, const float* mod, const float* norm_pre, const float* norm_post, LAS unsigned char* lds, int gw, int ngw, int tid, int lane) {
    { int t2 = threadIdx.x; asm volatile("" : "+v"(t2)); tid = t2; lane = t2 & 63; gw = blockIdx.x * NWAVES + __builtin_amdgcn_readfirstlane(t2 >> 6); }
    LAS float* TA = (LAS float*)lds; LAS float* TB = TA + 5 * D; LAS float* TCc = TB + 5 * D;
    for (int i = tid; i < 5 * D; i += NTHR) { const int var = i >> 11, j = i & (D - 1);
        if (p.has_y) TA[i] = p.w * mod[((size_t)p.lp * 5 + var) * (NMOD * D) + (3 * p.sp + 2) * D + j] * norm_post[(p.lp * 3 + p.sp) * D + j];
        if (p.has_h) { TB[i] = norm_pre[(p.ln * 3 + p.sn) * D + j] * (1.0f + mod[((size_t)p.ln * 5 + var) * (NMOD * D) + (3 * p.sn + 1) * D + j]);
                       TCc[i] = mod[((size_t)p.ln * 5 + var) * (NMOD * D) + (3 * p.sn) * D + j]; } }
    __syncthreads();
    for (int r = gw; r < p.rows_end; r += ngw) {
        const int var = r < TL ? (r >> 12) : 4;
        const float* xi = r < TL ? p.xin_lat + (size_t)r * D : p.xin_ctx + (size_t)(r - TL) * D;
        float* xo = r < TL ? p.xout_lat + (size_t)r * D : p.xout_ctx + (size_t)(r - TL) * D;
        f32x4 xv[8];
#pragma unroll
        for (int j = 0; j < 8; ++j) xv[j] = *(const f32x4*)(xi + 4 * lane + 256 * j);
        if (p.has_y) {
            const bool yc = (r >= TL) && p.y_ctx; const float* yr = p.y_ctx + (size_t)(r - TL) * D; f32x4 yv[8]; float s = 0.f;
            if (!yc) { const bf16* yb = p.y + (size_t)r * D;
#pragma unroll
                for (int j = 0; j < 8; ++j) { const v2u w = *(const v2u*)(yb + 4 * lane + 256 * j); yv[j] = (f32x4){__uint_as_float(w.x << 16), __uint_as_float(w.x & 0xffff0000u), __uint_as_float(w.y << 16), __uint_as_float(w.y & 0xffff0000u)}; }
            } else {
#pragma unroll
                for (int j = 0; j < 8; ++j) yv[j] = *(const f32x4*)(yr + 4 * lane + 256 * j);
                for (int q = 1; q < YPARTS; ++q) {
#pragma unroll
                for (int j = 0; j < 8; ++j) yv[j] += *(const f32x4*)(yr + (size_t)q * TC * D + 4 * lane + 256 * j); } }
#pragma unroll
            for (int j = 0; j < 8; ++j) { s += (yv[j].x * yv[j].x + yv[j].y * yv[j].y) + (yv[j].z * yv[j].z + yv[j].w * yv[j].w); }
            const float rstd = 1.0f / sqrtf(wave_sum(s) * (1.0f / D) + EPS);
#pragma unroll
            for (int j = 0; j < 8; ++j) { const f32x4 a = *(const LAS f32x4*)(TA + var * D + 4 * lane + 256 * j); xv[j] = xv[j] + a * (yv[j] * rstd); *(f32x4*)(xo + 4 * lane + 256 * j) = xv[j]; }
        }
        if (p.has_h) {
            float s = 0.f;
#pragma unroll
            for (int j = 0; j < 8; ++j) s += (xv[j].x * xv[j].x + xv[j].y * xv[j].y) + (xv[j].z * xv[j].z + xv[j].w * xv[j].w);
            const float rstd = 1.0f / sqrtf(wave_sum(s) * (1.0f / D) + EPS);
            bf16* hr = p.h + (size_t)r * D;
#pragma unroll
            for (int j = 0; j < 8; ++j) { const f32x4 b = *(const LAS f32x4*)(TB + var * D + 4 * lane + 256 * j), c = *(const LAS f32x4*)(TCc + var * D + 4 * lane + 256 * j);
                const f32x4 o = xv[j] * rstd * b + c; v2u w; w.x = pk2(o.x, o.y); w.y = pk2(o.z, o.w); *(v2u*)(hr + 4 * lane + 256 * j) = w; }
        }
    }
    __syncthreads();
}

struct EpiSwiGLU {
    static constexpr bool PERM = true, AFTER_DRAIN = false;
    bf16* O; int ldc;
    __device__ __forceinline__ void operator()(const pg8::f32x4 (&acc)[2][2][4][2], const pg8::Unit& u, int wr, int wc, int fr, int fq) const {
        const int row0 = u.pm * 256 + wr * 64 + fr, col0 = u.pn * 128 + wc * 32 + 8 * fq;
#pragma unroll
        for (int ai = 0; ai < 2; ++ai)
#pragma unroll
            for (int m = 0; m < 4; ++m) { bf16* rowp = O + (size_t)(row0 + ai * 128 + m * 16) * ldc + col0;
                const pg8::f32x4 g0 = acc[ai][0][m][0], g1 = acc[ai][0][m][1], u0 = acc[ai][1][m][0], u1 = acc[ai][1][m][1];
                v4u w; w.x = pk2(fast_silu(g0[0]) * u0[0], fast_silu(g0[1]) * u0[1]); w.y = pk2(fast_silu(g0[2]) * u0[2], fast_silu(g0[3]) * u0[3]);
                w.z = pk2(fast_silu(g1[0]) * u1[0], fast_silu(g1[1]) * u1[1]); w.w = pk2(fast_silu(g1[2]) * u1[2], fast_silu(g1[3]) * u1[3]);
                *(v4u*)rowp = w; }
    }
};
struct EpiF32 {
    static constexpr bool PERM = true, AFTER_DRAIN = false;
    bf16* C; float* Cs;
    static constexpr int ldc = D;
    __device__ __forceinline__ void operator()(const pg8::f32x4 (&acc)[2][2][4][2], const pg8::Unit& u, int wr, int wc, int fr, int fq) const {
        const int row0 = u.pm * 256 + wr * 64 + fr, col0 = u.pn * 256 + wc * 32 + 8 * fq;
        if (u.part >= 0) {
            float* base = Cs + ((size_t)u.part * TC - (size_t)TL) * D;
#pragma unroll
            for (int ai = 0; ai < 2; ++ai)
#pragma unroll
                for (int m = 0; m < 4; ++m) { float* rowp = base + (size_t)(row0 + ai * 128 + m * 16) * ldc + col0;
#pragma unroll
                    for (int bj = 0; bj < 2; ++bj) { *(pg8::f32x4*)(rowp + bj * 128) = acc[ai][bj][m][0]; *(pg8::f32x4*)(rowp + bj * 128 + 4) = acc[ai][bj][m][1]; } }
        } else {
#pragma unroll
            for (int ai = 0; ai < 2; ++ai)
#pragma unroll
                for (int m = 0; m < 4; ++m) { bf16* rowp = C + (size_t)(row0 + ai * 128 + m * 16) * ldc + col0;
#pragma unroll
                    for (int bj = 0; bj < 2; ++bj) { const pg8::f32x4 v0 = acc[ai][bj][m][0], v1 = acc[ai][bj][m][1];
                        v4u w; w.x = pk2(v0[0], v0[1]); w.y = pk2(v0[2], v0[3]); w.z = pk2(v1[0], v1[1]); w.w = pk2(v1[2], v1[3]);
                        *(v4u*)(rowp + bj * 128) = w; } }
        }
    }
};
struct EpiS {
    static constexpr bool PERM = true, AFTER_DRAIN = false;
    bf16* S; int ldc; float* GT; int gt_pn;
    __device__ __forceinline__ void operator()(const pg8::f32x4 (&acc)[2][2][4][2], const pg8::Unit& u, int wr, int wc, int fr, int fq) const {
        const int row0 = u.pm * 256 + wr * 64 + fr;
        if (u.pn == gt_pn) {
            if (wc < 2) {
#pragma unroll
                for (int ai = 0; ai < 2; ++ai)
#pragma unroll
                    for (int m = 0; m < 4; ++m) { float* rowp = GT + (size_t)(row0 + ai * 128 + m * 16) * 256 + wc * 32 + 8 * fq;
                        *(pg8::f32x4*)rowp = acc[ai][0][m][0]; *(pg8::f32x4*)(rowp + 4) = acc[ai][0][m][1]; }
            }
        } else {
            const int col0 = u.pn * 256 + wc * 32 + 8 * fq;
#pragma unroll
            for (int ai = 0; ai < 2; ++ai)
#pragma unroll
                for (int m = 0; m < 4; ++m) { bf16* rowp = S + (size_t)(row0 + ai * 128 + m * 16) * ldc + col0;
#pragma unroll
                    for (int bj = 0; bj < 2; ++bj) { const pg8::f32x4 v0 = acc[ai][bj][m][0], v1 = acc[ai][bj][m][1];
                        v4u w; w.x = pk2(v0[0], v0[1]); w.y = pk2(v0[2], v0[3]); w.z = pk2(v1[0], v1[1]); w.w = pk2(v1[2], v1[3]);
                        *(v4u*)(rowp + bj * 128) = w; } }
        }
    }
};

#define DEV __device__ __forceinline__
#define LP(T) LAS T*
#define SYNC() do { asm volatile("s_waitcnt lgkmcnt(0)" ::: "memory"); __builtin_amdgcn_s_barrier(); asm volatile("" ::: "memory"); } while (0)
typedef short v8s __attribute__((ext_vector_type(8)));
typedef float v4f __attribute__((ext_vector_type(4)));
#define MFMA16(x, y, c) __builtin_amdgcn_mfma_f32_16x16x32_bf16((x), (y), (c), 0, 0, 0)
#define SHX(v, m) __shfl_xor((v), (m))
#define SHUP(v, d) __shfl_up((v), (d))
#define SHIDX(v, l) __shfl((v), (l))
#define EXPF(x) __expf(x)
#define LOGF(x) __logf(x)
#define RCPF(x) __builtin_amdgcn_rcpf(x)
#define RSQRTF(x) (1.0f / sqrtf(x))
#define PK2(lo, hi) pk2((lo), (hi))
#define F2BF(x) ((unsigned short)f2bf(x))
#define WAVE_SYNC() asm volatile("s_waitcnt lgkmcnt(0)" ::: "memory")
typedef short v4s __attribute__((ext_vector_type(4)));
#define LDS_TR16(p) __builtin_amdgcn_ds_read_tr16_b64_v4i16((LAS v4s*)(p))
#define RDLANE(v, l) __int_as_float(__builtin_amdgcn_readlane(__float_as_int(v), (l)))
#define RDLANE16(v, l) __shfl((v), (l))
#define SIB_SYNC_IMPL(p, target) do { __hip_atomic_fetch_add((p), 1u, __ATOMIC_RELAXED, __HIP_MEMORY_SCOPE_AGENT); unsigned sp_ = 0; \
    while (__hip_atomic_load((p), __ATOMIC_RELAXED, __HIP_MEMORY_SCOPE_AGENT) < (target) && ++sp_ < 100000u) __builtin_amdgcn_s_sleep(2); } while (0)

DEV int seq_row(int b, int seg, int np, int cm) {
    if (!seg) return TL + b * CTXL + np;
    const int n = cm ? ((np & 63) * 64 + (np >> 6)) : np;
    return b * SEQ + n;
}
DEV int tok_row(int b, int seg, int pos, int dir, int cm) {
    const int len = seg ? SEQ : CTXL;
    return seq_row(b, seg, dir ? len - 1 - pos : pos, cm);
}
DEV float bflo(unsigned u) { return __uint_as_float(u << 16); }
DEV float bfhi(unsigned u) { return __uint_as_float(u & 0xffff0000u); }
DEV float logsigmoidf(float z) { return fminf(z, 0.f) - LOGF(1.0f + EXPF(-fabsf(z))); }
DEV v4f tile_mma(v4f acc, LP(const unsigned char) A, int sa, int m0, LP(const unsigned char) B, int sb, int n0, int ksteps, int fr, int fq) {
    LP(const unsigned char) ap = A + (m0 + fr) * sa + fq * 16;
    LP(const unsigned char) bp = B + (n0 + fr) * sb + fq * 16;
    for (int k = 0; k < ksteps; ++k) {
        const v8s af = *(LP(const v8s))(ap + k * 64);
        const v8s bf = *(LP(const v8s))(bp + k * 64);
        acc = MFMA16(bf, af, acc);
    }
    return acc;
}
DEV v8s tr_frag(LP(const unsigned char) T, int st, int k0, int n0, int lane) {
    const int l16 = lane & 15, fq = lane >> 4;
    LP(const unsigned char) p = T + (k0 + 8 * fq + (l16 >> 2)) * st + (n0 + 4 * (l16 & 3)) * 2;
    const v4s a = LDS_TR16(p), b = LDS_TR16(p + 4 * st);
    return (v8s){a.x, a.y, a.z, a.w, b.x, b.y, b.z, b.w};
}
DEV v4f tile_mma_nt(v4f acc, LP(const unsigned char) A, int sa, int m0, LP(const unsigned char) Bt, int sb, int n0, int ksteps, int lane) {
    const int fr = lane & 15, fq = lane >> 4;
    for (int k = 0; k < ksteps; ++k) { const v8s af = *(LP(const v8s))(A + (m0 + fr) * sa + fq * 16 + k * 64); const v8s bf = tr_frag(Bt, sb, 32 * k, n0, lane); acc = MFMA16(bf, af, acc); }
    return acc;
}
DEV v4f tile_mma_tt(v4f acc, LP(const unsigned char) At, int sa, int m0, LP(const unsigned char) Bt, int sb, int n0, int ksteps, int lane) {
    for (int k = 0; k < ksteps; ++k) { const v8s af = tr_frag(At, sa, 32 * k, m0, lane); const v8s bf = tr_frag(Bt, sb, 32 * k, n0, lane); acc = MFMA16(bf, af, acc); }
    return acc;
}
constexpr int ST128 = 272, ST64 = 144, ST256 = 528, STV = 80;
DEV void sibling_sync(unsigned* sib, unsigned target, int tid) {
#ifdef SIB_SYNC_IMPL
    if (sib) { if (tid == 0) SIB_SYNC_IMPL(sib, target); SYNC(); }
#endif
}

constexpr int MIX_UNITS = NB * 32;
constexpr int GLA_TASKS = NB * 4 * 2 * (CTXL / 64 + SEQ / 64);
DEV void gla_prep_loop(int first, int stride, const bf16* S, const float* GT, const float* wg_all, const float* bg_all, bf16* QKS, float* VEC, LP(unsigned char) lds, int tid) {
    constexpr int NCHUNK = CTXL / 64 + SEQ / 64;
    LP(float) LA = (LP(float))lds; LP(float) SEG = (LP(float))(lds + 32768); LP(unsigned char) LRb = lds + 34816; LP(unsigned char) WGb = lds + 39936; LP(float) BG = (LP(float))(lds + 50176);
    for (int i = tid; i < (5120 + 10240) / 4; i += NTHR) ((LP(unsigned))LRb)[i] = 0u;
    SYNC();
    const int lane = tid & 63, wave = tid >> 6, fr = lane & 15, fq = lane >> 4;
    const int j = tid >> 3, c8 = tid & 7, dc = c8 * 16;
    const float qscale = 0.08838834764831845f;
    v4u pq0, pq1, pk0, pk1; v4f plr = (v4f){0.f, 0.f, 0.f, 0.f}, pwg = plr; float pbg = 0.f;
#define GP_ISSUE(tk) do { const int cx_ = (tk) % NCHUNK, r1_ = (tk) / NCHUNK, dir_ = r1_ & 1, h_ = (r1_ >> 1) & 3, b_ = r1_ >> 3; \
        const int seg_ = cx_ >= CTXL / 64, ci_ = seg_ ? cx_ - CTXL / 64 : cx_; \
        const bf16* sr_ = S + (size_t)tok_row(b_, seg_, ci_ * 64 + j, dir_, 0) * EV_PAD; \
        pq0 = *(const v4u*)(sr_ + h_ * 128 + dc); pq1 = *(const v4u*)(sr_ + h_ * 128 + dc + 8); pk0 = *(const v4u*)(sr_ + 512 + h_ * 128 + dc); pk1 = *(const v4u*)(sr_ + 512 + h_ * 128 + dc + 8); \
        pwg = *(const v4f*)(wg_all + (dir_ * 16 + (tid >> 5)) * 512 + h_ * 128 + (tid & 31) * 4); \
        if (tid < 128) pbg = bg_all[dir_ * 512 + h_ * 128 + tid]; \
        if (tid < 256) { const int rr_ = tok_row(b_, seg_, ci_ * 64 + (tid >> 2), dir_, 0); plr = *(const v4f*)(GT + (size_t)rr_ * 256 + dir_ * 16 + (tid & 3) * 4); } } while (0)
    if (first < GLA_TASKS) GP_ISSUE(first);
    for (int task = first; task < GLA_TASKS; task += stride) {
    const int cidx = task % NCHUNK, r1 = task / NCHUNK, dir = r1 & 1, h = (r1 >> 1) & 3, b = r1 >> 3;
    const int seg = cidx >= CTXL / 64, ci = seg ? cidx - CTXL / 64 : cidx;
    const int row = tok_row(b, seg, ci * 64 + j, dir, 0);
    const v4u q0 = pq0, q1 = pq1, k0 = pk0, k1 = pk1;
    { const int m = tid >> 5, d0 = (tid & 31) * 4;
      *(LP(unsigned short))(WGb + (d0 + 0) * 80 + m * 2) = F2BF(pwg.x); *(LP(unsigned short))(WGb + (d0 + 1) * 80 + m * 2) = F2BF(pwg.y);
      *(LP(unsigned short))(WGb + (d0 + 2) * 80 + m * 2) = F2BF(pwg.z); *(LP(unsigned short))(WGb + (d0 + 3) * 80 + m * 2) = F2BF(pwg.w); }
    if (tid < 128) BG[tid] = pbg;
    if (tid < 256) *(LP(v2u))(LRb + (tid >> 2) * 80 + (tid & 3) * 8) = (v2u){PK2(plr.x, plr.y), PK2(plr.z, plr.w)};
    if (task + stride < GLA_TASKS) GP_ISSUE(task + stride);
    SYNC();
    {
        const int tt = wave >> 1; const v8s af = *(LP(const v8s))(LRb + (16 * tt + fr) * 80 + fq * 16);
#pragma unroll
        for (int i = 0; i < 4; ++i) { const int dt = (wave & 1) * 4 + i; const v8s bf = *(LP(const v8s))(WGb + (16 * dt + fr) * 80 + fq * 16);
            v4f z = (v4f){0.f, 0.f, 0.f, 0.f}; z = MFMA16(bf, af, z);
            const v4f bg4 = *(LP(const v4f))(BG + 16 * dt + 4 * fq);
            v4f o; o.x = logsigmoidf(z.x + bg4.x) * 0.0625f; o.y = logsigmoidf(z.y + bg4.y) * 0.0625f; o.z = logsigmoidf(z.z + bg4.z) * 0.0625f; o.w = logsigmoidf(z.w + bg4.w) * 0.0625f;
            *(LP(v4f))(LA + (16 * tt + fr) * 128 + 16 * dt + 4 * fq) = o; }
    }
    SYNC();
    {
        const int d = tid & 127, sg = tid >> 7; float acc = 0.f;
        for (int jj = 0; jj < 16; ++jj) { acc += LA[(sg * 16 + jj) * 128 + d]; LA[(sg * 16 + jj) * 128 + d] = acc; }
        SEG[sg * 128 + d] = acc;
    }
    SYNC();
    {
        const int sgj = j >> 4;
        bf16* orow = QKS + ((size_t)dir * TT + row) * 1024 + h * 128 + dc;
#pragma unroll 1
        for (int g = 0; g < 2; ++g) {
            const v4u qv = g ? q1 : q0, kv = g ? k1 : k0;
            const unsigned qw[4] = {qv.x, qv.y, qv.z, qv.w}, kw[4] = {kv.x, kv.y, kv.z, kv.w};
            unsigned oqs[4], oks[4];
#pragma unroll
            for (int i2 = 0; i2 < 4; ++i2) {
                float vqs[2], vks[2];
#pragma unroll
                for (int e = 0; e < 2; ++e) {
                    const int d = dc + 8 * g + 2 * i2 + e;
                    const float s0 = SEG[d], s1 = SEG[128 + d], s2 = SEG[256 + d];
                    const float pre = (sgj > 0 ? s0 : 0.f) + (sgj > 1 ? s1 : 0.f) + (sgj > 2 ? s2 : 0.f);
                    const float bv = LA[j * 128 + d] + pre;
                    const float bmid = LA[32 * 128 + d] + s0 + s1;
                    const float q = (e ? bfhi(qw[i2]) : bflo(qw[i2])) * qscale, k = e ? bfhi(kw[i2]) : bflo(kw[i2]);
                    const float e1 = EXPF(bv - bmid);
                    vqs[e] = q * e1; vks[e] = k * RCPF(e1);
                    if (j == 63) { const float bend = bv; float* vp = VEC + (size_t)task * 384 + d; vp[0] = EXPF(bmid); vp[128] = EXPF(bend - bmid); vp[256] = EXPF(bend); }
                }
                oqs[i2] = PK2(vqs[0], vqs[1]); oks[i2] = PK2(vks[0], vks[1]);
            }
            *(v4u*)(orow + 8 * g) = (v4u){oqs[0], oqs[1], oqs[2], oqs[3]};
            *(v4u*)(orow + 512 + 8 * g) = (v4u){oks[0], oks[1], oks[2], oks[3]};
        }
    }
    SYNC();
    }
#undef GP_ISSUE
}

DEV void gla_unit(const bf16* S, const bf16* QKS, const float* VEC, bf16* O, int unit, LP(unsigned char) lds, int tid, unsigned* sib) {
    const int lane = tid & 63, wave = tid >> 6, fr = lane & 15, fq = lane >> 4;
    const int vs = unit & 3, dir = (unit >> 2) & 1, h = (unit >> 3) & 3, b = unit >> 5;
    LP(unsigned char) QS = lds; LP(unsigned char) KS = lds + 17408; LP(unsigned char) QB = lds + 34816;
    LP(unsigned char) VV = lds + 52224; LP(unsigned char) PM = lds + 61440; LP(unsigned char) STT = lds + 70656;
    LP(float) DV = (LP(float))(lds + 88064);
    for (int i = tid; i < 64 * ST128 / 4; i += NTHR) ((LP(unsigned))STT)[i] = 0u;
    v4f sacc[4];
#pragma unroll
    for (int i = 0; i < 4; ++i) sacc[i] = (v4f){0.f, 0.f, 0.f, 0.f};
    const int j = tid >> 3, c8 = tid & 7, dc = c8 * 16;
    const int tt = wave >> 1, vt0 = (wave & 1) * 2;
    const int svt = wave & 3, sdt0 = (wave >> 2) * 4;
    bf16* Od = O + (size_t)dir * TT * 1024;
    constexpr int NCHUNK = CTXL / 64 + SEQ / 64;
    const int task0 = ((b * 4 + h) * 2 + dir) * NCHUNK;
    v4u gq0[2], gq1[2], gk0[2], gk1[2], gvv[2]; v4f gem[4]; v4f gdv = (v4f){0.f, 0.f, 0.f, 0.f};
#define GLA_ISSUE(cx, P_) do { const int seg_ = (cx) >= CTXL / 64, ci_ = seg_ ? (cx) - CTXL / 64 : (cx); \
        const int row_ = tok_row(b, seg_, ci_ * 64 + j, dir, 0); \
        const bf16* qr_ = QKS + ((size_t)dir * TT + row_) * 1024 + h * 128 + dc; \
        gq0[P_] = *(const v4u*)(qr_); gq1[P_] = *(const v4u*)(qr_ + 8); gk0[P_] = *(const v4u*)(qr_ + 512); gk1[P_] = *(const v4u*)(qr_ + 520); \
        gvv[P_] = *(const v4u*)(S + (size_t)row_ * EV_PAD + 1024 + h * 256 + vs * 64 + c8 * 8); } while (0)
#define GLA_ISSUE_V(cx) do { const float* vp_ = VEC + (size_t)(task0 + (cx)) * 384;     \
        _Pragma("unroll") for (int i_ = 0; i_ < 4; ++i_) gem[i_] = *(const v4f*)(vp_ + dc + 4 * i_); \
        if (tid < 64) gdv = *(const v4f*)(vp_ + 128 + tid * 4); } while (0)
    GLA_ISSUE(0, 0); GLA_ISSUE(1, 1); GLA_ISSUE_V(0);
    SYNC();
#pragma unroll 1
    for (int c2 = 0; c2 < NCHUNK; c2 += 2) {
#pragma unroll
    for (int u_ = 0; u_ < 2; ++u_) {
        const int cidx = c2 + u_;
        const int seg = cidx >= CTXL / 64, ci = seg ? cidx - CTXL / 64 : cidx;
        if (u_ == 0 && (c2 & 3) == 0 && c2 > 0) sibling_sync(sib, (unsigned)(c2 >> 2) * 4u, tid);
        const v4u q0 = gq0[u_], q1 = gq1[u_], k0 = gk0[u_], k1 = gk1[u_], vv = gvv[u_]; const v4f dvv = gdv;
        v4f em[4];
#pragma unroll
        for (int i_ = 0; i_ < 4; ++i_) em[i_] = gem[i_];
        {
            *(LP(v4u))(QS + j * ST128 + dc * 2) = q0; *(LP(v4u))(QS + j * ST128 + dc * 2 + 16) = q1;
            *(LP(v4u))(KS + j * ST128 + dc * 2) = k0; *(LP(v4u))(KS + j * ST128 + dc * 2 + 16) = k1;
            const unsigned qw[8] = {q0.x, q0.y, q0.z, q0.w, q1.x, q1.y, q1.z, q1.w}; unsigned ob[8];
#pragma unroll
            for (int i2 = 0; i2 < 8; ++i2) { const v4f e4 = em[i2 >> 1]; const float ea = (i2 & 1) ? e4.z : e4.x, eb = (i2 & 1) ? e4.w : e4.y; ob[i2] = PK2(bflo(qw[i2]) * ea, bfhi(qw[i2]) * eb); }
            *(LP(v4u))(QB + j * ST128 + dc * 2) = (v4u){ob[0], ob[1], ob[2], ob[3]}; *(LP(v4u))(QB + j * ST128 + dc * 2 + 16) = (v4u){ob[4], ob[5], ob[6], ob[7]};
            *(LP(v4u))(VV + j * ST64 + c8 * 16) = vv;
            if (tid < 64) *(LP(v4f))(DV + tid * 4) = dvv;
        }
        if (cidx + 2 < NCHUNK) GLA_ISSUE(cidx + 2, u_);
        if (cidx + 1 < NCHUNK) GLA_ISSUE_V(cidx + 1);
        SYNC();
        v4f oacc[2]; oacc[0] = (v4f){0.f, 0.f, 0.f, 0.f}; oacc[1] = oacc[0];
        {
#pragma unroll
            for (int i = 0; i < 2; ++i) { const int st = vt0 + i; v4f p = (v4f){0.f, 0.f, 0.f, 0.f};
                if (st <= tt) { p = tile_mma(p, QS, ST128, 16 * tt, KS, ST128, 16 * st, 4, fr, fq);
                    if (st == tt) { if (4 * fq + 0 > fr) p.x = 0.f; if (4 * fq + 1 > fr) p.y = 0.f; if (4 * fq + 2 > fr) p.z = 0.f; if (4 * fq + 3 > fr) p.w = 0.f; } }
                *(LP(v2u))(PM + (16 * tt + fr) * ST64 + (16 * st + 4 * fq) * 2) = (v2u){PK2(p.x, p.y), PK2(p.z, p.w)}; }
#pragma unroll
            for (int k = 0; k < 4; ++k) { const v8s af = *(LP(const v8s))(QB + (16 * tt + fr) * ST128 + fq * 16 + k * 64);
#pragma unroll
                for (int i = 0; i < 2; ++i) { const v8s bf = *(LP(const v8s))(STT + (16 * (vt0 + i) + fr) * ST128 + fq * 16 + k * 64); oacc[i] = MFMA16(bf, af, oacc[i]); } }
        }
        SYNC();
#pragma unroll
        for (int k = 0; k < 2; ++k) { const v8s af = *(LP(const v8s))(PM + (16 * tt + fr) * ST64 + fq * 16 + k * 64);
#pragma unroll
            for (int i = 0; i < 2; ++i) { const v8s bf = tr_frag(VV, ST64, 32 * k, 16 * (vt0 + i), lane); oacc[i] = MFMA16(bf, af, oacc[i]); } }
        { const int orow = tok_row(b, seg, ci * 64 + 16 * tt + fr, dir, 0);
#pragma unroll
          for (int i = 0; i < 2; ++i) *(v2u*)(Od + (size_t)orow * 1024 + h * 256 + vs * 64 + 16 * (vt0 + i) + 4 * fq) = (v2u){PK2(oacc[i].x, oacc[i].y), PK2(oacc[i].z, oacc[i].w)}; }
        {
            v4f tmp[4];
#pragma unroll
            for (int i = 0; i < 4; ++i) tmp[i] = (v4f){0.f, 0.f, 0.f, 0.f};
#pragma unroll
            for (int k = 0; k < 2; ++k) { const v8s af = tr_frag(VV, ST64, 32 * k, 16 * svt, lane);
#pragma unroll
                for (int i = 0; i < 4; ++i) { const v8s bf = tr_frag(KS, ST128, 32 * k, 16 * (sdt0 + i), lane); tmp[i] = MFMA16(bf, af, tmp[i]); } }
#pragma unroll
            for (int i = 0; i < 4; ++i) { const v4f ee = *(LP(const v4f))(DV + 16 * (sdt0 + i) + 4 * fq), de = *(LP(const v4f))(DV + 128 + 16 * (sdt0 + i) + 4 * fq);
                sacc[i] = sacc[i] * de + tmp[i] * ee;
                *(LP(v2u))(STT + (16 * svt + fr) * ST128 + (16 * (sdt0 + i) + 4 * fq) * 2) = (v2u){PK2(sacc[i].x, sacc[i].y), PK2(sacc[i].z, sacc[i].w)}; }
        }
        SYNC();
    }
    }
#undef GLA_ISSUE
#undef GLA_ISSUE_V
}

constexpr int MAT_TASKS = NB * 4 * 2 * (CTXL / 64 + SEQ / 64);
template <int MODE>
DEV void mat_prep_loop(int first, int stride, const bf16* Sqk, int ldqk, int qoff, int koff, float kscale, const float* GT, const float* gate_b, float* GP, float* GPK,
                       const float* ret_log_decay, bf16* PP, float* RS, LP(unsigned char) lds, int tid) {
    constexpr int NCHUNK = CTXL / 64 + SEQ / 64;
    const int lane = tid & 63, wave = tid >> 6, fr = lane & 15, fq = lane >> 4;
    LP(unsigned char) Q = lds; LP(unsigned char) K = lds + 33792; LP(float) AS = (LP(float))(lds + 67584); LP(float) R0 = AS + 64; LP(float) DENP = AS + 128; LP(float) W0 = AS + 384;
    const int j = tid >> 3, c8 = tid & 7, dc = c8 * 32;
    v4u rq[4], rk[4]; float gi = 0.f, gf = 0.f;
#define MP_ISSUE(tk) do { const int cx_ = (tk) % NCHUNK, r1_ = (tk) / NCHUNK, dir_ = r1_ & 1, h_ = (r1_ >> 1) & 3, b_ = r1_ >> 3; \
        const int seg_ = cx_ >= CTXL / 64, ci_ = seg_ ? cx_ - CTXL / 64 : cx_; \
        const bf16* s1_ = Sqk + (size_t)tok_row(b_, seg_, ci_ * 64 + j, dir_, 1) * ldqk; \
        _Pragma("unroll") for (int g_ = 0; g_ < 4; ++g_) { rq[g_] = *(const v4u*)(s1_ + qoff + h_ * 256 + dc + 8 * g_); rk[g_] = *(const v4u*)(s1_ + koff + h_ * 256 + dc + 8 * g_); } \
        if (MODE == 0 && wave == 0) { const int prow_ = tok_row(b_, seg_, ci_ * 64 + lane, dir_, 1); \
            gi = GT[(size_t)prow_ * 256 + 32 + (dir_ * 2 + 0) * 4 + h_]; gf = GT[(size_t)prow_ * 256 + 32 + (dir_ * 2 + 1) * 4 + h_]; } } while (0)
    if (first < MAT_TASKS) MP_ISSUE(first);
    for (int task = first; task < MAT_TASKS; task += stride) {
        const int cidx = task % NCHUNK, r1 = task / NCHUNK, dir = r1 & 1, h = (r1 >> 1) & 3, b = r1 >> 3;
        const int seg = cidx >= CTXL / 64, ci = seg ? cidx - CTXL / 64 : cidx;
#pragma unroll
        for (int g8 = 0; g8 < 4; ++g8) { *(LP(v4u))(Q + j * ST256 + (dc + 8 * g8) * 2) = rq[g8]; *(LP(v4u))(K + j * ST256 + (dc + 8 * g8) * 2) = rk[g8]; }
        if (wave == 0) {
            if (MODE == 0) {
                const int prow = tok_row(b, seg, ci * 64 + lane, dir, 1);
                const float ig = gi + gate_b[(dir * 2 + 0) * 4 + h];
                float bcum = logsigmoidf(gf + gate_b[(dir * 2 + 1) * 4 + h]);
#pragma unroll
                for (int o = 1; o < 64; o <<= 1) { const float t = SHUP(bcum, o); if (lane >= o) bcum += t; }
                const float a_s = ig - bcum;
                float cm = a_s;
#pragma unroll
                for (int o = 1; o < 64; o <<= 1) { const float t = SHUP(cm, o); if (lane >= o) cm = fmaxf(cm, t); }
                *(v4f*)(GP + ((size_t)prow * 8 + dir * 4 + h) * 4) = (v4f){bcum, a_s, cm, 0.f};
                AS[lane] = a_s; R0[lane] = -cm; W0[lane] = EXPF(a_s - RDLANE(cm, 63));
            } else { const float lg = -expf(ret_log_decay[dir * 4 + h]); AS[lane] = -(float)(lane + 1) * lg; R0[lane] = (float)(lane + 1) * lg; }
        }
        if (task + stride < MAT_TASKS) MP_ISSUE(task + stride);
        SYNC();
        const int tt = wave >> 1;
        bf16* pp = PP + (size_t)task * 4096;
        const float rt = R0[16 * tt + fr];
#pragma unroll
        for (int i = 0; i < 2; ++i) { const int st = (wave & 1) * 2 + i; v4f p = (v4f){0.f, 0.f, 0.f, 0.f};
            if (st <= tt) { p = tile_mma(p, Q, ST256, 16 * tt, K, ST256, 16 * st, 8, fr, fq);
                const v4f as4 = *(LP(const v4f))(AS + 16 * st + 4 * fq);
                p.x *= kscale * EXPF(as4.x + rt); p.y *= kscale * EXPF(as4.y + rt); p.z *= kscale * EXPF(as4.z + rt); p.w *= kscale * EXPF(as4.w + rt);
                if (st == tt) { if (4 * fq + 0 > fr) p.x = 0.f; if (4 * fq + 1 > fr) p.y = 0.f; if (4 * fq + 2 > fr) p.z = 0.f; if (4 * fq + 3 > fr) p.w = 0.f; } }
            *(v2u*)(pp + (16 * tt + fr) * 64 + 16 * st + 4 * fq) = (v2u){PK2(p.x, p.y), PK2(p.z, p.w)};
            if (MODE == 0) { float rs = (p.x + p.y) + (p.z + p.w); rs += SHX(rs, 16); rs += SHX(rs, 32); if (fq == 0) DENP[st * 64 + 16 * tt + fr] = rs; } }
        if (MODE == 0 && tid >= 256) {
            const int d = tid - 256; float kw = 0.f;
            for (int jj = 0; jj < 64; ++jj) kw += __uint_as_float(((unsigned)*(LP(const unsigned short))(K + jj * ST256 + d * 2)) << 16) * W0[jj];
            GPK[(size_t)task * 256 + d] = kw; }
        SYNC();
        if (MODE == 0 && tid < 64) RS[(size_t)task * 64 + tid] = (DENP[tid] + DENP[64 + tid]) + (DENP[128 + tid] + DENP[192 + tid]);
        SYNC();
    }
#undef MP_ISSUE
}

template <int MODE>
DEV void mat_unit(const bf16* Sqk, int ldqk, int qoff, int koff, const bf16* Sv, int ldv, int voff, float kscale, const float* GP, const float* GPK, const bf16* PP, const float* RS, bf16* O, int store_ctx,
                  const float* ret_log_decay, int unit, LP(unsigned char) lds, int tid, unsigned* sib) {
    const int lane = tid & 63, wave = tid >> 6, fr = lane & 15, fq = lane >> 4;
    const int vs = unit & 3, dir = (unit >> 2) & 1, h = (unit >> 3) & 3, b = unit >> 5;
    LP(unsigned char) Q = lds; LP(unsigned char) K = lds + 33792;
    LP(unsigned char) VV = lds + 67584; LP(unsigned char) VW = lds + 76800;
    LP(unsigned char) PM = lds + 86016; LP(unsigned char) STT = lds + 95232;
    LP(float) SCAL = (LP(float))(lds + 137472);
    LP(float) NV = SCAL + 768;
    for (int i = tid; i < 80 * ST256 / 4; i += NTHR) ((LP(unsigned))STT)[i] = 0u;
    if (tid < 256) NV[tid] = 0.f;
    v4f sacc[8];
#pragma unroll
    for (int i = 0; i < 8; ++i) sacc[i] = (v4f){0.f, 0.f, 0.f, 0.f};
    const int j = tid >> 3, c8 = tid & 7, dc = c8 * 32;
    const int tt = wave >> 1, vt0 = (wave & 1) * 2;
    const int svt = wave & 3, sdt0 = (wave >> 2) * 8;
    float m_st = 0.f;
    float lg = 0.f;
    if (MODE == 1) lg = -expf(ret_log_decay[dir * 4 + h]);
    bf16* Od = O + (size_t)(2 + dir) * TT * 1024;
    constexpr int NCHUNK = CTXL / 64 + SEQ / 64;
    v4u rq[2][4], rk[2][4], rv, rp; v4f gpv = (v4f){0.f, 0.f, 0.f, 0.f}; float kwv[2] = {0.f, 0.f}, rsv = 0.f;
    const int task0 = ((b * 4 + h) * 2 + dir) * NCHUNK;
#define MAT_ISSUE(cx, P_) do { const int seg_ = (cx) >= CTXL / 64, ci_ = seg_ ? (cx) - CTXL / 64 : (cx); \
        const int row_ = tok_row(b, seg_, ci_ * 64 + j, dir, 1); \
        const bf16* s1_ = Sqk + (size_t)row_ * ldqk; \
        _Pragma("unroll") for (int g_ = 0; g_ < 4; ++g_) { rq[P_][g_] = *(const v4u*)(s1_ + qoff + h * 256 + dc + 8 * g_); rk[P_][g_] = *(const v4u*)(s1_ + koff + h * 256 + dc + 8 * g_); } \
        if (MODE == 0 && tid < 256) kwv[P_] = GPK[(size_t)(task0 + (cx)) * 256 + tid]; } while (0)
#define MAT_GATE_LOAD(cx) do { if (MODE == 0 && wave == 0) { const int seg_ = (cx) >= CTXL / 64, ci_ = seg_ ? (cx) - CTXL / 64 : (cx); \
        const int prow_ = tok_row(b, seg_, ci_ * 64 + lane, dir, 1); gpv = *(const v4f*)(GP + ((size_t)prow_ * 8 + dir * 4 + h) * 4); rsv = RS[(size_t)(task0 + (cx)) * 64 + lane]; } } while (0)
#define MAT_GATES(cx) do { if (wave == 0) { LP(float) sc_ = SCAL + ((cx) & 1) * 384; \
        if (MODE == 0) { const float bcum_ = gpv.x, a_s_ = gpv.y, Mt_ = fmaxf(m_st, gpv.z); \
            const float M63_ = RDLANE(Mt_, 63), bend_ = RDLANE(bcum_, 63), cm63_ = RDLANE(gpv.z, 63); const float wp_ = EXPF(gpv.z - Mt_); \
            sc_[lane] = wp_; sc_[64 + lane] = EXPF(m_st - Mt_); sc_[128 + lane] = EXPF(a_s_ - M63_); sc_[192 + lane] = EXPF(-(bcum_ + Mt_)); sc_[256 + lane] = rsv * wp_; \
            if (lane == 0) { sc_[320] = EXPF(m_st - M63_); sc_[321] = EXPF(cm63_ - M63_); } \
            m_st = bend_ + M63_; \
        } else { sc_[lane] = 1.0f; sc_[64 + lane] = EXPF((float)(lane + 1) * lg); sc_[128 + lane] = EXPF((float)(63 - lane) * lg); sc_[192 + lane] = 0.f; sc_[256 + lane] = 0.f; \
            if (lane == 0) { sc_[320] = EXPF(64.f * lg); sc_[321] = 0.f; } } } } while (0)
    static_assert(NCHUNK % 2 == 0, "the chunk loop is unrolled by two");
#define MAT_ISSUE_P(cx) do { const int seg_ = (cx) >= CTXL / 64, ci_ = seg_ ? (cx) - CTXL / 64 : (cx); rp = *(const v4u*)(PP + (size_t)(task0 + (cx)) * 4096 + j * 64 + c8 * 8); \
        rv = *(const v4u*)(Sv + (size_t)tok_row(b, seg_, ci_ * 64 + j, dir, 1) * ldv + voff + h * 256 + vs * 64 + c8 * 8); } while (0)
    MAT_ISSUE(0, 0); MAT_ISSUE(1, 1); MAT_ISSUE_P(0); MAT_GATE_LOAD(0);
    MAT_GATES(0);
    MAT_GATE_LOAD(1);
    SYNC();
#pragma unroll 1
    for (int c2 = 0; c2 < NCHUNK; c2 += 2) {
#pragma unroll
    for (int u_ = 0; u_ < 2; ++u_) {
        const int cidx = c2 + u_;
        const int seg = cidx >= CTXL / 64, ci = seg ? cidx - CTXL / 64 : cidx;
        if (u_ == 0 && (c2 & 3) == 0 && c2 > 0) sibling_sync(sib, (unsigned)(c2 >> 2) * 4u, tid);
        LP(const float) sc = SCAL + u_ * 384;
        const float kw_cur = kwv[u_];
        {
            const float wk = sc[128 + j] * kscale;
#pragma unroll
            for (int g8 = 0; g8 < 4; ++g8) { const int d0 = dc + 8 * g8; *(LP(v4u))(Q + j * ST256 + d0 * 2) = rq[u_][g8]; *(LP(v4u))(K + j * ST256 + d0 * 2) = rk[u_][g8]; }
            const v4u rvv = rv;
            *(LP(v4u))(VV + j * ST64 + c8 * 16) = rvv;
            *(LP(v4u))(VW + j * ST64 + c8 * 16) = (v4u){PK2(bflo(rvv.x) * wk, bfhi(rvv.x) * wk), PK2(bflo(rvv.y) * wk, bfhi(rvv.y) * wk), PK2(bflo(rvv.z) * wk, bfhi(rvv.z) * wk), PK2(bflo(rvv.w) * wk, bfhi(rvv.w) * wk)};
            *(LP(v4u))(PM + j * ST64 + c8 * 16) = rp;
#pragma unroll
            for (int i = 0; i < 8; ++i) *(LP(v2u))(STT + (16 * svt + fr) * ST256 + (16 * (sdt0 + i) + 4 * fq) * 2) = (v2u){PK2(sacc[i].x, sacc[i].y), PK2(sacc[i].z, sacc[i].w)};
        }
        if (cidx + 2 < NCHUNK) MAT_ISSUE(cidx + 2, u_);
        if (cidx + 1 < NCHUNK) MAT_ISSUE_P(cidx + 1);
        SYNC();
        if (cidx + 1 < NCHUNK) { MAT_GATES(cidx + 1); if (cidx + 2 < NCHUNK) MAT_GATE_LOAD(cidx + 2); }
        v4f oP[2], oI[2]; oP[0] = (v4f){0.f, 0.f, 0.f, 0.f}; oP[1] = oP[0]; oI[0] = oP[0]; oI[1] = oP[0];
        v4f qa = (v4f){0.f, 0.f, 0.f, 0.f};
#pragma unroll 1
        for (int k = 0; k < 8; ++k) { const v8s af = *(LP(const v8s))(Q + (16 * tt + fr) * ST256 + fq * 16 + k * 64);
#pragma unroll
            for (int i = 0; i < 2; ++i) { const v8s bf = *(LP(const v8s))(STT + (16 * (vt0 + i) + fr) * ST256 + fq * 16 + k * 64); oI[i] = MFMA16(bf, af, oI[i]); }
            if (MODE == 0) { const v8s bn = *(LP(const v8s))(STT + (64 + fr) * ST256 + fq * 16 + k * 64); qa = MFMA16(bn, af, qa); } }
#pragma unroll
        for (int k = 0; k < 2; ++k) { const v8s af = *(LP(const v8s))(PM + (16 * tt + fr) * ST64 + fq * 16 + k * 64);
#pragma unroll
            for (int i = 0; i < 2; ++i) { const v8s bf = tr_frag(VV, ST64, 32 * k, 16 * (vt0 + i), lane); oP[i] = MFMA16(bf, af, oP[i]); } }
        { const int t = 16 * tt + fr; const float wp = sc[t], wi = sc[64 + t];
          v4f o0 = oP[0] * wp + oI[0] * wi, o1 = oP[1] * wp + oI[1] * wi;
          if (MODE == 0) { const float qn = RDLANE16(qa.x, fr); const float den = sc[256 + t] + wi * qn; const float dv = 1.0f / fmaxf(fabsf(den), sc[192 + t]); o0 = o0 * dv; o1 = o1 * dv; }
          if (seg || store_ctx) { const int orow = tok_row(b, seg, ci * 64 + t, dir, 1);
              *(v2u*)(Od + (size_t)orow * 1024 + h * 256 + vs * 64 + 16 * vt0 + 4 * fq) = (v2u){PK2(o0.x, o0.y), PK2(o0.z, o0.w)};
              *(v2u*)(Od + (size_t)orow * 1024 + h * 256 + vs * 64 + 16 * (vt0 + 1) + 4 * fq) = (v2u){PK2(o1.x, o1.y), PK2(o1.z, o1.w)}; } }
        const float dcy = sc[320];
        {
#pragma unroll
            for (int i = 0; i < 8; ++i) sacc[i] = sacc[i] * dcy;
#pragma unroll 1
            for (int k = 0; k < 2; ++k) { const v8s af = tr_frag(VW, ST64, 32 * k, 16 * svt, lane);
#pragma unroll
                for (int i = 0; i < 8; ++i) { const v8s bf = tr_frag(K, ST256, 32 * k, 16 * (sdt0 + i), lane); sacc[i] = MFMA16(bf, af, sacc[i]); } }
        }
        SYNC();
        if (MODE == 0 && tid < 256) {
            const float nn = dcy * NV[tid] + sc[321] * kw_cur * kscale; NV[tid] = nn;
            *(LP(unsigned short))(STT + 64 * ST256 + tid * 2) = F2BF(nn); }
    }
    }
#undef MAT_ISSUE
#undef MAT_ISSUE_P
#undef MAT_GATE_LOAD
#undef MAT_GATES
    SYNC();
}

constexpr int S5_LDS_PER_WAVE = 1280 + 2 * 10240 + 2 * 6144;
DEV void s5_unit(const bf16* S, int ldS, bf16* O, const float* lam_re, const float* lam_im, const float* log_step, const float* b_re, const float* b_im,
                 const float* c_re, const float* c_im, int unit, LP(unsigned char) wl, int lane) {
    const int fr = lane & 15, fq = lane >> 4;
    const int dir = unit & 1, g = (unit >> 1) & 63, b = unit >> 7;
    LP(unsigned char) UB = wl; LP(unsigned char) XB = wl + 1280; LP(unsigned char) HB = wl + 1280 + 2 * 10240;
    const int pg = (dir * 64 + g);
    const float lr = lam_re[pg * 64 + lane], li = lam_im[pg * 64 + lane], step = expf(log_step[pg]);
    const float mag = expf(lr * step); float sn, cs; sincosf(li * step, &sn, &cs);
    const float ar = mag * cs, ai = mag * sn, den = lr * lr + li * li;
    const float cre = ((ar - 1.0f) * lr + ai * li) / den, cim = (ai * lr - (ar - 1.0f) * li) / den;
    for (int p = 0; p < 16; ++p) { const float br = b_re[(pg * 64 + lane) * 16 + p], bi = b_im[(pg * 64 + lane) * 16 + p];
        *(LP(unsigned short))(XB + lane * 32 + p * 2) = F2BF(cre * br - cim * bi);
        *(LP(unsigned short))(XB + (64 + lane) * 32 + p * 2) = F2BF(cre * bi + cim * br); }
    WAVE_SYNC();
    v8s bfrag[8];
#pragma unroll
    for (int nt = 0; nt < 8; ++nt) { if (fq < 2) bfrag[nt] = *(LP(const v8s))(XB + (16 * nt + fr) * 32 + fq * 16); else bfrag[nt] = (v8s){0, 0, 0, 0, 0, 0, 0, 0}; }
    v8s cfrag[4];
#pragma unroll
    for (int ks = 0; ks < 4; ++ks) { const int n0 = 32 * ks + 8 * fq; const float* src = (n0 < 64 ? c_re : c_im) + ((size_t)pg * 16 + fr) * 64 + (n0 & 63); const float sgn = n0 < 64 ? 1.f : -1.f;
        v8s f;
#pragma unroll
        for (int i = 0; i < 8; ++i) f[i] = (short)F2BF(sgn * src[i]);
        cfrag[ks] = f; }
    WAVE_SYNC();
    for (int i = lane; i < 1280 / 4; i += 64) ((LP(unsigned))UB)[i] = 0u;
    WAVE_SYNC();
    float hr = 0.f, hi = 0.f;
    bf16* Od = O + (size_t)dir * TT * 1024;
    constexpr int NBLK = CTXL / 16 + SEQ / 16;
    constexpr int S5_PF = 8;
    v4u ur[S5_PF];
#pragma unroll
    for (int i_ = 0; i_ < S5_PF; ++i_) ur[i_] = (v4u){0u, 0u, 0u, 0u};
#define S5_LOAD(bx, dst) do { if (lane < 32 && (bx) < NBLK) { const int seg_ = (bx) >= CTXL / 16, bi_ = seg_ ? (bx) - CTXL / 16 : (bx); \
        dst = *(const v4u*)(S + (size_t)tok_row(b, seg_, bi_ * 16 + (lane >> 1), dir, 0) * ldS + g * 16 + (lane & 1) * 8); } } while (0)
#define S5_STAGE_A(bx) do { const v8s uf_ = *(LP(const v8s))(UB + fr * 80 + fq * 16); LP(unsigned char) xb_ = XB + ((bx) & 1) * 10240; \
        _Pragma("unroll") for (int nt = 0; nt < 8; ++nt) { v4f x = (v4f){0.f, 0.f, 0.f, 0.f}; x = MFMA16(uf_, bfrag[nt], x); *(LP(v4f))(xb_ + (16 * nt + fr) * 80 + fq * 16) = x; } } while (0)
#pragma unroll
    for (int i_ = 0; i_ < S5_PF; ++i_) S5_LOAD(i_, ur[i_]);
    if (lane < 32) *(LP(v4u))(UB + (lane >> 1) * 80 + (lane & 1) * 16) = ur[0];
#pragma unroll
    for (int i_ = 0; i_ + 1 < S5_PF; ++i_) ur[i_] = ur[i_ + 1];
    S5_LOAD(S5_PF, ur[S5_PF - 1]);
    WAVE_SYNC();
    S5_STAGE_A(0);
    static_assert(NBLK % S5_PF == 0, "ring unrolling");
#pragma unroll 1
    for (int bx0 = 0; bx0 <= NBLK; bx0 += S5_PF) {
#pragma unroll
    for (int ui = 0; ui < S5_PF; ++ui) {
        const int bx = bx0 + ui; if (bx > NBLK) break;
        WAVE_SYNC();
        v8s hf[4]; float xr[16], xi[16];
        if (bx >= 1) { LP(unsigned char) hb = HB + ((bx - 1) & 1) * 6144;
#pragma unroll
            for (int ks = 0; ks < 4; ++ks) hf[ks] = tr_frag(hb, 48, 32 * ks, 0, lane); }
        if (bx < NBLK) { LP(unsigned char) xb = XB + (bx & 1) * 10240;
#pragma unroll
            for (int q4 = 0; q4 < 4; ++q4) { const v4f a4 = *(LP(const v4f))(xb + lane * 80 + q4 * 16), b4 = *(LP(const v4f))(xb + (64 + lane) * 80 + q4 * 16);
                xr[4 * q4] = a4.x; xr[4 * q4 + 1] = a4.y; xr[4 * q4 + 2] = a4.z; xr[4 * q4 + 3] = a4.w; xi[4 * q4] = b4.x; xi[4 * q4 + 1] = b4.y; xi[4 * q4 + 2] = b4.z; xi[4 * q4 + 3] = b4.w; } }
        if (bx + 1 < NBLK) { if (lane < 32) *(LP(v4u))(UB + (lane >> 1) * 80 + (lane & 1) * 16) = ur[ui]; S5_LOAD(bx + 1 + S5_PF, ur[ui]); }
        WAVE_SYNC();
        if (bx + 1 < NBLK) S5_STAGE_A(bx + 1);
        if (bx >= 1) { const int pb = bx - 1, seg = pb >= CTXL / 16, bi = seg ? pb - CTXL / 16 : pb;
            if (seg) { v4f y = (v4f){0.f, 0.f, 0.f, 0.f};
#pragma unroll
                for (int ks = 0; ks < 4; ++ks) y = MFMA16(cfrag[ks], hf[ks], y);
                const int orow = tok_row(b, seg, bi * 16 + fr, dir, 0);
                *(v2u*)(Od + (size_t)orow * 1024 + g * 16 + 4 * fq) = (v2u){PK2(y.x, y.y), PK2(y.z, y.w)}; } }
        if (bx < NBLK) { LP(unsigned char) hb = HB + (bx & 1) * 6144;
            unsigned pr[8], pi[8];
#pragma unroll
            for (int t2 = 0; t2 < 8; ++t2) {
                const float r0 = ar * hr - ai * hi + xr[2 * t2], i0 = ar * hi + ai * hr + xi[2 * t2];
                hr = ar * r0 - ai * i0 + xr[2 * t2 + 1]; hi = ar * i0 + ai * r0 + xi[2 * t2 + 1];
                pr[t2] = PK2(r0, hr); pi[t2] = PK2(i0, hi); }
            *(LP(v4u))(hb + lane * 48) = (v4u){pr[0], pr[1], pr[2], pr[3]}; *(LP(v4u))(hb + lane * 48 + 16) = (v4u){pr[4], pr[5], pr[6], pr[7]};
            *(LP(v4u))(hb + (64 + lane) * 48) = (v4u){pi[0], pi[1], pi[2], pi[3]}; *(LP(v4u))(hb + (64 + lane) * 48 + 16) = (v4u){pi[4], pi[5], pi[6], pi[7]}; }
    }
    }
#undef S5_STAGE_A
#undef S5_LOAD
}

DEV void conv_prep_row(int r, const bf16* S, bf16* QK2, const float* conv_w, const float* conv_b, int lane) {
    int rm, rp; bool hasm, hasp;
    if (r < TL) { const int b = r >> 12, n = r & (SEQ - 1), gr = n >> 6, col = n & 63, np = col * 64 + gr;
        hasm = np > 0; hasp = np < SEQ - 1; rm = seq_row(b, 1, hasm ? np - 1 : np, 1); rp = seq_row(b, 1, hasp ? np + 1 : np, 1); }
    else { const int n = (r - TL) & (CTXL - 1); hasm = n > 0; hasp = n < CTXL - 1; rm = hasm ? r - 1 : r; rp = hasp ? r + 1 : r; }
    const bf16* s0 = S + (size_t)rm * EV_PAD + 3072; const bf16* s1 = S + (size_t)r * EV_PAD + 3072; const bf16* s2 = S + (size_t)rp * EV_PAD + 3072;
#pragma unroll
    for (int i = 0; i < 4; ++i) { const int c = 8 * lane + 512 * i;
        const v4u a0 = *(const v4u*)(s0 + c), a1 = *(const v4u*)(s1 + c), a2 = *(const v4u*)(s2 + c);
        const unsigned w0[4] = {a0.x, a0.y, a0.z, a0.w}, w1[4] = {a1.x, a1.y, a1.z, a1.w}, w2[4] = {a2.x, a2.y, a2.z, a2.w};
        const float sc = c >= 1024 ? 0.0625f : 1.0f;
        float val[8];
#pragma unroll
        for (int i2 = 0; i2 < 4; ++i2)
#pragma unroll
            for (int e = 0; e < 2; ++e) { const int di = 2 * i2 + e;
                const float um = hasm ? (e ? bfhi(w0[i2]) : bflo(w0[i2])) : 0.f, u0 = e ? bfhi(w1[i2]) : bflo(w1[i2]), up = hasp ? (e ? bfhi(w2[i2]) : bflo(w2[i2])) : 0.f;
                const float pre = conv_b[c + di] + conv_w[c + di] * um + conv_w[2048 + c + di] * u0 + conv_w[4096 + c + di] * up;
                val[di] = pre * RCPF(1.0f + EXPF(-pre)) * sc; }
        *(v4u*)(QK2 + (size_t)r * 2048 + c) = (v4u){PK2(val[0], val[1]), PK2(val[2], val[3]), PK2(val[4], val[5]), PK2(val[6], val[7])}; }
}

DEV v4f ld4bf(const bf16* p) { const v2u w = *(const v2u*)p; return (v4f){bflo(w.x), bfhi(w.x), bflo(w.y), bfhi(w.y)}; }
DEV float wsum(float v) {
#pragma unroll
    for (int o = 1; o < 64; o <<= 1) v += SHX(v, o);
    return v;
}
DEV float grp16_sum(float v) { v += SHX(v, 1); v += SHX(v, 2); v += SHX(v, 4); v += SHX(v, 8); return v; }
DEV void ld16bf(const bf16* p, float (&o)[16]) { const v4u a = *(const v4u*)p, b = *(const v4u*)(p + 8); const unsigned w[8] = {a.x, a.y, a.z, a.w, b.x, b.y, b.z, b.w};
#pragma unroll
    for (int i = 0; i < 8; ++i) { o[2 * i] = bflo(w[i]); o[2 * i + 1] = bfhi(w[i]); } }
DEV void ld16f(const float* p, float (&o)[16]) {
#pragma unroll
    for (int i = 0; i < 4; ++i) { const v4f a = *(const v4f*)(p + 4 * i); o[4 * i] = a.x; o[4 * i + 1] = a.y; o[4 * i + 2] = a.z; o[4 * i + 3] = a.w; } }
DEV void st16bf(bf16* p, const float (&o)[16]) { *(v4u*)p = (v4u){PK2(o[0], o[1]), PK2(o[2], o[3]), PK2(o[4], o[5]), PK2(o[6], o[7])}; *(v4u*)(p + 8) = (v4u){PK2(o[8], o[9]), PK2(o[10], o[11]), PK2(o[12], o[13]), PK2(o[14], o[15])}; }
template <int CENTER, int GATE>
DEV void head_norm16(const bf16* o0, const bf16* o1, const float* gain, const bf16* gs, bf16* dst) {
    float a[16], b2[16], g[16], gt[16];
    ld16bf(o0, a); ld16bf(o1, b2); ld16f(gain, g); ld16bf(gs, gt);
    float s = 0.f;
#pragma unroll
    for (int i = 0; i < 16; ++i) { a[i] += b2[i]; s += a[i]; }
    if (CENTER) { const float mean = grp16_sum(s) * (1.0f / 256.0f);
#pragma unroll
        for (int i = 0; i < 16; ++i) a[i] -= mean; }
    float q = 0.f;
#pragma unroll
    for (int i = 0; i < 16; ++i) q += a[i] * a[i];
    const float rstd = RSQRTF(grp16_sum(q) * (1.0f / 256.0f) + EPS);
#pragma unroll
    for (int i = 0; i < 16; ++i) { const float sg = RCPF(1.0f + EXPF(-gt[i])); const float gate = GATE ? sg : gt[i] * sg; a[i] = gate * (a[i] * rstd * g[i]); }
    st16bf(dst, a);
}
DEV void merge_even_row(int r, const bf16* S, const bf16* O, const float* gla_norm, const float* ml_norm, bf16* HBo, int lane) {
    const bf16* sr = S + (size_t)r * EV_PAD; const int c = 16 * lane; const bf16* ob = O + (size_t)r * 1024 + c; const size_t os = (size_t)TT * 1024;
    head_norm16<0, 0>(ob, ob + os, gla_norm + c, sr + 2048 + c, HBo + (size_t)r * D + c);
    head_norm16<1, 1>(ob + 2 * os, ob + 3 * os, ml_norm + c, sr + 6144 + c, HBo + (size_t)r * D + 1024 + c);
}
DEV float gelu_tanh(float y) { const float z = 0.7978845608028654f * (y + 0.044715f * y * y * y); const float t = 1.0f - 2.0f * RCPF(1.0f + EXPF(2.0f * z)); return 0.5f * y * (1.0f + t); }
DEV void merge_odd_row(int r, const bf16* S, const bf16* O, const float* s5_d, const float* ret_norm, bf16* GBo, bf16* HBo, int lane) {
    const bf16* sr = S + (size_t)r * OD_COLS; const int c = 16 * lane; const bf16* ob = O + (size_t)r * 1024 + c; const size_t os = (size_t)TT * 1024;
    {
        float y0[16], y1[16], dd[16], u[16];
        ld16bf(ob, y0); ld16bf(ob + os, y1); ld16f(s5_d + c, dd); ld16bf(sr + c, u);
#pragma unroll
        for (int i = 0; i < 16; ++i) {
#ifdef NO_S5
            y0[i] = 0.f; y1[i] = 0.f;
#endif
            y0[i] = gelu_tanh(y0[i] + y1[i] + dd[i] * u[i]); }
        st16bf(GBo + (size_t)r * 1024 + c, y0);
    }
    head_norm16<1, 0>(ob + 2 * os, ob + 3 * os, ret_norm + c, sr + 4096 + c, HBo + (size_t)r * D + 1024 + c);
}

struct EpiGLU {
    static constexpr bool PERM = true, AFTER_DRAIN = false;
    const bf16* G; const float* bias; bf16* O;
    __device__ __forceinline__ void operator()(const pg8::f32x4 (&acc)[2][2][4][2], const pg8::Unit& u, int wr, int wc, int fr, int fq) const {
        const int row0 = u.pm * 256 + wr * 64 + fr, col0 = u.pn * 256 + wc * 32 + 8 * fq;
#pragma unroll
        for (int ai = 0; ai < 2; ++ai)
#pragma unroll
            for (int m = 0; m < 4; ++m) { const size_t row = (size_t)(row0 + ai * 128 + m * 16);
#pragma unroll
                for (int bj = 0; bj < 2; ++bj) { const int col = col0 + bj * 128;
                    const v4u gw = *(const v4u*)(G + row * 1024 + col); const pg8::f32x4 b0 = *(const pg8::f32x4*)(bias + col), b1 = *(const pg8::f32x4*)(bias + col + 4);
                    const pg8::f32x4 v0 = acc[ai][bj][m][0] + b0, v1 = acc[ai][bj][m][1] + b1;
                    v4u w; w.x = pk2(bflo(gw.x) * fast_sigmoid(v0[0]), bfhi(gw.x) * fast_sigmoid(v0[1])); w.y = pk2(bflo(gw.y) * fast_sigmoid(v0[2]), bfhi(gw.y) * fast_sigmoid(v0[3]));
                    w.z = pk2(bflo(gw.z) * fast_sigmoid(v1[0]), bfhi(gw.z) * fast_sigmoid(v1[1])); w.w = pk2(bflo(gw.w) * fast_sigmoid(v1[2]), bfhi(gw.w) * fast_sigmoid(v1[3]));
                    *(v4u*)(O + row * D + col) = w; } }
    }
};

#ifndef SCAN_REPS
#define SCAN_REPS 1
#endif
__device__ __forceinline__ void mixer_phases(const Args& a, unsigned char* ws, LAS unsigned char* lds, const XcdBarrier& bar, int layer, int G, int gw, int ngw, int tid, int lane, int wave) {
#define HB ((bf16*)wsp(ws, WS_HB))
#define S ((bf16*)wsp(ws, WS_S))
#define GT ((float*)wsp(ws, WS_GT))
#define O ((bf16*)wsp(ws, WS_O))
#define GB ((bf16*)wsp(ws, WS_GB))
#define Y ((bf16*)wsp(ws, WS_Y))
    const int ldS = layer == 0 ? EV_PAD : OD_COLS;
    { pg8::Gemm g{HB, (const bf16*)(wsp(ws, (layer == 0 ? WS_WIN_EV : WS_WIN_OD))), TT, ldS, D}; pg8::StaticOrder So; So.init(TT, ldS, G, (int)blockIdx.x);
      EpiS E{S, ldS, GT, layer == 0 ? 28 : -1};
      pg8::gemm_phase<EpiS, pg8::StaticOrder, true, true>(lds, g, So, E); }
    XBAR();
#define QK2 ((bf16*)wsp(ws, WS_QK2))
#define GP ((float*)wsp(ws, WS_GP))
#define QKS ((bf16*)wsp(ws, WS_QKS))
#define GPK ((float*)wsp(ws, WS_GPK))
#define PP ((bf16*)wsp(ws, WS_PP))
#define RS ((float*)wsp(ws, WS_RS))
#define VEC ((float*)wsp(ws, WS_VEC))
    { int t2 = threadIdx.x; asm volatile("" : "+v"(t2)); tid = t2; lane = t2 & 63; wave = __builtin_amdgcn_readfirstlane(t2 >> 6); gw = blockIdx.x * NWAVES + wave; }
    if (layer == 0) {
        { const bf16* s_ = S; bf16* qk_ = QK2; const float* cw_ = ARG(16); const float* cb_ = ARG(17); for (int r = gw; r < TT; r += ngw) conv_prep_row(r, s_, qk_, cw_, cb_, lane); }
        { int t2 = threadIdx.x; asm volatile("" : "+v"(t2)); gla_prep_loop((int)blockIdx.x, G, S, GT, ARG(13), ARG(14), QKS, VEC, lds, t2); }
        XBAR();
        { int t2 = threadIdx.x; asm volatile("" : "+v"(t2)); mat_prep_loop<0>((int)blockIdx.x, G, QK2, 2048, 0, 1024, 1.0f, GT, ARG(18), GP, GPK, nullptr, PP, RS, lds, t2); }
        XBAR();
    } else {
        { int t2 = threadIdx.x; asm volatile("" : "+v"(t2)); mat_prep_loop<1>((int)blockIdx.x, G, S, OD_COLS, 1024, 2048, 0.0625f, nullptr, nullptr, nullptr, nullptr, ARG(32), PP, RS, lds, t2); }
        XBAR();
    }
#ifdef PRE_SLEEP
    { const unsigned long long t0_ = __builtin_amdgcn_s_memrealtime(); while (__builtin_amdgcn_s_memrealtime() - t0_ < (unsigned long long)(PRE_SLEEP) * 100ull) __builtin_amdgcn_s_sleep(16); XBAR(); }
#endif
    { int t2 = threadIdx.x; asm volatile("" : "+v"(t2)); tid = t2; lane = t2 & 63; wave = __builtin_amdgcn_readfirstlane(t2 >> 6); }
#pragma unroll 1
    for (int rep = 0; rep < SCAN_REPS; ++rep) {
#ifndef SIB_LOCKSTEP
#define SIB_LOCKSTEP 0
#endif
#define SIBP(ty, un) ((SIB_LOCKSTEP && G >= 2 * MIX_UNITS && SCAN_REPS == 1) ? (unsigned*)(wsp(ws, WS_CTL) + 16384 + ((ty) * 32 + ((un) >> 2)) * 64) : (unsigned*)nullptr)
#define UNIT_OF(w) (NB == 4 ? (((((w) & 7) * 4 + (((w) >> 3) & 15) / 4) << 2) | ((((w) >> 3) & 15) & 3)) : (w))
    if (layer == 0) {
#ifdef SPLIT_L0
        for (int it = blockIdx.x; it < MIX_UNITS; it += G) gla_unit(S, QKS, VEC, O, UNIT_OF(it), lds, tid, SIBP(0, UNIT_OF(it)));
        XBAR();
        for (int it = blockIdx.x; it < 2 * MIX_UNITS; it += G) if (it >= MIX_UNITS) mat_unit<0>(QK2, 2048, 0, 1024, S, EV_PAD, 5120, 1.0f, GP, GPK, PP, RS, O, 1, nullptr, UNIT_OF(it - MIX_UNITS), lds, tid, SIBP(1, UNIT_OF(it - MIX_UNITS)));
        if (false)
#endif
        for (int it = blockIdx.x; it < 2 * MIX_UNITS; it += G) {
            if (it < MIX_UNITS) {
#ifndef REP_GLA
#define REP_GLA 1
#endif
#pragma unroll 1
                for (int r_ = 0; r_ < REP_GLA; ++r_) gla_unit(S, QKS, VEC, O, UNIT_OF(it), lds, tid, SIBP(0, UNIT_OF(it)));
                if (DEFER == 1 && G >= 2 * MIX_UNITS) convert_tiles(a, ws, 1, (int)blockIdx.x * NWAVES + wave, MIX_UNITS * NWAVES, lane);
            } else {
#ifndef REP_ML
#define REP_ML 1
#endif
#pragma unroll 1
                for (int r_ = 0; r_ < REP_ML; ++r_) mat_unit<0>(QK2, 2048, 0, 1024, S, EV_PAD, 5120, 1.0f, GP, GPK, PP, RS, O, 1, nullptr, UNIT_OF(it - MIX_UNITS), lds, tid, SIBP(1, UNIT_OF(it - MIX_UNITS)));
            }
        }
        if (DEFER == 1 && G < 2 * MIX_UNITS) convert_tiles(a, ws, 1, (int)blockIdx.x * NWAVES + wave, G * NWAVES, lane);
    } else {
        const int s5_first = G >= 2 * MIX_UNITS ? MIX_UNITS : 0, s5_wgs = G - s5_first;
#ifndef REP_RET
#define REP_RET 1
#endif
#ifndef REP_S5
#define REP_S5 1
#endif
#pragma unroll 1
        for (int r_ = 0; r_ < REP_RET; ++r_)
        for (int u = blockIdx.x; u < MIX_UNITS; u += G)
            mat_unit<1>(S, OD_COLS, 1024, 2048, S, OD_COLS, 3072, 0.0625f, nullptr, nullptr, PP, RS, O, 0, ARG(32), UNIT_OF(u), lds, tid, SIBP(2, UNIT_OF(u)));
        if (DEFER == 1 && rep == 0 && (int)blockIdx.x >= s5_first && wave >= 4) convert_tiles(a, ws, 2, ((int)blockIdx.x - s5_first) * 4 + (wave - 4), 4 * s5_wgs, lane);
#pragma unroll 1
        for (int r_ = 0; r_ < REP_S5; ++r_)
        if ((int)blockIdx.x >= s5_first && wave < 4) { for (int su = ((int)blockIdx.x - s5_first) * 4 + wave; su < NB * 128; su += 4 * s5_wgs)
            s5_unit(S, OD_COLS, O, ARG(22), ARG(23), ARG(24), ARG(25), ARG(26), ARG(27), ARG(28), su, lds + wave * S5_LDS_PER_WAVE, lane); }
    }
    }
    XBAR();
    { int t2 = threadIdx.x; asm volatile("" : "+v"(t2)); tid = t2; lane = t2 & 63; wave = __builtin_amdgcn_readfirstlane(t2 >> 6); gw = blockIdx.x * NWAVES + wave; }
#ifndef NO_MERGE
    if (layer == 0) { const bf16* s_ = S; const bf16* o_ = O; const float* n0 = ARG(15); const float* n1 = ARG(19); bf16* hb_ = HB; for (int r = gw; r < TT; r += ngw) merge_even_row(r, s_, o_, n0, n1, hb_, lane); }
    else { const bf16* s_ = S; const bf16* o_ = O; const float* n0 = ARG(29); const float* n1 = ARG(33); bf16* gb_ = GB; bf16* hb_ = HB; for (int r = gw; r < TL; r += ngw) merge_odd_row(r, s_, o_, n0, n1, gb_, hb_, lane); }
#endif
    XBAR();
    const int Mo = layer == 0 ? TT : TL;
    if (layer == 1) {
        pg8::Gemm g{GB, (const bf16*)(wsp(ws, WS_WGLU)), TL, 1024, 1024}; pg8::StaticOrder So; So.init(TL, 1024, G, (int)blockIdx.x);
        EpiGLU E{GB, ARG(31), HB};
        pg8::gemm_phase<EpiGLU, pg8::StaticOrder, true, true>(lds, g, So, E);
        XBAR();
    }
    { pg8::Gemm g{HB, (const bf16*)(wsp(ws, (layer == 0 ? WS_WOUT_EV : WS_WOUT_OD))), Mo, D, D}; pg8::SplitOrder So; So.init(Mo - TL, D, G, (int)blockIdx.x);
      EpiF32 E{Y, (float*)(wsp(ws, WS_YCP))};
      pg8::gemm_phase<EpiF32, pg8::SplitOrder, true, true>(lds, g, So, E); }
    XBAR();
}
#undef HB
#undef S
#undef GT
#undef O
#undef GB
#undef Y
#undef QK2
#undef GP
#undef QKS
#undef GPK
#undef PP
#undef RS
#undef VEC
#undef UNIT_OF
#undef SIBP

#ifndef MIXER_ON
#define MIXER_ON 1
#endif
__global__ void __launch_bounds__(NTHR, 2) fwd(Args a) {
    extern __shared__ __attribute__((aligned(16))) unsigned char lds_raw[];
    LAS unsigned char* lds = (LAS unsigned char*)lds_raw;
    const int tid = threadIdx.x, lane = tid & 63, wave = __builtin_amdgcn_readfirstlane(tid >> 6);
    const int G = gridDim.x, gw = blockIdx.x * NWAVES + wave, ngw = G * NWAVES;
    unsigned char* ws = a.ws;
    if (tid < 16) ((LAS unsigned*)(lds + MISC_OFF))[tid] = 0u;
    __syncthreads();
#ifdef PROBE_A
    if (blockIdx.x == 0 && tid == 0) { volatile LAS unsigned* M_ = (volatile LAS unsigned*)(lds + MISC_OFF); const unsigned lo_ = (unsigned)__builtin_amdgcn_s_memrealtime(); if (PROBE_A == 0) M_[6] = lo_; if (PROBE_B == 0) M_[8] = lo_; }
#endif
    XcdBarrier bar = xcd_barrier_post((unsigned*)(wsp(ws, WS_CTL)), (volatile LAS unsigned*)(lds + MISC_OFF));

#ifdef NAN_POISON
    {
        v4u q = (v4u){0xffffffffu, 0xffffffffu, 0xffffffffu, 0xffffffffu};
        for (int i = tid; i < (MISC_OFF) / 16; i += NTHR) ((LAS v4u*)lds)[i] = q;
        { v4u* p = (v4u*)(wsp(ws, WS_MOD)); const size_t n = (WS_WGU - WS_MOD) / 16; for (size_t i = (size_t)blockIdx.x * NTHR + tid; i < n; i += (size_t)G * NTHR) p[i] = q; }
        { v4u* p = (v4u*)(wsp(ws, WS_XC)); const size_t n = (WS_END - WS_XC) / 16; for (size_t i = (size_t)blockIdx.x * NTHR + tid; i < n; i += (size_t)G * NTHR) p[i] = q; }
        { v4u* p = (v4u*)a.out; const size_t n = (size_t)TL * D * 4 / 16; for (size_t i = (size_t)blockIdx.x * NTHR + tid; i < n; i += (size_t)G * NTHR) p[i] = q; }
        __syncthreads();
        XBAR();
    }
#endif
#define MOD ((float*)wsp(ws, WS_MOD))
#define MODP ((float*)wsp(ws, WS_MODP))
#define HB ((bf16*)wsp(ws, WS_HB))
#define HID ((bf16*)wsp(ws, WS_HID))
#define Y ((bf16*)wsp(ws, WS_Y))
#define XC ((float*)wsp(ws, WS_XC))

#ifndef REP_PRO
#define REP_PRO 1
#endif
#ifndef REP_GU
#define REP_GU 1
#endif
#ifndef REP_DN
#define REP_DN 1
#endif
#pragma unroll 1
    for (int rep_ = 0; rep_ < REP_PRO; ++rep_) {
        __syncthreads();
        LAS float* stab = (LAS float*)(lds + 1024);
        { const float* cin = ARG(1); const float* cctx = ARG(3);
        for (int i = tid; i < 5 * D; i += NTHR) { const int r = i >> 11, k = i & (D - 1); const float c = r < 4 ? cin[r * D + k] : cctx[k]; stab[i] = c / (1.0f + expf(-c)); } }
        __syncthreads();
        for (int it = gw; it < 2 * MOD_KC * 72; it += ngw) {
            const int l = it / (MOD_KC * 72), rem = it % (MOD_KC * 72), kc = rem / 72, jb = rem % 72; constexpr int KCH = D / MOD_KC;
            const float* W = ARG(4) + ((size_t)l * D + kc * KCH) * (NMOD * D) + jb * 256 + lane * 4;
            f32x4 acc[5];
#pragma unroll
            for (int r = 0; r < 5; ++r) acc[r] = (f32x4){0.f, 0.f, 0.f, 0.f};
            for (int k = 0; k < KCH; k += 8) { f32x4 w[8];
#pragma unroll
                for (int i = 0; i < 8; ++i) w[i] = *(const f32x4*)(W + (size_t)(k + i) * (NMOD * D));
#pragma unroll
                for (int i = 0; i < 8; ++i)
#pragma unroll
                    for (int r = 0; r < 5; ++r) acc[r] += stab[r * D + kc * KCH + k + i] * w[i]; }
            { float* modp = MODP;
#pragma unroll
            for (int r = 0; r < 5; ++r) *(f32x4*)(modp + (((size_t)l * MOD_KC + kc) * 5 + r) * (NMOD * D) + jb * 256 + lane * 4) = acc[r]; }
        }
        convert_tiles(a, ws, 0, gw, ngw, lane);
#ifndef DEFER
#define DEFER 1
#endif
        if (!DEFER) { convert_tiles(a, ws, 1, gw, ngw, lane); convert_tiles(a, ws, 2, gw, ngw, lane); }
        { v4u z = (v4u){0u, 0u, 0u, 0u}; v4u* p = (v4u*)(wsp(ws, WS_WIN_EV) + (size_t)EV_COLS * 2048 * 2); const int n16 = (EV_PAD - EV_COLS) * 2048 * 2 / 16;
          for (int i = blockIdx.x * NTHR + tid; i < n16; i += G * NTHR) p[i] = z; }
    }
    XBAR();
    { const float* bmod = ARG(5); const float* modp = MODP; float* modf = MOD;
    for (int i = blockIdx.x * NTHR + tid; i < 2 * 5 * NMOD * D; i += G * NTHR) {
        const int l = i / (5 * NMOD * D), rem = i % (5 * NMOD * D), r = rem / (NMOD * D), j = rem % (NMOD * D);
        float s = bmod[l * (NMOD * D) + j];
        for (int kc = 0; kc < MOD_KC; ++kc) s += modp[(((size_t)l * MOD_KC + kc) * 5 + r) * (NMOD * D) + j];
        modf[i] = s;
    } }
    XBAR();
#ifndef REP_N0
#define REP_N0 1
#endif
#pragma unroll 1
    for (int rep_ = 0; rep_ < REP_N0; ++rep_)
    { NormP p{}; p.xin_lat = ARG(0); p.xin_ctx = ARG(2); p.xout_lat = a.out; p.xout_ctx = XC; p.y = nullptr; p.h = HB; p.rows_end = TT; p.has_y = 0; p.has_h = 1; p.w = 0.f; p.lp = 0; p.sp = 0; p.ln = 0; p.sn = 0;
      norm_phase(p, MOD, ARG(6), ARG(7), lds, gw, ngw, tid, lane); }
    XBAR();

#pragma unroll 1
    for (int layer = 0; layer < 2; ++layer) {
#pragma unroll 1
        for (int half = 0; half < 2; ++half) {
            const int Mrows = (layer == 1 && half == 1) ? TL : TT;
#if MIXER_ON
            if (half == 1) {
                mixer_phases(a, ws, lds, bar, layer, G, gw, ngw, tid, lane, wave);
                NormP p{}; p.xin_lat = a.out; p.xin_ctx = XC; p.xout_lat = a.out; p.xout_ctx = XC; p.y = Y; p.y_ctx = (const float*)(wsp(ws, WS_YCP)); p.h = HB; p.rows_end = Mrows; p.has_y = 1; p.has_h = 1; p.w = 1.0f; p.lp = layer; p.sp = 1; p.ln = layer; p.sn = 2;
                norm_phase(p, MOD, ARG(6), ARG(7), lds, gw, ngw, tid, lane);
                XBAR();
            }
#endif
            const int sub = half * 2;
#pragma unroll 1
            for (int rep_ = 0; rep_ < REP_GU; ++rep_) { pg8::Gemm g{HB, (const bf16*)(wsp(ws, WS_WGU) + (size_t)(layer * 2 + half) * SZ_WGU), Mrows, 2 * DFF, D}; pg8::StaticOrder S; S.init(Mrows, 2 * DFF, G, (int)blockIdx.x);
              EpiSwiGLU E{HID, DFF};
              pg8::gemm_phase<EpiSwiGLU, pg8::StaticOrder, true, true>(lds, g, S, E);
              if (DEFER == 2 && rep_ == 0 && !(layer == 1 && half == 1)) {
                  const int rem = ((Mrows / 256) * (2 * DFF / 256)) % G, nidle = rem ? G - rem : G, me = rem ? (int)blockIdx.x - rem : (int)blockIdx.x;
                  if (me >= 0) { int t2 = threadIdx.x; asm volatile("" : "+v"(t2)); convert_tiles(a, ws, layer * 2 + half + 1, me * NWAVES + __builtin_amdgcn_readfirstlane(t2 >> 6), nidle * NWAVES, t2 & 63); } }
              if (rep_ + 1 < REP_GU) XBAR(); }
            XBAR();
#pragma unroll 1
            for (int rep_ = 0; rep_ < REP_DN; ++rep_) { pg8::Gemm g{HID, (const bf16*)(wsp(ws, WS_WD) + (size_t)(layer * 2 + half) * SZ_WD), Mrows, D, DFF}; pg8::SplitOrder S; S.init(Mrows - TL, DFF, G, (int)blockIdx.x);
              EpiF32 E{Y, (float*)(wsp(ws, WS_YCP))};
              pg8::gemm_phase<EpiF32, pg8::SplitOrder, true, true>(lds, g, S, E);
              if (rep_ + 1 < REP_DN) XBAR(); }
            XBAR();
            { NormP p{}; const bool first = (layer == 0 && half == 0);
              p.xin_lat = first ? ARG(0) : a.out; p.xin_ctx = first ? ARG(2) : XC; p.xout_lat = a.out; p.xout_ctx = XC; p.y = Y; p.y_ctx = (const float*)(wsp(ws, WS_YCP)); p.h = HB; p.rows_end = Mrows; p.has_y = 1; p.w = 0.5f; p.lp = layer; p.sp = sub;
              if (half == 0) { p.has_h = 1; p.ln = layer; p.sn = MIXER_ON ? 1 : 2; }
              else if (layer == 0) { p.has_h = 1; p.ln = 1; p.sn = 0; }
              else { p.has_h = 0; p.ln = 0; p.sn = 0; }
              norm_phase(p, MOD, ARG(6), ARG(7), lds, gw, ngw, tid, lane); }
            if (!(layer == 1 && half == 1)) XBAR();
        }
    }
#ifdef PROBE_A
    XBAR();
    if (blockIdx.x == 0 && threadIdx.x == 0) { volatile LAS unsigned* M_ = (volatile LAS unsigned*)(lds + MISC_OFF);
        const unsigned ticks = (M_[7] - M_[6]) + (PROBE_B >= 0 ? (M_[9] - M_[8]) : 0u);
        const unsigned long long t0 = __builtin_amdgcn_s_memrealtime();
        while (__builtin_amdgcn_s_memrealtime() - t0 < 8ull * ticks) __builtin_amdgcn_s_sleep(8); }
#endif
}

#undef MOD
#undef MODP
#undef HB
#undef HID
#undef Y
#undef XC
extern "C" void kernel_launch(void* const* d_in, const int* in_sizes, int n_in, void* d_out, int out_size, void* d_ws, size_t ws_size, hipStream_t stream) {
    static int grid = 0;
    if (grid == 0) {
        if (n_in != 34 || out_size != TL * D || ws_size < WS_END) { fprintf(stderr, "kernel_launch: unexpected shapes (n_in %d out %d ws %zu need %zu)\n", n_in, out_size, ws_size, (size_t)WS_END); grid = -1; return; }
        int dev = 0, cus = 0, per_cu = 0;
        if (hipGetDevice(&dev) != hipSuccess || hipDeviceGetAttribute(&cus, hipDeviceAttributeMultiprocessorCount, dev) != hipSuccess) { grid = -1; return; }
        if (hipFuncSetAttribute((const void*)fwd, hipFuncAttributeMaxDynamicSharedMemorySize, LDS_BYTES) != hipSuccess) { fprintf(stderr, "kernel_launch: hipFuncSetAttribute failed\n"); grid = -1; return; }
        if (hipOccupancyMaxActiveBlocksPerMultiprocessor(&per_cu, (const void*)fwd, NTHR, LDS_BYTES) != hipSuccess || per_cu < 1) { fprintf(stderr, "kernel_launch: occupancy query says %d\n", per_cu); }
        (void)hipGetLastError();
        grid = cus;
    }
    if (grid < 0) return;
    if (hipMemsetAsync((char*)d_ws + WS_CTL, 0, CTL_ZERO_BYTES, stream) != hipSuccess) return;
    Args a{};
    for (int i = 0; i < 34; ++i) a.in[i] = (const float*)d_in[i];
    a.out = (float*)d_out; a.ws = (unsigned char*)d_ws;
    hipLaunchKernelGGL(fwd, dim3(grid), dim3(NTHR), LDS_BYTES, stream, a);
}
```

```cpp
#include <hip/hip_runtime.h>
#include <cstdio>
#include <cstdint>
#define MIXER_ON 1

#define XB_TMO      128
#define XB_XCNT(j)  (256  + 64 * (j))
#define XB_XSUB(j)  (1280 + 64 * (j))
#define XB_XGEN(j)  (2304 + 64 * (j))
#define XB_TOP      3328
#define XB_TOPGEN   3392
#define XCD_BAR_WORDS 3456
#define XB_SPIN_CAP (1u << 18)
#define LAS __attribute__((address_space(3)))

__device__ __forceinline__ unsigned xb_ld(unsigned* p)              { return __hip_atomic_load(p, __ATOMIC_RELAXED, __HIP_MEMORY_SCOPE_AGENT); }
__device__ __forceinline__ unsigned xb_add(unsigned* p, unsigned v) { return __hip_atomic_fetch_add(p, v, __ATOMIC_RELAXED, __HIP_MEMORY_SCOPE_AGENT); }
__device__ __forceinline__ unsigned xb_xcc_id() { return (unsigned)__builtin_amdgcn_s_getreg((3 << 11) | 20) & 0xFu; }
#define XB_SPIN(cond, bar) do { unsigned _sp = 0; while (cond) { __builtin_amdgcn_s_sleep(1); \
    if ((++_sp & 255u) == 0u) { if (xb_ld(&(bar)[XB_TMO])) break; if (_sp > XB_SPIN_CAP) { atomicAdd(&(bar)[XB_TMO], 1u); break; } } } } while (0)

struct XcdBarrier {
    unsigned* bar; unsigned x;
    volatile LAS unsigned* st;
};

__device__ __forceinline__ XcdBarrier xcd_barrier_post(unsigned* bar, volatile LAS unsigned* st) {
    XcdBarrier b; b.bar = bar; b.x = xb_xcc_id(); b.st = st;
    if (threadIdx.x == 0) (void)xb_add(&bar[XB_XCNT(b.x)], 1u);
    return b;
}
__device__ __forceinline__ void xcd_barrier_complete(unsigned* bar, unsigned x, unsigned& nloc, unsigned& nx) {
    const unsigned G = gridDim.x * gridDim.y * gridDim.z;
    unsigned sum, cnt, mine, sp = 0u;
    for (;;) {
        sum = 0u; cnt = 0u; mine = 0u;
#pragma unroll
        for (unsigned j = 0; j < 16; ++j) { const unsigned c = xb_ld(&bar[XB_XCNT(j)]); sum += c; cnt += (c > 0u) ? 1u : 0u; mine = (j == x) ? c : mine; }
        if (sum == G) break;
        __builtin_amdgcn_s_sleep(1);
        if ((++sp & 255u) == 0u) { if (xb_ld(&bar[XB_TMO])) break; if (sp > XB_SPIN_CAP) { atomicAdd(&bar[XB_TMO], 1u); break; } }
    }
    nloc = mine > 0u ? mine : 1u; nx = cnt > 0u ? cnt : 1u;
}

__device__ __forceinline__ void xcd_barrier(const XcdBarrier& b) {
    asm volatile("s_waitcnt vmcnt(0)" ::: "memory");
    __syncthreads();
    if (threadIdx.x == 0) {
        unsigned* bar = b.bar;
        unsigned bx = __builtin_amdgcn_readfirstlane(b.x); asm volatile("" : "+s"(bx));
        __builtin_amdgcn_s_waitcnt(0);
        unsigned nloc = b.st[0], nx = b.st[1];
        if (nloc == 0u) { xcd_barrier_complete(bar, bx, nloc, nx); b.st[0] = nloc; b.st[1] = nx; }
        const unsigned old = xb_add(&bar[XB_XSUB(bx)], 1u);
        const unsigned gen = old / nloc;
        if (old + 1u == (gen + 1u) * nloc) {
            __builtin_amdgcn_fence(__ATOMIC_RELEASE, "agent");
            asm volatile("s_waitcnt vmcnt(0)" ::: "memory");
            const unsigned og = xb_add(&bar[XB_TOP], 1u);
            const unsigned tg = og / nx;
            if (og + 1u == (tg + 1u) * nx) xb_add(&bar[XB_TOPGEN], 1u);
            else XB_SPIN(xb_ld(&bar[XB_TOPGEN]) == tg, bar);
            __builtin_amdgcn_fence(__ATOMIC_ACQUIRE, "agent");
            xb_add(&bar[XB_XGEN(bx)], 1u);
            asm volatile("s_waitcnt vmcnt(0)" ::: "memory");
        } else {
            XB_SPIN(xb_ld(&bar[XB_XGEN(bx)]) == gen, bar);
            __builtin_amdgcn_fence(__ATOMIC_ACQUIRE, "agent");
            asm volatile("s_waitcnt vmcnt(0)" ::: "memory");
        }
    }
    __syncthreads();
}

namespace pg8 {
#define PG8_LAS __attribute__((address_space(3)))
typedef unsigned short bf16_t;
typedef short bf16x8 __attribute__((ext_vector_type(8)));
typedef float f32x4 __attribute__((ext_vector_type(4)));
typedef unsigned u32x4 __attribute__((ext_vector_type(4)));
constexpr int BM = 256, BK = 64, HALF = 128, HTB = HALF * BK * 2  , STAGE_BYTES = 8 * HTB, NXCD = 8, WGM = 8;

__host__ __device__ __forceinline__ int lds_byte(int r, int c) { const int st = (r >> 4) * 2 + (c >> 5), rr = r & 15, cc = c & 31, ob = rr * 64 + cc * 2; return st * 1024 + (ob ^ (((ob >> 9) & 1) << 5)); }
__host__ __device__ __forceinline__ void stage_rc(int b, int& R, int& C) { const int st = b / 1024, sb = b % 1024, swz = sb ^ (((sb >> 9) & 1) << 5); R = (st >> 1) * 16 + swz / 64; C = (st & 1) * 32 + (swz % 64) / 2; }
__host__ __device__ __forceinline__ int perm32(int rho) { const int n = rho >> 4, i = rho & 15; return 8 * (i >> 2) + 4 * n + (i & 3); }

struct Unit { int pm, pn, k0, nt, part; };
struct Gemm { const bf16_t* A; const bf16_t* Bt; int M, N, K; };

struct StaticOrder {
    int nM, nN, nwg, G, c;
    __host__ __device__ void init(int M, int N, int G_, int c_) { nM = M / BM; nN = N / BM; nwg = nM * nN; G = G_; c = c_; }
    __host__ __device__ bool next(int i, Unit& u) const {
        const long L = (long)i * G + c; if (L >= nwg) return false;
        int wgid = (int)L; { const int q = nwg / NXCD, r = nwg % NXCD, xcd = wgid % NXCD, off = wgid / NXCD; wgid = (xcd < r ? xcd * (q + 1) : r * (q + 1) + (xcd - r) * q) + off; }
        const int nig = WGM * nN, gid = wgid / nig, fm = gid * WGM, gsz = (nM - fm) < WGM ? (nM - fm) : WGM;
        u.pm = fm + ((wgid % nig) % gsz); u.pn = (wgid % nig) / gsz; u.k0 = 0; u.nt = 0; u.part = -1; return true;
    }
    __device__ __forceinline__ void a_ready(const Unit&) const {}
    __device__ __forceinline__ void done(const Unit&) const {}
};
struct SplitOrder {
    static constexpr int NMF = 64, NN = 8, PARTS = 8, NFULL = NMF * NN;
    int nsplit, ntK, G, c;
    __host__ __device__ void init(int Msplit, int K, int G_, int c_) { nsplit = (Msplit / BM) * NN * PARTS; ntK = K / BK; G = G_; c = c_; }
    __host__ __device__ bool next(int i, Unit& u) const {
        const int L = i * G + c, p = L - NFULL; const bool fullu = L < NFULL;
        const int wgid = (L % NXCD) * (NFULL / NXCD) + L / NXCD, nig = WGM * NN, fm = (wgid / nig) * WGM;
        const int q = p & 7, cu = p >> 3, h = ntK >> 1, ks = ((h * q) >> 3) << 1, ke = ((h * (q + 1)) >> 3) << 1;
        u.pm = fullu ? fm + ((wgid % nig) % WGM) : NMF + (cu >> 3);
        u.pn = fullu ? (wgid % nig) / WGM : (cu & 7);
        u.k0 = fullu ? 0 : ks; u.nt = fullu ? 0 : ke - ks; u.part = fullu ? -1 : q;
        return fullu || p < nsplit;
    }
    __device__ __forceinline__ void a_ready(const Unit&) const {}
    __device__ __forceinline__ void done(const Unit&) const {}
};
__device__ __forceinline__ unsigned cvt_pk_bf16(float lo, float hi) { unsigned r; asm volatile("v_cvt_pk_bf16_f32 %0, %1, %2" : "=v"(r) : "v"(lo), "v"(hi)); return r; }
template <class Epi, class Sched, bool ALIGN_EPI = false, bool SP2 = false>
__device__ __forceinline__ void gemm_phase(PG8_LAS unsigned char* lds, const Gemm g, const Sched& S, const Epi& E) {
    int tid_ = threadIdx.x; asm volatile("" : "+v"(tid_));
    const int tid = tid_, wid = __builtin_amdgcn_readfirstlane(tid >> 6), lane = tid & 63, wr = wid >> 2, wc = wid & 3, fr = lane & 15, fq = lane >> 4;
    const int K = g.K, nt = K / BK;
    unsigned voffA[2], voffB[2];
#pragma unroll
    for (int i = 0; i < 2; ++i) { int R, C; stage_rc(tid * 16 + i * 8192, R, C); const int Rb = Epi::PERM ? ((R & ~31) + perm32(R & 31)) : R;
        voffA[i] = (unsigned)(R * K + C) * 2u; voffB[i] = (unsigned)(Rb * K + C) * 2u; }
    const unsigned kstep = BK * 2;
    const unsigned hstep = (unsigned)HALF * K * 2;
    const unsigned tstep = 2 * hstep;
    const unsigned ldsw = (unsigned)wid * 1024u;
    const int aoff = lds_byte(wr * 64 + fr, fq * 8), boff = lds_byte(wc * 32 + fr, fq * 8);
#define PG8_SA(b, h) (((b) * 2 + (h)) * HTB)
#define PG8_SB(b, h) ((4 + (b) * 2 + (h)) * HTB)
#define PG8_STAGE(bufoff, gbase, voff) do { _Pragma("unroll") for (int _i = 0; _i < 2; ++_i) \
        __builtin_amdgcn_global_load_lds((const unsigned*)((const char*)(gbase) + (voff)[_i]), (PG8_LAS unsigned*)(lds + (bufoff) + ldsw + _i * 8192), 16, 0, 0); } while (0)
#define PG8_LDA(dst, b, h) do { _Pragma("unroll") for (int m = 0; m < 4; ++m) _Pragma("unroll") for (int k = 0; k < 2; ++k) dst[m][k] = *(const PG8_LAS bf16x8*)(lds + PG8_SA(b, h) + aoff + m * 2048 + k * 1024); } while (0)
#define PG8_LDB(dst, b, h) do { _Pragma("unroll") for (int n = 0; n < 2; ++n) _Pragma("unroll") for (int k = 0; k < 2; ++k) dst[n][k] = *(const PG8_LAS bf16x8*)(lds + PG8_SB(b, h) + boff + n * 2048 + k * 1024); } while (0)
#define PG8_MMA(ai, bj, At, Bt) do { __builtin_amdgcn_s_setprio(1); _Pragma("unroll") for (int m = 0; m < 4; ++m) _Pragma("unroll") for (int n = 0; n < 2; ++n) _Pragma("unroll") for (int k = 0; k < 2; ++k) \
        acc[ai][bj][m][n] = __builtin_amdgcn_mfma_f32_16x16x32_bf16(Bt[n][k], At[m][k], acc[ai][bj][m][n], 0, 0, 0); __builtin_amdgcn_s_setprio(0); } while (0)
#define PG8_WAIT_V(n) asm volatile("s_waitcnt vmcnt(" #n ")" ::: "memory")
#define PG8_WAIT_L(n) asm volatile("s_waitcnt lgkmcnt(" #n ")" ::: "memory")
#define PG8_BAR __builtin_amdgcn_s_barrier()
#define PG8_SCHED __builtin_amdgcn_sched_barrier(0)
    Unit cur, nxt; int ui = 0;
    if (!S.next(0, cur)) return;
    f32x4 acc[2][2][4][2];
#pragma unroll
    for (int a = 0; a < 2; ++a)
#pragma unroll
        for (int b = 0; b < 2; ++b)
#pragma unroll
            for (int m = 0; m < 4; ++m)
#pragma unroll
                for (int n = 0; n < 2; ++n) acc[a][b][m][n] = (f32x4){0.f, 0.f, 0.f, 0.f};
    bf16x8 At[4][2], B0[2][2], B1[2][2];
    unsigned cA = (unsigned)cur.pm * tstep + (unsigned)cur.k0 * kstep, cB = (unsigned)cur.pn * tstep + (unsigned)cur.k0 * kstep;
    S.a_ready(cur);
    if constexpr (SP2) {
        PG8_STAGE(PG8_SB(0, 0), (const char*)g.Bt + (size_t)(cB), voffB); PG8_STAGE(PG8_SB(0, 1), (const char*)g.Bt + (size_t)(cB + hstep), voffB); PG8_STAGE(PG8_SA(0, 0), (const char*)g.A + (size_t)(cA), voffA); PG8_STAGE(PG8_SA(0, 1), (const char*)g.A + (size_t)(cA + hstep), voffA);
        if (wr == 1) PG8_BAR;
        PG8_WAIT_V(2); PG8_BAR;
        PG8_STAGE(PG8_SB(1, 0), (const char*)g.Bt + (size_t)(cB + kstep), voffB); PG8_STAGE(PG8_SA(1, 0), (const char*)g.A + (size_t)(cA + kstep), voffA); PG8_STAGE(PG8_SB(1, 1), (const char*)g.Bt + (size_t)(cB + hstep + kstep), voffB);
        PG8_WAIT_V(6); PG8_BAR;
    } else {
        PG8_STAGE(PG8_SB(0, 0), (const char*)g.Bt + (size_t)(cB), voffB); PG8_STAGE(PG8_SA(0, 0), (const char*)g.A + (size_t)(cA), voffA); PG8_STAGE(PG8_SB(0, 1), (const char*)g.Bt + (size_t)(cB + hstep), voffB); PG8_STAGE(PG8_SA(0, 1), (const char*)g.A + (size_t)(cA + hstep), voffA);
        if (wr == 1) PG8_BAR;
        PG8_WAIT_V(4); PG8_BAR;
        PG8_STAGE(PG8_SB(1, 0), (const char*)g.Bt + (size_t)(cB + kstep), voffB); PG8_STAGE(PG8_SA(1, 0), (const char*)g.A + (size_t)(cA + kstep), voffA); PG8_STAGE(PG8_SB(1, 1), (const char*)g.Bt + (size_t)(cB + hstep + kstep), voffB);
        PG8_WAIT_V(6); PG8_BAR;
    }
    for (;;) {
        const bool has_next = S.next(ui + 1, nxt);
        const unsigned nA = has_next ? (unsigned)nxt.pm * tstep + (unsigned)nxt.k0 * kstep : cA, nB = has_next ? (unsigned)nxt.pn * tstep + (unsigned)nxt.k0 * kstep : cB;
        const int unt = cur.nt ? cur.nt : nt;
        for (int t = 0; t < unt; t += 2) {
            const bool last = (t == unt - 2);
            const unsigned a1 = cA + (unsigned)(t + 1) * kstep;
            const unsigned a2 = last ? nA : cA + (unsigned)(t + 2) * kstep, b2 = last ? nB : cB + (unsigned)(t + 2) * kstep;
            const unsigned a3 = a2 + kstep, b3 = b2 + kstep;
            if (last && has_next) S.a_ready(nxt);
            if constexpr (SP2) {
            PG8_LDB(B0, 0, 0); PG8_LDB(B1, 0, 1); PG8_SCHED; PG8_LDA(At, 0, 0); PG8_STAGE(PG8_SA(1, 1), (const char*)g.A + (size_t)(a1 + hstep), voffA);
            PG8_WAIT_V(8); PG8_WAIT_L(0); PG8_BAR; PG8_MMA(0, 0, At, B0); PG8_MMA(0, 1, At, B1); PG8_BAR; PG8_SCHED;
            PG8_LDA(At, 0, 1); PG8_STAGE(PG8_SB(0, 0), (const char*)g.Bt + (size_t)(b2), voffB); PG8_STAGE(PG8_SB(0, 1), (const char*)g.Bt + (size_t)(b2 + hstep), voffB); PG8_STAGE(PG8_SA(0, 0), (const char*)g.A + (size_t)(a2), voffA);
            PG8_WAIT_V(8); PG8_WAIT_L(0); PG8_BAR; PG8_MMA(1, 0, At, B0); PG8_MMA(1, 1, At, B1); PG8_BAR; PG8_SCHED;
            PG8_LDB(B0, 1, 0); PG8_LDB(B1, 1, 1); PG8_SCHED; PG8_LDA(At, 1, 0); PG8_STAGE(PG8_SA(0, 1), (const char*)g.A + (size_t)(a2 + hstep), voffA);
            PG8_WAIT_V(8); PG8_WAIT_L(0); PG8_BAR; PG8_MMA(0, 0, At, B0); PG8_MMA(0, 1, At, B1); PG8_BAR; PG8_SCHED;
            PG8_LDA(At, 1, 1); PG8_STAGE(PG8_SB(1, 0), (const char*)g.Bt + (size_t)(b3), voffB); PG8_STAGE(PG8_SB(1, 1), (const char*)g.Bt + (size_t)(b3 + hstep), voffB); PG8_STAGE(PG8_SA(1, 0), (const char*)g.A + (size_t)(a3), voffA);
            PG8_WAIT_V(8); PG8_WAIT_L(0); PG8_BAR; PG8_MMA(1, 0, At, B0); PG8_MMA(1, 1, At, B1); PG8_BAR; PG8_SCHED;
            } else {
            PG8_LDB(B0, 0, 0); PG8_SCHED; PG8_LDA(At, 0, 0); PG8_STAGE(PG8_SA(1, 1), (const char*)g.A + (size_t)(a1 + hstep), voffA);
            PG8_WAIT_L(8); PG8_BAR; PG8_WAIT_L(0); PG8_MMA(0, 0, At, B0); PG8_BAR; PG8_SCHED;
            PG8_LDB(B1, 0, 1); PG8_STAGE(PG8_SB(0, 0), (const char*)g.Bt + (size_t)(b2), voffB);
            PG8_BAR; PG8_WAIT_L(0); PG8_MMA(0, 1, At, B1); PG8_BAR;
            PG8_LDA(At, 0, 1); PG8_STAGE(PG8_SA(0, 0), (const char*)g.A + (size_t)(a2), voffA);
            PG8_BAR; PG8_WAIT_L(0); PG8_MMA(1, 0, At, B0); PG8_BAR; PG8_SCHED;
            PG8_STAGE(PG8_SB(0, 1), (const char*)g.Bt + (size_t)(b2 + hstep), voffB);
            PG8_WAIT_V(6); PG8_BAR; PG8_MMA(1, 1, At, B1); PG8_BAR;
            PG8_LDB(B0, 1, 0); PG8_SCHED; PG8_LDA(At, 1, 0); PG8_STAGE(PG8_SA(0, 1), (const char*)g.A + (size_t)(a2 + hstep), voffA);
            PG8_WAIT_L(8); PG8_BAR; PG8_WAIT_L(0); PG8_MMA(0, 0, At, B0); PG8_BAR; PG8_SCHED;
            PG8_LDB(B1, 1, 1); PG8_STAGE(PG8_SB(1, 0), (const char*)g.Bt + (size_t)(b3), voffB);
            PG8_BAR; PG8_WAIT_L(0); PG8_MMA(0, 1, At, B1); PG8_BAR;
            PG8_LDA(At, 1, 1); PG8_STAGE(PG8_SA(1, 0), (const char*)g.A + (size_t)(a3), voffA);
            PG8_BAR; PG8_WAIT_L(0); PG8_MMA(1, 0, At, B0); PG8_BAR; PG8_SCHED;
            PG8_STAGE(PG8_SB(1, 1), (const char*)g.Bt + (size_t)(b3 + hstep), voffB);
            PG8_WAIT_V(6); PG8_BAR; PG8_MMA(1, 1, At, B1); PG8_BAR;
            }
        }
        if constexpr (ALIGN_EPI) { if (wr == 0) PG8_BAR; }
        if constexpr (!Epi::AFTER_DRAIN) { int t_ = threadIdx.x; asm volatile("" : "+v"(t_)); const int l_ = t_ & 63, w_ = __builtin_amdgcn_readfirstlane(t_ >> 6);
            E(acc, cur, w_ >> 2, w_ & 3, l_ & 15, l_ >> 4); S.done(cur); }
        if (!has_next) break;
#pragma unroll
        for (int a = 0; a < 2; ++a)
#pragma unroll
            for (int b = 0; b < 2; ++b)
#pragma unroll
                for (int m = 0; m < 4; ++m)
#pragma unroll
                    for (int n = 0; n < 2; ++n) acc[a][b][m][n] = (f32x4){0.f, 0.f, 0.f, 0.f};
        cur = nxt; cA = nA; cB = nB; ++ui;
        if constexpr (ALIGN_EPI) { if (wr == 1) PG8_BAR; }
    }
    PG8_WAIT_V(0);
    if constexpr (!ALIGN_EPI) { if (wr == 0) PG8_BAR; }
    PG8_BAR;
    if constexpr (Epi::AFTER_DRAIN) { E.fused(acc, cur, wr, wc, fr, fq, lds, wid, lane); S.done(cur); }
#undef PG8_SA
#undef PG8_SB
#undef PG8_STAGE
#undef PG8_LDA
#undef PG8_LDB
#undef PG8_MMA
#undef PG8_WAIT_V
#undef PG8_WAIT_L
#undef PG8_BAR
#undef PG8_SCHED
}
}

#define GAS __attribute__((address_space(1)))
typedef unsigned short bf16;
typedef float f32x4 __attribute__((ext_vector_type(4)));
typedef unsigned v4u __attribute__((ext_vector_type(4)));
typedef unsigned v2u __attribute__((ext_vector_type(2)));
constexpr int D = 2048, NB = 4, SEQ = 4096, CTXL = 256, DFF = 5504, NMOD = 9;
constexpr int TL = NB * SEQ, TC = NB * CTXL, TT = TL + TC;
constexpr int MIXH = 1024;
constexpr int EV_COLS = 7216, EV_PAD = 7424, OD_COLS = 5120;
constexpr int NWAVES = 8, NTHR = 512;
constexpr float EPS = 1e-6f;

constexpr size_t MiB = 1u << 20;
constexpr size_t WS_CTL = 0, CTL_ZERO_BYTES = 64 * 1024;
constexpr size_t WS_MOD = 1 * MiB;
constexpr size_t WS_MODP = 2 * MiB;
constexpr int MOD_KC = 16;
constexpr size_t WS_WGU = 16 * MiB;
constexpr size_t SZ_WGU = (size_t)11008 * 2048 * 2;
constexpr size_t WS_WD = WS_WGU + 4 * SZ_WGU;
constexpr size_t SZ_WD = (size_t)2048 * 5504 * 2;
constexpr size_t WS_WIN_EV = WS_WD + 4 * SZ_WD;
constexpr size_t WS_WOUT_EV = WS_WIN_EV + (size_t)EV_PAD * 2048 * 2;
constexpr size_t WS_WIN_OD = WS_WOUT_EV + (size_t)2048 * 2048 * 2;
constexpr size_t WS_WOUT_OD = WS_WIN_OD + (size_t)OD_COLS * 2048 * 2;
constexpr size_t WS_WGLU = WS_WOUT_OD + (size_t)2048 * 2048 * 2;
constexpr size_t WS_XC = WS_WGLU + (size_t)1024 * 1024 * 2;
constexpr size_t WS_HB = WS_XC + (size_t)TC * D * 4;
constexpr size_t WS_R = WS_HB + (size_t)TT * D * 2;
constexpr size_t WS_HID = WS_R;
constexpr size_t WS_Y = WS_R + 183 * MiB;
constexpr size_t WS_S = WS_R;
constexpr size_t WS_GT = WS_R + 247 * MiB;
constexpr size_t WS_GB = WS_R + 264 * MiB;
constexpr size_t WS_O = WS_R + 298 * MiB;
constexpr size_t SZ_O = (size_t)TT * 1024 * 2;
constexpr size_t WS_XL = WS_R + 434 * MiB;
constexpr size_t WS_QK2 = WS_XL + (size_t)TL * D * 2;
constexpr size_t WS_GP = WS_QK2 + (size_t)TT * 2048 * 2;
constexpr size_t WS_QKS = WS_GP + (size_t)TT * 8 * 4 * 4;
constexpr size_t WS_VEC = WS_QKS + (size_t)2 * TT * 1024 * 2;
constexpr size_t WS_GPK = WS_VEC + (size_t)NB * 4 * 2 * 68 * 384 * 4;
constexpr size_t WS_PP = WS_GPK + (size_t)NB * 4 * 2 * 68 * 256 * 4;
constexpr size_t WS_RS = WS_PP + (size_t)NB * 4 * 2 * 68 * 4096 * 2;
constexpr size_t WS_END = WS_RS + (size_t)NB * 4 * 2 * 68 * 64 * 4;
constexpr size_t WS_YCP = WS_R + 320 * MiB;
constexpr int YPARTS = 8;
static_assert(WS_YCP >= WS_Y + (size_t)TT * D * 2 && WS_YCP + (size_t)YPARTS * TC * D * 4 <= WS_XL && WS_O + 4 * SZ_O <= WS_XL, "ws map");
static_assert(WS_HID + (size_t)TT * DFF * 2 <= WS_Y && WS_S + (size_t)TT * EV_PAD * 2 <= WS_GT && WS_GT + (size_t)TT * 256 * 4 <= WS_GB && WS_GB + (size_t)TT * 1024 * 2 <= WS_O, "ws map");
static_assert(WS_Y + (size_t)TT * D * 2 <= WS_O, "ws map");

constexpr int LDS_BYTES = 156 * 1024;
constexpr int MISC_OFF = LDS_BYTES - 64;

struct Args { const float* in[34]; float* out; unsigned char* ws; };
#ifdef PROBE_A
#ifndef PROBE_A1
#define PROBE_A1 PROBE_A
#endif
#ifndef PROBE_B
#define PROBE_B -100
#endif
#ifndef PROBE_B1
#define PROBE_B1 PROBE_B
#endif
#define XBAR() do { xcd_barrier(bar); if (blockIdx.x == 0 && threadIdx.x == 0) { volatile LAS unsigned* M_ = (volatile LAS unsigned*)(lds + MISC_OFF); const unsigned c_ = M_[4]; \
        const unsigned long long t_ = __builtin_amdgcn_s_memrealtime(); const unsigned lo_ = (unsigned)t_; \
        if ((int)c_ == PROBE_A - 1) M_[6] = lo_; if ((int)c_ == PROBE_A1) M_[7] = lo_; if ((int)c_ == PROBE_B - 1) M_[8] = lo_; if ((int)c_ == PROBE_B1) M_[9] = lo_; M_[4] = c_ + 1u; } } while (0)
#else
#define XBAR() xcd_barrier(bar)
#endif
#define ARG(k) ((const float*)(GAS const float*)(a.in[opaque_idx(k)]))
__device__ __forceinline__ unsigned char* wsp(unsigned char* w, size_t off) { asm volatile("" : "+s"(off)); return w + off; }
__device__ __forceinline__ int opaque_idx(int k) { asm volatile("" : "+s"(k)); return k; }

__device__ __forceinline__ unsigned f2bf(float f) { unsigned u = __float_as_uint(f); u += 0x7FFFu + ((u >> 16) & 1u); return u >> 16; }
typedef __bf16 bf16x2_t __attribute__((ext_vector_type(2)));
typedef float f32x2_t __attribute__((ext_vector_type(2)));
__device__ __forceinline__ unsigned pk2(float lo, float hi) { const f32x2_t v = {lo, hi}; const bf16x2_t b = __builtin_convertvector(v, bf16x2_t); return __builtin_bit_cast(unsigned, b); }
__device__ __forceinline__ float bf2f(unsigned short b) { return __uint_as_float(((unsigned)b) << 16); }
__device__ __forceinline__ float wave_sum(float v) {
#pragma unroll
    for (int o = 1; o < 64; o <<= 1) v += __shfl_xor(v, o);
    return v;
}
__device__ __forceinline__ float fast_silu(float g) { return g * __builtin_amdgcn_rcpf(1.0f + __expf(-g)); }
__device__ __forceinline__ float fast_sigmoid(float g) { return __builtin_amdgcn_rcpf(1.0f + __expf(-g)); }

#ifndef DEFER
#define DEFER 2
#endif
struct TJob { const float* src; bf16* dst; int K, N, map; };
constexpr int NT_FFN = 5504, NT_EVIN = 32 * 226, NT_SQ = 2048, NT_ODIN = 32 * 160, NT_GLU = 512;
constexpr int NT_SET0 = 6 * NT_FFN + NT_EVIN + NT_SQ + NT_ODIN + NT_SQ + NT_GLU, NT_SET1 = 3 * NT_FFN, NT_SET2 = 3 * NT_FFN;
__device__ __forceinline__ void transpose_tile(const TJob& j, int tl, int lane) {
    const int nblk = (j.N + 31) / 32, kb = tl / nblk, nb = tl % nblk, k0 = 64 * kb, n0 = 32 * nb;
    const int kb8 = lane >> 3, nb4 = lane & 7, n = n0 + 4 * nb4;
    int drow0;
    if (j.map == 0) drow0 = n0;
    else if (j.map == 1) drow0 = (n0 / 128) * 256 + (n0 % 128);
    else if (j.map == 2) drow0 = (n0 / 128) * 256 + (n0 % 128) + 128;
    else drow0 = (nb < 96) ? n0 : (nb == 96 ? 7168 : (nb < 225 ? n0 - 32 : 7200));
    if (n < j.N) {
        const float* s = j.src + (size_t)(k0 + 8 * kb8) * j.N + n;
        f32x4 v[8];
#pragma unroll
        for (int i = 0; i < 8; ++i) v[i] = *(const f32x4*)(s + (size_t)i * j.N);
        bf16* d = j.dst + (size_t)(drow0 + 4 * nb4) * j.K + k0 + 8 * kb8;
#pragma unroll
        for (int e = 0; e < 4; ++e) { v4u o; o.x = pk2(v[0][e], v[1][e]); o.y = pk2(v[2][e], v[3][e]); o.z = pk2(v[4][e], v[5][e]); o.w = pk2(v[6][e], v[7][e]);
            *(v4u*)(d + (size_t)e * j.K) = o; }
    }
}

__device__ __forceinline__ void transpose_tile2(const TJob& j, int tl0, int tl1, int lane) {
    const int nblk = (j.N + 31) / 32; const int kb8 = lane >> 3, nb4 = lane & 7;
    f32x4 v[2][8]; int drow[2], k0s[2]; bool ok[2];
#pragma unroll
    for (int u = 0; u < 2; ++u) { const int tl = u ? tl1 : tl0; const int kb = tl / nblk, nb = tl % nblk, k0 = 64 * kb, n0 = 32 * nb, n = n0 + 4 * nb4;
        int drow0;
        if (j.map == 0) drow0 = n0;
        else if (j.map == 1) drow0 = (n0 / 128) * 256 + (n0 % 128);
        else if (j.map == 2) drow0 = (n0 / 128) * 256 + (n0 % 128) + 128;
        else drow0 = (nb < 96) ? n0 : (nb == 96 ? 7168 : (nb < 225 ? n0 - 32 : 7200));
        drow[u] = drow0; k0s[u] = k0; ok[u] = n < j.N;
        if (ok[u]) { const float* s = j.src + (size_t)(k0 + 8 * kb8) * j.N + n;
#pragma unroll
            for (int i = 0; i < 8; ++i) v[u][i] = *(const f32x4*)(s + (size_t)i * j.N); } }
#pragma unroll
    for (int u = 0; u < 2; ++u) if (ok[u]) { bf16* d = j.dst + (size_t)(drow[u] + 4 * nb4) * j.K + k0s[u] + 8 * kb8;
#pragma unroll
        for (int e = 0; e < 4; ++e) { v4u o; o.x = pk2(v[u][0][e], v[u][1][e]); o.y = pk2(v[u][2][e], v[u][3][e]); o.z = pk2(v[u][4][e], v[u][5][e]); o.w = pk2(v[u][6][e], v[u][7][e]);
            *(v4u*)(d + (size_t)e * j.K) = o; } }
}
__device__ __forceinline__ TJob make_job(const Args& a, unsigned char* ws, int id) {
    TJob j;
    if (id < 12) { const int li = id / 3, kind = id % 3; const size_t wo = (size_t)li * 2048 * 5504;
        j.src = ARG(8 + kind) + wo;
        if (kind == 2) { j.K = 5504; j.N = 2048; j.map = 0; j.dst = (bf16*)(wsp(ws, WS_WD) + (size_t)li * SZ_WD); }
        else { j.K = 2048; j.N = 5504; j.map = 1 + kind; j.dst = (bf16*)(wsp(ws, WS_WGU) + (size_t)li * SZ_WGU); } }
    else if (id == 12) { j.src = ARG(11); j.K = 2048; j.N = EV_COLS; j.map = 3; j.dst = (bf16*)wsp(ws, WS_WIN_EV); }
    else if (id == 13) { j.src = ARG(12); j.K = 2048; j.N = 2048; j.map = 0; j.dst = (bf16*)wsp(ws, WS_WOUT_EV); }
    else if (id == 14) { j.src = ARG(20); j.K = 2048; j.N = OD_COLS; j.map = 0; j.dst = (bf16*)wsp(ws, WS_WIN_OD); }
    else if (id == 15) { j.src = ARG(21); j.K = 2048; j.N = 2048; j.map = 0; j.dst = (bf16*)wsp(ws, WS_WOUT_OD); }
    else { j.src = ARG(30); j.K = 1024; j.N = 1024; j.map = 0; j.dst = (bf16*)wsp(ws, WS_WGLU); }
    return j;
}
__device__ __forceinline__ void convert_tiles(const Args& a, unsigned char* ws, int set, int wave_index, int nwaves, int lane) {
    const int njobs = DEFER == 2 ? (set == 0 ? 8 : 3) : (set == 0 ? 11 : 3);
    int start = wave_index;
#pragma unroll 1
    for (int q = 0; q < njobs; ++q) {
        const int id = DEFER == 2 ? (set == 0 ? (q < 3 ? q : q + 9) : 3 * set + q) : (set == 0 ? (q < 3 ? q : (q < 6 ? q + 3 : q + 6)) : (set == 1 ? 3 + q : 9 + q));
        const int nt = id < 12 ? NT_FFN : (id == 12 ? NT_EVIN : (id == 14 ? NT_ODIN : (id == 16 ? NT_GLU : NT_SQ)));
        const TJob j = make_job(a, ws, id);
        int t = start;
#pragma unroll 1
        for (; t + nwaves < nt; t += 2 * nwaves) transpose_tile2(j, t, t + nwaves, lane);
        if (t < nt) { transpose_tile(j, t, lane); t += nwaves; }
        start = t - nt;
    }
}

struct NormP {
    const void* xin_lat; const void* xin_ctx; void* xout_lat; void* xout_ctx; const bf16* y; bf16* h;
    int xin_f32, xout_f32;
    int rows_end; int has_y, has_h; float w;
    const float* y_ctx;
    int lp, sp;
    int ln, sn;
};
__device__ __forceinline__ void norm_phase(const NormP& p, const float* mod, const float* norm_pre, const float* norm_post, LAS unsigned char* lds, int gw, int ngw, int tid, int lane) {
    { int t2 = threadIdx.x; asm volatile("" : "+v"(t2)); tid = t2; lane = t2 & 63; gw = blockIdx.x * NWAVES + __builtin_amdgcn_readfirstlane(t2 >> 6); }
    LAS float* TA = (LAS float*)lds; LAS float* TB = TA + 5 * D; LAS float* TCc = TB + 5 * D;
    for (int i = tid; i < 5 * D; i += NTHR) { const int var = i >> 11, j = i & (D - 1);
        if (p.has_y) TA[i] = p.w * mod[((size_t)p.lp * 5 + var) * (NMOD * D) + (3 * p.sp + 2) * D + j] * norm_post[(p.lp * 3 + p.sp) * D + j];
        if (p.has_h) { TB[i] = norm_pre[(p.ln * 3 + p.sn) * D + j] * (1.0f + mod[((size_t)p.ln * 5 + var) * (NMOD * D) + (3 * p.sn + 1) * D + j]);
                       TCc[i] = mod[((size_t)p.ln * 5 + var) * (NMOD * D) + (3 * p.sn) * D + j]; } }
    __syncthreads();
    for (int r = gw; r < p.rows_end; r += ngw) {
        const int var = r < TL ? (r >> 12) : 4;
        const size_t xoff = r < TL ? (size_t)r * D : (size_t)(r - TL) * D;
        const void* xi = r < TL ? p.xin_lat : p.xin_ctx; void* xo = r < TL ? p.xout_lat : p.xout_ctx;
        f32x4 xv[8];
        if (p.xin_f32) {
#pragma unroll
            for (int j = 0; j < 8; ++j) xv[j] = *(const f32x4*)((const float*)xi + xoff + 4 * lane + 256 * j);
        } else {
#pragma unroll
            for (int j = 0; j < 8; ++j) { const v2u w = *(const v2u*)((const bf16*)xi + xoff + 4 * lane + 256 * j); xv[j] = (f32x4){__uint_as_float(w.x << 16), __uint_as_float(w.x & 0xffff0000u), __uint_as_float(w.y << 16), __uint_as_float(w.y & 0xffff0000u)}; }
        }
        if (p.has_y) {
            const bool yc = (r >= TL) && p.y_ctx; const float* yr = p.y_ctx + (size_t)(r - TL) * D; f32x4 yv[8]; float s = 0.f;
            if (!yc) { const bf16* yb = p.y + (size_t)r * D;
#pragma unroll
                for (int j = 0; j < 8; ++j) { const v2u w = *(const v2u*)(yb + 4 * lane + 256 * j); yv[j] = (f32x4){__uint_as_float(w.x << 16), __uint_as_float(w.x & 0xffff0000u), __uint_as_float(w.y << 16), __uint_as_float(w.y & 0xffff0000u)}; }
            } else {
#pragma unroll
                for (int j = 0; j < 8; ++j) yv[j] = *(const f32x4*)(yr + 4 * lane + 256 * j);
                for (int q = 1; q < YPARTS; ++q) {
#pragma unroll
                for (int j = 0; j < 8; ++j) yv[j] += *(const f32x4*)(yr + (size_t)q * TC * D + 4 * lane + 256 * j); } }
#pragma unroll
            for (int j = 0; j < 8; ++j) { s += (yv[j].x * yv[j].x + yv[j].y * yv[j].y) + (yv[j].z * yv[j].z + yv[j].w * yv[j].w); }
            const float rstd = 1.0f / sqrtf(wave_sum(s) * (1.0f / D) + EPS);
#pragma unroll
            for (int j = 0; j < 8; ++j) { const f32x4 a = *(const LAS f32x4*)(TA + var * D + 4 * lane + 256 * j); xv[j] = xv[j] + a * (yv[j] * rstd);
                if (p.xout_f32) *(f32x4*)((float*)xo + xoff + 4 * lane + 256 * j) = xv[j];
                else { v2u w; w.x = pk2(xv[j].x, xv[j].y); w.y = pk2(xv[j].z, xv[j].w); *(v2u*)((bf16*)xo + xoff + 4 * lane + 256 * j) = w; } }
        }
        if (p.has_h) {
            float s = 0.f;
#pragma unroll
            for (int j = 0; j < 8; ++j) s += (xv[j].x * xv[j].x + xv[j].y * xv[j].y) + (xv[j].z * xv[j].z + xv[j].w * xv[j].w);
            const float rstd = 1.0f / sqrtf(wave_sum(s) * (1.0f / D) + EPS);
            bf16* hr = p.h + (size_t)r * D;
#pragma unroll
            for (int j = 0; j < 8; ++j) { const f32x4 b = *(const LAS f32x4*)(TB + var * D + 4 * lane + 256 * j), c = *(const LAS f32x4*)(TCc + var * D + 4 * lane + 256 * j);
                const f32x4 o = xv[j] * rstd * b + c; v2u w; w.x = pk2(o.x, o.y); w.y = pk2(o.z, o.w); *(v2u*)(hr + 4 * lane + 256 * j) = w; }
        }
    }
    __syncthreads();
}

struct EpiSwiGLU {
    static constexpr bool PERM = true, AFTER_DRAIN = false;
    bf16* O; int ldc;
    __device__ __forceinline__ void operator()(const pg8::f32x4 (&acc)[2][2][4][2], const pg8::Unit& u, int wr, int wc, int fr, int fq) const {
        const int row0 = u.pm * 256 + wr * 64 + fr, col0 = u.pn * 128 + wc * 32 + 8 * fq;
#pragma unroll
        for (int ai = 0; ai < 2; ++ai)
#pragma unroll
            for (int m = 0; m < 4; ++m) { bf16* rowp = O + (size_t)(row0 + ai * 128 + m * 16) * ldc + col0;
                const pg8::f32x4 g0 = acc[ai][0][m][0], g1 = acc[ai][0][m][1], u0 = acc[ai][1][m][0], u1 = acc[ai][1][m][1];
                v4u w; w.x = pk2(fast_silu(g0[0]) * u0[0], fast_silu(g0[1]) * u0[1]); w.y = pk2(fast_silu(g0[2]) * u0[2], fast_silu(g0[3]) * u0[3]);
                w.z = pk2(fast_silu(g1[0]) * u1[0], fast_silu(g1[1]) * u1[1]); w.w = pk2(fast_silu(g1[2]) * u1[2], fast_silu(g1[3]) * u1[3]);
                *(v4u*)rowp = w; }
    }
};
struct EpiF32 {
    static constexpr bool PERM = true, AFTER_DRAIN = false;
    bf16* C; float* Cs;
    static constexpr int ldc = D;
    __device__ __forceinline__ void operator()(const pg8::f32x4 (&acc)[2][2][4][2], const pg8::Unit& u, int wr, int wc, int fr, int fq) const {
        const int row0 = u.pm * 256 + wr * 64 + fr, col0 = u.pn * 256 + wc * 32 + 8 * fq;
        if (u.part >= 0) {
            float* base = Cs + ((size_t)u.part * TC - (size_t)TL) * D;
#pragma unroll
            for (int ai = 0; ai < 2; ++ai)
#pragma unroll
                for (int m = 0; m < 4; ++m) { float* rowp = base + (size_t)(row0 + ai * 128 + m * 16) * ldc + col0;
#pragma unroll
                    for (int bj = 0; bj < 2; ++bj) { *(pg8::f32x4*)(rowp + bj * 128) = acc[ai][bj][m][0]; *(pg8::f32x4*)(rowp + bj * 128 + 4) = acc[ai][bj][m][1]; } }
        } else {
#pragma unroll
            for (int ai = 0; ai < 2; ++ai)
#pragma unroll
                for (int m = 0; m < 4; ++m) { bf16* rowp = C + (size_t)(row0 + ai * 128 + m * 16) * ldc + col0;
#pragma unroll
                    for (int bj = 0; bj < 2; ++bj) { const pg8::f32x4 v0 = acc[ai][bj][m][0], v1 = acc[ai][bj][m][1];
                        v4u w; w.x = pk2(v0[0], v0[1]); w.y = pk2(v0[2], v0[3]); w.z = pk2(v1[0], v1[1]); w.w = pk2(v1[2], v1[3]);
                        *(v4u*)(rowp + bj * 128) = w; } }
        }
    }
};
struct EpiS {
    static constexpr bool PERM = true, AFTER_DRAIN = false;
    bf16* S; int ldc; float* GT; int gt_pn;
    __device__ __forceinline__ void operator()(const pg8::f32x4 (&acc)[2][2][4][2], const pg8::Unit& u, int wr, int wc, int fr, int fq) const {
        const int row0 = u.pm * 256 + wr * 64 + fr;
        if (u.pn == gt_pn) {
            if (wc < 2) {
#pragma unroll
                for (int ai = 0; ai < 2; ++ai)
#pragma unroll
                    for (int m = 0; m < 4; ++m) { float* rowp = GT + (size_t)(row0 + ai * 128 + m * 16) * 256 + wc * 32 + 8 * fq;
                        *(pg8::f32x4*)rowp = acc[ai][0][m][0]; *(pg8::f32x4*)(rowp + 4) = acc[ai][0][m][1]; }
            }
        } else {
            const int col0 = u.pn * 256 + wc * 32 + 8 * fq;
#pragma unroll
            for (int ai = 0; ai < 2; ++ai)
#pragma unroll
                for (int m = 0; m < 4; ++m) { bf16* rowp = S + (size_t)(row0 + ai * 128 + m * 16) * ldc + col0;
#pragma unroll
                    for (int bj = 0; bj < 2; ++bj) { const pg8::f32x4 v0 = acc[ai][bj][m][0], v1 = acc[ai][bj][m][1];
                        v4u w; w.x = pk2(v0[0], v0[1]); w.y = pk2(v0[2], v0[3]); w.z = pk2(v1[0], v1[1]); w.w = pk2(v1[2], v1[3]);
                        *(v4u*)(rowp + bj * 128) = w; } }
        }
    }
};

#define DEV __device__ __forceinline__
#define LP(T) LAS T*
#define SYNC() do { asm volatile("s_waitcnt lgkmcnt(0)" ::: "memory"); __builtin_amdgcn_s_barrier(); asm volatile("" ::: "memory"); } while (0)
typedef short v8s __attribute__((ext_vector_type(8)));
typedef float v4f __attribute__((ext_vector_type(4)));
#define MFMA16(x, y, c) __builtin_amdgcn_mfma_f32_16x16x32_bf16((x), (y), (c), 0, 0, 0)
#define SHX(v, m) __shfl_xor((v), (m))
#define SHUP(v, d) __shfl_up((v), (d))
#define SHIDX(v, l) __shfl((v), (l))
#define EXPF(x) __expf(x)
#define LOGF(x) __logf(x)
#define RCPF(x) __builtin_amdgcn_rcpf(x)
#define RSQRTF(x) (1.0f / sqrtf(x))
#define PK2(lo, hi) pk2((lo), (hi))
#define F2BF(x) ((unsigned short)f2bf(x))
#define WAVE_SYNC() asm volatile("s_waitcnt lgkmcnt(0)" ::: "memory")
typedef short v4s __attribute__((ext_vector_type(4)));
#define LDS_TR16(p) __builtin_amdgcn_ds_read_tr16_b64_v4i16((LAS v4s*)(p))
#define RDLANE(v, l) __int_as_float(__builtin_amdgcn_readlane(__float_as_int(v), (l)))
#define RDLANE16(v, l) __shfl((v), (l))
#define SIB_SYNC_IMPL(p, target) do { __hip_atomic_fetch_add((p), 1u, __ATOMIC_RELAXED, __HIP_MEMORY_SCOPE_AGENT); unsigned sp_ = 0; \
    while (__hip_atomic_load((p), __ATOMIC_RELAXED, __HIP_MEMORY_SCOPE_AGENT) < (target) && ++sp_ < 100000u) __builtin_amdgcn_s_sleep(2); } while (0)

DEV int seq_row(int b, int seg, int np, int cm) {
    if (!seg) return TL + b * CTXL + np;
    const int n = cm ? ((np & 63) * 64 + (np >> 6)) : np;
    return b * SEQ + n;
}
DEV int tok_row(int b, int seg, int pos, int dir, int cm) {
    const int len = seg ? SEQ : CTXL;
    return seq_row(b, seg, dir ? len - 1 - pos : pos, cm);
}
DEV float bflo(unsigned u) { return __uint_as_float(u << 16); }
DEV float bfhi(unsigned u) { return __uint_as_float(u & 0xffff0000u); }
DEV float logsigmoidf(float z) { return fminf(z, 0.f) - LOGF(1.0f + EXPF(-fabsf(z))); }
DEV v4f tile_mma(v4f acc, LP(const unsigned char) A, int sa, int m0, LP(const unsigned char) B, int sb, int n0, int ksteps, int fr, int fq) {
    LP(const unsigned char) ap = A + (m0 + fr) * sa + fq * 16;
    LP(const unsigned char) bp = B + (n0 + fr) * sb + fq * 16;
    for (int k = 0; k < ksteps; ++k) {
        const v8s af = *(LP(const v8s))(ap + k * 64);
        const v8s bf = *(LP(const v8s))(bp + k * 64);
        acc = MFMA16(bf, af, acc);
    }
    return acc;
}
DEV v8s tr_frag(LP(const unsigned char) T, int st, int k0, int n0, int lane) {
    const int l16 = lane & 15, fq = lane >> 4;
    LP(const unsigned char) p = T + (k0 + 8 * fq + (l16 >> 2)) * st + (n0 + 4 * (l16 & 3)) * 2;
    const v4s a = LDS_TR16(p), b = LDS_TR16(p + 4 * st);
    return (v8s){a.x, a.y, a.z, a.w, b.x, b.y, b.z, b.w};
}
DEV v4f tile_mma_nt(v4f acc, LP(const unsigned char) A, int sa, int m0, LP(const unsigned char) Bt, int sb, int n0, int ksteps, int lane) {
    const int fr = lane & 15, fq = lane >> 4;
    for (int k = 0; k < ksteps; ++k) { const v8s af = *(LP(const v8s))(A + (m0 + fr) * sa + fq * 16 + k * 64); const v8s bf = tr_frag(Bt, sb, 32 * k, n0, lane); acc = MFMA16(bf, af, acc); }
    return acc;
}
DEV v4f tile_mma_tt(v4f acc, LP(const unsigned char) At, int sa, int m0, LP(const unsigned char) Bt, int sb, int n0, int ksteps, int lane) {
    for (int k = 0; k < ksteps; ++k) { const v8s af = tr_frag(At, sa, 32 * k, m0, lane); const v8s bf = tr_frag(Bt, sb, 32 * k, n0, lane); acc = MFMA16(bf, af, acc); }
    return acc;
}
constexpr int ST128 = 272, ST64 = 144, ST256 = 528, STV = 80;
DEV void sibling_sync(unsigned* sib, unsigned target, int tid) {
#ifdef SIB_SYNC_IMPL
    if (sib) { if (tid == 0) SIB_SYNC_IMPL(sib, target); SYNC(); }
#endif
}

constexpr int MIX_UNITS = NB * 32;
constexpr int GLA_TASKS = NB * 4 * 2 * (CTXL / 64 + SEQ / 64);
DEV void gla_prep_loop(int first, int stride, const bf16* S, const float* GT, const float* wg_all, const float* bg_all, bf16* QKS, float* VEC, LP(unsigned char) lds, int tid) {
    constexpr int NCHUNK = CTXL / 64 + SEQ / 64;
    LP(float) LA = (LP(float))lds; LP(float) SEG = (LP(float))(lds + 32768); LP(unsigned char) LRb = lds + 34816; LP(unsigned char) WGb = lds + 39936; LP(float) BG = (LP(float))(lds + 50176);
    for (int i = tid; i < (5120 + 10240) / 4; i += NTHR) ((LP(unsigned))LRb)[i] = 0u;
    SYNC();
    const int lane = tid & 63, wave = tid >> 6, fr = lane & 15, fq = lane >> 4;
    const int j = tid >> 3, c8 = tid & 7, dc = c8 * 16;
    const float qscale = 0.08838834764831845f;
    v4u pq0, pq1, pk0, pk1; v4f plr = (v4f){0.f, 0.f, 0.f, 0.f}, pwg = plr; float pbg = 0.f;
#define GP_ISSUE(tk) do { const int cx_ = (tk) % NCHUNK, r1_ = (tk) / NCHUNK, dir_ = r1_ & 1, h_ = (r1_ >> 1) & 3, b_ = r1_ >> 3; \
        const int seg_ = cx_ >= CTXL / 64, ci_ = seg_ ? cx_ - CTXL / 64 : cx_; \
        const bf16* sr_ = S + (size_t)tok_row(b_, seg_, ci_ * 64 + j, dir_, 0) * EV_PAD; \
        pq0 = *(const v4u*)(sr_ + h_ * 128 + dc); pq1 = *(const v4u*)(sr_ + h_ * 128 + dc + 8); pk0 = *(const v4u*)(sr_ + 512 + h_ * 128 + dc); pk1 = *(const v4u*)(sr_ + 512 + h_ * 128 + dc + 8); \
        pwg = *(const v4f*)(wg_all + (dir_ * 16 + (tid >> 5)) * 512 + h_ * 128 + (tid & 31) * 4); \
        if (tid < 128) pbg = bg_all[dir_ * 512 + h_ * 128 + tid]; \
        if (tid < 256) { const int rr_ = tok_row(b_, seg_, ci_ * 64 + (tid >> 2), dir_, 0); plr = *(const v4f*)(GT + (size_t)rr_ * 256 + dir_ * 16 + (tid & 3) * 4); } } while (0)
    if (first < GLA_TASKS) GP_ISSUE(first);
    for (int task = first; task < GLA_TASKS; task += stride) {
    const int cidx = task % NCHUNK, r1 = task / NCHUNK, dir = r1 & 1, h = (r1 >> 1) & 3, b = r1 >> 3;
    const int seg = cidx >= CTXL / 64, ci = seg ? cidx - CTXL / 64 : cidx;
    const int row = tok_row(b, seg, ci * 64 + j, dir, 0);
    const v4u q0 = pq0, q1 = pq1, k0 = pk0, k1 = pk1;
    { const int m = tid >> 5, d0 = (tid & 31) * 4;
      *(LP(unsigned short))(WGb + (d0 + 0) * 80 + m * 2) = F2BF(pwg.x); *(LP(unsigned short))(WGb + (d0 + 1) * 80 + m * 2) = F2BF(pwg.y);
      *(LP(unsigned short))(WGb + (d0 + 2) * 80 + m * 2) = F2BF(pwg.z); *(LP(unsigned short))(WGb + (d0 + 3) * 80 + m * 2) = F2BF(pwg.w); }
    if (tid < 128) BG[tid] = pbg;
    if (tid < 256) *(LP(v2u))(LRb + (tid >> 2) * 80 + (tid & 3) * 8) = (v2u){PK2(plr.x, plr.y), PK2(plr.z, plr.w)};
    if (task + stride < GLA_TASKS) GP_ISSUE(task + stride);
    SYNC();
    {
        const int tt = wave >> 1; const v8s af = *(LP(const v8s))(LRb + (16 * tt + fr) * 80 + fq * 16);
#pragma unroll
        for (int i = 0; i < 4; ++i) { const int dt = (wave & 1) * 4 + i; const v8s bf = *(LP(const v8s))(WGb + (16 * dt + fr) * 80 + fq * 16);
            v4f z = (v4f){0.f, 0.f, 0.f, 0.f}; z = MFMA16(bf, af, z);
            const v4f bg4 = *(LP(const v4f))(BG + 16 * dt + 4 * fq);
            v4f o; o.x = logsigmoidf(z.x + bg4.x) * 0.0625f; o.y = logsigmoidf(z.y + bg4.y) * 0.0625f; o.z = logsigmoidf(z.z + bg4.z) * 0.0625f; o.w = logsigmoidf(z.w + bg4.w) * 0.0625f;
            *(LP(v4f))(LA + (16 * tt + fr) * 128 + 16 * dt + 4 * fq) = o; }
    }
    SYNC();
    {
        const int d = tid & 127, sg = tid >> 7; float acc = 0.f;
        for (int jj = 0; jj < 16; ++jj) { acc += LA[(sg * 16 + jj) * 128 + d]; LA[(sg * 16 + jj) * 128 + d] = acc; }
        SEG[sg * 128 + d] = acc;
    }
    SYNC();
    {
        const int sgj = j >> 4;
        bf16* orow = QKS + ((size_t)dir * TT + row) * 1024 + h * 128 + dc;
#pragma unroll 1
        for (int g = 0; g < 2; ++g) {
            const v4u qv = g ? q1 : q0, kv = g ? k1 : k0;
            const unsigned qw[4] = {qv.x, qv.y, qv.z, qv.w}, kw[4] = {kv.x, kv.y, kv.z, kv.w};
            unsigned oqs[4], oks[4];
#pragma unroll
            for (int i2 = 0; i2 < 4; ++i2) {
                float vqs[2], vks[2];
#pragma unroll
                for (int e = 0; e < 2; ++e) {
                    const int d = dc + 8 * g + 2 * i2 + e;
                    const float s0 = SEG[d], s1 = SEG[128 + d], s2 = SEG[256 + d];
                    const float pre = (sgj > 0 ? s0 : 0.f) + (sgj > 1 ? s1 : 0.f) + (sgj > 2 ? s2 : 0.f);
                    const float bv = LA[j * 128 + d] + pre;
                    const float bmid = LA[32 * 128 + d] + s0 + s1;
                    const float q = (e ? bfhi(qw[i2]) : bflo(qw[i2])) * qscale, k = e ? bfhi(kw[i2]) : bflo(kw[i2]);
                    const float e1 = EXPF(bv - bmid);
                    vqs[e] = q * e1; vks[e] = k * RCPF(e1);
                    if (j == 63) { const float bend = bv; float* vp = VEC + (size_t)task * 384 + d; vp[0] = EXPF(bmid); vp[128] = EXPF(bend - bmid); vp[256] = EXPF(bend); }
                }
                oqs[i2] = PK2(vqs[0], vqs[1]); oks[i2] = PK2(vks[0], vks[1]);
            }
            *(v4u*)(orow + 8 * g) = (v4u){oqs[0], oqs[1], oqs[2], oqs[3]};
            *(v4u*)(orow + 512 + 8 * g) = (v4u){oks[0], oks[1], oks[2], oks[3]};
        }
    }
    SYNC();
    }
#undef GP_ISSUE
}

DEV void gla_unit(const bf16* S, const bf16* QKS, const float* VEC, bf16* O, int unit, LP(unsigned char) lds, int tid, unsigned* sib) {
    const int lane = tid & 63, wave = tid >> 6, fr = lane & 15, fq = lane >> 4;
    const int vs = unit & 3, dir = (unit >> 2) & 1, h = (unit >> 3) & 3, b = unit >> 5;
    LP(unsigned char) QS = lds; LP(unsigned char) KS = lds + 17408; LP(unsigned char) QB = lds + 34816;
    LP(unsigned char) VV = lds + 52224; LP(unsigned char) PM = lds + 61440; LP(unsigned char) STT = lds + 70656;
    LP(float) DV = (LP(float))(lds + 88064);
    for (int i = tid; i < 64 * ST128 / 4; i += NTHR) ((LP(unsigned))STT)[i] = 0u;
    v4f sacc[4];
#pragma unroll
    for (int i = 0; i < 4; ++i) sacc[i] = (v4f){0.f, 0.f, 0.f, 0.f};
    const int j = tid >> 3, c8 = tid & 7, dc = c8 * 16;
    const int tt = wave >> 1, vt0 = (wave & 1) * 2;
    const int svt = wave & 3, sdt0 = (wave >> 2) * 4;
    bf16* Od = O + (size_t)dir * TT * 1024;
    constexpr int NCHUNK = CTXL / 64 + SEQ / 64;
    const int task0 = ((b * 4 + h) * 2 + dir) * NCHUNK;
    v4u gq0[2], gq1[2], gk0[2], gk1[2], gvv[2]; v4f gem[4]; v4f gdv = (v4f){0.f, 0.f, 0.f, 0.f};
#define GLA_ISSUE(cx, P_) do { const int seg_ = (cx) >= CTXL / 64, ci_ = seg_ ? (cx) - CTXL / 64 : (cx); \
        const int row_ = tok_row(b, seg_, ci_ * 64 + j, dir, 0); \
        const bf16* qr_ = QKS + ((size_t)dir * TT + row_) * 1024 + h * 128 + dc; \
        gq0[P_] = *(const v4u*)(qr_); gq1[P_] = *(const v4u*)(qr_ + 8); gk0[P_] = *(const v4u*)(qr_ + 512); gk1[P_] = *(const v4u*)(qr_ + 520); \
        gvv[P_] = *(const v4u*)(S + (size_t)row_ * EV_PAD + 1024 + h * 256 + vs * 64 + c8 * 8); } while (0)
#define GLA_ISSUE_V(cx) do { const float* vp_ = VEC + (size_t)(task0 + (cx)) * 384;     \
        _Pragma("unroll") for (int i_ = 0; i_ < 4; ++i_) gem[i_] = *(const v4f*)(vp_ + dc + 4 * i_); \
        if (tid < 64) gdv = *(const v4f*)(vp_ + 128 + tid * 4); } while (0)
    GLA_ISSUE(0, 0); GLA_ISSUE(1, 1); GLA_ISSUE_V(0);
    SYNC();
#pragma unroll 1
    for (int c2 = 0; c2 < NCHUNK; c2 += 2) {
#pragma unroll
    for (int u_ = 0; u_ < 2; ++u_) {
        const int cidx = c2 + u_;
        const int seg = cidx >= CTXL / 64, ci = seg ? cidx - CTXL / 64 : cidx;
        if (u_ == 0 && (c2 & 3) == 0 && c2 > 0) sibling_sync(sib, (unsigned)(c2 >> 2) * 4u, tid);
        const v4u q0 = gq0[u_], q1 = gq1[u_], k0 = gk0[u_], k1 = gk1[u_], vv = gvv[u_]; const v4f dvv = gdv;
        v4f em[4];
#pragma unroll
        for (int i_ = 0; i_ < 4; ++i_) em[i_] = gem[i_];
        {
            *(LP(v4u))(QS + j * ST128 + dc * 2) = q0; *(LP(v4u))(QS + j * ST128 + dc * 2 + 16) = q1;
            *(LP(v4u))(KS + j * ST128 + dc * 2) = k0; *(LP(v4u))(KS + j * ST128 + dc * 2 + 16) = k1;
            const unsigned qw[8] = {q0.x, q0.y, q0.z, q0.w, q1.x, q1.y, q1.z, q1.w}; unsigned ob[8];
#pragma unroll
            for (int i2 = 0; i2 < 8; ++i2) { const v4f e4 = em[i2 >> 1]; const float ea = (i2 & 1) ? e4.z : e4.x, eb = (i2 & 1) ? e4.w : e4.y; ob[i2] = PK2(bflo(qw[i2]) * ea, bfhi(qw[i2]) * eb); }
            *(LP(v4u))(QB + j * ST128 + dc * 2) = (v4u){ob[0], ob[1], ob[2], ob[3]}; *(LP(v4u))(QB + j * ST128 + dc * 2 + 16) = (v4u){ob[4], ob[5], ob[6], ob[7]};
            *(LP(v4u))(VV + j * ST64 + c8 * 16) = vv;
            if (tid < 64) *(LP(v4f))(DV + tid * 4) = dvv;
        }
        if (cidx + 2 < NCHUNK) GLA_ISSUE(cidx + 2, u_);
        if (cidx + 1 < NCHUNK) GLA_ISSUE_V(cidx + 1);
        SYNC();
        v4f oacc[2]; oacc[0] = (v4f){0.f, 0.f, 0.f, 0.f}; oacc[1] = oacc[0];
        {
#pragma unroll
            for (int i = 0; i < 2; ++i) { const int st = vt0 + i; v4f p = (v4f){0.f, 0.f, 0.f, 0.f};
                if (st <= tt) { p = tile_mma(p, QS, ST128, 16 * tt, KS, ST128, 16 * st, 4, fr, fq);
                    if (st == tt) { if (4 * fq + 0 > fr) p.x = 0.f; if (4 * fq + 1 > fr) p.y = 0.f; if (4 * fq + 2 > fr) p.z = 0.f; if (4 * fq + 3 > fr) p.w = 0.f; } }
                *(LP(v2u))(PM + (16 * tt + fr) * ST64 + (16 * st + 4 * fq) * 2) = (v2u){PK2(p.x, p.y), PK2(p.z, p.w)}; }
#pragma unroll
            for (int k = 0; k < 4; ++k) { const v8s af = *(LP(const v8s))(QB + (16 * tt + fr) * ST128 + fq * 16 + k * 64);
#pragma unroll
                for (int i = 0; i < 2; ++i) { const v8s bf = *(LP(const v8s))(STT + (16 * (vt0 + i) + fr) * ST128 + fq * 16 + k * 64); oacc[i] = MFMA16(bf, af, oacc[i]); } }
        }
        SYNC();
#pragma unroll
        for (int k = 0; k < 2; ++k) { const v8s af = *(LP(const v8s))(PM + (16 * tt + fr) * ST64 + fq * 16 + k * 64);
#pragma unroll
            for (int i = 0; i < 2; ++i) { const v8s bf = tr_frag(VV, ST64, 32 * k, 16 * (vt0 + i), lane); oacc[i] = MFMA16(bf, af, oacc[i]); } }
        { const int orow = tok_row(b, seg, ci * 64 + 16 * tt + fr, dir, 0);
#pragma unroll
          for (int i = 0; i < 2; ++i) *(v2u*)(Od + (size_t)orow * 1024 + h * 256 + vs * 64 + 16 * (vt0 + i) + 4 * fq) = (v2u){PK2(oacc[i].x, oacc[i].y), PK2(oacc[i].z, oacc[i].w)}; }
        {
            v4f tmp[4];
#pragma unroll
            for (int i = 0; i < 4; ++i) tmp[i] = (v4f){0.f, 0.f, 0.f, 0.f};
#pragma unroll
            for (int k = 0; k < 2; ++k) { const v8s af = tr_frag(VV, ST64, 32 * k, 16 * svt, lane);
#pragma unroll
                for (int i = 0; i < 4; ++i) { const v8s bf = tr_frag(KS, ST128, 32 * k, 16 * (sdt0 + i), lane); tmp[i] = MFMA16(bf, af, tmp[i]); } }
#pragma unroll
            for (int i = 0; i < 4; ++i) { const v4f ee = *(LP(const v4f))(DV + 16 * (sdt0 + i) + 4 * fq), de = *(LP(const v4f))(DV + 128 + 16 * (sdt0 + i) + 4 * fq);
                sacc[i] = sacc[i] * de + tmp[i] * ee;
                *(LP(v2u))(STT + (16 * svt + fr) * ST128 + (16 * (sdt0 + i) + 4 * fq) * 2) = (v2u){PK2(sacc[i].x, sacc[i].y), PK2(sacc[i].z, sacc[i].w)}; }
        }
        SYNC();
    }
    }
#undef GLA_ISSUE
#undef GLA_ISSUE_V
}

constexpr int MAT_TASKS = NB * 4 * 2 * (CTXL / 64 + SEQ / 64);
template <int MODE>
DEV void mat_prep_loop(int first, int stride, const bf16* Sqk, int ldqk, int qoff, int koff, float kscale, const float* GT, const float* gate_b, float* GP, float* GPK,
                       const float* ret_log_decay, bf16* PP, float* RS, LP(unsigned char) lds, int tid) {
    constexpr int NCHUNK = CTXL / 64 + SEQ / 64;
    const int lane = tid & 63, wave = tid >> 6, fr = lane & 15, fq = lane >> 4;
    LP(unsigned char) Q = lds; LP(unsigned char) K = lds + 33792; LP(float) AS = (LP(float))(lds + 67584); LP(float) R0 = AS + 64; LP(float) DENP = AS + 128; LP(float) W0 = AS + 384;
    const int j = tid >> 3, c8 = tid & 7, dc = c8 * 32;
    v4u rq[4], rk[4]; float gi = 0.f, gf = 0.f;
#define MP_ISSUE(tk) do { const int cx_ = (tk) % NCHUNK, r1_ = (tk) / NCHUNK, dir_ = r1_ & 1, h_ = (r1_ >> 1) & 3, b_ = r1_ >> 3; \
        const int seg_ = cx_ >= CTXL / 64, ci_ = seg_ ? cx_ - CTXL / 64 : cx_; \
        const bf16* s1_ = Sqk + (size_t)tok_row(b_, seg_, ci_ * 64 + j, dir_, 1) * ldqk; \
        _Pragma("unroll") for (int g_ = 0; g_ < 4; ++g_) { rq[g_] = *(const v4u*)(s1_ + qoff + h_ * 256 + dc + 8 * g_); rk[g_] = *(const v4u*)(s1_ + koff + h_ * 256 + dc + 8 * g_); } \
        if (MODE == 0 && wave == 0) { const int prow_ = tok_row(b_, seg_, ci_ * 64 + lane, dir_, 1); \
            gi = GT[(size_t)prow_ * 256 + 32 + (dir_ * 2 + 0) * 4 + h_]; gf = GT[(size_t)prow_ * 256 + 32 + (dir_ * 2 + 1) * 4 + h_]; } } while (0)
    if (first < MAT_TASKS) MP_ISSUE(first);
    for (int task = first; task < MAT_TASKS; task += stride) {
        const int cidx = task % NCHUNK, r1 = task / NCHUNK, dir = r1 & 1, h = (r1 >> 1) & 3, b = r1 >> 3;
        const int seg = cidx >= CTXL / 64, ci = seg ? cidx - CTXL / 64 : cidx;
#pragma unroll
        for (int g8 = 0; g8 < 4; ++g8) { *(LP(v4u))(Q + j * ST256 + (dc + 8 * g8) * 2) = rq[g8]; *(LP(v4u))(K + j * ST256 + (dc + 8 * g8) * 2) = rk[g8]; }
        if (wave == 0) {
            if (MODE == 0) {
                const int prow = tok_row(b, seg, ci * 64 + lane, dir, 1);
                const float ig = gi + gate_b[(dir * 2 + 0) * 4 + h];
                float bcum = logsigmoidf(gf + gate_b[(dir * 2 + 1) * 4 + h]);
#pragma unroll
                for (int o = 1; o < 64; o <<= 1) { const float t = SHUP(bcum, o); if (lane >= o) bcum += t; }
                const float a_s = ig - bcum;
                float cm = a_s;
#pragma unroll
                for (int o = 1; o < 64; o <<= 1) { const float t = SHUP(cm, o); if (lane >= o) cm = fmaxf(cm, t); }
                *(v4f*)(GP + ((size_t)prow * 8 + dir * 4 + h) * 4) = (v4f){bcum, a_s, cm, 0.f};
                AS[lane] = a_s; R0[lane] = -cm; W0[lane] = EXPF(a_s - RDLANE(cm, 63));
            } else { const float lg = -expf(ret_log_decay[dir * 4 + h]); AS[lane] = -(float)(lane + 1) * lg; R0[lane] = (float)(lane + 1) * lg; }
        }
        if (task + stride < MAT_TASKS) MP_ISSUE(task + stride);
        SYNC();
        const int tt = wave >> 1;
        bf16* pp = PP + (size_t)task * 4096;
        const float rt = R0[16 * tt + fr];
#pragma unroll
        for (int i = 0; i < 2; ++i) { const int st = (wave & 1) * 2 + i; v4f p = (v4f){0.f, 0.f, 0.f, 0.f};
            if (st <= tt) { p = tile_mma(p, Q, ST256, 16 * tt, K, ST256, 16 * st, 8, fr, fq);
                const v4f as4 = *(LP(const v4f))(AS + 16 * st + 4 * fq);
                p.x *= kscale * EXPF(as4.x + rt); p.y *= kscale * EXPF(as4.y + rt); p.z *= kscale * EXPF(as4.z + rt); p.w *= kscale * EXPF(as4.w + rt);
                if (st == tt) { if (4 * fq + 0 > fr) p.x = 0.f; if (4 * fq + 1 > fr) p.y = 0.f; if (4 * fq + 2 > fr) p.z = 0.f; if (4 * fq + 3 > fr) p.w = 0.f; } }
            *(v2u*)(pp + (16 * tt + fr) * 64 + 16 * st + 4 * fq) = (v2u){PK2(p.x, p.y), PK2(p.z, p.w)};
            if (MODE == 0) { float rs = (p.x + p.y) + (p.z + p.w); rs += SHX(rs, 16); rs += SHX(rs, 32); if (fq == 0) DENP[st * 64 + 16 * tt + fr] = rs; } }
        if (MODE == 0 && tid >= 256) {
            const int d = tid - 256; float kw = 0.f;
            for (int jj = 0; jj < 64; ++jj) kw += __uint_as_float(((unsigned)*(LP(const unsigned short))(K + jj * ST256 + d * 2)) << 16) * W0[jj];
            GPK[(size_t)task * 256 + d] = kw; }
        SYNC();
        if (MODE == 0 && tid < 64) RS[(size_t)task * 64 + tid] = (DENP[tid] + DENP[64 + tid]) + (DENP[128 + tid] + DENP[192 + tid]);
        SYNC();
    }
#undef MP_ISSUE
}

template <int MODE>
DEV void mat_unit(const bf16* Sqk, int ldqk, int qoff, int koff, const bf16* Sv, int ldv, int voff, float kscale, const float* GP, const float* GPK, const bf16* PP, const float* RS, bf16* O, int store_ctx,
                  const float* ret_log_decay, int unit, LP(unsigned char) lds, int tid, unsigned* sib) {
    const int lane = tid & 63, wave = tid >> 6, fr = lane & 15, fq = lane >> 4;
    const int vs = unit & 3, dir = (unit >> 2) & 1, h = (unit >> 3) & 3, b = unit >> 5;
    LP(unsigned char) Q = lds; LP(unsigned char) K = lds + 33792;
    LP(unsigned char) VV = lds + 67584; LP(unsigned char) VW = lds + 76800;
    LP(unsigned char) PM = lds + 86016; LP(unsigned char) STT = lds + 95232;
    LP(float) SCAL = (LP(float))(lds + 137472);
    LP(float) NV = SCAL + 768;
    for (int i = tid; i < 80 * ST256 / 4; i += NTHR) ((LP(unsigned))STT)[i] = 0u;
    if (tid < 256) NV[tid] = 0.f;
    v4f sacc[8];
#pragma unroll
    for (int i = 0; i < 8; ++i) sacc[i] = (v4f){0.f, 0.f, 0.f, 0.f};
    const int j = tid >> 3, c8 = tid & 7, dc = c8 * 32;
    const int tt = wave >> 1, vt0 = (wave & 1) * 2;
    const int svt = wave & 3, sdt0 = (wave >> 2) * 8;
    float m_st = 0.f;
    float lg = 0.f;
    if (MODE == 1) lg = -expf(ret_log_decay[dir * 4 + h]);
    bf16* Od = O + (size_t)(2 + dir) * TT * 1024;
    constexpr int NCHUNK = CTXL / 64 + SEQ / 64;
    v4u rq[2][4], rk[2][4], rv, rp; v4f gpv = (v4f){0.f, 0.f, 0.f, 0.f}; float kwv[2] = {0.f, 0.f}, rsv = 0.f;
    const int task0 = ((b * 4 + h) * 2 + dir) * NCHUNK;
#define MAT_ISSUE(cx, P_) do { const int seg_ = (cx) >= CTXL / 64, ci_ = seg_ ? (cx) - CTXL / 64 : (cx); \
        const int row_ = tok_row(b, seg_, ci_ * 64 + j, dir, 1); \
        const bf16* s1_ = Sqk + (size_t)row_ * ldqk; \
        _Pragma("unroll") for (int g_ = 0; g_ < 4; ++g_) { rq[P_][g_] = *(const v4u*)(s1_ + qoff + h * 256 + dc + 8 * g_); rk[P_][g_] = *(const v4u*)(s1_ + koff + h * 256 + dc + 8 * g_); } \
        if (MODE == 0 && tid < 256) kwv[P_] = GPK[(size_t)(task0 + (cx)) * 256 + tid]; } while (0)
#define MAT_GATE_LOAD(cx) do { if (MODE == 0 && wave == 0) { const int seg_ = (cx) >= CTXL / 64, ci_ = seg_ ? (cx) - CTXL / 64 : (cx); \
        const int prow_ = tok_row(b, seg_, ci_ * 64 + lane, dir, 1); gpv = *(const v4f*)(GP + ((size_t)prow_ * 8 + dir * 4 + h) * 4); rsv = RS[(size_t)(task0 + (cx)) * 64 + lane]; } } while (0)
#define MAT_GATES(cx) do { if (wave == 0) { LP(float) sc_ = SCAL + ((cx) & 1) * 384; \
        if (MODE == 0) { const float bcum_ = gpv.x, a_s_ = gpv.y, Mt_ = fmaxf(m_st, gpv.z); \
            const float M63_ = RDLANE(Mt_, 63), bend_ = RDLANE(bcum_, 63), cm63_ = RDLANE(gpv.z, 63); const float wp_ = EXPF(gpv.z - Mt_); \
            sc_[lane] = wp_; sc_[64 + lane] = EXPF(m_st - Mt_); sc_[128 + lane] = EXPF(a_s_ - M63_); sc_[192 + lane] = EXPF(-(bcum_ + Mt_)); sc_[256 + lane] = rsv * wp_; \
            if (lane == 0) { sc_[320] = EXPF(m_st - M63_); sc_[321] = EXPF(cm63_ - M63_); } \
            m_st = bend_ + M63_; \
        } else { sc_[lane] = 1.0f; sc_[64 + lane] = EXPF((float)(lane + 1) * lg); sc_[128 + lane] = EXPF((float)(63 - lane) * lg); sc_[192 + lane] = 0.f; sc_[256 + lane] = 0.f; \
            if (lane == 0) { sc_[320] = EXPF(64.f * lg); sc_[321] = 0.f; } } } } while (0)
    static_assert(NCHUNK % 2 == 0, "the chunk loop is unrolled by two");
#define MAT_ISSUE_P(cx) do { const int seg_ = (cx) >= CTXL / 64, ci_ = seg_ ? (cx) - CTXL / 64 : (cx); rp = *(const v4u*)(PP + (size_t)(task0 + (cx)) * 4096 + j * 64 + c8 * 8); \
        rv = *(const v4u*)(Sv + (size_t)tok_row(b, seg_, ci_ * 64 + j, dir, 1) * ldv + voff + h * 256 + vs * 64 + c8 * 8); } while (0)
    MAT_ISSUE(0, 0); MAT_ISSUE(1, 1); MAT_ISSUE_P(0); MAT_GATE_LOAD(0);
    MAT_GATES(0);
    MAT_GATE_LOAD(1);
    SYNC();
#pragma unroll 1
    for (int c2 = 0; c2 < NCHUNK; c2 += 2) {
#pragma unroll
    for (int u_ = 0; u_ < 2; ++u_) {
        const int cidx = c2 + u_;
        const int seg = cidx >= CTXL / 64, ci = seg ? cidx - CTXL / 64 : cidx;
        if (u_ == 0 && (c2 & 3) == 0 && c2 > 0) sibling_sync(sib, (unsigned)(c2 >> 2) * 4u, tid);
        LP(const float) sc = SCAL + u_ * 384;
        const float kw_cur = kwv[u_];
        {
            const float wk = sc[128 + j] * kscale;
#pragma unroll
            for (int g8 = 0; g8 < 4; ++g8) { const int d0 = dc + 8 * g8; *(LP(v4u))(Q + j * ST256 + d0 * 2) = rq[u_][g8]; *(LP(v4u))(K + j * ST256 + d0 * 2) = rk[u_][g8]; }
            const v4u rvv = rv;
            *(LP(v4u))(VV + j * ST64 + c8 * 16) = rvv;
            *(LP(v4u))(VW + j * ST64 + c8 * 16) = (v4u){PK2(bflo(rvv.x) * wk, bfhi(rvv.x) * wk), PK2(bflo(rvv.y) * wk, bfhi(rvv.y) * wk), PK2(bflo(rvv.z) * wk, bfhi(rvv.z) * wk), PK2(bflo(rvv.w) * wk, bfhi(rvv.w) * wk)};
            *(LP(v4u))(PM + j * ST64 + c8 * 16) = rp;
#pragma unroll
            for (int i = 0; i < 8; ++i) *(LP(v2u))(STT + (16 * svt + fr) * ST256 + (16 * (sdt0 + i) + 4 * fq) * 2) = (v2u){PK2(sacc[i].x, sacc[i].y), PK2(sacc[i].z, sacc[i].w)};
        }
        if (cidx + 2 < NCHUNK) MAT_ISSUE(cidx + 2, u_);
        if (cidx + 1 < NCHUNK) MAT_ISSUE_P(cidx + 1);
        SYNC();
        if (cidx + 1 < NCHUNK) { MAT_GATES(cidx + 1); if (cidx + 2 < NCHUNK) MAT_GATE_LOAD(cidx + 2); }
        v4f oP[2], oI[2]; oP[0] = (v4f){0.f, 0.f, 0.f, 0.f}; oP[1] = oP[0]; oI[0] = oP[0]; oI[1] = oP[0];
        v4f qa = (v4f){0.f, 0.f, 0.f, 0.f};
#pragma unroll 1
        for (int k = 0; k < 8; ++k) { const v8s af = *(LP(const v8s))(Q + (16 * tt + fr) * ST256 + fq * 16 + k * 64);
#pragma unroll
            for (int i = 0; i < 2; ++i) { const v8s bf = *(LP(const v8s))(STT + (16 * (vt0 + i) + fr) * ST256 + fq * 16 + k * 64); oI[i] = MFMA16(bf, af, oI[i]); }
            if (MODE == 0) { const v8s bn = *(LP(const v8s))(STT + (64 + fr) * ST256 + fq * 16 + k * 64); qa = MFMA16(bn, af, qa); } }
#pragma unroll
        for (int k = 0; k < 2; ++k) { const v8s af = *(LP(const v8s))(PM + (16 * tt + fr) * ST64 + fq * 16 + k * 64);
#pragma unroll
            for (int i = 0; i < 2; ++i) { const v8s bf = tr_frag(VV, ST64, 32 * k, 16 * (vt0 + i), lane); oP[i] = MFMA16(bf, af, oP[i]); } }
        { const int t = 16 * tt + fr; const float wp = sc[t], wi = sc[64 + t];
          v4f o0 = oP[0] * wp + oI[0] * wi, o1 = oP[1] * wp + oI[1] * wi;
          if (MODE == 0) { const float qn = RDLANE16(qa.x, fr); const float den = sc[256 + t] + wi * qn; const float dv = 1.0f / fmaxf(fabsf(den), sc[192 + t]); o0 = o0 * dv; o1 = o1 * dv; }
          if (seg || store_ctx) { const int orow = tok_row(b, seg, ci * 64 + t, dir, 1);
              *(v2u*)(Od + (size_t)orow * 1024 + h * 256 + vs * 64 + 16 * vt0 + 4 * fq) = (v2u){PK2(o0.x, o0.y), PK2(o0.z, o0.w)};
              *(v2u*)(Od + (size_t)orow * 1024 + h * 256 + vs * 64 + 16 * (vt0 + 1) + 4 * fq) = (v2u){PK2(o1.x, o1.y), PK2(o1.z, o1.w)}; } }
        const float dcy = sc[320];
        {
#pragma unroll
            for (int i = 0; i < 8; ++i) sacc[i] = sacc[i] * dcy;
#pragma unroll 1
            for (int k = 0; k < 2; ++k) { const v8s af = tr_frag(VW, ST64, 32 * k, 16 * svt, lane);
#pragma unroll
                for (int i = 0; i < 8; ++i) { const v8s bf = tr_frag(K, ST256, 32 * k, 16 * (sdt0 + i), lane); sacc[i] = MFMA16(bf, af, sacc[i]); } }
        }
        SYNC();
        if (MODE == 0 && tid < 256) {
            const float nn = dcy * NV[tid] + sc[321] * kw_cur * kscale; NV[tid] = nn;
            *(LP(unsigned short))(STT + 64 * ST256 + tid * 2) = F2BF(nn); }
    }
    }
#undef MAT_ISSUE
#undef MAT_ISSUE_P
#undef MAT_GATE_LOAD
#undef MAT_GATES
    SYNC();
}

constexpr int S5_LDS_PER_WAVE = 1280 + 2 * 10240 + 2 * 6144;
DEV void s5_unit(const bf16* S, int ldS, bf16* O, const float* lam_re, const float* lam_im, const float* log_step, const float* b_re, const float* b_im,
                 const float* c_re, const float* c_im, int unit, LP(unsigned char) wl, int lane) {
    const int fr = lane & 15, fq = lane >> 4;
    const int dir = unit & 1, g = (unit >> 1) & 63, b = unit >> 7;
    LP(unsigned char) UB = wl; LP(unsigned char) XB = wl + 1280; LP(unsigned char) HB = wl + 1280 + 2 * 10240;
    const int pg = (dir * 64 + g);
    const float lr = lam_re[pg * 64 + lane], li = lam_im[pg * 64 + lane], step = expf(log_step[pg]);
    const float mag = expf(lr * step); float sn, cs; sincosf(li * step, &sn, &cs);
    const float ar = mag * cs, ai = mag * sn, den = lr * lr + li * li;
    const float cre = ((ar - 1.0f) * lr + ai * li) / den, cim = (ai * lr - (ar - 1.0f) * li) / den;
    for (int p = 0; p < 16; ++p) { const float br = b_re[(pg * 64 + lane) * 16 + p], bi = b_im[(pg * 64 + lane) * 16 + p];
        *(LP(unsigned short))(XB + lane * 32 + p * 2) = F2BF(cre * br - cim * bi);
        *(LP(unsigned short))(XB + (64 + lane) * 32 + p * 2) = F2BF(cre * bi + cim * br); }
    WAVE_SYNC();
    v8s bfrag[8];
#pragma unroll
    for (int nt = 0; nt < 8; ++nt) { if (fq < 2) bfrag[nt] = *(LP(const v8s))(XB + (16 * nt + fr) * 32 + fq * 16); else bfrag[nt] = (v8s){0, 0, 0, 0, 0, 0, 0, 0}; }
    v8s cfrag[4];
#pragma unroll
    for (int ks = 0; ks < 4; ++ks) { const int n0 = 32 * ks + 8 * fq; const float* src = (n0 < 64 ? c_re : c_im) + ((size_t)pg * 16 + fr) * 64 + (n0 & 63); const float sgn = n0 < 64 ? 1.f : -1.f;
        v8s f;
#pragma unroll
        for (int i = 0; i < 8; ++i) f[i] = (short)F2BF(sgn * src[i]);
        cfrag[ks] = f; }
    WAVE_SYNC();
    for (int i = lane; i < 1280 / 4; i += 64) ((LP(unsigned))UB)[i] = 0u;
    WAVE_SYNC();
    float hr = 0.f, hi = 0.f;
    bf16* Od = O + (size_t)dir * TT * 1024;
    constexpr int NBLK = CTXL / 16 + SEQ / 16;
    constexpr int S5_PF = 8;
    v4u ur[S5_PF];
#pragma unroll
    for (int i_ = 0; i_ < S5_PF; ++i_) ur[i_] = (v4u){0u, 0u, 0u, 0u};
#define S5_LOAD(bx, dst) do { if (lane < 32 && (bx) < NBLK) { const int seg_ = (bx) >= CTXL / 16, bi_ = seg_ ? (bx) - CTXL / 16 : (bx); \
        dst = *(const v4u*)(S + (size_t)tok_row(b, seg_, bi_ * 16 + (lane >> 1), dir, 0) * ldS + g * 16 + (lane & 1) * 8); } } while (0)
#define S5_STAGE_A(bx) do { const v8s uf_ = *(LP(const v8s))(UB + fr * 80 + fq * 16); LP(unsigned char) xb_ = XB + ((bx) & 1) * 10240; \
        _Pragma("unroll") for (int nt = 0; nt < 8; ++nt) { v4f x = (v4f){0.f, 0.f, 0.f, 0.f}; x = MFMA16(uf_, bfrag[nt], x); *(LP(v4f))(xb_ + (16 * nt + fr) * 80 + fq * 16) = x; } } while (0)
#pragma unroll
    for (int i_ = 0; i_ < S5_PF; ++i_) S5_LOAD(i_, ur[i_]);
    if (lane < 32) *(LP(v4u))(UB + (lane >> 1) * 80 + (lane & 1) * 16) = ur[0];
#pragma unroll
    for (int i_ = 0; i_ + 1 < S5_PF; ++i_) ur[i_] = ur[i_ + 1];
    S5_LOAD(S5_PF, ur[S5_PF - 1]);
    WAVE_SYNC();
    S5_STAGE_A(0);
    static_assert(NBLK % S5_PF == 0, "ring unrolling");
#pragma unroll 1
    for (int bx0 = 0; bx0 <= NBLK; bx0 += S5_PF) {
#pragma unroll
    for (int ui = 0; ui < S5_PF; ++ui) {
        const int bx = bx0 + ui; if (bx > NBLK) break;
        WAVE_SYNC();
        v8s hf[4]; float xr[16], xi[16];
        if (bx >= 1) { LP(unsigned char) hb = HB + ((bx - 1) & 1) * 6144;
#pragma unroll
            for (int ks = 0; ks < 4; ++ks) hf[ks] = tr_frag(hb, 48, 32 * ks, 0, lane); }
        if (bx < NBLK) { LP(unsigned char) xb = XB + (bx & 1) * 10240;
#pragma unroll
            for (int q4 = 0; q4 < 4; ++q4) { const v4f a4 = *(LP(const v4f))(xb + lane * 80 + q4 * 16), b4 = *(LP(const v4f))(xb + (64 + lane) * 80 + q4 * 16);
                xr[4 * q4] = a4.x; xr[4 * q4 + 1] = a4.y; xr[4 * q4 + 2] = a4.z; xr[4 * q4 + 3] = a4.w; xi[4 * q4] = b4.x; xi[4 * q4 + 1] = b4.y; xi[4 * q4 + 2] = b4.z; xi[4 * q4 + 3] = b4.w; } }
        if (bx + 1 < NBLK) { if (lane < 32) *(LP(v4u))(UB + (lane >> 1) * 80 + (lane & 1) * 16) = ur[ui]; S5_LOAD(bx + 1 + S5_PF, ur[ui]); }
        WAVE_SYNC();
        if (bx + 1 < NBLK) S5_STAGE_A(bx + 1);
        if (bx >= 1) { const int pb = bx - 1, seg = pb >= CTXL / 16, bi = seg ? pb - CTXL / 16 : pb;
            if (seg) { v4f y = (v4f){0.f, 0.f, 0.f, 0.f};
#pragma unroll
                for (int ks = 0; ks < 4; ++ks) y = MFMA16(cfrag[ks], hf[ks], y);
                const int orow = tok_row(b, seg, bi * 16 + fr, dir, 0);
                *(v2u*)(Od + (size_t)orow * 1024 + g * 16 + 4 * fq) = (v2u){PK2(y.x, y.y), PK2(y.z, y.w)}; } }
        if (bx < NBLK) { LP(unsigned char) hb = HB + (bx & 1) * 6144;
            unsigned pr[8], pi[8];
#pragma unroll
            for (int t2 = 0; t2 < 8; ++t2) {
                const float r0 = ar * hr - ai * hi + xr[2 * t2], i0 = ar * hi + ai * hr + xi[2 * t2];
                hr = ar * r0 - ai * i0 + xr[2 * t2 + 1]; hi = ar * i0 + ai * r0 + xi[2 * t2 + 1];
                pr[t2] = PK2(r0, hr); pi[t2] = PK2(i0, hi); }
            *(LP(v4u))(hb + lane * 48) = (v4u){pr[0], pr[1], pr[2], pr[3]}; *(LP(v4u))(hb + lane * 48 + 16) = (v4u){pr[4], pr[5], pr[6], pr[7]};
            *(LP(v4u))(hb + (64 + lane) * 48) = (v4u){pi[0], pi[1], pi[2], pi[3]}; *(LP(v4u))(hb + (64 + lane) * 48 + 16) = (v4u){pi[4], pi[5], pi[6], pi[7]}; }
    }
    }
#undef S5_STAGE_A
#undef S5_LOAD
}

DEV void conv_prep_row(int r, const bf16* S, bf16* QK2, const float* conv_w, const float* conv_b, int lane) {
    int rm, rp; bool hasm, hasp;
    if (r < TL) { const int b = r >> 12, n = r & (SEQ - 1), gr = n >> 6, col = n & 63, np = col * 64 + gr;
        hasm = np > 0; hasp = np < SEQ - 1; rm = seq_row(b, 1, hasm ? np - 1 : np, 1); rp = seq_row(b, 1, hasp ? np + 1 : np, 1); }
    else { const int n = (r - TL) & (CTXL - 1); hasm = n > 0; hasp = n < CTXL - 1; rm = hasm ? r - 1 : r; rp = hasp ? r + 1 : r; }
    const bf16* s0 = S + (size_t)rm * EV_PAD + 3072; const bf16* s1 = S + (size_t)r * EV_PAD + 3072; const bf16* s2 = S + (size_t)rp * EV_PAD + 3072;
#pragma unroll
    for (int i = 0; i < 4; ++i) { const int c = 8 * lane + 512 * i;
        const v4u a0 = *(const v4u*)(s0 + c), a1 = *(const v4u*)(s1 + c), a2 = *(const v4u*)(s2 + c);
        const unsigned w0[4] = {a0.x, a0.y, a0.z, a0.w}, w1[4] = {a1.x, a1.y, a1.z, a1.w}, w2[4] = {a2.x, a2.y, a2.z, a2.w};
        const float sc = c >= 1024 ? 0.0625f : 1.0f;
        float val[8];
#pragma unroll
        for (int i2 = 0; i2 < 4; ++i2)
#pragma unroll
            for (int e = 0; e < 2; ++e) { const int di = 2 * i2 + e;
                const float um = hasm ? (e ? bfhi(w0[i2]) : bflo(w0[i2])) : 0.f, u0 = e ? bfhi(w1[i2]) : bflo(w1[i2]), up = hasp ? (e ? bfhi(w2[i2]) : bflo(w2[i2])) : 0.f;
                const float pre = conv_b[c + di] + conv_w[c + di] * um + conv_w[2048 + c + di] * u0 + conv_w[4096 + c + di] * up;
                val[di] = pre * RCPF(1.0f + EXPF(-pre)) * sc; }
        *(v4u*)(QK2 + (size_t)r * 2048 + c) = (v4u){PK2(val[0], val[1]), PK2(val[2], val[3]), PK2(val[4], val[5]), PK2(val[6], val[7])}; }
}

DEV v4f ld4bf(const bf16* p) { const v2u w = *(const v2u*)p; return (v4f){bflo(w.x), bfhi(w.x), bflo(w.y), bfhi(w.y)}; }
DEV float wsum(float v) {
#pragma unroll
    for (int o = 1; o < 64; o <<= 1) v += SHX(v, o);
    return v;
}
DEV float grp16_sum(float v) { v += SHX(v, 1); v += SHX(v, 2); v += SHX(v, 4); v += SHX(v, 8); return v; }
DEV void ld16bf(const bf16* p, float (&o)[16]) { const v4u a = *(const v4u*)p, b = *(const v4u*)(p + 8); const unsigned w[8] = {a.x, a.y, a.z, a.w, b.x, b.y, b.z, b.w};
#pragma unroll
    for (int i = 0; i < 8; ++i) { o[2 * i] = bflo(w[i]); o[2 * i + 1] = bfhi(w[i]); } }
DEV void ld16f(const float* p, float (&o)[16]) {
#pragma unroll
    for (int i = 0; i < 4; ++i) { const v4f a = *(const v4f*)(p + 4 * i); o[4 * i] = a.x; o[4 * i + 1] = a.y; o[4 * i + 2] = a.z; o[4 * i + 3] = a.w; } }
DEV void st16bf(bf16* p, const float (&o)[16]) { *(v4u*)p = (v4u){PK2(o[0], o[1]), PK2(o[2], o[3]), PK2(o[4], o[5]), PK2(o[6], o[7])}; *(v4u*)(p + 8) = (v4u){PK2(o[8], o[9]), PK2(o[10], o[11]), PK2(o[12], o[13]), PK2(o[14], o[15])}; }
template <int CENTER, int GATE>
DEV void head_norm16(const bf16* o0, const bf16* o1, const float* gain, const bf16* gs, bf16* dst) {
    float a[16], b2[16], g[16], gt[16];
    ld16bf(o0, a); ld16bf(o1, b2); ld16f(gain, g); ld16bf(gs, gt);
    float s = 0.f;
#pragma unroll
    for (int i = 0; i < 16; ++i) { a[i] += b2[i]; s += a[i]; }
    if (CENTER) { const float mean = grp16_sum(s) * (1.0f / 256.0f);
#pragma unroll
        for (int i = 0; i < 16; ++i) a[i] -= mean; }
    float q = 0.f;
#pragma unroll
    for (int i = 0; i < 16; ++i) q += a[i] * a[i];
    const float rstd = RSQRTF(grp16_sum(q) * (1.0f / 256.0f) + EPS);
#pragma unroll
    for (int i = 0; i < 16; ++i) { const float sg = RCPF(1.0f + EXPF(-gt[i])); const float gate = GATE ? sg : gt[i] * sg; a[i] = gate * (a[i] * rstd * g[i]); }
    st16bf(dst, a);
}
DEV void merge_even_row(int r, const bf16* S, const bf16* O, const float* gla_norm, const float* ml_norm, bf16* HBo, int lane) {
    const bf16* sr = S + (size_t)r * EV_PAD; const int c = 16 * lane; const bf16* ob = O + (size_t)r * 1024 + c; const size_t os = (size_t)TT * 1024;
    head_norm16<0, 0>(ob, ob + os, gla_norm + c, sr + 2048 + c, HBo + (size_t)r * D + c);
    head_norm16<1, 1>(ob + 2 * os, ob + 3 * os, ml_norm + c, sr + 6144 + c, HBo + (size_t)r * D + 1024 + c);
}
DEV float gelu_tanh(float y) { const float z = 0.7978845608028654f * (y + 0.044715f * y * y * y); const float t = 1.0f - 2.0f * RCPF(1.0f + EXPF(2.0f * z)); return 0.5f * y * (1.0f + t); }
DEV void merge_odd_row(int r, const bf16* S, const bf16* O, const float* s5_d, const float* ret_norm, bf16* GBo, bf16* HBo, int lane) {
    const bf16* sr = S + (size_t)r * OD_COLS; const int c = 16 * lane; const bf16* ob = O + (size_t)r * 1024 + c; const size_t os = (size_t)TT * 1024;
    {
        float y0[16], y1[16], dd[16], u[16];
        ld16bf(ob, y0); ld16bf(ob + os, y1); ld16f(s5_d + c, dd); ld16bf(sr + c, u);
#pragma unroll
        for (int i = 0; i < 16; ++i) {
#ifdef NO_S5
            y0[i] = 0.f; y1[i] = 0.f;
#endif
            y0[i] = gelu_tanh(y0[i] + y1[i] + dd[i] * u[i]); }
        st16bf(GBo + (size_t)r * 1024 + c, y0);
    }
    head_norm16<1, 0>(ob + 2 * os, ob + 3 * os, ret_norm + c, sr + 4096 + c, HBo + (size_t)r * D + 1024 + c);
}

struct EpiGLU {
    static constexpr bool PERM = true, AFTER_DRAIN = false;
    const bf16* G; const float* bias; bf16* O;
    __device__ __forceinline__ void operator()(const pg8::f32x4 (&acc)[2][2][4][2], const pg8::Unit& u, int wr, int wc, int fr, int fq) const {
        const int row0 = u.pm * 256 + wr * 64 + fr, col0 = u.pn * 256 + wc * 32 + 8 * fq;
#pragma unroll
        for (int ai = 0; ai < 2; ++ai)
#pragma unroll
            for (int m = 0; m < 4; ++m) { const size_t row = (size_t)(row0 + ai * 128 + m * 16);
#pragma unroll
                for (int bj = 0; bj < 2; ++bj) { const int col = col0 + bj * 128;
                    const v4u gw = *(const v4u*)(G + row * 1024 + col); const pg8::f32x4 b0 = *(const pg8::f32x4*)(bias + col), b1 = *(const pg8::f32x4*)(bias + col + 4);
                    const pg8::f32x4 v0 = acc[ai][bj][m][0] + b0, v1 = acc[ai][bj][m][1] + b1;
                    v4u w; w.x = pk2(bflo(gw.x) * fast_sigmoid(v0[0]), bfhi(gw.x) * fast_sigmoid(v0[1])); w.y = pk2(bflo(gw.y) * fast_sigmoid(v0[2]), bfhi(gw.y) * fast_sigmoid(v0[3]));
                    w.z = pk2(bflo(gw.z) * fast_sigmoid(v1[0]), bfhi(gw.z) * fast_sigmoid(v1[1])); w.w = pk2(bflo(gw.w) * fast_sigmoid(v1[2]), bfhi(gw.w) * fast_sigmoid(v1[3]));
                    *(v4u*)(O + row * D + col) = w; } }
    }
};

#ifndef SCAN_REPS
#define SCAN_REPS 1
#endif
__device__ __forceinline__ void mixer_phases(const Args& a, unsigned char* ws, LAS unsigned char* lds, const XcdBarrier& bar, int layer, int G, int gw, int ngw, int tid, int lane, int wave) {
#define HB ((bf16*)wsp(ws, WS_HB))
#define S ((bf16*)wsp(ws, WS_S))
#define GT ((float*)wsp(ws, WS_GT))
#define O ((bf16*)wsp(ws, WS_O))
#define GB ((bf16*)wsp(ws, WS_GB))
#define Y ((bf16*)wsp(ws, WS_Y))
    const int ldS = layer == 0 ? EV_PAD : OD_COLS;
    { pg8::Gemm g{HB, (const bf16*)(wsp(ws, (layer == 0 ? WS_WIN_EV : WS_WIN_OD))), TT, ldS, D}; pg8::StaticOrder So; So.init(TT, ldS, G, (int)blockIdx.x);
      EpiS E{S, ldS, GT, layer == 0 ? 28 : -1};
      pg8::gemm_phase<EpiS, pg8::StaticOrder, true, true>(lds, g, So, E); }
    XBAR();
#define QK2 ((bf16*)wsp(ws, WS_QK2))
#define GP ((float*)wsp(ws, WS_GP))
#define QKS ((bf16*)wsp(ws, WS_QKS))
#define GPK ((float*)wsp(ws, WS_GPK))
#define PP ((bf16*)wsp(ws, WS_PP))
#define RS ((float*)wsp(ws, WS_RS))
#define VEC ((float*)wsp(ws, WS_VEC))
    { int t2 = threadIdx.x; asm volatile("" : "+v"(t2)); tid = t2; lane = t2 & 63; wave = __builtin_amdgcn_readfirstlane(t2 >> 6); gw = blockIdx.x * NWAVES + wave; }
    if (layer == 0) {
        { const bf16* s_ = S; bf16* qk_ = QK2; const float* cw_ = ARG(16); const float* cb_ = ARG(17); for (int r = gw; r < TT; r += ngw) conv_prep_row(r, s_, qk_, cw_, cb_, lane); }
        { int t2 = threadIdx.x; asm volatile("" : "+v"(t2)); gla_prep_loop((int)blockIdx.x, G, S, GT, ARG(13), ARG(14), QKS, VEC, lds, t2); }
        XBAR();
        { int t2 = threadIdx.x; asm volatile("" : "+v"(t2)); mat_prep_loop<0>((int)blockIdx.x, G, QK2, 2048, 0, 1024, 1.0f, GT, ARG(18), GP, GPK, nullptr, PP, RS, lds, t2); }
        XBAR();
    } else {
        { int t2 = threadIdx.x; asm volatile("" : "+v"(t2)); mat_prep_loop<1>((int)blockIdx.x, G, S, OD_COLS, 1024, 2048, 0.0625f, nullptr, nullptr, nullptr, nullptr, ARG(32), PP, RS, lds, t2); }
        XBAR();
    }
#ifdef PRE_SLEEP
    { const unsigned long long t0_ = __builtin_amdgcn_s_memrealtime(); while (__builtin_amdgcn_s_memrealtime() - t0_ < (unsigned long long)(PRE_SLEEP) * 100ull) __builtin_amdgcn_s_sleep(16); XBAR(); }
#endif
    { int t2 = threadIdx.x; asm volatile("" : "+v"(t2)); tid = t2; lane = t2 & 63; wave = __builtin_amdgcn_readfirstlane(t2 >> 6); }
#pragma unroll 1
    for (int rep = 0; rep < SCAN_REPS; ++rep) {
#ifndef SIB_LOCKSTEP
#define SIB_LOCKSTEP 0
#endif
#define SIBP(ty, un) ((SIB_LOCKSTEP && G >= 2 * MIX_UNITS && SCAN_REPS == 1) ? (unsigned*)(wsp(ws, WS_CTL) + 16384 + ((ty) * 32 + ((un) >> 2)) * 64) : (unsigned*)nullptr)
#define UNIT_OF(w) (NB == 4 ? (((((w) & 7) * 4 + (((w) >> 3) & 15) / 4) << 2) | ((((w) >> 3) & 15) & 3)) : (w))
    if (layer == 0) {
#ifdef SPLIT_L0
        for (int it = blockIdx.x; it < MIX_UNITS; it += G) gla_unit(S, QKS, VEC, O, UNIT_OF(it), lds, tid, SIBP(0, UNIT_OF(it)));
        XBAR();
        for (int it = blockIdx.x; it < 2 * MIX_UNITS; it += G) if (it >= MIX_UNITS) mat_unit<0>(QK2, 2048, 0, 1024, S, EV_PAD, 5120, 1.0f, GP, GPK, PP, RS, O, 1, nullptr, UNIT_OF(it - MIX_UNITS), lds, tid, SIBP(1, UNIT_OF(it - MIX_UNITS)));
        if (false)
#endif
        for (int it = blockIdx.x; it < 2 * MIX_UNITS; it += G) {
            if (it < MIX_UNITS) {
#ifndef REP_GLA
#define REP_GLA 1
#endif
#pragma unroll 1
                for (int r_ = 0; r_ < REP_GLA; ++r_) gla_unit(S, QKS, VEC, O, UNIT_OF(it), lds, tid, SIBP(0, UNIT_OF(it)));
                if (DEFER == 1 && G >= 2 * MIX_UNITS) convert_tiles(a, ws, 1, (int)blockIdx.x * NWAVES + wave, MIX_UNITS * NWAVES, lane);
            } else {
#ifndef REP_ML
#define REP_ML 1
#endif
#pragma unroll 1
                for (int r_ = 0; r_ < REP_ML; ++r_) mat_unit<0>(QK2, 2048, 0, 1024, S, EV_PAD, 5120, 1.0f, GP, GPK, PP, RS, O, 1, nullptr, UNIT_OF(it - MIX_UNITS), lds, tid, SIBP(1, UNIT_OF(it - MIX_UNITS)));
            }
        }
        if (DEFER == 1 && G < 2 * MIX_UNITS) convert_tiles(a, ws, 1, (int)blockIdx.x * NWAVES + wave, G * NWAVES, lane);
    } else {
        const int s5_first = G >= 2 * MIX_UNITS ? MIX_UNITS : 0, s5_wgs = G - s5_first;
#ifndef REP_RET
#define REP_RET 1
#endif
#ifndef REP_S5
#define REP_S5 1
#endif
#pragma unroll 1
        for (int r_ = 0; r_ < REP_RET; ++r_)
        for (int u = blockIdx.x; u < MIX_UNITS; u += G)
            mat_unit<1>(S, OD_COLS, 1024, 2048, S, OD_COLS, 3072, 0.0625f, nullptr, nullptr, PP, RS, O, 0, ARG(32), UNIT_OF(u), lds, tid, SIBP(2, UNIT_OF(u)));
        if (DEFER == 1 && rep == 0 && (int)blockIdx.x >= s5_first && wave >= 4) convert_tiles(a, ws, 2, ((int)blockIdx.x - s5_first) * 4 + (wave - 4), 4 * s5_wgs, lane);
#pragma unroll 1
        for (int r_ = 0; r_ < REP_S5; ++r_)
        if ((int)blockIdx.x >= s5_first && wave < 4) { for (int su = ((int)blockIdx.x - s5_first) * 4 + wave; su < NB * 128; su += 4 * s5_wgs)
            s5_unit(S, OD_COLS, O, ARG(22), ARG(23), ARG(24), ARG(25), ARG(26), ARG(27), ARG(28), su, lds + wave * S5_LDS_PER_WAVE, lane); }
    }
    }
    XBAR();
    { int t2 = threadIdx.x; asm volatile("" : "+v"(t2)); tid = t2; lane = t2 & 63; wave = __builtin_amdgcn_readfirstlane(t2 >> 6); gw = blockIdx.x * NWAVES + wave; }
#ifndef NO_MERGE
    if (layer == 0) { const bf16* s_ = S; const bf16* o_ = O; const float* n0 = ARG(15); const float* n1 = ARG(19); bf16* hb_ = HB; for (int r = gw; r < TT; r += ngw) merge_even_row(r, s_, o_, n0, n1, hb_, lane); }
    else { const bf16* s_ = S; const bf16* o_ = O; const float* n0 = ARG(29); const float* n1 = ARG(33); bf16* gb_ = GB; bf16* hb_ = HB; for (int r = gw; r < TL; r += ngw) merge_odd_row(r, s_, o_, n0, n1, gb_, hb_, lane); }
#endif
    XBAR();
    const int Mo = layer == 0 ? TT : TL;
    if (layer == 1) {
        pg8::Gemm g{GB, (const bf16*)(wsp(ws, WS_WGLU)), TL, 1024, 1024}; pg8::StaticOrder So; So.init(TL, 1024, G, (int)blockIdx.x);
        EpiGLU E{GB, ARG(31), HB};
        pg8::gemm_phase<EpiGLU, pg8::StaticOrder, true, true>(lds, g, So, E);
        XBAR();
    }
    { pg8::Gemm g{HB, (const bf16*)(wsp(ws, (layer == 0 ? WS_WOUT_EV : WS_WOUT_OD))), Mo, D, D}; pg8::SplitOrder So; So.init(Mo - TL, D, G, (int)blockIdx.x);
      EpiF32 E{Y, (float*)(wsp(ws, WS_YCP))};
      pg8::gemm_phase<EpiF32, pg8::SplitOrder, true, true>(lds, g, So, E); }
    XBAR();
}
#undef HB
#undef S
#undef GT
#undef O
#undef GB
#undef Y
#undef QK2
#undef GP
#undef QKS
#undef GPK
#undef PP
#undef RS
#undef VEC
#undef UNIT_OF
#undef SIBP

#ifndef MIXER_ON
#define MIXER_ON 1
#endif
__global__ void __launch_bounds__(NTHR, 2) fwd(Args a) {
    extern __shared__ __attribute__((aligned(16))) unsigned char lds_raw[];
    LAS unsigned char* lds = (LAS unsigned char*)lds_raw;
    const int tid = threadIdx.x, lane = tid & 63, wave = __builtin_amdgcn_readfirstlane(tid >> 6);
    const int G = gridDim.x, gw = blockIdx.x * NWAVES + wave, ngw = G * NWAVES;
    unsigned char* ws = a.ws;
    if (tid < 16) ((LAS unsigned*)(lds + MISC_OFF))[tid] = 0u;
    __syncthreads();
#ifdef PROBE_A
    if (blockIdx.x == 0 && tid == 0) { volatile LAS unsigned* M_ = (volatile LAS unsigned*)(lds + MISC_OFF); const unsigned lo_ = (unsigned)__builtin_amdgcn_s_memrealtime(); if (PROBE_A == 0) M_[6] = lo_; if (PROBE_B == 0) M_[8] = lo_; }
#endif
    XcdBarrier bar = xcd_barrier_post((unsigned*)(wsp(ws, WS_CTL)), (volatile LAS unsigned*)(lds + MISC_OFF));

#ifdef NAN_POISON
    {
        v4u q = (v4u){0xffffffffu, 0xffffffffu, 0xffffffffu, 0xffffffffu};
        for (int i = tid; i < (MISC_OFF) / 16; i += NTHR) ((LAS v4u*)lds)[i] = q;
        { v4u* p = (v4u*)(wsp(ws, WS_MOD)); const size_t n = (WS_WGU - WS_MOD) / 16; for (size_t i = (size_t)blockIdx.x * NTHR + tid; i < n; i += (size_t)G * NTHR) p[i] = q; }
        { v4u* p = (v4u*)(wsp(ws, WS_XC)); const size_t n = (WS_END - WS_XC) / 16; for (size_t i = (size_t)blockIdx.x * NTHR + tid; i < n; i += (size_t)G * NTHR) p[i] = q; }
        { v4u* p = (v4u*)a.out; const size_t n = (size_t)TL * D * 4 / 16; for (size_t i = (size_t)blockIdx.x * NTHR + tid; i < n; i += (size_t)G * NTHR) p[i] = q; }
        __syncthreads();
        XBAR();
    }
#endif
#define MOD ((float*)wsp(ws, WS_MOD))
#define MODP ((float*)wsp(ws, WS_MODP))
#define HB ((bf16*)wsp(ws, WS_HB))
#define HID ((bf16*)wsp(ws, WS_HID))
#define Y ((bf16*)wsp(ws, WS_Y))
#define XC ((bf16*)wsp(ws, WS_XC))
#define XL ((bf16*)wsp(ws, WS_XL))

#ifndef REP_PRO
#define REP_PRO 1
#endif
#ifndef REP_GU
#define REP_GU 1
#endif
#ifndef REP_DN
#define REP_DN 1
#endif
#pragma unroll 1
    for (int rep_ = 0; rep_ < REP_PRO; ++rep_) {
        __syncthreads();
        LAS float* stab = (LAS float*)(lds + 1024);
        { const float* cin = ARG(1); const float* cctx = ARG(3);
        for (int i = tid; i < 5 * D; i += NTHR) { const int r = i >> 11, k = i & (D - 1); const float c = r < 4 ? cin[r * D + k] : cctx[k]; stab[i] = c / (1.0f + expf(-c)); } }
        __syncthreads();
        for (int it = gw; it < 2 * MOD_KC * 72; it += ngw) {
            const int l = it / (MOD_KC * 72), rem = it % (MOD_KC * 72), kc = rem / 72, jb = rem % 72; constexpr int KCH = D / MOD_KC;
            const float* W = ARG(4) + ((size_t)l * D + kc * KCH) * (NMOD * D) + jb * 256 + lane * 4;
            f32x4 acc[5];
#pragma unroll
            for (int r = 0; r < 5; ++r) acc[r] = (f32x4){0.f, 0.f, 0.f, 0.f};
            for (int k = 0; k < KCH; k += 8) { f32x4 w[8];
#pragma unroll
                for (int i = 0; i < 8; ++i) w[i] = *(const f32x4*)(W + (size_t)(k + i) * (NMOD * D));
#pragma unroll
                for (int i = 0; i < 8; ++i)
#pragma unroll
                    for (int r = 0; r < 5; ++r) acc[r] += stab[r * D + kc * KCH + k + i] * w[i]; }
            { float* modp = MODP;
#pragma unroll
            for (int r = 0; r < 5; ++r) *(f32x4*)(modp + (((size_t)l * MOD_KC + kc) * 5 + r) * (NMOD * D) + jb * 256 + lane * 4) = acc[r]; }
        }
        convert_tiles(a, ws, 0, gw, ngw, lane);
#ifndef DEFER
#define DEFER 1
#endif
        if (!DEFER) { convert_tiles(a, ws, 1, gw, ngw, lane); convert_tiles(a, ws, 2, gw, ngw, lane); }
        { v4u z = (v4u){0u, 0u, 0u, 0u}; v4u* p = (v4u*)(wsp(ws, WS_WIN_EV) + (size_t)EV_COLS * 2048 * 2); const int n16 = (EV_PAD - EV_COLS) * 2048 * 2 / 16;
          for (int i = blockIdx.x * NTHR + tid; i < n16; i += G * NTHR) p[i] = z; }
    }
    XBAR();
    { const float* bmod = ARG(5); const float* modp = MODP; float* modf = MOD;
    for (int i = blockIdx.x * NTHR + tid; i < 2 * 5 * NMOD * D; i += G * NTHR) {
        const int l = i / (5 * NMOD * D), rem = i % (5 * NMOD * D), r = rem / (NMOD * D), j = rem % (NMOD * D);
        float s = bmod[l * (NMOD * D) + j];
        for (int kc = 0; kc < MOD_KC; ++kc) s += modp[(((size_t)l * MOD_KC + kc) * 5 + r) * (NMOD * D) + j];
        modf[i] = s;
    } }
    XBAR();
#ifndef REP_N0
#define REP_N0 1
#endif
#pragma unroll 1
    for (int rep_ = 0; rep_ < REP_N0; ++rep_)
    { NormP p{}; p.xin_lat = ARG(0); p.xin_ctx = ARG(2); p.xin_f32 = 1; p.xout_f32 = 0; p.xout_lat = XL; p.xout_ctx = XC; p.y = nullptr; p.h = HB; p.rows_end = TT; p.has_y = 0; p.has_h = 1; p.w = 0.f; p.lp = 0; p.sp = 0; p.ln = 0; p.sn = 0;
      norm_phase(p, MOD, ARG(6), ARG(7), lds, gw, ngw, tid, lane); }
    XBAR();

#pragma unroll 1
    for (int layer = 0; layer < 2; ++layer) {
#pragma unroll 1
        for (int half = 0; half < 2; ++half) {
            const int Mrows = (layer == 1 && half == 1) ? TL : TT;
#if MIXER_ON
            if (half == 1) {
                mixer_phases(a, ws, lds, bar, layer, G, gw, ngw, tid, lane, wave);
                NormP p{}; p.xin_lat = XL; p.xin_ctx = XC; p.xin_f32 = 0; p.xout_f32 = 0; p.xout_lat = XL; p.xout_ctx = XC; p.y = Y; p.y_ctx = (const float*)(wsp(ws, WS_YCP)); p.h = HB; p.rows_end = Mrows; p.has_y = 1; p.has_h = 1; p.w = 1.0f; p.lp = layer; p.sp = 1; p.ln = layer; p.sn = 2;
                norm_phase(p, MOD, ARG(6), ARG(7), lds, gw, ngw, tid, lane);
                XBAR();
            }
#endif
            const int sub = half * 2;
#pragma unroll 1
            for (int rep_ = 0; rep_ < REP_GU; ++rep_) { pg8::Gemm g{HB, (const bf16*)(wsp(ws, WS_WGU) + (size_t)(layer * 2 + half) * SZ_WGU), Mrows, 2 * DFF, D}; pg8::StaticOrder S; S.init(Mrows, 2 * DFF, G, (int)blockIdx.x);
              EpiSwiGLU E{HID, DFF};
              pg8::gemm_phase<EpiSwiGLU, pg8::StaticOrder, true, true>(lds, g, S, E);
              if (DEFER == 2 && rep_ == 0 && !(layer == 1 && half == 1)) {
                  const int rem = ((Mrows / 256) * (2 * DFF / 256)) % G, nidle = rem ? G - rem : G, me = rem ? (int)blockIdx.x - rem : (int)blockIdx.x;
                  if (me >= 0) { int t2 = threadIdx.x; asm volatile("" : "+v"(t2)); convert_tiles(a, ws, layer * 2 + half + 1, me * NWAVES + __builtin_amdgcn_readfirstlane(t2 >> 6), nidle * NWAVES, t2 & 63); } }
              if (rep_ + 1 < REP_GU) XBAR(); }
            XBAR();
#pragma unroll 1
            for (int rep_ = 0; rep_ < REP_DN; ++rep_) { pg8::Gemm g{HID, (const bf16*)(wsp(ws, WS_WD) + (size_t)(layer * 2 + half) * SZ_WD), Mrows, D, DFF}; pg8::SplitOrder S; S.init(Mrows - TL, DFF, G, (int)blockIdx.x);
              EpiF32 E{Y, (float*)(wsp(ws, WS_YCP))};
              pg8::gemm_phase<EpiF32, pg8::SplitOrder, true, true>(lds, g, S, E);
              if (rep_ + 1 < REP_DN) XBAR(); }
            XBAR();
            { NormP p{}; const bool first = (layer == 0 && half == 0);
              const bool lastp = (layer == 1 && half == 1);
              p.xin_lat = first ? (const void*)ARG(0) : (const void*)XL; p.xin_ctx = first ? (const void*)ARG(2) : (const void*)XC; p.xin_f32 = first ? 1 : 0;
              p.xout_lat = lastp ? (void*)a.out : (void*)XL; p.xout_ctx = XC; p.xout_f32 = lastp ? 1 : 0; p.y = Y; p.y_ctx = (const float*)(wsp(ws, WS_YCP)); p.h = HB; p.rows_end = Mrows; p.has_y = 1; p.w = 0.5f; p.lp = layer; p.sp = sub;
              if (half == 0) { p.has_h = 1; p.ln = layer; p.sn = MIXER_ON ? 1 : 2; }
              else if (layer == 0) { p.has_h = 1; p.ln = 1; p.sn = 0; }
              else { p.has_h = 0; p.ln = 0; p.sn = 0; }
              norm_phase(p, MOD, ARG(6), ARG(7), lds, gw, ngw, tid, lane); }
            if (!(layer == 1 && half == 1)) XBAR();
        }
    }
#ifdef PROBE_A
    XBAR();
    if (blockIdx.x == 0 && threadIdx.x == 0) { volatile LAS unsigned* M_ = (volatile LAS unsigned*)(lds + MISC_OFF);
        const unsigned ticks = (M_[7] - M_[6]) + (PROBE_B >= 0 ? (M_[9] - M_[8]) : 0u);
        const unsigned long long t0 = __builtin_amdgcn_s_memrealtime();
        while (__builtin_amdgcn_s_memrealtime() - t0 < 8ull * ticks) __builtin_amdgcn_s_sleep(8); }
#endif
}

#undef MOD
#undef MODP
#undef HB
#undef HID
#undef Y
#undef XC
#undef XL
extern "C" void kernel_launch(void* const* d_in, const int* in_sizes, int n_in, void* d_out, int out_size, void* d_ws, size_t ws_size, hipStream_t stream) {
    static int grid = 0;
    if (grid == 0) {
        if (n_in != 34 || out_size != TL * D || ws_size < WS_END) { fprintf(stderr, "kernel_launch: unexpected shapes (n_in %d out %d ws %zu need %zu)\n", n_in, out_size, ws_size, (size_t)WS_END); grid = -1; return; }
        int dev = 0, cus = 0, per_cu = 0;
        if (hipGetDevice(&dev) != hipSuccess || hipDeviceGetAttribute(&cus, hipDeviceAttributeMultiprocessorCount, dev) != hipSuccess) { grid = -1; return; }
        if (hipFuncSetAttribute((const void*)fwd, hipFuncAttributeMaxDynamicSharedMemorySize, LDS_BYTES) != hipSuccess) { fprintf(stderr, "kernel_launch: hipFuncSetAttribute failed\n"); grid = -1; return; }
        if (hipOccupancyMaxActiveBlocksPerMultiprocessor(&per_cu, (const void*)fwd, NTHR, LDS_BYTES) != hipSuccess || per_cu < 1) { fprintf(stderr, "kernel_launch: occupancy query says %d\n", per_cu); }
        (void)hipGetLastError();
        grid = cus;
    }
    if (grid < 0) return;
    if (hipMemsetAsync((char*)d_ws + WS_CTL, 0, CTL_ZERO_BYTES, stream) != hipSuccess) return;
    Args a{};
    for (int i = 0; i < 34; ++i) a.in[i] = (const float*)d_in[i];
    a.out = (float*)d_out; a.ws = (unsigned char*)d_ws;
    hipLaunchKernelGGL(fwd, dim3(grid), dim3(NTHR), LDS_BYTES, stream, a);
}
```

```cpp
#include <hip/hip_runtime.h>
#include <cstdio>
#include <cstdint>
#define MIXER_ON 1

#define XB_TMO      128
#define XB_XCNT(j)  (256  + 64 * (j))
#define XB_XSUB(j)  (1280 + 64 * (j))
#define XB_XGEN(j)  (2304 + 64 * (j))
#define XB_TOP      3328
#define XB_TOPGEN   3392
#define XCD_BAR_WORDS 3456
#define XB_SPIN_CAP (1u << 18)
#define LAS __attribute__((address_space(3)))

__device__ __forceinline__ unsigned xb_ld(unsigned* p)              { return __hip_atomic_load(p, __ATOMIC_RELAXED, __HIP_MEMORY_SCOPE_AGENT); }
__device__ __forceinline__ unsigned xb_add(unsigned* p, unsigned v) { return __hip_atomic_fetch_add(p, v, __ATOMIC_RELAXED, __HIP_MEMORY_SCOPE_AGENT); }
__device__ __forceinline__ unsigned xb_xcc_id() { return (unsigned)__builtin_amdgcn_s_getreg((3 << 11) | 20) & 0xFu; }
#define XB_SPIN(cond, bar) do { unsigned _sp = 0; while (cond) { __builtin_amdgcn_s_sleep(1); \
    if ((++_sp & 255u) == 0u) { if (xb_ld(&(bar)[XB_TMO])) break; if (_sp > XB_SPIN_CAP) { atomicAdd(&(bar)[XB_TMO], 1u); break; } } } } while (0)

struct XcdBarrier {
    unsigned* bar; unsigned x;
    volatile LAS unsigned* st;
};

__device__ __forceinline__ XcdBarrier xcd_barrier_post(unsigned* bar, volatile LAS unsigned* st) {
    XcdBarrier b; b.bar = bar; b.x = xb_xcc_id(); b.st = st;
    if (threadIdx.x == 0) (void)xb_add(&bar[XB_XCNT(b.x)], 1u);
    return b;
}
__device__ __forceinline__ void xcd_barrier_complete(unsigned* bar, unsigned x, unsigned& nloc, unsigned& nx) {
    const unsigned G = gridDim.x * gridDim.y * gridDim.z;
    unsigned sum, cnt, mine, sp = 0u;
    for (;;) {
        sum = 0u; cnt = 0u; mine = 0u;
#pragma unroll
        for (unsigned j = 0; j < 16; ++j) { const unsigned c = xb_ld(&bar[XB_XCNT(j)]); sum += c; cnt += (c > 0u) ? 1u : 0u; mine = (j == x) ? c : mine; }
        if (sum == G) break;
        __builtin_amdgcn_s_sleep(1);
        if ((++sp & 255u) == 0u) { if (xb_ld(&bar[XB_TMO])) break; if (sp > XB_SPIN_CAP) { atomicAdd(&bar[XB_TMO], 1u); break; } }
    }
    nloc = mine > 0u ? mine : 1u; nx = cnt > 0u ? cnt : 1u;
}

__device__ __forceinline__ void xcd_barrier(const XcdBarrier& b) {
    asm volatile("s_waitcnt vmcnt(0)" ::: "memory");
    __syncthreads();
    if (threadIdx.x == 0) {
        unsigned* bar = b.bar;
        unsigned bx = __builtin_amdgcn_readfirstlane(b.x); asm volatile("" : "+s"(bx));
        __builtin_amdgcn_s_waitcnt(0);
        unsigned nloc = b.st[0], nx = b.st[1];
        if (nloc == 0u) { xcd_barrier_complete(bar, bx, nloc, nx); b.st[0] = nloc; b.st[1] = nx; }
        const unsigned old = xb_add(&bar[XB_XSUB(bx)], 1u);
        const unsigned gen = old / nloc;
        if (old + 1u == (gen + 1u) * nloc) {
            __builtin_amdgcn_fence(__ATOMIC_RELEASE, "agent");
            asm volatile("s_waitcnt vmcnt(0)" ::: "memory");
            const unsigned og = xb_add(&bar[XB_TOP], 1u);
            const unsigned tg = og / nx;
            if (og + 1u == (tg + 1u) * nx) xb_add(&bar[XB_TOPGEN], 1u);
            else XB_SPIN(xb_ld(&bar[XB_TOPGEN]) == tg, bar);
            __builtin_amdgcn_fence(__ATOMIC_ACQUIRE, "agent");
            xb_add(&bar[XB_XGEN(bx)], 1u);
            asm volatile("s_waitcnt vmcnt(0)" ::: "memory");
        } else {
            XB_SPIN(xb_ld(&bar[XB_XGEN(bx)]) == gen, bar);
            __builtin_amdgcn_fence(__ATOMIC_ACQUIRE, "agent");
            asm volatile("s_waitcnt vmcnt(0)" ::: "memory");
        }
    }
    __syncthreads();
}

namespace pg8 {
#define PG8_LAS __attribute__((address_space(3)))
typedef unsigned short bf16_t;
typedef short bf16x8 __attribute__((ext_vector_type(8)));
typedef float f32x4 __attribute__((ext_vector_type(4)));
typedef unsigned u32x4 __attribute__((ext_vector_type(4)));
constexpr int BM = 256, BK = 64, HALF = 128, HTB = HALF * BK * 2  , STAGE_BYTES = 8 * HTB, NXCD = 8, WGM = 8;

__host__ __device__ __forceinline__ int lds_byte(int r, int c) { const int st = (r >> 4) * 2 + (c >> 5), rr = r & 15, cc = c & 31, ob = rr * 64 + cc * 2; return st * 1024 + (ob ^ (((ob >> 9) & 1) << 5)); }
__host__ __device__ __forceinline__ void stage_rc(int b, int& R, int& C) { const int st = b / 1024, sb = b % 1024, swz = sb ^ (((sb >> 9) & 1) << 5); R = (st >> 1) * 16 + swz / 64; C = (st & 1) * 32 + (swz % 64) / 2; }
__host__ __device__ __forceinline__ int perm32(int rho) { const int n = rho >> 4, i = rho & 15; return 8 * (i >> 2) + 4 * n + (i & 3); }

struct Unit { int pm, pn, k0, nt, part; };
struct Gemm { const bf16_t* A; const bf16_t* Bt; int M, N, K; };

struct StaticOrder {
    int nM, nN, nwg, G, c;
    __host__ __device__ void init(int M, int N, int G_, int c_) { nM = M / BM; nN = N / BM; nwg = nM * nN; G = G_; c = c_; }
    __host__ __device__ bool next(int i, Unit& u) const {
        const long L = (long)i * G + c; if (L >= nwg) return false;
        int wgid = (int)L; { const int q = nwg / NXCD, r = nwg % NXCD, xcd = wgid % NXCD, off = wgid / NXCD; wgid = (xcd < r ? xcd * (q + 1) : r * (q + 1) + (xcd - r) * q) + off; }
        const int nig = WGM * nN, gid = wgid / nig, fm = gid * WGM, gsz = (nM - fm) < WGM ? (nM - fm) : WGM;
        u.pm = fm + ((wgid % nig) % gsz); u.pn = (wgid % nig) / gsz; u.k0 = 0; u.nt = 0; u.part = -1; return true;
    }
    __device__ __forceinline__ void a_ready(const Unit&) const {}
    __device__ __forceinline__ void done(const Unit&) const {}
};
struct SplitOrder {
    static constexpr int NMF = 64, NN = 8, PARTS = 8, NFULL = NMF * NN;
    int nsplit, ntK, G, c;
    __host__ __device__ void init(int Msplit, int K, int G_, int c_) { nsplit = (Msplit / BM) * NN * PARTS; ntK = K / BK; G = G_; c = c_; }
    __host__ __device__ bool next(int i, Unit& u) const {
        const int L = i * G + c, p = L - NFULL; const bool fullu = L < NFULL;
        const int wgid = (L % NXCD) * (NFULL / NXCD) + L / NXCD, nig = WGM * NN, fm = (wgid / nig) * WGM;
        const int q = p & 7, cu = p >> 3, h = ntK >> 1, ks = ((h * q) >> 3) << 1, ke = ((h * (q + 1)) >> 3) << 1;
        u.pm = fullu ? fm + ((wgid % nig) % WGM) : NMF + (cu >> 3);
        u.pn = fullu ? (wgid % nig) / WGM : (cu & 7);
        u.k0 = fullu ? 0 : ks; u.nt = fullu ? 0 : ke - ks; u.part = fullu ? -1 : q;
        return fullu || p < nsplit;
    }
    __device__ __forceinline__ void a_ready(const Unit&) const {}
    __device__ __forceinline__ void done(const Unit&) const {}
};
__device__ __forceinline__ unsigned cvt_pk_bf16(float lo, float hi) { unsigned r; asm volatile("v_cvt_pk_bf16_f32 %0, %1, %2" : "=v"(r) : "v"(lo), "v"(hi)); return r; }
template <class Epi, class Sched, bool ALIGN_EPI = false, bool SP2 = false>
__device__ __forceinline__ void gemm_phase(PG8_LAS unsigned char* lds, const Gemm g, const Sched& S, const Epi& E) {
    int tid_ = threadIdx.x; asm volatile("" : "+v"(tid_));
    const int tid = tid_, wid = __builtin_amdgcn_readfirstlane(tid >> 6), lane = tid & 63, wr = wid >> 2, wc = wid & 3, fr = lane & 15, fq = lane >> 4;
    const int K = g.K, nt = K / BK;
    unsigned voffA[2], voffB[2];
#pragma unroll
    for (int i = 0; i < 2; ++i) { int R, C; stage_rc(tid * 16 + i * 8192, R, C); const int Rb = Epi::PERM ? ((R & ~31) + perm32(R & 31)) : R;
        voffA[i] = (unsigned)(R * K + C) * 2u; voffB[i] = (unsigned)(Rb * K + C) * 2u; }
    const unsigned kstep = BK * 2;
    const unsigned hstep = (unsigned)HALF * K * 2;
    const unsigned tstep = 2 * hstep;
    const unsigned ldsw = (unsigned)wid * 1024u;
    const int aoff = lds_byte(wr * 64 + fr, fq * 8), boff = lds_byte(wc * 32 + fr, fq * 8);
#define PG8_SA(b, h) (((b) * 2 + (h)) * HTB)
#define PG8_SB(b, h) ((4 + (b) * 2 + (h)) * HTB)
#define PG8_STAGE(bufoff, gbase, voff) do { _Pragma("unroll") for (int _i = 0; _i < 2; ++_i) \
        __builtin_amdgcn_global_load_lds((const unsigned*)((const char*)(gbase) + (voff)[_i]), (PG8_LAS unsigned*)(lds + (bufoff) + ldsw + _i * 8192), 16, 0, 0); } while (0)
#define PG8_LDA(dst, b, h) do { _Pragma("unroll") for (int m = 0; m < 4; ++m) _Pragma("unroll") for (int k = 0; k < 2; ++k) dst[m][k] = *(const PG8_LAS bf16x8*)(lds + PG8_SA(b, h) + aoff + m * 2048 + k * 1024); } while (0)
#define PG8_LDB(dst, b, h) do { _Pragma("unroll") for (int n = 0; n < 2; ++n) _Pragma("unroll") for (int k = 0; k < 2; ++k) dst[n][k] = *(const PG8_LAS bf16x8*)(lds + PG8_SB(b, h) + boff + n * 2048 + k * 1024); } while (0)
#define PG8_MMA(ai, bj, At, Bt) do { __builtin_amdgcn_s_setprio(1); _Pragma("unroll") for (int m = 0; m < 4; ++m) _Pragma("unroll") for (int n = 0; n < 2; ++n) _Pragma("unroll") for (int k = 0; k < 2; ++k) \
        acc[ai][bj][m][n] = __builtin_amdgcn_mfma_f32_16x16x32_bf16(Bt[n][k], At[m][k], acc[ai][bj][m][n], 0, 0, 0); __builtin_amdgcn_s_setprio(0); } while (0)
#define PG8_WAIT_V(n) asm volatile("s_waitcnt vmcnt(" #n ")" ::: "memory")
#define PG8_WAIT_L(n) asm volatile("s_waitcnt lgkmcnt(" #n ")" ::: "memory")
#define PG8_BAR __builtin_amdgcn_s_barrier()
#define PG8_SCHED __builtin_amdgcn_sched_barrier(0)
    Unit cur, nxt; int ui = 0;
    if (!S.next(0, cur)) return;
    f32x4 acc[2][2][4][2];
#pragma unroll
    for (int a = 0; a < 2; ++a)
#pragma unroll
        for (int b = 0; b < 2; ++b)
#pragma unroll
            for (int m = 0; m < 4; ++m)
#pragma unroll
                for (int n = 0; n < 2; ++n) acc[a][b][m][n] = (f32x4){0.f, 0.f, 0.f, 0.f};
    bf16x8 At[4][2], B0[2][2], B1[2][2];
    unsigned cA = (unsigned)cur.pm * tstep + (unsigned)cur.k0 * kstep, cB = (unsigned)cur.pn * tstep + (unsigned)cur.k0 * kstep;
    S.a_ready(cur);
    if constexpr (SP2) {
        PG8_STAGE(PG8_SB(0, 0), (const char*)g.Bt + (size_t)(cB), voffB); PG8_STAGE(PG8_SB(0, 1), (const char*)g.Bt + (size_t)(cB + hstep), voffB); PG8_STAGE(PG8_SA(0, 0), (const char*)g.A + (size_t)(cA), voffA); PG8_STAGE(PG8_SA(0, 1), (const char*)g.A + (size_t)(cA + hstep), voffA);
        if (wr == 1) PG8_BAR;
        PG8_WAIT_V(2); PG8_BAR;
        PG8_STAGE(PG8_SB(1, 0), (const char*)g.Bt + (size_t)(cB + kstep), voffB); PG8_STAGE(PG8_SA(1, 0), (const char*)g.A + (size_t)(cA + kstep), voffA); PG8_STAGE(PG8_SB(1, 1), (const char*)g.Bt + (size_t)(cB + hstep + kstep), voffB);
        PG8_WAIT_V(6); PG8_BAR;
    } else {
        PG8_STAGE(PG8_SB(0, 0), (const char*)g.Bt + (size_t)(cB), voffB); PG8_STAGE(PG8_SA(0, 0), (const char*)g.A + (size_t)(cA), voffA); PG8_STAGE(PG8_SB(0, 1), (const char*)g.Bt + (size_t)(cB + hstep), voffB); PG8_STAGE(PG8_SA(0, 1), (const char*)g.A + (size_t)(cA + hstep), voffA);
        if (wr == 1) PG8_BAR;
        PG8_WAIT_V(4); PG8_BAR;
        PG8_STAGE(PG8_SB(1, 0), (const char*)g.Bt + (size_t)(cB + kstep), voffB); PG8_STAGE(PG8_SA(1, 0), (const char*)g.A + (size_t)(cA + kstep), voffA); PG8_STAGE(PG8_SB(1, 1), (const char*)g.Bt + (size_t)(cB + hstep + kstep), voffB);
        PG8_WAIT_V(6); PG8_BAR;
    }
    for (;;) {
        const bool has_next = S.next(ui + 1, nxt);
        const unsigned nA = has_next ? (unsigned)nxt.pm * tstep + (unsigned)nxt.k0 * kstep : cA, nB = has_next ? (unsigned)nxt.pn * tstep + (unsigned)nxt.k0 * kstep : cB;
        const int unt = cur.nt ? cur.nt : nt;
        for (int t = 0; t < unt; t += 2) {
            const bool last = (t == unt - 2);
            const unsigned a1 = cA + (unsigned)(t + 1) * kstep;
            const unsigned a2 = last ? nA : cA + (unsigned)(t + 2) * kstep, b2 = last ? nB : cB + (unsigned)(t + 2) * kstep;
            const unsigned a3 = a2 + kstep, b3 = b2 + kstep;
            if (last && has_next) S.a_ready(nxt);
            if constexpr (SP2) {
            PG8_LDB(B0, 0, 0); PG8_LDB(B1, 0, 1); PG8_SCHED; PG8_LDA(At, 0, 0); PG8_STAGE(PG8_SA(1, 1), (const char*)g.A + (size_t)(a1 + hstep), voffA);
            PG8_WAIT_V(8); PG8_WAIT_L(0); PG8_BAR; PG8_MMA(0, 0, At, B0); PG8_MMA(0, 1, At, B1); PG8_BAR; PG8_SCHED;
            PG8_LDA(At, 0, 1); PG8_STAGE(PG8_SB(0, 0), (const char*)g.Bt + (size_t)(b2), voffB); PG8_STAGE(PG8_SB(0, 1), (const char*)g.Bt + (size_t)(b2 + hstep), voffB); PG8_STAGE(PG8_SA(0, 0), (const char*)g.A + (size_t)(a2), voffA);
            PG8_WAIT_V(8); PG8_WAIT_L(0); PG8_BAR; PG8_MMA(1, 0, At, B0); PG8_MMA(1, 1, At, B1); PG8_BAR; PG8_SCHED;
            PG8_LDB(B0, 1, 0); PG8_LDB(B1, 1, 1); PG8_SCHED; PG8_LDA(At, 1, 0); PG8_STAGE(PG8_SA(0, 1), (const char*)g.A + (size_t)(a2 + hstep), voffA);
            PG8_WAIT_V(8); PG8_WAIT_L(0); PG8_BAR; PG8_MMA(0, 0, At, B0); PG8_MMA(0, 1, At, B1); PG8_BAR; PG8_SCHED;
            PG8_LDA(At, 1, 1); PG8_STAGE(PG8_SB(1, 0), (const char*)g.Bt + (size_t)(b3), voffB); PG8_STAGE(PG8_SB(1, 1), (const char*)g.Bt + (size_t)(b3 + hstep), voffB); PG8_STAGE(PG8_SA(1, 0), (const char*)g.A + (size_t)(a3), voffA);
            PG8_WAIT_V(8); PG8_WAIT_L(0); PG8_BAR; PG8_MMA(1, 0, At, B0); PG8_MMA(1, 1, At, B1); PG8_BAR; PG8_SCHED;
            } else {
            PG8_LDB(B0, 0, 0); PG8_SCHED; PG8_LDA(At, 0, 0); PG8_STAGE(PG8_SA(1, 1), (const char*)g.A + (size_t)(a1 + hstep), voffA);
            PG8_WAIT_L(8); PG8_BAR; PG8_WAIT_L(0); PG8_MMA(0, 0, At, B0); PG8_BAR; PG8_SCHED;
            PG8_LDB(B1, 0, 1); PG8_STAGE(PG8_SB(0, 0), (const char*)g.Bt + (size_t)(b2), voffB);
            PG8_BAR; PG8_WAIT_L(0); PG8_MMA(0, 1, At, B1); PG8_BAR;
            PG8_LDA(At, 0, 1); PG8_STAGE(PG8_SA(0, 0), (const char*)g.A + (size_t)(a2), voffA);
            PG8_BAR; PG8_WAIT_L(0); PG8_MMA(1, 0, At, B0); PG8_BAR; PG8_SCHED;
            PG8_STAGE(PG8_SB(0, 1), (const char*)g.Bt + (size_t)(b2 + hstep), voffB);
            PG8_WAIT_V(6); PG8_BAR; PG8_MMA(1, 1, At, B1); PG8_BAR;
            PG8_LDB(B0, 1, 0); PG8_SCHED; PG8_LDA(At, 1, 0); PG8_STAGE(PG8_SA(0, 1), (const char*)g.A + (size_t)(a2 + hstep), voffA);
            PG8_WAIT_L(8); PG8_BAR; PG8_WAIT_L(0); PG8_MMA(0, 0, At, B0); PG8_BAR; PG8_SCHED;
            PG8_LDB(B1, 1, 1); PG8_STAGE(PG8_SB(1, 0), (const char*)g.Bt + (size_t)(b3), voffB);
            PG8_BAR; PG8_WAIT_L(0); PG8_MMA(0, 1, At, B1); PG8_BAR;
            PG8_LDA(At, 1, 1); PG8_STAGE(PG8_SA(1, 0), (const char*)g.A + (size_t)(a3), voffA);
            PG8_BAR; PG8_WAIT_L(0); PG8_MMA(1, 0, At, B0); PG8_BAR; PG8_SCHED;
            PG8_STAGE(PG8_SB(1, 1), (const char*)g.Bt + (size_t)(b3 + hstep), voffB);
            PG8_WAIT_V(6); PG8_BAR; PG8_MMA(1, 1, At, B1); PG8_BAR;
            }
        }
        if constexpr (ALIGN_EPI) { if (wr == 0) PG8_BAR; }
        if constexpr (!Epi::AFTER_DRAIN) { int t_ = threadIdx.x; asm volatile("" : "+v"(t_)); const int l_ = t_ & 63, w_ = __builtin_amdgcn_readfirstlane(t_ >> 6);
            E(acc, cur, w_ >> 2, w_ & 3, l_ & 15, l_ >> 4); S.done(cur); }
        if (!has_next) break;
#pragma unroll
        for (int a = 0; a < 2; ++a)
#pragma unroll
            for (int b = 0; b < 2; ++b)
#pragma unroll
                for (int m = 0; m < 4; ++m)
#pragma unroll
                    for (int n = 0; n < 2; ++n) acc[a][b][m][n] = (f32x4){0.f, 0.f, 0.f, 0.f};
        cur = nxt; cA = nA; cB = nB; ++ui;
        if constexpr (ALIGN_EPI) { if (wr == 1) PG8_BAR; }
    }
    PG8_WAIT_V(0);
    if constexpr (!ALIGN_EPI) { if (wr == 0) PG8_BAR; }
    PG8_BAR;
    if constexpr (Epi::AFTER_DRAIN) { E.fused(acc, cur, wr, wc, fr, fq, lds, wid, lane); S.done(cur); }
#undef PG8_SA
#undef PG8_SB
#undef PG8_STAGE
#undef PG8_LDA
#undef PG8_LDB
#undef PG8_MMA
#undef PG8_WAIT_V
#undef PG8_WAIT_L
#undef PG8_BAR
#undef PG8_SCHED
}
}

#define GAS __attribute__((address_space(1)))
typedef unsigned short bf16;
typedef float f32x4 __attribute__((ext_vector_type(4)));
typedef unsigned v4u __attribute__((ext_vector_type(4)));
typedef unsigned v2u __attribute__((ext_vector_type(2)));
constexpr int D = 2048, NB = 4, SEQ = 4096, CTXL = 256, DFF = 5504, NMOD = 9;
constexpr int TL = NB * SEQ, TC = NB * CTXL, TT = TL + TC;
constexpr int MIXH = 1024;
constexpr int EV_COLS = 7216, EV_PAD = 7424, OD_COLS = 5120;
constexpr int NWAVES = 8, NTHR = 512;
constexpr float EPS = 1e-6f;

constexpr size_t MiB = 1u << 20;
constexpr size_t WS_CTL = 0, CTL_ZERO_BYTES = 64 * 1024;
constexpr size_t WS_MOD = 1 * MiB;
constexpr size_t WS_MODP = 2 * MiB;
constexpr int MOD_KC = 16;
constexpr size_t WS_WGU = 16 * MiB;
constexpr size_t SZ_WGU = (size_t)11008 * 2048 * 2;
constexpr size_t WS_WD = WS_WGU + 4 * SZ_WGU;
constexpr size_t SZ_WD = (size_t)2048 * 5504 * 2;
constexpr size_t WS_WIN_EV = WS_WD + 4 * SZ_WD;
constexpr size_t WS_WOUT_EV = WS_WIN_EV + (size_t)EV_PAD * 2048 * 2;
constexpr size_t WS_WIN_OD = WS_WOUT_EV + (size_t)2048 * 2048 * 2;
constexpr size_t WS_WOUT_OD = WS_WIN_OD + (size_t)OD_COLS * 2048 * 2;
constexpr size_t WS_WGLU = WS_WOUT_OD + (size_t)2048 * 2048 * 2;
constexpr size_t WS_XC = WS_WGLU + (size_t)1024 * 1024 * 2;
constexpr size_t WS_HB = WS_XC + (size_t)TC * D * 4;
constexpr size_t WS_R = WS_HB + (size_t)TT * D * 2;
constexpr size_t WS_HID = WS_R;
constexpr size_t WS_Y = WS_R + 183 * MiB;
constexpr size_t WS_S = WS_R;
constexpr size_t WS_GT = WS_R + 247 * MiB;
constexpr size_t WS_GB = WS_R + 264 * MiB;
constexpr size_t WS_O = WS_R + 298 * MiB;
constexpr size_t SZ_O = (size_t)TT * 1024 * 2;
constexpr size_t WS_XL = WS_R + 434 * MiB;
constexpr size_t WS_QK2 = WS_XL + (size_t)TL * D * 2;
constexpr size_t WS_GP = WS_QK2 + (size_t)TT * 2048 * 2;
constexpr size_t WS_QKS = WS_GP + (size_t)TT * 8 * 4 * 4;
constexpr size_t WS_VEC = WS_QKS + (size_t)2 * TT * 1024 * 2;
constexpr size_t WS_GPK = WS_VEC + (size_t)NB * 4 * 2 * 68 * 384 * 4;
constexpr size_t WS_PP = WS_GPK + (size_t)NB * 4 * 2 * 68 * 256 * 4;
constexpr size_t WS_RS = WS_PP + (size_t)NB * 4 * 2 * 68 * 4096 * 2;
constexpr size_t WS_END = WS_RS + (size_t)NB * 4 * 2 * 68 * 64 * 4;
constexpr size_t WS_YCP = WS_R + 320 * MiB;
constexpr int YPARTS = 8;
static_assert(WS_YCP >= WS_Y + (size_t)TT * D * 2 && WS_YCP + (size_t)YPARTS * TC * D * 4 <= WS_XL && WS_O + 4 * SZ_O <= WS_XL, "ws map");
static_assert(WS_HID + (size_t)TT * DFF * 2 <= WS_Y && WS_S + (size_t)TT * EV_PAD * 2 <= WS_GT && WS_GT + (size_t)TT * 256 * 4 <= WS_GB && WS_GB + (size_t)TT * 1024 * 2 <= WS_O, "ws map");
static_assert(WS_Y + (size_t)TT * D * 2 <= WS_O, "ws map");

constexpr int LDS_BYTES = 156 * 1024;
constexpr int MISC_OFF = LDS_BYTES - 64;

struct Args { const float* in[34]; float* out; unsigned char* ws; };
#ifdef PROBE_A
#ifndef PROBE_A1
#define PROBE_A1 PROBE_A
#endif
#ifndef PROBE_B
#define PROBE_B -100
#endif
#ifndef PROBE_B1
#define PROBE_B1 PROBE_B
#endif
#define XBAR() do { xcd_barrier(bar); if (blockIdx.x == 0 && threadIdx.x == 0) { volatile LAS unsigned* M_ = (volatile LAS unsigned*)(lds + MISC_OFF); const unsigned c_ = M_[4]; \
        const unsigned long long t_ = __builtin_amdgcn_s_memrealtime(); const unsigned lo_ = (unsigned)t_; \
        if ((int)c_ == PROBE_A - 1) M_[6] = lo_; if ((int)c_ == PROBE_A1) M_[7] = lo_; if ((int)c_ == PROBE_B - 1) M_[8] = lo_; if ((int)c_ == PROBE_B1) M_[9] = lo_; M_[4] = c_ + 1u; } } while (0)
#else
#define XBAR() xcd_barrier(bar)
#endif
#define ARG(k) ((const float*)(GAS const float*)(a.in[opaque_idx(k)]))
__device__ __forceinline__ unsigned char* wsp(unsigned char* w, size_t off) { asm volatile("" : "+s"(off)); return w + off; }
__device__ __forceinline__ int opaque_idx(int k) { asm volatile("" : "+s"(k)); return k; }

__device__ __forceinline__ unsigned f2bf(float f) { unsigned u = __float_as_uint(f); u += 0x7FFFu + ((u >> 16) & 1u); return u >> 16; }
typedef __bf16 bf16x2_t __attribute__((ext_vector_type(2)));
typedef float f32x2_t __attribute__((ext_vector_type(2)));
__device__ __forceinline__ unsigned pk2(float lo, float hi) { const f32x2_t v = {lo, hi}; const bf16x2_t b = __builtin_convertvector(v, bf16x2_t); return __builtin_bit_cast(unsigned, b); }
__device__ __forceinline__ float bf2f(unsigned short b) { return __uint_as_float(((unsigned)b) << 16); }
__device__ __forceinline__ float wave_sum(float v) {
#pragma unroll
    for (int o = 1; o < 64; o <<= 1) v += __shfl_xor(v, o);
    return v;
}
__device__ __forceinline__ float fast_silu(float g) { return g * __builtin_amdgcn_rcpf(1.0f + __expf(-g)); }
__device__ __forceinline__ float fast_sigmoid(float g) { return __builtin_amdgcn_rcpf(1.0f + __expf(-g)); }

#ifndef DEFER
#define DEFER 2
#endif
struct TJob { const float* src; bf16* dst; int K, N, map; };
constexpr int NT_FFN = 5504, NT_EVIN = 32 * 226, NT_SQ = 2048, NT_ODIN = 32 * 160, NT_GLU = 512;
constexpr int NT_SET0 = 6 * NT_FFN + NT_EVIN + NT_SQ + NT_ODIN + NT_SQ + NT_GLU, NT_SET1 = 3 * NT_FFN, NT_SET2 = 3 * NT_FFN;
__device__ __forceinline__ void transpose_tile(const TJob& j, int tl, int lane) {
    const int nblk = (j.N + 31) / 32, kb = tl / nblk, nb = tl % nblk, k0 = 64 * kb, n0 = 32 * nb;
    const int kb8 = lane >> 3, nb4 = lane & 7, n = n0 + 4 * nb4;
    int drow0;
    if (j.map == 0) drow0 = n0;
    else if (j.map == 1) drow0 = (n0 / 128) * 256 + (n0 % 128);
    else if (j.map == 2) drow0 = (n0 / 128) * 256 + (n0 % 128) + 128;
    else drow0 = (nb < 96) ? n0 : (nb == 96 ? 7168 : (nb < 225 ? n0 - 32 : 7200));
    if (n < j.N) {
        const float* s = j.src + (size_t)(k0 + 8 * kb8) * j.N + n;
        f32x4 v[8];
#pragma unroll
        for (int i = 0; i < 8; ++i) v[i] = *(const f32x4*)(s + (size_t)i * j.N);
        bf16* d = j.dst + (size_t)(drow0 + 4 * nb4) * j.K + k0 + 8 * kb8;
#pragma unroll
        for (int e = 0; e < 4; ++e) { v4u o; o.x = pk2(v[0][e], v[1][e]); o.y = pk2(v[2][e], v[3][e]); o.z = pk2(v[4][e], v[5][e]); o.w = pk2(v[6][e], v[7][e]);
            *(v4u*)(d + (size_t)e * j.K) = o; }
    }
}

__device__ __forceinline__ void transpose_tile2(const TJob& j, int tl0, int tl1, int lane) {
    const int nblk = (j.N + 31) / 32; const int kb8 = lane >> 3, nb4 = lane & 7;
    f32x4 v[2][8]; int drow[2], k0s[2]; bool ok[2];
#pragma unroll
    for (int u = 0; u < 2; ++u) { const int tl = u ? tl1 : tl0; const int kb = tl / nblk, nb = tl % nblk, k0 = 64 * kb, n0 = 32 * nb, n = n0 + 4 * nb4;
        int drow0;
        if (j.map == 0) drow0 = n0;
        else if (j.map == 1) drow0 = (n0 / 128) * 256 + (n0 % 128);
        else if (j.map == 2) drow0 = (n0 / 128) * 256 + (n0 % 128) + 128;
        else drow0 = (nb < 96) ? n0 : (nb == 96 ? 7168 : (nb < 225 ? n0 - 32 : 7200));
        drow[u] = drow0; k0s[u] = k0; ok[u] = n < j.N;
        if (ok[u]) { const float* s = j.src + (size_t)(k0 + 8 * kb8) * j.N + n;
#pragma unroll
            for (int i = 0; i < 8; ++i) v[u][i] = *(const f32x4*)(s + (size_t)i * j.N); } }
#pragma unroll
    for (int u = 0; u < 2; ++u) if (ok[u]) { bf16* d = j.dst + (size_t)(drow[u] + 4 * nb4) * j.K + k0s[u] + 8 * kb8;
#pragma unroll
        for (int e = 0; e < 4; ++e) { v4u o; o.x = pk2(v[u][0][e], v[u][1][e]); o.y = pk2(v[u][2][e], v[u][3][e]); o.z = pk2(v[u][4][e], v[u][5][e]); o.w = pk2(v[u][6][e], v[u][7][e]);
            *(v4u*)(d + (size_t)e * j.K) = o; } }
}
__device__ __forceinline__ TJob make_job(const Args& a, unsigned char* ws, int id) {
    TJob j;
    if (id < 12) { const int li = id / 3, kind = id % 3; const size_t wo = (size_t)li * 2048 * 5504;
        j.src = ARG(8 + kind) + wo;
        if (kind == 2) { j.K = 5504; j.N = 2048; j.map = 0; j.dst = (bf16*)(wsp(ws, WS_WD) + (size_t)li * SZ_WD); }
        else { j.K = 2048; j.N = 5504; j.map = 1 + kind; j.dst = (bf16*)(wsp(ws, WS_WGU) + (size_t)li * SZ_WGU); } }
    else if (id == 12) { j.src = ARG(11); j.K = 2048; j.N = EV_COLS; j.map = 3; j.dst = (bf16*)wsp(ws, WS_WIN_EV); }
    else if (id == 13) { j.src = ARG(12); j.K = 2048; j.N = 2048; j.map = 0; j.dst = (bf16*)wsp(ws, WS_WOUT_EV); }
    else if (id == 14) { j.src = ARG(20); j.K = 2048; j.N = OD_COLS; j.map = 0; j.dst = (bf16*)wsp(ws, WS_WIN_OD); }
    else if (id == 15) { j.src = ARG(21); j.K = 2048; j.N = 2048; j.map = 0; j.dst = (bf16*)wsp(ws, WS_WOUT_OD); }
    else { j.src = ARG(30); j.K = 1024; j.N = 1024; j.map = 0; j.dst = (bf16*)wsp(ws, WS_WGLU); }
    return j;
}
__device__ __forceinline__ void convert_tiles(const Args& a, unsigned char* ws, int set, int wave_index, int nwaves, int lane) {
    const int njobs = DEFER == 2 ? (set == 0 ? 8 : 3) : (set == 0 ? 11 : 3);
    int start = wave_index;
#pragma unroll 1
    for (int q = 0; q < njobs; ++q) {
        const int id = DEFER == 2 ? (set == 0 ? (q < 3 ? q : q + 9) : 3 * set + q) : (set == 0 ? (q < 3 ? q : (q < 6 ? q + 3 : q + 6)) : (set == 1 ? 3 + q : 9 + q));
        const int nt = id < 12 ? NT_FFN : (id == 12 ? NT_EVIN : (id == 14 ? NT_ODIN : (id == 16 ? NT_GLU : NT_SQ)));
        const TJob j = make_job(a, ws, id);
        int t = start;
#pragma unroll 1
        for (; t + nwaves < nt; t += 2 * nwaves) transpose_tile2(j, t, t + nwaves, lane);
        if (t < nt) { transpose_tile(j, t, lane); t += nwaves; }
        start = t - nt;
    }
}

struct NormP {
    const void* xin_lat; const void* xin_ctx; void* xout_lat; void* xout_ctx; const bf16* y; bf16* h;
    int xin_f32, xout_f32;
    int rows_end; int has_y, has_h; float w;
    const float* y_ctx;
    int lp, sp;
    int ln, sn;
};
__device__ __forceinline__ void norm_phase(const NormP& p, const float* mod, const float* norm_pre, const float* norm_post, LAS unsigned char* lds, int gw, int ngw, int tid, int lane) {
    { int t2 = threadIdx.x; asm volatile("" : "+v"(t2)); tid = t2; lane = t2 & 63; gw = blockIdx.x * NWAVES + __builtin_amdgcn_readfirstlane(t2 >> 6); }
    LAS float* TA = (LAS float*)lds; LAS float* TB = TA + 5 * D; LAS float* TCc = TB + 5 * D;
    for (int i = tid; i < 5 * D; i += NTHR) { const int var = i >> 11, j = i & (D - 1);
        if (p.has_y) TA[i] = p.w * mod[((size_t)p.lp * 5 + var) * (NMOD * D) + (3 * p.sp + 2) * D + j] * norm_post[(p.lp * 3 + p.sp) * D + j];
        if (p.has_h) { TB[i] = norm_pre[(p.ln * 3 + p.sn) * D + j] * (1.0f + mod[((size_t)p.ln * 5 + var) * (NMOD * D) + (3 * p.sn + 1) * D + j]);
                       TCc[i] = mod[((size_t)p.ln * 5 + var) * (NMOD * D) + (3 * p.sn) * D + j]; } }
    __syncthreads();
    for (int r = gw; r < p.rows_end; r += ngw) {
        const int var = r < TL ? (r >> 12) : 4;
        const size_t xoff = r < TL ? (size_t)r * D : (size_t)(r - TL) * D;
        const void* xi = r < TL ? p.xin_lat : p.xin_ctx; void* xo = r < TL ? p.xout_lat : p.xout_ctx;
        f32x4 xv[8];
        if (p.xin_f32) {
#pragma unroll
            for (int j = 0; j < 8; ++j) xv[j] = *(const f32x4*)((const float*)xi + xoff + 4 * lane + 256 * j);
        } else {
#pragma unroll
            for (int j = 0; j < 8; ++j) { const v2u w = *(const v2u*)((const bf16*)xi + xoff + 4 * lane + 256 * j); xv[j] = (f32x4){__uint_as_float(w.x << 16), __uint_as_float(w.x & 0xffff0000u), __uint_as_float(w.y << 16), __uint_as_float(w.y & 0xffff0000u)}; }
        }
        if (p.has_y) {
            const bool yc = (r >= TL) && p.y_ctx; const float* yr = p.y_ctx + (size_t)(r - TL) * D; f32x4 yv[8]; float s = 0.f;
            if (!yc) { const bf16* yb = p.y + (size_t)r * D;
#pragma unroll
                for (int j = 0; j < 8; ++j) { const v2u w = *(const v2u*)(yb + 4 * lane + 256 * j); yv[j] = (f32x4){__uint_as_float(w.x << 16), __uint_as_float(w.x & 0xffff0000u), __uint_as_float(w.y << 16), __uint_as_float(w.y & 0xffff0000u)}; }
            } else {
#pragma unroll
                for (int j = 0; j < 8; ++j) yv[j] = *(const f32x4*)(yr + 4 * lane + 256 * j);
                for (int q = 1; q < YPARTS; ++q) {
#pragma unroll
                for (int j = 0; j < 8; ++j) yv[j] += *(const f32x4*)(yr + (size_t)q * TC * D + 4 * lane + 256 * j); } }
#pragma unroll
            for (int j = 0; j < 8; ++j) { s += (yv[j].x * yv[j].x + yv[j].y * yv[j].y) + (yv[j].z * yv[j].z + yv[j].w * yv[j].w); }
            const float rstd = 1.0f / sqrtf(wave_sum(s) * (1.0f / D) + EPS);
#pragma unroll
            for (int j = 0; j < 8; ++j) { const f32x4 a = *(const LAS f32x4*)(TA + var * D + 4 * lane + 256 * j); xv[j] = xv[j] + a * (yv[j] * rstd);
                if (p.xout_f32) *(f32x4*)((float*)xo + xoff + 4 * lane + 256 * j) = xv[j];
                else { v2u w; w.x = pk2(xv[j].x, xv[j].y); w.y = pk2(xv[j].z, xv[j].w); *(v2u*)((bf16*)xo + xoff + 4 * lane + 256 * j) = w; } }
        }
        if (p.has_h) {
            float s = 0.f;
#pragma unroll
            for (int j = 0; j < 8; ++j) s += (xv[j].x * xv[j].x + xv[j].y * xv[j].y) + (xv[j].z * xv[j].z + xv[j].w * xv[j].w);
            const float rstd = 1.0f / sqrtf(wave_sum(s) * (1.0f / D) + EPS);
            bf16* hr = p.h + (size_t)r * D;
#pragma unroll
            for (int j = 0; j < 8; ++j) { const f32x4 b = *(const LAS f32x4*)(TB + var * D + 4 * lane + 256 * j), c = *(const LAS f32x4*)(TCc + var * D + 4 * lane + 256 * j);
                const f32x4 o = xv[j] * rstd * b + c; v2u w; w.x = pk2(o.x, o.y); w.y = pk2(o.z, o.w); *(v2u*)(hr + 4 * lane + 256 * j) = w; }
        }
    }
    __syncthreads();
}

struct EpiSwiGLU {
    static constexpr bool PERM = true, AFTER_DRAIN = false;
    bf16* O; int ldc;
    __device__ __forceinline__ void operator()(const pg8::f32x4 (&acc)[2][2][4][2], const pg8::Unit& u, int wr, int wc, int fr, int fq) const {
        const int row0 = u.pm * 256 + wr * 64 + fr, col0 = u.pn * 128 + wc * 32 + 8 * fq;
#pragma unroll
        for (int ai = 0; ai < 2; ++ai)
#pragma unroll
            for (int m = 0; m < 4; ++m) { bf16* rowp = O + (size_t)(row0 + ai * 128 + m * 16) * ldc + col0;
                const pg8::f32x4 g0 = acc[ai][0][m][0], g1 = acc[ai][0][m][1], u0 = acc[ai][1][m][0], u1 = acc[ai][1][m][1];
                v4u w; w.x = pk2(fast_silu(g0[0]) * u0[0], fast_silu(g0[1]) * u0[1]); w.y = pk2(fast_silu(g0[2]) * u0[2], fast_silu(g0[3]) * u0[3]);
                w.z = pk2(fast_silu(g1[0]) * u1[0], fast_silu(g1[1]) * u1[1]); w.w = pk2(fast_silu(g1[2]) * u1[2], fast_silu(g1[3]) * u1[3]);
                *(v4u*)rowp = w; }
    }
};
struct EpiF32 {
    static constexpr bool PERM = true, AFTER_DRAIN = false;
    bf16* C; float* Cs;
    static constexpr int ldc = D;
    __device__ __forceinline__ void operator()(const pg8::f32x4 (&acc)[2][2][4][2], const pg8::Unit& u, int wr, int wc, int fr, int fq) const {
        const int row0 = u.pm * 256 + wr * 64 + fr, col0 = u.pn * 256 + wc * 32 + 8 * fq;
        if (u.part >= 0) {
            float* base = Cs + ((size_t)u.part * TC - (size_t)TL) * D;
#pragma unroll
            for (int ai = 0; ai < 2; ++ai)
#pragma unroll
                for (int m = 0; m < 4; ++m) { float* rowp = base + (size_t)(row0 + ai * 128 + m * 16) * ldc + col0;
#pragma unroll
                    for (int bj = 0; bj < 2; ++bj) { *(pg8::f32x4*)(rowp + bj * 128) = acc[ai][bj][m][0]; *(pg8::f32x4*)(rowp + bj * 128 + 4) = acc[ai][bj][m][1]; } }
        } else {
#pragma unroll
            for (int ai = 0; ai < 2; ++ai)
#pragma unroll
                for (int m = 0; m < 4; ++m) { bf16* rowp = C + (size_t)(row0 + ai * 128 + m * 16) * ldc + col0;
#pragma unroll
                    for (int bj = 0; bj < 2; ++bj) { const pg8::f32x4 v0 = acc[ai][bj][m][0], v1 = acc[ai][bj][m][1];
                        v4u w; w.x = pk2(v0[0], v0[1]); w.y = pk2(v0[2], v0[3]); w.z = pk2(v1[0], v1[1]); w.w = pk2(v1[2], v1[3]);
                        *(v4u*)(rowp + bj * 128) = w; } }
        }
    }
};
struct EpiS {
    static constexpr bool PERM = true, AFTER_DRAIN = false;
    bf16* S; int ldc; float* GT; int gt_pn;
    __device__ __forceinline__ void operator()(const pg8::f32x4 (&acc)[2][2][4][2], const pg8::Unit& u, int wr, int wc, int fr, int fq) const {
        const int row0 = u.pm * 256 + wr * 64 + fr;
        if (u.pn == gt_pn) {
            if (wc < 2) {
#pragma unroll
                for (int ai = 0; ai < 2; ++ai)
#pragma unroll
                    for (int m = 0; m < 4; ++m) { float* rowp = GT + (size_t)(row0 + ai * 128 + m * 16) * 256 + wc * 32 + 8 * fq;
                        *(pg8::f32x4*)rowp = acc[ai][0][m][0]; *(pg8::f32x4*)(rowp + 4) = acc[ai][0][m][1]; }
            }
        } else {
            const int col0 = u.pn * 256 + wc * 32 + 8 * fq;
#pragma unroll
            for (int ai = 0; ai < 2; ++ai)
#pragma unroll
                for (int m = 0; m < 4; ++m) { bf16* rowp = S + (size_t)(row0 + ai * 128 + m * 16) * ldc + col0;
#pragma unroll
                    for (int bj = 0; bj < 2; ++bj) { const pg8::f32x4 v0 = acc[ai][bj][m][0], v1 = acc[ai][bj][m][1];
                        v4u w; w.x = pk2(v0[0], v0[1]); w.y = pk2(v0[2], v0[3]); w.z = pk2(v1[0], v1[1]); w.w = pk2(v1[2], v1[3]);
                        *(v4u*)(rowp + bj * 128) = w; } }
        }
    }
};

#define DEV __device__ __forceinline__
#define LP(T) LAS T*
#define SYNC() do { asm volatile("s_waitcnt lgkmcnt(0)" ::: "memory"); __builtin_amdgcn_s_barrier(); asm volatile("" ::: "memory"); } while (0)
typedef short v8s __attribute__((ext_vector_type(8)));
typedef float v4f __attribute__((ext_vector_type(4)));
#define MFMA16(x, y, c) __builtin_amdgcn_mfma_f32_16x16x32_bf16((x), (y), (c), 0, 0, 0)
#define SHX(v, m) __shfl_xor((v), (m))
#define SHUP(v, d) __shfl_up((v), (d))
#define SHIDX(v, l) __shfl((v), (l))
#define EXPF(x) __expf(x)
#define LOGF(x) __logf(x)
#define RCPF(x) __builtin_amdgcn_rcpf(x)
#define RSQRTF(x) (1.0f / sqrtf(x))
#define PK2(lo, hi) pk2((lo), (hi))
#define F2BF(x) ((unsigned short)f2bf(x))
#define WAVE_SYNC() asm volatile("s_waitcnt lgkmcnt(0)" ::: "memory")
typedef short v4s __attribute__((ext_vector_type(4)));
#define LDS_TR16(p) __builtin_amdgcn_ds_read_tr16_b64_v4i16((LAS v4s*)(p))
#define RDLANE(v, l) __int_as_float(__builtin_amdgcn_readlane(__float_as_int(v), (l)))
#define RDLANE16(v, l) __shfl((v), (l))
#define SIB_SYNC_IMPL(p, target) do { __hip_atomic_fetch_add((p), 1u, __ATOMIC_RELAXED, __HIP_MEMORY_SCOPE_AGENT); unsigned sp_ = 0; \
    while (__hip_atomic_load((p), __ATOMIC_RELAXED, __HIP_MEMORY_SCOPE_AGENT) < (target) && ++sp_ < 100000u) __builtin_amdgcn_s_sleep(2); } while (0)

#define PRBROW(r) ((prb) == 1 ? ((r) & 63) : (r))
#define PRBTSK(t) ((prb) == 1 ? 0 : (t))
DEV int seq_row(int b, int seg, int np, int cm) {
    if (!seg) return TL + b * CTXL + np;
    const int n = cm ? ((np & 63) * 64 + (np >> 6)) : np;
    return b * SEQ + n;
}
DEV int tok_row(int b, int seg, int pos, int dir, int cm) {
    const int len = seg ? SEQ : CTXL;
    return seq_row(b, seg, dir ? len - 1 - pos : pos, cm);
}
DEV float bflo(unsigned u) { return __uint_as_float(u << 16); }
DEV float bfhi(unsigned u) { return __uint_as_float(u & 0xffff0000u); }
DEV float logsigmoidf(float z) { return fminf(z, 0.f) - LOGF(1.0f + EXPF(-fabsf(z))); }
DEV v4f tile_mma(v4f acc, LP(const unsigned char) A, int sa, int m0, LP(const unsigned char) B, int sb, int n0, int ksteps, int fr, int fq) {
    LP(const unsigned char) ap = A + (m0 + fr) * sa + fq * 16;
    LP(const unsigned char) bp = B + (n0 + fr) * sb + fq * 16;
    for (int k = 0; k < ksteps; ++k) {
        const v8s af = *(LP(const v8s))(ap + k * 64);
        const v8s bf = *(LP(const v8s))(bp + k * 64);
        acc = MFMA16(bf, af, acc);
    }
    return acc;
}
DEV v8s tr_frag(LP(const unsigned char) T, int st, int k0, int n0, int lane) {
    const int l16 = lane & 15, fq = lane >> 4;
    LP(const unsigned char) p = T + (k0 + 8 * fq + (l16 >> 2)) * st + (n0 + 4 * (l16 & 3)) * 2;
    const v4s a = LDS_TR16(p), b = LDS_TR16(p + 4 * st);
    return (v8s){a.x, a.y, a.z, a.w, b.x, b.y, b.z, b.w};
}
DEV v4f tile_mma_nt(v4f acc, LP(const unsigned char) A, int sa, int m0, LP(const unsigned char) Bt, int sb, int n0, int ksteps, int lane) {
    const int fr = lane & 15, fq = lane >> 4;
    for (int k = 0; k < ksteps; ++k) { const v8s af = *(LP(const v8s))(A + (m0 + fr) * sa + fq * 16 + k * 64); const v8s bf = tr_frag(Bt, sb, 32 * k, n0, lane); acc = MFMA16(bf, af, acc); }
    return acc;
}
DEV v4f tile_mma_tt(v4f acc, LP(const unsigned char) At, int sa, int m0, LP(const unsigned char) Bt, int sb, int n0, int ksteps, int lane) {
    for (int k = 0; k < ksteps; ++k) { const v8s af = tr_frag(At, sa, 32 * k, m0, lane); const v8s bf = tr_frag(Bt, sb, 32 * k, n0, lane); acc = MFMA16(bf, af, acc); }
    return acc;
}
constexpr int ST128 = 272, ST64 = 144, ST256 = 528, STV = 80;
DEV void sibling_sync(unsigned* sib, unsigned target, int tid) {
#ifdef SIB_SYNC_IMPL
    if (sib) { if (tid == 0) SIB_SYNC_IMPL(sib, target); SYNC(); }
#endif
}

constexpr int MIX_UNITS = NB * 32;
constexpr int GLA_TASKS = NB * 4 * 2 * (CTXL / 64 + SEQ / 64);
DEV void gla_prep_loop(int first, int stride, const bf16* S, const float* GT, const float* wg_all, const float* bg_all, bf16* QKS, float* VEC, LP(unsigned char) lds, int tid) {
    constexpr int NCHUNK = CTXL / 64 + SEQ / 64;
    LP(float) LA = (LP(float))lds; LP(float) SEG = (LP(float))(lds + 32768); LP(unsigned char) LRb = lds + 34816; LP(unsigned char) WGb = lds + 39936; LP(float) BG = (LP(float))(lds + 50176);
    for (int i = tid; i < (5120 + 10240) / 4; i += NTHR) ((LP(unsigned))LRb)[i] = 0u;
    SYNC();
    const int lane = tid & 63, wave = tid >> 6, fr = lane & 15, fq = lane >> 4;
    const int j = tid >> 3, c8 = tid & 7, dc = c8 * 16;
    const float qscale = 0.08838834764831845f;
    v4u pq0, pq1, pk0, pk1; v4f plr = (v4f){0.f, 0.f, 0.f, 0.f}, pwg = plr; float pbg = 0.f;
#define GP_ISSUE(tk) do { const int cx_ = (tk) % NCHUNK, r1_ = (tk) / NCHUNK, dir_ = r1_ & 1, h_ = (r1_ >> 1) & 3, b_ = r1_ >> 3; \
        const int seg_ = cx_ >= CTXL / 64, ci_ = seg_ ? cx_ - CTXL / 64 : cx_; \
        const bf16* sr_ = S + (size_t)tok_row(b_, seg_, ci_ * 64 + j, dir_, 0) * EV_PAD; \
        pq0 = *(const v4u*)(sr_ + h_ * 128 + dc); pq1 = *(const v4u*)(sr_ + h_ * 128 + dc + 8); pk0 = *(const v4u*)(sr_ + 512 + h_ * 128 + dc); pk1 = *(const v4u*)(sr_ + 512 + h_ * 128 + dc + 8); \
        pwg = *(const v4f*)(wg_all + (dir_ * 16 + (tid >> 5)) * 512 + h_ * 128 + (tid & 31) * 4); \
        if (tid < 128) pbg = bg_all[dir_ * 512 + h_ * 128 + tid]; \
        if (tid < 256) { const int rr_ = tok_row(b_, seg_, ci_ * 64 + (tid >> 2), dir_, 0); plr = *(const v4f*)(GT + (size_t)rr_ * 256 + dir_ * 16 + (tid & 3) * 4); } } while (0)
    if (first < GLA_TASKS) GP_ISSUE(first);
    for (int task = first; task < GLA_TASKS; task += stride) {
    const int cidx = task % NCHUNK, r1 = task / NCHUNK, dir = r1 & 1, h = (r1 >> 1) & 3, b = r1 >> 3;
    const int seg = cidx >= CTXL / 64, ci = seg ? cidx - CTXL / 64 : cidx;
    const int row = tok_row(b, seg, ci * 64 + j, dir, 0);
    const v4u q0 = pq0, q1 = pq1, k0 = pk0, k1 = pk1;
    { const int m = tid >> 5, d0 = (tid & 31) * 4;
      *(LP(unsigned short))(WGb + (d0 + 0) * 80 + m * 2) = F2BF(pwg.x); *(LP(unsigned short))(WGb + (d0 + 1) * 80 + m * 2) = F2BF(pwg.y);
      *(LP(unsigned short))(WGb + (d0 + 2) * 80 + m * 2) = F2BF(pwg.z); *(LP(unsigned short))(WGb + (d0 + 3) * 80 + m * 2) = F2BF(pwg.w); }
    if (tid < 128) BG[tid] = pbg;
    if (tid < 256) *(LP(v2u))(LRb + (tid >> 2) * 80 + (tid & 3) * 8) = (v2u){PK2(plr.x, plr.y), PK2(plr.z, plr.w)};
    if (task + stride < GLA_TASKS) GP_ISSUE(task + stride);
    SYNC();
    {
        const int tt = wave >> 1; const v8s af = *(LP(const v8s))(LRb + (16 * tt + fr) * 80 + fq * 16);
#pragma unroll
        for (int i = 0; i < 4; ++i) { const int dt = (wave & 1) * 4 + i; const v8s bf = *(LP(const v8s))(WGb + (16 * dt + fr) * 80 + fq * 16);
            v4f z = (v4f){0.f, 0.f, 0.f, 0.f}; z = MFMA16(bf, af, z);
            const v4f bg4 = *(LP(const v4f))(BG + 16 * dt + 4 * fq);
            v4f o; o.x = logsigmoidf(z.x + bg4.x) * 0.0625f; o.y = logsigmoidf(z.y + bg4.y) * 0.0625f; o.z = logsigmoidf(z.z + bg4.z) * 0.0625f; o.w = logsigmoidf(z.w + bg4.w) * 0.0625f;
            *(LP(v4f))(LA + (16 * tt + fr) * 128 + 16 * dt + 4 * fq) = o; }
    }
    SYNC();
    {
        const int d = tid & 127, sg = tid >> 7; float acc = 0.f;
        for (int jj = 0; jj < 16; ++jj) { acc += LA[(sg * 16 + jj) * 128 + d]; LA[(sg * 16 + jj) * 128 + d] = acc; }
        SEG[sg * 128 + d] = acc;
    }
    SYNC();
    {
        const int sgj = j >> 4;
        bf16* orow = QKS + ((size_t)dir * TT + row) * 1024 + h * 128 + dc;
#pragma unroll 1
        for (int g = 0; g < 2; ++g) {
            const v4u qv = g ? q1 : q0, kv = g ? k1 : k0;
            const unsigned qw[4] = {qv.x, qv.y, qv.z, qv.w}, kw[4] = {kv.x, kv.y, kv.z, kv.w};
            unsigned oqs[4], oks[4];
#pragma unroll
            for (int i2 = 0; i2 < 4; ++i2) {
                float vqs[2], vks[2];
#pragma unroll
                for (int e = 0; e < 2; ++e) {
                    const int d = dc + 8 * g + 2 * i2 + e;
                    const float s0 = SEG[d], s1 = SEG[128 + d], s2 = SEG[256 + d];
                    const float pre = (sgj > 0 ? s0 : 0.f) + (sgj > 1 ? s1 : 0.f) + (sgj > 2 ? s2 : 0.f);
                    const float bv = LA[j * 128 + d] + pre;
                    const float bmid = LA[32 * 128 + d] + s0 + s1;
                    const float q = (e ? bfhi(qw[i2]) : bflo(qw[i2])) * qscale, k = e ? bfhi(kw[i2]) : bflo(kw[i2]);
                    const float e1 = EXPF(bv - bmid);
                    vqs[e] = q * e1; vks[e] = k * RCPF(e1);
                    if (j == 63) { const float bend = bv; float* vp = VEC + (size_t)task * 384 + d; vp[0] = EXPF(bmid); vp[128] = EXPF(bend - bmid); vp[256] = EXPF(bend); }
                }
                oqs[i2] = PK2(vqs[0], vqs[1]); oks[i2] = PK2(vks[0], vks[1]);
            }
            *(v4u*)(orow + 8 * g) = (v4u){oqs[0], oqs[1], oqs[2], oqs[3]};
            *(v4u*)(orow + 512 + 8 * g) = (v4u){oks[0], oks[1], oks[2], oks[3]};
        }
    }
    SYNC();
    }
#undef GP_ISSUE
}

DEV void gla_unit(const bf16* S, const bf16* QKS, const float* VEC, bf16* O, int unit, LP(unsigned char) lds, int tid, unsigned* sib, int prb = 0) {
    const int lane = tid & 63, wave = tid >> 6, fr = lane & 15, fq = lane >> 4;
    const int vs = unit & 3, dir = (unit >> 2) & 1, h = (unit >> 3) & 3, b = unit >> 5;
    LP(unsigned char) QS = lds; LP(unsigned char) KS = lds + 17408; LP(unsigned char) QB = lds + 34816;
    LP(unsigned char) VV = lds + 52224; LP(unsigned char) PM = lds + 61440; LP(unsigned char) STT = lds + 70656;
    LP(float) DV = (LP(float))(lds + 88064);
    for (int i = tid; i < 64 * ST128 / 4; i += NTHR) ((LP(unsigned))STT)[i] = 0u;
    v4f sacc[4];
#pragma unroll
    for (int i = 0; i < 4; ++i) sacc[i] = (v4f){0.f, 0.f, 0.f, 0.f};
    const int j = tid >> 3, c8 = tid & 7, dc = c8 * 16;
    const int tt = wave >> 1, vt0 = (wave & 1) * 2;
    const int svt = wave & 3, sdt0 = (wave >> 2) * 4;
    bf16* Od = O + (size_t)dir * TT * 1024;
    constexpr int NCHUNK = CTXL / 64 + SEQ / 64;
    const int task0 = ((b * 4 + h) * 2 + dir) * NCHUNK;
    v4u gq0[2], gq1[2], gk0[2], gk1[2], gvv[2]; v4f gem[4]; v4f gdv = (v4f){0.f, 0.f, 0.f, 0.f};
#define GLA_ISSUE(cx, P_) do { const int seg_ = (cx) >= CTXL / 64, ci_ = seg_ ? (cx) - CTXL / 64 : (cx); \
        const int row_ = PRBROW(tok_row(b, seg_, ci_ * 64 + j, dir, 0)); \
        const bf16* qr_ = QKS + ((size_t)dir * TT + row_) * 1024 + h * 128 + c8 * 8; \
        gq0[P_] = *(const v4u*)(qr_); gq1[P_] = *(const v4u*)(qr_ + 64); gk0[P_] = *(const v4u*)(qr_ + 512); gk1[P_] = *(const v4u*)(qr_ + 576); \
        gvv[P_] = *(const v4u*)(S + (size_t)row_ * EV_PAD + 1024 + h * 256 + vs * 64 + c8 * 8); } while (0)
#define GLA_ISSUE_V(cx) do { const float* vp_ = VEC + (size_t)PRBTSK(task0 + (cx)) * 384;     \
        _Pragma("unroll") for (int i_ = 0; i_ < 4; ++i_) gem[i_] = *(const v4f*)(vp_ + (i_ >> 1) * 64 + c8 * 8 + 4 * (i_ & 1)); \
        if (tid < 64) gdv = *(const v4f*)(vp_ + 128 + tid * 4); } while (0)
    GLA_ISSUE(0, 0); GLA_ISSUE(1, 1); GLA_ISSUE_V(0);
    SYNC();
#pragma unroll 1
    for (int c2 = 0; c2 < NCHUNK; c2 += 2) {
#pragma unroll
    for (int u_ = 0; u_ < 2; ++u_) {
        const int cidx = c2 + u_;
        const int seg = cidx >= CTXL / 64, ci = seg ? cidx - CTXL / 64 : cidx;
        if (u_ == 0 && (c2 & 3) == 0 && c2 > 0) sibling_sync(sib, (unsigned)(c2 >> 2) * 4u, tid);
        const v4u q0 = gq0[u_], q1 = gq1[u_], k0 = gk0[u_], k1 = gk1[u_], vv = gvv[u_]; const v4f dvv = gdv;
        v4f em[4];
#pragma unroll
        for (int i_ = 0; i_ < 4; ++i_) em[i_] = gem[i_];
        {
            *(LP(v4u))(QS + j * ST128 + c8 * 16) = q0; *(LP(v4u))(QS + j * ST128 + c8 * 16 + 128) = q1;
            *(LP(v4u))(KS + j * ST128 + c8 * 16) = k0; *(LP(v4u))(KS + j * ST128 + c8 * 16 + 128) = k1;
            const unsigned qw[8] = {q0.x, q0.y, q0.z, q0.w, q1.x, q1.y, q1.z, q1.w}; unsigned ob[8];
#pragma unroll
            for (int i2 = 0; i2 < 8; ++i2) { const v4f e4 = em[i2 >> 1]; const float ea = (i2 & 1) ? e4.z : e4.x, eb = (i2 & 1) ? e4.w : e4.y; ob[i2] = PK2(bflo(qw[i2]) * ea, bfhi(qw[i2]) * eb); }
            *(LP(v4u))(QB + j * ST128 + c8 * 16) = (v4u){ob[0], ob[1], ob[2], ob[3]}; *(LP(v4u))(QB + j * ST128 + c8 * 16 + 128) = (v4u){ob[4], ob[5], ob[6], ob[7]};
            *(LP(v4u))(VV + j * ST64 + c8 * 16) = vv;
            if (tid < 64) *(LP(v4f))(DV + tid * 4) = dvv;
        }
        if (cidx + 2 < NCHUNK) GLA_ISSUE(cidx + 2, u_);
        if (cidx + 1 < NCHUNK) GLA_ISSUE_V(cidx + 1);
        SYNC();
        v4f oacc[2]; oacc[0] = (v4f){0.f, 0.f, 0.f, 0.f}; oacc[1] = oacc[0];
        {
#pragma unroll
            for (int i = 0; i < 2; ++i) { const int st = vt0 + i; v4f p = (v4f){0.f, 0.f, 0.f, 0.f};
                if (st <= tt) { p = tile_mma(p, QS, ST128, 16 * tt, KS, ST128, 16 * st, 4, fr, fq);
                    if (st == tt) { if (4 * fq + 0 > fr) p.x = 0.f; if (4 * fq + 1 > fr) p.y = 0.f; if (4 * fq + 2 > fr) p.z = 0.f; if (4 * fq + 3 > fr) p.w = 0.f; } }
                *(LP(v2u))(PM + (16 * tt + fr) * ST64 + (16 * st + 4 * fq) * 2) = (v2u){PK2(p.x, p.y), PK2(p.z, p.w)}; }
#pragma unroll
            for (int k = 0; k < 4; ++k) { const v8s af = *(LP(const v8s))(QB + (16 * tt + fr) * ST128 + fq * 16 + k * 64);
#pragma unroll
                for (int i = 0; i < 2; ++i) { const v8s bf = *(LP(const v8s))(STT + (16 * (vt0 + i) + fr) * ST128 + fq * 16 + k * 64); oacc[i] = MFMA16(bf, af, oacc[i]); } }
        }
        SYNC();
#pragma unroll
        for (int k = 0; k < 2; ++k) { const v8s af = *(LP(const v8s))(PM + (16 * tt + fr) * ST64 + fq * 16 + k * 64);
#pragma unroll
            for (int i = 0; i < 2; ++i) { const v8s bf = tr_frag(VV, ST64, 32 * k, 16 * (vt0 + i), lane); oacc[i] = MFMA16(bf, af, oacc[i]); } }
        if (!prb) { const int orow = tok_row(b, seg, ci * 64 + 16 * tt + fr, dir, 0);
#pragma unroll
          for (int i = 0; i < 2; ++i) *(v2u*)(Od + (size_t)orow * 1024 + h * 256 + vs * 64 + 16 * (vt0 + i) + 4 * fq) = (v2u){PK2(oacc[i].x, oacc[i].y), PK2(oacc[i].z, oacc[i].w)}; }
        {
            v4f tmp[4];
#pragma unroll
            for (int i = 0; i < 4; ++i) tmp[i] = (v4f){0.f, 0.f, 0.f, 0.f};
#pragma unroll
            for (int k = 0; k < 2; ++k) { const v8s af = tr_frag(VV, ST64, 32 * k, 16 * svt, lane);
#pragma unroll
                for (int i = 0; i < 4; ++i) { const v8s bf = tr_frag(KS, ST128, 32 * k, 16 * (sdt0 + i), lane); tmp[i] = MFMA16(bf, af, tmp[i]); } }
#pragma unroll
            for (int i = 0; i < 4; ++i) { const v4f ee = *(LP(const v4f))(DV + 16 * (sdt0 + i) + 4 * fq), de = *(LP(const v4f))(DV + 128 + 16 * (sdt0 + i) + 4 * fq);
                sacc[i] = sacc[i] * de + tmp[i] * ee;
                *(LP(v2u))(STT + (16 * svt + fr) * ST128 + (16 * (sdt0 + i) + 4 * fq) * 2) = (v2u){PK2(sacc[i].x, sacc[i].y), PK2(sacc[i].z, sacc[i].w)}; }
        }
        SYNC();
    }
    }
#undef GLA_ISSUE
#undef GLA_ISSUE_V
}

constexpr int MAT_TASKS = NB * 4 * 2 * (CTXL / 64 + SEQ / 64);
template <int MODE>
DEV void mat_prep_loop(int first, int stride, const bf16* Sqk, int ldqk, int qoff, int koff, float kscale, const float* GT, const float* gate_b, float* GP, float* GPK,
                       const float* ret_log_decay, bf16* PP, float* RS, LP(unsigned char) lds, int tid) {
    constexpr int NCHUNK = CTXL / 64 + SEQ / 64;
    const int lane = tid & 63, wave = tid >> 6, fr = lane & 15, fq = lane >> 4;
    LP(unsigned char) Q = lds; LP(unsigned char) K = lds + 33792; LP(float) AS = (LP(float))(lds + 67584); LP(float) R0 = AS + 64; LP(float) DENP = AS + 128; LP(float) W0 = AS + 384;
    const int j = tid >> 3, c8 = tid & 7, dc = c8 * 32;
    v4u rq[4], rk[4]; float gi = 0.f, gf = 0.f;
#define MP_ISSUE(tk) do { const int cx_ = (tk) % NCHUNK, r1_ = (tk) / NCHUNK, dir_ = r1_ & 1, h_ = (r1_ >> 1) & 3, b_ = r1_ >> 3; \
        const int seg_ = cx_ >= CTXL / 64, ci_ = seg_ ? cx_ - CTXL / 64 : cx_; \
        const bf16* s1_ = Sqk + (size_t)tok_row(b_, seg_, ci_ * 64 + j, dir_, 1) * ldqk; \
        _Pragma("unroll") for (int g_ = 0; g_ < 4; ++g_) { rq[g_] = *(const v4u*)(s1_ + qoff + h_ * 256 + c8 * 8 + 64 * g_); rk[g_] = *(const v4u*)(s1_ + koff + h_ * 256 + c8 * 8 + 64 * g_); } \
        if (MODE == 0 && wave == 0) { const int prow_ = tok_row(b_, seg_, ci_ * 64 + lane, dir_, 1); \
            gi = GT[(size_t)prow_ * 256 + 32 + (dir_ * 2 + 0) * 4 + h_]; gf = GT[(size_t)prow_ * 256 + 32 + (dir_ * 2 + 1) * 4 + h_]; } } while (0)
    if (first < MAT_TASKS) MP_ISSUE(first);
    for (int task = first; task < MAT_TASKS; task += stride) {
        const int cidx = task % NCHUNK, r1 = task / NCHUNK, dir = r1 & 1, h = (r1 >> 1) & 3, b = r1 >> 3;
        const int seg = cidx >= CTXL / 64, ci = seg ? cidx - CTXL / 64 : cidx;
#pragma unroll
        for (int g8 = 0; g8 < 4; ++g8) { *(LP(v4u))(Q + j * ST256 + (c8 * 8 + 64 * g8) * 2) = rq[g8]; *(LP(v4u))(K + j * ST256 + (c8 * 8 + 64 * g8) * 2) = rk[g8]; }
        if (wave == 0) {
            if (MODE == 0) {
                const int prow = tok_row(b, seg, ci * 64 + lane, dir, 1);
                const float ig = gi + gate_b[(dir * 2 + 0) * 4 + h];
                float bcum = logsigmoidf(gf + gate_b[(dir * 2 + 1) * 4 + h]);
#pragma unroll
                for (int o = 1; o < 64; o <<= 1) { const float t = SHUP(bcum, o); if (lane >= o) bcum += t; }
                const float a_s = ig - bcum;
                float cm = a_s;
#pragma unroll
                for (int o = 1; o < 64; o <<= 1) { const float t = SHUP(cm, o); if (lane >= o) cm = fmaxf(cm, t); }
                *(v4f*)(GP + ((size_t)prow * 8 + dir * 4 + h) * 4) = (v4f){bcum, a_s, cm, 0.f};
                AS[lane] = a_s; R0[lane] = -cm; W0[lane] = EXPF(a_s - RDLANE(cm, 63));
            } else { const float lg = -expf(ret_log_decay[dir * 4 + h]); AS[lane] = -(float)(lane + 1) * lg; R0[lane] = (float)(lane + 1) * lg; }
        }
        if (task + stride < MAT_TASKS) MP_ISSUE(task + stride);
        SYNC();
        const int tt = wave >> 1;
        bf16* pp = PP + (size_t)task * 4096;
        const float rt = R0[16 * tt + fr];
#pragma unroll
        for (int i = 0; i < 2; ++i) { const int st = (wave & 1) * 2 + i; v4f p = (v4f){0.f, 0.f, 0.f, 0.f};
            if (st <= tt) { p = tile_mma(p, Q, ST256, 16 * tt, K, ST256, 16 * st, 8, fr, fq);
                const v4f as4 = *(LP(const v4f))(AS + 16 * st + 4 * fq);
                p.x *= kscale * EXPF(as4.x + rt); p.y *= kscale * EXPF(as4.y + rt); p.z *= kscale * EXPF(as4.z + rt); p.w *= kscale * EXPF(as4.w + rt);
                if (st == tt) { if (4 * fq + 0 > fr) p.x = 0.f; if (4 * fq + 1 > fr) p.y = 0.f; if (4 * fq + 2 > fr) p.z = 0.f; if (4 * fq + 3 > fr) p.w = 0.f; } }
            *(v2u*)(pp + (16 * tt + fr) * 64 + 16 * st + 4 * fq) = (v2u){PK2(p.x, p.y), PK2(p.z, p.w)};
            if (MODE == 0) { float rs = (p.x + p.y) + (p.z + p.w); rs += SHX(rs, 16); rs += SHX(rs, 32); if (fq == 0) DENP[st * 64 + 16 * tt + fr] = rs; } }
        if (MODE == 0 && tid >= 256) {
            const int d = tid - 256; float kw = 0.f;
            for (int jj = 0; jj < 64; ++jj) kw += __uint_as_float(((unsigned)*(LP(const unsigned short))(K + jj * ST256 + d * 2)) << 16) * W0[jj];
            GPK[(size_t)task * 256 + d] = kw; }
        SYNC();
        if (MODE == 0 && tid < 64) RS[(size_t)task * 64 + tid] = (DENP[tid] + DENP[64 + tid]) + (DENP[128 + tid] + DENP[192 + tid]);
        SYNC();
    }
#undef MP_ISSUE
}

#ifdef SEC_PROBE
#ifndef SEC_WAVE
#define SEC_WAVE 1
#endif
#ifndef SEC_MODE
#define SEC_MODE 0
#endif
#define SECT(s, e) do { if ((s) == SEC_PROBE && MODE == SEC_MODE) { const unsigned long long t_ = __builtin_amdgcn_s_memrealtime(); if (e) sec_acc += t_ - sec_t0; else sec_t0 = t_; } } while (0)
#else
#define SECT(s, e) do {} while (0)
#endif
template <int MODE>
DEV void mat_unit(const bf16* Sqk, int ldqk, int qoff, int koff, const bf16* Sv, int ldv, int voff, float kscale, const float* GP, const float* GPK, const bf16* PP, const float* RS, bf16* O, int store_ctx,
                  const float* ret_log_decay, int unit, LP(unsigned char) lds, int tid, unsigned* sib, int prb = 0) {
    const int lane = tid & 63, wave = tid >> 6, fr = lane & 15, fq = lane >> 4;
    const int vs = unit & 3, dir = (unit >> 2) & 1, h = (unit >> 3) & 3, b = unit >> 5;
    LP(unsigned char) Q = lds; LP(unsigned char) K = lds + 33792;
    LP(unsigned char) VV = lds + 67584; LP(unsigned char) VW = lds + 76800;
    LP(unsigned char) PM = lds + 86016; LP(unsigned char) STT = lds + 95232;
    LP(float) SCAL = (LP(float))(lds + 137472);
    LP(float) NV = SCAL + 768;
    for (int i = tid; i < 80 * ST256 / 4; i += NTHR) ((LP(unsigned))STT)[i] = 0u;
    if (tid < 256) NV[tid] = 0.f;
    v4f sacc[8];
#pragma unroll
    for (int i = 0; i < 8; ++i) sacc[i] = (v4f){0.f, 0.f, 0.f, 0.f};
    const int j = tid >> 3, c8 = tid & 7;
    const int tt = wave >> 1, vt0 = (wave & 1) * 2;
    const int svt = wave & 3, sdt0 = (wave >> 2) * 8;
#ifdef SEC_PROBE
    unsigned long long sec_acc = 0ull, sec_t0 = 0ull;
#endif
    float m_st = 0.f;
    float lg = 0.f;
    if (MODE == 1) lg = -expf(ret_log_decay[dir * 4 + h]);
    bf16* Od = O + (size_t)(2 + dir) * TT * 1024;
    constexpr int NCHUNK = CTXL / 64 + SEQ / 64;
    v4u rq[2][4], rk[2][4], rv, rp; v4f gpv = (v4f){0.f, 0.f, 0.f, 0.f}; float kwv[2] = {0.f, 0.f}, rsv = 0.f;
    const int task0 = ((b * 4 + h) * 2 + dir) * NCHUNK;
#define MAT_ISSUE(cx, P_) do { const int seg_ = (cx) >= CTXL / 64, ci_ = seg_ ? (cx) - CTXL / 64 : (cx); \
        const int row_ = PRBROW(tok_row(b, seg_, ci_ * 64 + j, dir, 1)); \
        const bf16* s1_ = Sqk + (size_t)row_ * ldqk; \
        _Pragma("unroll") for (int g_ = 0; g_ < 4; ++g_) { rq[P_][g_] = *(const v4u*)(s1_ + qoff + h * 256 + c8 * 8 + 64 * g_); rk[P_][g_] = *(const v4u*)(s1_ + koff + h * 256 + c8 * 8 + 64 * g_); } \
        if (MODE == 0 && tid < 256) kwv[P_] = GPK[(size_t)(task0 + (cx)) * 256 + tid]; } while (0)
#define MAT_GATE_LOAD(cx) do { if (MODE == 0 && wave == 0) { const int seg_ = (cx) >= CTXL / 64, ci_ = seg_ ? (cx) - CTXL / 64 : (cx); \
        const int prow_ = PRBROW(tok_row(b, seg_, ci_ * 64 + lane, dir, 1)); gpv = *(const v4f*)(GP + ((size_t)prow_ * 8 + dir * 4 + h) * 4); rsv = RS[(size_t)PRBTSK(task0 + (cx)) * 64 + lane]; } } while (0)
#define MAT_GATES(cx) do { if (wave == 0) { LP(float) sc_ = SCAL + ((cx) & 1) * 384; \
        if (MODE == 0) { const float bcum_ = gpv.x, a_s_ = gpv.y, Mt_ = fmaxf(m_st, gpv.z); \
            const float M63_ = RDLANE(Mt_, 63), bend_ = RDLANE(bcum_, 63), cm63_ = RDLANE(gpv.z, 63); const float wp_ = EXPF(gpv.z - Mt_); \
            sc_[lane] = wp_; sc_[64 + lane] = EXPF(m_st - Mt_); sc_[128 + lane] = EXPF(a_s_ - M63_); sc_[192 + lane] = EXPF(-(bcum_ + Mt_)); sc_[256 + lane] = rsv * wp_; \
            if (lane == 0) { sc_[320] = EXPF(m_st - M63_); sc_[321] = EXPF(cm63_ - M63_); } \
            m_st = bend_ + M63_; \
        } else { sc_[lane] = 1.0f; sc_[64 + lane] = EXPF((float)(lane + 1) * lg); sc_[128 + lane] = EXPF((float)(63 - lane) * lg); sc_[192 + lane] = 0.f; sc_[256 + lane] = 0.f; \
            if (lane == 0) { sc_[320] = EXPF(64.f * lg); sc_[321] = 0.f; } } } } while (0)
    static_assert(NCHUNK % 2 == 0, "the chunk loop is unrolled by two");
#define MAT_ISSUE_P(cx) do { const int seg_ = (cx) >= CTXL / 64, ci_ = seg_ ? (cx) - CTXL / 64 : (cx); rp = *(const v4u*)(PP + (size_t)PRBTSK(task0 + (cx)) * 4096 + j * 64 + c8 * 8); \
        rv = *(const v4u*)(Sv + (size_t)PRBROW(tok_row(b, seg_, ci_ * 64 + j, dir, 1)) * ldv + voff + h * 256 + vs * 64 + c8 * 8); } while (0)
    SECT(5, 0);
    MAT_ISSUE(0, 0); MAT_ISSUE(1, 1); MAT_ISSUE_P(0); MAT_GATE_LOAD(0);
    MAT_GATES(0);
    MAT_GATE_LOAD(1);
    SYNC();
#pragma unroll 1
    for (int c2 = 0; c2 < NCHUNK; c2 += 2) {
#pragma unroll
    for (int u_ = 0; u_ < 2; ++u_) {
        const int cidx = c2 + u_;
        const int seg = cidx >= CTXL / 64, ci = seg ? cidx - CTXL / 64 : cidx;
        if (u_ == 0 && (c2 & 3) == 0 && c2 > 0) sibling_sync(sib, (unsigned)(c2 >> 2) * 4u, tid);
        LP(const float) sc = SCAL + u_ * 384;
        const float kw_cur = kwv[u_];
        SECT(6, 0);
#if defined(SEC_PROBE) && SEC_PROBE == 6
        asm volatile("s_waitcnt vmcnt(0)" ::: "memory");
#endif
        SECT(6, 1);
        SECT(1, 0);
        {
            const float wk = sc[128 + j] * kscale;
#pragma unroll
            for (int g8 = 0; g8 < 4; ++g8) { const int d0 = c8 * 8 + 64 * g8;     *(LP(v4u))(Q + j * ST256 + d0 * 2) = rq[u_][g8]; *(LP(v4u))(K + j * ST256 + d0 * 2) = rk[u_][g8]; }
            const v4u rvv = rv;
            *(LP(v4u))(VV + j * ST64 + c8 * 16) = rvv;
            *(LP(v4u))(VW + j * ST64 + c8 * 16) = (v4u){PK2(bflo(rvv.x) * wk, bfhi(rvv.x) * wk), PK2(bflo(rvv.y) * wk, bfhi(rvv.y) * wk), PK2(bflo(rvv.z) * wk, bfhi(rvv.z) * wk), PK2(bflo(rvv.w) * wk, bfhi(rvv.w) * wk)};
            *(LP(v4u))(PM + j * ST64 + c8 * 16) = rp;
#pragma unroll
            for (int i = 0; i < 8; ++i) *(LP(v2u))(STT + (16 * svt + fr) * ST256 + (16 * (sdt0 + i) + 4 * fq) * 2) = (v2u){PK2(sacc[i].x, sacc[i].y), PK2(sacc[i].z, sacc[i].w)};
        }
        if (cidx + 2 < NCHUNK) MAT_ISSUE(cidx + 2, u_);
        if (cidx + 1 < NCHUNK) MAT_ISSUE_P(cidx + 1);
        SECT(1, 1); SECT(2, 0);
        SYNC();
        SECT(2, 1); SECT(3, 0);
        if (cidx + 1 < NCHUNK) { MAT_GATES(cidx + 1); if (cidx + 2 < NCHUNK) MAT_GATE_LOAD(cidx + 2); }
        v4f oP[2], oI[2]; oP[0] = (v4f){0.f, 0.f, 0.f, 0.f}; oP[1] = oP[0]; oI[0] = oP[0]; oI[1] = oP[0];
        v4f qa = (v4f){0.f, 0.f, 0.f, 0.f};
#pragma unroll 1
        for (int k = 0; k < 8; ++k) { const v8s af = *(LP(const v8s))(Q + (16 * tt + fr) * ST256 + fq * 16 + k * 64);
#pragma unroll
            for (int i = 0; i < 2; ++i) { const v8s bf = *(LP(const v8s))(STT + (16 * (vt0 + i) + fr) * ST256 + fq * 16 + k * 64); oI[i] = MFMA16(bf, af, oI[i]); }
            if (MODE == 0) { const v8s bn = *(LP(const v8s))(STT + (64 + fr) * ST256 + fq * 16 + k * 64); qa = MFMA16(bn, af, qa); } }
#pragma unroll
        for (int k = 0; k < 2; ++k) { const v8s af = *(LP(const v8s))(PM + (16 * tt + fr) * ST64 + fq * 16 + k * 64);
#pragma unroll
            for (int i = 0; i < 2; ++i) { const v8s bf = tr_frag(VV, ST64, 32 * k, 16 * (vt0 + i), lane); oP[i] = MFMA16(bf, af, oP[i]); } }
        { const int t = 16 * tt + fr; const float wp = sc[t], wi = sc[64 + t];
          v4f o0 = oP[0] * wp + oI[0] * wi, o1 = oP[1] * wp + oI[1] * wi;
          if (MODE == 0) { const float qn = RDLANE16(qa.x, fr); const float den = sc[256 + t] + wi * qn; const float dv = 1.0f / fmaxf(fabsf(den), sc[192 + t]); o0 = o0 * dv; o1 = o1 * dv; }
          if ((seg || store_ctx) && !prb) { const int orow = tok_row(b, seg, ci * 64 + t, dir, 1);
              *(v2u*)(Od + (size_t)orow * 1024 + h * 256 + vs * 64 + 16 * vt0 + 4 * fq) = (v2u){PK2(o0.x, o0.y), PK2(o0.z, o0.w)};
              *(v2u*)(Od + (size_t)orow * 1024 + h * 256 + vs * 64 + 16 * (vt0 + 1) + 4 * fq) = (v2u){PK2(o1.x, o1.y), PK2(o1.z, o1.w)}; } }
        const float dcy = sc[320];
        {
#pragma unroll
            for (int i = 0; i < 8; ++i) sacc[i] = sacc[i] * dcy;
#pragma unroll 1
            for (int k = 0; k < 2; ++k) { const v8s af = tr_frag(VW, ST64, 32 * k, 16 * svt, lane);
#pragma unroll
                for (int i = 0; i < 8; ++i) { const v8s bf = tr_frag(K, ST256, 32 * k, 16 * (sdt0 + i), lane); sacc[i] = MFMA16(bf, af, sacc[i]); } }
        }
        SECT(3, 1); SECT(4, 0);
        SYNC();
        SECT(4, 1);
        if (MODE == 0 && tid < 256) {
            const float nn = dcy * NV[tid] + sc[321] * kw_cur * kscale; NV[tid] = nn;
            *(LP(unsigned short))(STT + 64 * ST256 + tid * 2) = F2BF(nn); }
    }
    }
#undef MAT_ISSUE
#undef MAT_ISSUE_P
#undef MAT_GATE_LOAD
#undef MAT_GATES
    SYNC();
    SECT(5, 1);
#ifdef SEC_PROBE
    if (MODE == SEC_MODE && (SEC_UNIT < 0 || unit == SEC_UNIT) && wave == SEC_WAVE) { const unsigned long long t0_ = __builtin_amdgcn_s_memrealtime(); while (__builtin_amdgcn_s_memrealtime() - t0_ < 8ull * sec_acc) __builtin_amdgcn_s_sleep(8); }
#endif
}

constexpr int S5_LDS_PER_WAVE = 1280 + 2 * 10240 + 2 * 6144;
DEV void s5_unit(const bf16* S, int ldS, bf16* O, const float* lam_re, const float* lam_im, const float* log_step, const float* b_re, const float* b_im,
                 const float* c_re, const float* c_im, int unit, LP(unsigned char) wl, int lane, int prb = 0) {
    const int fr = lane & 15, fq = lane >> 4;
    const int dir = unit & 1, g = (unit >> 1) & 63, b = unit >> 7;
    LP(unsigned char) UB = wl; LP(unsigned char) XB = wl + 1280; LP(unsigned char) HB = wl + 1280 + 2 * 10240;
    const int pg = (dir * 64 + g);
    const float lr = lam_re[pg * 64 + lane], li = lam_im[pg * 64 + lane], step = expf(log_step[pg]);
    const float mag = expf(lr * step); float sn, cs; sincosf(li * step, &sn, &cs);
    const float ar = mag * cs, ai = mag * sn, den = lr * lr + li * li;
    const float cre = ((ar - 1.0f) * lr + ai * li) / den, cim = (ai * lr - (ar - 1.0f) * li) / den;
    for (int p = 0; p < 16; ++p) { const float br = b_re[(pg * 64 + lane) * 16 + p], bi = b_im[(pg * 64 + lane) * 16 + p];
        *(LP(unsigned short))(XB + lane * 32 + p * 2) = F2BF(cre * br - cim * bi);
        *(LP(unsigned short))(XB + (64 + lane) * 32 + p * 2) = F2BF(cre * bi + cim * br); }
    WAVE_SYNC();
    v8s bfrag[8];
#pragma unroll
    for (int nt = 0; nt < 8; ++nt) { if (fq < 2) bfrag[nt] = *(LP(const v8s))(XB + (16 * nt + fr) * 32 + fq * 16); else bfrag[nt] = (v8s){0, 0, 0, 0, 0, 0, 0, 0}; }
    v8s cfrag[4];
#pragma unroll
    for (int ks = 0; ks < 4; ++ks) { const int n0 = 32 * ks + 8 * fq; const float* src = (n0 < 64 ? c_re : c_im) + ((size_t)pg * 16 + fr) * 64 + (n0 & 63); const float sgn = n0 < 64 ? 1.f : -1.f;
        v8s f;
#pragma unroll
        for (int i = 0; i < 8; ++i) f[i] = (short)F2BF(sgn * src[i]);
        cfrag[ks] = f; }
    WAVE_SYNC();
    for (int i = lane; i < 1280 / 4; i += 64) ((LP(unsigned))UB)[i] = 0u;
    WAVE_SYNC();
    float hr = 0.f, hi = 0.f;
    bf16* Od = O + (size_t)dir * TT * 1024;
    constexpr int NBLK = CTXL / 16 + SEQ / 16;
    constexpr int S5_PF = 8;
    v4u ur[S5_PF];
#pragma unroll
    for (int i_ = 0; i_ < S5_PF; ++i_) ur[i_] = (v4u){0u, 0u, 0u, 0u};
#define S5_LOAD(bx, dst) do { if (lane < 32 && (bx) < NBLK) { const int seg_ = (bx) >= CTXL / 16, bi_ = seg_ ? (bx) - CTXL / 16 : (bx); \
        dst = *(const v4u*)(S + (size_t)PRBROW(tok_row(b, seg_, bi_ * 16 + (lane >> 1), dir, 0)) * ldS + g * 16 + (lane & 1) * 8); } } while (0)
#define S5_STAGE_A(bx) do { const v8s uf_ = *(LP(const v8s))(UB + fr * 80 + fq * 16); LP(unsigned char) xb_ = XB + ((bx) & 1) * 10240; \
        _Pragma("unroll") for (int nt = 0; nt < 8; ++nt) { v4f x = (v4f){0.f, 0.f, 0.f, 0.f}; x = MFMA16(uf_, bfrag[nt], x); *(LP(v4f))(xb_ + (16 * nt + fr) * 80 + fq * 16) = x; } } while (0)
#pragma unroll
    for (int i_ = 0; i_ < S5_PF; ++i_) S5_LOAD(i_, ur[i_]);
    if (lane < 32) *(LP(v4u))(UB + (lane >> 1) * 80 + (lane & 1) * 16) = ur[0];
#pragma unroll
    for (int i_ = 0; i_ + 1 < S5_PF; ++i_) ur[i_] = ur[i_ + 1];
    S5_LOAD(S5_PF, ur[S5_PF - 1]);
    WAVE_SYNC();
    S5_STAGE_A(0);
    static_assert(NBLK % S5_PF == 0, "ring unrolling");
#pragma unroll 1
    for (int bx0 = 0; bx0 <= NBLK; bx0 += S5_PF) {
#pragma unroll
    for (int ui = 0; ui < S5_PF; ++ui) {
        const int bx = bx0 + ui; if (bx > NBLK) break;
        WAVE_SYNC();
        v8s hf[4]; float xr[16], xi[16];
        if (bx >= 1) { LP(unsigned char) hb = HB + ((bx - 1) & 1) * 6144;
#pragma unroll
            for (int ks = 0; ks < 4; ++ks) hf[ks] = tr_frag(hb, 48, 32 * ks, 0, lane); }
        if (bx < NBLK) { LP(unsigned char) xb = XB + (bx & 1) * 10240;
#pragma unroll
            for (int q4 = 0; q4 < 4; ++q4) { const v4f a4 = *(LP(const v4f))(xb + lane * 80 + q4 * 16), b4 = *(LP(const v4f))(xb + (64 + lane) * 80 + q4 * 16);
                xr[4 * q4] = a4.x; xr[4 * q4 + 1] = a4.y; xr[4 * q4 + 2] = a4.z; xr[4 * q4 + 3] = a4.w; xi[4 * q4] = b4.x; xi[4 * q4 + 1] = b4.y; xi[4 * q4 + 2] = b4.z; xi[4 * q4 + 3] = b4.w; } }
        if (bx + 1 < NBLK) { if (lane < 32) *(LP(v4u))(UB + (lane >> 1) * 80 + (lane & 1) * 16) = ur[ui]; S5_LOAD(bx + 1 + S5_PF, ur[ui]); }
        WAVE_SYNC();
        if (bx + 1 < NBLK) S5_STAGE_A(bx + 1);
        if (bx >= 1) { const int pb = bx - 1, seg = pb >= CTXL / 16, bi = seg ? pb - CTXL / 16 : pb;
            if (seg && !prb) { v4f y = (v4f){0.f, 0.f, 0.f, 0.f};
#pragma unroll
                for (int ks = 0; ks < 4; ++ks) y = MFMA16(cfrag[ks], hf[ks], y);
                const int orow = tok_row(b, seg, bi * 16 + fr, dir, 0);
                *(v2u*)(Od + (size_t)orow * 1024 + g * 16 + 4 * fq) = (v2u){PK2(y.x, y.y), PK2(y.z, y.w)}; } }
        if (bx < NBLK) { LP(unsigned char) hb = HB + (bx & 1) * 6144;
            unsigned pr[8], pi[8];
#pragma unroll
            for (int t2 = 0; t2 < 8; ++t2) {
                const float r0 = ar * hr - ai * hi + xr[2 * t2], i0 = ar * hi + ai * hr + xi[2 * t2];
                hr = ar * r0 - ai * i0 + xr[2 * t2 + 1]; hi = ar * i0 + ai * r0 + xi[2 * t2 + 1];
                pr[t2] = PK2(r0, hr); pi[t2] = PK2(i0, hi); }
            *(LP(v4u))(hb + lane * 48) = (v4u){pr[0], pr[1], pr[2], pr[3]}; *(LP(v4u))(hb + lane * 48 + 16) = (v4u){pr[4], pr[5], pr[6], pr[7]};
            *(LP(v4u))(hb + (64 + lane) * 48) = (v4u){pi[0], pi[1], pi[2], pi[3]}; *(LP(v4u))(hb + (64 + lane) * 48 + 16) = (v4u){pi[4], pi[5], pi[6], pi[7]}; }
    }
    }
#undef S5_STAGE_A
#undef S5_LOAD
}

DEV void conv_prep_row(int r, const bf16* S, bf16* QK2, const float* conv_w, const float* conv_b, int lane) {
    int rm, rp; bool hasm, hasp;
    if (r < TL) { const int b = r >> 12, n = r & (SEQ - 1), gr = n >> 6, col = n & 63, np = col * 64 + gr;
        hasm = np > 0; hasp = np < SEQ - 1; rm = seq_row(b, 1, hasm ? np - 1 : np, 1); rp = seq_row(b, 1, hasp ? np + 1 : np, 1); }
    else { const int n = (r - TL) & (CTXL - 1); hasm = n > 0; hasp = n < CTXL - 1; rm = hasm ? r - 1 : r; rp = hasp ? r + 1 : r; }
    const bf16* s0 = S + (size_t)rm * EV_PAD + 3072; const bf16* s1 = S + (size_t)r * EV_PAD + 3072; const bf16* s2 = S + (size_t)rp * EV_PAD + 3072;
#pragma unroll
    for (int i = 0; i < 4; ++i) { const int c = 8 * lane + 512 * i;
        const v4u a0 = *(const v4u*)(s0 + c), a1 = *(const v4u*)(s1 + c), a2 = *(const v4u*)(s2 + c);
        const unsigned w0[4] = {a0.x, a0.y, a0.z, a0.w}, w1[4] = {a1.x, a1.y, a1.z, a1.w}, w2[4] = {a2.x, a2.y, a2.z, a2.w};
        const float sc = c >= 1024 ? 0.0625f : 1.0f;
        float val[8];
#pragma unroll
        for (int i2 = 0; i2 < 4; ++i2)
#pragma unroll
            for (int e = 0; e < 2; ++e) { const int di = 2 * i2 + e;
                const float um = hasm ? (e ? bfhi(w0[i2]) : bflo(w0[i2])) : 0.f, u0 = e ? bfhi(w1[i2]) : bflo(w1[i2]), up = hasp ? (e ? bfhi(w2[i2]) : bflo(w2[i2])) : 0.f;
                const float pre = conv_b[c + di] + conv_w[c + di] * um + conv_w[2048 + c + di] * u0 + conv_w[4096 + c + di] * up;
                val[di] = pre * RCPF(1.0f + EXPF(-pre)) * sc; }
        *(v4u*)(QK2 + (size_t)r * 2048 + c) = (v4u){PK2(val[0], val[1]), PK2(val[2], val[3]), PK2(val[4], val[5]), PK2(val[6], val[7])}; }
}

DEV v4f ld4bf(const bf16* p) { const v2u w = *(const v2u*)p; return (v4f){bflo(w.x), bfhi(w.x), bflo(w.y), bfhi(w.y)}; }
DEV float wsum(float v) {
#pragma unroll
    for (int o = 1; o < 64; o <<= 1) v += SHX(v, o);
    return v;
}
DEV float grp16_sum(float v) { v += SHX(v, 1); v += SHX(v, 2); v += SHX(v, 4); v += SHX(v, 8); return v; }
DEV void ld16bf(const bf16* p, float (&o)[16]) { const v4u a = *(const v4u*)p, b = *(const v4u*)(p + 8); const unsigned w[8] = {a.x, a.y, a.z, a.w, b.x, b.y, b.z, b.w};
#pragma unroll
    for (int i = 0; i < 8; ++i) { o[2 * i] = bflo(w[i]); o[2 * i + 1] = bfhi(w[i]); } }
DEV void ld16f(const float* p, float (&o)[16]) {
#pragma unroll
    for (int i = 0; i < 4; ++i) { const v4f a = *(const v4f*)(p + 4 * i); o[4 * i] = a.x; o[4 * i + 1] = a.y; o[4 * i + 2] = a.z; o[4 * i + 3] = a.w; } }
DEV void st16bf(bf16* p, const float (&o)[16]) { *(v4u*)p = (v4u){PK2(o[0], o[1]), PK2(o[2], o[3]), PK2(o[4], o[5]), PK2(o[6], o[7])}; *(v4u*)(p + 8) = (v4u){PK2(o[8], o[9]), PK2(o[10], o[11]), PK2(o[12], o[13]), PK2(o[14], o[15])}; }
template <int CENTER, int GATE>
DEV void head_norm16(const bf16* o0, const bf16* o1, const float* gain, const bf16* gs, bf16* dst) {
    float a[16], b2[16], g[16], gt[16];
    ld16bf(o0, a); ld16bf(o1, b2); ld16f(gain, g); ld16bf(gs, gt);
    float s = 0.f;
#pragma unroll
    for (int i = 0; i < 16; ++i) { a[i] += b2[i]; s += a[i]; }
    if (CENTER) { const float mean = grp16_sum(s) * (1.0f / 256.0f);
#pragma unroll
        for (int i = 0; i < 16; ++i) a[i] -= mean; }
    float q = 0.f;
#pragma unroll
    for (int i = 0; i < 16; ++i) q += a[i] * a[i];
    const float rstd = RSQRTF(grp16_sum(q) * (1.0f / 256.0f) + EPS);
#pragma unroll
    for (int i = 0; i < 16; ++i) { const float sg = RCPF(1.0f + EXPF(-gt[i])); const float gate = GATE ? sg : gt[i] * sg; a[i] = gate * (a[i] * rstd * g[i]); }
    st16bf(dst, a);
}
DEV void merge_even_row(int r, const bf16* S, const bf16* O, const float* gla_norm, const float* ml_norm, bf16* HBo, int lane) {
    const bf16* sr = S + (size_t)r * EV_PAD; const int c = 16 * lane; const bf16* ob = O + (size_t)r * 1024 + c; const size_t os = (size_t)TT * 1024;
    head_norm16<0, 0>(ob, ob + os, gla_norm + c, sr + 2048 + c, HBo + (size_t)r * D + c);
    head_norm16<1, 1>(ob + 2 * os, ob + 3 * os, ml_norm + c, sr + 6144 + c, HBo + (size_t)r * D + 1024 + c);
}
DEV float gelu_tanh(float y) { const float z = 0.7978845608028654f * (y + 0.044715f * y * y * y); const float t = 1.0f - 2.0f * RCPF(1.0f + EXPF(2.0f * z)); return 0.5f * y * (1.0f + t); }
DEV void merge_odd_row(int r, const bf16* S, const bf16* O, const float* s5_d, const float* ret_norm, bf16* GBo, bf16* HBo, int lane) {
    const bf16* sr = S + (size_t)r * OD_COLS; const int c = 16 * lane; const bf16* ob = O + (size_t)r * 1024 + c; const size_t os = (size_t)TT * 1024;
    {
        float y0[16], y1[16], dd[16], u[16];
        ld16bf(ob, y0); ld16bf(ob + os, y1); ld16f(s5_d + c, dd); ld16bf(sr + c, u);
#pragma unroll
        for (int i = 0; i < 16; ++i) {
#ifdef NO_S5
            y0[i] = 0.f; y1[i] = 0.f;
#endif
            y0[i] = gelu_tanh(y0[i] + y1[i] + dd[i] * u[i]); }
        st16bf(GBo + (size_t)r * 1024 + c, y0);
    }
    head_norm16<1, 0>(ob + 2 * os, ob + 3 * os, ret_norm + c, sr + 4096 + c, HBo + (size_t)r * D + 1024 + c);
}

struct EpiGLU {
    static constexpr bool PERM = true, AFTER_DRAIN = false;
    const bf16* G; const float* bias; bf16* O;
    __device__ __forceinline__ void operator()(const pg8::f32x4 (&acc)[2][2][4][2], const pg8::Unit& u, int wr, int wc, int fr, int fq) const {
        const int row0 = u.pm * 256 + wr * 64 + fr, col0 = u.pn * 256 + wc * 32 + 8 * fq;
#pragma unroll
        for (int ai = 0; ai < 2; ++ai)
#pragma unroll
            for (int m = 0; m < 4; ++m) { const size_t row = (size_t)(row0 + ai * 128 + m * 16);
#pragma unroll
                for (int bj = 0; bj < 2; ++bj) { const int col = col0 + bj * 128;
                    const v4u gw = *(const v4u*)(G + row * 1024 + col); const pg8::f32x4 b0 = *(const pg8::f32x4*)(bias + col), b1 = *(const pg8::f32x4*)(bias + col + 4);
                    const pg8::f32x4 v0 = acc[ai][bj][m][0] + b0, v1 = acc[ai][bj][m][1] + b1;
                    v4u w; w.x = pk2(bflo(gw.x) * fast_sigmoid(v0[0]), bfhi(gw.x) * fast_sigmoid(v0[1])); w.y = pk2(bflo(gw.y) * fast_sigmoid(v0[2]), bfhi(gw.y) * fast_sigmoid(v0[3]));
                    w.z = pk2(bflo(gw.z) * fast_sigmoid(v1[0]), bfhi(gw.z) * fast_sigmoid(v1[1])); w.w = pk2(bflo(gw.w) * fast_sigmoid(v1[2]), bfhi(gw.w) * fast_sigmoid(v1[3]));
                    *(v4u*)(O + row * D + col) = w; } }
    }
};

#ifndef SCAN_REPS
#define SCAN_REPS 1
#endif
__device__ __forceinline__ void mixer_phases(const Args& a, unsigned char* ws, LAS unsigned char* lds, const XcdBarrier& bar, int layer, int G, int gw, int ngw, int tid, int lane, int wave) {
#define HB ((bf16*)wsp(ws, WS_HB))
#define S ((bf16*)wsp(ws, WS_S))
#define GT ((float*)wsp(ws, WS_GT))
#define O ((bf16*)wsp(ws, WS_O))
#define GB ((bf16*)wsp(ws, WS_GB))
#define Y ((bf16*)wsp(ws, WS_Y))
    const int ldS = layer == 0 ? EV_PAD : OD_COLS;
    { pg8::Gemm g{HB, (const bf16*)(wsp(ws, (layer == 0 ? WS_WIN_EV : WS_WIN_OD))), TT, ldS, D}; pg8::StaticOrder So; So.init(TT, ldS, G, (int)blockIdx.x);
      EpiS E{S, ldS, GT, layer == 0 ? 28 : -1};
      pg8::gemm_phase<EpiS, pg8::StaticOrder, true, true>(lds, g, So, E); }
    XBAR();
#define QK2 ((bf16*)wsp(ws, WS_QK2))
#define GP ((float*)wsp(ws, WS_GP))
#define QKS ((bf16*)wsp(ws, WS_QKS))
#define GPK ((float*)wsp(ws, WS_GPK))
#define PP ((bf16*)wsp(ws, WS_PP))
#define RS ((float*)wsp(ws, WS_RS))
#define VEC ((float*)wsp(ws, WS_VEC))
    { int t2 = threadIdx.x; asm volatile("" : "+v"(t2)); tid = t2; lane = t2 & 63; wave = __builtin_amdgcn_readfirstlane(t2 >> 6); gw = blockIdx.x * NWAVES + wave; }
    if (layer == 0) {
#ifndef REP_CONV
#define REP_CONV 1
#endif
#ifndef REP_GPREP
#define REP_GPREP 1
#endif
#pragma unroll 1
        for (int r_ = 0; r_ < REP_CONV; ++r_)
        { const bf16* s_ = S; bf16* qk_ = QK2; const float* cw_ = ARG(16); const float* cb_ = ARG(17); for (int r = gw; r < TT; r += ngw) conv_prep_row(r, s_, qk_, cw_, cb_, lane); }
#pragma unroll 1
        for (int r_ = 0; r_ < REP_GPREP; ++r_)
        { int t2 = threadIdx.x; asm volatile("" : "+v"(t2)); gla_prep_loop((int)blockIdx.x, G, S, GT, ARG(13), ARG(14), QKS, VEC, lds, t2); }
        XBAR();
        { int t2 = threadIdx.x; asm volatile("" : "+v"(t2)); mat_prep_loop<0>((int)blockIdx.x, G, QK2, 2048, 0, 1024, 1.0f, GT, ARG(18), GP, GPK, nullptr, PP, RS, lds, t2); }
        XBAR();
    } else {
        { int t2 = threadIdx.x; asm volatile("" : "+v"(t2)); mat_prep_loop<1>((int)blockIdx.x, G, S, OD_COLS, 1024, 2048, 0.0625f, nullptr, nullptr, nullptr, nullptr, ARG(32), PP, RS, lds, t2); }
        XBAR();
    }
#ifdef PRE_SLEEP
    { const unsigned long long t0_ = __builtin_amdgcn_s_memrealtime(); while (__builtin_amdgcn_s_memrealtime() - t0_ < (unsigned long long)(PRE_SLEEP) * 100ull) __builtin_amdgcn_s_sleep(16); XBAR(); }
#endif
    { int t2 = threadIdx.x; asm volatile("" : "+v"(t2)); tid = t2; lane = t2 & 63; wave = __builtin_amdgcn_readfirstlane(t2 >> 6); }
#ifdef PREREAD
    if (layer == 0) {
        const v4u* p0 = (const v4u*)QKS; const v4u* p1 = (const v4u*)QK2; v4u acc = (v4u){0u, 0u, 0u, 0u};
        const unsigned n0 = 2u * TT * 1024 / 8, n1 = (unsigned)TT * 2048 / 8;
        for (unsigned i = blockIdx.x * NTHR + tid; i < n0; i += (unsigned)G * NTHR) { const v4u v = p0[i]; acc.x ^= v.x; acc.y ^= v.y; acc.z ^= v.z; acc.w ^= v.w; }
        if (PREREAD >= 2) for (unsigned i = blockIdx.x * NTHR + tid; i < n1; i += (unsigned)G * NTHR) { const v4u v = p1[i]; acc.x ^= v.x; acc.y ^= v.y; acc.z ^= v.z; acc.w ^= v.w; }
        if ((acc.x ^ acc.y ^ acc.z ^ acc.w) == 0x9e3779b9u && tid == 511) ((unsigned*)wsp(ws, WS_CTL))[8000] = 1u;
        { int t2 = threadIdx.x; asm volatile("" : "+v"(t2)); tid = t2; lane = t2 & 63; wave = __builtin_amdgcn_readfirstlane(t2 >> 6); }
    }
#endif
#ifdef SCAN_PROBE
#pragma unroll
#else
#pragma unroll 1
#endif
    for (int rep = 0; rep < SCAN_REPS; ++rep) {
#ifdef SCAN_PROBE
    const int prb = rep < SCAN_REPS - 1 ? SCAN_PROBE : 0;
#else
    constexpr int prb = 0;
#endif
#ifndef SIB_LOCKSTEP
#define SIB_LOCKSTEP 0
#endif
#define SIBP(ty, un) ((SIB_LOCKSTEP && G >= 2 * MIX_UNITS && SCAN_REPS == 1) ? (unsigned*)(wsp(ws, WS_CTL) + 16384 + ((ty) * 32 + ((un) >> 2)) * 64) : (unsigned*)nullptr)
#define UNIT_OF(w) (NB == 4 ? (((((w) & 7) * 4 + (((w) >> 3) & 15) / 4) << 2) | ((((w) >> 3) & 15) & 3)) : (w))
    if (layer == 0) {
#ifdef SPLIT_L0
        for (int it = blockIdx.x; it < MIX_UNITS; it += G) gla_unit(S, QKS, VEC, O, UNIT_OF(it), lds, tid, SIBP(0, UNIT_OF(it)), prb);
        XBAR();
        for (int it = blockIdx.x; it < 2 * MIX_UNITS; it += G) if (it >= MIX_UNITS) mat_unit<0>(QK2, 2048, 0, 1024, S, EV_PAD, 5120, 1.0f, GP, GPK, PP, RS, O, 1, nullptr, UNIT_OF(it - MIX_UNITS), lds, tid, SIBP(1, UNIT_OF(it - MIX_UNITS)), prb);
        if (false)
#endif
        for (int it = blockIdx.x; it < 2 * MIX_UNITS; it += G) {
            if (it < MIX_UNITS) {
#ifndef REP_GLA
#define REP_GLA 1
#endif
#pragma unroll 1
                for (int r_ = 0; r_ < REP_GLA; ++r_) gla_unit(S, QKS, VEC, O, UNIT_OF(it), lds, tid, SIBP(0, UNIT_OF(it)), prb);
                if (DEFER == 1 && G >= 2 * MIX_UNITS) convert_tiles(a, ws, 1, (int)blockIdx.x * NWAVES + wave, MIX_UNITS * NWAVES, lane);
            } else {
#ifndef REP_ML
#define REP_ML 1
#endif
#pragma unroll 1
                for (int r_ = 0; r_ < REP_ML; ++r_) mat_unit<0>(QK2, 2048, 0, 1024, S, EV_PAD, 5120, 1.0f, GP, GPK, PP, RS, O, 1, nullptr, UNIT_OF(it - MIX_UNITS), lds, tid, SIBP(1, UNIT_OF(it - MIX_UNITS)), prb);
            }
        }
        if (DEFER == 1 && G < 2 * MIX_UNITS) convert_tiles(a, ws, 1, (int)blockIdx.x * NWAVES + wave, G * NWAVES, lane);
    } else {
        const int s5_first = G >= 2 * MIX_UNITS ? MIX_UNITS : 0, s5_wgs = G - s5_first;
#ifndef REP_RET
#define REP_RET 1
#endif
#ifndef REP_S5
#define REP_S5 1
#endif
#pragma unroll 1
        for (int r_ = 0; r_ < REP_RET; ++r_)
        for (int u = blockIdx.x; u < MIX_UNITS; u += G)
            mat_unit<1>(S, OD_COLS, 1024, 2048, S, OD_COLS, 3072, 0.0625f, nullptr, nullptr, PP, RS, O, 0, ARG(32), UNIT_OF(u), lds, tid, SIBP(2, UNIT_OF(u)), prb);
        if (DEFER == 1 && rep == 0 && (int)blockIdx.x >= s5_first && wave >= 4) convert_tiles(a, ws, 2, ((int)blockIdx.x - s5_first) * 4 + (wave - 4), 4 * s5_wgs, lane);
#pragma unroll 1
        for (int r_ = 0; r_ < REP_S5; ++r_)
        if ((int)blockIdx.x >= s5_first && wave < 4) { for (int su = ((int)blockIdx.x - s5_first) * 4 + wave; su < NB * 128; su += 4 * s5_wgs)
            s5_unit(S, OD_COLS, O, ARG(22), ARG(23), ARG(24), ARG(25), ARG(26), ARG(27), ARG(28), su, lds + wave * S5_LDS_PER_WAVE, lane, prb); }
    }
    }
    XBAR();
    { int t2 = threadIdx.x; asm volatile("" : "+v"(t2)); tid = t2; lane = t2 & 63; wave = __builtin_amdgcn_readfirstlane(t2 >> 6); gw = blockIdx.x * NWAVES + wave; }
#ifndef NO_MERGE
    if (layer == 0) { const bf16* s_ = S; const bf16* o_ = O; const float* n0 = ARG(15); const float* n1 = ARG(19); bf16* hb_ = HB; for (int r = gw; r < TT; r += ngw) merge_even_row(r, s_, o_, n0, n1, hb_, lane); }
    else { const bf16* s_ = S; const bf16* o_ = O; const float* n0 = ARG(29); const float* n1 = ARG(33); bf16* gb_ = GB; bf16* hb_ = HB; for (int r = gw; r < TL; r += ngw) merge_odd_row(r, s_, o_, n0, n1, gb_, hb_, lane); }
#endif
    XBAR();
    const int Mo = layer == 0 ? TT : TL;
    if (layer == 1) {
        pg8::Gemm g{GB, (const bf16*)(wsp(ws, WS_WGLU)), TL, 1024, 1024}; pg8::StaticOrder So; So.init(TL, 1024, G, (int)blockIdx.x);
        EpiGLU E{GB, ARG(31), HB};
        pg8::gemm_phase<EpiGLU, pg8::StaticOrder, true, true>(lds, g, So, E);
        XBAR();
    }
    { pg8::Gemm g{HB, (const bf16*)(wsp(ws, (layer == 0 ? WS_WOUT_EV : WS_WOUT_OD))), Mo, D, D}; pg8::SplitOrder So; So.init(Mo - TL, D, G, (int)blockIdx.x);
      EpiF32 E{Y, (float*)(wsp(ws, WS_YCP))};
      pg8::gemm_phase<EpiF32, pg8::SplitOrder, true, true>(lds, g, So, E); }
    XBAR();
}
#undef HB
#undef S
#undef GT
#undef O
#undef GB
#undef Y
#undef QK2
#undef GP
#undef QKS
#undef GPK
#undef PP
#undef RS
#undef VEC
#undef UNIT_OF
#undef SIBP

#ifndef MIXER_ON
#define MIXER_ON 1
#endif
__global__ void __launch_bounds__(NTHR, 2) fwd(Args a) {
    extern __shared__ __attribute__((aligned(16))) unsigned char lds_raw[];
    LAS unsigned char* lds = (LAS unsigned char*)lds_raw;
    const int tid = threadIdx.x, lane = tid & 63, wave = __builtin_amdgcn_readfirstlane(tid >> 6);
    const int G = gridDim.x, gw = blockIdx.x * NWAVES + wave, ngw = G * NWAVES;
    unsigned char* ws = a.ws;
    if (tid < 16) ((LAS unsigned*)(lds + MISC_OFF))[tid] = 0u;
    __syncthreads();
#ifdef PROBE_A
    if (blockIdx.x == 0 && tid == 0) { volatile LAS unsigned* M_ = (volatile LAS unsigned*)(lds + MISC_OFF); const unsigned lo_ = (unsigned)__builtin_amdgcn_s_memrealtime(); if (PROBE_A == 0) M_[6] = lo_; if (PROBE_B == 0) M_[8] = lo_; }
#endif
    XcdBarrier bar = xcd_barrier_post((unsigned*)(wsp(ws, WS_CTL)), (volatile LAS unsigned*)(lds + MISC_OFF));

#ifdef NAN_POISON
    {
        v4u q = (v4u){0xffffffffu, 0xffffffffu, 0xffffffffu, 0xffffffffu};
        for (int i = tid; i < (MISC_OFF) / 16; i += NTHR) ((LAS v4u*)lds)[i] = q;
        { v4u* p = (v4u*)(wsp(ws, WS_MOD)); const size_t n = (WS_WGU - WS_MOD) / 16; for (size_t i = (size_t)blockIdx.x * NTHR + tid; i < n; i += (size_t)G * NTHR) p[i] = q; }
        { v4u* p = (v4u*)(wsp(ws, WS_XC)); const size_t n = (WS_END - WS_XC) / 16; for (size_t i = (size_t)blockIdx.x * NTHR + tid; i < n; i += (size_t)G * NTHR) p[i] = q; }
        { v4u* p = (v4u*)a.out; const size_t n = (size_t)TL * D * 4 / 16; for (size_t i = (size_t)blockIdx.x * NTHR + tid; i < n; i += (size_t)G * NTHR) p[i] = q; }
        __syncthreads();
        XBAR();
    }
#endif
#define MOD ((float*)wsp(ws, WS_MOD))
#define MODP ((float*)wsp(ws, WS_MODP))
#define HB ((bf16*)wsp(ws, WS_HB))
#define HID ((bf16*)wsp(ws, WS_HID))
#define Y ((bf16*)wsp(ws, WS_Y))
#define XC ((bf16*)wsp(ws, WS_XC))
#define XL ((bf16*)wsp(ws, WS_XL))

#ifndef REP_PRO
#define REP_PRO 1
#endif
#ifndef REP_GU
#define REP_GU 1
#endif
#ifndef REP_DN
#define REP_DN 1
#endif
#pragma unroll 1
    for (int rep_ = 0; rep_ < REP_PRO; ++rep_) {
        __syncthreads();
        LAS float* stab = (LAS float*)(lds + 1024);
        { const float* cin = ARG(1); const float* cctx = ARG(3);
        for (int i = tid; i < 5 * D; i += NTHR) { const int r = i >> 11, k = i & (D - 1); const float c = r < 4 ? cin[r * D + k] : cctx[k]; stab[i] = c / (1.0f + expf(-c)); } }
        __syncthreads();
        for (int it = gw; it < 2 * MOD_KC * 72; it += ngw) {
            const int l = it / (MOD_KC * 72), rem = it % (MOD_KC * 72), kc = rem / 72, jb = rem % 72; constexpr int KCH = D / MOD_KC;
            const float* W = ARG(4) + ((size_t)l * D + kc * KCH) * (NMOD * D) + jb * 256 + lane * 4;
            f32x4 acc[5];
#pragma unroll
            for (int r = 0; r < 5; ++r) acc[r] = (f32x4){0.f, 0.f, 0.f, 0.f};
            for (int k = 0; k < KCH; k += 8) { f32x4 w[8];
#pragma unroll
                for (int i = 0; i < 8; ++i) w[i] = *(const f32x4*)(W + (size_t)(k + i) * (NMOD * D));
#pragma unroll
                for (int i = 0; i < 8; ++i)
#pragma unroll
                    for (int r = 0; r < 5; ++r) acc[r] += stab[r * D + kc * KCH + k + i] * w[i]; }
            { float* modp = MODP;
#pragma unroll
            for (int r = 0; r < 5; ++r) *(f32x4*)(modp + (((size_t)l * MOD_KC + kc) * 5 + r) * (NMOD * D) + jb * 256 + lane * 4) = acc[r]; }
        }
        convert_tiles(a, ws, 0, gw, ngw, lane);
#ifndef DEFER
#define DEFER 1
#endif
        if (!DEFER) { convert_tiles(a, ws, 1, gw, ngw, lane); convert_tiles(a, ws, 2, gw, ngw, lane); }
        { v4u z = (v4u){0u, 0u, 0u, 0u}; v4u* p = (v4u*)(wsp(ws, WS_WIN_EV) + (size_t)EV_COLS * 2048 * 2); const int n16 = (EV_PAD - EV_COLS) * 2048 * 2 / 16;
          for (int i = blockIdx.x * NTHR + tid; i < n16; i += G * NTHR) p[i] = z; }
    }
    XBAR();
    { const float* bmod = ARG(5); const float* modp = MODP; float* modf = MOD;
    for (int i = blockIdx.x * NTHR + tid; i < 2 * 5 * NMOD * D; i += G * NTHR) {
        const int l = i / (5 * NMOD * D), rem = i % (5 * NMOD * D), r = rem / (NMOD * D), j = rem % (NMOD * D);
        float s = bmod[l * (NMOD * D) + j];
        for (int kc = 0; kc < MOD_KC; ++kc) s += modp[(((size_t)l * MOD_KC + kc) * 5 + r) * (NMOD * D) + j];
        modf[i] = s;
    } }
    XBAR();
#ifndef REP_N0
#define REP_N0 1
#endif
#pragma unroll 1
    for (int rep_ = 0; rep_ < REP_N0; ++rep_)
    { NormP p{}; p.xin_lat = ARG(0); p.xin_ctx = ARG(2); p.xin_f32 = 1; p.xout_f32 = 0; p.xout_lat = XL; p.xout_ctx = XC; p.y = nullptr; p.h = HB; p.rows_end = TT; p.has_y = 0; p.has_h = 1; p.w = 0.f; p.lp = 0; p.sp = 0; p.ln = 0; p.sn = 0;
      norm_phase(p, MOD, ARG(6), ARG(7), lds, gw, ngw, tid, lane); }
    XBAR();

#pragma unroll 1
    for (int layer = 0; layer < 2; ++layer) {
#pragma unroll 1
        for (int half = 0; half < 2; ++half) {
            const int Mrows = (layer == 1 && half == 1) ? TL : TT;
#if MIXER_ON
            if (half == 1) {
                mixer_phases(a, ws, lds, bar, layer, G, gw, ngw, tid, lane, wave);
                NormP p{}; p.xin_lat = XL; p.xin_ctx = XC; p.xin_f32 = 0; p.xout_f32 = 0; p.xout_lat = XL; p.xout_ctx = XC; p.y = Y; p.y_ctx = (const float*)(wsp(ws, WS_YCP)); p.h = HB; p.rows_end = Mrows; p.has_y = 1; p.has_h = 1; p.w = 1.0f; p.lp = layer; p.sp = 1; p.ln = layer; p.sn = 2;
                norm_phase(p, MOD, ARG(6), ARG(7), lds, gw, ngw, tid, lane);
                XBAR();
            }
#endif
            const int sub = half * 2;
#pragma unroll 1
            for (int rep_ = 0; rep_ < REP_GU; ++rep_) { pg8::Gemm g{HB, (const bf16*)(wsp(ws, WS_WGU) + (size_t)(layer * 2 + half) * SZ_WGU), Mrows, 2 * DFF, D}; pg8::StaticOrder S; S.init(Mrows, 2 * DFF, G, (int)blockIdx.x);
              EpiSwiGLU E{HID, DFF};
              pg8::gemm_phase<EpiSwiGLU, pg8::StaticOrder, true, true>(lds, g, S, E);
              if (DEFER == 2 && rep_ == 0 && !(layer == 1 && half == 1)) {
                  const int rem = ((Mrows / 256) * (2 * DFF / 256)) % G, nidle = rem ? G - rem : G, me = rem ? (int)blockIdx.x - rem : (int)blockIdx.x;
                  if (me >= 0) { int t2 = threadIdx.x; asm volatile("" : "+v"(t2)); convert_tiles(a, ws, layer * 2 + half + 1, me * NWAVES + __builtin_amdgcn_readfirstlane(t2 >> 6), nidle * NWAVES, t2 & 63); } }
              if (rep_ + 1 < REP_GU) XBAR(); }
            XBAR();
#pragma unroll 1
            for (int rep_ = 0; rep_ < REP_DN; ++rep_) { pg8::Gemm g{HID, (const bf16*)(wsp(ws, WS_WD) + (size_t)(layer * 2 + half) * SZ_WD), Mrows, D, DFF}; pg8::SplitOrder S; S.init(Mrows - TL, DFF, G, (int)blockIdx.x);
              EpiF32 E{Y, (float*)(wsp(ws, WS_YCP))};
              pg8::gemm_phase<EpiF32, pg8::SplitOrder, true, true>(lds, g, S, E);
              if (rep_ + 1 < REP_DN) XBAR(); }
            XBAR();
            { NormP p{}; const bool first = (layer == 0 && half == 0);
              const bool lastp = (layer == 1 && half == 1);
              p.xin_lat = first ? (const void*)ARG(0) : (const void*)XL; p.xin_ctx = first ? (const void*)ARG(2) : (const void*)XC; p.xin_f32 = first ? 1 : 0;
              p.xout_lat = lastp ? (void*)a.out : (void*)XL; p.xout_ctx = XC; p.xout_f32 = lastp ? 1 : 0; p.y = Y; p.y_ctx = (const float*)(wsp(ws, WS_YCP)); p.h = HB; p.rows_end = Mrows; p.has_y = 1; p.w = 0.5f; p.lp = layer; p.sp = sub;
              if (half == 0) { p.has_h = 1; p.ln = layer; p.sn = MIXER_ON ? 1 : 2; }
              else if (layer == 0) { p.has_h = 1; p.ln = 1; p.sn = 0; }
              else { p.has_h = 0; p.ln = 0; p.sn = 0; }
              norm_phase(p, MOD, ARG(6), ARG(7), lds, gw, ngw, tid, lane); }
            if (!(layer == 1 && half == 1)) XBAR();
        }
    }
#ifdef PROBE_A
    XBAR();
    if (blockIdx.x == 0 && threadIdx.x == 0) { volatile LAS unsigned* M_ = (volatile LAS unsigned*)(lds + MISC_OFF);
        const unsigned ticks = (M_[7] - M_[6]) + (PROBE_B >= 0 ? (M_[9] - M_[8]) : 0u);
        const unsigned long long t0 = __builtin_amdgcn_s_memrealtime();
        while (__builtin_amdgcn_s_memrealtime() - t0 < 8ull * ticks) __builtin_amdgcn_s_sleep(8); }
#endif
}

#undef MOD
#undef MODP
#undef HB
#undef HID
#undef Y
#undef XC
#undef XL
extern "C" void kernel_launch(void* const* d_in, const int* in_sizes, int n_in, void* d_out, int out_size, void* d_ws, size_t ws_size, hipStream_t stream) {
    static int grid = 0;
    if (grid == 0) {
        if (n_in != 34 || out_size != TL * D || ws_size < WS_END) { fprintf(stderr, "kernel_launch: unexpected shapes (n_in %d out %d ws %zu need %zu)\n", n_in, out_size, ws_size, (size_t)WS_END); grid = -1; return; }
        int dev = 0, cus = 0, per_cu = 0;
        if (hipGetDevice(&dev) != hipSuccess || hipDeviceGetAttribute(&cus, hipDeviceAttributeMultiprocessorCount, dev) != hipSuccess) { grid = -1; return; }
        if (hipFuncSetAttribute((const void*)fwd, hipFuncAttributeMaxDynamicSharedMemorySize, LDS_BYTES) != hipSuccess) { fprintf(stderr, "kernel_launch: hipFuncSetAttribute failed\n"); grid = -1; return; }
        if (hipOccupancyMaxActiveBlocksPerMultiprocessor(&per_cu, (const void*)fwd, NTHR, LDS_BYTES) != hipSuccess || per_cu < 1) { fprintf(stderr, "kernel_launch: occupancy query says %d\n", per_cu); }
        (void)hipGetLastError();
        grid = cus;
    }
    if (grid < 0) return;
    if (hipMemsetAsync((char*)d_ws + WS_CTL, 0, CTL_ZERO_BYTES, stream) != hipSuccess) return;
    Args a{};
    for (int i = 0; i < 34; ++i) a.in[i] = (const float*)d_in[i];
    a.out = (float*)d_out; a.ws = (unsigned char*)d_ws;
    hipLaunchKernelGGL(fwd, dim3(grid), dim3(NTHR), LDS_BYTES, stream, a);
}
```

```cpp
#include <hip/hip_runtime.h>
#include <cstdio>
#include <cstdint>
#define MIXER_ON 1

#define XB_TMO      128
#define XB_XCNT(j)  (256  + 64 * (j))
#define XB_XSUB(j)  (1280 + 64 * (j))
#define XB_XGEN(j)  (2304 + 64 * (j))
#define XB_TOP      3328
#define XB_TOPGEN   3392
#define XCD_BAR_WORDS 3456
#define XB_SPIN_CAP (1u << 18)
#define LAS __attribute__((address_space(3)))

__device__ __forceinline__ unsigned xb_ld(unsigned* p)              { return __hip_atomic_load(p, __ATOMIC_RELAXED, __HIP_MEMORY_SCOPE_AGENT); }
__device__ __forceinline__ unsigned xb_add(unsigned* p, unsigned v) { return __hip_atomic_fetch_add(p, v, __ATOMIC_RELAXED, __HIP_MEMORY_SCOPE_AGENT); }
__device__ __forceinline__ unsigned xb_xcc_id() { return (unsigned)__builtin_amdgcn_s_getreg((3 << 11) | 20) & 0xFu; }
#define XB_SPIN(cond, bar) do { unsigned _sp = 0; while (cond) { __builtin_amdgcn_s_sleep(1); \
    if ((++_sp & 255u) == 0u) { if (xb_ld(&(bar)[XB_TMO])) break; if (_sp > XB_SPIN_CAP) { atomicAdd(&(bar)[XB_TMO], 1u); break; } } } } while (0)

struct XcdBarrier {
    unsigned* bar; unsigned x;
    volatile LAS unsigned* st;
};

__device__ __forceinline__ XcdBarrier xcd_barrier_post(unsigned* bar, volatile LAS unsigned* st) {
    XcdBarrier b; b.bar = bar; b.x = xb_xcc_id(); b.st = st;
    if (threadIdx.x == 0) (void)xb_add(&bar[XB_XCNT(b.x)], 1u);
    return b;
}
__device__ __forceinline__ void xcd_barrier_complete(unsigned* bar, unsigned x, unsigned& nloc, unsigned& nx) {
    const unsigned G = gridDim.x * gridDim.y * gridDim.z;
    unsigned sum, cnt, mine, sp = 0u;
    for (;;) {
        sum = 0u; cnt = 0u; mine = 0u;
#pragma unroll
        for (unsigned j = 0; j < 16; ++j) { const unsigned c = xb_ld(&bar[XB_XCNT(j)]); sum += c; cnt += (c > 0u) ? 1u : 0u; mine = (j == x) ? c : mine; }
        if (sum == G) break;
        __builtin_amdgcn_s_sleep(1);
        if ((++sp & 255u) == 0u) { if (xb_ld(&bar[XB_TMO])) break; if (sp > XB_SPIN_CAP) { atomicAdd(&bar[XB_TMO], 1u); break; } }
    }
    nloc = mine > 0u ? mine : 1u; nx = cnt > 0u ? cnt : 1u;
}

__device__ __forceinline__ void xcd_barrier(const XcdBarrier& b) {
    asm volatile("s_waitcnt vmcnt(0)" ::: "memory");
    __syncthreads();
    if (threadIdx.x == 0) {
        unsigned* bar = b.bar;
        unsigned bx = __builtin_amdgcn_readfirstlane(b.x); asm volatile("" : "+s"(bx));
        __builtin_amdgcn_s_waitcnt(0);
        unsigned nloc = b.st[0], nx = b.st[1];
        if (nloc == 0u) { xcd_barrier_complete(bar, bx, nloc, nx); b.st[0] = nloc; b.st[1] = nx; }
        const unsigned old = xb_add(&bar[XB_XSUB(bx)], 1u);
        const unsigned gen = old / nloc;
        if (old + 1u == (gen + 1u) * nloc) {
            __builtin_amdgcn_fence(__ATOMIC_RELEASE, "agent");
            asm volatile("s_waitcnt vmcnt(0)" ::: "memory");
            const unsigned og = xb_add(&bar[XB_TOP], 1u);
            const unsigned tg = og / nx;
            if (og + 1u == (tg + 1u) * nx) xb_add(&bar[XB_TOPGEN], 1u);
            else XB_SPIN(xb_ld(&bar[XB_TOPGEN]) == tg, bar);
            __builtin_amdgcn_fence(__ATOMIC_ACQUIRE, "agent");
            xb_add(&bar[XB_XGEN(bx)], 1u);
            asm volatile("s_waitcnt vmcnt(0)" ::: "memory");
        } else {
            XB_SPIN(xb_ld(&bar[XB_XGEN(bx)]) == gen, bar);
            __builtin_amdgcn_fence(__ATOMIC_ACQUIRE, "agent");
            asm volatile("s_waitcnt vmcnt(0)" ::: "memory");
        }
    }
    __syncthreads();
}

namespace pg8 {
#define PG8_LAS __attribute__((address_space(3)))
typedef unsigned short bf16_t;
typedef short bf16x8 __attribute__((ext_vector_type(8)));
typedef float f32x4 __attribute__((ext_vector_type(4)));
typedef unsigned u32x4 __attribute__((ext_vector_type(4)));
constexpr int BM = 256, BK = 64, HALF = 128, HTB = HALF * BK * 2  , STAGE_BYTES = 8 * HTB, NXCD = 8, WGM = 8;

__host__ __device__ __forceinline__ int lds_byte(int r, int c) { const int st = (r >> 4) * 2 + (c >> 5), rr = r & 15, cc = c & 31, ob = rr * 64 + cc * 2; return st * 1024 + (ob ^ (((ob >> 9) & 1) << 5)); }
__host__ __device__ __forceinline__ void stage_rc(int b, int& R, int& C) { const int st = b / 1024, sb = b % 1024, swz = sb ^ (((sb >> 9) & 1) << 5); R = (st >> 1) * 16 + swz / 64; C = (st & 1) * 32 + (swz % 64) / 2; }
__host__ __device__ __forceinline__ int perm32(int rho) { const int n = rho >> 4, i = rho & 15; return 8 * (i >> 2) + 4 * n + (i & 3); }

struct Unit { int pm, pn, k0, nt, part; };
struct Gemm { const bf16_t* A; const bf16_t* Bt; int M, N, K; };

struct StaticOrder {
    int nM, nN, nwg, G, c;
    __host__ __device__ void init(int M, int N, int G_, int c_) { nM = M / BM; nN = N / BM; nwg = nM * nN; G = G_; c = c_; }
    __host__ __device__ bool next(int i, Unit& u) const {
        const long L = (long)i * G + c; if (L >= nwg) return false;
        int wgid = (int)L; { const int q = nwg / NXCD, r = nwg % NXCD, xcd = wgid % NXCD, off = wgid / NXCD; wgid = (xcd < r ? xcd * (q + 1) : r * (q + 1) + (xcd - r) * q) + off; }
        const int nig = WGM * nN, gid = wgid / nig, fm = gid * WGM, gsz = (nM - fm) < WGM ? (nM - fm) : WGM;
        u.pm = fm + ((wgid % nig) % gsz); u.pn = (wgid % nig) / gsz; u.k0 = 0; u.nt = 0; u.part = -1; return true;
    }
    __device__ __forceinline__ void a_ready(const Unit&) const {}
    __device__ __forceinline__ void done(const Unit&) const {}
};
struct SplitOrder {
    static constexpr int NMF = 64, NN = 8, PARTS = 8, NFULL = NMF * NN;
    int nsplit, ntK, G, c;
    __host__ __device__ void init(int Msplit, int K, int G_, int c_) { nsplit = (Msplit / BM) * NN * PARTS; ntK = K / BK; G = G_; c = c_; }
    __host__ __device__ bool next(int i, Unit& u) const {
        const int L = i * G + c, p = L - NFULL; const bool fullu = L < NFULL;
        const int wgid = (L % NXCD) * (NFULL / NXCD) + L / NXCD, nig = WGM * NN, fm = (wgid / nig) * WGM;
        const int q = p & 7, cu = p >> 3, h = ntK >> 1, ks = ((h * q) >> 3) << 1, ke = ((h * (q + 1)) >> 3) << 1;
        u.pm = fullu ? fm + ((wgid % nig) % WGM) : NMF + (cu >> 3);
        u.pn = fullu ? (wgid % nig) / WGM : (cu & 7);
        u.k0 = fullu ? 0 : ks; u.nt = fullu ? 0 : ke - ks; u.part = fullu ? -1 : q;
        return fullu || p < nsplit;
    }
    __device__ __forceinline__ void a_ready(const Unit&) const {}
    __device__ __forceinline__ void done(const Unit&) const {}
};
__device__ __forceinline__ unsigned cvt_pk_bf16(float lo, float hi) { unsigned r; asm volatile("v_cvt_pk_bf16_f32 %0, %1, %2" : "=v"(r) : "v"(lo), "v"(hi)); return r; }
template <class Epi, class Sched, bool ALIGN_EPI = false, bool SP2 = false>
__device__ __forceinline__ void gemm_phase(PG8_LAS unsigned char* lds, const Gemm g, const Sched& S, const Epi& E) {
    int tid_ = threadIdx.x; asm volatile("" : "+v"(tid_));
    const int tid = tid_, wid = __builtin_amdgcn_readfirstlane(tid >> 6), lane = tid & 63, wr = wid >> 2, wc = wid & 3, fr = lane & 15, fq = lane >> 4;
    const int K = g.K, nt = K / BK;
    unsigned voffA[2], voffB[2];
#pragma unroll
    for (int i = 0; i < 2; ++i) { int R, C; stage_rc(tid * 16 + i * 8192, R, C); const int Rb = Epi::PERM ? ((R & ~31) + perm32(R & 31)) : R;
        voffA[i] = (unsigned)(R * K + C) * 2u; voffB[i] = (unsigned)(Rb * K + C) * 2u; }
    const unsigned kstep = BK * 2;
    const unsigned hstep = (unsigned)HALF * K * 2;
    const unsigned tstep = 2 * hstep;
    const unsigned ldsw = (unsigned)wid * 1024u;
    const int aoff = lds_byte(wr * 64 + fr, fq * 8), boff = lds_byte(wc * 32 + fr, fq * 8);
#define PG8_SA(b, h) (((b) * 2 + (h)) * HTB)
#define PG8_SB(b, h) ((4 + (b) * 2 + (h)) * HTB)
#define PG8_STAGE(bufoff, gbase, voff) do { _Pragma("unroll") for (int _i = 0; _i < 2; ++_i) \
        __builtin_amdgcn_global_load_lds((const unsigned*)((const char*)(gbase) + (voff)[_i]), (PG8_LAS unsigned*)(lds + (bufoff) + ldsw + _i * 8192), 16, 0, 0); } while (0)
#define PG8_LDA(dst, b, h) do { _Pragma("unroll") for (int m = 0; m < 4; ++m) _Pragma("unroll") for (int k = 0; k < 2; ++k) dst[m][k] = *(const PG8_LAS bf16x8*)(lds + PG8_SA(b, h) + aoff + m * 2048 + k * 1024); } while (0)
#define PG8_LDB(dst, b, h) do { _Pragma("unroll") for (int n = 0; n < 2; ++n) _Pragma("unroll") for (int k = 0; k < 2; ++k) dst[n][k] = *(const PG8_LAS bf16x8*)(lds + PG8_SB(b, h) + boff + n * 2048 + k * 1024); } while (0)
#define PG8_MMA(ai, bj, At, Bt) do { __builtin_amdgcn_s_setprio(1); _Pragma("unroll") for (int m = 0; m < 4; ++m) _Pragma("unroll") for (int n = 0; n < 2; ++n) _Pragma("unroll") for (int k = 0; k < 2; ++k) \
        acc[ai][bj][m][n] = __builtin_amdgcn_mfma_f32_16x16x32_bf16(Bt[n][k], At[m][k], acc[ai][bj][m][n], 0, 0, 0); __builtin_amdgcn_s_setprio(0); } while (0)
#define PG8_WAIT_V(n) asm volatile("s_waitcnt vmcnt(" #n ")" ::: "memory")
#define PG8_WAIT_L(n) asm volatile("s_waitcnt lgkmcnt(" #n ")" ::: "memory")
#define PG8_BAR __builtin_amdgcn_s_barrier()
#define PG8_SCHED __builtin_amdgcn_sched_barrier(0)
    Unit cur, nxt; int ui = 0;
    if (!S.next(0, cur)) return;
    f32x4 acc[2][2][4][2];
#pragma unroll
    for (int a = 0; a < 2; ++a)
#pragma unroll
        for (int b = 0; b < 2; ++b)
#pragma unroll
            for (int m = 0; m < 4; ++m)
#pragma unroll
                for (int n = 0; n < 2; ++n) acc[a][b][m][n] = (f32x4){0.f, 0.f, 0.f, 0.f};
    bf16x8 At[4][2], B0[2][2], B1[2][2];
    unsigned cA = (unsigned)cur.pm * tstep + (unsigned)cur.k0 * kstep, cB = (unsigned)cur.pn * tstep + (unsigned)cur.k0 * kstep;
    S.a_ready(cur);
    if constexpr (SP2) {
        PG8_STAGE(PG8_SB(0, 0), (const char*)g.Bt + (size_t)(cB), voffB); PG8_STAGE(PG8_SB(0, 1), (const char*)g.Bt + (size_t)(cB + hstep), voffB); PG8_STAGE(PG8_SA(0, 0), (const char*)g.A + (size_t)(cA), voffA); PG8_STAGE(PG8_SA(0, 1), (const char*)g.A + (size_t)(cA + hstep), voffA);
        if (wr == 1) PG8_BAR;
        PG8_WAIT_V(2); PG8_BAR;
        PG8_STAGE(PG8_SB(1, 0), (const char*)g.Bt + (size_t)(cB + kstep), voffB); PG8_STAGE(PG8_SA(1, 0), (const char*)g.A + (size_t)(cA + kstep), voffA); PG8_STAGE(PG8_SB(1, 1), (const char*)g.Bt + (size_t)(cB + hstep + kstep), voffB);
        PG8_WAIT_V(6); PG8_BAR;
    } else {
        PG8_STAGE(PG8_SB(0, 0), (const char*)g.Bt + (size_t)(cB), voffB); PG8_STAGE(PG8_SA(0, 0), (const char*)g.A + (size_t)(cA), voffA); PG8_STAGE(PG8_SB(0, 1), (const char*)g.Bt + (size_t)(cB + hstep), voffB); PG8_STAGE(PG8_SA(0, 1), (const char*)g.A + (size_t)(cA + hstep), voffA);
        if (wr == 1) PG8_BAR;
        PG8_WAIT_V(4); PG8_BAR;
        PG8_STAGE(PG8_SB(1, 0), (const char*)g.Bt + (size_t)(cB + kstep), voffB); PG8_STAGE(PG8_SA(1, 0), (const char*)g.A + (size_t)(cA + kstep), voffA); PG8_STAGE(PG8_SB(1, 1), (const char*)g.Bt + (size_t)(cB + hstep + kstep), voffB);
        PG8_WAIT_V(6); PG8_BAR;
    }
    for (;;) {
        const bool has_next = S.next(ui + 1, nxt);
        const unsigned nA = has_next ? (unsigned)nxt.pm * tstep + (unsigned)nxt.k0 * kstep : cA, nB = has_next ? (unsigned)nxt.pn * tstep + (unsigned)nxt.k0 * kstep : cB;
        const int unt = cur.nt ? cur.nt : nt;
        for (int t = 0; t < unt; t += 2) {
            const bool last = (t == unt - 2);
            const unsigned a1 = cA + (unsigned)(t + 1) * kstep;
            const unsigned a2 = last ? nA : cA + (unsigned)(t + 2) * kstep, b2 = last ? nB : cB + (unsigned)(t + 2) * kstep;
            const unsigned a3 = a2 + kstep, b3 = b2 + kstep;
            if (last && has_next) S.a_ready(nxt);
            if constexpr (SP2) {
            PG8_LDB(B0, 0, 0); PG8_LDB(B1, 0, 1); PG8_SCHED; PG8_LDA(At, 0, 0); PG8_STAGE(PG8_SA(1, 1), (const char*)g.A + (size_t)(a1 + hstep), voffA);
            PG8_WAIT_V(8); PG8_WAIT_L(0); PG8_BAR; PG8_MMA(0, 0, At, B0); PG8_MMA(0, 1, At, B1); PG8_BAR; PG8_SCHED;
            PG8_LDA(At, 0, 1); PG8_STAGE(PG8_SB(0, 0), (const char*)g.Bt + (size_t)(b2), voffB); PG8_STAGE(PG8_SB(0, 1), (const char*)g.Bt + (size_t)(b2 + hstep), voffB); PG8_STAGE(PG8_SA(0, 0), (const char*)g.A + (size_t)(a2), voffA);
            PG8_WAIT_V(8); PG8_WAIT_L(0); PG8_BAR; PG8_MMA(1, 0, At, B0); PG8_MMA(1, 1, At, B1); PG8_BAR; PG8_SCHED;
            PG8_LDB(B0, 1, 0); PG8_LDB(B1, 1, 1); PG8_SCHED; PG8_LDA(At, 1, 0); PG8_STAGE(PG8_SA(0, 1), (const char*)g.A + (size_t)(a2 + hstep), voffA);
            PG8_WAIT_V(8); PG8_WAIT_L(0); PG8_BAR; PG8_MMA(0, 0, At, B0); PG8_MMA(0, 1, At, B1); PG8_BAR; PG8_SCHED;
            PG8_LDA(At, 1, 1); PG8_STAGE(PG8_SB(1, 0), (const char*)g.Bt + (size_t)(b3), voffB); PG8_STAGE(PG8_SB(1, 1), (const char*)g.Bt + (size_t)(b3 + hstep), voffB); PG8_STAGE(PG8_SA(1, 0), (const char*)g.A + (size_t)(a3), voffA);
            PG8_WAIT_V(8); PG8_WAIT_L(0); PG8_BAR; PG8_MMA(1, 0, At, B0); PG8_MMA(1, 1, At, B1); PG8_BAR; PG8_SCHED;
            } else {
            PG8_LDB(B0, 0, 0); PG8_SCHED; PG8_LDA(At, 0, 0); PG8_STAGE(PG8_SA(1, 1), (const char*)g.A + (size_t)(a1 + hstep), voffA);
            PG8_WAIT_L(8); PG8_BAR; PG8_WAIT_L(0); PG8_MMA(0, 0, At, B0); PG8_BAR; PG8_SCHED;
            PG8_LDB(B1, 0, 1); PG8_STAGE(PG8_SB(0, 0), (const char*)g.Bt + (size_t)(b2), voffB);
            PG8_BAR; PG8_WAIT_L(0); PG8_MMA(0, 1, At, B1); PG8_BAR;
            PG8_LDA(At, 0, 1); PG8_STAGE(PG8_SA(0, 0), (const char*)g.A + (size_t)(a2), voffA);
            PG8_BAR; PG8_WAIT_L(0); PG8_MMA(1, 0, At, B0); PG8_BAR; PG8_SCHED;
            PG8_STAGE(PG8_SB(0, 1), (const char*)g.Bt + (size_t)(b2 + hstep), voffB);
            PG8_WAIT_V(6); PG8_BAR; PG8_MMA(1, 1, At, B1); PG8_BAR;
            PG8_LDB(B0, 1, 0); PG8_SCHED; PG8_LDA(At, 1, 0); PG8_STAGE(PG8_SA(0, 1), (const char*)g.A + (size_t)(a2 + hstep), voffA);
            PG8_WAIT_L(8); PG8_BAR; PG8_WAIT_L(0); PG8_MMA(0, 0, At, B0); PG8_BAR; PG8_SCHED;
            PG8_LDB(B1, 1, 1); PG8_STAGE(PG8_SB(1, 0), (const char*)g.Bt + (size_t)(b3), voffB);
            PG8_BAR; PG8_WAIT_L(0); PG8_MMA(0, 1, At, B1); PG8_BAR;
            PG8_LDA(At, 1, 1); PG8_STAGE(PG8_SA(1, 0), (const char*)g.A + (size_t)(a3), voffA);
            PG8_BAR; PG8_WAIT_L(0); PG8_MMA(1, 0, At, B0); PG8_BAR; PG8_SCHED;
            PG8_STAGE(PG8_SB(1, 1), (const char*)g.Bt + (size_t)(b3 + hstep), voffB);
            PG8_WAIT_V(6); PG8_BAR; PG8_MMA(1, 1, At, B1); PG8_BAR;
            }
        }
        if constexpr (ALIGN_EPI) { if (wr == 0) PG8_BAR; }
        if constexpr (!Epi::AFTER_DRAIN) { int t_ = threadIdx.x; asm volatile("" : "+v"(t_)); const int l_ = t_ & 63, w_ = __builtin_amdgcn_readfirstlane(t_ >> 6);
            E(acc, cur, w_ >> 2, w_ & 3, l_ & 15, l_ >> 4); S.done(cur); }
        if (!has_next) break;
#pragma unroll
        for (int a = 0; a < 2; ++a)
#pragma unroll
            for (int b = 0; b < 2; ++b)
#pragma unroll
                for (int m = 0; m < 4; ++m)
#pragma unroll
                    for (int n = 0; n < 2; ++n) acc[a][b][m][n] = (f32x4){0.f, 0.f, 0.f, 0.f};
        cur = nxt; cA = nA; cB = nB; ++ui;
        if constexpr (ALIGN_EPI) { if (wr == 1) PG8_BAR; }
    }
    PG8_WAIT_V(0);
    if constexpr (!ALIGN_EPI) { if (wr == 0) PG8_BAR; }
    PG8_BAR;
    if constexpr (Epi::AFTER_DRAIN) { E.fused(acc, cur, wr, wc, fr, fq, lds, wid, lane); S.done(cur); }
#undef PG8_SA
#undef PG8_SB
#undef PG8_STAGE
#undef PG8_LDA
#undef PG8_LDB
#undef PG8_MMA
#undef PG8_WAIT_V
#undef PG8_WAIT_L
#undef PG8_BAR
#undef PG8_SCHED
}
}

#define GAS __attribute__((address_space(1)))
typedef unsigned short bf16;
typedef float f32x4 __attribute__((ext_vector_type(4)));
typedef unsigned v4u __attribute__((ext_vector_type(4)));
typedef unsigned v2u __attribute__((ext_vector_type(2)));
constexpr int D = 2048, NB = 4, SEQ = 4096, CTXL = 256, DFF = 5504, NMOD = 9;
constexpr int TL = NB * SEQ, TC = NB * CTXL, TT = TL + TC;
constexpr int MIXH = 1024;
constexpr int EV_COLS = 7216, EV_PAD = 7424, OD_COLS = 5120;
constexpr int NWAVES = 8, NTHR = 512;
constexpr float EPS = 1e-6f;

constexpr size_t MiB = 1u << 20;
constexpr size_t WS_CTL = 0, CTL_ZERO_BYTES = 64 * 1024;
constexpr size_t WS_MOD = 1 * MiB;
constexpr size_t WS_MODP = 2 * MiB;
constexpr int MOD_KC = 16;
constexpr size_t WS_WGU = 16 * MiB;
constexpr size_t SZ_WGU = (size_t)11008 * 2048 * 2;
constexpr size_t WS_WD = WS_WGU + 4 * SZ_WGU;
constexpr size_t SZ_WD = (size_t)2048 * 5504 * 2;
constexpr size_t WS_WIN_EV = WS_WD + 4 * SZ_WD;
constexpr size_t WS_WOUT_EV = WS_WIN_EV + (size_t)EV_PAD * 2048 * 2;
constexpr size_t WS_WIN_OD = WS_WOUT_EV + (size_t)2048 * 2048 * 2;
constexpr size_t WS_WOUT_OD = WS_WIN_OD + (size_t)OD_COLS * 2048 * 2;
constexpr size_t WS_WGLU = WS_WOUT_OD + (size_t)2048 * 2048 * 2;
constexpr size_t WS_XC = WS_WGLU + (size_t)1024 * 1024 * 2;
constexpr size_t WS_HB = WS_XC + (size_t)TC * D * 4;
constexpr size_t WS_R = WS_HB + (size_t)TT * D * 2;
constexpr size_t WS_HID = WS_R;
constexpr size_t WS_Y = WS_R + 183 * MiB;
constexpr size_t WS_S = WS_R;
constexpr size_t WS_GT = WS_R + 247 * MiB;
constexpr size_t WS_GB = WS_R + 264 * MiB;
constexpr size_t WS_O = WS_R + 298 * MiB;
constexpr size_t SZ_O = (size_t)TT * 1024 * 2;
constexpr size_t WS_XL = WS_R + 434 * MiB;
constexpr size_t WS_QK2 = WS_XL + (size_t)TL * D * 2;
constexpr size_t WS_GP = WS_QK2 + (size_t)TT * 2048 * 2;
constexpr size_t WS_QKS = WS_GP + (size_t)TT * 8 * 4 * 4;
constexpr size_t WS_VEC = WS_QKS + (size_t)2 * TT * 1024 * 2;
constexpr size_t WS_GPK = WS_VEC + (size_t)NB * 4 * 2 * 68 * 384 * 4;
constexpr size_t WS_PP = WS_GPK + (size_t)NB * 4 * 2 * 68 * 256 * 4;
constexpr size_t WS_RS = WS_PP + (size_t)NB * 4 * 2 * 68 * 4096 * 2;
constexpr size_t WS_END = WS_RS + (size_t)NB * 4 * 2 * 68 * 64 * 4;
constexpr size_t WS_YCP = WS_R + 320 * MiB;
constexpr int YPARTS = 8;
static_assert(WS_YCP >= WS_Y + (size_t)TT * D * 2 && WS_YCP + (size_t)YPARTS * TC * D * 4 <= WS_XL && WS_O + 4 * SZ_O <= WS_XL, "ws map");
static_assert(WS_HID + (size_t)TT * DFF * 2 <= WS_Y && WS_S + (size_t)TT * EV_PAD * 2 <= WS_GT && WS_GT + (size_t)TT * 256 * 4 <= WS_GB && WS_GB + (size_t)TT * 1024 * 2 <= WS_O, "ws map");
static_assert(WS_Y + (size_t)TT * D * 2 <= WS_O, "ws map");

constexpr int LDS_BYTES = 156 * 1024;
constexpr int MISC_OFF = LDS_BYTES - 64;

struct Args { const float* in[34]; float* out; unsigned char* ws; };
#ifdef PROBE_A
#ifndef PROBE_A1
#define PROBE_A1 PROBE_A
#endif
#ifndef PROBE_B
#define PROBE_B -100
#endif
#ifndef PROBE_B1
#define PROBE_B1 PROBE_B
#endif
#define XBAR() do { xcd_barrier(bar); if (blockIdx.x == 0 && threadIdx.x == 0) { volatile LAS unsigned* M_ = (volatile LAS unsigned*)(lds + MISC_OFF); const unsigned c_ = M_[4]; \
        const unsigned long long t_ = __builtin_amdgcn_s_memrealtime(); const unsigned lo_ = (unsigned)t_; \
        if ((int)c_ == PROBE_A - 1) M_[6] = lo_; if ((int)c_ == PROBE_A1) M_[7] = lo_; if ((int)c_ == PROBE_B - 1) M_[8] = lo_; if ((int)c_ == PROBE_B1) M_[9] = lo_; M_[4] = c_ + 1u; } } while (0)
#else
#define XBAR() xcd_barrier(bar)
#endif
#define ARG(k) ((const float*)(GAS const float*)(a.in[opaque_idx(k)]))
__device__ __forceinline__ unsigned char* wsp(unsigned char* w, size_t off) { asm volatile("" : "+s"(off)); return w + off; }
__device__ __forceinline__ int opaque_idx(int k) { asm volatile("" : "+s"(k)); return k; }

__device__ __forceinline__ unsigned f2bf(float f) { unsigned u = __float_as_uint(f); u += 0x7FFFu + ((u >> 16) & 1u); return u >> 16; }
typedef __bf16 bf16x2_t __attribute__((ext_vector_type(2)));
typedef float f32x2_t __attribute__((ext_vector_type(2)));
__device__ __forceinline__ unsigned pk2(float lo, float hi) { const f32x2_t v = {lo, hi}; const bf16x2_t b = __builtin_convertvector(v, bf16x2_t); return __builtin_bit_cast(unsigned, b); }
__device__ __forceinline__ float bf2f(unsigned short b) { return __uint_as_float(((unsigned)b) << 16); }
__device__ __forceinline__ float wave_sum(float v) {
#pragma unroll
    for (int o = 1; o < 64; o <<= 1) v += __shfl_xor(v, o);
    return v;
}
__device__ __forceinline__ float fast_silu(float g) { return g * __builtin_amdgcn_rcpf(1.0f + __expf(-g)); }
__device__ __forceinline__ float fast_sigmoid(float g) { return __builtin_amdgcn_rcpf(1.0f + __expf(-g)); }

#ifndef DEFER
#define DEFER 2
#endif
struct TJob { const float* src; bf16* dst; int K, N, map; };
constexpr int NT_FFN = 5504, NT_EVIN = 32 * 226, NT_SQ = 2048, NT_ODIN = 32 * 160, NT_GLU = 512;
constexpr int NT_SET0 = 6 * NT_FFN + NT_EVIN + NT_SQ + NT_ODIN + NT_SQ + NT_GLU, NT_SET1 = 3 * NT_FFN, NT_SET2 = 3 * NT_FFN;
__device__ __forceinline__ void transpose_tile(const TJob& j, int tl, int lane) {
    const int nblk = (j.N + 31) / 32, kb = tl / nblk, nb = tl % nblk, k0 = 64 * kb, n0 = 32 * nb;
    const int kb8 = lane >> 3, nb4 = lane & 7, n = n0 + 4 * nb4;
    int drow0;
    if (j.map == 0) drow0 = n0;
    else if (j.map == 1) drow0 = (n0 / 128) * 256 + (n0 % 128);
    else if (j.map == 2) drow0 = (n0 / 128) * 256 + (n0 % 128) + 128;
    else drow0 = (nb < 96) ? n0 : (nb == 96 ? 7168 : (nb < 225 ? n0 - 32 : 7200));
    if (n < j.N) {
        const float* s = j.src + (size_t)(k0 + 8 * kb8) * j.N + n;
        f32x4 v[8];
#pragma unroll
        for (int i = 0; i < 8; ++i) v[i] = *(const f32x4*)(s + (size_t)i * j.N);
        bf16* d = j.dst + (size_t)(drow0 + 4 * nb4) * j.K + k0 + 8 * kb8;
#pragma unroll
        for (int e = 0; e < 4; ++e) { v4u o; o.x = pk2(v[0][e], v[1][e]); o.y = pk2(v[2][e], v[3][e]); o.z = pk2(v[4][e], v[5][e]); o.w = pk2(v[6][e], v[7][e]);
            *(v4u*)(d + (size_t)e * j.K) = o; }
    }
}

__device__ __forceinline__ void transpose_tile2(const TJob& j, int tl0, int tl1, int lane) {
    const int nblk = (j.N + 31) / 32; const int kb8 = lane >> 3, nb4 = lane & 7;
    f32x4 v[2][8]; int drow[2], k0s[2]; bool ok[2];
#pragma unroll
    for (int u = 0; u < 2; ++u) { const int tl = u ? tl1 : tl0; const int kb = tl / nblk, nb = tl % nblk, k0 = 64 * kb, n0 = 32 * nb, n = n0 + 4 * nb4;
        int drow0;
        if (j.map == 0) drow0 = n0;
        else if (j.map == 1) drow0 = (n0 / 128) * 256 + (n0 % 128);
        else if (j.map == 2) drow0 = (n0 / 128) * 256 + (n0 % 128) + 128;
        else drow0 = (nb < 96) ? n0 : (nb == 96 ? 7168 : (nb < 225 ? n0 - 32 : 7200));
        drow[u] = drow0; k0s[u] = k0; ok[u] = n < j.N;
        if (ok[u]) { const float* s = j.src + (size_t)(k0 + 8 * kb8) * j.N + n;
#pragma unroll
            for (int i = 0; i < 8; ++i) v[u][i] = *(const f32x4*)(s + (size_t)i * j.N); } }
#pragma unroll
    for (int u = 0; u < 2; ++u) if (ok[u]) { bf16* d = j.dst + (size_t)(drow[u] + 4 * nb4) * j.K + k0s[u] + 8 * kb8;
#pragma unroll
        for (int e = 0; e < 4; ++e) { v4u o; o.x = pk2(v[u][0][e], v[u][1][e]); o.y = pk2(v[u][2][e], v[u][3][e]); o.z = pk2(v[u][4][e], v[u][5][e]); o.w = pk2(v[u][6][e], v[u][7][e]);
            *(v4u*)(d + (size_t)e * j.K) = o; } }
}
__device__ __forceinline__ TJob make_job(const Args& a, unsigned char* ws, int id) {
    TJob j;
    if (id < 12) { const int li = id / 3, kind = id % 3; const size_t wo = (size_t)li * 2048 * 5504;
        j.src = ARG(8 + kind) + wo;
        if (kind == 2) { j.K = 5504; j.N = 2048; j.map = 0; j.dst = (bf16*)(wsp(ws, WS_WD) + (size_t)li * SZ_WD); }
        else { j.K = 2048; j.N = 5504; j.map = 1 + kind; j.dst = (bf16*)(wsp(ws, WS_WGU) + (size_t)li * SZ_WGU); } }
    else if (id == 12) { j.src = ARG(11); j.K = 2048; j.N = EV_COLS; j.map = 3; j.dst = (bf16*)wsp(ws, WS_WIN_EV); }
    else if (id == 13) { j.src = ARG(12); j.K = 2048; j.N = 2048; j.map = 0; j.dst = (bf16*)wsp(ws, WS_WOUT_EV); }
    else if (id == 14) { j.src = ARG(20); j.K = 2048; j.N = OD_COLS; j.map = 0; j.dst = (bf16*)wsp(ws, WS_WIN_OD); }
    else if (id == 15) { j.src = ARG(21); j.K = 2048; j.N = 2048; j.map = 0; j.dst = (bf16*)wsp(ws, WS_WOUT_OD); }
    else { j.src = ARG(30); j.K = 1024; j.N = 1024; j.map = 0; j.dst = (bf16*)wsp(ws, WS_WGLU); }
    return j;
}
__device__ __forceinline__ void convert_tiles(const Args& a, unsigned char* ws, int set, int wave_index, int nwaves, int lane) {
    const int njobs = DEFER == 2 ? (set == 0 ? 8 : 3) : (set == 0 ? 11 : 3);
    int start = wave_index;
#pragma unroll 1
    for (int q = 0; q < njobs; ++q) {
        const int id = DEFER == 2 ? (set == 0 ? (q < 3 ? q : q + 9) : 3 * set + q) : (set == 0 ? (q < 3 ? q : (q < 6 ? q + 3 : q + 6)) : (set == 1 ? 3 + q : 9 + q));
        const int nt = id < 12 ? NT_FFN : (id == 12 ? NT_EVIN : (id == 14 ? NT_ODIN : (id == 16 ? NT_GLU : NT_SQ)));
        const TJob j = make_job(a, ws, id);
        int t = start;
#pragma unroll 1
        for (; t + nwaves < nt; t += 2 * nwaves) transpose_tile2(j, t, t + nwaves, lane);
        if (t < nt) { transpose_tile(j, t, lane); t += nwaves; }
        start = t - nt;
    }
}

struct NormP {
    const void* xin_lat; const void* xin_ctx; void* xout_lat; void* xout_ctx; const bf16* y; bf16* h;
    int xin_f32, xout_f32;
    int rows_end; int has_y, has_h; float w;
    const float* y_ctx;
    int lp, sp;
    int ln, sn;
};
__device__ __forceinline__ void norm_phase(const NormP& p, const float* mod, const float* norm_pre, const float* norm_post, LAS unsigned char* lds, int gw, int ngw, int tid, int lane) {
    { int t2 = threadIdx.x; asm volatile("" : "+v"(t2)); tid = t2; lane = t2 & 63; gw = blockIdx.x * NWAVES + __builtin_amdgcn_readfirstlane(t2 >> 6); }
    LAS float* TA = (LAS float*)lds; LAS float* TB = TA + 5 * D; LAS float* TCc = TB + 5 * D;
    for (int i = tid; i < 5 * D; i += NTHR) { const int var = i >> 11, j = i & (D - 1);
        if (p.has_y) TA[i] = p.w * mod[((size_t)p.lp * 5 + var) * (NMOD * D) + (3 * p.sp + 2) * D + j] * norm_post[(p.lp * 3 + p.sp) * D + j];
        if (p.has_h) { TB[i] = norm_pre[(p.ln * 3 + p.sn) * D + j] * (1.0f + mod[((size_t)p.ln * 5 + var) * (NMOD * D) + (3 * p.sn + 1) * D + j]);
                       TCc[i] = mod[((size_t)p.ln * 5 + var) * (NMOD * D) + (3 * p.sn) * D + j]; } }
    __syncthreads();
    for (int r = gw; r < p.rows_end; r += ngw) {
        const int var = r < TL ? (r >> 12) : 4;
        const size_t xoff = r < TL ? (size_t)r * D : (size_t)(r - TL) * D;
        const void* xi = r < TL ? p.xin_lat : p.xin_ctx; void* xo = r < TL ? p.xout_lat : p.xout_ctx;
        f32x4 xv[8];
        if (p.xin_f32) {
#pragma unroll
            for (int j = 0; j < 8; ++j) xv[j] = *(const f32x4*)((const float*)xi + xoff + 4 * lane + 256 * j);
        } else {
#pragma unroll
            for (int j = 0; j < 8; ++j) { const v2u w = *(const v2u*)((const bf16*)xi + xoff + 4 * lane + 256 * j); xv[j] = (f32x4){__uint_as_float(w.x << 16), __uint_as_float(w.x & 0xffff0000u), __uint_as_float(w.y << 16), __uint_as_float(w.y & 0xffff0000u)}; }
        }
        if (p.has_y) {
            const bool yc = (r >= TL) && p.y_ctx; const float* yr = p.y_ctx + (size_t)(r - TL) * D; f32x4 yv[8]; float s = 0.f;
            if (!yc) { const bf16* yb = p.y + (size_t)r * D;
#pragma unroll
                for (int j = 0; j < 8; ++j) { const v2u w = *(const v2u*)(yb + 4 * lane + 256 * j); yv[j] = (f32x4){__uint_as_float(w.x << 16), __uint_as_float(w.x & 0xffff0000u), __uint_as_float(w.y << 16), __uint_as_float(w.y & 0xffff0000u)}; }
            } else {
#pragma unroll
                for (int j = 0; j < 8; ++j) yv[j] = *(const f32x4*)(yr + 4 * lane + 256 * j);
                for (int q = 1; q < YPARTS; ++q) {
#pragma unroll
                for (int j = 0; j < 8; ++j) yv[j] += *(const f32x4*)(yr + (size_t)q * TC * D + 4 * lane + 256 * j); } }
#pragma unroll
            for (int j = 0; j < 8; ++j) { s += (yv[j].x * yv[j].x + yv[j].y * yv[j].y) + (yv[j].z * yv[j].z + yv[j].w * yv[j].w); }
            const float rstd = 1.0f / sqrtf(wave_sum(s) * (1.0f / D) + EPS);
#pragma unroll
            for (int j = 0; j < 8; ++j) { const f32x4 a = *(const LAS f32x4*)(TA + var * D + 4 * lane + 256 * j); xv[j] = xv[j] + a * (yv[j] * rstd);
                if (p.xout_f32) *(f32x4*)((float*)xo + xoff + 4 * lane + 256 * j) = xv[j];
                else { v2u w; w.x = pk2(xv[j].x, xv[j].y); w.y = pk2(xv[j].z, xv[j].w); *(v2u*)((bf16*)xo + xoff + 4 * lane + 256 * j) = w; } }
        }
        if (p.has_h) {
            float s = 0.f;
#pragma unroll
            for (int j = 0; j < 8; ++j) s += (xv[j].x * xv[j].x + xv[j].y * xv[j].y) + (xv[j].z * xv[j].z + xv[j].w * xv[j].w);
            const float rstd = 1.0f / sqrtf(wave_sum(s) * (1.0f / D) + EPS);
            bf16* hr = p.h + (size_t)r * D;
#pragma unroll
            for (int j = 0; j < 8; ++j) { const f32x4 b = *(const LAS f32x4*)(TB + var * D + 4 * lane + 256 * j), c = *(const LAS f32x4*)(TCc + var * D + 4 * lane + 256 * j);
                const f32x4 o = xv[j] * rstd * b + c; v2u w; w.x = pk2(o.x, o.y); w.y = pk2(o.z, o.w); *(v2u*)(hr + 4 * lane + 256 * j) = w; }
        }
    }
    __syncthreads();
}

struct EpiSwiGLU {
    static constexpr bool PERM = true, AFTER_DRAIN = false;
    bf16* O; int ldc;
    __device__ __forceinline__ void operator()(const pg8::f32x4 (&acc)[2][2][4][2], const pg8::Unit& u, int wr, int wc, int fr, int fq) const {
        const int row0 = u.pm * 256 + wr * 64 + fr, col0 = u.pn * 128 + wc * 32 + 8 * fq;
#pragma unroll
        for (int ai = 0; ai < 2; ++ai)
#pragma unroll
            for (int m = 0; m < 4; ++m) { bf16* rowp = O + (size_t)(row0 + ai * 128 + m * 16) * ldc + col0;
                const pg8::f32x4 g0 = acc[ai][0][m][0], g1 = acc[ai][0][m][1], u0 = acc[ai][1][m][0], u1 = acc[ai][1][m][1];
                v4u w; w.x = pk2(fast_silu(g0[0]) * u0[0], fast_silu(g0[1]) * u0[1]); w.y = pk2(fast_silu(g0[2]) * u0[2], fast_silu(g0[3]) * u0[3]);
                w.z = pk2(fast_silu(g1[0]) * u1[0], fast_silu(g1[1]) * u1[1]); w.w = pk2(fast_silu(g1[2]) * u1[2], fast_silu(g1[3]) * u1[3]);
                *(v4u*)rowp = w; }
    }
};
struct EpiF32 {
    static constexpr bool PERM = true, AFTER_DRAIN = false;
    bf16* C; float* Cs;
    static constexpr int ldc = D;
    __device__ __forceinline__ void operator()(const pg8::f32x4 (&acc)[2][2][4][2], const pg8::Unit& u, int wr, int wc, int fr, int fq) const {
        const int row0 = u.pm * 256 + wr * 64 + fr, col0 = u.pn * 256 + wc * 32 + 8 * fq;
        if (u.part >= 0) {
            float* base = Cs + ((size_t)u.part * TC - (size_t)TL) * D;
#pragma unroll
            for (int ai = 0; ai < 2; ++ai)
#pragma unroll
                for (int m = 0; m < 4; ++m) { float* rowp = base + (size_t)(row0 + ai * 128 + m * 16) * ldc + col0;
#pragma unroll
                    for (int bj = 0; bj < 2; ++bj) { *(pg8::f32x4*)(rowp + bj * 128) = acc[ai][bj][m][0]; *(pg8::f32x4*)(rowp + bj * 128 + 4) = acc[ai][bj][m][1]; } }
        } else {
#pragma unroll
            for (int ai = 0; ai < 2; ++ai)
#pragma unroll
                for (int m = 0; m < 4; ++m) { bf16* rowp = C + (size_t)(row0 + ai * 128 + m * 16) * ldc + col0;
#pragma unroll
                    for (int bj = 0; bj < 2; ++bj) { const pg8::f32x4 v0 = acc[ai][bj][m][0], v1 = acc[ai][bj][m][1];
                        v4u w; w.x = pk2(v0[0], v0[1]); w.y = pk2(v0[2], v0[3]); w.z = pk2(v1[0], v1[1]); w.w = pk2(v1[2], v1[3]);
                        *(v4u*)(rowp + bj * 128) = w; } }
        }
    }
};
struct EpiS {
    static constexpr bool PERM = true, AFTER_DRAIN = false;
    bf16* S; int ldc; float* GT; int gt_pn;
    __device__ __forceinline__ void operator()(const pg8::f32x4 (&acc)[2][2][4][2], const pg8::Unit& u, int wr, int wc, int fr, int fq) const {
        const int row0 = u.pm * 256 + wr * 64 + fr;
        if (u.pn == gt_pn) {
            if (wc < 2) {
#pragma unroll
                for (int ai = 0; ai < 2; ++ai)
#pragma unroll
                    for (int m = 0; m < 4; ++m) { float* rowp = GT + (size_t)(row0 + ai * 128 + m * 16) * 256 + wc * 32 + 8 * fq;
                        *(pg8::f32x4*)rowp = acc[ai][0][m][0]; *(pg8::f32x4*)(rowp + 4) = acc[ai][0][m][1]; }
            }
        } else {
            const int col0 = u.pn * 256 + wc * 32 + 8 * fq;
#pragma unroll
            for (int ai = 0; ai < 2; ++ai)
#pragma unroll
                for (int m = 0; m < 4; ++m) { bf16* rowp = S + (size_t)(row0 + ai * 128 + m * 16) * ldc + col0;
#pragma unroll
                    for (int bj = 0; bj < 2; ++bj) { const pg8::f32x4 v0 = acc[ai][bj][m][0], v1 = acc[ai][bj][m][1];
                        v4u w; w.x = pk2(v0[0], v0[1]); w.y = pk2(v0[2], v0[3]); w.z = pk2(v1[0], v1[1]); w.w = pk2(v1[2], v1[3]);
                        *(v4u*)(rowp + bj * 128) = w; } }
        }
    }
};

#define DEV __device__ __forceinline__
#define LP(T) LAS T*
#define SYNC() do { asm volatile("s_waitcnt lgkmcnt(0)" ::: "memory"); __builtin_amdgcn_s_barrier(); asm volatile("" ::: "memory"); } while (0)
typedef short v8s __attribute__((ext_vector_type(8)));
typedef float v4f __attribute__((ext_vector_type(4)));
#define MFMA16(x, y, c) __builtin_amdgcn_mfma_f32_16x16x32_bf16((x), (y), (c), 0, 0, 0)
#define SHX(v, m) __shfl_xor((v), (m))
#define SHUP(v, d) __shfl_up((v), (d))
#define SHIDX(v, l) __shfl((v), (l))
#define EXPF(x) __expf(x)
#define LOGF(x) __logf(x)
#define RCPF(x) __builtin_amdgcn_rcpf(x)
#define RSQRTF(x) (1.0f / sqrtf(x))
#define PK2(lo, hi) pk2((lo), (hi))
#define F2BF(x) ((unsigned short)f2bf(x))
#define WAVE_SYNC() asm volatile("s_waitcnt lgkmcnt(0)" ::: "memory")
typedef short v4s __attribute__((ext_vector_type(4)));
#define LDS_TR16(p) __builtin_amdgcn_ds_read_tr16_b64_v4i16((LAS v4s*)(p))
#define RDLANE(v, l) __int_as_float(__builtin_amdgcn_readlane(__float_as_int(v), (l)))
#define RDLANE16(v, l) __shfl((v), (l))
#define SIB_SYNC_IMPL(p, target) do { __hip_atomic_fetch_add((p), 1u, __ATOMIC_RELAXED, __HIP_MEMORY_SCOPE_AGENT); unsigned sp_ = 0; \
    while (__hip_atomic_load((p), __ATOMIC_RELAXED, __HIP_MEMORY_SCOPE_AGENT) < (target) && ++sp_ < 100000u) __builtin_amdgcn_s_sleep(2); } while (0)

#define PRBROW(r) ((prb) == 1 ? ((r) & 63) : (r))
#define PRBTSK(t) ((prb) == 1 ? 0 : (t))
DEV int seq_row(int b, int seg, int np, int cm) {
    if (!seg) return TL + b * CTXL + np;
    const int n = cm ? ((np & 63) * 64 + (np >> 6)) : np;
    return b * SEQ + n;
}
DEV int tok_row(int b, int seg, int pos, int dir, int cm) {
    const int len = seg ? SEQ : CTXL;
    return seq_row(b, seg, dir ? len - 1 - pos : pos, cm);
}
DEV float bflo(unsigned u) { return __uint_as_float(u << 16); }
DEV float bfhi(unsigned u) { return __uint_as_float(u & 0xffff0000u); }
DEV float logsigmoidf(float z) { return fminf(z, 0.f) - LOGF(1.0f + EXPF(-fabsf(z))); }
DEV v4f tile_mma(v4f acc, LP(const unsigned char) A, int sa, int m0, LP(const unsigned char) B, int sb, int n0, int ksteps, int fr, int fq) {
    LP(const unsigned char) ap = A + (m0 + fr) * sa + fq * 16;
    LP(const unsigned char) bp = B + (n0 + fr) * sb + fq * 16;
    for (int k = 0; k < ksteps; ++k) {
        const v8s af = *(LP(const v8s))(ap + k * 64);
        const v8s bf = *(LP(const v8s))(bp + k * 64);
        acc = MFMA16(bf, af, acc);
    }
    return acc;
}
DEV v8s tr_frag(LP(const unsigned char) T, int st, int k0, int n0, int lane) {
    const int l16 = lane & 15, fq = lane >> 4;
    LP(const unsigned char) p = T + (k0 + 8 * fq + (l16 >> 2)) * st + (n0 + 4 * (l16 & 3)) * 2;
    const v4s a = LDS_TR16(p), b = LDS_TR16(p + 4 * st);
    return (v8s){a.x, a.y, a.z, a.w, b.x, b.y, b.z, b.w};
}
DEV v4f tile_mma_nt(v4f acc, LP(const unsigned char) A, int sa, int m0, LP(const unsigned char) Bt, int sb, int n0, int ksteps, int lane) {
    const int fr = lane & 15, fq = lane >> 4;
    for (int k = 0; k < ksteps; ++k) { const v8s af = *(LP(const v8s))(A + (m0 + fr) * sa + fq * 16 + k * 64); const v8s bf = tr_frag(Bt, sb, 32 * k, n0, lane); acc = MFMA16(bf, af, acc); }
    return acc;
}
DEV v4f tile_mma_tt(v4f acc, LP(const unsigned char) At, int sa, int m0, LP(const unsigned char) Bt, int sb, int n0, int ksteps, int lane) {
    for (int k = 0; k < ksteps; ++k) { const v8s af = tr_frag(At, sa, 32 * k, m0, lane); const v8s bf = tr_frag(Bt, sb, 32 * k, n0, lane); acc = MFMA16(bf, af, acc); }
    return acc;
}
constexpr int ST128 = 272, ST64 = 144, ST256 = 528, STV = 80;
DEV void sibling_sync(unsigned* sib, unsigned target, int tid) {
#ifdef SIB_SYNC_IMPL
    if (sib) { if (tid == 0) SIB_SYNC_IMPL(sib, target); SYNC(); }
#endif
}

constexpr int MIX_UNITS = NB * 32;
constexpr int GLA_TASKS = NB * 4 * 2 * (CTXL / 64 + SEQ / 64);
DEV void gla_prep_loop(int first, int stride, const bf16* S, const float* GT, const float* wg_all, const float* bg_all, bf16* QKS, float* VEC, LP(unsigned char) lds, int tid) {
    constexpr int NCHUNK = CTXL / 64 + SEQ / 64;
    LP(float) LA = (LP(float))lds; LP(float) SEG = (LP(float))(lds + 32768); LP(unsigned char) LRb = lds + 34816; LP(unsigned char) WGb = lds + 39936; LP(float) BG = (LP(float))(lds + 50176);
    for (int i = tid; i < (5120 + 10240) / 4; i += NTHR) ((LP(unsigned))LRb)[i] = 0u;
    SYNC();
    const int lane = tid & 63, wave = tid >> 6, fr = lane & 15, fq = lane >> 4;
    const int j = tid >> 3, c8 = tid & 7, dc = c8 * 16;
    const float qscale = 0.08838834764831845f;
    v4u pq0, pq1, pk0, pk1; v4f plr = (v4f){0.f, 0.f, 0.f, 0.f}, pwg = plr; float pbg = 0.f;
#define GP_ISSUE(tk) do { const int cx_ = (tk) % NCHUNK, r1_ = (tk) / NCHUNK, dir_ = r1_ & 1, h_ = (r1_ >> 1) & 3, b_ = r1_ >> 3; \
        const int seg_ = cx_ >= CTXL / 64, ci_ = seg_ ? cx_ - CTXL / 64 : cx_; \
        const bf16* sr_ = S + (size_t)tok_row(b_, seg_, ci_ * 64 + j, dir_, 0) * EV_PAD; \
        pq0 = *(const v4u*)(sr_ + h_ * 128 + dc); pq1 = *(const v4u*)(sr_ + h_ * 128 + dc + 8); pk0 = *(const v4u*)(sr_ + 512 + h_ * 128 + dc); pk1 = *(const v4u*)(sr_ + 512 + h_ * 128 + dc + 8); \
        pwg = *(const v4f*)(wg_all + (dir_ * 16 + (tid >> 5)) * 512 + h_ * 128 + (tid & 31) * 4); \
        if (tid < 128) pbg = bg_all[dir_ * 512 + h_ * 128 + tid]; \
        if (tid < 256) { const int rr_ = tok_row(b_, seg_, ci_ * 64 + (tid >> 2), dir_, 0); plr = *(const v4f*)(GT + (size_t)rr_ * 256 + dir_ * 16 + (tid & 3) * 4); } } while (0)
    if (first < GLA_TASKS) GP_ISSUE(first);
    for (int task = first; task < GLA_TASKS; task += stride) {
    const int cidx = task % NCHUNK, r1 = task / NCHUNK, dir = r1 & 1, h = (r1 >> 1) & 3, b = r1 >> 3;
    const int seg = cidx >= CTXL / 64, ci = seg ? cidx - CTXL / 64 : cidx;
    const int row = tok_row(b, seg, ci * 64 + j, dir, 0);
    const v4u q0 = pq0, q1 = pq1, k0 = pk0, k1 = pk1;
    { const int m = tid >> 5, d0 = (tid & 31) * 4;
      *(LP(unsigned short))(WGb + (d0 + 0) * 80 + m * 2) = F2BF(pwg.x); *(LP(unsigned short))(WGb + (d0 + 1) * 80 + m * 2) = F2BF(pwg.y);
      *(LP(unsigned short))(WGb + (d0 + 2) * 80 + m * 2) = F2BF(pwg.z); *(LP(unsigned short))(WGb + (d0 + 3) * 80 + m * 2) = F2BF(pwg.w); }
    if (tid < 128) BG[tid] = pbg;
    if (tid < 256) *(LP(v2u))(LRb + (tid >> 2) * 80 + (tid & 3) * 8) = (v2u){PK2(plr.x, plr.y), PK2(plr.z, plr.w)};
    if (task + stride < GLA_TASKS) GP_ISSUE(task + stride);
    SYNC();
    {
        const int tt = wave >> 1; const v8s af = *(LP(const v8s))(LRb + (16 * tt + fr) * 80 + fq * 16);
#pragma unroll
        for (int i = 0; i < 4; ++i) { const int dt = (wave & 1) * 4 + i; const v8s bf = *(LP(const v8s))(WGb + (16 * dt + fr) * 80 + fq * 16);
            v4f z = (v4f){0.f, 0.f, 0.f, 0.f}; z = MFMA16(bf, af, z);
            const v4f bg4 = *(LP(const v4f))(BG + 16 * dt + 4 * fq);
            v4f o; o.x = logsigmoidf(z.x + bg4.x) * 0.0625f; o.y = logsigmoidf(z.y + bg4.y) * 0.0625f; o.z = logsigmoidf(z.z + bg4.z) * 0.0625f; o.w = logsigmoidf(z.w + bg4.w) * 0.0625f;
            *(LP(v4f))(LA + (16 * tt + fr) * 128 + 16 * dt + 4 * fq) = o; }
    }
    SYNC();
    {
        const int d = tid & 127, sg = tid >> 7; float acc = 0.f;
        for (int jj = 0; jj < 16; ++jj) { acc += LA[(sg * 16 + jj) * 128 + d]; LA[(sg * 16 + jj) * 128 + d] = acc; }
        SEG[sg * 128 + d] = acc;
    }
    SYNC();
    {
        const int sgj = j >> 4;
        bf16* orow = QKS + ((size_t)dir * TT + row) * 1024 + h * 128 + dc;
#pragma unroll 1
        for (int g = 0; g < 2; ++g) {
            const v4u qv = g ? q1 : q0, kv = g ? k1 : k0;
            const unsigned qw[4] = {qv.x, qv.y, qv.z, qv.w}, kw[4] = {kv.x, kv.y, kv.z, kv.w};
            unsigned oqs[4], oks[4];
#pragma unroll
            for (int i2 = 0; i2 < 4; ++i2) {
                float vqs[2], vks[2];
#pragma unroll
                for (int e = 0; e < 2; ++e) {
                    const int d = dc + 8 * g + 2 * i2 + e;
                    const float s0 = SEG[d], s1 = SEG[128 + d], s2 = SEG[256 + d];
                    const float pre = (sgj > 0 ? s0 : 0.f) + (sgj > 1 ? s1 : 0.f) + (sgj > 2 ? s2 : 0.f);
                    const float bv = LA[j * 128 + d] + pre;
                    const float bmid = LA[32 * 128 + d] + s0 + s1;
                    const float q = (e ? bfhi(qw[i2]) : bflo(qw[i2])) * qscale, k = e ? bfhi(kw[i2]) : bflo(kw[i2]);
                    const float e1 = EXPF(bv - bmid);
                    vqs[e] = q * e1; vks[e] = k * RCPF(e1);
                    if (j == 63) { const float bend = bv; float* vp = VEC + (size_t)task * 384 + d; vp[0] = EXPF(bmid); vp[128] = EXPF(bend - bmid); vp[256] = EXPF(bend); }
                }
                oqs[i2] = PK2(vqs[0], vqs[1]); oks[i2] = PK2(vks[0], vks[1]);
            }
            *(v4u*)(orow + 8 * g) = (v4u){oqs[0], oqs[1], oqs[2], oqs[3]};
            *(v4u*)(orow + 512 + 8 * g) = (v4u){oks[0], oks[1], oks[2], oks[3]};
        }
    }
    SYNC();
    }
#undef GP_ISSUE
}

DEV void gla_unit(const bf16* S, const bf16* QKS, const float* VEC, bf16* O, int unit, LP(unsigned char) lds, int tid, unsigned* sib, int prb = 0) {
    const int lane = tid & 63, wave = tid >> 6, fr = lane & 15, fq = lane >> 4;
    const int vs = unit & 3, dir = (unit >> 2) & 1, h = (unit >> 3) & 3, b = unit >> 5;
    LP(unsigned char) QS = lds; LP(unsigned char) KS = lds + 17408; LP(unsigned char) QB = lds + 34816;
    LP(unsigned char) VV = lds + 52224; LP(unsigned char) PM = lds + 61440; LP(unsigned char) STT = lds + 70656;
    LP(float) DV = (LP(float))(lds + 88064);
    for (int i = tid; i < 64 * ST128 / 4; i += NTHR) ((LP(unsigned))STT)[i] = 0u;
    v4f sacc[4];
#pragma unroll
    for (int i = 0; i < 4; ++i) sacc[i] = (v4f){0.f, 0.f, 0.f, 0.f};
    const int j = tid >> 3, c8 = tid & 7, dc = c8 * 16;
    const int tt = wave >> 1, vt0 = (wave & 1) * 2;
    const int svt = wave & 3, sdt0 = (wave >> 2) * 4;
    bf16* Od = O + (size_t)dir * TT * 1024;
    constexpr int NCHUNK = CTXL / 64 + SEQ / 64;
    const int task0 = ((b * 4 + h) * 2 + dir) * NCHUNK;
    v4u gq0[2], gq1[2], gk0[2], gk1[2], gvv[2]; v4f gem[4]; v4f gdv = (v4f){0.f, 0.f, 0.f, 0.f};
#define GLA_ISSUE(cx, P_) do { const int seg_ = (cx) >= CTXL / 64, ci_ = seg_ ? (cx) - CTXL / 64 : (cx); \
        const int row_ = PRBROW(tok_row(b, seg_, ci_ * 64 + j, dir, 0)); \
        const bf16* qr_ = QKS + ((size_t)dir * TT + row_) * 1024 + h * 128 + c8 * 8; \
        gq0[P_] = *(const v4u*)(qr_); gq1[P_] = *(const v4u*)(qr_ + 64); gk0[P_] = *(const v4u*)(qr_ + 512); gk1[P_] = *(const v4u*)(qr_ + 576); \
        gvv[P_] = *(const v4u*)(S + (size_t)row_ * EV_PAD + 1024 + h * 256 + vs * 64 + c8 * 8); } while (0)
#define GLA_ISSUE_V(cx) do { const float* vp_ = VEC + (size_t)PRBTSK(task0 + (cx)) * 384;     \
        _Pragma("unroll") for (int i_ = 0; i_ < 4; ++i_) gem[i_] = *(const v4f*)(vp_ + (i_ >> 1) * 64 + c8 * 8 + 4 * (i_ & 1)); \
        if (tid < 64) gdv = *(const v4f*)(vp_ + 128 + tid * 4); } while (0)
#ifdef GLA_TOTAL_PROBE
    const unsigned long long gt0_ = __builtin_amdgcn_s_memrealtime();
#endif
    GLA_ISSUE(0, 0); GLA_ISSUE(1, 1); GLA_ISSUE_V(0);
    SYNC();
#pragma unroll 1
    for (int c2 = 0; c2 < NCHUNK; c2 += 2) {
#pragma unroll
    for (int u_ = 0; u_ < 2; ++u_) {
        const int cidx = c2 + u_;
        const int seg = cidx >= CTXL / 64, ci = seg ? cidx - CTXL / 64 : cidx;
        if (u_ == 0 && (c2 & 3) == 0 && c2 > 0) sibling_sync(sib, (unsigned)(c2 >> 2) * 4u, tid);
        const v4u q0 = gq0[u_], q1 = gq1[u_], k0 = gk0[u_], k1 = gk1[u_], vv = gvv[u_]; const v4f dvv = gdv;
        v4f em[4];
#pragma unroll
        for (int i_ = 0; i_ < 4; ++i_) em[i_] = gem[i_];
        {
            *(LP(v4u))(QS + j * ST128 + c8 * 16) = q0; *(LP(v4u))(QS + j * ST128 + c8 * 16 + 128) = q1;
            *(LP(v4u))(KS + j * ST128 + c8 * 16) = k0; *(LP(v4u))(KS + j * ST128 + c8 * 16 + 128) = k1;
            const unsigned qw[8] = {q0.x, q0.y, q0.z, q0.w, q1.x, q1.y, q1.z, q1.w}; unsigned ob[8];
#pragma unroll
            for (int i2 = 0; i2 < 8; ++i2) { const v4f e4 = em[i2 >> 1]; const float ea = (i2 & 1) ? e4.z : e4.x, eb = (i2 & 1) ? e4.w : e4.y; ob[i2] = PK2(bflo(qw[i2]) * ea, bfhi(qw[i2]) * eb); }
            *(LP(v4u))(QB + j * ST128 + c8 * 16) = (v4u){ob[0], ob[1], ob[2], ob[3]}; *(LP(v4u))(QB + j * ST128 + c8 * 16 + 128) = (v4u){ob[4], ob[5], ob[6], ob[7]};
            *(LP(v4u))(VV + j * ST64 + c8 * 16) = vv;
            if (tid < 64) *(LP(v4f))(DV + tid * 4) = dvv;
        }
        if (cidx + 2 < NCHUNK) GLA_ISSUE(cidx + 2, u_);
        if (cidx + 1 < NCHUNK) GLA_ISSUE_V(cidx + 1);
        SYNC();
        v4f oacc[2]; oacc[0] = (v4f){0.f, 0.f, 0.f, 0.f}; oacc[1] = oacc[0];
        {
#pragma unroll
            for (int i = 0; i < 2; ++i) { const int st = vt0 + i; v4f p = (v4f){0.f, 0.f, 0.f, 0.f};
                if (st <= tt) { p = tile_mma(p, QS, ST128, 16 * tt, KS, ST128, 16 * st, 4, fr, fq);
                    if (st == tt) { if (4 * fq + 0 > fr) p.x = 0.f; if (4 * fq + 1 > fr) p.y = 0.f; if (4 * fq + 2 > fr) p.z = 0.f; if (4 * fq + 3 > fr) p.w = 0.f; } }
                *(LP(v2u))(PM + (16 * tt + fr) * ST64 + (16 * st + 4 * fq) * 2) = (v2u){PK2(p.x, p.y), PK2(p.z, p.w)}; }
#pragma unroll
            for (int k = 0; k < 4; ++k) { const v8s af = *(LP(const v8s))(QB + (16 * tt + fr) * ST128 + fq * 16 + k * 64);
#pragma unroll
                for (int i = 0; i < 2; ++i) { const v8s bf = *(LP(const v8s))(STT + (16 * (vt0 + i) + fr) * ST128 + fq * 16 + k * 64); oacc[i] = MFMA16(bf, af, oacc[i]); } }
        }
        SYNC();
#pragma unroll
        for (int k = 0; k < 2; ++k) { const v8s af = *(LP(const v8s))(PM + (16 * tt + fr) * ST64 + fq * 16 + k * 64);
#pragma unroll
            for (int i = 0; i < 2; ++i) { const v8s bf = tr_frag(VV, ST64, 32 * k, 16 * (vt0 + i), lane); oacc[i] = MFMA16(bf, af, oacc[i]); } }
        if (!prb) { const int orow = tok_row(b, seg, ci * 64 + 16 * tt + fr, dir, 0);
#pragma unroll
          for (int i = 0; i < 2; ++i) *(v2u*)(Od + (size_t)orow * 1024 + h * 256 + vs * 64 + 16 * (vt0 + i) + 4 * fq) = (v2u){PK2(oacc[i].x, oacc[i].y), PK2(oacc[i].z, oacc[i].w)}; }
        {
            v4f tmp[4];
#pragma unroll
            for (int i = 0; i < 4; ++i) tmp[i] = (v4f){0.f, 0.f, 0.f, 0.f};
#pragma unroll
            for (int k = 0; k < 2; ++k) { const v8s af = tr_frag(VV, ST64, 32 * k, 16 * svt, lane);
#pragma unroll
                for (int i = 0; i < 4; ++i) { const v8s bf = tr_frag(KS, ST128, 32 * k, 16 * (sdt0 + i), lane); tmp[i] = MFMA16(bf, af, tmp[i]); } }
#pragma unroll
            for (int i = 0; i < 4; ++i) { const v4f ee = *(LP(const v4f))(DV + 16 * (sdt0 + i) + 4 * fq), de = *(LP(const v4f))(DV + 128 + 16 * (sdt0 + i) + 4 * fq);
                sacc[i] = sacc[i] * de + tmp[i] * ee;
                *(LP(v2u))(STT + (16 * svt + fr) * ST128 + (16 * (sdt0 + i) + 4 * fq) * 2) = (v2u){PK2(sacc[i].x, sacc[i].y), PK2(sacc[i].z, sacc[i].w)}; }
        }
        SYNC();
    }
    }
#undef GLA_ISSUE
#undef GLA_ISSUE_V
#ifdef GLA_TOTAL_PROBE
    if (wave == 1) { const unsigned long long acc_ = __builtin_amdgcn_s_memrealtime() - gt0_, t0_ = __builtin_amdgcn_s_memrealtime(); while (__builtin_amdgcn_s_memrealtime() - t0_ < 8ull * acc_) __builtin_amdgcn_s_sleep(8); }
#endif
}

constexpr int MAT_TASKS = NB * 4 * 2 * (CTXL / 64 + SEQ / 64);
template <int MODE>
DEV void mat_prep_loop(int first, int stride, const bf16* Sqk, int ldqk, int qoff, int koff, float kscale, const float* GT, const float* gate_b, float* GP, float* GPK,
                       const float* ret_log_decay, bf16* PP, float* RS, LP(unsigned char) lds, int tid) {
    constexpr int NCHUNK = CTXL / 64 + SEQ / 64;
    const int lane = tid & 63, wave = tid >> 6, fr = lane & 15, fq = lane >> 4;
    LP(unsigned char) Q = lds; LP(unsigned char) K = lds + 33792; LP(float) AS = (LP(float))(lds + 67584); LP(float) R0 = AS + 64; LP(float) DENP = AS + 128; LP(float) W0 = AS + 384;
    const int j = tid >> 3, c8 = tid & 7, dc = c8 * 32;
    v4u rq[4], rk[4]; float gi = 0.f, gf = 0.f;
#define MP_ISSUE(tk) do { const int cx_ = (tk) % NCHUNK, r1_ = (tk) / NCHUNK, dir_ = r1_ & 1, h_ = (r1_ >> 1) & 3, b_ = r1_ >> 3; \
        const int seg_ = cx_ >= CTXL / 64, ci_ = seg_ ? cx_ - CTXL / 64 : cx_; \
        const bf16* s1_ = Sqk + (size_t)tok_row(b_, seg_, ci_ * 64 + j, dir_, 1) * ldqk; \
        _Pragma("unroll") for (int g_ = 0; g_ < 4; ++g_) { rq[g_] = *(const v4u*)(s1_ + qoff + h_ * 256 + c8 * 8 + 64 * g_); rk[g_] = *(const v4u*)(s1_ + koff + h_ * 256 + c8 * 8 + 64 * g_); } \
        if (MODE == 0 && wave == 0) { const int prow_ = tok_row(b_, seg_, ci_ * 64 + lane, dir_, 1); \
            gi = GT[(size_t)prow_ * 256 + 32 + (dir_ * 2 + 0) * 4 + h_]; gf = GT[(size_t)prow_ * 256 + 32 + (dir_ * 2 + 1) * 4 + h_]; } } while (0)
    if (first < MAT_TASKS) MP_ISSUE(first);
    for (int task = first; task < MAT_TASKS; task += stride) {
        const int cidx = task % NCHUNK, r1 = task / NCHUNK, dir = r1 & 1, h = (r1 >> 1) & 3, b = r1 >> 3;
        const int seg = cidx >= CTXL / 64, ci = seg ? cidx - CTXL / 64 : cidx;
#pragma unroll
        for (int g8 = 0; g8 < 4; ++g8) { *(LP(v4u))(Q + j * ST256 + (c8 * 8 + 64 * g8) * 2) = rq[g8]; *(LP(v4u))(K + j * ST256 + (c8 * 8 + 64 * g8) * 2) = rk[g8]; }
        if (wave == 0) {
            if (MODE == 0) {
                const int prow = tok_row(b, seg, ci * 64 + lane, dir, 1);
                const float ig = gi + gate_b[(dir * 2 + 0) * 4 + h];
                float bcum = logsigmoidf(gf + gate_b[(dir * 2 + 1) * 4 + h]);
#pragma unroll
                for (int o = 1; o < 64; o <<= 1) { const float t = SHUP(bcum, o); if (lane >= o) bcum += t; }
                const float a_s = ig - bcum;
                float cm = a_s;
#pragma unroll
                for (int o = 1; o < 64; o <<= 1) { const float t = SHUP(cm, o); if (lane >= o) cm = fmaxf(cm, t); }
                *(v4f*)(GP + ((size_t)prow * 8 + dir * 4 + h) * 4) = (v4f){bcum, a_s, cm, 0.f};
                AS[lane] = a_s; R0[lane] = -cm; W0[lane] = EXPF(a_s - RDLANE(cm, 63));
            } else { const float lg = -expf(ret_log_decay[dir * 4 + h]); AS[lane] = -(float)(lane + 1) * lg; R0[lane] = (float)(lane + 1) * lg; }
        }
        if (task + stride < MAT_TASKS) MP_ISSUE(task + stride);
        SYNC();
        const int tt = wave >> 1;
        bf16* pp = PP + (size_t)task * 4096;
        const float rt = R0[16 * tt + fr];
#pragma unroll
        for (int i = 0; i < 2; ++i) { const int st = (wave & 1) * 2 + i; v4f p = (v4f){0.f, 0.f, 0.f, 0.f};
            if (st <= tt) { p = tile_mma(p, Q, ST256, 16 * tt, K, ST256, 16 * st, 8, fr, fq);
                const v4f as4 = *(LP(const v4f))(AS + 16 * st + 4 * fq);
                p.x *= kscale * EXPF(as4.x + rt); p.y *= kscale * EXPF(as4.y + rt); p.z *= kscale * EXPF(as4.z + rt); p.w *= kscale * EXPF(as4.w + rt);
                if (st == tt) { if (4 * fq + 0 > fr) p.x = 0.f; if (4 * fq + 1 > fr) p.y = 0.f; if (4 * fq + 2 > fr) p.z = 0.f; if (4 * fq + 3 > fr) p.w = 0.f; } }
            *(v2u*)(pp + (16 * tt + fr) * 64 + 16 * st + 4 * fq) = (v2u){PK2(p.x, p.y), PK2(p.z, p.w)};
            if (MODE == 0) { float rs = (p.x + p.y) + (p.z + p.w); rs += SHX(rs, 16); rs += SHX(rs, 32); if (fq == 0) DENP[st * 64 + 16 * tt + fr] = rs; } }
        if (MODE == 0 && tid >= 256) {
            const int d = tid - 256; float kw = 0.f;
            for (int jj = 0; jj < 64; ++jj) kw += __uint_as_float(((unsigned)*(LP(const unsigned short))(K + jj * ST256 + d * 2)) << 16) * W0[jj];
            GPK[(size_t)task * 256 + d] = kw; }
        SYNC();
        if (MODE == 0 && tid < 64) RS[(size_t)task * 64 + tid] = (DENP[tid] + DENP[64 + tid]) + (DENP[128 + tid] + DENP[192 + tid]);
        SYNC();
    }
#undef MP_ISSUE
}

#ifdef SEC_PROBE
#ifndef SEC_WAVE
#define SEC_WAVE 1
#endif
#ifndef SEC_MODE
#define SEC_MODE 0
#endif
#define SECT(s, e) do { if ((s) == SEC_PROBE && MODE == SEC_MODE) { const unsigned long long t_ = __builtin_amdgcn_s_memrealtime(); if (e) sec_acc += t_ - sec_t0; else sec_t0 = t_; } } while (0)
#else
#define SECT(s, e) do {} while (0)
#endif
template <int MODE>
DEV void mat_unit(const bf16* Sqk, int ldqk, int qoff, int koff, const bf16* Sv, int ldv, int voff, float kscale, const float* GP, const float* GPK, const bf16* PP, const float* RS, bf16* O, int store_ctx,
                  const float* ret_log_decay, int unit, LP(unsigned char) lds, int tid, unsigned* sib, int prb = 0) {
    const int lane = tid & 63, wave = tid >> 6, fr = lane & 15, fq = lane >> 4;
    const int vs = unit & 3, dir = (unit >> 2) & 1, h = (unit >> 3) & 3, b = unit >> 5;
    LP(unsigned char) Q = lds; LP(unsigned char) K = lds + 33792;
    LP(unsigned char) VV = lds + 67584; LP(unsigned char) VW = lds + 76800;
    LP(unsigned char) PM = lds + 86016; LP(unsigned char) STT = lds + 95232;
    LP(float) SCAL = (LP(float))(lds + 137472);
    LP(float) NV = SCAL + 768;
    for (int i = tid; i < 80 * ST256 / 4; i += NTHR) ((LP(unsigned))STT)[i] = 0u;
    if (tid < 256) NV[tid] = 0.f;
    v4f sacc[8];
#pragma unroll
    for (int i = 0; i < 8; ++i) sacc[i] = (v4f){0.f, 0.f, 0.f, 0.f};
    const int j = tid >> 3, c8 = tid & 7;
    const int tt = wave >> 1, vt0 = (wave & 1) * 2;
#ifdef SEC_PROBE
    unsigned long long sec_acc = 0ull, sec_t0 = 0ull;
#endif
    float m_st = 0.f;
    float lg = 0.f;
    if (MODE == 1) lg = -expf(ret_log_decay[dir * 4 + h]);
    bf16* Od = O + (size_t)(2 + dir) * TT * 1024;
    constexpr int NCHUNK = CTXL / 64 + SEQ / 64;
    v4u rq[2][4], rk[2][4], rv, rp; v4f gpv = (v4f){0.f, 0.f, 0.f, 0.f}; float kwv[2] = {0.f, 0.f}, rsv = 0.f;
    const int task0 = ((b * 4 + h) * 2 + dir) * NCHUNK;
#define MAT_ISSUE(cx, P_) do { const int seg_ = (cx) >= CTXL / 64, ci_ = seg_ ? (cx) - CTXL / 64 : (cx); \
        const int row_ = PRBROW(tok_row(b, seg_, ci_ * 64 + j, dir, 1)); \
        const bf16* s1_ = Sqk + (size_t)row_ * ldqk; \
        _Pragma("unroll") for (int g_ = 0; g_ < 4; ++g_) { rq[P_][g_] = *(const v4u*)(s1_ + qoff + h * 256 + c8 * 8 + 64 * g_); rk[P_][g_] = *(const v4u*)(s1_ + koff + h * 256 + c8 * 8 + 64 * g_); } \
        if (MODE == 0 && tid < 256) kwv[P_] = GPK[(size_t)(task0 + (cx)) * 256 + tid]; } while (0)
#define MAT_GATE_LOAD(cx) do { if (MODE == 0 && wave == 0) { const int seg_ = (cx) >= CTXL / 64, ci_ = seg_ ? (cx) - CTXL / 64 : (cx); \
        const int prow_ = PRBROW(tok_row(b, seg_, ci_ * 64 + lane, dir, 1)); gpv = *(const v4f*)(GP + ((size_t)prow_ * 8 + dir * 4 + h) * 4); rsv = RS[(size_t)PRBTSK(task0 + (cx)) * 64 + lane]; } } while (0)
#define MAT_GATES(cx) do { if (wave == 0) { LP(float) sc_ = SCAL + ((cx) & 1) * 384; \
        if (MODE == 0) { const float bcum_ = gpv.x, a_s_ = gpv.y, Mt_ = fmaxf(m_st, gpv.z); \
            const float M63_ = RDLANE(Mt_, 63), bend_ = RDLANE(bcum_, 63), cm63_ = RDLANE(gpv.z, 63); const float wp_ = EXPF(gpv.z - Mt_); \
            sc_[lane] = wp_; sc_[64 + lane] = EXPF(m_st - Mt_); sc_[128 + lane] = EXPF(a_s_ - M63_); sc_[192 + lane] = EXPF(-(bcum_ + Mt_)); sc_[256 + lane] = rsv * wp_; \
            if (lane == 0) { sc_[320] = EXPF(m_st - M63_); sc_[321] = EXPF(cm63_ - M63_); } \
            m_st = bend_ + M63_; \
        } else { sc_[lane] = 1.0f; sc_[64 + lane] = EXPF((float)(lane + 1) * lg); sc_[128 + lane] = EXPF((float)(63 - lane) * lg); sc_[192 + lane] = 0.f; sc_[256 + lane] = 0.f; \
            if (lane == 0) { sc_[320] = EXPF(64.f * lg); sc_[321] = 0.f; } } } } while (0)
    static_assert(NCHUNK % 2 == 0, "the chunk loop is unrolled by two");
#define MAT_ISSUE_P(cx) do { const int seg_ = (cx) >= CTXL / 64, ci_ = seg_ ? (cx) - CTXL / 64 : (cx); rp = *(const v4u*)(PP + (size_t)PRBTSK(task0 + (cx)) * 4096 + j * 64 + c8 * 8); \
        rv = *(const v4u*)(Sv + (size_t)PRBROW(tok_row(b, seg_, ci_ * 64 + j, dir, 1)) * ldv + voff + h * 256 + vs * 64 + c8 * 8); } while (0)
    SECT(5, 0);
    MAT_ISSUE(0, 0); MAT_ISSUE(1, 1); MAT_ISSUE_P(0); MAT_GATE_LOAD(0);
    MAT_GATES(0);
    MAT_GATE_LOAD(1);
    SYNC();
#pragma unroll 1
    for (int c2 = 0; c2 < NCHUNK; c2 += 2) {
#pragma unroll
    for (int u_ = 0; u_ < 2; ++u_) {
        const int cidx = c2 + u_;
        const int seg = cidx >= CTXL / 64, ci = seg ? cidx - CTXL / 64 : cidx;
        if (u_ == 0 && (c2 & 3) == 0 && c2 > 0) sibling_sync(sib, (unsigned)(c2 >> 2) * 4u, tid);
        LP(const float) sc = SCAL + u_ * 384;
        const float kw_cur = kwv[u_];
        SECT(6, 0);
#if defined(SEC_PROBE) && SEC_PROBE == 6
        asm volatile("s_waitcnt vmcnt(0)" ::: "memory");
#endif
        SECT(6, 1);
        SECT(1, 0);
        {
            const float wk = sc[128 + j] * kscale;
#pragma unroll
            for (int g8 = 0; g8 < 4; ++g8) { const int d0 = c8 * 8 + 64 * g8;     *(LP(v4u))(Q + j * ST256 + d0 * 2) = rq[u_][g8]; *(LP(v4u))(K + j * ST256 + d0 * 2) = rk[u_][g8]; }
            const v4u rvv = rv;
            *(LP(v4u))(VV + j * ST64 + c8 * 16) = rvv;
            *(LP(v4u))(VW + j * ST64 + c8 * 16) = (v4u){PK2(bflo(rvv.x) * wk, bfhi(rvv.x) * wk), PK2(bflo(rvv.y) * wk, bfhi(rvv.y) * wk), PK2(bflo(rvv.z) * wk, bfhi(rvv.z) * wk), PK2(bflo(rvv.w) * wk, bfhi(rvv.w) * wk)};
            *(LP(v4u))(PM + j * ST64 + c8 * 16) = rp;
#pragma unroll
            for (int i = 0; i < 8; ++i) *(LP(v2u))(STT + (16 * (i >> 1) + fr) * ST256 + (16 * (2 * wave + (i & 1)) + 4 * fq) * 2) = (v2u){PK2(sacc[i].x, sacc[i].y), PK2(sacc[i].z, sacc[i].w)};
        }
        if (cidx + 2 < NCHUNK) MAT_ISSUE(cidx + 2, u_);
        if (cidx + 1 < NCHUNK) MAT_ISSUE_P(cidx + 1);
        SECT(1, 1); SECT(2, 0);
        SYNC();
        SECT(2, 1); SECT(3, 0);
        if (cidx + 1 < NCHUNK) { MAT_GATES(cidx + 1); if (cidx + 2 < NCHUNK) MAT_GATE_LOAD(cidx + 2); }
        v4f oP[2], oI[2]; oP[0] = (v4f){0.f, 0.f, 0.f, 0.f}; oP[1] = oP[0]; oI[0] = oP[0]; oI[1] = oP[0];
        v4f qa = (v4f){0.f, 0.f, 0.f, 0.f};
#pragma unroll 1
        for (int k = 0; k < 8; ++k) { const v8s af = *(LP(const v8s))(Q + (16 * tt + fr) * ST256 + fq * 16 + k * 64);
#pragma unroll
            for (int i = 0; i < 2; ++i) { const v8s bf = *(LP(const v8s))(STT + (16 * (vt0 + i) + fr) * ST256 + fq * 16 + k * 64); oI[i] = MFMA16(bf, af, oI[i]); }
            if (MODE == 0) { const v8s bn = *(LP(const v8s))(STT + (64 + fr) * ST256 + fq * 16 + k * 64); qa = MFMA16(bn, af, qa); } }
#pragma unroll
        for (int k = 0; k < 2; ++k) { const v8s af = *(LP(const v8s))(PM + (16 * tt + fr) * ST64 + fq * 16 + k * 64);
#pragma unroll
            for (int i = 0; i < 2; ++i) { const v8s bf = tr_frag(VV, ST64, 32 * k, 16 * (vt0 + i), lane); oP[i] = MFMA16(bf, af, oP[i]); } }
        { const int t = 16 * tt + fr; const float wp = sc[t], wi = sc[64 + t];
          v4f o0 = oP[0] * wp + oI[0] * wi, o1 = oP[1] * wp + oI[1] * wi;
          if (MODE == 0) { const float qn = RDLANE16(qa.x, fr); const float den = sc[256 + t] + wi * qn; const float dv = 1.0f / fmaxf(fabsf(den), sc[192 + t]); o0 = o0 * dv; o1 = o1 * dv; }
          if ((seg || store_ctx) && !prb) { const int orow = tok_row(b, seg, ci * 64 + t, dir, 1);
              *(v2u*)(Od + (size_t)orow * 1024 + h * 256 + vs * 64 + 16 * vt0 + 4 * fq) = (v2u){PK2(o0.x, o0.y), PK2(o0.z, o0.w)};
              *(v2u*)(Od + (size_t)orow * 1024 + h * 256 + vs * 64 + 16 * (vt0 + 1) + 4 * fq) = (v2u){PK2(o1.x, o1.y), PK2(o1.z, o1.w)}; } }
        const float dcy = sc[320];
        {
#pragma unroll
            for (int i = 0; i < 8; ++i) sacc[i] = sacc[i] * dcy;
#pragma unroll 1
            for (int k = 0; k < 2; ++k) {
                const v8s bf0 = tr_frag(K, ST256, 32 * k, 16 * (2 * wave), lane), bf1 = tr_frag(K, ST256, 32 * k, 16 * (2 * wave + 1), lane);
#pragma unroll
                for (int a4 = 0; a4 < 4; ++a4) { const v8s af = tr_frag(VW, ST64, 32 * k, 16 * a4, lane); sacc[2 * a4] = MFMA16(bf0, af, sacc[2 * a4]); sacc[2 * a4 + 1] = MFMA16(bf1, af, sacc[2 * a4 + 1]); } }
        }
        SECT(3, 1); SECT(4, 0);
        SYNC();
        SECT(4, 1);
        if (MODE == 0 && tid < 256) {
            const float nn = dcy * NV[tid] + sc[321] * kw_cur * kscale; NV[tid] = nn;
            *(LP(unsigned short))(STT + 64 * ST256 + tid * 2) = F2BF(nn); }
    }
    }
#undef MAT_ISSUE
#undef MAT_ISSUE_P
#undef MAT_GATE_LOAD
#undef MAT_GATES
    SYNC();
    SECT(5, 1);
#ifdef SEC_PROBE
    if (MODE == SEC_MODE && (SEC_UNIT < 0 || unit == SEC_UNIT) && wave == SEC_WAVE) { const unsigned long long t0_ = __builtin_amdgcn_s_memrealtime(); while (__builtin_amdgcn_s_memrealtime() - t0_ < 8ull * sec_acc) __builtin_amdgcn_s_sleep(8); }
#endif
}

constexpr int S5_LDS_PER_WAVE = 1280 + 2 * 10240 + 2 * 6144;
DEV void s5_unit(const bf16* S, int ldS, bf16* O, const float* lam_re, const float* lam_im, const float* log_step, const float* b_re, const float* b_im,
                 const float* c_re, const float* c_im, int unit, LP(unsigned char) wl, int lane, int prb = 0) {
    const int fr = lane & 15, fq = lane >> 4;
    const int dir = unit & 1, g = (unit >> 1) & 63, b = unit >> 7;
    LP(unsigned char) UB = wl; LP(unsigned char) XB = wl + 1280; LP(unsigned char) HB = wl + 1280 + 2 * 10240;
    const int pg = (dir * 64 + g);
    const float lr = lam_re[pg * 64 + lane], li = lam_im[pg * 64 + lane], step = expf(log_step[pg]);
    const float mag = expf(lr * step); float sn, cs; sincosf(li * step, &sn, &cs);
    const float ar = mag * cs, ai = mag * sn, den = lr * lr + li * li;
    const float cre = ((ar - 1.0f) * lr + ai * li) / den, cim = (ai * lr - (ar - 1.0f) * li) / den;
    for (int p = 0; p < 16; ++p) { const float br = b_re[(pg * 64 + lane) * 16 + p], bi = b_im[(pg * 64 + lane) * 16 + p];
        *(LP(unsigned short))(XB + lane * 32 + p * 2) = F2BF(cre * br - cim * bi);
        *(LP(unsigned short))(XB + (64 + lane) * 32 + p * 2) = F2BF(cre * bi + cim * br); }
    WAVE_SYNC();
    v8s bfrag[8];
#pragma unroll
    for (int nt = 0; nt < 8; ++nt) { if (fq < 2) bfrag[nt] = *(LP(const v8s))(XB + (16 * nt + fr) * 32 + fq * 16); else bfrag[nt] = (v8s){0, 0, 0, 0, 0, 0, 0, 0}; }
    v8s cfrag[4];
#pragma unroll
    for (int ks = 0; ks < 4; ++ks) { const int n0 = 32 * ks + 8 * fq; const float* src = (n0 < 64 ? c_re : c_im) + ((size_t)pg * 16 + fr) * 64 + (n0 & 63); const float sgn = n0 < 64 ? 1.f : -1.f;
        v8s f;
#pragma unroll
        for (int i = 0; i < 8; ++i) f[i] = (short)F2BF(sgn * src[i]);
        cfrag[ks] = f; }
    WAVE_SYNC();
    for (int i = lane; i < 1280 / 4; i += 64) ((LP(unsigned))UB)[i] = 0u;
    WAVE_SYNC();
    float hr = 0.f, hi = 0.f;
    bf16* Od = O + (size_t)dir * TT * 1024;
    constexpr int NBLK = CTXL / 16 + SEQ / 16;
    constexpr int S5_PF = 8;
    v4u ur[S5_PF];
#pragma unroll
    for (int i_ = 0; i_ < S5_PF; ++i_) ur[i_] = (v4u){0u, 0u, 0u, 0u};
#define S5_LOAD(bx, dst) do { if (lane < 32 && (bx) < NBLK) { const int seg_ = (bx) >= CTXL / 16, bi_ = seg_ ? (bx) - CTXL / 16 : (bx); \
        dst = *(const v4u*)(S + (size_t)PRBROW(tok_row(b, seg_, bi_ * 16 + (lane >> 1), dir, 0)) * ldS + g * 16 + (lane & 1) * 8); } } while (0)
#define S5_STAGE_A(bx) do { const v8s uf_ = *(LP(const v8s))(UB + fr * 80 + fq * 16); LP(unsigned char) xb_ = XB + ((bx) & 1) * 10240; \
        _Pragma("unroll") for (int nt = 0; nt < 8; ++nt) { v4f x = (v4f){0.f, 0.f, 0.f, 0.f}; x = MFMA16(uf_, bfrag[nt], x); *(LP(v4f))(xb_ + (16 * nt + fr) * 80 + fq * 16) = x; } } while (0)
#pragma unroll
    for (int i_ = 0; i_ < S5_PF; ++i_) S5_LOAD(i_, ur[i_]);
    if (lane < 32) *(LP(v4u))(UB + (lane >> 1) * 80 + (lane & 1) * 16) = ur[0];
#pragma unroll
    for (int i_ = 0; i_ + 1 < S5_PF; ++i_) ur[i_] = ur[i_ + 1];
    S5_LOAD(S5_PF, ur[S5_PF - 1]);
    WAVE_SYNC();
    S5_STAGE_A(0);
    static_assert(NBLK % S5_PF == 0, "ring unrolling");
#pragma unroll 1
    for (int bx0 = 0; bx0 <= NBLK; bx0 += S5_PF) {
#pragma unroll
    for (int ui = 0; ui < S5_PF; ++ui) {
        const int bx = bx0 + ui; if (bx > NBLK) break;
        WAVE_SYNC();
        v8s hf[4]; float xr[16], xi[16];
        if (bx >= 1) { LP(unsigned char) hb = HB + ((bx - 1) & 1) * 6144;
#pragma unroll
            for (int ks = 0; ks < 4; ++ks) hf[ks] = tr_frag(hb, 48, 32 * ks, 0, lane); }
        if (bx < NBLK) { LP(unsigned char) xb = XB + (bx & 1) * 10240;
#pragma unroll
            for (int q4 = 0; q4 < 4; ++q4) { const v4f a4 = *(LP(const v4f))(xb + lane * 80 + q4 * 16), b4 = *(LP(const v4f))(xb + (64 + lane) * 80 + q4 * 16);
                xr[4 * q4] = a4.x; xr[4 * q4 + 1] = a4.y; xr[4 * q4 + 2] = a4.z; xr[4 * q4 + 3] = a4.w; xi[4 * q4] = b4.x; xi[4 * q4 + 1] = b4.y; xi[4 * q4 + 2] = b4.z; xi[4 * q4 + 3] = b4.w; } }
        if (bx + 1 < NBLK) { if (lane < 32) *(LP(v4u))(UB + (lane >> 1) * 80 + (lane & 1) * 16) = ur[ui]; S5_LOAD(bx + 1 + S5_PF, ur[ui]); }
        WAVE_SYNC();
        if (bx + 1 < NBLK) S5_STAGE_A(bx + 1);
        if (bx >= 1) { const int pb = bx - 1, seg = pb >= CTXL / 16, bi = seg ? pb - CTXL / 16 : pb;
            if (seg && !prb) { v4f y = (v4f){0.f, 0.f, 0.f, 0.f};
#pragma unroll
                for (int ks = 0; ks < 4; ++ks) y = MFMA16(cfrag[ks], hf[ks], y);
                const int orow = tok_row(b, seg, bi * 16 + fr, dir, 0);
                *(v2u*)(Od + (size_t)orow * 1024 + g * 16 + 4 * fq) = (v2u){PK2(y.x, y.y), PK2(y.z, y.w)}; } }
        if (bx < NBLK) { LP(unsigned char) hb = HB + (bx & 1) * 6144;
            unsigned pr[8], pi[8];
#pragma unroll
            for (int t2 = 0; t2 < 8; ++t2) {
                const float r0 = ar * hr - ai * hi + xr[2 * t2], i0 = ar * hi + ai * hr + xi[2 * t2];
                hr = ar * r0 - ai * i0 + xr[2 * t2 + 1]; hi = ar * i0 + ai * r0 + xi[2 * t2 + 1];
                pr[t2] = PK2(r0, hr); pi[t2] = PK2(i0, hi); }
            *(LP(v4u))(hb + lane * 48) = (v4u){pr[0], pr[1], pr[2], pr[3]}; *(LP(v4u))(hb + lane * 48 + 16) = (v4u){pr[4], pr[5], pr[6], pr[7]};
            *(LP(v4u))(hb + (64 + lane) * 48) = (v4u){pi[0], pi[1], pi[2], pi[3]}; *(LP(v4u))(hb + (64 + lane) * 48 + 16) = (v4u){pi[4], pi[5], pi[6], pi[7]}; }
    }
    }
#undef S5_STAGE_A
#undef S5_LOAD
}

DEV void conv_prep_row(int r, const bf16* S, bf16* QK2, const float* conv_w, const float* conv_b, int lane) {
    int rm, rp; bool hasm, hasp;
    if (r < TL) { const int b = r >> 12, n = r & (SEQ - 1), gr = n >> 6, col = n & 63, np = col * 64 + gr;
        hasm = np > 0; hasp = np < SEQ - 1; rm = seq_row(b, 1, hasm ? np - 1 : np, 1); rp = seq_row(b, 1, hasp ? np + 1 : np, 1); }
    else { const int n = (r - TL) & (CTXL - 1); hasm = n > 0; hasp = n < CTXL - 1; rm = hasm ? r - 1 : r; rp = hasp ? r + 1 : r; }
    const bf16* s0 = S + (size_t)rm * EV_PAD + 3072; const bf16* s1 = S + (size_t)r * EV_PAD + 3072; const bf16* s2 = S + (size_t)rp * EV_PAD + 3072;
#pragma unroll
    for (int i = 0; i < 4; ++i) { const int c = 8 * lane + 512 * i;
        const v4u a0 = *(const v4u*)(s0 + c), a1 = *(const v4u*)(s1 + c), a2 = *(const v4u*)(s2 + c);
        const unsigned w0[4] = {a0.x, a0.y, a0.z, a0.w}, w1[4] = {a1.x, a1.y, a1.z, a1.w}, w2[4] = {a2.x, a2.y, a2.z, a2.w};
        const float sc = c >= 1024 ? 0.0625f : 1.0f;
        float val[8];
#pragma unroll
        for (int i2 = 0; i2 < 4; ++i2)
#pragma unroll
            for (int e = 0; e < 2; ++e) { const int di = 2 * i2 + e;
                const float um = hasm ? (e ? bfhi(w0[i2]) : bflo(w0[i2])) : 0.f, u0 = e ? bfhi(w1[i2]) : bflo(w1[i2]), up = hasp ? (e ? bfhi(w2[i2]) : bflo(w2[i2])) : 0.f;
                const float pre = conv_b[c + di] + conv_w[c + di] * um + conv_w[2048 + c + di] * u0 + conv_w[4096 + c + di] * up;
                val[di] = pre * RCPF(1.0f + EXPF(-pre)) * sc; }
        *(v4u*)(QK2 + (size_t)r * 2048 + c) = (v4u){PK2(val[0], val[1]), PK2(val[2], val[3]), PK2(val[4], val[5]), PK2(val[6], val[7])}; }
}

DEV v4f ld4bf(const bf16* p) { const v2u w = *(const v2u*)p; return (v4f){bflo(w.x), bfhi(w.x), bflo(w.y), bfhi(w.y)}; }
DEV float wsum(float v) {
#pragma unroll
    for (int o = 1; o < 64; o <<= 1) v += SHX(v, o);
    return v;
}
DEV float grp16_sum(float v) { v += SHX(v, 1); v += SHX(v, 2); v += SHX(v, 4); v += SHX(v, 8); return v; }
DEV void ld16bf(const bf16* p, float (&o)[16]) { const v4u a = *(const v4u*)p, b = *(const v4u*)(p + 8); const unsigned w[8] = {a.x, a.y, a.z, a.w, b.x, b.y, b.z, b.w};
#pragma unroll
    for (int i = 0; i < 8; ++i) { o[2 * i] = bflo(w[i]); o[2 * i + 1] = bfhi(w[i]); } }
DEV void ld16f(const float* p, float (&o)[16]) {
#pragma unroll
    for (int i = 0; i < 4; ++i) { const v4f a = *(const v4f*)(p + 4 * i); o[4 * i] = a.x; o[4 * i + 1] = a.y; o[4 * i + 2] = a.z; o[4 * i + 3] = a.w; } }
DEV void st16bf(bf16* p, const float (&o)[16]) { *(v4u*)p = (v4u){PK2(o[0], o[1]), PK2(o[2], o[3]), PK2(o[4], o[5]), PK2(o[6], o[7])}; *(v4u*)(p + 8) = (v4u){PK2(o[8], o[9]), PK2(o[10], o[11]), PK2(o[12], o[13]), PK2(o[14], o[15])}; }
template <int CENTER, int GATE>
DEV void head_norm16(const bf16* o0, const bf16* o1, const float* gain, const bf16* gs, bf16* dst) {
    float a[16], b2[16], g[16], gt[16];
    ld16bf(o0, a); ld16bf(o1, b2); ld16f(gain, g); ld16bf(gs, gt);
    float s = 0.f;
#pragma unroll
    for (int i = 0; i < 16; ++i) { a[i] += b2[i]; s += a[i]; }
    if (CENTER) { const float mean = grp16_sum(s) * (1.0f / 256.0f);
#pragma unroll
        for (int i = 0; i < 16; ++i) a[i] -= mean; }
    float q = 0.f;
#pragma unroll
    for (int i = 0; i < 16; ++i) q += a[i] * a[i];
    const float rstd = RSQRTF(grp16_sum(q) * (1.0f / 256.0f) + EPS);
#pragma unroll
    for (int i = 0; i < 16; ++i) { const float sg = RCPF(1.0f + EXPF(-gt[i])); const float gate = GATE ? sg : gt[i] * sg; a[i] = gate * (a[i] * rstd * g[i]); }
    st16bf(dst, a);
}
DEV void merge_even_row(int r, const bf16* S, const bf16* O, const float* gla_norm, const float* ml_norm, bf16* HBo, int lane) {
    const bf16* sr = S + (size_t)r * EV_PAD; const int c = 16 * lane; const bf16* ob = O + (size_t)r * 1024 + c; const size_t os = (size_t)TT * 1024;
    head_norm16<0, 0>(ob, ob + os, gla_norm + c, sr + 2048 + c, HBo + (size_t)r * D + c);
    head_norm16<1, 1>(ob + 2 * os, ob + 3 * os, ml_norm + c, sr + 6144 + c, HBo + (size_t)r * D + 1024 + c);
}
DEV float gelu_tanh(float y) { const float z = 0.7978845608028654f * (y + 0.044715f * y * y * y); const float t = 1.0f - 2.0f * RCPF(1.0f + EXPF(2.0f * z)); return 0.5f * y * (1.0f + t); }
DEV void merge_odd_row(int r, const bf16* S, const bf16* O, const float* s5_d, const float* ret_norm, bf16* GBo, bf16* HBo, int lane) {
    const bf16* sr = S + (size_t)r * OD_COLS; const int c = 16 * lane; const bf16* ob = O + (size_t)r * 1024 + c; const size_t os = (size_t)TT * 1024;
    {
        float y0[16], y1[16], dd[16], u[16];
        ld16bf(ob, y0); ld16bf(ob + os, y1); ld16f(s5_d + c, dd); ld16bf(sr + c, u);
#pragma unroll
        for (int i = 0; i < 16; ++i) {
#ifdef NO_S5
            y0[i] = 0.f; y1[i] = 0.f;
#endif
            y0[i] = gelu_tanh(y0[i] + y1[i] + dd[i] * u[i]); }
        st16bf(GBo + (size_t)r * 1024 + c, y0);
    }
    head_norm16<1, 0>(ob + 2 * os, ob + 3 * os, ret_norm + c, sr + 4096 + c, HBo + (size_t)r * D + 1024 + c);
}

struct EpiGLU {
    static constexpr bool PERM = true, AFTER_DRAIN = false;
    const bf16* G; const float* bias; bf16* O;
    __device__ __forceinline__ void operator()(const pg8::f32x4 (&acc)[2][2][4][2], const pg8::Unit& u, int wr, int wc, int fr, int fq) const {
        const int row0 = u.pm * 256 + wr * 64 + fr, col0 = u.pn * 256 + wc * 32 + 8 * fq;
#pragma unroll
        for (int ai = 0; ai < 2; ++ai)
#pragma unroll
            for (int m = 0; m < 4; ++m) { const size_t row = (size_t)(row0 + ai * 128 + m * 16);
#pragma unroll
                for (int bj = 0; bj < 2; ++bj) { const int col = col0 + bj * 128;
                    const v4u gw = *(const v4u*)(G + row * 1024 + col); const pg8::f32x4 b0 = *(const pg8::f32x4*)(bias + col), b1 = *(const pg8::f32x4*)(bias + col + 4);
                    const pg8::f32x4 v0 = acc[ai][bj][m][0] + b0, v1 = acc[ai][bj][m][1] + b1;
                    v4u w; w.x = pk2(bflo(gw.x) * fast_sigmoid(v0[0]), bfhi(gw.x) * fast_sigmoid(v0[1])); w.y = pk2(bflo(gw.y) * fast_sigmoid(v0[2]), bfhi(gw.y) * fast_sigmoid(v0[3]));
                    w.z = pk2(bflo(gw.z) * fast_sigmoid(v1[0]), bfhi(gw.z) * fast_sigmoid(v1[1])); w.w = pk2(bflo(gw.w) * fast_sigmoid(v1[2]), bfhi(gw.w) * fast_sigmoid(v1[3]));
                    *(v4u*)(O + row * D + col) = w; } }
    }
};

#ifndef SCAN_REPS
#define SCAN_REPS 1
#endif
__device__ __forceinline__ void mixer_phases(const Args& a, unsigned char* ws, LAS unsigned char* lds, const XcdBarrier& bar, int layer, int G, int gw, int ngw, int tid, int lane, int wave) {
#define HB ((bf16*)wsp(ws, WS_HB))
#define S ((bf16*)wsp(ws, WS_S))
#define GT ((float*)wsp(ws, WS_GT))
#define O ((bf16*)wsp(ws, WS_O))
#define GB ((bf16*)wsp(ws, WS_GB))
#define Y ((bf16*)wsp(ws, WS_Y))
    const int ldS = layer == 0 ? EV_PAD : OD_COLS;
    { pg8::Gemm g{HB, (const bf16*)(wsp(ws, (layer == 0 ? WS_WIN_EV : WS_WIN_OD))), TT, ldS, D}; pg8::StaticOrder So; So.init(TT, ldS, G, (int)blockIdx.x);
      EpiS E{S, ldS, GT, layer == 0 ? 28 : -1};
      pg8::gemm_phase<EpiS, pg8::StaticOrder, true, true>(lds, g, So, E); }
    XBAR();
#define QK2 ((bf16*)wsp(ws, WS_QK2))
#define GP ((float*)wsp(ws, WS_GP))
#define QKS ((bf16*)wsp(ws, WS_QKS))
#define GPK ((float*)wsp(ws, WS_GPK))
#define PP ((bf16*)wsp(ws, WS_PP))
#define RS ((float*)wsp(ws, WS_RS))
#define VEC ((float*)wsp(ws, WS_VEC))
    { int t2 = threadIdx.x; asm volatile("" : "+v"(t2)); tid = t2; lane = t2 & 63; wave = __builtin_amdgcn_readfirstlane(t2 >> 6); gw = blockIdx.x * NWAVES + wave; }
    if (layer == 0) {
#ifndef REP_CONV
#define REP_CONV 1
#endif
#ifndef REP_GPREP
#define REP_GPREP 1
#endif
#pragma unroll 1
        for (int r_ = 0; r_ < REP_CONV; ++r_)
        { const bf16* s_ = S; bf16* qk_ = QK2; const float* cw_ = ARG(16); const float* cb_ = ARG(17); for (int r = gw; r < TT; r += ngw) conv_prep_row(r, s_, qk_, cw_, cb_, lane); }
#pragma unroll 1
        for (int r_ = 0; r_ < REP_GPREP; ++r_)
        { int t2 = threadIdx.x; asm volatile("" : "+v"(t2)); gla_prep_loop((int)blockIdx.x, G, S, GT, ARG(13), ARG(14), QKS, VEC, lds, t2); }
        XBAR();
        { int t2 = threadIdx.x; asm volatile("" : "+v"(t2)); mat_prep_loop<0>((int)blockIdx.x, G, QK2, 2048, 0, 1024, 1.0f, GT, ARG(18), GP, GPK, nullptr, PP, RS, lds, t2); }
        XBAR();
    } else {
        { int t2 = threadIdx.x; asm volatile("" : "+v"(t2)); mat_prep_loop<1>((int)blockIdx.x, G, S, OD_COLS, 1024, 2048, 0.0625f, nullptr, nullptr, nullptr, nullptr, ARG(32), PP, RS, lds, t2); }
        XBAR();
    }
#ifdef PRE_SLEEP
    { const unsigned long long t0_ = __builtin_amdgcn_s_memrealtime(); while (__builtin_amdgcn_s_memrealtime() - t0_ < (unsigned long long)(PRE_SLEEP) * 100ull) __builtin_amdgcn_s_sleep(16); XBAR(); }
#endif
    { int t2 = threadIdx.x; asm volatile("" : "+v"(t2)); tid = t2; lane = t2 & 63; wave = __builtin_amdgcn_readfirstlane(t2 >> 6); }
#ifdef PREREAD
    if (layer == 0) {
        const v4u* p0 = (const v4u*)QKS; const v4u* p1 = (const v4u*)QK2; v4u acc = (v4u){0u, 0u, 0u, 0u};
        const unsigned n0 = 2u * TT * 1024 / 8, n1 = (unsigned)TT * 2048 / 8;
        for (unsigned i = blockIdx.x * NTHR + tid; i < n0; i += (unsigned)G * NTHR) { const v4u v = p0[i]; acc.x ^= v.x; acc.y ^= v.y; acc.z ^= v.z; acc.w ^= v.w; }
        if (PREREAD >= 2) for (unsigned i = blockIdx.x * NTHR + tid; i < n1; i += (unsigned)G * NTHR) { const v4u v = p1[i]; acc.x ^= v.x; acc.y ^= v.y; acc.z ^= v.z; acc.w ^= v.w; }
        if ((acc.x ^ acc.y ^ acc.z ^ acc.w) == 0x9e3779b9u && tid == 511) ((unsigned*)wsp(ws, WS_CTL))[8000] = 1u;
        { int t2 = threadIdx.x; asm volatile("" : "+v"(t2)); tid = t2; lane = t2 & 63; wave = __builtin_amdgcn_readfirstlane(t2 >> 6); }
    }
#endif
#ifdef SCAN_PROBE
#pragma unroll
#else
#pragma unroll 1
#endif
    for (int rep = 0; rep < SCAN_REPS; ++rep) {
#ifdef SCAN_PROBE
    const int prb = rep < SCAN_REPS - 1 ? SCAN_PROBE : 0;
#else
    constexpr int prb = 0;
#endif
#ifndef SIB_LOCKSTEP
#define SIB_LOCKSTEP 0
#endif
#define SIBP(ty, un) ((SIB_LOCKSTEP && G >= 2 * MIX_UNITS && SCAN_REPS == 1) ? (unsigned*)(wsp(ws, WS_CTL) + 16384 + ((ty) * 32 + ((un) >> 2)) * 64) : (unsigned*)nullptr)
#define UNIT_OF(w) (NB == 4 ? (((((w) & 7) * 4 + (((w) >> 3) & 15) / 4) << 2) | ((((w) >> 3) & 15) & 3)) : (w))
    if (layer == 0) {
#ifdef SPLIT_L0
        for (int it = blockIdx.x; it < MIX_UNITS; it += G) gla_unit(S, QKS, VEC, O, UNIT_OF(it), lds, tid, SIBP(0, UNIT_OF(it)), prb);
        XBAR();
        for (int it = blockIdx.x; it < 2 * MIX_UNITS; it += G) if (it >= MIX_UNITS) mat_unit<0>(QK2, 2048, 0, 1024, S, EV_PAD, 5120, 1.0f, GP, GPK, PP, RS, O, 1, nullptr, UNIT_OF(it - MIX_UNITS), lds, tid, SIBP(1, UNIT_OF(it - MIX_UNITS)), prb);
        if (false)
#endif
        for (int it = blockIdx.x; it < 2 * MIX_UNITS; it += G) {
            if (it < MIX_UNITS) {
#ifndef REP_GLA
#define REP_GLA 1
#endif
#pragma unroll 1
                for (int r_ = 0; r_ < REP_GLA; ++r_) gla_unit(S, QKS, VEC, O, UNIT_OF(it), lds, tid, SIBP(0, UNIT_OF(it)), prb);
                if (DEFER == 1 && G >= 2 * MIX_UNITS) convert_tiles(a, ws, 1, (int)blockIdx.x * NWAVES + wave, MIX_UNITS * NWAVES, lane);
            } else {
#ifndef REP_ML
#define REP_ML 1
#endif
#pragma unroll 1
                for (int r_ = 0; r_ < REP_ML; ++r_) mat_unit<0>(QK2, 2048, 0, 1024, S, EV_PAD, 5120, 1.0f, GP, GPK, PP, RS, O, 1, nullptr, UNIT_OF(it - MIX_UNITS), lds, tid, SIBP(1, UNIT_OF(it - MIX_UNITS)), prb);
            }
        }
        if (DEFER == 1 && G < 2 * MIX_UNITS) convert_tiles(a, ws, 1, (int)blockIdx.x * NWAVES + wave, G * NWAVES, lane);
    } else {
        const int s5_first = G >= 2 * MIX_UNITS ? MIX_UNITS : 0, s5_wgs = G - s5_first;
#ifndef REP_RET
#define REP_RET 1
#endif
#ifndef REP_S5
#define REP_S5 1
#endif
#pragma unroll 1
        for (int r_ = 0; r_ < REP_RET; ++r_)
        for (int u = blockIdx.x; u < MIX_UNITS; u += G)
            mat_unit<1>(S, OD_COLS, 1024, 2048, S, OD_COLS, 3072, 0.0625f, nullptr, nullptr, PP, RS, O, 0, ARG(32), UNIT_OF(u), lds, tid, SIBP(2, UNIT_OF(u)), prb);
        if (DEFER == 1 && rep == 0 && (int)blockIdx.x >= s5_first && wave >= 4) convert_tiles(a, ws, 2, ((int)blockIdx.x - s5_first) * 4 + (wave - 4), 4 * s5_wgs, lane);
#pragma unroll 1
        for (int r_ = 0; r_ < REP_S5; ++r_)
        if ((int)blockIdx.x >= s5_first && wave < 4) { for (int su = ((int)blockIdx.x - s5_first) * 4 + wave; su < NB * 128; su += 4 * s5_wgs)
            s5_unit(S, OD_COLS, O, ARG(22), ARG(23), ARG(24), ARG(25), ARG(26), ARG(27), ARG(28), su, lds + wave * S5_LDS_PER_WAVE, lane, prb); }
    }
    }
    XBAR();
    { int t2 = threadIdx.x; asm volatile("" : "+v"(t2)); tid = t2; lane = t2 & 63; wave = __builtin_amdgcn_readfirstlane(t2 >> 6); gw = blockIdx.x * NWAVES + wave; }
#ifndef NO_MERGE
    if (layer == 0) { const bf16* s_ = S; const bf16* o_ = O; const float* n0 = ARG(15); const float* n1 = ARG(19); bf16* hb_ = HB; for (int r = gw; r < TT; r += ngw) merge_even_row(r, s_, o_, n0, n1, hb_, lane); }
    else { const bf16* s_ = S; const bf16* o_ = O; const float* n0 = ARG(29); const float* n1 = ARG(33); bf16* gb_ = GB; bf16* hb_ = HB; for (int r = gw; r < TL; r += ngw) merge_odd_row(r, s_, o_, n0, n1, gb_, hb_, lane); }
#endif
    XBAR();
    const int Mo = layer == 0 ? TT : TL;
    if (layer == 1) {
        pg8::Gemm g{GB, (const bf16*)(wsp(ws, WS_WGLU)), TL, 1024, 1024}; pg8::StaticOrder So; So.init(TL, 1024, G, (int)blockIdx.x);
        EpiGLU E{GB, ARG(31), HB};
        pg8::gemm_phase<EpiGLU, pg8::StaticOrder, true, true>(lds, g, So, E);
        XBAR();
    }
    { pg8::Gemm g{HB, (const bf16*)(wsp(ws, (layer == 0 ? WS_WOUT_EV : WS_WOUT_OD))), Mo, D, D}; pg8::SplitOrder So; So.init(Mo - TL, D, G, (int)blockIdx.x);
      EpiF32 E{Y, (float*)(wsp(ws, WS_YCP))};
      pg8::gemm_phase<EpiF32, pg8::SplitOrder, true, true>(lds, g, So, E); }
    XBAR();
}
#undef HB
#undef S
#undef GT
#undef O
#undef GB
#undef Y
#undef QK2
#undef GP
#undef QKS
#undef GPK
#undef PP
#undef RS
#undef VEC
#undef UNIT_OF
#undef SIBP

#ifndef MIXER_ON
#define MIXER_ON 1
#endif
__global__ void __launch_bounds__(NTHR, 2) fwd(Args a) {
    extern __shared__ __attribute__((aligned(16))) unsigned char lds_raw[];
    LAS unsigned char* lds = (LAS unsigned char*)lds_raw;
    const int tid = threadIdx.x, lane = tid & 63, wave = __builtin_amdgcn_readfirstlane(tid >> 6);
    const int G = gridDim.x, gw = blockIdx.x * NWAVES + wave, ngw = G * NWAVES;
    unsigned char* ws = a.ws;
    if (tid < 16) ((LAS unsigned*)(lds + MISC_OFF))[tid] = 0u;
    __syncthreads();
#ifdef PROBE_A
    if (blockIdx.x == 0 && tid == 0) { volatile LAS unsigned* M_ = (volatile LAS unsigned*)(lds + MISC_OFF); const unsigned lo_ = (unsigned)__builtin_amdgcn_s_memrealtime(); if (PROBE_A == 0) M_[6] = lo_; if (PROBE_B == 0) M_[8] = lo_; }
#endif
    XcdBarrier bar = xcd_barrier_post((unsigned*)(wsp(ws, WS_CTL)), (volatile LAS unsigned*)(lds + MISC_OFF));

#ifdef NAN_POISON
    {
        v4u q = (v4u){0xffffffffu, 0xffffffffu, 0xffffffffu, 0xffffffffu};
        for (int i = tid; i < (MISC_OFF) / 16; i += NTHR) ((LAS v4u*)lds)[i] = q;
        { v4u* p = (v4u*)(wsp(ws, WS_MOD)); const size_t n = (WS_WGU - WS_MOD) / 16; for (size_t i = (size_t)blockIdx.x * NTHR + tid; i < n; i += (size_t)G * NTHR) p[i] = q; }
        { v4u* p = (v4u*)(wsp(ws, WS_XC)); const size_t n = (WS_END - WS_XC) / 16; for (size_t i = (size_t)blockIdx.x * NTHR + tid; i < n; i += (size_t)G * NTHR) p[i] = q; }
        { v4u* p = (v4u*)a.out; const size_t n = (size_t)TL * D * 4 / 16; for (size_t i = (size_t)blockIdx.x * NTHR + tid; i < n; i += (size_t)G * NTHR) p[i] = q; }
        __syncthreads();
        XBAR();
    }
#endif
#define MOD ((float*)wsp(ws, WS_MOD))
#define MODP ((float*)wsp(ws, WS_MODP))
#define HB ((bf16*)wsp(ws, WS_HB))
#define HID ((bf16*)wsp(ws, WS_HID))
#define Y ((bf16*)wsp(ws, WS_Y))
#define XC ((bf16*)wsp(ws, WS_XC))
#define XL ((bf16*)wsp(ws, WS_XL))

#ifndef REP_PRO
#define REP_PRO 1
#endif
#ifndef REP_GU
#define REP_GU 1
#endif
#ifndef REP_DN
#define REP_DN 1
#endif
#pragma unroll 1
    for (int rep_ = 0; rep_ < REP_PRO; ++rep_) {
        __syncthreads();
        LAS float* stab = (LAS float*)(lds + 1024);
        { const float* cin = ARG(1); const float* cctx = ARG(3);
        for (int i = tid; i < 5 * D; i += NTHR) { const int r = i >> 11, k = i & (D - 1); const float c = r < 4 ? cin[r * D + k] : cctx[k]; stab[i] = c / (1.0f + expf(-c)); } }
        __syncthreads();
        for (int it = gw; it < 2 * MOD_KC * 72; it += ngw) {
            const int l = it / (MOD_KC * 72), rem = it % (MOD_KC * 72), kc = rem / 72, jb = rem % 72; constexpr int KCH = D / MOD_KC;
            const float* W = ARG(4) + ((size_t)l * D + kc * KCH) * (NMOD * D) + jb * 256 + lane * 4;
            f32x4 acc[5];
#pragma unroll
            for (int r = 0; r < 5; ++r) acc[r] = (f32x4){0.f, 0.f, 0.f, 0.f};
            for (int k = 0; k < KCH; k += 8) { f32x4 w[8];
#pragma unroll
                for (int i = 0; i < 8; ++i) w[i] = *(const f32x4*)(W + (size_t)(k + i) * (NMOD * D));
#pragma unroll
                for (int i = 0; i < 8; ++i)
#pragma unroll
                    for (int r = 0; r < 5; ++r) acc[r] += stab[r * D + kc * KCH + k + i] * w[i]; }
            { float* modp = MODP;
#pragma unroll
            for (int r = 0; r < 5; ++r) *(f32x4*)(modp + (((size_t)l * MOD_KC + kc) * 5 + r) * (NMOD * D) + jb * 256 + lane * 4) = acc[r]; }
        }
        convert_tiles(a, ws, 0, gw, ngw, lane);
#ifndef DEFER
#define DEFER 1
#endif
        if (!DEFER) { convert_tiles(a, ws, 1, gw, ngw, lane); convert_tiles(a, ws, 2, gw, ngw, lane); }
        { v4u z = (v4u){0u, 0u, 0u, 0u}; v4u* p = (v4u*)(wsp(ws, WS_WIN_EV) + (size_t)EV_COLS * 2048 * 2); const int n16 = (EV_PAD - EV_COLS) * 2048 * 2 / 16;
          for (int i = blockIdx.x * NTHR + tid; i < n16; i += G * NTHR) p[i] = z; }
    }
    XBAR();
    { const float* bmod = ARG(5); const float* modp = MODP; float* modf = MOD;
    for (int i = blockIdx.x * NTHR + tid; i < 2 * 5 * NMOD * D; i += G * NTHR) {
        const int l = i / (5 * NMOD * D), rem = i % (5 * NMOD * D), r = rem / (NMOD * D), j = rem % (NMOD * D);
        float s = bmod[l * (NMOD * D) + j];
        for (int kc = 0; kc < MOD_KC; ++kc) s += modp[(((size_t)l * MOD_KC + kc) * 5 + r) * (NMOD * D) + j];
        modf[i] = s;
    } }
    XBAR();
#ifndef REP_N0
#define REP_N0 1
#endif
#pragma unroll 1
    for (int rep_ = 0; rep_ < REP_N0; ++rep_)
    { NormP p{}; p.xin_lat = ARG(0); p.xin_ctx = ARG(2); p.xin_f32 = 1; p.xout_f32 = 0; p.xout_lat = XL; p.xout_ctx = XC; p.y = nullptr; p.h = HB; p.rows_end = TT; p.has_y = 0; p.has_h = 1; p.w = 0.f; p.lp = 0; p.sp = 0; p.ln = 0; p.sn = 0;
      norm_phase(p, MOD, ARG(6), ARG(7), lds, gw, ngw, tid, lane); }
    XBAR();

#pragma unroll 1
    for (int layer = 0; layer < 2; ++layer) {
#pragma unroll 1
        for (int half = 0; half < 2; ++half) {
            const int Mrows = (layer == 1 && half == 1) ? TL : TT;
#if MIXER_ON
            if (half == 1) {
                mixer_phases(a, ws, lds, bar, layer, G, gw, ngw, tid, lane, wave);
                NormP p{}; p.xin_lat = XL; p.xin_ctx = XC; p.xin_f32 = 0; p.xout_f32 = 0; p.xout_lat = XL; p.xout_ctx = XC; p.y = Y; p.y_ctx = (const float*)(wsp(ws, WS_YCP)); p.h = HB; p.rows_end = Mrows; p.has_y = 1; p.has_h = 1; p.w = 1.0f; p.lp = layer; p.sp = 1; p.ln = layer; p.sn = 2;
                norm_phase(p, MOD, ARG(6), ARG(7), lds, gw, ngw, tid, lane);
                XBAR();
            }
#endif
            const int sub = half * 2;
#pragma unroll 1
            for (int rep_ = 0; rep_ < REP_GU; ++rep_) { pg8::Gemm g{HB, (const bf16*)(wsp(ws, WS_WGU) + (size_t)(layer * 2 + half) * SZ_WGU), Mrows, 2 * DFF, D}; pg8::StaticOrder S; S.init(Mrows, 2 * DFF, G, (int)blockIdx.x);
              EpiSwiGLU E{HID, DFF};
              pg8::gemm_phase<EpiSwiGLU, pg8::StaticOrder, true, true>(lds, g, S, E);
              if (DEFER == 2 && rep_ == 0 && !(layer == 1 && half == 1)) {
                  const int rem = ((Mrows / 256) * (2 * DFF / 256)) % G, nidle = rem ? G - rem : G, me = rem ? (int)blockIdx.x - rem : (int)blockIdx.x;
                  if (me >= 0) { int t2 = threadIdx.x; asm volatile("" : "+v"(t2)); convert_tiles(a, ws, layer * 2 + half + 1, me * NWAVES + __builtin_amdgcn_readfirstlane(t2 >> 6), nidle * NWAVES, t2 & 63); } }
              if (rep_ + 1 < REP_GU) XBAR(); }
            XBAR();
#pragma unroll 1
            for (int rep_ = 0; rep_ < REP_DN; ++rep_) { pg8::Gemm g{HID, (const bf16*)(wsp(ws, WS_WD) + (size_t)(layer * 2 + half) * SZ_WD), Mrows, D, DFF}; pg8::SplitOrder S; S.init(Mrows - TL, DFF, G, (int)blockIdx.x);
              EpiF32 E{Y, (float*)(wsp(ws, WS_YCP))};
              pg8::gemm_phase<EpiF32, pg8::SplitOrder, true, true>(lds, g, S, E);
              if (rep_ + 1 < REP_DN) XBAR(); }
            XBAR();
            { NormP p{}; const bool first = (layer == 0 && half == 0);
              const bool lastp = (layer == 1 && half == 1);
              p.xin_lat = first ? (const void*)ARG(0) : (const void*)XL; p.xin_ctx = first ? (const void*)ARG(2) : (const void*)XC; p.xin_f32 = first ? 1 : 0;
              p.xout_lat = lastp ? (void*)a.out : (void*)XL; p.xout_ctx = XC; p.xout_f32 = lastp ? 1 : 0; p.y = Y; p.y_ctx = (const float*)(wsp(ws, WS_YCP)); p.h = HB; p.rows_end = Mrows; p.has_y = 1; p.w = 0.5f; p.lp = layer; p.sp = sub;
              if (half == 0) { p.has_h = 1; p.ln = layer; p.sn = MIXER_ON ? 1 : 2; }
              else if (layer == 0) { p.has_h = 1; p.ln = 1; p.sn = 0; }
              else { p.has_h = 0; p.ln = 0; p.sn = 0; }
              norm_phase(p, MOD, ARG(6), ARG(7), lds, gw, ngw, tid, lane); }
            if (!(layer == 1 && half == 1)) XBAR();
        }
    }
#ifdef PROBE_A
    XBAR();
    if (blockIdx.x == 0 && threadIdx.x == 0) { volatile LAS unsigned* M_ = (volatile LAS unsigned*)(lds + MISC_OFF);
        const unsigned ticks = (M_[7] - M_[6]) + (PROBE_B >= 0 ? (M_[9] - M_[8]) : 0u);
        const unsigned long long t0 = __builtin_amdgcn_s_memrealtime();
        while (__builtin_amdgcn_s_memrealtime() - t0 < 8ull * ticks) __builtin_amdgcn_s_sleep(8); }
#endif
}

#undef MOD
#undef MODP
#undef HB
#undef HID
#undef Y
#undef XC
#undef XL
extern "C" void kernel_launch(void* const* d_in, const int* in_sizes, int n_in, void* d_out, int out_size, void* d_ws, size_t ws_size, hipStream_t stream) {
    static int grid = 0;
    if (grid == 0) {
        if (n_in != 34 || out_size != TL * D || ws_size < WS_END) { fprintf(stderr, "kernel_launch: unexpected shapes (n_in %d out %d ws %zu need %zu)\n", n_in, out_size, ws_size, (size_t)WS_END); grid = -1; return; }
        int dev = 0, cus = 0, per_cu = 0;
        if (hipGetDevice(&dev) != hipSuccess || hipDeviceGetAttribute(&cus, hipDeviceAttributeMultiprocessorCount, dev) != hipSuccess) { grid = -1; return; }
        if (hipFuncSetAttribute((const void*)fwd, hipFuncAttributeMaxDynamicSharedMemorySize, LDS_BYTES) != hipSuccess) { fprintf(stderr, "kernel_launch: hipFuncSetAttribute failed\n"); grid = -1; return; }
        if (hipOccupancyMaxActiveBlocksPerMultiprocessor(&per_cu, (const void*)fwd, NTHR, LDS_BYTES) != hipSuccess || per_cu < 1) { fprintf(stderr, "kernel_launch: occupancy query says %d\n", per_cu); }
        (void)hipGetLastError();
        grid = cus;
    }
    if (grid < 0) return;
    if (hipMemsetAsync((char*)d_ws + WS_CTL, 0, CTL_ZERO_BYTES, stream) != hipSuccess) return;
    Args a{};
    for (int i = 0; i < 34; ++i) a.in[i] = (const float*)d_in[i];
    a.out = (float*)d_out; a.ws = (unsigned char*)d_ws;
    hipLaunchKernelGGL(fwd, dim3(grid), dim3(NTHR), LDS_BYTES, stream, a);
}
```

```cpp
#include <hip/hip_runtime.h>
#include <cstdio>
#include <cstdint>
#define MIXER_ON 1

#define XB_TMO      128
#define XB_XCNT(j)  (256  + 64 * (j))
#define XB_XSUB(j)  (1280 + 64 * (j))
#define XB_XGEN(j)  (2304 + 64 * (j))
#define XB_TOP      3328
#define XB_TOPGEN   3392
#define XCD_BAR_WORDS 3456
#define XB_SPIN_CAP (1u << 18)
#define LAS __attribute__((address_space(3)))

__device__ __forceinline__ unsigned xb_ld(unsigned* p)              { return __hip_atomic_load(p, __ATOMIC_RELAXED, __HIP_MEMORY_SCOPE_AGENT); }
__device__ __forceinline__ unsigned xb_add(unsigned* p, unsigned v) { return __hip_atomic_fetch_add(p, v, __ATOMIC_RELAXED, __HIP_MEMORY_SCOPE_AGENT); }
__device__ __forceinline__ unsigned xb_xcc_id() { return (unsigned)__builtin_amdgcn_s_getreg((3 << 11) | 20) & 0xFu; }
#define XB_SPIN(cond, bar) do { unsigned _sp = 0; while (cond) { __builtin_amdgcn_s_sleep(1); \
    if ((++_sp & 255u) == 0u) { if (xb_ld(&(bar)[XB_TMO])) break; if (_sp > XB_SPIN_CAP) { atomicAdd(&(bar)[XB_TMO], 1u); break; } } } } while (0)

struct XcdBarrier {
    unsigned* bar; unsigned x;
    volatile LAS unsigned* st;
};

__device__ __forceinline__ XcdBarrier xcd_barrier_post(unsigned* bar, volatile LAS unsigned* st) {
    XcdBarrier b; b.bar = bar; b.x = xb_xcc_id(); b.st = st;
    if (threadIdx.x == 0) (void)xb_add(&bar[XB_XCNT(b.x)], 1u);
    return b;
}
__device__ __forceinline__ void xcd_barrier_complete(unsigned* bar, unsigned x, unsigned& nloc, unsigned& nx) {
    const unsigned G = gridDim.x * gridDim.y * gridDim.z;
    unsigned sum, cnt, mine, sp = 0u;
    for (;;) {
        sum = 0u; cnt = 0u; mine = 0u;
#pragma unroll
        for (unsigned j = 0; j < 16; ++j) { const unsigned c = xb_ld(&bar[XB_XCNT(j)]); sum += c; cnt += (c > 0u) ? 1u : 0u; mine = (j == x) ? c : mine; }
        if (sum == G) break;
        __builtin_amdgcn_s_sleep(1);
        if ((++sp & 255u) == 0u) { if (xb_ld(&bar[XB_TMO])) break; if (sp > XB_SPIN_CAP) { atomicAdd(&bar[XB_TMO], 1u); break; } }
    }
    nloc = mine > 0u ? mine : 1u; nx = cnt > 0u ? cnt : 1u;
}

__device__ __forceinline__ void xcd_barrier(const XcdBarrier& b) {
    asm volatile("s_waitcnt vmcnt(0)" ::: "memory");
    __syncthreads();
    if (threadIdx.x == 0) {
        unsigned* bar = b.bar;
        unsigned bx = __builtin_amdgcn_readfirstlane(b.x); asm volatile("" : "+s"(bx));
        __builtin_amdgcn_s_waitcnt(0);
        unsigned nloc = b.st[0], nx = b.st[1];
        if (nloc == 0u) { xcd_barrier_complete(bar, bx, nloc, nx); b.st[0] = nloc; b.st[1] = nx; }
        const unsigned old = xb_add(&bar[XB_XSUB(bx)], 1u);
        const unsigned gen = old / nloc;
        if (old + 1u == (gen + 1u) * nloc) {
            __builtin_amdgcn_fence(__ATOMIC_RELEASE, "agent");
            asm volatile("s_waitcnt vmcnt(0)" ::: "memory");
            const unsigned og = xb_add(&bar[XB_TOP], 1u);
            const unsigned tg = og / nx;
            if (og + 1u == (tg + 1u) * nx) xb_add(&bar[XB_TOPGEN], 1u);
            else XB_SPIN(xb_ld(&bar[XB_TOPGEN]) == tg, bar);
            __builtin_amdgcn_fence(__ATOMIC_ACQUIRE, "agent");
            xb_add(&bar[XB_XGEN(bx)], 1u);
            asm volatile("s_waitcnt vmcnt(0)" ::: "memory");
        } else {
            XB_SPIN(xb_ld(&bar[XB_XGEN(bx)]) == gen, bar);
            __builtin_amdgcn_fence(__ATOMIC_ACQUIRE, "agent");
            asm volatile("s_waitcnt vmcnt(0)" ::: "memory");
        }
    }
    __syncthreads();
}

namespace pg8 {
#define PG8_LAS __attribute__((address_space(3)))
typedef unsigned short bf16_t;
typedef short bf16x8 __attribute__((ext_vector_type(8)));
typedef float f32x4 __attribute__((ext_vector_type(4)));
typedef unsigned u32x4 __attribute__((ext_vector_type(4)));
constexpr int BM = 256, BK = 64, HALF = 128, HTB = HALF * BK * 2  , STAGE_BYTES = 8 * HTB, NXCD = 8, WGM = 8;

__host__ __device__ __forceinline__ int lds_byte(int r, int c) { const int st = (r >> 4) * 2 + (c >> 5), rr = r & 15, cc = c & 31, ob = rr * 64 + cc * 2; return st * 1024 + (ob ^ (((ob >> 9) & 1) << 5)); }
__host__ __device__ __forceinline__ void stage_rc(int b, int& R, int& C) { const int st = b / 1024, sb = b % 1024, swz = sb ^ (((sb >> 9) & 1) << 5); R = (st >> 1) * 16 + swz / 64; C = (st & 1) * 32 + (swz % 64) / 2; }
__host__ __device__ __forceinline__ int perm32(int rho) { const int n = rho >> 4, i = rho & 15; return 8 * (i >> 2) + 4 * n + (i & 3); }

struct Unit { int pm, pn, k0, nt, part; };
struct Gemm { const bf16_t* A; const bf16_t* Bt; int M, N, K; };

struct StaticOrder {
    int nM, nN, nwg, G, c;
    __host__ __device__ void init(int M, int N, int G_, int c_) { nM = M / BM; nN = N / BM; nwg = nM * nN; G = G_; c = c_; }
    __host__ __device__ bool next(int i, Unit& u) const {
        const long L = (long)i * G + c; if (L >= nwg) return false;
        int wgid = (int)L; { const int q = nwg / NXCD, r = nwg % NXCD, xcd = wgid % NXCD, off = wgid / NXCD; wgid = (xcd < r ? xcd * (q + 1) : r * (q + 1) + (xcd - r) * q) + off; }
        const int nig = WGM * nN, gid = wgid / nig, fm = gid * WGM, gsz = (nM - fm) < WGM ? (nM - fm) : WGM;
        u.pm = fm + ((wgid % nig) % gsz); u.pn = (wgid % nig) / gsz; u.k0 = 0; u.nt = 0; u.part = -1; return true;
    }
    __device__ __forceinline__ void a_ready(const Unit&) const {}
    __device__ __forceinline__ void done(const Unit&) const {}
};
struct SplitOrder {
    static constexpr int NMF = 64, NN = 8, PARTS = 8, NFULL = NMF * NN;
    int nsplit, ntK, G, c;
    __host__ __device__ void init(int Msplit, int K, int G_, int c_) { nsplit = (Msplit / BM) * NN * PARTS; ntK = K / BK; G = G_; c = c_; }
    __host__ __device__ bool next(int i, Unit& u) const {
        const int L = i * G + c, p = L - NFULL; const bool fullu = L < NFULL;
        const int wgid = (L % NXCD) * (NFULL / NXCD) + L / NXCD, nig = WGM * NN, fm = (wgid / nig) * WGM;
        const int q = p & 7, cu = p >> 3, h = ntK >> 1, ks = ((h * q) >> 3) << 1, ke = ((h * (q + 1)) >> 3) << 1;
        u.pm = fullu ? fm + ((wgid % nig) % WGM) : NMF + (cu >> 3);
        u.pn = fullu ? (wgid % nig) / WGM : (cu & 7);
        u.k0 = fullu ? 0 : ks; u.nt = fullu ? 0 : ke - ks; u.part = fullu ? -1 : q;
        return fullu || p < nsplit;
    }
    __device__ __forceinline__ void a_ready(const Unit&) const {}
    __device__ __forceinline__ void done(const Unit&) const {}
};
__device__ __forceinline__ unsigned cvt_pk_bf16(float lo, float hi) { unsigned r; asm volatile("v_cvt_pk_bf16_f32 %0, %1, %2" : "=v"(r) : "v"(lo), "v"(hi)); return r; }
template <class Epi, class Sched, bool ALIGN_EPI = false, bool SP2 = false>
__device__ __forceinline__ void gemm_phase(PG8_LAS unsigned char* lds, const Gemm g, const Sched& S, const Epi& E) {
    int tid_ = threadIdx.x; asm volatile("" : "+v"(tid_));
    const int tid = tid_, wid = __builtin_amdgcn_readfirstlane(tid >> 6), lane = tid & 63, wr = wid >> 2, wc = wid & 3, fr = lane & 15, fq = lane >> 4;
    const int K = g.K, nt = K / BK;
    unsigned voffA[2], voffB[2];
#pragma unroll
    for (int i = 0; i < 2; ++i) { int R, C; stage_rc(tid * 16 + i * 8192, R, C); const int Rb = Epi::PERM ? ((R & ~31) + perm32(R & 31)) : R;
        voffA[i] = (unsigned)(R * K + C) * 2u; voffB[i] = (unsigned)(Rb * K + C) * 2u; }
    const unsigned kstep = BK * 2;
    const unsigned hstep = (unsigned)HALF * K * 2;
    const unsigned tstep = 2 * hstep;
    const unsigned ldsw = (unsigned)wid * 1024u;
    const int aoff = lds_byte(wr * 64 + fr, fq * 8), boff = lds_byte(wc * 32 + fr, fq * 8);
#define PG8_SA(b, h) (((b) * 2 + (h)) * HTB)
#define PG8_SB(b, h) ((4 + (b) * 2 + (h)) * HTB)
#define PG8_STAGE(bufoff, gbase, voff) do { _Pragma("unroll") for (int _i = 0; _i < 2; ++_i) \
        __builtin_amdgcn_global_load_lds((const unsigned*)((const char*)(gbase) + (voff)[_i]), (PG8_LAS unsigned*)(lds + (bufoff) + ldsw + _i * 8192), 16, 0, 0); } while (0)
#define PG8_LDA(dst, b, h) do { _Pragma("unroll") for (int m = 0; m < 4; ++m) _Pragma("unroll") for (int k = 0; k < 2; ++k) dst[m][k] = *(const PG8_LAS bf16x8*)(lds + PG8_SA(b, h) + aoff + m * 2048 + k * 1024); } while (0)
#define PG8_LDB(dst, b, h) do { _Pragma("unroll") for (int n = 0; n < 2; ++n) _Pragma("unroll") for (int k = 0; k < 2; ++k) dst[n][k] = *(const PG8_LAS bf16x8*)(lds + PG8_SB(b, h) + boff + n * 2048 + k * 1024); } while (0)
#define PG8_MMA(ai, bj, At, Bt) do { __builtin_amdgcn_s_setprio(1); _Pragma("unroll") for (int m = 0; m < 4; ++m) _Pragma("unroll") for (int n = 0; n < 2; ++n) _Pragma("unroll") for (int k = 0; k < 2; ++k) \
        acc[ai][bj][m][n] = __builtin_amdgcn_mfma_f32_16x16x32_bf16(Bt[n][k], At[m][k], acc[ai][bj][m][n], 0, 0, 0); __builtin_amdgcn_s_setprio(0); } while (0)
#define PG8_WAIT_V(n) asm volatile("s_waitcnt vmcnt(" #n ")" ::: "memory")
#define PG8_WAIT_L(n) asm volatile("s_waitcnt lgkmcnt(" #n ")" ::: "memory")
#define PG8_BAR __builtin_amdgcn_s_barrier()
#define PG8_SCHED __builtin_amdgcn_sched_barrier(0)
    Unit cur, nxt; int ui = 0;
    if (!S.next(0, cur)) return;
    f32x4 acc[2][2][4][2];
#pragma unroll
    for (int a = 0; a < 2; ++a)
#pragma unroll
        for (int b = 0; b < 2; ++b)
#pragma unroll
            for (int m = 0; m < 4; ++m)
#pragma unroll
                for (int n = 0; n < 2; ++n) acc[a][b][m][n] = (f32x4){0.f, 0.f, 0.f, 0.f};
    bf16x8 At[4][2], B0[2][2], B1[2][2];
    unsigned cA = (unsigned)cur.pm * tstep + (unsigned)cur.k0 * kstep, cB = (unsigned)cur.pn * tstep + (unsigned)cur.k0 * kstep;
    S.a_ready(cur);
    if constexpr (SP2) {
        PG8_STAGE(PG8_SB(0, 0), (const char*)g.Bt + (size_t)(cB), voffB); PG8_STAGE(PG8_SB(0, 1), (const char*)g.Bt + (size_t)(cB + hstep), voffB); PG8_STAGE(PG8_SA(0, 0), (const char*)g.A + (size_t)(cA), voffA); PG8_STAGE(PG8_SA(0, 1), (const char*)g.A + (size_t)(cA + hstep), voffA);
        if (wr == 1) PG8_BAR;
        PG8_WAIT_V(2); PG8_BAR;
        PG8_STAGE(PG8_SB(1, 0), (const char*)g.Bt + (size_t)(cB + kstep), voffB); PG8_STAGE(PG8_SA(1, 0), (const char*)g.A + (size_t)(cA + kstep), voffA); PG8_STAGE(PG8_SB(1, 1), (const char*)g.Bt + (size_t)(cB + hstep + kstep), voffB);
        PG8_WAIT_V(6); PG8_BAR;
    } else {
        PG8_STAGE(PG8_SB(0, 0), (const char*)g.Bt + (size_t)(cB), voffB); PG8_STAGE(PG8_SA(0, 0), (const char*)g.A + (size_t)(cA), voffA); PG8_STAGE(PG8_SB(0, 1), (const char*)g.Bt + (size_t)(cB + hstep), voffB); PG8_STAGE(PG8_SA(0, 1), (const char*)g.A + (size_t)(cA + hstep), voffA);
        if (wr == 1) PG8_BAR;
        PG8_WAIT_V(4); PG8_BAR;
        PG8_STAGE(PG8_SB(1, 0), (const char*)g.Bt + (size_t)(cB + kstep), voffB); PG8_STAGE(PG8_SA(1, 0), (const char*)g.A + (size_t)(cA + kstep), voffA); PG8_STAGE(PG8_SB(1, 1), (const char*)g.Bt + (size_t)(cB + hstep + kstep), voffB);
        PG8_WAIT_V(6); PG8_BAR;
    }
    for (;;) {
        const bool has_next = S.next(ui + 1, nxt);
        const unsigned nA = has_next ? (unsigned)nxt.pm * tstep + (unsigned)nxt.k0 * kstep : cA, nB = has_next ? (unsigned)nxt.pn * tstep + (unsigned)nxt.k0 * kstep : cB;
        const int unt = cur.nt ? cur.nt : nt;
        for (int t = 0; t < unt; t += 2) {
            const bool last = (t == unt - 2);
            const unsigned a1 = cA + (unsigned)(t + 1) * kstep;
            const unsigned a2 = last ? nA : cA + (unsigned)(t + 2) * kstep, b2 = last ? nB : cB + (unsigned)(t + 2) * kstep;
            const unsigned a3 = a2 + kstep, b3 = b2 + kstep;
            if (last && has_next) S.a_ready(nxt);
            if constexpr (SP2) {
            PG8_LDB(B0, 0, 0); PG8_LDB(B1, 0, 1); PG8_SCHED; PG8_LDA(At, 0, 0); PG8_STAGE(PG8_SA(1, 1), (const char*)g.A + (size_t)(a1 + hstep), voffA);
            PG8_WAIT_V(8); PG8_WAIT_L(0); PG8_BAR; PG8_MMA(0, 0, At, B0); PG8_MMA(0, 1, At, B1); PG8_BAR; PG8_SCHED;
            PG8_LDA(At, 0, 1); PG8_STAGE(PG8_SB(0, 0), (const char*)g.Bt + (size_t)(b2), voffB); PG8_STAGE(PG8_SB(0, 1), (const char*)g.Bt + (size_t)(b2 + hstep), voffB); PG8_STAGE(PG8_SA(0, 0), (const char*)g.A + (size_t)(a2), voffA);
            PG8_WAIT_V(8); PG8_WAIT_L(0); PG8_BAR; PG8_MMA(1, 0, At, B0); PG8_MMA(1, 1, At, B1); PG8_BAR; PG8_SCHED;
            PG8_LDB(B0, 1, 0); PG8_LDB(B1, 1, 1); PG8_SCHED; PG8_LDA(At, 1, 0); PG8_STAGE(PG8_SA(0, 1), (const char*)g.A + (size_t)(a2 + hstep), voffA);
            PG8_WAIT_V(8); PG8_WAIT_L(0); PG8_BAR; PG8_MMA(0, 0, At, B0); PG8_MMA(0, 1, At, B1); PG8_BAR; PG8_SCHED;
            PG8_LDA(At, 1, 1); PG8_STAGE(PG8_SB(1, 0), (const char*)g.Bt + (size_t)(b3), voffB); PG8_STAGE(PG8_SB(1, 1), (const char*)g.Bt + (size_t)(b3 + hstep), voffB); PG8_STAGE(PG8_SA(1, 0), (const char*)g.A + (size_t)(a3), voffA);
            PG8_WAIT_V(8); PG8_WAIT_L(0); PG8_BAR; PG8_MMA(1, 0, At, B0); PG8_MMA(1, 1, At, B1); PG8_BAR; PG8_SCHED;
            } else {
            PG8_LDB(B0, 0, 0); PG8_SCHED; PG8_LDA(At, 0, 0); PG8_STAGE(PG8_SA(1, 1), (const char*)g.A + (size_t)(a1 + hstep), voffA);
            PG8_WAIT_L(8); PG8_BAR; PG8_WAIT_L(0); PG8_MMA(0, 0, At, B0); PG8_BAR; PG8_SCHED;
            PG8_LDB(B1, 0, 1); PG8_STAGE(PG8_SB(0, 0), (const char*)g.Bt + (size_t)(b2), voffB);
            PG8_BAR; PG8_WAIT_L(0); PG8_MMA(0, 1, At, B1); PG8_BAR;
            PG8_LDA(At, 0, 1); PG8_STAGE(PG8_SA(0, 0), (const char*)g.A + (size_t)(a2), voffA);
            PG8_BAR; PG8_WAIT_L(0); PG8_MMA(1, 0, At, B0); PG8_BAR; PG8_SCHED;
            PG8_STAGE(PG8_SB(0, 1), (const char*)g.Bt + (size_t)(b2 + hstep), voffB);
            PG8_WAIT_V(6); PG8_BAR; PG8_MMA(1, 1, At, B1); PG8_BAR;
            PG8_LDB(B0, 1, 0); PG8_SCHED; PG8_LDA(At, 1, 0); PG8_STAGE(PG8_SA(0, 1), (const char*)g.A + (size_t)(a2 + hstep), voffA);
            PG8_WAIT_L(8); PG8_BAR; PG8_WAIT_L(0); PG8_MMA(0, 0, At, B0); PG8_BAR; PG8_SCHED;
            PG8_LDB(B1, 1, 1); PG8_STAGE(PG8_SB(1, 0), (const char*)g.Bt + (size_t)(b3), voffB);
            PG8_BAR; PG8_WAIT_L(0); PG8_MMA(0, 1, At, B1); PG8_BAR;
            PG8_LDA(At, 1, 1); PG8_STAGE(PG8_SA(1, 0), (const char*)g.A + (size_t)(a3), voffA);
            PG8_BAR; PG8_WAIT_L(0); PG8_MMA(1, 0, At, B0); PG8_BAR; PG8_SCHED;
            PG8_STAGE(PG8_SB(1, 1), (const char*)g.Bt + (size_t)(b3 + hstep), voffB);
            PG8_WAIT_V(6); PG8_BAR; PG8_MMA(1, 1, At, B1); PG8_BAR;
            }
        }
        if constexpr (ALIGN_EPI) { if (wr == 0) PG8_BAR; }
        if constexpr (!Epi::AFTER_DRAIN) { int t_ = threadIdx.x; asm volatile("" : "+v"(t_)); const int l_ = t_ & 63, w_ = __builtin_amdgcn_readfirstlane(t_ >> 6);
            E(acc, cur, w_ >> 2, w_ & 3, l_ & 15, l_ >> 4); S.done(cur); }
        if (!has_next) break;
#pragma unroll
        for (int a = 0; a < 2; ++a)
#pragma unroll
            for (int b = 0; b < 2; ++b)
#pragma unroll
                for (int m = 0; m < 4; ++m)
#pragma unroll
                    for (int n = 0; n < 2; ++n) acc[a][b][m][n] = (f32x4){0.f, 0.f, 0.f, 0.f};
        cur = nxt; cA = nA; cB = nB; ++ui;
        if constexpr (ALIGN_EPI) { if (wr == 1) PG8_BAR; }
    }
    PG8_WAIT_V(0);
    if constexpr (!ALIGN_EPI) { if (wr == 0) PG8_BAR; }
    PG8_BAR;
    if constexpr (Epi::AFTER_DRAIN) { E.fused(acc, cur, wr, wc, fr, fq, lds, wid, lane); S.done(cur); }
#undef PG8_SA
#undef PG8_SB
#undef PG8_STAGE
#undef PG8_LDA
#undef PG8_LDB
#undef PG8_MMA
#undef PG8_WAIT_V
#undef PG8_WAIT_L
#undef PG8_BAR
#undef PG8_SCHED
}
}

#define GAS __attribute__((address_space(1)))
typedef unsigned short bf16;
typedef float f32x4 __attribute__((ext_vector_type(4)));
typedef unsigned v4u __attribute__((ext_vector_type(4)));
typedef unsigned v2u __attribute__((ext_vector_type(2)));
constexpr int D = 2048, NB = 4, SEQ = 4096, CTXL = 256, DFF = 5504, NMOD = 9;
constexpr int TL = NB * SEQ, TC = NB * CTXL, TT = TL + TC;
constexpr int MIXH = 1024;
constexpr int EV_COLS = 7216, EV_PAD = 7424, OD_COLS = 5120;
constexpr int NWAVES = 8, NTHR = 512;
constexpr float EPS = 1e-6f;

constexpr size_t MiB = 1u << 20;
constexpr size_t WS_CTL = 0, CTL_ZERO_BYTES = 64 * 1024;
constexpr size_t WS_MOD = 1 * MiB;
constexpr size_t WS_MODP = 2 * MiB;
constexpr int MOD_KC = 16;
constexpr size_t WS_WGU = 16 * MiB;
constexpr size_t SZ_WGU = (size_t)11008 * 2048 * 2;
constexpr size_t WS_WD = WS_WGU + 4 * SZ_WGU;
constexpr size_t SZ_WD = (size_t)2048 * 5504 * 2;
constexpr size_t WS_WIN_EV = WS_WD + 4 * SZ_WD;
constexpr size_t WS_WOUT_EV = WS_WIN_EV + (size_t)EV_PAD * 2048 * 2;
constexpr size_t WS_WIN_OD = WS_WOUT_EV + (size_t)2048 * 2048 * 2;
constexpr size_t WS_WOUT_OD = WS_WIN_OD + (size_t)OD_COLS * 2048 * 2;
constexpr size_t WS_WGLU = WS_WOUT_OD + (size_t)2048 * 2048 * 2;
constexpr size_t WS_XC = WS_WGLU + (size_t)1024 * 1024 * 2;
constexpr size_t WS_HB = WS_XC + (size_t)TC * D * 4;
constexpr size_t WS_R = WS_HB + (size_t)TT * D * 2;
constexpr size_t WS_HID = WS_R;
constexpr size_t WS_Y = WS_R + 183 * MiB;
constexpr size_t WS_S = WS_R;
constexpr size_t WS_GT = WS_R + 247 * MiB;
constexpr size_t WS_GB = WS_R + 264 * MiB;
constexpr size_t WS_O = WS_R + 298 * MiB;
constexpr size_t SZ_O = (size_t)TT * 1024 * 2;
constexpr size_t WS_XL = WS_R + 434 * MiB;
constexpr size_t WS_QK2 = WS_XL + (size_t)TL * D * 2;
constexpr size_t WS_GP = WS_QK2 + (size_t)TT * 2048 * 2;
constexpr size_t WS_QKS = WS_GP + (size_t)TT * 8 * 4 * 4;
constexpr size_t WS_VEC = WS_QKS + (size_t)2 * TT * 1024 * 2;
constexpr size_t WS_GPK = WS_VEC + (size_t)NB * 4 * 2 * 68 * 384 * 4;
constexpr size_t WS_PP = WS_GPK + (size_t)NB * 4 * 2 * 68 * 256 * 4;
constexpr size_t WS_RS = WS_PP + (size_t)NB * 4 * 2 * 68 * 4096 * 2;
constexpr size_t WS_END = WS_RS + (size_t)NB * 4 * 2 * 68 * 64 * 4;
constexpr size_t WS_YCP = WS_R + 320 * MiB;
constexpr int YPARTS = 8;
static_assert(WS_YCP >= WS_Y + (size_t)TT * D * 2 && WS_YCP + (size_t)YPARTS * TC * D * 4 <= WS_XL && WS_O + 4 * SZ_O <= WS_XL, "ws map");
static_assert(WS_HID + (size_t)TT * DFF * 2 <= WS_Y && WS_S + (size_t)TT * EV_PAD * 2 <= WS_GT && WS_GT + (size_t)TT * 256 * 4 <= WS_GB && WS_GB + (size_t)TT * 1024 * 2 <= WS_O, "ws map");
static_assert(WS_Y + (size_t)TT * D * 2 <= WS_O, "ws map");

constexpr int LDS_BYTES = 156 * 1024;
constexpr int MISC_OFF = LDS_BYTES - 64;

struct Args { const float* in[34]; float* out; unsigned char* ws; };
#ifdef PROBE_A
#ifndef PROBE_A1
#define PROBE_A1 PROBE_A
#endif
#ifndef PROBE_B
#define PROBE_B -100
#endif
#ifndef PROBE_B1
#define PROBE_B1 PROBE_B
#endif
#define XBAR() do { xcd_barrier(bar); if (blockIdx.x == 0 && threadIdx.x == 0) { volatile LAS unsigned* M_ = (volatile LAS unsigned*)(lds + MISC_OFF); const unsigned c_ = M_[4]; \
        const unsigned long long t_ = __builtin_amdgcn_s_memrealtime(); const unsigned lo_ = (unsigned)t_; \
        if ((int)c_ == PROBE_A - 1) M_[6] = lo_; if ((int)c_ == PROBE_A1) M_[7] = lo_; if ((int)c_ == PROBE_B - 1) M_[8] = lo_; if ((int)c_ == PROBE_B1) M_[9] = lo_; M_[4] = c_ + 1u; } } while (0)
#else
#define XBAR() xcd_barrier(bar)
#endif
#define ARG(k) ((const float*)(GAS const float*)(a.in[opaque_idx(k)]))
__device__ __forceinline__ unsigned char* wsp(unsigned char* w, size_t off) { asm volatile("" : "+s"(off)); return w + off; }
__device__ __forceinline__ int opaque_idx(int k) { asm volatile("" : "+s"(k)); return k; }

__device__ __forceinline__ unsigned f2bf(float f) { unsigned u = __float_as_uint(f); u += 0x7FFFu + ((u >> 16) & 1u); return u >> 16; }
typedef __bf16 bf16x2_t __attribute__((ext_vector_type(2)));
typedef float f32x2_t __attribute__((ext_vector_type(2)));
__device__ __forceinline__ unsigned pk2(float lo, float hi) { const f32x2_t v = {lo, hi}; const bf16x2_t b = __builtin_convertvector(v, bf16x2_t); return __builtin_bit_cast(unsigned, b); }
__device__ __forceinline__ float bf2f(unsigned short b) { return __uint_as_float(((unsigned)b) << 16); }
__device__ __forceinline__ float wave_sum(float v) {
#pragma unroll
    for (int o = 1; o < 64; o <<= 1) v += __shfl_xor(v, o);
    return v;
}
__device__ __forceinline__ float fast_silu(float g) { return g * __builtin_amdgcn_rcpf(1.0f + __expf(-g)); }
__device__ __forceinline__ float fast_sigmoid(float g) { return __builtin_amdgcn_rcpf(1.0f + __expf(-g)); }

#ifndef DEFER
#define DEFER 2
#endif
struct TJob { const float* src; bf16* dst; int K, N, map; };
constexpr int NT_FFN = 5504, NT_EVIN = 32 * 226, NT_SQ = 2048, NT_ODIN = 32 * 160, NT_GLU = 512;
constexpr int NT_SET0 = 6 * NT_FFN + NT_EVIN + NT_SQ + NT_ODIN + NT_SQ + NT_GLU, NT_SET1 = 3 * NT_FFN, NT_SET2 = 3 * NT_FFN;
__device__ __forceinline__ void transpose_tile(const TJob& j, int tl, int lane) {
    const int nblk = (j.N + 31) / 32, kb = tl / nblk, nb = tl % nblk, k0 = 64 * kb, n0 = 32 * nb;
    const int kb8 = lane >> 3, nb4 = lane & 7, n = n0 + 4 * nb4;
    int drow0;
    if (j.map == 0) drow0 = n0;
    else if (j.map == 1) drow0 = (n0 / 128) * 256 + (n0 % 128);
    else if (j.map == 2) drow0 = (n0 / 128) * 256 + (n0 % 128) + 128;
    else drow0 = (nb < 96) ? n0 : (nb == 96 ? 7168 : (nb < 225 ? n0 - 32 : 7200));
    if (n < j.N) {
        const float* s = j.src + (size_t)(k0 + 8 * kb8) * j.N + n;
        f32x4 v[8];
#pragma unroll
        for (int i = 0; i < 8; ++i) v[i] = *(const f32x4*)(s + (size_t)i * j.N);
        bf16* d = j.dst + (size_t)(drow0 + 4 * nb4) * j.K + k0 + 8 * kb8;
#pragma unroll
        for (int e = 0; e < 4; ++e) { v4u o; o.x = pk2(v[0][e], v[1][e]); o.y = pk2(v[2][e], v[3][e]); o.z = pk2(v[4][e], v[5][e]); o.w = pk2(v[6][e], v[7][e]);
            *(v4u*)(d + (size_t)e * j.K) = o; }
    }
}

__device__ __forceinline__ void transpose_tile2(const TJob& j, int tl0, int tl1, int lane) {
    const int nblk = (j.N + 31) / 32; const int kb8 = lane >> 3, nb4 = lane & 7;
    f32x4 v[2][8]; int drow[2], k0s[2]; bool ok[2];
#pragma unroll
    for (int u = 0; u < 2; ++u) { const int tl = u ? tl1 : tl0; const int kb = tl / nblk, nb = tl % nblk, k0 = 64 * kb, n0 = 32 * nb, n = n0 + 4 * nb4;
        int drow0;
        if (j.map == 0) drow0 = n0;
        else if (j.map == 1) drow0 = (n0 / 128) * 256 + (n0 % 128);
        else if (j.map == 2) drow0 = (n0 / 128) * 256 + (n0 % 128) + 128;
        else drow0 = (nb < 96) ? n0 : (nb == 96 ? 7168 : (nb < 225 ? n0 - 32 : 7200));
        drow[u] = drow0; k0s[u] = k0; ok[u] = n < j.N;
        if (ok[u]) { const float* s = j.src + (size_t)(k0 + 8 * kb8) * j.N + n;
#pragma unroll
            for (int i = 0; i < 8; ++i) v[u][i] = *(const f32x4*)(s + (size_t)i * j.N); } }
#pragma unroll
    for (int u = 0; u < 2; ++u) if (ok[u]) { bf16* d = j.dst + (size_t)(drow[u] + 4 * nb4) * j.K + k0s[u] + 8 * kb8;
#pragma unroll
        for (int e = 0; e < 4; ++e) { v4u o; o.x = pk2(v[u][0][e], v[u][1][e]); o.y = pk2(v[u][2][e], v[u][3][e]); o.z = pk2(v[u][4][e], v[u][5][e]); o.w = pk2(v[u][6][e], v[u][7][e]);
            *(v4u*)(d + (size_t)e * j.K) = o; } }
}
__device__ __forceinline__ TJob make_job(const Args& a, unsigned char* ws, int id) {
    TJob j;
    if (id < 12) { const int li = id / 3, kind = id % 3; const size_t wo = (size_t)li * 2048 * 5504;
        j.src = ARG(8 + kind) + wo;
        if (kind == 2) { j.K = 5504; j.N = 2048; j.map = 0; j.dst = (bf16*)(wsp(ws, WS_WD) + (size_t)li * SZ_WD); }
        else { j.K = 2048; j.N = 5504; j.map = 1 + kind; j.dst = (bf16*)(wsp(ws, WS_WGU) + (size_t)li * SZ_WGU); } }
    else if (id == 12) { j.src = ARG(11); j.K = 2048; j.N = EV_COLS; j.map = 3; j.dst = (bf16*)wsp(ws, WS_WIN_EV); }
    else if (id == 13) { j.src = ARG(12); j.K = 2048; j.N = 2048; j.map = 0; j.dst = (bf16*)wsp(ws, WS_WOUT_EV); }
    else if (id == 14) { j.src = ARG(20); j.K = 2048; j.N = OD_COLS; j.map = 0; j.dst = (bf16*)wsp(ws, WS_WIN_OD); }
    else if (id == 15) { j.src = ARG(21); j.K = 2048; j.N = 2048; j.map = 0; j.dst = (bf16*)wsp(ws, WS_WOUT_OD); }
    else { j.src = ARG(30); j.K = 1024; j.N = 1024; j.map = 0; j.dst = (bf16*)wsp(ws, WS_WGLU); }
    return j;
}
__device__ __forceinline__ void convert_tiles(const Args& a, unsigned char* ws, int set, int wave_index, int nwaves, int lane) {
    const int njobs = DEFER == 2 ? (set == 0 ? 8 : 3) : (set == 0 ? 11 : 3);
    int start = wave_index;
#pragma unroll 1
    for (int q = 0; q < njobs; ++q) {
        const int id = DEFER == 2 ? (set == 0 ? (q < 3 ? q : q + 9) : 3 * set + q) : (set == 0 ? (q < 3 ? q : (q < 6 ? q + 3 : q + 6)) : (set == 1 ? 3 + q : 9 + q));
        const int nt = id < 12 ? NT_FFN : (id == 12 ? NT_EVIN : (id == 14 ? NT_ODIN : (id == 16 ? NT_GLU : NT_SQ)));
        const TJob j = make_job(a, ws, id);
        int t = start;
#pragma unroll 1
        for (; t + nwaves < nt; t += 2 * nwaves) transpose_tile2(j, t, t + nwaves, lane);
        if (t < nt) { transpose_tile(j, t, lane); t += nwaves; }
        start = t - nt;
    }
}

static_assert(NT_FFN % 2 == 0 && NT_EVIN % 2 == 0 && NT_SQ % 2 == 0 && NT_ODIN % 2 == 0 && NT_GLU % 2 == 0, "tile pairs must not straddle jobs");
constexpr int NT_SET0_D2 = 3 * NT_FFN + NT_EVIN + NT_SQ + NT_ODIN + NT_SQ + NT_GLU;
__device__ __forceinline__ void convert_pair_set0(const Args& a, unsigned char* ws, int t, int lane) {
    int id = 16;
    if (t < 3 * NT_FFN) { id = t / NT_FFN; t -= id * NT_FFN; }
    else { t -= 3 * NT_FFN;
        if (t < NT_EVIN) id = 12;
        else { t -= NT_EVIN; if (t < NT_SQ) id = 13;
            else { t -= NT_SQ; if (t < NT_ODIN) id = 14;
                else { t -= NT_ODIN; if (t < NT_SQ) id = 15; else { t -= NT_SQ; id = 16; } } } } }
    const TJob j = make_job(a, ws, id);
    transpose_tile2(j, t, t + 1, lane);
}

struct NormP {
    const void* xin_lat; const void* xin_ctx; void* xout_lat; void* xout_ctx; const bf16* y; bf16* h;
    int xin_f32, xout_f32;
    int rows_end; int has_y, has_h; float w;
    const float* y_ctx;
    int lp, sp;
    int ln, sn;
};
__device__ __forceinline__ void norm_phase(const NormP& p, const float* mod, const float* norm_pre, const float* norm_post, LAS unsigned char* lds, int gw, int ngw, int tid, int lane) {
    { int t2 = threadIdx.x; asm volatile("" : "+v"(t2)); tid = t2; lane = t2 & 63; gw = blockIdx.x * NWAVES + __builtin_amdgcn_readfirstlane(t2 >> 6); }
    LAS float* TA = (LAS float*)lds; LAS float* TB = TA + 5 * D; LAS float* TCc = TB + 5 * D;
    for (int i = tid; i < 5 * D; i += NTHR) { const int var = i >> 11, j = i & (D - 1);
        if (p.has_y) TA[i] = p.w * mod[((size_t)p.lp * 5 + var) * (NMOD * D) + (3 * p.sp + 2) * D + j] * norm_post[(p.lp * 3 + p.sp) * D + j];
        if (p.has_h) { TB[i] = norm_pre[(p.ln * 3 + p.sn) * D + j] * (1.0f + mod[((size_t)p.ln * 5 + var) * (NMOD * D) + (3 * p.sn + 1) * D + j]);
                       TCc[i] = mod[((size_t)p.ln * 5 + var) * (NMOD * D) + (3 * p.sn) * D + j]; } }
    __syncthreads();
    for (int r = gw; r < p.rows_end; r += ngw) {
        const int var = r < TL ? (r >> 12) : 4;
        const size_t xoff = r < TL ? (size_t)r * D : (size_t)(r - TL) * D;
        const void* xi = r < TL ? p.xin_lat : p.xin_ctx; void* xo = r < TL ? p.xout_lat : p.xout_ctx;
        f32x4 xv[8];
        if (p.xin_f32) {
#pragma unroll
            for (int j = 0; j < 8; ++j) xv[j] = *(const f32x4*)((const float*)xi + xoff + 4 * lane + 256 * j);
        } else {
#pragma unroll
            for (int j = 0; j < 8; ++j) { const v2u w = *(const v2u*)((const bf16*)xi + xoff + 4 * lane + 256 * j); xv[j] = (f32x4){__uint_as_float(w.x << 16), __uint_as_float(w.x & 0xffff0000u), __uint_as_float(w.y << 16), __uint_as_float(w.y & 0xffff0000u)}; }
        }
        if (p.has_y) {
            const bool yc = (r >= TL) && p.y_ctx; const float* yr = p.y_ctx + (size_t)(r - TL) * D; f32x4 yv[8]; float s = 0.f;
            if (!yc) { const bf16* yb = p.y + (size_t)r * D;
#pragma unroll
                for (int j = 0; j < 8; ++j) { const v2u w = *(const v2u*)(yb + 4 * lane + 256 * j); yv[j] = (f32x4){__uint_as_float(w.x << 16), __uint_as_float(w.x & 0xffff0000u), __uint_as_float(w.y << 16), __uint_as_float(w.y & 0xffff0000u)}; }
            } else {
#pragma unroll
                for (int j = 0; j < 8; ++j) yv[j] = *(const f32x4*)(yr + 4 * lane + 256 * j);
                for (int q = 1; q < YPARTS; ++q) {
#pragma unroll
                for (int j = 0; j < 8; ++j) yv[j] += *(const f32x4*)(yr + (size_t)q * TC * D + 4 * lane + 256 * j); } }
#pragma unroll
            for (int j = 0; j < 8; ++j) { s += (yv[j].x * yv[j].x + yv[j].y * yv[j].y) + (yv[j].z * yv[j].z + yv[j].w * yv[j].w); }
            const float rstd = 1.0f / sqrtf(wave_sum(s) * (1.0f / D) + EPS);
#pragma unroll
            for (int j = 0; j < 8; ++j) { const f32x4 a = *(const LAS f32x4*)(TA + var * D + 4 * lane + 256 * j); xv[j] = xv[j] + a * (yv[j] * rstd);
                if (p.xout_f32) *(f32x4*)((float*)xo + xoff + 4 * lane + 256 * j) = xv[j];
                else { v2u w; w.x = pk2(xv[j].x, xv[j].y); w.y = pk2(xv[j].z, xv[j].w); *(v2u*)((bf16*)xo + xoff + 4 * lane + 256 * j) = w; } }
        }
        if (p.has_h) {
            float s = 0.f;
#pragma unroll
            for (int j = 0; j < 8; ++j) s += (xv[j].x * xv[j].x + xv[j].y * xv[j].y) + (xv[j].z * xv[j].z + xv[j].w * xv[j].w);
            const float rstd = 1.0f / sqrtf(wave_sum(s) * (1.0f / D) + EPS);
            bf16* hr = p.h + (size_t)r * D;
#pragma unroll
            for (int j = 0; j < 8; ++j) { const f32x4 b = *(const LAS f32x4*)(TB + var * D + 4 * lane + 256 * j), c = *(const LAS f32x4*)(TCc + var * D + 4 * lane + 256 * j);
                const f32x4 o = xv[j] * rstd * b + c; v2u w; w.x = pk2(o.x, o.y); w.y = pk2(o.z, o.w); *(v2u*)(hr + 4 * lane + 256 * j) = w; }
        }
    }
    __syncthreads();
}

struct EpiSwiGLU {
    static constexpr bool PERM = true, AFTER_DRAIN = false;
    bf16* O; int ldc;
    __device__ __forceinline__ void operator()(const pg8::f32x4 (&acc)[2][2][4][2], const pg8::Unit& u, int wr, int wc, int fr, int fq) const {
        const int row0 = u.pm * 256 + wr * 64 + fr, col0 = u.pn * 128 + wc * 32 + 8 * fq;
#pragma unroll
        for (int ai = 0; ai < 2; ++ai)
#pragma unroll
            for (int m = 0; m < 4; ++m) { bf16* rowp = O + (size_t)(row0 + ai * 128 + m * 16) * ldc + col0;
                const pg8::f32x4 g0 = acc[ai][0][m][0], g1 = acc[ai][0][m][1], u0 = acc[ai][1][m][0], u1 = acc[ai][1][m][1];
                v4u w; w.x = pk2(fast_silu(g0[0]) * u0[0], fast_silu(g0[1]) * u0[1]); w.y = pk2(fast_silu(g0[2]) * u0[2], fast_silu(g0[3]) * u0[3]);
                w.z = pk2(fast_silu(g1[0]) * u1[0], fast_silu(g1[1]) * u1[1]); w.w = pk2(fast_silu(g1[2]) * u1[2], fast_silu(g1[3]) * u1[3]);
                *(v4u*)rowp = w; }
    }
};
struct EpiF32 {
    static constexpr bool PERM = true, AFTER_DRAIN = false;
    bf16* C; float* Cs;
    static constexpr int ldc = D;
    __device__ __forceinline__ void operator()(const pg8::f32x4 (&acc)[2][2][4][2], const pg8::Unit& u, int wr, int wc, int fr, int fq) const {
        const int row0 = u.pm * 256 + wr * 64 + fr, col0 = u.pn * 256 + wc * 32 + 8 * fq;
        if (u.part >= 0) {
            float* base = Cs + ((size_t)u.part * TC - (size_t)TL) * D;
#pragma unroll
            for (int ai = 0; ai < 2; ++ai)
#pragma unroll
                for (int m = 0; m < 4; ++m) { float* rowp = base + (size_t)(row0 + ai * 128 + m * 16) * ldc + col0;
#pragma unroll
                    for (int bj = 0; bj < 2; ++bj) { *(pg8::f32x4*)(rowp + bj * 128) = acc[ai][bj][m][0]; *(pg8::f32x4*)(rowp + bj * 128 + 4) = acc[ai][bj][m][1]; } }
        } else {
#pragma unroll
            for (int ai = 0; ai < 2; ++ai)
#pragma unroll
                for (int m = 0; m < 4; ++m) { bf16* rowp = C + (size_t)(row0 + ai * 128 + m * 16) * ldc + col0;
#pragma unroll
                    for (int bj = 0; bj < 2; ++bj) { const pg8::f32x4 v0 = acc[ai][bj][m][0], v1 = acc[ai][bj][m][1];
                        v4u w; w.x = pk2(v0[0], v0[1]); w.y = pk2(v0[2], v0[3]); w.z = pk2(v1[0], v1[1]); w.w = pk2(v1[2], v1[3]);
                        *(v4u*)(rowp + bj * 128) = w; } }
        }
    }
};
struct EpiS {
    static constexpr bool PERM = true, AFTER_DRAIN = false;
    bf16* S; int ldc; float* GT; int gt_pn;
    __device__ __forceinline__ void operator()(const pg8::f32x4 (&acc)[2][2][4][2], const pg8::Unit& u, int wr, int wc, int fr, int fq) const {
        const int row0 = u.pm * 256 + wr * 64 + fr;
        if (u.pn == gt_pn) {
            if (wc < 2) {
#pragma unroll
                for (int ai = 0; ai < 2; ++ai)
#pragma unroll
                    for (int m = 0; m < 4; ++m) { float* rowp = GT + (size_t)(row0 + ai * 128 + m * 16) * 256 + wc * 32 + 8 * fq;
                        *(pg8::f32x4*)rowp = acc[ai][0][m][0]; *(pg8::f32x4*)(rowp + 4) = acc[ai][0][m][1]; }
            }
        } else {
            const int col0 = u.pn * 256 + wc * 32 + 8 * fq;
#pragma unroll
            for (int ai = 0; ai < 2; ++ai)
#pragma unroll
                for (int m = 0; m < 4; ++m) { bf16* rowp = S + (size_t)(row0 + ai * 128 + m * 16) * ldc + col0;
#pragma unroll
                    for (int bj = 0; bj < 2; ++bj) { const pg8::f32x4 v0 = acc[ai][bj][m][0], v1 = acc[ai][bj][m][1];
                        v4u w; w.x = pk2(v0[0], v0[1]); w.y = pk2(v0[2], v0[3]); w.z = pk2(v1[0], v1[1]); w.w = pk2(v1[2], v1[3]);
                        *(v4u*)(rowp + bj * 128) = w; } }
        }
    }
};

#define DEV __device__ __forceinline__
#define LP(T) LAS T*
#define SYNC() do { asm volatile("s_waitcnt lgkmcnt(0)" ::: "memory"); __builtin_amdgcn_s_barrier(); asm volatile("" ::: "memory"); } while (0)
typedef short v8s __attribute__((ext_vector_type(8)));
typedef float v4f __attribute__((ext_vector_type(4)));
#define MFMA16(x, y, c) __builtin_amdgcn_mfma_f32_16x16x32_bf16((x), (y), (c), 0, 0, 0)
#define SHX(v, m) __shfl_xor((v), (m))
#define SHUP(v, d) __shfl_up((v), (d))
#define SHIDX(v, l) __shfl((v), (l))
#define EXPF(x) __expf(x)
#define LOGF(x) __logf(x)
#define RCPF(x) __builtin_amdgcn_rcpf(x)
#define RSQRTF(x) (1.0f / sqrtf(x))
#define PK2(lo, hi) pk2((lo), (hi))
#define F2BF(x) ((unsigned short)f2bf(x))
#define WAVE_SYNC() asm volatile("s_waitcnt lgkmcnt(0)" ::: "memory")
typedef short v4s __attribute__((ext_vector_type(4)));
#define LDS_TR16(p) __builtin_amdgcn_ds_read_tr16_b64_v4i16((LAS v4s*)(p))
#define RDLANE(v, l) __int_as_float(__builtin_amdgcn_readlane(__float_as_int(v), (l)))
#define RDLANE16(v, l) __shfl((v), (l))
#define SIB_SYNC_IMPL(p, target) do { __hip_atomic_fetch_add((p), 1u, __ATOMIC_RELAXED, __HIP_MEMORY_SCOPE_AGENT); unsigned sp_ = 0; \
    while (__hip_atomic_load((p), __ATOMIC_RELAXED, __HIP_MEMORY_SCOPE_AGENT) < (target) && ++sp_ < 100000u) __builtin_amdgcn_s_sleep(2); } while (0)

#define PRBROW(r) ((prb) == 1 ? ((r) & 63) : (r))
#define PRBTSK(t) ((prb) == 1 ? 0 : (t))
DEV int seq_row(int b, int seg, int np, int cm) {
    if (!seg) return TL + b * CTXL + np;
    const int n = cm ? ((np & 63) * 64 + (np >> 6)) : np;
    return b * SEQ + n;
}
DEV int tok_row(int b, int seg, int pos, int dir, int cm) {
    const int len = seg ? SEQ : CTXL;
    return seq_row(b, seg, dir ? len - 1 - pos : pos, cm);
}
DEV float bflo(unsigned u) { return __uint_as_float(u << 16); }
DEV float bfhi(unsigned u) { return __uint_as_float(u & 0xffff0000u); }
DEV float logsigmoidf(float z) { return fminf(z, 0.f) - LOGF(1.0f + EXPF(-fabsf(z))); }
DEV v4f tile_mma(v4f acc, LP(const unsigned char) A, int sa, int m0, LP(const unsigned char) B, int sb, int n0, int ksteps, int fr, int fq) {
    LP(const unsigned char) ap = A + (m0 + fr) * sa + fq * 16;
    LP(const unsigned char) bp = B + (n0 + fr) * sb + fq * 16;
    for (int k = 0; k < ksteps; ++k) {
        const v8s af = *(LP(const v8s))(ap + k * 64);
        const v8s bf = *(LP(const v8s))(bp + k * 64);
        acc = MFMA16(bf, af, acc);
    }
    return acc;
}
DEV v8s tr_frag(LP(const unsigned char) T, int st, int k0, int n0, int lane) {
    const int l16 = lane & 15, fq = lane >> 4;
    LP(const unsigned char) p = T + (k0 + 8 * fq + (l16 >> 2)) * st + (n0 + 4 * (l16 & 3)) * 2;
    const v4s a = LDS_TR16(p), b = LDS_TR16(p + 4 * st);
    return (v8s){a.x, a.y, a.z, a.w, b.x, b.y, b.z, b.w};
}
DEV v4f tile_mma_nt(v4f acc, LP(const unsigned char) A, int sa, int m0, LP(const unsigned char) Bt, int sb, int n0, int ksteps, int lane) {
    const int fr = lane & 15, fq = lane >> 4;
    for (int k = 0; k < ksteps; ++k) { const v8s af = *(LP(const v8s))(A + (m0 + fr) * sa + fq * 16 + k * 64); const v8s bf = tr_frag(Bt, sb, 32 * k, n0, lane); acc = MFMA16(bf, af, acc); }
    return acc;
}
DEV v4f tile_mma_tt(v4f acc, LP(const unsigned char) At, int sa, int m0, LP(const unsigned char) Bt, int sb, int n0, int ksteps, int lane) {
    for (int k = 0; k < ksteps; ++k) { const v8s af = tr_frag(At, sa, 32 * k, m0, lane); const v8s bf = tr_frag(Bt, sb, 32 * k, n0, lane); acc = MFMA16(bf, af, acc); }
    return acc;
}
constexpr int ST128 = 272, ST64 = 144, ST256 = 528, STV = 80;
DEV void sibling_sync(unsigned* sib, unsigned target, int tid) {
#ifdef SIB_SYNC_IMPL
    if (sib) { if (tid == 0) SIB_SYNC_IMPL(sib, target); SYNC(); }
#endif
}

constexpr int MIX_UNITS = NB * 32;
constexpr int GLA_TASKS = NB * 4 * 2 * (CTXL / 64 + SEQ / 64);
DEV void gla_prep_loop(int first, int stride, const bf16* S, const float* GT, const float* wg_all, const float* bg_all, bf16* QKS, float* VEC, LP(unsigned char) lds, int tid) {
    constexpr int NCHUNK = CTXL / 64 + SEQ / 64;
    constexpr int LA_RS = 132;
    LP(float) LA = (LP(float))lds; LP(float) SEG = (LP(float))(lds + 33792); LP(unsigned char) LRb = lds + 35840; LP(unsigned char) WGb = lds + 40960; LP(float) BG = (LP(float))(lds + 51200);
    for (int i = tid; i < (5120 + 10240) / 4; i += NTHR) ((LP(unsigned))LRb)[i] = 0u;
    SYNC();
    const int lane = tid & 63, wave = tid >> 6, fr = lane & 15, fq = lane >> 4;
    const int j = tid >> 3, c8 = tid & 7, dc = c8 * 16;
    const float qscale = 0.08838834764831845f;
    v4u pq0, pq1, pk0, pk1; v4f plr = (v4f){0.f, 0.f, 0.f, 0.f}, pwg = plr; float pbg = 0.f;
#define GP_ISSUE(tk) do { const int cx_ = (tk) % NCHUNK, r1_ = (tk) / NCHUNK, dir_ = r1_ & 1, h_ = (r1_ >> 1) & 3, b_ = r1_ >> 3; \
        const int seg_ = cx_ >= CTXL / 64, ci_ = seg_ ? cx_ - CTXL / 64 : cx_; \
        const bf16* sr_ = S + (size_t)tok_row(b_, seg_, ci_ * 64 + j, dir_, 0) * EV_PAD; \
        pq0 = *(const v4u*)(sr_ + h_ * 128 + dc); pq1 = *(const v4u*)(sr_ + h_ * 128 + dc + 8); pk0 = *(const v4u*)(sr_ + 512 + h_ * 128 + dc); pk1 = *(const v4u*)(sr_ + 512 + h_ * 128 + dc + 8); \
        pwg = *(const v4f*)(wg_all + (dir_ * 16 + (tid >> 5)) * 512 + h_ * 128 + (tid & 31) * 4); \
        if (tid < 128) pbg = bg_all[dir_ * 512 + h_ * 128 + tid]; \
        if (tid < 256) { const int rr_ = tok_row(b_, seg_, ci_ * 64 + (tid >> 2), dir_, 0); plr = *(const v4f*)(GT + (size_t)rr_ * 256 + dir_ * 16 + (tid & 3) * 4); } } while (0)
    if (first < GLA_TASKS) GP_ISSUE(first);
    for (int task = first; task < GLA_TASKS; task += stride) {
    const int cidx = task % NCHUNK, r1 = task / NCHUNK, dir = r1 & 1, h = (r1 >> 1) & 3, b = r1 >> 3;
    const int seg = cidx >= CTXL / 64, ci = seg ? cidx - CTXL / 64 : cidx;
    const int row = tok_row(b, seg, ci * 64 + j, dir, 0);
    const v4u q0 = pq0, q1 = pq1, k0 = pk0, k1 = pk1;
    { const int m = tid >> 5, d0 = (tid & 31) * 4;
      *(LP(unsigned short))(WGb + (d0 + 0) * 80 + m * 2) = F2BF(pwg.x); *(LP(unsigned short))(WGb + (d0 + 1) * 80 + m * 2) = F2BF(pwg.y);
      *(LP(unsigned short))(WGb + (d0 + 2) * 80 + m * 2) = F2BF(pwg.z); *(LP(unsigned short))(WGb + (d0 + 3) * 80 + m * 2) = F2BF(pwg.w); }
    if (tid < 128) BG[tid] = pbg;
    if (tid < 256) *(LP(v2u))(LRb + (tid >> 2) * 80 + (tid & 3) * 8) = (v2u){PK2(plr.x, plr.y), PK2(plr.z, plr.w)};
    if (task + stride < GLA_TASKS) GP_ISSUE(task + stride);
    SYNC();
    {
        const int tt = wave >> 1; const v8s af = *(LP(const v8s))(LRb + (16 * tt + fr) * 80 + fq * 16);
#pragma unroll
        for (int i = 0; i < 4; ++i) { const int dt = (wave & 1) * 4 + i; const v8s bf = *(LP(const v8s))(WGb + (16 * dt + fr) * 80 + fq * 16);
            v4f z = (v4f){0.f, 0.f, 0.f, 0.f}; z = MFMA16(bf, af, z);
            const v4f bg4 = *(LP(const v4f))(BG + 16 * dt + 4 * fq);
            v4f o; o.x = logsigmoidf(z.x + bg4.x) * 0.0625f; o.y = logsigmoidf(z.y + bg4.y) * 0.0625f; o.z = logsigmoidf(z.z + bg4.z) * 0.0625f; o.w = logsigmoidf(z.w + bg4.w) * 0.0625f;
            *(LP(v4f))(LA + (16 * tt + fr) * LA_RS + 32 * fq + 4 * dt) = o; }
    }
    SYNC();
    {
        const int d = tid & 127, sg = tid >> 7; float acc = 0.f;
        for (int jj = 0; jj < 16; ++jj) { acc += LA[(sg * 16 + jj) * LA_RS + d]; LA[(sg * 16 + jj) * LA_RS + d] = acc; }
        SEG[sg * 128 + d] = acc;
    }
    SYNC();
    {
        const int sgj = j >> 4;
        bf16* orow = QKS + ((size_t)dir * TT + row) * 1024 + h * 128 + dc;
#pragma unroll 1
        for (int g = 0; g < 2; ++g) {
            const v4u qv = g ? q1 : q0, kv = g ? k1 : k0;
            const unsigned qw[4] = {qv.x, qv.y, qv.z, qv.w}, kw[4] = {kv.x, kv.y, kv.z, kv.w};
            unsigned oqs[4], oks[4];
#pragma unroll
            for (int g2 = 0; g2 < 2; ++g2) {
                const int po = 32 * (2 * g + g2) + 4 * c8;
                const v4f la4 = *(LP(const v4f))(LA + j * LA_RS + po), mid4 = *(LP(const v4f))(LA + 32 * LA_RS + po);
                const v4f s04 = *(LP(const v4f))(SEG + po), s14 = *(LP(const v4f))(SEG + 128 + po), s24 = *(LP(const v4f))(SEG + 256 + po);
                const float lav[4] = {la4.x, la4.y, la4.z, la4.w}, midv[4] = {mid4.x, mid4.y, mid4.z, mid4.w};
                const float s0v[4] = {s04.x, s04.y, s04.z, s04.w}, s1v[4] = {s14.x, s14.y, s14.z, s14.w}, s2v[4] = {s24.x, s24.y, s24.z, s24.w};
                float vqs[4], vks[4];
#pragma unroll
                for (int e = 0; e < 4; ++e) {
                    const int d = dc + 8 * g + 4 * g2 + e, i2 = 2 * g2 + (e >> 1);
                    const float s0 = s0v[e], s1 = s1v[e], s2 = s2v[e];
                    const float pre = (sgj > 0 ? s0 : 0.f) + (sgj > 1 ? s1 : 0.f) + (sgj > 2 ? s2 : 0.f);
                    const float bv = lav[e] + pre;
                    const float bmid = midv[e] + s0 + s1;
                    const float q = ((e & 1) ? bfhi(qw[i2]) : bflo(qw[i2])) * qscale, k = (e & 1) ? bfhi(kw[i2]) : bflo(kw[i2]);
                    const float e1 = EXPF(bv - bmid);
                    vqs[e] = q * e1; vks[e] = k * RCPF(e1);
                    if (j == 63) { const float bend = bv; float* vp = VEC + (size_t)task * 384 + d; vp[0] = EXPF(bmid); vp[128] = EXPF(bend - bmid); vp[256] = EXPF(bend); }
                }
                oqs[2 * g2] = PK2(vqs[0], vqs[1]); oqs[2 * g2 + 1] = PK2(vqs[2], vqs[3]);
                oks[2 * g2] = PK2(vks[0], vks[1]); oks[2 * g2 + 1] = PK2(vks[2], vks[3]);
            }
            *(v4u*)(orow + 8 * g) = (v4u){oqs[0], oqs[1], oqs[2], oqs[3]};
            *(v4u*)(orow + 512 + 8 * g) = (v4u){oks[0], oks[1], oks[2], oks[3]};
        }
    }
    SYNC();
    }
#undef GP_ISSUE
}

DEV void gla_unit(const bf16* S, const bf16* QKS, const float* VEC, bf16* O, int unit, LP(unsigned char) lds, int tid, unsigned* sib, int prb = 0) {
    const int lane = tid & 63, wave = tid >> 6, fr = lane & 15, fq = lane >> 4;
    const int vs = unit & 3, dir = (unit >> 2) & 1, h = (unit >> 3) & 3, b = unit >> 5;
    LP(unsigned char) QS = lds; LP(unsigned char) KS = lds + 17408; LP(unsigned char) QB = lds + 34816;
    LP(unsigned char) VV = lds + 52224; LP(unsigned char) PM = lds + 61440; LP(unsigned char) STT = lds + 70656;
    LP(float) DV = (LP(float))(lds + 88064);
    for (int i = tid; i < 64 * ST128 / 4; i += NTHR) ((LP(unsigned))STT)[i] = 0u;
    v4f sacc[4];
#pragma unroll
    for (int i = 0; i < 4; ++i) sacc[i] = (v4f){0.f, 0.f, 0.f, 0.f};
    const int j = tid >> 3, c8 = tid & 7, dc = c8 * 16;
    const int tt = wave >> 1, vt0 = (wave & 1) * 2;
    const int svt = wave & 3, sdt0 = (wave >> 2) * 4;
    bf16* Od = O + (size_t)dir * TT * 1024;
    constexpr int NCHUNK = CTXL / 64 + SEQ / 64;
    const int task0 = ((b * 4 + h) * 2 + dir) * NCHUNK;
    v4u gq0[2], gq1[2], gk0[2], gk1[2], gvv[2]; v4f gem[4]; v4f gdv = (v4f){0.f, 0.f, 0.f, 0.f};
#define GLA_ISSUE(cx, P_) do { const int seg_ = (cx) >= CTXL / 64, ci_ = seg_ ? (cx) - CTXL / 64 : (cx); \
        const int row_ = PRBROW(tok_row(b, seg_, ci_ * 64 + j, dir, 0)); \
        const bf16* qr_ = QKS + ((size_t)dir * TT + row_) * 1024 + h * 128 + c8 * 8; \
        gq0[P_] = *(const v4u*)(qr_); gq1[P_] = *(const v4u*)(qr_ + 64); gk0[P_] = *(const v4u*)(qr_ + 512); gk1[P_] = *(const v4u*)(qr_ + 576); \
        gvv[P_] = *(const v4u*)(S + (size_t)row_ * EV_PAD + 1024 + h * 256 + vs * 64 + c8 * 8); } while (0)
#define GLA_ISSUE_V(cx) do { const float* vp_ = VEC + (size_t)PRBTSK(task0 + (cx)) * 384;     \
        _Pragma("unroll") for (int i_ = 0; i_ < 4; ++i_) gem[i_] = *(const v4f*)(vp_ + (i_ >> 1) * 64 + c8 * 8 + 4 * (i_ & 1)); \
        if (tid < 64) gdv = *(const v4f*)(vp_ + 128 + tid * 4); } while (0)
#ifdef GLA_TOTAL_PROBE
    const unsigned long long gt0_ = __builtin_amdgcn_s_memrealtime();
#endif
    GLA_ISSUE(0, 0); GLA_ISSUE(1, 1); GLA_ISSUE_V(0);
    SYNC();
#pragma unroll 1
    for (int c2 = 0; c2 < NCHUNK; c2 += 2) {
#pragma unroll
    for (int u_ = 0; u_ < 2; ++u_) {
        const int cidx = c2 + u_;
        const int seg = cidx >= CTXL / 64, ci = seg ? cidx - CTXL / 64 : cidx;
        if (u_ == 0 && (c2 & 3) == 0 && c2 > 0) sibling_sync(sib, (unsigned)(c2 >> 2) * 4u, tid);
        const v4u q0 = gq0[u_], q1 = gq1[u_], k0 = gk0[u_], k1 = gk1[u_], vv = gvv[u_]; const v4f dvv = gdv;
        v4f em[4];
#pragma unroll
        for (int i_ = 0; i_ < 4; ++i_) em[i_] = gem[i_];
        {
            *(LP(v4u))(QS + j * ST128 + c8 * 16) = q0; *(LP(v4u))(QS + j * ST128 + c8 * 16 + 128) = q1;
            *(LP(v4u))(KS + j * ST128 + c8 * 16) = k0; *(LP(v4u))(KS + j * ST128 + c8 * 16 + 128) = k1;
            const unsigned qw[8] = {q0.x, q0.y, q0.z, q0.w, q1.x, q1.y, q1.z, q1.w}; unsigned ob[8];
#pragma unroll
            for (int i2 = 0; i2 < 8; ++i2) { const v4f e4 = em[i2 >> 1]; const float ea = (i2 & 1) ? e4.z : e4.x, eb = (i2 & 1) ? e4.w : e4.y; ob[i2] = PK2(bflo(qw[i2]) * ea, bfhi(qw[i2]) * eb); }
            *(LP(v4u))(QB + j * ST128 + c8 * 16) = (v4u){ob[0], ob[1], ob[2], ob[3]}; *(LP(v4u))(QB + j * ST128 + c8 * 16 + 128) = (v4u){ob[4], ob[5], ob[6], ob[7]};
            *(LP(v4u))(VV + j * ST64 + c8 * 16) = vv;
            if (tid < 64) *(LP(v4f))(DV + tid * 4) = dvv;
        }
        if (cidx + 2 < NCHUNK) GLA_ISSUE(cidx + 2, u_);
        if (cidx + 1 < NCHUNK) GLA_ISSUE_V(cidx + 1);
        SYNC();
        v4f oacc[2]; oacc[0] = (v4f){0.f, 0.f, 0.f, 0.f}; oacc[1] = oacc[0];
        {
#pragma unroll
            for (int i = 0; i < 2; ++i) { const int st = vt0 + i; v4f p = (v4f){0.f, 0.f, 0.f, 0.f};
                if (st <= tt) { p = tile_mma(p, QS, ST128, 16 * tt, KS, ST128, 16 * st, 4, fr, fq);
                    if (st == tt) { if (4 * fq + 0 > fr) p.x = 0.f; if (4 * fq + 1 > fr) p.y = 0.f; if (4 * fq + 2 > fr) p.z = 0.f; if (4 * fq + 3 > fr) p.w = 0.f; } }
                *(LP(v2u))(PM + (16 * tt + fr) * ST64 + (16 * st + 4 * fq) * 2) = (v2u){PK2(p.x, p.y), PK2(p.z, p.w)}; }
#pragma unroll
            for (int k = 0; k < 4; ++k) { const v8s af = *(LP(const v8s))(QB + (16 * tt + fr) * ST128 + fq * 16 + k * 64);
#pragma unroll
                for (int i = 0; i < 2; ++i) { const v8s bf = *(LP(const v8s))(STT + (16 * (vt0 + i) + fr) * ST128 + fq * 16 + k * 64); oacc[i] = MFMA16(bf, af, oacc[i]); } }
        }
        SYNC();
#pragma unroll
        for (int k = 0; k < 2; ++k) { const v8s af = *(LP(const v8s))(PM + (16 * tt + fr) * ST64 + fq * 16 + k * 64);
#pragma unroll
            for (int i = 0; i < 2; ++i) { const v8s bf = tr_frag(VV, ST64, 32 * k, 16 * (vt0 + i), lane); oacc[i] = MFMA16(bf, af, oacc[i]); } }
        if (!prb) { const int orow = tok_row(b, seg, ci * 64 + 16 * tt + fr, dir, 0);
#pragma unroll
          for (int i = 0; i < 2; ++i) *(v2u*)(Od + (size_t)orow * 1024 + h * 256 + vs * 64 + 16 * (vt0 + i) + 4 * fq) = (v2u){PK2(oacc[i].x, oacc[i].y), PK2(oacc[i].z, oacc[i].w)}; }
        {
            v4f tmp[4];
#pragma unroll
            for (int i = 0; i < 4; ++i) tmp[i] = (v4f){0.f, 0.f, 0.f, 0.f};
#pragma unroll
            for (int k = 0; k < 2; ++k) { const v8s af = tr_frag(VV, ST64, 32 * k, 16 * svt, lane);
#pragma unroll
                for (int i = 0; i < 4; ++i) { const v8s bf = tr_frag(KS, ST128, 32 * k, 16 * (sdt0 + i), lane); tmp[i] = MFMA16(bf, af, tmp[i]); } }
#pragma unroll
            for (int i = 0; i < 4; ++i) { const v4f ee = *(LP(const v4f))(DV + 16 * (sdt0 + i) + 4 * fq), de = *(LP(const v4f))(DV + 128 + 16 * (sdt0 + i) + 4 * fq);
                sacc[i] = sacc[i] * de + tmp[i] * ee;
                *(LP(v2u))(STT + (16 * svt + fr) * ST128 + (16 * (sdt0 + i) + 4 * fq) * 2) = (v2u){PK2(sacc[i].x, sacc[i].y), PK2(sacc[i].z, sacc[i].w)}; }
        }
        SYNC();
    }
    }
#undef GLA_ISSUE
#undef GLA_ISSUE_V
#ifdef GLA_TOTAL_PROBE
    if (wave == 1) { const unsigned long long acc_ = __builtin_amdgcn_s_memrealtime() - gt0_, t0_ = __builtin_amdgcn_s_memrealtime(); while (__builtin_amdgcn_s_memrealtime() - t0_ < 8ull * acc_) __builtin_amdgcn_s_sleep(8); }
#endif
}

constexpr int MAT_TASKS = NB * 4 * 2 * (CTXL / 64 + SEQ / 64);
template <int MODE>
DEV void mat_prep_loop(int first, int stride, const bf16* Sqk, int ldqk, int qoff, int koff, float kscale, const float* GT, const float* gate_b, float* GP, float* GPK,
                       const float* ret_log_decay, bf16* PP, float* RS, LP(unsigned char) lds, int tid) {
    constexpr int NCHUNK = CTXL / 64 + SEQ / 64;
    const int lane = tid & 63, wave = tid >> 6, fr = lane & 15, fq = lane >> 4;
    LP(unsigned char) Q = lds; LP(unsigned char) K = lds + 33792; LP(float) AS = (LP(float))(lds + 67584); LP(float) R0 = AS + 64; LP(float) DENP = AS + 128; LP(float) W0 = AS + 384;
    const int j = tid >> 3, c8 = tid & 7, dc = c8 * 32;
    v4u rq[4], rk[4]; float gi = 0.f, gf = 0.f;
#define MP_ISSUE(tk) do { const int cx_ = (tk) % NCHUNK, r1_ = (tk) / NCHUNK, dir_ = r1_ & 1, h_ = (r1_ >> 1) & 3, b_ = r1_ >> 3; \
        const int seg_ = cx_ >= CTXL / 64, ci_ = seg_ ? cx_ - CTXL / 64 : cx_; \
        const bf16* s1_ = Sqk + (size_t)tok_row(b_, seg_, ci_ * 64 + j, dir_, 1) * ldqk; \
        _Pragma("unroll") for (int g_ = 0; g_ < 4; ++g_) { rq[g_] = *(const v4u*)(s1_ + qoff + h_ * 256 + c8 * 8 + 64 * g_); rk[g_] = *(const v4u*)(s1_ + koff + h_ * 256 + c8 * 8 + 64 * g_); } \
        if (MODE == 0 && wave == 0) { const int prow_ = tok_row(b_, seg_, ci_ * 64 + lane, dir_, 1); \
            gi = GT[(size_t)prow_ * 256 + 32 + (dir_ * 2 + 0) * 4 + h_]; gf = GT[(size_t)prow_ * 256 + 32 + (dir_ * 2 + 1) * 4 + h_]; } } while (0)
    if (first < MAT_TASKS) MP_ISSUE(first);
    for (int task = first; task < MAT_TASKS; task += stride) {
        const int cidx = task % NCHUNK, r1 = task / NCHUNK, dir = r1 & 1, h = (r1 >> 1) & 3, b = r1 >> 3;
        const int seg = cidx >= CTXL / 64, ci = seg ? cidx - CTXL / 64 : cidx;
#pragma unroll
        for (int g8 = 0; g8 < 4; ++g8) { *(LP(v4u))(Q + j * ST256 + (c8 * 8 + 64 * g8) * 2) = rq[g8]; *(LP(v4u))(K + j * ST256 + (c8 * 8 + 64 * g8) * 2) = rk[g8]; }
        if (wave == 0) {
            if (MODE == 0) {
                const int prow = tok_row(b, seg, ci * 64 + lane, dir, 1);
                const float ig = gi + gate_b[(dir * 2 + 0) * 4 + h];
                float bcum = logsigmoidf(gf + gate_b[(dir * 2 + 1) * 4 + h]);
#pragma unroll
                for (int o = 1; o < 64; o <<= 1) { const float t = SHUP(bcum, o); if (lane >= o) bcum += t; }
                const float a_s = ig - bcum;
                float cm = a_s;
#pragma unroll
                for (int o = 1; o < 64; o <<= 1) { const float t = SHUP(cm, o); if (lane >= o) cm = fmaxf(cm, t); }
                *(v4f*)(GP + ((size_t)prow * 8 + dir * 4 + h) * 4) = (v4f){bcum, a_s, cm, 0.f};
                AS[lane] = a_s; R0[lane] = -cm; W0[lane] = EXPF(a_s - RDLANE(cm, 63));
            } else { const float lg = -expf(ret_log_decay[dir * 4 + h]); AS[lane] = -(float)(lane + 1) * lg; R0[lane] = (float)(lane + 1) * lg; }
        }
        if (task + stride < MAT_TASKS) MP_ISSUE(task + stride);
        SYNC();
        const int tt = wave >> 1;
        bf16* pp = PP + (size_t)task * 4096;
        const float rt = R0[16 * tt + fr];
#pragma unroll
        for (int i = 0; i < 2; ++i) { const int st = (wave & 1) * 2 + i; v4f p = (v4f){0.f, 0.f, 0.f, 0.f};
            if (st <= tt) { p = tile_mma(p, Q, ST256, 16 * tt, K, ST256, 16 * st, 8, fr, fq);
                const v4f as4 = *(LP(const v4f))(AS + 16 * st + 4 * fq);
                p.x *= kscale * EXPF(as4.x + rt); p.y *= kscale * EXPF(as4.y + rt); p.z *= kscale * EXPF(as4.z + rt); p.w *= kscale * EXPF(as4.w + rt);
                if (st == tt) { if (4 * fq + 0 > fr) p.x = 0.f; if (4 * fq + 1 > fr) p.y = 0.f; if (4 * fq + 2 > fr) p.z = 0.f; if (4 * fq + 3 > fr) p.w = 0.f; } }
            *(v2u*)(pp + (16 * tt + fr) * 64 + 16 * st + 4 * fq) = (v2u){PK2(p.x, p.y), PK2(p.z, p.w)};
            if (MODE == 0) { float rs = (p.x + p.y) + (p.z + p.w); rs += SHX(rs, 16); rs += SHX(rs, 32); if (fq == 0) DENP[st * 64 + 16 * tt + fr] = rs; } }
        if (MODE == 0 && tid >= 256) {
            const int d = tid - 256; float kw = 0.f;
            for (int jj = 0; jj < 64; ++jj) kw += __uint_as_float(((unsigned)*(LP(const unsigned short))(K + jj * ST256 + d * 2)) << 16) * W0[jj];
            GPK[(size_t)task * 256 + d] = kw; }
        SYNC();
        if (MODE == 0 && tid < 64) RS[(size_t)task * 64 + tid] = (DENP[tid] + DENP[64 + tid]) + (DENP[128 + tid] + DENP[192 + tid]);
        SYNC();
    }
#undef MP_ISSUE
}

#ifdef SEC_PROBE
#ifndef SEC_WAVE
#define SEC_WAVE 1
#endif
#ifndef SEC_MODE
#define SEC_MODE 0
#endif
#define SECT(s, e) do { if ((s) == SEC_PROBE && MODE == SEC_MODE) { const unsigned long long t_ = __builtin_amdgcn_s_memrealtime(); if (e) sec_acc += t_ - sec_t0; else sec_t0 = t_; } } while (0)
#else
#define SECT(s, e) do {} while (0)
#endif
template <int MODE>
DEV void mat_unit(const bf16* Sqk, int ldqk, int qoff, int koff, const bf16* Sv, int ldv, int voff, float kscale, const float* GP, const float* GPK, const bf16* PP, const float* RS, bf16* O, int store_ctx,
                  const float* ret_log_decay, int unit, LP(unsigned char) lds, int tid, unsigned* sib, int prb = 0) {
    const int lane = tid & 63, wave = tid >> 6, fr = lane & 15, fq = lane >> 4;
    const int vs = unit & 3, dir = (unit >> 2) & 1, h = (unit >> 3) & 3, b = unit >> 5;
    LP(unsigned char) Q = lds; LP(unsigned char) K = lds + 33792;
    LP(unsigned char) VV = lds + 67584; LP(unsigned char) VW = lds + 76800;
    LP(unsigned char) PM = lds + 86016; LP(unsigned char) STT = lds + 95232;
    LP(float) SCAL = (LP(float))(lds + 137472);
    LP(float) NV = SCAL + 768;
    for (int i = tid; i < 80 * ST256 / 4; i += NTHR) ((LP(unsigned))STT)[i] = 0u;
    if (tid < 256) NV[tid] = 0.f;
    v4f sacc[8];
#pragma unroll
    for (int i = 0; i < 8; ++i) sacc[i] = (v4f){0.f, 0.f, 0.f, 0.f};
    const int j = tid >> 3, c8 = tid & 7;
    const int tt = wave >> 1, vt0 = (wave & 1) * 2;
#ifdef SEC_PROBE
    unsigned long long sec_acc = 0ull, sec_t0 = 0ull;
#endif
    float m_st = 0.f;
    float lg = 0.f;
    if (MODE == 1) lg = -expf(ret_log_decay[dir * 4 + h]);
    bf16* Od = O + (size_t)(2 + dir) * TT * 1024;
    constexpr int NCHUNK = CTXL / 64 + SEQ / 64;
    v4u rq[2][4], rk[2][4], rv, rp; v4f gpv = (v4f){0.f, 0.f, 0.f, 0.f}; float kwv[2] = {0.f, 0.f}, rsv = 0.f;
    const int task0 = ((b * 4 + h) * 2 + dir) * NCHUNK;
#define MAT_ISSUE(cx, P_) do { const int seg_ = (cx) >= CTXL / 64, ci_ = seg_ ? (cx) - CTXL / 64 : (cx); \
        const int row_ = PRBROW(tok_row(b, seg_, ci_ * 64 + j, dir, 1)); \
        const bf16* s1_ = Sqk + (size_t)row_ * ldqk; \
        _Pragma("unroll") for (int g_ = 0; g_ < 4; ++g_) { rq[P_][g_] = *(const v4u*)(s1_ + qoff + h * 256 + c8 * 8 + 64 * g_); rk[P_][g_] = *(const v4u*)(s1_ + koff + h * 256 + c8 * 8 + 64 * g_); } \
        if (MODE == 0 && tid < 256) kwv[P_] = GPK[(size_t)(task0 + (cx)) * 256 + tid]; } while (0)
#define MAT_GATE_LOAD(cx) do { if (MODE == 0 && wave == 0) { const int seg_ = (cx) >= CTXL / 64, ci_ = seg_ ? (cx) - CTXL / 64 : (cx); \
        const int prow_ = PRBROW(tok_row(b, seg_, ci_ * 64 + lane, dir, 1)); gpv = *(const v4f*)(GP + ((size_t)prow_ * 8 + dir * 4 + h) * 4); rsv = RS[(size_t)PRBTSK(task0 + (cx)) * 64 + lane]; } } while (0)
#define MAT_GATES(cx) do { if (wave == 0) { LP(float) sc_ = SCAL + ((cx) & 1) * 384; \
        if (MODE == 0) { const float bcum_ = gpv.x, a_s_ = gpv.y, Mt_ = fmaxf(m_st, gpv.z); \
            const float M63_ = RDLANE(Mt_, 63), bend_ = RDLANE(bcum_, 63), cm63_ = RDLANE(gpv.z, 63); const float wp_ = EXPF(gpv.z - Mt_); \
            sc_[lane] = wp_; sc_[64 + lane] = EXPF(m_st - Mt_); sc_[128 + lane] = EXPF(a_s_ - M63_); sc_[192 + lane] = EXPF(-(bcum_ + Mt_)); sc_[256 + lane] = rsv * wp_; \
            if (lane == 0) { sc_[320] = EXPF(m_st - M63_); sc_[321] = EXPF(cm63_ - M63_); } \
            m_st = bend_ + M63_; \
        } else { sc_[lane] = 1.0f; sc_[64 + lane] = EXPF((float)(lane + 1) * lg); sc_[128 + lane] = EXPF((float)(63 - lane) * lg); sc_[192 + lane] = 0.f; sc_[256 + lane] = 0.f; \
            if (lane == 0) { sc_[320] = EXPF(64.f * lg); sc_[321] = 0.f; } } } } while (0)
    static_assert(NCHUNK % 2 == 0, "the chunk loop is unrolled by two");
#define MAT_ISSUE_P(cx) do { const int seg_ = (cx) >= CTXL / 64, ci_ = seg_ ? (cx) - CTXL / 64 : (cx); rp = *(const v4u*)(PP + (size_t)PRBTSK(task0 + (cx)) * 4096 + j * 64 + c8 * 8); \
        rv = *(const v4u*)(Sv + (size_t)PRBROW(tok_row(b, seg_, ci_ * 64 + j, dir, 1)) * ldv + voff + h * 256 + vs * 64 + c8 * 8); } while (0)
    SECT(5, 0);
    MAT_ISSUE(0, 0); MAT_ISSUE(1, 1); MAT_ISSUE_P(0); MAT_GATE_LOAD(0);
    MAT_GATES(0);
    MAT_GATE_LOAD(1);
    SYNC();
#pragma unroll 1
    for (int c2 = 0; c2 < NCHUNK; c2 += 2) {
#pragma unroll
    for (int u_ = 0; u_ < 2; ++u_) {
        const int cidx = c2 + u_;
        const int seg = cidx >= CTXL / 64, ci = seg ? cidx - CTXL / 64 : cidx;
        if (u_ == 0 && (c2 & 3) == 0 && c2 > 0) sibling_sync(sib, (unsigned)(c2 >> 2) * 4u, tid);
        LP(const float) sc = SCAL + u_ * 384;
        const float kw_cur = kwv[u_];
        SECT(6, 0);
#if defined(SEC_PROBE) && SEC_PROBE == 6
        asm volatile("s_waitcnt vmcnt(0)" ::: "memory");
#endif
        SECT(6, 1);
        SECT(1, 0);
        {
            const float wk = sc[128 + j] * kscale;
#pragma unroll
            for (int g8 = 0; g8 < 4; ++g8) { const int d0 = c8 * 8 + 64 * g8;     *(LP(v4u))(Q + j * ST256 + d0 * 2) = rq[u_][g8]; *(LP(v4u))(K + j * ST256 + d0 * 2) = rk[u_][g8]; }
            const v4u rvv = rv;
            *(LP(v4u))(VV + j * ST64 + c8 * 16) = rvv;
            *(LP(v4u))(VW + j * ST64 + c8 * 16) = (v4u){PK2(bflo(rvv.x) * wk, bfhi(rvv.x) * wk), PK2(bflo(rvv.y) * wk, bfhi(rvv.y) * wk), PK2(bflo(rvv.z) * wk, bfhi(rvv.z) * wk), PK2(bflo(rvv.w) * wk, bfhi(rvv.w) * wk)};
            *(LP(v4u))(PM + j * ST64 + c8 * 16) = rp;
#pragma unroll
            for (int i = 0; i < 8; ++i) *(LP(v2u))(STT + (16 * (i >> 1) + fr) * ST256 + (16 * (2 * wave + (i & 1)) + 4 * fq) * 2) = (v2u){PK2(sacc[i].x, sacc[i].y), PK2(sacc[i].z, sacc[i].w)};
        }
        if (cidx + 2 < NCHUNK) MAT_ISSUE(cidx + 2, u_);
        if (cidx + 1 < NCHUNK) MAT_ISSUE_P(cidx + 1);
        SECT(1, 1); SECT(2, 0);
        SYNC();
        SECT(2, 1); SECT(3, 0);
        if (cidx + 1 < NCHUNK) { MAT_GATES(cidx + 1); if (cidx + 2 < NCHUNK) MAT_GATE_LOAD(cidx + 2); }
        v4f oP[2], oI[2]; oP[0] = (v4f){0.f, 0.f, 0.f, 0.f}; oP[1] = oP[0]; oI[0] = oP[0]; oI[1] = oP[0];
        v4f qa = (v4f){0.f, 0.f, 0.f, 0.f};
#pragma unroll 1
        for (int k = 0; k < 8; ++k) { const v8s af = *(LP(const v8s))(Q + (16 * tt + fr) * ST256 + fq * 16 + k * 64);
#pragma unroll
            for (int i = 0; i < 2; ++i) { const v8s bf = *(LP(const v8s))(STT + (16 * (vt0 + i) + fr) * ST256 + fq * 16 + k * 64); oI[i] = MFMA16(bf, af, oI[i]); }
            if (MODE == 0) { const v8s bn = *(LP(const v8s))(STT + (64 + fr) * ST256 + fq * 16 + k * 64); qa = MFMA16(bn, af, qa); } }
#pragma unroll
        for (int k = 0; k < 2; ++k) { const v8s af = *(LP(const v8s))(PM + (16 * tt + fr) * ST64 + fq * 16 + k * 64);
#pragma unroll
            for (int i = 0; i < 2; ++i) { const v8s bf = tr_frag(VV, ST64, 32 * k, 16 * (vt0 + i), lane); oP[i] = MFMA16(bf, af, oP[i]); } }
        { const int t = 16 * tt + fr; const float wp = sc[t], wi = sc[64 + t];
          v4f o0 = oP[0] * wp + oI[0] * wi, o1 = oP[1] * wp + oI[1] * wi;
          if (MODE == 0) { const float qn = RDLANE16(qa.x, fr); const float den = sc[256 + t] + wi * qn; const float dv = 1.0f / fmaxf(fabsf(den), sc[192 + t]); o0 = o0 * dv; o1 = o1 * dv; }
          if ((seg || store_ctx) && !prb) { const int orow = tok_row(b, seg, ci * 64 + t, dir, 1);
              *(v2u*)(Od + (size_t)orow * 1024 + h * 256 + vs * 64 + 16 * vt0 + 4 * fq) = (v2u){PK2(o0.x, o0.y), PK2(o0.z, o0.w)};
              *(v2u*)(Od + (size_t)orow * 1024 + h * 256 + vs * 64 + 16 * (vt0 + 1) + 4 * fq) = (v2u){PK2(o1.x, o1.y), PK2(o1.z, o1.w)}; } }
        const float dcy = sc[320];
        {
#pragma unroll
            for (int i = 0; i < 8; ++i) sacc[i] = sacc[i] * dcy;
#pragma unroll 1
            for (int k = 0; k < 2; ++k) {
                const v8s bf0 = tr_frag(K, ST256, 32 * k, 16 * (2 * wave), lane), bf1 = tr_frag(K, ST256, 32 * k, 16 * (2 * wave + 1), lane);
#pragma unroll
                for (int a4 = 0; a4 < 4; ++a4) { const v8s af = tr_frag(VW, ST64, 32 * k, 16 * a4, lane); sacc[2 * a4] = MFMA16(bf0, af, sacc[2 * a4]); sacc[2 * a4 + 1] = MFMA16(bf1, af, sacc[2 * a4 + 1]); } }
        }
        SECT(3, 1); SECT(4, 0);
        SYNC();
        SECT(4, 1);
        if (MODE == 0 && tid < 256) {
            const float nn = dcy * NV[tid] + sc[321] * kw_cur * kscale; NV[tid] = nn;
            *(LP(unsigned short))(STT + 64 * ST256 + tid * 2) = F2BF(nn); }
    }
    }
#undef MAT_ISSUE
#undef MAT_ISSUE_P
#undef MAT_GATE_LOAD
#undef MAT_GATES
    SYNC();
    SECT(5, 1);
#ifdef SEC_PROBE
    if (MODE == SEC_MODE && (SEC_UNIT < 0 || unit == SEC_UNIT) && wave == SEC_WAVE) { const unsigned long long t0_ = __builtin_amdgcn_s_memrealtime(); while (__builtin_amdgcn_s_memrealtime() - t0_ < 8ull * sec_acc) __builtin_amdgcn_s_sleep(8); }
#endif
}

constexpr int S5_LDS_PER_WAVE = 1280 + 2 * 10240 + 2 * 6144;
DEV void s5_unit(const bf16* S, int ldS, bf16* O, const float* lam_re, const float* lam_im, const float* log_step, const float* b_re, const float* b_im,
                 const float* c_re, const float* c_im, int unit, LP(unsigned char) wl, int lane, int prb = 0) {
    const int fr = lane & 15, fq = lane >> 4;
    const int dir = unit & 1, g = (unit >> 1) & 63, b = unit >> 7;
    LP(unsigned char) UB = wl; LP(unsigned char) XB = wl + 1280; LP(unsigned char) HB = wl + 1280 + 2 * 10240;
    const int pg = (dir * 64 + g);
    const float lr = lam_re[pg * 64 + lane], li = lam_im[pg * 64 + lane], step = expf(log_step[pg]);
    const float mag = expf(lr * step); float sn, cs; sincosf(li * step, &sn, &cs);
    const float ar = mag * cs, ai = mag * sn, den = lr * lr + li * li;
    const float cre = ((ar - 1.0f) * lr + ai * li) / den, cim = (ai * lr - (ar - 1.0f) * li) / den;
    for (int p = 0; p < 16; ++p) { const float br = b_re[(pg * 64 + lane) * 16 + p], bi = b_im[(pg * 64 + lane) * 16 + p];
        *(LP(unsigned short))(XB + lane * 32 + p * 2) = F2BF(cre * br - cim * bi);
        *(LP(unsigned short))(XB + (64 + lane) * 32 + p * 2) = F2BF(cre * bi + cim * br); }
    WAVE_SYNC();
    v8s bfrag[8];
#pragma unroll
    for (int nt = 0; nt < 8; ++nt) { if (fq < 2) bfrag[nt] = *(LP(const v8s))(XB + (16 * nt + fr) * 32 + fq * 16); else bfrag[nt] = (v8s){0, 0, 0, 0, 0, 0, 0, 0}; }
    v8s cfrag[4];
#pragma unroll
    for (int ks = 0; ks < 4; ++ks) { const int n0 = 32 * ks + 8 * fq; const float* src = (n0 < 64 ? c_re : c_im) + ((size_t)pg * 16 + fr) * 64 + (n0 & 63); const float sgn = n0 < 64 ? 1.f : -1.f;
        v8s f;
#pragma unroll
        for (int i = 0; i < 8; ++i) f[i] = (short)F2BF(sgn * src[i]);
        cfrag[ks] = f; }
    WAVE_SYNC();
    for (int i = lane; i < 1280 / 4; i += 64) ((LP(unsigned))UB)[i] = 0u;
    WAVE_SYNC();
    float hr = 0.f, hi = 0.f;
    bf16* Od = O + (size_t)dir * TT * 1024;
    constexpr int NBLK = CTXL / 16 + SEQ / 16;
    constexpr int S5_PF = 8;
    v4u ur[S5_PF];
#pragma unroll
    for (int i_ = 0; i_ < S5_PF; ++i_) ur[i_] = (v4u){0u, 0u, 0u, 0u};
#define S5_LOAD(bx, dst) do { if (lane < 32 && (bx) < NBLK) { const int seg_ = (bx) >= CTXL / 16, bi_ = seg_ ? (bx) - CTXL / 16 : (bx); \
        dst = *(const v4u*)(S + (size_t)PRBROW(tok_row(b, seg_, bi_ * 16 + (lane >> 1), dir, 0)) * ldS + g * 16 + (lane & 1) * 8); } } while (0)
#define S5_STAGE_A(bx) do { const v8s uf_ = *(LP(const v8s))(UB + fr * 80 + fq * 16); LP(unsigned char) xb_ = XB + ((bx) & 1) * 10240; \
        _Pragma("unroll") for (int nt = 0; nt < 8; ++nt) { v4f x = (v4f){0.f, 0.f, 0.f, 0.f}; x = MFMA16(uf_, bfrag[nt], x); *(LP(v4f))(xb_ + (16 * nt + fr) * 80 + fq * 16) = x; } } while (0)
#pragma unroll
    for (int i_ = 0; i_ < S5_PF; ++i_) S5_LOAD(i_, ur[i_]);
    if (lane < 32) *(LP(v4u))(UB + (lane >> 1) * 80 + (lane & 1) * 16) = ur[0];
#pragma unroll
    for (int i_ = 0; i_ + 1 < S5_PF; ++i_) ur[i_] = ur[i_ + 1];
    S5_LOAD(S5_PF, ur[S5_PF - 1]);
    WAVE_SYNC();
    S5_STAGE_A(0);
    static_assert(NBLK % S5_PF == 0, "ring unrolling");
#pragma unroll 1
    for (int bx0 = 0; bx0 <= NBLK; bx0 += S5_PF) {
#pragma unroll
    for (int ui = 0; ui < S5_PF; ++ui) {
        const int bx = bx0 + ui; if (bx > NBLK) break;
        WAVE_SYNC();
        v8s hf[4]; float xr[16], xi[16];
        if (bx >= 1) { LP(unsigned char) hb = HB + ((bx - 1) & 1) * 6144;
#pragma unroll
            for (int ks = 0; ks < 4; ++ks) hf[ks] = tr_frag(hb, 48, 32 * ks, 0, lane); }
        if (bx < NBLK) { LP(unsigned char) xb = XB + (bx & 1) * 10240;
#pragma unroll
            for (int q4 = 0; q4 < 4; ++q4) { const v4f a4 = *(LP(const v4f))(xb + lane * 80 + q4 * 16), b4 = *(LP(const v4f))(xb + (64 + lane) * 80 + q4 * 16);
                xr[4 * q4] = a4.x; xr[4 * q4 + 1] = a4.y; xr[4 * q4 + 2] = a4.z; xr[4 * q4 + 3] = a4.w; xi[4 * q4] = b4.x; xi[4 * q4 + 1] = b4.y; xi[4 * q4 + 2] = b4.z; xi[4 * q4 + 3] = b4.w; } }
        if (bx + 1 < NBLK) { if (lane < 32) *(LP(v4u))(UB + (lane >> 1) * 80 + (lane & 1) * 16) = ur[ui]; S5_LOAD(bx + 1 + S5_PF, ur[ui]); }
        WAVE_SYNC();
        if (bx + 1 < NBLK) S5_STAGE_A(bx + 1);
        if (bx >= 1) { const int pb = bx - 1, seg = pb >= CTXL / 16, bi = seg ? pb - CTXL / 16 : pb;
            if (seg && !prb) { v4f y = (v4f){0.f, 0.f, 0.f, 0.f};
#pragma unroll
                for (int ks = 0; ks < 4; ++ks) y = MFMA16(cfrag[ks], hf[ks], y);
                const int orow = tok_row(b, seg, bi * 16 + fr, dir, 0);
                *(v2u*)(Od + (size_t)orow * 1024 + g * 16 + 4 * fq) = (v2u){PK2(y.x, y.y), PK2(y.z, y.w)}; } }
        if (bx < NBLK) { LP(unsigned char) hb = HB + (bx & 1) * 6144;
            unsigned pr[8], pi[8];
#pragma unroll
            for (int t2 = 0; t2 < 8; ++t2) {
                const float r0 = ar * hr - ai * hi + xr[2 * t2], i0 = ar * hi + ai * hr + xi[2 * t2];
                hr = ar * r0 - ai * i0 + xr[2 * t2 + 1]; hi = ar * i0 + ai * r0 + xi[2 * t2 + 1];
                pr[t2] = PK2(r0, hr); pi[t2] = PK2(i0, hi); }
            *(LP(v4u))(hb + lane * 48) = (v4u){pr[0], pr[1], pr[2], pr[3]}; *(LP(v4u))(hb + lane * 48 + 16) = (v4u){pr[4], pr[5], pr[6], pr[7]};
            *(LP(v4u))(hb + (64 + lane) * 48) = (v4u){pi[0], pi[1], pi[2], pi[3]}; *(LP(v4u))(hb + (64 + lane) * 48 + 16) = (v4u){pi[4], pi[5], pi[6], pi[7]}; }
    }
    }
#undef S5_STAGE_A
#undef S5_LOAD
}

DEV void conv_prep_row(int r, const bf16* S, bf16* QK2, const float* conv_w, const float* conv_b, int lane) {
    int rm, rp; bool hasm, hasp;
    if (r < TL) { const int b = r >> 12, n = r & (SEQ - 1), gr = n >> 6, col = n & 63, np = col * 64 + gr;
        hasm = np > 0; hasp = np < SEQ - 1; rm = seq_row(b, 1, hasm ? np - 1 : np, 1); rp = seq_row(b, 1, hasp ? np + 1 : np, 1); }
    else { const int n = (r - TL) & (CTXL - 1); hasm = n > 0; hasp = n < CTXL - 1; rm = hasm ? r - 1 : r; rp = hasp ? r + 1 : r; }
    const bf16* s0 = S + (size_t)rm * EV_PAD + 3072; const bf16* s1 = S + (size_t)r * EV_PAD + 3072; const bf16* s2 = S + (size_t)rp * EV_PAD + 3072;
#pragma unroll
    for (int i = 0; i < 4; ++i) { const int c = 8 * lane + 512 * i;
        const v4u a0 = *(const v4u*)(s0 + c), a1 = *(const v4u*)(s1 + c), a2 = *(const v4u*)(s2 + c);
        const unsigned w0[4] = {a0.x, a0.y, a0.z, a0.w}, w1[4] = {a1.x, a1.y, a1.z, a1.w}, w2[4] = {a2.x, a2.y, a2.z, a2.w};
        const float sc = c >= 1024 ? 0.0625f : 1.0f;
        float val[8];
#pragma unroll
        for (int i2 = 0; i2 < 4; ++i2)
#pragma unroll
            for (int e = 0; e < 2; ++e) { const int di = 2 * i2 + e;
                const float um = hasm ? (e ? bfhi(w0[i2]) : bflo(w0[i2])) : 0.f, u0 = e ? bfhi(w1[i2]) : bflo(w1[i2]), up = hasp ? (e ? bfhi(w2[i2]) : bflo(w2[i2])) : 0.f;
                const float pre = conv_b[c + di] + conv_w[c + di] * um + conv_w[2048 + c + di] * u0 + conv_w[4096 + c + di] * up;
                val[di] = pre * RCPF(1.0f + EXPF(-pre)) * sc; }
        *(v4u*)(QK2 + (size_t)r * 2048 + c) = (v4u){PK2(val[0], val[1]), PK2(val[2], val[3]), PK2(val[4], val[5]), PK2(val[6], val[7])}; }
}

DEV v4f ld4bf(const bf16* p) { const v2u w = *(const v2u*)p; return (v4f){bflo(w.x), bfhi(w.x), bflo(w.y), bfhi(w.y)}; }
DEV float wsum(float v) {
#pragma unroll
    for (int o = 1; o < 64; o <<= 1) v += SHX(v, o);
    return v;
}
DEV float grp16_sum(float v) { v += SHX(v, 1); v += SHX(v, 2); v += SHX(v, 4); v += SHX(v, 8); return v; }
DEV void ld16bf(const bf16* p, float (&o)[16]) { const v4u a = *(const v4u*)p, b = *(const v4u*)(p + 8); const unsigned w[8] = {a.x, a.y, a.z, a.w, b.x, b.y, b.z, b.w};
#pragma unroll
    for (int i = 0; i < 8; ++i) { o[2 * i] = bflo(w[i]); o[2 * i + 1] = bfhi(w[i]); } }
DEV void ld16f(const float* p, float (&o)[16]) {
#pragma unroll
    for (int i = 0; i < 4; ++i) { const v4f a = *(const v4f*)(p + 4 * i); o[4 * i] = a.x; o[4 * i + 1] = a.y; o[4 * i + 2] = a.z; o[4 * i + 3] = a.w; } }
DEV void st16bf(bf16* p, const float (&o)[16]) { *(v4u*)p = (v4u){PK2(o[0], o[1]), PK2(o[2], o[3]), PK2(o[4], o[5]), PK2(o[6], o[7])}; *(v4u*)(p + 8) = (v4u){PK2(o[8], o[9]), PK2(o[10], o[11]), PK2(o[12], o[13]), PK2(o[14], o[15])}; }
template <int CENTER, int GATE>
DEV void head_norm16(const bf16* o0, const bf16* o1, const float* gain, const bf16* gs, bf16* dst) {
    float a[16], b2[16], g[16], gt[16];
    ld16bf(o0, a); ld16bf(o1, b2); ld16f(gain, g); ld16bf(gs, gt);
    float s = 0.f;
#pragma unroll
    for (int i = 0; i < 16; ++i) { a[i] += b2[i]; s += a[i]; }
    if (CENTER) { const float mean = grp16_sum(s) * (1.0f / 256.0f);
#pragma unroll
        for (int i = 0; i < 16; ++i) a[i] -= mean; }
    float q = 0.f;
#pragma unroll
    for (int i = 0; i < 16; ++i) q += a[i] * a[i];
    const float rstd = RSQRTF(grp16_sum(q) * (1.0f / 256.0f) + EPS);
#pragma unroll
    for (int i = 0; i < 16; ++i) { const float sg = RCPF(1.0f + EXPF(-gt[i])); const float gate = GATE ? sg : gt[i] * sg; a[i] = gate * (a[i] * rstd * g[i]); }
    st16bf(dst, a);
}
DEV void merge_even_row(int r, const bf16* S, const bf16* O, const float* gla_norm, const float* ml_norm, bf16* HBo, int lane) {
    const bf16* sr = S + (size_t)r * EV_PAD; const int c = 16 * lane; const bf16* ob = O + (size_t)r * 1024 + c; const size_t os = (size_t)TT * 1024;
    head_norm16<0, 0>(ob, ob + os, gla_norm + c, sr + 2048 + c, HBo + (size_t)r * D + c);
    head_norm16<1, 1>(ob + 2 * os, ob + 3 * os, ml_norm + c, sr + 6144 + c, HBo + (size_t)r * D + 1024 + c);
}
DEV float gelu_tanh(float y) { const float z = 0.7978845608028654f * (y + 0.044715f * y * y * y); const float t = 1.0f - 2.0f * RCPF(1.0f + EXPF(2.0f * z)); return 0.5f * y * (1.0f + t); }
DEV void merge_odd_row(int r, const bf16* S, const bf16* O, const float* s5_d, const float* ret_norm, bf16* GBo, bf16* HBo, int lane) {
    const bf16* sr = S + (size_t)r * OD_COLS; const int c = 16 * lane; const bf16* ob = O + (size_t)r * 1024 + c; const size_t os = (size_t)TT * 1024;
    {
        float y0[16], y1[16], dd[16], u[16];
        ld16bf(ob, y0); ld16bf(ob + os, y1); ld16f(s5_d + c, dd); ld16bf(sr + c, u);
#pragma unroll
        for (int i = 0; i < 16; ++i) {
#ifdef NO_S5
            y0[i] = 0.f; y1[i] = 0.f;
#endif
            y0[i] = gelu_tanh(y0[i] + y1[i] + dd[i] * u[i]); }
        st16bf(GBo + (size_t)r * 1024 + c, y0);
    }
    head_norm16<1, 0>(ob + 2 * os, ob + 3 * os, ret_norm + c, sr + 4096 + c, HBo + (size_t)r * D + 1024 + c);
}

struct EpiGLU {
    static constexpr bool PERM = true, AFTER_DRAIN = false;
    const bf16* G; const float* bias; bf16* O;
    __device__ __forceinline__ void operator()(const pg8::f32x4 (&acc)[2][2][4][2], const pg8::Unit& u, int wr, int wc, int fr, int fq) const {
        const int row0 = u.pm * 256 + wr * 64 + fr, col0 = u.pn * 256 + wc * 32 + 8 * fq;
#pragma unroll
        for (int ai = 0; ai < 2; ++ai)
#pragma unroll
            for (int m = 0; m < 4; ++m) { const size_t row = (size_t)(row0 + ai * 128 + m * 16);
#pragma unroll
                for (int bj = 0; bj < 2; ++bj) { const int col = col0 + bj * 128;
                    const v4u gw = *(const v4u*)(G + row * 1024 + col); const pg8::f32x4 b0 = *(const pg8::f32x4*)(bias + col), b1 = *(const pg8::f32x4*)(bias + col + 4);
                    const pg8::f32x4 v0 = acc[ai][bj][m][0] + b0, v1 = acc[ai][bj][m][1] + b1;
                    v4u w; w.x = pk2(bflo(gw.x) * fast_sigmoid(v0[0]), bfhi(gw.x) * fast_sigmoid(v0[1])); w.y = pk2(bflo(gw.y) * fast_sigmoid(v0[2]), bfhi(gw.y) * fast_sigmoid(v0[3]));
                    w.z = pk2(bflo(gw.z) * fast_sigmoid(v1[0]), bfhi(gw.z) * fast_sigmoid(v1[1])); w.w = pk2(bflo(gw.w) * fast_sigmoid(v1[2]), bfhi(gw.w) * fast_sigmoid(v1[3]));
                    *(v4u*)(O + row * D + col) = w; } }
    }
};

#ifndef SCAN_REPS
#define SCAN_REPS 1
#endif
__device__ __forceinline__ void mixer_phases(const Args& a, unsigned char* ws, LAS unsigned char* lds, const XcdBarrier& bar, int layer, int G, int gw, int ngw, int tid, int lane, int wave) {
#define HB ((bf16*)wsp(ws, WS_HB))
#define S ((bf16*)wsp(ws, WS_S))
#define GT ((float*)wsp(ws, WS_GT))
#define O ((bf16*)wsp(ws, WS_O))
#define GB ((bf16*)wsp(ws, WS_GB))
#define Y ((bf16*)wsp(ws, WS_Y))
    const int ldS = layer == 0 ? EV_PAD : OD_COLS;
    { pg8::Gemm g{HB, (const bf16*)(wsp(ws, (layer == 0 ? WS_WIN_EV : WS_WIN_OD))), TT, ldS, D}; pg8::StaticOrder So; So.init(TT, ldS, G, (int)blockIdx.x);
      EpiS E{S, ldS, GT, layer == 0 ? 28 : -1};
      pg8::gemm_phase<EpiS, pg8::StaticOrder, true, true>(lds, g, So, E); }
    XBAR();
#define QK2 ((bf16*)wsp(ws, WS_QK2))
#define GP ((float*)wsp(ws, WS_GP))
#define QKS ((bf16*)wsp(ws, WS_QKS))
#define GPK ((float*)wsp(ws, WS_GPK))
#define PP ((bf16*)wsp(ws, WS_PP))
#define RS ((float*)wsp(ws, WS_RS))
#define VEC ((float*)wsp(ws, WS_VEC))
    { int t2 = threadIdx.x; asm volatile("" : "+v"(t2)); tid = t2; lane = t2 & 63; wave = __builtin_amdgcn_readfirstlane(t2 >> 6); gw = blockIdx.x * NWAVES + wave; }
    if (layer == 0) {
#ifndef REP_CONV
#define REP_CONV 1
#endif
#ifndef REP_GPREP
#define REP_GPREP 1
#endif
#pragma unroll 1
        for (int r_ = 0; r_ < REP_CONV; ++r_)
        { const bf16* s_ = S; bf16* qk_ = QK2; const float* cw_ = ARG(16); const float* cb_ = ARG(17); for (int r = gw; r < TT; r += ngw) conv_prep_row(r, s_, qk_, cw_, cb_, lane); }
#pragma unroll 1
        for (int r_ = 0; r_ < REP_GPREP; ++r_)
        { int t2 = threadIdx.x; asm volatile("" : "+v"(t2)); gla_prep_loop((int)blockIdx.x, G, S, GT, ARG(13), ARG(14), QKS, VEC, lds, t2); }
        XBAR();
        { int t2 = threadIdx.x; asm volatile("" : "+v"(t2)); mat_prep_loop<0>((int)blockIdx.x, G, QK2, 2048, 0, 1024, 1.0f, GT, ARG(18), GP, GPK, nullptr, PP, RS, lds, t2); }
        XBAR();
    } else {
        { int t2 = threadIdx.x; asm volatile("" : "+v"(t2)); mat_prep_loop<1>((int)blockIdx.x, G, S, OD_COLS, 1024, 2048, 0.0625f, nullptr, nullptr, nullptr, nullptr, ARG(32), PP, RS, lds, t2); }
        XBAR();
    }
#ifdef PRE_SLEEP
    { const unsigned long long t0_ = __builtin_amdgcn_s_memrealtime(); while (__builtin_amdgcn_s_memrealtime() - t0_ < (unsigned long long)(PRE_SLEEP) * 100ull) __builtin_amdgcn_s_sleep(16); XBAR(); }
#endif
    { int t2 = threadIdx.x; asm volatile("" : "+v"(t2)); tid = t2; lane = t2 & 63; wave = __builtin_amdgcn_readfirstlane(t2 >> 6); }
#ifdef PREREAD
    if (layer == 0) {
        const v4u* p0 = (const v4u*)QKS; const v4u* p1 = (const v4u*)QK2; v4u acc = (v4u){0u, 0u, 0u, 0u};
        const unsigned n0 = 2u * TT * 1024 / 8, n1 = (unsigned)TT * 2048 / 8;
        for (unsigned i = blockIdx.x * NTHR + tid; i < n0; i += (unsigned)G * NTHR) { const v4u v = p0[i]; acc.x ^= v.x; acc.y ^= v.y; acc.z ^= v.z; acc.w ^= v.w; }
        if (PREREAD >= 2) for (unsigned i = blockIdx.x * NTHR + tid; i < n1; i += (unsigned)G * NTHR) { const v4u v = p1[i]; acc.x ^= v.x; acc.y ^= v.y; acc.z ^= v.z; acc.w ^= v.w; }
        if ((acc.x ^ acc.y ^ acc.z ^ acc.w) == 0x9e3779b9u && tid == 511) ((unsigned*)wsp(ws, WS_CTL))[8000] = 1u;
        { int t2 = threadIdx.x; asm volatile("" : "+v"(t2)); tid = t2; lane = t2 & 63; wave = __builtin_amdgcn_readfirstlane(t2 >> 6); }
    }
#endif
#ifdef SCAN_PROBE
#pragma unroll
#else
#pragma unroll 1
#endif
    for (int rep = 0; rep < SCAN_REPS; ++rep) {
#ifdef SCAN_PROBE
    const int prb = rep < SCAN_REPS - 1 ? SCAN_PROBE : 0;
#else
    constexpr int prb = 0;
#endif
#ifndef SIB_LOCKSTEP
#define SIB_LOCKSTEP 0
#endif
#define SIBP(ty, un) ((SIB_LOCKSTEP && G >= 2 * MIX_UNITS && SCAN_REPS == 1) ? (unsigned*)(wsp(ws, WS_CTL) + 16384 + ((ty) * 32 + ((un) >> 2)) * 64) : (unsigned*)nullptr)
#define UNIT_OF(w) (NB == 4 ? (((((w) & 7) * 4 + (((w) >> 3) & 15) / 4) << 2) | ((((w) >> 3) & 15) & 3)) : (w))
    if (layer == 0) {
#ifdef SPLIT_L0
        for (int it = blockIdx.x; it < MIX_UNITS; it += G) gla_unit(S, QKS, VEC, O, UNIT_OF(it), lds, tid, SIBP(0, UNIT_OF(it)), prb);
        XBAR();
        for (int it = blockIdx.x; it < 2 * MIX_UNITS; it += G) if (it >= MIX_UNITS) mat_unit<0>(QK2, 2048, 0, 1024, S, EV_PAD, 5120, 1.0f, GP, GPK, PP, RS, O, 1, nullptr, UNIT_OF(it - MIX_UNITS), lds, tid, SIBP(1, UNIT_OF(it - MIX_UNITS)), prb);
        if (false)
#endif
        for (int it = blockIdx.x; it < 2 * MIX_UNITS; it += G) {
            if (it < MIX_UNITS) {
#ifndef REP_GLA
#define REP_GLA 1
#endif
#pragma unroll 1
                for (int r_ = 0; r_ < REP_GLA; ++r_) gla_unit(S, QKS, VEC, O, UNIT_OF(it), lds, tid, SIBP(0, UNIT_OF(it)), prb);
                if (DEFER == 1 && G >= 2 * MIX_UNITS) convert_tiles(a, ws, 1, (int)blockIdx.x * NWAVES + wave, MIX_UNITS * NWAVES, lane);
            } else {
#ifndef REP_ML
#define REP_ML 1
#endif
#pragma unroll 1
                for (int r_ = 0; r_ < REP_ML; ++r_) mat_unit<0>(QK2, 2048, 0, 1024, S, EV_PAD, 5120, 1.0f, GP, GPK, PP, RS, O, 1, nullptr, UNIT_OF(it - MIX_UNITS), lds, tid, SIBP(1, UNIT_OF(it - MIX_UNITS)), prb);
            }
        }
        if (DEFER == 1 && G < 2 * MIX_UNITS) convert_tiles(a, ws, 1, (int)blockIdx.x * NWAVES + wave, G * NWAVES, lane);
    } else {
        const int s5_first = G >= 2 * MIX_UNITS ? MIX_UNITS : 0, s5_wgs = G - s5_first;
#ifndef REP_RET
#define REP_RET 1
#endif
#ifndef REP_S5
#define REP_S5 1
#endif
#pragma unroll 1
        for (int r_ = 0; r_ < REP_RET; ++r_)
        for (int u = blockIdx.x; u < MIX_UNITS; u += G)
            mat_unit<1>(S, OD_COLS, 1024, 2048, S, OD_COLS, 3072, 0.0625f, nullptr, nullptr, PP, RS, O, 0, ARG(32), UNIT_OF(u), lds, tid, SIBP(2, UNIT_OF(u)), prb);
        if (DEFER == 1 && rep == 0 && (int)blockIdx.x >= s5_first && wave >= 4) convert_tiles(a, ws, 2, ((int)blockIdx.x - s5_first) * 4 + (wave - 4), 4 * s5_wgs, lane);
#pragma unroll 1
        for (int r_ = 0; r_ < REP_S5; ++r_)
        if ((int)blockIdx.x >= s5_first && wave < 4) { for (int su = ((int)blockIdx.x - s5_first) * 4 + wave; su < NB * 128; su += 4 * s5_wgs)
            s5_unit(S, OD_COLS, O, ARG(22), ARG(23), ARG(24), ARG(25), ARG(26), ARG(27), ARG(28), su, lds + wave * S5_LDS_PER_WAVE, lane, prb); }
    }
    }
    XBAR();
    { int t2 = threadIdx.x; asm volatile("" : "+v"(t2)); tid = t2; lane = t2 & 63; wave = __builtin_amdgcn_readfirstlane(t2 >> 6); gw = blockIdx.x * NWAVES + wave; }
#ifndef NO_MERGE
    if (layer == 0) { const bf16* s_ = S; const bf16* o_ = O; const float* n0 = ARG(15); const float* n1 = ARG(19); bf16* hb_ = HB; for (int r = gw; r < TT; r += ngw) merge_even_row(r, s_, o_, n0, n1, hb_, lane); }
    else { const bf16* s_ = S; const bf16* o_ = O; const float* n0 = ARG(29); const float* n1 = ARG(33); bf16* gb_ = GB; bf16* hb_ = HB; for (int r = gw; r < TL; r += ngw) merge_odd_row(r, s_, o_, n0, n1, gb_, hb_, lane); }
#endif
    XBAR();
    const int Mo = layer == 0 ? TT : TL;
    if (layer == 1) {
        pg8::Gemm g{GB, (const bf16*)(wsp(ws, WS_WGLU)), TL, 1024, 1024}; pg8::StaticOrder So; So.init(TL, 1024, G, (int)blockIdx.x);
        EpiGLU E{GB, ARG(31), HB};
        pg8::gemm_phase<EpiGLU, pg8::StaticOrder, true, true>(lds, g, So, E);
        XBAR();
    }
    { pg8::Gemm g{HB, (const bf16*)(wsp(ws, (layer == 0 ? WS_WOUT_EV : WS_WOUT_OD))), Mo, D, D}; pg8::SplitOrder So; So.init(Mo - TL, D, G, (int)blockIdx.x);
      EpiF32 E{Y, (float*)(wsp(ws, WS_YCP))};
      pg8::gemm_phase<EpiF32, pg8::SplitOrder, true, true>(lds, g, So, E); }
    XBAR();
}
#undef HB
#undef S
#undef GT
#undef O
#undef GB
#undef Y
#undef QK2
#undef GP
#undef QKS
#undef GPK
#undef PP
#undef RS
#undef VEC
#undef UNIT_OF
#undef SIBP

#ifndef MIXER_ON
#define MIXER_ON 1
#endif
__global__ void __launch_bounds__(NTHR, 2) fwd(Args a) {
    extern __shared__ __attribute__((aligned(16))) unsigned char lds_raw[];
    LAS unsigned char* lds = (LAS unsigned char*)lds_raw;
    const int tid = threadIdx.x, lane = tid & 63, wave = __builtin_amdgcn_readfirstlane(tid >> 6);
    const int G = gridDim.x, gw = blockIdx.x * NWAVES + wave, ngw = G * NWAVES;
    unsigned char* ws = a.ws;
    if (tid < 16) ((LAS unsigned*)(lds + MISC_OFF))[tid] = 0u;
    __syncthreads();
#ifdef PROBE_A
    if (blockIdx.x == 0 && tid == 0) { volatile LAS unsigned* M_ = (volatile LAS unsigned*)(lds + MISC_OFF); const unsigned lo_ = (unsigned)__builtin_amdgcn_s_memrealtime(); if (PROBE_A == 0) M_[6] = lo_; if (PROBE_B == 0) M_[8] = lo_; }
#endif
    XcdBarrier bar = xcd_barrier_post((unsigned*)(wsp(ws, WS_CTL)), (volatile LAS unsigned*)(lds + MISC_OFF));

#ifdef NAN_POISON
    {
        v4u q = (v4u){0xffffffffu, 0xffffffffu, 0xffffffffu, 0xffffffffu};
        for (int i = tid; i < (MISC_OFF) / 16; i += NTHR) ((LAS v4u*)lds)[i] = q;
        { v4u* p = (v4u*)(wsp(ws, WS_MOD)); const size_t n = (WS_WGU - WS_MOD) / 16; for (size_t i = (size_t)blockIdx.x * NTHR + tid; i < n; i += (size_t)G * NTHR) p[i] = q; }
        { v4u* p = (v4u*)(wsp(ws, WS_XC)); const size_t n = (WS_END - WS_XC) / 16; for (size_t i = (size_t)blockIdx.x * NTHR + tid; i < n; i += (size_t)G * NTHR) p[i] = q; }
        { v4u* p = (v4u*)a.out; const size_t n = (size_t)TL * D * 4 / 16; for (size_t i = (size_t)blockIdx.x * NTHR + tid; i < n; i += (size_t)G * NTHR) p[i] = q; }
        __syncthreads();
        XBAR();
    }
#endif
#define MOD ((float*)wsp(ws, WS_MOD))
#define MODP ((float*)wsp(ws, WS_MODP))
#define HB ((bf16*)wsp(ws, WS_HB))
#define HID ((bf16*)wsp(ws, WS_HID))
#define Y ((bf16*)wsp(ws, WS_Y))
#define XC ((bf16*)wsp(ws, WS_XC))
#define XL ((bf16*)wsp(ws, WS_XL))

#ifndef REP_PRO
#define REP_PRO 1
#endif
#ifndef REP_GU
#define REP_GU 1
#endif
#ifndef REP_DN
#define REP_DN 1
#endif
#pragma unroll 1
    for (int rep_ = 0; rep_ < REP_PRO; ++rep_) {
        __syncthreads();
        LAS float* stab = (LAS float*)(lds + 1024);
        { const float* cin = ARG(1); const float* cctx = ARG(3);
        for (int i = tid; i < 5 * D; i += NTHR) { const int r = i >> 11, k = i & (D - 1); const float c = r < 4 ? cin[r * D + k] : cctx[k]; stab[i] = c / (1.0f + expf(-c)); } }
        __syncthreads();
#define MOD_ITEM(it) do { \
            const int l = (it) / (MOD_KC * 72), rem = (it) % (MOD_KC * 72), kc = rem / 72, jb = rem % 72; constexpr int KCH = D / MOD_KC; \
            const float* W = ARG(4) + ((size_t)l * D + kc * KCH) * (NMOD * D) + jb * 256 + lane * 4; \
            f32x4 acc[5]; \
            _Pragma("unroll") for (int r = 0; r < 5; ++r) acc[r] = (f32x4){0.f, 0.f, 0.f, 0.f}; \
            for (int k = 0; k < KCH; k += 8) { f32x4 w[8]; \
                _Pragma("unroll") for (int i = 0; i < 8; ++i) w[i] = *(const f32x4*)(W + (size_t)(k + i) * (NMOD * D)); \
                _Pragma("unroll") for (int i = 0; i < 8; ++i) \
                    _Pragma("unroll") for (int r = 0; r < 5; ++r) acc[r] += stab[r * D + kc * KCH + k + i] * w[i]; } \
            { float* modp = MODP; \
            _Pragma("unroll") for (int r = 0; r < 5; ++r) *(f32x4*)(modp + (((size_t)l * MOD_KC + kc) * 5 + r) * (NMOD * D) + jb * 256 + lane * 4) = acc[r]; } } while (0)
#ifndef DEFER
#define DEFER 1
#endif
#if DEFER == 2
        {
            LAS unsigned* tick = (LAS unsigned*)(lds + MISC_OFF) + 12;
            constexpr int MOD_ITEMS = 2 * MOD_KC * 72, NPAIRS = NT_SET0_D2 / 2;
            const int mod_tk = (MOD_ITEMS + G - 1) / G;
#pragma unroll 1
            for (;;) {
                unsigned tk0 = 0u; if (lane == 0) tk0 = __hip_atomic_fetch_add(tick, 1u, __ATOMIC_RELAXED, __HIP_MEMORY_SCOPE_WORKGROUP);
                const int tk = __builtin_amdgcn_readfirstlane((int)tk0);
                if (tk < mod_tk) { const int it = tk * G + (int)blockIdx.x; if (it < MOD_ITEMS) MOD_ITEM(it); }
                else { const int p = (tk - mod_tk) * G + (int)blockIdx.x; if (p >= NPAIRS) break; convert_pair_set0(a, ws, 2 * p, lane); }
            }
        }
#else
        for (int it = gw; it < 2 * MOD_KC * 72; it += ngw) MOD_ITEM(it);
        convert_tiles(a, ws, 0, gw, ngw, lane);
        if (!DEFER) { convert_tiles(a, ws, 1, gw, ngw, lane); convert_tiles(a, ws, 2, gw, ngw, lane); }
#endif
#undef MOD_ITEM
        { v4u z = (v4u){0u, 0u, 0u, 0u}; v4u* p = (v4u*)(wsp(ws, WS_WIN_EV) + (size_t)EV_COLS * 2048 * 2); const int n16 = (EV_PAD - EV_COLS) * 2048 * 2 / 16;
          for (int i = blockIdx.x * NTHR + tid; i < n16; i += G * NTHR) p[i] = z; }
    }
    XBAR();
    { const float* bmod = ARG(5); const float* modp = MODP; float* modf = MOD;
    for (int i = blockIdx.x * NTHR + tid; i < 2 * 5 * NMOD * D; i += G * NTHR) {
        const int l = i / (5 * NMOD * D), rem = i % (5 * NMOD * D), r = rem / (NMOD * D), j = rem % (NMOD * D);
        float s = bmod[l * (NMOD * D) + j];
        for (int kc = 0; kc < MOD_KC; ++kc) s += modp[(((size_t)l * MOD_KC + kc) * 5 + r) * (NMOD * D) + j];
        modf[i] = s;
    } }
    XBAR();
#ifndef REP_N0
#define REP_N0 1
#endif
#pragma unroll 1
    for (int rep_ = 0; rep_ < REP_N0; ++rep_)
    { NormP p{}; p.xin_lat = ARG(0); p.xin_ctx = ARG(2); p.xin_f32 = 1; p.xout_f32 = 0; p.xout_lat = XL; p.xout_ctx = XC; p.y = nullptr; p.h = HB; p.rows_end = TT; p.has_y = 0; p.has_h = 1; p.w = 0.f; p.lp = 0; p.sp = 0; p.ln = 0; p.sn = 0;
      norm_phase(p, MOD, ARG(6), ARG(7), lds, gw, ngw, tid, lane); }
    XBAR();

#pragma unroll 1
    for (int layer = 0; layer < 2; ++layer) {
#pragma unroll 1
        for (int half = 0; half < 2; ++half) {
            const int Mrows = (layer == 1 && half == 1) ? TL : TT;
#if MIXER_ON
            if (half == 1) {
                mixer_phases(a, ws, lds, bar, layer, G, gw, ngw, tid, lane, wave);
                NormP p{}; p.xin_lat = XL; p.xin_ctx = XC; p.xin_f32 = 0; p.xout_f32 = 0; p.xout_lat = XL; p.xout_ctx = XC; p.y = Y; p.y_ctx = (const float*)(wsp(ws, WS_YCP)); p.h = HB; p.rows_end = Mrows; p.has_y = 1; p.has_h = 1; p.w = 1.0f; p.lp = layer; p.sp = 1; p.ln = layer; p.sn = 2;
                norm_phase(p, MOD, ARG(6), ARG(7), lds, gw, ngw, tid, lane);
                XBAR();
            }
#endif
            const int sub = half * 2;
#pragma unroll 1
            for (int rep_ = 0; rep_ < REP_GU; ++rep_) { pg8::Gemm g{HB, (const bf16*)(wsp(ws, WS_WGU) + (size_t)(layer * 2 + half) * SZ_WGU), Mrows, 2 * DFF, D}; pg8::StaticOrder S; S.init(Mrows, 2 * DFF, G, (int)blockIdx.x);
              EpiSwiGLU E{HID, DFF};
              pg8::gemm_phase<EpiSwiGLU, pg8::StaticOrder, true, true>(lds, g, S, E);
              if (DEFER == 2 && rep_ == 0 && !(layer == 1 && half == 1)) {
                  const int rem = ((Mrows / 256) * (2 * DFF / 256)) % G, nidle = rem ? G - rem : G, me = rem ? (int)blockIdx.x - rem : (int)blockIdx.x;
                  if (me >= 0) { int t2 = threadIdx.x; asm volatile("" : "+v"(t2)); convert_tiles(a, ws, layer * 2 + half + 1, me * NWAVES + __builtin_amdgcn_readfirstlane(t2 >> 6), nidle * NWAVES, t2 & 63); } }
              if (rep_ + 1 < REP_GU) XBAR(); }
            XBAR();
#pragma unroll 1
            for (int rep_ = 0; rep_ < REP_DN; ++rep_) { pg8::Gemm g{HID, (const bf16*)(wsp(ws, WS_WD) + (size_t)(layer * 2 + half) * SZ_WD), Mrows, D, DFF}; pg8::SplitOrder S; S.init(Mrows - TL, DFF, G, (int)blockIdx.x);
              EpiF32 E{Y, (float*)(wsp(ws, WS_YCP))};
              pg8::gemm_phase<EpiF32, pg8::SplitOrder, true, true>(lds, g, S, E);
              if (rep_ + 1 < REP_DN) XBAR(); }
            XBAR();
            { NormP p{}; const bool first = (layer == 0 && half == 0);
              const bool lastp = (layer == 1 && half == 1);
              p.xin_lat = first ? (const void*)ARG(0) : (const void*)XL; p.xin_ctx = first ? (const void*)ARG(2) : (const void*)XC; p.xin_f32 = first ? 1 : 0;
              p.xout_lat = lastp ? (void*)a.out : (void*)XL; p.xout_ctx = XC; p.xout_f32 = lastp ? 1 : 0; p.y = Y; p.y_ctx = (const float*)(wsp(ws, WS_YCP)); p.h = HB; p.rows_end = Mrows; p.has_y = 1; p.w = 0.5f; p.lp = layer; p.sp = sub;
              if (half == 0) { p.has_h = 1; p.ln = layer; p.sn = MIXER_ON ? 1 : 2; }
              else if (layer == 0) { p.has_h = 1; p.ln = 1; p.sn = 0; }
              else { p.has_h = 0; p.ln = 0; p.sn = 0; }
              norm_phase(p, MOD, ARG(6), ARG(7), lds, gw, ngw, tid, lane); }
            if (!(layer == 1 && half == 1)) XBAR();
        }
    }
#ifdef PROBE_A
    XBAR();
    if (blockIdx.x == 0 && threadIdx.x == 0) { volatile LAS unsigned* M_ = (volatile LAS unsigned*)(lds + MISC_OFF);
        const unsigned ticks = (M_[7] - M_[6]) + (PROBE_B >= 0 ? (M_[9] - M_[8]) : 0u);
        const unsigned long long t0 = __builtin_amdgcn_s_memrealtime();
        while (__builtin_amdgcn_s_memrealtime() - t0 < 8ull * ticks) __builtin_amdgcn_s_sleep(8); }
#endif
}

#undef MOD
#undef MODP
#undef HB
#undef HID
#undef Y
#undef XC
#undef XL
extern "C" void kernel_launch(void* const* d_in, const int* in_sizes, int n_in, void* d_out, int out_size, void* d_ws, size_t ws_size, hipStream_t stream) {
    static int grid = 0;
    if (grid == 0) {
        if (n_in != 34 || out_size != TL * D || ws_size < WS_END) { fprintf(stderr, "kernel_launch: unexpected shapes (n_in %d out %d ws %zu need %zu)\n", n_in, out_size, ws_size, (size_t)WS_END); grid = -1; return; }
        int dev = 0, cus = 0, per_cu = 0;
        if (hipGetDevice(&dev) != hipSuccess || hipDeviceGetAttribute(&cus, hipDeviceAttributeMultiprocessorCount, dev) != hipSuccess) { grid = -1; return; }
        if (hipFuncSetAttribute((const void*)fwd, hipFuncAttributeMaxDynamicSharedMemorySize, LDS_BYTES) != hipSuccess) { fprintf(stderr, "kernel_launch: hipFuncSetAttribute failed\n"); grid = -1; return; }
        if (hipOccupancyMaxActiveBlocksPerMultiprocessor(&per_cu, (const void*)fwd, NTHR, LDS_BYTES) != hipSuccess || per_cu < 1) { fprintf(stderr, "kernel_launch: occupancy query says %d\n", per_cu); }
        (void)hipGetLastError();
        grid = cus;
    }
    if (grid < 0) return;
    if (hipMemsetAsync((char*)d_ws + WS_CTL, 0, CTL_ZERO_BYTES, stream) != hipSuccess) return;
    Args a{};
    for (int i = 0; i < 34; ++i) a.in[i] = (const float*)d_in[i];
    a.out = (float*)d_out; a.ws = (unsigned char*)d_ws;
    hipLaunchKernelGGL(fwd, dim3(grid), dim3(NTHR), LDS_BYTES, stream, a);
}
```

```cpp
#include <hip/hip_runtime.h>
#include <cstdio>
#include <cstdint>
#define MIXER_ON 1

#define XB_TMO      128
#define XB_XCNT(j)  (256  + 64 * (j))
#define XB_XSUB(j)  (1280 + 64 * (j))
#define XB_XGEN(j)  (2304 + 64 * (j))
#define XB_TOP      3328
#define XB_TOPGEN   3392
#define XCD_BAR_WORDS 3456
#define XB_SPIN_CAP (1u << 18)
#define LAS __attribute__((address_space(3)))

__device__ __forceinline__ unsigned xb_ld(unsigned* p)              { return __hip_atomic_load(p, __ATOMIC_RELAXED, __HIP_MEMORY_SCOPE_AGENT); }
__device__ __forceinline__ unsigned xb_add(unsigned* p, unsigned v) { return __hip_atomic_fetch_add(p, v, __ATOMIC_RELAXED, __HIP_MEMORY_SCOPE_AGENT); }
__device__ __forceinline__ unsigned xb_xcc_id() { return (unsigned)__builtin_amdgcn_s_getreg((3 << 11) | 20) & 0xFu; }
#define XB_SPIN(cond, bar) do { unsigned _sp = 0; while (cond) { __builtin_amdgcn_s_sleep(1); \
    if ((++_sp & 255u) == 0u) { if (xb_ld(&(bar)[XB_TMO])) break; if (_sp > XB_SPIN_CAP) { atomicAdd(&(bar)[XB_TMO], 1u); break; } } } } while (0)

struct XcdBarrier {
    unsigned* bar; unsigned x;
    volatile LAS unsigned* st;
};

__device__ __forceinline__ XcdBarrier xcd_barrier_post(unsigned* bar, volatile LAS unsigned* st) {
    XcdBarrier b; b.bar = bar; b.x = xb_xcc_id(); b.st = st;
    if (threadIdx.x == 0) (void)xb_add(&bar[XB_XCNT(b.x)], 1u);
    return b;
}
__device__ __forceinline__ void xcd_barrier_complete(unsigned* bar, unsigned x, unsigned& nloc, unsigned& nx) {
    const unsigned G = gridDim.x * gridDim.y * gridDim.z;
    unsigned sum, cnt, mine, sp = 0u;
    for (;;) {
        sum = 0u; cnt = 0u; mine = 0u;
#pragma unroll
        for (unsigned j = 0; j < 16; ++j) { const unsigned c = xb_ld(&bar[XB_XCNT(j)]); sum += c; cnt += (c > 0u) ? 1u : 0u; mine = (j == x) ? c : mine; }
        if (sum == G) break;
        __builtin_amdgcn_s_sleep(1);
        if ((++sp & 255u) == 0u) { if (xb_ld(&bar[XB_TMO])) break; if (sp > XB_SPIN_CAP) { atomicAdd(&bar[XB_TMO], 1u); break; } }
    }
    nloc = mine > 0u ? mine : 1u; nx = cnt > 0u ? cnt : 1u;
}

__device__ __forceinline__ void xcd_barrier(const XcdBarrier& b) {
    asm volatile("s_waitcnt vmcnt(0)" ::: "memory");
    __syncthreads();
    if (threadIdx.x == 0) {
        unsigned* bar = b.bar;
        unsigned bx = __builtin_amdgcn_readfirstlane(b.x); asm volatile("" : "+s"(bx));
        __builtin_amdgcn_s_waitcnt(0);
        unsigned nloc = b.st[0], nx = b.st[1];
        if (nloc == 0u) { xcd_barrier_complete(bar, bx, nloc, nx); b.st[0] = nloc; b.st[1] = nx; }
        const unsigned old = xb_add(&bar[XB_XSUB(bx)], 1u);
        const unsigned gen = old / nloc;
        if (old + 1u == (gen + 1u) * nloc) {
            __builtin_amdgcn_fence(__ATOMIC_RELEASE, "agent");
            asm volatile("s_waitcnt vmcnt(0)" ::: "memory");
            const unsigned og = xb_add(&bar[XB_TOP], 1u);
            const unsigned tg = og / nx;
            if (og + 1u == (tg + 1u) * nx) xb_add(&bar[XB_TOPGEN], 1u);
            else XB_SPIN(xb_ld(&bar[XB_TOPGEN]) == tg, bar);
            __builtin_amdgcn_fence(__ATOMIC_ACQUIRE, "agent");
            xb_add(&bar[XB_XGEN(bx)], 1u);
            asm volatile("s_waitcnt vmcnt(0)" ::: "memory");
        } else {
            XB_SPIN(xb_ld(&bar[XB_XGEN(bx)]) == gen, bar);
            __builtin_amdgcn_fence(__ATOMIC_ACQUIRE, "agent");
            asm volatile("s_waitcnt vmcnt(0)" ::: "memory");
        }
    }
    __syncthreads();
}

namespace pg8 {
#define PG8_LAS __attribute__((address_space(3)))
typedef unsigned short bf16_t;
typedef short bf16x8 __attribute__((ext_vector_type(8)));
typedef float f32x4 __attribute__((ext_vector_type(4)));
typedef unsigned u32x4 __attribute__((ext_vector_type(4)));
constexpr int BM = 256, BK = 64, HALF = 128, HTB = HALF * BK * 2  , STAGE_BYTES = 8 * HTB, NXCD = 8, WGM = 8;

__host__ __device__ __forceinline__ int lds_byte(int r, int c) { const int st = (r >> 4) * 2 + (c >> 5), rr = r & 15, cc = c & 31, ob = rr * 64 + cc * 2; return st * 1024 + (ob ^ (((ob >> 9) & 1) << 5)); }
__host__ __device__ __forceinline__ void stage_rc(int b, int& R, int& C) { const int st = b / 1024, sb = b % 1024, swz = sb ^ (((sb >> 9) & 1) << 5); R = (st >> 1) * 16 + swz / 64; C = (st & 1) * 32 + (swz % 64) / 2; }
__host__ __device__ __forceinline__ int perm32(int rho) { const int n = rho >> 4, i = rho & 15; return 8 * (i >> 2) + 4 * n + (i & 3); }

struct Unit { int pm, pn, k0, nt, part; };
struct Gemm { const bf16_t* A; const bf16_t* Bt; int M, N, K; };

struct StaticOrder {
    int nM, nN, nwg, G, c;
    __host__ __device__ void init(int M, int N, int G_, int c_) { nM = M / BM; nN = N / BM; nwg = nM * nN; G = G_; c = c_; }
    __host__ __device__ bool next(int i, Unit& u) const {
        const long L = (long)i * G + c; if (L >= nwg) return false;
        int wgid = (int)L; { const int q = nwg / NXCD, r = nwg % NXCD, xcd = wgid % NXCD, off = wgid / NXCD; wgid = (xcd < r ? xcd * (q + 1) : r * (q + 1) + (xcd - r) * q) + off; }
        const int nig = WGM * nN, gid = wgid / nig, fm = gid * WGM, gsz = (nM - fm) < WGM ? (nM - fm) : WGM;
        u.pm = fm + ((wgid % nig) % gsz); u.pn = (wgid % nig) / gsz; u.k0 = 0; u.nt = 0; u.part = -1; return true;
    }
    __device__ __forceinline__ void a_ready(const Unit&) const {}
    __device__ __forceinline__ void done(const Unit&) const {}
};
struct SplitOrder {
    static constexpr int NMF = 64, NN = 8, PARTS = 8, NFULL = NMF * NN;
    int nsplit, ntK, G, c;
    __host__ __device__ void init(int Msplit, int K, int G_, int c_) { nsplit = (Msplit / BM) * NN * PARTS; ntK = K / BK; G = G_; c = c_; }
    __host__ __device__ bool next(int i, Unit& u) const {
        const int L = i * G + c, p = L - NFULL; const bool fullu = L < NFULL;
        const int wgid = (L % NXCD) * (NFULL / NXCD) + L / NXCD, nig = WGM * NN, fm = (wgid / nig) * WGM;
        const int q = p & 7, cu = p >> 3, h = ntK >> 1, ks = ((h * q) >> 3) << 1, ke = ((h * (q + 1)) >> 3) << 1;
        u.pm = fullu ? fm + ((wgid % nig) % WGM) : NMF + (cu >> 3);
        u.pn = fullu ? (wgid % nig) / WGM : (cu & 7);
        u.k0 = fullu ? 0 : ks; u.nt = fullu ? 0 : ke - ks; u.part = fullu ? -1 : q;
        return fullu || p < nsplit;
    }
    __device__ __forceinline__ void a_ready(const Unit&) const {}
    __device__ __forceinline__ void done(const Unit&) const {}
};
__device__ __forceinline__ unsigned cvt_pk_bf16(float lo, float hi) { unsigned r; asm volatile("v_cvt_pk_bf16_f32 %0, %1, %2" : "=v"(r) : "v"(lo), "v"(hi)); return r; }
template <class Epi, class Sched, bool ALIGN_EPI = false, bool SP2 = false>
__device__ __forceinline__ void gemm_phase(PG8_LAS unsigned char* lds, const Gemm g, const Sched& S, const Epi& E) {
    int tid_ = threadIdx.x; asm volatile("" : "+v"(tid_));
    const int tid = tid_, wid = __builtin_amdgcn_readfirstlane(tid >> 6), lane = tid & 63, wr = wid >> 2, wc = wid & 3, fr = lane & 15, fq = lane >> 4;
    const int K = g.K, nt = K / BK;
    unsigned voffA[2], voffB[2];
#pragma unroll
    for (int i = 0; i < 2; ++i) { int R, C; stage_rc(tid * 16 + i * 8192, R, C); const int Rb = Epi::PERM ? ((R & ~31) + perm32(R & 31)) : R;
        voffA[i] = (unsigned)(R * K + C) * 2u; voffB[i] = (unsigned)(Rb * K + C) * 2u; }
    const unsigned kstep = BK * 2;
    const unsigned hstep = (unsigned)HALF * K * 2;
    const unsigned tstep = 2 * hstep;
    const unsigned ldsw = (unsigned)wid * 1024u;
    const int aoff = lds_byte(wr * 64 + fr, fq * 8), boff = lds_byte(wc * 32 + fr, fq * 8);
#define PG8_SA(b, h) (((b) * 2 + (h)) * HTB)
#define PG8_SB(b, h) ((4 + (b) * 2 + (h)) * HTB)
#define PG8_STAGE(bufoff, gbase, voff) do { _Pragma("unroll") for (int _i = 0; _i < 2; ++_i) \
        __builtin_amdgcn_global_load_lds((const unsigned*)((const char*)(gbase) + (voff)[_i]), (PG8_LAS unsigned*)(lds + (bufoff) + ldsw + _i * 8192), 16, 0, 0); } while (0)
#define PG8_LDA(dst, b, h) do { _Pragma("unroll") for (int m = 0; m < 4; ++m) _Pragma("unroll") for (int k = 0; k < 2; ++k) dst[m][k] = *(const PG8_LAS bf16x8*)(lds + PG8_SA(b, h) + aoff + m * 2048 + k * 1024); } while (0)
#define PG8_LDB(dst, b, h) do { _Pragma("unroll") for (int n = 0; n < 2; ++n) _Pragma("unroll") for (int k = 0; k < 2; ++k) dst[n][k] = *(const PG8_LAS bf16x8*)(lds + PG8_SB(b, h) + boff + n * 2048 + k * 1024); } while (0)
#define PG8_MMA(ai, bj, At, Bt) do { __builtin_amdgcn_s_setprio(1); _Pragma("unroll") for (int m = 0; m < 4; ++m) _Pragma("unroll") for (int n = 0; n < 2; ++n) _Pragma("unroll") for (int k = 0; k < 2; ++k) \
        acc[ai][bj][m][n] = __builtin_amdgcn_mfma_f32_16x16x32_bf16(Bt[n][k], At[m][k], acc[ai][bj][m][n], 0, 0, 0); __builtin_amdgcn_s_setprio(0); } while (0)
#define PG8_WAIT_V(n) asm volatile("s_waitcnt vmcnt(" #n ")" ::: "memory")
#define PG8_WAIT_L(n) asm volatile("s_waitcnt lgkmcnt(" #n ")" ::: "memory")
#define PG8_BAR __builtin_amdgcn_s_barrier()
#define PG8_SCHED __builtin_amdgcn_sched_barrier(0)
    Unit cur, nxt; int ui = 0;
    if (!S.next(0, cur)) return;
    f32x4 acc[2][2][4][2];
#pragma unroll
    for (int a = 0; a < 2; ++a)
#pragma unroll
        for (int b = 0; b < 2; ++b)
#pragma unroll
            for (int m = 0; m < 4; ++m)
#pragma unroll
                for (int n = 0; n < 2; ++n) acc[a][b][m][n] = (f32x4){0.f, 0.f, 0.f, 0.f};
    bf16x8 At[4][2], B0[2][2], B1[2][2];
    unsigned cA = (unsigned)cur.pm * tstep + (unsigned)cur.k0 * kstep, cB = (unsigned)cur.pn * tstep + (unsigned)cur.k0 * kstep;
    S.a_ready(cur);
    if constexpr (SP2) {
        PG8_STAGE(PG8_SB(0, 0), (const char*)g.Bt + (size_t)(cB), voffB); PG8_STAGE(PG8_SB(0, 1), (const char*)g.Bt + (size_t)(cB + hstep), voffB); PG8_STAGE(PG8_SA(0, 0), (const char*)g.A + (size_t)(cA), voffA); PG8_STAGE(PG8_SA(0, 1), (const char*)g.A + (size_t)(cA + hstep), voffA);
        if (wr == 1) PG8_BAR;
        PG8_WAIT_V(2); PG8_BAR;
        PG8_STAGE(PG8_SB(1, 0), (const char*)g.Bt + (size_t)(cB + kstep), voffB); PG8_STAGE(PG8_SA(1, 0), (const char*)g.A + (size_t)(cA + kstep), voffA); PG8_STAGE(PG8_SB(1, 1), (const char*)g.Bt + (size_t)(cB + hstep + kstep), voffB);
        PG8_WAIT_V(6); PG8_BAR;
    } else {
        PG8_STAGE(PG8_SB(0, 0), (const char*)g.Bt + (size_t)(cB), voffB); PG8_STAGE(PG8_SA(0, 0), (const char*)g.A + (size_t)(cA), voffA); PG8_STAGE(PG8_SB(0, 1), (const char*)g.Bt + (size_t)(cB + hstep), voffB); PG8_STAGE(PG8_SA(0, 1), (const char*)g.A + (size_t)(cA + hstep), voffA);
        if (wr == 1) PG8_BAR;
        PG8_WAIT_V(4); PG8_BAR;
        PG8_STAGE(PG8_SB(1, 0), (const char*)g.Bt + (size_t)(cB + kstep), voffB); PG8_STAGE(PG8_SA(1, 0), (const char*)g.A + (size_t)(cA + kstep), voffA); PG8_STAGE(PG8_SB(1, 1), (const char*)g.Bt + (size_t)(cB + hstep + kstep), voffB);
        PG8_WAIT_V(6); PG8_BAR;
    }
    for (;;) {
        const bool has_next = S.next(ui + 1, nxt);
        const unsigned nA = has_next ? (unsigned)nxt.pm * tstep + (unsigned)nxt.k0 * kstep : cA, nB = has_next ? (unsigned)nxt.pn * tstep + (unsigned)nxt.k0 * kstep : cB;
        const int unt = cur.nt ? cur.nt : nt;
        for (int t = 0; t < unt; t += 2) {
            const bool last = (t == unt - 2);
            const unsigned a1 = cA + (unsigned)(t + 1) * kstep;
            const unsigned a2 = last ? nA : cA + (unsigned)(t + 2) * kstep, b2 = last ? nB : cB + (unsigned)(t + 2) * kstep;
            const unsigned a3 = a2 + kstep, b3 = b2 + kstep;
            if (last && has_next) S.a_ready(nxt);
            if constexpr (SP2) {
            PG8_LDB(B0, 0, 0); PG8_LDB(B1, 0, 1); PG8_SCHED; PG8_LDA(At, 0, 0); PG8_STAGE(PG8_SA(1, 1), (const char*)g.A + (size_t)(a1 + hstep), voffA);
            PG8_WAIT_V(8); PG8_WAIT_L(0); PG8_BAR; PG8_MMA(0, 0, At, B0); PG8_MMA(0, 1, At, B1); PG8_BAR; PG8_SCHED;
            PG8_LDA(At, 0, 1); PG8_STAGE(PG8_SB(0, 0), (const char*)g.Bt + (size_t)(b2), voffB); PG8_STAGE(PG8_SB(0, 1), (const char*)g.Bt + (size_t)(b2 + hstep), voffB); PG8_STAGE(PG8_SA(0, 0), (const char*)g.A + (size_t)(a2), voffA);
            PG8_WAIT_V(8); PG8_WAIT_L(0); PG8_BAR; PG8_MMA(1, 0, At, B0); PG8_MMA(1, 1, At, B1); PG8_BAR; PG8_SCHED;
            PG8_LDB(B0, 1, 0); PG8_LDB(B1, 1, 1); PG8_SCHED; PG8_LDA(At, 1, 0); PG8_STAGE(PG8_SA(0, 1), (const char*)g.A + (size_t)(a2 + hstep), voffA);
            PG8_WAIT_V(8); PG8_WAIT_L(0); PG8_BAR; PG8_MMA(0, 0, At, B0); PG8_MMA(0, 1, At, B1); PG8_BAR; PG8_SCHED;
            PG8_LDA(At, 1, 1); PG8_STAGE(PG8_SB(1, 0), (const char*)g.Bt + (size_t)(b3), voffB); PG8_STAGE(PG8_SB(1, 1), (const char*)g.Bt + (size_t)(b3 + hstep), voffB); PG8_STAGE(PG8_SA(1, 0), (const char*)g.A + (size_t)(a3), voffA);
            PG8_WAIT_V(8); PG8_WAIT_L(0); PG8_BAR; PG8_MMA(1, 0, At, B0); PG8_MMA(1, 1, At, B1); PG8_BAR; PG8_SCHED;
            } else {
            PG8_LDB(B0, 0, 0); PG8_SCHED; PG8_LDA(At, 0, 0); PG8_STAGE(PG8_SA(1, 1), (const char*)g.A + (size_t)(a1 + hstep), voffA);
            PG8_WAIT_L(8); PG8_BAR; PG8_WAIT_L(0); PG8_MMA(0, 0, At, B0); PG8_BAR; PG8_SCHED;
            PG8_LDB(B1, 0, 1); PG8_STAGE(PG8_SB(0, 0), (const char*)g.Bt + (size_t)(b2), voffB);
            PG8_BAR; PG8_WAIT_L(0); PG8_MMA(0, 1, At, B1); PG8_BAR;
            PG8_LDA(At, 0, 1); PG8_STAGE(PG8_SA(0, 0), (const char*)g.A + (size_t)(a2), voffA);
            PG8_BAR; PG8_WAIT_L(0); PG8_MMA(1, 0, At, B0); PG8_BAR; PG8_SCHED;
            PG8_STAGE(PG8_SB(0, 1), (const char*)g.Bt + (size_t)(b2 + hstep), voffB);
            PG8_WAIT_V(6); PG8_BAR; PG8_MMA(1, 1, At, B1); PG8_BAR;
            PG8_LDB(B0, 1, 0); PG8_SCHED; PG8_LDA(At, 1, 0); PG8_STAGE(PG8_SA(0, 1), (const char*)g.A + (size_t)(a2 + hstep), voffA);
            PG8_WAIT_L(8); PG8_BAR; PG8_WAIT_L(0); PG8_MMA(0, 0, At, B0); PG8_BAR; PG8_SCHED;
            PG8_LDB(B1, 1, 1); PG8_STAGE(PG8_SB(1, 0), (const char*)g.Bt + (size_t)(b3), voffB);
            PG8_BAR; PG8_WAIT_L(0); PG8_MMA(0, 1, At, B1); PG8_BAR;
            PG8_LDA(At, 1, 1); PG8_STAGE(PG8_SA(1, 0), (const char*)g.A + (size_t)(a3), voffA);
            PG8_BAR; PG8_WAIT_L(0); PG8_MMA(1, 0, At, B0); PG8_BAR; PG8_SCHED;
            PG8_STAGE(PG8_SB(1, 1), (const char*)g.Bt + (size_t)(b3 + hstep), voffB);
            PG8_WAIT_V(6); PG8_BAR; PG8_MMA(1, 1, At, B1); PG8_BAR;
            }
        }
        if constexpr (ALIGN_EPI) { if (wr == 0) PG8_BAR; }
        if constexpr (!Epi::AFTER_DRAIN) { int t_ = threadIdx.x; asm volatile("" : "+v"(t_)); const int l_ = t_ & 63, w_ = __builtin_amdgcn_readfirstlane(t_ >> 6);
            E(acc, cur, w_ >> 2, w_ & 3, l_ & 15, l_ >> 4); S.done(cur); }
        if (!has_next) break;
#pragma unroll
        for (int a = 0; a < 2; ++a)
#pragma unroll
            for (int b = 0; b < 2; ++b)
#pragma unroll
                for (int m = 0; m < 4; ++m)
#pragma unroll
                    for (int n = 0; n < 2; ++n) acc[a][b][m][n] = (f32x4){0.f, 0.f, 0.f, 0.f};
        cur = nxt; cA = nA; cB = nB; ++ui;
        if constexpr (ALIGN_EPI) { if (wr == 1) PG8_BAR; }
    }
    PG8_WAIT_V(0);
    if constexpr (!ALIGN_EPI) { if (wr == 0) PG8_BAR; }
    PG8_BAR;
    if constexpr (Epi::AFTER_DRAIN) { E.fused(acc, cur, wr, wc, fr, fq, lds, wid, lane); S.done(cur); }
#undef PG8_SA
#undef PG8_SB
#undef PG8_STAGE
#undef PG8_LDA
#undef PG8_LDB
#undef PG8_MMA
#undef PG8_WAIT_V
#undef PG8_WAIT_L
#undef PG8_BAR
#undef PG8_SCHED
}
}

#define GAS __attribute__((address_space(1)))
typedef unsigned short bf16;
typedef float f32x4 __attribute__((ext_vector_type(4)));
typedef unsigned v4u __attribute__((ext_vector_type(4)));
typedef unsigned v2u __attribute__((ext_vector_type(2)));
constexpr int D = 2048, NB = 4, SEQ = 4096, CTXL = 256, DFF = 5504, NMOD = 9;
constexpr int TL = NB * SEQ, TC = NB * CTXL, TT = TL + TC;
constexpr int MIXH = 1024;
constexpr int EV_COLS = 7216, EV_PAD = 7424, OD_COLS = 5120;
constexpr int NWAVES = 8, NTHR = 512;
constexpr float EPS = 1e-6f;

constexpr size_t MiB = 1u << 20;
constexpr size_t WS_CTL = 0, CTL_ZERO_BYTES = 64 * 1024;
constexpr size_t WS_MOD = 1 * MiB;
constexpr size_t WS_MODP = 2 * MiB;
constexpr int MOD_KC = 16;
constexpr size_t WS_WGU = 16 * MiB;
constexpr size_t SZ_WGU = (size_t)11008 * 2048 * 2;
constexpr size_t WS_WD = WS_WGU + 4 * SZ_WGU;
constexpr size_t SZ_WD = (size_t)2048 * 5504 * 2;
constexpr size_t WS_WIN_EV = WS_WD + 4 * SZ_WD;
constexpr size_t WS_WOUT_EV = WS_WIN_EV + (size_t)EV_PAD * 2048 * 2;
constexpr size_t WS_WIN_OD = WS_WOUT_EV + (size_t)2048 * 2048 * 2;
constexpr size_t WS_WOUT_OD = WS_WIN_OD + (size_t)OD_COLS * 2048 * 2;
constexpr size_t WS_WGLU = WS_WOUT_OD + (size_t)2048 * 2048 * 2;
constexpr size_t WS_XC = WS_WGLU + (size_t)1024 * 1024 * 2;
constexpr size_t WS_HB = WS_XC + (size_t)TC * D * 4;
constexpr size_t WS_R = WS_HB + (size_t)TT * D * 2;
constexpr size_t WS_HID = WS_R;
constexpr size_t WS_Y = WS_R + 183 * MiB;
constexpr size_t WS_S = WS_R;
constexpr size_t WS_GT = WS_R + 247 * MiB;
constexpr size_t WS_GB = WS_R + 264 * MiB;
constexpr size_t WS_O = WS_R + 298 * MiB;
constexpr size_t SZ_O = (size_t)TT * 1024 * 2;
constexpr size_t WS_XL = WS_R + 434 * MiB;
constexpr size_t WS_QK2 = WS_XL + (size_t)TL * D * 2;
constexpr size_t WS_GP = WS_QK2 + (size_t)TT * 2048 * 2;
constexpr size_t WS_QKS = WS_GP + (size_t)TT * 8 * 4 * 4;
constexpr size_t WS_VEC = WS_QKS + (size_t)2 * TT * 1024 * 2;
constexpr size_t WS_GPK = WS_VEC + (size_t)NB * 4 * 2 * 68 * 384 * 4;
constexpr size_t WS_PP = WS_GPK + (size_t)NB * 4 * 2 * 68 * 256 * 4;
constexpr size_t WS_RS = WS_PP + (size_t)NB * 4 * 2 * 68 * 4096 * 2;
constexpr size_t WS_END = WS_RS + (size_t)NB * 4 * 2 * 68 * 64 * 4;
constexpr size_t WS_YCP = WS_R + 320 * MiB;
constexpr int YPARTS = 8;
static_assert(WS_YCP >= WS_Y + (size_t)TT * D * 2 && WS_YCP + (size_t)YPARTS * TC * D * 4 <= WS_XL && WS_O + 4 * SZ_O <= WS_XL, "ws map");
static_assert(WS_HID + (size_t)TT * DFF * 2 <= WS_Y && WS_S + (size_t)TT * EV_PAD * 2 <= WS_GT && WS_GT + (size_t)TT * 256 * 4 <= WS_GB && WS_GB + (size_t)TT * 1024 * 2 <= WS_O, "ws map");
static_assert(WS_Y + (size_t)TT * D * 2 <= WS_O, "ws map");

constexpr int LDS_BYTES = 156 * 1024;
constexpr int MISC_OFF = LDS_BYTES - 64;

struct Args { const float* in[34]; float* out; unsigned char* ws; };
#ifdef PROBE_A
#ifndef PROBE_A1
#define PROBE_A1 PROBE_A
#endif
#ifndef PROBE_B
#define PROBE_B -100
#endif
#ifndef PROBE_B1
#define PROBE_B1 PROBE_B
#endif
#define XBAR() do { xcd_barrier(bar); if (blockIdx.x == 0 && threadIdx.x == 0) { volatile LAS unsigned* M_ = (volatile LAS unsigned*)(lds + MISC_OFF); const unsigned c_ = M_[4]; \
        const unsigned long long t_ = __builtin_amdgcn_s_memrealtime(); const unsigned lo_ = (unsigned)t_; \
        if ((int)c_ == PROBE_A - 1) M_[6] = lo_; if ((int)c_ == PROBE_A1) M_[7] = lo_; if ((int)c_ == PROBE_B - 1) M_[8] = lo_; if ((int)c_ == PROBE_B1) M_[9] = lo_; M_[4] = c_ + 1u; } } while (0)
#else
#define XBAR() xcd_barrier(bar)
#endif
#define ARG(k) ((const float*)(GAS const float*)(a.in[opaque_idx(k)]))
__device__ __forceinline__ unsigned char* wsp(unsigned char* w, size_t off) { asm volatile("" : "+s"(off)); return w + off; }
__device__ __forceinline__ int opaque_idx(int k) { asm volatile("" : "+s"(k)); return k; }

__device__ __forceinline__ unsigned f2bf(float f) { unsigned u = __float_as_uint(f); u += 0x7FFFu + ((u >> 16) & 1u); return u >> 16; }
typedef __bf16 bf16x2_t __attribute__((ext_vector_type(2)));
typedef float f32x2_t __attribute__((ext_vector_type(2)));
__device__ __forceinline__ unsigned pk2(float lo, float hi) { const f32x2_t v = {lo, hi}; const bf16x2_t b = __builtin_convertvector(v, bf16x2_t); return __builtin_bit_cast(unsigned, b); }
__device__ __forceinline__ float bf2f(unsigned short b) { return __uint_as_float(((unsigned)b) << 16); }
__device__ __forceinline__ float wave_sum(float v) {
#pragma unroll
    for (int o = 1; o < 64; o <<= 1) v += __shfl_xor(v, o);
    return v;
}
__device__ __forceinline__ float fast_silu(float g) { return g * __builtin_amdgcn_rcpf(1.0f + __expf(-g)); }
__device__ __forceinline__ float fast_sigmoid(float g) { return __builtin_amdgcn_rcpf(1.0f + __expf(-g)); }

#ifndef DEFER
#define DEFER 2
#endif
struct TJob { const float* src; bf16* dst; int K, N, map; };
constexpr int NT_FFN = 5504, NT_EVIN = 32 * 226, NT_SQ = 2048, NT_ODIN = 32 * 160, NT_GLU = 512;
constexpr int NT_SET0 = 6 * NT_FFN + NT_EVIN + NT_SQ + NT_ODIN + NT_SQ + NT_GLU, NT_SET1 = 3 * NT_FFN, NT_SET2 = 3 * NT_FFN;
__device__ __forceinline__ void transpose_tile(const TJob& j, int tl, int lane) {
    const int nblk = (j.N + 31) / 32, kb = tl / nblk, nb = tl % nblk, k0 = 64 * kb, n0 = 32 * nb;
    const int kb8 = lane >> 3, nb4 = lane & 7, n = n0 + 4 * nb4;
    int drow0;
    if (j.map == 0) drow0 = n0;
    else if (j.map == 1) drow0 = (n0 / 128) * 256 + (n0 % 128);
    else if (j.map == 2) drow0 = (n0 / 128) * 256 + (n0 % 128) + 128;
    else drow0 = (nb < 96) ? n0 : (nb == 96 ? 7168 : (nb < 225 ? n0 - 32 : 7200));
    if (n < j.N) {
        const float* s = j.src + (size_t)(k0 + 8 * kb8) * j.N + n;
        f32x4 v[8];
#pragma unroll
        for (int i = 0; i < 8; ++i) v[i] = *(const f32x4*)(s + (size_t)i * j.N);
        bf16* d = j.dst + (size_t)(drow0 + 4 * nb4) * j.K + k0 + 8 * kb8;
#pragma unroll
        for (int e = 0; e < 4; ++e) { v4u o; o.x = pk2(v[0][e], v[1][e]); o.y = pk2(v[2][e], v[3][e]); o.z = pk2(v[4][e], v[5][e]); o.w = pk2(v[6][e], v[7][e]);
            *(v4u*)(d + (size_t)e * j.K) = o; }
    }
}

__device__ __forceinline__ void transpose_tile2(const TJob& j, int tl0, int tl1, int lane) {
    const int nblk = (j.N + 31) / 32; const int kb8 = lane >> 3, nb4 = lane & 7;
    f32x4 v[2][8]; int drow[2], k0s[2]; bool ok[2];
#pragma unroll
    for (int u = 0; u < 2; ++u) { const int tl = u ? tl1 : tl0; const int kb = tl / nblk, nb = tl % nblk, k0 = 64 * kb, n0 = 32 * nb, n = n0 + 4 * nb4;
        int drow0;
        if (j.map == 0) drow0 = n0;
        else if (j.map == 1) drow0 = (n0 / 128) * 256 + (n0 % 128);
        else if (j.map == 2) drow0 = (n0 / 128) * 256 + (n0 % 128) + 128;
        else drow0 = (nb < 96) ? n0 : (nb == 96 ? 7168 : (nb < 225 ? n0 - 32 : 7200));
        drow[u] = drow0; k0s[u] = k0; ok[u] = n < j.N;
        if (ok[u]) { const float* s = j.src + (size_t)(k0 + 8 * kb8) * j.N + n;
#pragma unroll
            for (int i = 0; i < 8; ++i) v[u][i] = *(const f32x4*)(s + (size_t)i * j.N); } }
#pragma unroll
    for (int u = 0; u < 2; ++u) if (ok[u]) { bf16* d = j.dst + (size_t)(drow[u] + 4 * nb4) * j.K + k0s[u] + 8 * kb8;
#pragma unroll
        for (int e = 0; e < 4; ++e) { v4u o; o.x = pk2(v[u][0][e], v[u][1][e]); o.y = pk2(v[u][2][e], v[u][3][e]); o.z = pk2(v[u][4][e], v[u][5][e]); o.w = pk2(v[u][6][e], v[u][7][e]);
            *(v4u*)(d + (size_t)e * j.K) = o; } }
}
__device__ __forceinline__ TJob make_job(const Args& a, unsigned char* ws, int id) {
    TJob j;
    if (id < 12) { const int li = id / 3, kind = id % 3; const size_t wo = (size_t)li * 2048 * 5504;
        j.src = ARG(8 + kind) + wo;
        if (kind == 2) { j.K = 5504; j.N = 2048; j.map = 0; j.dst = (bf16*)(wsp(ws, WS_WD) + (size_t)li * SZ_WD); }
        else { j.K = 2048; j.N = 5504; j.map = 1 + kind; j.dst = (bf16*)(wsp(ws, WS_WGU) + (size_t)li * SZ_WGU); } }
    else if (id == 12) { j.src = ARG(11); j.K = 2048; j.N = EV_COLS; j.map = 3; j.dst = (bf16*)wsp(ws, WS_WIN_EV); }
    else if (id == 13) { j.src = ARG(12); j.K = 2048; j.N = 2048; j.map = 0; j.dst = (bf16*)wsp(ws, WS_WOUT_EV); }
    else if (id == 14) { j.src = ARG(20); j.K = 2048; j.N = OD_COLS; j.map = 0; j.dst = (bf16*)wsp(ws, WS_WIN_OD); }
    else if (id == 15) { j.src = ARG(21); j.K = 2048; j.N = 2048; j.map = 0; j.dst = (bf16*)wsp(ws, WS_WOUT_OD); }
    else { j.src = ARG(30); j.K = 1024; j.N = 1024; j.map = 0; j.dst = (bf16*)wsp(ws, WS_WGLU); }
    return j;
}
__device__ __forceinline__ void convert_tiles(const Args& a, unsigned char* ws, int set, int wave_index, int nwaves, int lane) {
    const int njobs = DEFER == 2 ? (set == 0 ? 8 : 3) : (set == 0 ? 11 : 3);
    int start = wave_index;
#pragma unroll 1
    for (int q = 0; q < njobs; ++q) {
        const int id = DEFER == 2 ? (set == 0 ? (q < 3 ? q : q + 9) : 3 * set + q) : (set == 0 ? (q < 3 ? q : (q < 6 ? q + 3 : q + 6)) : (set == 1 ? 3 + q : 9 + q));
        const int nt = id < 12 ? NT_FFN : (id == 12 ? NT_EVIN : (id == 14 ? NT_ODIN : (id == 16 ? NT_GLU : NT_SQ)));
        const TJob j = make_job(a, ws, id);
        int t = start;
#pragma unroll 1
        for (; t + nwaves < nt; t += 2 * nwaves) transpose_tile2(j, t, t + nwaves, lane);
        if (t < nt) { transpose_tile(j, t, lane); t += nwaves; }
        start = t - nt;
    }
}

static_assert(NT_FFN % 2 == 0 && NT_EVIN % 2 == 0 && NT_SQ % 2 == 0 && NT_ODIN % 2 == 0 && NT_GLU % 2 == 0, "tile pairs must not straddle jobs");
constexpr int NT_SET0_D2 = 3 * NT_FFN + NT_EVIN + NT_SQ + NT_ODIN + NT_SQ + NT_GLU;
__device__ __forceinline__ void convert_pair_set0(const Args& a, unsigned char* ws, int t, int lane) {
    int id = 16;
    if (t < 3 * NT_FFN) { id = t / NT_FFN; t -= id * NT_FFN; }
    else { t -= 3 * NT_FFN;
        if (t < NT_EVIN) id = 12;
        else { t -= NT_EVIN; if (t < NT_SQ) id = 13;
            else { t -= NT_SQ; if (t < NT_ODIN) id = 14;
                else { t -= NT_ODIN; if (t < NT_SQ) id = 15; else { t -= NT_SQ; id = 16; } } } } }
    const TJob j = make_job(a, ws, id);
    transpose_tile2(j, t, t + 1, lane);
}

struct NormP {
    const void* xin_lat; const void* xin_ctx; void* xout_lat; void* xout_ctx; const bf16* y; bf16* h;
    int xin_f32, xout_f32;
    int rows_end; int has_y, has_h; float w;
    const float* y_ctx;
    int lp, sp;
    int ln, sn;
};
__device__ __forceinline__ void norm_phase(const NormP& p, const float* mod, const float* norm_pre, const float* norm_post, LAS unsigned char* lds, int gw, int ngw, int tid, int lane) {
    { int t2 = threadIdx.x; asm volatile("" : "+v"(t2)); tid = t2; lane = t2 & 63; gw = blockIdx.x * NWAVES + __builtin_amdgcn_readfirstlane(t2 >> 6); }
    LAS float* TA = (LAS float*)lds; LAS float* TB = TA + 5 * D; LAS float* TCc = TB + 5 * D;
    for (int i = tid; i < 5 * D; i += NTHR) { const int var = i >> 11, j = i & (D - 1);
        if (p.has_y) TA[i] = p.w * mod[((size_t)p.lp * 5 + var) * (NMOD * D) + (3 * p.sp + 2) * D + j] * norm_post[(p.lp * 3 + p.sp) * D + j];
        if (p.has_h) { TB[i] = norm_pre[(p.ln * 3 + p.sn) * D + j] * (1.0f + mod[((size_t)p.ln * 5 + var) * (NMOD * D) + (3 * p.sn + 1) * D + j]);
                       TCc[i] = mod[((size_t)p.ln * 5 + var) * (NMOD * D) + (3 * p.sn) * D + j]; } }
    __syncthreads();
    for (int r = gw; r < p.rows_end; r += ngw) {
        const int var = r < TL ? (r >> 12) : 4;
        const size_t xoff = r < TL ? (size_t)r * D : (size_t)(r - TL) * D;
        const void* xi = r < TL ? p.xin_lat : p.xin_ctx; void* xo = r < TL ? p.xout_lat : p.xout_ctx;
        f32x4 xv[8];
        if (p.xin_f32) {
#pragma unroll
            for (int j = 0; j < 8; ++j) xv[j] = *(const f32x4*)((const float*)xi + xoff + 4 * lane + 256 * j);
        } else {
#pragma unroll
            for (int j = 0; j < 8; ++j) { const v2u w = *(const v2u*)((const bf16*)xi + xoff + 4 * lane + 256 * j); xv[j] = (f32x4){__uint_as_float(w.x << 16), __uint_as_float(w.x & 0xffff0000u), __uint_as_float(w.y << 16), __uint_as_float(w.y & 0xffff0000u)}; }
        }
        if (p.has_y) {
            const bool yc = (r >= TL) && p.y_ctx; const float* yr = p.y_ctx + (size_t)(r - TL) * D; f32x4 yv[8]; float s = 0.f;
            if (!yc) { const bf16* yb = p.y + (size_t)r * D;
#pragma unroll
                for (int j = 0; j < 8; ++j) { const v2u w = *(const v2u*)(yb + 4 * lane + 256 * j); yv[j] = (f32x4){__uint_as_float(w.x << 16), __uint_as_float(w.x & 0xffff0000u), __uint_as_float(w.y << 16), __uint_as_float(w.y & 0xffff0000u)}; }
            } else {
#pragma unroll
                for (int j = 0; j < 8; ++j) yv[j] = *(const f32x4*)(yr + 4 * lane + 256 * j);
                for (int q = 1; q < YPARTS; ++q) {
#pragma unroll
                for (int j = 0; j < 8; ++j) yv[j] += *(const f32x4*)(yr + (size_t)q * TC * D + 4 * lane + 256 * j); } }
#pragma unroll
            for (int j = 0; j < 8; ++j) { s += (yv[j].x * yv[j].x + yv[j].y * yv[j].y) + (yv[j].z * yv[j].z + yv[j].w * yv[j].w); }
            const float rstd = 1.0f / sqrtf(wave_sum(s) * (1.0f / D) + EPS);
#pragma unroll
            for (int j = 0; j < 8; ++j) { const f32x4 a = *(const LAS f32x4*)(TA + var * D + 4 * lane + 256 * j); xv[j] = xv[j] + a * (yv[j] * rstd);
                if (p.xout_f32) *(f32x4*)((float*)xo + xoff + 4 * lane + 256 * j) = xv[j];
                else { v2u w; w.x = pk2(xv[j].x, xv[j].y); w.y = pk2(xv[j].z, xv[j].w); *(v2u*)((bf16*)xo + xoff + 4 * lane + 256 * j) = w; } }
        }
        if (p.has_h) {
            float s = 0.f;
#pragma unroll
            for (int j = 0; j < 8; ++j) s += (xv[j].x * xv[j].x + xv[j].y * xv[j].y) + (xv[j].z * xv[j].z + xv[j].w * xv[j].w);
            const float rstd = 1.0f / sqrtf(wave_sum(s) * (1.0f / D) + EPS);
            bf16* hr = p.h + (size_t)r * D;
#pragma unroll
            for (int j = 0; j < 8; ++j) { const f32x4 b = *(const LAS f32x4*)(TB + var * D + 4 * lane + 256 * j), c = *(const LAS f32x4*)(TCc + var * D + 4 * lane + 256 * j);
                const f32x4 o = xv[j] * rstd * b + c; v2u w; w.x = pk2(o.x, o.y); w.y = pk2(o.z, o.w); *(v2u*)(hr + 4 * lane + 256 * j) = w; }
        }
    }
    __syncthreads();
}

struct EpiSwiGLU {
    static constexpr bool PERM = true, AFTER_DRAIN = false;
    bf16* O; int ldc;
    __device__ __forceinline__ void operator()(const pg8::f32x4 (&acc)[2][2][4][2], const pg8::Unit& u, int wr, int wc, int fr, int fq) const {
        const int row0 = u.pm * 256 + wr * 64 + fr, col0 = u.pn * 128 + wc * 32 + 8 * fq;
#pragma unroll
        for (int ai = 0; ai < 2; ++ai)
#pragma unroll
            for (int m = 0; m < 4; ++m) { bf16* rowp = O + (size_t)(row0 + ai * 128 + m * 16) * ldc + col0;
                const pg8::f32x4 g0 = acc[ai][0][m][0], g1 = acc[ai][0][m][1], u0 = acc[ai][1][m][0], u1 = acc[ai][1][m][1];
                v4u w; w.x = pk2(fast_silu(g0[0]) * u0[0], fast_silu(g0[1]) * u0[1]); w.y = pk2(fast_silu(g0[2]) * u0[2], fast_silu(g0[3]) * u0[3]);
                w.z = pk2(fast_silu(g1[0]) * u1[0], fast_silu(g1[1]) * u1[1]); w.w = pk2(fast_silu(g1[2]) * u1[2], fast_silu(g1[3]) * u1[3]);
                *(v4u*)rowp = w; }
    }
};
struct EpiF32 {
    static constexpr bool PERM = true, AFTER_DRAIN = false;
    bf16* C; float* Cs;
    static constexpr int ldc = D;
    __device__ __forceinline__ void operator()(const pg8::f32x4 (&acc)[2][2][4][2], const pg8::Unit& u, int wr, int wc, int fr, int fq) const {
        const int row0 = u.pm * 256 + wr * 64 + fr, col0 = u.pn * 256 + wc * 32 + 8 * fq;
        if (u.part >= 0) {
            float* base = Cs + ((size_t)u.part * TC - (size_t)TL) * D;
#pragma unroll
            for (int ai = 0; ai < 2; ++ai)
#pragma unroll
                for (int m = 0; m < 4; ++m) { float* rowp = base + (size_t)(row0 + ai * 128 + m * 16) * ldc + col0;
#pragma unroll
                    for (int bj = 0; bj < 2; ++bj) { *(pg8::f32x4*)(rowp + bj * 128) = acc[ai][bj][m][0]; *(pg8::f32x4*)(rowp + bj * 128 + 4) = acc[ai][bj][m][1]; } }
        } else {
#pragma unroll
            for (int ai = 0; ai < 2; ++ai)
#pragma unroll
                for (int m = 0; m < 4; ++m) { bf16* rowp = C + (size_t)(row0 + ai * 128 + m * 16) * ldc + col0;
#pragma unroll
                    for (int bj = 0; bj < 2; ++bj) { const pg8::f32x4 v0 = acc[ai][bj][m][0], v1 = acc[ai][bj][m][1];
                        v4u w; w.x = pk2(v0[0], v0[1]); w.y = pk2(v0[2], v0[3]); w.z = pk2(v1[0], v1[1]); w.w = pk2(v1[2], v1[3]);
                        *(v4u*)(rowp + bj * 128) = w; } }
        }
    }
};
struct EpiS {
    static constexpr bool PERM = true, AFTER_DRAIN = false;
    bf16* S; int ldc; float* GT; int gt_pn;
    __device__ __forceinline__ void operator()(const pg8::f32x4 (&acc)[2][2][4][2], const pg8::Unit& u, int wr, int wc, int fr, int fq) const {
        const int row0 = u.pm * 256 + wr * 64 + fr;
        if (u.pn == gt_pn) {
            if (wc < 2) {
#pragma unroll
                for (int ai = 0; ai < 2; ++ai)
#pragma unroll
                    for (int m = 0; m < 4; ++m) { float* rowp = GT + (size_t)(row0 + ai * 128 + m * 16) * 256 + wc * 32 + 8 * fq;
                        *(pg8::f32x4*)rowp = acc[ai][0][m][0]; *(pg8::f32x4*)(rowp + 4) = acc[ai][0][m][1]; }
            }
        } else {
            const int col0 = u.pn * 256 + wc * 32 + 8 * fq;
#pragma unroll
            for (int ai = 0; ai < 2; ++ai)
#pragma unroll
                for (int m = 0; m < 4; ++m) { bf16* rowp = S + (size_t)(row0 + ai * 128 + m * 16) * ldc + col0;
#pragma unroll
                    for (int bj = 0; bj < 2; ++bj) { const pg8::f32x4 v0 = acc[ai][bj][m][0], v1 = acc[ai][bj][m][1];
                        v4u w; w.x = pk2(v0[0], v0[1]); w.y = pk2(v0[2], v0[3]); w.z = pk2(v1[0], v1[1]); w.w = pk2(v1[2], v1[3]);
                        *(v4u*)(rowp + bj * 128) = w; } }
        }
    }
};

#define DEV __device__ __forceinline__
#define LP(T) LAS T*
#define SYNC() do { asm volatile("s_waitcnt lgkmcnt(0)" ::: "memory"); __builtin_amdgcn_s_barrier(); asm volatile("" ::: "memory"); } while (0)
typedef short v8s __attribute__((ext_vector_type(8)));
typedef float v4f __attribute__((ext_vector_type(4)));
#define MFMA16(x, y, c) __builtin_amdgcn_mfma_f32_16x16x32_bf16((x), (y), (c), 0, 0, 0)
#define SHX(v, m) __shfl_xor((v), (m))
#define SHUP(v, d) __shfl_up((v), (d))
#define SHIDX(v, l) __shfl((v), (l))
#define EXPF(x) __expf(x)
#define LOGF(x) __logf(x)
#define RCPF(x) __builtin_amdgcn_rcpf(x)
#define RSQRTF(x) (1.0f / sqrtf(x))
#define PK2(lo, hi) pk2((lo), (hi))
#define F2BF(x) ((unsigned short)f2bf(x))
#define WAVE_SYNC() asm volatile("s_waitcnt lgkmcnt(0)" ::: "memory")
typedef short v4s __attribute__((ext_vector_type(4)));
#define LDS_TR16(p) __builtin_amdgcn_ds_read_tr16_b64_v4i16((LAS v4s*)(p))
#define RDLANE(v, l) __int_as_float(__builtin_amdgcn_readlane(__float_as_int(v), (l)))
#define RDLANE16(v, l) __shfl((v), (l))
#define SIB_SYNC_IMPL(p, target) do { __hip_atomic_fetch_add((p), 1u, __ATOMIC_RELAXED, __HIP_MEMORY_SCOPE_AGENT); unsigned sp_ = 0; \
    while (__hip_atomic_load((p), __ATOMIC_RELAXED, __HIP_MEMORY_SCOPE_AGENT) < (target) && ++sp_ < 100000u) __builtin_amdgcn_s_sleep(2); } while (0)

#define PRBROW(r) ((prb) == 1 ? ((r) & 63) : (r))
#define PRBTSK(t) ((prb) == 1 ? 0 : (t))
DEV int seq_row(int b, int seg, int np, int cm) {
    if (!seg) return TL + b * CTXL + np;
    const int n = cm ? ((np & 63) * 64 + (np >> 6)) : np;
    return b * SEQ + n;
}
DEV int tok_row(int b, int seg, int pos, int dir, int cm) {
    const int len = seg ? SEQ : CTXL;
    return seq_row(b, seg, dir ? len - 1 - pos : pos, cm);
}
DEV float bflo(unsigned u) { return __uint_as_float(u << 16); }
DEV float bfhi(unsigned u) { return __uint_as_float(u & 0xffff0000u); }
DEV float logsigmoidf(float z) { return fminf(z, 0.f) - LOGF(1.0f + EXPF(-fabsf(z))); }
DEV v4f tile_mma(v4f acc, LP(const unsigned char) A, int sa, int m0, LP(const unsigned char) B, int sb, int n0, int ksteps, int fr, int fq) {
    LP(const unsigned char) ap = A + (m0 + fr) * sa + fq * 16;
    LP(const unsigned char) bp = B + (n0 + fr) * sb + fq * 16;
    for (int k = 0; k < ksteps; ++k) {
        const v8s af = *(LP(const v8s))(ap + k * 64);
        const v8s bf = *(LP(const v8s))(bp + k * 64);
        acc = MFMA16(bf, af, acc);
    }
    return acc;
}
DEV v8s tr_frag(LP(const unsigned char) T, int st, int k0, int n0, int lane) {
    const int l16 = lane & 15, fq = lane >> 4;
    LP(const unsigned char) p = T + (k0 + 8 * fq + (l16 >> 2)) * st + (n0 + 4 * (l16 & 3)) * 2;
    const v4s a = LDS_TR16(p), b = LDS_TR16(p + 4 * st);
    return (v8s){a.x, a.y, a.z, a.w, b.x, b.y, b.z, b.w};
}
DEV v4f tile_mma_nt(v4f acc, LP(const unsigned char) A, int sa, int m0, LP(const unsigned char) Bt, int sb, int n0, int ksteps, int lane) {
    const int fr = lane & 15, fq = lane >> 4;
    for (int k = 0; k < ksteps; ++k) { const v8s af = *(LP(const v8s))(A + (m0 + fr) * sa + fq * 16 + k * 64); const v8s bf = tr_frag(Bt, sb, 32 * k, n0, lane); acc = MFMA16(bf, af, acc); }
    return acc;
}
DEV v4f tile_mma_tt(v4f acc, LP(const unsigned char) At, int sa, int m0, LP(const unsigned char) Bt, int sb, int n0, int ksteps, int lane) {
    for (int k = 0; k < ksteps; ++k) { const v8s af = tr_frag(At, sa, 32 * k, m0, lane); const v8s bf = tr_frag(Bt, sb, 32 * k, n0, lane); acc = MFMA16(bf, af, acc); }
    return acc;
}
constexpr int ST128 = 272, ST64 = 144, ST256 = 528, STV = 80;
DEV void sibling_sync(unsigned* sib, unsigned target, int tid) {
#ifdef SIB_SYNC_IMPL
    if (sib) { if (tid == 0) SIB_SYNC_IMPL(sib, target); SYNC(); }
#endif
}

constexpr int MIX_UNITS = NB * 32;
constexpr int GLA_TASKS = NB * 4 * 2 * (CTXL / 64 + SEQ / 64);
DEV void gla_prep_loop(int first, int stride, const bf16* S, const float* GT, const float* wg_all, const float* bg_all, bf16* QKS, float* VEC, LP(unsigned char) lds, int tid) {
    constexpr int NCHUNK = CTXL / 64 + SEQ / 64;
    constexpr int LA_RS = 132;
    LP(float) LA = (LP(float))lds; LP(float) SEG = (LP(float))(lds + 33792); LP(unsigned char) LRb = lds + 35840; LP(unsigned char) WGb = lds + 40960; LP(float) BG = (LP(float))(lds + 51200);
    for (int i = tid; i < (5120 + 10240) / 4; i += NTHR) ((LP(unsigned))LRb)[i] = 0u;
    SYNC();
    const int lane = tid & 63, wave = tid >> 6, fr = lane & 15, fq = lane >> 4;
    const int j = tid >> 3, c8 = tid & 7, dc = c8 * 16;
    const float qscale = 0.08838834764831845f;
    v4u pq0, pq1, pk0, pk1; v4f plr = (v4f){0.f, 0.f, 0.f, 0.f}, pwg = plr; float pbg = 0.f;
#define GP_ISSUE(tk) do { const int cx_ = (tk) % NCHUNK, r1_ = (tk) / NCHUNK, dir_ = r1_ & 1, h_ = (r1_ >> 1) & 3, b_ = r1_ >> 3; \
        const int seg_ = cx_ >= CTXL / 64, ci_ = seg_ ? cx_ - CTXL / 64 : cx_; \
        const bf16* sr_ = S + (size_t)tok_row(b_, seg_, ci_ * 64 + j, dir_, 0) * EV_PAD; \
        pq0 = *(const v4u*)(sr_ + h_ * 128 + dc); pq1 = *(const v4u*)(sr_ + h_ * 128 + dc + 8); pk0 = *(const v4u*)(sr_ + 512 + h_ * 128 + dc); pk1 = *(const v4u*)(sr_ + 512 + h_ * 128 + dc + 8); \
        pwg = *(const v4f*)(wg_all + (dir_ * 16 + (tid & 15)) * 512 + h_ * 128 + (tid >> 4) * 4); \
        if (tid < 128) pbg = bg_all[dir_ * 512 + h_ * 128 + tid]; \
        if (tid < 256) { const int rr_ = tok_row(b_, seg_, ci_ * 64 + (tid >> 2), dir_, 0); plr = *(const v4f*)(GT + (size_t)rr_ * 256 + dir_ * 16 + (tid & 3) * 4); } } while (0)
    if (first < GLA_TASKS) GP_ISSUE(first);
    for (int task = first; task < GLA_TASKS; task += stride) {
    const int cidx = task % NCHUNK, r1 = task / NCHUNK, dir = r1 & 1, h = (r1 >> 1) & 3, b = r1 >> 3;
    const int seg = cidx >= CTXL / 64, ci = seg ? cidx - CTXL / 64 : cidx;
    const int row = tok_row(b, seg, ci * 64 + j, dir, 0);
    const v4u q0 = pq0, q1 = pq1, k0 = pk0, k1 = pk1;
    { const int m = tid & 15, d0 = (tid >> 4) * 4;
      *(LP(unsigned short))(WGb + (d0 + 0) * 80 + m * 2) = F2BF(pwg.x); *(LP(unsigned short))(WGb + (d0 + 1) * 80 + m * 2) = F2BF(pwg.y);
      *(LP(unsigned short))(WGb + (d0 + 2) * 80 + m * 2) = F2BF(pwg.z); *(LP(unsigned short))(WGb + (d0 + 3) * 80 + m * 2) = F2BF(pwg.w); }
    if (tid < 128) BG[tid] = pbg;
    if (tid < 256) *(LP(v2u))(LRb + (tid >> 2) * 80 + (tid & 3) * 8) = (v2u){PK2(plr.x, plr.y), PK2(plr.z, plr.w)};
    if (task + stride < GLA_TASKS) GP_ISSUE(task + stride);
    SYNC();
    {
        const int tt = wave >> 1; const v8s af = *(LP(const v8s))(LRb + (16 * tt + fr) * 80 + fq * 16);
#pragma unroll
        for (int i = 0; i < 4; ++i) { const int dt = (wave & 1) * 4 + i; const v8s bf = *(LP(const v8s))(WGb + (16 * dt + fr) * 80 + fq * 16);
            v4f z = (v4f){0.f, 0.f, 0.f, 0.f}; z = MFMA16(bf, af, z);
            const v4f bg4 = *(LP(const v4f))(BG + 16 * dt + 4 * fq);
            v4f o; o.x = logsigmoidf(z.x + bg4.x) * 0.0625f; o.y = logsigmoidf(z.y + bg4.y) * 0.0625f; o.z = logsigmoidf(z.z + bg4.z) * 0.0625f; o.w = logsigmoidf(z.w + bg4.w) * 0.0625f;
            *(LP(v4f))(LA + (16 * tt + fr) * LA_RS + 32 * fq + 4 * dt) = o; }
    }
    SYNC();
    {
        const int d = tid & 127, sg = tid >> 7; float acc = 0.f;
        float cv[16];
#pragma unroll
        for (int jj = 0; jj < 16; ++jj) cv[jj] = LA[(sg * 16 + jj) * LA_RS + d];
#pragma unroll
        for (int jj = 0; jj < 16; ++jj) { acc += cv[jj]; LA[(sg * 16 + jj) * LA_RS + d] = acc; }
        SEG[sg * 128 + d] = acc;
    }
    SYNC();
    {
        const int sgj = j >> 4;
        bf16* orow = QKS + ((size_t)dir * TT + row) * 1024 + h * 128 + dc;
#pragma unroll 1
        for (int g = 0; g < 2; ++g) {
            const v4u qv = g ? q1 : q0, kv = g ? k1 : k0;
            const unsigned qw[4] = {qv.x, qv.y, qv.z, qv.w}, kw[4] = {kv.x, kv.y, kv.z, kv.w};
            unsigned oqs[4], oks[4];
#pragma unroll
            for (int g2 = 0; g2 < 2; ++g2) {
                const int po = 32 * (2 * g + g2) + 4 * c8;
                const v4f la4 = *(LP(const v4f))(LA + j * LA_RS + po), mid4 = *(LP(const v4f))(LA + 32 * LA_RS + po);
                const v4f s04 = *(LP(const v4f))(SEG + po), s14 = *(LP(const v4f))(SEG + 128 + po), s24 = *(LP(const v4f))(SEG + 256 + po);
                const float lav[4] = {la4.x, la4.y, la4.z, la4.w}, midv[4] = {mid4.x, mid4.y, mid4.z, mid4.w};
                const float s0v[4] = {s04.x, s04.y, s04.z, s04.w}, s1v[4] = {s14.x, s14.y, s14.z, s14.w}, s2v[4] = {s24.x, s24.y, s24.z, s24.w};
                float vqs[4], vks[4];
#pragma unroll
                for (int e = 0; e < 4; ++e) {
                    const int d = dc + 8 * g + 4 * g2 + e, i2 = 2 * g2 + (e >> 1);
                    const float s0 = s0v[e], s1 = s1v[e], s2 = s2v[e];
                    const float pre = (sgj > 0 ? s0 : 0.f) + (sgj > 1 ? s1 : 0.f) + (sgj > 2 ? s2 : 0.f);
                    const float bv = lav[e] + pre;
                    const float bmid = midv[e] + s0 + s1;
                    const float q = ((e & 1) ? bfhi(qw[i2]) : bflo(qw[i2])) * qscale, k = (e & 1) ? bfhi(kw[i2]) : bflo(kw[i2]);
                    const float e1 = EXPF(bv - bmid);
                    vqs[e] = q * e1; vks[e] = k * RCPF(e1);
                    if (j == 63) { const float bend = bv; float* vp = VEC + (size_t)task * 384 + d; vp[0] = EXPF(bmid); vp[128] = EXPF(bend - bmid); vp[256] = EXPF(bend); }
                }
                oqs[2 * g2] = PK2(vqs[0], vqs[1]); oqs[2 * g2 + 1] = PK2(vqs[2], vqs[3]);
                oks[2 * g2] = PK2(vks[0], vks[1]); oks[2 * g2 + 1] = PK2(vks[2], vks[3]);
            }
            *(v4u*)(orow + 8 * g) = (v4u){oqs[0], oqs[1], oqs[2], oqs[3]};
            *(v4u*)(orow + 512 + 8 * g) = (v4u){oks[0], oks[1], oks[2], oks[3]};
        }
    }
    SYNC();
    }
#undef GP_ISSUE
}

DEV void gla_unit(const bf16* S, const bf16* QKS, const float* VEC, bf16* O, int unit, LP(unsigned char) lds, int tid, unsigned* sib, int prb = 0) {
    const int lane = tid & 63, wave = tid >> 6, fr = lane & 15, fq = lane >> 4;
    const int vs = unit & 3, dir = (unit >> 2) & 1, h = (unit >> 3) & 3, b = unit >> 5;
    LP(unsigned char) QS = lds; LP(unsigned char) KS = lds + 17408; LP(unsigned char) QB = lds + 34816;
    LP(unsigned char) VV = lds + 52224; LP(unsigned char) PM = lds + 61440; LP(unsigned char) STT = lds + 70656;
    LP(float) DV = (LP(float))(lds + 88064);
    for (int i = tid; i < 64 * ST128 / 4; i += NTHR) ((LP(unsigned))STT)[i] = 0u;
    v4f sacc[4];
#pragma unroll
    for (int i = 0; i < 4; ++i) sacc[i] = (v4f){0.f, 0.f, 0.f, 0.f};
    const int j = tid >> 3, c8 = tid & 7, dc = c8 * 16;
    const int tt = wave >> 1, vt0 = (wave & 1) * 2;
    const int svt = wave & 3, sdt0 = (wave >> 2) * 4;
    bf16* Od = O + (size_t)dir * TT * 1024;
    constexpr int NCHUNK = CTXL / 64 + SEQ / 64;
    const int task0 = ((b * 4 + h) * 2 + dir) * NCHUNK;
    v4u gq0[2], gq1[2], gk0[2], gk1[2], gvv[2]; v4f gem[4]; v4f gdv = (v4f){0.f, 0.f, 0.f, 0.f};
#define GLA_ISSUE(cx, P_) do { const int seg_ = (cx) >= CTXL / 64, ci_ = seg_ ? (cx) - CTXL / 64 : (cx); \
        const int row_ = PRBROW(tok_row(b, seg_, ci_ * 64 + j, dir, 0)); \
        const bf16* qr_ = QKS + ((size_t)dir * TT + row_) * 1024 + h * 128 + c8 * 8; \
        gq0[P_] = *(const v4u*)(qr_); gq1[P_] = *(const v4u*)(qr_ + 64); gk0[P_] = *(const v4u*)(qr_ + 512); gk1[P_] = *(const v4u*)(qr_ + 576); \
        gvv[P_] = *(const v4u*)(S + (size_t)row_ * EV_PAD + 1024 + h * 256 + vs * 64 + c8 * 8); } while (0)
#define GLA_ISSUE_V(cx) do { const float* vp_ = VEC + (size_t)PRBTSK(task0 + (cx)) * 384;     \
        _Pragma("unroll") for (int i_ = 0; i_ < 4; ++i_) gem[i_] = *(const v4f*)(vp_ + (i_ >> 1) * 64 + c8 * 8 + 4 * (i_ & 1)); \
        if (tid < 64) gdv = *(const v4f*)(vp_ + 128 + tid * 4); } while (0)
#ifdef GLA_TOTAL_PROBE
    const unsigned long long gt0_ = __builtin_amdgcn_s_memrealtime();
#endif
    GLA_ISSUE(0, 0); GLA_ISSUE(1, 1); GLA_ISSUE_V(0);
    SYNC();
#pragma unroll 1
    for (int c2 = 0; c2 < NCHUNK; c2 += 2) {
#pragma unroll
    for (int u_ = 0; u_ < 2; ++u_) {
        const int cidx = c2 + u_;
        const int seg = cidx >= CTXL / 64, ci = seg ? cidx - CTXL / 64 : cidx;
        if (u_ == 0 && (c2 & 3) == 0 && c2 > 0) sibling_sync(sib, (unsigned)(c2 >> 2) * 4u, tid);
        const v4u q0 = gq0[u_], q1 = gq1[u_], k0 = gk0[u_], k1 = gk1[u_], vv = gvv[u_]; const v4f dvv = gdv;
        v4f em[4];
#pragma unroll
        for (int i_ = 0; i_ < 4; ++i_) em[i_] = gem[i_];
        {
            *(LP(v4u))(QS + j * ST128 + c8 * 16) = q0; *(LP(v4u))(QS + j * ST128 + c8 * 16 + 128) = q1;
            *(LP(v4u))(KS + j * ST128 + c8 * 16) = k0; *(LP(v4u))(KS + j * ST128 + c8 * 16 + 128) = k1;
            const unsigned qw[8] = {q0.x, q0.y, q0.z, q0.w, q1.x, q1.y, q1.z, q1.w}; unsigned ob[8];
#pragma unroll
            for (int i2 = 0; i2 < 8; ++i2) { const v4f e4 = em[i2 >> 1]; const float ea = (i2 & 1) ? e4.z : e4.x, eb = (i2 & 1) ? e4.w : e4.y; ob[i2] = PK2(bflo(qw[i2]) * ea, bfhi(qw[i2]) * eb); }
            *(LP(v4u))(QB + j * ST128 + c8 * 16) = (v4u){ob[0], ob[1], ob[2], ob[3]}; *(LP(v4u))(QB + j * ST128 + c8 * 16 + 128) = (v4u){ob[4], ob[5], ob[6], ob[7]};
            *(LP(v4u))(VV + j * ST64 + c8 * 16) = vv;
            if (tid < 64) *(LP(v4f))(DV + tid * 4) = dvv;
        }
        if (cidx + 2 < NCHUNK) GLA_ISSUE(cidx + 2, u_);
        if (cidx + 1 < NCHUNK) GLA_ISSUE_V(cidx + 1);
        SYNC();
        v4f oacc[2]; oacc[0] = (v4f){0.f, 0.f, 0.f, 0.f}; oacc[1] = oacc[0];
        {
#pragma unroll
            for (int i = 0; i < 2; ++i) { const int st = vt0 + i; v4f p = (v4f){0.f, 0.f, 0.f, 0.f};
                if (st <= tt) { p = tile_mma(p, QS, ST128, 16 * tt, KS, ST128, 16 * st, 4, fr, fq);
                    if (st == tt) { if (4 * fq + 0 > fr) p.x = 0.f; if (4 * fq + 1 > fr) p.y = 0.f; if (4 * fq + 2 > fr) p.z = 0.f; if (4 * fq + 3 > fr) p.w = 0.f; } }
                *(LP(v2u))(PM + (16 * tt + fr) * ST64 + (16 * st + 4 * fq) * 2) = (v2u){PK2(p.x, p.y), PK2(p.z, p.w)}; }
#pragma unroll
            for (int k = 0; k < 4; ++k) { const v8s af = *(LP(const v8s))(QB + (16 * tt + fr) * ST128 + fq * 16 + k * 64);
#pragma unroll
                for (int i = 0; i < 2; ++i) { const v8s bf = *(LP(const v8s))(STT + (16 * (vt0 + i) + fr) * ST128 + fq * 16 + k * 64); oacc[i] = MFMA16(bf, af, oacc[i]); } }
        }
        SYNC();
#pragma unroll
        for (int k = 0; k < 2; ++k) { const v8s af = *(LP(const v8s))(PM + (16 * tt + fr) * ST64 + fq * 16 + k * 64);
#pragma unroll
            for (int i = 0; i < 2; ++i) { const v8s bf = tr_frag(VV, ST64, 32 * k, 16 * (vt0 + i), lane); oacc[i] = MFMA16(bf, af, oacc[i]); } }
        if (!prb) { const int orow = tok_row(b, seg, ci * 64 + 16 * tt + fr, dir, 0);
#pragma unroll
          for (int i = 0; i < 2; ++i) *(v2u*)(Od + (size_t)orow * 1024 + h * 256 + vs * 64 + 16 * (vt0 + i) + 4 * fq) = (v2u){PK2(oacc[i].x, oacc[i].y), PK2(oacc[i].z, oacc[i].w)}; }
        {
            v4f tmp[4];
#pragma unroll
            for (int i = 0; i < 4; ++i) tmp[i] = (v4f){0.f, 0.f, 0.f, 0.f};
#pragma unroll
            for (int k = 0; k < 2; ++k) { const v8s af = tr_frag(VV, ST64, 32 * k, 16 * svt, lane);
#pragma unroll
                for (int i = 0; i < 4; ++i) { const v8s bf = tr_frag(KS, ST128, 32 * k, 16 * (sdt0 + i), lane); tmp[i] = MFMA16(bf, af, tmp[i]); } }
#pragma unroll
            for (int i = 0; i < 4; ++i) { const v4f ee = *(LP(const v4f))(DV + 16 * (sdt0 + i) + 4 * fq), de = *(LP(const v4f))(DV + 128 + 16 * (sdt0 + i) + 4 * fq);
                sacc[i] = sacc[i] * de + tmp[i] * ee;
                *(LP(v2u))(STT + (16 * svt + fr) * ST128 + (16 * (sdt0 + i) + 4 * fq) * 2) = (v2u){PK2(sacc[i].x, sacc[i].y), PK2(sacc[i].z, sacc[i].w)}; }
        }
        SYNC();
    }
    }
#undef GLA_ISSUE
#undef GLA_ISSUE_V
#ifdef GLA_TOTAL_PROBE
    if (wave == 1) { const unsigned long long acc_ = __builtin_amdgcn_s_memrealtime() - gt0_, t0_ = __builtin_amdgcn_s_memrealtime(); while (__builtin_amdgcn_s_memrealtime() - t0_ < 8ull * acc_) __builtin_amdgcn_s_sleep(8); }
#endif
}

constexpr int MAT_TASKS = NB * 4 * 2 * (CTXL / 64 + SEQ / 64);
template <int MODE>
DEV void mat_prep_loop(int first, int stride, const bf16* Sqk, int ldqk, int qoff, int koff, float kscale, const float* GT, const float* gate_b, float* GP, float* GPK,
                       const float* ret_log_decay, bf16* PP, float* RS, LP(unsigned char) lds, int tid) {
    constexpr int NCHUNK = CTXL / 64 + SEQ / 64;
    const int lane = tid & 63, wave = tid >> 6, fr = lane & 15, fq = lane >> 4;
    LP(unsigned char) Q = lds; LP(unsigned char) K = lds + 33792; LP(float) AS = (LP(float))(lds + 67584); LP(float) R0 = AS + 64; LP(float) DENP = AS + 128; LP(float) W0 = AS + 384;
    const int j = tid >> 3, c8 = tid & 7, dc = c8 * 32;
    v4u rq[4], rk[4]; float gi = 0.f, gf = 0.f;
#define MP_ISSUE(tk) do { const int cx_ = (tk) % NCHUNK, r1_ = (tk) / NCHUNK, dir_ = r1_ & 1, h_ = (r1_ >> 1) & 3, b_ = r1_ >> 3; \
        const int seg_ = cx_ >= CTXL / 64, ci_ = seg_ ? cx_ - CTXL / 64 : cx_; \
        const bf16* s1_ = Sqk + (size_t)tok_row(b_, seg_, ci_ * 64 + j, dir_, 1) * ldqk; \
        _Pragma("unroll") for (int g_ = 0; g_ < 4; ++g_) { rq[g_] = *(const v4u*)(s1_ + qoff + h_ * 256 + c8 * 8 + 64 * g_); rk[g_] = *(const v4u*)(s1_ + koff + h_ * 256 + c8 * 8 + 64 * g_); } \
        if (MODE == 0 && wave == 0) { const int prow_ = tok_row(b_, seg_, ci_ * 64 + lane, dir_, 1); \
            gi = GT[(size_t)prow_ * 256 + 32 + (dir_ * 2 + 0) * 4 + h_]; gf = GT[(size_t)prow_ * 256 + 32 + (dir_ * 2 + 1) * 4 + h_]; } } while (0)
    if (first < MAT_TASKS) MP_ISSUE(first);
    for (int task = first; task < MAT_TASKS; task += stride) {
        const int cidx = task % NCHUNK, r1 = task / NCHUNK, dir = r1 & 1, h = (r1 >> 1) & 3, b = r1 >> 3;
        const int seg = cidx >= CTXL / 64, ci = seg ? cidx - CTXL / 64 : cidx;
#pragma unroll
        for (int g8 = 0; g8 < 4; ++g8) { *(LP(v4u))(Q + j * ST256 + (c8 * 8 + 64 * g8) * 2) = rq[g8]; *(LP(v4u))(K + j * ST256 + (c8 * 8 + 64 * g8) * 2) = rk[g8]; }
        if (wave == 0) {
            if (MODE == 0) {
                const int prow = tok_row(b, seg, ci * 64 + lane, dir, 1);
                const float ig = gi + gate_b[(dir * 2 + 0) * 4 + h];
                float bcum = logsigmoidf(gf + gate_b[(dir * 2 + 1) * 4 + h]);
#pragma unroll
                for (int o = 1; o < 64; o <<= 1) { const float t = SHUP(bcum, o); if (lane >= o) bcum += t; }
                const float a_s = ig - bcum;
                float cm = a_s;
#pragma unroll
                for (int o = 1; o < 64; o <<= 1) { const float t = SHUP(cm, o); if (lane >= o) cm = fmaxf(cm, t); }
                *(v4f*)(GP + ((size_t)prow * 8 + dir * 4 + h) * 4) = (v4f){bcum, a_s, cm, 0.f};
                AS[lane] = a_s; R0[lane] = -cm; W0[lane] = EXPF(a_s - RDLANE(cm, 63));
            } else { const float lg = -expf(ret_log_decay[dir * 4 + h]); AS[lane] = -(float)(lane + 1) * lg; R0[lane] = (float)(lane + 1) * lg; }
        }
        if (task + stride < MAT_TASKS) MP_ISSUE(task + stride);
        SYNC();
        const int tt = wave >> 1;
        bf16* pp = PP + (size_t)task * 4096;
        const float rt = R0[16 * tt + fr];
#pragma unroll
        for (int i = 0; i < 2; ++i) { const int st = (wave & 1) * 2 + i; v4f p = (v4f){0.f, 0.f, 0.f, 0.f};
            if (st <= tt) { p = tile_mma(p, Q, ST256, 16 * tt, K, ST256, 16 * st, 8, fr, fq);
                const v4f as4 = *(LP(const v4f))(AS + 16 * st + 4 * fq);
                p.x *= kscale * EXPF(as4.x + rt); p.y *= kscale * EXPF(as4.y + rt); p.z *= kscale * EXPF(as4.z + rt); p.w *= kscale * EXPF(as4.w + rt);
                if (st == tt) { if (4 * fq + 0 > fr) p.x = 0.f; if (4 * fq + 1 > fr) p.y = 0.f; if (4 * fq + 2 > fr) p.z = 0.f; if (4 * fq + 3 > fr) p.w = 0.f; } }
            *(v2u*)(pp + (16 * tt + fr) * 64 + 16 * st + 4 * fq) = (v2u){PK2(p.x, p.y), PK2(p.z, p.w)};
            if (MODE == 0) { float rs = (p.x + p.y) + (p.z + p.w); rs += SHX(rs, 16); rs += SHX(rs, 32); if (fq == 0) DENP[st * 64 + 16 * tt + fr] = rs; } }
        if (MODE == 0 && tid >= 256) {
            const int d = tid - 256; float kw = 0.f;
            for (int jj = 0; jj < 64; ++jj) kw += __uint_as_float(((unsigned)*(LP(const unsigned short))(K + jj * ST256 + d * 2)) << 16) * W0[jj];
            GPK[(size_t)task * 256 + d] = kw; }
        SYNC();
        if (MODE == 0 && tid < 64) RS[(size_t)task * 64 + tid] = (DENP[tid] + DENP[64 + tid]) + (DENP[128 + tid] + DENP[192 + tid]);
        SYNC();
    }
#undef MP_ISSUE
}

#ifdef SEC_PROBE
#ifndef SEC_WAVE
#define SEC_WAVE 1
#endif
#ifndef SEC_MODE
#define SEC_MODE 0
#endif
#define SECT(s, e) do { if ((s) == SEC_PROBE && MODE == SEC_MODE) { const unsigned long long t_ = __builtin_amdgcn_s_memrealtime(); if (e) sec_acc += t_ - sec_t0; else sec_t0 = t_; } } while (0)
#else
#define SECT(s, e) do {} while (0)
#endif
template <int MODE>
DEV void mat_unit(const bf16* Sqk, int ldqk, int qoff, int koff, const bf16* Sv, int ldv, int voff, float kscale, const float* GP, const float* GPK, const bf16* PP, const float* RS, bf16* O, int store_ctx,
                  const float* ret_log_decay, int unit, LP(unsigned char) lds, int tid, unsigned* sib, int prb = 0) {
    const int lane = tid & 63, wave = tid >> 6, fr = lane & 15, fq = lane >> 4;
    const int vs = unit & 3, dir = (unit >> 2) & 1, h = (unit >> 3) & 3, b = unit >> 5;
    LP(unsigned char) Q = lds; LP(unsigned char) K = lds + 33792;
    LP(unsigned char) VV = lds + 67584; LP(unsigned char) VW = lds + 76800;
    LP(unsigned char) PM = lds + 86016; LP(unsigned char) STT = lds + 95232;
    LP(float) SCAL = (LP(float))(lds + 137472);
    LP(float) NV = SCAL + 768;
    for (int i = tid; i < 80 * ST256 / 4; i += NTHR) ((LP(unsigned))STT)[i] = 0u;
    if (tid < 256) NV[tid] = 0.f;
    v4f sacc[8];
#pragma unroll
    for (int i = 0; i < 8; ++i) sacc[i] = (v4f){0.f, 0.f, 0.f, 0.f};
    const int j = tid >> 3, c8 = tid & 7;
    const int tt = wave >> 1, vt0 = (wave & 1) * 2;
#ifdef SEC_PROBE
    unsigned long long sec_acc = 0ull, sec_t0 = 0ull;
#endif
    float m_st = 0.f;
    float lg = 0.f;
    if (MODE == 1) lg = -expf(ret_log_decay[dir * 4 + h]);
    bf16* Od = O + (size_t)(2 + dir) * TT * 1024;
    constexpr int NCHUNK = CTXL / 64 + SEQ / 64;
    v4u rq[2][4], rk[2][4], rv, rp; v4f gpv = (v4f){0.f, 0.f, 0.f, 0.f}; float kwv[2] = {0.f, 0.f}, rsv = 0.f;
    const int task0 = ((b * 4 + h) * 2 + dir) * NCHUNK;
#define MAT_ISSUE(cx, P_) do { const int seg_ = (cx) >= CTXL / 64, ci_ = seg_ ? (cx) - CTXL / 64 : (cx); \
        const int row_ = PRBROW(tok_row(b, seg_, ci_ * 64 + j, dir, 1)); \
        const bf16* s1_ = Sqk + (size_t)row_ * ldqk; \
        _Pragma("unroll") for (int g_ = 0; g_ < 4; ++g_) { rq[P_][g_] = *(const v4u*)(s1_ + qoff + h * 256 + c8 * 8 + 64 * g_); rk[P_][g_] = *(const v4u*)(s1_ + koff + h * 256 + c8 * 8 + 64 * g_); } \
        if (MODE == 0 && tid < 256) kwv[P_] = GPK[(size_t)(task0 + (cx)) * 256 + tid]; } while (0)
#define MAT_GATE_LOAD(cx) do { if (MODE == 0 && wave == 0) { const int seg_ = (cx) >= CTXL / 64, ci_ = seg_ ? (cx) - CTXL / 64 : (cx); \
        const int prow_ = PRBROW(tok_row(b, seg_, ci_ * 64 + lane, dir, 1)); gpv = *(const v4f*)(GP + ((size_t)prow_ * 8 + dir * 4 + h) * 4); rsv = RS[(size_t)PRBTSK(task0 + (cx)) * 64 + lane]; } } while (0)
#define MAT_GATES(cx) do { if (wave == 0) { LP(float) sc_ = SCAL + ((cx) & 1) * 384; \
        if (MODE == 0) { const float bcum_ = gpv.x, a_s_ = gpv.y, Mt_ = fmaxf(m_st, gpv.z); \
            const float M63_ = RDLANE(Mt_, 63), bend_ = RDLANE(bcum_, 63), cm63_ = RDLANE(gpv.z, 63); const float wp_ = EXPF(gpv.z - Mt_); \
            sc_[lane] = wp_; sc_[64 + lane] = EXPF(m_st - Mt_); sc_[128 + lane] = EXPF(a_s_ - M63_); sc_[192 + lane] = EXPF(-(bcum_ + Mt_)); sc_[256 + lane] = rsv * wp_; \
            if (lane == 0) { sc_[320] = EXPF(m_st - M63_); sc_[321] = EXPF(cm63_ - M63_); } \
            m_st = bend_ + M63_; \
        } else { sc_[lane] = 1.0f; sc_[64 + lane] = EXPF((float)(lane + 1) * lg); sc_[128 + lane] = EXPF((float)(63 - lane) * lg); sc_[192 + lane] = 0.f; sc_[256 + lane] = 0.f; \
            if (lane == 0) { sc_[320] = EXPF(64.f * lg); sc_[321] = 0.f; } } } } while (0)
    static_assert(NCHUNK % 2 == 0, "the chunk loop is unrolled by two");
#define MAT_ISSUE_P(cx) do { const int seg_ = (cx) >= CTXL / 64, ci_ = seg_ ? (cx) - CTXL / 64 : (cx); rp = *(const v4u*)(PP + (size_t)PRBTSK(task0 + (cx)) * 4096 + j * 64 + c8 * 8); \
        rv = *(const v4u*)(Sv + (size_t)PRBROW(tok_row(b, seg_, ci_ * 64 + j, dir, 1)) * ldv + voff + h * 256 + vs * 64 + c8 * 8); } while (0)
    SECT(5, 0);
    MAT_ISSUE(0, 0); MAT_ISSUE(1, 1); MAT_ISSUE_P(0); MAT_GATE_LOAD(0);
    MAT_GATES(0);
    MAT_GATE_LOAD(1);
    SYNC();
#pragma unroll 1
    for (int c2 = 0; c2 < NCHUNK; c2 += 2) {
#pragma unroll
    for (int u_ = 0; u_ < 2; ++u_) {
        const int cidx = c2 + u_;
        const int seg = cidx >= CTXL / 64, ci = seg ? cidx - CTXL / 64 : cidx;
        if (u_ == 0 && (c2 & 3) == 0 && c2 > 0) sibling_sync(sib, (unsigned)(c2 >> 2) * 4u, tid);
        LP(const float) sc = SCAL + u_ * 384;
        const float kw_cur = kwv[u_];
        SECT(6, 0);
#if defined(SEC_PROBE) && SEC_PROBE == 6
        asm volatile("s_waitcnt vmcnt(0)" ::: "memory");
#endif
        SECT(6, 1);
        SECT(1, 0);
        {
            const float wk = sc[128 + j] * kscale;
#pragma unroll
            for (int g8 = 0; g8 < 4; ++g8) { const int d0 = c8 * 8 + 64 * g8;     *(LP(v4u))(Q + j * ST256 + d0 * 2) = rq[u_][g8]; *(LP(v4u))(K + j * ST256 + d0 * 2) = rk[u_][g8]; }
            const v4u rvv = rv;
            *(LP(v4u))(VV + j * ST64 + c8 * 16) = rvv;
            *(LP(v4u))(VW + j * ST64 + c8 * 16) = (v4u){PK2(bflo(rvv.x) * wk, bfhi(rvv.x) * wk), PK2(bflo(rvv.y) * wk, bfhi(rvv.y) * wk), PK2(bflo(rvv.z) * wk, bfhi(rvv.z) * wk), PK2(bflo(rvv.w) * wk, bfhi(rvv.w) * wk)};
            *(LP(v4u))(PM + j * ST64 + c8 * 16) = rp;
#pragma unroll
            for (int i = 0; i < 8; ++i) *(LP(v2u))(STT + (16 * (i >> 1) + fr) * ST256 + (16 * (2 * wave + (i & 1)) + 4 * fq) * 2) = (v2u){PK2(sacc[i].x, sacc[i].y), PK2(sacc[i].z, sacc[i].w)};
        }
        if (cidx + 2 < NCHUNK) MAT_ISSUE(cidx + 2, u_);
        if (cidx + 1 < NCHUNK) MAT_ISSUE_P(cidx + 1);
        SECT(1, 1); SECT(2, 0);
        SYNC();
        SECT(2, 1); SECT(3, 0);
        if (cidx + 1 < NCHUNK) { MAT_GATES(cidx + 1); if (cidx + 2 < NCHUNK) MAT_GATE_LOAD(cidx + 2); }
        v4f oP[2], oI[2]; oP[0] = (v4f){0.f, 0.f, 0.f, 0.f}; oP[1] = oP[0]; oI[0] = oP[0]; oI[1] = oP[0];
        v4f qa = (v4f){0.f, 0.f, 0.f, 0.f};
#pragma unroll 1
        for (int k = 0; k < 8; ++k) { const v8s af = *(LP(const v8s))(Q + (16 * tt + fr) * ST256 + fq * 16 + k * 64);
#pragma unroll
            for (int i = 0; i < 2; ++i) { const v8s bf = *(LP(const v8s))(STT + (16 * (vt0 + i) + fr) * ST256 + fq * 16 + k * 64); oI[i] = MFMA16(bf, af, oI[i]); }
            if (MODE == 0) { const v8s bn = *(LP(const v8s))(STT + (64 + fr) * ST256 + fq * 16 + k * 64); qa = MFMA16(bn, af, qa); } }
#pragma unroll
        for (int k = 0; k < 2; ++k) { const v8s af = *(LP(const v8s))(PM + (16 * tt + fr) * ST64 + fq * 16 + k * 64);
#pragma unroll
            for (int i = 0; i < 2; ++i) { const v8s bf = tr_frag(VV, ST64, 32 * k, 16 * (vt0 + i), lane); oP[i] = MFMA16(bf, af, oP[i]); } }
        { const int t = 16 * tt + fr; const float wp = sc[t], wi = sc[64 + t];
          v4f o0 = oP[0] * wp + oI[0] * wi, o1 = oP[1] * wp + oI[1] * wi;
          if (MODE == 0) { const float qn = RDLANE16(qa.x, fr); const float den = sc[256 + t] + wi * qn; const float dv = 1.0f / fmaxf(fabsf(den), sc[192 + t]); o0 = o0 * dv; o1 = o1 * dv; }
          if ((seg || store_ctx) && !prb) { const int orow = tok_row(b, seg, ci * 64 + t, dir, 1);
              *(v2u*)(Od + (size_t)orow * 1024 + h * 256 + vs * 64 + 16 * vt0 + 4 * fq) = (v2u){PK2(o0.x, o0.y), PK2(o0.z, o0.w)};
              *(v2u*)(Od + (size_t)orow * 1024 + h * 256 + vs * 64 + 16 * (vt0 + 1) + 4 * fq) = (v2u){PK2(o1.x, o1.y), PK2(o1.z, o1.w)}; } }
        const float dcy = sc[320];
        {
#pragma unroll
            for (int i = 0; i < 8; ++i) sacc[i] = sacc[i] * dcy;
#pragma unroll 1
            for (int k = 0; k < 2; ++k) {
                const v8s bf0 = tr_frag(K, ST256, 32 * k, 16 * (2 * wave), lane), bf1 = tr_frag(K, ST256, 32 * k, 16 * (2 * wave + 1), lane);
#pragma unroll
                for (int a4 = 0; a4 < 4; ++a4) { const v8s af = tr_frag(VW, ST64, 32 * k, 16 * a4, lane); sacc[2 * a4] = MFMA16(bf0, af, sacc[2 * a4]); sacc[2 * a4 + 1] = MFMA16(bf1, af, sacc[2 * a4 + 1]); } }
        }
        SECT(3, 1); SECT(4, 0);
        SYNC();
        SECT(4, 1);
        if (MODE == 0 && tid < 256) {
            const float nn = dcy * NV[tid] + sc[321] * kw_cur * kscale; NV[tid] = nn;
            *(LP(unsigned short))(STT + 64 * ST256 + tid * 2) = F2BF(nn); }
    }
    }
#undef MAT_ISSUE
#undef MAT_ISSUE_P
#undef MAT_GATE_LOAD
#undef MAT_GATES
    SYNC();
    SECT(5, 1);
#ifdef SEC_PROBE
    if (MODE == SEC_MODE && (SEC_UNIT < 0 || unit == SEC_UNIT) && wave == SEC_WAVE) { const unsigned long long t0_ = __builtin_amdgcn_s_memrealtime(); while (__builtin_amdgcn_s_memrealtime() - t0_ < 8ull * sec_acc) __builtin_amdgcn_s_sleep(8); }
#endif
}

constexpr int S5_LDS_PER_WAVE = 1280 + 2 * 10240 + 2 * 6144;
DEV void s5_unit(const bf16* S, int ldS, bf16* O, const float* lam_re, const float* lam_im, const float* log_step, const float* b_re, const float* b_im,
                 const float* c_re, const float* c_im, int unit, LP(unsigned char) wl, int lane, int prb = 0) {
    const int fr = lane & 15, fq = lane >> 4;
    const int dir = unit & 1, g = (unit >> 1) & 63, b = unit >> 7;
    LP(unsigned char) UB = wl; LP(unsigned char) XB = wl + 1280; LP(unsigned char) HB = wl + 1280 + 2 * 10240;
    const int pg = (dir * 64 + g);
    const float lr = lam_re[pg * 64 + lane], li = lam_im[pg * 64 + lane], step = expf(log_step[pg]);
    const float mag = expf(lr * step); float sn, cs; sincosf(li * step, &sn, &cs);
    const float ar = mag * cs, ai = mag * sn, den = lr * lr + li * li;
    const float cre = ((ar - 1.0f) * lr + ai * li) / den, cim = (ai * lr - (ar - 1.0f) * li) / den;
    for (int p = 0; p < 16; ++p) { const float br = b_re[(pg * 64 + lane) * 16 + p], bi = b_im[(pg * 64 + lane) * 16 + p];
        *(LP(unsigned short))(XB + lane * 32 + p * 2) = F2BF(cre * br - cim * bi);
        *(LP(unsigned short))(XB + (64 + lane) * 32 + p * 2) = F2BF(cre * bi + cim * br); }
    WAVE_SYNC();
    v8s bfrag[8];
#pragma unroll
    for (int nt = 0; nt < 8; ++nt) { if (fq < 2) bfrag[nt] = *(LP(const v8s))(XB + (16 * nt + fr) * 32 + fq * 16); else bfrag[nt] = (v8s){0, 0, 0, 0, 0, 0, 0, 0}; }
    v8s cfrag[4];
#pragma unroll
    for (int ks = 0; ks < 4; ++ks) { const int n0 = 32 * ks + 8 * fq; const float* src = (n0 < 64 ? c_re : c_im) + ((size_t)pg * 16 + fr) * 64 + (n0 & 63); const float sgn = n0 < 64 ? 1.f : -1.f;
        v8s f;
#pragma unroll
        for (int i = 0; i < 8; ++i) f[i] = (short)F2BF(sgn * src[i]);
        cfrag[ks] = f; }
    WAVE_SYNC();
    for (int i = lane; i < 1280 / 4; i += 64) ((LP(unsigned))UB)[i] = 0u;
    WAVE_SYNC();
    float hr = 0.f, hi = 0.f;
    bf16* Od = O + (size_t)dir * TT * 1024;
    constexpr int NBLK = CTXL / 16 + SEQ / 16;
    constexpr int S5_PF = 8;
    v4u ur[S5_PF];
#pragma unroll
    for (int i_ = 0; i_ < S5_PF; ++i_) ur[i_] = (v4u){0u, 0u, 0u, 0u};
#define S5_LOAD(bx, dst) do { if (lane < 32 && (bx) < NBLK) { const int seg_ = (bx) >= CTXL / 16, bi_ = seg_ ? (bx) - CTXL / 16 : (bx); \
        dst = *(const v4u*)(S + (size_t)PRBROW(tok_row(b, seg_, bi_ * 16 + (lane >> 1), dir, 0)) * ldS + g * 16 + (lane & 1) * 8); } } while (0)
#define S5_STAGE_A(bx) do { const v8s uf_ = *(LP(const v8s))(UB + fr * 80 + fq * 16); LP(unsigned char) xb_ = XB + ((bx) & 1) * 10240; \
        _Pragma("unroll") for (int nt = 0; nt < 8; ++nt) { v4f x = (v4f){0.f, 0.f, 0.f, 0.f}; x = MFMA16(uf_, bfrag[nt], x); *(LP(v4f))(xb_ + (16 * nt + fr) * 80 + fq * 16) = x; } } while (0)
#pragma unroll
    for (int i_ = 0; i_ < S5_PF; ++i_) S5_LOAD(i_, ur[i_]);
    if (lane < 32) *(LP(v4u))(UB + (lane >> 1) * 80 + (lane & 1) * 16) = ur[0];
#pragma unroll
    for (int i_ = 0; i_ + 1 < S5_PF; ++i_) ur[i_] = ur[i_ + 1];
    S5_LOAD(S5_PF, ur[S5_PF - 1]);
    WAVE_SYNC();
    S5_STAGE_A(0);
    static_assert(NBLK % S5_PF == 0, "ring unrolling");
#pragma unroll 1
    for (int bx0 = 0; bx0 <= NBLK; bx0 += S5_PF) {
#pragma unroll
    for (int ui = 0; ui < S5_PF; ++ui) {
        const int bx = bx0 + ui; if (bx > NBLK) break;
        WAVE_SYNC();
        v8s hf[4]; float xr[16], xi[16];
        if (bx >= 1) { LP(unsigned char) hb = HB + ((bx - 1) & 1) * 6144;
#pragma unroll
            for (int ks = 0; ks < 4; ++ks) hf[ks] = tr_frag(hb, 48, 32 * ks, 0, lane); }
        if (bx < NBLK) { LP(unsigned char) xb = XB + (bx & 1) * 10240;
#pragma unroll
            for (int q4 = 0; q4 < 4; ++q4) { const v4f a4 = *(LP(const v4f))(xb + lane * 80 + q4 * 16), b4 = *(LP(const v4f))(xb + (64 + lane) * 80 + q4 * 16);
                xr[4 * q4] = a4.x; xr[4 * q4 + 1] = a4.y; xr[4 * q4 + 2] = a4.z; xr[4 * q4 + 3] = a4.w; xi[4 * q4] = b4.x; xi[4 * q4 + 1] = b4.y; xi[4 * q4 + 2] = b4.z; xi[4 * q4 + 3] = b4.w; } }
        if (bx + 1 < NBLK) { if (lane < 32) *(LP(v4u))(UB + (lane >> 1) * 80 + (lane & 1) * 16) = ur[ui]; S5_LOAD(bx + 1 + S5_PF, ur[ui]); }
        WAVE_SYNC();
        if (bx + 1 < NBLK) S5_STAGE_A(bx + 1);
        if (bx >= 1) { const int pb = bx - 1, seg = pb >= CTXL / 16, bi = seg ? pb - CTXL / 16 : pb;
            if (seg && !prb) { v4f y = (v4f){0.f, 0.f, 0.f, 0.f};
#pragma unroll
                for (int ks = 0; ks < 4; ++ks) y = MFMA16(cfrag[ks], hf[ks], y);
                const int orow = tok_row(b, seg, bi * 16 + fr, dir, 0);
                *(v2u*)(Od + (size_t)orow * 1024 + g * 16 + 4 * fq) = (v2u){PK2(y.x, y.y), PK2(y.z, y.w)}; } }
        if (bx < NBLK) { LP(unsigned char) hb = HB + (bx & 1) * 6144;
            unsigned pr[8], pi[8];
#pragma unroll
            for (int t2 = 0; t2 < 8; ++t2) {
                const float r0 = ar * hr - ai * hi + xr[2 * t2], i0 = ar * hi + ai * hr + xi[2 * t2];
                hr = ar * r0 - ai * i0 + xr[2 * t2 + 1]; hi = ar * i0 + ai * r0 + xi[2 * t2 + 1];
                pr[t2] = PK2(r0, hr); pi[t2] = PK2(i0, hi); }
            *(LP(v4u))(hb + lane * 48) = (v4u){pr[0], pr[1], pr[2], pr[3]}; *(LP(v4u))(hb + lane * 48 + 16) = (v4u){pr[4], pr[5], pr[6], pr[7]};
            *(LP(v4u))(hb + (64 + lane) * 48) = (v4u){pi[0], pi[1], pi[2], pi[3]}; *(LP(v4u))(hb + (64 + lane) * 48 + 16) = (v4u){pi[4], pi[5], pi[6], pi[7]}; }
    }
    }
#undef S5_STAGE_A
#undef S5_LOAD
}

DEV void conv_prep_row(int r, const bf16* S, bf16* QK2, const float* conv_w, const float* conv_b, int lane) {
    int rm, rp; bool hasm, hasp;
    if (r < TL) { const int b = r >> 12, n = r & (SEQ - 1), gr = n >> 6, col = n & 63, np = col * 64 + gr;
        hasm = np > 0; hasp = np < SEQ - 1; rm = seq_row(b, 1, hasm ? np - 1 : np, 1); rp = seq_row(b, 1, hasp ? np + 1 : np, 1); }
    else { const int n = (r - TL) & (CTXL - 1); hasm = n > 0; hasp = n < CTXL - 1; rm = hasm ? r - 1 : r; rp = hasp ? r + 1 : r; }
    const bf16* s0 = S + (size_t)rm * EV_PAD + 3072; const bf16* s1 = S + (size_t)r * EV_PAD + 3072; const bf16* s2 = S + (size_t)rp * EV_PAD + 3072;
#pragma unroll
    for (int i = 0; i < 4; ++i) { const int c = 8 * lane + 512 * i;
        const v4u a0 = *(const v4u*)(s0 + c), a1 = *(const v4u*)(s1 + c), a2 = *(const v4u*)(s2 + c);
        const unsigned w0[4] = {a0.x, a0.y, a0.z, a0.w}, w1[4] = {a1.x, a1.y, a1.z, a1.w}, w2[4] = {a2.x, a2.y, a2.z, a2.w};
        const float sc = c >= 1024 ? 0.0625f : 1.0f;
        float val[8];
#pragma unroll
        for (int i2 = 0; i2 < 4; ++i2)
#pragma unroll
            for (int e = 0; e < 2; ++e) { const int di = 2 * i2 + e;
                const float um = hasm ? (e ? bfhi(w0[i2]) : bflo(w0[i2])) : 0.f, u0 = e ? bfhi(w1[i2]) : bflo(w1[i2]), up = hasp ? (e ? bfhi(w2[i2]) : bflo(w2[i2])) : 0.f;
                const float pre = conv_b[c + di] + conv_w[c + di] * um + conv_w[2048 + c + di] * u0 + conv_w[4096 + c + di] * up;
                val[di] = pre * RCPF(1.0f + EXPF(-pre)) * sc; }
        *(v4u*)(QK2 + (size_t)r * 2048 + c) = (v4u){PK2(val[0], val[1]), PK2(val[2], val[3]), PK2(val[4], val[5]), PK2(val[6], val[7])}; }
}
DEV void conv_prep_row_lds(int r, const bf16* S, bf16* QK2, LP(const float) tab, int lane) {
    int rm, rp; bool hasm, hasp;
    if (r < TL) { const int b = r >> 12, n = r & (SEQ - 1), gr = n >> 6, col = n & 63, np = col * 64 + gr;
        hasm = np > 0; hasp = np < SEQ - 1; rm = seq_row(b, 1, hasm ? np - 1 : np, 1); rp = seq_row(b, 1, hasp ? np + 1 : np, 1); }
    else { const int n = (r - TL) & (CTXL - 1); hasm = n > 0; hasp = n < CTXL - 1; rm = hasm ? r - 1 : r; rp = hasp ? r + 1 : r; }
    const bf16* s0 = S + (size_t)rm * EV_PAD + 3072; const bf16* s1 = S + (size_t)r * EV_PAD + 3072; const bf16* s2 = S + (size_t)rp * EV_PAD + 3072;
#pragma unroll
    for (int i = 0; i < 4; ++i) { const int c = 8 * lane + 512 * i;
        const v4u a0 = *(const v4u*)(s0 + c), a1 = *(const v4u*)(s1 + c), a2 = *(const v4u*)(s2 + c);
        const unsigned w0[4] = {a0.x, a0.y, a0.z, a0.w}, w1[4] = {a1.x, a1.y, a1.z, a1.w}, w2[4] = {a2.x, a2.y, a2.z, a2.w};
        const float sc = c >= 1024 ? 0.0625f : 1.0f;
        float t0[8], t1[8], t2[8], tb[8];
#pragma unroll
        for (int q4 = 0; q4 < 2; ++q4) { const v4f x0 = *(LP(const v4f))(tab + c + 4 * q4), x1 = *(LP(const v4f))(tab + 2048 + c + 4 * q4), x2 = *(LP(const v4f))(tab + 4096 + c + 4 * q4), xb = *(LP(const v4f))(tab + 6144 + c + 4 * q4);
            t0[4 * q4] = x0.x; t0[4 * q4 + 1] = x0.y; t0[4 * q4 + 2] = x0.z; t0[4 * q4 + 3] = x0.w; t1[4 * q4] = x1.x; t1[4 * q4 + 1] = x1.y; t1[4 * q4 + 2] = x1.z; t1[4 * q4 + 3] = x1.w;
            t2[4 * q4] = x2.x; t2[4 * q4 + 1] = x2.y; t2[4 * q4 + 2] = x2.z; t2[4 * q4 + 3] = x2.w; tb[4 * q4] = xb.x; tb[4 * q4 + 1] = xb.y; tb[4 * q4 + 2] = xb.z; tb[4 * q4 + 3] = xb.w; }
        float val[8];
#pragma unroll
        for (int i2 = 0; i2 < 4; ++i2)
#pragma unroll
            for (int e = 0; e < 2; ++e) { const int di = 2 * i2 + e;
                const float um = hasm ? (e ? bfhi(w0[i2]) : bflo(w0[i2])) : 0.f, u0 = e ? bfhi(w1[i2]) : bflo(w1[i2]), up = hasp ? (e ? bfhi(w2[i2]) : bflo(w2[i2])) : 0.f;
                const float pre = tb[di] + t0[di] * um + t1[di] * u0 + t2[di] * up;
                val[di] = pre * RCPF(1.0f + EXPF(-pre)) * sc; }
        *(v4u*)(QK2 + (size_t)r * 2048 + c) = (v4u){PK2(val[0], val[1]), PK2(val[2], val[3]), PK2(val[4], val[5]), PK2(val[6], val[7])}; }
}

DEV v4f ld4bf(const bf16* p) { const v2u w = *(const v2u*)p; return (v4f){bflo(w.x), bfhi(w.x), bflo(w.y), bfhi(w.y)}; }
DEV float wsum(float v) {
#pragma unroll
    for (int o = 1; o < 64; o <<= 1) v += SHX(v, o);
    return v;
}
DEV float grp16_sum(float v) { v += SHX(v, 1); v += SHX(v, 2); v += SHX(v, 4); v += SHX(v, 8); return v; }
DEV void ld16bf(const bf16* p, float (&o)[16]) { const v4u a = *(const v4u*)p, b = *(const v4u*)(p + 8); const unsigned w[8] = {a.x, a.y, a.z, a.w, b.x, b.y, b.z, b.w};
#pragma unroll
    for (int i = 0; i < 8; ++i) { o[2 * i] = bflo(w[i]); o[2 * i + 1] = bfhi(w[i]); } }
DEV void ld16f(const float* p, float (&o)[16]) {
#pragma unroll
    for (int i = 0; i < 4; ++i) { const v4f a = *(const v4f*)(p + 4 * i); o[4 * i] = a.x; o[4 * i + 1] = a.y; o[4 * i + 2] = a.z; o[4 * i + 3] = a.w; } }
DEV void st16bf(bf16* p, const float (&o)[16]) { *(v4u*)p = (v4u){PK2(o[0], o[1]), PK2(o[2], o[3]), PK2(o[4], o[5]), PK2(o[6], o[7])}; *(v4u*)(p + 8) = (v4u){PK2(o[8], o[9]), PK2(o[10], o[11]), PK2(o[12], o[13]), PK2(o[14], o[15])}; }
template <int CENTER, int GATE>
DEV void head_norm16(const bf16* o0, const bf16* o1, const float* gain, const bf16* gs, bf16* dst) {
    float a[16], b2[16], g[16], gt[16];
    ld16bf(o0, a); ld16bf(o1, b2); ld16f(gain, g); ld16bf(gs, gt);
    float s = 0.f;
#pragma unroll
    for (int i = 0; i < 16; ++i) { a[i] += b2[i]; s += a[i]; }
    if (CENTER) { const float mean = grp16_sum(s) * (1.0f / 256.0f);
#pragma unroll
        for (int i = 0; i < 16; ++i) a[i] -= mean; }
    float q = 0.f;
#pragma unroll
    for (int i = 0; i < 16; ++i) q += a[i] * a[i];
    const float rstd = RSQRTF(grp16_sum(q) * (1.0f / 256.0f) + EPS);
#pragma unroll
    for (int i = 0; i < 16; ++i) { const float sg = RCPF(1.0f + EXPF(-gt[i])); const float gate = GATE ? sg : gt[i] * sg; a[i] = gate * (a[i] * rstd * g[i]); }
    st16bf(dst, a);
}
DEV void merge_even_row(int r, const bf16* S, const bf16* O, const float* gla_norm, const float* ml_norm, bf16* HBo, int lane) {
    const bf16* sr = S + (size_t)r * EV_PAD; const int c = 16 * lane; const bf16* ob = O + (size_t)r * 1024 + c; const size_t os = (size_t)TT * 1024;
    head_norm16<0, 0>(ob, ob + os, gla_norm + c, sr + 2048 + c, HBo + (size_t)r * D + c);
    head_norm16<1, 1>(ob + 2 * os, ob + 3 * os, ml_norm + c, sr + 6144 + c, HBo + (size_t)r * D + 1024 + c);
}
DEV float gelu_tanh(float y) { const float z = 0.7978845608028654f * (y + 0.044715f * y * y * y); const float t = 1.0f - 2.0f * RCPF(1.0f + EXPF(2.0f * z)); return 0.5f * y * (1.0f + t); }
DEV void merge_odd_row(int r, const bf16* S, const bf16* O, const float* s5_d, const float* ret_norm, bf16* GBo, bf16* HBo, int lane) {
    const bf16* sr = S + (size_t)r * OD_COLS; const int c = 16 * lane; const bf16* ob = O + (size_t)r * 1024 + c; const size_t os = (size_t)TT * 1024;
    {
        float y0[16], y1[16], dd[16], u[16];
        ld16bf(ob, y0); ld16bf(ob + os, y1); ld16f(s5_d + c, dd); ld16bf(sr + c, u);
#pragma unroll
        for (int i = 0; i < 16; ++i) {
#ifdef NO_S5
            y0[i] = 0.f; y1[i] = 0.f;
#endif
            y0[i] = gelu_tanh(y0[i] + y1[i] + dd[i] * u[i]); }
        st16bf(GBo + (size_t)r * 1024 + c, y0);
    }
    head_norm16<1, 0>(ob + 2 * os, ob + 3 * os, ret_norm + c, sr + 4096 + c, HBo + (size_t)r * D + 1024 + c);
}

struct EpiGLU {
    static constexpr bool PERM = true, AFTER_DRAIN = false;
    const bf16* G; const float* bias; bf16* O;
    __device__ __forceinline__ void operator()(const pg8::f32x4 (&acc)[2][2][4][2], const pg8::Unit& u, int wr, int wc, int fr, int fq) const {
        const int row0 = u.pm * 256 + wr * 64 + fr, col0 = u.pn * 256 + wc * 32 + 8 * fq;
#pragma unroll
        for (int ai = 0; ai < 2; ++ai)
#pragma unroll
            for (int m = 0; m < 4; ++m) { const size_t row = (size_t)(row0 + ai * 128 + m * 16);
#pragma unroll
                for (int bj = 0; bj < 2; ++bj) { const int col = col0 + bj * 128;
                    const v4u gw = *(const v4u*)(G + row * 1024 + col); const pg8::f32x4 b0 = *(const pg8::f32x4*)(bias + col), b1 = *(const pg8::f32x4*)(bias + col + 4);
                    const pg8::f32x4 v0 = acc[ai][bj][m][0] + b0, v1 = acc[ai][bj][m][1] + b1;
                    v4u w; w.x = pk2(bflo(gw.x) * fast_sigmoid(v0[0]), bfhi(gw.x) * fast_sigmoid(v0[1])); w.y = pk2(bflo(gw.y) * fast_sigmoid(v0[2]), bfhi(gw.y) * fast_sigmoid(v0[3]));
                    w.z = pk2(bflo(gw.z) * fast_sigmoid(v1[0]), bfhi(gw.z) * fast_sigmoid(v1[1])); w.w = pk2(bflo(gw.w) * fast_sigmoid(v1[2]), bfhi(gw.w) * fast_sigmoid(v1[3]));
                    *(v4u*)(O + row * D + col) = w; } }
    }
};

#ifndef SCAN_REPS
#define SCAN_REPS 1
#endif
__device__ __forceinline__ void mixer_phases(const Args& a, unsigned char* ws, LAS unsigned char* lds, const XcdBarrier& bar, int layer, int G, int gw, int ngw, int tid, int lane, int wave) {
#define HB ((bf16*)wsp(ws, WS_HB))
#define S ((bf16*)wsp(ws, WS_S))
#define GT ((float*)wsp(ws, WS_GT))
#define O ((bf16*)wsp(ws, WS_O))
#define GB ((bf16*)wsp(ws, WS_GB))
#define Y ((bf16*)wsp(ws, WS_Y))
    const int ldS = layer == 0 ? EV_PAD : OD_COLS;
    { pg8::Gemm g{HB, (const bf16*)(wsp(ws, (layer == 0 ? WS_WIN_EV : WS_WIN_OD))), TT, ldS, D}; pg8::StaticOrder So; So.init(TT, ldS, G, (int)blockIdx.x);
      EpiS E{S, ldS, GT, layer == 0 ? 28 : -1};
      pg8::gemm_phase<EpiS, pg8::StaticOrder, true, true>(lds, g, So, E); }
    XBAR();
#define QK2 ((bf16*)wsp(ws, WS_QK2))
#define GP ((float*)wsp(ws, WS_GP))
#define QKS ((bf16*)wsp(ws, WS_QKS))
#define GPK ((float*)wsp(ws, WS_GPK))
#define PP ((bf16*)wsp(ws, WS_PP))
#define RS ((float*)wsp(ws, WS_RS))
#define VEC ((float*)wsp(ws, WS_VEC))
    { int t2 = threadIdx.x; asm volatile("" : "+v"(t2)); tid = t2; lane = t2 & 63; wave = __builtin_amdgcn_readfirstlane(t2 >> 6); gw = blockIdx.x * NWAVES + wave; }
    if (layer == 0) {
#ifndef REP_CONV
#define REP_CONV 1
#endif
#ifndef REP_GPREP
#define REP_GPREP 1
#endif
#pragma unroll 1
        for (int r_ = 0; r_ < REP_CONV; ++r_)
        { const bf16* s_ = S; bf16* qk_ = QK2; const float* cw_ = ARG(16); const float* cb_ = ARG(17);
          LAS float* ctab = (LAS float*)(lds + 65536);
          if (r_ == 0) { for (int i = tid; i < 8192; i += NTHR) ctab[i] = i < 6144 ? cw_[i] : cb_[i - 6144]; __syncthreads(); }
          for (int r = gw; r < TT; r += ngw) conv_prep_row_lds(r, s_, qk_, ctab, lane); }
#pragma unroll 1
        for (int r_ = 0; r_ < REP_GPREP; ++r_)
        { int t2 = threadIdx.x; asm volatile("" : "+v"(t2)); gla_prep_loop((int)blockIdx.x, G, S, GT, ARG(13), ARG(14), QKS, VEC, lds, t2); }
        XBAR();
        { int t2 = threadIdx.x; asm volatile("" : "+v"(t2)); mat_prep_loop<0>((int)blockIdx.x, G, QK2, 2048, 0, 1024, 1.0f, GT, ARG(18), GP, GPK, nullptr, PP, RS, lds, t2); }
        XBAR();
    } else {
        { int t2 = threadIdx.x; asm volatile("" : "+v"(t2)); mat_prep_loop<1>((int)blockIdx.x, G, S, OD_COLS, 1024, 2048, 0.0625f, nullptr, nullptr, nullptr, nullptr, ARG(32), PP, RS, lds, t2); }
        XBAR();
    }
#ifdef PRE_SLEEP
    { const unsigned long long t0_ = __builtin_amdgcn_s_memrealtime(); while (__builtin_amdgcn_s_memrealtime() - t0_ < (unsigned long long)(PRE_SLEEP) * 100ull) __builtin_amdgcn_s_sleep(16); XBAR(); }
#endif
    { int t2 = threadIdx.x; asm volatile("" : "+v"(t2)); tid = t2; lane = t2 & 63; wave = __builtin_amdgcn_readfirstlane(t2 >> 6); }
#ifdef PREREAD
    if (layer == 0) {
        const v4u* p0 = (const v4u*)QKS; const v4u* p1 = (const v4u*)QK2; v4u acc = (v4u){0u, 0u, 0u, 0u};
        const unsigned n0 = 2u * TT * 1024 / 8, n1 = (unsigned)TT * 2048 / 8;
        for (unsigned i = blockIdx.x * NTHR + tid; i < n0; i += (unsigned)G * NTHR) { const v4u v = p0[i]; acc.x ^= v.x; acc.y ^= v.y; acc.z ^= v.z; acc.w ^= v.w; }
        if (PREREAD >= 2) for (unsigned i = blockIdx.x * NTHR + tid; i < n1; i += (unsigned)G * NTHR) { const v4u v = p1[i]; acc.x ^= v.x; acc.y ^= v.y; acc.z ^= v.z; acc.w ^= v.w; }
        if ((acc.x ^ acc.y ^ acc.z ^ acc.w) == 0x9e3779b9u && tid == 511) ((unsigned*)wsp(ws, WS_CTL))[8000] = 1u;
        { int t2 = threadIdx.x; asm volatile("" : "+v"(t2)); tid = t2; lane = t2 & 63; wave = __builtin_amdgcn_readfirstlane(t2 >> 6); }
    }
#endif
#ifdef SCAN_PROBE
#pragma unroll
#else
#pragma unroll 1
#endif
    for (int rep = 0; rep < SCAN_REPS; ++rep) {
#ifdef SCAN_PROBE
    const int prb = rep < SCAN_REPS - 1 ? SCAN_PROBE : 0;
#else
    constexpr int prb = 0;
#endif
#ifndef SIB_LOCKSTEP
#define SIB_LOCKSTEP 0
#endif
#define SIBP(ty, un) ((SIB_LOCKSTEP && G >= 2 * MIX_UNITS && SCAN_REPS == 1) ? (unsigned*)(wsp(ws, WS_CTL) + 16384 + ((ty) * 32 + ((un) >> 2)) * 64) : (unsigned*)nullptr)
#define UNIT_OF(w) (NB == 4 ? (((((w) & 7) * 4 + (((w) >> 3) & 15) / 4) << 2) | ((((w) >> 3) & 15) & 3)) : (w))
    if (layer == 0) {
#ifdef SPLIT_L0
        for (int it = blockIdx.x; it < MIX_UNITS; it += G) gla_unit(S, QKS, VEC, O, UNIT_OF(it), lds, tid, SIBP(0, UNIT_OF(it)), prb);
        XBAR();
        for (int it = blockIdx.x; it < 2 * MIX_UNITS; it += G) if (it >= MIX_UNITS) mat_unit<0>(QK2, 2048, 0, 1024, S, EV_PAD, 5120, 1.0f, GP, GPK, PP, RS, O, 1, nullptr, UNIT_OF(it - MIX_UNITS), lds, tid, SIBP(1, UNIT_OF(it - MIX_UNITS)), prb);
        if (false)
#endif
        for (int it = blockIdx.x; it < 2 * MIX_UNITS; it += G) {
            if (it < MIX_UNITS) {
#ifndef REP_GLA
#define REP_GLA 1
#endif
#pragma unroll 1
                for (int r_ = 0; r_ < REP_GLA; ++r_) gla_unit(S, QKS, VEC, O, UNIT_OF(it), lds, tid, SIBP(0, UNIT_OF(it)), prb);
                if (DEFER == 1 && G >= 2 * MIX_UNITS) convert_tiles(a, ws, 1, (int)blockIdx.x * NWAVES + wave, MIX_UNITS * NWAVES, lane);
            } else {
#ifndef REP_ML
#define REP_ML 1
#endif
#pragma unroll 1
                for (int r_ = 0; r_ < REP_ML; ++r_) mat_unit<0>(QK2, 2048, 0, 1024, S, EV_PAD, 5120, 1.0f, GP, GPK, PP, RS, O, 1, nullptr, UNIT_OF(it - MIX_UNITS), lds, tid, SIBP(1, UNIT_OF(it - MIX_UNITS)), prb);
            }
        }
        if (DEFER == 1 && G < 2 * MIX_UNITS) convert_tiles(a, ws, 1, (int)blockIdx.x * NWAVES + wave, G * NWAVES, lane);
    } else {
        const int s5_first = G >= 2 * MIX_UNITS ? MIX_UNITS : 0, s5_wgs = G - s5_first;
#ifndef REP_RET
#define REP_RET 1
#endif
#ifndef REP_S5
#define REP_S5 1
#endif
#pragma unroll 1
        for (int r_ = 0; r_ < REP_RET; ++r_)
        for (int u = blockIdx.x; u < MIX_UNITS; u += G)
            mat_unit<1>(S, OD_COLS, 1024, 2048, S, OD_COLS, 3072, 0.0625f, nullptr, nullptr, PP, RS, O, 0, ARG(32), UNIT_OF(u), lds, tid, SIBP(2, UNIT_OF(u)), prb);
        if (DEFER == 1 && rep == 0 && (int)blockIdx.x >= s5_first && wave >= 4) convert_tiles(a, ws, 2, ((int)blockIdx.x - s5_first) * 4 + (wave - 4), 4 * s5_wgs, lane);
#pragma unroll 1
        for (int r_ = 0; r_ < REP_S5; ++r_)
        if ((int)blockIdx.x >= s5_first && wave < 4) { for (int su = ((int)blockIdx.x - s5_first) * 4 + wave; su < NB * 128; su += 4 * s5_wgs)
            s5_unit(S, OD_COLS, O, ARG(22), ARG(23), ARG(24), ARG(25), ARG(26), ARG(27), ARG(28), su, lds + wave * S5_LDS_PER_WAVE, lane, prb); }
    }
    }
    XBAR();
    { int t2 = threadIdx.x; asm volatile("" : "+v"(t2)); tid = t2; lane = t2 & 63; wave = __builtin_amdgcn_readfirstlane(t2 >> 6); gw = blockIdx.x * NWAVES + wave; }
#ifndef NO_MERGE
    if (layer == 0) { const bf16* s_ = S; const bf16* o_ = O; const float* n0 = ARG(15); const float* n1 = ARG(19); bf16* hb_ = HB; for (int r = gw; r < TT; r += ngw) merge_even_row(r, s_, o_, n0, n1, hb_, lane); }
    else { const bf16* s_ = S; const bf16* o_ = O; const float* n0 = ARG(29); const float* n1 = ARG(33); bf16* gb_ = GB; bf16* hb_ = HB; for (int r = gw; r < TL; r += ngw) merge_odd_row(r, s_, o_, n0, n1, gb_, hb_, lane); }
#endif
    XBAR();
    const int Mo = layer == 0 ? TT : TL;
    if (layer == 1) {
        pg8::Gemm g{GB, (const bf16*)(wsp(ws, WS_WGLU)), TL, 1024, 1024}; pg8::StaticOrder So; So.init(TL, 1024, G, (int)blockIdx.x);
        EpiGLU E{GB, ARG(31), HB};
        pg8::gemm_phase<EpiGLU, pg8::StaticOrder, true, true>(lds, g, So, E);
        XBAR();
    }
    { pg8::Gemm g{HB, (const bf16*)(wsp(ws, (layer == 0 ? WS_WOUT_EV : WS_WOUT_OD))), Mo, D, D}; pg8::SplitOrder So; So.init(Mo - TL, D, G, (int)blockIdx.x);
      EpiF32 E{Y, (float*)(wsp(ws, WS_YCP))};
      pg8::gemm_phase<EpiF32, pg8::SplitOrder, true, true>(lds, g, So, E); }
    XBAR();
}
#undef HB
#undef S
#undef GT
#undef O
#undef GB
#undef Y
#undef QK2
#undef GP
#undef QKS
#undef GPK
#undef PP
#undef RS
#undef VEC
#undef UNIT_OF
#undef SIBP

#ifndef MIXER_ON
#define MIXER_ON 1
#endif
__global__ void __launch_bounds__(NTHR, 2) fwd(Args a) {
    extern __shared__ __attribute__((aligned(16))) unsigned char lds_raw[];
    LAS unsigned char* lds = (LAS unsigned char*)lds_raw;
    const int tid = threadIdx.x, lane = tid & 63, wave = __builtin_amdgcn_readfirstlane(tid >> 6);
    const int G = gridDim.x, gw = blockIdx.x * NWAVES + wave, ngw = G * NWAVES;
    unsigned char* ws = a.ws;
    if (tid < 16) ((LAS unsigned*)(lds + MISC_OFF))[tid] = 0u;
    __syncthreads();
#ifdef PROBE_A
    if (blockIdx.x == 0 && tid == 0) { volatile LAS unsigned* M_ = (volatile LAS unsigned*)(lds + MISC_OFF); const unsigned lo_ = (unsigned)__builtin_amdgcn_s_memrealtime(); if (PROBE_A == 0) M_[6] = lo_; if (PROBE_B == 0) M_[8] = lo_; }
#endif
    XcdBarrier bar = xcd_barrier_post((unsigned*)(wsp(ws, WS_CTL)), (volatile LAS unsigned*)(lds + MISC_OFF));

#ifdef NAN_POISON
    {
        v4u q = (v4u){0xffffffffu, 0xffffffffu, 0xffffffffu, 0xffffffffu};
        for (int i = tid; i < (MISC_OFF) / 16; i += NTHR) ((LAS v4u*)lds)[i] = q;
        { v4u* p = (v4u*)(wsp(ws, WS_MOD)); const size_t n = (WS_WGU - WS_MOD) / 16; for (size_t i = (size_t)blockIdx.x * NTHR + tid; i < n; i += (size_t)G * NTHR) p[i] = q; }
        { v4u* p = (v4u*)(wsp(ws, WS_XC)); const size_t n = (WS_END - WS_XC) / 16; for (size_t i = (size_t)blockIdx.x * NTHR + tid; i < n; i += (size_t)G * NTHR) p[i] = q; }
        { v4u* p = (v4u*)a.out; const size_t n = (size_t)TL * D * 4 / 16; for (size_t i = (size_t)blockIdx.x * NTHR + tid; i < n; i += (size_t)G * NTHR) p[i] = q; }
        __syncthreads();
        XBAR();
    }
#endif
#define MOD ((float*)wsp(ws, WS_MOD))
#define MODP ((float*)wsp(ws, WS_MODP))
#define HB ((bf16*)wsp(ws, WS_HB))
#define HID ((bf16*)wsp(ws, WS_HID))
#define Y ((bf16*)wsp(ws, WS_Y))
#define XC ((bf16*)wsp(ws, WS_XC))
#define XL ((bf16*)wsp(ws, WS_XL))

#ifndef REP_PRO
#define REP_PRO 1
#endif
#ifndef REP_GU
#define REP_GU 1
#endif
#ifndef REP_DN
#define REP_DN 1
#endif
#pragma unroll 1
    for (int rep_ = 0; rep_ < REP_PRO; ++rep_) {
        __syncthreads();
        LAS float* stab = (LAS float*)(lds + 1024);
        { const float* cin = ARG(1); const float* cctx = ARG(3);
        for (int i = tid; i < 5 * D; i += NTHR) { const int r = i >> 11, k = i & (D - 1); const float c = r < 4 ? cin[r * D + k] : cctx[k]; stab[i] = c / (1.0f + expf(-c)); } }
        __syncthreads();
#define MOD_ITEM(it) do { \
            const int l = (it) / (MOD_KC * 72), rem = (it) % (MOD_KC * 72), kc = rem / 72, jb = rem % 72; constexpr int KCH = D / MOD_KC; \
            const float* W = ARG(4) + ((size_t)l * D + kc * KCH) * (NMOD * D) + jb * 256 + lane * 4; \
            f32x4 acc[5]; \
            _Pragma("unroll") for (int r = 0; r < 5; ++r) acc[r] = (f32x4){0.f, 0.f, 0.f, 0.f}; \
            for (int k = 0; k < KCH; k += 8) { f32x4 w[8]; \
                _Pragma("unroll") for (int i = 0; i < 8; ++i) w[i] = *(const f32x4*)(W + (size_t)(k + i) * (NMOD * D)); \
                _Pragma("unroll") for (int i = 0; i < 8; ++i) \
                    _Pragma("unroll") for (int r = 0; r < 5; ++r) acc[r] += stab[r * D + kc * KCH + k + i] * w[i]; } \
            { float* modp = MODP; \
            _Pragma("unroll") for (int r = 0; r < 5; ++r) *(f32x4*)(modp + (((size_t)l * MOD_KC + kc) * 5 + r) * (NMOD * D) + jb * 256 + lane * 4) = acc[r]; } } while (0)
#ifndef DEFER
#define DEFER 1
#endif
#if DEFER == 2
        {
            LAS unsigned* tick = (LAS unsigned*)(lds + MISC_OFF) + 12;
            constexpr int MOD_ITEMS = 2 * MOD_KC * 72, NPAIRS = NT_SET0_D2 / 2;
            const int mod_tk = (MOD_ITEMS + G - 1) / G;
#pragma unroll 1
            for (;;) {
                unsigned tk0 = 0u; if (lane == 0) tk0 = __hip_atomic_fetch_add(tick, 1u, __ATOMIC_RELAXED, __HIP_MEMORY_SCOPE_WORKGROUP);
                const int tk = __builtin_amdgcn_readfirstlane((int)tk0);
                if (tk < mod_tk) { const int it = tk * G + (int)blockIdx.x; if (it < MOD_ITEMS) MOD_ITEM(it); }
                else { const int p = (tk - mod_tk) * G + (int)blockIdx.x; if (p >= NPAIRS) break; convert_pair_set0(a, ws, 2 * p, lane); }
            }
        }
#else
        for (int it = gw; it < 2 * MOD_KC * 72; it += ngw) MOD_ITEM(it);
        convert_tiles(a, ws, 0, gw, ngw, lane);
        if (!DEFER) { convert_tiles(a, ws, 1, gw, ngw, lane); convert_tiles(a, ws, 2, gw, ngw, lane); }
#endif
#undef MOD_ITEM
        { v4u z = (v4u){0u, 0u, 0u, 0u}; v4u* p = (v4u*)(wsp(ws, WS_WIN_EV) + (size_t)EV_COLS * 2048 * 2); const int n16 = (EV_PAD - EV_COLS) * 2048 * 2 / 16;
          for (int i = blockIdx.x * NTHR + tid; i < n16; i += G * NTHR) p[i] = z; }
    }
    XBAR();
    { const float* bmod = ARG(5); const float* modp = MODP; float* modf = MOD;
    for (int i = blockIdx.x * NTHR + tid; i < 2 * 5 * NMOD * D; i += G * NTHR) {
        const int l = i / (5 * NMOD * D), rem = i % (5 * NMOD * D), r = rem / (NMOD * D), j = rem % (NMOD * D);
        float s = bmod[l * (NMOD * D) + j];
        for (int kc = 0; kc < MOD_KC; ++kc) s += modp[(((size_t)l * MOD_KC + kc) * 5 + r) * (NMOD * D) + j];
        modf[i] = s;
    } }
    XBAR();
#ifndef REP_N0
#define REP_N0 1
#endif
#pragma unroll 1
    for (int rep_ = 0; rep_ < REP_N0; ++rep_)
    { NormP p{}; p.xin_lat = ARG(0); p.xin_ctx = ARG(2); p.xin_f32 = 1; p.xout_f32 = 0; p.xout_lat = XL; p.xout_ctx = XC; p.y = nullptr; p.h = HB; p.rows_end = TT; p.has_y = 0; p.has_h = 1; p.w = 0.f; p.lp = 0; p.sp = 0; p.ln = 0; p.sn = 0;
      norm_phase(p, MOD, ARG(6), ARG(7), lds, gw, ngw, tid, lane); }
    XBAR();

#pragma unroll 1
    for (int layer = 0; layer < 2; ++layer) {
#pragma unroll 1
        for (int half = 0; half < 2; ++half) {
            const int Mrows = (layer == 1 && half == 1) ? TL : TT;
#if MIXER_ON
            if (half == 1) {
                mixer_phases(a, ws, lds, bar, layer, G, gw, ngw, tid, lane, wave);
                NormP p{}; p.xin_lat = XL; p.xin_ctx = XC; p.xin_f32 = 0; p.xout_f32 = 0; p.xout_lat = XL; p.xout_ctx = XC; p.y = Y; p.y_ctx = (const float*)(wsp(ws, WS_YCP)); p.h = HB; p.rows_end = Mrows; p.has_y = 1; p.has_h = 1; p.w = 1.0f; p.lp = layer; p.sp = 1; p.ln = layer; p.sn = 2;
                norm_phase(p, MOD, ARG(6), ARG(7), lds, gw, ngw, tid, lane);
                XBAR();
            }
#endif
            const int sub = half * 2;
#pragma unroll 1
            for (int rep_ = 0; rep_ < REP_GU; ++rep_) { pg8::Gemm g{HB, (const bf16*)(wsp(ws, WS_WGU) + (size_t)(layer * 2 + half) * SZ_WGU), Mrows, 2 * DFF, D}; pg8::StaticOrder S; S.init(Mrows, 2 * DFF, G, (int)blockIdx.x);
              EpiSwiGLU E{HID, DFF};
              pg8::gemm_phase<EpiSwiGLU, pg8::StaticOrder, true, true>(lds, g, S, E);
              if (DEFER == 2 && rep_ == 0 && !(layer == 1 && half == 1)) {
                  const int rem = ((Mrows / 256) * (2 * DFF / 256)) % G, nidle = rem ? G - rem : G, me = rem ? (int)blockIdx.x - rem : (int)blockIdx.x;
                  if (me >= 0) { int t2 = threadIdx.x; asm volatile("" : "+v"(t2)); convert_tiles(a, ws, layer * 2 + half + 1, me * NWAVES + __builtin_amdgcn_readfirstlane(t2 >> 6), nidle * NWAVES, t2 & 63); } }
              if (rep_ + 1 < REP_GU) XBAR(); }
            XBAR();
#pragma unroll 1
            for (int rep_ = 0; rep_ < REP_DN; ++rep_) { pg8::Gemm g{HID, (const bf16*)(wsp(ws, WS_WD) + (size_t)(layer * 2 + half) * SZ_WD), Mrows, D, DFF}; pg8::SplitOrder S; S.init(Mrows - TL, DFF, G, (int)blockIdx.x);
              EpiF32 E{Y, (float*)(wsp(ws, WS_YCP))};
              pg8::gemm_phase<EpiF32, pg8::SplitOrder, true, true>(lds, g, S, E);
              if (rep_ + 1 < REP_DN) XBAR(); }
            XBAR();
            { NormP p{}; const bool first = (layer == 0 && half == 0);
              const bool lastp = (layer == 1 && half == 1);
              p.xin_lat = first ? (const void*)ARG(0) : (const void*)XL; p.xin_ctx = first ? (const void*)ARG(2) : (const void*)XC; p.xin_f32 = first ? 1 : 0;
              p.xout_lat = lastp ? (void*)a.out : (void*)XL; p.xout_ctx = XC; p.xout_f32 = lastp ? 1 : 0; p.y = Y; p.y_ctx = (const float*)(wsp(ws, WS_YCP)); p.h = HB; p.rows_end = Mrows; p.has_y = 1; p.w = 0.5f; p.lp = layer; p.sp = sub;
              if (half == 0) { p.has_h = 1; p.ln = layer; p.sn = MIXER_ON ? 1 : 2; }
              else if (layer == 0) { p.has_h = 1; p.ln = 1; p.sn = 0; }
              else { p.has_h = 0; p.ln = 0; p.sn = 0; }
              norm_phase(p, MOD, ARG(6), ARG(7), lds, gw, ngw, tid, lane); }
            if (!(layer == 1 && half == 1)) XBAR();
        }
    }
#ifdef PROBE_A
    XBAR();
    if (blockIdx.x == 0 && threadIdx.x == 0) { volatile LAS unsigned* M_ = (volatile LAS unsigned*)(lds + MISC_OFF);
        const unsigned ticks = (M_[7] - M_[6]) + (PROBE_B >= 0 ? (M_[9] - M_[8]) : 0u);
        const unsigned long long t0 = __builtin_amdgcn_s_memrealtime();
        while (__builtin_amdgcn_s_memrealtime() - t0 < 8ull * ticks) __builtin_amdgcn_s_sleep(8); }
#endif
}

#undef MOD
#undef MODP
#undef HB
#undef HID
#undef Y
#undef XC
#undef XL
extern "C" void kernel_launch(void* const* d_in, const int* in_sizes, int n_in, void* d_out, int out_size, void* d_ws, size_t ws_size, hipStream_t stream) {
    static int grid = 0;
    if (grid == 0) {
        if (n_in != 34 || out_size != TL * D || ws_size < WS_END) { fprintf(stderr, "kernel_launch: unexpected shapes (n_in %d out %d ws %zu need %zu)\n", n_in, out_size, ws_size, (size_t)WS_END); grid = -1; return; }
        int dev = 0, cus = 0, per_cu = 0;
        if (hipGetDevice(&dev) != hipSuccess || hipDeviceGetAttribute(&cus, hipDeviceAttributeMultiprocessorCount, dev) != hipSuccess) { grid = -1; return; }
        if (hipFuncSetAttribute((const void*)fwd, hipFuncAttributeMaxDynamicSharedMemorySize, LDS_BYTES) != hipSuccess) { fprintf(stderr, "kernel_launch: hipFuncSetAttribute failed\n"); grid = -1; return; }
        if (hipOccupancyMaxActiveBlocksPerMultiprocessor(&per_cu, (const void*)fwd, NTHR, LDS_BYTES) != hipSuccess || per_cu < 1) { fprintf(stderr, "kernel_launch: occupancy query says %d\n", per_cu); }
        (void)hipGetLastError();
        grid = cus;
    }
    if (grid < 0) return;
    if (hipMemsetAsync((char*)d_ws + WS_CTL, 0, CTL_ZERO_BYTES, stream) != hipSuccess) return;
    Args a{};
    for (int i = 0; i < 34; ++i) a.in[i] = (const float*)d_in[i];
    a.out = (float*)d_out; a.ws = (unsigned char*)d_ws;
    hipLaunchKernelGGL(fwd, dim3(grid), dim3(NTHR), LDS_BYTES, stream, a);
}
```

```cpp
#include <hip/hip_runtime.h>
#include <cstdio>
#include <cstdint>
#define MIXER_ON 1

#define XB_TMO      128
#define XB_XCNT(j)  (256  + 64 * (j))
#define XB_XSUB(j)  (1280 + 64 * (j))
#define XB_XGEN(j)  (2304 + 64 * (j))
#define XB_TOP      3328
#define XB_TOPGEN   3392
#define XCD_BAR_WORDS 3456
#define XB_SPIN_CAP (1u << 18)
#define LAS __attribute__((address_space(3)))

__device__ __forceinline__ unsigned xb_ld(unsigned* p)              { return __hip_atomic_load(p, __ATOMIC_RELAXED, __HIP_MEMORY_SCOPE_AGENT); }
__device__ __forceinline__ unsigned xb_add(unsigned* p, unsigned v) { return __hip_atomic_fetch_add(p, v, __ATOMIC_RELAXED, __HIP_MEMORY_SCOPE_AGENT); }
__device__ __forceinline__ unsigned xb_xcc_id() { return (unsigned)__builtin_amdgcn_s_getreg((3 << 11) | 20) & 0xFu; }
#define XB_SPIN(cond, bar) do { unsigned _sp = 0; while (cond) { __builtin_amdgcn_s_sleep(1); \
    if ((++_sp & 255u) == 0u) { if (xb_ld(&(bar)[XB_TMO])) break; if (_sp > XB_SPIN_CAP) { atomicAdd(&(bar)[XB_TMO], 1u); break; } } } } while (0)

struct XcdBarrier {
    unsigned* bar; unsigned x;
    volatile LAS unsigned* st;
};

__device__ __forceinline__ XcdBarrier xcd_barrier_post(unsigned* bar, volatile LAS unsigned* st) {
    XcdBarrier b; b.bar = bar; b.x = xb_xcc_id(); b.st = st;
    if (threadIdx.x == 0) (void)xb_add(&bar[XB_XCNT(b.x)], 1u);
    return b;
}
__device__ __forceinline__ void xcd_barrier_complete(unsigned* bar, unsigned x, unsigned& nloc, unsigned& nx) {
    const unsigned G = gridDim.x * gridDim.y * gridDim.z;
    unsigned sum, cnt, mine, sp = 0u;
    for (;;) {
        sum = 0u; cnt = 0u; mine = 0u;
#pragma unroll
        for (unsigned j = 0; j < 16; ++j) { const unsigned c = xb_ld(&bar[XB_XCNT(j)]); sum += c; cnt += (c > 0u) ? 1u : 0u; mine = (j == x) ? c : mine; }
        if (sum == G) break;
        __builtin_amdgcn_s_sleep(1);
        if ((++sp & 255u) == 0u) { if (xb_ld(&bar[XB_TMO])) break; if (sp > XB_SPIN_CAP) { atomicAdd(&bar[XB_TMO], 1u); break; } }
    }
    nloc = mine > 0u ? mine : 1u; nx = cnt > 0u ? cnt : 1u;
}

__device__ __forceinline__ void xcd_barrier(const XcdBarrier& b) {
    asm volatile("s_waitcnt vmcnt(0)" ::: "memory");
    __syncthreads();
    if (threadIdx.x == 0) {
        unsigned* bar = b.bar;
        unsigned bx = __builtin_amdgcn_readfirstlane(b.x); asm volatile("" : "+s"(bx));
        __builtin_amdgcn_s_waitcnt(0);
        unsigned nloc = b.st[0], nx = b.st[1];
        if (nloc == 0u) { xcd_barrier_complete(bar, bx, nloc, nx); b.st[0] = nloc; b.st[1] = nx; }
        const unsigned old = xb_add(&bar[XB_XSUB(bx)], 1u);
        const unsigned gen = old / nloc;
        if (old + 1u == (gen + 1u) * nloc) {
            __builtin_amdgcn_fence(__ATOMIC_RELEASE, "agent");
            asm volatile("s_waitcnt vmcnt(0)" ::: "memory");
            const unsigned og = xb_add(&bar[XB_TOP], 1u);
            const unsigned tg = og / nx;
            if (og + 1u == (tg + 1u) * nx) xb_add(&bar[XB_TOPGEN], 1u);
            else XB_SPIN(xb_ld(&bar[XB_TOPGEN]) == tg, bar);
            __builtin_amdgcn_fence(__ATOMIC_ACQUIRE, "agent");
            xb_add(&bar[XB_XGEN(bx)], 1u);
            asm volatile("s_waitcnt vmcnt(0)" ::: "memory");
        } else {
            XB_SPIN(xb_ld(&bar[XB_XGEN(bx)]) == gen, bar);
            __builtin_amdgcn_fence(__ATOMIC_ACQUIRE, "agent");
            asm volatile("s_waitcnt vmcnt(0)" ::: "memory");
        }
    }
    __syncthreads();
}

namespace pg8 {
#define PG8_LAS __attribute__((address_space(3)))
typedef unsigned short bf16_t;
typedef short bf16x8 __attribute__((ext_vector_type(8)));
typedef float f32x4 __attribute__((ext_vector_type(4)));
typedef unsigned u32x4 __attribute__((ext_vector_type(4)));
constexpr int BM = 256, BK = 64, HALF = 128, HTB = HALF * BK * 2  , STAGE_BYTES = 8 * HTB, NXCD = 8, WGM = 8;

__host__ __device__ __forceinline__ int lds_byte(int r, int c) { const int st = (r >> 4) * 2 + (c >> 5), rr = r & 15, cc = c & 31, ob = rr * 64 + cc * 2; return st * 1024 + (ob ^ (((ob >> 9) & 1) << 5)); }
__host__ __device__ __forceinline__ void stage_rc(int b, int& R, int& C) { const int st = b / 1024, sb = b % 1024, swz = sb ^ (((sb >> 9) & 1) << 5); R = (st >> 1) * 16 + swz / 64; C = (st & 1) * 32 + (swz % 64) / 2; }
__host__ __device__ __forceinline__ int perm32(int rho) { const int n = rho >> 4, i = rho & 15; return 8 * (i >> 2) + 4 * n + (i & 3); }

struct Unit { int pm, pn, k0, nt, part; };
struct Gemm { const bf16_t* A; const bf16_t* Bt; int M, N, K; };

struct StaticOrder {
    int nM, nN, nwg, G, c;
    __host__ __device__ void init(int M, int N, int G_, int c_) { nM = M / BM; nN = N / BM; nwg = nM * nN; G = G_; c = c_; }
    __host__ __device__ bool next(int i, Unit& u) const {
        const long L = (long)i * G + c; if (L >= nwg) return false;
        int wgid = (int)L; { const int q = nwg / NXCD, r = nwg % NXCD, xcd = wgid % NXCD, off = wgid / NXCD; wgid = (xcd < r ? xcd * (q + 1) : r * (q + 1) + (xcd - r) * q) + off; }
        const int nig = WGM * nN, gid = wgid / nig, fm = gid * WGM, gsz = (nM - fm) < WGM ? (nM - fm) : WGM;
        u.pm = fm + ((wgid % nig) % gsz); u.pn = (wgid % nig) / gsz; u.k0 = 0; u.nt = 0; u.part = -1; return true;
    }
    __device__ __forceinline__ void a_ready(const Unit&) const {}
    __device__ __forceinline__ void done(const Unit&) const {}
};
struct SplitOrder {
    static constexpr int NMF = 64, NN = 8, PARTS = 8, NFULL = NMF * NN;
    int nsplit, ntK, G, c;
    __host__ __device__ void init(int Msplit, int K, int G_, int c_) { nsplit = (Msplit / BM) * NN * PARTS; ntK = K / BK; G = G_; c = c_; }
    __host__ __device__ bool next(int i, Unit& u) const {
        const int L = i * G + c, p = L - NFULL; const bool fullu = L < NFULL;
        const int wgid = (L % NXCD) * (NFULL / NXCD) + L / NXCD, nig = WGM * NN, fm = (wgid / nig) * WGM;
        const int q = p & 7, cu = p >> 3, h = ntK >> 1, ks = ((h * q) >> 3) << 1, ke = ((h * (q + 1)) >> 3) << 1;
        u.pm = fullu ? fm + ((wgid % nig) % WGM) : NMF + (cu >> 3);
        u.pn = fullu ? (wgid % nig) / WGM : (cu & 7);
        u.k0 = fullu ? 0 : ks; u.nt = fullu ? 0 : ke - ks; u.part = fullu ? -1 : q;
        return fullu || p < nsplit;
    }
    __device__ __forceinline__ void a_ready(const Unit&) const {}
    __device__ __forceinline__ void done(const Unit&) const {}
};
__device__ __forceinline__ unsigned cvt_pk_bf16(float lo, float hi) { unsigned r; asm volatile("v_cvt_pk_bf16_f32 %0, %1, %2" : "=v"(r) : "v"(lo), "v"(hi)); return r; }
template <class Epi, class Sched, bool ALIGN_EPI = false, bool SP2 = false>
__device__ __forceinline__ void gemm_phase(PG8_LAS unsigned char* lds, const Gemm g, const Sched& S, const Epi& E) {
    int tid_ = threadIdx.x; asm volatile("" : "+v"(tid_));
    const int tid = tid_, wid = __builtin_amdgcn_readfirstlane(tid >> 6), lane = tid & 63, wr = wid >> 2, wc = wid & 3, fr = lane & 15, fq = lane >> 4;
    const int K = g.K, nt = K / BK;
    unsigned voffA[2], voffB[2];
#pragma unroll
    for (int i = 0; i < 2; ++i) { int R, C; stage_rc(tid * 16 + i * 8192, R, C); const int Rb = Epi::PERM ? ((R & ~31) + perm32(R & 31)) : R;
        voffA[i] = (unsigned)(R * K + C) * 2u; voffB[i] = (unsigned)(Rb * K + C) * 2u; }
    const unsigned kstep = BK * 2;
    const unsigned hstep = (unsigned)HALF * K * 2;
    const unsigned tstep = 2 * hstep;
    const unsigned ldsw = (unsigned)wid * 1024u;
    const int aoff = lds_byte(wr * 64 + fr, fq * 8), boff = lds_byte(wc * 32 + fr, fq * 8);
#define PG8_SA(b, h) (((b) * 2 + (h)) * HTB)
#define PG8_SB(b, h) ((4 + (b) * 2 + (h)) * HTB)
#define PG8_STAGE(bufoff, gbase, voff) do { _Pragma("unroll") for (int _i = 0; _i < 2; ++_i) \
        __builtin_amdgcn_global_load_lds((const unsigned*)((const char*)(gbase) + (voff)[_i]), (PG8_LAS unsigned*)(lds + (bufoff) + ldsw + _i * 8192), 16, 0, 0); } while (0)
#define PG8_LDA(dst, b, h) do { _Pragma("unroll") for (int m = 0; m < 4; ++m) _Pragma("unroll") for (int k = 0; k < 2; ++k) dst[m][k] = *(const PG8_LAS bf16x8*)(lds + PG8_SA(b, h) + aoff + m * 2048 + k * 1024); } while (0)
#define PG8_LDB(dst, b, h) do { _Pragma("unroll") for (int n = 0; n < 2; ++n) _Pragma("unroll") for (int k = 0; k < 2; ++k) dst[n][k] = *(const PG8_LAS bf16x8*)(lds + PG8_SB(b, h) + boff + n * 2048 + k * 1024); } while (0)
#define PG8_MMA(ai, bj, At, Bt) do { __builtin_amdgcn_s_setprio(1); _Pragma("unroll") for (int m = 0; m < 4; ++m) _Pragma("unroll") for (int n = 0; n < 2; ++n) _Pragma("unroll") for (int k = 0; k < 2; ++k) \
        acc[ai][bj][m][n] = __builtin_amdgcn_mfma_f32_16x16x32_bf16(Bt[n][k], At[m][k], acc[ai][bj][m][n], 0, 0, 0); __builtin_amdgcn_s_setprio(0); } while (0)
#define PG8_WAIT_V(n) asm volatile("s_waitcnt vmcnt(" #n ")" ::: "memory")
#define PG8_WAIT_L(n) asm volatile("s_waitcnt lgkmcnt(" #n ")" ::: "memory")
#define PG8_BAR __builtin_amdgcn_s_barrier()
#define PG8_SCHED __builtin_amdgcn_sched_barrier(0)
    Unit cur, nxt; int ui = 0;
    if (!S.next(0, cur)) return;
    f32x4 acc[2][2][4][2];
#pragma unroll
    for (int a = 0; a < 2; ++a)
#pragma unroll
        for (int b = 0; b < 2; ++b)
#pragma unroll
            for (int m = 0; m < 4; ++m)
#pragma unroll
                for (int n = 0; n < 2; ++n) acc[a][b][m][n] = (f32x4){0.f, 0.f, 0.f, 0.f};
    bf16x8 At[4][2], B0[2][2], B1[2][2];
    unsigned cA = (unsigned)cur.pm * tstep + (unsigned)cur.k0 * kstep, cB = (unsigned)cur.pn * tstep + (unsigned)cur.k0 * kstep;
    S.a_ready(cur);
    if constexpr (SP2) {
        PG8_STAGE(PG8_SB(0, 0), (const char*)g.Bt + (size_t)(cB), voffB); PG8_STAGE(PG8_SB(0, 1), (const char*)g.Bt + (size_t)(cB + hstep), voffB); PG8_STAGE(PG8_SA(0, 0), (const char*)g.A + (size_t)(cA), voffA); PG8_STAGE(PG8_SA(0, 1), (const char*)g.A + (size_t)(cA + hstep), voffA);
        if (wr == 1) PG8_BAR;
        PG8_WAIT_V(2); PG8_BAR;
        PG8_STAGE(PG8_SB(1, 0), (const char*)g.Bt + (size_t)(cB + kstep), voffB); PG8_STAGE(PG8_SA(1, 0), (const char*)g.A + (size_t)(cA + kstep), voffA); PG8_STAGE(PG8_SB(1, 1), (const char*)g.Bt + (size_t)(cB + hstep + kstep), voffB);
        PG8_WAIT_V(6); PG8_BAR;
    } else {
        PG8_STAGE(PG8_SB(0, 0), (const char*)g.Bt + (size_t)(cB), voffB); PG8_STAGE(PG8_SA(0, 0), (const char*)g.A + (size_t)(cA), voffA); PG8_STAGE(PG8_SB(0, 1), (const char*)g.Bt + (size_t)(cB + hstep), voffB); PG8_STAGE(PG8_SA(0, 1), (const char*)g.A + (size_t)(cA + hstep), voffA);
        if (wr == 1) PG8_BAR;
        PG8_WAIT_V(4); PG8_BAR;
        PG8_STAGE(PG8_SB(1, 0), (const char*)g.Bt + (size_t)(cB + kstep), voffB); PG8_STAGE(PG8_SA(1, 0), (const char*)g.A + (size_t)(cA + kstep), voffA); PG8_STAGE(PG8_SB(1, 1), (const char*)g.Bt + (size_t)(cB + hstep + kstep), voffB);
        PG8_WAIT_V(6); PG8_BAR;
    }
    for (;;) {
        const bool has_next = S.next(ui + 1, nxt);
        const unsigned nA = has_next ? (unsigned)nxt.pm * tstep + (unsigned)nxt.k0 * kstep : cA, nB = has_next ? (unsigned)nxt.pn * tstep + (unsigned)nxt.k0 * kstep : cB;
        const int unt = cur.nt ? cur.nt : nt;
        for (int t = 0; t < unt; t += 2) {
            const bool last = (t == unt - 2);
            const unsigned a1 = cA + (unsigned)(t + 1) * kstep;
            const unsigned a2 = last ? nA : cA + (unsigned)(t + 2) * kstep, b2 = last ? nB : cB + (unsigned)(t + 2) * kstep;
            const unsigned a3 = a2 + kstep, b3 = b2 + kstep;
            if (last && has_next) S.a_ready(nxt);
            if constexpr (SP2) {
            PG8_LDB(B0, 0, 0); PG8_LDB(B1, 0, 1); PG8_SCHED; PG8_LDA(At, 0, 0); PG8_STAGE(PG8_SA(1, 1), (const char*)g.A + (size_t)(a1 + hstep), voffA);
            PG8_WAIT_V(8); PG8_WAIT_L(0); PG8_BAR; PG8_MMA(0, 0, At, B0); PG8_MMA(0, 1, At, B1); PG8_BAR; PG8_SCHED;
            PG8_LDA(At, 0, 1); PG8_STAGE(PG8_SB(0, 0), (const char*)g.Bt + (size_t)(b2), voffB); PG8_STAGE(PG8_SB(0, 1), (const char*)g.Bt + (size_t)(b2 + hstep), voffB); PG8_STAGE(PG8_SA(0, 0), (const char*)g.A + (size_t)(a2), voffA);
            PG8_WAIT_V(8); PG8_WAIT_L(0); PG8_BAR; PG8_MMA(1, 0, At, B0); PG8_MMA(1, 1, At, B1); PG8_BAR; PG8_SCHED;
            PG8_LDB(B0, 1, 0); PG8_LDB(B1, 1, 1); PG8_SCHED; PG8_LDA(At, 1, 0); PG8_STAGE(PG8_SA(0, 1), (const char*)g.A + (size_t)(a2 + hstep), voffA);
            PG8_WAIT_V(8); PG8_WAIT_L(0); PG8_BAR; PG8_MMA(0, 0, At, B0); PG8_MMA(0, 1, At, B1); PG8_BAR; PG8_SCHED;
            PG8_LDA(At, 1, 1); PG8_STAGE(PG8_SB(1, 0), (const char*)g.Bt + (size_t)(b3), voffB); PG8_STAGE(PG8_SB(1, 1), (const char*)g.Bt + (size_t)(b3 + hstep), voffB); PG8_STAGE(PG8_SA(1, 0), (const char*)g.A + (size_t)(a3), voffA);
            PG8_WAIT_V(8); PG8_WAIT_L(0); PG8_BAR; PG8_MMA(1, 0, At, B0); PG8_MMA(1, 1, At, B1); PG8_BAR; PG8_SCHED;
            } else {
            PG8_LDB(B0, 0, 0); PG8_SCHED; PG8_LDA(At, 0, 0); PG8_STAGE(PG8_SA(1, 1), (const char*)g.A + (size_t)(a1 + hstep), voffA);
            PG8_WAIT_L(8); PG8_BAR; PG8_WAIT_L(0); PG8_MMA(0, 0, At, B0); PG8_BAR; PG8_SCHED;
            PG8_LDB(B1, 0, 1); PG8_STAGE(PG8_SB(0, 0), (const char*)g.Bt + (size_t)(b2), voffB);
            PG8_BAR; PG8_WAIT_L(0); PG8_MMA(0, 1, At, B1); PG8_BAR;
            PG8_LDA(At, 0, 1); PG8_STAGE(PG8_SA(0, 0), (const char*)g.A + (size_t)(a2), voffA);
            PG8_BAR; PG8_WAIT_L(0); PG8_MMA(1, 0, At, B0); PG8_BAR; PG8_SCHED;
            PG8_STAGE(PG8_SB(0, 1), (const char*)g.Bt + (size_t)(b2 + hstep), voffB);
            PG8_WAIT_V(6); PG8_BAR; PG8_MMA(1, 1, At, B1); PG8_BAR;
            PG8_LDB(B0, 1, 0); PG8_SCHED; PG8_LDA(At, 1, 0); PG8_STAGE(PG8_SA(0, 1), (const char*)g.A + (size_t)(a2 + hstep), voffA);
            PG8_WAIT_L(8); PG8_BAR; PG8_WAIT_L(0); PG8_MMA(0, 0, At, B0); PG8_BAR; PG8_SCHED;
            PG8_LDB(B1, 1, 1); PG8_STAGE(PG8_SB(1, 0), (const char*)g.Bt + (size_t)(b3), voffB);
            PG8_BAR; PG8_WAIT_L(0); PG8_MMA(0, 1, At, B1); PG8_BAR;
            PG8_LDA(At, 1, 1); PG8_STAGE(PG8_SA(1, 0), (const char*)g.A + (size_t)(a3), voffA);
            PG8_BAR; PG8_WAIT_L(0); PG8_MMA(1, 0, At, B0); PG8_BAR; PG8_SCHED;
            PG8_STAGE(PG8_SB(1, 1), (const char*)g.Bt + (size_t)(b3 + hstep), voffB);
            PG8_WAIT_V(6); PG8_BAR; PG8_MMA(1, 1, At, B1); PG8_BAR;
            }
        }
        if constexpr (ALIGN_EPI) { if (wr == 0) PG8_BAR; }
        if constexpr (!Epi::AFTER_DRAIN) { int t_ = threadIdx.x; asm volatile("" : "+v"(t_)); const int l_ = t_ & 63, w_ = __builtin_amdgcn_readfirstlane(t_ >> 6);
            E(acc, cur, w_ >> 2, w_ & 3, l_ & 15, l_ >> 4); S.done(cur); }
        if (!has_next) break;
#pragma unroll
        for (int a = 0; a < 2; ++a)
#pragma unroll
            for (int b = 0; b < 2; ++b)
#pragma unroll
                for (int m = 0; m < 4; ++m)
#pragma unroll
                    for (int n = 0; n < 2; ++n) acc[a][b][m][n] = (f32x4){0.f, 0.f, 0.f, 0.f};
        cur = nxt; cA = nA; cB = nB; ++ui;
        if constexpr (ALIGN_EPI) { if (wr == 1) PG8_BAR; }
    }
    PG8_WAIT_V(0);
    if constexpr (!ALIGN_EPI) { if (wr == 0) PG8_BAR; }
    PG8_BAR;
    if constexpr (Epi::AFTER_DRAIN) { E.fused(acc, cur, wr, wc, fr, fq, lds, wid, lane); S.done(cur); }
#undef PG8_SA
#undef PG8_SB
#undef PG8_STAGE
#undef PG8_LDA
#undef PG8_LDB
#undef PG8_MMA
#undef PG8_WAIT_V
#undef PG8_WAIT_L
#undef PG8_BAR
#undef PG8_SCHED
}
}

#define GAS __attribute__((address_space(1)))
typedef unsigned short bf16;
typedef float f32x4 __attribute__((ext_vector_type(4)));
typedef unsigned v4u __attribute__((ext_vector_type(4)));
typedef unsigned v2u __attribute__((ext_vector_type(2)));
constexpr int D = 2048, NB = 4, SEQ = 4096, CTXL = 256, DFF = 5504, NMOD = 9;
constexpr int TL = NB * SEQ, TC = NB * CTXL, TT = TL + TC;
constexpr int MIXH = 1024;
constexpr int EV_COLS = 7216, EV_PAD = 7424, OD_COLS = 5120;
constexpr int NWAVES = 8, NTHR = 512;
constexpr float EPS = 1e-6f;

constexpr size_t MiB = 1u << 20;
constexpr size_t WS_CTL = 0, CTL_ZERO_BYTES = 64 * 1024;
constexpr size_t WS_MOD = 1 * MiB;
constexpr size_t WS_MODP = 2 * MiB;
constexpr int MOD_KC = 16;
constexpr size_t WS_WGU = 16 * MiB;
constexpr size_t SZ_WGU = (size_t)11008 * 2048 * 2;
constexpr size_t WS_WD = WS_WGU + 4 * SZ_WGU;
constexpr size_t SZ_WD = (size_t)2048 * 5504 * 2;
constexpr size_t WS_WIN_EV = WS_WD + 4 * SZ_WD;
constexpr size_t WS_WOUT_EV = WS_WIN_EV + (size_t)EV_PAD * 2048 * 2;
constexpr size_t WS_WIN_OD = WS_WOUT_EV + (size_t)2048 * 2048 * 2;
constexpr size_t WS_WOUT_OD = WS_WIN_OD + (size_t)OD_COLS * 2048 * 2;
constexpr size_t WS_WGLU = WS_WOUT_OD + (size_t)2048 * 2048 * 2;
constexpr size_t WS_XC = WS_WGLU + (size_t)1024 * 1024 * 2;
constexpr size_t WS_HB = WS_XC + (size_t)TC * D * 4;
constexpr size_t WS_R = WS_HB + (size_t)TT * D * 2;
constexpr size_t WS_HID = WS_R;
constexpr size_t WS_Y = WS_R + 183 * MiB;
constexpr size_t WS_S = WS_R;
constexpr size_t WS_GT = WS_R + 247 * MiB;
constexpr size_t WS_GB = WS_R + 264 * MiB;
constexpr size_t WS_O = WS_R + 298 * MiB;
constexpr size_t SZ_O = (size_t)TT * 1024 * 2;
constexpr size_t WS_XL = WS_R + 434 * MiB;
constexpr size_t WS_QK2 = WS_XL + (size_t)TL * D * 2;
constexpr size_t WS_GP = WS_QK2 + (size_t)TT * 2048 * 2;
constexpr size_t WS_QKS = WS_GP + (size_t)TT * 8 * 4 * 4;
constexpr size_t WS_VEC = WS_QKS + (size_t)2 * TT * 1024 * 2;
constexpr size_t WS_GPK = WS_VEC + (size_t)NB * 4 * 2 * 68 * 384 * 4;
constexpr size_t WS_PP = WS_GPK + (size_t)NB * 4 * 2 * 68 * 256 * 4;
constexpr size_t WS_RS = WS_PP + (size_t)NB * 4 * 2 * 68 * 4096 * 2;
constexpr size_t WS_END = WS_RS + (size_t)NB * 4 * 2 * 68 * 64 * 4;
constexpr size_t WS_YCP = WS_R + 320 * MiB;
constexpr int YPARTS = 8;
static_assert(WS_YCP >= WS_Y + (size_t)TT * D * 2 && WS_YCP + (size_t)YPARTS * TC * D * 4 <= WS_XL && WS_O + 4 * SZ_O <= WS_XL, "ws map");
static_assert(WS_HID + (size_t)TT * DFF * 2 <= WS_Y && WS_S + (size_t)TT * EV_PAD * 2 <= WS_GT && WS_GT + (size_t)TT * 256 * 4 <= WS_GB && WS_GB + (size_t)TT * 1024 * 2 <= WS_O, "ws map");
static_assert(WS_Y + (size_t)TT * D * 2 <= WS_O, "ws map");

constexpr int LDS_BYTES = 156 * 1024;
constexpr int MISC_OFF = LDS_BYTES - 64;

struct Args { const float* in[34]; float* out; unsigned char* ws; };
#ifdef PROBE_A
#ifndef PROBE_A1
#define PROBE_A1 PROBE_A
#endif
#ifndef PROBE_B
#define PROBE_B -100
#endif
#ifndef PROBE_B1
#define PROBE_B1 PROBE_B
#endif
#define XBAR() do { xcd_barrier(bar); if (blockIdx.x == 0 && threadIdx.x == 0) { volatile LAS unsigned* M_ = (volatile LAS unsigned*)(lds + MISC_OFF); const unsigned c_ = M_[4]; \
        const unsigned long long t_ = __builtin_amdgcn_s_memrealtime(); const unsigned lo_ = (unsigned)t_; \
        if ((int)c_ == PROBE_A - 1) M_[6] = lo_; if ((int)c_ == PROBE_A1) M_[7] = lo_; if ((int)c_ == PROBE_B - 1) M_[8] = lo_; if ((int)c_ == PROBE_B1) M_[9] = lo_; M_[4] = c_ + 1u; } } while (0)
#else
#define XBAR() xcd_barrier(bar)
#endif
#define ARG(k) ((const float*)(GAS const float*)(a.in[opaque_idx(k)]))
__device__ __forceinline__ unsigned char* wsp(unsigned char* w, size_t off) { asm volatile("" : "+s"(off)); return w + off; }
__device__ __forceinline__ int opaque_idx(int k) { asm volatile("" : "+s"(k)); return k; }

__device__ __forceinline__ unsigned f2bf(float f) { unsigned u = __float_as_uint(f); u += 0x7FFFu + ((u >> 16) & 1u); return u >> 16; }
typedef __bf16 bf16x2_t __attribute__((ext_vector_type(2)));
typedef float f32x2_t __attribute__((ext_vector_type(2)));
__device__ __forceinline__ unsigned pk2(float lo, float hi) { const f32x2_t v = {lo, hi}; const bf16x2_t b = __builtin_convertvector(v, bf16x2_t); return __builtin_bit_cast(unsigned, b); }
__device__ __forceinline__ float bf2f(unsigned short b) { return __uint_as_float(((unsigned)b) << 16); }
__device__ __forceinline__ float wave_sum(float v) {
#pragma unroll
    for (int o = 1; o < 64; o <<= 1) v += __shfl_xor(v, o);
    return v;
}
__device__ __forceinline__ float fast_silu(float g) { return g * __builtin_amdgcn_rcpf(1.0f + __expf(-g)); }
__device__ __forceinline__ float fast_sigmoid(float g) { return __builtin_amdgcn_rcpf(1.0f + __expf(-g)); }

#ifndef DEFER
#define DEFER 2
#endif
struct TJob { const float* src; bf16* dst; int K, N, map; };
constexpr int NT_FFN = 5504, NT_EVIN = 32 * 226, NT_SQ = 2048, NT_ODIN = 32 * 160, NT_GLU = 512;
constexpr int NT_SET0 = 6 * NT_FFN + NT_EVIN + NT_SQ + NT_ODIN + NT_SQ + NT_GLU, NT_SET1 = 3 * NT_FFN, NT_SET2 = 3 * NT_FFN;
__device__ __forceinline__ void transpose_tile(const TJob& j, int tl, int lane) {
    const int nblk = (j.N + 31) / 32, kb = tl / nblk, nb = tl % nblk, k0 = 64 * kb, n0 = 32 * nb;
    const int kb8 = lane >> 3, nb4 = lane & 7, n = n0 + 4 * nb4;
    int drow0;
    if (j.map == 0) drow0 = n0;
    else if (j.map == 1) drow0 = (n0 / 128) * 256 + (n0 % 128);
    else if (j.map == 2) drow0 = (n0 / 128) * 256 + (n0 % 128) + 128;
    else drow0 = (nb < 96) ? n0 : (nb == 96 ? 7168 : (nb < 225 ? n0 - 32 : 7200));
    if (n < j.N) {
        const float* s = j.src + (size_t)(k0 + 8 * kb8) * j.N + n;
        f32x4 v[8];
#pragma unroll
        for (int i = 0; i < 8; ++i) v[i] = *(const f32x4*)(s + (size_t)i * j.N);
        bf16* d = j.dst + (size_t)(drow0 + 4 * nb4) * j.K + k0 + 8 * kb8;
#pragma unroll
        for (int e = 0; e < 4; ++e) { v4u o; o.x = pk2(v[0][e], v[1][e]); o.y = pk2(v[2][e], v[3][e]); o.z = pk2(v[4][e], v[5][e]); o.w = pk2(v[6][e], v[7][e]);
            *(v4u*)(d + (size_t)e * j.K) = o; }
    }
}

__device__ __forceinline__ void transpose_tile2(const TJob& j, int tl0, int tl1, int lane) {
    const int nblk = (j.N + 31) / 32; const int kb8 = lane >> 3, nb4 = lane & 7;
    f32x4 v[2][8]; int drow[2], k0s[2]; bool ok[2];
#pragma unroll
    for (int u = 0; u < 2; ++u) { const int tl = u ? tl1 : tl0; const int kb = tl / nblk, nb = tl % nblk, k0 = 64 * kb, n0 = 32 * nb, n = n0 + 4 * nb4;
        int drow0;
        if (j.map == 0) drow0 = n0;
        else if (j.map == 1) drow0 = (n0 / 128) * 256 + (n0 % 128);
        else if (j.map == 2) drow0 = (n0 / 128) * 256 + (n0 % 128) + 128;
        else drow0 = (nb < 96) ? n0 : (nb == 96 ? 7168 : (nb < 225 ? n0 - 32 : 7200));
        drow[u] = drow0; k0s[u] = k0; ok[u] = n < j.N;
        if (ok[u]) { const float* s = j.src + (size_t)(k0 + 8 * kb8) * j.N + n;
#pragma unroll
            for (int i = 0; i < 8; ++i) v[u][i] = *(const f32x4*)(s + (size_t)i * j.N); } }
#pragma unroll
    for (int u = 0; u < 2; ++u) if (ok[u]) { bf16* d = j.dst + (size_t)(drow[u] + 4 * nb4) * j.K + k0s[u] + 8 * kb8;
#pragma unroll
        for (int e = 0; e < 4; ++e) { v4u o; o.x = pk2(v[u][0][e], v[u][1][e]); o.y = pk2(v[u][2][e], v[u][3][e]); o.z = pk2(v[u][4][e], v[u][5][e]); o.w = pk2(v[u][6][e], v[u][7][e]);
            *(v4u*)(d + (size_t)e * j.K) = o; } }
}
__device__ __forceinline__ TJob make_job(const Args& a, unsigned char* ws, int id) {
    TJob j;
    if (id < 12) { const int li = id / 3, kind = id % 3; const size_t wo = (size_t)li * 2048 * 5504;
        j.src = ARG(8 + kind) + wo;
        if (kind == 2) { j.K = 5504; j.N = 2048; j.map = 0; j.dst = (bf16*)(wsp(ws, WS_WD) + (size_t)li * SZ_WD); }
        else { j.K = 2048; j.N = 5504; j.map = 1 + kind; j.dst = (bf16*)(wsp(ws, WS_WGU) + (size_t)li * SZ_WGU); } }
    else if (id == 12) { j.src = ARG(11); j.K = 2048; j.N = EV_COLS; j.map = 3; j.dst = (bf16*)wsp(ws, WS_WIN_EV); }
    else if (id == 13) { j.src = ARG(12); j.K = 2048; j.N = 2048; j.map = 0; j.dst = (bf16*)wsp(ws, WS_WOUT_EV); }
    else if (id == 14) { j.src = ARG(20); j.K = 2048; j.N = OD_COLS; j.map = 0; j.dst = (bf16*)wsp(ws, WS_WIN_OD); }
    else if (id == 15) { j.src = ARG(21); j.K = 2048; j.N = 2048; j.map = 0; j.dst = (bf16*)wsp(ws, WS_WOUT_OD); }
    else { j.src = ARG(30); j.K = 1024; j.N = 1024; j.map = 0; j.dst = (bf16*)wsp(ws, WS_WGLU); }
    return j;
}
__device__ __forceinline__ void convert_tiles(const Args& a, unsigned char* ws, int set, int wave_index, int nwaves, int lane) {
    const int njobs = DEFER == 2 ? (set == 0 ? 8 : 3) : (set == 0 ? 11 : 3);
    int start = wave_index;
#pragma unroll 1
    for (int q = 0; q < njobs; ++q) {
        const int id = DEFER == 2 ? (set == 0 ? (q < 3 ? q : q + 9) : 3 * set + q) : (set == 0 ? (q < 3 ? q : (q < 6 ? q + 3 : q + 6)) : (set == 1 ? 3 + q : 9 + q));
        const int nt = id < 12 ? NT_FFN : (id == 12 ? NT_EVIN : (id == 14 ? NT_ODIN : (id == 16 ? NT_GLU : NT_SQ)));
        const TJob j = make_job(a, ws, id);
        int t = start;
#pragma unroll 1
        for (; t + nwaves < nt; t += 2 * nwaves) transpose_tile2(j, t, t + nwaves, lane);
        if (t < nt) { transpose_tile(j, t, lane); t += nwaves; }
        start = t - nt;
    }
}

static_assert(NT_FFN % 2 == 0 && NT_EVIN % 2 == 0 && NT_SQ % 2 == 0 && NT_ODIN % 2 == 0 && NT_GLU % 2 == 0, "tile pairs must not straddle jobs");
constexpr int NT_SET0_D2 = 3 * NT_FFN + NT_EVIN + NT_SQ + NT_ODIN + NT_SQ + NT_GLU;
__device__ __forceinline__ void convert_pair_set0(const Args& a, unsigned char* ws, int t, int lane) {
    int id = 16;
    if (t < 3 * NT_FFN) { id = t / NT_FFN; t -= id * NT_FFN; }
    else { t -= 3 * NT_FFN;
        if (t < NT_EVIN) id = 12;
        else { t -= NT_EVIN; if (t < NT_SQ) id = 13;
            else { t -= NT_SQ; if (t < NT_ODIN) id = 14;
                else { t -= NT_ODIN; if (t < NT_SQ) id = 15; else { t -= NT_SQ; id = 16; } } } } }
    const TJob j = make_job(a, ws, id);
    transpose_tile2(j, t, t + 1, lane);
}

struct NormP {
    const void* xin_lat; const void* xin_ctx; void* xout_lat; void* xout_ctx; const bf16* y; bf16* h;
    int xin_f32, xout_f32;
    int rows_end; int has_y, has_h; float w;
    const float* y_ctx;
    int lp, sp;
    int ln, sn;
};
__device__ __forceinline__ void norm_phase(const NormP& p, const float* mod, const float* norm_pre, const float* norm_post, LAS unsigned char* lds, int gw, int ngw, int tid, int lane) {
    { int t2 = threadIdx.x; asm volatile("" : "+v"(t2)); tid = t2; lane = t2 & 63; gw = blockIdx.x * NWAVES + __builtin_amdgcn_readfirstlane(t2 >> 6); }
    LAS float* TA = (LAS float*)lds; LAS float* TB = TA + 5 * D; LAS float* TCc = TB + 5 * D;
    for (int i = tid; i < 5 * D; i += NTHR) { const int var = i >> 11, j = i & (D - 1);
        if (p.has_y) TA[i] = p.w * mod[((size_t)p.lp * 5 + var) * (NMOD * D) + (3 * p.sp + 2) * D + j] * norm_post[(p.lp * 3 + p.sp) * D + j];
        if (p.has_h) { TB[i] = norm_pre[(p.ln * 3 + p.sn) * D + j] * (1.0f + mod[((size_t)p.ln * 5 + var) * (NMOD * D) + (3 * p.sn + 1) * D + j]);
                       TCc[i] = mod[((size_t)p.ln * 5 + var) * (NMOD * D) + (3 * p.sn) * D + j]; } }
    __syncthreads();
    for (int r = gw; r < p.rows_end; r += ngw) {
        const int var = r < TL ? (r >> 12) : 4;
        const size_t xoff = r < TL ? (size_t)r * D : (size_t)(r - TL) * D;
        const void* xi = r < TL ? p.xin_lat : p.xin_ctx; void* xo = r < TL ? p.xout_lat : p.xout_ctx;
        f32x4 xv[8];
        if (p.xin_f32) {
#pragma unroll
            for (int j = 0; j < 8; ++j) xv[j] = *(const f32x4*)((const float*)xi + xoff + 4 * lane + 256 * j);
        } else {
#pragma unroll
            for (int j = 0; j < 8; ++j) { const v2u w = *(const v2u*)((const bf16*)xi + xoff + 4 * lane + 256 * j); xv[j] = (f32x4){__uint_as_float(w.x << 16), __uint_as_float(w.x & 0xffff0000u), __uint_as_float(w.y << 16), __uint_as_float(w.y & 0xffff0000u)}; }
        }
        if (p.has_y) {
            const bool yc = (r >= TL) && p.y_ctx; const float* yr = p.y_ctx + (size_t)(r - TL) * D; f32x4 yv[8]; float s = 0.f;
            if (!yc) { const bf16* yb = p.y + (size_t)r * D;
#pragma unroll
                for (int j = 0; j < 8; ++j) { const v2u w = *(const v2u*)(yb + 4 * lane + 256 * j); yv[j] = (f32x4){__uint_as_float(w.x << 16), __uint_as_float(w.x & 0xffff0000u), __uint_as_float(w.y << 16), __uint_as_float(w.y & 0xffff0000u)}; }
            } else {
#pragma unroll
                for (int j = 0; j < 8; ++j) yv[j] = *(const f32x4*)(yr + 4 * lane + 256 * j);
                for (int q = 1; q < YPARTS; ++q) {
#pragma unroll
                for (int j = 0; j < 8; ++j) yv[j] += *(const f32x4*)(yr + (size_t)q * TC * D + 4 * lane + 256 * j); } }
#pragma unroll
            for (int j = 0; j < 8; ++j) { s += (yv[j].x * yv[j].x + yv[j].y * yv[j].y) + (yv[j].z * yv[j].z + yv[j].w * yv[j].w); }
            const float rstd = 1.0f / sqrtf(wave_sum(s) * (1.0f / D) + EPS);
#pragma unroll
            for (int j = 0; j < 8; ++j) { const f32x4 a = *(const LAS f32x4*)(TA + var * D + 4 * lane + 256 * j); xv[j] = xv[j] + a * (yv[j] * rstd);
                if (p.xout_f32) *(f32x4*)((float*)xo + xoff + 4 * lane + 256 * j) = xv[j];
                else { v2u w; w.x = pk2(xv[j].x, xv[j].y); w.y = pk2(xv[j].z, xv[j].w); *(v2u*)((bf16*)xo + xoff + 4 * lane + 256 * j) = w; } }
        }
        if (p.has_h) {
            float s = 0.f;
#pragma unroll
            for (int j = 0; j < 8; ++j) s += (xv[j].x * xv[j].x + xv[j].y * xv[j].y) + (xv[j].z * xv[j].z + xv[j].w * xv[j].w);
            const float rstd = 1.0f / sqrtf(wave_sum(s) * (1.0f / D) + EPS);
            bf16* hr = p.h + (size_t)r * D;
#pragma unroll
            for (int j = 0; j < 8; ++j) { const f32x4 b = *(const LAS f32x4*)(TB + var * D + 4 * lane + 256 * j), c = *(const LAS f32x4*)(TCc + var * D + 4 * lane + 256 * j);
                const f32x4 o = xv[j] * rstd * b + c; v2u w; w.x = pk2(o.x, o.y); w.y = pk2(o.z, o.w); *(v2u*)(hr + 4 * lane + 256 * j) = w; }
        }
    }
    __syncthreads();
}

struct EpiSwiGLU {
    static constexpr bool PERM = true, AFTER_DRAIN = false;
    bf16* O; int ldc;
    __device__ __forceinline__ void operator()(const pg8::f32x4 (&acc)[2][2][4][2], const pg8::Unit& u, int wr, int wc, int fr, int fq) const {
        const int row0 = u.pm * 256 + wr * 64 + fr, col0 = u.pn * 128 + wc * 32 + 8 * fq;
#pragma unroll
        for (int ai = 0; ai < 2; ++ai)
#pragma unroll
            for (int m = 0; m < 4; ++m) { bf16* rowp = O + (size_t)(row0 + ai * 128 + m * 16) * ldc + col0;
                const pg8::f32x4 g0 = acc[ai][0][m][0], g1 = acc[ai][0][m][1], u0 = acc[ai][1][m][0], u1 = acc[ai][1][m][1];
                v4u w; w.x = pk2(fast_silu(g0[0]) * u0[0], fast_silu(g0[1]) * u0[1]); w.y = pk2(fast_silu(g0[2]) * u0[2], fast_silu(g0[3]) * u0[3]);
                w.z = pk2(fast_silu(g1[0]) * u1[0], fast_silu(g1[1]) * u1[1]); w.w = pk2(fast_silu(g1[2]) * u1[2], fast_silu(g1[3]) * u1[3]);
                *(v4u*)rowp = w; }
    }
};
struct EpiF32 {
    static constexpr bool PERM = true, AFTER_DRAIN = false;
    bf16* C; float* Cs;
    static constexpr int ldc = D;
    __device__ __forceinline__ void operator()(const pg8::f32x4 (&acc)[2][2][4][2], const pg8::Unit& u, int wr, int wc, int fr, int fq) const {
        const int row0 = u.pm * 256 + wr * 64 + fr, col0 = u.pn * 256 + wc * 32 + 8 * fq;
        if (u.part >= 0) {
            float* base = Cs + ((size_t)u.part * TC - (size_t)TL) * D;
#pragma unroll
            for (int ai = 0; ai < 2; ++ai)
#pragma unroll
                for (int m = 0; m < 4; ++m) { float* rowp = base + (size_t)(row0 + ai * 128 + m * 16) * ldc + col0;
#pragma unroll
                    for (int bj = 0; bj < 2; ++bj) { *(pg8::f32x4*)(rowp + bj * 128) = acc[ai][bj][m][0]; *(pg8::f32x4*)(rowp + bj * 128 + 4) = acc[ai][bj][m][1]; } }
        } else {
#pragma unroll
            for (int ai = 0; ai < 2; ++ai)
#pragma unroll
                for (int m = 0; m < 4; ++m) { bf16* rowp = C + (size_t)(row0 + ai * 128 + m * 16) * ldc + col0;
#pragma unroll
                    for (int bj = 0; bj < 2; ++bj) { const pg8::f32x4 v0 = acc[ai][bj][m][0], v1 = acc[ai][bj][m][1];
                        v4u w; w.x = pk2(v0[0], v0[1]); w.y = pk2(v0[2], v0[3]); w.z = pk2(v1[0], v1[1]); w.w = pk2(v1[2], v1[3]);
                        *(v4u*)(rowp + bj * 128) = w; } }
        }
    }
};
struct EpiS {
    static constexpr bool PERM = true, AFTER_DRAIN = false;
    bf16* S; int ldc; float* GT; int gt_pn;
    __device__ __forceinline__ void operator()(const pg8::f32x4 (&acc)[2][2][4][2], const pg8::Unit& u, int wr, int wc, int fr, int fq) const {
        const int row0 = u.pm * 256 + wr * 64 + fr;
        if (u.pn == gt_pn) {
            if (wc < 2) {
#pragma unroll
                for (int ai = 0; ai < 2; ++ai)
#pragma unroll
                    for (int m = 0; m < 4; ++m) { float* rowp = GT + (size_t)(row0 + ai * 128 + m * 16) * 256 + wc * 32 + 8 * fq;
                        *(pg8::f32x4*)rowp = acc[ai][0][m][0]; *(pg8::f32x4*)(rowp + 4) = acc[ai][0][m][1]; }
            }
        } else {
            const int col0 = u.pn * 256 + wc * 32 + 8 * fq;
#pragma unroll
            for (int ai = 0; ai < 2; ++ai)
#pragma unroll
                for (int m = 0; m < 4; ++m) { bf16* rowp = S + (size_t)(row0 + ai * 128 + m * 16) * ldc + col0;
#pragma unroll
                    for (int bj = 0; bj < 2; ++bj) { const pg8::f32x4 v0 = acc[ai][bj][m][0], v1 = acc[ai][bj][m][1];
                        v4u w; w.x = pk2(v0[0], v0[1]); w.y = pk2(v0[2], v0[3]); w.z = pk2(v1[0], v1[1]); w.w = pk2(v1[2], v1[3]);
                        *(v4u*)(rowp + bj * 128) = w; } }
        }
    }
};

#define DEV __device__ __forceinline__
#define LP(T) LAS T*
#define SYNC() do { asm volatile("s_waitcnt lgkmcnt(0)" ::: "memory"); __builtin_amdgcn_s_barrier(); asm volatile("" ::: "memory"); } while (0)
typedef short v8s __attribute__((ext_vector_type(8)));
typedef float v4f __attribute__((ext_vector_type(4)));
#define MFMA16(x, y, c) __builtin_amdgcn_mfma_f32_16x16x32_bf16((x), (y), (c), 0, 0, 0)
#define SHX(v, m) __shfl_xor((v), (m))
#define SHUP(v, d) __shfl_up((v), (d))
#define SHIDX(v, l) __shfl((v), (l))
#define EXPF(x) __expf(x)
#define LOGF(x) __logf(x)
#define RCPF(x) __builtin_amdgcn_rcpf(x)
#define RSQRTF(x) (1.0f / sqrtf(x))
#define PK2(lo, hi) pk2((lo), (hi))
#define F2BF(x) ((unsigned short)f2bf(x))
#define WAVE_SYNC() asm volatile("s_waitcnt lgkmcnt(0)" ::: "memory")
typedef short v4s __attribute__((ext_vector_type(4)));
#define LDS_TR16(p) __builtin_amdgcn_ds_read_tr16_b64_v4i16((LAS v4s*)(p))
#define RDLANE(v, l) __int_as_float(__builtin_amdgcn_readlane(__float_as_int(v), (l)))
#define RDLANE16(v, l) __shfl((v), (l))
#define SIB_SYNC_IMPL(p, target) do { __hip_atomic_fetch_add((p), 1u, __ATOMIC_RELAXED, __HIP_MEMORY_SCOPE_AGENT); unsigned sp_ = 0; \
    while (__hip_atomic_load((p), __ATOMIC_RELAXED, __HIP_MEMORY_SCOPE_AGENT) < (target) && ++sp_ < 100000u) __builtin_amdgcn_s_sleep(2); } while (0)

#define PRBROW(r) ((prb) == 1 ? ((r) & 63) : (r))
#define PRBTSK(t) ((prb) == 1 ? 0 : (t))
DEV int seq_row(int b, int seg, int np, int cm) {
    if (!seg) return TL + b * CTXL + np;
    const int n = cm ? ((np & 63) * 64 + (np >> 6)) : np;
    return b * SEQ + n;
}
DEV int tok_row(int b, int seg, int pos, int dir, int cm) {
    const int len = seg ? SEQ : CTXL;
    return seq_row(b, seg, dir ? len - 1 - pos : pos, cm);
}
DEV float bflo(unsigned u) { return __uint_as_float(u << 16); }
DEV float bfhi(unsigned u) { return __uint_as_float(u & 0xffff0000u); }
DEV float logsigmoidf(float z) { return fminf(z, 0.f) - LOGF(1.0f + EXPF(-fabsf(z))); }
DEV v4f tile_mma(v4f acc, LP(const unsigned char) A, int sa, int m0, LP(const unsigned char) B, int sb, int n0, int ksteps, int fr, int fq) {
    LP(const unsigned char) ap = A + (m0 + fr) * sa + fq * 16;
    LP(const unsigned char) bp = B + (n0 + fr) * sb + fq * 16;
    for (int k = 0; k < ksteps; ++k) {
        const v8s af = *(LP(const v8s))(ap + k * 64);
        const v8s bf = *(LP(const v8s))(bp + k * 64);
        acc = MFMA16(bf, af, acc);
    }
    return acc;
}
DEV v8s tr_frag(LP(const unsigned char) T, int st, int k0, int n0, int lane) {
    const int l16 = lane & 15, fq = lane >> 4;
    LP(const unsigned char) p = T + (k0 + 8 * fq + (l16 >> 2)) * st + (n0 + 4 * (l16 & 3)) * 2;
    const v4s a = LDS_TR16(p), b = LDS_TR16(p + 4 * st);
    return (v8s){a.x, a.y, a.z, a.w, b.x, b.y, b.z, b.w};
}
DEV v4f tile_mma_nt(v4f acc, LP(const unsigned char) A, int sa, int m0, LP(const unsigned char) Bt, int sb, int n0, int ksteps, int lane) {
    const int fr = lane & 15, fq = lane >> 4;
    for (int k = 0; k < ksteps; ++k) { const v8s af = *(LP(const v8s))(A + (m0 + fr) * sa + fq * 16 + k * 64); const v8s bf = tr_frag(Bt, sb, 32 * k, n0, lane); acc = MFMA16(bf, af, acc); }
    return acc;
}
DEV v4f tile_mma_tt(v4f acc, LP(const unsigned char) At, int sa, int m0, LP(const unsigned char) Bt, int sb, int n0, int ksteps, int lane) {
    for (int k = 0; k < ksteps; ++k) { const v8s af = tr_frag(At, sa, 32 * k, m0, lane); const v8s bf = tr_frag(Bt, sb, 32 * k, n0, lane); acc = MFMA16(bf, af, acc); }
    return acc;
}
constexpr int ST128 = 272, ST64 = 144, ST256 = 528, STV = 80;
DEV void sibling_sync(unsigned* sib, unsigned target, int tid) {
#ifdef SIB_SYNC_IMPL
    if (sib) { if (tid == 0) SIB_SYNC_IMPL(sib, target); SYNC(); }
#endif
}

constexpr int MIX_UNITS = NB * 32;
constexpr int GLA_TASKS = NB * 4 * 2 * (CTXL / 64 + SEQ / 64);
DEV void gla_prep_loop(int first, int stride, const bf16* S, const float* GT, const float* wg_all, const float* bg_all, bf16* QKS, float* VEC, LP(unsigned char) lds, int tid) {
    constexpr int NCHUNK = CTXL / 64 + SEQ / 64;
    constexpr int LA_RS = 132;
    LP(float) LA = (LP(float))lds; LP(float) SEG = (LP(float))(lds + 33792); LP(unsigned char) LRb = lds + 35840; LP(unsigned char) WGb = lds + 40960; LP(float) BG = (LP(float))(lds + 51200);
    for (int i = tid; i < (5120 + 10240) / 4; i += NTHR) ((LP(unsigned))LRb)[i] = 0u;
    SYNC();
    const int lane = tid & 63, wave = tid >> 6, fr = lane & 15, fq = lane >> 4;
    const int j = tid >> 3, c8 = tid & 7, dc = c8 * 16;
    const float qscale = 0.08838834764831845f;
    v4u pq0, pq1, pk0, pk1; v4f plr = (v4f){0.f, 0.f, 0.f, 0.f}, pwg = plr; float pbg = 0.f;
#define GP_ISSUE(tk) do { const int cx_ = (tk) % NCHUNK, r1_ = (tk) / NCHUNK, dir_ = r1_ & 1, h_ = (r1_ >> 1) & 3, b_ = r1_ >> 3; \
        const int seg_ = cx_ >= CTXL / 64, ci_ = seg_ ? cx_ - CTXL / 64 : cx_; \
        const bf16* sr_ = S + (size_t)tok_row(b_, seg_, ci_ * 64 + j, dir_, 0) * EV_PAD; \
        pq0 = *(const v4u*)(sr_ + h_ * 128 + dc); pq1 = *(const v4u*)(sr_ + h_ * 128 + dc + 8); pk0 = *(const v4u*)(sr_ + 512 + h_ * 128 + dc); pk1 = *(const v4u*)(sr_ + 512 + h_ * 128 + dc + 8); \
        pwg = *(const v4f*)(wg_all + (dir_ * 16 + (tid & 15)) * 512 + h_ * 128 + (tid >> 4) * 4); \
        if (tid < 128) pbg = bg_all[dir_ * 512 + h_ * 128 + tid]; \
        if (tid < 256) { const int rr_ = tok_row(b_, seg_, ci_ * 64 + (tid >> 2), dir_, 0); plr = *(const v4f*)(GT + (size_t)rr_ * 256 + dir_ * 16 + (tid & 3) * 4); } } while (0)
    if (first < GLA_TASKS) GP_ISSUE(first);
    for (int task = first; task < GLA_TASKS; task += stride) {
    const int cidx = task % NCHUNK, r1 = task / NCHUNK, dir = r1 & 1, h = (r1 >> 1) & 3, b = r1 >> 3;
    const int seg = cidx >= CTXL / 64, ci = seg ? cidx - CTXL / 64 : cidx;
    const int row = tok_row(b, seg, ci * 64 + j, dir, 0);
    const v4u q0 = pq0, q1 = pq1, k0 = pk0, k1 = pk1;
    { const int m = tid & 15, d0 = (tid >> 4) * 4;
      *(LP(unsigned short))(WGb + (d0 + 0) * 80 + m * 2) = F2BF(pwg.x); *(LP(unsigned short))(WGb + (d0 + 1) * 80 + m * 2) = F2BF(pwg.y);
      *(LP(unsigned short))(WGb + (d0 + 2) * 80 + m * 2) = F2BF(pwg.z); *(LP(unsigned short))(WGb + (d0 + 3) * 80 + m * 2) = F2BF(pwg.w); }
    if (tid < 128) BG[tid] = pbg;
    if (tid < 256) *(LP(v2u))(LRb + (tid >> 2) * 80 + (tid & 3) * 8) = (v2u){PK2(plr.x, plr.y), PK2(plr.z, plr.w)};
    if (task + stride < GLA_TASKS) GP_ISSUE(task + stride);
    SYNC();
    {
        const int tt = wave >> 1; const v8s af = *(LP(const v8s))(LRb + (16 * tt + fr) * 80 + fq * 16);
#pragma unroll
        for (int i = 0; i < 4; ++i) { const int dt = (wave & 1) * 4 + i; const v8s bf = *(LP(const v8s))(WGb + (16 * dt + fr) * 80 + fq * 16);
            v4f z = (v4f){0.f, 0.f, 0.f, 0.f}; z = MFMA16(bf, af, z);
            const v4f bg4 = *(LP(const v4f))(BG + 16 * dt + 4 * fq);
            v4f o; o.x = logsigmoidf(z.x + bg4.x) * 0.0625f; o.y = logsigmoidf(z.y + bg4.y) * 0.0625f; o.z = logsigmoidf(z.z + bg4.z) * 0.0625f; o.w = logsigmoidf(z.w + bg4.w) * 0.0625f;
            *(LP(v4f))(LA + (16 * tt + fr) * LA_RS + 32 * fq + 4 * dt) = o; }
    }
    SYNC();
    {
        const int d = tid & 127, sg = tid >> 7; float acc = 0.f;
        float cv[16];
#pragma unroll
        for (int jj = 0; jj < 16; ++jj) cv[jj] = LA[(sg * 16 + jj) * LA_RS + d];
#pragma unroll
        for (int jj = 0; jj < 16; ++jj) { acc += cv[jj]; LA[(sg * 16 + jj) * LA_RS + d] = acc; }
        SEG[sg * 128 + d] = acc;
    }
    SYNC();
    {
        const int sgj = j >> 4;
        bf16* orow = QKS + ((size_t)dir * TT + row) * 1024 + h * 128 + dc;
#pragma unroll 1
        for (int g = 0; g < 2; ++g) {
            const v4u qv = g ? q1 : q0, kv = g ? k1 : k0;
            const unsigned qw[4] = {qv.x, qv.y, qv.z, qv.w}, kw[4] = {kv.x, kv.y, kv.z, kv.w};
            unsigned oqs[4], oks[4];
#pragma unroll
            for (int g2 = 0; g2 < 2; ++g2) {
                const int po = 32 * (2 * g + g2) + 4 * c8;
                const v4f la4 = *(LP(const v4f))(LA + j * LA_RS + po), mid4 = *(LP(const v4f))(LA + 32 * LA_RS + po);
                const v4f s04 = *(LP(const v4f))(SEG + po), s14 = *(LP(const v4f))(SEG + 128 + po), s24 = *(LP(const v4f))(SEG + 256 + po);
                const float lav[4] = {la4.x, la4.y, la4.z, la4.w}, midv[4] = {mid4.x, mid4.y, mid4.z, mid4.w};
                const float s0v[4] = {s04.x, s04.y, s04.z, s04.w}, s1v[4] = {s14.x, s14.y, s14.z, s14.w}, s2v[4] = {s24.x, s24.y, s24.z, s24.w};
                float vqs[4], vks[4];
#pragma unroll
                for (int e = 0; e < 4; ++e) {
                    const int d = dc + 8 * g + 4 * g2 + e, i2 = 2 * g2 + (e >> 1);
                    const float s0 = s0v[e], s1 = s1v[e], s2 = s2v[e];
                    const float pre = (sgj > 0 ? s0 : 0.f) + (sgj > 1 ? s1 : 0.f) + (sgj > 2 ? s2 : 0.f);
                    const float bv = lav[e] + pre;
                    const float bmid = midv[e] + s0 + s1;
                    const float q = ((e & 1) ? bfhi(qw[i2]) : bflo(qw[i2])) * qscale, k = (e & 1) ? bfhi(kw[i2]) : bflo(kw[i2]);
                    const float e1 = EXPF(bv - bmid);
                    vqs[e] = q * e1; vks[e] = k * RCPF(e1);
                    if (j == 63) { const float bend = bv; float* vp = VEC + (size_t)task * 384 + d; vp[0] = EXPF(bmid); vp[128] = EXPF(bend - bmid); vp[256] = EXPF(bend); }
                }
                oqs[2 * g2] = PK2(vqs[0], vqs[1]); oqs[2 * g2 + 1] = PK2(vqs[2], vqs[3]);
                oks[2 * g2] = PK2(vks[0], vks[1]); oks[2 * g2 + 1] = PK2(vks[2], vks[3]);
            }
            *(v4u*)(orow + 8 * g) = (v4u){oqs[0], oqs[1], oqs[2], oqs[3]};
            *(v4u*)(orow + 512 + 8 * g) = (v4u){oks[0], oks[1], oks[2], oks[3]};
        }
    }
    SYNC();
    }
#undef GP_ISSUE
}

DEV void gla_unit(const bf16* S, const bf16* QKS, const float* VEC, bf16* O, int unit, LP(unsigned char) lds, int tid, unsigned* sib, int prb = 0) {
    const int lane = tid & 63, wave = tid >> 6, fr = lane & 15, fq = lane >> 4;
    const int vs = unit & 3, dir = (unit >> 2) & 1, h = (unit >> 3) & 3, b = unit >> 5;
    LP(unsigned char) QS = lds; LP(unsigned char) KS = lds + 17408; LP(unsigned char) QB = lds + 34816;
    LP(unsigned char) VV = lds + 52224; LP(unsigned char) PM = lds + 61440; LP(unsigned char) STT = lds + 70656;
    LP(float) DV = (LP(float))(lds + 88064);
    for (int i = tid; i < 64 * ST128 / 4; i += NTHR) ((LP(unsigned))STT)[i] = 0u;
    v4f sacc[4];
#pragma unroll
    for (int i = 0; i < 4; ++i) sacc[i] = (v4f){0.f, 0.f, 0.f, 0.f};
    const int j = tid >> 3, c8 = tid & 7, dc = c8 * 16;
    const int tt = wave >> 1, vt0 = (wave & 1) * 2;
    const int svt = wave & 3, sdt0 = (wave >> 2) * 4;
    bf16* Od = O + (size_t)dir * TT * 1024;
    constexpr int NCHUNK = CTXL / 64 + SEQ / 64;
    const int task0 = ((b * 4 + h) * 2 + dir) * NCHUNK;
    v4u gq0[2], gq1[2], gk0[2], gk1[2], gvv[2]; v4f gem[4]; v4f gdv = (v4f){0.f, 0.f, 0.f, 0.f};
#define GLA_ISSUE(cx, P_) do { const int seg_ = (cx) >= CTXL / 64, ci_ = seg_ ? (cx) - CTXL / 64 : (cx); \
        const int row_ = PRBROW(tok_row(b, seg_, ci_ * 64 + j, dir, 0)); \
        const bf16* qr_ = QKS + ((size_t)dir * TT + row_) * 1024 + h * 128 + c8 * 8; \
        gq0[P_] = *(const v4u*)(qr_); gq1[P_] = *(const v4u*)(qr_ + 64); gk0[P_] = *(const v4u*)(qr_ + 512); gk1[P_] = *(const v4u*)(qr_ + 576); \
        gvv[P_] = *(const v4u*)(S + (size_t)row_ * EV_PAD + 1024 + h * 256 + vs * 64 + c8 * 8); } while (0)
#define GLA_ISSUE_V(cx) do { const float* vp_ = VEC + (size_t)PRBTSK(task0 + (cx)) * 384;     \
        _Pragma("unroll") for (int i_ = 0; i_ < 4; ++i_) gem[i_] = *(const v4f*)(vp_ + (i_ >> 1) * 64 + c8 * 8 + 4 * (i_ & 1)); \
        if (tid < 64) gdv = *(const v4f*)(vp_ + 128 + tid * 4); } while (0)
#ifdef GLA_TOTAL_PROBE
    const unsigned long long gt0_ = __builtin_amdgcn_s_memrealtime();
#endif
    GLA_ISSUE(0, 0); GLA_ISSUE(1, 1); GLA_ISSUE_V(0);
    SYNC();
#pragma unroll 1
    for (int c2 = 0; c2 < NCHUNK; c2 += 2) {
#pragma unroll
    for (int u_ = 0; u_ < 2; ++u_) {
        const int cidx = c2 + u_;
        const int seg = cidx >= CTXL / 64, ci = seg ? cidx - CTXL / 64 : cidx;
        if (u_ == 0 && (c2 & 3) == 0 && c2 > 0) sibling_sync(sib, (unsigned)(c2 >> 2) * 4u, tid);
        const v4u q0 = gq0[u_], q1 = gq1[u_], k0 = gk0[u_], k1 = gk1[u_], vv = gvv[u_]; const v4f dvv = gdv;
        v4f em[4];
#pragma unroll
        for (int i_ = 0; i_ < 4; ++i_) em[i_] = gem[i_];
        {
            *(LP(v4u))(QS + j * ST128 + c8 * 16) = q0; *(LP(v4u))(QS + j * ST128 + c8 * 16 + 128) = q1;
            *(LP(v4u))(KS + j * ST128 + c8 * 16) = k0; *(LP(v4u))(KS + j * ST128 + c8 * 16 + 128) = k1;
            const unsigned qw[8] = {q0.x, q0.y, q0.z, q0.w, q1.x, q1.y, q1.z, q1.w}; unsigned ob[8];
#pragma unroll
            for (int i2 = 0; i2 < 8; ++i2) { const v4f e4 = em[i2 >> 1]; const float ea = (i2 & 1) ? e4.z : e4.x, eb = (i2 & 1) ? e4.w : e4.y; ob[i2] = PK2(bflo(qw[i2]) * ea, bfhi(qw[i2]) * eb); }
            *(LP(v4u))(QB + j * ST128 + c8 * 16) = (v4u){ob[0], ob[1], ob[2], ob[3]}; *(LP(v4u))(QB + j * ST128 + c8 * 16 + 128) = (v4u){ob[4], ob[5], ob[6], ob[7]};
            *(LP(v4u))(VV + j * ST64 + c8 * 16) = vv;
            if (tid < 64) *(LP(v4f))(DV + tid * 4) = dvv;
        }
        if (cidx + 2 < NCHUNK) GLA_ISSUE(cidx + 2, u_);
        if (cidx + 1 < NCHUNK) GLA_ISSUE_V(cidx + 1);
        SYNC();
        v4f oacc[2]; oacc[0] = (v4f){0.f, 0.f, 0.f, 0.f}; oacc[1] = oacc[0];
        {
#pragma unroll
            for (int i = 0; i < 2; ++i) { const int st = vt0 + i; v4f p = (v4f){0.f, 0.f, 0.f, 0.f};
                if (st <= tt) { p = tile_mma(p, QS, ST128, 16 * tt, KS, ST128, 16 * st, 4, fr, fq);
                    if (st == tt) { if (4 * fq + 0 > fr) p.x = 0.f; if (4 * fq + 1 > fr) p.y = 0.f; if (4 * fq + 2 > fr) p.z = 0.f; if (4 * fq + 3 > fr) p.w = 0.f; } }
                *(LP(v2u))(PM + (16 * tt + fr) * ST64 + (16 * st + 4 * fq) * 2) = (v2u){PK2(p.x, p.y), PK2(p.z, p.w)}; }
#pragma unroll
            for (int k = 0; k < 4; ++k) { const v8s af = *(LP(const v8s))(QB + (16 * tt + fr) * ST128 + fq * 16 + k * 64);
#pragma unroll
                for (int i = 0; i < 2; ++i) { const v8s bf = *(LP(const v8s))(STT + (16 * (vt0 + i) + fr) * ST128 + fq * 16 + k * 64); oacc[i] = MFMA16(bf, af, oacc[i]); } }
        }
        SYNC();
#pragma unroll
        for (int k = 0; k < 2; ++k) { const v8s af = *(LP(const v8s))(PM + (16 * tt + fr) * ST64 + fq * 16 + k * 64);
#pragma unroll
            for (int i = 0; i < 2; ++i) { const v8s bf = tr_frag(VV, ST64, 32 * k, 16 * (vt0 + i), lane); oacc[i] = MFMA16(bf, af, oacc[i]); } }
        if (!prb) { const int orow = tok_row(b, seg, ci * 64 + 16 * tt + fr, dir, 0);
#pragma unroll
          for (int i = 0; i < 2; ++i) *(v2u*)(Od + (size_t)orow * 1024 + h * 256 + vs * 64 + 16 * (vt0 + i) + 4 * fq) = (v2u){PK2(oacc[i].x, oacc[i].y), PK2(oacc[i].z, oacc[i].w)}; }
        {
            v4f tmp[4];
#pragma unroll
            for (int i = 0; i < 4; ++i) tmp[i] = (v4f){0.f, 0.f, 0.f, 0.f};
#pragma unroll
            for (int k = 0; k < 2; ++k) { const v8s af = tr_frag(VV, ST64, 32 * k, 16 * svt, lane);
#pragma unroll
                for (int i = 0; i < 4; ++i) { const v8s bf = tr_frag(KS, ST128, 32 * k, 16 * (sdt0 + i), lane); tmp[i] = MFMA16(bf, af, tmp[i]); } }
#pragma unroll
            for (int i = 0; i < 4; ++i) { const v4f ee = *(LP(const v4f))(DV + 16 * (sdt0 + i) + 4 * fq), de = *(LP(const v4f))(DV + 128 + 16 * (sdt0 + i) + 4 * fq);
                sacc[i] = sacc[i] * de + tmp[i] * ee;
                *(LP(v2u))(STT + (16 * svt + fr) * ST128 + (16 * (sdt0 + i) + 4 * fq) * 2) = (v2u){PK2(sacc[i].x, sacc[i].y), PK2(sacc[i].z, sacc[i].w)}; }
        }
        SYNC();
    }
    }
#undef GLA_ISSUE
#undef GLA_ISSUE_V
#ifdef GLA_TOTAL_PROBE
    if (wave == 1) { const unsigned long long acc_ = __builtin_amdgcn_s_memrealtime() - gt0_, t0_ = __builtin_amdgcn_s_memrealtime(); while (__builtin_amdgcn_s_memrealtime() - t0_ < 8ull * acc_) __builtin_amdgcn_s_sleep(8); }
#endif
}

constexpr int MAT_TASKS = NB * 4 * 2 * (CTXL / 64 + SEQ / 64);
template <int MODE>
DEV void mat_prep_loop(int first, int stride, const bf16* Sqk, int ldqk, int qoff, int koff, float kscale, const float* GT, const float* gate_b, float* GP, float* GPK,
                       const float* ret_log_decay, bf16* PP, float* RS, LP(unsigned char) lds, int tid) {
    constexpr int NCHUNK = CTXL / 64 + SEQ / 64;
    const int lane = tid & 63, wave = tid >> 6, fr = lane & 15, fq = lane >> 4;
    LP(unsigned char) Q = lds; LP(unsigned char) K = lds + 33792; LP(float) AS = (LP(float))(lds + 67584);
    const int j = tid >> 3, c8 = tid & 7;
    v4u rq[4], rk[4]; float gi = 0.f, gf = 0.f;
#define MP_ISSUE(tk) do { const int cx_ = (tk) % NCHUNK, r1_ = (tk) / NCHUNK, h_ = r1_ & 3, b_ = r1_ >> 2; \
        const int seg_ = cx_ >= CTXL / 64, ci_ = seg_ ? cx_ - CTXL / 64 : cx_; \
        const bf16* s1_ = Sqk + (size_t)tok_row(b_, seg_, ci_ * 64 + j, 0, 1) * ldqk; \
        _Pragma("unroll") for (int g_ = 0; g_ < 4; ++g_) { rq[g_] = *(const v4u*)(s1_ + qoff + h_ * 256 + c8 * 8 + 64 * g_); rk[g_] = *(const v4u*)(s1_ + koff + h_ * 256 + c8 * 8 + 64 * g_); } \
        if (MODE == 0 && wave < 2) { const int prow_ = tok_row(b_, seg_, ci_ * 64 + (wave ? 63 - lane : lane), 0, 1); \
            gi = GT[(size_t)prow_ * 256 + 32 + (wave * 2 + 0) * 4 + h_]; gf = GT[(size_t)prow_ * 256 + 32 + (wave * 2 + 1) * 4 + h_]; } } while (0)
    if (first < MAT_TASKS / 2) MP_ISSUE(first);
    for (int task = first; task < MAT_TASKS / 2; task += stride) {
        const int cidx = task % NCHUNK, r1 = task / NCHUNK, h = r1 & 3, b = r1 >> 2;
        const int seg = cidx >= CTXL / 64, ci = seg ? cidx - CTXL / 64 : cidx;
        const int cidx_b = seg ? CTXL / 64 + (SEQ / 64 - 1 - ci) : (CTXL / 64 - 1 - ci);
        const int tf = ((b * 4 + h) * 2 + 0) * NCHUNK + cidx, tb = ((b * 4 + h) * 2 + 1) * NCHUNK + cidx_b;
#pragma unroll
        for (int g8 = 0; g8 < 4; ++g8) { *(LP(v4u))(Q + j * ST256 + (c8 * 8 + 64 * g8) * 2) = rq[g8]; *(LP(v4u))(K + j * ST256 + (c8 * 8 + 64 * g8) * 2) = rk[g8]; }
        if (wave < 2) {
            const int dd = wave; LP(float) ASd = AS + dd * 448;
            if (MODE == 0) {
                const int prow = tok_row(b, seg, ci * 64 + (dd ? 63 - lane : lane), 0, 1);
                const float ig = gi + gate_b[(dd * 2 + 0) * 4 + h];
                float bcum = logsigmoidf(gf + gate_b[(dd * 2 + 1) * 4 + h]);
#pragma unroll
                for (int o = 1; o < 64; o <<= 1) { const float t = SHUP(bcum, o); if (lane >= o) bcum += t; }
                const float a_s = ig - bcum;
                float cm = a_s;
#pragma unroll
                for (int o = 1; o < 64; o <<= 1) { const float t = SHUP(cm, o); if (lane >= o) cm = fmaxf(cm, t); }
                *(v4f*)(GP + ((size_t)prow * 8 + dd * 4 + h) * 4) = (v4f){bcum, a_s, cm, 0.f};
                ASd[lane] = a_s; ASd[64 + lane] = -cm; ASd[384 + lane] = EXPF(a_s - RDLANE(cm, 63));
            } else { const float lg = -expf(ret_log_decay[dd * 4 + h]); ASd[lane] = -(float)(lane + 1) * lg; ASd[64 + lane] = (float)(lane + 1) * lg; }
        }
        if (task + stride < MAT_TASKS / 2) MP_ISSUE(task + stride);
        SYNC();
        const int tt = wave >> 1;
        bf16* ppf = PP + (size_t)tf * 4096; bf16* ppb = PP + (size_t)tb * 4096;
        const float rtf = AS[64 + 16 * tt + fr], rtb = AS[448 + 64 + 63 - 16 * tt - fr];
#pragma unroll
        for (int i = 0; i < 2; ++i) { const int st = (wave & 1) * 2 + i; v4f p = (v4f){0.f, 0.f, 0.f, 0.f};
            p = tile_mma(p, Q, ST256, 16 * tt, K, ST256, 16 * st, 8, fr, fq);
            v4f pf = (v4f){0.f, 0.f, 0.f, 0.f}, pb = pf;
            if (st <= tt) { const v4f as4 = *(LP(const v4f))(AS + 16 * st + 4 * fq);
                pf.x = p.x * kscale * EXPF(as4.x + rtf); pf.y = p.y * kscale * EXPF(as4.y + rtf); pf.z = p.z * kscale * EXPF(as4.z + rtf); pf.w = p.w * kscale * EXPF(as4.w + rtf);
                if (st == tt) { if (4 * fq + 0 > fr) pf.x = 0.f; if (4 * fq + 1 > fr) pf.y = 0.f; if (4 * fq + 2 > fr) pf.z = 0.f; if (4 * fq + 3 > fr) pf.w = 0.f; } }
            if (st >= tt) { const v4f as4 = *(LP(const v4f))(AS + 448 + 60 - 16 * st - 4 * fq);
                pb.x = p.x * kscale * EXPF(as4.w + rtb); pb.y = p.y * kscale * EXPF(as4.z + rtb); pb.z = p.z * kscale * EXPF(as4.y + rtb); pb.w = p.w * kscale * EXPF(as4.x + rtb);
                if (st == tt) { if (4 * fq + 0 < fr) pb.x = 0.f; if (4 * fq + 1 < fr) pb.y = 0.f; if (4 * fq + 2 < fr) pb.z = 0.f; if (4 * fq + 3 < fr) pb.w = 0.f; } }
            *(v2u*)(ppf + (16 * tt + fr) * 64 + 16 * st + 4 * fq) = (v2u){PK2(pf.x, pf.y), PK2(pf.z, pf.w)};
            *(v2u*)(ppb + (63 - 16 * tt - fr) * 64 + 60 - 16 * st - 4 * fq) = (v2u){PK2(pb.w, pb.z), PK2(pb.y, pb.x)};
            if (MODE == 0) { float rf = (pf.x + pf.y) + (pf.z + pf.w), rb = (pb.x + pb.y) + (pb.z + pb.w); rf += SHX(rf, 16); rf += SHX(rf, 32); rb += SHX(rb, 16); rb += SHX(rb, 32);
                if (fq == 0) { AS[128 + st * 64 + 16 * tt + fr] = rf; AS[448 + 128 + st * 64 + 63 - 16 * tt - fr] = rb; } } }
        if (MODE == 0 && tid >= 256) {
            const int d = tid - 256; float kwf = 0.f, kwb = 0.f;
#pragma unroll 8
            for (int jj = 0; jj < 64; ++jj) { const float kv = __uint_as_float(((unsigned)*(LP(const unsigned short))(K + jj * ST256 + d * 2)) << 16); kwf += kv * AS[384 + jj]; kwb += kv * AS[448 + 384 + 63 - jj]; }
            GPK[(size_t)tf * 256 + d] = kwf; GPK[(size_t)tb * 256 + d] = kwb; }
        SYNC();
        if (MODE == 0 && tid < 128) { const int dd = tid >> 6, t = tid & 63; LP(const float) dn = AS + dd * 448 + 128; RS[(size_t)(dd ? tb : tf) * 64 + t] = (dn[t] + dn[64 + t]) + (dn[128 + t] + dn[192 + t]); }
        SYNC();
    }
#undef MP_ISSUE
}

#ifdef SEC_PROBE
#ifndef SEC_WAVE
#define SEC_WAVE 1
#endif
#ifndef SEC_MODE
#define SEC_MODE 0
#endif
#define SECT(s, e) do { if ((s) == SEC_PROBE && MODE == SEC_MODE) { const unsigned long long t_ = __builtin_amdgcn_s_memrealtime(); if (e) sec_acc += t_ - sec_t0; else sec_t0 = t_; } } while (0)
#else
#define SECT(s, e) do {} while (0)
#endif
template <int MODE>
DEV void mat_unit(const bf16* Sqk, int ldqk, int qoff, int koff, const bf16* Sv, int ldv, int voff, float kscale, const float* GP, const float* GPK, const bf16* PP, const float* RS, bf16* O, int store_ctx,
                  const float* ret_log_decay, int unit, LP(unsigned char) lds, int tid, unsigned* sib, int prb = 0) {
    const int lane = tid & 63, wave = tid >> 6, fr = lane & 15, fq = lane >> 4;
    const int vs = unit & 3, dir = (unit >> 2) & 1, h = (unit >> 3) & 3, b = unit >> 5;
    LP(unsigned char) Q = lds; LP(unsigned char) K = lds + 33792;
    LP(unsigned char) VV = lds + 67584; LP(unsigned char) VW = lds + 76800;
    LP(unsigned char) PM = lds + 86016; LP(unsigned char) STT = lds + 95232;
    LP(float) SCAL = (LP(float))(lds + 137472);
    LP(float) NV = SCAL + 768;
    for (int i = tid; i < 80 * ST256 / 4; i += NTHR) ((LP(unsigned))STT)[i] = 0u;
    if (tid < 256) NV[tid] = 0.f;
    v4f sacc[8];
#pragma unroll
    for (int i = 0; i < 8; ++i) sacc[i] = (v4f){0.f, 0.f, 0.f, 0.f};
    const int j = tid >> 3, c8 = tid & 7;
    const int tt = wave >> 1, vt0 = (wave & 1) * 2;
#ifdef SEC_PROBE
    unsigned long long sec_acc = 0ull, sec_t0 = 0ull;
#endif
    float m_st = 0.f;
    float lg = 0.f;
    if (MODE == 1) lg = -expf(ret_log_decay[dir * 4 + h]);
    bf16* Od = O + (size_t)(2 + dir) * TT * 1024;
    constexpr int NCHUNK = CTXL / 64 + SEQ / 64;
    v4u rq[2][4], rk[2][4], rv, rp; v4f gpv = (v4f){0.f, 0.f, 0.f, 0.f}; float kwv[2] = {0.f, 0.f}, rsv = 0.f;
    const int task0 = ((b * 4 + h) * 2 + dir) * NCHUNK;
#define MAT_ISSUE(cx, P_) do { const int seg_ = (cx) >= CTXL / 64, ci_ = seg_ ? (cx) - CTXL / 64 : (cx); \
        const int row_ = PRBROW(tok_row(b, seg_, ci_ * 64 + j, dir, 1)); \
        const bf16* s1_ = Sqk + (size_t)row_ * ldqk; \
        _Pragma("unroll") for (int g_ = 0; g_ < 4; ++g_) { rq[P_][g_] = *(const v4u*)(s1_ + qoff + h * 256 + c8 * 8 + 64 * g_); rk[P_][g_] = *(const v4u*)(s1_ + koff + h * 256 + c8 * 8 + 64 * g_); } \
        if (MODE == 0 && tid < 256) kwv[P_] = GPK[(size_t)(task0 + (cx)) * 256 + tid]; } while (0)
#define MAT_GATE_LOAD(cx) do { if (MODE == 0 && wave == 0) { const int seg_ = (cx) >= CTXL / 64, ci_ = seg_ ? (cx) - CTXL / 64 : (cx); \
        const int prow_ = PRBROW(tok_row(b, seg_, ci_ * 64 + lane, dir, 1)); gpv = *(const v4f*)(GP + ((size_t)prow_ * 8 + dir * 4 + h) * 4); rsv = RS[(size_t)PRBTSK(task0 + (cx)) * 64 + lane]; } } while (0)
#define MAT_GATES(cx) do { if (wave == 0) { LP(float) sc_ = SCAL + ((cx) & 1) * 384; \
        if (MODE == 0) { const float bcum_ = gpv.x, a_s_ = gpv.y, Mt_ = fmaxf(m_st, gpv.z); \
            const float M63_ = RDLANE(Mt_, 63), bend_ = RDLANE(bcum_, 63), cm63_ = RDLANE(gpv.z, 63); const float wp_ = EXPF(gpv.z - Mt_); \
            sc_[lane] = wp_; sc_[64 + lane] = EXPF(m_st - Mt_); sc_[128 + lane] = EXPF(a_s_ - M63_); sc_[192 + lane] = EXPF(-(bcum_ + Mt_)); sc_[256 + lane] = rsv * wp_; \
            if (lane == 0) { sc_[320] = EXPF(m_st - M63_); sc_[321] = EXPF(cm63_ - M63_); } \
            m_st = bend_ + M63_; \
        } else { sc_[lane] = 1.0f; sc_[64 + lane] = EXPF((float)(lane + 1) * lg); sc_[128 + lane] = EXPF((float)(63 - lane) * lg); sc_[192 + lane] = 0.f; sc_[256 + lane] = 0.f; \
            if (lane == 0) { sc_[320] = EXPF(64.f * lg); sc_[321] = 0.f; } } } } while (0)
    static_assert(NCHUNK % 2 == 0, "the chunk loop is unrolled by two");
#define MAT_ISSUE_P(cx) do { const int seg_ = (cx) >= CTXL / 64, ci_ = seg_ ? (cx) - CTXL / 64 : (cx); rp = *(const v4u*)(PP + (size_t)PRBTSK(task0 + (cx)) * 4096 + j * 64 + c8 * 8); \
        rv = *(const v4u*)(Sv + (size_t)PRBROW(tok_row(b, seg_, ci_ * 64 + j, dir, 1)) * ldv + voff + h * 256 + vs * 64 + c8 * 8); } while (0)
    SECT(5, 0);
    MAT_ISSUE(0, 0); MAT_ISSUE(1, 1); MAT_ISSUE_P(0); MAT_GATE_LOAD(0);
    MAT_GATES(0);
    MAT_GATE_LOAD(1);
    SYNC();
#pragma unroll 1
    for (int c2 = 0; c2 < NCHUNK; c2 += 2) {
#pragma unroll
    for (int u_ = 0; u_ < 2; ++u_) {
        const int cidx = c2 + u_;
        const int seg = cidx >= CTXL / 64, ci = seg ? cidx - CTXL / 64 : cidx;
        if (u_ == 0 && (c2 & 3) == 0 && c2 > 0) sibling_sync(sib, (unsigned)(c2 >> 2) * 4u, tid);
        LP(const float) sc = SCAL + u_ * 384;
        const float kw_cur = kwv[u_];
        SECT(6, 0);
#if defined(SEC_PROBE) && SEC_PROBE == 6
        asm volatile("s_waitcnt vmcnt(0)" ::: "memory");
#endif
        SECT(6, 1);
        SECT(1, 0);
        {
            const float wk = sc[128 + j] * kscale;
#pragma unroll
            for (int g8 = 0; g8 < 4; ++g8) { const int d0 = c8 * 8 + 64 * g8;     *(LP(v4u))(Q + j * ST256 + d0 * 2) = rq[u_][g8]; *(LP(v4u))(K + j * ST256 + d0 * 2) = rk[u_][g8]; }
            const v4u rvv = rv;
            *(LP(v4u))(VV + j * ST64 + c8 * 16) = rvv;
            *(LP(v4u))(VW + j * ST64 + c8 * 16) = (v4u){PK2(bflo(rvv.x) * wk, bfhi(rvv.x) * wk), PK2(bflo(rvv.y) * wk, bfhi(rvv.y) * wk), PK2(bflo(rvv.z) * wk, bfhi(rvv.z) * wk), PK2(bflo(rvv.w) * wk, bfhi(rvv.w) * wk)};
            *(LP(v4u))(PM + j * ST64 + c8 * 16) = rp;
#pragma unroll
            for (int i = 0; i < 8; ++i) *(LP(v2u))(STT + (16 * (i >> 1) + fr) * ST256 + (16 * (2 * wave + (i & 1)) + 4 * fq) * 2) = (v2u){PK2(sacc[i].x, sacc[i].y), PK2(sacc[i].z, sacc[i].w)};
        }
        if (cidx + 2 < NCHUNK) MAT_ISSUE(cidx + 2, u_);
        if (cidx + 1 < NCHUNK) MAT_ISSUE_P(cidx + 1);
        SECT(1, 1); SECT(2, 0);
        SYNC();
        SECT(2, 1); SECT(3, 0);
        if (cidx + 1 < NCHUNK) { MAT_GATES(cidx + 1); if (cidx + 2 < NCHUNK) MAT_GATE_LOAD(cidx + 2); }
        v4f oP[2], oI[2]; oP[0] = (v4f){0.f, 0.f, 0.f, 0.f}; oP[1] = oP[0]; oI[0] = oP[0]; oI[1] = oP[0];
        v4f qa = (v4f){0.f, 0.f, 0.f, 0.f};
#pragma unroll 1
        for (int k = 0; k < 8; ++k) { const v8s af = *(LP(const v8s))(Q + (16 * tt + fr) * ST256 + fq * 16 + k * 64);
#pragma unroll
            for (int i = 0; i < 2; ++i) { const v8s bf = *(LP(const v8s))(STT + (16 * (vt0 + i) + fr) * ST256 + fq * 16 + k * 64); oI[i] = MFMA16(bf, af, oI[i]); }
            if (MODE == 0) { const v8s bn = *(LP(const v8s))(STT + (64 + fr) * ST256 + fq * 16 + k * 64); qa = MFMA16(bn, af, qa); } }
#pragma unroll
        for (int k = 0; k < 2; ++k) { const v8s af = *(LP(const v8s))(PM + (16 * tt + fr) * ST64 + fq * 16 + k * 64);
#pragma unroll
            for (int i = 0; i < 2; ++i) { const v8s bf = tr_frag(VV, ST64, 32 * k, 16 * (vt0 + i), lane); oP[i] = MFMA16(bf, af, oP[i]); } }
        { const int t = 16 * tt + fr; const float wp = sc[t], wi = sc[64 + t];
          v4f o0 = oP[0] * wp + oI[0] * wi, o1 = oP[1] * wp + oI[1] * wi;
          if (MODE == 0) { const float qn = RDLANE16(qa.x, fr); const float den = sc[256 + t] + wi * qn; const float dv = 1.0f / fmaxf(fabsf(den), sc[192 + t]); o0 = o0 * dv; o1 = o1 * dv; }
          if ((seg || store_ctx) && !prb) { const int orow = tok_row(b, seg, ci * 64 + t, dir, 1);
              *(v2u*)(Od + (size_t)orow * 1024 + h * 256 + vs * 64 + 16 * vt0 + 4 * fq) = (v2u){PK2(o0.x, o0.y), PK2(o0.z, o0.w)};
              *(v2u*)(Od + (size_t)orow * 1024 + h * 256 + vs * 64 + 16 * (vt0 + 1) + 4 * fq) = (v2u){PK2(o1.x, o1.y), PK2(o1.z, o1.w)}; } }
        const float dcy = sc[320];
        {
#pragma unroll
            for (int i = 0; i < 8; ++i) sacc[i] = sacc[i] * dcy;
#pragma unroll 1
            for (int k = 0; k < 2; ++k) {
                const v8s bf0 = tr_frag(K, ST256, 32 * k, 16 * (2 * wave), lane), bf1 = tr_frag(K, ST256, 32 * k, 16 * (2 * wave + 1), lane);
#pragma unroll
                for (int a4 = 0; a4 < 4; ++a4) { const v8s af = tr_frag(VW, ST64, 32 * k, 16 * a4, lane); sacc[2 * a4] = MFMA16(bf0, af, sacc[2 * a4]); sacc[2 * a4 + 1] = MFMA16(bf1, af, sacc[2 * a4 + 1]); } }
        }
        SECT(3, 1); SECT(4, 0);
        SYNC();
        SECT(4, 1);
        if (MODE == 0 && tid < 256) {
            const float nn = dcy * NV[tid] + sc[321] * kw_cur * kscale; NV[tid] = nn;
            *(LP(unsigned short))(STT + 64 * ST256 + tid * 2) = F2BF(nn); }
    }
    }
#undef MAT_ISSUE
#undef MAT_ISSUE_P
#undef MAT_GATE_LOAD
#undef MAT_GATES
    SYNC();
    SECT(5, 1);
#ifdef SEC_PROBE
    if (MODE == SEC_MODE && (SEC_UNIT < 0 || unit == SEC_UNIT) && wave == SEC_WAVE) { const unsigned long long t0_ = __builtin_amdgcn_s_memrealtime(); while (__builtin_amdgcn_s_memrealtime() - t0_ < 8ull * sec_acc) __builtin_amdgcn_s_sleep(8); }
#endif
}

constexpr int S5_LDS_PER_WAVE = 1280 + 2 * 10240 + 2 * 6144;
DEV void s5_unit(const bf16* S, int ldS, bf16* O, const float* lam_re, const float* lam_im, const float* log_step, const float* b_re, const float* b_im,
                 const float* c_re, const float* c_im, int unit, LP(unsigned char) wl, int lane, int prb = 0) {
    const int fr = lane & 15, fq = lane >> 4;
    const int dir = unit & 1, g = (unit >> 1) & 63, b = unit >> 7;
    LP(unsigned char) UB = wl; LP(unsigned char) XB = wl + 1280; LP(unsigned char) HB = wl + 1280 + 2 * 10240;
    const int pg = (dir * 64 + g);
    const float lr = lam_re[pg * 64 + lane], li = lam_im[pg * 64 + lane], step = expf(log_step[pg]);
    const float mag = expf(lr * step); float sn, cs; sincosf(li * step, &sn, &cs);
    const float ar = mag * cs, ai = mag * sn, den = lr * lr + li * li;
    const float cre = ((ar - 1.0f) * lr + ai * li) / den, cim = (ai * lr - (ar - 1.0f) * li) / den;
    for (int p = 0; p < 16; ++p) { const float br = b_re[(pg * 64 + lane) * 16 + p], bi = b_im[(pg * 64 + lane) * 16 + p];
        *(LP(unsigned short))(XB + lane * 32 + p * 2) = F2BF(cre * br - cim * bi);
        *(LP(unsigned short))(XB + (64 + lane) * 32 + p * 2) = F2BF(cre * bi + cim * br); }
    WAVE_SYNC();
    v8s bfrag[8];
#pragma unroll
    for (int nt = 0; nt < 8; ++nt) { if (fq < 2) bfrag[nt] = *(LP(const v8s))(XB + (16 * nt + fr) * 32 + fq * 16); else bfrag[nt] = (v8s){0, 0, 0, 0, 0, 0, 0, 0}; }
    v8s cfrag[4];
#pragma unroll
    for (int ks = 0; ks < 4; ++ks) { const int n0 = 32 * ks + 8 * fq; const float* src = (n0 < 64 ? c_re : c_im) + ((size_t)pg * 16 + fr) * 64 + (n0 & 63); const float sgn = n0 < 64 ? 1.f : -1.f;
        v8s f;
#pragma unroll
        for (int i = 0; i < 8; ++i) f[i] = (short)F2BF(sgn * src[i]);
        cfrag[ks] = f; }
    WAVE_SYNC();
    for (int i = lane; i < 1280 / 4; i += 64) ((LP(unsigned))UB)[i] = 0u;
    WAVE_SYNC();
    float hr = 0.f, hi = 0.f;
    bf16* Od = O + (size_t)dir * TT * 1024;
    constexpr int NBLK = CTXL / 16 + SEQ / 16;
    constexpr int S5_PF = 8;
    v4u ur[S5_PF];
#pragma unroll
    for (int i_ = 0; i_ < S5_PF; ++i_) ur[i_] = (v4u){0u, 0u, 0u, 0u};
#define S5_LOAD(bx, dst) do { if (lane < 32 && (bx) < NBLK) { const int seg_ = (bx) >= CTXL / 16, bi_ = seg_ ? (bx) - CTXL / 16 : (bx); \
        dst = *(const v4u*)(S + (size_t)PRBROW(tok_row(b, seg_, bi_ * 16 + (lane >> 1), dir, 0)) * ldS + g * 16 + (lane & 1) * 8); } } while (0)
#define S5_STAGE_A(bx) do { const v8s uf_ = *(LP(const v8s))(UB + fr * 80 + fq * 16); LP(unsigned char) xb_ = XB + ((bx) & 1) * 10240; \
        _Pragma("unroll") for (int nt = 0; nt < 8; ++nt) { v4f x = (v4f){0.f, 0.f, 0.f, 0.f}; x = MFMA16(uf_, bfrag[nt], x); *(LP(v4f))(xb_ + (16 * nt + fr) * 80 + fq * 16) = x; } } while (0)
#pragma unroll
    for (int i_ = 0; i_ < S5_PF; ++i_) S5_LOAD(i_, ur[i_]);
    if (lane < 32) *(LP(v4u))(UB + (lane >> 1) * 80 + (lane & 1) * 16) = ur[0];
#pragma unroll
    for (int i_ = 0; i_ + 1 < S5_PF; ++i_) ur[i_] = ur[i_ + 1];
    S5_LOAD(S5_PF, ur[S5_PF - 1]);
    WAVE_SYNC();
    S5_STAGE_A(0);
    static_assert(NBLK % S5_PF == 0, "ring unrolling");
#pragma unroll 1
    for (int bx0 = 0; bx0 <= NBLK; bx0 += S5_PF) {
#pragma unroll
    for (int ui = 0; ui < S5_PF; ++ui) {
        const int bx = bx0 + ui; if (bx > NBLK) break;
        WAVE_SYNC();
        v8s hf[4]; float xr[16], xi[16];
        if (bx >= 1) { LP(unsigned char) hb = HB + ((bx - 1) & 1) * 6144;
#pragma unroll
            for (int ks = 0; ks < 4; ++ks) hf[ks] = tr_frag(hb, 48, 32 * ks, 0, lane); }
        if (bx < NBLK) { LP(unsigned char) xb = XB + (bx & 1) * 10240;
#pragma unroll
            for (int q4 = 0; q4 < 4; ++q4) { const v4f a4 = *(LP(const v4f))(xb + lane * 80 + q4 * 16), b4 = *(LP(const v4f))(xb + (64 + lane) * 80 + q4 * 16);
                xr[4 * q4] = a4.x; xr[4 * q4 + 1] = a4.y; xr[4 * q4 + 2] = a4.z; xr[4 * q4 + 3] = a4.w; xi[4 * q4] = b4.x; xi[4 * q4 + 1] = b4.y; xi[4 * q4 + 2] = b4.z; xi[4 * q4 + 3] = b4.w; } }
        if (bx + 1 < NBLK) { if (lane < 32) *(LP(v4u))(UB + (lane >> 1) * 80 + (lane & 1) * 16) = ur[ui]; S5_LOAD(bx + 1 + S5_PF, ur[ui]); }
        WAVE_SYNC();
        if (bx + 1 < NBLK) S5_STAGE_A(bx + 1);
        if (bx >= 1) { const int pb = bx - 1, seg = pb >= CTXL / 16, bi = seg ? pb - CTXL / 16 : pb;
            if (seg && !prb) { v4f y = (v4f){0.f, 0.f, 0.f, 0.f};
#pragma unroll
                for (int ks = 0; ks < 4; ++ks) y = MFMA16(cfrag[ks], hf[ks], y);
                const int orow = tok_row(b, seg, bi * 16 + fr, dir, 0);
                *(v2u*)(Od + (size_t)orow * 1024 + g * 16 + 4 * fq) = (v2u){PK2(y.x, y.y), PK2(y.z, y.w)}; } }
        if (bx < NBLK) { LP(unsigned char) hb = HB + (bx & 1) * 6144;
            unsigned pr[8], pi[8];
#pragma unroll
            for (int t2 = 0; t2 < 8; ++t2) {
                const float r0 = ar * hr - ai * hi + xr[2 * t2], i0 = ar * hi + ai * hr + xi[2 * t2];
                hr = ar * r0 - ai * i0 + xr[2 * t2 + 1]; hi = ar * i0 + ai * r0 + xi[2 * t2 + 1];
                pr[t2] = PK2(r0, hr); pi[t2] = PK2(i0, hi); }
            *(LP(v4u))(hb + lane * 48) = (v4u){pr[0], pr[1], pr[2], pr[3]}; *(LP(v4u))(hb + lane * 48 + 16) = (v4u){pr[4], pr[5], pr[6], pr[7]};
            *(LP(v4u))(hb + (64 + lane) * 48) = (v4u){pi[0], pi[1], pi[2], pi[3]}; *(LP(v4u))(hb + (64 + lane) * 48 + 16) = (v4u){pi[4], pi[5], pi[6], pi[7]}; }
    }
    }
#undef S5_STAGE_A
#undef S5_LOAD
}

DEV void conv_prep_row(int r, const bf16* S, bf16* QK2, const float* conv_w, const float* conv_b, int lane) {
    int rm, rp; bool hasm, hasp;
    if (r < TL) { const int b = r >> 12, n = r & (SEQ - 1), gr = n >> 6, col = n & 63, np = col * 64 + gr;
        hasm = np > 0; hasp = np < SEQ - 1; rm = seq_row(b, 1, hasm ? np - 1 : np, 1); rp = seq_row(b, 1, hasp ? np + 1 : np, 1); }
    else { const int n = (r - TL) & (CTXL - 1); hasm = n > 0; hasp = n < CTXL - 1; rm = hasm ? r - 1 : r; rp = hasp ? r + 1 : r; }
    const bf16* s0 = S + (size_t)rm * EV_PAD + 3072; const bf16* s1 = S + (size_t)r * EV_PAD + 3072; const bf16* s2 = S + (size_t)rp * EV_PAD + 3072;
#pragma unroll
    for (int i = 0; i < 4; ++i) { const int c = 8 * lane + 512 * i;
        const v4u a0 = *(const v4u*)(s0 + c), a1 = *(const v4u*)(s1 + c), a2 = *(const v4u*)(s2 + c);
        const unsigned w0[4] = {a0.x, a0.y, a0.z, a0.w}, w1[4] = {a1.x, a1.y, a1.z, a1.w}, w2[4] = {a2.x, a2.y, a2.z, a2.w};
        const float sc = c >= 1024 ? 0.0625f : 1.0f;
        float val[8];
#pragma unroll
        for (int i2 = 0; i2 < 4; ++i2)
#pragma unroll
            for (int e = 0; e < 2; ++e) { const int di = 2 * i2 + e;
                const float um = hasm ? (e ? bfhi(w0[i2]) : bflo(w0[i2])) : 0.f, u0 = e ? bfhi(w1[i2]) : bflo(w1[i2]), up = hasp ? (e ? bfhi(w2[i2]) : bflo(w2[i2])) : 0.f;
                const float pre = conv_b[c + di] + conv_w[c + di] * um + conv_w[2048 + c + di] * u0 + conv_w[4096 + c + di] * up;
                val[di] = pre * RCPF(1.0f + EXPF(-pre)) * sc; }
        *(v4u*)(QK2 + (size_t)r * 2048 + c) = (v4u){PK2(val[0], val[1]), PK2(val[2], val[3]), PK2(val[4], val[5]), PK2(val[6], val[7])}; }
}
DEV void conv_prep_row_lds(int r, const bf16* S, bf16* QK2, LP(const float) tab, int lane) {
    int rm, rp; bool hasm, hasp;
    if (r < TL) { const int b = r >> 12, n = r & (SEQ - 1), gr = n >> 6, col = n & 63, np = col * 64 + gr;
        hasm = np > 0; hasp = np < SEQ - 1; rm = seq_row(b, 1, hasm ? np - 1 : np, 1); rp = seq_row(b, 1, hasp ? np + 1 : np, 1); }
    else { const int n = (r - TL) & (CTXL - 1); hasm = n > 0; hasp = n < CTXL - 1; rm = hasm ? r - 1 : r; rp = hasp ? r + 1 : r; }
    const bf16* s0 = S + (size_t)rm * EV_PAD + 3072; const bf16* s1 = S + (size_t)r * EV_PAD + 3072; const bf16* s2 = S + (size_t)rp * EV_PAD + 3072;
#pragma unroll
    for (int i = 0; i < 4; ++i) { const int c = 8 * lane + 512 * i;
        const v4u a0 = *(const v4u*)(s0 + c), a1 = *(const v4u*)(s1 + c), a2 = *(const v4u*)(s2 + c);
        const unsigned w0[4] = {a0.x, a0.y, a0.z, a0.w}, w1[4] = {a1.x, a1.y, a1.z, a1.w}, w2[4] = {a2.x, a2.y, a2.z, a2.w};
        const float sc = c >= 1024 ? 0.0625f : 1.0f;
        float t0[8], t1[8], t2[8], tb[8];
#pragma unroll
        for (int q4 = 0; q4 < 2; ++q4) { const v4f x0 = *(LP(const v4f))(tab + c + 4 * q4), x1 = *(LP(const v4f))(tab + 2048 + c + 4 * q4), x2 = *(LP(const v4f))(tab + 4096 + c + 4 * q4), xb = *(LP(const v4f))(tab + 6144 + c + 4 * q4);
            t0[4 * q4] = x0.x; t0[4 * q4 + 1] = x0.y; t0[4 * q4 + 2] = x0.z; t0[4 * q4 + 3] = x0.w; t1[4 * q4] = x1.x; t1[4 * q4 + 1] = x1.y; t1[4 * q4 + 2] = x1.z; t1[4 * q4 + 3] = x1.w;
            t2[4 * q4] = x2.x; t2[4 * q4 + 1] = x2.y; t2[4 * q4 + 2] = x2.z; t2[4 * q4 + 3] = x2.w; tb[4 * q4] = xb.x; tb[4 * q4 + 1] = xb.y; tb[4 * q4 + 2] = xb.z; tb[4 * q4 + 3] = xb.w; }
        float val[8];
#pragma unroll
        for (int i2 = 0; i2 < 4; ++i2)
#pragma unroll
            for (int e = 0; e < 2; ++e) { const int di = 2 * i2 + e;
                const float um = hasm ? (e ? bfhi(w0[i2]) : bflo(w0[i2])) : 0.f, u0 = e ? bfhi(w1[i2]) : bflo(w1[i2]), up = hasp ? (e ? bfhi(w2[i2]) : bflo(w2[i2])) : 0.f;
                const float pre = tb[di] + t0[di] * um + t1[di] * u0 + t2[di] * up;
                val[di] = pre * RCPF(1.0f + EXPF(-pre)) * sc; }
        *(v4u*)(QK2 + (size_t)r * 2048 + c) = (v4u){PK2(val[0], val[1]), PK2(val[2], val[3]), PK2(val[4], val[5]), PK2(val[6], val[7])}; }
}

DEV v4f ld4bf(const bf16* p) { const v2u w = *(const v2u*)p; return (v4f){bflo(w.x), bfhi(w.x), bflo(w.y), bfhi(w.y)}; }
DEV float wsum(float v) {
#pragma unroll
    for (int o = 1; o < 64; o <<= 1) v += SHX(v, o);
    return v;
}
DEV float grp16_sum(float v) { v += SHX(v, 1); v += SHX(v, 2); v += SHX(v, 4); v += SHX(v, 8); return v; }
DEV void ld16bf(const bf16* p, float (&o)[16]) { const v4u a = *(const v4u*)p, b = *(const v4u*)(p + 8); const unsigned w[8] = {a.x, a.y, a.z, a.w, b.x, b.y, b.z, b.w};
#pragma unroll
    for (int i = 0; i < 8; ++i) { o[2 * i] = bflo(w[i]); o[2 * i + 1] = bfhi(w[i]); } }
DEV void ld16f(const float* p, float (&o)[16]) {
#pragma unroll
    for (int i = 0; i < 4; ++i) { const v4f a = *(const v4f*)(p + 4 * i); o[4 * i] = a.x; o[4 * i + 1] = a.y; o[4 * i + 2] = a.z; o[4 * i + 3] = a.w; } }
DEV void st16bf(bf16* p, const float (&o)[16]) { *(v4u*)p = (v4u){PK2(o[0], o[1]), PK2(o[2], o[3]), PK2(o[4], o[5]), PK2(o[6], o[7])}; *(v4u*)(p + 8) = (v4u){PK2(o[8], o[9]), PK2(o[10], o[11]), PK2(o[12], o[13]), PK2(o[14], o[15])}; }
template <int CENTER, int GATE>
DEV void head_norm16(const bf16* o0, const bf16* o1, const float* gain, const bf16* gs, bf16* dst) {
    float a[16], b2[16], g[16], gt[16];
    ld16bf(o0, a); ld16bf(o1, b2); ld16f(gain, g); ld16bf(gs, gt);
    float s = 0.f;
#pragma unroll
    for (int i = 0; i < 16; ++i) { a[i] += b2[i]; s += a[i]; }
    if (CENTER) { const float mean = grp16_sum(s) * (1.0f / 256.0f);
#pragma unroll
        for (int i = 0; i < 16; ++i) a[i] -= mean; }
    float q = 0.f;
#pragma unroll
    for (int i = 0; i < 16; ++i) q += a[i] * a[i];
    const float rstd = RSQRTF(grp16_sum(q) * (1.0f / 256.0f) + EPS);
#pragma unroll
    for (int i = 0; i < 16; ++i) { const float sg = RCPF(1.0f + EXPF(-gt[i])); const float gate = GATE ? sg : gt[i] * sg; a[i] = gate * (a[i] * rstd * g[i]); }
    st16bf(dst, a);
}
DEV void merge_even_row(int r, const bf16* S, const bf16* O, const float* gla_norm, const float* ml_norm, bf16* HBo, int lane) {
    const bf16* sr = S + (size_t)r * EV_PAD; const int c = 16 * lane; const bf16* ob = O + (size_t)r * 1024 + c; const size_t os = (size_t)TT * 1024;
    head_norm16<0, 0>(ob, ob + os, gla_norm + c, sr + 2048 + c, HBo + (size_t)r * D + c);
    head_norm16<1, 1>(ob + 2 * os, ob + 3 * os, ml_norm + c, sr + 6144 + c, HBo + (size_t)r * D + 1024 + c);
}
DEV float gelu_tanh(float y) { const float z = 0.7978845608028654f * (y + 0.044715f * y * y * y); const float t = 1.0f - 2.0f * RCPF(1.0f + EXPF(2.0f * z)); return 0.5f * y * (1.0f + t); }
DEV void merge_odd_row(int r, const bf16* S, const bf16* O, const float* s5_d, const float* ret_norm, bf16* GBo, bf16* HBo, int lane) {
    const bf16* sr = S + (size_t)r * OD_COLS; const int c = 16 * lane; const bf16* ob = O + (size_t)r * 1024 + c; const size_t os = (size_t)TT * 1024;
    {
        float y0[16], y1[16], dd[16], u[16];
        ld16bf(ob, y0); ld16bf(ob + os, y1); ld16f(s5_d + c, dd); ld16bf(sr + c, u);
#pragma unroll
        for (int i = 0; i < 16; ++i) {
#ifdef NO_S5
            y0[i] = 0.f; y1[i] = 0.f;
#endif
            y0[i] = gelu_tanh(y0[i] + y1[i] + dd[i] * u[i]); }
        st16bf(GBo + (size_t)r * 1024 + c, y0);
    }
    head_norm16<1, 0>(ob + 2 * os, ob + 3 * os, ret_norm + c, sr + 4096 + c, HBo + (size_t)r * D + 1024 + c);
}

struct EpiGLU {
    static constexpr bool PERM = true, AFTER_DRAIN = false;
    const bf16* G; const float* bias; bf16* O;
    __device__ __forceinline__ void operator()(const pg8::f32x4 (&acc)[2][2][4][2], const pg8::Unit& u, int wr, int wc, int fr, int fq) const {
        const int row0 = u.pm * 256 + wr * 64 + fr, col0 = u.pn * 256 + wc * 32 + 8 * fq;
#pragma unroll
        for (int ai = 0; ai < 2; ++ai)
#pragma unroll
            for (int m = 0; m < 4; ++m) { const size_t row = (size_t)(row0 + ai * 128 + m * 16);
#pragma unroll
                for (int bj = 0; bj < 2; ++bj) { const int col = col0 + bj * 128;
                    const v4u gw = *(const v4u*)(G + row * 1024 + col); const pg8::f32x4 b0 = *(const pg8::f32x4*)(bias + col), b1 = *(const pg8::f32x4*)(bias + col + 4);
                    const pg8::f32x4 v0 = acc[ai][bj][m][0] + b0, v1 = acc[ai][bj][m][1] + b1;
                    v4u w; w.x = pk2(bflo(gw.x) * fast_sigmoid(v0[0]), bfhi(gw.x) * fast_sigmoid(v0[1])); w.y = pk2(bflo(gw.y) * fast_sigmoid(v0[2]), bfhi(gw.y) * fast_sigmoid(v0[3]));
                    w.z = pk2(bflo(gw.z) * fast_sigmoid(v1[0]), bfhi(gw.z) * fast_sigmoid(v1[1])); w.w = pk2(bflo(gw.w) * fast_sigmoid(v1[2]), bfhi(gw.w) * fast_sigmoid(v1[3]));
                    *(v4u*)(O + row * D + col) = w; } }
    }
};

#ifndef SCAN_REPS
#define SCAN_REPS 1
#endif
__device__ __forceinline__ void mixer_phases(const Args& a, unsigned char* ws, LAS unsigned char* lds, const XcdBarrier& bar, int layer, int G, int gw, int ngw, int tid, int lane, int wave) {
#define HB ((bf16*)wsp(ws, WS_HB))
#define S ((bf16*)wsp(ws, WS_S))
#define GT ((float*)wsp(ws, WS_GT))
#define O ((bf16*)wsp(ws, WS_O))
#define GB ((bf16*)wsp(ws, WS_GB))
#define Y ((bf16*)wsp(ws, WS_Y))
    const int ldS = layer == 0 ? EV_PAD : OD_COLS;
    { pg8::Gemm g{HB, (const bf16*)(wsp(ws, (layer == 0 ? WS_WIN_EV : WS_WIN_OD))), TT, ldS, D}; pg8::StaticOrder So; So.init(TT, ldS, G, (int)blockIdx.x);
      EpiS E{S, ldS, GT, layer == 0 ? 28 : -1};
      pg8::gemm_phase<EpiS, pg8::StaticOrder, true, true>(lds, g, So, E); }
    XBAR();
#define QK2 ((bf16*)wsp(ws, WS_QK2))
#define GP ((float*)wsp(ws, WS_GP))
#define QKS ((bf16*)wsp(ws, WS_QKS))
#define GPK ((float*)wsp(ws, WS_GPK))
#define PP ((bf16*)wsp(ws, WS_PP))
#define RS ((float*)wsp(ws, WS_RS))
#define VEC ((float*)wsp(ws, WS_VEC))
    { int t2 = threadIdx.x; asm volatile("" : "+v"(t2)); tid = t2; lane = t2 & 63; wave = __builtin_amdgcn_readfirstlane(t2 >> 6); gw = blockIdx.x * NWAVES + wave; }
    if (layer == 0) {
#ifndef REP_CONV
#define REP_CONV 1
#endif
#ifndef REP_GPREP
#define REP_GPREP 1
#endif
#pragma unroll 1
        for (int r_ = 0; r_ < REP_CONV; ++r_)
        { const bf16* s_ = S; bf16* qk_ = QK2; const float* cw_ = ARG(16); const float* cb_ = ARG(17);
          LAS float* ctab = (LAS float*)(lds + 65536);
          if (r_ == 0) { for (int i = tid; i < 8192; i += NTHR) ctab[i] = i < 6144 ? cw_[i] : cb_[i - 6144]; __syncthreads(); }
          for (int r = gw; r < TT; r += ngw) conv_prep_row_lds(r, s_, qk_, ctab, lane); }
#pragma unroll 1
        for (int r_ = 0; r_ < REP_GPREP; ++r_)
        { int t2 = threadIdx.x; asm volatile("" : "+v"(t2)); gla_prep_loop((int)blockIdx.x, G, S, GT, ARG(13), ARG(14), QKS, VEC, lds, t2); }
        XBAR();
        { int t2 = threadIdx.x; asm volatile("" : "+v"(t2)); mat_prep_loop<0>((int)blockIdx.x, G, QK2, 2048, 0, 1024, 1.0f, GT, ARG(18), GP, GPK, nullptr, PP, RS, lds, t2); }
        XBAR();
    } else {
        { int t2 = threadIdx.x; asm volatile("" : "+v"(t2)); mat_prep_loop<1>((int)blockIdx.x, G, S, OD_COLS, 1024, 2048, 0.0625f, nullptr, nullptr, nullptr, nullptr, ARG(32), PP, RS, lds, t2); }
        XBAR();
    }
#ifdef PRE_SLEEP
    { const unsigned long long t0_ = __builtin_amdgcn_s_memrealtime(); while (__builtin_amdgcn_s_memrealtime() - t0_ < (unsigned long long)(PRE_SLEEP) * 100ull) __builtin_amdgcn_s_sleep(16); XBAR(); }
#endif
    { int t2 = threadIdx.x; asm volatile("" : "+v"(t2)); tid = t2; lane = t2 & 63; wave = __builtin_amdgcn_readfirstlane(t2 >> 6); }
#ifdef PREREAD
    if (layer == 0) {
        const v4u* p0 = (const v4u*)QKS; const v4u* p1 = (const v4u*)QK2; v4u acc = (v4u){0u, 0u, 0u, 0u};
        const unsigned n0 = 2u * TT * 1024 / 8, n1 = (unsigned)TT * 2048 / 8;
        for (unsigned i = blockIdx.x * NTHR + tid; i < n0; i += (unsigned)G * NTHR) { const v4u v = p0[i]; acc.x ^= v.x; acc.y ^= v.y; acc.z ^= v.z; acc.w ^= v.w; }
        if (PREREAD >= 2) for (unsigned i = blockIdx.x * NTHR + tid; i < n1; i += (unsigned)G * NTHR) { const v4u v = p1[i]; acc.x ^= v.x; acc.y ^= v.y; acc.z ^= v.z; acc.w ^= v.w; }
        if ((acc.x ^ acc.y ^ acc.z ^ acc.w) == 0x9e3779b9u && tid == 511) ((unsigned*)wsp(ws, WS_CTL))[8000] = 1u;
        { int t2 = threadIdx.x; asm volatile("" : "+v"(t2)); tid = t2; lane = t2 & 63; wave = __builtin_amdgcn_readfirstlane(t2 >> 6); }
    }
#endif
#ifdef SCAN_PROBE
#pragma unroll
#else
#pragma unroll 1
#endif
    for (int rep = 0; rep < SCAN_REPS; ++rep) {
#ifdef SCAN_PROBE
    const int prb = rep < SCAN_REPS - 1 ? SCAN_PROBE : 0;
#else
    constexpr int prb = 0;
#endif
#ifndef SIB_LOCKSTEP
#define SIB_LOCKSTEP 0
#endif
#define SIBP(ty, un) ((SIB_LOCKSTEP && G >= 2 * MIX_UNITS && SCAN_REPS == 1) ? (unsigned*)(wsp(ws, WS_CTL) + 16384 + ((ty) * 32 + ((un) >> 2)) * 64) : (unsigned*)nullptr)
#define UNIT_OF(w) (NB == 4 ? (((((w) & 7) * 4 + (((w) >> 3) & 15) / 4) << 2) | ((((w) >> 3) & 15) & 3)) : (w))
    if (layer == 0) {
#ifdef SPLIT_L0
        for (int it = blockIdx.x; it < MIX_UNITS; it += G) gla_unit(S, QKS, VEC, O, UNIT_OF(it), lds, tid, SIBP(0, UNIT_OF(it)), prb);
        XBAR();
        for (int it = blockIdx.x; it < 2 * MIX_UNITS; it += G) if (it >= MIX_UNITS) mat_unit<0>(QK2, 2048, 0, 1024, S, EV_PAD, 5120, 1.0f, GP, GPK, PP, RS, O, 1, nullptr, UNIT_OF(it - MIX_UNITS), lds, tid, SIBP(1, UNIT_OF(it - MIX_UNITS)), prb);
        if (false)
#endif
        for (int it = blockIdx.x; it < 2 * MIX_UNITS; it += G) {
            if (it < MIX_UNITS) {
#ifndef REP_GLA
#define REP_GLA 1
#endif
#pragma unroll 1
                for (int r_ = 0; r_ < REP_GLA; ++r_) gla_unit(S, QKS, VEC, O, UNIT_OF(it), lds, tid, SIBP(0, UNIT_OF(it)), prb);
                if (DEFER == 1 && G >= 2 * MIX_UNITS) convert_tiles(a, ws, 1, (int)blockIdx.x * NWAVES + wave, MIX_UNITS * NWAVES, lane);
            } else {
#ifndef REP_ML
#define REP_ML 1
#endif
#pragma unroll 1
                for (int r_ = 0; r_ < REP_ML; ++r_) mat_unit<0>(QK2, 2048, 0, 1024, S, EV_PAD, 5120, 1.0f, GP, GPK, PP, RS, O, 1, nullptr, UNIT_OF(it - MIX_UNITS), lds, tid, SIBP(1, UNIT_OF(it - MIX_UNITS)), prb);
            }
        }
        if (DEFER == 1 && G < 2 * MIX_UNITS) convert_tiles(a, ws, 1, (int)blockIdx.x * NWAVES + wave, G * NWAVES, lane);
    } else {
        const int s5_first = G >= 2 * MIX_UNITS ? MIX_UNITS : 0, s5_wgs = G - s5_first;
#ifndef REP_RET
#define REP_RET 1
#endif
#ifndef REP_S5
#define REP_S5 1
#endif
#pragma unroll 1
        for (int r_ = 0; r_ < REP_RET; ++r_)
        for (int u = blockIdx.x; u < MIX_UNITS; u += G)
            mat_unit<1>(S, OD_COLS, 1024, 2048, S, OD_COLS, 3072, 0.0625f, nullptr, nullptr, PP, RS, O, 0, ARG(32), UNIT_OF(u), lds, tid, SIBP(2, UNIT_OF(u)), prb);
        if (DEFER == 1 && rep == 0 && (int)blockIdx.x >= s5_first && wave >= 4) convert_tiles(a, ws, 2, ((int)blockIdx.x - s5_first) * 4 + (wave - 4), 4 * s5_wgs, lane);
#pragma unroll 1
        for (int r_ = 0; r_ < REP_S5; ++r_)
        if ((int)blockIdx.x >= s5_first && wave < 4) { for (int su = ((int)blockIdx.x - s5_first) * 4 + wave; su < NB * 128; su += 4 * s5_wgs)
            s5_unit(S, OD_COLS, O, ARG(22), ARG(23), ARG(24), ARG(25), ARG(26), ARG(27), ARG(28), su, lds + wave * S5_LDS_PER_WAVE, lane, prb); }
    }
    }
    XBAR();
    { int t2 = threadIdx.x; asm volatile("" : "+v"(t2)); tid = t2; lane = t2 & 63; wave = __builtin_amdgcn_readfirstlane(t2 >> 6); gw = blockIdx.x * NWAVES + wave; }
#ifndef NO_MERGE
    if (layer == 0) { const bf16* s_ = S; const bf16* o_ = O; const float* n0 = ARG(15); const float* n1 = ARG(19); bf16* hb_ = HB; for (int r = gw; r < TT; r += ngw) merge_even_row(r, s_, o_, n0, n1, hb_, lane); }
    else { const bf16* s_ = S; const bf16* o_ = O; const float* n0 = ARG(29); const float* n1 = ARG(33); bf16* gb_ = GB; bf16* hb_ = HB; for (int r = gw; r < TL; r += ngw) merge_odd_row(r, s_, o_, n0, n1, gb_, hb_, lane); }
#endif
    XBAR();
    const int Mo = layer == 0 ? TT : TL;
    if (layer == 1) {
        pg8::Gemm g{GB, (const bf16*)(wsp(ws, WS_WGLU)), TL, 1024, 1024}; pg8::StaticOrder So; So.init(TL, 1024, G, (int)blockIdx.x);
        EpiGLU E{GB, ARG(31), HB};
        pg8::gemm_phase<EpiGLU, pg8::StaticOrder, true, true>(lds, g, So, E);
        XBAR();
    }
    { pg8::Gemm g{HB, (const bf16*)(wsp(ws, (layer == 0 ? WS_WOUT_EV : WS_WOUT_OD))), Mo, D, D}; pg8::SplitOrder So; So.init(Mo - TL, D, G, (int)blockIdx.x);
      EpiF32 E{Y, (float*)(wsp(ws, WS_YCP))};
      pg8::gemm_phase<EpiF32, pg8::SplitOrder, true, true>(lds, g, So, E); }
    XBAR();
}
#undef HB
#undef S
#undef GT
#undef O
#undef GB
#undef Y
#undef QK2
#undef GP
#undef QKS
#undef GPK
#undef PP
#undef RS
#undef VEC
#undef UNIT_OF
#undef SIBP

#ifndef MIXER_ON
#define MIXER_ON 1
#endif
__global__ void __launch_bounds__(NTHR, 2) fwd(Args a) {
    extern __shared__ __attribute__((aligned(16))) unsigned char lds_raw[];
    LAS unsigned char* lds = (LAS unsigned char*)lds_raw;
    const int tid = threadIdx.x, lane = tid & 63, wave = __builtin_amdgcn_readfirstlane(tid >> 6);
    const int G = gridDim.x, gw = blockIdx.x * NWAVES + wave, ngw = G * NWAVES;
    unsigned char* ws = a.ws;
    if (tid < 16) ((LAS unsigned*)(lds + MISC_OFF))[tid] = 0u;
    __syncthreads();
#ifdef PROBE_A
    if (blockIdx.x == 0 && tid == 0) { volatile LAS unsigned* M_ = (volatile LAS unsigned*)(lds + MISC_OFF); const unsigned lo_ = (unsigned)__builtin_amdgcn_s_memrealtime(); if (PROBE_A == 0) M_[6] = lo_; if (PROBE_B == 0) M_[8] = lo_; }
#endif
    XcdBarrier bar = xcd_barrier_post((unsigned*)(wsp(ws, WS_CTL)), (volatile LAS unsigned*)(lds + MISC_OFF));

#ifdef NAN_POISON
    {
        v4u q = (v4u){0xffffffffu, 0xffffffffu, 0xffffffffu, 0xffffffffu};
        for (int i = tid; i < (MISC_OFF) / 16; i += NTHR) ((LAS v4u*)lds)[i] = q;
        { v4u* p = (v4u*)(wsp(ws, WS_MOD)); const size_t n = (WS_WGU - WS_MOD) / 16; for (size_t i = (size_t)blockIdx.x * NTHR + tid; i < n; i += (size_t)G * NTHR) p[i] = q; }
        { v4u* p = (v4u*)(wsp(ws, WS_XC)); const size_t n = (WS_END - WS_XC) / 16; for (size_t i = (size_t)blockIdx.x * NTHR + tid; i < n; i += (size_t)G * NTHR) p[i] = q; }
        { v4u* p = (v4u*)a.out; const size_t n = (size_t)TL * D * 4 / 16; for (size_t i = (size_t)blockIdx.x * NTHR + tid; i < n; i += (size_t)G * NTHR) p[i] = q; }
        __syncthreads();
        XBAR();
    }
#endif
#define MOD ((float*)wsp(ws, WS_MOD))
#define MODP ((float*)wsp(ws, WS_MODP))
#define HB ((bf16*)wsp(ws, WS_HB))
#define HID ((bf16*)wsp(ws, WS_HID))
#define Y ((bf16*)wsp(ws, WS_Y))
#define XC ((bf16*)wsp(ws, WS_XC))
#define XL ((bf16*)wsp(ws, WS_XL))

#ifndef REP_PRO
#define REP_PRO 1
#endif
#ifndef REP_GU
#define REP_GU 1
#endif
#ifndef REP_DN
#define REP_DN 1
#endif
#pragma unroll 1
    for (int rep_ = 0; rep_ < REP_PRO; ++rep_) {
        __syncthreads();
        LAS float* stab = (LAS float*)(lds + 1024);
        { const float* cin = ARG(1); const float* cctx = ARG(3);
        for (int i = tid; i < 5 * D; i += NTHR) { const int r = i >> 11, k = i & (D - 1); const float c = r < 4 ? cin[r * D + k] : cctx[k]; stab[i] = c / (1.0f + expf(-c)); } }
        __syncthreads();
#define MOD_ITEM(it) do { \
            const int l = (it) / (MOD_KC * 72), rem = (it) % (MOD_KC * 72), kc = rem / 72, jb = rem % 72; constexpr int KCH = D / MOD_KC; \
            const float* W = ARG(4) + ((size_t)l * D + kc * KCH) * (NMOD * D) + jb * 256 + lane * 4; \
            f32x4 acc[5]; \
            _Pragma("unroll") for (int r = 0; r < 5; ++r) acc[r] = (f32x4){0.f, 0.f, 0.f, 0.f}; \
            for (int k = 0; k < KCH; k += 8) { f32x4 w[8]; \
                _Pragma("unroll") for (int i = 0; i < 8; ++i) w[i] = *(const f32x4*)(W + (size_t)(k + i) * (NMOD * D)); \
                _Pragma("unroll") for (int i = 0; i < 8; ++i) \
                    _Pragma("unroll") for (int r = 0; r < 5; ++r) acc[r] += stab[r * D + kc * KCH + k + i] * w[i]; } \
            { float* modp = MODP; \
            _Pragma("unroll") for (int r = 0; r < 5; ++r) *(f32x4*)(modp + (((size_t)l * MOD_KC + kc) * 5 + r) * (NMOD * D) + jb * 256 + lane * 4) = acc[r]; } } while (0)
#ifndef DEFER
#define DEFER 1
#endif
#if DEFER == 2
        {
            LAS unsigned* tick = (LAS unsigned*)(lds + MISC_OFF) + 12;
            constexpr int MOD_ITEMS = 2 * MOD_KC * 72, NPAIRS = NT_SET0_D2 / 2;
            const int mod_tk = (MOD_ITEMS + G - 1) / G;
#pragma unroll 1
            for (;;) {
                unsigned tk0 = 0u; if (lane == 0) tk0 = __hip_atomic_fetch_add(tick, 1u, __ATOMIC_RELAXED, __HIP_MEMORY_SCOPE_WORKGROUP);
                const int tk = __builtin_amdgcn_readfirstlane((int)tk0);
                if (tk < mod_tk) { const int it = tk * G + (int)blockIdx.x; if (it < MOD_ITEMS) MOD_ITEM(it); }
                else { const int p = (tk - mod_tk) * G + (int)blockIdx.x; if (p >= NPAIRS) break; convert_pair_set0(a, ws, 2 * p, lane); }
            }
        }
#else
        for (int it = gw; it < 2 * MOD_KC * 72; it += ngw) MOD_ITEM(it);
        convert_tiles(a, ws, 0, gw, ngw, lane);
        if (!DEFER) { convert_tiles(a, ws, 1, gw, ngw, lane); convert_tiles(a, ws, 2, gw, ngw, lane); }
#endif
#undef MOD_ITEM
        { v4u z = (v4u){0u, 0u, 0u, 0u}; v4u* p = (v4u*)(wsp(ws, WS_WIN_EV) + (size_t)EV_COLS * 2048 * 2); const int n16 = (EV_PAD - EV_COLS) * 2048 * 2 / 16;
          for (int i = blockIdx.x * NTHR + tid; i < n16; i += G * NTHR) p[i] = z; }
    }
    XBAR();
    { const float* bmod = ARG(5); const float* modp = MODP; float* modf = MOD;
    for (int i = blockIdx.x * NTHR + tid; i < 2 * 5 * NMOD * D; i += G * NTHR) {
        const int l = i / (5 * NMOD * D), rem = i % (5 * NMOD * D), r = rem / (NMOD * D), j = rem % (NMOD * D);
        float s = bmod[l * (NMOD * D) + j];
        for (int kc = 0; kc < MOD_KC; ++kc) s += modp[(((size_t)l * MOD_KC + kc) * 5 + r) * (NMOD * D) + j];
        modf[i] = s;
    } }
    XBAR();
#ifndef REP_N0
#define REP_N0 1
#endif
#pragma unroll 1
    for (int rep_ = 0; rep_ < REP_N0; ++rep_)
    { NormP p{}; p.xin_lat = ARG(0); p.xin_ctx = ARG(2); p.xin_f32 = 1; p.xout_f32 = 0; p.xout_lat = XL; p.xout_ctx = XC; p.y = nullptr; p.h = HB; p.rows_end = TT; p.has_y = 0; p.has_h = 1; p.w = 0.f; p.lp = 0; p.sp = 0; p.ln = 0; p.sn = 0;
      norm_phase(p, MOD, ARG(6), ARG(7), lds, gw, ngw, tid, lane); }
    XBAR();

#pragma unroll 1
    for (int layer = 0; layer < 2; ++layer) {
#pragma unroll 1
        for (int half = 0; half < 2; ++half) {
            const int Mrows = (layer == 1 && half == 1) ? TL : TT;
#if MIXER_ON
            if (half == 1) {
                mixer_phases(a, ws, lds, bar, layer, G, gw, ngw, tid, lane, wave);
                NormP p{}; p.xin_lat = XL; p.xin_ctx = XC; p.xin_f32 = 0; p.xout_f32 = 0; p.xout_lat = XL; p.xout_ctx = XC; p.y = Y; p.y_ctx = (const float*)(wsp(ws, WS_YCP)); p.h = HB; p.rows_end = Mrows; p.has_y = 1; p.has_h = 1; p.w = 1.0f; p.lp = layer; p.sp = 1; p.ln = layer; p.sn = 2;
                norm_phase(p, MOD, ARG(6), ARG(7), lds, gw, ngw, tid, lane);
                XBAR();
            }
#endif
            const int sub = half * 2;
#pragma unroll 1
            for (int rep_ = 0; rep_ < REP_GU; ++rep_) { pg8::Gemm g{HB, (const bf16*)(wsp(ws, WS_WGU) + (size_t)(layer * 2 + half) * SZ_WGU), Mrows, 2 * DFF, D}; pg8::StaticOrder S; S.init(Mrows, 2 * DFF, G, (int)blockIdx.x);
              EpiSwiGLU E{HID, DFF};
              pg8::gemm_phase<EpiSwiGLU, pg8::StaticOrder, true, true>(lds, g, S, E);
              if (DEFER == 2 && rep_ == 0 && !(layer == 1 && half == 1)) {
                  const int rem = ((Mrows / 256) * (2 * DFF / 256)) % G, nidle = rem ? G - rem : G, me = rem ? (int)blockIdx.x - rem : (int)blockIdx.x;
                  if (me >= 0) { int t2 = threadIdx.x; asm volatile("" : "+v"(t2)); convert_tiles(a, ws, layer * 2 + half + 1, me * NWAVES + __builtin_amdgcn_readfirstlane(t2 >> 6), nidle * NWAVES, t2 & 63); } }
              if (rep_ + 1 < REP_GU) XBAR(); }
            XBAR();
#pragma unroll 1
            for (int rep_ = 0; rep_ < REP_DN; ++rep_) { pg8::Gemm g{HID, (const bf16*)(wsp(ws, WS_WD) + (size_t)(layer * 2 + half) * SZ_WD), Mrows, D, DFF}; pg8::SplitOrder S; S.init(Mrows - TL, DFF, G, (int)blockIdx.x);
              EpiF32 E{Y, (float*)(wsp(ws, WS_YCP))};
              pg8::gemm_phase<EpiF32, pg8::SplitOrder, true, true>(lds, g, S, E);
              if (rep_ + 1 < REP_DN) XBAR(); }
            XBAR();
            { NormP p{}; const bool first = (layer == 0 && half == 0);
              const bool lastp = (layer == 1 && half == 1);
              p.xin_lat = first ? (const void*)ARG(0) : (const void*)XL; p.xin_ctx = first ? (const void*)ARG(2) : (const void*)XC; p.xin_f32 = first ? 1 : 0;
              p.xout_lat = lastp ? (void*)a.out : (void*)XL; p.xout_ctx = XC; p.xout_f32 = lastp ? 1 : 0; p.y = Y; p.y_ctx = (const float*)(wsp(ws, WS_YCP)); p.h = HB; p.rows_end = Mrows; p.has_y = 1; p.w = 0.5f; p.lp = layer; p.sp = sub;
              if (half == 0) { p.has_h = 1; p.ln = layer; p.sn = MIXER_ON ? 1 : 2; }
              else if (layer == 0) { p.has_h = 1; p.ln = 1; p.sn = 0; }
              else { p.has_h = 0; p.ln = 0; p.sn = 0; }
              norm_phase(p, MOD, ARG(6), ARG(7), lds, gw, ngw, tid, lane); }
            if (!(layer == 1 && half == 1)) XBAR();
        }
    }
#ifdef PROBE_A
    XBAR();
    if (blockIdx.x == 0 && threadIdx.x == 0) { volatile LAS unsigned* M_ = (volatile LAS unsigned*)(lds + MISC_OFF);
        const unsigned ticks = (M_[7] - M_[6]) + (PROBE_B >= 0 ? (M_[9] - M_[8]) : 0u);
        const unsigned long long t0 = __builtin_amdgcn_s_memrealtime();
        while (__builtin_amdgcn_s_memrealtime() - t0 < 8ull * ticks) __builtin_amdgcn_s_sleep(8); }
#endif
}

#undef MOD
#undef MODP
#undef HB
#undef HID
#undef Y
#undef XC
#undef XL
extern "C" void kernel_launch(void* const* d_in, const int* in_sizes, int n_in, void* d_out, int out_size, void* d_ws, size_t ws_size, hipStream_t stream) {
    static int grid = 0;
    if (grid == 0) {
        if (n_in != 34 || out_size != TL * D || ws_size < WS_END) { fprintf(stderr, "kernel_launch: unexpected shapes (n_in %d out %d ws %zu need %zu)\n", n_in, out_size, ws_size, (size_t)WS_END); grid = -1; return; }
        int dev = 0, cus = 0, per_cu = 0;
        if (hipGetDevice(&dev) != hipSuccess || hipDeviceGetAttribute(&cus, hipDeviceAttributeMultiprocessorCount, dev) != hipSuccess) { grid = -1; return; }
        if (hipFuncSetAttribute((const void*)fwd, hipFuncAttributeMaxDynamicSharedMemorySize, LDS_BYTES) != hipSuccess) { fprintf(stderr, "kernel_launch: hipFuncSetAttribute failed\n"); grid = -1; return; }
        if (hipOccupancyMaxActiveBlocksPerMultiprocessor(&per_cu, (const void*)fwd, NTHR, LDS_BYTES) != hipSuccess || per_cu < 1) { fprintf(stderr, "kernel_launch: occupancy query says %d\n", per_cu); }
        (void)hipGetLastError();
        grid = cus;
    }
    if (grid < 0) return;
    if (hipMemsetAsync((char*)d_ws + WS_CTL, 0, CTL_ZERO_BYTES, stream) != hipSuccess) return;
    Args a{};
    for (int i = 0; i < 34; ++i) a.in[i] = (const float*)d_in[i];
    a.out = (float*)d_out; a.ws = (unsigned char*)d_ws;
    hipLaunchKernelGGL(fwd, dim3(grid), dim3(NTHR), LDS_BYTES, stream, a);
}
```
